# Optimizing an MI355X kernel written in HIP

```python
import math
import jax
import jax.numpy as jnp
from jax import lax
import numpy as np

D_MODEL = 1024
BATCH = 2
SEQ = 16384
DEPTH = 2

CTX_LEN = 256
GRID_W = 64
ROPE_THETA = 10000.0
NORM_EPS = 1e-6
Q_BLOCK = 128

DIFF_HEADS = 4
DIFF_DK = 64
DIFF_DV = 2 * DIFF_DK
MLA_HEADS = 8
MLA_Q_LORA = 384
MLA_KV_LORA = 256
MLA_NOPE = 64
MLA_ROPE = 32
MLA_DV = 64
ATT_SPLITS = (2 * DIFF_HEADS * DIFF_DK, 2 * DIFF_HEADS * DIFF_DK, DIFF_HEADS * DIFF_DV,
              MLA_Q_LORA, MLA_KV_LORA, MLA_ROPE)
ATT_IN = sum(ATT_SPLITS)
D_MIX = DIFF_HEADS * DIFF_DV + MLA_HEADS * MLA_DV

RWKV_HEADS = 8
RWKV_N = 64
RWKV_C = RWKV_HEADS * RWKV_N
DECAY_LORA = 64
ICLR_LORA = 64
GATE_LORA = 128
RWKV_SPLITS = (RWKV_C, RWKV_C, RWKV_C, 2 * DECAY_LORA, 2 * ICLR_LORA, GATE_LORA)
RWKV_IN = sum(RWKV_SPLITS)
RWKV_LN_EPS = 64e-5
MLSTM_HEADS = 4
MLSTM_DK = 64
MLSTM_DV = 128
MLSTM_CHUNK = 64
GATE_CAP = 15.0
MLSTM_SPLITS = (MLSTM_HEADS * MLSTM_DK, MLSTM_HEADS * MLSTM_DK, MLSTM_HEADS * MLSTM_DV,
                MLSTM_HEADS * MLSTM_DV, 2 * 2 * MLSTM_HEADS)
REC_IN = RWKV_IN + sum(MLSTM_SPLITS)

N_EXPERTS = 32
TOP_K = 4
D_EXPERT = 1024
SWIGLU_ALPHA = 1.702
SWIGLU_LIMIT = 7.0
MOE_BLOCK = 128

kernel_name = 'hybrid_diffattn_mla_rwkv7_mlstm_moe_prefix_dit'


def _rmsnorm(x, w):
    xf = x.astype(jnp.float32)
    y = xf * lax.rsqrt(jnp.mean(xf * xf, axis=-1, keepdims=True) + NORM_EPS)
    return (y * w.astype(jnp.float32)).astype(x.dtype)


def _head_layernorm(y, w, b):
    yf = y.astype(jnp.float32)
    mean = jnp.mean(yf, axis=-1, keepdims=True)
    var = jnp.mean(jnp.square(yf - mean), axis=-1, keepdims=True)
    return (yf - mean) * lax.rsqrt(var + RWKV_LN_EPS) * w.astype(jnp.float32) + b.astype(jnp.float32)


def _ada(cond, w, b):
    return jnp.split(jax.nn.silu(cond) @ w + b, 6, axis=-1)


def _modulate(x, shift, scale):
    return x * (1 + scale) + shift


def _split(p, sizes):
    return jnp.split(p, np.cumsum(sizes)[:-1].tolist(), axis=-1)


def _heads(t, n_heads):
    return t.reshape(*t.shape[:-1], n_heads, t.shape[-1] // n_heads)


def _axial_rope(n_tok, rot_dim, dtype):
    rows = n_tok // GRID_W
    t = jnp.arange(rows * GRID_W)
    row = (t // GRID_W).astype(jnp.float32)
    col = (t % GRID_W).astype(jnp.float32)
    n_freq = rot_dim // 4
    inv = ROPE_THETA ** (-jnp.arange(n_freq, dtype=jnp.float32) / n_freq)
    ang = jnp.concatenate([row[:, None] * inv, col[:, None] * inv], axis=-1)
    return jnp.cos(ang).astype(dtype), jnp.sin(ang).astype(dtype)


def _apply_rope(x, cos, sin):
    half = x.shape[-1] // 2
    x1, x2 = x[..., :half], x[..., half:]
    cos, sin = cos[None, :, None, :], sin[None, :, None, :]
    return jnp.concatenate([x1 * cos - x2 * sin, x1 * sin + x2 * cos], axis=-1)


def _probs(q, k, scale):
    s = jnp.einsum('bqhd,bkhd->bhqk', q, k).astype(jnp.float32) * scale
    return jax.nn.softmax(s, axis=-1)


def _attend(q, k, v, scale):
    return jnp.einsum('bhqk,bkhe->bqhe', _probs(q, k, scale).astype(v.dtype), v)


def _diff_attend(q1, q2, k1, k2, v, lam, scale):
    p = _probs(q1, k1, scale) - lam * _probs(q2, k2, scale)
    return jnp.einsum('bhqk,bkhe->bqhe', p.astype(v.dtype), v)


def _map_query_blocks(fn, *qs):
    b, s = qs[0].shape[:2]
    nb = s // Q_BLOCK
    blocks = tuple(jnp.moveaxis(q.reshape(b, nb, Q_BLOCK, *q.shape[2:]), 1, 0) for q in qs)
    out = lax.map(lambda a: fn(*a), blocks)
    return jnp.moveaxis(out, 0, 1).reshape(b, s, *out.shape[3:])


def _attention_group(a_lat, a_ctx, w_in, lam_vecs, subln_w, q_norm_w, kv_norm_w, w_uq, w_ukv,
                     lambda_init, rope_diff, rope_mla, need_ctx):
    def project(a):
        b, n = a.shape[:2]
        dq, dk, dv, cq, ckv, kr = _split(a @ w_in, ATT_SPLITS)
        dq = dq.reshape(b, n, 2 * DIFF_HEADS, DIFF_DK)
        dk = dk.reshape(b, n, 2 * DIFF_HEADS, DIFF_DK)
        dv = dv.reshape(b, n, DIFF_HEADS, DIFF_DV)
        mq = (_rmsnorm(cq, q_norm_w) @ w_uq).reshape(b, n, MLA_HEADS, MLA_NOPE + MLA_ROPE)
        mkv = (_rmsnorm(ckv, kv_norm_w) @ w_ukv).reshape(b, n, MLA_HEADS, MLA_NOPE + MLA_DV)
        return dq, dk, dv, mq, mkv, kr[:, :, None, :]

    def mla_kv(mkv, kr):
        b, n = mkv.shape[:2]
        k = jnp.concatenate([mkv[..., :MLA_NOPE], jnp.broadcast_to(kr, (b, n, MLA_HEADS, MLA_ROPE))], axis=-1)
        return k, mkv[..., MLA_NOPE:]

    dq_l, dk_l, dv_l, mq_l, mkv_l, kr_l = project(a_lat)
    dq_c, dk_c, dv_c, mq_c, mkv_c, kr_c = project(a_ctx)
    dq_l = _apply_rope(dq_l, *rope_diff)
    dk_l = _apply_rope(dk_l, *rope_diff)
    mq_l = jnp.concatenate([mq_l[..., :MLA_NOPE], _apply_rope(mq_l[..., MLA_NOPE:], *rope_mla)], axis=-1)
    kr_l = _apply_rope(kr_l, *rope_mla)
    mk_l, mv_l = mla_kv(mkv_l, kr_l)
    mk_c, mv_c = mla_kv(mkv_c, kr_c)

    lq1, lk1, lq2, lk2 = lam_vecs.astype(jnp.float32)
    lam = jnp.exp(jnp.sum(lq1 * lk1)) - jnp.exp(jnp.sum(lq2 * lk2)) + lambda_init
    d_scale = DIFF_DK ** -0.5
    m_scale = (MLA_NOPE + MLA_ROPE) ** -0.5

    dk_all = jnp.concatenate([dk_c, dk_l], axis=1)
    k1_all, k2_all = dk_all[:, :, 0::2], dk_all[:, :, 1::2]
    dv_all = jnp.concatenate([dv_c, dv_l], axis=1)
    mk_all = jnp.concatenate([mk_c, mk_l], axis=1)
    mv_all = jnp.concatenate([mv_c, mv_l], axis=1)
    diff_l = _map_query_blocks(lambda q1, q2: _diff_attend(q1, q2, k1_all, k2_all, dv_all, lam, d_scale),
                               dq_l[:, :, 0::2], dq_l[:, :, 1::2])
    mla_l = _map_query_blocks(lambda q: _attend(q, mk_all, mv_all, m_scale), mq_l)

    def merge(diff_o, mla_o):
        b, n = diff_o.shape[:2]
        diff_o = _rmsnorm(diff_o, subln_w) * (1 - lambda_init)
        return jnp.concatenate([diff_o.reshape(b, n, DIFF_HEADS * DIFF_DV),
                                mla_o.reshape(b, n, MLA_HEADS * MLA_DV)], axis=-1)

    out_l = merge(diff_l, mla_l)
    if not need_ctx:
        return out_l, None
    diff_c = _diff_attend(dq_c[:, :, 0::2], dq_c[:, :, 1::2], dk_c[:, :, 0::2], dk_c[:, :, 1::2], dv_c, lam, d_scale)
    mla_c = _attend(mq_c, mk_c, mv_c, m_scale)
    return out_l, merge(diff_c, mla_c)


def _centred_shift(u):
    prev = jnp.pad(u[:, :-1], ((0, 0), (1, 0), (0, 0)))
    nxt = jnp.pad(u[:, 1:], ((0, 0), (0, 1), (0, 0)))
    return 0.5 * (prev + nxt) - u


def _bidir(x_fwd, x_bwd):
    return jnp.concatenate([x_fwd, jnp.flip(x_bwd, axis=1)], axis=0)


def _unbidir(y):
    b = y.shape[0] // 2
    return y[:b] + jnp.flip(y[b:], axis=1)


def _rwkv_prep(p, mu, w0, w2, a0, a2, g2, k_k, k_a):
    b, n = p.shape[:2]
    u = p + mu * _centred_shift(p)
    r, k, v, wd, ad, gd = _split(u, RWKV_SPLITS)
    wd = wd.reshape(b, n, 2, DECAY_LORA)
    ad = ad.reshape(b, n, 2, ICLR_LORA)
    w_log = -jax.nn.softplus(-(w0 + jnp.einsum('btzr,zrc->btzc', jnp.tanh(wd), w2))) - 0.5
    decay = jnp.exp(-jnp.exp(w_log.astype(jnp.float32)))
    a = jax.nn.sigmoid(a0 + jnp.einsum('btzr,zrc->btzc', ad, a2))
    g = jax.nn.sigmoid(gd) @ g2
    kk = _heads(k * k_k, RWKV_HEADS).astype(jnp.float32)
    kk = kk * lax.rsqrt(jnp.maximum(jnp.sum(kk * kk, axis=-1, keepdims=True), 1e-24))
    k_dir = _heads(k[:, :, None] * (1 + (a - 1) * k_a), RWKV_HEADS)
    return (_heads(r, RWKV_HEADS), _heads(v, RWKV_HEADS), kk, k_dir,
            _heads(a, RWKV_HEADS), _heads(decay, RWKV_HEADS), g)


def _rwkv_scan_inputs(r, v, kk, k_dir, a, decay):
    f = lambda t: t.astype(jnp.float32)
    return (f(_bidir(r, r)), _bidir(decay[:, :, 0], decay[:, :, 1]),
            f(_bidir(k_dir[:, :, 0], k_dir[:, :, 1])), f(_bidir(v, v)), _bidir(-kk, -kk),
            f(_bidir(kk * a[:, :, 0], kk * a[:, :, 1])))


def _rwkv_scan(state, r, w, k, v, a, b):
    def step(s, inp):
        rt, wt, kt, vt, at, bt = inp
        sa = jnp.einsum('zhij,zhj->zhi', s, at)
        s = s * wt[:, :, None, :] + sa[..., None] * bt[:, :, None, :] + vt[..., None] * kt[:, :, None, :]
        return s, jnp.einsum('zhij,zhj->zhi', s, rt)
    xs = tuple(jnp.moveaxis(t, 1, 0) for t in (r, w, k, v, a, b))
    s, y = lax.scan(step, state, xs)
    return s, jnp.moveaxis(y, 0, 1)


def _rwkv_out(y, r, v, k_dir, g, r_k, ln_w, ln_b):
    b, n = r.shape[:2]
    yn = _head_layernorm(_unbidir(y), _heads(ln_w, RWKV_HEADS), _heads(ln_b, RWKV_HEADS))
    bonus = jnp.sum(jnp.sum(r[:, :, None] * k_dir * r_k, axis=-1, keepdims=True), axis=2)
    out = yn.astype(r.dtype) + bonus * v
    return out.reshape(b, n, RWKV_C) * g


def _mlstm_prep(p, gate_b):
    b, n = p.shape[:2]
    q, k, v, o, gates = _split(p, MLSTM_SPLITS)
    q = _heads(q, MLSTM_HEADS)
    k = _heads(k, MLSTM_HEADS) * MLSTM_DK ** -0.5
    v = _heads(v, MLSTM_HEADS)
    gates = gates.reshape(b, n, 2, 2, MLSTM_HEADS).astype(jnp.float32) + gate_b.astype(jnp.float32)
    gates = GATE_CAP * jnp.tanh(gates / GATE_CAP)
    ig = gates[:, :, :, 0]
    lf = jax.nn.log_sigmoid(gates[:, :, :, 1])
    return q, k, v, ig, lf, jax.nn.sigmoid(o)


def _mlstm_scan_inputs(q, k, v, ig, lf):
    f = lambda t: t.astype(jnp.float32)
    return (f(_bidir(q, q)), f(_bidir(k, k)), f(_bidir(v, v)),
            _bidir(ig[:, :, 0], ig[:, :, 1]), _bidir(lf[:, :, 0], lf[:, :, 1]))


def _mlstm_chunkwise(state, q, k, v, ig, lf):
    z, t, hh = ig.shape
    nc = t // MLSTM_CHUNK

    def chunks(a):
        a = a.reshape(z, nc, MLSTM_CHUNK, hh, *a.shape[3:])
        return jnp.moveaxis(jnp.moveaxis(a, 1, 0), 3, 2)

    mask = jnp.tril(jnp.ones((MLSTM_CHUNK, MLSTM_CHUNK), dtype=bool))

    def step(carry, inp):
        c_st, n_st, m_st = carry
        qc, kc, vc, ic, fc = inp
        bcum = jnp.cumsum(fc, axis=-1)
        g_inter = bcum + m_st[..., None]
        d_log = bcum[..., :, None] - bcum[..., None, :] + ic[..., None, :]
        d_log = jnp.where(mask, d_log, -jnp.inf)
        m_out = jnp.maximum(g_inter, jnp.max(d_log, axis=-1))
        d_w = jnp.exp(d_log - m_out[..., None])
        g_w = jnp.exp(g_inter - m_out)
        qk = jnp.einsum('zhtd,zhsd->zhts', qc, kc) * d_w
        num = g_w[..., None] * jnp.einsum('zhvd,zhtd->zhtv', c_st, qc) + jnp.einsum('zhts,zhsv->zhtv', qk, vc)
        den = g_w * jnp.einsum('zhd,zhtd->zht', n_st, qc) + jnp.sum(qk, axis=-1)
        h = num / jnp.maximum(jnp.abs(den), jnp.exp(-m_out))[..., None]
        b_last = bcum[..., -1]
        u = b_last[..., None] - bcum + ic
        m_new = jnp.maximum(b_last + m_st, jnp.max(u, axis=-1))
        s_w = jnp.exp(u - m_new[..., None])
        carry_decay = jnp.exp(b_last + m_st - m_new)
        c_st = carry_decay[..., None, None] * c_st + jnp.einsum('zhsv,zhsd->zhvd', vc * s_w[..., None], kc)
        n_st = carry_decay[..., None] * n_st + jnp.einsum('zhs,zhsd->zhd', s_w, kc)
        return (c_st, n_st, m_new), h

    state, h = lax.scan(step, state, tuple(chunks(a) for a in (q, k, v, ig, lf)))
    h = jnp.moveaxis(jnp.moveaxis(h, 2, 3), 0, 1).reshape(z, t, hh, MLSTM_DV)
    return state, h


def _mlstm_out(h, o, norm_w):
    b, n = o.shape[:2]
    h = _unbidir(h).astype(o.dtype)
    h = _rmsnorm(h, norm_w.reshape(MLSTM_HEADS, MLSTM_DV))
    return h.reshape(b, n, MLSTM_HEADS * MLSTM_DV) * o


def _recurrent_group(a_lat, a_ctx, w_in, mu, w0, w2, a0, a2, g2, k_k, k_a, r_k, ln_w, ln_b,
                     gate_b, norm_w, need_ctx):
    p_lat, p_ctx = a_lat @ w_in, a_ctx @ w_in
    z = 2 * a_lat.shape[0]
    rw = (mu, w0, w2, a0, a2, g2, k_k, k_a)
    rc = _rwkv_prep(p_ctx[..., :RWKV_IN], *rw)
    rl = _rwkv_prep(p_lat[..., :RWKV_IN], *rw)
    s0 = jnp.zeros((z, RWKV_HEADS, RWKV_N, RWKV_N), jnp.float32)
    s_ctx, y_ctx = _rwkv_scan(s0, *_rwkv_scan_inputs(*rc[:6]))
    _, y_lat = _rwkv_scan(s_ctx, *_rwkv_scan_inputs(*rl[:6]))
    mc = _mlstm_prep(p_ctx[..., RWKV_IN:], gate_b)
    ml = _mlstm_prep(p_lat[..., RWKV_IN:], gate_b)
    st0 = (jnp.zeros((z, MLSTM_HEADS, MLSTM_DV, MLSTM_DK), jnp.float32),
           jnp.zeros((z, MLSTM_HEADS, MLSTM_DK), jnp.float32),
           jnp.zeros((z, MLSTM_HEADS), jnp.float32))
    st_ctx, h_ctx = _mlstm_chunkwise(st0, *_mlstm_scan_inputs(*mc[:5]))
    _, h_lat = _mlstm_chunkwise(st_ctx, *_mlstm_scan_inputs(*ml[:5]))

    out_l = jnp.concatenate([_rwkv_out(y_lat, rl[0], rl[1], rl[3], rl[6], r_k, ln_w, ln_b),
                             _mlstm_out(h_lat, ml[5], norm_w)], axis=-1)
    if not need_ctx:
        return out_l, None
    out_c = jnp.concatenate([_rwkv_out(y_ctx, rc[0], rc[1], rc[3], rc[6], r_k, ln_w, ln_b),
                             _mlstm_out(h_ctx, mc[5], norm_w)], axis=-1)
    return out_l, out_c


def _clamped_swiglu(hdn):
    x_glu, x_lin = hdn[..., ::2], hdn[..., 1::2]
    x_glu = jnp.minimum(x_glu, SWIGLU_LIMIT)
    x_lin = jnp.clip(x_lin, -SWIGLU_LIMIT, SWIGLU_LIMIT)
    return x_glu * jax.nn.sigmoid(SWIGLU_ALPHA * x_glu) * (x_lin + 1)


def _moe(x, router_w, router_b, w1, b1, w2, b2):
    n_tok, d = x.shape
    logits = (x @ router_w + router_b).astype(jnp.float32)
    top_val, top_idx = lax.top_k(logits, TOP_K)
    gate = jax.nn.softmax(top_val, axis=-1).astype(x.dtype)
    flat_e = top_idx.reshape(-1)
    m = flat_e.shape[0]
    order = jnp.argsort(flat_e)
    e_sorted = flat_e[order]
    tok_sorted = order // TOP_K
    counts = jnp.bincount(flat_e, length=N_EXPERTS)
    padded = (counts + MOE_BLOCK - 1) // MOE_BLOCK * MOE_BLOCK
    pad_end = jnp.cumsum(padded)
    pad_start = pad_end - padded
    start = jnp.cumsum(counts) - counts
    dest = pad_start[e_sorted] + jnp.arange(m) - start[e_sorted]
    n_blocks = -(-m // MOE_BLOCK) + N_EXPERTS
    rows = n_blocks * MOE_BLOCK
    buf = jnp.zeros((rows, d), x.dtype).at[dest].set(x[tok_sorted])
    block_e = jnp.minimum(jnp.searchsorted(pad_end, jnp.arange(n_blocks) * MOE_BLOCK, side='right'),
                          N_EXPERTS - 1)

    def expert_block(args):
        xb, e = args
        hdn = xb @ w1[e] + b1[e]
        return _clamped_swiglu(hdn) @ w2[e] + b2[e]

    y_buf = lax.map(expert_block, (buf.reshape(n_blocks, MOE_BLOCK, d), block_e))
    y_rows = y_buf.reshape(rows, d)[dest] * gate.reshape(-1)[order][:, None]
    return jax.ops.segment_sum(y_rows, tok_sorted, num_segments=n_tok)


def setup_inputs(seed: int = 0) -> dict:
    key = jax.random.key(seed)
    ks = iter(jax.random.split(key, 48))
    f32 = jnp.float32

    def nrm(shape, scale):
        return jax.random.normal(next(ks), shape, f32) * scale

    def gain(shape):
        return 1.0 + nrm(shape, 0.02)

    def unif(shape, lo, hi):
        return jax.random.uniform(next(ks), shape, f32, lo, hi)

    n_att = (DEPTH + 1) // 2
    n_rec = DEPTH // 2
    d = D_MODEL
    return {
        'x': nrm((BATCH, SEQ, d), 1.0),
        'c': nrm((BATCH, d), 1.0),
        'ctx': nrm((BATCH, CTX_LEN, d), 1.0),
        'c_ctx': nrm((d,), 1.0),
        'norm_mix_w': gain((DEPTH, d)),
        'norm_ffn_w': gain((DEPTH, d)),
        'ada_w': nrm((DEPTH, d, 6 * d), 0.5 * d ** -0.5),
        'ada_b': nrm((DEPTH, 6 * d), 0.02),
        'w_out': nrm((DEPTH, D_MIX, d), D_MIX ** -0.5),
        'router_w': nrm((DEPTH, d, N_EXPERTS), d ** -0.5),
        'router_b': nrm((DEPTH, N_EXPERTS), 0.01),
        'moe_w1': nrm((DEPTH, N_EXPERTS, d, 2 * D_EXPERT), d ** -0.5),
        'moe_b1': nrm((DEPTH, N_EXPERTS, 2 * D_EXPERT), 0.02),
        'moe_w2': nrm((DEPTH, N_EXPERTS, D_EXPERT, d), D_EXPERT ** -0.5),
        'moe_b2': nrm((DEPTH, N_EXPERTS, d), 0.02),
        'att_w_in': nrm((n_att, d, ATT_IN), d ** -0.5),
        'diff_lambda': nrm((n_att, 4, DIFF_DK), 0.1),
        'diff_subln_w': gain((n_att, DIFF_DV)),
        'mla_q_norm_w': gain((n_att, MLA_Q_LORA)),
        'mla_kv_norm_w': gain((n_att, MLA_KV_LORA)),
        'mla_w_uq': nrm((n_att, MLA_Q_LORA, MLA_HEADS * (MLA_NOPE + MLA_ROPE)), MLA_Q_LORA ** -0.5),
        'mla_w_ukv': nrm((n_att, MLA_KV_LORA, MLA_HEADS * (MLA_NOPE + MLA_DV)), MLA_KV_LORA ** -0.5),
        'rec_w_in': nrm((n_rec, d, REC_IN), d ** -0.5),
        'rwkv_mu': unif((n_rec, RWKV_IN), 0.0, 1.0),
        'rwkv_w0': unif((n_rec, 2, RWKV_C), -6.0, -1.0),
        'rwkv_w2': nrm((n_rec, 2, DECAY_LORA, RWKV_C), 0.1 * DECAY_LORA ** -0.5),
        'rwkv_a0': nrm((n_rec, 2, RWKV_C), 0.1),
        'rwkv_a2': nrm((n_rec, 2, ICLR_LORA, RWKV_C), ICLR_LORA ** -0.5),
        'rwkv_g2': nrm((n_rec, GATE_LORA, RWKV_C), GATE_LORA ** -0.5),
        'rwkv_kk': 0.85 + nrm((n_rec, RWKV_C), 0.05),
        'rwkv_ka': 1.0 + nrm((n_rec, RWKV_C), 0.05),
        'rwkv_rk': nrm((n_rec, RWKV_HEADS, RWKV_N), 0.1),
        'rwkv_ln_w': gain((n_rec, RWKV_C)),
        'rwkv_ln_b': nrm((n_rec, RWKV_C), 0.02),
        'mlstm_gate_b': jnp.concatenate([nrm((n_rec, 2, 1, MLSTM_HEADS), 0.5),
                                         unif((n_rec, 2, 1, MLSTM_HEADS), 3.0, 6.0)], axis=2),
        'mlstm_norm_w': gain((n_rec, MLSTM_HEADS * MLSTM_DV)),
        'final_norm_w': gain((d,)),
    }


def reference(x, c, ctx, c_ctx, norm_mix_w, norm_ffn_w, ada_w, ada_b, w_out, router_w, router_b,
              moe_w1, moe_b1, moe_w2, moe_b2, att_w_in, diff_lambda, diff_subln_w, mla_q_norm_w,
              mla_kv_norm_w, mla_w_uq, mla_w_ukv, rec_w_in, rwkv_mu, rwkv_w0, rwkv_w2, rwkv_a0, rwkv_a2,
              rwkv_g2, rwkv_kk, rwkv_ka, rwkv_rk, rwkv_ln_w, rwkv_ln_b, mlstm_gate_b, mlstm_norm_w,
              final_norm_w):
    n_lat = x.shape[1]
    rope_diff = _axial_rope(n_lat, DIFF_DK, x.dtype)
    rope_mla = _axial_rope(n_lat, MLA_ROPE, x.dtype)
    h, hc = x, ctx
    for layer in range(DEPTH):
        last = layer == DEPTH - 1
        i = layer // 2
        shift_m, scale_m, gate_m, shift_f, scale_f, gate_f = [t[:, None, :] for t in _ada(c, ada_w[layer], ada_b[layer])]
        cshift_m, cscale_m, cgate_m, cshift_f, cscale_f, cgate_f = _ada(c_ctx, ada_w[layer], ada_b[layer])
        a_lat = _modulate(_rmsnorm(h, norm_mix_w[layer]), shift_m, scale_m)
        a_ctx = _modulate(_rmsnorm(hc, norm_mix_w[layer]), cshift_m, cscale_m)
        if layer % 2 == 0:
            lambda_init = 0.8 - 0.6 * math.exp(-0.3 * layer)
            m_lat, m_ctx = _attention_group(a_lat, a_ctx, att_w_in[i], diff_lambda[i], diff_subln_w[i],
                                            mla_q_norm_w[i], mla_kv_norm_w[i], mla_w_uq[i], mla_w_ukv[i],
                                            lambda_init, rope_diff, rope_mla, not last)
        else:
            m_lat, m_ctx = _recurrent_group(a_lat, a_ctx, rec_w_in[i], rwkv_mu[i], rwkv_w0[i], rwkv_w2[i],
                                            rwkv_a0[i], rwkv_a2[i], rwkv_g2[i], rwkv_kk[i], rwkv_ka[i],
                                            rwkv_rk[i], rwkv_ln_w[i], rwkv_ln_b[i], mlstm_gate_b[i],
                                            mlstm_norm_w[i], not last)
        h = h + gate_m * (m_lat @ w_out[layer])
        f_lat = _modulate(_rmsnorm(h, norm_ffn_w[layer]), shift_f, scale_f)
        b, n, d = h.shape
        moe_args = (router_w[layer], router_b[layer], moe_w1[layer], moe_b1[layer], moe_w2[layer], moe_b2[layer])
        if last:
            h = h + gate_f * _moe(f_lat.reshape(b * n, d), *moe_args).reshape(b, n, d)
        else:
            hc = hc + cgate_m * (m_ctx @ w_out[layer])
            f_ctx = _modulate(_rmsnorm(hc, norm_ffn_w[layer]), cshift_f, cscale_f)
            n_c = hc.shape[1]
            y = _moe(jnp.concatenate([f_ctx.reshape(b * n_c, d), f_lat.reshape(b * n, d)], axis=0), *moe_args)
            hc = hc + cgate_f * y[:b * n_c].reshape(b, n_c, d)
            h = h + gate_f * y[b * n_c:].reshape(b, n, d)
    return _rmsnorm(h, final_norm_w)
```

```cpp
#include <hip/hip_runtime.h>
#include <cstdio>
#include <cstdint>
#define MK_PER_PHASE 1
namespace pg8 {
#define PG8_LAS __attribute__((address_space(3)))
typedef unsigned short bf16_t;
typedef short bf16x8 __attribute__((ext_vector_type(8)));
typedef float f32x4 __attribute__((ext_vector_type(4)));
typedef unsigned u32x4 __attribute__((ext_vector_type(4)));
constexpr int BM = 256, BK = 64, HALF = 128, HTB = HALF * BK * 2  , STAGE_BYTES = 8 * HTB, NXCD = 8, WGM = 8;

__host__ __device__ __forceinline__ int lds_byte(int r, int c) { const int st = (r >> 4) * 2 + (c >> 5), rr = r & 15, cc = c & 31, ob = rr * 64 + cc * 2; return st * 1024 + (ob ^ (((ob >> 9) & 1) << 5)); }
__host__ __device__ __forceinline__ void stage_rc(int b, int& R, int& C) { const int st = b / 1024, sb = b % 1024, swz = sb ^ (((sb >> 9) & 1) << 5); R = (st >> 1) * 16 + swz / 64; C = (st & 1) * 32 + (swz % 64) / 2; }
__host__ __device__ __forceinline__ int perm32(int rho) { const int n = rho >> 4, i = rho & 15; return 8 * (i >> 2) + 4 * n + (i & 3); }

struct Unit { int pm, pn; };
struct Gemm { const bf16_t* A; const bf16_t* Bt; int M, N, K; };

struct StaticOrder {
    int nM, nN, nwg, G, c;
    __host__ __device__ void init(int M, int N, int G_, int c_) { nM = M / BM; nN = N / BM; nwg = nM * nN; G = G_; c = c_; }
    __host__ __device__ bool next(int i, Unit& u) const {
        const long L = (long)i * G + c; if (L >= nwg) return false;
        int wgid = (int)L; { const int q = nwg / NXCD, r = nwg % NXCD, xcd = wgid % NXCD, off = wgid / NXCD; wgid = (xcd < r ? xcd * (q + 1) : r * (q + 1) + (xcd - r) * q) + off; }
        const int nig = WGM * nN, gid = wgid / nig, fm = gid * WGM, gsz = (nM - fm) < WGM ? (nM - fm) : WGM;
        u.pm = fm + ((wgid % nig) % gsz); u.pn = (wgid % nig) / gsz; return true;
    }
    __device__ __forceinline__ void a_ready(const Unit&) const {}
    __device__ __forceinline__ void done(const Unit&) const {}
};

__device__ __forceinline__ unsigned cvt_pk_bf16(float lo, float hi) { unsigned r; asm volatile("v_cvt_pk_bf16_f32 %0, %1, %2" : "=v"(r) : "v"(lo), "v"(hi)); return r; }
template <class Fn> struct EpiGen {
    static constexpr bool PERM = true, AFTER_DRAIN = false;
    Fn fn;
    __device__ __forceinline__ void operator()(const f32x4 (&acc)[2][2][4][2], const Unit& u, int wr, int wc, int fr, int fq) const {
#pragma unroll
        for (int ai = 0; ai < 2; ++ai)
#pragma unroll
            for (int m = 0; m < 4; ++m) { const int row = u.pm * BM + ai * HALF + wr * 64 + m * 16 + fr;
#pragma unroll
                for (int bj = 0; bj < 2; ++bj) { const int col = u.pn * BM + bj * HALF + wc * 32 + 8 * fq; fn(row, col, acc[ai][bj][m][0], acc[ai][bj][m][1]); } }
    }
};
template <class Epi, class Sched, bool ALIGN_EPI = false, bool SP2 = false>
__device__ __forceinline__ void gemm_phase(PG8_LAS unsigned char* lds, const Gemm g, const Sched& S, const Epi& E) {
    const int tid = threadIdx.x, wid = __builtin_amdgcn_readfirstlane(tid >> 6), lane = tid & 63, wr = wid >> 2, wc = wid & 3, fr = lane & 15, fq = lane >> 4;
    const int K = g.K, nt = K / BK;
    unsigned voffA[2], voffB[2];
#pragma unroll
    for (int i = 0; i < 2; ++i) { int R, C; stage_rc(tid * 16 + i * 8192, R, C); const int Rb = Epi::PERM ? ((R & ~31) + perm32(R & 31)) : R;
        voffA[i] = (unsigned)(R * K + C) * 2u; voffB[i] = (unsigned)(Rb * K + C) * 2u; }
    const size_t kstep = (size_t)(BK * 2);
    const size_t hstep = (size_t)HALF * K * 2;
    const size_t tstep = 2 * hstep;
    const unsigned ldsw = (unsigned)wid * 1024u;
    const int aoff = lds_byte(wr * 64 + fr, fq * 8), boff = lds_byte(wc * 32 + fr, fq * 8);
#define PG8_SA(b, h) (((b) * 2 + (h)) * HTB)
#define PG8_SB(b, h) ((4 + (b) * 2 + (h)) * HTB)
#define PG8_STAGE(bufoff, gbase, voff) do { _Pragma("unroll") for (int _i = 0; _i < 2; ++_i) \
        __builtin_amdgcn_global_load_lds((const unsigned*)((const char*)(gbase) + (voff)[_i]), (PG8_LAS unsigned*)(lds + (bufoff) + ldsw + _i * 8192), 16, 0, 0); } while (0)
#define PG8_LDA(dst, b, h) do { _Pragma("unroll") for (int m = 0; m < 4; ++m) _Pragma("unroll") for (int k = 0; k < 2; ++k) dst[m][k] = *(const PG8_LAS bf16x8*)(lds + PG8_SA(b, h) + aoff + m * 2048 + k * 1024); } while (0)
#define PG8_LDB(dst, b, h) do { _Pragma("unroll") for (int n = 0; n < 2; ++n) _Pragma("unroll") for (int k = 0; k < 2; ++k) dst[n][k] = *(const PG8_LAS bf16x8*)(lds + PG8_SB(b, h) + boff + n * 2048 + k * 1024); } while (0)
#define PG8_MMA(ai, bj, At, Bt) do { __builtin_amdgcn_s_setprio(1); _Pragma("unroll") for (int m = 0; m < 4; ++m) _Pragma("unroll") for (int n = 0; n < 2; ++n) _Pragma("unroll") for (int k = 0; k < 2; ++k) \
        acc[ai][bj][m][n] = __builtin_amdgcn_mfma_f32_16x16x32_bf16(Bt[n][k], At[m][k], acc[ai][bj][m][n], 0, 0, 0); __builtin_amdgcn_s_setprio(0); } while (0)
#define PG8_WAIT_V(n) asm volatile("s_waitcnt vmcnt(" #n ")" ::: "memory")
#define PG8_WAIT_L(n) asm volatile("s_waitcnt lgkmcnt(" #n ")" ::: "memory")
#define PG8_BAR __builtin_amdgcn_s_barrier()
#define PG8_SCHED __builtin_amdgcn_sched_barrier(0)
    Unit cur, nxt; int ui = 0;
    if (!S.next(0, cur)) return;
    f32x4 acc[2][2][4][2];
#pragma unroll
    for (int a = 0; a < 2; ++a)
#pragma unroll
        for (int b = 0; b < 2; ++b)
#pragma unroll
            for (int m = 0; m < 4; ++m)
#pragma unroll
                for (int n = 0; n < 2; ++n) acc[a][b][m][n] = (f32x4){0.f, 0.f, 0.f, 0.f};
    bf16x8 At[4][2], B0[2][2], B1[2][2];
    const char* cA = (const char*)g.A + (size_t)cur.pm * tstep; const char* cB = (const char*)g.Bt + (size_t)cur.pn * tstep;
    S.a_ready(cur);
    if constexpr (SP2) {
        PG8_STAGE(PG8_SB(0, 0), cB, voffB); PG8_STAGE(PG8_SB(0, 1), cB + hstep, voffB); PG8_STAGE(PG8_SA(0, 0), cA, voffA); PG8_STAGE(PG8_SA(0, 1), cA + hstep, voffA);
        if (wr == 1) PG8_BAR;
        PG8_WAIT_V(2); PG8_BAR;
        PG8_STAGE(PG8_SB(1, 0), cB + kstep, voffB); PG8_STAGE(PG8_SA(1, 0), cA + kstep, voffA); PG8_STAGE(PG8_SB(1, 1), cB + hstep + kstep, voffB);
        PG8_WAIT_V(6); PG8_BAR;
    } else {
        PG8_STAGE(PG8_SB(0, 0), cB, voffB); PG8_STAGE(PG8_SA(0, 0), cA, voffA); PG8_STAGE(PG8_SB(0, 1), cB + hstep, voffB); PG8_STAGE(PG8_SA(0, 1), cA + hstep, voffA);
        if (wr == 1) PG8_BAR;
        PG8_WAIT_V(4); PG8_BAR;
        PG8_STAGE(PG8_SB(1, 0), cB + kstep, voffB); PG8_STAGE(PG8_SA(1, 0), cA + kstep, voffA); PG8_STAGE(PG8_SB(1, 1), cB + hstep + kstep, voffB);
        PG8_WAIT_V(6); PG8_BAR;
    }
    for (;;) {
        const bool has_next = S.next(ui + 1, nxt);
        const char* nA = has_next ? (const char*)g.A + (size_t)nxt.pm * tstep : cA; const char* nB = has_next ? (const char*)g.Bt + (size_t)nxt.pn * tstep : cB;
        for (int t = 0; t < nt; t += 2) {
            const bool last = (t == nt - 2);
            const char* a1 = cA + (size_t)(t + 1) * kstep;
            const char* a2 = last ? nA : cA + (size_t)(t + 2) * kstep; const char* b2 = last ? nB : cB + (size_t)(t + 2) * kstep;
            const char* a3 = a2 + kstep; const char* b3 = b2 + kstep;
            if (last && has_next) S.a_ready(nxt);
            if constexpr (SP2) {
            PG8_LDB(B0, 0, 0); PG8_LDB(B1, 0, 1); PG8_SCHED; PG8_LDA(At, 0, 0); PG8_STAGE(PG8_SA(1, 1), a1 + hstep, voffA);
            PG8_WAIT_V(8); PG8_WAIT_L(0); PG8_BAR; PG8_MMA(0, 0, At, B0); PG8_MMA(0, 1, At, B1); PG8_BAR; PG8_SCHED;
            PG8_LDA(At, 0, 1); PG8_STAGE(PG8_SB(0, 0), b2, voffB); PG8_STAGE(PG8_SB(0, 1), b2 + hstep, voffB); PG8_STAGE(PG8_SA(0, 0), a2, voffA);
            PG8_WAIT_V(8); PG8_WAIT_L(0); PG8_BAR; PG8_MMA(1, 0, At, B0); PG8_MMA(1, 1, At, B1); PG8_BAR; PG8_SCHED;
            PG8_LDB(B0, 1, 0); PG8_LDB(B1, 1, 1); PG8_SCHED; PG8_LDA(At, 1, 0); PG8_STAGE(PG8_SA(0, 1), a2 + hstep, voffA);
            PG8_WAIT_V(8); PG8_WAIT_L(0); PG8_BAR; PG8_MMA(0, 0, At, B0); PG8_MMA(0, 1, At, B1); PG8_BAR; PG8_SCHED;
            PG8_LDA(At, 1, 1); PG8_STAGE(PG8_SB(1, 0), b3, voffB); PG8_STAGE(PG8_SB(1, 1), b3 + hstep, voffB); PG8_STAGE(PG8_SA(1, 0), a3, voffA);
            PG8_WAIT_V(8); PG8_WAIT_L(0); PG8_BAR; PG8_MMA(1, 0, At, B0); PG8_MMA(1, 1, At, B1); PG8_BAR; PG8_SCHED;
            } else {
            PG8_LDB(B0, 0, 0); PG8_SCHED; PG8_LDA(At, 0, 0); PG8_STAGE(PG8_SA(1, 1), a1 + hstep, voffA);
            PG8_WAIT_L(8); PG8_BAR; PG8_WAIT_L(0); PG8_MMA(0, 0, At, B0); PG8_BAR; PG8_SCHED;
            PG8_LDB(B1, 0, 1); PG8_STAGE(PG8_SB(0, 0), b2, voffB);
            PG8_BAR; PG8_WAIT_L(0); PG8_MMA(0, 1, At, B1); PG8_BAR;
            PG8_LDA(At, 0, 1); PG8_STAGE(PG8_SA(0, 0), a2, voffA);
            PG8_BAR; PG8_WAIT_L(0); PG8_MMA(1, 0, At, B0); PG8_BAR; PG8_SCHED;
            PG8_STAGE(PG8_SB(0, 1), b2 + hstep, voffB);
            PG8_WAIT_V(6); PG8_BAR; PG8_MMA(1, 1, At, B1); PG8_BAR;
            PG8_LDB(B0, 1, 0); PG8_SCHED; PG8_LDA(At, 1, 0); PG8_STAGE(PG8_SA(0, 1), a2 + hstep, voffA);
            PG8_WAIT_L(8); PG8_BAR; PG8_WAIT_L(0); PG8_MMA(0, 0, At, B0); PG8_BAR; PG8_SCHED;
            PG8_LDB(B1, 1, 1); PG8_STAGE(PG8_SB(1, 0), b3, voffB);
            PG8_BAR; PG8_WAIT_L(0); PG8_MMA(0, 1, At, B1); PG8_BAR;
            PG8_LDA(At, 1, 1); PG8_STAGE(PG8_SA(1, 0), a3, voffA);
            PG8_BAR; PG8_WAIT_L(0); PG8_MMA(1, 0, At, B0); PG8_BAR; PG8_SCHED;
            PG8_STAGE(PG8_SB(1, 1), b3 + hstep, voffB);
            PG8_WAIT_V(6); PG8_BAR; PG8_MMA(1, 1, At, B1); PG8_BAR;
            }
        }
        if constexpr (ALIGN_EPI) { if (wr == 0) PG8_BAR; }
        if constexpr (!Epi::AFTER_DRAIN) { E(acc, cur, wr, wc, fr, fq); S.done(cur); }
        if (!has_next) break;
#pragma unroll
        for (int a = 0; a < 2; ++a)
#pragma unroll
            for (int b = 0; b < 2; ++b)
#pragma unroll
                for (int m = 0; m < 4; ++m)
#pragma unroll
                    for (int n = 0; n < 2; ++n) acc[a][b][m][n] = (f32x4){0.f, 0.f, 0.f, 0.f};
        cur = nxt; cA = nA; cB = nB; ++ui;
        if constexpr (ALIGN_EPI) { if (wr == 1) PG8_BAR; }
    }
    PG8_WAIT_V(0);
    if constexpr (!ALIGN_EPI) { if (wr == 0) PG8_BAR; }
    PG8_BAR;
    if constexpr (Epi::AFTER_DRAIN) { E.fused(acc, cur, wr, wc, fr, fq, lds, wid, lane); S.done(cur); }
#undef PG8_SA
#undef PG8_SB
#undef PG8_STAGE
#undef PG8_LDA
#undef PG8_LDB
#undef PG8_MMA
#undef PG8_WAIT_V
#undef PG8_WAIT_L
#undef PG8_BAR
#undef PG8_SCHED
}
}
#define GAS __attribute__((address_space(1)))
#define LAS __attribute__((address_space(3)))
typedef unsigned short bf16;
typedef unsigned v4u __attribute__((ext_vector_type(4)));
typedef unsigned v2u __attribute__((ext_vector_type(2)));
typedef float f32x4 __attribute__((ext_vector_type(4)));
typedef short bf16x8 __attribute__((ext_vector_type(8)));
typedef GAS unsigned gu32;
typedef GAS unsigned long long gu64;
#define RLX_AGENT __ATOMIC_RELAXED, __HIP_MEMORY_SCOPE_AGENT
#define LDS_WAIT() asm volatile("s_waitcnt lgkmcnt(0)" ::: "memory")
#define VM_WAIT() asm volatile("s_waitcnt vmcnt(0)" ::: "memory")
__device__ __forceinline__ unsigned f2bf(float f) { unsigned u = __builtin_bit_cast(unsigned, f); return (u + 0x7fffu + ((u >> 16) & 1u)) >> 16; }
__device__ __forceinline__ unsigned pk2(float lo, float hi) { return f2bf(lo) | (f2bf(hi) << 16); }
__device__ __forceinline__ float bflo(unsigned w) { return __builtin_bit_cast(float, w << 16); }
__device__ __forceinline__ float bfhi(unsigned w) { return __builtin_bit_cast(float, w & 0xffff0000u); }
__device__ __forceinline__ float bf2f(bf16 b) { return __builtin_bit_cast(float, (unsigned)b << 16); }
__device__ __forceinline__ float wave_sum(float v) {
#pragma unroll
    for (int o = 1; o < 64; o <<= 1) v += __shfl_xor(v, o);
    return v;
}
__device__ __forceinline__ float sigmoidf_(float x) { return 1.f / (1.f + __expf(-x)); }

#define XB_TMO      128
#define XB_XCNT(j)  (256  + 64 * (j))
#define XB_XSUB(j)  (1280 + 64 * (j))
#define XB_XGEN(j)  (2304 + 64 * (j))
#define XB_TOP      3328
#define XB_TOPGEN   3392
#define XCD_BAR_WORDS 3456
#define XB_SPIN_CAP (1u << 22)

__device__ __forceinline__ unsigned xb_ld(unsigned* p)              { return __hip_atomic_load(p, __ATOMIC_RELAXED, __HIP_MEMORY_SCOPE_AGENT); }
__device__ __forceinline__ unsigned xb_add(unsigned* p, unsigned v) { return __hip_atomic_fetch_add(p, v, __ATOMIC_RELAXED, __HIP_MEMORY_SCOPE_AGENT); }
__device__ __forceinline__ unsigned xb_xcc_id() { return (unsigned)__builtin_amdgcn_s_getreg((3 << 11) | 20) & 0xFu; }
#define XB_SPIN(cond, bar) do { unsigned _sp = 0; while (cond) { __builtin_amdgcn_s_sleep(1); \
    if ((++_sp & 255u) == 0u) { if (xb_ld(&(bar)[XB_TMO])) break; if (_sp > XB_SPIN_CAP) { atomicAdd(&(bar)[XB_TMO], 1u); break; } } } } while (0)

struct XcdBarrier {
    unsigned* bar; unsigned x;
    volatile LAS unsigned* st;
};

__device__ __forceinline__ XcdBarrier xcd_barrier_post(unsigned* bar, volatile LAS unsigned* st) {
    XcdBarrier b; b.bar = bar; b.x = xb_xcc_id(); b.st = st;
    if (threadIdx.x == 0) (void)xb_add(&bar[XB_XCNT(b.x)], 1u);
    return b;
}
__device__ __forceinline__ void xcd_barrier_complete(unsigned* bar, unsigned x, unsigned& nloc, unsigned& nx) {
    const unsigned G = gridDim.x * gridDim.y * gridDim.z;
    unsigned sum, cnt, mine, sp = 0u;
    for (;;) {
        sum = 0u; cnt = 0u; mine = 0u;
#pragma unroll
        for (unsigned j = 0; j < 16; ++j) { const unsigned c = xb_ld(&bar[XB_XCNT(j)]); sum += c; cnt += (c > 0u) ? 1u : 0u; mine = (j == x) ? c : mine; }
        if (sum == G) break;
        __builtin_amdgcn_s_sleep(1);
        if ((++sp & 255u) == 0u) { if (xb_ld(&bar[XB_TMO])) break; if (sp > XB_SPIN_CAP) { atomicAdd(&bar[XB_TMO], 1u); break; } }
    }
    nloc = mine > 0u ? mine : 1u; nx = cnt > 0u ? cnt : 1u;
}

__device__ __forceinline__ void xcd_barrier(const XcdBarrier& b) {
    asm volatile("s_waitcnt vmcnt(0)" ::: "memory");
    __syncthreads();
    if (threadIdx.x == 0) {
        unsigned* bar = b.bar;
        __builtin_amdgcn_s_waitcnt(0);
        unsigned nloc = b.st[0], nx = b.st[1];
        if (nloc == 0u) { xcd_barrier_complete(bar, b.x, nloc, nx); b.st[0] = nloc; b.st[1] = nx; }
        const unsigned old = xb_add(&bar[XB_XSUB(b.x)], 1u);
        const unsigned gen = old / nloc;
        if (old + 1u == (gen + 1u) * nloc) {
            __builtin_amdgcn_fence(__ATOMIC_RELEASE, "agent");
            asm volatile("s_waitcnt vmcnt(0)" ::: "memory");
            const unsigned og = xb_add(&bar[XB_TOP], 1u);
            const unsigned tg = og / nx;
            if (og + 1u == (tg + 1u) * nx) xb_add(&bar[XB_TOPGEN], 1u);
            else XB_SPIN(xb_ld(&bar[XB_TOPGEN]) == tg, bar);
            __builtin_amdgcn_fence(__ATOMIC_ACQUIRE, "agent");
            xb_add(&bar[XB_XGEN(b.x)], 1u);
            asm volatile("s_waitcnt vmcnt(0)" ::: "memory");
        } else {
            XB_SPIN(xb_ld(&bar[XB_XGEN(b.x)]) == gen, bar);
            __builtin_amdgcn_fence(__ATOMIC_ACQUIRE, "agent");
            asm volatile("s_waitcnt vmcnt(0)" ::: "memory");
        }
    }
    __syncthreads();
}
namespace att {
using s16x4  = __attribute__((ext_vector_type(4))) short;
using f32x16 = __attribute__((ext_vector_type(16))) float;
using u32x4  = __attribute__((ext_vector_type(4))) unsigned;
#define ATT_SBAR() __builtin_amdgcn_sched_barrier(0)
constexpr float THR2 = 11.5f;
__device__ __forceinline__ int crow(int r, int hi) { return (r & 3) + 8 * (r >> 2) + 4 * hi; }
__device__ __forceinline__ unsigned cvtpk(float lo, float hi) { unsigned r; asm volatile("v_cvt_pk_bf16_f32 %0, %1, %2" : "=v"(r) : "v"(lo), "v"(hi)); return r; }

__device__ __forceinline__ void partialSM(f32x16& p0, f32x16& p1, float& m_reg, float& mn, float& alpha) {
  float pmax = p0[0];
#pragma unroll
  for (int r = 1; r < 16; ++r) pmax = fmaxf(pmax, p0[r]);
#pragma unroll
  for (int r = 0; r < 16; ++r) pmax = fmaxf(pmax, p1[r]);
  { auto rr = __builtin_amdgcn_permlane32_swap(__float_as_uint(pmax), __float_as_uint(pmax), false, false);
    pmax = fmaxf(__uint_as_float(rr[0]), __uint_as_float(rr[1])); }
  if (__builtin_expect(__all(pmax - m_reg <= THR2), 1)) { mn = m_reg; alpha = 1.f; }
  else { mn = fmaxf(m_reg, pmax); alpha = __builtin_amdgcn_exp2f(m_reg - mn); m_reg = mn; }
#pragma unroll
  for (int r = 0; r < 16; ++r) p0[r] = p0[r] - mn;
#pragma unroll
  for (int r = 0; r < 16; ++r) p1[r] = p1[r] - mn;
#pragma unroll
  for (int r = 0; r < 16; ++r) p0[r] = __builtin_amdgcn_exp2f(p0[r]);
}
__device__ __forceinline__ void finishSM(f32x16& p0, f32x16& p1, float alpha, float& l_reg, bf16x8& pa0, bf16x8& pa1, bf16x8& pa2, bf16x8& pa3) {
#pragma unroll
  for (int r = 0; r < 16; ++r) p1[r] = __builtin_amdgcn_exp2f(p1[r]);
  float ps = 0;
#pragma unroll
  for (int r = 0; r < 16; ++r) ps += p0[r];
#pragma unroll
  for (int r = 0; r < 16; ++r) ps += p1[r];
  { auto rr = __builtin_amdgcn_permlane32_swap(__float_as_uint(ps), __float_as_uint(ps), false, false);
    ps = __uint_as_float(rr[0]) + __uint_as_float(rr[1]); }
  l_reg = l_reg * alpha + ps;
#define ATT_PK4(P, BASE, OUT) do { unsigned a0 = cvtpk(P[BASE + 0], P[BASE + 1]), a1 = cvtpk(P[BASE + 2], P[BASE + 3]);   \
    unsigned b0 = cvtpk(P[BASE + 4], P[BASE + 5]), b1 = cvtpk(P[BASE + 6], P[BASE + 7]);                              \
    auto r0 = __builtin_amdgcn_permlane32_swap(a0, b0, false, false); auto r1 = __builtin_amdgcn_permlane32_swap(a1, b1, false, false); \
    u32x4 w = {r0[0], r1[0], r0[1], r1[1]}; OUT = *reinterpret_cast<bf16x8*>(&w); } while (0)
  ATT_PK4(p0, 0, pa0); ATT_PK4(p0, 8, pa1); ATT_PK4(p1, 0, pa2); ATT_PK4(p1, 8, pa3);
#undef ATT_PK4
}
template <int NB> __device__ __forceinline__ int v_st(int k, int c) { const int kk = (k & ~0xC) | ((k & 4) << 1) | ((k & 8) >> 1); return ((kk >> 3) * NB + (c >> 5)) * 512 + ((kk & 7) * 32 + (c & 31)) * 2; }
__device__ __forceinline__ int v_rd_base(int lane) { return ((lane & 3) << 3) | (((lane >> 2) & 3) << 6) | (((lane >> 4) & 1) << 5) | (((lane >> 5) & 1) << 8); }
template <int OFF> __device__ __forceinline__ s16x4 tr_read(int vb) {
  s16x4 r; asm volatile("ds_read_b64_tr_b16 %0, %1 offset:%2" : "=&v"(r) : "v"(vb), "i"(OFF) : "memory"); return r;
}
template <int NB, int D0> __device__ __forceinline__ void pv_one(f32x16& od, int vb, bf16x8 pa0, bf16x8 pa1, bf16x8 pa2, bf16x8 pa3) {
#define ATT_VOFF(ks, half) (D0 * 512 + (ks) * (NB * 1024) + (half) * (NB * 512))
  const s16x4 l0 = tr_read<ATT_VOFF(0, 0)>(vb), h0 = tr_read<ATT_VOFF(0, 1)>(vb), l1 = tr_read<ATT_VOFF(1, 0)>(vb), h1 = tr_read<ATT_VOFF(1, 1)>(vb);
  const s16x4 l2 = tr_read<ATT_VOFF(2, 0)>(vb), h2 = tr_read<ATT_VOFF(2, 1)>(vb), l3 = tr_read<ATT_VOFF(3, 0)>(vb), h3 = tr_read<ATT_VOFF(3, 1)>(vb);
#undef ATT_VOFF
  asm volatile("s_waitcnt lgkmcnt(0)" ::: "memory"); ATT_SBAR();
#define ATT_PK(L, H) (bf16x8){L[0], L[1], L[2], L[3], H[0], H[1], H[2], H[3]}
  od = __builtin_amdgcn_mfma_f32_32x32x16_bf16(pa0, ATT_PK(l0, h0), od, 0, 0, 0);
  od = __builtin_amdgcn_mfma_f32_32x32x16_bf16(pa1, ATT_PK(l1, h1), od, 0, 0, 0);
  od = __builtin_amdgcn_mfma_f32_32x32x16_bf16(pa2, ATT_PK(l2, h2), od, 0, 0, 0);
  od = __builtin_amdgcn_mfma_f32_32x32x16_bf16(pa3, ATT_PK(l3, h3), od, 0, 0, 0);
#undef ATT_PK
}
template <int NB> __device__ __forceinline__ void pv_all(f32x16* o, int vb, bf16x8 pa0, bf16x8 pa1, bf16x8 pa2, bf16x8 pa3) {
  pv_one<NB, 0>(o[0], vb, pa0, pa1, pa2, pa3); pv_one<NB, 1>(o[1], vb, pa0, pa1, pa2, pa3);
  if constexpr (NB == 4) { pv_one<NB, 2>(o[2], vb, pa0, pa1, pa2, pa3); pv_one<NB, 3>(o[3], vb, pa0, pa1, pa2, pa3); }
}
template <int DK> __device__ __forceinline__ void qkt(f32x16& p0, f32x16& p1, LAS const char* Ks, const bf16x8* qr, int r32, int hi) {
  constexpr int KSTR = DK * 2 + 16;
  p0 = f32x16{}; p1 = f32x16{};
#pragma unroll
  for (int d0 = 0; d0 < DK / 16; ++d0) { const int cb = (d0 * 16 + hi * 8) * 2;
    const bf16x8 b0 = *(LAS const bf16x8*)(Ks + r32 * KSTR + cb);
    const bf16x8 b1 = *(LAS const bf16x8*)(Ks + (32 + r32) * KSTR + cb);
    p0 = __builtin_amdgcn_mfma_f32_32x32x16_bf16(b0, qr[d0], p0, 0, 0, 0);
    p1 = __builtin_amdgcn_mfma_f32_32x32x16_bf16(b1, qr[d0], p1, 0, 0, 0); }
}
template <int DK, int DV> struct Cfg {
  static constexpr int KSTR = DK * 2 + 16, KT = 64 * KSTR, NB = DV / 32, VT = 64 * DV * 2, NQ = DK / 16;
  static constexpr int NKC = DK / 8, NVC = DV / 8;
  static constexpr int KN = (64 * NKC + 511) / 512, VN = (64 * NVC + 511) / 512;
  static constexpr int OFF_V = 0, OFF_K = 2 * VT, OFF_WS = 2 * VT + 2 * KT, LDS_BYTES = OFF_WS + 8 * 64 * 4;
};
template <int DK, int DV>
__device__ __forceinline__ void attn_unit(const bf16* __restrict__ Qb, int ldq, const bf16* __restrict__ K1, int ldk1, const bf16* __restrict__ K2, int ldk2,
                                          const bf16* __restrict__ Vh, int ldv, float* __restrict__ Ob, int ldo, int nkeys, LAS char* lds) {
  using C = Cfg<DK, DV>;
  const int tid = threadIdx.x, wid = tid >> 6, lane = tid & 63, r32 = lane & 31, hi = lane >> 5;
  LAS char* V_lds = lds + C::OFF_V; LAS char* K_lds = lds + C::OFF_K;
  LAS float* ws = (LAS float*)(lds + C::OFF_WS) + wid * 64; LAS float* li_l = ws; LAS float* al_l = ws + 32;
  float m_reg = -1e30f, l_reg = 0; f32x16 o[C::NB] = {}; bf16x8 qr[C::NQ];
  { const bf16* Qw = Qb + (long)(wid * 32 + r32) * ldq + hi * 8;
#pragma unroll
    for (int d0 = 0; d0 < C::NQ; ++d0) qr[d0] = *(const bf16x8*)(Qw + d0 * 16); }
  int krow[C::KN], kch[C::KN], vrow[C::VN], vcol[C::VN]; bool kval[C::KN]; const bf16* kptr[C::KN]; int kstr[C::KN]; const bf16* vptr[C::VN];
#pragma unroll
  for (int i = 0; i < C::KN; ++i) { int it = tid + 512 * i; kval[i] = it < 64 * C::NKC; if (!kval[i]) it = tid; krow[i] = it / C::NKC; kch[i] = it % C::NKC;
    if (DK == 64 || kch[i] < 8) { kptr[i] = K1 + (long)krow[i] * ldk1 + kch[i] * 8; kstr[i] = ldk1; } else { kptr[i] = K2 + (long)krow[i] * ldk2 + (kch[i] - 8) * 8; kstr[i] = ldk2; } }
#pragma unroll
  for (int i = 0; i < C::VN; ++i) { const int it = tid + 512 * i; vrow[i] = it / C::NVC; vcol[i] = (it % C::NVC) * 8; vptr[i] = Vh + (long)vrow[i] * ldv + vcol[i]; }
  const int vb0 = (int)(uintptr_t)V_lds + v_rd_base(lane);
  struct Slot { bf16x8 ks[C::KN], vs[C::VN]; } sS;
#define ATT_SLOAD(S, k0) do { _Pragma("unroll") for (int i = 0; i < C::KN; ++i) S.ks[i] = *(const bf16x8*)(kptr[i] + (long)(k0) * kstr[i]); \
    _Pragma("unroll") for (int i = 0; i < C::VN; ++i) S.vs[i] = *(const bf16x8*)(vptr[i] + (long)(k0) * ldv); } while (0)
#define ATT_SWRITE(b, S) do { _Pragma("unroll") for (int i = 0; i < C::KN; ++i) if (kval[i]) *(LAS bf16x8*)(K_lds + (b) * C::KT + krow[i] * C::KSTR + kch[i] * 16) = S.ks[i]; \
    _Pragma("unroll") for (int i = 0; i < C::VN; ++i) *(LAS bf16x8*)(V_lds + (b) * C::VT + v_st<C::NB>(vrow[i], vcol[i])) = S.vs[i]; } while (0)
#define ATT_SWAIT() asm volatile("s_waitcnt vmcnt(0)" ::: "memory")
#define ATT_RESC(a) do { if (__any((a) < 1.f)) { if (hi == 0) al_l[r32] = (a); asm volatile("s_waitcnt lgkmcnt(0)" ::: "memory"); \
    _Pragma("unroll") for (int d = 0; d < C::NB; ++d) _Pragma("unroll") for (int r = 0; r < 16; ++r) o[d][r] *= al_l[crow(r, hi)]; } } while (0)
  static_assert(C::KN + C::VN == 3, "three staging loads per thread per tile (ATT_SWAIT)");
  f32x16 pA0, pA1, pB0, pB1; float mnA, mnB, alA, alB; bf16x8 pa0, pa1, pa2, pa3; const int NT = nkeys / 64;
  __syncthreads();
  ATT_SLOAD(sS, 0); asm volatile("s_waitcnt vmcnt(0)" ::: "memory"); ATT_SWRITE(0, sS); __syncthreads();
  qkt<DK>(pA0, pA1, K_lds, qr, r32, hi); partialSM(pA0, pA1, m_reg, mnA, alA);
  ATT_SLOAD(sS, 64);
  ATT_SWAIT(); ATT_SWRITE(1, sS); __syncthreads();
  for (int j = 1; j + 1 < NT; j += 2) {
    ATT_SBAR(); qkt<DK>(pB0, pB1, K_lds + C::KT, qr, r32, hi);
    finishSM(pA0, pA1, alA, l_reg, pa0, pa1, pa2, pa3); ATT_SBAR();
    ATT_SLOAD(sS, (j + 1) * 64); ATT_SBAR();
    pv_all<C::NB>(o, vb0, pa0, pa1, pa2, pa3); partialSM(pB0, pB1, m_reg, mnB, alB);
    __syncthreads(); ATT_SWAIT(); ATT_SWRITE(0, sS);
    ATT_RESC(alB); __syncthreads();
    ATT_SBAR(); qkt<DK>(pA0, pA1, K_lds, qr, r32, hi);
    finishSM(pB0, pB1, alB, l_reg, pa0, pa1, pa2, pa3); ATT_SBAR();
    ATT_SLOAD(sS, (j + 2) * 64); ATT_SBAR();
    pv_all<C::NB>(o, vb0 + C::VT, pa0, pa1, pa2, pa3); partialSM(pA0, pA1, m_reg, mnA, alA);
    __syncthreads(); ATT_SWAIT(); ATT_SWRITE(1, sS);
    ATT_RESC(alA); __syncthreads();
  }
  ATT_SBAR(); qkt<DK>(pB0, pB1, K_lds + C::KT, qr, r32, hi);
  finishSM(pA0, pA1, alA, l_reg, pa0, pa1, pa2, pa3); ATT_SBAR();
  pv_all<C::NB>(o, vb0, pa0, pa1, pa2, pa3); partialSM(pB0, pB1, m_reg, mnB, alB);
  __syncthreads(); ATT_RESC(alB);
  finishSM(pB0, pB1, alB, l_reg, pa0, pa1, pa2, pa3); ATT_SBAR();
  pv_all<C::NB>(o, vb0 + C::VT, pa0, pa1, pa2, pa3);
  if (hi == 0) li_l[r32] = l_reg; asm volatile("s_waitcnt lgkmcnt(0)" ::: "memory");
  float rli[16];
#pragma unroll
  for (int r = 0; r < 16; ++r) rli[r] = __builtin_amdgcn_rcpf(li_l[crow(r, hi)]);
  float* Ow = Ob + (long)(wid * 32) * ldo;
#pragma unroll
  for (int r = 0; r < 16; ++r) { const int orow = crow(r, hi);
#pragma unroll
    for (int d0 = 0; d0 < C::NB; ++d0) Ow[(long)orow * ldo + d0 * 32 + r32] = o[d0][r] * rli[r]; }
#undef ATT_SLOAD
#undef ATT_SWRITE
#undef ATT_SWAIT
#undef ATT_RESC
}
}
constexpr int DM = 1024, NBATCH = 2, SEQ = 16384, CT = 256, TB = SEQ + CT  , R = NBATCH * TB  ;
constexpr int ATT_IN = 2208, ATT_NP = 2304, REC_IN = 3472, REC_NP = 3584, RWKV_IN = 1920;
constexpr int NE = 32, TOPK = 4, MAXT = R * TOPK / 256 + NE  , MAXROWS = MAXT * 256;
constexpr int NUNIT_M = 16 * 260;
constexpr float NORM_EPS = 1e-6f;
enum { I_X = 0, I_C, I_CTX, I_CCTX, I_NMIX, I_NFFN, I_ADAW, I_ADAB, I_WOUT, I_RW, I_RB, I_W1, I_B1, I_W2, I_B2, I_ATTW, I_LAM, I_SUBLN, I_QNW, I_KVNW, I_WUQ, I_WUKV,
       I_RECW, I_MU, I_W0, I_RW2, I_A0, I_A2, I_G2, I_KK, I_KA, I_RK, I_LNW, I_LNB, I_GATEB, I_MNW, I_FNW, N_IN };
constexpr size_t al256(size_t x) { return (x + 255) & ~(size_t)255; }
constexpr size_t WS_CTL = 0, CTL_ZERO_BYTES = 1u << 20;
constexpr size_t WS_MOD = CTL_ZERO_BYTES;
constexpr size_t WS_ROPE = al256(WS_MOD + 2 * 3 * 6144 * 4);
constexpr size_t ROPE_DR = 0, ROPE_DC = 256 * 16 * 2, ROPE_MR = ROPE_DC + 64 * 16 * 2, ROPE_MC = ROPE_MR + 256 * 8 * 2, ROPE_FLOATS = ROPE_MC + 64 * 8 * 2;
constexpr size_t WS_WIN0 = al256(WS_ROPE + ROPE_FLOATS * 4);
constexpr size_t WS_WUQ = al256(WS_WIN0 + (size_t)ATT_NP * 1024 * 2);
constexpr size_t WS_WUKV = al256(WS_WUQ + (size_t)768 * 384 * 2);
constexpr size_t WS_WOUT = al256(WS_WUKV + (size_t)1024 * 256 * 2);
constexpr size_t WS_WREC = al256(WS_WOUT + (size_t)2 * 1024 * 1024 * 2);
constexpr size_t WS_WLORA = al256(WS_WREC + (size_t)REC_NP * 1024 * 2);
constexpr size_t WS_W1T = al256(WS_WLORA + (size_t)2560 * 384 * 2);
constexpr size_t WS_W2T = al256(WS_W1T + (size_t)NE * 2048 * 1024 * 2);
constexpr size_t WS_H = al256(WS_W2T + (size_t)NE * 1024 * 1024 * 2);
constexpr size_t WS_A = al256(WS_H + (size_t)R * 1024 * 4);
constexpr size_t WS_A1 = al256(WS_A + (size_t)R * 1024 * 2);
constexpr size_t WS_F = al256(WS_A1 + (size_t)R * 1024 * 2);
constexpr size_t WS_P = al256(WS_F + (size_t)R * 1024 * 2);
constexpr size_t WS_TOPE = al256(WS_P + (size_t)R * REC_NP * 2);
constexpr size_t WS_GATE = al256(WS_TOPE + (size_t)R * 16);
constexpr size_t WS_POS = al256(WS_GATE + (size_t)R * 16);
constexpr size_t WS_DEST = al256(WS_POS + (size_t)R * 16);
constexpr size_t WS_TILE = al256(WS_DEST + (size_t)R * 16);
constexpr size_t WS_T = al256(WS_TILE + (size_t)(MAXT + 8) * 4);
constexpr size_t WS_QD = WS_T;
constexpr size_t WS_KD = al256(WS_QD + (size_t)R * 512 * 2);
constexpr size_t WS_CQN = al256(WS_KD + (size_t)R * 512 * 2);
constexpr size_t WS_CKVN = al256(WS_CQN + (size_t)R * 384 * 2);
constexpr size_t WS_MQ = al256(WS_CKVN + (size_t)R * 256 * 2);
constexpr size_t WS_MKV = al256(WS_MQ + (size_t)R * 768 * 2);
constexpr size_t WS_KRR = al256(WS_MKV + (size_t)R * 1024 * 2);
constexpr size_t WS_ODIFF = al256(WS_KRR + (size_t)R * 32 * 2);
constexpr size_t WS_OMLA = al256(WS_ODIFF + (size_t)R * 1024 * 4);
constexpr size_t WS_T0_END = al256(WS_OMLA + (size_t)R * 512 * 4);
constexpr size_t WS_XS = WS_T;
constexpr size_t WS_HS = al256(WS_XS + (size_t)MAXROWS * 1024 * 2);
constexpr size_t WS_TM_END = al256(WS_HS + (size_t)MAXROWS * 1024 * 2);
constexpr size_t SZ_RC = (size_t)R * 512 * 4;
constexpr size_t WS_RR = WS_T, WS_VV = WS_RR + SZ_RC, WS_AKK = WS_VV + SZ_RC, WS_KL = WS_AKK + SZ_RC;
constexpr size_t WS_WDEC = WS_KL + SZ_RC  , WS_KDIR = WS_WDEC + 2 * SZ_RC  , WS_BB = WS_KDIR + 2 * SZ_RC  , WS_GG = WS_BB + 2 * SZ_RC;
constexpr size_t WS_ALORA = al256(WS_GG + SZ_RC);
constexpr size_t WS_YR = al256(WS_ALORA + (size_t)R * 384 * 2);
constexpr size_t WS_DC = WS_YR;
constexpr size_t WS_HM = al256(WS_YR + 2 * SZ_RC);
constexpr size_t WS_CST = al256(WS_HM + 2 * SZ_RC);
constexpr size_t WS_DN = al256(WS_CST + (size_t)NUNIT_M * 8192 * 4);
constexpr size_t WS_NST = al256(WS_DN + (size_t)NUNIT_M * 64 * 4);
constexpr size_t WS_SC = al256(WS_NST + (size_t)NUNIT_M * 64 * 4);
constexpr size_t WS_MST = al256(WS_SC + (size_t)NUNIT_M * 2 * 4);
constexpr size_t WS_T1_END = al256(WS_MST + (size_t)NUNIT_M * 4);
constexpr size_t WS_END = WS_T1_END > WS_TM_END ? (WS_T1_END > WS_T0_END ? WS_T1_END : WS_T0_END) : (WS_TM_END > WS_T0_END ? WS_TM_END : WS_T0_END);
static_assert(WS_END <= (size_t)2147483648ull, "workspace map exceeds 2 GiB");
constexpr int CW_CNT = 1024;
constexpr int CW_BAR = 4096;
constexpr int RING_BYTES = 131072, AUX_OFF = 131072, AUX_BYTES = 16384, MISC_OFF = 147456, LDS_BYTES = 163840;

struct Frame {
    LAS unsigned char* lds; gu32* ctl; int tid, lane, wave, blk, G;
    float* out; unsigned char* ws;
    struct InTab { LAS const unsigned* t;
        __device__ __forceinline__ const float* operator[](int i) const { const unsigned lo = __builtin_amdgcn_readfirstlane(t[2 * i]), hi = __builtin_amdgcn_readfirstlane(t[2 * i + 1]);
            return (const float*)(((unsigned long long)hi << 32) | lo); } } in;
};
template <class T> __device__ __forceinline__ T* wsp(const Frame& F, size_t off) { return (T*)(F.ws + off); }
__device__ __forceinline__ int row_sel(int row) { const int b = row / TB, t = row - b * TB; return t < CT ? 2 : b; }
__device__ __forceinline__ const float* h0_row(const Frame& F, int row) {
    const int b = row / TB, t = row - b * TB;
    return t < CT ? F.in[I_CTX] + ((size_t)b * CT + t) * DM : F.in[I_X] + ((size_t)b * SEQ + (t - CT)) * DM;
}
__device__ __forceinline__ const float* modp(const Frame& F, int layer, int sel, int chunk) { return wsp<const float>(F, WS_MOD) + ((size_t)(layer * 3 + sel) * 6 + chunk) * DM; }
__device__ __forceinline__ int scan_tok(int z, int sg) { return z == 0 ? sg : (sg < CT ? CT - 1 - sg : TB + CT - 1 - sg); }
__device__ __forceinline__ void tr_item(const float* W, int K, int N, bf16* WT, int row_off, LAS float* scr, int kb, int nb, int lane) {
    const int k0 = 64 * kb, n0 = 32 * nb;
    const int n = n0 + (lane & 31);
#pragma unroll 8
    for (int i = 0; i < 32; ++i) { const int kk = 2 * i + (lane >> 5); scr[kk * 33 + (lane & 31)] = (n < N) ? W[(size_t)(k0 + kk) * N + n] : 0.f; }
    LDS_WAIT(); asm volatile("" ::: "memory");
    const int c = lane & 7;
#pragma unroll
    for (int j = 0; j < 4; ++j) { const int nn = (lane >> 3) + 8 * j; const LAS float* s = scr + (8 * c) * 33 + nn;
        v4u o; o.x = pk2(s[0 * 33], s[1 * 33]); o.y = pk2(s[2 * 33], s[3 * 33]); o.z = pk2(s[4 * 33], s[5 * 33]); o.w = pk2(s[6 * 33], s[7 * 33]);
        *(v4u*)(WT + (size_t)(row_off + n0 + nn) * K + k0 + 8 * c) = o; }
    LDS_WAIT(); asm volatile("" ::: "memory");
}
__device__ __forceinline__ void tr_family(const Frame& F, const float* W, size_t src_stride, int nmat, int K, int N, int Npad, bf16* WT, int gw, int NGW) {
    LAS float* scr = (LAS float*)(F.lds + F.wave * 16384);
    const int nkb = K / 64, nnb = Npad / 32, per = nkb * nnb, total = per * nmat;
    for (int it = gw; it < total; it += NGW) { const int m = it / per, r = it - m * per, kb = r / nnb, nb = r - kb * nnb;
        tr_item(W + (size_t)m * src_stride, K, N, WT, m * Npad, scr, kb, nb, F.lane); }
}
__device__ __forceinline__ void moe_weights_convert(const Frame& F, int layer, int gw, int NGW) {
    tr_family(F, F.in[I_W1] + (size_t)layer * NE * 1024 * 2048, (size_t)1024 * 2048, NE, 1024, 2048, 2048, wsp<bf16>(F, WS_W1T), gw, NGW);
    tr_family(F, F.in[I_W2] + (size_t)layer * NE * 1024 * 1024, (size_t)1024 * 1024, NE, 1024, 1024, 1024, wsp<bf16>(F, WS_W2T), gw, NGW);
}
__device__ __forceinline__ void norm_mod_row(const Frame& F, const float* src, const float* nw, const float* shift, const float* scale, bf16* orow) {
    const f32x4* xr = (const f32x4*)src + F.lane;
    f32x4 v[4]; float s = 0.f;
#pragma unroll
    for (int j = 0; j < 4; ++j) { v[j] = xr[64 * j]; s += (v[j].x * v[j].x + v[j].y * v[j].y) + (v[j].z * v[j].z + v[j].w * v[j].w); }
    const float rs = 1.f / sqrtf(wave_sum(s) * (1.f / DM) + NORM_EPS);
    unsigned long long* o8 = (unsigned long long*)orow + F.lane;
#pragma unroll
    for (int j = 0; j < 4; ++j) { const f32x4 w = ((const f32x4*)nw)[F.lane + 64 * j], sh = ((const f32x4*)shift)[F.lane + 64 * j], sc = ((const f32x4*)scale)[F.lane + 64 * j];
        const f32x4 y = v[j] * rs * w * (sc + 1.f) + sh;
        o8[64 * j] = (unsigned long long)pk2(y.x, y.y) | ((unsigned long long)pk2(y.z, y.w) << 32); }
}
__device__ __forceinline__ void p0a(const Frame& F) {
    LAS float* sv = (LAS float*)F.lds; LAS float* red = (LAS float*)(F.lds + 16384);
    for (int i = F.tid; i < 3 * DM; i += 512) { const int s = i / DM, k = i - s * DM; const float cv = (s < 2) ? F.in[I_C][s * DM + k] : F.in[I_CCTX][k]; sv[i] = cv / (1.f + __expf(-cv)); }
    __syncthreads();
    for (int it = F.blk; it < 192; it += F.G) {
        const int l = it / 96, cgp = it - l * 96, kq = F.tid >> 4, cg = F.tid & 15, col = cgp * 64 + cg * 4;
        float acc[3][4];
#pragma unroll
        for (int s = 0; s < 3; ++s)
#pragma unroll
            for (int j = 0; j < 4; ++j) acc[s][j] = 0.f;
        const float* W = F.in[I_ADAW] + (size_t)l * DM * 6144 + col;
        for (int kk = 0; kk < 32; ++kk) { const int k = kq * 32 + kk; const f32x4 w = *(const f32x4*)(W + (size_t)k * 6144);
            const float s0 = sv[k], s1 = sv[DM + k], s2 = sv[2 * DM + k];
#pragma unroll
            for (int j = 0; j < 4; ++j) { acc[0][j] += s0 * w[j]; acc[1][j] += s1 * w[j]; acc[2][j] += s2 * w[j]; } }
#pragma unroll
        for (int s = 0; s < 3; ++s)
#pragma unroll
            for (int j = 0; j < 4; ++j) red[(kq * 16 + cg) * 12 + s * 4 + j] = acc[s][j];
        __syncthreads();
        if (F.tid < 192) { const int s = F.tid / 64, cc = F.tid - s * 64, cg2 = cc >> 2, j = cc & 3; float t = 0.f;
            for (int q = 0; q < 32; ++q) t += red[(q * 16 + cg2) * 12 + s * 4 + j];
            wsp<float>(F, WS_MOD)[(size_t)(l * 3 + s) * 6144 + cgp * 64 + cc] = t + F.in[I_ADAB][l * 6144 + cgp * 64 + cc]; }
        __syncthreads();
    }
    const int gid = F.blk * 512 + F.tid, GT = F.G * 512;
    float* rope = wsp<float>(F, WS_ROPE);
    for (int i = gid; i < 256 * 16 + 64 * 16 + 256 * 8 + 64 * 8; i += GT) {
        int j = i; float pos, inv; size_t off;
        if (j < 256 * 16) { pos = (float)(j / 16); inv = powf(10000.f, -(float)(j % 16) / 16.f); off = ROPE_DR + (size_t)j * 2; }
        else if ((j -= 256 * 16) < 64 * 16) { pos = (float)(j / 16); inv = powf(10000.f, -(float)(j % 16) / 16.f); off = ROPE_DC + (size_t)j * 2; }
        else if ((j -= 64 * 16) < 256 * 8) { pos = (float)(j / 8); inv = powf(10000.f, -(float)(j % 8) / 8.f); off = ROPE_MR + (size_t)j * 2; }
        else { j -= 256 * 8; pos = (float)(j / 8); inv = powf(10000.f, -(float)(j % 8) / 8.f); off = ROPE_MC + (size_t)j * 2; }
        const float ang = pos * inv; rope[off] = cosf(ang); rope[off + 1] = sinf(ang);
    }
    bf16* WL = wsp<bf16>(F, WS_WLORA);
    for (int i = gid; i < 2560 * 384; i += GT) { const int n = i / 384, k = i - n * 384, part = n >> 9, c = n & 511; float v = 0.f;
        if (part < 2) { if ((k >> 6) == part) v = F.in[I_RW2][((size_t)part * 64 + (k & 63)) * 512 + c]; }
        else if (part < 4) { if ((k >> 6) == part) v = F.in[I_A2][((size_t)(part - 2) * 64 + (k & 63)) * 512 + c]; }
        else { if (k >= 256) v = F.in[I_G2][(size_t)(k - 256) * 512 + c]; }
        WL[i] = (bf16)f2bf(v); }
    const int gw = F.blk * 8 + F.wave, NGW = F.G * 8;
    tr_family(F, F.in[I_ATTW], 0, 1, 1024, ATT_IN, ATT_NP, wsp<bf16>(F, WS_WIN0), gw, NGW);
    tr_family(F, F.in[I_WUQ], 0, 1, 384, 768, 768, wsp<bf16>(F, WS_WUQ), gw, NGW);
    tr_family(F, F.in[I_WUKV], 0, 1, 256, 1024, 1024, wsp<bf16>(F, WS_WUKV), gw, NGW);
    tr_family(F, F.in[I_WOUT], (size_t)1024 * 1024, 2, 1024, 1024, 1024, wsp<bf16>(F, WS_WOUT), gw, NGW);
    tr_family(F, F.in[I_RECW], 0, 1, 1024, REC_IN, REC_NP, wsp<bf16>(F, WS_WREC), gw, NGW);
    moe_weights_convert(F, 0, gw, NGW);
}
__device__ __forceinline__ void p0b(const Frame& F) {
    const int gw = F.blk * 8 + F.wave, NGW = F.G * 8;
    for (int row = gw; row < R; row += NGW) { const int sel = row_sel(row);
        norm_mod_row(F, h0_row(F, row), F.in[I_NMIX], modp(F, 0, sel, 0), modp(F, 0, sel, 1), wsp<bf16>(F, WS_A) + (size_t)row * DM); }
}
struct FnStoreBf16 {
    bf16* O; int ldc;
    __device__ __forceinline__ void operator()(int row, int col, f32x4 v0, f32x4 v1) const {
        v4u w; w.x = pg8::cvt_pk_bf16(v0[0], v0[1]); w.y = pg8::cvt_pk_bf16(v0[2], v0[3]); w.z = pg8::cvt_pk_bf16(v1[0], v1[1]); w.w = pg8::cvt_pk_bf16(v1[2], v1[3]);
        *(v4u*)(O + (size_t)row * ldc + col) = w; }
};
struct FnWout {
    const Frame* F; int layer;
    __device__ __forceinline__ void operator()(int row, int col, f32x4 v0, f32x4 v1) const {
        float* hrow = wsp<float>(*F, WS_H) + (size_t)row * DM + col;
        const float* base = (layer == 0) ? h0_row(*F, row) + col : hrow;
        const float* g = modp(*F, layer, row_sel(row), 2) + col;
        const f32x4 b0 = *(const f32x4*)base, b1 = *(const f32x4*)(base + 4), g0 = *(const f32x4*)g, g1 = *(const f32x4*)(g + 4);
        *(f32x4*)hrow = b0 + g0 * v0; *(f32x4*)(hrow + 4) = b1 + g1 * v1; }
};
__device__ __forceinline__ void l0_post_proj(const Frame& F) {
    const int gw = F.blk * 8 + F.wave, NGW = F.G * 8, lane = F.lane;
    const bf16* P = wsp<const bf16>(F, WS_P); const float* rope = wsp<const float>(F, WS_ROPE);
    constexpr float CD = 0.125f * 1.4426950408889634f;
    for (int row = gw; row < R; row += NGW) {
        const int b = row / TB, t = row - b * TB; const bool lat = t >= CT; const int pos = t - CT, prow = lat ? pos >> 6 : 0, pcol = lat ? pos & 63 : 0;
        const bf16* p = P + (size_t)row * ATT_NP;
        bf16* qd = wsp<bf16>(F, WS_QD) + (size_t)row * 512; bf16* kd = wsp<bf16>(F, WS_KD) + (size_t)row * 512;
#pragma unroll
        for (int j = 0; j < 8; ++j) { const int pr = lane + 64 * j, h16 = pr >> 5, i = pr & 31;
            const float x1 = bf2f(p[h16 * 64 + i]), x2 = bf2f(p[h16 * 64 + i + 32]); float c = 1.f, s = 0.f;
            if (lat) { const float* tb = (i < 16) ? rope + ROPE_DR + (size_t)(prow * 16 + i) * 2 : rope + ROPE_DC + (size_t)(pcol * 16 + i - 16) * 2; c = tb[0]; s = tb[1]; }
            float y1 = x1 * c - x2 * s, y2 = x1 * s + x2 * c;
            if (h16 < 8) { qd[h16 * 64 + i] = (bf16)f2bf(y1 * CD); qd[h16 * 64 + i + 32] = (bf16)f2bf(y2 * CD); }
            else { kd[(h16 - 8) * 64 + i] = (bf16)f2bf(y1); kd[(h16 - 8) * 64 + i + 32] = (bf16)f2bf(y2); } }
        { float x[6]; float ss = 0.f;
#pragma unroll
          for (int j = 0; j < 6; ++j) { x[j] = bf2f(p[1536 + lane + 64 * j]); ss += x[j] * x[j]; }
          const float rs = 1.f / sqrtf(wave_sum(ss) * (1.f / 384.f) + NORM_EPS); bf16* o = wsp<bf16>(F, WS_CQN) + (size_t)row * 384;
#pragma unroll
          for (int j = 0; j < 6; ++j) o[lane + 64 * j] = (bf16)f2bf(x[j] * rs * F.in[I_QNW][lane + 64 * j]); }
        { float x[4]; float ss = 0.f;
#pragma unroll
          for (int j = 0; j < 4; ++j) { x[j] = bf2f(p[1920 + lane + 64 * j]); ss += x[j] * x[j]; }
          const float rs = 1.f / sqrtf(wave_sum(ss) * (1.f / 256.f) + NORM_EPS); bf16* o = wsp<bf16>(F, WS_CKVN) + (size_t)row * 256;
#pragma unroll
          for (int j = 0; j < 4; ++j) o[lane + 64 * j] = (bf16)f2bf(x[j] * rs * F.in[I_KVNW][lane + 64 * j]); }
        if (lane < 16) { const int i = lane; const float x1 = bf2f(p[2176 + i]), x2 = bf2f(p[2176 + i + 16]); float c = 1.f, s = 0.f;
            if (lat) { const float* tb = (i < 8) ? rope + ROPE_MR + (size_t)(prow * 8 + i) * 2 : rope + ROPE_MC + (size_t)(pcol * 8 + i - 8) * 2; c = tb[0]; s = tb[1]; }
            bf16* o = wsp<bf16>(F, WS_KRR) + (size_t)row * 32; o[i] = (bf16)f2bf(x1 * c - x2 * s); o[i + 16] = (bf16)f2bf(x1 * s + x2 * c); }
    }
}
__device__ __forceinline__ void l0_mq_rope(const Frame& F) {
    const int gw = F.blk * 8 + F.wave, NGW = F.G * 8, lane = F.lane; const float* rope = wsp<const float>(F, WS_ROPE);
    const float CM = 0.10206207261596575f * 1.4426950408889634f;
    for (int row = gw; row < R; row += NGW) {
        const int b = row / TB, t = row - b * TB; const bool lat = t >= CT; const int pos = t - CT, prow = lat ? pos >> 6 : 0, pcol = lat ? pos & 63 : 0;
        bf16* q = wsp<bf16>(F, WS_MQ) + (size_t)row * 768;
#pragma unroll
        for (int j = 0; j < 8; ++j) { const int idx = lane + 64 * j, h = idx >> 6, d = idx & 63; q[h * 96 + d] = (bf16)f2bf(bf2f(q[h * 96 + d]) * CM); }
#pragma unroll
        for (int j = 0; j < 2; ++j) { const int pr = lane + 64 * j, h = pr >> 4, i = pr & 15; const float x1 = bf2f(q[h * 96 + 64 + i]), x2 = bf2f(q[h * 96 + 80 + i]); float c = 1.f, s = 0.f;
            if (lat) { const float* tb = (i < 8) ? rope + ROPE_MR + (size_t)(prow * 8 + i) * 2 : rope + ROPE_MC + (size_t)(pcol * 8 + i - 8) * 2; c = tb[0]; s = tb[1]; }
            q[h * 96 + 64 + i] = (bf16)f2bf((x1 * c - x2 * s) * CM); q[h * 96 + 80 + i] = (bf16)f2bf((x1 * s + x2 * c) * CM); }
    }
}
__device__ __forceinline__ void l0_attention(const Frame& F) {
    LAS char* lds = (LAS char*)F.lds;
    const bf16* QD = wsp<const bf16>(F, WS_QD); const bf16* KD = wsp<const bf16>(F, WS_KD); const bf16* P = wsp<const bf16>(F, WS_P);
    const bf16* MQ = wsp<const bf16>(F, WS_MQ); const bf16* MKV = wsp<const bf16>(F, WS_MKV); const bf16* KRR = wsp<const bf16>(F, WS_KRR);
    float* OD = wsp<float>(F, WS_ODIFF); float* OM = wsp<float>(F, WS_OMLA);
    for (int kind = 0; kind < 2; ++kind) {
        for (int L = F.blk; L < 1024 + 16; L += F.G) {
            int b, h8, qb, nkeys;
            if (L < 1024) { int pair;
                if (F.G == 256) { const int round = L >> 8, c = L & 255; pair = round * 4 + ((c & 7) >> 1); qb = 1 + (c & 1) * 32 + (c >> 3); }
                else { pair = L >> 6; qb = 1 + (L & 63); }
                b = pair >> 3; h8 = pair & 7; nkeys = TB; }
            else { const int s = L - 1024; b = s >> 3; h8 = s & 7; qb = 0; nkeys = CT; }
            const size_t q0 = (size_t)b * TB + (size_t)qb * 256, k0 = (size_t)b * TB;
            if (kind == 0)
                att::attn_unit<64, 128>(QD + q0 * 512 + h8 * 64, 512, KD + k0 * 512 + h8 * 64, 512, nullptr, 0, P + k0 * ATT_NP + 1024 + (h8 >> 1) * 128, ATT_NP,
                                        OD + q0 * 1024 + h8 * 128, 1024, nkeys, lds);
            else
                att::attn_unit<96, 64>(MQ + q0 * 768 + h8 * 96, 768, MKV + k0 * 1024 + h8 * 128, 1024, KRR + k0 * 32, 32, MKV + k0 * 1024 + h8 * 128 + 64, 1024,
                                       OM + q0 * 512 + h8 * 64, 512, nkeys, lds);
        }
    }
}
__device__ __forceinline__ void l0_combine(const Frame& F) {
    const int gw = F.blk * 8 + F.wave, NGW = F.G * 8, lane = F.lane;
    const float* lv = F.in[I_LAM];
    const float lam = __expf(wave_sum(lv[lane] * lv[64 + lane])) - __expf(wave_sum(lv[128 + lane] * lv[192 + lane])) + 0.2f;
    const float sw0 = F.in[I_SUBLN][2 * lane] * 0.8f, sw1 = F.in[I_SUBLN][2 * lane + 1] * 0.8f;
    for (int row = gw; row < R; row += NGW) {
        const float* od = wsp<const float>(F, WS_ODIFF) + (size_t)row * 1024; const float* om = wsp<const float>(F, WS_OMLA) + (size_t)row * 512;
        bf16* a1 = wsp<bf16>(F, WS_A1) + (size_t)row * DM;
#pragma unroll
        for (int h = 0; h < 4; ++h) {
            const float o1a = od[(2 * h) * 128 + 2 * lane], o1b = od[(2 * h) * 128 + 2 * lane + 1], o2a = od[(2 * h + 1) * 128 + 2 * lane], o2b = od[(2 * h + 1) * 128 + 2 * lane + 1];
            const float da = o1a - lam * o2a, db = o1b - lam * o2b;
            const float rs = 1.f / sqrtf(wave_sum(da * da + db * db) * (1.f / 128.f) + NORM_EPS);
            *(unsigned*)(a1 + h * 128 + 2 * lane) = pk2(da * rs * sw0, db * rs * sw1); }
#pragma unroll
        for (int j = 0; j < 2; ++j) { const f32x4 v = *(const f32x4*)(om + 4 * (lane + 64 * j)); v2u w; w.x = pk2(v.x, v.y); w.y = pk2(v.z, v.w); *(v2u*)(a1 + 512 + 4 * (lane + 64 * j)) = w; }
    }
}
constexpr int RT_MAXROWS = 24;
__device__ __forceinline__ void ph_router(const Frame& F, int layer) {
    LAS float* Wr = (LAS float*)F.lds;
    LAS float* fst = (LAS float*)(F.lds + AUX_OFF) + F.wave * 512;
    LAS int* hist = (LAS int*)(F.lds + MISC_OFF + 256);
    LAS int* recs = hist + 64 + F.wave * (RT_MAXROWS * 4);
    const int lane = F.lane, gw = F.blk * 8 + F.wave, NGW = F.G * 8;
    { const f32x4* src = (const f32x4*)(F.in[I_RW] + (size_t)layer * DM * NE);
      for (int i = F.tid; i < DM * NE / 4; i += 512) ((LAS f32x4*)Wr)[i] = src[i];
      if (F.tid < 64) hist[F.tid] = 0; }
    __syncthreads();
    const float* nw = F.in[I_NFFN] + (size_t)layer * DM; const float rb = F.in[I_RB][layer * NE + (lane & 31)];
    int ri = 0;
    for (int row = gw; row < R; row += NGW, ++ri) {
        const int sel = row_sel(row); const float* sh = modp(F, layer, sel, 3); const float* sc = modp(F, layer, sel, 4);
        const f32x4* xr = (const f32x4*)(wsp<const float>(F, WS_H) + (size_t)row * DM) + lane;
        f32x4 v[4]; float s = 0.f;
#pragma unroll
        for (int j = 0; j < 4; ++j) { v[j] = xr[64 * j]; s += (v[j].x * v[j].x + v[j].y * v[j].y) + (v[j].z * v[j].z + v[j].w * v[j].w); }
        const float rs = 1.f / sqrtf(wave_sum(s) * (1.f / DM) + NORM_EPS);
        unsigned long long* o8 = (unsigned long long*)(wsp<bf16>(F, WS_F) + (size_t)row * DM) + lane;
#pragma unroll
        for (int j = 0; j < 4; ++j) { const f32x4 w = ((const f32x4*)nw)[lane + 64 * j], a = ((const f32x4*)sh)[lane + 64 * j], c = ((const f32x4*)sc)[lane + 64 * j];
            v[j] = v[j] * rs * w * (c + 1.f) + a;
            o8[64 * j] = (unsigned long long)pk2(v[j].x, v[j].y) | ((unsigned long long)pk2(v[j].z, v[j].w) << 32); }
        float acc0 = 0.f, acc1 = 0.f, acc2 = 0.f, acc3 = 0.f; const int e = lane & 31, hf = lane >> 5;
#pragma unroll
        for (int ps = 0; ps < 2; ++ps) {
            ((LAS f32x4*)fst)[lane] = v[2 * ps]; ((LAS f32x4*)fst)[64 + lane] = v[2 * ps + 1];
            LDS_WAIT(); asm volatile("" ::: "memory");
            const LAS float* wp = Wr + (size_t)(512 * ps + 256 * hf) * NE + e; const LAS f32x4* fp = (const LAS f32x4*)(fst + 256 * hf);
#pragma unroll 8
            for (int k4 = 0; k4 < 64; ++k4) { const f32x4 f4 = fp[k4];
                acc0 += f4.x * wp[(4 * k4) * NE]; acc1 += f4.y * wp[(4 * k4 + 1) * NE]; acc2 += f4.z * wp[(4 * k4 + 2) * NE]; acc3 += f4.w * wp[(4 * k4 + 3) * NE]; }
            LDS_WAIT(); asm volatile("" ::: "memory");
        }
        const float acc = (acc0 + acc1) + (acc2 + acc3); float logit = acc + __shfl_xor(acc, 32) + rb;
        float selv[4]; int seli[4]; float val = logit;
#pragma unroll
        for (int r = 0; r < 4; ++r) { float bv = val; int bi = e;
#pragma unroll
            for (int o = 1; o < 32; o <<= 1) { const float ov = __shfl_xor(bv, o); const int oi = __shfl_xor(bi, o); if (ov > bv || (ov == bv && oi < bi)) { bv = ov; bi = oi; } }
            selv[r] = bv; seli[r] = bi; if (e == bi) val = -3.0e38f; }
        float ex[4], es = 0.f;
#pragma unroll
        for (int r = 0; r < 4; ++r) { ex[r] = __expf(selv[r] - selv[0]); es += ex[r]; }
        if (lane < 4) { const int r = lane; const int ee = r == 0 ? seli[0] : r == 1 ? seli[1] : r == 2 ? seli[2] : seli[3]; const float gg = (r == 0 ? ex[0] : r == 1 ? ex[1] : r == 2 ? ex[2] : ex[3]) / es;
            wsp<int>(F, WS_TOPE)[(size_t)row * 4 + r] = ee; wsp<float>(F, WS_GATE)[(size_t)row * 4 + r] = gg;
            const int rk = __hip_atomic_fetch_add(&hist[ee], 1, __ATOMIC_RELAXED, __HIP_MEMORY_SCOPE_WORKGROUP);
            if (ri < RT_MAXROWS) recs[ri * 4 + r] = ee | (rk << 8); }
    }
    __syncthreads();
    if (F.tid < NE) hist[32 + F.tid] = (int)__hip_atomic_fetch_add(F.ctl + CW_CNT + 64 * layer + F.tid, (unsigned)hist[F.tid], RLX_AGENT);
    __syncthreads();
    ri = 0;
    for (int row = gw; row < R; row += NGW, ++ri)
        if (lane < 4 && ri < RT_MAXROWS) { const int rc = recs[ri * 4 + lane]; wsp<int>(F, WS_POS)[(size_t)row * 4 + lane] = hist[32 + (rc & 255)] + (rc >> 8); }
}
__device__ __forceinline__ void moe_tables(const Frame& F, int layer, LAS int* ps, LAS int* tile_e) {
    if (F.tid == 0) { int acc = 0, t = 0;
        for (int e = 0; e < NE; ++e) { const int c = (int)__hip_atomic_load(F.ctl + CW_CNT + 64 * layer + e, RLX_AGENT); ps[e] = acc; const int nt = (c + 255) >> 8;
            for (int i = 0; i < nt && t < MAXT; ++i) tile_e[t++] = e; acc += nt * 256; }
        ps[NE] = acc; ps[NE + 1] = t; }
    __syncthreads();
}
__device__ __forceinline__ void ph_gather(const Frame& F, int layer) {
    LAS int* ps = (LAS int*)(F.lds + MISC_OFF + 256); LAS int* tile_e = ps + 64;
    moe_tables(F, layer, ps, tile_e);
    if (F.blk == 0) { int* tab = wsp<int>(F, WS_TILE); const int nt = ps[NE + 1]; if (F.tid == 0) tab[0] = nt; for (int i = F.tid; i < nt; i += 512) tab[1 + i] = tile_e[i]; }
    const int lane = F.lane, gw = F.blk * 8 + F.wave, NGW = F.G * 8;
    for (int row = gw; row < R; row += NGW) {
        int dest = 0;
        if (lane < 4) { const int e = wsp<const int>(F, WS_TOPE)[(size_t)row * 4 + lane]; dest = ps[e] + wsp<const int>(F, WS_POS)[(size_t)row * 4 + lane]; wsp<int>(F, WS_DEST)[(size_t)row * 4 + lane] = dest; }
        const v4u* src = (const v4u*)(wsp<const bf16>(F, WS_F) + (size_t)row * DM); const v4u a = src[lane], b = src[64 + lane];
#pragma unroll
        for (int r = 0; r < 4; ++r) { const int d = __shfl(dest, r); v4u* dst = (v4u*)(wsp<bf16>(F, WS_XS) + (size_t)d * DM); dst[lane] = a; dst[64 + lane] = b; }
    }
}
struct MoeOrder {
    const int* tile_e; int ntiles, nN, G, c;
    __device__ __forceinline__ bool next(int i, pg8::Unit& u) const {
        const long L = (long)i * G + c; if (L >= (long)ntiles * nN) return false;
        const int rt = (int)(L / nN), pl = (int)(L - (long)rt * nN); const int e = __builtin_amdgcn_readfirstlane(tile_e[rt]);
        u.pm = rt; u.pn = e * nN + pl; return true; }
    __device__ __forceinline__ void a_ready(const pg8::Unit&) const {}
    __device__ __forceinline__ void done(const pg8::Unit&) const {}
};
struct FnSwiglu {
    bf16* HS; const float* b1;
    __device__ __forceinline__ void operator()(int row, int col, f32x4 v0, f32x4 v1) const {
        const float* bp = b1 + col;
        const f32x4 b0 = *(const f32x4*)bp, b1v = *(const f32x4*)(bp + 4); v0 = v0 + b0; v1 = v1 + b1v;
        const float hv[8] = {v0[0], v0[1], v0[2], v0[3], v1[0], v1[1], v1[2], v1[3]}; float o[4];
#pragma unroll
        for (int i = 0; i < 4; ++i) { const float g = hv[2 * i], l = hv[2 * i + 1];
            const float gl = fminf(g, 7.f), li = fminf(fmaxf(l, -7.f), 7.f); o[i] = gl * sigmoidf_(1.702f * gl) * (li + 1.f); }
        const int lc = col & 2047; v2u w; w.x = pk2(o[0], o[1]); w.y = pk2(o[2], o[3]);
        *(v2u*)(HS + (size_t)row * 1024 + (lc >> 1)) = w; }
};
struct FnBiasBf16 {
    bf16* YS; const float* b2;
    __device__ __forceinline__ void operator()(int row, int col, f32x4 v0, f32x4 v1) const {
        const f32x4 b0 = *(const f32x4*)(b2 + col), b1v = *(const f32x4*)(b2 + col + 4); v0 = v0 + b0; v1 = v1 + b1v;
        v4u w; w.x = pk2(v0[0], v0[1]); w.y = pk2(v0[2], v0[3]); w.z = pk2(v1[0], v1[1]); w.w = pk2(v1[2], v1[3]);
        *(v4u*)(YS + (size_t)row * 1024 + (col & 1023)) = w; }
};
__device__ __forceinline__ void ph_combine(const Frame& F, int layer) {
    const int lane = F.lane, gw = F.blk * 8 + F.wave, NGW = F.G * 8;
    for (int row = gw; row < R; row += NGW) {
        const int sel = row_sel(row); const float* gf = modp(F, layer, sel, 5);
        float* hrow = wsp<float>(F, WS_H) + (size_t)row * DM;
        f32x4 y[4];
#pragma unroll
        for (int j = 0; j < 4; ++j) y[j] = (f32x4){0.f, 0.f, 0.f, 0.f};
#pragma unroll
        for (int r = 0; r < 4; ++r) { const int d = wsp<const int>(F, WS_DEST)[(size_t)row * 4 + r]; const float g = wsp<const float>(F, WS_GATE)[(size_t)row * 4 + r];
            const v2u* yp = (const v2u*)(wsp<const bf16>(F, WS_XS) + (size_t)d * DM);
#pragma unroll
            for (int j = 0; j < 4; ++j) { const v2u w = yp[lane + 64 * j]; y[j] += g * (f32x4){bflo(w.x), bfhi(w.x), bflo(w.y), bfhi(w.y)}; } }
        f32x4 h[4]; float s = 0.f;
#pragma unroll
        for (int j = 0; j < 4; ++j) { h[j] = ((const f32x4*)hrow)[lane + 64 * j] + ((const f32x4*)gf)[lane + 64 * j] * y[j]; s += (h[j].x * h[j].x + h[j].y * h[j].y) + (h[j].z * h[j].z + h[j].w * h[j].w); }
        const float rs = 1.f / sqrtf(wave_sum(s) * (1.f / DM) + NORM_EPS);
        if (layer == 0) {
#pragma unroll
            for (int j = 0; j < 4; ++j) ((f32x4*)hrow)[lane + 64 * j] = h[j];
            const float* nw = F.in[I_NMIX] + DM; const float* sh = modp(F, 1, sel, 0); const float* sc = modp(F, 1, sel, 1);
            unsigned long long* o8 = (unsigned long long*)(wsp<bf16>(F, WS_A) + (size_t)row * DM) + lane;
#pragma unroll
            for (int j = 0; j < 4; ++j) { const f32x4 w = ((const f32x4*)nw)[lane + 64 * j], a = ((const f32x4*)sh)[lane + 64 * j], c = ((const f32x4*)sc)[lane + 64 * j];
                const f32x4 o = h[j] * rs * w * (c + 1.f) + a; o8[64 * j] = (unsigned long long)pk2(o.x, o.y) | ((unsigned long long)pk2(o.z, o.w) << 32); }
        } else {
            const int b = row / TB, t = row - b * TB;
            if (t >= CT) { float* orow = F.out + ((size_t)b * SEQ + (t - CT)) * DM; const float* nw = F.in[I_FNW];
#pragma unroll
                for (int j = 0; j < 4; ++j) ((f32x4*)orow)[lane + 64 * j] = h[j] * rs * ((const f32x4*)nw)[lane + 64 * j]; }
        }
    }
}
constexpr int PC_Q = 1920, PC_K = 2176, PC_V = 2432, PC_O = 2944, PC_G = 3456;
__device__ __forceinline__ float softplusf_(float y) { return fmaxf(y, 0.f) + __logf(1.f + __expf(-fabsf(y))); }
__device__ __forceinline__ float tanhf_(float x) { return 1.f - 2.f / (1.f + __expf(2.f * x)); }
__device__ __forceinline__ void unpack8(v4u w, float (&x)[8]) { x[0] = bflo(w.x); x[1] = bfhi(w.x); x[2] = bflo(w.y); x[3] = bfhi(w.y); x[4] = bflo(w.z); x[5] = bfhi(w.z); x[6] = bflo(w.w); x[7] = bfhi(w.w); }
__device__ __forceinline__ void lerp8(const bf16* p, bool hp, bool hn, int c0, const float* mu, float (&u)[8]) {
    const v4u z4 = {0u, 0u, 0u, 0u};
    const v4u wx = *(const v4u*)(p + c0), wp = hp ? *(const v4u*)(p - REC_NP + c0) : z4, wn = hn ? *(const v4u*)(p + REC_NP + c0) : z4;
    float x[8], xp[8], xn[8]; unpack8(wx, x); unpack8(wp, xp); unpack8(wn, xn);
    const f32x4 m0 = *(const f32x4*)(mu + c0), m1 = *(const f32x4*)(mu + c0 + 4);
#pragma unroll
    for (int e = 0; e < 8; ++e) { const float m = e < 4 ? m0[e & 3] : m1[e & 3]; u[e] = x[e] + m * (0.5f * (xp[e] + xn[e]) - x[e]); }
}
__device__ __forceinline__ void st8f(float* o, const float (&u)[8]) { *(f32x4*)o = (f32x4){u[0], u[1], u[2], u[3]}; *(f32x4*)(o + 4) = (f32x4){u[4], u[5], u[6], u[7]}; }
__device__ __forceinline__ void l1_rwkv_prep(const Frame& F) {
    const int gw = F.blk * 8 + F.wave, NGW = F.G * 8, lane = F.lane; const float* mu = F.in[I_MU];
    for (int row = gw; row < R; row += NGW) {
        const int b = row / TB, t = row - b * TB; const bool hp = (t != 0 && t != CT), hn = (t != CT - 1 && t != TB - 1);
        const bf16* p = wsp<const bf16>(F, WS_P) + (size_t)row * REC_NP; const size_t ro = (size_t)row * 512 + 8 * lane;
        float u[8];
        lerp8(p, hp, hn, 8 * lane, mu, u); st8f(wsp<float>(F, WS_RR) + ro, u);
        lerp8(p, hp, hn, 1024 + 8 * lane, mu, u); st8f(wsp<float>(F, WS_VV) + ro, u);
        lerp8(p, hp, hn, 512 + 8 * lane, mu, u); st8f(wsp<float>(F, WS_KL) + ro, u);
        { const f32x4 k0 = *(const f32x4*)(F.in[I_KK] + 8 * lane), k1 = *(const f32x4*)(F.in[I_KK] + 8 * lane + 4); float ss = 0.f;
#pragma unroll
          for (int e = 0; e < 8; ++e) { u[e] *= (e < 4 ? k0[e & 3] : k1[e & 3]); ss += u[e] * u[e]; }
          ss += __shfl_xor(ss, 1); ss += __shfl_xor(ss, 2); ss += __shfl_xor(ss, 4);
          const float inv = -1.f / sqrtf(fmaxf(ss, 1e-24f));
#pragma unroll
          for (int e = 0; e < 8; ++e) u[e] *= inv;
          st8f(wsp<float>(F, WS_AKK) + ro, u); }
        if (lane < 48) { lerp8(p, hp, hn, 1536 + 8 * lane, mu, u);
#pragma unroll
            for (int e = 0; e < 8; ++e) u[e] = lane < 16 ? tanhf_(u[e]) : (lane < 32 ? u[e] : sigmoidf_(u[e]));
            v4u w; w.x = pk2(u[0], u[1]); w.y = pk2(u[2], u[3]); w.z = pk2(u[4], u[5]); w.w = pk2(u[6], u[7]);
            *(v4u*)(wsp<bf16>(F, WS_ALORA) + (size_t)row * 384 + 8 * lane) = w; }
    }
}
struct EpiLora {
    static constexpr bool PERM = true, AFTER_DRAIN = false;
    const Frame* F;
    template <int KIND> __device__ __forceinline__ void run(const pg8::f32x4 (&acc)[2][2][4][2], const pg8::Unit& u, int wr, int wc, int fr, int fq, int z) const {
#pragma unroll
        for (int ai = 0; ai < 2; ++ai)
#pragma unroll
            for (int m = 0; m < 4; ++m) { const int row = u.pm * 256 + ai * 128 + wr * 64 + m * 16 + fr;
#pragma unroll
                for (int bj = 0; bj < 2; ++bj) { const int c = ((u.pn & 1) * 256) + bj * 128 + wc * 32 + 8 * fq; const size_t ro = (size_t)row * 512 + c;
                    const pg8::f32x4 v0 = acc[ai][bj][m][0], v1 = acc[ai][bj][m][1]; const float x[8] = {v0[0], v0[1], v0[2], v0[3], v1[0], v1[1], v1[2], v1[3]}; float o[8];
                    if constexpr (KIND == 0) { const float* w0 = F->in[I_W0] + z * 512 + c;
#pragma unroll
                        for (int e = 0; e < 8; ++e) { const float wl = -softplusf_(-(w0[e] + x[e])) - 0.5f; o[e] = __expf(-__expf(wl)); }
                        st8f(wsp<float>(*F, WS_WDEC) + (size_t)z * R * 512 + ro, o); }
                    else if constexpr (KIND == 1) { const float* a0 = F->in[I_A0] + z * 512 + c; const float* ka = F->in[I_KA] + c;
                        const float* kl = wsp<const float>(*F, WS_KL) + ro; const float* ak = wsp<const float>(*F, WS_AKK) + ro; float o2[8];
#pragma unroll
                        for (int e = 0; e < 8; ++e) { const float a = sigmoidf_(a0[e] + x[e]); o[e] = kl[e] * (1.f + (a - 1.f) * ka[e]); o2[e] = -ak[e] * a; }
                        st8f(wsp<float>(*F, WS_KDIR) + (size_t)z * R * 512 + ro, o); st8f(wsp<float>(*F, WS_BB) + (size_t)z * R * 512 + ro, o2); }
                    else st8f(wsp<float>(*F, WS_GG) + ro, x); } }
    }
    __device__ __forceinline__ void operator()(const pg8::f32x4 (&acc)[2][2][4][2], const pg8::Unit& u, int wr, int wc, int fr, int fq) const {
        const int part = u.pn >> 1;
        if (part < 2) run<0>(acc, u, wr, wc, fr, fq, part); else if (part < 4) run<1>(acc, u, wr, wc, fr, fq, part - 2); else run<2>(acc, u, wr, wc, fr, fq, 0);
    }
};
__device__ __forceinline__ void mlstm_gates(const Frame& F, int row, int z, int h, float& ig, float& lf) {
    const bf16* g = wsp<const bf16>(F, WS_P) + (size_t)row * REC_NP + PC_G + z * 8 + h; const float* gb = F.in[I_GATEB] + z * 8 + h;
    const float gi = bf2f(g[0]) + gb[0], gf = bf2f(g[4]) + gb[4];
    ig = 15.f * tanhf_(gi * (1.f / 15.f)); const float cf = 15.f * tanhf_(gf * (1.f / 15.f)); lf = fminf(cf, 0.f) - __logf(1.f + __expf(-fabsf(cf)));
}
__device__ __forceinline__ void mlstm_chunk_head(const Frame& F, int z, int b, int h, int c, LAS float* vec) {
    LAS int* rows = (LAS int*)vec;
    if (F.tid < 64) { const int s = F.tid, row = b * TB + scan_tok(z, 64 * c + s); float ig, lf; mlstm_gates(F, row, z, h, ig, lf); rows[s] = row; vec[64 + s] = ig; vec[192 + s] = lf; }
    __syncthreads();
    if (F.tid < 64) { float a = 0.f; for (int s = 0; s <= F.tid; ++s) a += vec[192 + s]; vec[128 + F.tid] = a; }
    __syncthreads();
}
__device__ __forceinline__ void l1_mlstm_a(const Frame& F) {
    LAS float* Ks = (LAS float*)F.lds; LAS float* Vs = Ks + 64 * 64; LAS float* vec = (LAS float*)(F.lds + AUX_OFF); LAS int* rows = (LAS int*)vec;
    const bf16* P = wsp<const bf16>(F, WS_P);
    for (int u = F.blk; u < NUNIT_M; u += F.G) {
        const int cidx = u / 260, c = u - cidx * 260, z = cidx >> 3, b = (cidx >> 2) & 1, h = cidx & 3;
        mlstm_chunk_head(F, z, b, h, c, vec);
        if (F.tid < 64) { const float bl = vec[128 + 63]; const float uu = bl - vec[128 + F.tid] + vec[64 + F.tid]; float m = uu;
#pragma unroll
            for (int o = 1; o < 64; o <<= 1) m = fmaxf(m, __shfl_xor(m, o));
            vec[256 + F.tid] = __expf(uu - m);
            if (F.tid == 0) { wsp<float>(F, WS_SC)[2 * u] = bl; wsp<float>(F, WS_SC)[2 * u + 1] = m; } }
        __syncthreads();
        { const int s = F.tid >> 3, c8 = F.tid & 7; float x[8]; unpack8(*(const v4u*)(P + (size_t)rows[s] * REC_NP + PC_K + h * 64 + 8 * c8), x);
#pragma unroll
          for (int e = 0; e < 8; ++e) Ks[s * 64 + 8 * c8 + e] = x[e] * 0.125f; }
#pragma unroll
        for (int i = 0; i < 2; ++i) { const int s = (F.tid >> 4) + 32 * i, c8 = F.tid & 15; float x[8]; unpack8(*(const v4u*)(P + (size_t)rows[s] * REC_NP + PC_V + h * 128 + 8 * c8), x); const float w = vec[256 + s];
#pragma unroll
            for (int e = 0; e < 8; ++e) Vs[s * 128 + 8 * c8 + e] = x[e] * w; }
        __syncthreads();
        { const int dg = F.tid >> 5, vg = F.tid & 31; f32x4 acc[4];
#pragma unroll
          for (int i = 0; i < 4; ++i) acc[i] = (f32x4){0.f, 0.f, 0.f, 0.f};
#pragma unroll 4
          for (int s = 0; s < 64; ++s) { const f32x4 kd = *(const LAS f32x4*)(Ks + s * 64 + 4 * dg), vv = *(const LAS f32x4*)(Vs + s * 128 + 4 * vg);
              acc[0] += kd.x * vv; acc[1] += kd.y * vv; acc[2] += kd.z * vv; acc[3] += kd.w * vv; }
          float* dc = wsp<float>(F, WS_DC) + (size_t)u * 8192 + (size_t)(4 * dg) * 128 + 4 * vg;
#pragma unroll
          for (int i = 0; i < 4; ++i) *(f32x4*)(dc + i * 128) = acc[i];
          if (F.tid < 64) { float a = 0.f; for (int s = 0; s < 64; ++s) a += vec[256 + s] * Ks[s * 64 + F.tid]; wsp<float>(F, WS_DN)[(size_t)u * 64 + F.tid] = a; } }
        __syncthreads();
    }
}
__device__ __forceinline__ void l1_mlstm_b(const Frame& F) {
    const float* SC = wsp<const float>(F, WS_SC); const float* DC = wsp<const float>(F, WS_DC); float* CST = wsp<float>(F, WS_CST);
    for (int g = F.blk * 512 + F.tid; g < 16 * 8192; g += F.G * 512) {
        const int chain = g >> 13, el = g & 8191; float m = 0.f, C = 0.f, N = 0.f; const bool don = el < 64;
        for (int c = 0; c < 260; ++c) { const size_t u = (size_t)chain * 260 + c;
            CST[u * 8192 + el] = C; if (don) wsp<float>(F, WS_NST)[u * 64 + el] = N; if (el == 0) wsp<float>(F, WS_MST)[u] = m;
            const float bl = SC[2 * u], ml = SC[2 * u + 1], mn = fmaxf(bl + m, ml), cd = __expf(bl + m - mn), inj = __expf(ml - mn);
            C = cd * C + inj * DC[u * 8192 + el]; if (don) N = cd * N + inj * wsp<const float>(F, WS_DN)[u * 64 + el]; m = mn; }
    }
}
__device__ __forceinline__ void l1_mlstm_c(const Frame& F, int first_blk, int nblk) {
    LAS float* qT = (LAS float*)F.lds; LAS float* kT = qT + 4096; LAS float* Vs = kT + 4096; LAS float* Cs = Vs + 8192; LAS float* PT = Cs + 8192;
    LAS float* vec = (LAS float*)(F.lds + AUX_OFF); LAS int* rows = (LAS int*)vec;
    const bf16* P = wsp<const bf16>(F, WS_P);
    for (int u = F.blk - first_blk; u < NUNIT_M; u += nblk) {
        const int cidx = u / 260, c = u - cidx * 260, z = cidx >> 3, b = (cidx >> 2) & 1, h = cidx & 3;
        mlstm_chunk_head(F, z, b, h, c, vec);
        const float mst = wsp<const float>(F, WS_MST)[u];
        if (F.tid < 64) { const int t = F.tid; float pm = -3.0e38f; for (int s = 0; s <= t; ++s) pm = fmaxf(pm, vec[64 + s] - vec[128 + s]);
            const float gi = vec[128 + t] + mst, mo = fmaxf(gi, vec[128 + t] + pm); vec[320 + t] = __expf(gi - mo); vec[384 + t] = mo;
            vec[256 + t] = wsp<const float>(F, WS_NST)[(size_t)u * 64 + t]; }
        { const int c8 = F.tid >> 6, t = F.tid & 63; float x[8]; unpack8(*(const v4u*)(P + (size_t)rows[t] * REC_NP + PC_Q + h * 64 + 8 * c8), x);
#pragma unroll
          for (int e = 0; e < 8; ++e) qT[(8 * c8 + e) * 64 + t] = x[e];
          unpack8(*(const v4u*)(P + (size_t)rows[t] * REC_NP + PC_K + h * 64 + 8 * c8), x);
#pragma unroll
          for (int e = 0; e < 8; ++e) kT[(8 * c8 + e) * 64 + t] = x[e] * 0.125f; }
#pragma unroll
        for (int i = 0; i < 2; ++i) { const int s = (F.tid >> 4) + 32 * i, c8 = F.tid & 15; float x[8]; unpack8(*(const v4u*)(P + (size_t)rows[s] * REC_NP + PC_V + h * 128 + 8 * c8), x);
            *(LAS f32x4*)(Vs + s * 128 + 8 * c8) = (f32x4){x[0], x[1], x[2], x[3]}; *(LAS f32x4*)(Vs + s * 128 + 8 * c8 + 4) = (f32x4){x[4], x[5], x[6], x[7]}; }
        { const f32x4* src = (const f32x4*)(wsp<const float>(F, WS_CST) + (size_t)u * 8192);
#pragma unroll
          for (int i = 0; i < 4; ++i) ((LAS f32x4*)Cs)[F.tid + 512 * i] = src[F.tid + 512 * i]; }
        __syncthreads();
        { const int tg = F.tid & 15, sg = F.tid >> 4; f32x4 a0 = {0.f, 0.f, 0.f, 0.f}, a1 = a0;
#pragma unroll 4
          for (int d = 0; d < 64; ++d) { const f32x4 q4 = *(const LAS f32x4*)(qT + d * 64 + 4 * tg); const float k0 = kT[d * 64 + 2 * sg], k1 = kT[d * 64 + 2 * sg + 1]; a0 += q4 * k0; a1 += q4 * k1; }
#pragma unroll
          for (int j = 0; j < 2; ++j) { const int s = 2 * sg + j; const float cs = vec[64 + s] - vec[128 + s]; f32x4 pv;
#pragma unroll
              for (int i = 0; i < 4; ++i) { const int t = 4 * tg + i; const float qk = j == 0 ? a0[i] : a1[i]; pv[i] = (s <= t) ? qk * __expf(vec[128 + t] + cs - vec[384 + t]) : 0.f; }
              *(LAS f32x4*)(PT + s * 64 + 4 * tg) = pv; } }
        __syncthreads();
        { const int tg = F.tid >> 5, vg = F.tid & 31; f32x4 ac[4], ap[4]; f32x4 nq = {0.f, 0.f, 0.f, 0.f}, rs = nq;
#pragma unroll
          for (int i = 0; i < 4; ++i) { ac[i] = (f32x4){0.f, 0.f, 0.f, 0.f}; ap[i] = ac[i]; }
#pragma unroll 4
          for (int d = 0; d < 64; ++d) { const f32x4 q4 = *(const LAS f32x4*)(qT + d * 64 + 4 * tg), c4 = *(const LAS f32x4*)(Cs + d * 128 + 4 * vg);
              ac[0] += q4.x * c4; ac[1] += q4.y * c4; ac[2] += q4.z * c4; ac[3] += q4.w * c4; nq += q4 * vec[256 + d]; }
#pragma unroll 4
          for (int s = 0; s < 64; ++s) { const f32x4 p4 = *(const LAS f32x4*)(PT + s * 64 + 4 * tg), v4 = *(const LAS f32x4*)(Vs + s * 128 + 4 * vg);
              ap[0] += p4.x * v4; ap[1] += p4.y * v4; ap[2] += p4.z * v4; ap[3] += p4.w * v4; rs += p4; }
#pragma unroll
          for (int i = 0; i < 4; ++i) { const int t = 4 * tg + i; const float g = vec[320 + t], den = g * nq[i] + rs[i], dn = fmaxf(fabsf(den), __expf(-vec[384 + t]));
              const f32x4 hv = (g * ac[i] + ap[i]) * (1.f / dn);
              *(f32x4*)(wsp<float>(F, WS_HM) + ((size_t)z * R + rows[t]) * 512 + h * 128 + 4 * vg) = hv; } }
        __syncthreads();
    }
}
template <int CTRL> __device__ __forceinline__ float dpp_add(float v) { return v + __builtin_bit_cast(float, __builtin_amdgcn_update_dpp(0, __builtin_bit_cast(int, v), CTRL, 0xF, 0xF, true)); }
__device__ __forceinline__ float reduce16(float v) { v = dpp_add<0xB1>(v); v = dpp_add<0x4E>(v); v = dpp_add<0x141>(v); v = dpp_add<0x140>(v); return v; }
struct ScanIn { f32x4 a, b, w, k, r; float v; };
__device__ __forceinline__ void l1_rwkv_scan(const Frame& F) {
    const int chain = F.blk >> 1, z = chain >> 4, b = (chain >> 3) & 1, h = chain & 7;
    const int g = F.lane >> 4, p = F.lane & 15, i = (F.blk & 1) * 32 + F.wave * 4 + g;
    const float* AK = wsp<const float>(F, WS_AKK); const float* BBz = wsp<const float>(F, WS_BB) + (size_t)z * R * 512; const float* WD = wsp<const float>(F, WS_WDEC) + (size_t)z * R * 512;
    const float* KDz = wsp<const float>(F, WS_KDIR) + (size_t)z * R * 512; const float* RRp = wsp<const float>(F, WS_RR); const float* VVp = wsp<const float>(F, WS_VV);
    float* Y = wsp<float>(F, WS_YR) + (size_t)z * R * 512;
    const int co = h * 64 + 4 * p, cv = h * 64 + i;
    float s0 = 0.f, s1 = 0.f, s2 = 0.f, s3 = 0.f;
#define SC_LOAD(S, sg) do { const size_t ro_ = ((size_t)b * TB + scan_tok(z, (sg))) * 512; S.a = *(const f32x4*)(AK + ro_ + co); S.b = *(const f32x4*)(BBz + ro_ + co); \
    S.w = *(const f32x4*)(WD + ro_ + co); S.k = *(const f32x4*)(KDz + ro_ + co); S.r = *(const f32x4*)(RRp + ro_ + co); S.v = VVp[ro_ + cv]; } while (0)
#define SC_STEP(S, sg) do { float pa = (s0 * S.a.x + s1 * S.a.y) + (s2 * S.a.z + s3 * S.a.w); pa = reduce16(pa); \
    s0 = s0 * S.w.x + (pa * S.b.x + S.v * S.k.x); s1 = s1 * S.w.y + (pa * S.b.y + S.v * S.k.y); s2 = s2 * S.w.z + (pa * S.b.z + S.v * S.k.z); s3 = s3 * S.w.w + (pa * S.b.w + S.v * S.k.w); \
    float py = (s0 * S.r.x + s1 * S.r.y) + (s2 * S.r.z + s3 * S.r.w); py = reduce16(py); \
    if (p == 0) Y[((size_t)b * TB + scan_tok(z, (sg))) * 512 + cv] = py; } while (0)
    ScanIn A0, A1, A2, A3, B0, B1, B2, B3;
    SC_LOAD(A0, 0); SC_LOAD(A1, 1); SC_LOAD(A2, 2); SC_LOAD(A3, 3);
    for (int sg = 0; sg < TB; sg += 8) {
        SC_LOAD(B0, sg + 4); SC_LOAD(B1, sg + 5); SC_LOAD(B2, sg + 6); SC_LOAD(B3, sg + 7);
        SC_STEP(A0, sg); SC_STEP(A1, sg + 1); SC_STEP(A2, sg + 2); SC_STEP(A3, sg + 3);
        if (sg + 8 < TB) { SC_LOAD(A0, sg + 8); SC_LOAD(A1, sg + 9); SC_LOAD(A2, sg + 10); SC_LOAD(A3, sg + 11); }
        SC_STEP(B0, sg + 4); SC_STEP(B1, sg + 5); SC_STEP(B2, sg + 6); SC_STEP(B3, sg + 7);
    }
#undef SC_LOAD
#undef SC_STEP
}
__device__ __forceinline__ void l1_rec_out(const Frame& F) {
    const int gw = F.blk * 8 + F.wave, NGW = F.G * 8, lane = F.lane, c0 = 8 * lane;
    for (int row = gw; row < R; row += NGW) {
        const size_t ro = (size_t)row * 512 + c0; bf16* a1 = wsp<bf16>(F, WS_A1) + (size_t)row * DM;
        { const float* y0 = wsp<const float>(F, WS_YR) + ro; const float* y1 = y0 + (size_t)R * 512; float y[8]; float s = 0.f;
#pragma unroll
          for (int e = 0; e < 8; ++e) { y[e] = y0[e] + y1[e]; s += y[e]; }
          s += __shfl_xor(s, 1); s += __shfl_xor(s, 2); s += __shfl_xor(s, 4); const float mean = s * (1.f / 64.f); float q = 0.f;
#pragma unroll
          for (int e = 0; e < 8; ++e) { y[e] -= mean; q += y[e] * y[e]; }
          q += __shfl_xor(q, 1); q += __shfl_xor(q, 2); q += __shfl_xor(q, 4); const float rstd = 1.f / sqrtf(q * (1.f / 64.f) + 64e-5f);
          const float* rr = wsp<const float>(F, WS_RR) + ro; const float* k0 = wsp<const float>(F, WS_KDIR) + ro; const float* k1 = k0 + (size_t)R * 512; const float* rk = F.in[I_RK] + c0; float bs = 0.f;
#pragma unroll
          for (int e = 0; e < 8; ++e) bs += rr[e] * (k0[e] + k1[e]) * rk[e];
          bs += __shfl_xor(bs, 1); bs += __shfl_xor(bs, 2); bs += __shfl_xor(bs, 4);
          const float* vv = wsp<const float>(F, WS_VV) + ro; const float* gg = wsp<const float>(F, WS_GG) + ro; const float* lw = F.in[I_LNW] + c0; const float* lb = F.in[I_LNB] + c0; float o[8];
#pragma unroll
          for (int e = 0; e < 8; ++e) o[e] = (y[e] * rstd * lw[e] + lb[e] + bs * vv[e]) * gg[e];
          v4u w; w.x = pk2(o[0], o[1]); w.y = pk2(o[2], o[3]); w.z = pk2(o[4], o[5]); w.w = pk2(o[6], o[7]); *(v4u*)(a1 + c0) = w; }
        { const float* h0 = wsp<const float>(F, WS_HM) + ro; const float* h1 = h0 + (size_t)R * 512; float x[8]; float q = 0.f;
#pragma unroll
          for (int e = 0; e < 8; ++e) { x[e] = h0[e] + h1[e]; q += x[e] * x[e]; }
          q += __shfl_xor(q, 1); q += __shfl_xor(q, 2); q += __shfl_xor(q, 4); q += __shfl_xor(q, 8); const float rs = 1.f / sqrtf(q * (1.f / 128.f) + NORM_EPS);
          float og[8]; unpack8(*(const v4u*)(wsp<const bf16>(F, WS_P) + (size_t)row * REC_NP + PC_O + c0), og); const float* nw = F.in[I_MNW] + c0; float o[8];
#pragma unroll
          for (int e = 0; e < 8; ++e) o[e] = x[e] * rs * nw[e] * sigmoidf_(og[e]);
          v4u w; w.x = pk2(o[0], o[1]); w.y = pk2(o[2], o[3]); w.z = pk2(o[4], o[5]); w.w = pk2(o[6], o[7]); *(v4u*)(a1 + 512 + c0) = w; }
    }
}
#ifndef MK_PER_PHASE
#define MK_PER_PHASE 0
#endif
constexpr int NPHASE = 26;
struct Args { const float* in[N_IN]; float* out; unsigned char* ws; int ph_lo, ph_hi, li, pad; };
#define GEMM_CALL(FnT, SchedT, g, S, fn) do { pg8::EpiGen<FnT> E_{fn}; { int k_ = g.K; asm volatile("" : "+s"(k_)); g.K = k_; } pg8::gemm_phase<pg8::EpiGen<FnT>, SchedT, true, true>((PG8_LAS unsigned char*)F.lds, g, S, E_); } while (0)
#ifndef SITE_MASK
#define SITE_MASK 0xFFFFFFFFull
#endif
#define SITE(s) (((SITE_MASK) >> (s)) & 1ull)
#define IN(k) (lo <= (k) && (k) < hi)
#define SEAM(k) do { if (IN(k) && IN((k) + 1)) xcd_barrier(bar); } while (0)
template <int LAYER> __device__ __forceinline__ void layer_phases(const Frame& F, const XcdBarrier& bar, const int lo, const int hi) {
    constexpr int layer = LAYER; constexpr int pb = 2 + 12 * LAYER;
        if (SITE(2) && IN(pb + 0)) {
            const int N = layer == 0 ? ATT_NP : REC_NP;
            pg8::Gemm g{wsp<const bf16>(F, WS_A), layer == 0 ? wsp<const bf16>(F, WS_WIN0) : wsp<const bf16>(F, WS_WREC), R, N, 1024};
            pg8::StaticOrder S; S.init(R, N, F.G, F.blk);
            GEMM_CALL(FnStoreBf16, pg8::StaticOrder, g, S, (FnStoreBf16{wsp<bf16>(F, WS_P), N}));
            SEAM(pb + 0);
        }
        if constexpr (LAYER == 0) {
            if (SITE(3) && IN(pb + 1)) { l0_post_proj(F); SEAM(pb + 1); }
            if (SITE(4) && IN(pb + 2)) {
                pg8::Gemm g{wsp<const bf16>(F, WS_CQN), wsp<const bf16>(F, WS_WUQ), R, 768, 384}; pg8::StaticOrder S; S.init(R, 768, F.G, F.blk);
                GEMM_CALL(FnStoreBf16, pg8::StaticOrder, g, S, (FnStoreBf16{wsp<bf16>(F, WS_MQ), 768}));
                SEAM(pb + 2);
            }
            if (SITE(5) && IN(pb + 3)) {
                pg8::Gemm g{wsp<const bf16>(F, WS_CKVN), wsp<const bf16>(F, WS_WUKV), R, 1024, 256}; pg8::StaticOrder S; S.init(R, 1024, F.G, F.blk);
                GEMM_CALL(FnStoreBf16, pg8::StaticOrder, g, S, (FnStoreBf16{wsp<bf16>(F, WS_MKV), 1024}));
                l0_mq_rope(F);
                SEAM(pb + 3);
            }
            if (SITE(6) && IN(pb + 4)) { l0_attention(F); SEAM(pb + 4); }
            if (SITE(7) && IN(pb + 5)) { l0_combine(F); SEAM(pb + 5); }
        } else {
            if (SITE(8) && IN(pb + 1)) { l1_rwkv_prep(F); l1_mlstm_a(F); SEAM(pb + 1); }
            if (SITE(9) && IN(pb + 2)) {
                pg8::Gemm g{wsp<const bf16>(F, WS_ALORA), wsp<const bf16>(F, WS_WLORA), R, 2560, 384}; pg8::StaticOrder S; S.init(R, 2560, F.G, F.blk);
                { int k_ = g.K; asm volatile("" : "+s"(k_)); g.K = k_; EpiLora E_{&F}; pg8::gemm_phase<EpiLora, pg8::StaticOrder, true, true>((PG8_LAS unsigned char*)F.lds, g, S, E_); }
                l1_mlstm_b(F);
                SEAM(pb + 2);
            }
            if (IN(pb + 3)) { SEAM(pb + 3); }
            if (SITE(10) && IN(pb + 4)) {
                if (F.G >= 128) { if (F.blk < 64) l1_rwkv_scan(F); else { l1_mlstm_c(F, 64, F.G - 64); moe_weights_convert(F, 1, (F.blk - 64) * 8 + F.wave, (F.G - 64) * 8); } }
                SEAM(pb + 4);
            }
            if (SITE(11) && IN(pb + 5)) { l1_rec_out(F); SEAM(pb + 5); }
        }
        if (SITE(12) && IN(pb + 6)) {
            pg8::Gemm g{wsp<const bf16>(F, WS_A1), wsp<const bf16>(F, WS_WOUT) + (size_t)layer * 1024 * 1024, R, 1024, 1024}; pg8::StaticOrder S; S.init(R, 1024, F.G, F.blk);
            GEMM_CALL(FnWout, pg8::StaticOrder, g, S, (FnWout{&F, layer}));
            SEAM(pb + 6);
        }
        if (SITE(13) && IN(pb + 7)) { ph_router(F, layer); SEAM(pb + 7); }
        if (SITE(14) && IN(pb + 8)) { ph_gather(F, layer); SEAM(pb + 8); }
        if (SITE(15) && IN(pb + 9)) {
            const int* tab = wsp<const int>(F, WS_TILE);
            pg8::Gemm g{wsp<const bf16>(F, WS_XS), wsp<const bf16>(F, WS_W1T), MAXROWS, NE * 2048, 1024}; MoeOrder S{tab + 1, __builtin_amdgcn_readfirstlane(tab[0]), 8, F.G, F.blk};
            GEMM_CALL(FnSwiglu, MoeOrder, g, S, (FnSwiglu{wsp<bf16>(F, WS_HS), F.in[I_B1] + (size_t)layer * NE * 2048}));
            SEAM(pb + 9);
        }
        if (SITE(16) && IN(pb + 10)) {
            const int* tab = wsp<const int>(F, WS_TILE);
            pg8::Gemm g{wsp<const bf16>(F, WS_HS), wsp<const bf16>(F, WS_W2T), MAXROWS, NE * 1024, 1024}; MoeOrder S{tab + 1, __builtin_amdgcn_readfirstlane(tab[0]), 4, F.G, F.blk};
            GEMM_CALL(FnBiasBf16, MoeOrder, g, S, (FnBiasBf16{wsp<bf16>(F, WS_XS), F.in[I_B2] + (size_t)layer * NE * 1024}));
            SEAM(pb + 10);
        }
        if (SITE(17) && IN(pb + 11)) { ph_combine(F, layer); SEAM(pb + 11); }
}
__global__ void __launch_bounds__(512, 2) fwd(Args args) {
    extern __shared__ __attribute__((aligned(16))) unsigned char lds_[];
    Frame F;
    F.lds = (LAS unsigned char*)lds_; F.tid = threadIdx.x; F.lane = F.tid & 63; F.wave = __builtin_amdgcn_readfirstlane(F.tid >> 6); F.blk = blockIdx.x; F.G = gridDim.x;
    F.ws = args.ws; F.out = args.out; F.ctl = (gu32*)(args.ws + WS_CTL);
    F.in.t = (LAS const unsigned*)(F.lds + MISC_OFF + 8192);
    if (F.tid < 64) ((LAS unsigned*)(F.lds + MISC_OFF))[F.tid] = 0u;
    if (F.tid < N_IN) { const unsigned long long pv = (unsigned long long)args.in[F.tid]; ((LAS unsigned*)(F.lds + MISC_OFF + 8192))[2 * F.tid] = (unsigned)pv; ((LAS unsigned*)(F.lds + MISC_OFF + 8192))[2 * F.tid + 1] = (unsigned)(pv >> 32); }
    __syncthreads();
    const int lo = args.ph_lo, hi = args.ph_hi;
    XcdBarrier bar; bar.bar = (unsigned*)(F.ctl + CW_BAR) + args.li * XCD_BAR_WORDS; bar.x = 0; bar.st = nullptr;
    if (hi - lo > 1) bar = xcd_barrier_post((unsigned*)(F.ctl + CW_BAR) + args.li * XCD_BAR_WORDS, (volatile LAS unsigned*)(F.lds + MISC_OFF));
    if (SITE(0) && IN(0)) { p0a(F); SEAM(0); }
    if (SITE(1) && IN(1)) { p0b(F); SEAM(1); }
    layer_phases<0>(F, bar, lo, hi);
    layer_phases<1>(F, bar, lo, hi);
}
#undef IN
#undef SEAM


extern "C" void kernel_launch(void* const* d_in, const int* in_sizes, int n_in, void* d_out, int out_size, void* d_ws, size_t ws_size, hipStream_t stream) {
    static int grid = 0;
    if (grid == 0) {
        const bool ok = n_in == N_IN && in_sizes[I_X] == NBATCH * SEQ * DM && in_sizes[I_RECW] == 1024 * REC_IN && in_sizes[I_ATTW] == 1024 * ATT_IN && in_sizes[I_MU] == RWKV_IN &&
                        in_sizes[I_GATEB] == 16 && in_sizes[I_W1] == 2 * NE * 1024 * 2048 && out_size == NBATCH * SEQ * DM && ws_size >= WS_END;
        if (!ok) { fprintf(stderr, "kernel_launch: shape mismatch (n_in %d, recw %d, attw %d, mu %d, out %d, ws %zu need %zu); nothing launched\n", n_in, n_in > I_RECW ? in_sizes[I_RECW] : -1,
                           n_in > I_ATTW ? in_sizes[I_ATTW] : -1, n_in > I_MU ? in_sizes[I_MU] : -1, out_size, ws_size, (size_t)WS_END); grid = -1; return; }
        int dev = 0, cus = 0;
        if (hipGetDevice(&dev) != hipSuccess || hipDeviceGetAttribute(&cus, hipDeviceAttributeMultiprocessorCount, dev) != hipSuccess) { grid = -1; return; }
        if (hipFuncSetAttribute((const void*)fwd, hipFuncAttributeMaxDynamicSharedMemorySize, LDS_BYTES) != hipSuccess) { fprintf(stderr, "kernel_launch: hipFuncSetAttribute failed\n"); grid = -1; return; }
        int per_cu = 0;
        if (hipOccupancyMaxActiveBlocksPerMultiprocessor(&per_cu, (const void*)fwd, 512, LDS_BYTES) != hipSuccess || per_cu < 1) { fprintf(stderr, "kernel_launch: occupancy query says %d blocks per CU\n", per_cu); }
        (void)hipGetLastError();
        grid = cus < 256 ? cus : 256;
        if (grid != 256) fprintf(stderr, "kernel_launch: %d CUs; this kernel is written for a 256-CU device\n", cus);
    }
    if (grid < 0) return;
    if (hipMemsetAsync((char*)d_ws + WS_CTL, 0, CTL_ZERO_BYTES, stream) != hipSuccess) return;
    Args a{};
    for (int i = 0; i < N_IN; ++i) a.in[i] = (const float*)d_in[i];
    a.out = (float*)d_out; a.ws = (unsigned char*)d_ws; a.pad = 0;
#if MK_PER_PHASE
    for (int ph = 0; ph < NPHASE; ++ph) { if (ph == 2 + 12 + 3) continue; a.ph_lo = ph; a.ph_hi = ph + 1; a.li = 0; hipLaunchKernelGGL(fwd, dim3(grid), dim3(512), LDS_BYTES, stream, a); }
#else
    a.ph_lo = 0; a.ph_hi = NPHASE; a.li = 0; hipLaunchKernelGGL(fwd, dim3(grid), dim3(512), LDS_BYTES, stream, a);
#endif
    const hipError_t le = hipPeekAtLastError();
    if (le != hipSuccess) fprintf(stderr, "kernel_launch: launch failed: %s\n", hipGetErrorName(le));
}
```

```cpp
#include <hip/hip_runtime.h>
#include <cstdio>
#include <cstdint>
#define MK_PER_PHASE 0
namespace pg8 {
#define PG8_LAS __attribute__((address_space(3)))
typedef unsigned short bf16_t;
typedef short bf16x8 __attribute__((ext_vector_type(8)));
typedef float f32x4 __attribute__((ext_vector_type(4)));
typedef unsigned u32x4 __attribute__((ext_vector_type(4)));
constexpr int BM = 256, BK = 64, HALF = 128, HTB = HALF * BK * 2  , STAGE_BYTES = 8 * HTB, NXCD = 8, WGM = 8;

__host__ __device__ __forceinline__ int lds_byte(int r, int c) { const int st = (r >> 4) * 2 + (c >> 5), rr = r & 15, cc = c & 31, ob = rr * 64 + cc * 2; return st * 1024 + (ob ^ (((ob >> 9) & 1) << 5)); }
__host__ __device__ __forceinline__ void stage_rc(int b, int& R, int& C) { const int st = b / 1024, sb = b % 1024, swz = sb ^ (((sb >> 9) & 1) << 5); R = (st >> 1) * 16 + swz / 64; C = (st & 1) * 32 + (swz % 64) / 2; }
__host__ __device__ __forceinline__ int perm32(int rho) { const int n = rho >> 4, i = rho & 15; return 8 * (i >> 2) + 4 * n + (i & 3); }

struct Unit { int pm, pn; };
struct Gemm { const bf16_t* A; const bf16_t* Bt; int M, N, K; };

struct StaticOrder {
    int nM, nN, nwg, G, c;
    __host__ __device__ void init(int M, int N, int G_, int c_) { nM = M / BM; nN = N / BM; nwg = nM * nN; G = G_; c = c_; }
    __host__ __device__ bool next(int i, Unit& u) const {
        const long L = (long)i * G + c; if (L >= nwg) return false;
        int wgid = (int)L; { const int q = nwg / NXCD, r = nwg % NXCD, xcd = wgid % NXCD, off = wgid / NXCD; wgid = (xcd < r ? xcd * (q + 1) : r * (q + 1) + (xcd - r) * q) + off; }
        const int nig = WGM * nN, gid = wgid / nig, fm = gid * WGM, gsz = (nM - fm) < WGM ? (nM - fm) : WGM;
        u.pm = fm + ((wgid % nig) % gsz); u.pn = (wgid % nig) / gsz; return true;
    }
    __device__ __forceinline__ void a_ready(const Unit&) const {}
    __device__ __forceinline__ void done(const Unit&) const {}
};

__device__ __forceinline__ unsigned cvt_pk_bf16(float lo, float hi) { unsigned r; asm volatile("v_cvt_pk_bf16_f32 %0, %1, %2" : "=v"(r) : "v"(lo), "v"(hi)); return r; }
template <class Fn> struct EpiGen {
    static constexpr bool PERM = true, AFTER_DRAIN = false;
    Fn fn;
    __device__ __forceinline__ void operator()(const f32x4 (&acc)[2][2][4][2], const Unit& u, int wr, int wc, int fr, int fq) const {
#pragma unroll
        for (int ai = 0; ai < 2; ++ai)
#pragma unroll
            for (int m = 0; m < 4; ++m) { const int row = u.pm * BM + ai * HALF + wr * 64 + m * 16 + fr;
#pragma unroll
                for (int bj = 0; bj < 2; ++bj) { const int col = u.pn * BM + bj * HALF + wc * 32 + 8 * fq; fn(row, col, acc[ai][bj][m][0], acc[ai][bj][m][1]); } }
    }
};
template <class Epi, class Sched, bool ALIGN_EPI = false, bool SP2 = false>
__device__ __forceinline__ void gemm_phase(PG8_LAS unsigned char* lds, const Gemm g, const Sched& S, const Epi& E) {
    const int tid = threadIdx.x, wid = __builtin_amdgcn_readfirstlane(tid >> 6), lane = tid & 63, wr = wid >> 2, wc = wid & 3, fr = lane & 15, fq = lane >> 4;
    const int K = g.K, nt = K / BK;
    unsigned voffA[2], voffB[2];
#pragma unroll
    for (int i = 0; i < 2; ++i) { int R, C; stage_rc(tid * 16 + i * 8192, R, C); const int Rb = Epi::PERM ? ((R & ~31) + perm32(R & 31)) : R;
        voffA[i] = (unsigned)(R * K + C) * 2u; voffB[i] = (unsigned)(Rb * K + C) * 2u; }
    const size_t kstep = (size_t)(BK * 2);
    const size_t hstep = (size_t)HALF * K * 2;
    const size_t tstep = 2 * hstep;
    const unsigned ldsw = (unsigned)wid * 1024u;
    const int aoff = lds_byte(wr * 64 + fr, fq * 8), boff = lds_byte(wc * 32 + fr, fq * 8);
#define PG8_SA(b, h) (((b) * 2 + (h)) * HTB)
#define PG8_SB(b, h) ((4 + (b) * 2 + (h)) * HTB)
#define PG8_STAGE(bufoff, gbase, voff) do { _Pragma("unroll") for (int _i = 0; _i < 2; ++_i) \
        __builtin_amdgcn_global_load_lds((const unsigned*)((const char*)(gbase) + (voff)[_i]), (PG8_LAS unsigned*)(lds + (bufoff) + ldsw + _i * 8192), 16, 0, 0); } while (0)
#define PG8_LDA(dst, b, h) do { _Pragma("unroll") for (int m = 0; m < 4; ++m) _Pragma("unroll") for (int k = 0; k < 2; ++k) dst[m][k] = *(const PG8_LAS bf16x8*)(lds + PG8_SA(b, h) + aoff + m * 2048 + k * 1024); } while (0)
#define PG8_LDB(dst, b, h) do { _Pragma("unroll") for (int n = 0; n < 2; ++n) _Pragma("unroll") for (int k = 0; k < 2; ++k) dst[n][k] = *(const PG8_LAS bf16x8*)(lds + PG8_SB(b, h) + boff + n * 2048 + k * 1024); } while (0)
#define PG8_MMA(ai, bj, At, Bt) do { __builtin_amdgcn_s_setprio(1); _Pragma("unroll") for (int m = 0; m < 4; ++m) _Pragma("unroll") for (int n = 0; n < 2; ++n) _Pragma("unroll") for (int k = 0; k < 2; ++k) \
        acc[ai][bj][m][n] = __builtin_amdgcn_mfma_f32_16x16x32_bf16(Bt[n][k], At[m][k], acc[ai][bj][m][n], 0, 0, 0); __builtin_amdgcn_s_setprio(0); } while (0)
#define PG8_WAIT_V(n) asm volatile("s_waitcnt vmcnt(" #n ")" ::: "memory")
#define PG8_WAIT_L(n) asm volatile("s_waitcnt lgkmcnt(" #n ")" ::: "memory")
#define PG8_BAR __builtin_amdgcn_s_barrier()
#define PG8_SCHED __builtin_amdgcn_sched_barrier(0)
    Unit cur, nxt; int ui = 0;
    if (!S.next(0, cur)) return;
    f32x4 acc[2][2][4][2];
#pragma unroll
    for (int a = 0; a < 2; ++a)
#pragma unroll
        for (int b = 0; b < 2; ++b)
#pragma unroll
            for (int m = 0; m < 4; ++m)
#pragma unroll
                for (int n = 0; n < 2; ++n) acc[a][b][m][n] = (f32x4){0.f, 0.f, 0.f, 0.f};
    bf16x8 At[4][2], B0[2][2], B1[2][2];
    const char* cA = (const char*)g.A + (size_t)cur.pm * tstep; const char* cB = (const char*)g.Bt + (size_t)cur.pn * tstep;
    S.a_ready(cur);
    if constexpr (SP2) {
        PG8_STAGE(PG8_SB(0, 0), cB, voffB); PG8_STAGE(PG8_SB(0, 1), cB + hstep, voffB); PG8_STAGE(PG8_SA(0, 0), cA, voffA); PG8_STAGE(PG8_SA(0, 1), cA + hstep, voffA);
        if (wr == 1) PG8_BAR;
        PG8_WAIT_V(2); PG8_BAR;
        PG8_STAGE(PG8_SB(1, 0), cB + kstep, voffB); PG8_STAGE(PG8_SA(1, 0), cA + kstep, voffA); PG8_STAGE(PG8_SB(1, 1), cB + hstep + kstep, voffB);
        PG8_WAIT_V(6); PG8_BAR;
    } else {
        PG8_STAGE(PG8_SB(0, 0), cB, voffB); PG8_STAGE(PG8_SA(0, 0), cA, voffA); PG8_STAGE(PG8_SB(0, 1), cB + hstep, voffB); PG8_STAGE(PG8_SA(0, 1), cA + hstep, voffA);
        if (wr == 1) PG8_BAR;
        PG8_WAIT_V(4); PG8_BAR;
        PG8_STAGE(PG8_SB(1, 0), cB + kstep, voffB); PG8_STAGE(PG8_SA(1, 0), cA + kstep, voffA); PG8_STAGE(PG8_SB(1, 1), cB + hstep + kstep, voffB);
        PG8_WAIT_V(6); PG8_BAR;
    }
    for (;;) {
        const bool has_next = S.next(ui + 1, nxt);
        const char* nA = has_next ? (const char*)g.A + (size_t)nxt.pm * tstep : cA; const char* nB = has_next ? (const char*)g.Bt + (size_t)nxt.pn * tstep : cB;
        for (int t = 0; t < nt; t += 2) {
            const bool last = (t == nt - 2);
            const char* a1 = cA + (size_t)(t + 1) * kstep;
            const char* a2 = last ? nA : cA + (size_t)(t + 2) * kstep; const char* b2 = last ? nB : cB + (size_t)(t + 2) * kstep;
            const char* a3 = a2 + kstep; const char* b3 = b2 + kstep;
            if (last && has_next) S.a_ready(nxt);
            if constexpr (SP2) {
            PG8_LDB(B0, 0, 0); PG8_LDB(B1, 0, 1); PG8_SCHED; PG8_LDA(At, 0, 0); PG8_STAGE(PG8_SA(1, 1), a1 + hstep, voffA);
            PG8_WAIT_V(8); PG8_WAIT_L(0); PG8_BAR; PG8_MMA(0, 0, At, B0); PG8_MMA(0, 1, At, B1); PG8_BAR; PG8_SCHED;
            PG8_LDA(At, 0, 1); PG8_STAGE(PG8_SB(0, 0), b2, voffB); PG8_STAGE(PG8_SB(0, 1), b2 + hstep, voffB); PG8_STAGE(PG8_SA(0, 0), a2, voffA);
            PG8_WAIT_V(8); PG8_WAIT_L(0); PG8_BAR; PG8_MMA(1, 0, At, B0); PG8_MMA(1, 1, At, B1); PG8_BAR; PG8_SCHED;
            PG8_LDB(B0, 1, 0); PG8_LDB(B1, 1, 1); PG8_SCHED; PG8_LDA(At, 1, 0); PG8_STAGE(PG8_SA(0, 1), a2 + hstep, voffA);
            PG8_WAIT_V(8); PG8_WAIT_L(0); PG8_BAR; PG8_MMA(0, 0, At, B0); PG8_MMA(0, 1, At, B1); PG8_BAR; PG8_SCHED;
            PG8_LDA(At, 1, 1); PG8_STAGE(PG8_SB(1, 0), b3, voffB); PG8_STAGE(PG8_SB(1, 1), b3 + hstep, voffB); PG8_STAGE(PG8_SA(1, 0), a3, voffA);
            PG8_WAIT_V(8); PG8_WAIT_L(0); PG8_BAR; PG8_MMA(1, 0, At, B0); PG8_MMA(1, 1, At, B1); PG8_BAR; PG8_SCHED;
            } else {
            PG8_LDB(B0, 0, 0); PG8_SCHED; PG8_LDA(At, 0, 0); PG8_STAGE(PG8_SA(1, 1), a1 + hstep, voffA);
            PG8_WAIT_L(8); PG8_BAR; PG8_WAIT_L(0); PG8_MMA(0, 0, At, B0); PG8_BAR; PG8_SCHED;
            PG8_LDB(B1, 0, 1); PG8_STAGE(PG8_SB(0, 0), b2, voffB);
            PG8_BAR; PG8_WAIT_L(0); PG8_MMA(0, 1, At, B1); PG8_BAR;
            PG8_LDA(At, 0, 1); PG8_STAGE(PG8_SA(0, 0), a2, voffA);
            PG8_BAR; PG8_WAIT_L(0); PG8_MMA(1, 0, At, B0); PG8_BAR; PG8_SCHED;
            PG8_STAGE(PG8_SB(0, 1), b2 + hstep, voffB);
            PG8_WAIT_V(6); PG8_BAR; PG8_MMA(1, 1, At, B1); PG8_BAR;
            PG8_LDB(B0, 1, 0); PG8_SCHED; PG8_LDA(At, 1, 0); PG8_STAGE(PG8_SA(0, 1), a2 + hstep, voffA);
            PG8_WAIT_L(8); PG8_BAR; PG8_WAIT_L(0); PG8_MMA(0, 0, At, B0); PG8_BAR; PG8_SCHED;
            PG8_LDB(B1, 1, 1); PG8_STAGE(PG8_SB(1, 0), b3, voffB);
            PG8_BAR; PG8_WAIT_L(0); PG8_MMA(0, 1, At, B1); PG8_BAR;
            PG8_LDA(At, 1, 1); PG8_STAGE(PG8_SA(1, 0), a3, voffA);
            PG8_BAR; PG8_WAIT_L(0); PG8_MMA(1, 0, At, B0); PG8_BAR; PG8_SCHED;
            PG8_STAGE(PG8_SB(1, 1), b3 + hstep, voffB);
            PG8_WAIT_V(6); PG8_BAR; PG8_MMA(1, 1, At, B1); PG8_BAR;
            }
        }
        if constexpr (ALIGN_EPI) { if (wr == 0) PG8_BAR; }
        if constexpr (!Epi::AFTER_DRAIN) { E(acc, cur, wr, wc, fr, fq); S.done(cur); }
        if (!has_next) break;
#pragma unroll
        for (int a = 0; a < 2; ++a)
#pragma unroll
            for (int b = 0; b < 2; ++b)
#pragma unroll
                for (int m = 0; m < 4; ++m)
#pragma unroll
                    for (int n = 0; n < 2; ++n) acc[a][b][m][n] = (f32x4){0.f, 0.f, 0.f, 0.f};
        cur = nxt; cA = nA; cB = nB; ++ui;
        if constexpr (ALIGN_EPI) { if (wr == 1) PG8_BAR; }
    }
    PG8_WAIT_V(0);
    if constexpr (!ALIGN_EPI) { if (wr == 0) PG8_BAR; }
    PG8_BAR;
    if constexpr (Epi::AFTER_DRAIN) { E.fused(acc, cur, wr, wc, fr, fq, lds, wid, lane); S.done(cur); }
#undef PG8_SA
#undef PG8_SB
#undef PG8_STAGE
#undef PG8_LDA
#undef PG8_LDB
#undef PG8_MMA
#undef PG8_WAIT_V
#undef PG8_WAIT_L
#undef PG8_BAR
#undef PG8_SCHED
}
}
#define GAS __attribute__((address_space(1)))
#define LAS __attribute__((address_space(3)))
typedef unsigned short bf16;
typedef unsigned v4u __attribute__((ext_vector_type(4)));
typedef unsigned v2u __attribute__((ext_vector_type(2)));
typedef float f32x4 __attribute__((ext_vector_type(4)));
typedef short bf16x8 __attribute__((ext_vector_type(8)));
typedef GAS unsigned gu32;
typedef GAS unsigned long long gu64;
#define RLX_AGENT __ATOMIC_RELAXED, __HIP_MEMORY_SCOPE_AGENT
#define LDS_WAIT() asm volatile("s_waitcnt lgkmcnt(0)" ::: "memory")
#define VM_WAIT() asm volatile("s_waitcnt vmcnt(0)" ::: "memory")
__device__ __forceinline__ unsigned f2bf(float f) { unsigned u = __builtin_bit_cast(unsigned, f); return (u + 0x7fffu + ((u >> 16) & 1u)) >> 16; }
__device__ __forceinline__ unsigned pk2(float lo, float hi) { return f2bf(lo) | (f2bf(hi) << 16); }
__device__ __forceinline__ float bflo(unsigned w) { return __builtin_bit_cast(float, w << 16); }
__device__ __forceinline__ float bfhi(unsigned w) { return __builtin_bit_cast(float, w & 0xffff0000u); }
__device__ __forceinline__ float bf2f(bf16 b) { return __builtin_bit_cast(float, (unsigned)b << 16); }
__device__ __forceinline__ float wave_sum(float v) {
#pragma unroll
    for (int o = 1; o < 64; o <<= 1) v += __shfl_xor(v, o);
    return v;
}
__device__ __forceinline__ float sigmoidf_(float x) { return 1.f / (1.f + __expf(-x)); }

#define XB_TMO      128
#define XB_XCNT(j)  (256  + 64 * (j))
#define XB_XSUB(j)  (1280 + 64 * (j))
#define XB_XGEN(j)  (2304 + 64 * (j))
#define XB_TOP      3328
#define XB_TOPGEN   3392
#define XCD_BAR_WORDS 3456
#define XB_SPIN_CAP (1u << 22)

__device__ __forceinline__ unsigned xb_ld(unsigned* p)              { return __hip_atomic_load(p, __ATOMIC_RELAXED, __HIP_MEMORY_SCOPE_AGENT); }
__device__ __forceinline__ unsigned xb_add(unsigned* p, unsigned v) { return __hip_atomic_fetch_add(p, v, __ATOMIC_RELAXED, __HIP_MEMORY_SCOPE_AGENT); }
__device__ __forceinline__ unsigned xb_xcc_id() { return (unsigned)__builtin_amdgcn_s_getreg((3 << 11) | 20) & 0xFu; }
#define XB_SPIN(cond, bar) do { unsigned _sp = 0; while (cond) { __builtin_amdgcn_s_sleep(1); \
    if ((++_sp & 255u) == 0u) { if (xb_ld(&(bar)[XB_TMO])) break; if (_sp > XB_SPIN_CAP) { atomicAdd(&(bar)[XB_TMO], 1u); break; } } } } while (0)

struct XcdBarrier {
    unsigned* bar; unsigned x;
    volatile LAS unsigned* st;
};

__device__ __forceinline__ XcdBarrier xcd_barrier_post(unsigned* bar, volatile LAS unsigned* st) {
    XcdBarrier b; b.bar = bar; b.x = xb_xcc_id(); b.st = st;
    if (threadIdx.x == 0) (void)xb_add(&bar[XB_XCNT(b.x)], 1u);
    return b;
}
__device__ __forceinline__ void xcd_barrier_complete(unsigned* bar, unsigned x, unsigned& nloc, unsigned& nx) {
    const unsigned G = gridDim.x * gridDim.y * gridDim.z;
    unsigned sum, cnt, mine, sp = 0u;
    for (;;) {
        sum = 0u; cnt = 0u; mine = 0u;
#pragma unroll
        for (unsigned j = 0; j < 16; ++j) { const unsigned c = xb_ld(&bar[XB_XCNT(j)]); sum += c; cnt += (c > 0u) ? 1u : 0u; mine = (j == x) ? c : mine; }
        if (sum == G) break;
        __builtin_amdgcn_s_sleep(1);
        if ((++sp & 255u) == 0u) { if (xb_ld(&bar[XB_TMO])) break; if (sp > XB_SPIN_CAP) { atomicAdd(&bar[XB_TMO], 1u); break; } }
    }
    nloc = mine > 0u ? mine : 1u; nx = cnt > 0u ? cnt : 1u;
}

__device__ __forceinline__ void xcd_barrier(const XcdBarrier& b) {
    asm volatile("s_waitcnt vmcnt(0)" ::: "memory");
    __syncthreads();
    if (threadIdx.x == 0) {
        unsigned* bar = b.bar;
        __builtin_amdgcn_s_waitcnt(0);
        unsigned nloc = b.st[0], nx = b.st[1];
        if (nloc == 0u) { xcd_barrier_complete(bar, b.x, nloc, nx); b.st[0] = nloc; b.st[1] = nx; }
        const unsigned old = xb_add(&bar[XB_XSUB(b.x)], 1u);
        const unsigned gen = old / nloc;
        if (old + 1u == (gen + 1u) * nloc) {
            __builtin_amdgcn_fence(__ATOMIC_RELEASE, "agent");
            asm volatile("s_waitcnt vmcnt(0)" ::: "memory");
            const unsigned og = xb_add(&bar[XB_TOP], 1u);
            const unsigned tg = og / nx;
            if (og + 1u == (tg + 1u) * nx) xb_add(&bar[XB_TOPGEN], 1u);
            else XB_SPIN(xb_ld(&bar[XB_TOPGEN]) == tg, bar);
            __builtin_amdgcn_fence(__ATOMIC_ACQUIRE, "agent");
            xb_add(&bar[XB_XGEN(b.x)], 1u);
            asm volatile("s_waitcnt vmcnt(0)" ::: "memory");
        } else {
            XB_SPIN(xb_ld(&bar[XB_XGEN(b.x)]) == gen, bar);
            __builtin_amdgcn_fence(__ATOMIC_ACQUIRE, "agent");
            asm volatile("s_waitcnt vmcnt(0)" ::: "memory");
        }
    }
    __syncthreads();
}
namespace att {
using s16x4  = __attribute__((ext_vector_type(4))) short;
using f32x16 = __attribute__((ext_vector_type(16))) float;
using u32x4  = __attribute__((ext_vector_type(4))) unsigned;
#define ATT_SBAR() __builtin_amdgcn_sched_barrier(0)
constexpr float THR2 = 11.5f;
__device__ __forceinline__ int crow(int r, int hi) { return (r & 3) + 8 * (r >> 2) + 4 * hi; }
__device__ __forceinline__ unsigned cvtpk(float lo, float hi) { unsigned r; asm volatile("v_cvt_pk_bf16_f32 %0, %1, %2" : "=v"(r) : "v"(lo), "v"(hi)); return r; }

__device__ __forceinline__ void partialSM(f32x16& p0, f32x16& p1, float& m_reg, float& mn, float& alpha) {
  float pmax = p0[0];
#pragma unroll
  for (int r = 1; r < 16; ++r) pmax = fmaxf(pmax, p0[r]);
#pragma unroll
  for (int r = 0; r < 16; ++r) pmax = fmaxf(pmax, p1[r]);
  { auto rr = __builtin_amdgcn_permlane32_swap(__float_as_uint(pmax), __float_as_uint(pmax), false, false);
    pmax = fmaxf(__uint_as_float(rr[0]), __uint_as_float(rr[1])); }
  if (__builtin_expect(__all(pmax - m_reg <= THR2), 1)) { mn = m_reg; alpha = 1.f; }
  else { mn = fmaxf(m_reg, pmax); alpha = __builtin_amdgcn_exp2f(m_reg - mn); m_reg = mn; }
#pragma unroll
  for (int r = 0; r < 16; ++r) p0[r] = p0[r] - mn;
#pragma unroll
  for (int r = 0; r < 16; ++r) p1[r] = p1[r] - mn;
#pragma unroll
  for (int r = 0; r < 16; ++r) p0[r] = __builtin_amdgcn_exp2f(p0[r]);
}
__device__ __forceinline__ void finishSM(f32x16& p0, f32x16& p1, float alpha, float& l_reg, bf16x8& pa0, bf16x8& pa1, bf16x8& pa2, bf16x8& pa3) {
#pragma unroll
  for (int r = 0; r < 16; ++r) p1[r] = __builtin_amdgcn_exp2f(p1[r]);
  float ps = 0;
#pragma unroll
  for (int r = 0; r < 16; ++r) ps += p0[r];
#pragma unroll
  for (int r = 0; r < 16; ++r) ps += p1[r];
  { auto rr = __builtin_amdgcn_permlane32_swap(__float_as_uint(ps), __float_as_uint(ps), false, false);
    ps = __uint_as_float(rr[0]) + __uint_as_float(rr[1]); }
  l_reg = l_reg * alpha + ps;
#define ATT_PK4(P, BASE, OUT) do { unsigned a0 = cvtpk(P[BASE + 0], P[BASE + 1]), a1 = cvtpk(P[BASE + 2], P[BASE + 3]);   \
    unsigned b0 = cvtpk(P[BASE + 4], P[BASE + 5]), b1 = cvtpk(P[BASE + 6], P[BASE + 7]);                              \
    auto r0 = __builtin_amdgcn_permlane32_swap(a0, b0, false, false); auto r1 = __builtin_amdgcn_permlane32_swap(a1, b1, false, false); \
    u32x4 w = {r0[0], r1[0], r0[1], r1[1]}; OUT = *reinterpret_cast<bf16x8*>(&w); } while (0)
  ATT_PK4(p0, 0, pa0); ATT_PK4(p0, 8, pa1); ATT_PK4(p1, 0, pa2); ATT_PK4(p1, 8, pa3);
#undef ATT_PK4
}
template <int NB> __device__ __forceinline__ int v_st(int k, int c) { const int kk = (k & ~0xC) | ((k & 4) << 1) | ((k & 8) >> 1); return ((kk >> 3) * NB + (c >> 5)) * 512 + ((kk & 7) * 32 + (c & 31)) * 2; }
__device__ __forceinline__ int v_rd_base(int lane) { return ((lane & 3) << 3) | (((lane >> 2) & 3) << 6) | (((lane >> 4) & 1) << 5) | (((lane >> 5) & 1) << 8); }
template <int OFF> __device__ __forceinline__ s16x4 tr_read(int vb) {
  s16x4 r; asm volatile("ds_read_b64_tr_b16 %0, %1 offset:%2" : "=&v"(r) : "v"(vb), "i"(OFF) : "memory"); return r;
}
template <int NB, int D0> __device__ __forceinline__ void pv_one(f32x16& od, int vb, bf16x8 pa0, bf16x8 pa1, bf16x8 pa2, bf16x8 pa3) {
#define ATT_VOFF(ks, half) (D0 * 512 + (ks) * (NB * 1024) + (half) * (NB * 512))
  const s16x4 l0 = tr_read<ATT_VOFF(0, 0)>(vb), h0 = tr_read<ATT_VOFF(0, 1)>(vb), l1 = tr_read<ATT_VOFF(1, 0)>(vb), h1 = tr_read<ATT_VOFF(1, 1)>(vb);
  const s16x4 l2 = tr_read<ATT_VOFF(2, 0)>(vb), h2 = tr_read<ATT_VOFF(2, 1)>(vb), l3 = tr_read<ATT_VOFF(3, 0)>(vb), h3 = tr_read<ATT_VOFF(3, 1)>(vb);
#undef ATT_VOFF
  asm volatile("s_waitcnt lgkmcnt(0)" ::: "memory"); ATT_SBAR();
#define ATT_PK(L, H) (bf16x8){L[0], L[1], L[2], L[3], H[0], H[1], H[2], H[3]}
  od = __builtin_amdgcn_mfma_f32_32x32x16_bf16(pa0, ATT_PK(l0, h0), od, 0, 0, 0);
  od = __builtin_amdgcn_mfma_f32_32x32x16_bf16(pa1, ATT_PK(l1, h1), od, 0, 0, 0);
  od = __builtin_amdgcn_mfma_f32_32x32x16_bf16(pa2, ATT_PK(l2, h2), od, 0, 0, 0);
  od = __builtin_amdgcn_mfma_f32_32x32x16_bf16(pa3, ATT_PK(l3, h3), od, 0, 0, 0);
#undef ATT_PK
}
template <int NB> __device__ __forceinline__ void pv_all(f32x16* o, int vb, bf16x8 pa0, bf16x8 pa1, bf16x8 pa2, bf16x8 pa3) {
  pv_one<NB, 0>(o[0], vb, pa0, pa1, pa2, pa3); pv_one<NB, 1>(o[1], vb, pa0, pa1, pa2, pa3);
  if constexpr (NB == 4) { pv_one<NB, 2>(o[2], vb, pa0, pa1, pa2, pa3); pv_one<NB, 3>(o[3], vb, pa0, pa1, pa2, pa3); }
}
template <int DK> __device__ __forceinline__ void qkt(f32x16& p0, f32x16& p1, LAS const char* Ks, const bf16x8* qr, int r32, int hi) {
  constexpr int KSTR = DK * 2 + 16;
  p0 = f32x16{}; p1 = f32x16{};
#pragma unroll
  for (int d0 = 0; d0 < DK / 16; ++d0) { const int cb = (d0 * 16 + hi * 8) * 2;
    const bf16x8 b0 = *(LAS const bf16x8*)(Ks + r32 * KSTR + cb);
    const bf16x8 b1 = *(LAS const bf16x8*)(Ks + (32 + r32) * KSTR + cb);
    p0 = __builtin_amdgcn_mfma_f32_32x32x16_bf16(b0, qr[d0], p0, 0, 0, 0);
    p1 = __builtin_amdgcn_mfma_f32_32x32x16_bf16(b1, qr[d0], p1, 0, 0, 0); }
}
template <int DK, int DV> struct Cfg {
  static constexpr int KSTR = DK * 2 + 16, KT = 64 * KSTR, NB = DV / 32, VT = 64 * DV * 2, NQ = DK / 16;
  static constexpr int NKC = DK / 8, NVC = DV / 8;
  static constexpr int KN = (64 * NKC + 511) / 512, VN = (64 * NVC + 511) / 512;
  static constexpr int OFF_V = 0, OFF_K = 2 * VT, OFF_WS = 2 * VT + 2 * KT, LDS_BYTES = OFF_WS + 8 * 64 * 4;
};
template <int DK, int DV>
__device__ __forceinline__ void attn_unit(const bf16* __restrict__ Qb, int ldq, const bf16* __restrict__ K1, int ldk1, const bf16* __restrict__ K2, int ldk2,
                                          const bf16* __restrict__ Vh, int ldv, float* __restrict__ Ob, int ldo, int nkeys, LAS char* lds) {
  using C = Cfg<DK, DV>;
  const int tid = threadIdx.x, wid = tid >> 6, lane = tid & 63, r32 = lane & 31, hi = lane >> 5;
  LAS char* V_lds = lds + C::OFF_V; LAS char* K_lds = lds + C::OFF_K;
  LAS float* ws = (LAS float*)(lds + C::OFF_WS) + wid * 64; LAS float* li_l = ws; LAS float* al_l = ws + 32;
  float m_reg = -1e30f, l_reg = 0; f32x16 o[C::NB] = {}; bf16x8 qr[C::NQ];
  { const bf16* Qw = Qb + (long)(wid * 32 + r32) * ldq + hi * 8;
#pragma unroll
    for (int d0 = 0; d0 < C::NQ; ++d0) qr[d0] = *(const bf16x8*)(Qw + d0 * 16); }
  int krow[C::KN], kch[C::KN], vrow[C::VN], vcol[C::VN]; bool kval[C::KN]; const bf16* kptr[C::KN]; int kstr[C::KN]; const bf16* vptr[C::VN];
#pragma unroll
  for (int i = 0; i < C::KN; ++i) { int it = tid + 512 * i; kval[i] = it < 64 * C::NKC; if (!kval[i]) it = tid; krow[i] = it / C::NKC; kch[i] = it % C::NKC;
    if (DK == 64 || kch[i] < 8) { kptr[i] = K1 + (long)krow[i] * ldk1 + kch[i] * 8; kstr[i] = ldk1; } else { kptr[i] = K2 + (long)krow[i] * ldk2 + (kch[i] - 8) * 8; kstr[i] = ldk2; } }
#pragma unroll
  for (int i = 0; i < C::VN; ++i) { const int it = tid + 512 * i; vrow[i] = it / C::NVC; vcol[i] = (it % C::NVC) * 8; vptr[i] = Vh + (long)vrow[i] * ldv + vcol[i]; }
  const int vb0 = (int)(uintptr_t)V_lds + v_rd_base(lane);
  struct Slot { bf16x8 ks[C::KN], vs[C::VN]; } sS;
#define ATT_SLOAD(S, k0) do { _Pragma("unroll") for (int i = 0; i < C::KN; ++i) S.ks[i] = *(const bf16x8*)(kptr[i] + (long)(k0) * kstr[i]); \
    _Pragma("unroll") for (int i = 0; i < C::VN; ++i) S.vs[i] = *(const bf16x8*)(vptr[i] + (long)(k0) * ldv); } while (0)
#define ATT_SWRITE(b, S) do { _Pragma("unroll") for (int i = 0; i < C::KN; ++i) if (kval[i]) *(LAS bf16x8*)(K_lds + (b) * C::KT + krow[i] * C::KSTR + kch[i] * 16) = S.ks[i]; \
    _Pragma("unroll") for (int i = 0; i < C::VN; ++i) *(LAS bf16x8*)(V_lds + (b) * C::VT + v_st<C::NB>(vrow[i], vcol[i])) = S.vs[i]; } while (0)
#define ATT_SWAIT() asm volatile("s_waitcnt vmcnt(0)" ::: "memory")
#define ATT_RESC(a) do { if (__any((a) < 1.f)) { if (hi == 0) al_l[r32] = (a); asm volatile("s_waitcnt lgkmcnt(0)" ::: "memory"); \
    _Pragma("unroll") for (int d = 0; d < C::NB; ++d) _Pragma("unroll") for (int r = 0; r < 16; ++r) o[d][r] *= al_l[crow(r, hi)]; } } while (0)
  static_assert(C::KN + C::VN == 3, "three staging loads per thread per tile (ATT_SWAIT)");
  f32x16 pA0, pA1, pB0, pB1; float mnA, mnB, alA, alB; bf16x8 pa0, pa1, pa2, pa3; const int NT = nkeys / 64;
  __syncthreads();
  ATT_SLOAD(sS, 0); asm volatile("s_waitcnt vmcnt(0)" ::: "memory"); ATT_SWRITE(0, sS); __syncthreads();
  qkt<DK>(pA0, pA1, K_lds, qr, r32, hi); partialSM(pA0, pA1, m_reg, mnA, alA);
  ATT_SLOAD(sS, 64);
  ATT_SWAIT(); ATT_SWRITE(1, sS); __syncthreads();
  for (int j = 1; j + 1 < NT; j += 2) {
    ATT_SBAR(); qkt<DK>(pB0, pB1, K_lds + C::KT, qr, r32, hi);
    finishSM(pA0, pA1, alA, l_reg, pa0, pa1, pa2, pa3); ATT_SBAR();
    ATT_SLOAD(sS, (j + 1) * 64); ATT_SBAR();
    pv_all<C::NB>(o, vb0, pa0, pa1, pa2, pa3); partialSM(pB0, pB1, m_reg, mnB, alB);
    __syncthreads(); ATT_SWAIT(); ATT_SWRITE(0, sS);
    ATT_RESC(alB); __syncthreads();
    ATT_SBAR(); qkt<DK>(pA0, pA1, K_lds, qr, r32, hi);
    finishSM(pB0, pB1, alB, l_reg, pa0, pa1, pa2, pa3); ATT_SBAR();
    ATT_SLOAD(sS, (j + 2) * 64); ATT_SBAR();
    pv_all<C::NB>(o, vb0 + C::VT, pa0, pa1, pa2, pa3); partialSM(pA0, pA1, m_reg, mnA, alA);
    __syncthreads(); ATT_SWAIT(); ATT_SWRITE(1, sS);
    ATT_RESC(alA); __syncthreads();
  }
  ATT_SBAR(); qkt<DK>(pB0, pB1, K_lds + C::KT, qr, r32, hi);
  finishSM(pA0, pA1, alA, l_reg, pa0, pa1, pa2, pa3); ATT_SBAR();
  pv_all<C::NB>(o, vb0, pa0, pa1, pa2, pa3); partialSM(pB0, pB1, m_reg, mnB, alB);
  __syncthreads(); ATT_RESC(alB);
  finishSM(pB0, pB1, alB, l_reg, pa0, pa1, pa2, pa3); ATT_SBAR();
  pv_all<C::NB>(o, vb0 + C::VT, pa0, pa1, pa2, pa3);
  if (hi == 0) li_l[r32] = l_reg; asm volatile("s_waitcnt lgkmcnt(0)" ::: "memory");
  float rli[16];
#pragma unroll
  for (int r = 0; r < 16; ++r) rli[r] = __builtin_amdgcn_rcpf(li_l[crow(r, hi)]);
  float* Ow = Ob + (long)(wid * 32) * ldo;
#pragma unroll
  for (int r = 0; r < 16; ++r) { const int orow = crow(r, hi);
#pragma unroll
    for (int d0 = 0; d0 < C::NB; ++d0) Ow[(long)orow * ldo + d0 * 32 + r32] = o[d0][r] * rli[r]; }
#undef ATT_SLOAD
#undef ATT_SWRITE
#undef ATT_SWAIT
#undef ATT_RESC
}
}
constexpr int DM = 1024, NBATCH = 2, SEQ = 16384, CT = 256, TB = SEQ + CT  , R = NBATCH * TB  ;
constexpr int ATT_IN = 2208, ATT_NP = 2304, REC_IN = 3472, REC_NP = 3584, RWKV_IN = 1920;
constexpr int NE = 32, TOPK = 4, MAXT = R * TOPK / 256 + NE  , MAXROWS = MAXT * 256;
constexpr int NUNIT_M = 16 * 260;
constexpr float NORM_EPS = 1e-6f;
enum { I_X = 0, I_C, I_CTX, I_CCTX, I_NMIX, I_NFFN, I_ADAW, I_ADAB, I_WOUT, I_RW, I_RB, I_W1, I_B1, I_W2, I_B2, I_ATTW, I_LAM, I_SUBLN, I_QNW, I_KVNW, I_WUQ, I_WUKV,
       I_RECW, I_MU, I_W0, I_RW2, I_A0, I_A2, I_G2, I_KK, I_KA, I_RK, I_LNW, I_LNB, I_GATEB, I_MNW, I_FNW, N_IN };
constexpr size_t al256(size_t x) { return (x + 255) & ~(size_t)255; }
constexpr size_t WS_CTL = 0, CTL_ZERO_BYTES = 1u << 20;
constexpr size_t WS_MOD = CTL_ZERO_BYTES;
constexpr size_t WS_ROPE = al256(WS_MOD + 2 * 3 * 6144 * 4);
constexpr size_t ROPE_DR = 0, ROPE_DC = 256 * 16 * 2, ROPE_MR = ROPE_DC + 64 * 16 * 2, ROPE_MC = ROPE_MR + 256 * 8 * 2, ROPE_FLOATS = ROPE_MC + 64 * 8 * 2;
constexpr size_t WS_WIN0 = al256(WS_ROPE + ROPE_FLOATS * 4);
constexpr size_t WS_WUQ = al256(WS_WIN0 + (size_t)ATT_NP * 1024 * 2);
constexpr size_t WS_WUKV = al256(WS_WUQ + (size_t)768 * 384 * 2);
constexpr size_t WS_WOUT = al256(WS_WUKV + (size_t)1024 * 256 * 2);
constexpr size_t WS_WREC = al256(WS_WOUT + (size_t)2 * 1024 * 1024 * 2);
constexpr size_t WS_WLORA = al256(WS_WREC + (size_t)REC_NP * 1024 * 2);
constexpr size_t WS_W1T = al256(WS_WLORA + (size_t)2560 * 384 * 2);
constexpr size_t WS_W2T = al256(WS_W1T + (size_t)NE * 2048 * 1024 * 2);
constexpr size_t WS_H = al256(WS_W2T + (size_t)NE * 1024 * 1024 * 2);
constexpr size_t WS_A = al256(WS_H + (size_t)R * 1024 * 4);
constexpr size_t WS_A1 = al256(WS_A + (size_t)R * 1024 * 2);
constexpr size_t WS_F = al256(WS_A1 + (size_t)R * 1024 * 2);
constexpr size_t WS_P = al256(WS_F + (size_t)R * 1024 * 2);
constexpr size_t WS_TOPE = al256(WS_P + (size_t)R * REC_NP * 2);
constexpr size_t WS_GATE = al256(WS_TOPE + (size_t)R * 16);
constexpr size_t WS_POS = al256(WS_GATE + (size_t)R * 16);
constexpr size_t WS_DEST = al256(WS_POS + (size_t)R * 16);
constexpr size_t WS_TILE = al256(WS_DEST + (size_t)R * 16);
constexpr size_t WS_T = al256(WS_TILE + (size_t)(MAXT + 8) * 4);
constexpr size_t WS_QD = WS_T;
constexpr size_t WS_KD = al256(WS_QD + (size_t)R * 512 * 2);
constexpr size_t WS_CQN = al256(WS_KD + (size_t)R * 512 * 2);
constexpr size_t WS_CKVN = al256(WS_CQN + (size_t)R * 384 * 2);
constexpr size_t WS_MQ = al256(WS_CKVN + (size_t)R * 256 * 2);
constexpr size_t WS_MKV = al256(WS_MQ + (size_t)R * 768 * 2);
constexpr size_t WS_KRR = al256(WS_MKV + (size_t)R * 1024 * 2);
constexpr size_t WS_ODIFF = al256(WS_KRR + (size_t)R * 32 * 2);
constexpr size_t WS_OMLA = al256(WS_ODIFF + (size_t)R * 1024 * 4);
constexpr size_t WS_T0_END = al256(WS_OMLA + (size_t)R * 512 * 4);
constexpr size_t WS_XS = WS_T;
constexpr size_t WS_HS = al256(WS_XS + (size_t)MAXROWS * 1024 * 2);
constexpr size_t WS_TM_END = al256(WS_HS + (size_t)MAXROWS * 1024 * 2);
constexpr size_t SZ_RC = (size_t)R * 512 * 4;
constexpr size_t WS_RR = WS_T, WS_VV = WS_RR + SZ_RC, WS_AKK = WS_VV + SZ_RC, WS_KL = WS_AKK + SZ_RC;
constexpr size_t WS_WDEC = WS_KL + SZ_RC  , WS_KDIR = WS_WDEC + 2 * SZ_RC  , WS_BB = WS_KDIR + 2 * SZ_RC  , WS_GG = WS_BB + 2 * SZ_RC;
constexpr size_t WS_ALORA = al256(WS_GG + SZ_RC);
constexpr size_t WS_YR = al256(WS_ALORA + (size_t)R * 384 * 2);
constexpr size_t WS_DC = WS_YR;
constexpr size_t WS_HM = al256(WS_YR + 2 * SZ_RC);
constexpr size_t WS_CST = al256(WS_HM + 2 * SZ_RC);
constexpr size_t WS_DN = al256(WS_CST + (size_t)NUNIT_M * 8192 * 4);
constexpr size_t WS_NST = al256(WS_DN + (size_t)NUNIT_M * 64 * 4);
constexpr size_t WS_SC = al256(WS_NST + (size_t)NUNIT_M * 64 * 4);
constexpr size_t WS_MST = al256(WS_SC + (size_t)NUNIT_M * 2 * 4);
constexpr size_t WS_T1_END = al256(WS_MST + (size_t)NUNIT_M * 4);
constexpr size_t WS_END = WS_T1_END > WS_TM_END ? (WS_T1_END > WS_T0_END ? WS_T1_END : WS_T0_END) : (WS_TM_END > WS_T0_END ? WS_TM_END : WS_T0_END);
static_assert(WS_END <= (size_t)2147483648ull, "workspace map exceeds 2 GiB");
constexpr int CW_CNT = 1024;
constexpr int CW_BAR = 4096;
constexpr int RING_BYTES = 131072, AUX_OFF = 131072, AUX_BYTES = 16384, MISC_OFF = 147456, LDS_BYTES = 163840;

struct Frame {
    LAS unsigned char* lds; gu32* ctl; int tid, lane, wave, blk, G;
    float* out; unsigned char* ws;
    struct InTab { LAS const unsigned* t;
        __device__ __forceinline__ const float* operator[](int i) const { const unsigned lo = __builtin_amdgcn_readfirstlane(t[2 * i]), hi = __builtin_amdgcn_readfirstlane(t[2 * i + 1]);
            return (const float*)(((unsigned long long)hi << 32) | lo); } } in;
};
template <class T> __device__ __forceinline__ T* wsp(const Frame& F, size_t off) { return (T*)(F.ws + off); }
__device__ __forceinline__ int row_sel(int row) { const int b = row / TB, t = row - b * TB; return t < CT ? 2 : b; }
__device__ __forceinline__ const float* h0_row(const Frame& F, int row) {
    const int b = row / TB, t = row - b * TB;
    return t < CT ? F.in[I_CTX] + ((size_t)b * CT + t) * DM : F.in[I_X] + ((size_t)b * SEQ + (t - CT)) * DM;
}
__device__ __forceinline__ const float* modp(const Frame& F, int layer, int sel, int chunk) { return wsp<const float>(F, WS_MOD) + ((size_t)(layer * 3 + sel) * 6 + chunk) * DM; }
__device__ __forceinline__ int scan_tok(int z, int sg) { return z == 0 ? sg : (sg < CT ? CT - 1 - sg : TB + CT - 1 - sg); }
__device__ __forceinline__ void tr_item(const float* W, int K, int N, bf16* WT, int row_off, LAS float* scr, int kb, int nb, int lane) {
    const int k0 = 64 * kb, n0 = 32 * nb;
    const int n = n0 + (lane & 31);
#pragma unroll 8
    for (int i = 0; i < 32; ++i) { const int kk = 2 * i + (lane >> 5); scr[kk * 33 + (lane & 31)] = (n < N) ? W[(size_t)(k0 + kk) * N + n] : 0.f; }
    LDS_WAIT(); asm volatile("" ::: "memory");
    const int c = lane & 7;
#pragma unroll
    for (int j = 0; j < 4; ++j) { const int nn = (lane >> 3) + 8 * j; const LAS float* s = scr + (8 * c) * 33 + nn;
        v4u o; o.x = pk2(s[0 * 33], s[1 * 33]); o.y = pk2(s[2 * 33], s[3 * 33]); o.z = pk2(s[4 * 33], s[5 * 33]); o.w = pk2(s[6 * 33], s[7 * 33]);
        *(v4u*)(WT + (size_t)(row_off + n0 + nn) * K + k0 + 8 * c) = o; }
    LDS_WAIT(); asm volatile("" ::: "memory");
}
__device__ __forceinline__ void tr_family(const Frame& F, const float* W, size_t src_stride, int nmat, int K, int N, int Npad, bf16* WT, int gw, int NGW) {
    LAS float* scr = (LAS float*)(F.lds + F.wave * 16384);
    const int nkb = K / 64, nnb = Npad / 32, per = nkb * nnb, total = per * nmat;
    for (int it = gw; it < total; it += NGW) { const int m = it / per, r = it - m * per, kb = r / nnb, nb = r - kb * nnb;
        tr_item(W + (size_t)m * src_stride, K, N, WT, m * Npad, scr, kb, nb, F.lane); }
}
__device__ __forceinline__ void moe_weights_convert(const Frame& F, int layer, int gw, int NGW) {
    tr_family(F, F.in[I_W1] + (size_t)layer * NE * 1024 * 2048, (size_t)1024 * 2048, NE, 1024, 2048, 2048, wsp<bf16>(F, WS_W1T), gw, NGW);
    tr_family(F, F.in[I_W2] + (size_t)layer * NE * 1024 * 1024, (size_t)1024 * 1024, NE, 1024, 1024, 1024, wsp<bf16>(F, WS_W2T), gw, NGW);
}
__device__ __forceinline__ void norm_mod_row(const Frame& F, const float* src, const float* nw, const float* shift, const float* scale, bf16* orow) {
    const f32x4* xr = (const f32x4*)src + F.lane;
    f32x4 v[4]; float s = 0.f;
#pragma unroll
    for (int j = 0; j < 4; ++j) { v[j] = xr[64 * j]; s += (v[j].x * v[j].x + v[j].y * v[j].y) + (v[j].z * v[j].z + v[j].w * v[j].w); }
    const float rs = 1.f / sqrtf(wave_sum(s) * (1.f / DM) + NORM_EPS);
    unsigned long long* o8 = (unsigned long long*)orow + F.lane;
#pragma unroll
    for (int j = 0; j < 4; ++j) { const f32x4 w = ((const f32x4*)nw)[F.lane + 64 * j], sh = ((const f32x4*)shift)[F.lane + 64 * j], sc = ((const f32x4*)scale)[F.lane + 64 * j];
        const f32x4 y = v[j] * rs * w * (sc + 1.f) + sh;
        o8[64 * j] = (unsigned long long)pk2(y.x, y.y) | ((unsigned long long)pk2(y.z, y.w) << 32); }
}
__device__ __forceinline__ void p0a(const Frame& F) {
    LAS float* sv = (LAS float*)F.lds; LAS float* red = (LAS float*)(F.lds + 16384);
    for (int i = F.tid; i < 3 * DM; i += 512) { const int s = i / DM, k = i - s * DM; const float cv = (s < 2) ? F.in[I_C][s * DM + k] : F.in[I_CCTX][k]; sv[i] = cv / (1.f + __expf(-cv)); }
    __syncthreads();
    for (int it = F.blk; it < 192; it += F.G) {
        const int l = it / 96, cgp = it - l * 96, kq = F.tid >> 4, cg = F.tid & 15, col = cgp * 64 + cg * 4;
        float acc[3][4];
#pragma unroll
        for (int s = 0; s < 3; ++s)
#pragma unroll
            for (int j = 0; j < 4; ++j) acc[s][j] = 0.f;
        const float* W = F.in[I_ADAW] + (size_t)l * DM * 6144 + col;
        for (int kk = 0; kk < 32; ++kk) { const int k = kq * 32 + kk; const f32x4 w = *(const f32x4*)(W + (size_t)k * 6144);
            const float s0 = sv[k], s1 = sv[DM + k], s2 = sv[2 * DM + k];
#pragma unroll
            for (int j = 0; j < 4; ++j) { acc[0][j] += s0 * w[j]; acc[1][j] += s1 * w[j]; acc[2][j] += s2 * w[j]; } }
#pragma unroll
        for (int s = 0; s < 3; ++s)
#pragma unroll
            for (int j = 0; j < 4; ++j) red[(kq * 16 + cg) * 12 + s * 4 + j] = acc[s][j];
        __syncthreads();
        if (F.tid < 192) { const int s = F.tid / 64, cc = F.tid - s * 64, cg2 = cc >> 2, j = cc & 3; float t = 0.f;
            for (int q = 0; q < 32; ++q) t += red[(q * 16 + cg2) * 12 + s * 4 + j];
            wsp<float>(F, WS_MOD)[(size_t)(l * 3 + s) * 6144 + cgp * 64 + cc] = t + F.in[I_ADAB][l * 6144 + cgp * 64 + cc]; }
        __syncthreads();
    }
    const int gid = F.blk * 512 + F.tid, GT = F.G * 512;
    float* rope = wsp<float>(F, WS_ROPE);
    for (int i = gid; i < 256 * 16 + 64 * 16 + 256 * 8 + 64 * 8; i += GT) {
        int j = i; float pos, inv; size_t off;
        if (j < 256 * 16) { pos = (float)(j / 16); inv = powf(10000.f, -(float)(j % 16) / 16.f); off = ROPE_DR + (size_t)j * 2; }
        else if ((j -= 256 * 16) < 64 * 16) { pos = (float)(j / 16); inv = powf(10000.f, -(float)(j % 16) / 16.f); off = ROPE_DC + (size_t)j * 2; }
        else if ((j -= 64 * 16) < 256 * 8) { pos = (float)(j / 8); inv = powf(10000.f, -(float)(j % 8) / 8.f); off = ROPE_MR + (size_t)j * 2; }
        else { j -= 256 * 8; pos = (float)(j / 8); inv = powf(10000.f, -(float)(j % 8) / 8.f); off = ROPE_MC + (size_t)j * 2; }
        const float ang = pos * inv; rope[off] = cosf(ang); rope[off + 1] = sinf(ang);
    }
    bf16* WL = wsp<bf16>(F, WS_WLORA);
    for (int i = gid; i < 2560 * 384; i += GT) { const int n = i / 384, k = i - n * 384, part = n >> 9, c = n & 511; float v = 0.f;
        if (part < 2) { if ((k >> 6) == part) v = F.in[I_RW2][((size_t)part * 64 + (k & 63)) * 512 + c]; }
        else if (part < 4) { if ((k >> 6) == part) v = F.in[I_A2][((size_t)(part - 2) * 64 + (k & 63)) * 512 + c]; }
        else { if (k >= 256) v = F.in[I_G2][(size_t)(k - 256) * 512 + c]; }
        WL[i] = (bf16)f2bf(v); }
    const int gw = F.blk * 8 + F.wave, NGW = F.G * 8;
    tr_family(F, F.in[I_ATTW], 0, 1, 1024, ATT_IN, ATT_NP, wsp<bf16>(F, WS_WIN0), gw, NGW);
    tr_family(F, F.in[I_WUQ], 0, 1, 384, 768, 768, wsp<bf16>(F, WS_WUQ), gw, NGW);
    tr_family(F, F.in[I_WUKV], 0, 1, 256, 1024, 1024, wsp<bf16>(F, WS_WUKV), gw, NGW);
    tr_family(F, F.in[I_WOUT], (size_t)1024 * 1024, 2, 1024, 1024, 1024, wsp<bf16>(F, WS_WOUT), gw, NGW);
    tr_family(F, F.in[I_RECW], 0, 1, 1024, REC_IN, REC_NP, wsp<bf16>(F, WS_WREC), gw, NGW);
    moe_weights_convert(F, 0, gw, NGW);
}
__device__ __forceinline__ void p0b(const Frame& F) {
    const int gw = F.blk * 8 + F.wave, NGW = F.G * 8;
    for (int row = gw; row < R; row += NGW) { const int sel = row_sel(row);
        norm_mod_row(F, h0_row(F, row), F.in[I_NMIX], modp(F, 0, sel, 0), modp(F, 0, sel, 1), wsp<bf16>(F, WS_A) + (size_t)row * DM); }
}
struct FnStoreBf16 {
    bf16* O; int ldc;
    __device__ __forceinline__ void operator()(int row, int col, f32x4 v0, f32x4 v1) const {
        v4u w; w.x = pg8::cvt_pk_bf16(v0[0], v0[1]); w.y = pg8::cvt_pk_bf16(v0[2], v0[3]); w.z = pg8::cvt_pk_bf16(v1[0], v1[1]); w.w = pg8::cvt_pk_bf16(v1[2], v1[3]);
        *(v4u*)(O + (size_t)row * ldc + col) = w; }
};
struct FnWout {
    const Frame* F; int layer;
    __device__ __forceinline__ void operator()(int row, int col, f32x4 v0, f32x4 v1) const {
        float* hrow = wsp<float>(*F, WS_H) + (size_t)row * DM + col;
        const float* base = (layer == 0) ? h0_row(*F, row) + col : hrow;
        const float* g = modp(*F, layer, row_sel(row), 2) + col;
        const f32x4 b0 = *(const f32x4*)base, b1 = *(const f32x4*)(base + 4), g0 = *(const f32x4*)g, g1 = *(const f32x4*)(g + 4);
        *(f32x4*)hrow = b0 + g0 * v0; *(f32x4*)(hrow + 4) = b1 + g1 * v1; }
};
__device__ __forceinline__ void l0_post_proj(const Frame& F) {
    const int gw = F.blk * 8 + F.wave, NGW = F.G * 8, lane = F.lane;
    const bf16* P = wsp<const bf16>(F, WS_P); const float* rope = wsp<const float>(F, WS_ROPE);
    constexpr float CD = 0.125f * 1.4426950408889634f;
    for (int row = gw; row < R; row += NGW) {
        const int b = row / TB, t = row - b * TB; const bool lat = t >= CT; const int pos = t - CT, prow = lat ? pos >> 6 : 0, pcol = lat ? pos & 63 : 0;
        const bf16* p = P + (size_t)row * ATT_NP;
        bf16* qd = wsp<bf16>(F, WS_QD) + (size_t)row * 512; bf16* kd = wsp<bf16>(F, WS_KD) + (size_t)row * 512;
#pragma unroll
        for (int j = 0; j < 8; ++j) { const int pr = lane + 64 * j, h16 = pr >> 5, i = pr & 31;
            const float x1 = bf2f(p[h16 * 64 + i]), x2 = bf2f(p[h16 * 64 + i + 32]); float c = 1.f, s = 0.f;
            if (lat) { const float* tb = (i < 16) ? rope + ROPE_DR + (size_t)(prow * 16 + i) * 2 : rope + ROPE_DC + (size_t)(pcol * 16 + i - 16) * 2; c = tb[0]; s = tb[1]; }
            float y1 = x1 * c - x2 * s, y2 = x1 * s + x2 * c;
            if (h16 < 8) { qd[h16 * 64 + i] = (bf16)f2bf(y1 * CD); qd[h16 * 64 + i + 32] = (bf16)f2bf(y2 * CD); }
            else { kd[(h16 - 8) * 64 + i] = (bf16)f2bf(y1); kd[(h16 - 8) * 64 + i + 32] = (bf16)f2bf(y2); } }
        { float x[6]; float ss = 0.f;
#pragma unroll
          for (int j = 0; j < 6; ++j) { x[j] = bf2f(p[1536 + lane + 64 * j]); ss += x[j] * x[j]; }
          const float rs = 1.f / sqrtf(wave_sum(ss) * (1.f / 384.f) + NORM_EPS); bf16* o = wsp<bf16>(F, WS_CQN) + (size_t)row * 384;
#pragma unroll
          for (int j = 0; j < 6; ++j) o[lane + 64 * j] = (bf16)f2bf(x[j] * rs * F.in[I_QNW][lane + 64 * j]); }
        { float x[4]; float ss = 0.f;
#pragma unroll
          for (int j = 0; j < 4; ++j) { x[j] = bf2f(p[1920 + lane + 64 * j]); ss += x[j] * x[j]; }
          const float rs = 1.f / sqrtf(wave_sum(ss) * (1.f / 256.f) + NORM_EPS); bf16* o = wsp<bf16>(F, WS_CKVN) + (size_t)row * 256;
#pragma unroll
          for (int j = 0; j < 4; ++j) o[lane + 64 * j] = (bf16)f2bf(x[j] * rs * F.in[I_KVNW][lane + 64 * j]); }
        if (lane < 16) { const int i = lane; const float x1 = bf2f(p[2176 + i]), x2 = bf2f(p[2176 + i + 16]); float c = 1.f, s = 0.f;
            if (lat) { const float* tb = (i < 8) ? rope + ROPE_MR + (size_t)(prow * 8 + i) * 2 : rope + ROPE_MC + (size_t)(pcol * 8 + i - 8) * 2; c = tb[0]; s = tb[1]; }
            bf16* o = wsp<bf16>(F, WS_KRR) + (size_t)row * 32; o[i] = (bf16)f2bf(x1 * c - x2 * s); o[i + 16] = (bf16)f2bf(x1 * s + x2 * c); }
    }
}
__device__ __forceinline__ void l0_mq_rope(const Frame& F) {
    const int gw = F.blk * 8 + F.wave, NGW = F.G * 8, lane = F.lane; const float* rope = wsp<const float>(F, WS_ROPE);
    const float CM = 0.10206207261596575f * 1.4426950408889634f;
    for (int row = gw; row < R; row += NGW) {
        const int b = row / TB, t = row - b * TB; const bool lat = t >= CT; const int pos = t - CT, prow = lat ? pos >> 6 : 0, pcol = lat ? pos & 63 : 0;
        bf16* q = wsp<bf16>(F, WS_MQ) + (size_t)row * 768;
#pragma unroll
        for (int j = 0; j < 8; ++j) { const int idx = lane + 64 * j, h = idx >> 6, d = idx & 63; q[h * 96 + d] = (bf16)f2bf(bf2f(q[h * 96 + d]) * CM); }
#pragma unroll
        for (int j = 0; j < 2; ++j) { const int pr = lane + 64 * j, h = pr >> 4, i = pr & 15; const float x1 = bf2f(q[h * 96 + 64 + i]), x2 = bf2f(q[h * 96 + 80 + i]); float c = 1.f, s = 0.f;
            if (lat) { const float* tb = (i < 8) ? rope + ROPE_MR + (size_t)(prow * 8 + i) * 2 : rope + ROPE_MC + (size_t)(pcol * 8 + i - 8) * 2; c = tb[0]; s = tb[1]; }
            q[h * 96 + 64 + i] = (bf16)f2bf((x1 * c - x2 * s) * CM); q[h * 96 + 80 + i] = (bf16)f2bf((x1 * s + x2 * c) * CM); }
    }
}
__device__ __forceinline__ void l0_attention(const Frame& F) {
    LAS char* lds = (LAS char*)F.lds;
    const bf16* QD = wsp<const bf16>(F, WS_QD); const bf16* KD = wsp<const bf16>(F, WS_KD); const bf16* P = wsp<const bf16>(F, WS_P);
    const bf16* MQ = wsp<const bf16>(F, WS_MQ); const bf16* MKV = wsp<const bf16>(F, WS_MKV); const bf16* KRR = wsp<const bf16>(F, WS_KRR);
    float* OD = wsp<float>(F, WS_ODIFF); float* OM = wsp<float>(F, WS_OMLA);
    for (int kind = 0; kind < 2; ++kind) {
        for (int L = F.blk; L < 1024 + 16; L += F.G) {
            int b, h8, qb, nkeys;
            if (L < 1024) { int pair;
                if (F.G == 256) { const int round = L >> 8, c = L & 255; pair = round * 4 + ((c & 7) >> 1); qb = 1 + (c & 1) * 32 + (c >> 3); }
                else { pair = L >> 6; qb = 1 + (L & 63); }
                b = pair >> 3; h8 = pair & 7; nkeys = TB; }
            else { const int s = L - 1024; b = s >> 3; h8 = s & 7; qb = 0; nkeys = CT; }
            const size_t q0 = (size_t)b * TB + (size_t)qb * 256, k0 = (size_t)b * TB;
            if (kind == 0)
                att::attn_unit<64, 128>(QD + q0 * 512 + h8 * 64, 512, KD + k0 * 512 + h8 * 64, 512, nullptr, 0, P + k0 * ATT_NP + 1024 + (h8 >> 1) * 128, ATT_NP,
                                        OD + q0 * 1024 + h8 * 128, 1024, nkeys, lds);
            else
                att::attn_unit<96, 64>(MQ + q0 * 768 + h8 * 96, 768, MKV + k0 * 1024 + h8 * 128, 1024, KRR + k0 * 32, 32, MKV + k0 * 1024 + h8 * 128 + 64, 1024,
                                       OM + q0 * 512 + h8 * 64, 512, nkeys, lds);
        }
    }
}
__device__ __forceinline__ void l0_combine(const Frame& F) {
    const int gw = F.blk * 8 + F.wave, NGW = F.G * 8, lane = F.lane;
    const float* lv = F.in[I_LAM];
    const float lam = __expf(wave_sum(lv[lane] * lv[64 + lane])) - __expf(wave_sum(lv[128 + lane] * lv[192 + lane])) + 0.2f;
    const float sw0 = F.in[I_SUBLN][2 * lane] * 0.8f, sw1 = F.in[I_SUBLN][2 * lane + 1] * 0.8f;
    for (int row = gw; row < R; row += NGW) {
        const float* od = wsp<const float>(F, WS_ODIFF) + (size_t)row * 1024; const float* om = wsp<const float>(F, WS_OMLA) + (size_t)row * 512;
        bf16* a1 = wsp<bf16>(F, WS_A1) + (size_t)row * DM;
#pragma unroll
        for (int h = 0; h < 4; ++h) {
            const float o1a = od[(2 * h) * 128 + 2 * lane], o1b = od[(2 * h) * 128 + 2 * lane + 1], o2a = od[(2 * h + 1) * 128 + 2 * lane], o2b = od[(2 * h + 1) * 128 + 2 * lane + 1];
            const float da = o1a - lam * o2a, db = o1b - lam * o2b;
            const float rs = 1.f / sqrtf(wave_sum(da * da + db * db) * (1.f / 128.f) + NORM_EPS);
            *(unsigned*)(a1 + h * 128 + 2 * lane) = pk2(da * rs * sw0, db * rs * sw1); }
#pragma unroll
        for (int j = 0; j < 2; ++j) { const f32x4 v = *(const f32x4*)(om + 4 * (lane + 64 * j)); v2u w; w.x = pk2(v.x, v.y); w.y = pk2(v.z, v.w); *(v2u*)(a1 + 512 + 4 * (lane + 64 * j)) = w; }
    }
}
constexpr int RT_MAXROWS = 24;
__device__ __forceinline__ void ph_router(const Frame& F, int layer) {
    LAS float* Wr = (LAS float*)F.lds;
    LAS float* fst = (LAS float*)(F.lds + AUX_OFF) + F.wave * 512;
    LAS int* hist = (LAS int*)(F.lds + MISC_OFF + 256);
    LAS int* recs = hist + 64 + F.wave * (RT_MAXROWS * 4);
    const int lane = F.lane, gw = F.blk * 8 + F.wave, NGW = F.G * 8;
    { const f32x4* src = (const f32x4*)(F.in[I_RW] + (size_t)layer * DM * NE);
      for (int i = F.tid; i < DM * NE / 4; i += 512) ((LAS f32x4*)Wr)[i] = src[i];
      if (F.tid < 64) hist[F.tid] = 0; }
    __syncthreads();
    const float* nw = F.in[I_NFFN] + (size_t)layer * DM; const float rb = F.in[I_RB][layer * NE + (lane & 31)];
    int ri = 0;
    for (int row = gw; row < R; row += NGW, ++ri) {
        const int sel = row_sel(row); const float* sh = modp(F, layer, sel, 3); const float* sc = modp(F, layer, sel, 4);
        const f32x4* xr = (const f32x4*)(wsp<const float>(F, WS_H) + (size_t)row * DM) + lane;
        f32x4 v[4]; float s = 0.f;
#pragma unroll
        for (int j = 0; j < 4; ++j) { v[j] = xr[64 * j]; s += (v[j].x * v[j].x + v[j].y * v[j].y) + (v[j].z * v[j].z + v[j].w * v[j].w); }
        const float rs = 1.f / sqrtf(wave_sum(s) * (1.f / DM) + NORM_EPS);
        unsigned long long* o8 = (unsigned long long*)(wsp<bf16>(F, WS_F) + (size_t)row * DM) + lane;
#pragma unroll
        for (int j = 0; j < 4; ++j) { const f32x4 w = ((const f32x4*)nw)[lane + 64 * j], a = ((const f32x4*)sh)[lane + 64 * j], c = ((const f32x4*)sc)[lane + 64 * j];
            v[j] = v[j] * rs * w * (c + 1.f) + a;
            o8[64 * j] = (unsigned long long)pk2(v[j].x, v[j].y) | ((unsigned long long)pk2(v[j].z, v[j].w) << 32); }
        float acc0 = 0.f, acc1 = 0.f, acc2 = 0.f, acc3 = 0.f; const int e = lane & 31, hf = lane >> 5;
#pragma unroll
        for (int ps = 0; ps < 2; ++ps) {
            ((LAS f32x4*)fst)[lane] = v[2 * ps]; ((LAS f32x4*)fst)[64 + lane] = v[2 * ps + 1];
            LDS_WAIT(); asm volatile("" ::: "memory");
            const LAS float* wp = Wr + (size_t)(512 * ps + 256 * hf) * NE + e; const LAS f32x4* fp = (const LAS f32x4*)(fst + 256 * hf);
#pragma unroll 8
            for (int k4 = 0; k4 < 64; ++k4) { const f32x4 f4 = fp[k4];
                acc0 += f4.x * wp[(4 * k4) * NE]; acc1 += f4.y * wp[(4 * k4 + 1) * NE]; acc2 += f4.z * wp[(4 * k4 + 2) * NE]; acc3 += f4.w * wp[(4 * k4 + 3) * NE]; }
            LDS_WAIT(); asm volatile("" ::: "memory");
        }
        const float acc = (acc0 + acc1) + (acc2 + acc3); float logit = acc + __shfl_xor(acc, 32) + rb;
        float selv[4]; int seli[4]; float val = logit;
#pragma unroll
        for (int r = 0; r < 4; ++r) { float bv = val; int bi = e;
#pragma unroll
            for (int o = 1; o < 32; o <<= 1) { const float ov = __shfl_xor(bv, o); const int oi = __shfl_xor(bi, o); if (ov > bv || (ov == bv && oi < bi)) { bv = ov; bi = oi; } }
            selv[r] = bv; seli[r] = bi; if (e == bi) val = -3.0e38f; }
        float ex[4], es = 0.f;
#pragma unroll
        for (int r = 0; r < 4; ++r) { ex[r] = __expf(selv[r] - selv[0]); es += ex[r]; }
        if (lane < 4) { const int r = lane; const int ee = r == 0 ? seli[0] : r == 1 ? seli[1] : r == 2 ? seli[2] : seli[3]; const float gg = (r == 0 ? ex[0] : r == 1 ? ex[1] : r == 2 ? ex[2] : ex[3]) / es;
            wsp<int>(F, WS_TOPE)[(size_t)row * 4 + r] = ee; wsp<float>(F, WS_GATE)[(size_t)row * 4 + r] = gg;
            const int rk = __hip_atomic_fetch_add(&hist[ee], 1, __ATOMIC_RELAXED, __HIP_MEMORY_SCOPE_WORKGROUP);
            if (ri < RT_MAXROWS) recs[ri * 4 + r] = ee | (rk << 8); }
    }
    __syncthreads();
    if (F.tid < NE) hist[32 + F.tid] = (int)__hip_atomic_fetch_add(F.ctl + CW_CNT + 64 * layer + F.tid, (unsigned)hist[F.tid], RLX_AGENT);
    __syncthreads();
    ri = 0;
    for (int row = gw; row < R; row += NGW, ++ri)
        if (lane < 4 && ri < RT_MAXROWS) { const int rc = recs[ri * 4 + lane]; wsp<int>(F, WS_POS)[(size_t)row * 4 + lane] = hist[32 + (rc & 255)] + (rc >> 8); }
}
__device__ __forceinline__ void moe_tables(const Frame& F, int layer, LAS int* ps, LAS int* tile_e) {
    if (F.tid == 0) { int acc = 0, t = 0;
        for (int e = 0; e < NE; ++e) { const int c = (int)__hip_atomic_load(F.ctl + CW_CNT + 64 * layer + e, RLX_AGENT); ps[e] = acc; const int nt = (c + 255) >> 8;
            for (int i = 0; i < nt && t < MAXT; ++i) tile_e[t++] = e; acc += nt * 256; }
        ps[NE] = acc; ps[NE + 1] = t; }
    __syncthreads();
}
__device__ __forceinline__ void ph_gather(const Frame& F, int layer) {
    LAS int* ps = (LAS int*)(F.lds + MISC_OFF + 256); LAS int* tile_e = ps + 64;
    moe_tables(F, layer, ps, tile_e);
    if (F.blk == 0) { int* tab = wsp<int>(F, WS_TILE); const int nt = ps[NE + 1]; if (F.tid == 0) tab[0] = nt; for (int i = F.tid; i < nt; i += 512) tab[1 + i] = tile_e[i]; }
    const int lane = F.lane, gw = F.blk * 8 + F.wave, NGW = F.G * 8;
    for (int row = gw; row < R; row += NGW) {
        int dest = 0;
        if (lane < 4) { const int e = wsp<const int>(F, WS_TOPE)[(size_t)row * 4 + lane]; dest = ps[e] + wsp<const int>(F, WS_POS)[(size_t)row * 4 + lane]; wsp<int>(F, WS_DEST)[(size_t)row * 4 + lane] = dest; }
        const v4u* src = (const v4u*)(wsp<const bf16>(F, WS_F) + (size_t)row * DM); const v4u a = src[lane], b = src[64 + lane];
#pragma unroll
        for (int r = 0; r < 4; ++r) { const int d = __shfl(dest, r); v4u* dst = (v4u*)(wsp<bf16>(F, WS_XS) + (size_t)d * DM); dst[lane] = a; dst[64 + lane] = b; }
    }
}
struct MoeOrder {
    const int* tile_e; int ntiles, nN, G, c;
    __device__ __forceinline__ bool next(int i, pg8::Unit& u) const {
        const long L = (long)i * G + c; if (L >= (long)ntiles * nN) return false;
        const int rt = (int)(L / nN), pl = (int)(L - (long)rt * nN); const int e = __builtin_amdgcn_readfirstlane(tile_e[rt]);
        u.pm = rt; u.pn = e * nN + pl; return true; }
    __device__ __forceinline__ void a_ready(const pg8::Unit&) const {}
    __device__ __forceinline__ void done(const pg8::Unit&) const {}
};
struct FnSwiglu {
    bf16* HS; const float* b1;
    __device__ __forceinline__ void operator()(int row, int col, f32x4 v0, f32x4 v1) const {
        const float* bp = b1 + col;
        const f32x4 b0 = *(const f32x4*)bp, b1v = *(const f32x4*)(bp + 4); v0 = v0 + b0; v1 = v1 + b1v;
        const float hv[8] = {v0[0], v0[1], v0[2], v0[3], v1[0], v1[1], v1[2], v1[3]}; float o[4];
#pragma unroll
        for (int i = 0; i < 4; ++i) { const float g = hv[2 * i], l = hv[2 * i + 1];
            const float gl = fminf(g, 7.f), li = fminf(fmaxf(l, -7.f), 7.f); o[i] = gl * sigmoidf_(1.702f * gl) * (li + 1.f); }
        const int lc = col & 2047; v2u w; w.x = pk2(o[0], o[1]); w.y = pk2(o[2], o[3]);
        *(v2u*)(HS + (size_t)row * 1024 + (lc >> 1)) = w; }
};
struct FnBiasBf16 {
    bf16* YS; const float* b2;
    __device__ __forceinline__ void operator()(int row, int col, f32x4 v0, f32x4 v1) const {
        const f32x4 b0 = *(const f32x4*)(b2 + col), b1v = *(const f32x4*)(b2 + col + 4); v0 = v0 + b0; v1 = v1 + b1v;
        v4u w; w.x = pk2(v0[0], v0[1]); w.y = pk2(v0[2], v0[3]); w.z = pk2(v1[0], v1[1]); w.w = pk2(v1[2], v1[3]);
        *(v4u*)(YS + (size_t)row * 1024 + (col & 1023)) = w; }
};
__device__ __forceinline__ void ph_combine(const Frame& F, int layer) {
    const int lane = F.lane, gw = F.blk * 8 + F.wave, NGW = F.G * 8;
    for (int row = gw; row < R; row += NGW) {
        const int sel = row_sel(row); const float* gf = modp(F, layer, sel, 5);
        float* hrow = wsp<float>(F, WS_H) + (size_t)row * DM;
        f32x4 y[4];
#pragma unroll
        for (int j = 0; j < 4; ++j) y[j] = (f32x4){0.f, 0.f, 0.f, 0.f};
#pragma unroll
        for (int r = 0; r < 4; ++r) { const int d = wsp<const int>(F, WS_DEST)[(size_t)row * 4 + r]; const float g = wsp<const float>(F, WS_GATE)[(size_t)row * 4 + r];
            const v2u* yp = (const v2u*)(wsp<const bf16>(F, WS_XS) + (size_t)d * DM);
#pragma unroll
            for (int j = 0; j < 4; ++j) { const v2u w = yp[lane + 64 * j]; y[j] += g * (f32x4){bflo(w.x), bfhi(w.x), bflo(w.y), bfhi(w.y)}; } }
        f32x4 h[4]; float s = 0.f;
#pragma unroll
        for (int j = 0; j < 4; ++j) { h[j] = ((const f32x4*)hrow)[lane + 64 * j] + ((const f32x4*)gf)[lane + 64 * j] * y[j]; s += (h[j].x * h[j].x + h[j].y * h[j].y) + (h[j].z * h[j].z + h[j].w * h[j].w); }
        const float rs = 1.f / sqrtf(wave_sum(s) * (1.f / DM) + NORM_EPS);
        if (layer == 0) {
#pragma unroll
            for (int j = 0; j < 4; ++j) ((f32x4*)hrow)[lane + 64 * j] = h[j];
            const float* nw = F.in[I_NMIX] + DM; const float* sh = modp(F, 1, sel, 0); const float* sc = modp(F, 1, sel, 1);
            unsigned long long* o8 = (unsigned long long*)(wsp<bf16>(F, WS_A) + (size_t)row * DM) + lane;
#pragma unroll
            for (int j = 0; j < 4; ++j) { const f32x4 w = ((const f32x4*)nw)[lane + 64 * j], a = ((const f32x4*)sh)[lane + 64 * j], c = ((const f32x4*)sc)[lane + 64 * j];
                const f32x4 o = h[j] * rs * w * (c + 1.f) + a; o8[64 * j] = (unsigned long long)pk2(o.x, o.y) | ((unsigned long long)pk2(o.z, o.w) << 32); }
        } else {
            const int b = row / TB, t = row - b * TB;
            if (t >= CT) { float* orow = F.out + ((size_t)b * SEQ + (t - CT)) * DM; const float* nw = F.in[I_FNW];
#pragma unroll
                for (int j = 0; j < 4; ++j) ((f32x4*)orow)[lane + 64 * j] = h[j] * rs * ((const f32x4*)nw)[lane + 64 * j]; }
        }
    }
}
constexpr int PC_Q = 1920, PC_K = 2176, PC_V = 2432, PC_O = 2944, PC_G = 3456;
__device__ __forceinline__ float softplusf_(float y) { return fmaxf(y, 0.f) + __logf(1.f + __expf(-fabsf(y))); }
__device__ __forceinline__ float tanhf_(float x) { return 1.f - 2.f / (1.f + __expf(2.f * x)); }
__device__ __forceinline__ void unpack8(v4u w, float (&x)[8]) { x[0] = bflo(w.x); x[1] = bfhi(w.x); x[2] = bflo(w.y); x[3] = bfhi(w.y); x[4] = bflo(w.z); x[5] = bfhi(w.z); x[6] = bflo(w.w); x[7] = bfhi(w.w); }
__device__ __forceinline__ void lerp8(const bf16* p, bool hp, bool hn, int c0, const float* mu, float (&u)[8]) {
    const v4u z4 = {0u, 0u, 0u, 0u};
    const v4u wx = *(const v4u*)(p + c0), wp = hp ? *(const v4u*)(p - REC_NP + c0) : z4, wn = hn ? *(const v4u*)(p + REC_NP + c0) : z4;
    float x[8], xp[8], xn[8]; unpack8(wx, x); unpack8(wp, xp); unpack8(wn, xn);
    const f32x4 m0 = *(const f32x4*)(mu + c0), m1 = *(const f32x4*)(mu + c0 + 4);
#pragma unroll
    for (int e = 0; e < 8; ++e) { const float m = e < 4 ? m0[e & 3] : m1[e & 3]; u[e] = x[e] + m * (0.5f * (xp[e] + xn[e]) - x[e]); }
}
__device__ __forceinline__ void st8f(float* o, const float (&u)[8]) { *(f32x4*)o = (f32x4){u[0], u[1], u[2], u[3]}; *(f32x4*)(o + 4) = (f32x4){u[4], u[5], u[6], u[7]}; }
__device__ __forceinline__ void l1_rwkv_prep(const Frame& F) {
    const int gw = F.blk * 8 + F.wave, NGW = F.G * 8, lane = F.lane; const float* mu = F.in[I_MU];
    for (int row = gw; row < R; row += NGW) {
        const int b = row / TB, t = row - b * TB; const bool hp = (t != 0 && t != CT), hn = (t != CT - 1 && t != TB - 1);
        const bf16* p = wsp<const bf16>(F, WS_P) + (size_t)row * REC_NP; const size_t ro = (size_t)row * 512 + 8 * lane;
        float u[8];
        lerp8(p, hp, hn, 8 * lane, mu, u); st8f(wsp<float>(F, WS_RR) + ro, u);
        lerp8(p, hp, hn, 1024 + 8 * lane, mu, u); st8f(wsp<float>(F, WS_VV) + ro, u);
        lerp8(p, hp, hn, 512 + 8 * lane, mu, u); st8f(wsp<float>(F, WS_KL) + ro, u);
        { const f32x4 k0 = *(const f32x4*)(F.in[I_KK] + 8 * lane), k1 = *(const f32x4*)(F.in[I_KK] + 8 * lane + 4); float ss = 0.f;
#pragma unroll
          for (int e = 0; e < 8; ++e) { u[e] *= (e < 4 ? k0[e & 3] : k1[e & 3]); ss += u[e] * u[e]; }
          ss += __shfl_xor(ss, 1); ss += __shfl_xor(ss, 2); ss += __shfl_xor(ss, 4);
          const float inv = -1.f / sqrtf(fmaxf(ss, 1e-24f));
#pragma unroll
          for (int e = 0; e < 8; ++e) u[e] *= inv;
          st8f(wsp<float>(F, WS_AKK) + ro, u); }
        if (lane < 48) { lerp8(p, hp, hn, 1536 + 8 * lane, mu, u);
#pragma unroll
            for (int e = 0; e < 8; ++e) u[e] = lane < 16 ? tanhf_(u[e]) : (lane < 32 ? u[e] : sigmoidf_(u[e]));
            v4u w; w.x = pk2(u[0], u[1]); w.y = pk2(u[2], u[3]); w.z = pk2(u[4], u[5]); w.w = pk2(u[6], u[7]);
            *(v4u*)(wsp<bf16>(F, WS_ALORA) + (size_t)row * 384 + 8 * lane) = w; }
    }
}
struct EpiLora {
    static constexpr bool PERM = true, AFTER_DRAIN = false;
    const Frame* F;
    template <int KIND> __device__ __forceinline__ void run(const pg8::f32x4 (&acc)[2][2][4][2], const pg8::Unit& u, int wr, int wc, int fr, int fq, int z) const {
#pragma unroll
        for (int ai = 0; ai < 2; ++ai)
#pragma unroll
            for (int m = 0; m < 4; ++m) { const int row = u.pm * 256 + ai * 128 + wr * 64 + m * 16 + fr;
#pragma unroll
                for (int bj = 0; bj < 2; ++bj) { const int c = ((u.pn & 1) * 256) + bj * 128 + wc * 32 + 8 * fq; const size_t ro = (size_t)row * 512 + c;
                    const pg8::f32x4 v0 = acc[ai][bj][m][0], v1 = acc[ai][bj][m][1]; const float x[8] = {v0[0], v0[1], v0[2], v0[3], v1[0], v1[1], v1[2], v1[3]}; float o[8];
                    if constexpr (KIND == 0) { const float* w0 = F->in[I_W0] + z * 512 + c;
#pragma unroll
                        for (int e = 0; e < 8; ++e) { const float wl = -softplusf_(-(w0[e] + x[e])) - 0.5f; o[e] = __expf(-__expf(wl)); }
                        st8f(wsp<float>(*F, WS_WDEC) + (size_t)z * R * 512 + ro, o); }
                    else if constexpr (KIND == 1) { const float* a0 = F->in[I_A0] + z * 512 + c; const float* ka = F->in[I_KA] + c;
                        const float* kl = wsp<const float>(*F, WS_KL) + ro; const float* ak = wsp<const float>(*F, WS_AKK) + ro; float o2[8];
#pragma unroll
                        for (int e = 0; e < 8; ++e) { const float a = sigmoidf_(a0[e] + x[e]); o[e] = kl[e] * (1.f + (a - 1.f) * ka[e]); o2[e] = -ak[e] * a; }
                        st8f(wsp<float>(*F, WS_KDIR) + (size_t)z * R * 512 + ro, o); st8f(wsp<float>(*F, WS_BB) + (size_t)z * R * 512 + ro, o2); }
                    else st8f(wsp<float>(*F, WS_GG) + ro, x); } }
    }
    __device__ __forceinline__ void operator()(const pg8::f32x4 (&acc)[2][2][4][2], const pg8::Unit& u, int wr, int wc, int fr, int fq) const {
        const int part = u.pn >> 1;
        if (part < 2) run<0>(acc, u, wr, wc, fr, fq, part); else if (part < 4) run<1>(acc, u, wr, wc, fr, fq, part - 2); else run<2>(acc, u, wr, wc, fr, fq, 0);
    }
};
__device__ __forceinline__ void mlstm_gates(const Frame& F, int row, int z, int h, float& ig, float& lf) {
    const bf16* g = wsp<const bf16>(F, WS_P) + (size_t)row * REC_NP + PC_G + z * 8 + h; const float* gb = F.in[I_GATEB] + z * 8 + h;
    const float gi = bf2f(g[0]) + gb[0], gf = bf2f(g[4]) + gb[4];
    ig = 15.f * tanhf_(gi * (1.f / 15.f)); const float cf = 15.f * tanhf_(gf * (1.f / 15.f)); lf = fminf(cf, 0.f) - __logf(1.f + __expf(-fabsf(cf)));
}
__device__ __forceinline__ void mlstm_chunk_head(const Frame& F, int z, int b, int h, int c, LAS float* vec) {
    LAS int* rows = (LAS int*)vec;
    if (F.tid < 64) { const int s = F.tid, row = b * TB + scan_tok(z, 64 * c + s); float ig, lf; mlstm_gates(F, row, z, h, ig, lf); rows[s] = row; vec[64 + s] = ig; vec[192 + s] = lf; }
    __syncthreads();
    if (F.tid < 64) { float a = 0.f; for (int s = 0; s <= F.tid; ++s) a += vec[192 + s]; vec[128 + F.tid] = a; }
    __syncthreads();
}
__device__ __forceinline__ void l1_mlstm_a(const Frame& F) {
    LAS float* Ks = (LAS float*)F.lds; LAS float* Vs = Ks + 64 * 64; LAS float* vec = (LAS float*)(F.lds + AUX_OFF); LAS int* rows = (LAS int*)vec;
    const bf16* P = wsp<const bf16>(F, WS_P);
    for (int u = F.blk; u < NUNIT_M; u += F.G) {
        const int cidx = u / 260, c = u - cidx * 260, z = cidx >> 3, b = (cidx >> 2) & 1, h = cidx & 3;
        mlstm_chunk_head(F, z, b, h, c, vec);
        if (F.tid < 64) { const float bl = vec[128 + 63]; const float uu = bl - vec[128 + F.tid] + vec[64 + F.tid]; float m = uu;
#pragma unroll
            for (int o = 1; o < 64; o <<= 1) m = fmaxf(m, __shfl_xor(m, o));
            vec[256 + F.tid] = __expf(uu - m);
            if (F.tid == 0) { wsp<float>(F, WS_SC)[2 * u] = bl; wsp<float>(F, WS_SC)[2 * u + 1] = m; } }
        __syncthreads();
        { const int s = F.tid >> 3, c8 = F.tid & 7; float x[8]; unpack8(*(const v4u*)(P + (size_t)rows[s] * REC_NP + PC_K + h * 64 + 8 * c8), x);
#pragma unroll
          for (int e = 0; e < 8; ++e) Ks[s * 64 + 8 * c8 + e] = x[e] * 0.125f; }
#pragma unroll
        for (int i = 0; i < 2; ++i) { const int s = (F.tid >> 4) + 32 * i, c8 = F.tid & 15; float x[8]; unpack8(*(const v4u*)(P + (size_t)rows[s] * REC_NP + PC_V + h * 128 + 8 * c8), x); const float w = vec[256 + s];
#pragma unroll
            for (int e = 0; e < 8; ++e) Vs[s * 128 + 8 * c8 + e] = x[e] * w; }
        __syncthreads();
        { const int dg = F.tid >> 5, vg = F.tid & 31; f32x4 acc[4];
#pragma unroll
          for (int i = 0; i < 4; ++i) acc[i] = (f32x4){0.f, 0.f, 0.f, 0.f};
#pragma unroll 4
          for (int s = 0; s < 64; ++s) { const f32x4 kd = *(const LAS f32x4*)(Ks + s * 64 + 4 * dg), vv = *(const LAS f32x4*)(Vs + s * 128 + 4 * vg);
              acc[0] += kd.x * vv; acc[1] += kd.y * vv; acc[2] += kd.z * vv; acc[3] += kd.w * vv; }
          float* dc = wsp<float>(F, WS_DC) + (size_t)u * 8192 + (size_t)(4 * dg) * 128 + 4 * vg;
#pragma unroll
          for (int i = 0; i < 4; ++i) *(f32x4*)(dc + i * 128) = acc[i];
          if (F.tid < 64) { float a = 0.f; for (int s = 0; s < 64; ++s) a += vec[256 + s] * Ks[s * 64 + F.tid]; wsp<float>(F, WS_DN)[(size_t)u * 64 + F.tid] = a; } }
        __syncthreads();
    }
}
__device__ __forceinline__ void l1_mlstm_b(const Frame& F) {
    const float* SC = wsp<const float>(F, WS_SC); const float* DC = wsp<const float>(F, WS_DC); float* CST = wsp<float>(F, WS_CST);
    for (int g = F.blk * 512 + F.tid; g < 16 * 8192; g += F.G * 512) {
        const int chain = g >> 13, el = g & 8191; float m = 0.f, C = 0.f, N = 0.f; const bool don = el < 64;
        for (int c = 0; c < 260; ++c) { const size_t u = (size_t)chain * 260 + c;
            CST[u * 8192 + el] = C; if (don) wsp<float>(F, WS_NST)[u * 64 + el] = N; if (el == 0) wsp<float>(F, WS_MST)[u] = m;
            const float bl = SC[2 * u], ml = SC[2 * u + 1], mn = fmaxf(bl + m, ml), cd = __expf(bl + m - mn), inj = __expf(ml - mn);
            C = cd * C + inj * DC[u * 8192 + el]; if (don) N = cd * N + inj * wsp<const float>(F, WS_DN)[u * 64 + el]; m = mn; }
    }
}
__device__ __forceinline__ void l1_mlstm_c(const Frame& F, int first_blk, int nblk) {
    LAS float* qT = (LAS float*)F.lds; LAS float* kT = qT + 4096; LAS float* Vs = kT + 4096; LAS float* Cs = Vs + 8192; LAS float* PT = Cs + 8192;
    LAS float* vec = (LAS float*)(F.lds + AUX_OFF); LAS int* rows = (LAS int*)vec;
    const bf16* P = wsp<const bf16>(F, WS_P);
    for (int u = F.blk - first_blk; u < NUNIT_M; u += nblk) {
        const int cidx = u / 260, c = u - cidx * 260, z = cidx >> 3, b = (cidx >> 2) & 1, h = cidx & 3;
        mlstm_chunk_head(F, z, b, h, c, vec);
        const float mst = wsp<const float>(F, WS_MST)[u];
        if (F.tid < 64) { const int t = F.tid; float pm = -3.0e38f; for (int s = 0; s <= t; ++s) pm = fmaxf(pm, vec[64 + s] - vec[128 + s]);
            const float gi = vec[128 + t] + mst, mo = fmaxf(gi, vec[128 + t] + pm); vec[320 + t] = __expf(gi - mo); vec[384 + t] = mo;
            vec[256 + t] = wsp<const float>(F, WS_NST)[(size_t)u * 64 + t]; }
        { const int c8 = F.tid >> 6, t = F.tid & 63; float x[8]; unpack8(*(const v4u*)(P + (size_t)rows[t] * REC_NP + PC_Q + h * 64 + 8 * c8), x);
#pragma unroll
          for (int e = 0; e < 8; ++e) qT[(8 * c8 + e) * 64 + t] = x[e];
          unpack8(*(const v4u*)(P + (size_t)rows[t] * REC_NP + PC_K + h * 64 + 8 * c8), x);
#pragma unroll
          for (int e = 0; e < 8; ++e) kT[(8 * c8 + e) * 64 + t] = x[e] * 0.125f; }
#pragma unroll
        for (int i = 0; i < 2; ++i) { const int s = (F.tid >> 4) + 32 * i, c8 = F.tid & 15; float x[8]; unpack8(*(const v4u*)(P + (size_t)rows[s] * REC_NP + PC_V + h * 128 + 8 * c8), x);
            *(LAS f32x4*)(Vs + s * 128 + 8 * c8) = (f32x4){x[0], x[1], x[2], x[3]}; *(LAS f32x4*)(Vs + s * 128 + 8 * c8 + 4) = (f32x4){x[4], x[5], x[6], x[7]}; }
        { const f32x4* src = (const f32x4*)(wsp<const float>(F, WS_CST) + (size_t)u * 8192);
#pragma unroll
          for (int i = 0; i < 4; ++i) ((LAS f32x4*)Cs)[F.tid + 512 * i] = src[F.tid + 512 * i]; }
        __syncthreads();
        { const int tg = F.tid & 15, sg = F.tid >> 4; f32x4 a0 = {0.f, 0.f, 0.f, 0.f}, a1 = a0;
#pragma unroll 4
          for (int d = 0; d < 64; ++d) { const f32x4 q4 = *(const LAS f32x4*)(qT + d * 64 + 4 * tg); const float k0 = kT[d * 64 + 2 * sg], k1 = kT[d * 64 + 2 * sg + 1]; a0 += q4 * k0; a1 += q4 * k1; }
#pragma unroll
          for (int j = 0; j < 2; ++j) { const int s = 2 * sg + j; const float cs = vec[64 + s] - vec[128 + s]; f32x4 pv;
#pragma unroll
              for (int i = 0; i < 4; ++i) { const int t = 4 * tg + i; const float qk = j == 0 ? a0[i] : a1[i]; pv[i] = (s <= t) ? qk * __expf(vec[128 + t] + cs - vec[384 + t]) : 0.f; }
              *(LAS f32x4*)(PT + s * 64 + 4 * tg) = pv; } }
        __syncthreads();
        { const int tg = F.tid >> 5, vg = F.tid & 31; f32x4 ac[4], ap[4]; f32x4 nq = {0.f, 0.f, 0.f, 0.f}, rs = nq;
#pragma unroll
          for (int i = 0; i < 4; ++i) { ac[i] = (f32x4){0.f, 0.f, 0.f, 0.f}; ap[i] = ac[i]; }
#pragma unroll 4
          for (int d = 0; d < 64; ++d) { const f32x4 q4 = *(const LAS f32x4*)(qT + d * 64 + 4 * tg), c4 = *(const LAS f32x4*)(Cs + d * 128 + 4 * vg);
              ac[0] += q4.x * c4; ac[1] += q4.y * c4; ac[2] += q4.z * c4; ac[3] += q4.w * c4; nq += q4 * vec[256 + d]; }
#pragma unroll 4
          for (int s = 0; s < 64; ++s) { const f32x4 p4 = *(const LAS f32x4*)(PT + s * 64 + 4 * tg), v4 = *(const LAS f32x4*)(Vs + s * 128 + 4 * vg);
              ap[0] += p4.x * v4; ap[1] += p4.y * v4; ap[2] += p4.z * v4; ap[3] += p4.w * v4; rs += p4; }
#pragma unroll
          for (int i = 0; i < 4; ++i) { const int t = 4 * tg + i; const float g = vec[320 + t], den = g * nq[i] + rs[i], dn = fmaxf(fabsf(den), __expf(-vec[384 + t]));
              const f32x4 hv = (g * ac[i] + ap[i]) * (1.f / dn);
              *(f32x4*)(wsp<float>(F, WS_HM) + ((size_t)z * R + rows[t]) * 512 + h * 128 + 4 * vg) = hv; } }
        __syncthreads();
    }
}
template <int CTRL> __device__ __forceinline__ float dpp_add(float v) { return v + __builtin_bit_cast(float, __builtin_amdgcn_update_dpp(0, __builtin_bit_cast(int, v), CTRL, 0xF, 0xF, true)); }
__device__ __forceinline__ float reduce16(float v) { v = dpp_add<0xB1>(v); v = dpp_add<0x4E>(v); v = dpp_add<0x141>(v); v = dpp_add<0x140>(v); return v; }
struct ScanIn { f32x4 a, b, w, k, r; float v; };
__device__ __forceinline__ void l1_rwkv_scan(const Frame& F) {
    const int chain = F.blk >> 1, z = chain >> 4, b = (chain >> 3) & 1, h = chain & 7;
    const int g = F.lane >> 4, p = F.lane & 15, i = (F.blk & 1) * 32 + F.wave * 4 + g;
    const float* AK = wsp<const float>(F, WS_AKK); const float* BBz = wsp<const float>(F, WS_BB) + (size_t)z * R * 512; const float* WD = wsp<const float>(F, WS_WDEC) + (size_t)z * R * 512;
    const float* KDz = wsp<const float>(F, WS_KDIR) + (size_t)z * R * 512; const float* RRp = wsp<const float>(F, WS_RR); const float* VVp = wsp<const float>(F, WS_VV);
    float* Y = wsp<float>(F, WS_YR) + (size_t)z * R * 512;
    const int co = h * 64 + 4 * p, cv = h * 64 + i;
    float s0 = 0.f, s1 = 0.f, s2 = 0.f, s3 = 0.f;
#define SC_LOAD(S, sg) do { const size_t ro_ = ((size_t)b * TB + scan_tok(z, (sg))) * 512; S.a = *(const f32x4*)(AK + ro_ + co); S.b = *(const f32x4*)(BBz + ro_ + co); \
    S.w = *(const f32x4*)(WD + ro_ + co); S.k = *(const f32x4*)(KDz + ro_ + co); S.r = *(const f32x4*)(RRp + ro_ + co); S.v = VVp[ro_ + cv]; } while (0)
#define SC_STEP(S, sg) do { float pa = (s0 * S.a.x + s1 * S.a.y) + (s2 * S.a.z + s3 * S.a.w); pa = reduce16(pa); \
    s0 = s0 * S.w.x + (pa * S.b.x + S.v * S.k.x); s1 = s1 * S.w.y + (pa * S.b.y + S.v * S.k.y); s2 = s2 * S.w.z + (pa * S.b.z + S.v * S.k.z); s3 = s3 * S.w.w + (pa * S.b.w + S.v * S.k.w); \
    float py = (s0 * S.r.x + s1 * S.r.y) + (s2 * S.r.z + s3 * S.r.w); py = reduce16(py); \
    if (p == 0) Y[((size_t)b * TB + scan_tok(z, (sg))) * 512 + cv] = py; } while (0)
    ScanIn A0, A1, A2, A3, B0, B1, B2, B3;
    SC_LOAD(A0, 0); SC_LOAD(A1, 1); SC_LOAD(A2, 2); SC_LOAD(A3, 3);
    for (int sg = 0; sg < TB; sg += 8) {
        SC_LOAD(B0, sg + 4); SC_LOAD(B1, sg + 5); SC_LOAD(B2, sg + 6); SC_LOAD(B3, sg + 7);
        SC_STEP(A0, sg); SC_STEP(A1, sg + 1); SC_STEP(A2, sg + 2); SC_STEP(A3, sg + 3);
        if (sg + 8 < TB) { SC_LOAD(A0, sg + 8); SC_LOAD(A1, sg + 9); SC_LOAD(A2, sg + 10); SC_LOAD(A3, sg + 11); }
        SC_STEP(B0, sg + 4); SC_STEP(B1, sg + 5); SC_STEP(B2, sg + 6); SC_STEP(B3, sg + 7);
    }
#undef SC_LOAD
#undef SC_STEP
}
__device__ __forceinline__ void l1_rec_out(const Frame& F) {
    const int gw = F.blk * 8 + F.wave, NGW = F.G * 8, lane = F.lane, c0 = 8 * lane;
    for (int row = gw; row < R; row += NGW) {
        const size_t ro = (size_t)row * 512 + c0; bf16* a1 = wsp<bf16>(F, WS_A1) + (size_t)row * DM;
        { const float* y0 = wsp<const float>(F, WS_YR) + ro; const float* y1 = y0 + (size_t)R * 512; float y[8]; float s = 0.f;
#pragma unroll
          for (int e = 0; e < 8; ++e) { y[e] = y0[e] + y1[e]; s += y[e]; }
          s += __shfl_xor(s, 1); s += __shfl_xor(s, 2); s += __shfl_xor(s, 4); const float mean = s * (1.f / 64.f); float q = 0.f;
#pragma unroll
          for (int e = 0; e < 8; ++e) { y[e] -= mean; q += y[e] * y[e]; }
          q += __shfl_xor(q, 1); q += __shfl_xor(q, 2); q += __shfl_xor(q, 4); const float rstd = 1.f / sqrtf(q * (1.f / 64.f) + 64e-5f);
          const float* rr = wsp<const float>(F, WS_RR) + ro; const float* k0 = wsp<const float>(F, WS_KDIR) + ro; const float* k1 = k0 + (size_t)R * 512; const float* rk = F.in[I_RK] + c0; float bs = 0.f;
#pragma unroll
          for (int e = 0; e < 8; ++e) bs += rr[e] * (k0[e] + k1[e]) * rk[e];
          bs += __shfl_xor(bs, 1); bs += __shfl_xor(bs, 2); bs += __shfl_xor(bs, 4);
          const float* vv = wsp<const float>(F, WS_VV) + ro; const float* gg = wsp<const float>(F, WS_GG) + ro; const float* lw = F.in[I_LNW] + c0; const float* lb = F.in[I_LNB] + c0; float o[8];
#pragma unroll
          for (int e = 0; e < 8; ++e) o[e] = (y[e] * rstd * lw[e] + lb[e] + bs * vv[e]) * gg[e];
          v4u w; w.x = pk2(o[0], o[1]); w.y = pk2(o[2], o[3]); w.z = pk2(o[4], o[5]); w.w = pk2(o[6], o[7]); *(v4u*)(a1 + c0) = w; }
        { const float* h0 = wsp<const float>(F, WS_HM) + ro; const float* h1 = h0 + (size_t)R * 512; float x[8]; float q = 0.f;
#pragma unroll
          for (int e = 0; e < 8; ++e) { x[e] = h0[e] + h1[e]; q += x[e] * x[e]; }
          q += __shfl_xor(q, 1); q += __shfl_xor(q, 2); q += __shfl_xor(q, 4); q += __shfl_xor(q, 8); const float rs = 1.f / sqrtf(q * (1.f / 128.f) + NORM_EPS);
          float og[8]; unpack8(*(const v4u*)(wsp<const bf16>(F, WS_P) + (size_t)row * REC_NP + PC_O + c0), og); const float* nw = F.in[I_MNW] + c0; float o[8];
#pragma unroll
          for (int e = 0; e < 8; ++e) o[e] = x[e] * rs * nw[e] * sigmoidf_(og[e]);
          v4u w; w.x = pk2(o[0], o[1]); w.y = pk2(o[2], o[3]); w.z = pk2(o[4], o[5]); w.w = pk2(o[6], o[7]); *(v4u*)(a1 + 512 + c0) = w; }
    }
}
#ifndef MK_PER_PHASE
#define MK_PER_PHASE 0
#endif
constexpr int NPHASE = 26;
struct Args { const float* in[N_IN]; float* out; unsigned char* ws; int ph_lo, ph_hi, li, pad; };
#define GEMM_CALL(FnT, SchedT, g, S, fn) do { pg8::EpiGen<FnT> E_{fn}; { int k_ = g.K; asm volatile("" : "+s"(k_)); g.K = k_; } pg8::gemm_phase<pg8::EpiGen<FnT>, SchedT, true, true>((PG8_LAS unsigned char*)F.lds, g, S, E_); } while (0)
#ifndef SITE_MASK
#define SITE_MASK 0xFFFFFFFFull
#endif
#define SITE(s) (((SITE_MASK) >> (s)) & 1ull)
#define IN(k) (lo <= (k) && (k) < hi)
#define SEAM(k) do { if (IN(k) && IN((k) + 1)) xcd_barrier(bar); } while (0)
template <int LAYER> __device__ __forceinline__ void layer_phases(const Frame& F, const XcdBarrier& bar, const int lo, const int hi) {
    constexpr int layer = LAYER; constexpr int pb = 2 + 12 * LAYER;
        if (SITE(2) && IN(pb + 0)) {
            const int N = layer == 0 ? ATT_NP : REC_NP;
            pg8::Gemm g{wsp<const bf16>(F, WS_A), layer == 0 ? wsp<const bf16>(F, WS_WIN0) : wsp<const bf16>(F, WS_WREC), R, N, 1024};
            pg8::StaticOrder S; S.init(R, N, F.G, F.blk);
            GEMM_CALL(FnStoreBf16, pg8::StaticOrder, g, S, (FnStoreBf16{wsp<bf16>(F, WS_P), N}));
            SEAM(pb + 0);
        }
        if constexpr (LAYER == 0) {
            if (SITE(3) && IN(pb + 1)) { l0_post_proj(F); SEAM(pb + 1); }
            if (SITE(4) && IN(pb + 2)) {
                pg8::Gemm g{wsp<const bf16>(F, WS_CQN), wsp<const bf16>(F, WS_WUQ), R, 768, 384}; pg8::StaticOrder S; S.init(R, 768, F.G, F.blk);
                GEMM_CALL(FnStoreBf16, pg8::StaticOrder, g, S, (FnStoreBf16{wsp<bf16>(F, WS_MQ), 768}));
                SEAM(pb + 2);
            }
            if (SITE(5) && IN(pb + 3)) {
                pg8::Gemm g{wsp<const bf16>(F, WS_CKVN), wsp<const bf16>(F, WS_WUKV), R, 1024, 256}; pg8::StaticOrder S; S.init(R, 1024, F.G, F.blk);
                GEMM_CALL(FnStoreBf16, pg8::StaticOrder, g, S, (FnStoreBf16{wsp<bf16>(F, WS_MKV), 1024}));
                l0_mq_rope(F);
                SEAM(pb + 3);
            }
            if (SITE(6) && IN(pb + 4)) { l0_attention(F); SEAM(pb + 4); }
            if (SITE(7) && IN(pb + 5)) { l0_combine(F); SEAM(pb + 5); }
        } else {
            if (SITE(8) && IN(pb + 1)) { l1_rwkv_prep(F); l1_mlstm_a(F); SEAM(pb + 1); }
            if (SITE(9) && IN(pb + 2)) {
                pg8::Gemm g{wsp<const bf16>(F, WS_ALORA), wsp<const bf16>(F, WS_WLORA), R, 2560, 384}; pg8::StaticOrder S; S.init(R, 2560, F.G, F.blk);
                { int k_ = g.K; asm volatile("" : "+s"(k_)); g.K = k_; EpiLora E_{&F}; pg8::gemm_phase<EpiLora, pg8::StaticOrder, true, true>((PG8_LAS unsigned char*)F.lds, g, S, E_); }
                l1_mlstm_b(F);
                SEAM(pb + 2);
            }
            if (IN(pb + 3)) { SEAM(pb + 3); }
            if (SITE(10) && IN(pb + 4)) {
                if (F.G >= 128) { if (F.blk < 64) l1_rwkv_scan(F); else { l1_mlstm_c(F, 64, F.G - 64); moe_weights_convert(F, 1, (F.blk - 64) * 8 + F.wave, (F.G - 64) * 8); } }
                SEAM(pb + 4);
            }
            if (SITE(11) && IN(pb + 5)) { l1_rec_out(F); SEAM(pb + 5); }
        }
        if (SITE(12) && IN(pb + 6)) {
            pg8::Gemm g{wsp<const bf16>(F, WS_A1), wsp<const bf16>(F, WS_WOUT) + (size_t)layer * 1024 * 1024, R, 1024, 1024}; pg8::StaticOrder S; S.init(R, 1024, F.G, F.blk);
            GEMM_CALL(FnWout, pg8::StaticOrder, g, S, (FnWout{&F, layer}));
            SEAM(pb + 6);
        }
        if (SITE(13) && IN(pb + 7)) { ph_router(F, layer); SEAM(pb + 7); }
        if (SITE(14) && IN(pb + 8)) { ph_gather(F, layer); SEAM(pb + 8); }
        if (SITE(15) && IN(pb + 9)) {
            const int* tab = wsp<const int>(F, WS_TILE);
            pg8::Gemm g{wsp<const bf16>(F, WS_XS), wsp<const bf16>(F, WS_W1T), MAXROWS, NE * 2048, 1024}; MoeOrder S{tab + 1, __builtin_amdgcn_readfirstlane(tab[0]), 8, F.G, F.blk};
            GEMM_CALL(FnSwiglu, MoeOrder, g, S, (FnSwiglu{wsp<bf16>(F, WS_HS), F.in[I_B1] + (size_t)layer * NE * 2048}));
            SEAM(pb + 9);
        }
        if (SITE(16) && IN(pb + 10)) {
            const int* tab = wsp<const int>(F, WS_TILE);
            pg8::Gemm g{wsp<const bf16>(F, WS_HS), wsp<const bf16>(F, WS_W2T), MAXROWS, NE * 1024, 1024}; MoeOrder S{tab + 1, __builtin_amdgcn_readfirstlane(tab[0]), 4, F.G, F.blk};
            GEMM_CALL(FnBiasBf16, MoeOrder, g, S, (FnBiasBf16{wsp<bf16>(F, WS_XS), F.in[I_B2] + (size_t)layer * NE * 1024}));
            SEAM(pb + 10);
        }
        if (SITE(17) && IN(pb + 11)) { ph_combine(F, layer); SEAM(pb + 11); }
}
__global__ void __launch_bounds__(512, 2) fwd(Args args) {
    extern __shared__ __attribute__((aligned(16))) unsigned char lds_[];
    Frame F;
    F.lds = (LAS unsigned char*)lds_; F.tid = threadIdx.x; F.lane = F.tid & 63; F.wave = __builtin_amdgcn_readfirstlane(F.tid >> 6); F.blk = blockIdx.x; F.G = gridDim.x;
    F.ws = args.ws; F.out = args.out; F.ctl = (gu32*)(args.ws + WS_CTL);
    F.in.t = (LAS const unsigned*)(F.lds + MISC_OFF + 8192);
    if (F.tid < 64) ((LAS unsigned*)(F.lds + MISC_OFF))[F.tid] = 0u;
    if (F.tid < N_IN) { const unsigned long long pv = (unsigned long long)args.in[F.tid]; ((LAS unsigned*)(F.lds + MISC_OFF + 8192))[2 * F.tid] = (unsigned)pv; ((LAS unsigned*)(F.lds + MISC_OFF + 8192))[2 * F.tid + 1] = (unsigned)(pv >> 32); }
    __syncthreads();
    const int lo = args.ph_lo, hi = args.ph_hi;
    XcdBarrier bar; bar.bar = (unsigned*)(F.ctl + CW_BAR) + args.li * XCD_BAR_WORDS; bar.x = 0; bar.st = nullptr;
    if (hi - lo > 1) bar = xcd_barrier_post((unsigned*)(F.ctl + CW_BAR) + args.li * XCD_BAR_WORDS, (volatile LAS unsigned*)(F.lds + MISC_OFF));
    if (SITE(0) && IN(0)) { p0a(F); SEAM(0); }
    if (SITE(1) && IN(1)) { p0b(F); SEAM(1); }
    layer_phases<0>(F, bar, lo, hi);
    layer_phases<1>(F, bar, lo, hi);
}
#undef IN
#undef SEAM


extern "C" void kernel_launch(void* const* d_in, const int* in_sizes, int n_in, void* d_out, int out_size, void* d_ws, size_t ws_size, hipStream_t stream) {
    static int grid = 0;
    if (grid == 0) {
        const bool ok = n_in == N_IN && in_sizes[I_X] == NBATCH * SEQ * DM && in_sizes[I_RECW] == 1024 * REC_IN && in_sizes[I_ATTW] == 1024 * ATT_IN && in_sizes[I_MU] == RWKV_IN &&
                        in_sizes[I_GATEB] == 16 && in_sizes[I_W1] == 2 * NE * 1024 * 2048 && out_size == NBATCH * SEQ * DM && ws_size >= WS_END;
        if (!ok) { fprintf(stderr, "kernel_launch: shape mismatch (n_in %d, recw %d, attw %d, mu %d, out %d, ws %zu need %zu); nothing launched\n", n_in, n_in > I_RECW ? in_sizes[I_RECW] : -1,
                           n_in > I_ATTW ? in_sizes[I_ATTW] : -1, n_in > I_MU ? in_sizes[I_MU] : -1, out_size, ws_size, (size_t)WS_END); grid = -1; return; }
        int dev = 0, cus = 0;
        if (hipGetDevice(&dev) != hipSuccess || hipDeviceGetAttribute(&cus, hipDeviceAttributeMultiprocessorCount, dev) != hipSuccess) { grid = -1; return; }
        if (hipFuncSetAttribute((const void*)fwd, hipFuncAttributeMaxDynamicSharedMemorySize, LDS_BYTES) != hipSuccess) { fprintf(stderr, "kernel_launch: hipFuncSetAttribute failed\n"); grid = -1; return; }
        int per_cu = 0;
        if (hipOccupancyMaxActiveBlocksPerMultiprocessor(&per_cu, (const void*)fwd, 512, LDS_BYTES) != hipSuccess || per_cu < 1) { fprintf(stderr, "kernel_launch: occupancy query says %d blocks per CU\n", per_cu); }
        (void)hipGetLastError();
        grid = cus < 256 ? cus : 256;
        if (grid != 256) fprintf(stderr, "kernel_launch: %d CUs; this kernel is written for a 256-CU device\n", cus);
    }
    if (grid < 0) return;
    if (hipMemsetAsync((char*)d_ws + WS_CTL, 0, CTL_ZERO_BYTES, stream) != hipSuccess) return;
    Args a{};
    for (int i = 0; i < N_IN; ++i) a.in[i] = (const float*)d_in[i];
    a.out = (float*)d_out; a.ws = (unsigned char*)d_ws; a.pad = 0;
#if MK_PER_PHASE
    for (int ph = 0; ph < NPHASE; ++ph) { if (ph == 2 + 12 + 3) continue; a.ph_lo = ph; a.ph_hi = ph + 1; a.li = 0; hipLaunchKernelGGL(fwd, dim3(grid), dim3(512), LDS_BYTES, stream, a); }
#else
    a.ph_lo = 0; a.ph_hi = NPHASE; a.li = 0; hipLaunchKernelGGL(fwd, dim3(grid), dim3(512), LDS_BYTES, stream, a);
#endif
    const hipError_t le = hipPeekAtLastError();
    if (le != hipSuccess) fprintf(stderr, "kernel_launch: launch failed: %s\n", hipGetErrorName(le));
}
```

```cpp
#include <hip/hip_runtime.h>
#include <cstdio>
#include <cstdint>
#define MK_PER_PHASE 0
namespace pg8 {
#define PG8_LAS __attribute__((address_space(3)))
typedef unsigned short bf16_t;
typedef short bf16x8 __attribute__((ext_vector_type(8)));
typedef float f32x4 __attribute__((ext_vector_type(4)));
typedef unsigned u32x4 __attribute__((ext_vector_type(4)));
constexpr int BM = 256, BK = 64, HALF = 128, HTB = HALF * BK * 2  , STAGE_BYTES = 8 * HTB, NXCD = 8, WGM = 8;

__host__ __device__ __forceinline__ int lds_byte(int r, int c) { const int st = (r >> 4) * 2 + (c >> 5), rr = r & 15, cc = c & 31, ob = rr * 64 + cc * 2; return st * 1024 + (ob ^ (((ob >> 9) & 1) << 5)); }
__host__ __device__ __forceinline__ void stage_rc(int b, int& R, int& C) { const int st = b / 1024, sb = b % 1024, swz = sb ^ (((sb >> 9) & 1) << 5); R = (st >> 1) * 16 + swz / 64; C = (st & 1) * 32 + (swz % 64) / 2; }
__host__ __device__ __forceinline__ int perm32(int rho) { const int n = rho >> 4, i = rho & 15; return 8 * (i >> 2) + 4 * n + (i & 3); }

struct Unit { int pm, pn; };
struct Gemm { const bf16_t* A; const bf16_t* Bt; int M, N, K; };

struct StaticOrder {
    int nM, nN, nwg, G, c;
    __host__ __device__ void init(int M, int N, int G_, int c_) { nM = M / BM; nN = N / BM; nwg = nM * nN; G = G_; c = c_; }
    __host__ __device__ bool next(int i, Unit& u) const {
        const long L = (long)i * G + c; if (L >= nwg) return false;
        int wgid = (int)L; { const int q = nwg / NXCD, r = nwg % NXCD, xcd = wgid % NXCD, off = wgid / NXCD; wgid = (xcd < r ? xcd * (q + 1) : r * (q + 1) + (xcd - r) * q) + off; }
        const int nig = WGM * nN, gid = wgid / nig, fm = gid * WGM, gsz = (nM - fm) < WGM ? (nM - fm) : WGM;
        u.pm = fm + ((wgid % nig) % gsz); u.pn = (wgid % nig) / gsz; return true;
    }
    __device__ __forceinline__ void a_ready(const Unit&) const {}
    __device__ __forceinline__ void done(const Unit&) const {}
};

__device__ __forceinline__ unsigned cvt_pk_bf16(float lo, float hi) { unsigned r; asm volatile("v_cvt_pk_bf16_f32 %0, %1, %2" : "=v"(r) : "v"(lo), "v"(hi)); return r; }
template <class Fn> struct EpiGen {
    static constexpr bool PERM = true, AFTER_DRAIN = false;
    Fn fn;
    __device__ __forceinline__ void operator()(const f32x4 (&acc)[2][2][4][2], const Unit& u, int wr, int wc, int fr, int fq) const {
#pragma unroll
        for (int ai = 0; ai < 2; ++ai)
#pragma unroll
            for (int m = 0; m < 4; ++m) { const int row = u.pm * BM + ai * HALF + wr * 64 + m * 16 + fr;
#pragma unroll
                for (int bj = 0; bj < 2; ++bj) { const int col = u.pn * BM + bj * HALF + wc * 32 + 8 * fq; fn(row, col, acc[ai][bj][m][0], acc[ai][bj][m][1]); } }
    }
};
template <class Epi, class Sched, bool ALIGN_EPI = false, bool SP2 = false>
__device__ __forceinline__ void gemm_phase(PG8_LAS unsigned char* lds, const Gemm g, const Sched& S, const Epi& E) {
    const int tid = threadIdx.x, wid = __builtin_amdgcn_readfirstlane(tid >> 6), lane = tid & 63, wr = wid >> 2, wc = wid & 3, fr = lane & 15, fq = lane >> 4;
    const int K = g.K, nt = K / BK;
    unsigned voffA[2], voffB[2];
#pragma unroll
    for (int i = 0; i < 2; ++i) { int R, C; stage_rc(tid * 16 + i * 8192, R, C); const int Rb = Epi::PERM ? ((R & ~31) + perm32(R & 31)) : R;
        voffA[i] = (unsigned)(R * K + C) * 2u; voffB[i] = (unsigned)(Rb * K + C) * 2u; }
    const size_t kstep = (size_t)(BK * 2);
    const size_t hstep = (size_t)HALF * K * 2;
    const size_t tstep = 2 * hstep;
    const unsigned ldsw = (unsigned)wid * 1024u;
    const int aoff = lds_byte(wr * 64 + fr, fq * 8), boff = lds_byte(wc * 32 + fr, fq * 8);
#define PG8_SA(b, h) (((b) * 2 + (h)) * HTB)
#define PG8_SB(b, h) ((4 + (b) * 2 + (h)) * HTB)
#define PG8_STAGE(bufoff, gbase, voff) do { _Pragma("unroll") for (int _i = 0; _i < 2; ++_i) \
        __builtin_amdgcn_global_load_lds((const unsigned*)((const char*)(gbase) + (voff)[_i]), (PG8_LAS unsigned*)(lds + (bufoff) + ldsw + _i * 8192), 16, 0, 0); } while (0)
#define PG8_LDA(dst, b, h) do { _Pragma("unroll") for (int m = 0; m < 4; ++m) _Pragma("unroll") for (int k = 0; k < 2; ++k) dst[m][k] = *(const PG8_LAS bf16x8*)(lds + PG8_SA(b, h) + aoff + m * 2048 + k * 1024); } while (0)
#define PG8_LDB(dst, b, h) do { _Pragma("unroll") for (int n = 0; n < 2; ++n) _Pragma("unroll") for (int k = 0; k < 2; ++k) dst[n][k] = *(const PG8_LAS bf16x8*)(lds + PG8_SB(b, h) + boff + n * 2048 + k * 1024); } while (0)
#define PG8_MMA(ai, bj, At, Bt) do { __builtin_amdgcn_s_setprio(1); _Pragma("unroll") for (int m = 0; m < 4; ++m) _Pragma("unroll") for (int n = 0; n < 2; ++n) _Pragma("unroll") for (int k = 0; k < 2; ++k) \
        acc[ai][bj][m][n] = __builtin_amdgcn_mfma_f32_16x16x32_bf16(Bt[n][k], At[m][k], acc[ai][bj][m][n], 0, 0, 0); __builtin_amdgcn_s_setprio(0); } while (0)
#define PG8_WAIT_V(n) asm volatile("s_waitcnt vmcnt(" #n ")" ::: "memory")
#define PG8_WAIT_L(n) asm volatile("s_waitcnt lgkmcnt(" #n ")" ::: "memory")
#define PG8_BAR __builtin_amdgcn_s_barrier()
#define PG8_SCHED __builtin_amdgcn_sched_barrier(0)
    Unit cur, nxt; int ui = 0;
    if (!S.next(0, cur)) return;
    f32x4 acc[2][2][4][2];
#pragma unroll
    for (int a = 0; a < 2; ++a)
#pragma unroll
        for (int b = 0; b < 2; ++b)
#pragma unroll
            for (int m = 0; m < 4; ++m)
#pragma unroll
                for (int n = 0; n < 2; ++n) acc[a][b][m][n] = (f32x4){0.f, 0.f, 0.f, 0.f};
    bf16x8 At[4][2], B0[2][2], B1[2][2];
    const char* cA = (const char*)g.A + (size_t)cur.pm * tstep; const char* cB = (const char*)g.Bt + (size_t)cur.pn * tstep;
    S.a_ready(cur);
    if constexpr (SP2) {
        PG8_STAGE(PG8_SB(0, 0), cB, voffB); PG8_STAGE(PG8_SB(0, 1), cB + hstep, voffB); PG8_STAGE(PG8_SA(0, 0), cA, voffA); PG8_STAGE(PG8_SA(0, 1), cA + hstep, voffA);
        if (wr == 1) PG8_BAR;
        PG8_WAIT_V(2); PG8_BAR;
        PG8_STAGE(PG8_SB(1, 0), cB + kstep, voffB); PG8_STAGE(PG8_SA(1, 0), cA + kstep, voffA); PG8_STAGE(PG8_SB(1, 1), cB + hstep + kstep, voffB);
        PG8_WAIT_V(6); PG8_BAR;
    } else {
        PG8_STAGE(PG8_SB(0, 0), cB, voffB); PG8_STAGE(PG8_SA(0, 0), cA, voffA); PG8_STAGE(PG8_SB(0, 1), cB + hstep, voffB); PG8_STAGE(PG8_SA(0, 1), cA + hstep, voffA);
        if (wr == 1) PG8_BAR;
        PG8_WAIT_V(4); PG8_BAR;
        PG8_STAGE(PG8_SB(1, 0), cB + kstep, voffB); PG8_STAGE(PG8_SA(1, 0), cA + kstep, voffA); PG8_STAGE(PG8_SB(1, 1), cB + hstep + kstep, voffB);
        PG8_WAIT_V(6); PG8_BAR;
    }
    for (;;) {
        const bool has_next = S.next(ui + 1, nxt);
        const char* nA = has_next ? (const char*)g.A + (size_t)nxt.pm * tstep : cA; const char* nB = has_next ? (const char*)g.Bt + (size_t)nxt.pn * tstep : cB;
        for (int t = 0; t < nt; t += 2) {
            const bool last = (t == nt - 2);
            const char* a1 = cA + (size_t)(t + 1) * kstep;
            const char* a2 = last ? nA : cA + (size_t)(t + 2) * kstep; const char* b2 = last ? nB : cB + (size_t)(t + 2) * kstep;
            const char* a3 = a2 + kstep; const char* b3 = b2 + kstep;
            if (last && has_next) S.a_ready(nxt);
            if constexpr (SP2) {
            PG8_LDB(B0, 0, 0); PG8_LDB(B1, 0, 1); PG8_SCHED; PG8_LDA(At, 0, 0); PG8_STAGE(PG8_SA(1, 1), a1 + hstep, voffA);
            PG8_WAIT_V(8); PG8_WAIT_L(0); PG8_BAR; PG8_MMA(0, 0, At, B0); PG8_MMA(0, 1, At, B1); PG8_BAR; PG8_SCHED;
            PG8_LDA(At, 0, 1); PG8_STAGE(PG8_SB(0, 0), b2, voffB); PG8_STAGE(PG8_SB(0, 1), b2 + hstep, voffB); PG8_STAGE(PG8_SA(0, 0), a2, voffA);
            PG8_WAIT_V(8); PG8_WAIT_L(0); PG8_BAR; PG8_MMA(1, 0, At, B0); PG8_MMA(1, 1, At, B1); PG8_BAR; PG8_SCHED;
            PG8_LDB(B0, 1, 0); PG8_LDB(B1, 1, 1); PG8_SCHED; PG8_LDA(At, 1, 0); PG8_STAGE(PG8_SA(0, 1), a2 + hstep, voffA);
            PG8_WAIT_V(8); PG8_WAIT_L(0); PG8_BAR; PG8_MMA(0, 0, At, B0); PG8_MMA(0, 1, At, B1); PG8_BAR; PG8_SCHED;
            PG8_LDA(At, 1, 1); PG8_STAGE(PG8_SB(1, 0), b3, voffB); PG8_STAGE(PG8_SB(1, 1), b3 + hstep, voffB); PG8_STAGE(PG8_SA(1, 0), a3, voffA);
            PG8_WAIT_V(8); PG8_WAIT_L(0); PG8_BAR; PG8_MMA(1, 0, At, B0); PG8_MMA(1, 1, At, B1); PG8_BAR; PG8_SCHED;
            } else {
            PG8_LDB(B0, 0, 0); PG8_SCHED; PG8_LDA(At, 0, 0); PG8_STAGE(PG8_SA(1, 1), a1 + hstep, voffA);
            PG8_WAIT_L(8); PG8_BAR; PG8_WAIT_L(0); PG8_MMA(0, 0, At, B0); PG8_BAR; PG8_SCHED;
            PG8_LDB(B1, 0, 1); PG8_STAGE(PG8_SB(0, 0), b2, voffB);
            PG8_BAR; PG8_WAIT_L(0); PG8_MMA(0, 1, At, B1); PG8_BAR;
            PG8_LDA(At, 0, 1); PG8_STAGE(PG8_SA(0, 0), a2, voffA);
            PG8_BAR; PG8_WAIT_L(0); PG8_MMA(1, 0, At, B0); PG8_BAR; PG8_SCHED;
            PG8_STAGE(PG8_SB(0, 1), b2 + hstep, voffB);
            PG8_WAIT_V(6); PG8_BAR; PG8_MMA(1, 1, At, B1); PG8_BAR;
            PG8_LDB(B0, 1, 0); PG8_SCHED; PG8_LDA(At, 1, 0); PG8_STAGE(PG8_SA(0, 1), a2 + hstep, voffA);
            PG8_WAIT_L(8); PG8_BAR; PG8_WAIT_L(0); PG8_MMA(0, 0, At, B0); PG8_BAR; PG8_SCHED;
            PG8_LDB(B1, 1, 1); PG8_STAGE(PG8_SB(1, 0), b3, voffB);
            PG8_BAR; PG8_WAIT_L(0); PG8_MMA(0, 1, At, B1); PG8_BAR;
            PG8_LDA(At, 1, 1); PG8_STAGE(PG8_SA(1, 0), a3, voffA);
            PG8_BAR; PG8_WAIT_L(0); PG8_MMA(1, 0, At, B0); PG8_BAR; PG8_SCHED;
            PG8_STAGE(PG8_SB(1, 1), b3 + hstep, voffB);
            PG8_WAIT_V(6); PG8_BAR; PG8_MMA(1, 1, At, B1); PG8_BAR;
            }
        }
        if constexpr (ALIGN_EPI) { if (wr == 0) PG8_BAR; }
        if constexpr (!Epi::AFTER_DRAIN) { E(acc, cur, wr, wc, fr, fq); S.done(cur); }
        if (!has_next) break;
#pragma unroll
        for (int a = 0; a < 2; ++a)
#pragma unroll
            for (int b = 0; b < 2; ++b)
#pragma unroll
                for (int m = 0; m < 4; ++m)
#pragma unroll
                    for (int n = 0; n < 2; ++n) acc[a][b][m][n] = (f32x4){0.f, 0.f, 0.f, 0.f};
        cur = nxt; cA = nA; cB = nB; ++ui;
        if constexpr (ALIGN_EPI) { if (wr == 1) PG8_BAR; }
    }
    PG8_WAIT_V(0);
    if constexpr (!ALIGN_EPI) { if (wr == 0) PG8_BAR; }
    PG8_BAR;
    if constexpr (Epi::AFTER_DRAIN) { E.fused(acc, cur, wr, wc, fr, fq, lds, wid, lane); S.done(cur); }
#undef PG8_SA
#undef PG8_SB
#undef PG8_STAGE
#undef PG8_LDA
#undef PG8_LDB
#undef PG8_MMA
#undef PG8_WAIT_V
#undef PG8_WAIT_L
#undef PG8_BAR
#undef PG8_SCHED
}
}
#define GAS __attribute__((address_space(1)))
#define LAS __attribute__((address_space(3)))
typedef unsigned short bf16;
typedef unsigned v4u __attribute__((ext_vector_type(4)));
typedef unsigned v2u __attribute__((ext_vector_type(2)));
typedef float f32x4 __attribute__((ext_vector_type(4)));
typedef short bf16x8 __attribute__((ext_vector_type(8)));
typedef GAS unsigned gu32;
typedef GAS unsigned long long gu64;
#define RLX_AGENT __ATOMIC_RELAXED, __HIP_MEMORY_SCOPE_AGENT
#define LDS_WAIT() asm volatile("s_waitcnt lgkmcnt(0)" ::: "memory")
#define VM_WAIT() asm volatile("s_waitcnt vmcnt(0)" ::: "memory")
__device__ __forceinline__ unsigned f2bf(float f) { unsigned u = __builtin_bit_cast(unsigned, f); return (u + 0x7fffu + ((u >> 16) & 1u)) >> 16; }
__device__ __forceinline__ unsigned pk2(float lo, float hi) { return f2bf(lo) | (f2bf(hi) << 16); }
__device__ __forceinline__ float bflo(unsigned w) { return __builtin_bit_cast(float, w << 16); }
__device__ __forceinline__ float bfhi(unsigned w) { return __builtin_bit_cast(float, w & 0xffff0000u); }
__device__ __forceinline__ float bf2f(bf16 b) { return __builtin_bit_cast(float, (unsigned)b << 16); }
__device__ __forceinline__ float wave_sum(float v) {
#pragma unroll
    for (int o = 1; o < 64; o <<= 1) v += __shfl_xor(v, o);
    return v;
}
__device__ __forceinline__ float sigmoidf_(float x) { return 1.f / (1.f + __expf(-x)); }

#define XB_TMO      128
#define XB_XCNT(j)  (256  + 64 * (j))
#define XB_XSUB(j)  (1280 + 64 * (j))
#define XB_XGEN(j)  (2304 + 64 * (j))
#define XB_TOP      3328
#define XB_TOPGEN   3392
#define XCD_BAR_WORDS 3456
#define XB_SPIN_CAP (1u << 22)

__device__ __forceinline__ unsigned xb_ld(unsigned* p)              { return __hip_atomic_load(p, __ATOMIC_RELAXED, __HIP_MEMORY_SCOPE_AGENT); }
__device__ __forceinline__ unsigned xb_add(unsigned* p, unsigned v) { return __hip_atomic_fetch_add(p, v, __ATOMIC_RELAXED, __HIP_MEMORY_SCOPE_AGENT); }
__device__ __forceinline__ unsigned xb_xcc_id() { return (unsigned)__builtin_amdgcn_s_getreg((3 << 11) | 20) & 0xFu; }
#define XB_SPIN(cond, bar) do { unsigned _sp = 0; while (cond) { __builtin_amdgcn_s_sleep(1); \
    if ((++_sp & 255u) == 0u) { if (xb_ld(&(bar)[XB_TMO])) break; if (_sp > XB_SPIN_CAP) { atomicAdd(&(bar)[XB_TMO], 1u); break; } } } } while (0)

struct XcdBarrier {
    unsigned* bar; unsigned x;
    volatile LAS unsigned* st;
};

__device__ __forceinline__ XcdBarrier xcd_barrier_post(unsigned* bar, volatile LAS unsigned* st) {
    XcdBarrier b; b.bar = bar; b.x = xb_xcc_id(); b.st = st;
    if (threadIdx.x == 0) (void)xb_add(&bar[XB_XCNT(b.x)], 1u);
    return b;
}
__device__ __forceinline__ void xcd_barrier_complete(unsigned* bar, unsigned x, unsigned& nloc, unsigned& nx) {
    const unsigned G = gridDim.x * gridDim.y * gridDim.z;
    unsigned sum, cnt, mine, sp = 0u;
    for (;;) {
        sum = 0u; cnt = 0u; mine = 0u;
#pragma unroll
        for (unsigned j = 0; j < 16; ++j) { const unsigned c = xb_ld(&bar[XB_XCNT(j)]); sum += c; cnt += (c > 0u) ? 1u : 0u; mine = (j == x) ? c : mine; }
        if (sum == G) break;
        __builtin_amdgcn_s_sleep(1);
        if ((++sp & 255u) == 0u) { if (xb_ld(&bar[XB_TMO])) break; if (sp > XB_SPIN_CAP) { atomicAdd(&bar[XB_TMO], 1u); break; } }
    }
    nloc = mine > 0u ? mine : 1u; nx = cnt > 0u ? cnt : 1u;
}

__device__ __forceinline__ void xcd_barrier(const XcdBarrier& b) {
    asm volatile("s_waitcnt vmcnt(0)" ::: "memory");
    __syncthreads();
    if (threadIdx.x == 0) {
        unsigned* bar = b.bar;
        __builtin_amdgcn_s_waitcnt(0);
        unsigned nloc = b.st[0], nx = b.st[1];
        if (nloc == 0u) { xcd_barrier_complete(bar, b.x, nloc, nx); b.st[0] = nloc; b.st[1] = nx; }
        const unsigned old = xb_add(&bar[XB_XSUB(b.x)], 1u);
        const unsigned gen = old / nloc;
        if (old + 1u == (gen + 1u) * nloc) {
            __builtin_amdgcn_fence(__ATOMIC_RELEASE, "agent");
            asm volatile("s_waitcnt vmcnt(0)" ::: "memory");
            const unsigned og = xb_add(&bar[XB_TOP], 1u);
            const unsigned tg = og / nx;
            if (og + 1u == (tg + 1u) * nx) xb_add(&bar[XB_TOPGEN], 1u);
            else XB_SPIN(xb_ld(&bar[XB_TOPGEN]) == tg, bar);
            __builtin_amdgcn_fence(__ATOMIC_ACQUIRE, "agent");
            xb_add(&bar[XB_XGEN(b.x)], 1u);
            asm volatile("s_waitcnt vmcnt(0)" ::: "memory");
        } else {
            XB_SPIN(xb_ld(&bar[XB_XGEN(b.x)]) == gen, bar);
            __builtin_amdgcn_fence(__ATOMIC_ACQUIRE, "agent");
            asm volatile("s_waitcnt vmcnt(0)" ::: "memory");
        }
    }
    __syncthreads();
}
namespace att {
using s16x4  = __attribute__((ext_vector_type(4))) short;
using f32x16 = __attribute__((ext_vector_type(16))) float;
using u32x4  = __attribute__((ext_vector_type(4))) unsigned;
#define ATT_SBAR() __builtin_amdgcn_sched_barrier(0)
constexpr float THR2 = 11.5f;
__device__ __forceinline__ int crow(int r, int hi) { return (r & 3) + 8 * (r >> 2) + 4 * hi; }
__device__ __forceinline__ unsigned cvtpk(float lo, float hi) { unsigned r; asm volatile("v_cvt_pk_bf16_f32 %0, %1, %2" : "=v"(r) : "v"(lo), "v"(hi)); return r; }

__device__ __forceinline__ void partialSM(f32x16& p0, f32x16& p1, float& m_reg, float& mn, float& alpha) {
  float pmax = p0[0];
#pragma unroll
  for (int r = 1; r < 16; ++r) pmax = fmaxf(pmax, p0[r]);
#pragma unroll
  for (int r = 0; r < 16; ++r) pmax = fmaxf(pmax, p1[r]);
  { auto rr = __builtin_amdgcn_permlane32_swap(__float_as_uint(pmax), __float_as_uint(pmax), false, false);
    pmax = fmaxf(__uint_as_float(rr[0]), __uint_as_float(rr[1])); }
  if (__builtin_expect(__all(pmax - m_reg <= THR2), 1)) { mn = m_reg; alpha = 1.f; }
  else { mn = fmaxf(m_reg, pmax); alpha = __builtin_amdgcn_exp2f(m_reg - mn); m_reg = mn; }
#pragma unroll
  for (int r = 0; r < 16; ++r) p0[r] = p0[r] - mn;
#pragma unroll
  for (int r = 0; r < 16; ++r) p1[r] = p1[r] - mn;
#pragma unroll
  for (int r = 0; r < 16; ++r) p0[r] = __builtin_amdgcn_exp2f(p0[r]);
}
__device__ __forceinline__ void finishSM(f32x16& p0, f32x16& p1, float alpha, float& l_reg, bf16x8& pa0, bf16x8& pa1, bf16x8& pa2, bf16x8& pa3) {
#pragma unroll
  for (int r = 0; r < 16; ++r) p1[r] = __builtin_amdgcn_exp2f(p1[r]);
  float ps = 0;
#pragma unroll
  for (int r = 0; r < 16; ++r) ps += p0[r];
#pragma unroll
  for (int r = 0; r < 16; ++r) ps += p1[r];
  { auto rr = __builtin_amdgcn_permlane32_swap(__float_as_uint(ps), __float_as_uint(ps), false, false);
    ps = __uint_as_float(rr[0]) + __uint_as_float(rr[1]); }
  l_reg = l_reg * alpha + ps;
#define ATT_PK4(P, BASE, OUT) do { unsigned a0 = cvtpk(P[BASE + 0], P[BASE + 1]), a1 = cvtpk(P[BASE + 2], P[BASE + 3]);   \
    unsigned b0 = cvtpk(P[BASE + 4], P[BASE + 5]), b1 = cvtpk(P[BASE + 6], P[BASE + 7]);                              \
    auto r0 = __builtin_amdgcn_permlane32_swap(a0, b0, false, false); auto r1 = __builtin_amdgcn_permlane32_swap(a1, b1, false, false); \
    u32x4 w = {r0[0], r1[0], r0[1], r1[1]}; OUT = *reinterpret_cast<bf16x8*>(&w); } while (0)
  ATT_PK4(p0, 0, pa0); ATT_PK4(p0, 8, pa1); ATT_PK4(p1, 0, pa2); ATT_PK4(p1, 8, pa3);
#undef ATT_PK4
}
template <int NB> __device__ __forceinline__ int v_st(int k, int c) { const int kk = (k & ~0xC) | ((k & 4) << 1) | ((k & 8) >> 1); return ((kk >> 3) * NB + (c >> 5)) * 512 + ((kk & 7) * 32 + (c & 31)) * 2; }
__device__ __forceinline__ int v_rd_base(int lane) { return ((lane & 3) << 3) | (((lane >> 2) & 3) << 6) | (((lane >> 4) & 1) << 5) | (((lane >> 5) & 1) << 8); }
template <int OFF> __device__ __forceinline__ s16x4 tr_read(int vb) {
  s16x4 r; asm volatile("ds_read_b64_tr_b16 %0, %1 offset:%2" : "=&v"(r) : "v"(vb), "i"(OFF) : "memory"); return r;
}
template <int NB, int D0> __device__ __forceinline__ void pv_one(f32x16& od, int vb, bf16x8 pa0, bf16x8 pa1, bf16x8 pa2, bf16x8 pa3) {
#define ATT_VOFF(ks, half) (D0 * 512 + (ks) * (NB * 1024) + (half) * (NB * 512))
  const s16x4 l0 = tr_read<ATT_VOFF(0, 0)>(vb), h0 = tr_read<ATT_VOFF(0, 1)>(vb), l1 = tr_read<ATT_VOFF(1, 0)>(vb), h1 = tr_read<ATT_VOFF(1, 1)>(vb);
  const s16x4 l2 = tr_read<ATT_VOFF(2, 0)>(vb), h2 = tr_read<ATT_VOFF(2, 1)>(vb), l3 = tr_read<ATT_VOFF(3, 0)>(vb), h3 = tr_read<ATT_VOFF(3, 1)>(vb);
#undef ATT_VOFF
  asm volatile("s_waitcnt lgkmcnt(0)" ::: "memory"); ATT_SBAR();
#define ATT_PK(L, H) (bf16x8){L[0], L[1], L[2], L[3], H[0], H[1], H[2], H[3]}
  od = __builtin_amdgcn_mfma_f32_32x32x16_bf16(pa0, ATT_PK(l0, h0), od, 0, 0, 0);
  od = __builtin_amdgcn_mfma_f32_32x32x16_bf16(pa1, ATT_PK(l1, h1), od, 0, 0, 0);
  od = __builtin_amdgcn_mfma_f32_32x32x16_bf16(pa2, ATT_PK(l2, h2), od, 0, 0, 0);
  od = __builtin_amdgcn_mfma_f32_32x32x16_bf16(pa3, ATT_PK(l3, h3), od, 0, 0, 0);
#undef ATT_PK
}
template <int NB> __device__ __forceinline__ void pv_all(f32x16* o, int vb, bf16x8 pa0, bf16x8 pa1, bf16x8 pa2, bf16x8 pa3) {
  pv_one<NB, 0>(o[0], vb, pa0, pa1, pa2, pa3); pv_one<NB, 1>(o[1], vb, pa0, pa1, pa2, pa3);
  if constexpr (NB == 4) { pv_one<NB, 2>(o[2], vb, pa0, pa1, pa2, pa3); pv_one<NB, 3>(o[3], vb, pa0, pa1, pa2, pa3); }
}
template <int DK> __device__ __forceinline__ void qkt(f32x16& p0, f32x16& p1, LAS const char* Ks, const bf16x8* qr, int r32, int hi) {
  constexpr int KSTR = DK * 2 + 16;
  p0 = f32x16{}; p1 = f32x16{};
#pragma unroll
  for (int d0 = 0; d0 < DK / 16; ++d0) { const int cb = (d0 * 16 + hi * 8) * 2;
    const bf16x8 b0 = *(LAS const bf16x8*)(Ks + r32 * KSTR + cb);
    const bf16x8 b1 = *(LAS const bf16x8*)(Ks + (32 + r32) * KSTR + cb);
    p0 = __builtin_amdgcn_mfma_f32_32x32x16_bf16(b0, qr[d0], p0, 0, 0, 0);
    p1 = __builtin_amdgcn_mfma_f32_32x32x16_bf16(b1, qr[d0], p1, 0, 0, 0); }
}
template <int DK, int DV> struct Cfg {
  static constexpr int KSTR = DK * 2 + 16, KT = 64 * KSTR, NB = DV / 32, VT = 64 * DV * 2, NQ = DK / 16;
  static constexpr int NKC = DK / 8, NVC = DV / 8;
  static constexpr int KN = (64 * NKC + 511) / 512, VN = (64 * NVC + 511) / 512;
  static constexpr int OFF_V = 0, OFF_K = 2 * VT, OFF_WS = 2 * VT + 2 * KT, LDS_BYTES = OFF_WS + 8 * 64 * 4;
};
template <int DK, int DV>
__device__ __forceinline__ void attn_unit(const bf16* __restrict__ Qb, int ldq, const bf16* __restrict__ K1, int ldk1, const bf16* __restrict__ K2, int ldk2,
                                          const bf16* __restrict__ Vh, int ldv, float* __restrict__ Ob, int ldo, int nkeys, LAS char* lds) {
  using C = Cfg<DK, DV>;
  const int tid = threadIdx.x, wid = tid >> 6, lane = tid & 63, r32 = lane & 31, hi = lane >> 5;
  LAS char* V_lds = lds + C::OFF_V; LAS char* K_lds = lds + C::OFF_K;
  LAS float* ws = (LAS float*)(lds + C::OFF_WS) + wid * 64; LAS float* li_l = ws; LAS float* al_l = ws + 32;
  float m_reg = -1e30f, l_reg = 0; f32x16 o[C::NB] = {}; bf16x8 qr[C::NQ];
  { const bf16* Qw = Qb + (long)(wid * 32 + r32) * ldq + hi * 8;
#pragma unroll
    for (int d0 = 0; d0 < C::NQ; ++d0) qr[d0] = *(const bf16x8*)(Qw + d0 * 16); }
  int krow[C::KN], kch[C::KN], vrow[C::VN], vcol[C::VN]; bool kval[C::KN]; const bf16* kptr[C::KN]; int kstr[C::KN]; const bf16* vptr[C::VN];
#pragma unroll
  for (int i = 0; i < C::KN; ++i) { int it = tid + 512 * i; kval[i] = it < 64 * C::NKC; if (!kval[i]) it = tid; krow[i] = it / C::NKC; kch[i] = it % C::NKC;
    if (DK == 64 || kch[i] < 8) { kptr[i] = K1 + (long)krow[i] * ldk1 + kch[i] * 8; kstr[i] = ldk1; } else { kptr[i] = K2 + (long)krow[i] * ldk2 + (kch[i] - 8) * 8; kstr[i] = ldk2; } }
#pragma unroll
  for (int i = 0; i < C::VN; ++i) { const int it = tid + 512 * i; vrow[i] = it / C::NVC; vcol[i] = (it % C::NVC) * 8; vptr[i] = Vh + (long)vrow[i] * ldv + vcol[i]; }
  const int vb0 = (int)(uintptr_t)V_lds + v_rd_base(lane);
  struct Slot { bf16x8 ks[C::KN], vs[C::VN]; } sS;
#define ATT_SLOAD(S, k0) do { _Pragma("unroll") for (int i = 0; i < C::KN; ++i) S.ks[i] = *(const bf16x8*)(kptr[i] + (long)(k0) * kstr[i]); \
    _Pragma("unroll") for (int i = 0; i < C::VN; ++i) S.vs[i] = *(const bf16x8*)(vptr[i] + (long)(k0) * ldv); } while (0)
#define ATT_SWRITE(b, S) do { _Pragma("unroll") for (int i = 0; i < C::KN; ++i) if (kval[i]) *(LAS bf16x8*)(K_lds + (b) * C::KT + krow[i] * C::KSTR + kch[i] * 16) = S.ks[i]; \
    _Pragma("unroll") for (int i = 0; i < C::VN; ++i) *(LAS bf16x8*)(V_lds + (b) * C::VT + v_st<C::NB>(vrow[i], vcol[i])) = S.vs[i]; } while (0)
#define ATT_SWAIT() asm volatile("s_waitcnt vmcnt(0)" ::: "memory")
#define ATT_RESC(a) do { if (__any((a) < 1.f)) { if (hi == 0) al_l[r32] = (a); asm volatile("s_waitcnt lgkmcnt(0)" ::: "memory"); \
    _Pragma("unroll") for (int d = 0; d < C::NB; ++d) _Pragma("unroll") for (int r = 0; r < 16; ++r) o[d][r] *= al_l[crow(r, hi)]; } } while (0)
  static_assert(C::KN + C::VN == 3, "three staging loads per thread per tile (ATT_SWAIT)");
  f32x16 pA0, pA1, pB0, pB1; float mnA, mnB, alA, alB; bf16x8 pa0, pa1, pa2, pa3; const int NT = nkeys / 64;
  __syncthreads();
  ATT_SLOAD(sS, 0); asm volatile("s_waitcnt vmcnt(0)" ::: "memory"); ATT_SWRITE(0, sS); __syncthreads();
  qkt<DK>(pA0, pA1, K_lds, qr, r32, hi); partialSM(pA0, pA1, m_reg, mnA, alA);
  ATT_SLOAD(sS, 64);
  ATT_SWAIT(); ATT_SWRITE(1, sS); __syncthreads();
  for (int j = 1; j + 1 < NT; j += 2) {
    ATT_SBAR(); qkt<DK>(pB0, pB1, K_lds + C::KT, qr, r32, hi);
    finishSM(pA0, pA1, alA, l_reg, pa0, pa1, pa2, pa3); ATT_SBAR();
    ATT_SLOAD(sS, (j + 1) * 64); ATT_SBAR();
    pv_all<C::NB>(o, vb0, pa0, pa1, pa2, pa3); partialSM(pB0, pB1, m_reg, mnB, alB);
    __syncthreads(); ATT_SWAIT(); ATT_SWRITE(0, sS);
    ATT_RESC(alB); __syncthreads();
    ATT_SBAR(); qkt<DK>(pA0, pA1, K_lds, qr, r32, hi);
    finishSM(pB0, pB1, alB, l_reg, pa0, pa1, pa2, pa3); ATT_SBAR();
    ATT_SLOAD(sS, (j + 2) * 64); ATT_SBAR();
    pv_all<C::NB>(o, vb0 + C::VT, pa0, pa1, pa2, pa3); partialSM(pA0, pA1, m_reg, mnA, alA);
    __syncthreads(); ATT_SWAIT(); ATT_SWRITE(1, sS);
    ATT_RESC(alA); __syncthreads();
  }
  ATT_SBAR(); qkt<DK>(pB0, pB1, K_lds + C::KT, qr, r32, hi);
  finishSM(pA0, pA1, alA, l_reg, pa0, pa1, pa2, pa3); ATT_SBAR();
  pv_all<C::NB>(o, vb0, pa0, pa1, pa2, pa3); partialSM(pB0, pB1, m_reg, mnB, alB);
  __syncthreads(); ATT_RESC(alB);
  finishSM(pB0, pB1, alB, l_reg, pa0, pa1, pa2, pa3); ATT_SBAR();
  pv_all<C::NB>(o, vb0 + C::VT, pa0, pa1, pa2, pa3);
  if (hi == 0) li_l[r32] = l_reg; asm volatile("s_waitcnt lgkmcnt(0)" ::: "memory");
  float rli[16];
#pragma unroll
  for (int r = 0; r < 16; ++r) rli[r] = __builtin_amdgcn_rcpf(li_l[crow(r, hi)]);
  float* Ow = Ob + (long)(wid * 32) * ldo;
#pragma unroll
  for (int r = 0; r < 16; ++r) { const int orow = crow(r, hi);
#pragma unroll
    for (int d0 = 0; d0 < C::NB; ++d0) Ow[(long)orow * ldo + d0 * 32 + r32] = o[d0][r] * rli[r]; }
#undef ATT_SLOAD
#undef ATT_SWRITE
#undef ATT_SWAIT
#undef ATT_RESC
}
}
constexpr int DM = 1024, NBATCH = 2, SEQ = 16384, CT = 256, TB = SEQ + CT  , R = NBATCH * TB  ;
constexpr int ATT_IN = 2208, ATT_NP = 2304, REC_IN = 3472, REC_NP = 3584, RWKV_IN = 1920;
constexpr int NE = 32, TOPK = 4, MAXT = R * TOPK / 256 + NE  , MAXROWS = MAXT * 256;
constexpr int NUNIT_M = 16 * 260;
constexpr float NORM_EPS = 1e-6f;
enum { I_X = 0, I_C, I_CTX, I_CCTX, I_NMIX, I_NFFN, I_ADAW, I_ADAB, I_WOUT, I_RW, I_RB, I_W1, I_B1, I_W2, I_B2, I_ATTW, I_LAM, I_SUBLN, I_QNW, I_KVNW, I_WUQ, I_WUKV,
       I_RECW, I_MU, I_W0, I_RW2, I_A0, I_A2, I_G2, I_KK, I_KA, I_RK, I_LNW, I_LNB, I_GATEB, I_MNW, I_FNW, N_IN };
constexpr size_t al256(size_t x) { return (x + 255) & ~(size_t)255; }
constexpr size_t WS_CTL = 0, CTL_ZERO_BYTES = 1u << 20;
constexpr size_t WS_MOD = CTL_ZERO_BYTES;
constexpr size_t WS_ROPE = al256(WS_MOD + 2 * 3 * 6144 * 4);
constexpr size_t ROPE_DR = 0, ROPE_DC = 256 * 16 * 2, ROPE_MR = ROPE_DC + 64 * 16 * 2, ROPE_MC = ROPE_MR + 256 * 8 * 2, ROPE_FLOATS = ROPE_MC + 64 * 8 * 2;
constexpr size_t WS_WIN0 = al256(WS_ROPE + ROPE_FLOATS * 4);
constexpr size_t WS_WUQ = al256(WS_WIN0 + (size_t)ATT_NP * 1024 * 2);
constexpr size_t WS_WUKV = al256(WS_WUQ + (size_t)768 * 384 * 2);
constexpr size_t WS_WOUT = al256(WS_WUKV + (size_t)1024 * 256 * 2);
constexpr size_t WS_WREC = al256(WS_WOUT + (size_t)2 * 1024 * 1024 * 2);
constexpr size_t WS_WLORA = al256(WS_WREC + (size_t)REC_NP * 1024 * 2);
constexpr size_t WS_W1T = al256(WS_WLORA + (size_t)2560 * 384 * 2);
constexpr size_t WS_W2T = al256(WS_W1T + (size_t)NE * 2048 * 1024 * 2);
constexpr size_t WS_H = al256(WS_W2T + (size_t)NE * 1024 * 1024 * 2);
constexpr size_t WS_A = al256(WS_H + (size_t)R * 1024 * 4);
constexpr size_t WS_A1 = al256(WS_A + (size_t)R * 1024 * 2);
constexpr size_t WS_F = al256(WS_A1 + (size_t)R * 1024 * 2);
constexpr size_t WS_P = al256(WS_F + (size_t)R * 1024 * 2);
constexpr size_t WS_TOPE = al256(WS_P + (size_t)R * REC_NP * 2);
constexpr size_t WS_GATE = al256(WS_TOPE + (size_t)R * 16);
constexpr size_t WS_POS = al256(WS_GATE + (size_t)R * 16);
constexpr size_t WS_DEST = al256(WS_POS + (size_t)R * 16);
constexpr size_t WS_TILE = al256(WS_DEST + (size_t)R * 16);
constexpr size_t WS_T = al256(WS_TILE + (size_t)(MAXT + 8) * 4);
constexpr size_t WS_QD = WS_T;
constexpr size_t WS_KD = al256(WS_QD + (size_t)R * 512 * 2);
constexpr size_t WS_CQN = al256(WS_KD + (size_t)R * 512 * 2);
constexpr size_t WS_CKVN = al256(WS_CQN + (size_t)R * 384 * 2);
constexpr size_t WS_MQ = al256(WS_CKVN + (size_t)R * 256 * 2);
constexpr size_t WS_MKV = al256(WS_MQ + (size_t)R * 768 * 2);
constexpr size_t WS_KRR = al256(WS_MKV + (size_t)R * 1024 * 2);
constexpr size_t WS_ODIFF = al256(WS_KRR + (size_t)R * 32 * 2);
constexpr size_t WS_OMLA = al256(WS_ODIFF + (size_t)R * 1024 * 4);
constexpr size_t WS_T0_END = al256(WS_OMLA + (size_t)R * 512 * 4);
constexpr size_t WS_XS = WS_T;
constexpr size_t WS_HS = al256(WS_XS + (size_t)MAXROWS * 1024 * 2);
constexpr size_t WS_TM_END = al256(WS_HS + (size_t)MAXROWS * 1024 * 2);
constexpr size_t SZ_RC = (size_t)R * 512 * 4;
constexpr size_t WS_RR = WS_T, WS_VV = WS_RR + SZ_RC, WS_AKK = WS_VV + SZ_RC, WS_KL = WS_AKK + SZ_RC;
constexpr size_t WS_WDEC = WS_KL + SZ_RC  , WS_KDIR = WS_WDEC + 2 * SZ_RC  , WS_BB = WS_KDIR + 2 * SZ_RC  , WS_GG = WS_BB + 2 * SZ_RC;
constexpr size_t WS_ALORA = al256(WS_GG + SZ_RC);
constexpr size_t WS_YR = al256(WS_ALORA + (size_t)R * 384 * 2);
constexpr size_t WS_DC = WS_YR;
constexpr size_t WS_HM = al256(WS_YR + 2 * SZ_RC);
constexpr size_t WS_CST = al256(WS_HM + 2 * SZ_RC);
constexpr size_t WS_DN = al256(WS_CST + (size_t)NUNIT_M * 8192 * 4);
constexpr size_t WS_NST = al256(WS_DN + (size_t)NUNIT_M * 64 * 4);
constexpr size_t WS_SC = al256(WS_NST + (size_t)NUNIT_M * 64 * 4);
constexpr size_t WS_MST = al256(WS_SC + (size_t)NUNIT_M * 2 * 4);
constexpr size_t WS_T1_END = al256(WS_MST + (size_t)NUNIT_M * 4);
constexpr size_t WS_END = WS_T1_END > WS_TM_END ? (WS_T1_END > WS_T0_END ? WS_T1_END : WS_T0_END) : (WS_TM_END > WS_T0_END ? WS_TM_END : WS_T0_END);
static_assert(WS_END <= (size_t)2147483648ull, "workspace map exceeds 2 GiB");
constexpr int CW_CNT = 1024;
constexpr int CW_BAR = 4096;
constexpr int RING_BYTES = 131072, AUX_OFF = 131072, AUX_BYTES = 16384, MISC_OFF = 147456, LDS_BYTES = 163840;

struct Frame {
    LAS unsigned char* lds; gu32* ctl; int tid, lane, wave, blk, G, probe;
    float* out; unsigned char* ws;
    struct InTab { LAS const unsigned* t;
        __device__ __forceinline__ const float* operator[](int i) const { const unsigned lo = __builtin_amdgcn_readfirstlane(t[2 * i]), hi = __builtin_amdgcn_readfirstlane(t[2 * i + 1]);
            return (const float*)(((unsigned long long)hi << 32) | lo); } } in;
};
template <class T> __device__ __forceinline__ T* wsp(const Frame& F, size_t off) { return (T*)(F.ws + off); }
__device__ __forceinline__ int row_sel(int row) { const int b = row / TB, t = row - b * TB; return t < CT ? 2 : b; }
__device__ __forceinline__ const float* h0_row(const Frame& F, int row) {
    const int b = row / TB, t = row - b * TB;
    return t < CT ? F.in[I_CTX] + ((size_t)b * CT + t) * DM : F.in[I_X] + ((size_t)b * SEQ + (t - CT)) * DM;
}
__device__ __forceinline__ const float* modp(const Frame& F, int layer, int sel, int chunk) { return wsp<const float>(F, WS_MOD) + ((size_t)(layer * 3 + sel) * 6 + chunk) * DM; }
__device__ __forceinline__ int scan_tok(int z, int sg) { return z == 0 ? sg : (sg < CT ? CT - 1 - sg : TB + CT - 1 - sg); }
__device__ __forceinline__ void tr_item(const float* W, int K, int N, bf16* WT, int row_off, LAS float* scr, int kb, int nb, int lane) {
    const int k0 = 64 * kb, n0 = 32 * nb;
    const int n = n0 + (lane & 31);
#pragma unroll 8
    for (int i = 0; i < 32; ++i) { const int kk = 2 * i + (lane >> 5); scr[kk * 33 + (lane & 31)] = (n < N) ? W[(size_t)(k0 + kk) * N + n] : 0.f; }
    LDS_WAIT(); asm volatile("" ::: "memory");
    const int c = lane & 7;
#pragma unroll
    for (int j = 0; j < 4; ++j) { const int nn = (lane >> 3) + 8 * j; const LAS float* s = scr + (8 * c) * 33 + nn;
        v4u o; o.x = pk2(s[0 * 33], s[1 * 33]); o.y = pk2(s[2 * 33], s[3 * 33]); o.z = pk2(s[4 * 33], s[5 * 33]); o.w = pk2(s[6 * 33], s[7 * 33]);
        *(v4u*)(WT + (size_t)(row_off + n0 + nn) * K + k0 + 8 * c) = o; }
    LDS_WAIT(); asm volatile("" ::: "memory");
}
__device__ __forceinline__ void tr_family(const Frame& F, const float* W, size_t src_stride, int nmat, int K, int N, int Npad, bf16* WT, int gw, int NGW) {
    LAS float* scr = (LAS float*)(F.lds + F.wave * 16384);
    const int nkb = K / 64, nnb = Npad / 32, per = nkb * nnb, total = per * nmat;
    for (int it = gw; it < total; it += NGW) { const int m = it / per, r = it - m * per, kb = r / nnb, nb = r - kb * nnb;
        tr_item(W + (size_t)m * src_stride, K, N, WT, m * Npad, scr, kb, nb, F.lane); }
}
__device__ __forceinline__ void moe_weights_convert(const Frame& F, int layer, int gw, int NGW) {
    tr_family(F, F.in[I_W1] + (size_t)layer * NE * 1024 * 2048, (size_t)1024 * 2048, NE, 1024, 2048, 2048, wsp<bf16>(F, WS_W1T), gw, NGW);
    tr_family(F, F.in[I_W2] + (size_t)layer * NE * 1024 * 1024, (size_t)1024 * 1024, NE, 1024, 1024, 1024, wsp<bf16>(F, WS_W2T), gw, NGW);
}
__device__ __forceinline__ void norm_mod_row(const Frame& F, const float* src, const float* nw, const float* shift, const float* scale, bf16* orow) {
    const f32x4* xr = (const f32x4*)src + F.lane;
    f32x4 v[4]; float s = 0.f;
#pragma unroll
    for (int j = 0; j < 4; ++j) { v[j] = xr[64 * j]; s += (v[j].x * v[j].x + v[j].y * v[j].y) + (v[j].z * v[j].z + v[j].w * v[j].w); }
    const float rs = 1.f / sqrtf(wave_sum(s) * (1.f / DM) + NORM_EPS);
    unsigned long long* o8 = (unsigned long long*)orow + F.lane;
#pragma unroll
    for (int j = 0; j < 4; ++j) { const f32x4 w = ((const f32x4*)nw)[F.lane + 64 * j], sh = ((const f32x4*)shift)[F.lane + 64 * j], sc = ((const f32x4*)scale)[F.lane + 64 * j];
        const f32x4 y = v[j] * rs * w * (sc + 1.f) + sh;
        o8[64 * j] = (unsigned long long)pk2(y.x, y.y) | ((unsigned long long)pk2(y.z, y.w) << 32); }
}
__device__ __forceinline__ void p0a(const Frame& F) {
    LAS float* sv = (LAS float*)F.lds; LAS float* red = (LAS float*)(F.lds + 16384);
    for (int i = F.tid; i < 3 * DM; i += 512) { const int s = i / DM, k = i - s * DM; const float cv = (s < 2) ? F.in[I_C][s * DM + k] : F.in[I_CCTX][k]; sv[i] = cv / (1.f + __expf(-cv)); }
    __syncthreads();
    for (int it = F.blk; it < 192; it += F.G) {
        const int l = it / 96, cgp = it - l * 96, kq = F.tid >> 4, cg = F.tid & 15, col = cgp * 64 + cg * 4;
        float acc[3][4];
#pragma unroll
        for (int s = 0; s < 3; ++s)
#pragma unroll
            for (int j = 0; j < 4; ++j) acc[s][j] = 0.f;
        const float* W = F.in[I_ADAW] + (size_t)l * DM * 6144 + col;
        for (int kk = 0; kk < 32; ++kk) { const int k = kq * 32 + kk; const f32x4 w = *(const f32x4*)(W + (size_t)k * 6144);
            const float s0 = sv[k], s1 = sv[DM + k], s2 = sv[2 * DM + k];
#pragma unroll
            for (int j = 0; j < 4; ++j) { acc[0][j] += s0 * w[j]; acc[1][j] += s1 * w[j]; acc[2][j] += s2 * w[j]; } }
#pragma unroll
        for (int s = 0; s < 3; ++s)
#pragma unroll
            for (int j = 0; j < 4; ++j) red[(kq * 16 + cg) * 12 + s * 4 + j] = acc[s][j];
        __syncthreads();
        if (F.tid < 192) { const int s = F.tid / 64, cc = F.tid - s * 64, cg2 = cc >> 2, j = cc & 3; float t = 0.f;
            for (int q = 0; q < 32; ++q) t += red[(q * 16 + cg2) * 12 + s * 4 + j];
            wsp<float>(F, WS_MOD)[(size_t)(l * 3 + s) * 6144 + cgp * 64 + cc] = t + F.in[I_ADAB][l * 6144 + cgp * 64 + cc]; }
        __syncthreads();
    }
    const int gid = F.blk * 512 + F.tid, GT = F.G * 512;
    float* rope = wsp<float>(F, WS_ROPE);
    for (int i = gid; i < 256 * 16 + 64 * 16 + 256 * 8 + 64 * 8; i += GT) {
        int j = i; float pos, inv; size_t off;
        if (j < 256 * 16) { pos = (float)(j / 16); inv = powf(10000.f, -(float)(j % 16) / 16.f); off = ROPE_DR + (size_t)j * 2; }
        else if ((j -= 256 * 16) < 64 * 16) { pos = (float)(j / 16); inv = powf(10000.f, -(float)(j % 16) / 16.f); off = ROPE_DC + (size_t)j * 2; }
        else if ((j -= 64 * 16) < 256 * 8) { pos = (float)(j / 8); inv = powf(10000.f, -(float)(j % 8) / 8.f); off = ROPE_MR + (size_t)j * 2; }
        else { j -= 256 * 8; pos = (float)(j / 8); inv = powf(10000.f, -(float)(j % 8) / 8.f); off = ROPE_MC + (size_t)j * 2; }
        const float ang = pos * inv; rope[off] = cosf(ang); rope[off + 1] = sinf(ang);
    }
    bf16* WL = wsp<bf16>(F, WS_WLORA);
    for (int i = gid; i < 2560 * 384; i += GT) { const int n = i / 384, k = i - n * 384, part = n >> 9, c = n & 511; float v = 0.f;
        if (part < 2) { if ((k >> 6) == part) v = F.in[I_RW2][((size_t)part * 64 + (k & 63)) * 512 + c]; }
        else if (part < 4) { if ((k >> 6) == part) v = F.in[I_A2][((size_t)(part - 2) * 64 + (k & 63)) * 512 + c]; }
        else { if (k >= 256) v = F.in[I_G2][(size_t)(k - 256) * 512 + c]; }
        WL[i] = (bf16)f2bf(v); }
    const int gw = F.blk * 8 + F.wave, NGW = F.G * 8;
    tr_family(F, F.in[I_ATTW], 0, 1, 1024, ATT_IN, ATT_NP, wsp<bf16>(F, WS_WIN0), gw, NGW);
    tr_family(F, F.in[I_WUQ], 0, 1, 384, 768, 768, wsp<bf16>(F, WS_WUQ), gw, NGW);
    tr_family(F, F.in[I_WUKV], 0, 1, 256, 1024, 1024, wsp<bf16>(F, WS_WUKV), gw, NGW);
    tr_family(F, F.in[I_WOUT], (size_t)1024 * 1024, 2, 1024, 1024, 1024, wsp<bf16>(F, WS_WOUT), gw, NGW);
    tr_family(F, F.in[I_RECW], 0, 1, 1024, REC_IN, REC_NP, wsp<bf16>(F, WS_WREC), gw, NGW);
    moe_weights_convert(F, 0, gw, NGW);
}
__device__ __forceinline__ void p0b(const Frame& F) {
    const int gw = F.blk * 8 + F.wave, NGW = F.G * 8;
    for (int row = gw; row < R; row += NGW) { const int sel = row_sel(row);
        norm_mod_row(F, h0_row(F, row), F.in[I_NMIX], modp(F, 0, sel, 0), modp(F, 0, sel, 1), wsp<bf16>(F, WS_A) + (size_t)row * DM); }
}
struct FnStoreBf16 {
    bf16* O; int ldc;
    __device__ __forceinline__ void operator()(int row, int col, f32x4 v0, f32x4 v1) const {
        v4u w; w.x = pg8::cvt_pk_bf16(v0[0], v0[1]); w.y = pg8::cvt_pk_bf16(v0[2], v0[3]); w.z = pg8::cvt_pk_bf16(v1[0], v1[1]); w.w = pg8::cvt_pk_bf16(v1[2], v1[3]);
        *(v4u*)(O + (size_t)row * ldc + col) = w; }
};
struct FnWout {
    const Frame* F; int layer;
    __device__ __forceinline__ void operator()(int row, int col, f32x4 v0, f32x4 v1) const {
        float* hrow = wsp<float>(*F, WS_H) + (size_t)row * DM + col;
        const float* base = (layer == 0) ? h0_row(*F, row) + col : hrow;
        const float* g = modp(*F, layer, row_sel(row), 2) + col;
        const f32x4 b0 = *(const f32x4*)base, b1 = *(const f32x4*)(base + 4), g0 = *(const f32x4*)g, g1 = *(const f32x4*)(g + 4);
        *(f32x4*)hrow = b0 + g0 * v0; *(f32x4*)(hrow + 4) = b1 + g1 * v1; }
};
__device__ __forceinline__ void l0_post_proj(const Frame& F) {
    const int gw = F.blk * 8 + F.wave, NGW = F.G * 8, lane = F.lane;
    const bf16* P = wsp<const bf16>(F, WS_P); const float* rope = wsp<const float>(F, WS_ROPE);
    constexpr float CD = 0.125f * 1.4426950408889634f;
    for (int row = gw; row < R; row += NGW) {
        const int b = row / TB, t = row - b * TB; const bool lat = t >= CT; const int pos = t - CT, prow = lat ? pos >> 6 : 0, pcol = lat ? pos & 63 : 0;
        const bf16* p = P + (size_t)row * ATT_NP;
        bf16* qd = wsp<bf16>(F, WS_QD) + (size_t)row * 512; bf16* kd = wsp<bf16>(F, WS_KD) + (size_t)row * 512;
#pragma unroll
        for (int j = 0; j < 8; ++j) { const int pr = lane + 64 * j, h16 = pr >> 5, i = pr & 31;
            const float x1 = bf2f(p[h16 * 64 + i]), x2 = bf2f(p[h16 * 64 + i + 32]); float c = 1.f, s = 0.f;
            if (lat) { const float* tb = (i < 16) ? rope + ROPE_DR + (size_t)(prow * 16 + i) * 2 : rope + ROPE_DC + (size_t)(pcol * 16 + i - 16) * 2; c = tb[0]; s = tb[1]; }
            float y1 = x1 * c - x2 * s, y2 = x1 * s + x2 * c;
            if (h16 < 8) { qd[h16 * 64 + i] = (bf16)f2bf(y1 * CD); qd[h16 * 64 + i + 32] = (bf16)f2bf(y2 * CD); }
            else { kd[(h16 - 8) * 64 + i] = (bf16)f2bf(y1); kd[(h16 - 8) * 64 + i + 32] = (bf16)f2bf(y2); } }
        { float x[6]; float ss = 0.f;
#pragma unroll
          for (int j = 0; j < 6; ++j) { x[j] = bf2f(p[1536 + lane + 64 * j]); ss += x[j] * x[j]; }
          const float rs = 1.f / sqrtf(wave_sum(ss) * (1.f / 384.f) + NORM_EPS); bf16* o = wsp<bf16>(F, WS_CQN) + (size_t)row * 384;
#pragma unroll
          for (int j = 0; j < 6; ++j) o[lane + 64 * j] = (bf16)f2bf(x[j] * rs * F.in[I_QNW][lane + 64 * j]); }
        { float x[4]; float ss = 0.f;
#pragma unroll
          for (int j = 0; j < 4; ++j) { x[j] = bf2f(p[1920 + lane + 64 * j]); ss += x[j] * x[j]; }
          const float rs = 1.f / sqrtf(wave_sum(ss) * (1.f / 256.f) + NORM_EPS); bf16* o = wsp<bf16>(F, WS_CKVN) + (size_t)row * 256;
#pragma unroll
          for (int j = 0; j < 4; ++j) o[lane + 64 * j] = (bf16)f2bf(x[j] * rs * F.in[I_KVNW][lane + 64 * j]); }
        if (lane < 16) { const int i = lane; const float x1 = bf2f(p[2176 + i]), x2 = bf2f(p[2176 + i + 16]); float c = 1.f, s = 0.f;
            if (lat) { const float* tb = (i < 8) ? rope + ROPE_MR + (size_t)(prow * 8 + i) * 2 : rope + ROPE_MC + (size_t)(pcol * 8 + i - 8) * 2; c = tb[0]; s = tb[1]; }
            bf16* o = wsp<bf16>(F, WS_KRR) + (size_t)row * 32; o[i] = (bf16)f2bf(x1 * c - x2 * s); o[i + 16] = (bf16)f2bf(x1 * s + x2 * c); }
    }
}
__device__ __forceinline__ void l0_mq_rope(const Frame& F) {
    const int gw = F.blk * 8 + F.wave, NGW = F.G * 8, lane = F.lane; const float* rope = wsp<const float>(F, WS_ROPE);
    const float CM = 0.10206207261596575f * 1.4426950408889634f;
    for (int row = gw; row < R; row += NGW) {
        const int b = row / TB, t = row - b * TB; const bool lat = t >= CT; const int pos = t - CT, prow = lat ? pos >> 6 : 0, pcol = lat ? pos & 63 : 0;
        bf16* q = wsp<bf16>(F, WS_MQ) + (size_t)row * 768;
#pragma unroll
        for (int j = 0; j < 8; ++j) { const int idx = lane + 64 * j, h = idx >> 6, d = idx & 63; q[h * 96 + d] = (bf16)f2bf(bf2f(q[h * 96 + d]) * CM); }
#pragma unroll
        for (int j = 0; j < 2; ++j) { const int pr = lane + 64 * j, h = pr >> 4, i = pr & 15; const float x1 = bf2f(q[h * 96 + 64 + i]), x2 = bf2f(q[h * 96 + 80 + i]); float c = 1.f, s = 0.f;
            if (lat) { const float* tb = (i < 8) ? rope + ROPE_MR + (size_t)(prow * 8 + i) * 2 : rope + ROPE_MC + (size_t)(pcol * 8 + i - 8) * 2; c = tb[0]; s = tb[1]; }
            q[h * 96 + 64 + i] = (bf16)f2bf((x1 * c - x2 * s) * CM); q[h * 96 + 80 + i] = (bf16)f2bf((x1 * s + x2 * c) * CM); }
    }
}
__device__ __forceinline__ void l0_attention(const Frame& F) {
    LAS char* lds = (LAS char*)F.lds;
    const bf16* QD = wsp<const bf16>(F, WS_QD); const bf16* KD = wsp<const bf16>(F, WS_KD); const bf16* P = wsp<const bf16>(F, WS_P);
    const bf16* MQ = wsp<const bf16>(F, WS_MQ); const bf16* MKV = wsp<const bf16>(F, WS_MKV); const bf16* KRR = wsp<const bf16>(F, WS_KRR);
    float* OD = wsp<float>(F, WS_ODIFF); float* OM = wsp<float>(F, WS_OMLA);
    for (int kind = 0; kind < 2; ++kind) {
        for (int L = F.blk; L < 1024 + 16; L += F.G) {
            int b, h8, qb, nkeys;
            if (L < 1024) { int pair;
                if (F.G == 256) { const int round = L >> 8, c = L & 255; pair = round * 4 + ((c & 7) >> 1); qb = 1 + (c & 1) * 32 + (c >> 3); }
                else { pair = L >> 6; qb = 1 + (L & 63); }
                b = pair >> 3; h8 = pair & 7; nkeys = TB; }
            else { const int s = L - 1024; b = s >> 3; h8 = s & 7; qb = 0; nkeys = CT; }
            const size_t q0 = (size_t)b * TB + (size_t)qb * 256, k0 = (size_t)b * TB;
            if (kind == 0)
                att::attn_unit<64, 128>(QD + q0 * 512 + h8 * 64, 512, KD + k0 * 512 + h8 * 64, 512, nullptr, 0, P + k0 * ATT_NP + 1024 + (h8 >> 1) * 128, ATT_NP,
                                        OD + q0 * 1024 + h8 * 128, 1024, nkeys, lds);
            else
                att::attn_unit<96, 64>(MQ + q0 * 768 + h8 * 96, 768, MKV + k0 * 1024 + h8 * 128, 1024, KRR + k0 * 32, 32, MKV + k0 * 1024 + h8 * 128 + 64, 1024,
                                       OM + q0 * 512 + h8 * 64, 512, nkeys, lds);
        }
    }
}
__device__ __forceinline__ void l0_combine(const Frame& F) {
    const int gw = F.blk * 8 + F.wave, NGW = F.G * 8, lane = F.lane;
    const float* lv = F.in[I_LAM];
    const float lam = __expf(wave_sum(lv[lane] * lv[64 + lane])) - __expf(wave_sum(lv[128 + lane] * lv[192 + lane])) + 0.2f;
    const float sw0 = F.in[I_SUBLN][2 * lane] * 0.8f, sw1 = F.in[I_SUBLN][2 * lane + 1] * 0.8f;
    for (int row = gw; row < R; row += NGW) {
        const float* od = wsp<const float>(F, WS_ODIFF) + (size_t)row * 1024; const float* om = wsp<const float>(F, WS_OMLA) + (size_t)row * 512;
        bf16* a1 = wsp<bf16>(F, WS_A1) + (size_t)row * DM;
#pragma unroll
        for (int h = 0; h < 4; ++h) {
            const float o1a = od[(2 * h) * 128 + 2 * lane], o1b = od[(2 * h) * 128 + 2 * lane + 1], o2a = od[(2 * h + 1) * 128 + 2 * lane], o2b = od[(2 * h + 1) * 128 + 2 * lane + 1];
            const float da = o1a - lam * o2a, db = o1b - lam * o2b;
            const float rs = 1.f / sqrtf(wave_sum(da * da + db * db) * (1.f / 128.f) + NORM_EPS);
            *(unsigned*)(a1 + h * 128 + 2 * lane) = pk2(da * rs * sw0, db * rs * sw1); }
#pragma unroll
        for (int j = 0; j < 2; ++j) { const f32x4 v = *(const f32x4*)(om + 4 * (lane + 64 * j)); v2u w; w.x = pk2(v.x, v.y); w.y = pk2(v.z, v.w); *(v2u*)(a1 + 512 + 4 * (lane + 64 * j)) = w; }
    }
}
constexpr int RT_MAXROWS = 24;
__device__ __forceinline__ void ph_router(const Frame& F, int layer) {
    LAS float* Wr = (LAS float*)F.lds;
    LAS float* fst = (LAS float*)(F.lds + AUX_OFF) + F.wave * 512;
    LAS int* hist = (LAS int*)(F.lds + MISC_OFF + 256);
    LAS int* recs = hist + 64 + F.wave * (RT_MAXROWS * 4);
    const int lane = F.lane, gw = F.blk * 8 + F.wave, NGW = F.G * 8;
    { const f32x4* src = (const f32x4*)(F.in[I_RW] + (size_t)layer * DM * NE);
      for (int i = F.tid; i < DM * NE / 4; i += 512) ((LAS f32x4*)Wr)[i] = src[i];
      if (F.tid < 64) hist[F.tid] = 0; }
    __syncthreads();
    const float* nw = F.in[I_NFFN] + (size_t)layer * DM; const float rb = F.in[I_RB][layer * NE + (lane & 31)];
    int ri = 0;
    for (int row = gw; row < R; row += NGW, ++ri) {
        const int sel = row_sel(row); const float* sh = modp(F, layer, sel, 3); const float* sc = modp(F, layer, sel, 4);
        const f32x4* xr = (const f32x4*)(wsp<const float>(F, WS_H) + (size_t)row * DM) + lane;
        f32x4 v[4]; float s = 0.f;
#pragma unroll
        for (int j = 0; j < 4; ++j) { v[j] = xr[64 * j]; s += (v[j].x * v[j].x + v[j].y * v[j].y) + (v[j].z * v[j].z + v[j].w * v[j].w); }
        const float rs = 1.f / sqrtf(wave_sum(s) * (1.f / DM) + NORM_EPS);
        unsigned long long* o8 = (unsigned long long*)(wsp<bf16>(F, WS_F) + (size_t)row * DM) + lane;
#pragma unroll
        for (int j = 0; j < 4; ++j) { const f32x4 w = ((const f32x4*)nw)[lane + 64 * j], a = ((const f32x4*)sh)[lane + 64 * j], c = ((const f32x4*)sc)[lane + 64 * j];
            v[j] = v[j] * rs * w * (c + 1.f) + a;
            o8[64 * j] = (unsigned long long)pk2(v[j].x, v[j].y) | ((unsigned long long)pk2(v[j].z, v[j].w) << 32); }
        float acc0 = 0.f, acc1 = 0.f, acc2 = 0.f, acc3 = 0.f; const int e = lane & 31, hf = lane >> 5;
#pragma unroll
        for (int ps = 0; ps < 2; ++ps) {
            ((LAS f32x4*)fst)[lane] = v[2 * ps]; ((LAS f32x4*)fst)[64 + lane] = v[2 * ps + 1];
            LDS_WAIT(); asm volatile("" ::: "memory");
            const LAS float* wp = Wr + (size_t)(512 * ps + 256 * hf) * NE + e; const LAS f32x4* fp = (const LAS f32x4*)(fst + 256 * hf);
#pragma unroll 8
            for (int k4 = 0; k4 < 64; ++k4) { const f32x4 f4 = fp[k4];
                acc0 += f4.x * wp[(4 * k4) * NE]; acc1 += f4.y * wp[(4 * k4 + 1) * NE]; acc2 += f4.z * wp[(4 * k4 + 2) * NE]; acc3 += f4.w * wp[(4 * k4 + 3) * NE]; }
            LDS_WAIT(); asm volatile("" ::: "memory");
        }
        const float acc = (acc0 + acc1) + (acc2 + acc3); float logit = acc + __shfl_xor(acc, 32) + rb;
        float selv[4]; int seli[4]; float val = logit;
#pragma unroll
        for (int r = 0; r < 4; ++r) { float bv = val; int bi = e;
#pragma unroll
            for (int o = 1; o < 32; o <<= 1) { const float ov = __shfl_xor(bv, o); const int oi = __shfl_xor(bi, o); if (ov > bv || (ov == bv && oi < bi)) { bv = ov; bi = oi; } }
            selv[r] = bv; seli[r] = bi; if (e == bi) val = -3.0e38f; }
        float ex[4], es = 0.f;
#pragma unroll
        for (int r = 0; r < 4; ++r) { ex[r] = __expf(selv[r] - selv[0]); es += ex[r]; }
        if (lane < 4) { const int r = lane; const int ee = r == 0 ? seli[0] : r == 1 ? seli[1] : r == 2 ? seli[2] : seli[3]; const float gg = (r == 0 ? ex[0] : r == 1 ? ex[1] : r == 2 ? ex[2] : ex[3]) / es;
            wsp<int>(F, WS_TOPE)[(size_t)row * 4 + r] = ee; wsp<float>(F, WS_GATE)[(size_t)row * 4 + r] = gg;
            const int rk = __hip_atomic_fetch_add(&hist[ee], 1, __ATOMIC_RELAXED, __HIP_MEMORY_SCOPE_WORKGROUP);
            if (ri < RT_MAXROWS) recs[ri * 4 + r] = ee | (rk << 8); }
    }
    __syncthreads();
    if (F.tid < NE) hist[32 + F.tid] = (int)__hip_atomic_fetch_add(F.ctl + CW_CNT + 64 * (layer + 2 * F.probe) + F.tid, (unsigned)hist[F.tid], RLX_AGENT);
    __syncthreads();
    ri = 0;
    for (int row = gw; row < R; row += NGW, ++ri)
        if (lane < 4 && ri < RT_MAXROWS) { const int rc = recs[ri * 4 + lane]; wsp<int>(F, WS_POS)[(size_t)row * 4 + lane] = hist[32 + (rc & 255)] + (rc >> 8); }
}
__device__ __forceinline__ void moe_tables(const Frame& F, int layer, LAS int* ps, LAS int* tile_e) {
    if (F.tid == 0) { int acc = 0, t = 0;
        for (int e = 0; e < NE; ++e) { const int c = (int)__hip_atomic_load(F.ctl + CW_CNT + 64 * layer + e, RLX_AGENT); ps[e] = acc; const int nt = (c + 255) >> 8;
            for (int i = 0; i < nt && t < MAXT; ++i) tile_e[t++] = e; acc += nt * 256; }
        ps[NE] = acc; ps[NE + 1] = t; }
    __syncthreads();
}
__device__ __forceinline__ void ph_gather(const Frame& F, int layer) {
    LAS int* ps = (LAS int*)(F.lds + MISC_OFF + 256); LAS int* tile_e = ps + 64;
    moe_tables(F, layer, ps, tile_e);
    if (F.blk == 0) { int* tab = wsp<int>(F, WS_TILE); const int nt = ps[NE + 1]; if (F.tid == 0) tab[0] = nt; for (int i = F.tid; i < nt; i += 512) tab[1 + i] = tile_e[i]; }
    const int lane = F.lane, gw = F.blk * 8 + F.wave, NGW = F.G * 8;
    for (int row = gw; row < R; row += NGW) {
        int dest = 0;
        if (lane < 4) { const int e = wsp<const int>(F, WS_TOPE)[(size_t)row * 4 + lane]; dest = ps[e] + wsp<const int>(F, WS_POS)[(size_t)row * 4 + lane]; wsp<int>(F, WS_DEST)[(size_t)row * 4 + lane] = dest; }
        const v4u* src = (const v4u*)(wsp<const bf16>(F, WS_F) + (size_t)row * DM); const v4u a = src[lane], b = src[64 + lane];
#pragma unroll
        for (int r = 0; r < 4; ++r) { const int d = __shfl(dest, r); v4u* dst = (v4u*)(wsp<bf16>(F, WS_XS) + (size_t)d * DM); dst[lane] = a; dst[64 + lane] = b; }
    }
}
struct MoeOrder {
    const int* tile_e; int ntiles, nN, G, c;
    __device__ __forceinline__ bool next(int i, pg8::Unit& u) const {
        const long L = (long)i * G + c; if (L >= (long)ntiles * nN) return false;
        const int rt = (int)(L / nN), pl = (int)(L - (long)rt * nN); const int e = __builtin_amdgcn_readfirstlane(tile_e[rt]);
        u.pm = rt; u.pn = e * nN + pl; return true; }
    __device__ __forceinline__ void a_ready(const pg8::Unit&) const {}
    __device__ __forceinline__ void done(const pg8::Unit&) const {}
};
struct FnSwiglu {
    bf16* HS; const float* b1;
    __device__ __forceinline__ void operator()(int row, int col, f32x4 v0, f32x4 v1) const {
        const float* bp = b1 + col;
        const f32x4 b0 = *(const f32x4*)bp, b1v = *(const f32x4*)(bp + 4); v0 = v0 + b0; v1 = v1 + b1v;
        const float hv[8] = {v0[0], v0[1], v0[2], v0[3], v1[0], v1[1], v1[2], v1[3]}; float o[4];
#pragma unroll
        for (int i = 0; i < 4; ++i) { const float g = hv[2 * i], l = hv[2 * i + 1];
            const float gl = fminf(g, 7.f), li = fminf(fmaxf(l, -7.f), 7.f); o[i] = gl * sigmoidf_(1.702f * gl) * (li + 1.f); }
        const int lc = col & 2047; v2u w; w.x = pk2(o[0], o[1]); w.y = pk2(o[2], o[3]);
        *(v2u*)(HS + (size_t)row * 1024 + (lc >> 1)) = w; }
};
struct FnBiasBf16 {
    bf16* YS; const float* b2;
    __device__ __forceinline__ void operator()(int row, int col, f32x4 v0, f32x4 v1) const {
        const f32x4 b0 = *(const f32x4*)(b2 + col), b1v = *(const f32x4*)(b2 + col + 4); v0 = v0 + b0; v1 = v1 + b1v;
        v4u w; w.x = pk2(v0[0], v0[1]); w.y = pk2(v0[2], v0[3]); w.z = pk2(v1[0], v1[1]); w.w = pk2(v1[2], v1[3]);
        *(v4u*)(YS + (size_t)row * 1024 + (col & 1023)) = w; }
};
__device__ __forceinline__ void ph_combine(const Frame& F, int layer) {
    const int lane = F.lane, gw = F.blk * 8 + F.wave, NGW = F.G * 8;
    for (int row = gw; row < R; row += NGW) {
        const int sel = row_sel(row); const float* gf = modp(F, layer, sel, 5);
        float* hrow = wsp<float>(F, WS_H) + (size_t)row * DM;
        f32x4 y[4];
#pragma unroll
        for (int j = 0; j < 4; ++j) y[j] = (f32x4){0.f, 0.f, 0.f, 0.f};
#pragma unroll
        for (int r = 0; r < 4; ++r) { const int d = wsp<const int>(F, WS_DEST)[(size_t)row * 4 + r]; const float g = wsp<const float>(F, WS_GATE)[(size_t)row * 4 + r];
            const v2u* yp = (const v2u*)(wsp<const bf16>(F, WS_XS) + (size_t)d * DM);
#pragma unroll
            for (int j = 0; j < 4; ++j) { const v2u w = yp[lane + 64 * j]; y[j] += g * (f32x4){bflo(w.x), bfhi(w.x), bflo(w.y), bfhi(w.y)}; } }
        f32x4 h[4]; float s = 0.f;
#pragma unroll
        for (int j = 0; j < 4; ++j) { h[j] = ((const f32x4*)hrow)[lane + 64 * j] + ((const f32x4*)gf)[lane + 64 * j] * y[j]; s += (h[j].x * h[j].x + h[j].y * h[j].y) + (h[j].z * h[j].z + h[j].w * h[j].w); }
        const float rs = 1.f / sqrtf(wave_sum(s) * (1.f / DM) + NORM_EPS);
        if (layer == 0) {
#pragma unroll
            for (int j = 0; j < 4; ++j) ((f32x4*)hrow)[lane + 64 * j] = h[j];
            const float* nw = F.in[I_NMIX] + DM; const float* sh = modp(F, 1, sel, 0); const float* sc = modp(F, 1, sel, 1);
            unsigned long long* o8 = (unsigned long long*)(wsp<bf16>(F, WS_A) + (size_t)row * DM) + lane;
#pragma unroll
            for (int j = 0; j < 4; ++j) { const f32x4 w = ((const f32x4*)nw)[lane + 64 * j], a = ((const f32x4*)sh)[lane + 64 * j], c = ((const f32x4*)sc)[lane + 64 * j];
                const f32x4 o = h[j] * rs * w * (c + 1.f) + a; o8[64 * j] = (unsigned long long)pk2(o.x, o.y) | ((unsigned long long)pk2(o.z, o.w) << 32); }
        } else {
            const int b = row / TB, t = row - b * TB;
            if (t >= CT) { float* orow = F.out + ((size_t)b * SEQ + (t - CT)) * DM; const float* nw = F.in[I_FNW];
#pragma unroll
                for (int j = 0; j < 4; ++j) ((f32x4*)orow)[lane + 64 * j] = h[j] * rs * ((const f32x4*)nw)[lane + 64 * j]; }
        }
    }
}
constexpr int PC_Q = 1920, PC_K = 2176, PC_V = 2432, PC_O = 2944, PC_G = 3456;
__device__ __forceinline__ float softplusf_(float y) { return fmaxf(y, 0.f) + __logf(1.f + __expf(-fabsf(y))); }
__device__ __forceinline__ float tanhf_(float x) { return 1.f - 2.f / (1.f + __expf(2.f * x)); }
__device__ __forceinline__ void unpack8(v4u w, float (&x)[8]) { x[0] = bflo(w.x); x[1] = bfhi(w.x); x[2] = bflo(w.y); x[3] = bfhi(w.y); x[4] = bflo(w.z); x[5] = bfhi(w.z); x[6] = bflo(w.w); x[7] = bfhi(w.w); }
__device__ __forceinline__ void lerp8(const bf16* p, bool hp, bool hn, int c0, const float* mu, float (&u)[8]) {
    const v4u z4 = {0u, 0u, 0u, 0u};
    const v4u wx = *(const v4u*)(p + c0), wp = hp ? *(const v4u*)(p - REC_NP + c0) : z4, wn = hn ? *(const v4u*)(p + REC_NP + c0) : z4;
    float x[8], xp[8], xn[8]; unpack8(wx, x); unpack8(wp, xp); unpack8(wn, xn);
    const f32x4 m0 = *(const f32x4*)(mu + c0), m1 = *(const f32x4*)(mu + c0 + 4);
#pragma unroll
    for (int e = 0; e < 8; ++e) { const float m = e < 4 ? m0[e & 3] : m1[e & 3]; u[e] = x[e] + m * (0.5f * (xp[e] + xn[e]) - x[e]); }
}
__device__ __forceinline__ void st8f(float* o, const float (&u)[8]) { *(f32x4*)o = (f32x4){u[0], u[1], u[2], u[3]}; *(f32x4*)(o + 4) = (f32x4){u[4], u[5], u[6], u[7]}; }
__device__ __forceinline__ void l1_rwkv_prep(const Frame& F) {
    const int gw = F.blk * 8 + F.wave, NGW = F.G * 8, lane = F.lane; const float* mu = F.in[I_MU];
    for (int row = gw; row < R; row += NGW) {
        const int b = row / TB, t = row - b * TB; const bool hp = (t != 0 && t != CT), hn = (t != CT - 1 && t != TB - 1);
        const bf16* p = wsp<const bf16>(F, WS_P) + (size_t)row * REC_NP; const size_t ro = (size_t)row * 512 + 8 * lane;
        float u[8];
        lerp8(p, hp, hn, 8 * lane, mu, u); st8f(wsp<float>(F, WS_RR) + ro, u);
        lerp8(p, hp, hn, 1024 + 8 * lane, mu, u); st8f(wsp<float>(F, WS_VV) + ro, u);
        lerp8(p, hp, hn, 512 + 8 * lane, mu, u); st8f(wsp<float>(F, WS_KL) + ro, u);
        { const f32x4 k0 = *(const f32x4*)(F.in[I_KK] + 8 * lane), k1 = *(const f32x4*)(F.in[I_KK] + 8 * lane + 4); float ss = 0.f;
#pragma unroll
          for (int e = 0; e < 8; ++e) { u[e] *= (e < 4 ? k0[e & 3] : k1[e & 3]); ss += u[e] * u[e]; }
          ss += __shfl_xor(ss, 1); ss += __shfl_xor(ss, 2); ss += __shfl_xor(ss, 4);
          const float inv = -1.f / sqrtf(fmaxf(ss, 1e-24f));
#pragma unroll
          for (int e = 0; e < 8; ++e) u[e] *= inv;
          st8f(wsp<float>(F, WS_AKK) + ro, u); }
        if (lane < 48) { lerp8(p, hp, hn, 1536 + 8 * lane, mu, u);
#pragma unroll
            for (int e = 0; e < 8; ++e) u[e] = lane < 16 ? tanhf_(u[e]) : (lane < 32 ? u[e] : sigmoidf_(u[e]));
            v4u w; w.x = pk2(u[0], u[1]); w.y = pk2(u[2], u[3]); w.z = pk2(u[4], u[5]); w.w = pk2(u[6], u[7]);
            *(v4u*)(wsp<bf16>(F, WS_ALORA) + (size_t)row * 384 + 8 * lane) = w; }
    }
}
struct EpiLora {
    static constexpr bool PERM = true, AFTER_DRAIN = false;
    const Frame* F;
    template <int KIND> __device__ __forceinline__ void run(const pg8::f32x4 (&acc)[2][2][4][2], const pg8::Unit& u, int wr, int wc, int fr, int fq, int z) const {
#pragma unroll
        for (int ai = 0; ai < 2; ++ai)
#pragma unroll
            for (int m = 0; m < 4; ++m) { const int row = u.pm * 256 + ai * 128 + wr * 64 + m * 16 + fr;
#pragma unroll
                for (int bj = 0; bj < 2; ++bj) { const int c = ((u.pn & 1) * 256) + bj * 128 + wc * 32 + 8 * fq; const size_t ro = (size_t)row * 512 + c;
                    const pg8::f32x4 v0 = acc[ai][bj][m][0], v1 = acc[ai][bj][m][1]; const float x[8] = {v0[0], v0[1], v0[2], v0[3], v1[0], v1[1], v1[2], v1[3]}; float o[8];
                    if constexpr (KIND == 0) { const float* w0 = F->in[I_W0] + z * 512 + c;
#pragma unroll
                        for (int e = 0; e < 8; ++e) { const float wl = -softplusf_(-(w0[e] + x[e])) - 0.5f; o[e] = __expf(-__expf(wl)); }
                        st8f(wsp<float>(*F, WS_WDEC) + (size_t)z * R * 512 + ro, o); }
                    else if constexpr (KIND == 1) { const float* a0 = F->in[I_A0] + z * 512 + c; const float* ka = F->in[I_KA] + c;
                        const float* kl = wsp<const float>(*F, WS_KL) + ro; const float* ak = wsp<const float>(*F, WS_AKK) + ro; float o2[8];
#pragma unroll
                        for (int e = 0; e < 8; ++e) { const float a = sigmoidf_(a0[e] + x[e]); o[e] = kl[e] * (1.f + (a - 1.f) * ka[e]); o2[e] = -ak[e] * a; }
                        st8f(wsp<float>(*F, WS_KDIR) + (size_t)z * R * 512 + ro, o); st8f(wsp<float>(*F, WS_BB) + (size_t)z * R * 512 + ro, o2); }
                    else st8f(wsp<float>(*F, WS_GG) + ro, x); } }
    }
    __device__ __forceinline__ void operator()(const pg8::f32x4 (&acc)[2][2][4][2], const pg8::Unit& u, int wr, int wc, int fr, int fq) const {
        const int part = u.pn >> 1;
        if (part < 2) run<0>(acc, u, wr, wc, fr, fq, part); else if (part < 4) run<1>(acc, u, wr, wc, fr, fq, part - 2); else run<2>(acc, u, wr, wc, fr, fq, 0);
    }
};
__device__ __forceinline__ void mlstm_gates(const Frame& F, int row, int z, int h, float& ig, float& lf) {
    const bf16* g = wsp<const bf16>(F, WS_P) + (size_t)row * REC_NP + PC_G + z * 8 + h; const float* gb = F.in[I_GATEB] + z * 8 + h;
    const float gi = bf2f(g[0]) + gb[0], gf = bf2f(g[4]) + gb[4];
    ig = 15.f * tanhf_(gi * (1.f / 15.f)); const float cf = 15.f * tanhf_(gf * (1.f / 15.f)); lf = fminf(cf, 0.f) - __logf(1.f + __expf(-fabsf(cf)));
}
__device__ __forceinline__ void mlstm_chunk_head(const Frame& F, int z, int b, int h, int c, LAS float* vec) {
    LAS int* rows = (LAS int*)vec;
    if (F.tid < 64) { const int s = F.tid, row = b * TB + scan_tok(z, 64 * c + s); float ig, lf; mlstm_gates(F, row, z, h, ig, lf); rows[s] = row; vec[64 + s] = ig; vec[192 + s] = lf; }
    __syncthreads();
    if (F.tid < 64) { float a = 0.f; for (int s = 0; s <= F.tid; ++s) a += vec[192 + s]; vec[128 + F.tid] = a; }
    __syncthreads();
}
__device__ __forceinline__ void l1_mlstm_a(const Frame& F) {
    LAS float* Ks = (LAS float*)F.lds; LAS float* Vs = Ks + 64 * 64; LAS float* vec = (LAS float*)(F.lds + AUX_OFF); LAS int* rows = (LAS int*)vec;
    const bf16* P = wsp<const bf16>(F, WS_P);
    for (int u = F.blk; u < NUNIT_M; u += F.G) {
        const int cidx = u / 260, c = u - cidx * 260, z = cidx >> 3, b = (cidx >> 2) & 1, h = cidx & 3;
        mlstm_chunk_head(F, z, b, h, c, vec);
        if (F.tid < 64) { const float bl = vec[128 + 63]; const float uu = bl - vec[128 + F.tid] + vec[64 + F.tid]; float m = uu;
#pragma unroll
            for (int o = 1; o < 64; o <<= 1) m = fmaxf(m, __shfl_xor(m, o));
            vec[256 + F.tid] = __expf(uu - m);
            if (F.tid == 0) { wsp<float>(F, WS_SC)[2 * u] = bl; wsp<float>(F, WS_SC)[2 * u + 1] = m; } }
        __syncthreads();
        { const int s = F.tid >> 3, c8 = F.tid & 7; float x[8]; unpack8(*(const v4u*)(P + (size_t)rows[s] * REC_NP + PC_K + h * 64 + 8 * c8), x);
#pragma unroll
          for (int e = 0; e < 8; ++e) Ks[s * 64 + 8 * c8 + e] = x[e] * 0.125f; }
#pragma unroll
        for (int i = 0; i < 2; ++i) { const int s = (F.tid >> 4) + 32 * i, c8 = F.tid & 15; float x[8]; unpack8(*(const v4u*)(P + (size_t)rows[s] * REC_NP + PC_V + h * 128 + 8 * c8), x); const float w = vec[256 + s];
#pragma unroll
            for (int e = 0; e < 8; ++e) Vs[s * 128 + 8 * c8 + e] = x[e] * w; }
        __syncthreads();
        { const int dg = F.tid >> 5, vg = F.tid & 31; f32x4 acc[4];
#pragma unroll
          for (int i = 0; i < 4; ++i) acc[i] = (f32x4){0.f, 0.f, 0.f, 0.f};
#pragma unroll 4
          for (int s = 0; s < 64; ++s) { const f32x4 kd = *(const LAS f32x4*)(Ks + s * 64 + 4 * dg), vv = *(const LAS f32x4*)(Vs + s * 128 + 4 * vg);
              acc[0] += kd.x * vv; acc[1] += kd.y * vv; acc[2] += kd.z * vv; acc[3] += kd.w * vv; }
          float* dc = wsp<float>(F, WS_DC) + (size_t)u * 8192 + (size_t)(4 * dg) * 128 + 4 * vg;
#pragma unroll
          for (int i = 0; i < 4; ++i) *(f32x4*)(dc + i * 128) = acc[i];
          if (F.tid < 64) { float a = 0.f; for (int s = 0; s < 64; ++s) a += vec[256 + s] * Ks[s * 64 + F.tid]; wsp<float>(F, WS_DN)[(size_t)u * 64 + F.tid] = a; } }
        __syncthreads();
    }
}
__device__ __forceinline__ void l1_mlstm_b(const Frame& F) {
    const float* SC = wsp<const float>(F, WS_SC); const float* DC = wsp<const float>(F, WS_DC); float* CST = wsp<float>(F, WS_CST);
    for (int g = F.blk * 512 + F.tid; g < 16 * 8192; g += F.G * 512) {
        const int chain = g >> 13, el = g & 8191; float m = 0.f, C = 0.f, N = 0.f; const bool don = el < 64;
        for (int c = 0; c < 260; ++c) { const size_t u = (size_t)chain * 260 + c;
            CST[u * 8192 + el] = C; if (don) wsp<float>(F, WS_NST)[u * 64 + el] = N; if (el == 0) wsp<float>(F, WS_MST)[u] = m;
            const float bl = SC[2 * u], ml = SC[2 * u + 1], mn = fmaxf(bl + m, ml), cd = __expf(bl + m - mn), inj = __expf(ml - mn);
            C = cd * C + inj * DC[u * 8192 + el]; if (don) N = cd * N + inj * wsp<const float>(F, WS_DN)[u * 64 + el]; m = mn; }
    }
}
__device__ __forceinline__ void l1_mlstm_c(const Frame& F, int first_blk, int nblk) {
    LAS float* qT = (LAS float*)F.lds; LAS float* kT = qT + 4096; LAS float* Vs = kT + 4096; LAS float* Cs = Vs + 8192; LAS float* PT = Cs + 8192;
    LAS float* vec = (LAS float*)(F.lds + AUX_OFF); LAS int* rows = (LAS int*)vec;
    const bf16* P = wsp<const bf16>(F, WS_P);
    for (int u = F.blk - first_blk; u < NUNIT_M; u += nblk) {
        const int cidx = u / 260, c = u - cidx * 260, z = cidx >> 3, b = (cidx >> 2) & 1, h = cidx & 3;
        mlstm_chunk_head(F, z, b, h, c, vec);
        const float mst = wsp<const float>(F, WS_MST)[u];
        if (F.tid < 64) { const int t = F.tid; float pm = -3.0e38f; for (int s = 0; s <= t; ++s) pm = fmaxf(pm, vec[64 + s] - vec[128 + s]);
            const float gi = vec[128 + t] + mst, mo = fmaxf(gi, vec[128 + t] + pm); vec[320 + t] = __expf(gi - mo); vec[384 + t] = mo;
            vec[256 + t] = wsp<const float>(F, WS_NST)[(size_t)u * 64 + t]; }
        { const int c8 = F.tid >> 6, t = F.tid & 63; float x[8]; unpack8(*(const v4u*)(P + (size_t)rows[t] * REC_NP + PC_Q + h * 64 + 8 * c8), x);
#pragma unroll
          for (int e = 0; e < 8; ++e) qT[(8 * c8 + e) * 64 + t] = x[e];
          unpack8(*(const v4u*)(P + (size_t)rows[t] * REC_NP + PC_K + h * 64 + 8 * c8), x);
#pragma unroll
          for (int e = 0; e < 8; ++e) kT[(8 * c8 + e) * 64 + t] = x[e] * 0.125f; }
#pragma unroll
        for (int i = 0; i < 2; ++i) { const int s = (F.tid >> 4) + 32 * i, c8 = F.tid & 15; float x[8]; unpack8(*(const v4u*)(P + (size_t)rows[s] * REC_NP + PC_V + h * 128 + 8 * c8), x);
            *(LAS f32x4*)(Vs + s * 128 + 8 * c8) = (f32x4){x[0], x[1], x[2], x[3]}; *(LAS f32x4*)(Vs + s * 128 + 8 * c8 + 4) = (f32x4){x[4], x[5], x[6], x[7]}; }
        { const f32x4* src = (const f32x4*)(wsp<const float>(F, WS_CST) + (size_t)u * 8192);
#pragma unroll
          for (int i = 0; i < 4; ++i) ((LAS f32x4*)Cs)[F.tid + 512 * i] = src[F.tid + 512 * i]; }
        __syncthreads();
        { const int tg = F.tid & 15, sg = F.tid >> 4; f32x4 a0 = {0.f, 0.f, 0.f, 0.f}, a1 = a0;
#pragma unroll 4
          for (int d = 0; d < 64; ++d) { const f32x4 q4 = *(const LAS f32x4*)(qT + d * 64 + 4 * tg); const float k0 = kT[d * 64 + 2 * sg], k1 = kT[d * 64 + 2 * sg + 1]; a0 += q4 * k0; a1 += q4 * k1; }
#pragma unroll
          for (int j = 0; j < 2; ++j) { const int s = 2 * sg + j; const float cs = vec[64 + s] - vec[128 + s]; f32x4 pv;
#pragma unroll
              for (int i = 0; i < 4; ++i) { const int t = 4 * tg + i; const float qk = j == 0 ? a0[i] : a1[i]; pv[i] = (s <= t) ? qk * __expf(vec[128 + t] + cs - vec[384 + t]) : 0.f; }
              *(LAS f32x4*)(PT + s * 64 + 4 * tg) = pv; } }
        __syncthreads();
        { const int tg = F.tid >> 5, vg = F.tid & 31; f32x4 ac[4], ap[4]; f32x4 nq = {0.f, 0.f, 0.f, 0.f}, rs = nq;
#pragma unroll
          for (int i = 0; i < 4; ++i) { ac[i] = (f32x4){0.f, 0.f, 0.f, 0.f}; ap[i] = ac[i]; }
#pragma unroll 4
          for (int d = 0; d < 64; ++d) { const f32x4 q4 = *(const LAS f32x4*)(qT + d * 64 + 4 * tg), c4 = *(const LAS f32x4*)(Cs + d * 128 + 4 * vg);
              ac[0] += q4.x * c4; ac[1] += q4.y * c4; ac[2] += q4.z * c4; ac[3] += q4.w * c4; nq += q4 * vec[256 + d]; }
#pragma unroll 4
          for (int s = 0; s < 64; ++s) { const f32x4 p4 = *(const LAS f32x4*)(PT + s * 64 + 4 * tg), v4 = *(const LAS f32x4*)(Vs + s * 128 + 4 * vg);
              ap[0] += p4.x * v4; ap[1] += p4.y * v4; ap[2] += p4.z * v4; ap[3] += p4.w * v4; rs += p4; }
#pragma unroll
          for (int i = 0; i < 4; ++i) { const int t = 4 * tg + i; const float g = vec[320 + t], den = g * nq[i] + rs[i], dn = fmaxf(fabsf(den), __expf(-vec[384 + t]));
              const f32x4 hv = (g * ac[i] + ap[i]) * (1.f / dn);
              *(f32x4*)(wsp<float>(F, WS_HM) + ((size_t)z * R + rows[t]) * 512 + h * 128 + 4 * vg) = hv; } }
        __syncthreads();
    }
}
template <int CTRL> __device__ __forceinline__ float dpp_add(float v) { return v + __builtin_bit_cast(float, __builtin_amdgcn_update_dpp(0, __builtin_bit_cast(int, v), CTRL, 0xF, 0xF, true)); }
__device__ __forceinline__ float reduce16(float v) { v = dpp_add<0xB1>(v); v = dpp_add<0x4E>(v); v = dpp_add<0x141>(v); v = dpp_add<0x140>(v); return v; }
struct ScanIn { f32x4 a, b, w, k, r; float v; };
__device__ __forceinline__ float fma_s(float a, float b, float c) { float r; asm("v_fma_f32 %0, %1, %2, %3" : "=v"(r) : "v"(a), "v"(b), "v"(c)); return r; }
__device__ __forceinline__ float mul_s(float a, float b) { float r; asm("v_mul_f32_e32 %0, %1, %2" : "=v"(r) : "v"(a), "v"(b)); return r; }
__device__ __forceinline__ float add_s(float a, float b) { float r; asm("v_add_f32_e32 %0, %1, %2" : "=v"(r) : "v"(a), "v"(b)); return r; }
constexpr int SC_TS = 32, SC_MAIN = SC_TS * 320, SC_TILE = SC_MAIN + SC_TS * 16, SC_NBLK = 128;
typedef float f32x2_t __attribute__((ext_vector_type(2)));
__device__ __forceinline__ void l1_rwkv_scan(const Frame& F) {
    const int chain = F.blk >> 2, z = chain >> 4, b = (chain >> 3) & 1, h = chain & 7, qtr = F.blk & 3;
    const int g = F.lane >> 4, p = F.lane & 15, rowl = (F.wave & 3) * 4 + g; const bool cw = F.wave < 4;
    LAS float* lds = (LAS float*)F.lds; LAS float* ytile = lds + 2 * SC_TILE;
    float* Y = wsp<float>(F, WS_YR) + (size_t)z * R * 512;
    const int sst = F.tid >> 4, l16 = F.tid & 15; const size_t co = h * 64 + l16 * 4;
    const float* gR = wsp<const float>(F, WS_RR) + co; const float* gA = wsp<const float>(F, WS_AKK) + co; const float* gB = wsp<const float>(F, WS_BB) + (size_t)z * R * 512 + co;
    const float* gW = wsp<const float>(F, WS_WDEC) + (size_t)z * R * 512 + co; const float* gK = wsp<const float>(F, WS_KDIR) + (size_t)z * R * 512 + co;
    const float* gv = wsp<const float>(F, WS_VV) + h * 64 + qtr * 16 + (F.tid & 3) * 4; const int gvst = (F.tid >> 2) + 1; const bool vld = F.tid < 128;
    f32x4 tR, tA, tB, tW, tK, stv;
#define SC_ROW(sg) (((size_t)b * TB + scan_tok(z, (sg) < TB ? (sg) : TB - 1)) * 512)
#define SC_GLOAD(n) do { const size_t r0_ = SC_ROW((n) * SC_TS + sst), r1_ = SC_ROW((n) * SC_TS + sst + 1); tR = *(const f32x4*)(gR + r0_); tA = *(const f32x4*)(gA + r1_); tB = *(const f32x4*)(gB + r0_); \
    tW = *(const f32x4*)(gW + r0_); tK = *(const f32x4*)(gK + r1_); if (vld) stv = *(const f32x4*)(gv + SC_ROW((n) * SC_TS + gvst)); } while (0)
#define SC_LWRITE(buf) do { LAS float* d_ = lds + (buf) * SC_TILE + sst * 320; *(LAS f32x4*)(d_ + l16 * 8) = (f32x4){tR.x, tA.x, tR.y, tA.y}; *(LAS f32x4*)(d_ + l16 * 8 + 4) = (f32x4){tR.z, tA.z, tR.w, tA.w}; \
    *(LAS f32x4*)(d_ + 128 + l16 * 4) = tB; *(LAS f32x4*)(d_ + 192 + l16 * 4) = tW; *(LAS f32x4*)(d_ + 256 + l16 * 4) = tK; \
    if (vld) ((LAS f32x4*)(lds + (buf) * SC_TILE + SC_MAIN))[F.tid] = stv; } while (0)
    f32x2_t S01 = {0.f, 0.f}, S23 = {0.f, 0.f}; float pa = 0.f, vk0, vk1, vk2, vk3;
    { const size_t r0 = SC_ROW(0); const f32x4 k4 = *(const f32x4*)(wsp<const float>(F, WS_KDIR) + (size_t)z * R * 512 + r0 + h * 64 + 4 * p);
      const float v0 = wsp<const float>(F, WS_VV)[r0 + h * 64 + qtr * 16 + rowl]; vk0 = v0 * k4.x; vk1 = v0 * k4.y; vk2 = v0 * k4.z; vk3 = v0 * k4.w; }
    constexpr int NTILE = TB / SC_TS;
    SC_GLOAD(0); SC_LWRITE(0); __syncthreads();
    for (int n = 0; n < NTILE; ++n) {
        if (n + 1 < NTILE) SC_GLOAD(n + 1);
        const LAS float* tb = lds + (n & 1) * SC_TILE; const LAS float* tv = lds + (n & 1) * SC_TILE + SC_MAIN + rowl;
        LAS float* yw = (p == 0) ? (ytile + (n & 1) * (SC_TS * 16) + rowl) : (ytile + 2 * (SC_TS * 16) + F.tid);
        const int ystep = (p == 0) ? 16 : 0;
        struct In { f32x4 q0, q1, b, w, k; float v; };
#define SC_LD(S, s_) do { S.q0 = *(const LAS f32x4*)(tb + (s_) * 320 + 8 * p); S.q1 = *(const LAS f32x4*)(tb + (s_) * 320 + 8 * p + 4); S.b = *(const LAS f32x4*)(tb + (s_) * 320 + 128 + 4 * p); \
    S.w = *(const LAS f32x4*)(tb + (s_) * 320 + 192 + 4 * p); S.k = *(const LAS f32x4*)(tb + (s_) * 320 + 256 + 4 * p); S.v = tv[(s_) * 16]; } while (0)
#define SC_ST(S, s_) do { \
    { const f32x2_t t01_ = S.b.xy * pa + (f32x2_t){vk0, vk1}, t23_ = S.b.zw * pa + (f32x2_t){vk2, vk3}; S01 = S01 * S.w.xy + t01_; S23 = S23 * S.w.zw + t23_; } \
    f32x2_t P_ = S.q0.xy * S01.x, Q_ = S.q1.xy * S23.x; P_ = S.q0.zw * S01.y + P_; Q_ = S.q1.zw * S23.y + Q_; P_ = P_ + Q_; \
    float py_ = P_.x; pa = P_.y; \
    asm volatile("s_nop 1\n\tv_mul_f32_e32 %2, %6, %7\n\t" \
        "v_add_f32_dpp %0, %0, %0 quad_perm:[1,0,3,2] row_mask:0xf bank_mask:0xf bound_ctrl:1\n\tv_add_f32_dpp %1, %1, %1 quad_perm:[1,0,3,2] row_mask:0xf bank_mask:0xf bound_ctrl:1\n\tv_mul_f32_e32 %3, %6, %8\n\t" \
        "v_add_f32_dpp %0, %0, %0 quad_perm:[2,3,0,1] row_mask:0xf bank_mask:0xf bound_ctrl:1\n\tv_add_f32_dpp %1, %1, %1 quad_perm:[2,3,0,1] row_mask:0xf bank_mask:0xf bound_ctrl:1\n\tv_mul_f32_e32 %4, %6, %9\n\t" \
        "v_add_f32_dpp %0, %0, %0 row_half_mirror row_mask:0xf bank_mask:0xf bound_ctrl:1\n\tv_add_f32_dpp %1, %1, %1 row_half_mirror row_mask:0xf bank_mask:0xf bound_ctrl:1\n\tv_mul_f32_e32 %5, %6, %10\n\t" \
        "v_add_f32_dpp %0, %0, %0 row_mirror row_mask:0xf bank_mask:0xf bound_ctrl:1\n\tv_add_f32_dpp %1, %1, %1 row_mirror row_mask:0xf bank_mask:0xf bound_ctrl:1\n\ts_nop 0" \
        : "+v"(py_), "+v"(pa), "=&v"(vk0), "=&v"(vk1), "=&v"(vk2), "=&v"(vk3) : "v"(S.v), "v"(S.k.x), "v"(S.k.y), "v"(S.k.z), "v"(S.k.w)); \
    yw[(s_) * ystep] = py_; } while (0)
        if (cw) { In I0, I1; SC_LD(I0, 0);
#pragma unroll 4
        for (int s = 0; s < SC_TS; s += 2) {
            SC_LD(I1, s + 1); SC_ST(I0, s);
            if (s + 2 < SC_TS) SC_LD(I0, s + 2);
            SC_ST(I1, s + 1);
        } }
#undef SC_LD
#undef SC_ST
        if (n + 1 < NTILE) SC_LWRITE((n + 1) & 1);
        __syncthreads();
        { const int stp = F.tid >> 4, c1 = F.tid & 15; Y[((size_t)b * TB + scan_tok(z, n * SC_TS + stp)) * 512 + h * 64 + qtr * 16 + c1] = ytile[(n & 1) * (SC_TS * 16) + stp * 16 + c1]; }
    }
#undef SC_GLOAD
#undef SC_LWRITE
#undef SC_ROW
}
__device__ __forceinline__ void l1_rec_out(const Frame& F) {
    const int gw = F.blk * 8 + F.wave, NGW = F.G * 8, lane = F.lane, c0 = 8 * lane;
    for (int row = gw; row < R; row += NGW) {
        const size_t ro = (size_t)row * 512 + c0; bf16* a1 = wsp<bf16>(F, WS_A1) + (size_t)row * DM;
        { const float* y0 = wsp<const float>(F, WS_YR) + ro; const float* y1 = y0 + (size_t)R * 512; float y[8]; float s = 0.f;
#pragma unroll
          for (int e = 0; e < 8; ++e) { y[e] = y0[e] + y1[e]; s += y[e]; }
          s += __shfl_xor(s, 1); s += __shfl_xor(s, 2); s += __shfl_xor(s, 4); const float mean = s * (1.f / 64.f); float q = 0.f;
#pragma unroll
          for (int e = 0; e < 8; ++e) { y[e] -= mean; q += y[e] * y[e]; }
          q += __shfl_xor(q, 1); q += __shfl_xor(q, 2); q += __shfl_xor(q, 4); const float rstd = 1.f / sqrtf(q * (1.f / 64.f) + 64e-5f);
          const float* rr = wsp<const float>(F, WS_RR) + ro; const float* k0 = wsp<const float>(F, WS_KDIR) + ro; const float* k1 = k0 + (size_t)R * 512; const float* rk = F.in[I_RK] + c0; float bs = 0.f;
#pragma unroll
          for (int e = 0; e < 8; ++e) bs += rr[e] * (k0[e] + k1[e]) * rk[e];
          bs += __shfl_xor(bs, 1); bs += __shfl_xor(bs, 2); bs += __shfl_xor(bs, 4);
          const float* vv = wsp<const float>(F, WS_VV) + ro; const float* gg = wsp<const float>(F, WS_GG) + ro; const float* lw = F.in[I_LNW] + c0; const float* lb = F.in[I_LNB] + c0; float o[8];
#pragma unroll
          for (int e = 0; e < 8; ++e) o[e] = (y[e] * rstd * lw[e] + lb[e] + bs * vv[e]) * gg[e];
          v4u w; w.x = pk2(o[0], o[1]); w.y = pk2(o[2], o[3]); w.z = pk2(o[4], o[5]); w.w = pk2(o[6], o[7]); *(v4u*)(a1 + c0) = w; }
        { const float* h0 = wsp<const float>(F, WS_HM) + ro; const float* h1 = h0 + (size_t)R * 512; float x[8]; float q = 0.f;
#pragma unroll
          for (int e = 0; e < 8; ++e) { x[e] = h0[e] + h1[e]; q += x[e] * x[e]; }
          q += __shfl_xor(q, 1); q += __shfl_xor(q, 2); q += __shfl_xor(q, 4); q += __shfl_xor(q, 8); const float rs = 1.f / sqrtf(q * (1.f / 128.f) + NORM_EPS);
          float og[8]; unpack8(*(const v4u*)(wsp<const bf16>(F, WS_P) + (size_t)row * REC_NP + PC_O + c0), og); const float* nw = F.in[I_MNW] + c0; float o[8];
#pragma unroll
          for (int e = 0; e < 8; ++e) o[e] = x[e] * rs * nw[e] * sigmoidf_(og[e]);
          v4u w; w.x = pk2(o[0], o[1]); w.y = pk2(o[2], o[3]); w.z = pk2(o[4], o[5]); w.w = pk2(o[6], o[7]); *(v4u*)(a1 + 512 + c0) = w; }
    }
}
#ifndef MK_PER_PHASE
#define MK_PER_PHASE 0
#endif
constexpr int NPHASE = 26;
struct Args { const float* in[N_IN]; float* out; unsigned char* ws; int ph_lo, ph_hi, li, pad; };
#define GEMM_CALL(FnT, SchedT, g, S, fn) do { pg8::EpiGen<FnT> E_{fn}; { int k_ = g.K; asm volatile("" : "+s"(k_)); g.K = k_; } pg8::gemm_phase<pg8::EpiGen<FnT>, SchedT, true, true>((PG8_LAS unsigned char*)F.lds, g, S, E_); } while (0)
#ifndef SITE_MASK
#define SITE_MASK 0xFFFFFFFFull
#endif
#define SITE(s) (((SITE_MASK) >> (s)) & 1ull)
#ifndef DUP_MASK
#define DUP_MASK 0ull
#endif
#define NREP(s) ((((DUP_MASK) >> (s)) & 1ull) ? 2 : 1)
#define IN(k) (lo <= (k) && (k) < hi)
#define SEAM(k) do { if (IN(k) && IN((k) + 1)) xcd_barrier(bar); } while (0)
template <int LAYER> __device__ __forceinline__ void layer_phases(const Frame& F, const XcdBarrier& bar, const int lo, const int hi) {
    constexpr int layer = LAYER; constexpr int pb = 2 + 12 * LAYER;
        if (SITE(2) && IN(pb + 0)) { for (int rep_ = 0; rep_ < NREP(2); ++rep_) {
            const int N = layer == 0 ? ATT_NP : REC_NP;
            pg8::Gemm g{wsp<const bf16>(F, WS_A), layer == 0 ? wsp<const bf16>(F, WS_WIN0) : wsp<const bf16>(F, WS_WREC), R, N, 1024};
            pg8::StaticOrder S; S.init(R, N, F.G, F.blk);
            GEMM_CALL(FnStoreBf16, pg8::StaticOrder, g, S, (FnStoreBf16{wsp<bf16>(F, WS_P), N}));
             if (rep_ + 1 < NREP(2)) xcd_barrier(bar); } SEAM(pb + 0);
        }
        if constexpr (LAYER == 0) {
            if (SITE(3) && IN(pb + 1)) { for (int rep_ = 0; rep_ < NREP(3); ++rep_) { l0_post_proj(F);  if (rep_ + 1 < NREP(3)) xcd_barrier(bar); } SEAM(pb + 1); }
            if (SITE(4) && IN(pb + 2)) { for (int rep_ = 0; rep_ < NREP(4); ++rep_) {
                pg8::Gemm g{wsp<const bf16>(F, WS_CQN), wsp<const bf16>(F, WS_WUQ), R, 768, 384}; pg8::StaticOrder S; S.init(R, 768, F.G, F.blk);
                GEMM_CALL(FnStoreBf16, pg8::StaticOrder, g, S, (FnStoreBf16{wsp<bf16>(F, WS_MQ), 768}));
                 if (rep_ + 1 < NREP(4)) xcd_barrier(bar); } SEAM(pb + 2);
            }
            if (SITE(5) && IN(pb + 3)) { for (int rep_ = 0; rep_ < NREP(5); ++rep_) {
                pg8::Gemm g{wsp<const bf16>(F, WS_CKVN), wsp<const bf16>(F, WS_WUKV), R, 1024, 256}; pg8::StaticOrder S; S.init(R, 1024, F.G, F.blk);
                GEMM_CALL(FnStoreBf16, pg8::StaticOrder, g, S, (FnStoreBf16{wsp<bf16>(F, WS_MKV), 1024}));
                l0_mq_rope(F);
                 if (rep_ + 1 < NREP(5)) xcd_barrier(bar); } SEAM(pb + 3);
            }
            if (SITE(6) && IN(pb + 4)) { for (int rep_ = 0; rep_ < NREP(6); ++rep_) { l0_attention(F);  if (rep_ + 1 < NREP(6)) xcd_barrier(bar); } SEAM(pb + 4); }
            if (SITE(7) && IN(pb + 5)) { for (int rep_ = 0; rep_ < NREP(7); ++rep_) { l0_combine(F);  if (rep_ + 1 < NREP(7)) xcd_barrier(bar); } SEAM(pb + 5); }
        } else {
            if (SITE(8) && IN(pb + 1)) { for (int rep_ = 0; rep_ < NREP(8); ++rep_) { l1_rwkv_prep(F); l1_mlstm_a(F);  if (rep_ + 1 < NREP(8)) xcd_barrier(bar); } SEAM(pb + 1); }
            if (SITE(9) && IN(pb + 2)) { for (int rep_ = 0; rep_ < NREP(9); ++rep_) {
                pg8::Gemm g{wsp<const bf16>(F, WS_ALORA), wsp<const bf16>(F, WS_WLORA), R, 2560, 384}; pg8::StaticOrder S; S.init(R, 2560, F.G, F.blk);
                { int k_ = g.K; asm volatile("" : "+s"(k_)); g.K = k_; EpiLora E_{&F}; pg8::gemm_phase<EpiLora, pg8::StaticOrder, true, true>((PG8_LAS unsigned char*)F.lds, g, S, E_); }
                l1_mlstm_b(F);
                 if (rep_ + 1 < NREP(9)) xcd_barrier(bar); } SEAM(pb + 2);
            }
            if (IN(pb + 3)) { SEAM(pb + 3); }
            if (SITE(10) && IN(pb + 4)) { for (int rep_ = 0; rep_ < NREP(10); ++rep_) {
                if (F.G > SC_NBLK) { if (F.blk < SC_NBLK) l1_rwkv_scan(F); else { l1_mlstm_c(F, SC_NBLK, F.G - SC_NBLK); moe_weights_convert(F, 1, (F.blk - SC_NBLK) * 8 + F.wave, (F.G - SC_NBLK) * 8); } }
                 if (rep_ + 1 < NREP(10)) xcd_barrier(bar); } SEAM(pb + 4);
            }
            if (SITE(11) && IN(pb + 5)) { for (int rep_ = 0; rep_ < NREP(11); ++rep_) { l1_rec_out(F);  if (rep_ + 1 < NREP(11)) xcd_barrier(bar); } SEAM(pb + 5); }
        }
        if (SITE(12) && IN(pb + 6)) { for (int rep_ = 0; rep_ < NREP(12); ++rep_) {
            pg8::Gemm g{wsp<const bf16>(F, WS_A1), wsp<const bf16>(F, WS_WOUT) + (size_t)layer * 1024 * 1024, R, 1024, 1024}; pg8::StaticOrder S; S.init(R, 1024, F.G, F.blk);
            GEMM_CALL(FnWout, pg8::StaticOrder, g, S, (FnWout{&F, layer}));
             if (rep_ + 1 < NREP(12)) xcd_barrier(bar); } SEAM(pb + 6);
        }
        if (SITE(13) && IN(pb + 7)) { for (int rep_ = 0; rep_ < NREP(13); ++rep_) { ph_router(F, layer);  if (rep_ + 1 < NREP(13)) xcd_barrier(bar); } SEAM(pb + 7); }
        if (SITE(14) && IN(pb + 8)) { for (int rep_ = 0; rep_ < NREP(14); ++rep_) { ph_gather(F, layer);  if (rep_ + 1 < NREP(14)) xcd_barrier(bar); } SEAM(pb + 8); }
        if (SITE(15) && IN(pb + 9)) { for (int rep_ = 0; rep_ < NREP(15); ++rep_) {
            const int* tab = wsp<const int>(F, WS_TILE);
            pg8::Gemm g{wsp<const bf16>(F, WS_XS), wsp<const bf16>(F, WS_W1T), MAXROWS, NE * 2048, 1024}; MoeOrder S{tab + 1, __builtin_amdgcn_readfirstlane(tab[0]), 8, F.G, F.blk};
            GEMM_CALL(FnSwiglu, MoeOrder, g, S, (FnSwiglu{wsp<bf16>(F, WS_HS), F.in[I_B1] + (size_t)layer * NE * 2048}));
             if (rep_ + 1 < NREP(15)) xcd_barrier(bar); } SEAM(pb + 9);
        }
        if (SITE(16) && IN(pb + 10)) { for (int rep_ = 0; rep_ < NREP(16); ++rep_) {
            const int* tab = wsp<const int>(F, WS_TILE);
            pg8::Gemm g{wsp<const bf16>(F, WS_HS), wsp<const bf16>(F, WS_W2T), MAXROWS, NE * 1024, 1024}; MoeOrder S{tab + 1, __builtin_amdgcn_readfirstlane(tab[0]), 4, F.G, F.blk};
            GEMM_CALL(FnBiasBf16, MoeOrder, g, S, (FnBiasBf16{wsp<bf16>(F, WS_XS), F.in[I_B2] + (size_t)layer * NE * 1024}));
             if (rep_ + 1 < NREP(16)) xcd_barrier(bar); } SEAM(pb + 10);
        }
        if (SITE(17) && IN(pb + 11)) { for (int rep_ = 0; rep_ < NREP(17); ++rep_) { ph_combine(F, layer);  if (rep_ + 1 < NREP(17)) xcd_barrier(bar); } SEAM(pb + 11); }
}
__global__ void __launch_bounds__(512, 2) fwd(Args args) {
    extern __shared__ __attribute__((aligned(16))) unsigned char lds_[];
    Frame F;
    F.lds = (LAS unsigned char*)lds_; F.tid = threadIdx.x; F.lane = F.tid & 63; F.wave = __builtin_amdgcn_readfirstlane(F.tid >> 6); F.blk = blockIdx.x; F.G = gridDim.x; F.probe = args.pad;
    F.ws = args.ws; F.out = args.out; F.ctl = (gu32*)(args.ws + WS_CTL);
    F.in.t = (LAS const unsigned*)(F.lds + MISC_OFF + 8192);
    if (F.tid < 64) ((LAS unsigned*)(F.lds + MISC_OFF))[F.tid] = 0u;
    if (F.tid < N_IN) { const unsigned long long pv = (unsigned long long)args.in[F.tid]; ((LAS unsigned*)(F.lds + MISC_OFF + 8192))[2 * F.tid] = (unsigned)pv; ((LAS unsigned*)(F.lds + MISC_OFF + 8192))[2 * F.tid + 1] = (unsigned)(pv >> 32); }
    __syncthreads();
    const int lo = args.ph_lo, hi = args.ph_hi;
    XcdBarrier bar; bar.bar = (unsigned*)(F.ctl + CW_BAR) + args.li * XCD_BAR_WORDS; bar.x = 0; bar.st = nullptr;
    if (hi - lo > 1) bar = xcd_barrier_post((unsigned*)(F.ctl + CW_BAR) + args.li * XCD_BAR_WORDS, (volatile LAS unsigned*)(F.lds + MISC_OFF));
    if (SITE(0) && IN(0)) { for (int rep_ = 0; rep_ < NREP(0); ++rep_) { p0a(F);  if (rep_ + 1 < NREP(0)) xcd_barrier(bar); } SEAM(0); }
    if (SITE(1) && IN(1)) { for (int rep_ = 0; rep_ < NREP(1); ++rep_) { p0b(F);  if (rep_ + 1 < NREP(1)) xcd_barrier(bar); } SEAM(1); }
    layer_phases<0>(F, bar, lo, hi);
    layer_phases<1>(F, bar, lo, hi);
}
#undef IN
#undef SEAM


extern "C" void kernel_launch(void* const* d_in, const int* in_sizes, int n_in, void* d_out, int out_size, void* d_ws, size_t ws_size, hipStream_t stream) {
    static int grid = 0;
    if (grid == 0) {
        const bool ok = n_in == N_IN && in_sizes[I_X] == NBATCH * SEQ * DM && in_sizes[I_RECW] == 1024 * REC_IN && in_sizes[I_ATTW] == 1024 * ATT_IN && in_sizes[I_MU] == RWKV_IN &&
                        in_sizes[I_GATEB] == 16 && in_sizes[I_W1] == 2 * NE * 1024 * 2048 && out_size == NBATCH * SEQ * DM && ws_size >= WS_END;
        if (!ok) { fprintf(stderr, "kernel_launch: shape mismatch (n_in %d, recw %d, attw %d, mu %d, out %d, ws %zu need %zu); nothing launched\n", n_in, n_in > I_RECW ? in_sizes[I_RECW] : -1,
                           n_in > I_ATTW ? in_sizes[I_ATTW] : -1, n_in > I_MU ? in_sizes[I_MU] : -1, out_size, ws_size, (size_t)WS_END); grid = -1; return; }
        int dev = 0, cus = 0;
        if (hipGetDevice(&dev) != hipSuccess || hipDeviceGetAttribute(&cus, hipDeviceAttributeMultiprocessorCount, dev) != hipSuccess) { grid = -1; return; }
        if (hipFuncSetAttribute((const void*)fwd, hipFuncAttributeMaxDynamicSharedMemorySize, LDS_BYTES) != hipSuccess) { fprintf(stderr, "kernel_launch: hipFuncSetAttribute failed\n"); grid = -1; return; }
        int per_cu = 0;
        if (hipOccupancyMaxActiveBlocksPerMultiprocessor(&per_cu, (const void*)fwd, 512, LDS_BYTES) != hipSuccess || per_cu < 1) { fprintf(stderr, "kernel_launch: occupancy query says %d blocks per CU\n", per_cu); }
        (void)hipGetLastError();
        grid = cus < 256 ? cus : 256;
        if (grid != 256) fprintf(stderr, "kernel_launch: %d CUs; this kernel is written for a 256-CU device\n", cus);
    }
    if (grid < 0) return;
    if (hipMemsetAsync((char*)d_ws + WS_CTL, 0, CTL_ZERO_BYTES, stream) != hipSuccess) return;
    Args a{};
    for (int i = 0; i < N_IN; ++i) a.in[i] = (const float*)d_in[i];
    a.out = (float*)d_out; a.ws = (unsigned char*)d_ws; a.pad = 0;
#if MK_PER_PHASE
    for (int ph = 0; ph < NPHASE; ++ph) { a.ph_lo = ph; a.ph_hi = ph + 1; a.li = 0; hipLaunchKernelGGL(fwd, dim3(grid), dim3(512), LDS_BYTES, stream, a); }
#elif defined(PROBE_LIST)
    { const int plist[] = {PROBE_LIST}; int cur = 0, li = 0;
      for (int p : plist) { a.ph_lo = cur; a.ph_hi = p + 1; a.li = li++; hipLaunchKernelGGL(fwd, dim3(grid), dim3(512), LDS_BYTES, stream, a);
                            a.ph_lo = p; a.ph_hi = p + 1; a.li = li++; a.pad = 1; hipLaunchKernelGGL(fwd, dim3(grid), dim3(512), LDS_BYTES, stream, a); a.pad = 0; cur = p + 1; }
      if (cur < NPHASE) { a.ph_lo = cur; a.ph_hi = NPHASE; a.li = li++; hipLaunchKernelGGL(fwd, dim3(grid), dim3(512), LDS_BYTES, stream, a); } }
#else
    a.ph_lo = 0; a.ph_hi = NPHASE; a.li = 0; hipLaunchKernelGGL(fwd, dim3(grid), dim3(512), LDS_BYTES, stream, a);
#endif
    const hipError_t le = hipPeekAtLastError();
    if (le != hipSuccess) fprintf(stderr, "kernel_launch: launch failed: %s\n", hipGetErrorName(le));
}
```

```cpp
#include <hip/hip_runtime.h>
#include <cstdio>
#include <cstdint>
#define MK_PER_PHASE 0
namespace pg8 {
#define PG8_LAS __attribute__((address_space(3)))
typedef unsigned short bf16_t;
typedef short bf16x8 __attribute__((ext_vector_type(8)));
typedef float f32x4 __attribute__((ext_vector_type(4)));
typedef unsigned u32x4 __attribute__((ext_vector_type(4)));
constexpr int BM = 256, BK = 64, HALF = 128, HTB = HALF * BK * 2  , STAGE_BYTES = 8 * HTB, NXCD = 8, WGM = 8;

__host__ __device__ __forceinline__ int lds_byte(int r, int c) { const int st = (r >> 4) * 2 + (c >> 5), rr = r & 15, cc = c & 31, ob = rr * 64 + cc * 2; return st * 1024 + (ob ^ (((ob >> 9) & 1) << 5)); }
__host__ __device__ __forceinline__ void stage_rc(int b, int& R, int& C) { const int st = b / 1024, sb = b % 1024, swz = sb ^ (((sb >> 9) & 1) << 5); R = (st >> 1) * 16 + swz / 64; C = (st & 1) * 32 + (swz % 64) / 2; }
__host__ __device__ __forceinline__ int perm32(int rho) { const int n = rho >> 4, i = rho & 15; return 8 * (i >> 2) + 4 * n + (i & 3); }

struct Unit { int pm, pn; };
struct Gemm { const bf16_t* A; const bf16_t* Bt; int M, N, K; };

struct StaticOrder {
    int nM, nN, nwg, G, c;
    __host__ __device__ void init(int M, int N, int G_, int c_) { nM = M / BM; nN = N / BM; nwg = nM * nN; G = G_; c = c_; }
    __host__ __device__ bool next(int i, Unit& u) const {
        const long L = (long)i * G + c; if (L >= nwg) return false;
        int wgid = (int)L; { const int q = nwg / NXCD, r = nwg % NXCD, xcd = wgid % NXCD, off = wgid / NXCD; wgid = (xcd < r ? xcd * (q + 1) : r * (q + 1) + (xcd - r) * q) + off; }
        const int nig = WGM * nN, gid = wgid / nig, fm = gid * WGM, gsz = (nM - fm) < WGM ? (nM - fm) : WGM;
        u.pm = fm + ((wgid % nig) % gsz); u.pn = (wgid % nig) / gsz; return true;
    }
    __device__ __forceinline__ void a_ready(const Unit&) const {}
    __device__ __forceinline__ void done(const Unit&) const {}
};

__device__ __forceinline__ unsigned cvt_pk_bf16(float lo, float hi) { unsigned r; asm volatile("v_cvt_pk_bf16_f32 %0, %1, %2" : "=v"(r) : "v"(lo), "v"(hi)); return r; }
template <class Fn> struct EpiGen {
    static constexpr bool PERM = true, AFTER_DRAIN = false;
    Fn fn;
    __device__ __forceinline__ void operator()(const f32x4 (&acc)[2][2][4][2], const Unit& u, int wr, int wc, int fr, int fq) const {
#pragma unroll
        for (int ai = 0; ai < 2; ++ai)
#pragma unroll
            for (int m = 0; m < 4; ++m) { const int row = u.pm * BM + ai * HALF + wr * 64 + m * 16 + fr;
#pragma unroll
                for (int bj = 0; bj < 2; ++bj) { const int col = u.pn * BM + bj * HALF + wc * 32 + 8 * fq; fn(row, col, acc[ai][bj][m][0], acc[ai][bj][m][1]); } }
    }
};
template <class Epi, class Sched, bool ALIGN_EPI = false, bool SP2 = false>
__device__ __forceinline__ void gemm_phase(PG8_LAS unsigned char* lds, const Gemm g, const Sched& S, const Epi& E) {
    const int tid = threadIdx.x, wid = __builtin_amdgcn_readfirstlane(tid >> 6), lane = tid & 63, wr = wid >> 2, wc = wid & 3, fr = lane & 15, fq = lane >> 4;
    const int K = g.K, nt = K / BK;
    unsigned voffA[2], voffB[2];
#pragma unroll
    for (int i = 0; i < 2; ++i) { int R, C; stage_rc(tid * 16 + i * 8192, R, C); const int Rb = Epi::PERM ? ((R & ~31) + perm32(R & 31)) : R;
        voffA[i] = (unsigned)(R * K + C) * 2u; voffB[i] = (unsigned)(Rb * K + C) * 2u; }
    const size_t kstep = (size_t)(BK * 2);
    const size_t hstep = (size_t)HALF * K * 2;
    const size_t tstep = 2 * hstep;
    const unsigned ldsw = (unsigned)wid * 1024u;
    const int aoff = lds_byte(wr * 64 + fr, fq * 8), boff = lds_byte(wc * 32 + fr, fq * 8);
#define PG8_SA(b, h) (((b) * 2 + (h)) * HTB)
#define PG8_SB(b, h) ((4 + (b) * 2 + (h)) * HTB)
#define PG8_STAGE(bufoff, gbase, voff) do { _Pragma("unroll") for (int _i = 0; _i < 2; ++_i) \
        __builtin_amdgcn_global_load_lds((const unsigned*)((const char*)(gbase) + (voff)[_i]), (PG8_LAS unsigned*)(lds + (bufoff) + ldsw + _i * 8192), 16, 0, 0); } while (0)
#define PG8_LDA(dst, b, h) do { _Pragma("unroll") for (int m = 0; m < 4; ++m) _Pragma("unroll") for (int k = 0; k < 2; ++k) dst[m][k] = *(const PG8_LAS bf16x8*)(lds + PG8_SA(b, h) + aoff + m * 2048 + k * 1024); } while (0)
#define PG8_LDB(dst, b, h) do { _Pragma("unroll") for (int n = 0; n < 2; ++n) _Pragma("unroll") for (int k = 0; k < 2; ++k) dst[n][k] = *(const PG8_LAS bf16x8*)(lds + PG8_SB(b, h) + boff + n * 2048 + k * 1024); } while (0)
#define PG8_MMA(ai, bj, At, Bt) do { __builtin_amdgcn_s_setprio(1); _Pragma("unroll") for (int m = 0; m < 4; ++m) _Pragma("unroll") for (int n = 0; n < 2; ++n) _Pragma("unroll") for (int k = 0; k < 2; ++k) \
        acc[ai][bj][m][n] = __builtin_amdgcn_mfma_f32_16x16x32_bf16(Bt[n][k], At[m][k], acc[ai][bj][m][n], 0, 0, 0); __builtin_amdgcn_s_setprio(0); } while (0)
#define PG8_WAIT_V(n) asm volatile("s_waitcnt vmcnt(" #n ")" ::: "memory")
#define PG8_WAIT_L(n) asm volatile("s_waitcnt lgkmcnt(" #n ")" ::: "memory")
#define PG8_BAR __builtin_amdgcn_s_barrier()
#define PG8_SCHED __builtin_amdgcn_sched_barrier(0)
    Unit cur, nxt; int ui = 0;
    if (!S.next(0, cur)) return;
    f32x4 acc[2][2][4][2];
#pragma unroll
    for (int a = 0; a < 2; ++a)
#pragma unroll
        for (int b = 0; b < 2; ++b)
#pragma unroll
            for (int m = 0; m < 4; ++m)
#pragma unroll
                for (int n = 0; n < 2; ++n) acc[a][b][m][n] = (f32x4){0.f, 0.f, 0.f, 0.f};
    bf16x8 At[4][2], B0[2][2], B1[2][2];
    const char* cA = (const char*)g.A + (size_t)cur.pm * tstep; const char* cB = (const char*)g.Bt + (size_t)cur.pn * tstep;
    S.a_ready(cur);
    if constexpr (SP2) {
        PG8_STAGE(PG8_SB(0, 0), cB, voffB); PG8_STAGE(PG8_SB(0, 1), cB + hstep, voffB); PG8_STAGE(PG8_SA(0, 0), cA, voffA); PG8_STAGE(PG8_SA(0, 1), cA + hstep, voffA);
        if (wr == 1) PG8_BAR;
        PG8_WAIT_V(2); PG8_BAR;
        PG8_STAGE(PG8_SB(1, 0), cB + kstep, voffB); PG8_STAGE(PG8_SA(1, 0), cA + kstep, voffA); PG8_STAGE(PG8_SB(1, 1), cB + hstep + kstep, voffB);
        PG8_WAIT_V(6); PG8_BAR;
    } else {
        PG8_STAGE(PG8_SB(0, 0), cB, voffB); PG8_STAGE(PG8_SA(0, 0), cA, voffA); PG8_STAGE(PG8_SB(0, 1), cB + hstep, voffB); PG8_STAGE(PG8_SA(0, 1), cA + hstep, voffA);
        if (wr == 1) PG8_BAR;
        PG8_WAIT_V(4); PG8_BAR;
        PG8_STAGE(PG8_SB(1, 0), cB + kstep, voffB); PG8_STAGE(PG8_SA(1, 0), cA + kstep, voffA); PG8_STAGE(PG8_SB(1, 1), cB + hstep + kstep, voffB);
        PG8_WAIT_V(6); PG8_BAR;
    }
    for (;;) {
        const bool has_next = S.next(ui + 1, nxt);
        const char* nA = has_next ? (const char*)g.A + (size_t)nxt.pm * tstep : cA; const char* nB = has_next ? (const char*)g.Bt + (size_t)nxt.pn * tstep : cB;
        for (int t = 0; t < nt; t += 2) {
            const bool last = (t == nt - 2);
            const char* a1 = cA + (size_t)(t + 1) * kstep;
            const char* a2 = last ? nA : cA + (size_t)(t + 2) * kstep; const char* b2 = last ? nB : cB + (size_t)(t + 2) * kstep;
            const char* a3 = a2 + kstep; const char* b3 = b2 + kstep;
            if (last && has_next) S.a_ready(nxt);
            if constexpr (SP2) {
            PG8_LDB(B0, 0, 0); PG8_LDB(B1, 0, 1); PG8_SCHED; PG8_LDA(At, 0, 0); PG8_STAGE(PG8_SA(1, 1), a1 + hstep, voffA);
            PG8_WAIT_V(8); PG8_WAIT_L(0); PG8_BAR; PG8_MMA(0, 0, At, B0); PG8_MMA(0, 1, At, B1); PG8_BAR; PG8_SCHED;
            PG8_LDA(At, 0, 1); PG8_STAGE(PG8_SB(0, 0), b2, voffB); PG8_STAGE(PG8_SB(0, 1), b2 + hstep, voffB); PG8_STAGE(PG8_SA(0, 0), a2, voffA);
            PG8_WAIT_V(8); PG8_WAIT_L(0); PG8_BAR; PG8_MMA(1, 0, At, B0); PG8_MMA(1, 1, At, B1); PG8_BAR; PG8_SCHED;
            PG8_LDB(B0, 1, 0); PG8_LDB(B1, 1, 1); PG8_SCHED; PG8_LDA(At, 1, 0); PG8_STAGE(PG8_SA(0, 1), a2 + hstep, voffA);
            PG8_WAIT_V(8); PG8_WAIT_L(0); PG8_BAR; PG8_MMA(0, 0, At, B0); PG8_MMA(0, 1, At, B1); PG8_BAR; PG8_SCHED;
            PG8_LDA(At, 1, 1); PG8_STAGE(PG8_SB(1, 0), b3, voffB); PG8_STAGE(PG8_SB(1, 1), b3 + hstep, voffB); PG8_STAGE(PG8_SA(1, 0), a3, voffA);
            PG8_WAIT_V(8); PG8_WAIT_L(0); PG8_BAR; PG8_MMA(1, 0, At, B0); PG8_MMA(1, 1, At, B1); PG8_BAR; PG8_SCHED;
            } else {
            PG8_LDB(B0, 0, 0); PG8_SCHED; PG8_LDA(At, 0, 0); PG8_STAGE(PG8_SA(1, 1), a1 + hstep, voffA);
            PG8_WAIT_L(8); PG8_BAR; PG8_WAIT_L(0); PG8_MMA(0, 0, At, B0); PG8_BAR; PG8_SCHED;
            PG8_LDB(B1, 0, 1); PG8_STAGE(PG8_SB(0, 0), b2, voffB);
            PG8_BAR; PG8_WAIT_L(0); PG8_MMA(0, 1, At, B1); PG8_BAR;
            PG8_LDA(At, 0, 1); PG8_STAGE(PG8_SA(0, 0), a2, voffA);
            PG8_BAR; PG8_WAIT_L(0); PG8_MMA(1, 0, At, B0); PG8_BAR; PG8_SCHED;
            PG8_STAGE(PG8_SB(0, 1), b2 + hstep, voffB);
            PG8_WAIT_V(6); PG8_BAR; PG8_MMA(1, 1, At, B1); PG8_BAR;
            PG8_LDB(B0, 1, 0); PG8_SCHED; PG8_LDA(At, 1, 0); PG8_STAGE(PG8_SA(0, 1), a2 + hstep, voffA);
            PG8_WAIT_L(8); PG8_BAR; PG8_WAIT_L(0); PG8_MMA(0, 0, At, B0); PG8_BAR; PG8_SCHED;
            PG8_LDB(B1, 1, 1); PG8_STAGE(PG8_SB(1, 0), b3, voffB);
            PG8_BAR; PG8_WAIT_L(0); PG8_MMA(0, 1, At, B1); PG8_BAR;
            PG8_LDA(At, 1, 1); PG8_STAGE(PG8_SA(1, 0), a3, voffA);
            PG8_BAR; PG8_WAIT_L(0); PG8_MMA(1, 0, At, B0); PG8_BAR; PG8_SCHED;
            PG8_STAGE(PG8_SB(1, 1), b3 + hstep, voffB);
            PG8_WAIT_V(6); PG8_BAR; PG8_MMA(1, 1, At, B1); PG8_BAR;
            }
        }
        if constexpr (ALIGN_EPI) { if (wr == 0) PG8_BAR; }
        if constexpr (!Epi::AFTER_DRAIN) { E(acc, cur, wr, wc, fr, fq); S.done(cur); }
        if (!has_next) break;
#pragma unroll
        for (int a = 0; a < 2; ++a)
#pragma unroll
            for (int b = 0; b < 2; ++b)
#pragma unroll
                for (int m = 0; m < 4; ++m)
#pragma unroll
                    for (int n = 0; n < 2; ++n) acc[a][b][m][n] = (f32x4){0.f, 0.f, 0.f, 0.f};
        cur = nxt; cA = nA; cB = nB; ++ui;
        if constexpr (ALIGN_EPI) { if (wr == 1) PG8_BAR; }
    }
    PG8_WAIT_V(0);
    if constexpr (!ALIGN_EPI) { if (wr == 0) PG8_BAR; }
    PG8_BAR;
    if constexpr (Epi::AFTER_DRAIN) { E.fused(acc, cur, wr, wc, fr, fq, lds, wid, lane); S.done(cur); }
#undef PG8_SA
#undef PG8_SB
#undef PG8_STAGE
#undef PG8_LDA
#undef PG8_LDB
#undef PG8_MMA
#undef PG8_WAIT_V
#undef PG8_WAIT_L
#undef PG8_BAR
#undef PG8_SCHED
}
}
#define GAS __attribute__((address_space(1)))
#define LAS __attribute__((address_space(3)))
typedef unsigned short bf16;
typedef unsigned v4u __attribute__((ext_vector_type(4)));
typedef unsigned v2u __attribute__((ext_vector_type(2)));
typedef float f32x4 __attribute__((ext_vector_type(4)));
typedef short bf16x8 __attribute__((ext_vector_type(8)));
typedef GAS unsigned gu32;
typedef GAS unsigned long long gu64;
#define RLX_AGENT __ATOMIC_RELAXED, __HIP_MEMORY_SCOPE_AGENT
#define LDS_WAIT() asm volatile("s_waitcnt lgkmcnt(0)" ::: "memory")
#define VM_WAIT() asm volatile("s_waitcnt vmcnt(0)" ::: "memory")
__device__ __forceinline__ unsigned f2bf(float f) { unsigned u = __builtin_bit_cast(unsigned, f); return (u + 0x7fffu + ((u >> 16) & 1u)) >> 16; }
__device__ __forceinline__ unsigned pk2(float lo, float hi) { return f2bf(lo) | (f2bf(hi) << 16); }
__device__ __forceinline__ float bflo(unsigned w) { return __builtin_bit_cast(float, w << 16); }
__device__ __forceinline__ float bfhi(unsigned w) { return __builtin_bit_cast(float, w & 0xffff0000u); }
__device__ __forceinline__ float bf2f(bf16 b) { return __builtin_bit_cast(float, (unsigned)b << 16); }
__device__ __forceinline__ float wave_sum(float v) {
#pragma unroll
    for (int o = 1; o < 64; o <<= 1) v += __shfl_xor(v, o);
    return v;
}
__device__ __forceinline__ float sigmoidf_(float x) { return 1.f / (1.f + __expf(-x)); }

#define XB_TMO      128
#define XB_XCNT(j)  (256  + 64 * (j))
#define XB_XSUB(j)  (1280 + 64 * (j))
#define XB_XGEN(j)  (2304 + 64 * (j))
#define XB_TOP      3328
#define XB_TOPGEN   3392
#define XCD_BAR_WORDS 3456
#define XB_SPIN_CAP (1u << 22)

__device__ __forceinline__ unsigned xb_ld(unsigned* p)              { return __hip_atomic_load(p, __ATOMIC_RELAXED, __HIP_MEMORY_SCOPE_AGENT); }
__device__ __forceinline__ unsigned xb_add(unsigned* p, unsigned v) { return __hip_atomic_fetch_add(p, v, __ATOMIC_RELAXED, __HIP_MEMORY_SCOPE_AGENT); }
__device__ __forceinline__ unsigned xb_xcc_id() { return (unsigned)__builtin_amdgcn_s_getreg((3 << 11) | 20) & 0xFu; }
#define XB_SPIN(cond, bar) do { unsigned _sp = 0; while (cond) { __builtin_amdgcn_s_sleep(1); \
    if ((++_sp & 255u) == 0u) { if (xb_ld(&(bar)[XB_TMO])) break; if (_sp > XB_SPIN_CAP) { atomicAdd(&(bar)[XB_TMO], 1u); break; } } } } while (0)

struct XcdBarrier {
    unsigned* bar; unsigned x;
    volatile LAS unsigned* st;
};

__device__ __forceinline__ XcdBarrier xcd_barrier_post(unsigned* bar, volatile LAS unsigned* st) {
    XcdBarrier b; b.bar = bar; b.x = xb_xcc_id(); b.st = st;
    if (threadIdx.x == 0) (void)xb_add(&bar[XB_XCNT(b.x)], 1u);
    return b;
}
__device__ __forceinline__ void xcd_barrier_complete(unsigned* bar, unsigned x, unsigned& nloc, unsigned& nx) {
    const unsigned G = gridDim.x * gridDim.y * gridDim.z;
    unsigned sum, cnt, mine, sp = 0u;
    for (;;) {
        sum = 0u; cnt = 0u; mine = 0u;
#pragma unroll
        for (unsigned j = 0; j < 16; ++j) { const unsigned c = xb_ld(&bar[XB_XCNT(j)]); sum += c; cnt += (c > 0u) ? 1u : 0u; mine = (j == x) ? c : mine; }
        if (sum == G) break;
        __builtin_amdgcn_s_sleep(1);
        if ((++sp & 255u) == 0u) { if (xb_ld(&bar[XB_TMO])) break; if (sp > XB_SPIN_CAP) { atomicAdd(&bar[XB_TMO], 1u); break; } }
    }
    nloc = mine > 0u ? mine : 1u; nx = cnt > 0u ? cnt : 1u;
}

__device__ __forceinline__ void xcd_barrier(const XcdBarrier& b) {
    asm volatile("s_waitcnt vmcnt(0)" ::: "memory");
    __syncthreads();
    if (threadIdx.x == 0) {
        unsigned* bar = b.bar;
        __builtin_amdgcn_s_waitcnt(0);
        unsigned nloc = b.st[0], nx = b.st[1];
        if (nloc == 0u) { xcd_barrier_complete(bar, b.x, nloc, nx); b.st[0] = nloc; b.st[1] = nx; }
        const unsigned old = xb_add(&bar[XB_XSUB(b.x)], 1u);
        const unsigned gen = old / nloc;
        if (old + 1u == (gen + 1u) * nloc) {
            __builtin_amdgcn_fence(__ATOMIC_RELEASE, "agent");
            asm volatile("s_waitcnt vmcnt(0)" ::: "memory");
            const unsigned og = xb_add(&bar[XB_TOP], 1u);
            const unsigned tg = og / nx;
            if (og + 1u == (tg + 1u) * nx) xb_add(&bar[XB_TOPGEN], 1u);
            else XB_SPIN(xb_ld(&bar[XB_TOPGEN]) == tg, bar);
            __builtin_amdgcn_fence(__ATOMIC_ACQUIRE, "agent");
            xb_add(&bar[XB_XGEN(b.x)], 1u);
            asm volatile("s_waitcnt vmcnt(0)" ::: "memory");
        } else {
            XB_SPIN(xb_ld(&bar[XB_XGEN(b.x)]) == gen, bar);
            __builtin_amdgcn_fence(__ATOMIC_ACQUIRE, "agent");
            asm volatile("s_waitcnt vmcnt(0)" ::: "memory");
        }
    }
    __syncthreads();
}
namespace att {
using s16x4  = __attribute__((ext_vector_type(4))) short;
using f32x16 = __attribute__((ext_vector_type(16))) float;
using u32x4  = __attribute__((ext_vector_type(4))) unsigned;
#define ATT_SBAR() __builtin_amdgcn_sched_barrier(0)
constexpr float THR2 = 11.5f;
__device__ __forceinline__ int crow(int r, int hi) { return (r & 3) + 8 * (r >> 2) + 4 * hi; }
__device__ __forceinline__ unsigned cvtpk(float lo, float hi) { unsigned r; asm volatile("v_cvt_pk_bf16_f32 %0, %1, %2" : "=v"(r) : "v"(lo), "v"(hi)); return r; }

__device__ __forceinline__ void partialSM(f32x16& p0, f32x16& p1, float& m_reg, float& mn, float& alpha) {
  float pmax = p0[0];
#pragma unroll
  for (int r = 1; r < 16; ++r) pmax = fmaxf(pmax, p0[r]);
#pragma unroll
  for (int r = 0; r < 16; ++r) pmax = fmaxf(pmax, p1[r]);
  { auto rr = __builtin_amdgcn_permlane32_swap(__float_as_uint(pmax), __float_as_uint(pmax), false, false);
    pmax = fmaxf(__uint_as_float(rr[0]), __uint_as_float(rr[1])); }
  if (__builtin_expect(__all(pmax - m_reg <= THR2), 1)) { mn = m_reg; alpha = 1.f; }
  else { mn = fmaxf(m_reg, pmax); alpha = __builtin_amdgcn_exp2f(m_reg - mn); m_reg = mn; }
#pragma unroll
  for (int r = 0; r < 16; ++r) p0[r] = p0[r] - mn;
#pragma unroll
  for (int r = 0; r < 16; ++r) p1[r] = p1[r] - mn;
#pragma unroll
  for (int r = 0; r < 16; ++r) p0[r] = __builtin_amdgcn_exp2f(p0[r]);
}
__device__ __forceinline__ void finishSM(f32x16& p0, f32x16& p1, float alpha, float& l_reg, bf16x8& pa0, bf16x8& pa1, bf16x8& pa2, bf16x8& pa3) {
#pragma unroll
  for (int r = 0; r < 16; ++r) p1[r] = __builtin_amdgcn_exp2f(p1[r]);
  float ps = 0;
#pragma unroll
  for (int r = 0; r < 16; ++r) ps += p0[r];
#pragma unroll
  for (int r = 0; r < 16; ++r) ps += p1[r];
  { auto rr = __builtin_amdgcn_permlane32_swap(__float_as_uint(ps), __float_as_uint(ps), false, false);
    ps = __uint_as_float(rr[0]) + __uint_as_float(rr[1]); }
  l_reg = l_reg * alpha + ps;
#define ATT_PK4(P, BASE, OUT) do { unsigned a0 = cvtpk(P[BASE + 0], P[BASE + 1]), a1 = cvtpk(P[BASE + 2], P[BASE + 3]);   \
    unsigned b0 = cvtpk(P[BASE + 4], P[BASE + 5]), b1 = cvtpk(P[BASE + 6], P[BASE + 7]);                              \
    auto r0 = __builtin_amdgcn_permlane32_swap(a0, b0, false, false); auto r1 = __builtin_amdgcn_permlane32_swap(a1, b1, false, false); \
    u32x4 w = {r0[0], r1[0], r0[1], r1[1]}; OUT = *reinterpret_cast<bf16x8*>(&w); } while (0)
  ATT_PK4(p0, 0, pa0); ATT_PK4(p0, 8, pa1); ATT_PK4(p1, 0, pa2); ATT_PK4(p1, 8, pa3);
#undef ATT_PK4
}
template <int NB> __device__ __forceinline__ int v_st(int k, int c) { const int kk = (k & ~0xC) | ((k & 4) << 1) | ((k & 8) >> 1); return ((kk >> 3) * NB + (c >> 5)) * 512 + ((kk & 7) * 32 + (c & 31)) * 2; }
__device__ __forceinline__ int v_rd_base(int lane) { return ((lane & 3) << 3) | (((lane >> 2) & 3) << 6) | (((lane >> 4) & 1) << 5) | (((lane >> 5) & 1) << 8); }
template <int OFF> __device__ __forceinline__ s16x4 tr_read(int vb) {
  s16x4 r; asm volatile("ds_read_b64_tr_b16 %0, %1 offset:%2" : "=&v"(r) : "v"(vb), "i"(OFF) : "memory"); return r;
}
template <int NB, int D0> __device__ __forceinline__ void pv_one(f32x16& od, int vb, bf16x8 pa0, bf16x8 pa1, bf16x8 pa2, bf16x8 pa3) {
#define ATT_VOFF(ks, half) (D0 * 512 + (ks) * (NB * 1024) + (half) * (NB * 512))
  const s16x4 l0 = tr_read<ATT_VOFF(0, 0)>(vb), h0 = tr_read<ATT_VOFF(0, 1)>(vb), l1 = tr_read<ATT_VOFF(1, 0)>(vb), h1 = tr_read<ATT_VOFF(1, 1)>(vb);
  const s16x4 l2 = tr_read<ATT_VOFF(2, 0)>(vb), h2 = tr_read<ATT_VOFF(2, 1)>(vb), l3 = tr_read<ATT_VOFF(3, 0)>(vb), h3 = tr_read<ATT_VOFF(3, 1)>(vb);
#undef ATT_VOFF
  asm volatile("s_waitcnt lgkmcnt(0)" ::: "memory"); ATT_SBAR();
#define ATT_PK(L, H) (bf16x8){L[0], L[1], L[2], L[3], H[0], H[1], H[2], H[3]}
  od = __builtin_amdgcn_mfma_f32_32x32x16_bf16(pa0, ATT_PK(l0, h0), od, 0, 0, 0);
  od = __builtin_amdgcn_mfma_f32_32x32x16_bf16(pa1, ATT_PK(l1, h1), od, 0, 0, 0);
  od = __builtin_amdgcn_mfma_f32_32x32x16_bf16(pa2, ATT_PK(l2, h2), od, 0, 0, 0);
  od = __builtin_amdgcn_mfma_f32_32x32x16_bf16(pa3, ATT_PK(l3, h3), od, 0, 0, 0);
#undef ATT_PK
}
template <int NB> __device__ __forceinline__ void pv_all(f32x16* o, int vb, bf16x8 pa0, bf16x8 pa1, bf16x8 pa2, bf16x8 pa3) {
  pv_one<NB, 0>(o[0], vb, pa0, pa1, pa2, pa3); pv_one<NB, 1>(o[1], vb, pa0, pa1, pa2, pa3);
  if constexpr (NB == 4) { pv_one<NB, 2>(o[2], vb, pa0, pa1, pa2, pa3); pv_one<NB, 3>(o[3], vb, pa0, pa1, pa2, pa3); }
}
template <int DK> __device__ __forceinline__ void qkt(f32x16& p0, f32x16& p1, LAS const char* Ks, const bf16x8* qr, int r32, int hi) {
  constexpr int KSTR = DK * 2 + 16;
  p0 = f32x16{}; p1 = f32x16{};
#pragma unroll
  for (int d0 = 0; d0 < DK / 16; ++d0) { const int cb = (d0 * 16 + hi * 8) * 2;
    const bf16x8 b0 = *(LAS const bf16x8*)(Ks + r32 * KSTR + cb);
    const bf16x8 b1 = *(LAS const bf16x8*)(Ks + (32 + r32) * KSTR + cb);
    p0 = __builtin_amdgcn_mfma_f32_32x32x16_bf16(b0, qr[d0], p0, 0, 0, 0);
    p1 = __builtin_amdgcn_mfma_f32_32x32x16_bf16(b1, qr[d0], p1, 0, 0, 0); }
}
template <int DK, int DV> struct Cfg {
  static constexpr int KSTR = DK * 2 + 16, KT = 64 * KSTR, NB = DV / 32, VT = 64 * DV * 2, NQ = DK / 16;
  static constexpr int NKC = DK / 8, NVC = DV / 8;
  static constexpr int KN = (64 * NKC + 511) / 512, VN = (64 * NVC + 511) / 512;
  static constexpr int OFF_V = 0, OFF_K = 2 * VT, OFF_WS = 2 * VT + 2 * KT, LDS_BYTES = OFF_WS + 8 * 64 * 4;
};
template <int DK, int DV>
__device__ __forceinline__ void attn_unit(const bf16* __restrict__ Qb, int ldq, const bf16* __restrict__ K1, int ldk1, const bf16* __restrict__ K2, int ldk2,
                                          const bf16* __restrict__ Vh, int ldv, float* __restrict__ Ob, int ldo, int nkeys, LAS char* lds) {
  using C = Cfg<DK, DV>;
  const int tid = threadIdx.x, wid = tid >> 6, lane = tid & 63, r32 = lane & 31, hi = lane >> 5;
  LAS char* V_lds = lds + C::OFF_V; LAS char* K_lds = lds + C::OFF_K;
  LAS float* ws = (LAS float*)(lds + C::OFF_WS) + wid * 64; LAS float* li_l = ws; LAS float* al_l = ws + 32;
  float m_reg = -1e30f, l_reg = 0; f32x16 o[C::NB] = {}; bf16x8 qr[C::NQ];
  { const bf16* Qw = Qb + (long)(wid * 32 + r32) * ldq + hi * 8;
#pragma unroll
    for (int d0 = 0; d0 < C::NQ; ++d0) qr[d0] = *(const bf16x8*)(Qw + d0 * 16); }
  unsigned kg[C::KN], kw[C::KN], vg[C::VN], vw[C::VN]; const bool k2val = tid < 256;
  kg[0] = (unsigned)((tid >> 3) * ldk1 + (tid & 7) * 8); kw[0] = (unsigned)((tid >> 3) * C::KSTR + (tid & 7) * 16);
  if constexpr (C::KN == 2) { const int t2 = tid & 255; kg[1] = (unsigned)((t2 >> 2) * ldk2 + (t2 & 3) * 8); kw[1] = (unsigned)((t2 >> 2) * C::KSTR + (8 + (t2 & 3)) * 16); }
#pragma unroll
  for (int i = 0; i < C::VN; ++i) { const int it = tid + 512 * i, vrow = it / C::NVC, vcol = (it % C::NVC) * 8; vg[i] = (unsigned)(vrow * ldv + vcol); vw[i] = (unsigned)v_st<C::NB>(vrow, vcol); }
  const int vb0 = (int)(uintptr_t)V_lds + v_rd_base(lane);
  struct Slot { bf16x8 ks[C::KN], vs[C::VN]; } sA, sB;
#define ATT_SLOAD(S, k0) do { S.ks[0] = *(const bf16x8*)(K1 + (size_t)(k0) * ldk1 + kg[0]); if constexpr (C::KN == 2) S.ks[1] = *(const bf16x8*)(K2 + (size_t)(k0) * ldk2 + kg[1]); \
    _Pragma("unroll") for (int i = 0; i < C::VN; ++i) S.vs[i] = *(const bf16x8*)(Vh + (size_t)(k0) * ldv + vg[i]); } while (0)
#define ATT_SWRITE(b, S) do { *(LAS bf16x8*)(K_lds + (b) * C::KT + kw[0]) = S.ks[0]; if constexpr (C::KN == 2) { if (k2val) *(LAS bf16x8*)(K_lds + (b) * C::KT + kw[1]) = S.ks[1]; } \
    _Pragma("unroll") for (int i = 0; i < C::VN; ++i) *(LAS bf16x8*)(V_lds + (b) * C::VT + vw[i]) = S.vs[i]; } while (0)
#define ATT_SWAIT() asm volatile("s_waitcnt vmcnt(3)" ::: "memory")
#define ATT_RESC(a) do { if (__any((a) < 1.f)) { if (hi == 0) al_l[r32] = (a); asm volatile("s_waitcnt lgkmcnt(0)" ::: "memory"); \
    _Pragma("unroll") for (int d = 0; d < C::NB; ++d) _Pragma("unroll") for (int r = 0; r < 16; ++r) o[d][r] *= al_l[crow(r, hi)]; } } while (0)
  static_assert(C::KN + C::VN == 3, "three staging loads per thread per tile (ATT_SWAIT)");
  f32x16 pA0, pA1, pB0, pB1; float mnA, mnB, alA, alB; bf16x8 pa0, pa1, pa2, pa3; const int NT = nkeys / 64;
  __syncthreads();
  ATT_SLOAD(sA, 0); asm volatile("s_waitcnt vmcnt(0)" ::: "memory"); ATT_SWRITE(0, sA); __syncthreads();
  qkt<DK>(pA0, pA1, K_lds, qr, r32, hi); partialSM(pA0, pA1, m_reg, mnA, alA);
  ATT_SLOAD(sB, 64); if (2 < NT) ATT_SLOAD(sA, 128);
  ATT_SWAIT(); ATT_SWRITE(1, sB); __syncthreads();
  for (int j = 1; j + 1 < NT; j += 2) {
    ATT_SBAR(); qkt<DK>(pB0, pB1, K_lds + C::KT, qr, r32, hi);
    finishSM(pA0, pA1, alA, l_reg, pa0, pa1, pa2, pa3); ATT_SBAR();
    ATT_SLOAD(sB, (j + 2) * 64); ATT_SBAR();
    pv_all<C::NB>(o, vb0, pa0, pa1, pa2, pa3); partialSM(pB0, pB1, m_reg, mnB, alB);
    __syncthreads(); ATT_SWAIT(); ATT_SWRITE(0, sA);
    ATT_RESC(alB); __syncthreads();
    ATT_SBAR(); qkt<DK>(pA0, pA1, K_lds, qr, r32, hi);
    finishSM(pB0, pB1, alB, l_reg, pa0, pa1, pa2, pa3); ATT_SBAR();
    if (j + 3 < NT) ATT_SLOAD(sA, (j + 3) * 64); ATT_SBAR();
    pv_all<C::NB>(o, vb0 + C::VT, pa0, pa1, pa2, pa3); partialSM(pA0, pA1, m_reg, mnA, alA);
    __syncthreads(); ATT_SWAIT(); ATT_SWRITE(1, sB);
    ATT_RESC(alA); __syncthreads();
  }
  ATT_SBAR(); qkt<DK>(pB0, pB1, K_lds + C::KT, qr, r32, hi);
  finishSM(pA0, pA1, alA, l_reg, pa0, pa1, pa2, pa3); ATT_SBAR();
  pv_all<C::NB>(o, vb0, pa0, pa1, pa2, pa3); partialSM(pB0, pB1, m_reg, mnB, alB);
  __syncthreads(); ATT_RESC(alB);
  finishSM(pB0, pB1, alB, l_reg, pa0, pa1, pa2, pa3); ATT_SBAR();
  pv_all<C::NB>(o, vb0 + C::VT, pa0, pa1, pa2, pa3);
  if (hi == 0) li_l[r32] = l_reg; asm volatile("s_waitcnt lgkmcnt(0)" ::: "memory");
  float rli[16];
#pragma unroll
  for (int r = 0; r < 16; ++r) rli[r] = __builtin_amdgcn_rcpf(li_l[crow(r, hi)]);
  float* Ow = Ob + (long)(wid * 32) * ldo;
#pragma unroll
  for (int r = 0; r < 16; ++r) { const int orow = crow(r, hi);
#pragma unroll
    for (int d0 = 0; d0 < C::NB; ++d0) Ow[(long)orow * ldo + d0 * 32 + r32] = o[d0][r] * rli[r]; }
#undef ATT_SLOAD
#undef ATT_SWRITE
#undef ATT_SWAIT
#undef ATT_RESC
}
}
constexpr int DM = 1024, NBATCH = 2, SEQ = 16384, CT = 256, TB = SEQ + CT  , R = NBATCH * TB  ;
constexpr int ATT_IN = 2208, ATT_NP = 2304, REC_IN = 3472, REC_NP = 3584, RWKV_IN = 1920;
constexpr int NE = 32, TOPK = 4, MAXT = R * TOPK / 256 + NE  , MAXROWS = MAXT * 256;
constexpr int NUNIT_M = 16 * 260;
constexpr float NORM_EPS = 1e-6f;
enum { I_X = 0, I_C, I_CTX, I_CCTX, I_NMIX, I_NFFN, I_ADAW, I_ADAB, I_WOUT, I_RW, I_RB, I_W1, I_B1, I_W2, I_B2, I_ATTW, I_LAM, I_SUBLN, I_QNW, I_KVNW, I_WUQ, I_WUKV,
       I_RECW, I_MU, I_W0, I_RW2, I_A0, I_A2, I_G2, I_KK, I_KA, I_RK, I_LNW, I_LNB, I_GATEB, I_MNW, I_FNW, N_IN };
constexpr size_t al256(size_t x) { return (x + 255) & ~(size_t)255; }
constexpr size_t WS_CTL = 0, CTL_ZERO_BYTES = 1u << 20;
constexpr size_t WS_MOD = CTL_ZERO_BYTES;
constexpr size_t WS_ROPE = al256(WS_MOD + 2 * 3 * 6144 * 4);
constexpr size_t ROPE_DR = 0, ROPE_DC = 256 * 16 * 2, ROPE_MR = ROPE_DC + 64 * 16 * 2, ROPE_MC = ROPE_MR + 256 * 8 * 2, ROPE_FLOATS = ROPE_MC + 64 * 8 * 2;
constexpr size_t WS_WRT = al256(WS_ROPE + ROPE_FLOATS * 4);
constexpr size_t WS_WIN0 = al256(WS_WRT + (size_t)2 * 8 * 1024 * 4 * 4);
constexpr size_t WS_WUQ = al256(WS_WIN0 + (size_t)ATT_NP * 1024 * 2);
constexpr size_t WS_WUKV = al256(WS_WUQ + (size_t)768 * 384 * 2);
constexpr size_t WS_WOUT = al256(WS_WUKV + (size_t)1024 * 256 * 2);
constexpr size_t WS_WREC = al256(WS_WOUT + (size_t)2 * 1024 * 1024 * 2);
constexpr size_t WS_WLORA = al256(WS_WREC + (size_t)REC_NP * 1024 * 2);
constexpr size_t WS_W1T = al256(WS_WLORA + (size_t)2560 * 384 * 2);
constexpr size_t WS_W2T = al256(WS_W1T + (size_t)NE * 2048 * 1024 * 2);
constexpr size_t WS_H = al256(WS_W2T + (size_t)NE * 1024 * 1024 * 2);
constexpr size_t WS_A = al256(WS_H + (size_t)R * 1024 * 4);
constexpr size_t WS_A1 = al256(WS_A + (size_t)R * 1024 * 2);
constexpr size_t WS_F = al256(WS_A1 + (size_t)R * 1024 * 2);
constexpr size_t WS_P = al256(WS_F + (size_t)R * 1024 * 2);
constexpr size_t WS_TOPE = al256(WS_P + (size_t)R * REC_NP * 2);
constexpr size_t WS_GATE = al256(WS_TOPE + (size_t)R * 16);
constexpr size_t WS_POS = al256(WS_GATE + (size_t)R * 16);
constexpr size_t WS_DEST = al256(WS_POS + (size_t)R * 16);
constexpr size_t WS_TILE = al256(WS_DEST + (size_t)R * 16);
constexpr size_t WS_T = al256(WS_TILE + (size_t)(MAXT + 8) * 4);
constexpr size_t WS_QD = WS_T;
constexpr size_t WS_KD = al256(WS_QD + (size_t)R * 512 * 2);
constexpr size_t WS_CQN = al256(WS_KD + (size_t)R * 512 * 2);
constexpr size_t WS_CKVN = al256(WS_CQN + (size_t)R * 384 * 2);
constexpr size_t WS_MQ = al256(WS_CKVN + (size_t)R * 256 * 2);
constexpr size_t WS_MKV = al256(WS_MQ + (size_t)R * 768 * 2);
constexpr size_t WS_KRR = al256(WS_MKV + (size_t)R * 1024 * 2);
constexpr size_t WS_ODIFF = al256(WS_KRR + (size_t)R * 32 * 2);
constexpr size_t WS_OMLA = al256(WS_ODIFF + (size_t)R * 1024 * 4);
constexpr size_t WS_T0_END = al256(WS_OMLA + (size_t)R * 512 * 4);
constexpr size_t WS_XS = WS_T;
constexpr size_t WS_HS = al256(WS_XS + (size_t)MAXROWS * 1024 * 2);
constexpr size_t WS_TM_END = al256(WS_HS + (size_t)MAXROWS * 1024 * 2);
constexpr size_t SZ_RC = (size_t)R * 512 * 4;
constexpr size_t WS_RR = WS_T, WS_VV = WS_RR + SZ_RC, WS_AKK = WS_VV + SZ_RC, WS_KL = WS_AKK + SZ_RC;
constexpr size_t WS_WDEC = WS_KL + SZ_RC  , WS_KDIR = WS_WDEC + 2 * SZ_RC  , WS_BB = WS_KDIR + 2 * SZ_RC  , WS_GG = WS_BB + 2 * SZ_RC;
constexpr size_t WS_ALORA = al256(WS_GG + SZ_RC);
constexpr size_t WS_YR = al256(WS_ALORA + (size_t)R * 384 * 2);
constexpr size_t WS_DC = WS_YR;
constexpr size_t WS_HM = al256(WS_YR + 2 * SZ_RC);
constexpr size_t WS_CST = al256(WS_HM + 2 * SZ_RC);
constexpr size_t WS_DN = al256(WS_CST + (size_t)NUNIT_M * 8192 * 4);
constexpr size_t WS_NST = al256(WS_DN + (size_t)NUNIT_M * 64 * 4);
constexpr size_t WS_SC = al256(WS_NST + (size_t)NUNIT_M * 64 * 4);
constexpr size_t WS_MST = al256(WS_SC + (size_t)NUNIT_M * 2 * 4);
constexpr int NUNIT_R = 32 * 260;
constexpr size_t WS_RKM = WS_KL;
static_assert((size_t)NUNIT_R * 4096 * 2 <= SZ_RC, "M^T fits in KL");
constexpr size_t WS_RKQ = al256(WS_MST + (size_t)NUNIT_M * 4);
constexpr size_t WS_RKZ = al256(WS_RKQ + (size_t)NUNIT_R * 4096 * 2);
constexpr size_t WS_T1_END = al256(WS_RKZ + (size_t)NUNIT_R * 4096 * 2);
constexpr size_t WS_END = WS_T1_END > WS_TM_END ? (WS_T1_END > WS_T0_END ? WS_T1_END : WS_T0_END) : (WS_TM_END > WS_T0_END ? WS_TM_END : WS_T0_END);
static_assert(WS_END <= (size_t)2147483648ull, "workspace map exceeds 2 GiB");
constexpr int CW_CNT = 1024;
constexpr int CW_BAR = 4096;
constexpr int RING_BYTES = 131072, AUX_OFF = 131072, AUX_BYTES = 16384, MISC_OFF = 147456, LDS_BYTES = 163840;

struct Frame {
    LAS unsigned char* lds; gu32* ctl; int tid, lane, wave, blk, G, probe;
    float* out; unsigned char* ws;
    struct InTab { LAS const unsigned* t;
        __device__ __forceinline__ const float* operator[](int i) const { const unsigned lo = __builtin_amdgcn_readfirstlane(t[2 * i]), hi = __builtin_amdgcn_readfirstlane(t[2 * i + 1]);
            return (const float*)(((unsigned long long)hi << 32) | lo); } } in;
};
template <class T> __device__ __forceinline__ T* wsp(const Frame& F, size_t off) { return (T*)(F.ws + off); }
__device__ __forceinline__ int row_sel(int row) { const int b = row / TB, t = row - b * TB; return t < CT ? 2 : b; }
__device__ __forceinline__ const float* h0_row(const Frame& F, int row) {
    const int b = row / TB, t = row - b * TB;
    return t < CT ? F.in[I_CTX] + ((size_t)b * CT + t) * DM : F.in[I_X] + ((size_t)b * SEQ + (t - CT)) * DM;
}
__device__ __forceinline__ const float* modp(const Frame& F, int layer, int sel, int chunk) { return wsp<const float>(F, WS_MOD) + ((size_t)(layer * 3 + sel) * 6 + chunk) * DM; }
__device__ __forceinline__ int scan_tok(int z, int sg) { return z == 0 ? sg : (sg < CT ? CT - 1 - sg : TB + CT - 1 - sg); }
__device__ __forceinline__ void tr_item(const float* W, int K, int N, bf16* WT, int row_off, LAS float* scr, int kb, int nb, int lane) {
    const int k0 = 64 * kb, n0 = 32 * nb;
    const int n = n0 + (lane & 31);
    float tv[32];
#pragma unroll
    for (int i = 0; i < 32; ++i) { const int kk = 2 * i + (lane >> 5); tv[i] = (n < N) ? W[(size_t)(k0 + kk) * N + n] : 0.f; }
#pragma unroll
    for (int i = 0; i < 32; ++i) { const int kk = 2 * i + (lane >> 5); scr[kk * 33 + (lane & 31)] = tv[i]; }
    LDS_WAIT(); asm volatile("" ::: "memory");
    const int c = lane & 7;
#pragma unroll
    for (int j = 0; j < 4; ++j) { const int nn = (lane >> 3) + 8 * j; const LAS float* s = scr + (8 * c) * 33 + nn;
        v4u o; o.x = pk2(s[0 * 33], s[1 * 33]); o.y = pk2(s[2 * 33], s[3 * 33]); o.z = pk2(s[4 * 33], s[5 * 33]); o.w = pk2(s[6 * 33], s[7 * 33]);
        *(v4u*)(WT + (size_t)(row_off + n0 + nn) * K + k0 + 8 * c) = o; }
    LDS_WAIT(); asm volatile("" ::: "memory");
}
__device__ __forceinline__ void tr_family(const Frame& F, const float* W, size_t src_stride, int nmat, int K, int N, int Npad, bf16* WT, int gw, int NGW) {
    LAS float* scr = (LAS float*)(F.lds + F.wave * 16384);
    const int nkb = K / 64, nnb = Npad / 32, per = nkb * nnb, total = per * nmat;
    for (int it = gw; it < total; it += NGW) { const int m = it / per, r = it - m * per, kb = r / nnb, nb = r - kb * nnb;
        tr_item(W + (size_t)m * src_stride, K, N, WT, m * Npad, scr, kb, nb, F.lane); }
}
__device__ __forceinline__ void moe_weights_convert(const Frame& F, int layer, int gw, int NGW) {
    tr_family(F, F.in[I_W1] + (size_t)layer * NE * 1024 * 2048, (size_t)1024 * 2048, NE, 1024, 2048, 2048, wsp<bf16>(F, WS_W1T), gw, NGW);
    tr_family(F, F.in[I_W2] + (size_t)layer * NE * 1024 * 1024, (size_t)1024 * 1024, NE, 1024, 1024, 1024, wsp<bf16>(F, WS_W2T), gw, NGW);
}
__device__ __forceinline__ void norm_mod_row(const Frame& F, const float* src, const float* nw, const float* shift, const float* scale, bf16* orow) {
    const f32x4* xr = (const f32x4*)src + F.lane;
    f32x4 v[4]; float s = 0.f;
#pragma unroll
    for (int j = 0; j < 4; ++j) { v[j] = xr[64 * j]; s += (v[j].x * v[j].x + v[j].y * v[j].y) + (v[j].z * v[j].z + v[j].w * v[j].w); }
    const float rs = 1.f / sqrtf(wave_sum(s) * (1.f / DM) + NORM_EPS);
    unsigned long long* o8 = (unsigned long long*)orow + F.lane;
#pragma unroll
    for (int j = 0; j < 4; ++j) { const f32x4 w = ((const f32x4*)nw)[F.lane + 64 * j], sh = ((const f32x4*)shift)[F.lane + 64 * j], sc = ((const f32x4*)scale)[F.lane + 64 * j];
        const f32x4 y = v[j] * rs * w * (sc + 1.f) + sh;
        o8[64 * j] = (unsigned long long)pk2(y.x, y.y) | ((unsigned long long)pk2(y.z, y.w) << 32); }
}
__device__ __forceinline__ void p0a(const Frame& F) {
    LAS float* sv = (LAS float*)F.lds; LAS float* red = (LAS float*)(F.lds + 16384);
    for (int i = F.tid; i < 3 * DM; i += 512) { const int s = i / DM, k = i - s * DM; const float cv = (s < 2) ? F.in[I_C][s * DM + k] : F.in[I_CCTX][k]; sv[i] = cv / (1.f + __expf(-cv)); }
    __syncthreads();
    for (int it = F.blk; it < 192; it += F.G) {
        const int l = it / 96, cgp = it - l * 96, kq = F.tid >> 4, cg = F.tid & 15, col = cgp * 64 + cg * 4;
        float acc[3][4];
#pragma unroll
        for (int s = 0; s < 3; ++s)
#pragma unroll
            for (int j = 0; j < 4; ++j) acc[s][j] = 0.f;
        const float* W = F.in[I_ADAW] + (size_t)l * DM * 6144 + col;
#pragma unroll 16
        for (int kk = 0; kk < 32; ++kk) { const int k = kq * 32 + kk; const f32x4 w = *(const f32x4*)(W + (size_t)k * 6144);
            const float s0 = sv[k], s1 = sv[DM + k], s2 = sv[2 * DM + k];
#pragma unroll
            for (int j = 0; j < 4; ++j) { acc[0][j] += s0 * w[j]; acc[1][j] += s1 * w[j]; acc[2][j] += s2 * w[j]; } }
#pragma unroll
        for (int s = 0; s < 3; ++s)
#pragma unroll
            for (int j = 0; j < 4; ++j) red[(kq * 16 + cg) * 12 + s * 4 + j] = acc[s][j];
        __syncthreads();
        if (F.tid < 192) { const int s = F.tid / 64, cc = F.tid - s * 64, cg2 = cc >> 2, j = cc & 3; float t = 0.f;
            for (int q = 0; q < 32; ++q) t += red[(q * 16 + cg2) * 12 + s * 4 + j];
            wsp<float>(F, WS_MOD)[(size_t)(l * 3 + s) * 6144 + cgp * 64 + cc] = t + F.in[I_ADAB][l * 6144 + cgp * 64 + cc]; }
        __syncthreads();
    }
    const int gid = F.blk * 512 + F.tid, GT = F.G * 512;
    float* rope = wsp<float>(F, WS_ROPE);
    for (int i = gid; i < 256 * 16 + 64 * 16 + 256 * 8 + 64 * 8; i += GT) {
        int j = i; float pos, inv; size_t off;
        if (j < 256 * 16) { pos = (float)(j / 16); inv = powf(10000.f, -(float)(j % 16) / 16.f); off = ROPE_DR + (size_t)j * 2; }
        else if ((j -= 256 * 16) < 64 * 16) { pos = (float)(j / 16); inv = powf(10000.f, -(float)(j % 16) / 16.f); off = ROPE_DC + (size_t)j * 2; }
        else if ((j -= 64 * 16) < 256 * 8) { pos = (float)(j / 8); inv = powf(10000.f, -(float)(j % 8) / 8.f); off = ROPE_MR + (size_t)j * 2; }
        else { j -= 256 * 8; pos = (float)(j / 8); inv = powf(10000.f, -(float)(j % 8) / 8.f); off = ROPE_MC + (size_t)j * 2; }
        const float ang = pos * inv; rope[off] = cosf(ang); rope[off + 1] = sinf(ang);
    }
    { float* wrt = wsp<float>(F, WS_WRT); for (int i = gid; i < 2 * 8 * 1024 * 4; i += GT) { const int e4 = i & 3, k = (i >> 2) & 1023, wv = (i >> 12) & 7, l = i >> 15; wrt[i] = F.in[I_RW][((size_t)l * DM + k) * NE + 4 * wv + e4]; } }
    bf16* WL = wsp<bf16>(F, WS_WLORA);
    for (int i = gid; i < 2560 * 384; i += GT) { const int n = i / 384, k = i - n * 384, part = n >> 9, c = n & 511; float v = 0.f;
        if (part < 2) { if ((k >> 6) == part) v = F.in[I_RW2][((size_t)part * 64 + (k & 63)) * 512 + c]; }
        else if (part < 4) { if ((k >> 6) == part) v = F.in[I_A2][((size_t)(part - 2) * 64 + (k & 63)) * 512 + c]; }
        else { if (k >= 256) v = F.in[I_G2][(size_t)(k - 256) * 512 + c]; }
        WL[i] = (bf16)f2bf(v); }
    const int gw = F.blk * 8 + F.wave, NGW = F.G * 8;
    tr_family(F, F.in[I_ATTW], 0, 1, 1024, ATT_IN, ATT_NP, wsp<bf16>(F, WS_WIN0), gw, NGW);
    tr_family(F, F.in[I_WUQ], 0, 1, 384, 768, 768, wsp<bf16>(F, WS_WUQ), gw, NGW);
    tr_family(F, F.in[I_WUKV], 0, 1, 256, 1024, 1024, wsp<bf16>(F, WS_WUKV), gw, NGW);
    tr_family(F, F.in[I_WOUT], (size_t)1024 * 1024, 2, 1024, 1024, 1024, wsp<bf16>(F, WS_WOUT), gw, NGW);
    tr_family(F, F.in[I_RECW], 0, 1, 1024, REC_IN, REC_NP, wsp<bf16>(F, WS_WREC), gw, NGW);
    moe_weights_convert(F, 0, gw, NGW);
}
__device__ __forceinline__ void p0b(const Frame& F) {
    const int gw = F.blk * 8 + F.wave, NGW = F.G * 8;
    for (int row = gw; row < R; row += NGW) { const int sel = row_sel(row);
        norm_mod_row(F, h0_row(F, row), F.in[I_NMIX], modp(F, 0, sel, 0), modp(F, 0, sel, 1), wsp<bf16>(F, WS_A) + (size_t)row * DM); }
}
struct FnStoreBf16 {
    bf16* O; int ldc;
    __device__ __forceinline__ void operator()(int row, int col, f32x4 v0, f32x4 v1) const {
        v4u w; w.x = pg8::cvt_pk_bf16(v0[0], v0[1]); w.y = pg8::cvt_pk_bf16(v0[2], v0[3]); w.z = pg8::cvt_pk_bf16(v1[0], v1[1]); w.w = pg8::cvt_pk_bf16(v1[2], v1[3]);
        *(v4u*)(O + (size_t)row * ldc + col) = w; }
};
struct FnWout {
    const Frame* F; int layer;
    __device__ __forceinline__ void operator()(int row, int col, f32x4 v0, f32x4 v1) const {
        float* hrow = wsp<float>(*F, WS_H) + (size_t)row * DM + col;
        const float* base = (layer == 0) ? h0_row(*F, row) + col : hrow;
        const float* g = modp(*F, layer, row_sel(row), 2) + col;
        const f32x4 b0 = *(const f32x4*)base, b1 = *(const f32x4*)(base + 4), g0 = *(const f32x4*)g, g1 = *(const f32x4*)(g + 4);
        *(f32x4*)hrow = b0 + g0 * v0; *(f32x4*)(hrow + 4) = b1 + g1 * v1; }
};
__device__ __forceinline__ void l0_post_proj(const Frame& F) {
    const int gw = F.blk * 8 + F.wave, NGW = F.G * 8, lane = F.lane;
    const bf16* P = wsp<const bf16>(F, WS_P); const float* rope = wsp<const float>(F, WS_ROPE);
    constexpr float CD = 0.125f * 1.4426950408889634f;
    for (int row = gw; row < R; row += NGW) {
        const int b = row / TB, t = row - b * TB; const bool lat = t >= CT; const int pos = t - CT, prow = lat ? pos >> 6 : 0, pcol = lat ? pos & 63 : 0;
        const bf16* p = P + (size_t)row * ATT_NP;
        bf16* qd = wsp<bf16>(F, WS_QD) + (size_t)row * 512; bf16* kd = wsp<bf16>(F, WS_KD) + (size_t)row * 512;
#pragma unroll
        for (int j = 0; j < 8; ++j) { const int pr = lane + 64 * j, h16 = pr >> 5, i = pr & 31;
            const float x1 = bf2f(p[h16 * 64 + i]), x2 = bf2f(p[h16 * 64 + i + 32]); float c = 1.f, s = 0.f;
            if (lat) { const float* tb = (i < 16) ? rope + ROPE_DR + (size_t)(prow * 16 + i) * 2 : rope + ROPE_DC + (size_t)(pcol * 16 + i - 16) * 2; c = tb[0]; s = tb[1]; }
            float y1 = x1 * c - x2 * s, y2 = x1 * s + x2 * c;
            if (h16 < 8) { qd[h16 * 64 + i] = (bf16)f2bf(y1 * CD); qd[h16 * 64 + i + 32] = (bf16)f2bf(y2 * CD); }
            else { kd[(h16 - 8) * 64 + i] = (bf16)f2bf(y1); kd[(h16 - 8) * 64 + i + 32] = (bf16)f2bf(y2); } }
        { float x[6]; float ss = 0.f;
#pragma unroll
          for (int j = 0; j < 6; ++j) { x[j] = bf2f(p[1536 + lane + 64 * j]); ss += x[j] * x[j]; }
          const float rs = 1.f / sqrtf(wave_sum(ss) * (1.f / 384.f) + NORM_EPS); bf16* o = wsp<bf16>(F, WS_CQN) + (size_t)row * 384;
#pragma unroll
          for (int j = 0; j < 6; ++j) o[lane + 64 * j] = (bf16)f2bf(x[j] * rs * F.in[I_QNW][lane + 64 * j]); }
        { float x[4]; float ss = 0.f;
#pragma unroll
          for (int j = 0; j < 4; ++j) { x[j] = bf2f(p[1920 + lane + 64 * j]); ss += x[j] * x[j]; }
          const float rs = 1.f / sqrtf(wave_sum(ss) * (1.f / 256.f) + NORM_EPS); bf16* o = wsp<bf16>(F, WS_CKVN) + (size_t)row * 256;
#pragma unroll
          for (int j = 0; j < 4; ++j) o[lane + 64 * j] = (bf16)f2bf(x[j] * rs * F.in[I_KVNW][lane + 64 * j]); }
        if (lane < 16) { const int i = lane; const float x1 = bf2f(p[2176 + i]), x2 = bf2f(p[2176 + i + 16]); float c = 1.f, s = 0.f;
            if (lat) { const float* tb = (i < 8) ? rope + ROPE_MR + (size_t)(prow * 8 + i) * 2 : rope + ROPE_MC + (size_t)(pcol * 8 + i - 8) * 2; c = tb[0]; s = tb[1]; }
            bf16* o = wsp<bf16>(F, WS_KRR) + (size_t)row * 32; o[i] = (bf16)f2bf(x1 * c - x2 * s); o[i + 16] = (bf16)f2bf(x1 * s + x2 * c); }
    }
}
__device__ __forceinline__ void l0_mq_rope(const Frame& F) {
    const int gw = F.blk * 8 + F.wave, NGW = F.G * 8, lane = F.lane; const float* rope = wsp<const float>(F, WS_ROPE);
    const float CM = 0.10206207261596575f * 1.4426950408889634f;
    for (int row = gw; row < R; row += NGW) {
        const int b = row / TB, t = row - b * TB; const bool lat = t >= CT; const int pos = t - CT, prow = lat ? pos >> 6 : 0, pcol = lat ? pos & 63 : 0;
        bf16* q = wsp<bf16>(F, WS_MQ) + (size_t)row * 768;
#pragma unroll
        for (int j = 0; j < 8; ++j) { const int idx = lane + 64 * j, h = idx >> 6, d = idx & 63; q[h * 96 + d] = (bf16)f2bf(bf2f(q[h * 96 + d]) * CM); }
#pragma unroll
        for (int j = 0; j < 2; ++j) { const int pr = lane + 64 * j, h = pr >> 4, i = pr & 15; const float x1 = bf2f(q[h * 96 + 64 + i]), x2 = bf2f(q[h * 96 + 80 + i]); float c = 1.f, s = 0.f;
            if (lat) { const float* tb = (i < 8) ? rope + ROPE_MR + (size_t)(prow * 8 + i) * 2 : rope + ROPE_MC + (size_t)(pcol * 8 + i - 8) * 2; c = tb[0]; s = tb[1]; }
            q[h * 96 + 64 + i] = (bf16)f2bf((x1 * c - x2 * s) * CM); q[h * 96 + 80 + i] = (bf16)f2bf((x1 * s + x2 * c) * CM); }
    }
}
__device__ __forceinline__ void l0_attention(const Frame& F) {
    LAS char* lds = (LAS char*)F.lds;
    const bf16* QD = wsp<const bf16>(F, WS_QD); const bf16* KD = wsp<const bf16>(F, WS_KD); const bf16* P = wsp<const bf16>(F, WS_P);
    const bf16* MQ = wsp<const bf16>(F, WS_MQ); const bf16* MKV = wsp<const bf16>(F, WS_MKV); const bf16* KRR = wsp<const bf16>(F, WS_KRR);
    float* OD = wsp<float>(F, WS_ODIFF); float* OM = wsp<float>(F, WS_OMLA);
    for (int kind = 0; kind < 2; ++kind) {
        for (int L = F.blk; L < 1024 + 16; L += F.G) {
            int b, h8, qb, nkeys;
            if (L < 1024) { int pair;
                if (F.G == 256) { const int round = L >> 8, c = L & 255; pair = round * 4 + ((c & 7) >> 1); qb = 1 + (c & 1) * 32 + (c >> 3); }
                else { pair = L >> 6; qb = 1 + (L & 63); }
                b = pair >> 3; h8 = pair & 7; nkeys = TB; }
            else { const int s = L - 1024; b = s >> 3; h8 = s & 7; qb = 0; nkeys = CT; }
            const size_t q0 = (size_t)b * TB + (size_t)qb * 256, k0 = (size_t)b * TB;
            if (kind == 0)
                att::attn_unit<64, 128>(QD + q0 * 512 + h8 * 64, 512, KD + k0 * 512 + h8 * 64, 512, nullptr, 0, P + k0 * ATT_NP + 1024 + (h8 >> 1) * 128, ATT_NP,
                                        OD + q0 * 1024 + h8 * 128, 1024, nkeys, lds);
            else
                att::attn_unit<96, 64>(MQ + q0 * 768 + h8 * 96, 768, MKV + k0 * 1024 + h8 * 128, 1024, KRR + k0 * 32, 32, MKV + k0 * 1024 + h8 * 128 + 64, 1024,
                                       OM + q0 * 512 + h8 * 64, 512, nkeys, lds);
        }
    }
}
__device__ __forceinline__ void l0_combine(const Frame& F) {
    const int gw = F.blk * 8 + F.wave, NGW = F.G * 8, lane = F.lane;
    const float* lv = F.in[I_LAM];
    const float lam = __expf(wave_sum(lv[lane] * lv[64 + lane])) - __expf(wave_sum(lv[128 + lane] * lv[192 + lane])) + 0.2f;
    const float sw0 = F.in[I_SUBLN][2 * lane] * 0.8f, sw1 = F.in[I_SUBLN][2 * lane + 1] * 0.8f;
    for (int row = gw; row < R; row += NGW) {
        const float* od = wsp<const float>(F, WS_ODIFF) + (size_t)row * 1024; const float* om = wsp<const float>(F, WS_OMLA) + (size_t)row * 512;
        bf16* a1 = wsp<bf16>(F, WS_A1) + (size_t)row * DM;
#pragma unroll
        for (int h = 0; h < 4; ++h) {
            const float o1a = od[(2 * h) * 128 + 2 * lane], o1b = od[(2 * h) * 128 + 2 * lane + 1], o2a = od[(2 * h + 1) * 128 + 2 * lane], o2b = od[(2 * h + 1) * 128 + 2 * lane + 1];
            const float da = o1a - lam * o2a, db = o1b - lam * o2b;
            const float rs = 1.f / sqrtf(wave_sum(da * da + db * db) * (1.f / 128.f) + NORM_EPS);
            *(unsigned*)(a1 + h * 128 + 2 * lane) = pk2(da * rs * sw0, db * rs * sw1); }
#pragma unroll
        for (int j = 0; j < 2; ++j) { const f32x4 v = *(const f32x4*)(om + 4 * (lane + 64 * j)); v2u w; w.x = pk2(v.x, v.y); w.y = pk2(v.z, v.w); *(v2u*)(a1 + 512 + 4 * (lane + 64 * j)) = w; }
    }
}
constexpr int RT_MAXROWS = 24;
__device__ __forceinline__ void ph_router(const Frame& F, int layer) {
    LAS float* Wr = (LAS float*)F.lds;
    LAS float* fst = (LAS float*)(F.lds + AUX_OFF) + F.wave * 512;
    LAS int* hist = (LAS int*)(F.lds + MISC_OFF + 256);
    LAS int* recs = hist + 64 + F.wave * (RT_MAXROWS * 4);
    const int lane = F.lane, gw = F.blk * 8 + F.wave, NGW = F.G * 8;
    { const f32x4* src = (const f32x4*)(F.in[I_RW] + (size_t)layer * DM * NE);
      for (int i = F.tid; i < DM * NE / 4; i += 512) ((LAS f32x4*)Wr)[i] = src[i];
      if (F.tid < 64) hist[F.tid] = 0; }
    __syncthreads();
    const float* nw = F.in[I_NFFN] + (size_t)layer * DM; const float rb = F.in[I_RB][layer * NE + (lane & 31)];
    int ri = 0;
    for (int row = gw; row < R; row += NGW, ++ri) {
        const int sel = row_sel(row); const float* sh = modp(F, layer, sel, 3); const float* sc = modp(F, layer, sel, 4);
        const f32x4* xr = (const f32x4*)(wsp<const float>(F, WS_H) + (size_t)row * DM) + lane;
        f32x4 v[4]; float s = 0.f;
#pragma unroll
        for (int j = 0; j < 4; ++j) { v[j] = xr[64 * j]; s += (v[j].x * v[j].x + v[j].y * v[j].y) + (v[j].z * v[j].z + v[j].w * v[j].w); }
        const float rs = 1.f / sqrtf(wave_sum(s) * (1.f / DM) + NORM_EPS);
        unsigned long long* o8 = (unsigned long long*)(wsp<bf16>(F, WS_F) + (size_t)row * DM) + lane;
#pragma unroll
        for (int j = 0; j < 4; ++j) { const f32x4 w = ((const f32x4*)nw)[lane + 64 * j], a = ((const f32x4*)sh)[lane + 64 * j], c = ((const f32x4*)sc)[lane + 64 * j];
            v[j] = v[j] * rs * w * (c + 1.f) + a;
            o8[64 * j] = (unsigned long long)pk2(v[j].x, v[j].y) | ((unsigned long long)pk2(v[j].z, v[j].w) << 32); }
        float acc0 = 0.f, acc1 = 0.f, acc2 = 0.f, acc3 = 0.f; const int e = lane & 31, hf = lane >> 5;
#pragma unroll
        for (int ps = 0; ps < 2; ++ps) {
            ((LAS f32x4*)fst)[lane] = v[2 * ps]; ((LAS f32x4*)fst)[64 + lane] = v[2 * ps + 1];
            LDS_WAIT(); asm volatile("" ::: "memory");
            const LAS float* wp = Wr + (size_t)(512 * ps + 256 * hf) * NE + e; const LAS f32x4* fp = (const LAS f32x4*)(fst + 256 * hf);
#pragma unroll 8
            for (int k4 = 0; k4 < 64; ++k4) { const f32x4 f4 = fp[k4];
                acc0 += f4.x * wp[(4 * k4) * NE]; acc1 += f4.y * wp[(4 * k4 + 1) * NE]; acc2 += f4.z * wp[(4 * k4 + 2) * NE]; acc3 += f4.w * wp[(4 * k4 + 3) * NE]; }
            LDS_WAIT(); asm volatile("" ::: "memory");
        }
        const float acc = (acc0 + acc1) + (acc2 + acc3); float logit = acc + __shfl_xor(acc, 32) + rb;
        float selv[4]; int seli[4]; float val = logit;
#pragma unroll
        for (int r = 0; r < 4; ++r) { float bv = val; int bi = e;
#pragma unroll
            for (int o = 1; o < 32; o <<= 1) { const float ov = __shfl_xor(bv, o); const int oi = __shfl_xor(bi, o); if (ov > bv || (ov == bv && oi < bi)) { bv = ov; bi = oi; } }
            selv[r] = bv; seli[r] = bi; if (e == bi) val = -3.0e38f; }
        float ex[4], es = 0.f;
#pragma unroll
        for (int r = 0; r < 4; ++r) { ex[r] = __expf(selv[r] - selv[0]); es += ex[r]; }
        if (lane < 4) { const int r = lane; const int ee = r == 0 ? seli[0] : r == 1 ? seli[1] : r == 2 ? seli[2] : seli[3]; const float gg = (r == 0 ? ex[0] : r == 1 ? ex[1] : r == 2 ? ex[2] : ex[3]) / es;
            wsp<int>(F, WS_TOPE)[(size_t)row * 4 + r] = ee; wsp<float>(F, WS_GATE)[(size_t)row * 4 + r] = gg;
            const int rk = __hip_atomic_fetch_add(&hist[ee], 1, __ATOMIC_RELAXED, __HIP_MEMORY_SCOPE_WORKGROUP);
            if (ri < RT_MAXROWS) recs[ri * 4 + r] = ee | (rk << 8); }
    }
    __syncthreads();
    if (F.tid < NE) hist[32 + F.tid] = (int)__hip_atomic_fetch_add(F.ctl + CW_CNT + 64 * (layer + 2 * F.probe) + F.tid, (unsigned)hist[F.tid], RLX_AGENT);
    __syncthreads();
    ri = 0;
    for (int row = gw; row < R; row += NGW, ++ri)
        if (lane < 4 && ri < RT_MAXROWS) { const int rc = recs[ri * 4 + lane]; wsp<int>(F, WS_POS)[(size_t)row * 4 + lane] = hist[32 + (rc & 255)] + (rc >> 8); }
}
__device__ __forceinline__ void moe_tables(const Frame& F, int layer, LAS int* ps, LAS int* tile_e) {
    if (F.tid == 0) { int acc = 0, t = 0;
        for (int e = 0; e < NE; ++e) { const int c = (int)__hip_atomic_load(F.ctl + CW_CNT + 64 * layer + e, RLX_AGENT); ps[e] = acc; const int nt = (c + 255) >> 8;
            for (int i = 0; i < nt && t < MAXT; ++i) tile_e[t++] = e; acc += nt * 256; }
        ps[NE] = acc; ps[NE + 1] = t; }
    __syncthreads();
}
__device__ __forceinline__ void ph_gather(const Frame& F, int layer) {
    LAS int* ps = (LAS int*)(F.lds + MISC_OFF + 256); LAS int* tile_e = ps + 64;
    moe_tables(F, layer, ps, tile_e);
    if (F.blk == 0) { int* tab = wsp<int>(F, WS_TILE); const int nt = ps[NE + 1]; if (F.tid == 0) tab[0] = nt; for (int i = F.tid; i < nt; i += 512) tab[1 + i] = tile_e[i]; }
    const int lane = F.lane, gw = F.blk * 8 + F.wave, NGW = F.G * 8;
    for (int row = gw; row < R; row += NGW) {
        int dest = 0;
        if (lane < 4) { const int e = wsp<const int>(F, WS_TOPE)[(size_t)row * 4 + lane]; dest = ps[e] + wsp<const int>(F, WS_POS)[(size_t)row * 4 + lane]; wsp<int>(F, WS_DEST)[(size_t)row * 4 + lane] = dest; }
        const v4u* src = (const v4u*)(wsp<const bf16>(F, WS_F) + (size_t)row * DM); const v4u a = src[lane], b = src[64 + lane];
#pragma unroll
        for (int r = 0; r < 4; ++r) { const int d = __shfl(dest, r); v4u* dst = (v4u*)(wsp<bf16>(F, WS_XS) + (size_t)d * DM); dst[lane] = a; dst[64 + lane] = b; }
    }
}
struct MoeOrder {
    const int* tile_e; int ntiles, nN, G, c;
    __device__ __forceinline__ bool next(int i, pg8::Unit& u) const {
        int rt, pl;
        if (G == 256) { const int x = c & 7, y = c >> 3, rpx = 32 / nN; rt = (i * 8 + x) * rpx + y / nN; pl = y % nN; if (rt >= ntiles) return false; }
        else { const long L = (long)i * G + c; if (L >= (long)ntiles * nN) return false; rt = (int)(L / nN); pl = (int)(L - (long)rt * nN); }
        const int e = __builtin_amdgcn_readfirstlane(tile_e[rt]);
        u.pm = rt; u.pn = e * nN + pl; return true; }
    __device__ __forceinline__ void a_ready(const pg8::Unit&) const {}
    __device__ __forceinline__ void done(const pg8::Unit&) const {}
};
struct FnSwiglu {
    bf16* HS; const float* b1;
    __device__ __forceinline__ void operator()(int row, int col, f32x4 v0, f32x4 v1) const {
        const float* bp = b1 + col;
        const f32x4 b0 = *(const f32x4*)bp, b1v = *(const f32x4*)(bp + 4); v0 = v0 + b0; v1 = v1 + b1v;
        const float hv[8] = {v0[0], v0[1], v0[2], v0[3], v1[0], v1[1], v1[2], v1[3]}; float o[4];
#pragma unroll
        for (int i = 0; i < 4; ++i) { const float g = hv[2 * i], l = hv[2 * i + 1];
            const float gl = fminf(g, 7.f), li = fminf(fmaxf(l, -7.f), 7.f); o[i] = gl * sigmoidf_(1.702f * gl) * (li + 1.f); }
        const int lc = col & 2047; v2u w; w.x = pk2(o[0], o[1]); w.y = pk2(o[2], o[3]);
        *(v2u*)(HS + (size_t)row * 1024 + (lc >> 1)) = w; }
};
struct FnBiasBf16 {
    bf16* YS; const float* b2;
    __device__ __forceinline__ void operator()(int row, int col, f32x4 v0, f32x4 v1) const {
        const f32x4 b0 = *(const f32x4*)(b2 + col), b1v = *(const f32x4*)(b2 + col + 4); v0 = v0 + b0; v1 = v1 + b1v;
        v4u w; w.x = pk2(v0[0], v0[1]); w.y = pk2(v0[2], v0[3]); w.z = pk2(v1[0], v1[1]); w.w = pk2(v1[2], v1[3]);
        *(v4u*)(YS + (size_t)row * 1024 + (col & 1023)) = w; }
};
__device__ __forceinline__ void ph_combine(const Frame& F, int layer) {
    const int lane = F.lane, gw = F.blk * 8 + F.wave, NGW = F.G * 8;
    for (int row = gw; row < R; row += NGW) {
        const int sel = row_sel(row); const float* gf = modp(F, layer, sel, 5);
        float* hrow = wsp<float>(F, WS_H) + (size_t)row * DM;
        f32x4 y[4];
#pragma unroll
        for (int j = 0; j < 4; ++j) y[j] = (f32x4){0.f, 0.f, 0.f, 0.f};
#pragma unroll
        for (int r = 0; r < 4; ++r) { const int d = wsp<const int>(F, WS_DEST)[(size_t)row * 4 + r]; const float g = wsp<const float>(F, WS_GATE)[(size_t)row * 4 + r];
            const v2u* yp = (const v2u*)(wsp<const bf16>(F, WS_XS) + (size_t)d * DM);
#pragma unroll
            for (int j = 0; j < 4; ++j) { const v2u w = yp[lane + 64 * j]; y[j] += g * (f32x4){bflo(w.x), bfhi(w.x), bflo(w.y), bfhi(w.y)}; } }
        f32x4 h[4]; float s = 0.f;
#pragma unroll
        for (int j = 0; j < 4; ++j) { h[j] = ((const f32x4*)hrow)[lane + 64 * j] + ((const f32x4*)gf)[lane + 64 * j] * y[j]; s += (h[j].x * h[j].x + h[j].y * h[j].y) + (h[j].z * h[j].z + h[j].w * h[j].w); }
        const float rs = 1.f / sqrtf(wave_sum(s) * (1.f / DM) + NORM_EPS);
        if (layer == 0) {
#pragma unroll
            for (int j = 0; j < 4; ++j) ((f32x4*)hrow)[lane + 64 * j] = h[j];
            const float* nw = F.in[I_NMIX] + DM; const float* sh = modp(F, 1, sel, 0); const float* sc = modp(F, 1, sel, 1);
            unsigned long long* o8 = (unsigned long long*)(wsp<bf16>(F, WS_A) + (size_t)row * DM) + lane;
#pragma unroll
            for (int j = 0; j < 4; ++j) { const f32x4 w = ((const f32x4*)nw)[lane + 64 * j], a = ((const f32x4*)sh)[lane + 64 * j], c = ((const f32x4*)sc)[lane + 64 * j];
                const f32x4 o = h[j] * rs * w * (c + 1.f) + a; o8[64 * j] = (unsigned long long)pk2(o.x, o.y) | ((unsigned long long)pk2(o.z, o.w) << 32); }
        } else {
            const int b = row / TB, t = row - b * TB;
            if (t >= CT) { float* orow = F.out + ((size_t)b * SEQ + (t - CT)) * DM; const float* nw = F.in[I_FNW];
#pragma unroll
                for (int j = 0; j < 4; ++j) ((f32x4*)orow)[lane + 64 * j] = h[j] * rs * ((const f32x4*)nw)[lane + 64 * j]; }
        }
    }
}
constexpr int PC_Q = 1920, PC_K = 2176, PC_V = 2432, PC_O = 2944, PC_G = 3456;
__device__ __forceinline__ float softplusf_(float y) { return fmaxf(y, 0.f) + __logf(1.f + __expf(-fabsf(y))); }
__device__ __forceinline__ float tanhf_(float x) { return 1.f - 2.f / (1.f + __expf(2.f * x)); }
__device__ __forceinline__ void unpack8(v4u w, float (&x)[8]) { x[0] = bflo(w.x); x[1] = bfhi(w.x); x[2] = bflo(w.y); x[3] = bfhi(w.y); x[4] = bflo(w.z); x[5] = bfhi(w.z); x[6] = bflo(w.w); x[7] = bfhi(w.w); }
__device__ __forceinline__ void lerp8(const bf16* p, bool hp, bool hn, int c0, const float* mu, float (&u)[8]) {
    const v4u z4 = {0u, 0u, 0u, 0u};
    const v4u wx = *(const v4u*)(p + c0), wp = hp ? *(const v4u*)(p - REC_NP + c0) : z4, wn = hn ? *(const v4u*)(p + REC_NP + c0) : z4;
    float x[8], xp[8], xn[8]; unpack8(wx, x); unpack8(wp, xp); unpack8(wn, xn);
    const f32x4 m0 = *(const f32x4*)(mu + c0), m1 = *(const f32x4*)(mu + c0 + 4);
#pragma unroll
    for (int e = 0; e < 8; ++e) { const float m = e < 4 ? m0[e & 3] : m1[e & 3]; u[e] = x[e] + m * (0.5f * (xp[e] + xn[e]) - x[e]); }
}
__device__ __forceinline__ void st8f(float* o, const float (&u)[8]) { *(f32x4*)o = (f32x4){u[0], u[1], u[2], u[3]}; *(f32x4*)(o + 4) = (f32x4){u[4], u[5], u[6], u[7]}; }
__device__ __forceinline__ void l1_rwkv_prep(const Frame& F) {
    const int gw = F.blk * 8 + F.wave, NGW = F.G * 8, lane = F.lane; const float* mu = F.in[I_MU];
    for (int row = gw; row < R; row += NGW) {
        const int b = row / TB, t = row - b * TB; const bool hp = (t != 0 && t != CT), hn = (t != CT - 1 && t != TB - 1);
        const bf16* p = wsp<const bf16>(F, WS_P) + (size_t)row * REC_NP; const size_t ro = (size_t)row * 512 + 8 * lane;
        float u[8];
        lerp8(p, hp, hn, 8 * lane, mu, u); st8f(wsp<float>(F, WS_RR) + ro, u);
        lerp8(p, hp, hn, 1024 + 8 * lane, mu, u); st8f(wsp<float>(F, WS_VV) + ro, u);
        lerp8(p, hp, hn, 512 + 8 * lane, mu, u); st8f(wsp<float>(F, WS_KL) + ro, u);
        { const f32x4 k0 = *(const f32x4*)(F.in[I_KK] + 8 * lane), k1 = *(const f32x4*)(F.in[I_KK] + 8 * lane + 4); float ss = 0.f;
#pragma unroll
          for (int e = 0; e < 8; ++e) { u[e] *= (e < 4 ? k0[e & 3] : k1[e & 3]); ss += u[e] * u[e]; }
          ss += __shfl_xor(ss, 1); ss += __shfl_xor(ss, 2); ss += __shfl_xor(ss, 4);
          const float inv = -1.f / sqrtf(fmaxf(ss, 1e-24f));
#pragma unroll
          for (int e = 0; e < 8; ++e) u[e] *= inv;
          st8f(wsp<float>(F, WS_AKK) + ro, u); }
        if (lane < 48) { lerp8(p, hp, hn, 1536 + 8 * lane, mu, u);
#pragma unroll
            for (int e = 0; e < 8; ++e) u[e] = lane < 16 ? tanhf_(u[e]) : (lane < 32 ? u[e] : sigmoidf_(u[e]));
            v4u w; w.x = pk2(u[0], u[1]); w.y = pk2(u[2], u[3]); w.z = pk2(u[4], u[5]); w.w = pk2(u[6], u[7]);
            *(v4u*)(wsp<bf16>(F, WS_ALORA) + (size_t)row * 384 + 8 * lane) = w; }
    }
}
struct EpiLora {
    static constexpr bool PERM = true, AFTER_DRAIN = false;
    const Frame* F;
    template <int KIND> __device__ __forceinline__ void run(const pg8::f32x4 (&acc)[2][2][4][2], const pg8::Unit& u, int wr, int wc, int fr, int fq, int z) const {
#pragma unroll
        for (int ai = 0; ai < 2; ++ai)
#pragma unroll
            for (int m = 0; m < 4; ++m) { const int row = u.pm * 256 + ai * 128 + wr * 64 + m * 16 + fr;
#pragma unroll
                for (int bj = 0; bj < 2; ++bj) { const int c = ((u.pn & 1) * 256) + bj * 128 + wc * 32 + 8 * fq; const size_t ro = (size_t)row * 512 + c;
                    const pg8::f32x4 v0 = acc[ai][bj][m][0], v1 = acc[ai][bj][m][1]; const float x[8] = {v0[0], v0[1], v0[2], v0[3], v1[0], v1[1], v1[2], v1[3]}; float o[8];
                    if constexpr (KIND == 0) { const float* w0 = F->in[I_W0] + z * 512 + c;
#pragma unroll
                        for (int e = 0; e < 8; ++e) { const float wl = -softplusf_(-(w0[e] + x[e])) - 0.5f; o[e] = __expf(-__expf(wl)); }
                        st8f(wsp<float>(*F, WS_WDEC) + (size_t)z * R * 512 + ro, o); }
                    else if constexpr (KIND == 1) { const float* a0 = F->in[I_A0] + z * 512 + c; const float* ka = F->in[I_KA] + c;
                        const float* kl = wsp<const float>(*F, WS_KL) + ro; const float* ak = wsp<const float>(*F, WS_AKK) + ro; float o2[8];
#pragma unroll
                        for (int e = 0; e < 8; ++e) { const float a = sigmoidf_(a0[e] + x[e]); o[e] = kl[e] * (1.f + (a - 1.f) * ka[e]); o2[e] = -ak[e] * a; }
                        st8f(wsp<float>(*F, WS_KDIR) + (size_t)z * R * 512 + ro, o); st8f(wsp<float>(*F, WS_BB) + (size_t)z * R * 512 + ro, o2); }
                    else st8f(wsp<float>(*F, WS_GG) + ro, x); } }
    }
    __device__ __forceinline__ void operator()(const pg8::f32x4 (&acc)[2][2][4][2], const pg8::Unit& u, int wr, int wc, int fr, int fq) const {
        const int part = u.pn >> 1;
        if (part < 2) run<0>(acc, u, wr, wc, fr, fq, part); else if (part < 4) run<1>(acc, u, wr, wc, fr, fq, part - 2); else run<2>(acc, u, wr, wc, fr, fq, 0);
    }
};
__device__ __forceinline__ void mlstm_gates(const Frame& F, int row, int z, int h, float& ig, float& lf) {
    const bf16* g = wsp<const bf16>(F, WS_P) + (size_t)row * REC_NP + PC_G + z * 8 + h; const float* gb = F.in[I_GATEB] + z * 8 + h;
    const float gi = bf2f(g[0]) + gb[0], gf = bf2f(g[4]) + gb[4];
    ig = 15.f * tanhf_(gi * (1.f / 15.f)); const float cf = 15.f * tanhf_(gf * (1.f / 15.f)); lf = fminf(cf, 0.f) - __logf(1.f + __expf(-fabsf(cf)));
}
__device__ __forceinline__ void mlstm_chunk_head(const Frame& F, int z, int b, int h, int c, LAS float* vec) {
    LAS int* rows = (LAS int*)vec;
    if (F.tid < 64) { const int s = F.tid, row = b * TB + scan_tok(z, 64 * c + s); float ig, lf; mlstm_gates(F, row, z, h, ig, lf); rows[s] = row; vec[64 + s] = ig; vec[192 + s] = lf; }
    __syncthreads();
    if (F.tid < 64) { float a = 0.f; for (int s = 0; s <= F.tid; ++s) a += vec[192 + s]; vec[128 + F.tid] = a; }
    __syncthreads();
}
__device__ __forceinline__ void l1_mlstm_a(const Frame& F) {
    LAS float* Ks = (LAS float*)F.lds; LAS float* Vs = Ks + 64 * 64; LAS float* vec = (LAS float*)(F.lds + AUX_OFF); LAS int* rows = (LAS int*)vec;
    const bf16* P = wsp<const bf16>(F, WS_P);
    for (int u = F.blk; u < NUNIT_M; u += F.G) {
        const int cidx = u / 260, c = u - cidx * 260, z = cidx >> 3, b = (cidx >> 2) & 1, h = cidx & 3;
        mlstm_chunk_head(F, z, b, h, c, vec);
        if (F.tid < 64) { const float bl = vec[128 + 63]; const float uu = bl - vec[128 + F.tid] + vec[64 + F.tid]; float m = uu;
#pragma unroll
            for (int o = 1; o < 64; o <<= 1) m = fmaxf(m, __shfl_xor(m, o));
            vec[256 + F.tid] = __expf(uu - m);
            if (F.tid == 0) { wsp<float>(F, WS_SC)[2 * u] = bl; wsp<float>(F, WS_SC)[2 * u + 1] = m; } }
        __syncthreads();
        { const int s = F.tid >> 3, c8 = F.tid & 7; float x[8]; unpack8(*(const v4u*)(P + (size_t)rows[s] * REC_NP + PC_K + h * 64 + 8 * c8), x);
#pragma unroll
          for (int e = 0; e < 8; ++e) Ks[s * 64 + 8 * c8 + e] = x[e] * 0.125f; }
#pragma unroll
        for (int i = 0; i < 2; ++i) { const int s = (F.tid >> 4) + 32 * i, c8 = F.tid & 15; float x[8]; unpack8(*(const v4u*)(P + (size_t)rows[s] * REC_NP + PC_V + h * 128 + 8 * c8), x); const float w = vec[256 + s];
#pragma unroll
            for (int e = 0; e < 8; ++e) Vs[s * 128 + 8 * c8 + e] = x[e] * w; }
        __syncthreads();
        { const int dg = F.tid >> 5, vg = F.tid & 31; f32x4 acc[4];
#pragma unroll
          for (int i = 0; i < 4; ++i) acc[i] = (f32x4){0.f, 0.f, 0.f, 0.f};
#pragma unroll 4
          for (int s = 0; s < 64; ++s) { const f32x4 kd = *(const LAS f32x4*)(Ks + s * 64 + 4 * dg), vv = *(const LAS f32x4*)(Vs + s * 128 + 4 * vg);
              acc[0] += kd.x * vv; acc[1] += kd.y * vv; acc[2] += kd.z * vv; acc[3] += kd.w * vv; }
          float* dc = wsp<float>(F, WS_DC) + (size_t)u * 8192 + (size_t)(4 * dg) * 128 + 4 * vg;
#pragma unroll
          for (int i = 0; i < 4; ++i) *(f32x4*)(dc + i * 128) = acc[i];
          if (F.tid < 64) { float a = 0.f; for (int s = 0; s < 64; ++s) a += vec[256 + s] * Ks[s * 64 + F.tid]; wsp<float>(F, WS_DN)[(size_t)u * 64 + F.tid] = a; } }
        __syncthreads();
    }
}
__device__ __forceinline__ void l1_mlstm_b(const Frame& F) {
    const float* __restrict__ SC = wsp<const float>(F, WS_SC); const float* __restrict__ DC = wsp<const float>(F, WS_DC); float* __restrict__ CST = wsp<float>(F, WS_CST);
    const float* __restrict__ DN = wsp<const float>(F, WS_DN); float* __restrict__ NST = wsp<float>(F, WS_NST); float* __restrict__ MST = wsp<float>(F, WS_MST);
    for (int g = F.blk * 512 + F.tid; g < 16 * 8192; g += F.G * 512) {
        const int chain = g >> 13, el = g & 8191; float m = 0.f, C = 0.f, N = 0.f; const bool don = el < 64;
        for (int c0 = 0; c0 < 260; c0 += 10) {
            float dc[10], dn[10], bl[10], ml[10];
#pragma unroll
            for (int i = 0; i < 10; ++i) { const size_t u = (size_t)chain * 260 + c0 + i; dc[i] = DC[u * 8192 + el]; dn[i] = don ? DN[u * 64 + el] : 0.f; bl[i] = SC[2 * u]; ml[i] = SC[2 * u + 1]; }
#pragma unroll
            for (int i = 0; i < 10; ++i) { const size_t u = (size_t)chain * 260 + c0 + i;
                CST[u * 8192 + el] = C; if (don) NST[u * 64 + el] = N; if (el == 0) MST[u] = m;
                const float mn = fmaxf(bl[i] + m, ml[i]), cd = __expf(bl[i] + m - mn), inj = __expf(ml[i] - mn);
                C = cd * C + inj * dc[i]; N = cd * N + inj * dn[i]; m = mn; }
        }
    }
}
__device__ __forceinline__ void l1_mlstm_c(const Frame& F, int first_blk, int nblk) {
    LAS float* qT = (LAS float*)F.lds; LAS float* kT = qT + 4096; LAS float* Vs = kT + 4096; LAS float* Cs = Vs + 8192; LAS float* PT = Cs + 8192;
    LAS float* vec = (LAS float*)(F.lds + AUX_OFF); LAS int* rows = (LAS int*)vec;
    const bf16* P = wsp<const bf16>(F, WS_P);
    for (int u = F.blk - first_blk; u < NUNIT_M; u += nblk) {
        const int cidx = u / 260, c = u - cidx * 260, z = cidx >> 3, b = (cidx >> 2) & 1, h = cidx & 3;
        mlstm_chunk_head(F, z, b, h, c, vec);
        const float mst = wsp<const float>(F, WS_MST)[u];
        if (F.tid < 64) { const int t = F.tid; float pm = -3.0e38f; for (int s = 0; s <= t; ++s) pm = fmaxf(pm, vec[64 + s] - vec[128 + s]);
            const float gi = vec[128 + t] + mst, mo = fmaxf(gi, vec[128 + t] + pm); vec[320 + t] = __expf(gi - mo); vec[384 + t] = mo;
            vec[256 + t] = wsp<const float>(F, WS_NST)[(size_t)u * 64 + t]; }
        { const int c8 = F.tid >> 6, t = F.tid & 63; float x[8]; unpack8(*(const v4u*)(P + (size_t)rows[t] * REC_NP + PC_Q + h * 64 + 8 * c8), x);
#pragma unroll
          for (int e = 0; e < 8; ++e) qT[(8 * c8 + e) * 64 + t] = x[e];
          unpack8(*(const v4u*)(P + (size_t)rows[t] * REC_NP + PC_K + h * 64 + 8 * c8), x);
#pragma unroll
          for (int e = 0; e < 8; ++e) kT[(8 * c8 + e) * 64 + t] = x[e] * 0.125f; }
#pragma unroll
        for (int i = 0; i < 2; ++i) { const int s = (F.tid >> 4) + 32 * i, c8 = F.tid & 15; float x[8]; unpack8(*(const v4u*)(P + (size_t)rows[s] * REC_NP + PC_V + h * 128 + 8 * c8), x);
            *(LAS f32x4*)(Vs + s * 128 + 8 * c8) = (f32x4){x[0], x[1], x[2], x[3]}; *(LAS f32x4*)(Vs + s * 128 + 8 * c8 + 4) = (f32x4){x[4], x[5], x[6], x[7]}; }
        { const f32x4* src = (const f32x4*)(wsp<const float>(F, WS_CST) + (size_t)u * 8192);
#pragma unroll
          for (int i = 0; i < 4; ++i) ((LAS f32x4*)Cs)[F.tid + 512 * i] = src[F.tid + 512 * i]; }
        __syncthreads();
        { const int tg = F.tid & 15, sg = F.tid >> 4; f32x4 a0 = {0.f, 0.f, 0.f, 0.f}, a1 = a0;
#pragma unroll 4
          for (int d = 0; d < 64; ++d) { const f32x4 q4 = *(const LAS f32x4*)(qT + d * 64 + 4 * tg); const float k0 = kT[d * 64 + 2 * sg], k1 = kT[d * 64 + 2 * sg + 1]; a0 += q4 * k0; a1 += q4 * k1; }
#pragma unroll
          for (int j = 0; j < 2; ++j) { const int s = 2 * sg + j; const float cs = vec[64 + s] - vec[128 + s]; f32x4 pv;
#pragma unroll
              for (int i = 0; i < 4; ++i) { const int t = 4 * tg + i; const float qk = j == 0 ? a0[i] : a1[i]; pv[i] = (s <= t) ? qk * __expf(vec[128 + t] + cs - vec[384 + t]) : 0.f; }
              *(LAS f32x4*)(PT + s * 64 + 4 * tg) = pv; } }
        __syncthreads();
        { const int tg = F.tid >> 5, vg = F.tid & 31; f32x4 ac[4], ap[4]; f32x4 nq = {0.f, 0.f, 0.f, 0.f}, rs = nq;
#pragma unroll
          for (int i = 0; i < 4; ++i) { ac[i] = (f32x4){0.f, 0.f, 0.f, 0.f}; ap[i] = ac[i]; }
#pragma unroll 4
          for (int d = 0; d < 64; ++d) { const f32x4 q4 = *(const LAS f32x4*)(qT + d * 64 + 4 * tg), c4 = *(const LAS f32x4*)(Cs + d * 128 + 4 * vg);
              ac[0] += q4.x * c4; ac[1] += q4.y * c4; ac[2] += q4.z * c4; ac[3] += q4.w * c4; nq += q4 * vec[256 + d]; }
#pragma unroll 4
          for (int s = 0; s < 64; ++s) { const f32x4 p4 = *(const LAS f32x4*)(PT + s * 64 + 4 * tg), v4 = *(const LAS f32x4*)(Vs + s * 128 + 4 * vg);
              ap[0] += p4.x * v4; ap[1] += p4.y * v4; ap[2] += p4.z * v4; ap[3] += p4.w * v4; rs += p4; }
#pragma unroll
          for (int i = 0; i < 4; ++i) { const int t = 4 * tg + i; const float g = vec[320 + t], den = g * nq[i] + rs[i], dn = fmaxf(fabsf(den), __expf(-vec[384 + t]));
              const f32x4 hv = (g * ac[i] + ap[i]) * (1.f / dn);
              *(f32x4*)(wsp<float>(F, WS_HM) + ((size_t)z * R + rows[t]) * 512 + h * 128 + 4 * vg) = hv; } }
        __syncthreads();
    }
}
template <int CTRL> __device__ __forceinline__ float dpp_add(float v) { return v + __builtin_bit_cast(float, __builtin_amdgcn_update_dpp(0, __builtin_bit_cast(int, v), CTRL, 0xF, 0xF, true)); }
__device__ __forceinline__ float reduce16(float v) { v = dpp_add<0xB1>(v); v = dpp_add<0x4E>(v); v = dpp_add<0x141>(v); v = dpp_add<0x140>(v); return v; }
struct ScanIn { f32x4 a, b, w, k, r; float v; };
__device__ __forceinline__ float fma_s(float a, float b, float c) { float r; asm("v_fma_f32 %0, %1, %2, %3" : "=v"(r) : "v"(a), "v"(b), "v"(c)); return r; }
__device__ __forceinline__ float mul_s(float a, float b) { float r; asm("v_mul_f32_e32 %0, %1, %2" : "=v"(r) : "v"(a), "v"(b)); return r; }
__device__ __forceinline__ float add_s(float a, float b) { float r; asm("v_add_f32_e32 %0, %1, %2" : "=v"(r) : "v"(a), "v"(b)); return r; }
constexpr int SC_TS = 32, SC_MAIN = SC_TS * 320, SC_TILE = SC_MAIN + SC_TS * 16, SC_NBLK = 128;
typedef float f32x2_t __attribute__((ext_vector_type(2)));
__device__ __forceinline__ void l1_rwkv_scan(const Frame& F) {
    const int chain = F.blk >> 2, z = chain >> 4, b = (chain >> 3) & 1, h = chain & 7, qtr = F.blk & 3;
    const int g = F.lane >> 4, p = F.lane & 15, rowl = (F.wave & 3) * 4 + g; const bool cw = F.wave < 4;
    LAS float* lds = (LAS float*)F.lds; LAS float* ytile = lds + 2 * SC_TILE;
    float* Y = wsp<float>(F, WS_YR) + (size_t)z * R * 512;
    const int sst = F.tid >> 4, l16 = F.tid & 15; const size_t co = h * 64 + l16 * 4;
    const float* gR = wsp<const float>(F, WS_RR) + co; const float* gA = wsp<const float>(F, WS_AKK) + co; const float* gB = wsp<const float>(F, WS_BB) + (size_t)z * R * 512 + co;
    const float* gW = wsp<const float>(F, WS_WDEC) + (size_t)z * R * 512 + co; const float* gK = wsp<const float>(F, WS_KDIR) + (size_t)z * R * 512 + co;
    const float* gv = wsp<const float>(F, WS_VV) + h * 64 + qtr * 16 + (F.tid & 3) * 4; const int gvst = (F.tid >> 2) + 1; const bool vld = F.tid < 128;
    f32x4 tR, tA, tB, tW, tK, stv;
#define SC_ROW(sg) (((size_t)b * TB + scan_tok(z, (sg) < TB ? (sg) : TB - 1)) * 512)
#define SC_GLOAD(n) do { const size_t r0_ = SC_ROW((n) * SC_TS + sst), r1_ = SC_ROW((n) * SC_TS + sst + 1); tR = *(const f32x4*)(gR + r0_); tA = *(const f32x4*)(gA + r1_); tB = *(const f32x4*)(gB + r0_); \
    tW = *(const f32x4*)(gW + r0_); tK = *(const f32x4*)(gK + r1_); if (vld) stv = *(const f32x4*)(gv + SC_ROW((n) * SC_TS + gvst)); } while (0)
#define SC_LWRITE(buf) do { LAS float* d_ = lds + (buf) * SC_TILE + sst * 320; *(LAS f32x4*)(d_ + l16 * 8) = (f32x4){tR.x, tA.x, tR.y, tA.y}; *(LAS f32x4*)(d_ + l16 * 8 + 4) = (f32x4){tR.z, tA.z, tR.w, tA.w}; \
    *(LAS f32x4*)(d_ + 128 + l16 * 4) = tB; *(LAS f32x4*)(d_ + 192 + l16 * 4) = tW; *(LAS f32x4*)(d_ + 256 + l16 * 4) = tK; \
    if (vld) ((LAS f32x4*)(lds + (buf) * SC_TILE + SC_MAIN))[F.tid] = stv; } while (0)
    f32x2_t S01 = {0.f, 0.f}, S23 = {0.f, 0.f}; float pa = 0.f, vk0, vk1, vk2, vk3;
    { const size_t r0 = SC_ROW(0); const f32x4 k4 = *(const f32x4*)(wsp<const float>(F, WS_KDIR) + (size_t)z * R * 512 + r0 + h * 64 + 4 * p);
      const float v0 = wsp<const float>(F, WS_VV)[r0 + h * 64 + qtr * 16 + rowl]; vk0 = v0 * k4.x; vk1 = v0 * k4.y; vk2 = v0 * k4.z; vk3 = v0 * k4.w; }
    constexpr int NTILE = TB / SC_TS;
    SC_GLOAD(0); SC_LWRITE(0); __syncthreads();
    for (int n = 0; n < NTILE; ++n) {
        if (n + 1 < NTILE) SC_GLOAD(n + 1);
        const LAS float* tb = lds + (n & 1) * SC_TILE; const LAS float* tv = lds + (n & 1) * SC_TILE + SC_MAIN + rowl;
        LAS float* yw = (p == 0) ? (ytile + (n & 1) * (SC_TS * 16) + rowl) : (ytile + 2 * (SC_TS * 16) + F.tid);
        const int ystep = (p == 0) ? 16 : 0;
        struct In { f32x4 q0, q1, b, w, k; float v; };
#define SC_LD(S, s_) do { S.q0 = *(const LAS f32x4*)(tb + (s_) * 320 + 8 * p); S.q1 = *(const LAS f32x4*)(tb + (s_) * 320 + 8 * p + 4); S.b = *(const LAS f32x4*)(tb + (s_) * 320 + 128 + 4 * p); \
    S.w = *(const LAS f32x4*)(tb + (s_) * 320 + 192 + 4 * p); S.k = *(const LAS f32x4*)(tb + (s_) * 320 + 256 + 4 * p); S.v = tv[(s_) * 16]; } while (0)
#define SC_ST(S, s_) do { \
    { const f32x2_t t01_ = S.b.xy * pa + (f32x2_t){vk0, vk1}, t23_ = S.b.zw * pa + (f32x2_t){vk2, vk3}; S01 = S01 * S.w.xy + t01_; S23 = S23 * S.w.zw + t23_; } \
    f32x2_t P_ = S.q0.xy * S01.x, Q_ = S.q1.xy * S23.x; P_ = S.q0.zw * S01.y + P_; Q_ = S.q1.zw * S23.y + Q_; P_ = P_ + Q_; \
    float py_ = P_.x; pa = P_.y; \
    asm volatile("s_nop 1\n\tv_mul_f32_e32 %2, %6, %7\n\t" \
        "v_add_f32_dpp %0, %0, %0 quad_perm:[1,0,3,2] row_mask:0xf bank_mask:0xf bound_ctrl:1\n\tv_add_f32_dpp %1, %1, %1 quad_perm:[1,0,3,2] row_mask:0xf bank_mask:0xf bound_ctrl:1\n\tv_mul_f32_e32 %3, %6, %8\n\t" \
        "v_add_f32_dpp %0, %0, %0 quad_perm:[2,3,0,1] row_mask:0xf bank_mask:0xf bound_ctrl:1\n\tv_add_f32_dpp %1, %1, %1 quad_perm:[2,3,0,1] row_mask:0xf bank_mask:0xf bound_ctrl:1\n\tv_mul_f32_e32 %4, %6, %9\n\t" \
        "v_add_f32_dpp %0, %0, %0 row_half_mirror row_mask:0xf bank_mask:0xf bound_ctrl:1\n\tv_add_f32_dpp %1, %1, %1 row_half_mirror row_mask:0xf bank_mask:0xf bound_ctrl:1\n\tv_mul_f32_e32 %5, %6, %10\n\t" \
        "v_add_f32_dpp %0, %0, %0 row_mirror row_mask:0xf bank_mask:0xf bound_ctrl:1\n\tv_add_f32_dpp %1, %1, %1 row_mirror row_mask:0xf bank_mask:0xf bound_ctrl:1\n\ts_nop 0" \
        : "+v"(py_), "+v"(pa), "=&v"(vk0), "=&v"(vk1), "=&v"(vk2), "=&v"(vk3) : "v"(S.v), "v"(S.k.x), "v"(S.k.y), "v"(S.k.z), "v"(S.k.w)); \
    yw[(s_) * ystep] = py_; } while (0)
        if (cw) { In I0, I1; SC_LD(I0, 0);
#pragma unroll 4
        for (int s = 0; s < SC_TS; s += 2) {
            SC_LD(I1, s + 1); SC_ST(I0, s);
            if (s + 2 < SC_TS) SC_LD(I0, s + 2);
            SC_ST(I1, s + 1);
        } }
#undef SC_LD
#undef SC_ST
        if (n + 1 < NTILE) SC_LWRITE((n + 1) & 1);
        __syncthreads();
        { const int stp = F.tid >> 4, c1 = F.tid & 15; Y[((size_t)b * TB + scan_tok(z, n * SC_TS + stp)) * 512 + h * 64 + qtr * 16 + c1] = ytile[(n & 1) * (SC_TS * 16) + stp * 16 + c1]; }
    }
#undef SC_GLOAD
#undef SC_LWRITE
#undef SC_ROW
}
__device__ __forceinline__ void l1_rec_out(const Frame& F) {
    const int gw = F.blk * 8 + F.wave, NGW = F.G * 8, lane = F.lane, c0 = 8 * lane;
    for (int row = gw; row < R; row += NGW) {
        const size_t ro = (size_t)row * 512 + c0; bf16* a1 = wsp<bf16>(F, WS_A1) + (size_t)row * DM;
        { const float* y0 = wsp<const float>(F, WS_YR) + ro; const float* y1 = y0 + (size_t)R * 512; float y[8]; float s = 0.f;
#pragma unroll
          for (int e = 0; e < 8; ++e) { y[e] = y0[e] + y1[e]; s += y[e]; }
          s += __shfl_xor(s, 1); s += __shfl_xor(s, 2); s += __shfl_xor(s, 4); const float mean = s * (1.f / 64.f); float q = 0.f;
#pragma unroll
          for (int e = 0; e < 8; ++e) { y[e] -= mean; q += y[e] * y[e]; }
          q += __shfl_xor(q, 1); q += __shfl_xor(q, 2); q += __shfl_xor(q, 4); const float rstd = 1.f / sqrtf(q * (1.f / 64.f) + 64e-5f);
          const float* rr = wsp<const float>(F, WS_RR) + ro; const float* k0 = wsp<const float>(F, WS_KDIR) + ro; const float* k1 = k0 + (size_t)R * 512; const float* rk = F.in[I_RK] + c0; float bs = 0.f;
#pragma unroll
          for (int e = 0; e < 8; ++e) bs += rr[e] * (k0[e] + k1[e]) * rk[e];
          bs += __shfl_xor(bs, 1); bs += __shfl_xor(bs, 2); bs += __shfl_xor(bs, 4);
          const float* vv = wsp<const float>(F, WS_VV) + ro; const float* gg = wsp<const float>(F, WS_GG) + ro; const float* lw = F.in[I_LNW] + c0; const float* lb = F.in[I_LNB] + c0; float o[8];
#pragma unroll
          for (int e = 0; e < 8; ++e) o[e] = (y[e] * rstd * lw[e] + lb[e] + bs * vv[e]) * gg[e];
          v4u w; w.x = pk2(o[0], o[1]); w.y = pk2(o[2], o[3]); w.z = pk2(o[4], o[5]); w.w = pk2(o[6], o[7]); *(v4u*)(a1 + c0) = w; }
        { const float* h0 = wsp<const float>(F, WS_HM) + ro; const float* h1 = h0 + (size_t)R * 512; float x[8]; float q = 0.f;
#pragma unroll
          for (int e = 0; e < 8; ++e) { x[e] = h0[e] + h1[e]; q += x[e] * x[e]; }
          q += __shfl_xor(q, 1); q += __shfl_xor(q, 2); q += __shfl_xor(q, 4); q += __shfl_xor(q, 8); const float rs = 1.f / sqrtf(q * (1.f / 128.f) + NORM_EPS);
          float og[8]; unpack8(*(const v4u*)(wsp<const bf16>(F, WS_P) + (size_t)row * REC_NP + PC_O + c0), og); const float* nw = F.in[I_MNW] + c0; float o[8];
#pragma unroll
          for (int e = 0; e < 8; ++e) o[e] = x[e] * rs * nw[e] * sigmoidf_(og[e]);
          v4u w; w.x = pk2(o[0], o[1]); w.y = pk2(o[2], o[3]); w.z = pk2(o[4], o[5]); w.w = pk2(o[6], o[7]); *(v4u*)(a1 + 512 + c0) = w; }
    }
}
namespace rk {
constexpr int LS = 72;
constexpr int MB = 64 * LS * 2;
struct Acc2 { pg8::f32x4 t0, t1; };
__device__ __forceinline__ void zero(Acc2& a) { a.t0 = (pg8::f32x4){0.f, 0.f, 0.f, 0.f}; a.t1 = a.t0; }
__device__ __forceinline__ void mm_acc(Acc2& acc, const LAS bf16* A, const LAS bf16* Bt, int wave, int lane) {
    const int tm = wave >> 1, tn0 = (wave & 1) * 2, lr = lane & 15, kq = (lane >> 4) * 8;
    const LAS bf16* ap = A + (tm * 16 + lr) * LS + kq; const LAS bf16* bp0 = Bt + (tn0 * 16 + lr) * LS + kq; const LAS bf16* bp1 = bp0 + 16 * LS;
    const bf16x8 a0 = *(const LAS bf16x8*)ap, a1 = *(const LAS bf16x8*)(ap + 32);
    const bf16x8 b00 = *(const LAS bf16x8*)bp0, b01 = *(const LAS bf16x8*)(bp0 + 32), b10 = *(const LAS bf16x8*)bp1, b11 = *(const LAS bf16x8*)(bp1 + 32);
    acc.t0 = __builtin_amdgcn_mfma_f32_16x16x32_bf16(a0, b00, acc.t0, 0, 0, 0); acc.t0 = __builtin_amdgcn_mfma_f32_16x16x32_bf16(a1, b01, acc.t0, 0, 0, 0);
    acc.t1 = __builtin_amdgcn_mfma_f32_16x16x32_bf16(a0, b10, acc.t1, 0, 0, 0); acc.t1 = __builtin_amdgcn_mfma_f32_16x16x32_bf16(a1, b11, acc.t1, 0, 0, 0);
}
template <class Fn> __device__ __forceinline__ void each(const Acc2& acc, int wave, int lane, Fn fn) {
    const int m0 = (wave >> 1) * 16 + (lane >> 4) * 4, n0 = (wave & 1) * 32 + (lane & 15);
#pragma unroll
    for (int r = 0; r < 4; ++r) { fn(m0 + r, n0, acc.t0[r]); fn(m0 + r, n0 + 16, acc.t1[r]); }
}
__device__ __forceinline__ void stb(LAS bf16* M, int m, int n, float v) { M[m * LS + n] = (bf16)f2bf(v); }
}
__device__ __forceinline__ void l1_rk_phase_a(const Frame& F) {
    using namespace rk;
    LAS unsigned char* L = F.lds;
    LAS bf16* Rt = (LAS bf16*)(L + 0 * MB); LAS bf16* At = (LAS bf16*)(L + 1 * MB); LAS bf16* AtT = (LAS bf16*)(L + 2 * MB); LAS bf16* Bq = (LAS bf16*)(L + 3 * MB); LAS bf16* Kq = (LAS bf16*)(L + 4 * MB);
    LAS bf16* VT = (LAS bf16*)(L + 5 * MB); LAS bf16* BhT = (LAS bf16*)(L + 6 * MB); LAS bf16* KhT = (LAS bf16*)(L + 7 * MB);
    LAS bf16* AK = (LAS bf16*)(L + 8 * MB); LAS bf16* RB = (LAS bf16*)(L + 9 * MB); LAS bf16* RK = (LAS bf16*)(L + 10 * MB);
    LAS bf16* X = (LAS bf16*)(L + 11 * MB); LAS bf16* XT = (LAS bf16*)(L + 12 * MB); LAS bf16* P = (LAS bf16*)(L + 13 * MB);
    LAS bf16* AkVT = Bq; LAS bf16* ApT = Kq; LAS bf16* W2T = X;
    LAS float* G = (LAS float*)(L + 8 * MB);
    LAS float* gl = (LAS float*)(L + 14 * MB);
    const int w = F.wave, lane = F.lane, tid = F.tid;
    for (int u = F.blk; u < NUNIT_R; u += F.G) {
        const int chain = u / 260, c = u - chain * 260, z = chain >> 4, b = (chain >> 3) & 1, h = chain & 7;
        const int t = tid >> 3, j0 = (tid & 7) * 8; const size_t ro = ((size_t)b * TB + scan_tok(z, 64 * c + t)) * 512 + h * 64 + j0;
        float fr[8], fv[8], fa[8], fw[8], fk[8], fb[8];
        { const float* p0 = wsp<const float>(F, WS_RR) + ro; const float* p1 = wsp<const float>(F, WS_VV) + ro; const float* p2 = wsp<const float>(F, WS_AKK) + ro;
          const float* p3 = wsp<const float>(F, WS_WDEC) + (size_t)z * R * 512 + ro; const float* p4 = wsp<const float>(F, WS_KDIR) + (size_t)z * R * 512 + ro; const float* p5 = wsp<const float>(F, WS_BB) + (size_t)z * R * 512 + ro;
#pragma unroll
          for (int q = 0; q < 2; ++q) { const f32x4 x0 = *(const f32x4*)(p0 + 4 * q), x1 = *(const f32x4*)(p1 + 4 * q), x2 = *(const f32x4*)(p2 + 4 * q), x3 = *(const f32x4*)(p3 + 4 * q), x4 = *(const f32x4*)(p4 + 4 * q), x5 = *(const f32x4*)(p5 + 4 * q);
#pragma unroll
              for (int e = 0; e < 4; ++e) { fr[4 * q + e] = x0[e]; fv[4 * q + e] = x1[e]; fa[4 * q + e] = x2[e]; fw[4 * q + e] = x3[e]; fk[4 * q + e] = x4[e]; fb[4 * q + e] = x5[e]; } } }
        __syncthreads();
#pragma unroll
        for (int e = 0; e < 8; ++e) G[t * 65 + j0 + e] = fw[e];
        __syncthreads();
        if (tid < 64) { float g = 1.f; for (int s = 0; s < 64; ++s) { g *= G[s * 65 + tid]; G[s * 65 + tid] = g; } gl[tid] = g; }
        __syncthreads();
#pragma unroll
        for (int e = 0; e < 8; ++e) { const int j = j0 + e; const float gt = G[t * 65 + j], gp = t > 0 ? G[(t - 1) * 65 + j] : 1.f, gL = G[63 * 65 + j], ig = 1.f / gt;
            fr[e] *= gt; fa[e] *= gp; const float bq = fb[e] * ig, kq = fk[e] * ig; fb[e] = bq; fk[e] = kq; fw[e] = gL; }
        __syncthreads();
#pragma unroll
        for (int e = 0; e < 8; ++e) { const int j = j0 + e;
            stb(Rt, t, j, fr[e]); stb(At, t, j, fa[e]); stb(AtT, j, t, fa[e]); stb(Bq, t, j, fb[e]); stb(Kq, t, j, fk[e]);
            stb(VT, j, t, fv[e]); stb(BhT, j, t, fb[e] * fw[e]); stb(KhT, j, t, fk[e] * fw[e]); }
        __syncthreads();
        Acc2 a1, a2, a3, a4;
        zero(a1); mm_acc(a1, At, Bq, w, lane); zero(a2); mm_acc(a2, At, Kq, w, lane); zero(a3); mm_acc(a3, Rt, Bq, w, lane); zero(a4); mm_acc(a4, Rt, Kq, w, lane);
        each(a1, w, lane, [&](int m, int n, float v) { const float x = n < m ? v : 0.f; stb(X, m, n, x); stb(XT, n, m, x); stb(P, m, n, x + (m == n ? 1.f : 0.f)); });
        each(a2, w, lane, [&](int m, int n, float v) { stb(AK, m, n, n < m ? v : 0.f); });
        each(a3, w, lane, [&](int m, int n, float v) { stb(RB, m, n, n <= m ? v : 0.f); });
        each(a4, w, lane, [&](int m, int n, float v) { stb(RK, m, n, n <= m ? v : 0.f); });
        __syncthreads();
#pragma unroll 1
        for (int i = 0; i < 5; ++i) {
            zero(a1); mm_acc(a1, X, XT, w, lane);
            __syncthreads();
            each(a1, w, lane, [&](int m, int n, float v) { stb(X, m, n, v); stb(XT, n, m, v); });
            __syncthreads();
            zero(a2); mm_acc(a2, P, XT, w, lane);
            { const int m0 = (w >> 1) * 16 + (lane >> 4) * 4, n0 = (w & 1) * 32 + (lane & 15); float pv[8];
#pragma unroll
              for (int r = 0; r < 4; ++r) { pv[2 * r] = bf2f(P[(m0 + r) * LS + n0]); pv[2 * r + 1] = bf2f(P[(m0 + r) * LS + n0 + 16]); }
              __syncthreads();
#pragma unroll
              for (int r = 0; r < 4; ++r) { stb(P, m0 + r, n0, pv[2 * r] + a2.t0[r]); stb(P, m0 + r, n0 + 16, pv[2 * r + 1] + a2.t1[r]); } }
            __syncthreads();
        }
        zero(a1); mm_acc(a1, AK, VT, w, lane); zero(a2); mm_acc(a2, P, AtT, w, lane);
        each(a1, w, lane, [&](int m, int n, float v) { stb(AkVT, n, m, v); });
        each(a2, w, lane, [&](int m, int n, float v) { stb(ApT, n, m, v); });
        __syncthreads();
        zero(a3); mm_acc(a3, P, AkVT, w, lane);
        each(a3, w, lane, [&](int m, int n, float v) { stb(W2T, n, m, v); });
        __syncthreads();
        zero(a1); mm_acc(a1, RB, ApT, w, lane); zero(a2); mm_acc(a2, RB, W2T, w, lane); mm_acc(a2, RK, VT, w, lane);
        zero(a3); mm_acc(a3, BhT, ApT, w, lane); zero(a4); mm_acc(a4, BhT, W2T, w, lane); mm_acc(a4, KhT, VT, w, lane);
        bf16* Qg = wsp<bf16>(F, WS_RKQ) + (size_t)u * 4096; bf16* Mg = wsp<bf16>(F, WS_RKM) + (size_t)u * 4096; bf16* Zg = wsp<bf16>(F, WS_RKZ) + (size_t)u * 4096;
        float* Yg = wsp<float>(F, WS_YR) + (size_t)z * R * 512 + h * 64;
        each(a1, w, lane, [&](int m, int n, float v) { Qg[m * 64 + n] = (bf16)f2bf(v + bf2f(Rt[m * LS + n])); });
        each(a2, w, lane, [&](int m, int n, float v) { Yg[((size_t)b * TB + scan_tok(z, 64 * c + m)) * 512 + n] = v; });
        each(a3, w, lane, [&](int m, int n, float v) { Mg[m * 64 + n] = (bf16)f2bf(v + (m == n ? gl[m] : 0.f)); });
        each(a4, w, lane, [&](int m, int n, float v) { Zg[m * 64 + n] = (bf16)f2bf(v); });
    }
}
__device__ __forceinline__ void l1_rk_phase_b(const Frame& F) {
    using namespace rk;
    LAS unsigned char* L = F.lds; LAS bf16* S = (LAS bf16*)L;
    const int w = F.wave, lane = F.lane, tid = F.tid, chain = F.blk, z = chain >> 4, b = (chain >> 3) & 1, h = chain & 7;
    for (int i = tid; i < 64 * LS; i += 512) S[i] = 0;
    const int sr = tid >> 3, sc = (tid & 7) * 8;
    v4u gm, gq;
    { const size_t u0 = (size_t)chain * 260; gm = *(const v4u*)(wsp<const bf16>(F, WS_RKM) + u0 * 4096 + sr * 64 + sc); gq = *(const v4u*)(wsp<const bf16>(F, WS_RKQ) + u0 * 4096 + sr * 64 + sc); }
    *(LAS v4u*)((LAS bf16*)(L + 1 * MB) + sr * LS + sc) = gm; *(LAS v4u*)((LAS bf16*)(L + 2 * MB) + sr * LS + sc) = gq;
    __syncthreads();
    float* Yg = wsp<float>(F, WS_YR) + (size_t)z * R * 512 + h * 64;
    for (int c = 0; c < 260; ++c) {
        const size_t u = (size_t)chain * 260 + c;
        if (c + 1 < 260) { gm = *(const v4u*)(wsp<const bf16>(F, WS_RKM) + (u + 1) * 4096 + sr * 64 + sc); gq = *(const v4u*)(wsp<const bf16>(F, WS_RKQ) + (u + 1) * 4096 + sr * 64 + sc); }
        const LAS bf16* Mt = (const LAS bf16*)(L + (1 + 2 * (c & 1)) * MB); const LAS bf16* Qp = (const LAS bf16*)(L + (2 + 2 * (c & 1)) * MB);
        Acc2 a1, a2; zero(a1); mm_acc(a1, Mt, S, w, lane); zero(a2); mm_acc(a2, Qp, S, w, lane);
        const bf16* Zg = wsp<const bf16>(F, WS_RKZ) + u * 4096;
        float zv[8], yv[8]; const int m0 = (w >> 1) * 16 + (lane >> 4) * 4, n0 = (w & 1) * 32 + (lane & 15);
#pragma unroll
        for (int r = 0; r < 4; ++r) { zv[2 * r] = bf2f(Zg[(m0 + r) * 64 + n0]); zv[2 * r + 1] = bf2f(Zg[(m0 + r) * 64 + n0 + 16]);
            const size_t yo = ((size_t)b * TB + scan_tok(z, 64 * c + m0 + r)) * 512 + n0; yv[2 * r] = Yg[yo]; yv[2 * r + 1] = Yg[yo + 16]; }
        __syncthreads();
#pragma unroll
        for (int r = 0; r < 4; ++r) { stb(S, n0, m0 + r, a1.t0[r] + zv[2 * r]); stb(S, n0 + 16, m0 + r, a1.t1[r] + zv[2 * r + 1]);
            const size_t yo = ((size_t)b * TB + scan_tok(z, 64 * c + m0 + r)) * 512 + n0; Yg[yo] = yv[2 * r] + a2.t0[r]; Yg[yo + 16] = yv[2 * r + 1] + a2.t1[r]; }
        if (c + 1 < 260) { *(LAS v4u*)((LAS bf16*)(L + (1 + 2 * ((c + 1) & 1)) * MB) + sr * LS + sc) = gm; *(LAS v4u*)((LAS bf16*)(L + (2 + 2 * ((c + 1) & 1)) * MB) + sr * LS + sc) = gq; }
        __syncthreads();
    }
}
#ifndef MK_PER_PHASE
#define MK_PER_PHASE 0
#endif
#ifndef RK_CHUNKED
#define RK_CHUNKED 1
#endif
constexpr int NPHASE = 26;
struct Args { const float* in[N_IN]; float* out; unsigned char* ws; int ph_lo, ph_hi, li, pad; };
#define GEMM_CALL(FnT, SchedT, g, S, fn) do { pg8::EpiGen<FnT> E_{fn}; { int k_ = g.K; asm volatile("" : "+s"(k_)); g.K = k_; } pg8::gemm_phase<pg8::EpiGen<FnT>, SchedT, true, true>((PG8_LAS unsigned char*)F.lds, g, S, E_); } while (0)
#ifndef SITE_MASK
#define SITE_MASK 0xFFFFFFFFull
#endif
#define SITE(s) (((SITE_MASK) >> (s)) & 1ull)
#ifndef DUP_MASK
#define DUP_MASK 0ull
#endif
#define NREP(s) ((((DUP_MASK) >> (s)) & 1ull) ? 2 : 1)
#define IN(k) (lo <= (k) && (k) < hi)
#define SEAM(k) do { if (IN(k) && IN((k) + 1)) xcd_barrier(bar); } while (0)
template <int LAYER> __device__ __forceinline__ void layer_phases(const Frame& F, const XcdBarrier& bar, const int lo, const int hi) {
    constexpr int layer = LAYER; constexpr int pb = 2 + 12 * LAYER;
        if (SITE(2) && IN(pb + 0)) { for (int rep_ = 0; rep_ < NREP(2); ++rep_) {
            const int N = layer == 0 ? ATT_NP : REC_NP;
            pg8::Gemm g{wsp<const bf16>(F, WS_A), layer == 0 ? wsp<const bf16>(F, WS_WIN0) : wsp<const bf16>(F, WS_WREC), R, N, 1024};
            pg8::StaticOrder S; S.init(R, N, F.G, F.blk);
            GEMM_CALL(FnStoreBf16, pg8::StaticOrder, g, S, (FnStoreBf16{wsp<bf16>(F, WS_P), N}));
             if (rep_ + 1 < NREP(2)) xcd_barrier(bar); } SEAM(pb + 0);
        }
        if constexpr (LAYER == 0) {
            if (SITE(3) && IN(pb + 1)) { for (int rep_ = 0; rep_ < NREP(3); ++rep_) { l0_post_proj(F);  if (rep_ + 1 < NREP(3)) xcd_barrier(bar); } SEAM(pb + 1); }
            if (SITE(4) && IN(pb + 2)) { for (int rep_ = 0; rep_ < NREP(4); ++rep_) {
                pg8::Gemm g{wsp<const bf16>(F, WS_CQN), wsp<const bf16>(F, WS_WUQ), R, 768, 384}; pg8::StaticOrder S; S.init(R, 768, F.G, F.blk);
                GEMM_CALL(FnStoreBf16, pg8::StaticOrder, g, S, (FnStoreBf16{wsp<bf16>(F, WS_MQ), 768}));
                 if (rep_ + 1 < NREP(4)) xcd_barrier(bar); } SEAM(pb + 2);
            }
            if (SITE(5) && IN(pb + 3)) { for (int rep_ = 0; rep_ < NREP(5); ++rep_) {
                pg8::Gemm g{wsp<const bf16>(F, WS_CKVN), wsp<const bf16>(F, WS_WUKV), R, 1024, 256}; pg8::StaticOrder S; S.init(R, 1024, F.G, F.blk);
                GEMM_CALL(FnStoreBf16, pg8::StaticOrder, g, S, (FnStoreBf16{wsp<bf16>(F, WS_MKV), 1024}));
                l0_mq_rope(F);
                 if (rep_ + 1 < NREP(5)) xcd_barrier(bar); } SEAM(pb + 3);
            }
            if (SITE(6) && IN(pb + 4)) { for (int rep_ = 0; rep_ < NREP(6); ++rep_) { l0_attention(F);  if (rep_ + 1 < NREP(6)) xcd_barrier(bar); } SEAM(pb + 4); }
            if (SITE(7) && IN(pb + 5)) { for (int rep_ = 0; rep_ < NREP(7); ++rep_) { l0_combine(F);  if (rep_ + 1 < NREP(7)) xcd_barrier(bar); } SEAM(pb + 5); }
        } else {
            if (SITE(8) && IN(pb + 1)) { for (int rep_ = 0; rep_ < NREP(8); ++rep_) { l1_rwkv_prep(F); l1_mlstm_a(F);  if (rep_ + 1 < NREP(8)) xcd_barrier(bar); } SEAM(pb + 1); }
            if (SITE(9) && IN(pb + 2)) { for (int rep_ = 0; rep_ < NREP(9); ++rep_) {
                pg8::Gemm g{wsp<const bf16>(F, WS_ALORA), wsp<const bf16>(F, WS_WLORA), R, 2560, 384}; pg8::StaticOrder S; S.init(R, 2560, F.G, F.blk);
                { int k_ = g.K; asm volatile("" : "+s"(k_)); g.K = k_; EpiLora E_{&F}; pg8::gemm_phase<EpiLora, pg8::StaticOrder, true, true>((PG8_LAS unsigned char*)F.lds, g, S, E_); }
                l1_mlstm_b(F);
                 if (rep_ + 1 < NREP(9)) xcd_barrier(bar); } SEAM(pb + 2);
            }
#if RK_CHUNKED
            if (SITE(18) && IN(pb + 3)) { for (int rep_ = 0; rep_ < NREP(18); ++rep_) { l1_rk_phase_a(F); if (rep_ + 1 < NREP(18)) xcd_barrier(bar); } SEAM(pb + 3); }
            if (SITE(10) && IN(pb + 4)) { for (int rep_ = 0; rep_ < NREP(10); ++rep_) {
                if (F.G > 32) { if (F.blk < 32) l1_rk_phase_b(F); else { l1_mlstm_c(F, 32, F.G - 32); moe_weights_convert(F, 1, (F.blk - 32) * 8 + F.wave, (F.G - 32) * 8); } }
                 if (rep_ + 1 < NREP(10)) xcd_barrier(bar); } SEAM(pb + 4);
            }
#else
            if (IN(pb + 3)) { SEAM(pb + 3); }
            if (SITE(10) && IN(pb + 4)) { for (int rep_ = 0; rep_ < NREP(10); ++rep_) {
                if (F.G > SC_NBLK) { if (F.blk < SC_NBLK) l1_rwkv_scan(F); else { l1_mlstm_c(F, SC_NBLK, F.G - SC_NBLK); moe_weights_convert(F, 1, (F.blk - SC_NBLK) * 8 + F.wave, (F.G - SC_NBLK) * 8); } }
                 if (rep_ + 1 < NREP(10)) xcd_barrier(bar); } SEAM(pb + 4);
            }
#endif
            if (SITE(11) && IN(pb + 5)) { for (int rep_ = 0; rep_ < NREP(11); ++rep_) { l1_rec_out(F);  if (rep_ + 1 < NREP(11)) xcd_barrier(bar); } SEAM(pb + 5); }
        }
        if (SITE(12) && IN(pb + 6)) { for (int rep_ = 0; rep_ < NREP(12); ++rep_) {
            pg8::Gemm g{wsp<const bf16>(F, WS_A1), wsp<const bf16>(F, WS_WOUT) + (size_t)layer * 1024 * 1024, R, 1024, 1024}; pg8::StaticOrder S; S.init(R, 1024, F.G, F.blk);
            GEMM_CALL(FnWout, pg8::StaticOrder, g, S, (FnWout{&F, layer}));
             if (rep_ + 1 < NREP(12)) xcd_barrier(bar); } SEAM(pb + 6);
        }
        if (SITE(13) && IN(pb + 7)) { for (int rep_ = 0; rep_ < NREP(13); ++rep_) { ph_router(F, layer);  if (rep_ + 1 < NREP(13)) xcd_barrier(bar); } SEAM(pb + 7); }
        if (SITE(14) && IN(pb + 8)) { for (int rep_ = 0; rep_ < NREP(14); ++rep_) { ph_gather(F, layer);  if (rep_ + 1 < NREP(14)) xcd_barrier(bar); } SEAM(pb + 8); }
        if (SITE(15) && IN(pb + 9)) { for (int rep_ = 0; rep_ < NREP(15); ++rep_) {
            const int* tab = wsp<const int>(F, WS_TILE);
            pg8::Gemm g{wsp<const bf16>(F, WS_XS), wsp<const bf16>(F, WS_W1T), MAXROWS, NE * 2048, 1024}; MoeOrder S{tab + 1, __builtin_amdgcn_readfirstlane(tab[0]), 8, F.G, F.blk};
            GEMM_CALL(FnSwiglu, MoeOrder, g, S, (FnSwiglu{wsp<bf16>(F, WS_HS), F.in[I_B1] + (size_t)layer * NE * 2048}));
             if (rep_ + 1 < NREP(15)) xcd_barrier(bar); } SEAM(pb + 9);
        }
        if (SITE(16) && IN(pb + 10)) { for (int rep_ = 0; rep_ < NREP(16); ++rep_) {
            const int* tab = wsp<const int>(F, WS_TILE);
            pg8::Gemm g{wsp<const bf16>(F, WS_HS), wsp<const bf16>(F, WS_W2T), MAXROWS, NE * 1024, 1024}; MoeOrder S{tab + 1, __builtin_amdgcn_readfirstlane(tab[0]), 4, F.G, F.blk};
            GEMM_CALL(FnBiasBf16, MoeOrder, g, S, (FnBiasBf16{wsp<bf16>(F, WS_XS), F.in[I_B2] + (size_t)layer * NE * 1024}));
             if (rep_ + 1 < NREP(16)) xcd_barrier(bar); } SEAM(pb + 10);
        }
        if (SITE(17) && IN(pb + 11)) { for (int rep_ = 0; rep_ < NREP(17); ++rep_) { ph_combine(F, layer);  if (rep_ + 1 < NREP(17)) xcd_barrier(bar); } SEAM(pb + 11); }
}
__global__ void __launch_bounds__(512, 2) fwd(Args args) {
    extern __shared__ __attribute__((aligned(16))) unsigned char lds_[];
    Frame F;
    F.lds = (LAS unsigned char*)lds_; F.tid = threadIdx.x; F.lane = F.tid & 63; F.wave = __builtin_amdgcn_readfirstlane(F.tid >> 6); F.blk = blockIdx.x; F.G = gridDim.x; F.probe = args.pad;
    F.ws = args.ws; F.out = args.out; F.ctl = (gu32*)(args.ws + WS_CTL);
    F.in.t = (LAS const unsigned*)(F.lds + MISC_OFF + 8192);
    if (F.tid < 64) ((LAS unsigned*)(F.lds + MISC_OFF))[F.tid] = 0u;
    if (F.tid < N_IN) { const unsigned long long pv = (unsigned long long)args.in[F.tid]; ((LAS unsigned*)(F.lds + MISC_OFF + 8192))[2 * F.tid] = (unsigned)pv; ((LAS unsigned*)(F.lds + MISC_OFF + 8192))[2 * F.tid + 1] = (unsigned)(pv >> 32); }
    __syncthreads();
    const int lo = args.ph_lo, hi = args.ph_hi;
    XcdBarrier bar; bar.bar = (unsigned*)(F.ctl + CW_BAR) + args.li * XCD_BAR_WORDS; bar.x = 0; bar.st = nullptr;
    if (hi - lo > 1) bar = xcd_barrier_post((unsigned*)(F.ctl + CW_BAR) + args.li * XCD_BAR_WORDS, (volatile LAS unsigned*)(F.lds + MISC_OFF));
    if (SITE(0) && IN(0)) { for (int rep_ = 0; rep_ < NREP(0); ++rep_) { p0a(F);  if (rep_ + 1 < NREP(0)) xcd_barrier(bar); } SEAM(0); }
    if (SITE(1) && IN(1)) { for (int rep_ = 0; rep_ < NREP(1); ++rep_) { p0b(F);  if (rep_ + 1 < NREP(1)) xcd_barrier(bar); } SEAM(1); }
    layer_phases<0>(F, bar, lo, hi);
    layer_phases<1>(F, bar, lo, hi);
}
#undef IN
#undef SEAM


extern "C" void kernel_launch(void* const* d_in, const int* in_sizes, int n_in, void* d_out, int out_size, void* d_ws, size_t ws_size, hipStream_t stream) {
    static int grid = 0;
    if (grid == 0) {
        const bool ok = n_in == N_IN && in_sizes[I_X] == NBATCH * SEQ * DM && in_sizes[I_RECW] == 1024 * REC_IN && in_sizes[I_ATTW] == 1024 * ATT_IN && in_sizes[I_MU] == RWKV_IN &&
                        in_sizes[I_GATEB] == 16 && in_sizes[I_W1] == 2 * NE * 1024 * 2048 && out_size == NBATCH * SEQ * DM && ws_size >= WS_END;
        if (!ok) { fprintf(stderr, "kernel_launch: shape mismatch (n_in %d, recw %d, attw %d, mu %d, out %d, ws %zu need %zu); nothing launched\n", n_in, n_in > I_RECW ? in_sizes[I_RECW] : -1,
                           n_in > I_ATTW ? in_sizes[I_ATTW] : -1, n_in > I_MU ? in_sizes[I_MU] : -1, out_size, ws_size, (size_t)WS_END); grid = -1; return; }
        int dev = 0, cus = 0;
        if (hipGetDevice(&dev) != hipSuccess || hipDeviceGetAttribute(&cus, hipDeviceAttributeMultiprocessorCount, dev) != hipSuccess) { grid = -1; return; }
        if (hipFuncSetAttribute((const void*)fwd, hipFuncAttributeMaxDynamicSharedMemorySize, LDS_BYTES) != hipSuccess) { fprintf(stderr, "kernel_launch: hipFuncSetAttribute failed\n"); grid = -1; return; }
        int per_cu = 0;
        if (hipOccupancyMaxActiveBlocksPerMultiprocessor(&per_cu, (const void*)fwd, 512, LDS_BYTES) != hipSuccess || per_cu < 1) { fprintf(stderr, "kernel_launch: occupancy query says %d blocks per CU\n", per_cu); }
        (void)hipGetLastError();
        grid = cus < 256 ? cus : 256;
        if (grid != 256) fprintf(stderr, "kernel_launch: %d CUs; this kernel is written for a 256-CU device\n", cus);
    }
    if (grid < 0) return;
    if (hipMemsetAsync((char*)d_ws + WS_CTL, 0, CTL_ZERO_BYTES, stream) != hipSuccess) return;
    Args a{};
    for (int i = 0; i < N_IN; ++i) a.in[i] = (const float*)d_in[i];
    a.out = (float*)d_out; a.ws = (unsigned char*)d_ws; a.pad = 0;
#if MK_PER_PHASE
    for (int ph = 0; ph < NPHASE; ++ph) { a.ph_lo = ph; a.ph_hi = ph + 1; a.li = 0; hipLaunchKernelGGL(fwd, dim3(grid), dim3(512), LDS_BYTES, stream, a); }
#elif defined(PROBE_LIST)
    { const int plist[] = {PROBE_LIST}; int cur = 0, li = 0;
      for (int p : plist) { a.ph_lo = cur; a.ph_hi = p + 1; a.li = li++; hipLaunchKernelGGL(fwd, dim3(grid), dim3(512), LDS_BYTES, stream, a);
                            a.ph_lo = p; a.ph_hi = p + 1; a.li = li++; a.pad = 1; hipLaunchKernelGGL(fwd, dim3(grid), dim3(512), LDS_BYTES, stream, a); a.pad = 0; cur = p + 1; }
      if (cur < NPHASE) { a.ph_lo = cur; a.ph_hi = NPHASE; a.li = li++; hipLaunchKernelGGL(fwd, dim3(grid), dim3(512), LDS_BYTES, stream, a); } }
#else
    a.ph_lo = 0; a.ph_hi = NPHASE; a.li = 0; hipLaunchKernelGGL(fwd, dim3(grid), dim3(512), LDS_BYTES, stream, a);
#endif
    const hipError_t le = hipPeekAtLastError();
    if (le != hipSuccess) fprintf(stderr, "kernel_launch: launch failed: %s\n", hipGetErrorName(le));
}
```

```cpp
#include <hip/hip_runtime.h>
#include <cstdio>
#include <cstdint>
#ifndef RK_CHUNKED
#define RK_CHUNKED 1
#endif
#define MK_PER_PHASE 0
namespace pg8 {
#define PG8_LAS __attribute__((address_space(3)))
typedef unsigned short bf16_t;
typedef short bf16x8 __attribute__((ext_vector_type(8)));
typedef float f32x4 __attribute__((ext_vector_type(4)));
typedef unsigned u32x4 __attribute__((ext_vector_type(4)));
constexpr int BM = 256, BK = 64, HALF = 128, HTB = HALF * BK * 2  , STAGE_BYTES = 8 * HTB, NXCD = 8, WGM = 8;

__host__ __device__ __forceinline__ int lds_byte(int r, int c) { const int st = (r >> 4) * 2 + (c >> 5), rr = r & 15, cc = c & 31, ob = rr * 64 + cc * 2; return st * 1024 + (ob ^ (((ob >> 9) & 1) << 5)); }
__host__ __device__ __forceinline__ void stage_rc(int b, int& R, int& C) { const int st = b / 1024, sb = b % 1024, swz = sb ^ (((sb >> 9) & 1) << 5); R = (st >> 1) * 16 + swz / 64; C = (st & 1) * 32 + (swz % 64) / 2; }
__host__ __device__ __forceinline__ int perm32(int rho) { const int n = rho >> 4, i = rho & 15; return 8 * (i >> 2) + 4 * n + (i & 3); }

struct Unit { int pm, pn; };
struct Gemm { const bf16_t* A; const bf16_t* Bt; int M, N, K; };

struct StaticOrder {
    int nM, nN, nwg, G, c;
    __host__ __device__ void init(int M, int N, int G_, int c_) { nM = M / BM; nN = N / BM; nwg = nM * nN; G = G_; c = c_; }
    __host__ __device__ bool next(int i, Unit& u) const {
        const long L = (long)i * G + c; if (L >= nwg) return false;
        int wgid = (int)L; { const int q = nwg / NXCD, r = nwg % NXCD, xcd = wgid % NXCD, off = wgid / NXCD; wgid = (xcd < r ? xcd * (q + 1) : r * (q + 1) + (xcd - r) * q) + off; }
        const int nig = WGM * nN, gid = wgid / nig, fm = gid * WGM, gsz = (nM - fm) < WGM ? (nM - fm) : WGM;
        u.pm = fm + ((wgid % nig) % gsz); u.pn = (wgid % nig) / gsz; return true;
    }
    __device__ __forceinline__ void a_ready(const Unit&) const {}
    __device__ __forceinline__ void done(const Unit&) const {}
};

__device__ __forceinline__ unsigned cvt_pk_bf16(float lo, float hi) { unsigned r; asm volatile("v_cvt_pk_bf16_f32 %0, %1, %2" : "=v"(r) : "v"(lo), "v"(hi)); return r; }
template <class Fn> struct EpiGen {
    static constexpr bool PERM = true, AFTER_DRAIN = false;
    Fn fn;
    __device__ __forceinline__ void operator()(const f32x4 (&acc)[2][2][4][2], const Unit& u, int wr, int wc, int fr, int fq) const {
#pragma unroll
        for (int ai = 0; ai < 2; ++ai)
#pragma unroll
            for (int m = 0; m < 4; ++m) { const int row = u.pm * BM + ai * HALF + wr * 64 + m * 16 + fr;
#pragma unroll
                for (int bj = 0; bj < 2; ++bj) { const int col = u.pn * BM + bj * HALF + wc * 32 + 8 * fq; fn(row, col, acc[ai][bj][m][0], acc[ai][bj][m][1]); } }
    }
};
template <class Epi, class Sched, bool ALIGN_EPI = false, bool SP2 = false>
__device__ __forceinline__ void gemm_phase(PG8_LAS unsigned char* lds, const Gemm g, const Sched& S, const Epi& E) {
    const int tid = threadIdx.x, wid = __builtin_amdgcn_readfirstlane(tid >> 6), lane = tid & 63, wr = wid >> 2, wc = wid & 3, fr = lane & 15, fq = lane >> 4;
    const int K = g.K, nt = K / BK;
    unsigned voffA[2], voffB[2];
#pragma unroll
    for (int i = 0; i < 2; ++i) { int R, C; stage_rc(tid * 16 + i * 8192, R, C); const int Rb = Epi::PERM ? ((R & ~31) + perm32(R & 31)) : R;
        voffA[i] = (unsigned)(R * K + C) * 2u; voffB[i] = (unsigned)(Rb * K + C) * 2u; }
    const size_t kstep = (size_t)(BK * 2);
    const size_t hstep = (size_t)HALF * K * 2;
    const size_t tstep = 2 * hstep;
    const unsigned ldsw = (unsigned)wid * 1024u;
    const int aoff = lds_byte(wr * 64 + fr, fq * 8), boff = lds_byte(wc * 32 + fr, fq * 8);
#define PG8_SA(b, h) (((b) * 2 + (h)) * HTB)
#define PG8_SB(b, h) ((4 + (b) * 2 + (h)) * HTB)
#define PG8_STAGE(bufoff, gbase, voff) do { _Pragma("unroll") for (int _i = 0; _i < 2; ++_i) \
        __builtin_amdgcn_global_load_lds((const unsigned*)((const char*)(gbase) + (voff)[_i]), (PG8_LAS unsigned*)(lds + (bufoff) + ldsw + _i * 8192), 16, 0, 0); } while (0)
#define PG8_LDA(dst, b, h) do { _Pragma("unroll") for (int m = 0; m < 4; ++m) _Pragma("unroll") for (int k = 0; k < 2; ++k) dst[m][k] = *(const PG8_LAS bf16x8*)(lds + PG8_SA(b, h) + aoff + m * 2048 + k * 1024); } while (0)
#define PG8_LDB(dst, b, h) do { _Pragma("unroll") for (int n = 0; n < 2; ++n) _Pragma("unroll") for (int k = 0; k < 2; ++k) dst[n][k] = *(const PG8_LAS bf16x8*)(lds + PG8_SB(b, h) + boff + n * 2048 + k * 1024); } while (0)
#define PG8_MMA(ai, bj, At, Bt) do { __builtin_amdgcn_s_setprio(1); _Pragma("unroll") for (int m = 0; m < 4; ++m) _Pragma("unroll") for (int n = 0; n < 2; ++n) _Pragma("unroll") for (int k = 0; k < 2; ++k) \
        acc[ai][bj][m][n] = __builtin_amdgcn_mfma_f32_16x16x32_bf16(Bt[n][k], At[m][k], acc[ai][bj][m][n], 0, 0, 0); __builtin_amdgcn_s_setprio(0); } while (0)
#define PG8_WAIT_V(n) asm volatile("s_waitcnt vmcnt(" #n ")" ::: "memory")
#define PG8_WAIT_L(n) asm volatile("s_waitcnt lgkmcnt(" #n ")" ::: "memory")
#define PG8_BAR __builtin_amdgcn_s_barrier()
#define PG8_SCHED __builtin_amdgcn_sched_barrier(0)
    Unit cur, nxt; int ui = 0;
    if (!S.next(0, cur)) return;
    f32x4 acc[2][2][4][2];
#pragma unroll
    for (int a = 0; a < 2; ++a)
#pragma unroll
        for (int b = 0; b < 2; ++b)
#pragma unroll
            for (int m = 0; m < 4; ++m)
#pragma unroll
                for (int n = 0; n < 2; ++n) acc[a][b][m][n] = (f32x4){0.f, 0.f, 0.f, 0.f};
    bf16x8 At[4][2], B0[2][2], B1[2][2];
    const char* cA = (const char*)g.A + (size_t)cur.pm * tstep; const char* cB = (const char*)g.Bt + (size_t)cur.pn * tstep;
    S.a_ready(cur);
    if constexpr (SP2) {
        PG8_STAGE(PG8_SB(0, 0), cB, voffB); PG8_STAGE(PG8_SB(0, 1), cB + hstep, voffB); PG8_STAGE(PG8_SA(0, 0), cA, voffA); PG8_STAGE(PG8_SA(0, 1), cA + hstep, voffA);
        if (wr == 1) PG8_BAR;
        PG8_WAIT_V(2); PG8_BAR;
        PG8_STAGE(PG8_SB(1, 0), cB + kstep, voffB); PG8_STAGE(PG8_SA(1, 0), cA + kstep, voffA); PG8_STAGE(PG8_SB(1, 1), cB + hstep + kstep, voffB);
        PG8_WAIT_V(6); PG8_BAR;
    } else {
        PG8_STAGE(PG8_SB(0, 0), cB, voffB); PG8_STAGE(PG8_SA(0, 0), cA, voffA); PG8_STAGE(PG8_SB(0, 1), cB + hstep, voffB); PG8_STAGE(PG8_SA(0, 1), cA + hstep, voffA);
        if (wr == 1) PG8_BAR;
        PG8_WAIT_V(4); PG8_BAR;
        PG8_STAGE(PG8_SB(1, 0), cB + kstep, voffB); PG8_STAGE(PG8_SA(1, 0), cA + kstep, voffA); PG8_STAGE(PG8_SB(1, 1), cB + hstep + kstep, voffB);
        PG8_WAIT_V(6); PG8_BAR;
    }
    for (;;) {
        const bool has_next = S.next(ui + 1, nxt);
        const char* nA = has_next ? (const char*)g.A + (size_t)nxt.pm * tstep : cA; const char* nB = has_next ? (const char*)g.Bt + (size_t)nxt.pn * tstep : cB;
        for (int t = 0; t < nt; t += 2) {
            const bool last = (t == nt - 2);
            const char* a1 = cA + (size_t)(t + 1) * kstep;
            const char* a2 = last ? nA : cA + (size_t)(t + 2) * kstep; const char* b2 = last ? nB : cB + (size_t)(t + 2) * kstep;
            const char* a3 = a2 + kstep; const char* b3 = b2 + kstep;
            if (last && has_next) S.a_ready(nxt);
            if constexpr (SP2) {
            PG8_LDB(B0, 0, 0); PG8_LDB(B1, 0, 1); PG8_SCHED; PG8_LDA(At, 0, 0); PG8_STAGE(PG8_SA(1, 1), a1 + hstep, voffA);
            PG8_WAIT_V(8); PG8_WAIT_L(0); PG8_BAR; PG8_MMA(0, 0, At, B0); PG8_MMA(0, 1, At, B1); PG8_BAR; PG8_SCHED;
            PG8_LDA(At, 0, 1); PG8_STAGE(PG8_SB(0, 0), b2, voffB); PG8_STAGE(PG8_SB(0, 1), b2 + hstep, voffB); PG8_STAGE(PG8_SA(0, 0), a2, voffA);
            PG8_WAIT_V(8); PG8_WAIT_L(0); PG8_BAR; PG8_MMA(1, 0, At, B0); PG8_MMA(1, 1, At, B1); PG8_BAR; PG8_SCHED;
            PG8_LDB(B0, 1, 0); PG8_LDB(B1, 1, 1); PG8_SCHED; PG8_LDA(At, 1, 0); PG8_STAGE(PG8_SA(0, 1), a2 + hstep, voffA);
            PG8_WAIT_V(8); PG8_WAIT_L(0); PG8_BAR; PG8_MMA(0, 0, At, B0); PG8_MMA(0, 1, At, B1); PG8_BAR; PG8_SCHED;
            PG8_LDA(At, 1, 1); PG8_STAGE(PG8_SB(1, 0), b3, voffB); PG8_STAGE(PG8_SB(1, 1), b3 + hstep, voffB); PG8_STAGE(PG8_SA(1, 0), a3, voffA);
            PG8_WAIT_V(8); PG8_WAIT_L(0); PG8_BAR; PG8_MMA(1, 0, At, B0); PG8_MMA(1, 1, At, B1); PG8_BAR; PG8_SCHED;
            } else {
            PG8_LDB(B0, 0, 0); PG8_SCHED; PG8_LDA(At, 0, 0); PG8_STAGE(PG8_SA(1, 1), a1 + hstep, voffA);
            PG8_WAIT_L(8); PG8_BAR; PG8_WAIT_L(0); PG8_MMA(0, 0, At, B0); PG8_BAR; PG8_SCHED;
            PG8_LDB(B1, 0, 1); PG8_STAGE(PG8_SB(0, 0), b2, voffB);
            PG8_BAR; PG8_WAIT_L(0); PG8_MMA(0, 1, At, B1); PG8_BAR;
            PG8_LDA(At, 0, 1); PG8_STAGE(PG8_SA(0, 0), a2, voffA);
            PG8_BAR; PG8_WAIT_L(0); PG8_MMA(1, 0, At, B0); PG8_BAR; PG8_SCHED;
            PG8_STAGE(PG8_SB(0, 1), b2 + hstep, voffB);
            PG8_WAIT_V(6); PG8_BAR; PG8_MMA(1, 1, At, B1); PG8_BAR;
            PG8_LDB(B0, 1, 0); PG8_SCHED; PG8_LDA(At, 1, 0); PG8_STAGE(PG8_SA(0, 1), a2 + hstep, voffA);
            PG8_WAIT_L(8); PG8_BAR; PG8_WAIT_L(0); PG8_MMA(0, 0, At, B0); PG8_BAR; PG8_SCHED;
            PG8_LDB(B1, 1, 1); PG8_STAGE(PG8_SB(1, 0), b3, voffB);
            PG8_BAR; PG8_WAIT_L(0); PG8_MMA(0, 1, At, B1); PG8_BAR;
            PG8_LDA(At, 1, 1); PG8_STAGE(PG8_SA(1, 0), a3, voffA);
            PG8_BAR; PG8_WAIT_L(0); PG8_MMA(1, 0, At, B0); PG8_BAR; PG8_SCHED;
            PG8_STAGE(PG8_SB(1, 1), b3 + hstep, voffB);
            PG8_WAIT_V(6); PG8_BAR; PG8_MMA(1, 1, At, B1); PG8_BAR;
            }
        }
        if constexpr (ALIGN_EPI) { if (wr == 0) PG8_BAR; }
        if constexpr (!Epi::AFTER_DRAIN) { E(acc, cur, wr, wc, fr, fq); S.done(cur); }
        if (!has_next) break;
#pragma unroll
        for (int a = 0; a < 2; ++a)
#pragma unroll
            for (int b = 0; b < 2; ++b)
#pragma unroll
                for (int m = 0; m < 4; ++m)
#pragma unroll
                    for (int n = 0; n < 2; ++n) acc[a][b][m][n] = (f32x4){0.f, 0.f, 0.f, 0.f};
        cur = nxt; cA = nA; cB = nB; ++ui;
        if constexpr (ALIGN_EPI) { if (wr == 1) PG8_BAR; }
    }
    PG8_WAIT_V(0);
    if constexpr (!ALIGN_EPI) { if (wr == 0) PG8_BAR; }
    PG8_BAR;
    if constexpr (Epi::AFTER_DRAIN) { E.fused(acc, cur, wr, wc, fr, fq, lds, wid, lane); S.done(cur); }
#undef PG8_SA
#undef PG8_SB
#undef PG8_STAGE
#undef PG8_LDA
#undef PG8_LDB
#undef PG8_MMA
#undef PG8_WAIT_V
#undef PG8_WAIT_L
#undef PG8_BAR
#undef PG8_SCHED
}
}
#define GAS __attribute__((address_space(1)))
#define LAS __attribute__((address_space(3)))
typedef unsigned short bf16;
typedef unsigned v4u __attribute__((ext_vector_type(4)));
typedef unsigned v2u __attribute__((ext_vector_type(2)));
typedef float f32x4 __attribute__((ext_vector_type(4)));
typedef short bf16x8 __attribute__((ext_vector_type(8)));
typedef GAS unsigned gu32;
typedef GAS unsigned long long gu64;
#define RLX_AGENT __ATOMIC_RELAXED, __HIP_MEMORY_SCOPE_AGENT
#define LDS_WAIT() asm volatile("s_waitcnt lgkmcnt(0)" ::: "memory")
#define VM_WAIT() asm volatile("s_waitcnt vmcnt(0)" ::: "memory")
typedef float f32x2_cv __attribute__((ext_vector_type(2)));
typedef __bf16 bf16x2_cv __attribute__((ext_vector_type(2)));
__device__ __forceinline__ unsigned pk2(float lo, float hi) { const f32x2_cv v = {lo, hi}; return __builtin_bit_cast(unsigned, __builtin_convertvector(v, bf16x2_cv)); }
__device__ __forceinline__ unsigned f2bf(float f) { return (unsigned)__builtin_bit_cast(unsigned short, (__bf16)f); }
__device__ __forceinline__ float bflo(unsigned w) { return __builtin_bit_cast(float, w << 16); }
__device__ __forceinline__ float bfhi(unsigned w) { return __builtin_bit_cast(float, w & 0xffff0000u); }
__device__ __forceinline__ float bf2f(bf16 b) { return __builtin_bit_cast(float, (unsigned)b << 16); }
__device__ __forceinline__ float wave_sum(float v) {
#pragma unroll
    for (int o = 1; o < 64; o <<= 1) v += __shfl_xor(v, o);
    return v;
}
__device__ __forceinline__ float sigmoidf_(float x) { return 1.f / (1.f + __expf(-x)); }

#define XB_TMO      128
#define XB_XCNT(j)  (256  + 64 * (j))
#define XB_XSUB(j)  (1280 + 64 * (j))
#define XB_XGEN(j)  (2304 + 64 * (j))
#define XB_TOP      3328
#define XB_TOPGEN   3392
#define XCD_BAR_WORDS 3456
#define XB_SPIN_CAP (1u << 22)

__device__ __forceinline__ unsigned xb_ld(unsigned* p)              { return __hip_atomic_load(p, __ATOMIC_RELAXED, __HIP_MEMORY_SCOPE_AGENT); }
__device__ __forceinline__ unsigned xb_add(unsigned* p, unsigned v) { return __hip_atomic_fetch_add(p, v, __ATOMIC_RELAXED, __HIP_MEMORY_SCOPE_AGENT); }
__device__ __forceinline__ unsigned xb_xcc_id() { return (unsigned)__builtin_amdgcn_s_getreg((3 << 11) | 20) & 0xFu; }
#define XB_SPIN(cond, bar) do { unsigned _sp = 0; while (cond) { __builtin_amdgcn_s_sleep(1); \
    if ((++_sp & 255u) == 0u) { if (xb_ld(&(bar)[XB_TMO])) break; if (_sp > XB_SPIN_CAP) { atomicAdd(&(bar)[XB_TMO], 1u); break; } } } } while (0)

struct XcdBarrier {
    unsigned* bar; unsigned x;
    volatile LAS unsigned* st;
};

__device__ __forceinline__ XcdBarrier xcd_barrier_post(unsigned* bar, volatile LAS unsigned* st) {
    XcdBarrier b; b.bar = bar; b.x = xb_xcc_id(); b.st = st;
    if (threadIdx.x == 0) (void)xb_add(&bar[XB_XCNT(b.x)], 1u);
    return b;
}
__device__ __forceinline__ void xcd_barrier_complete(unsigned* bar, unsigned x, unsigned& nloc, unsigned& nx) {
    const unsigned G = gridDim.x * gridDim.y * gridDim.z;
    unsigned sum, cnt, mine, sp = 0u;
    for (;;) {
        sum = 0u; cnt = 0u; mine = 0u;
#pragma unroll
        for (unsigned j = 0; j < 16; ++j) { const unsigned c = xb_ld(&bar[XB_XCNT(j)]); sum += c; cnt += (c > 0u) ? 1u : 0u; mine = (j == x) ? c : mine; }
        if (sum == G) break;
        __builtin_amdgcn_s_sleep(1);
        if ((++sp & 255u) == 0u) { if (xb_ld(&bar[XB_TMO])) break; if (sp > XB_SPIN_CAP) { atomicAdd(&bar[XB_TMO], 1u); break; } }
    }
    nloc = mine > 0u ? mine : 1u; nx = cnt > 0u ? cnt : 1u;
}

__device__ __forceinline__ void xcd_barrier(const XcdBarrier& b) {
    asm volatile("s_waitcnt vmcnt(0)" ::: "memory");
    __syncthreads();
    if (threadIdx.x == 0) {
        unsigned* bar = b.bar;
        __builtin_amdgcn_s_waitcnt(0);
        unsigned nloc = b.st[0], nx = b.st[1];
        if (nloc == 0u) { xcd_barrier_complete(bar, b.x, nloc, nx); b.st[0] = nloc; b.st[1] = nx; }
        const unsigned old = xb_add(&bar[XB_XSUB(b.x)], 1u);
        const unsigned gen = old / nloc;
        if (old + 1u == (gen + 1u) * nloc) {
            __builtin_amdgcn_fence(__ATOMIC_RELEASE, "agent");
            asm volatile("s_waitcnt vmcnt(0)" ::: "memory");
            const unsigned og = xb_add(&bar[XB_TOP], 1u);
            const unsigned tg = og / nx;
            if (og + 1u == (tg + 1u) * nx) xb_add(&bar[XB_TOPGEN], 1u);
            else XB_SPIN(xb_ld(&bar[XB_TOPGEN]) == tg, bar);
            __builtin_amdgcn_fence(__ATOMIC_ACQUIRE, "agent");
            xb_add(&bar[XB_XGEN(b.x)], 1u);
            asm volatile("s_waitcnt vmcnt(0)" ::: "memory");
        } else {
            XB_SPIN(xb_ld(&bar[XB_XGEN(b.x)]) == gen, bar);
            __builtin_amdgcn_fence(__ATOMIC_ACQUIRE, "agent");
            asm volatile("s_waitcnt vmcnt(0)" ::: "memory");
        }
    }
    __syncthreads();
}
namespace att {
using s16x4  = __attribute__((ext_vector_type(4))) short;
using f32x16 = __attribute__((ext_vector_type(16))) float;
using u32x4  = __attribute__((ext_vector_type(4))) unsigned;
#define ATT_SBAR() __builtin_amdgcn_sched_barrier(0)
constexpr float THR2 = 11.5f;
__device__ __forceinline__ int crow(int r, int hi) { return (r & 3) + 8 * (r >> 2) + 4 * hi; }
__device__ __forceinline__ unsigned cvtpk(float lo, float hi) { unsigned r; asm volatile("v_cvt_pk_bf16_f32 %0, %1, %2" : "=v"(r) : "v"(lo), "v"(hi)); return r; }

__device__ __forceinline__ void partialSM(f32x16& p0, f32x16& p1, float& m_reg, float& mn, float& alpha) {
  float pmax = p0[0];
#pragma unroll
  for (int r = 1; r < 16; ++r) pmax = fmaxf(pmax, p0[r]);
#pragma unroll
  for (int r = 0; r < 16; ++r) pmax = fmaxf(pmax, p1[r]);
  { auto rr = __builtin_amdgcn_permlane32_swap(__float_as_uint(pmax), __float_as_uint(pmax), false, false);
    pmax = fmaxf(__uint_as_float(rr[0]), __uint_as_float(rr[1])); }
  if (__builtin_expect(__all(pmax - m_reg <= THR2), 1)) { mn = m_reg; alpha = 1.f; }
  else { mn = fmaxf(m_reg, pmax); alpha = __builtin_amdgcn_exp2f(m_reg - mn); m_reg = mn; }
#pragma unroll
  for (int r = 0; r < 16; ++r) p0[r] = p0[r] - mn;
#pragma unroll
  for (int r = 0; r < 16; ++r) p1[r] = p1[r] - mn;
#pragma unroll
  for (int r = 0; r < 16; ++r) p0[r] = __builtin_amdgcn_exp2f(p0[r]);
}
__device__ __forceinline__ void finishSM(f32x16& p0, f32x16& p1, float alpha, float& l_reg, bf16x8& pa0, bf16x8& pa1, bf16x8& pa2, bf16x8& pa3) {
#pragma unroll
  for (int r = 0; r < 16; ++r) p1[r] = __builtin_amdgcn_exp2f(p1[r]);
  float ps = 0;
#pragma unroll
  for (int r = 0; r < 16; ++r) ps += p0[r];
#pragma unroll
  for (int r = 0; r < 16; ++r) ps += p1[r];
  { auto rr = __builtin_amdgcn_permlane32_swap(__float_as_uint(ps), __float_as_uint(ps), false, false);
    ps = __uint_as_float(rr[0]) + __uint_as_float(rr[1]); }
  l_reg = l_reg * alpha + ps;
#define ATT_PK4(P, BASE, OUT) do { unsigned a0 = cvtpk(P[BASE + 0], P[BASE + 1]), a1 = cvtpk(P[BASE + 2], P[BASE + 3]);   \
    unsigned b0 = cvtpk(P[BASE + 4], P[BASE + 5]), b1 = cvtpk(P[BASE + 6], P[BASE + 7]);                              \
    auto r0 = __builtin_amdgcn_permlane32_swap(a0, b0, false, false); auto r1 = __builtin_amdgcn_permlane32_swap(a1, b1, false, false); \
    u32x4 w = {r0[0], r1[0], r0[1], r1[1]}; OUT = *reinterpret_cast<bf16x8*>(&w); } while (0)
  ATT_PK4(p0, 0, pa0); ATT_PK4(p0, 8, pa1); ATT_PK4(p1, 0, pa2); ATT_PK4(p1, 8, pa3);
#undef ATT_PK4
}
template <int NB> __device__ __forceinline__ int v_st(int k, int c) { const int kk = (k & ~0xC) | ((k & 4) << 1) | ((k & 8) >> 1); return ((kk >> 3) * NB + (c >> 5)) * 512 + ((kk & 7) * 32 + (c & 31)) * 2; }
__device__ __forceinline__ int v_rd_base(int lane) { return ((lane & 3) << 3) | (((lane >> 2) & 3) << 6) | (((lane >> 4) & 1) << 5) | (((lane >> 5) & 1) << 8); }
template <int OFF> __device__ __forceinline__ s16x4 tr_read(int vb) {
  s16x4 r; asm volatile("ds_read_b64_tr_b16 %0, %1 offset:%2" : "=&v"(r) : "v"(vb), "i"(OFF) : "memory"); return r;
}
template <int NB, int D0> __device__ __forceinline__ void pv_one(f32x16& od, int vb, bf16x8 pa0, bf16x8 pa1, bf16x8 pa2, bf16x8 pa3) {
#define ATT_VOFF(ks, half) (D0 * 512 + (ks) * (NB * 1024) + (half) * (NB * 512))
  const s16x4 l0 = tr_read<ATT_VOFF(0, 0)>(vb), h0 = tr_read<ATT_VOFF(0, 1)>(vb), l1 = tr_read<ATT_VOFF(1, 0)>(vb), h1 = tr_read<ATT_VOFF(1, 1)>(vb);
  const s16x4 l2 = tr_read<ATT_VOFF(2, 0)>(vb), h2 = tr_read<ATT_VOFF(2, 1)>(vb), l3 = tr_read<ATT_VOFF(3, 0)>(vb), h3 = tr_read<ATT_VOFF(3, 1)>(vb);
#undef ATT_VOFF
  asm volatile("s_waitcnt lgkmcnt(0)" ::: "memory"); ATT_SBAR();
#define ATT_PK(L, H) (bf16x8){L[0], L[1], L[2], L[3], H[0], H[1], H[2], H[3]}
  od = __builtin_amdgcn_mfma_f32_32x32x16_bf16(pa0, ATT_PK(l0, h0), od, 0, 0, 0);
  od = __builtin_amdgcn_mfma_f32_32x32x16_bf16(pa1, ATT_PK(l1, h1), od, 0, 0, 0);
  od = __builtin_amdgcn_mfma_f32_32x32x16_bf16(pa2, ATT_PK(l2, h2), od, 0, 0, 0);
  od = __builtin_amdgcn_mfma_f32_32x32x16_bf16(pa3, ATT_PK(l3, h3), od, 0, 0, 0);
#undef ATT_PK
}
template <int NB> __device__ __forceinline__ void pv_all(f32x16* o, int vb, bf16x8 pa0, bf16x8 pa1, bf16x8 pa2, bf16x8 pa3) {
  pv_one<NB, 0>(o[0], vb, pa0, pa1, pa2, pa3); pv_one<NB, 1>(o[1], vb, pa0, pa1, pa2, pa3);
  if constexpr (NB == 4) { pv_one<NB, 2>(o[2], vb, pa0, pa1, pa2, pa3); pv_one<NB, 3>(o[3], vb, pa0, pa1, pa2, pa3); }
}
template <int DK> __device__ __forceinline__ void qkt(f32x16& p0, f32x16& p1, LAS const char* Ks, const bf16x8* qr, int r32, int hi) {
  constexpr int KSTR = DK * 2 + 16;
  p0 = f32x16{}; p1 = f32x16{};
#pragma unroll
  for (int d0 = 0; d0 < DK / 16; ++d0) { const int cb = (d0 * 16 + hi * 8) * 2;
    const bf16x8 b0 = *(LAS const bf16x8*)(Ks + r32 * KSTR + cb);
    const bf16x8 b1 = *(LAS const bf16x8*)(Ks + (32 + r32) * KSTR + cb);
    p0 = __builtin_amdgcn_mfma_f32_32x32x16_bf16(b0, qr[d0], p0, 0, 0, 0);
    p1 = __builtin_amdgcn_mfma_f32_32x32x16_bf16(b1, qr[d0], p1, 0, 0, 0); }
}
template <int DK, int DV> struct Cfg {
  static constexpr int KSTR = DK * 2 + 16, KT = 64 * KSTR, NB = DV / 32, VT = 64 * DV * 2, NQ = DK / 16;
  static constexpr int NKC = DK / 8, NVC = DV / 8;
  static constexpr int KN = (64 * NKC + 511) / 512, VN = (64 * NVC + 511) / 512;
  static constexpr int OFF_V = 0, OFF_K = 2 * VT, OFF_WS = 2 * VT + 2 * KT, LDS_BYTES = OFF_WS + 8 * 64 * 4;
};
template <int DK, int DV>
__device__ __forceinline__ void attn_unit(const bf16* __restrict__ Qb, int ldq, const bf16* __restrict__ K1, int ldk1, const bf16* __restrict__ K2, int ldk2,
                                          const bf16* __restrict__ Vh, int ldv, float* __restrict__ Ob, int ldo, int nkeys, LAS char* lds) {
  using C = Cfg<DK, DV>;
  const int tid = threadIdx.x, wid = tid >> 6, lane = tid & 63, r32 = lane & 31, hi = lane >> 5;
  LAS char* V_lds = lds + C::OFF_V; LAS char* K_lds = lds + C::OFF_K;
  LAS float* ws = (LAS float*)(lds + C::OFF_WS) + wid * 64; LAS float* li_l = ws; LAS float* al_l = ws + 32;
  float m_reg = -1e30f, l_reg = 0; f32x16 o[C::NB] = {}; bf16x8 qr[C::NQ];
  { const bf16* Qw = Qb + (long)(wid * 32 + r32) * ldq + hi * 8;
#pragma unroll
    for (int d0 = 0; d0 < C::NQ; ++d0) qr[d0] = *(const bf16x8*)(Qw + d0 * 16); }
  unsigned kg[C::KN], kw[C::KN], vg[C::VN], vw[C::VN]; const bool k2val = tid < 256;
  kg[0] = (unsigned)((tid >> 3) * ldk1 + (tid & 7) * 8); kw[0] = (unsigned)((tid >> 3) * C::KSTR + (tid & 7) * 16);
  if constexpr (C::KN == 2) { const int t2 = tid & 255; kg[1] = (unsigned)((t2 >> 2) * ldk2 + (t2 & 3) * 8); kw[1] = (unsigned)((t2 >> 2) * C::KSTR + (8 + (t2 & 3)) * 16); }
#pragma unroll
  for (int i = 0; i < C::VN; ++i) { const int it = tid + 512 * i, vrow = it / C::NVC, vcol = (it % C::NVC) * 8; vg[i] = (unsigned)(vrow * ldv + vcol); vw[i] = (unsigned)v_st<C::NB>(vrow, vcol); }
  const int vb0 = (int)(uintptr_t)V_lds + v_rd_base(lane);
  struct Slot { bf16x8 ks[C::KN], vs[C::VN]; } sA, sB;
#define ATT_SLOAD(S, k0) do { S.ks[0] = *(const bf16x8*)(K1 + (size_t)(k0) * ldk1 + kg[0]); if constexpr (C::KN == 2) S.ks[1] = *(const bf16x8*)(K2 + (size_t)(k0) * ldk2 + kg[1]); \
    _Pragma("unroll") for (int i = 0; i < C::VN; ++i) S.vs[i] = *(const bf16x8*)(Vh + (size_t)(k0) * ldv + vg[i]); } while (0)
#define ATT_SWRITE(b, S) do { *(LAS bf16x8*)(K_lds + (b) * C::KT + kw[0]) = S.ks[0]; if constexpr (C::KN == 2) { if (k2val) *(LAS bf16x8*)(K_lds + (b) * C::KT + kw[1]) = S.ks[1]; } \
    _Pragma("unroll") for (int i = 0; i < C::VN; ++i) *(LAS bf16x8*)(V_lds + (b) * C::VT + vw[i]) = S.vs[i]; } while (0)
#define ATT_SWAIT() asm volatile("s_waitcnt vmcnt(3)" ::: "memory")
#define ATT_RESC(a) do { if (__any((a) < 1.f)) { if (hi == 0) al_l[r32] = (a); asm volatile("s_waitcnt lgkmcnt(0)" ::: "memory"); \
    _Pragma("unroll") for (int d = 0; d < C::NB; ++d) _Pragma("unroll") for (int r = 0; r < 16; ++r) o[d][r] *= al_l[crow(r, hi)]; } } while (0)
  static_assert(C::KN + C::VN == 3, "three staging loads per thread per tile (ATT_SWAIT)");
  f32x16 pA0, pA1, pB0, pB1; float mnA, mnB, alA, alB; bf16x8 pa0, pa1, pa2, pa3; const int NT = nkeys / 64;
  __syncthreads();
  ATT_SLOAD(sA, 0); asm volatile("s_waitcnt vmcnt(0)" ::: "memory"); ATT_SWRITE(0, sA); __syncthreads();
  qkt<DK>(pA0, pA1, K_lds, qr, r32, hi); partialSM(pA0, pA1, m_reg, mnA, alA);
  ATT_SLOAD(sB, 64); if (2 < NT) ATT_SLOAD(sA, 128);
  ATT_SWAIT(); ATT_SWRITE(1, sB); __syncthreads();
  for (int j = 1; j + 1 < NT; j += 2) {
    ATT_SBAR(); qkt<DK>(pB0, pB1, K_lds + C::KT, qr, r32, hi);
    finishSM(pA0, pA1, alA, l_reg, pa0, pa1, pa2, pa3); ATT_SBAR();
    ATT_SLOAD(sB, (j + 2) * 64); ATT_SBAR();
    pv_all<C::NB>(o, vb0, pa0, pa1, pa2, pa3); partialSM(pB0, pB1, m_reg, mnB, alB);
    __syncthreads(); ATT_SWAIT(); ATT_SWRITE(0, sA);
    ATT_RESC(alB); __syncthreads();
    ATT_SBAR(); qkt<DK>(pA0, pA1, K_lds, qr, r32, hi);
    finishSM(pB0, pB1, alB, l_reg, pa0, pa1, pa2, pa3); ATT_SBAR();
    if (j + 3 < NT) ATT_SLOAD(sA, (j + 3) * 64); ATT_SBAR();
    pv_all<C::NB>(o, vb0 + C::VT, pa0, pa1, pa2, pa3); partialSM(pA0, pA1, m_reg, mnA, alA);
    __syncthreads(); ATT_SWAIT(); ATT_SWRITE(1, sB);
    ATT_RESC(alA); __syncthreads();
  }
  ATT_SBAR(); qkt<DK>(pB0, pB1, K_lds + C::KT, qr, r32, hi);
  finishSM(pA0, pA1, alA, l_reg, pa0, pa1, pa2, pa3); ATT_SBAR();
  pv_all<C::NB>(o, vb0, pa0, pa1, pa2, pa3); partialSM(pB0, pB1, m_reg, mnB, alB);
  __syncthreads(); ATT_RESC(alB);
  finishSM(pB0, pB1, alB, l_reg, pa0, pa1, pa2, pa3); ATT_SBAR();
  pv_all<C::NB>(o, vb0 + C::VT, pa0, pa1, pa2, pa3);
  if (hi == 0) li_l[r32] = l_reg; asm volatile("s_waitcnt lgkmcnt(0)" ::: "memory");
  float rli[16];
#pragma unroll
  for (int r = 0; r < 16; ++r) rli[r] = __builtin_amdgcn_rcpf(li_l[crow(r, hi)]);
  float* Ow = Ob + (long)(wid * 32) * ldo;
#pragma unroll
  for (int r = 0; r < 16; ++r) { const int orow = crow(r, hi);
#pragma unroll
    for (int d0 = 0; d0 < C::NB; ++d0) Ow[(long)orow * ldo + d0 * 32 + r32] = o[d0][r] * rli[r]; }
#undef ATT_SLOAD
#undef ATT_SWRITE
#undef ATT_SWAIT
#undef ATT_RESC
}
}
constexpr int DM = 1024, NBATCH = 2, SEQ = 16384, CT = 256, TB = SEQ + CT  , R = NBATCH * TB  ;
constexpr int ATT_IN = 2208, ATT_NP = 2304, REC_IN = 3472, REC_NP = 3584, RWKV_IN = 1920;
constexpr int NE = 32, TOPK = 4, MAXT = R * TOPK / 256 + NE  , MAXROWS = MAXT * 256;
constexpr int NUNIT_M = 16 * 260;
constexpr float NORM_EPS = 1e-6f;
enum { I_X = 0, I_C, I_CTX, I_CCTX, I_NMIX, I_NFFN, I_ADAW, I_ADAB, I_WOUT, I_RW, I_RB, I_W1, I_B1, I_W2, I_B2, I_ATTW, I_LAM, I_SUBLN, I_QNW, I_KVNW, I_WUQ, I_WUKV,
       I_RECW, I_MU, I_W0, I_RW2, I_A0, I_A2, I_G2, I_KK, I_KA, I_RK, I_LNW, I_LNB, I_GATEB, I_MNW, I_FNW, N_IN };
constexpr size_t al256(size_t x) { return (x + 255) & ~(size_t)255; }
constexpr size_t WS_CTL = 0, CTL_ZERO_BYTES = 1u << 20;
constexpr size_t WS_MOD = CTL_ZERO_BYTES;
constexpr size_t WS_ROPE = al256(WS_MOD + 2 * 3 * 6144 * 4);
constexpr size_t ROPE_DR = 0, ROPE_DC = 256 * 16 * 2, ROPE_MR = ROPE_DC + 64 * 16 * 2, ROPE_MC = ROPE_MR + 256 * 8 * 2, ROPE_FLOATS = ROPE_MC + 64 * 8 * 2;
constexpr size_t WS_WRH = al256(WS_ROPE + ROPE_FLOATS * 4);
constexpr size_t WS_WRL = al256(WS_WRH + (size_t)2 * 32 * 1024 * 2);
constexpr size_t WS_WIN0 = al256(WS_WRL + (size_t)2 * 32 * 1024 * 2);
constexpr size_t WS_WUQ = al256(WS_WIN0 + (size_t)ATT_NP * 1024 * 2);
constexpr size_t WS_WUKV = al256(WS_WUQ + (size_t)768 * 384 * 2);
constexpr size_t WS_WOUT = al256(WS_WUKV + (size_t)1024 * 256 * 2);
constexpr size_t WS_WREC = al256(WS_WOUT + (size_t)2 * 1024 * 1024 * 2);
constexpr size_t WS_WLORA = al256(WS_WREC + (size_t)REC_NP * 1024 * 2);
constexpr size_t WS_W1T = al256(WS_WLORA + (size_t)2560 * 384 * 2);
constexpr size_t WS_W2T = al256(WS_W1T + (size_t)NE * 2048 * 1024 * 2);
constexpr size_t WS_H = al256(WS_W2T + (size_t)NE * 1024 * 1024 * 2);
constexpr size_t WS_A = al256(WS_H + (size_t)R * 1024 * 4);
constexpr size_t WS_A1 = al256(WS_A + (size_t)R * 1024 * 2);
constexpr size_t WS_F = al256(WS_A1 + (size_t)R * 1024 * 2);
constexpr size_t WS_P = al256(WS_F + (size_t)R * 1024 * 2);
constexpr size_t WS_TOPE = al256(WS_P + (size_t)R * REC_NP * 2);
constexpr size_t WS_GATE = al256(WS_TOPE + (size_t)R * 16);
constexpr size_t WS_POS = al256(WS_GATE + (size_t)R * 16);
constexpr size_t WS_DEST = al256(WS_POS + (size_t)R * 16);
constexpr size_t WS_TILE = al256(WS_DEST + (size_t)R * 16);
constexpr size_t WS_T = al256(WS_TILE + (size_t)(MAXT + 8) * 4);
constexpr size_t WS_QD = WS_T;
constexpr size_t WS_KD = al256(WS_QD + (size_t)R * 512 * 2);
constexpr size_t WS_CQN = al256(WS_KD + (size_t)R * 512 * 2);
constexpr size_t WS_CKVN = al256(WS_CQN + (size_t)R * 384 * 2);
constexpr size_t WS_MQ = al256(WS_CKVN + (size_t)R * 256 * 2);
constexpr size_t WS_MKV = al256(WS_MQ + (size_t)R * 768 * 2);
constexpr size_t WS_KRR = al256(WS_MKV + (size_t)R * 1024 * 2);
constexpr size_t WS_ODIFF = al256(WS_KRR + (size_t)R * 32 * 2);
constexpr size_t WS_OMLA = al256(WS_ODIFF + (size_t)R * 1024 * 4);
constexpr size_t WS_T0_END = al256(WS_OMLA + (size_t)R * 512 * 4);
constexpr size_t WS_XS = WS_T;
constexpr size_t WS_HS = al256(WS_XS + (size_t)MAXROWS * 1024 * 2);
constexpr size_t WS_TM_END = al256(WS_HS + (size_t)MAXROWS * 1024 * 2);
constexpr size_t SZ_RC = (size_t)R * 512 * 4;
constexpr size_t WS_RR = WS_T, WS_VV = WS_RR + SZ_RC, WS_AKK = WS_VV + SZ_RC, WS_KL = WS_AKK + SZ_RC;
constexpr size_t WS_WDEC = WS_KL + SZ_RC  , WS_KDIR = WS_WDEC + 2 * SZ_RC  , WS_BB = WS_KDIR + 2 * SZ_RC  , WS_GG = WS_BB + 2 * SZ_RC;
constexpr size_t WS_ALORA = al256(WS_GG + SZ_RC);
constexpr size_t WS_YR = al256(WS_ALORA + (size_t)R * 384 * 2);
constexpr size_t WS_DC = WS_YR;
constexpr size_t WS_HM = al256(WS_YR + 2 * SZ_RC);
constexpr size_t WS_CST = al256(WS_HM + 2 * SZ_RC);
constexpr size_t WS_DN = al256(WS_CST + (size_t)NUNIT_M * 8192 * 4);
constexpr size_t WS_NST = al256(WS_DN + (size_t)NUNIT_M * 64 * 4);
constexpr size_t WS_SC = al256(WS_NST + (size_t)NUNIT_M * 64 * 4);
constexpr size_t WS_MST = al256(WS_SC + (size_t)NUNIT_M * 2 * 4);
constexpr size_t WS_ASIG = WS_KDIR;
constexpr size_t WS_YB = WS_BB;
constexpr int NUNIT_R = 32 * 260;
constexpr size_t WS_RKM = WS_KDIR + SZ_RC;
static_assert((size_t)NUNIT_R * 4096 * 2 <= SZ_RC, "M^T fits in KL");
constexpr size_t WS_RKQ = al256(WS_MST + (size_t)NUNIT_M * 4);
constexpr size_t WS_RKZ = al256(WS_RKQ + (size_t)NUNIT_R * 4096 * 2);
constexpr size_t WS_T1_END = al256(WS_RKZ + (size_t)NUNIT_R * 4096 * 2);
constexpr size_t WS_END = WS_T1_END > WS_TM_END ? (WS_T1_END > WS_T0_END ? WS_T1_END : WS_T0_END) : (WS_TM_END > WS_T0_END ? WS_TM_END : WS_T0_END);
static_assert(WS_END <= (size_t)2147483648ull, "workspace map exceeds 2 GiB");
constexpr int CW_CNT = 1024;
constexpr int CW_BAR = 4096;
constexpr int RING_BYTES = 131072, AUX_OFF = 131072, AUX_BYTES = 16384, MISC_OFF = 147456, LDS_BYTES = 163840;

struct Frame {
    LAS unsigned char* lds; gu32* ctl; int tid, lane, wave, blk, G, probe;
    float* out; unsigned char* ws;
    struct InTab { LAS const unsigned* t;
        __device__ __forceinline__ const float* operator[](int i) const { const unsigned lo = __builtin_amdgcn_readfirstlane(t[2 * i]), hi = __builtin_amdgcn_readfirstlane(t[2 * i + 1]);
            return (const float*)(((unsigned long long)hi << 32) | lo); } } in;
};
template <class T> __device__ __forceinline__ T* wsp(const Frame& F, size_t off) { return (T*)(F.ws + off); }
__device__ __forceinline__ int row_sel(int row) { const int b = row / TB, t = row - b * TB; return t < CT ? 2 : b; }
__device__ __forceinline__ const float* h0_row(const Frame& F, int row) {
    const int b = row / TB, t = row - b * TB;
    return t < CT ? F.in[I_CTX] + ((size_t)b * CT + t) * DM : F.in[I_X] + ((size_t)b * SEQ + (t - CT)) * DM;
}
__device__ __forceinline__ const float* modp(const Frame& F, int layer, int sel, int chunk) { return wsp<const float>(F, WS_MOD) + ((size_t)(layer * 3 + sel) * 6 + chunk) * DM; }
__device__ __forceinline__ int scan_tok(int z, int sg) { return z == 0 ? sg : (sg < CT ? CT - 1 - sg : TB + CT - 1 - sg); }
__device__ __forceinline__ void tr_item(const float* W, int K, int N, bf16* WT, int row_off, LAS float* scr, int kb, int nb, int lane) {
    const int k0 = 64 * kb, n0 = 32 * nb;
    const int n = n0 + (lane & 31);
    float tv[32];
#pragma unroll
    for (int i = 0; i < 32; ++i) { const int kk = 2 * i + (lane >> 5); tv[i] = (n < N) ? W[(size_t)(k0 + kk) * N + n] : 0.f; }
#pragma unroll
    for (int i = 0; i < 32; ++i) { const int kk = 2 * i + (lane >> 5); scr[kk * 33 + (lane & 31)] = tv[i]; }
    LDS_WAIT(); asm volatile("" ::: "memory");
    const int c = lane & 7;
#pragma unroll
    for (int j = 0; j < 4; ++j) { const int nn = (lane >> 3) + 8 * j; const LAS float* s = scr + (8 * c) * 33 + nn;
        v4u o; o.x = pk2(s[0 * 33], s[1 * 33]); o.y = pk2(s[2 * 33], s[3 * 33]); o.z = pk2(s[4 * 33], s[5 * 33]); o.w = pk2(s[6 * 33], s[7 * 33]);
        *(v4u*)(WT + (size_t)(row_off + n0 + nn) * K + k0 + 8 * c) = o; }
    LDS_WAIT(); asm volatile("" ::: "memory");
}
__device__ __forceinline__ void tr_family(const Frame& F, const float* W, size_t src_stride, int nmat, int K, int N, int Npad, bf16* WT, int gw, int NGW) {
    LAS float* scr = (LAS float*)(F.lds + F.wave * 16384);
    const int nkb = K / 64, nnb = Npad / 32, per = nkb * nnb, total = per * nmat;
    for (int it = gw; it < total; it += NGW) { const int m = it / per, r = it - m * per, kb = r / nnb, nb = r - kb * nnb;
        tr_item(W + (size_t)m * src_stride, K, N, WT, m * Npad, scr, kb, nb, F.lane); }
}
__device__ __forceinline__ void moe_weights_convert(const Frame& F, int layer, int gw, int NGW) {
    tr_family(F, F.in[I_W1] + (size_t)layer * NE * 1024 * 2048, (size_t)1024 * 2048, NE, 1024, 2048, 2048, wsp<bf16>(F, WS_W1T), gw, NGW);
    tr_family(F, F.in[I_W2] + (size_t)layer * NE * 1024 * 1024, (size_t)1024 * 1024, NE, 1024, 1024, 1024, wsp<bf16>(F, WS_W2T), gw, NGW);
}
__device__ __forceinline__ void norm_mod_row(const Frame& F, const float* src, const float* nw, const float* shift, const float* scale, bf16* orow) {
    const f32x4* xr = (const f32x4*)src + F.lane;
    f32x4 v[4]; float s = 0.f;
#pragma unroll
    for (int j = 0; j < 4; ++j) { v[j] = xr[64 * j]; s += (v[j].x * v[j].x + v[j].y * v[j].y) + (v[j].z * v[j].z + v[j].w * v[j].w); }
    const float rs = 1.f / sqrtf(wave_sum(s) * (1.f / DM) + NORM_EPS);
    unsigned long long* o8 = (unsigned long long*)orow + F.lane;
#pragma unroll
    for (int j = 0; j < 4; ++j) { const f32x4 w = ((const f32x4*)nw)[F.lane + 64 * j], sh = ((const f32x4*)shift)[F.lane + 64 * j], sc = ((const f32x4*)scale)[F.lane + 64 * j];
        const f32x4 y = v[j] * rs * w * (sc + 1.f) + sh;
        o8[64 * j] = (unsigned long long)pk2(y.x, y.y) | ((unsigned long long)pk2(y.z, y.w) << 32); }
}
__device__ __forceinline__ void p0a(const Frame& F) {
    LAS float* sv = (LAS float*)F.lds; LAS float* red = (LAS float*)(F.lds + 16384);
    for (int i = F.tid; i < 3 * DM; i += 512) { const int s = i / DM, k = i - s * DM; const float cv = (s < 2) ? F.in[I_C][s * DM + k] : F.in[I_CCTX][k]; sv[i] = cv / (1.f + __expf(-cv)); }
    __syncthreads();
    for (int it = F.blk; it < 192; it += F.G) {
        const int l = it / 96, cgp = it - l * 96, kq = F.tid >> 4, cg = F.tid & 15, col = cgp * 64 + cg * 4;
        float acc[3][4];
#pragma unroll
        for (int s = 0; s < 3; ++s)
#pragma unroll
            for (int j = 0; j < 4; ++j) acc[s][j] = 0.f;
        const float* W = F.in[I_ADAW] + (size_t)l * DM * 6144 + col;
#pragma unroll 16
        for (int kk = 0; kk < 32; ++kk) { const int k = kq * 32 + kk; const f32x4 w = *(const f32x4*)(W + (size_t)k * 6144);
            const float s0 = sv[k], s1 = sv[DM + k], s2 = sv[2 * DM + k];
#pragma unroll
            for (int j = 0; j < 4; ++j) { acc[0][j] += s0 * w[j]; acc[1][j] += s1 * w[j]; acc[2][j] += s2 * w[j]; } }
#pragma unroll
        for (int s = 0; s < 3; ++s)
#pragma unroll
            for (int j = 0; j < 4; ++j) red[(kq * 16 + cg) * 12 + s * 4 + j] = acc[s][j];
        __syncthreads();
        if (F.tid < 192) { const int s = F.tid / 64, cc = F.tid - s * 64, cg2 = cc >> 2, j = cc & 3; float t = 0.f;
            for (int q = 0; q < 32; ++q) t += red[(q * 16 + cg2) * 12 + s * 4 + j];
            wsp<float>(F, WS_MOD)[(size_t)(l * 3 + s) * 6144 + cgp * 64 + cc] = t + F.in[I_ADAB][l * 6144 + cgp * 64 + cc]; }
        __syncthreads();
    }
    const int gid = F.blk * 512 + F.tid, GT = F.G * 512;
    float* rope = wsp<float>(F, WS_ROPE);
    for (int i = gid; i < 256 * 16 + 64 * 16 + 256 * 8 + 64 * 8; i += GT) {
        int j = i; float pos, inv; size_t off;
        if (j < 256 * 16) { pos = (float)(j / 16); inv = powf(10000.f, -(float)(j % 16) / 16.f); off = ROPE_DR + (size_t)j * 2; }
        else if ((j -= 256 * 16) < 64 * 16) { pos = (float)(j / 16); inv = powf(10000.f, -(float)(j % 16) / 16.f); off = ROPE_DC + (size_t)j * 2; }
        else if ((j -= 64 * 16) < 256 * 8) { pos = (float)(j / 8); inv = powf(10000.f, -(float)(j % 8) / 8.f); off = ROPE_MR + (size_t)j * 2; }
        else { j -= 256 * 8; pos = (float)(j / 8); inv = powf(10000.f, -(float)(j % 8) / 8.f); off = ROPE_MC + (size_t)j * 2; }
        const float ang = pos * inv; rope[off] = cosf(ang); rope[off + 1] = sinf(ang);
    }
    { bf16* wh = wsp<bf16>(F, WS_WRH); bf16* wl = wsp<bf16>(F, WS_WRL); for (int i = gid; i < 2 * 32 * 1024; i += GT) { const int k = i & 1023, e = (i >> 10) & 31, l = i >> 15; const float wv = F.in[I_RW][((size_t)l * DM + k) * NE + e];
        const unsigned hb = f2bf(wv); wh[i] = (bf16)hb; wl[i] = (bf16)f2bf(wv - bf2f((bf16)hb)); } }
    bf16* WL = wsp<bf16>(F, WS_WLORA);
    for (int i = gid; i < 2560 * 384; i += GT) { const int n = i / 384, k = i - n * 384, part = n >> 9, c = n & 511; float v = 0.f;
        if (part < 2) { if ((k >> 6) == part) v = F.in[I_RW2][((size_t)part * 64 + (k & 63)) * 512 + c]; }
        else if (part < 4) { if ((k >> 6) == part) v = F.in[I_A2][((size_t)(part - 2) * 64 + (k & 63)) * 512 + c]; }
        else { if (k >= 256) v = F.in[I_G2][(size_t)(k - 256) * 512 + c]; }
        WL[i] = (bf16)f2bf(v); }
    const int gw = F.blk * 8 + F.wave, NGW = F.G * 8;
    tr_family(F, F.in[I_ATTW], 0, 1, 1024, ATT_IN, ATT_NP, wsp<bf16>(F, WS_WIN0), gw, NGW);
    tr_family(F, F.in[I_WUQ], 0, 1, 384, 768, 768, wsp<bf16>(F, WS_WUQ), gw, NGW);
    tr_family(F, F.in[I_WUKV], 0, 1, 256, 1024, 1024, wsp<bf16>(F, WS_WUKV), gw, NGW);
    tr_family(F, F.in[I_WOUT], (size_t)1024 * 1024, 2, 1024, 1024, 1024, wsp<bf16>(F, WS_WOUT), gw, NGW);
    tr_family(F, F.in[I_RECW], 0, 1, 1024, REC_IN, REC_NP, wsp<bf16>(F, WS_WREC), gw, NGW);
    moe_weights_convert(F, 0, gw, NGW);
}
__device__ __forceinline__ void p0b(const Frame& F) {
    const int gw = F.blk * 8 + F.wave, NGW = F.G * 8;
    for (int row = gw; row < R; row += NGW) { const int sel = row_sel(row);
        norm_mod_row(F, h0_row(F, row), F.in[I_NMIX], modp(F, 0, sel, 0), modp(F, 0, sel, 1), wsp<bf16>(F, WS_A) + (size_t)row * DM); }
}
struct FnStoreBf16 {
    bf16* O; int ldc;
    __device__ __forceinline__ void operator()(int row, int col, f32x4 v0, f32x4 v1) const {
        v4u w; w.x = pg8::cvt_pk_bf16(v0[0], v0[1]); w.y = pg8::cvt_pk_bf16(v0[2], v0[3]); w.z = pg8::cvt_pk_bf16(v1[0], v1[1]); w.w = pg8::cvt_pk_bf16(v1[2], v1[3]);
        *(v4u*)(O + (size_t)row * ldc + col) = w; }
};
struct FnWout {
    const Frame* F; int layer;
    __device__ __forceinline__ void operator()(int row, int col, f32x4 v0, f32x4 v1) const {
        float* hrow = wsp<float>(*F, WS_H) + (size_t)row * DM + col;
        const float* base = (layer == 0) ? h0_row(*F, row) + col : hrow;
        const float* g = modp(*F, layer, row_sel(row), 2) + col;
        const f32x4 b0 = *(const f32x4*)base, b1 = *(const f32x4*)(base + 4), g0 = *(const f32x4*)g, g1 = *(const f32x4*)(g + 4);
        *(f32x4*)hrow = b0 + g0 * v0; *(f32x4*)(hrow + 4) = b1 + g1 * v1; }
};
__device__ __forceinline__ void l0_post_proj(const Frame& F) {
    const int gw = F.blk * 8 + F.wave, NGW = F.G * 8, lane = F.lane;
    const bf16* P = wsp<const bf16>(F, WS_P); const float* rope = wsp<const float>(F, WS_ROPE);
    constexpr float CD = 0.125f * 1.4426950408889634f;
    for (int row = gw; row < R; row += NGW) {
        const int b = row / TB, t = row - b * TB; const bool lat = t >= CT; const int pos = t - CT, prow = lat ? pos >> 6 : 0, pcol = lat ? pos & 63 : 0;
        const bf16* p = P + (size_t)row * ATT_NP;
        bf16* qd = wsp<bf16>(F, WS_QD) + (size_t)row * 512; bf16* kd = wsp<bf16>(F, WS_KD) + (size_t)row * 512;
#pragma unroll
        for (int j = 0; j < 8; ++j) { const int pr = lane + 64 * j, h16 = pr >> 5, i = pr & 31;
            const float x1 = bf2f(p[h16 * 64 + i]), x2 = bf2f(p[h16 * 64 + i + 32]); float c = 1.f, s = 0.f;
            if (lat) { const float* tb = (i < 16) ? rope + ROPE_DR + (size_t)(prow * 16 + i) * 2 : rope + ROPE_DC + (size_t)(pcol * 16 + i - 16) * 2; c = tb[0]; s = tb[1]; }
            float y1 = x1 * c - x2 * s, y2 = x1 * s + x2 * c;
            if (h16 < 8) { qd[h16 * 64 + i] = (bf16)f2bf(y1 * CD); qd[h16 * 64 + i + 32] = (bf16)f2bf(y2 * CD); }
            else { kd[(h16 - 8) * 64 + i] = (bf16)f2bf(y1); kd[(h16 - 8) * 64 + i + 32] = (bf16)f2bf(y2); } }
        { float x[6]; float ss = 0.f;
#pragma unroll
          for (int j = 0; j < 6; ++j) { x[j] = bf2f(p[1536 + lane + 64 * j]); ss += x[j] * x[j]; }
          const float rs = 1.f / sqrtf(wave_sum(ss) * (1.f / 384.f) + NORM_EPS); bf16* o = wsp<bf16>(F, WS_CQN) + (size_t)row * 384;
#pragma unroll
          for (int j = 0; j < 6; ++j) o[lane + 64 * j] = (bf16)f2bf(x[j] * rs * F.in[I_QNW][lane + 64 * j]); }
        { float x[4]; float ss = 0.f;
#pragma unroll
          for (int j = 0; j < 4; ++j) { x[j] = bf2f(p[1920 + lane + 64 * j]); ss += x[j] * x[j]; }
          const float rs = 1.f / sqrtf(wave_sum(ss) * (1.f / 256.f) + NORM_EPS); bf16* o = wsp<bf16>(F, WS_CKVN) + (size_t)row * 256;
#pragma unroll
          for (int j = 0; j < 4; ++j) o[lane + 64 * j] = (bf16)f2bf(x[j] * rs * F.in[I_KVNW][lane + 64 * j]); }
        if (lane < 16) { const int i = lane; const float x1 = bf2f(p[2176 + i]), x2 = bf2f(p[2176 + i + 16]); float c = 1.f, s = 0.f;
            if (lat) { const float* tb = (i < 8) ? rope + ROPE_MR + (size_t)(prow * 8 + i) * 2 : rope + ROPE_MC + (size_t)(pcol * 8 + i - 8) * 2; c = tb[0]; s = tb[1]; }
            bf16* o = wsp<bf16>(F, WS_KRR) + (size_t)row * 32; o[i] = (bf16)f2bf(x1 * c - x2 * s); o[i + 16] = (bf16)f2bf(x1 * s + x2 * c); }
    }
}
__device__ __forceinline__ void l0_mq_rope(const Frame& F) {
    const int gw = F.blk * 8 + F.wave, NGW = F.G * 8, lane = F.lane; const float* rope = wsp<const float>(F, WS_ROPE);
    const float CM = 0.10206207261596575f * 1.4426950408889634f;
    for (int row = gw; row < R; row += NGW) {
        const int b = row / TB, t = row - b * TB; const bool lat = t >= CT; const int pos = t - CT, prow = lat ? pos >> 6 : 0, pcol = lat ? pos & 63 : 0;
        bf16* q = wsp<bf16>(F, WS_MQ) + (size_t)row * 768;
#pragma unroll
        for (int j = 0; j < 8; ++j) { const int idx = lane + 64 * j, h = idx >> 6, d = idx & 63; q[h * 96 + d] = (bf16)f2bf(bf2f(q[h * 96 + d]) * CM); }
#pragma unroll
        for (int j = 0; j < 2; ++j) { const int pr = lane + 64 * j, h = pr >> 4, i = pr & 15; const float x1 = bf2f(q[h * 96 + 64 + i]), x2 = bf2f(q[h * 96 + 80 + i]); float c = 1.f, s = 0.f;
            if (lat) { const float* tb = (i < 8) ? rope + ROPE_MR + (size_t)(prow * 8 + i) * 2 : rope + ROPE_MC + (size_t)(pcol * 8 + i - 8) * 2; c = tb[0]; s = tb[1]; }
            q[h * 96 + 64 + i] = (bf16)f2bf((x1 * c - x2 * s) * CM); q[h * 96 + 80 + i] = (bf16)f2bf((x1 * s + x2 * c) * CM); }
    }
}
__device__ __forceinline__ void l0_attention(const Frame& F) {
    LAS char* lds = (LAS char*)F.lds;
    const bf16* QD = wsp<const bf16>(F, WS_QD); const bf16* KD = wsp<const bf16>(F, WS_KD); const bf16* P = wsp<const bf16>(F, WS_P);
    const bf16* MQ = wsp<const bf16>(F, WS_MQ); const bf16* MKV = wsp<const bf16>(F, WS_MKV); const bf16* KRR = wsp<const bf16>(F, WS_KRR);
    float* OD = wsp<float>(F, WS_ODIFF); float* OM = wsp<float>(F, WS_OMLA);
    for (int kind = 0; kind < 2; ++kind) {
        for (int L = F.blk; L < 1024 + 16; L += F.G) {
            int b, h8, qb, nkeys;
            if (L < 1024) { int pair;
                if (F.G == 256) { const int round = L >> 8, c = L & 255; pair = round * 4 + ((c & 7) >> 1); qb = 1 + (c & 1) * 32 + (c >> 3); }
                else { pair = L >> 6; qb = 1 + (L & 63); }
                b = pair >> 3; h8 = pair & 7; nkeys = TB; }
            else { const int s = L - 1024; b = s >> 3; h8 = s & 7; qb = 0; nkeys = CT; }
            const size_t q0 = (size_t)b * TB + (size_t)qb * 256, k0 = (size_t)b * TB;
            if (kind == 0)
                att::attn_unit<64, 128>(QD + q0 * 512 + h8 * 64, 512, KD + k0 * 512 + h8 * 64, 512, nullptr, 0, P + k0 * ATT_NP + 1024 + (h8 >> 1) * 128, ATT_NP,
                                        OD + q0 * 1024 + h8 * 128, 1024, nkeys, lds);
            else
                att::attn_unit<96, 64>(MQ + q0 * 768 + h8 * 96, 768, MKV + k0 * 1024 + h8 * 128, 1024, KRR + k0 * 32, 32, MKV + k0 * 1024 + h8 * 128 + 64, 1024,
                                       OM + q0 * 512 + h8 * 64, 512, nkeys, lds);
        }
    }
}
__device__ __forceinline__ void l0_combine(const Frame& F) {
    const int gw = F.blk * 8 + F.wave, NGW = F.G * 8, lane = F.lane;
    const float* lv = F.in[I_LAM];
    const float lam = __expf(wave_sum(lv[lane] * lv[64 + lane])) - __expf(wave_sum(lv[128 + lane] * lv[192 + lane])) + 0.2f;
    const float sw0 = F.in[I_SUBLN][2 * lane] * 0.8f, sw1 = F.in[I_SUBLN][2 * lane + 1] * 0.8f;
    for (int row = gw; row < R; row += NGW) {
        const float* od = wsp<const float>(F, WS_ODIFF) + (size_t)row * 1024; const float* om = wsp<const float>(F, WS_OMLA) + (size_t)row * 512;
        bf16* a1 = wsp<bf16>(F, WS_A1) + (size_t)row * DM;
#pragma unroll
        for (int h = 0; h < 4; ++h) {
            const float o1a = od[(2 * h) * 128 + 2 * lane], o1b = od[(2 * h) * 128 + 2 * lane + 1], o2a = od[(2 * h + 1) * 128 + 2 * lane], o2b = od[(2 * h + 1) * 128 + 2 * lane + 1];
            const float da = o1a - lam * o2a, db = o1b - lam * o2b;
            const float rs = 1.f / sqrtf(wave_sum(da * da + db * db) * (1.f / 128.f) + NORM_EPS);
            *(unsigned*)(a1 + h * 128 + 2 * lane) = pk2(da * rs * sw0, db * rs * sw1); }
#pragma unroll
        for (int j = 0; j < 2; ++j) { const f32x4 v = *(const f32x4*)(om + 4 * (lane + 64 * j)); v2u w; w.x = pk2(v.x, v.y); w.y = pk2(v.z, v.w); *(v2u*)(a1 + 512 + 4 * (lane + 64 * j)) = w; }
    }
}
constexpr int RT_LS = 264;
__device__ __forceinline__ void ph_router(const Frame& F, int layer) {
    LAS bf16* AH = (LAS bf16*)F.lds; LAS bf16* AL = AH + 64 * RT_LS; LAS bf16* WH = AL + 64 * RT_LS; LAS bf16* WL = WH + 32 * RT_LS;
    LAS float* lg = (LAS float*)(F.lds + 110592);
    LAS int* hist = (LAS int*)(F.lds + MISC_OFF + 256);
    LAS int* recs = (LAS int*)(F.lds + MISC_OFF + 512);
    const int lane = F.lane, w = F.wave, tid = F.tid, RPB = (R + F.G - 1) / F.G, row0 = F.blk * RPB;
    if (tid < 64) hist[tid] = 0;
    const float* nw = F.in[I_NFFN] + (size_t)layer * DM; const float* rbp = F.in[I_RB] + layer * NE;
    const bf16* wrh = wsp<const bf16>(F, WS_WRH) + (size_t)layer * 32 * 1024; const bf16* wrl = wsp<const bf16>(F, WS_WRL) + (size_t)layer * 32 * 1024;
    for (int pass = 0; pass * 64 < RPB; ++pass) {
        const int nrow = min(64, min(RPB - pass * 64, R - row0 - pass * 64));
        f32x4 fr[8][4];
#pragma unroll
        for (int i = 0; i < 8; ++i) { const int rl = w + 8 * i; const int row = row0 + pass * 64 + rl;
            if (rl < nrow) {
                const int sel = row_sel(row); const float* sh = modp(F, layer, sel, 3); const float* sc = modp(F, layer, sel, 4);
                const f32x4* xr = (const f32x4*)(wsp<const float>(F, WS_H) + (size_t)row * DM) + lane; float s = 0.f;
#pragma unroll
                for (int j = 0; j < 4; ++j) { fr[i][j] = xr[64 * j]; s += (fr[i][j].x * fr[i][j].x + fr[i][j].y * fr[i][j].y) + (fr[i][j].z * fr[i][j].z + fr[i][j].w * fr[i][j].w); }
                const float rs = 1.f / sqrtf(wave_sum(s) * (1.f / DM) + NORM_EPS);
                unsigned long long* o8 = (unsigned long long*)(wsp<bf16>(F, WS_F) + (size_t)row * DM) + lane;
#pragma unroll
                for (int j = 0; j < 4; ++j) { const f32x4 ww = ((const f32x4*)nw)[lane + 64 * j], a = ((const f32x4*)sh)[lane + 64 * j], c = ((const f32x4*)sc)[lane + 64 * j];
                    fr[i][j] = fr[i][j] * rs * ww * (c + 1.f) + a;
                    o8[64 * j] = (unsigned long long)pk2(fr[i][j].x, fr[i][j].y) | ((unsigned long long)pk2(fr[i][j].z, fr[i][j].w) << 32); }
            } else {
#pragma unroll
                for (int j = 0; j < 4; ++j) fr[i][j] = (f32x4){0.f, 0.f, 0.f, 0.f};
            } }
        pg8::f32x4 acc = {0.f, 0.f, 0.f, 0.f};
#pragma unroll
        for (int c = 0; c < 4; ++c) {
            __syncthreads();
#pragma unroll
            for (int i = 0; i < 8; ++i) { const f32x4 v = fr[i][c]; const unsigned h0 = pk2(v.x, v.y), h1 = pk2(v.z, v.w);
                const unsigned l0 = pk2(v.x - bflo(h0), v.y - bfhi(h0)), l1 = pk2(v.z - bflo(h1), v.w - bfhi(h1));
                v2u hh; hh.x = h0; hh.y = h1; v2u ll; ll.x = l0; ll.y = l1;
                *(LAS v2u*)(AH + (w + 8 * i) * RT_LS + 4 * lane) = hh; *(LAS v2u*)(AL + (w + 8 * i) * RT_LS + 4 * lane) = ll; }
            { const int e = tid >> 4, kp = (tid & 15) * 16;
              const v4u a0 = *(const v4u*)(wrh + (size_t)e * 1024 + 256 * c + kp), a1 = *(const v4u*)(wrh + (size_t)e * 1024 + 256 * c + kp + 8);
              const v4u b0 = *(const v4u*)(wrl + (size_t)e * 1024 + 256 * c + kp), b1 = *(const v4u*)(wrl + (size_t)e * 1024 + 256 * c + kp + 8);
              *(LAS v4u*)(WH + e * RT_LS + kp) = a0; *(LAS v4u*)(WH + e * RT_LS + kp + 8) = a1; *(LAS v4u*)(WL + e * RT_LS + kp) = b0; *(LAS v4u*)(WL + e * RT_LS + kp + 8) = b1; }
            __syncthreads();
            const int tm = w >> 1, tn = w & 1, lr = lane & 15, kq = (lane >> 4) * 8;
            const LAS bf16* ahp = AH + (tm * 16 + lr) * RT_LS + kq; const LAS bf16* alp = AL + (tm * 16 + lr) * RT_LS + kq;
            const LAS bf16* whp = WH + (tn * 16 + lr) * RT_LS + kq; const LAS bf16* wlp = WL + (tn * 16 + lr) * RT_LS + kq;
#pragma unroll
            for (int ks = 0; ks < 8; ++ks) { const bf16x8 ah = *(const LAS bf16x8*)(ahp + 32 * ks), al = *(const LAS bf16x8*)(alp + 32 * ks), bh = *(const LAS bf16x8*)(whp + 32 * ks), bl = *(const LAS bf16x8*)(wlp + 32 * ks);
                acc = __builtin_amdgcn_mfma_f32_16x16x32_bf16(ah, bh, acc, 0, 0, 0); acc = __builtin_amdgcn_mfma_f32_16x16x32_bf16(ah, bl, acc, 0, 0, 0); acc = __builtin_amdgcn_mfma_f32_16x16x32_bf16(al, bh, acc, 0, 0, 0); }
        }
        { const int m0 = (w >> 1) * 16 + (lane >> 4) * 4, n = (w & 1) * 16 + (lane & 15);
#pragma unroll
          for (int r = 0; r < 4; ++r) lg[(m0 + r) * 33 + n] = acc[r]; }
        __syncthreads();
        if (tid < nrow) { const int rl = tid, row = row0 + pass * 64 + rl; float lv[32];
#pragma unroll
            for (int e = 0; e < 32; ++e) lv[e] = lg[rl * 33 + e] + rbp[e];
            float selv[4]; int seli[4];
#pragma unroll
            for (int r = 0; r < 4; ++r) { float bv = -3.0e38f; int bi = 0;
#pragma unroll
                for (int e = 0; e < 32; ++e) { const bool taken = (r > 0 && seli[0] == e) || (r > 1 && seli[1] == e) || (r > 2 && seli[2] == e); if (!taken && lv[e] > bv) { bv = lv[e]; bi = e; } }
                selv[r] = bv; seli[r] = bi; }
            float ex[4], es = 0.f;
#pragma unroll
            for (int r = 0; r < 4; ++r) { ex[r] = __expf(selv[r] - selv[0]); es += ex[r]; }
            const float inv = 1.f / es;
#pragma unroll
            for (int r = 0; r < 4; ++r) { wsp<int>(F, WS_TOPE)[(size_t)row * 4 + r] = seli[r]; wsp<float>(F, WS_GATE)[(size_t)row * 4 + r] = ex[r] * inv;
                const int rk = __hip_atomic_fetch_add(&hist[seli[r]], 1, __ATOMIC_RELAXED, __HIP_MEMORY_SCOPE_WORKGROUP);
                recs[(pass * 64 + rl) * 4 + r] = seli[r] | (rk << 8); }
        }
    }
    __syncthreads();
    if (tid < NE) hist[32 + tid] = (int)__hip_atomic_fetch_add(F.ctl + CW_CNT + 64 * (layer + 2 * F.probe) + tid, (unsigned)hist[tid], RLX_AGENT);
    __syncthreads();
    for (int rl = tid; rl < RPB && row0 + rl < R; rl += 512) {
#pragma unroll
        for (int r = 0; r < 4; ++r) { const int rc = recs[rl * 4 + r]; wsp<int>(F, WS_POS)[(size_t)(row0 + rl) * 4 + r] = hist[32 + (rc & 255)] + (rc >> 8); } }
}
__device__ __forceinline__ void moe_tables(const Frame& F, int layer, LAS int* ps, LAS int* tile_e) {
    if (F.tid == 0) { int acc = 0, t = 0;
        for (int e = 0; e < NE; ++e) { const int c = (int)__hip_atomic_load(F.ctl + CW_CNT + 64 * layer + e, RLX_AGENT); ps[e] = acc; const int nt = (c + 255) >> 8;
            for (int i = 0; i < nt && t < MAXT; ++i) tile_e[t++] = e; acc += nt * 256; }
        ps[NE] = acc; ps[NE + 1] = t; }
    __syncthreads();
}
__device__ __forceinline__ void ph_gather(const Frame& F, int layer) {
    LAS int* ps = (LAS int*)(F.lds + MISC_OFF + 256); LAS int* tile_e = ps + 64;
    moe_tables(F, layer, ps, tile_e);
    if (F.blk == 0) { int* tab = wsp<int>(F, WS_TILE); const int nt = ps[NE + 1]; if (F.tid == 0) tab[0] = nt; for (int i = F.tid; i < nt; i += 512) tab[1 + i] = tile_e[i]; }
    const int lane = F.lane, gw = F.blk * 8 + F.wave, NGW = F.G * 8;
    for (int row = gw; row < R; row += NGW) {
        int dest = 0;
        if (lane < 4) { const int e = wsp<const int>(F, WS_TOPE)[(size_t)row * 4 + lane]; dest = ps[e] + wsp<const int>(F, WS_POS)[(size_t)row * 4 + lane]; wsp<int>(F, WS_DEST)[(size_t)row * 4 + lane] = dest; }
        const v4u* src = (const v4u*)(wsp<const bf16>(F, WS_F) + (size_t)row * DM); const v4u a = src[lane], b = src[64 + lane];
#pragma unroll
        for (int r = 0; r < 4; ++r) { const int d = __shfl(dest, r); v4u* dst = (v4u*)(wsp<bf16>(F, WS_XS) + (size_t)d * DM); dst[lane] = a; dst[64 + lane] = b; }
    }
}
struct MoeOrder {
    const int* tile_e; int ntiles, nN, G, c;
    __device__ __forceinline__ bool next(int i, pg8::Unit& u) const {
        int rt, pl;
        if (G == 256) { const int x = c & 7, y = c >> 3, rpx = 32 / nN; rt = (i * 8 + x) * rpx + y / nN; pl = y % nN; if (rt >= ntiles) return false; }
        else { const long L = (long)i * G + c; if (L >= (long)ntiles * nN) return false; rt = (int)(L / nN); pl = (int)(L - (long)rt * nN); }
        const int e = __builtin_amdgcn_readfirstlane(tile_e[rt]);
        u.pm = rt; u.pn = e * nN + pl; return true; }
    __device__ __forceinline__ void a_ready(const pg8::Unit&) const {}
    __device__ __forceinline__ void done(const pg8::Unit&) const {}
};
struct FnSwiglu {
    bf16* HS; const float* b1;
    __device__ __forceinline__ void operator()(int row, int col, f32x4 v0, f32x4 v1) const {
        const float* bp = b1 + col;
        const f32x4 b0 = *(const f32x4*)bp, b1v = *(const f32x4*)(bp + 4); v0 = v0 + b0; v1 = v1 + b1v;
        const float hv[8] = {v0[0], v0[1], v0[2], v0[3], v1[0], v1[1], v1[2], v1[3]}; float o[4];
#pragma unroll
        for (int i = 0; i < 4; ++i) { const float g = hv[2 * i], l = hv[2 * i + 1];
            const float gl = fminf(g, 7.f), li = fminf(fmaxf(l, -7.f), 7.f); o[i] = gl * sigmoidf_(1.702f * gl) * (li + 1.f); }
        const int lc = col & 2047; v2u w; w.x = pk2(o[0], o[1]); w.y = pk2(o[2], o[3]);
        *(v2u*)(HS + (size_t)row * 1024 + (lc >> 1)) = w; }
};
struct FnBiasBf16 {
    bf16* YS; const float* b2;
    __device__ __forceinline__ void operator()(int row, int col, f32x4 v0, f32x4 v1) const {
        const f32x4 b0 = *(const f32x4*)(b2 + col), b1v = *(const f32x4*)(b2 + col + 4); v0 = v0 + b0; v1 = v1 + b1v;
        v4u w; w.x = pk2(v0[0], v0[1]); w.y = pk2(v0[2], v0[3]); w.z = pk2(v1[0], v1[1]); w.w = pk2(v1[2], v1[3]);
        *(v4u*)(YS + (size_t)row * 1024 + (col & 1023)) = w; }
};
__device__ __forceinline__ void ph_combine(const Frame& F, int layer) {
    const int lane = F.lane, gw = F.blk * 8 + F.wave, NGW = F.G * 8;
    for (int row = gw; row < R; row += NGW) {
        const int sel = row_sel(row); const float* gf = modp(F, layer, sel, 5);
        float* hrow = wsp<float>(F, WS_H) + (size_t)row * DM;
        f32x4 y[4];
#pragma unroll
        for (int j = 0; j < 4; ++j) y[j] = (f32x4){0.f, 0.f, 0.f, 0.f};
#pragma unroll
        for (int r = 0; r < 4; ++r) { const int d = wsp<const int>(F, WS_DEST)[(size_t)row * 4 + r]; const float g = wsp<const float>(F, WS_GATE)[(size_t)row * 4 + r];
            const v2u* yp = (const v2u*)(wsp<const bf16>(F, WS_XS) + (size_t)d * DM);
#pragma unroll
            for (int j = 0; j < 4; ++j) { const v2u w = yp[lane + 64 * j]; y[j] += g * (f32x4){bflo(w.x), bfhi(w.x), bflo(w.y), bfhi(w.y)}; } }
        f32x4 h[4]; float s = 0.f;
#pragma unroll
        for (int j = 0; j < 4; ++j) { h[j] = ((const f32x4*)hrow)[lane + 64 * j] + ((const f32x4*)gf)[lane + 64 * j] * y[j]; s += (h[j].x * h[j].x + h[j].y * h[j].y) + (h[j].z * h[j].z + h[j].w * h[j].w); }
        const float rs = 1.f / sqrtf(wave_sum(s) * (1.f / DM) + NORM_EPS);
        if (layer == 0) {
#pragma unroll
            for (int j = 0; j < 4; ++j) ((f32x4*)hrow)[lane + 64 * j] = h[j];
            const float* nw = F.in[I_NMIX] + DM; const float* sh = modp(F, 1, sel, 0); const float* sc = modp(F, 1, sel, 1);
            unsigned long long* o8 = (unsigned long long*)(wsp<bf16>(F, WS_A) + (size_t)row * DM) + lane;
#pragma unroll
            for (int j = 0; j < 4; ++j) { const f32x4 w = ((const f32x4*)nw)[lane + 64 * j], a = ((const f32x4*)sh)[lane + 64 * j], c = ((const f32x4*)sc)[lane + 64 * j];
                const f32x4 o = h[j] * rs * w * (c + 1.f) + a; o8[64 * j] = (unsigned long long)pk2(o.x, o.y) | ((unsigned long long)pk2(o.z, o.w) << 32); }
        } else {
            const int b = row / TB, t = row - b * TB;
            if (t >= CT) { float* orow = F.out + ((size_t)b * SEQ + (t - CT)) * DM; const float* nw = F.in[I_FNW];
#pragma unroll
                for (int j = 0; j < 4; ++j) ((f32x4*)orow)[lane + 64 * j] = h[j] * rs * ((const f32x4*)nw)[lane + 64 * j]; }
        }
    }
}
constexpr int PC_Q = 1920, PC_K = 2176, PC_V = 2432, PC_O = 2944, PC_G = 3456;
__device__ __forceinline__ float softplusf_(float y) { return fmaxf(y, 0.f) + __logf(1.f + __expf(-fabsf(y))); }
__device__ __forceinline__ float tanhf_(float x) { return 1.f - 2.f / (1.f + __expf(2.f * x)); }
__device__ __forceinline__ void unpack8(v4u w, float (&x)[8]) { x[0] = bflo(w.x); x[1] = bfhi(w.x); x[2] = bflo(w.y); x[3] = bfhi(w.y); x[4] = bflo(w.z); x[5] = bfhi(w.z); x[6] = bflo(w.w); x[7] = bfhi(w.w); }
__device__ __forceinline__ void lerp8(const bf16* p, bool hp, bool hn, int c0, const float* mu, float (&u)[8]) {
    const v4u z4 = {0u, 0u, 0u, 0u};
    const v4u wx = *(const v4u*)(p + c0), wp = hp ? *(const v4u*)(p - REC_NP + c0) : z4, wn = hn ? *(const v4u*)(p + REC_NP + c0) : z4;
    float x[8], xp[8], xn[8]; unpack8(wx, x); unpack8(wp, xp); unpack8(wn, xn);
    const f32x4 m0 = *(const f32x4*)(mu + c0), m1 = *(const f32x4*)(mu + c0 + 4);
#pragma unroll
    for (int e = 0; e < 8; ++e) { const float m = e < 4 ? m0[e & 3] : m1[e & 3]; u[e] = x[e] + m * (0.5f * (xp[e] + xn[e]) - x[e]); }
}
__device__ __forceinline__ void st8h(bf16* o, const float (&u)[8]) { v4u w; w.x = pk2(u[0], u[1]); w.y = pk2(u[2], u[3]); w.z = pk2(u[4], u[5]); w.w = pk2(u[6], u[7]); *(v4u*)o = w; }
__device__ __forceinline__ void st8f(float* o, const float (&u)[8]) { *(f32x4*)o = (f32x4){u[0], u[1], u[2], u[3]}; *(f32x4*)(o + 4) = (f32x4){u[4], u[5], u[6], u[7]}; }
__device__ __forceinline__ void l1_rwkv_prep(const Frame& F) {
    const int gw = F.blk * 8 + F.wave, NGW = F.G * 8, lane = F.lane; const float* mu = F.in[I_MU];
    for (int row = gw; row < R; row += NGW) {
        const int b = row / TB, t = row - b * TB; const bool hp = (t != 0 && t != CT), hn = (t != CT - 1 && t != TB - 1);
        const bf16* p = wsp<const bf16>(F, WS_P) + (size_t)row * REC_NP; const size_t ro = (size_t)row * 512 + 8 * lane;
        float u[8];
        lerp8(p, hp, hn, 8 * lane, mu, u); st8h(wsp<bf16>(F, WS_RR) + ro, u);
        lerp8(p, hp, hn, 1024 + 8 * lane, mu, u); st8h(wsp<bf16>(F, WS_VV) + ro, u);
        lerp8(p, hp, hn, 512 + 8 * lane, mu, u); st8h(wsp<bf16>(F, WS_KL) + ro, u);
        { const f32x4 k0 = *(const f32x4*)(F.in[I_KK] + 8 * lane), k1 = *(const f32x4*)(F.in[I_KK] + 8 * lane + 4); float ss = 0.f;
#pragma unroll
          for (int e = 0; e < 8; ++e) { u[e] *= (e < 4 ? k0[e & 3] : k1[e & 3]); ss += u[e] * u[e]; }
          ss += __shfl_xor(ss, 1); ss += __shfl_xor(ss, 2); ss += __shfl_xor(ss, 4);
          const float inv = -1.f / sqrtf(fmaxf(ss, 1e-24f));
#pragma unroll
          for (int e = 0; e < 8; ++e) u[e] *= inv;
          st8h(wsp<bf16>(F, WS_AKK) + ro, u); }
        if (lane < 48) { lerp8(p, hp, hn, 1536 + 8 * lane, mu, u);
#pragma unroll
            for (int e = 0; e < 8; ++e) u[e] = lane < 16 ? tanhf_(u[e]) : (lane < 32 ? u[e] : sigmoidf_(u[e]));
            v4u w; w.x = pk2(u[0], u[1]); w.y = pk2(u[2], u[3]); w.z = pk2(u[4], u[5]); w.w = pk2(u[6], u[7]);
            *(v4u*)(wsp<bf16>(F, WS_ALORA) + (size_t)row * 384 + 8 * lane) = w; }
    }
}
struct EpiLora {
    static constexpr bool PERM = true, AFTER_DRAIN = false;
    const Frame* F;
    template <int KIND> __device__ __forceinline__ void run(const pg8::f32x4 (&acc)[2][2][4][2], const pg8::Unit& u, int wr, int wc, int fr, int fq, int z) const {
#pragma unroll
        for (int ai = 0; ai < 2; ++ai)
#pragma unroll
            for (int m = 0; m < 4; ++m) { const int row = u.pm * 256 + ai * 128 + wr * 64 + m * 16 + fr;
#pragma unroll
                for (int bj = 0; bj < 2; ++bj) { const int c = ((u.pn & 1) * 256) + bj * 128 + wc * 32 + 8 * fq; const size_t ro = (size_t)row * 512 + c;
                    const pg8::f32x4 v0 = acc[ai][bj][m][0], v1 = acc[ai][bj][m][1]; const float x[8] = {v0[0], v0[1], v0[2], v0[3], v1[0], v1[1], v1[2], v1[3]}; float o[8];
                    if constexpr (KIND == 0) { const float* w0 = F->in[I_W0] + z * 512 + c;
#pragma unroll
                        for (int e = 0; e < 8; ++e) { const float wl = -softplusf_(-(w0[e] + x[e])) - 0.5f; o[e] = __expf(-__expf(wl)); }
                        st8f(wsp<float>(*F, WS_WDEC) + (size_t)z * R * 512 + ro, o); }
                    else if constexpr (KIND == 1) { const float* a0 = F->in[I_A0] + z * 512 + c;
#pragma unroll
                        for (int e = 0; e < 8; ++e) o[e] = sigmoidf_(a0[e] + x[e]);
                        st8h(wsp<bf16>(*F, WS_ASIG) + (size_t)z * R * 512 + ro, o); }
                    else st8h(wsp<bf16>(*F, WS_GG) + ro, x); } }
    }
    __device__ __forceinline__ void operator()(const pg8::f32x4 (&acc)[2][2][4][2], const pg8::Unit& u, int wr, int wc, int fr, int fq) const {
        const int part = u.pn >> 1;
        if (part < 2) run<0>(acc, u, wr, wc, fr, fq, part); else if (part < 4) run<1>(acc, u, wr, wc, fr, fq, part - 2); else run<2>(acc, u, wr, wc, fr, fq, 0);
    }
};
__device__ __forceinline__ void mlstm_gates(const Frame& F, int row, int z, int h, float& ig, float& lf) {
    const bf16* g = wsp<const bf16>(F, WS_P) + (size_t)row * REC_NP + PC_G + z * 8 + h; const float* gb = F.in[I_GATEB] + z * 8 + h;
    const float gi = bf2f(g[0]) + gb[0], gf = bf2f(g[4]) + gb[4];
    ig = 15.f * tanhf_(gi * (1.f / 15.f)); const float cf = 15.f * tanhf_(gf * (1.f / 15.f)); lf = fminf(cf, 0.f) - __logf(1.f + __expf(-fabsf(cf)));
}
__device__ __forceinline__ void mlstm_chunk_head(const Frame& F, int z, int b, int h, int c, LAS float* vec) {
    LAS int* rows = (LAS int*)vec;
    if (F.tid < 64) { const int s = F.tid, row = b * TB + scan_tok(z, 64 * c + s); float ig, lf; mlstm_gates(F, row, z, h, ig, lf); rows[s] = row; vec[64 + s] = ig; vec[192 + s] = lf; }
    __syncthreads();
    if (F.tid < 64) { float a = 0.f; for (int s = 0; s <= F.tid; ++s) a += vec[192 + s]; vec[128 + F.tid] = a; }
    __syncthreads();
}
__device__ __forceinline__ void l1_mlstm_a(const Frame& F) {
    LAS float* Ks = (LAS float*)F.lds; LAS float* Vs = Ks + 64 * 64; LAS float* vec = (LAS float*)(F.lds + AUX_OFF); LAS int* rows = (LAS int*)vec;
    const bf16* P = wsp<const bf16>(F, WS_P);
    for (int u = F.blk; u < NUNIT_M; u += F.G) {
        const int cidx = u / 260, c = u - cidx * 260, z = cidx >> 3, b = (cidx >> 2) & 1, h = cidx & 3;
        mlstm_chunk_head(F, z, b, h, c, vec);
        if (F.tid < 64) { const float bl = vec[128 + 63]; const float uu = bl - vec[128 + F.tid] + vec[64 + F.tid]; float m = uu;
#pragma unroll
            for (int o = 1; o < 64; o <<= 1) m = fmaxf(m, __shfl_xor(m, o));
            vec[256 + F.tid] = __expf(uu - m);
            if (F.tid == 0) { wsp<float>(F, WS_SC)[2 * u] = bl; wsp<float>(F, WS_SC)[2 * u + 1] = m; } }
        __syncthreads();
        { const int s = F.tid >> 3, c8 = F.tid & 7; float x[8]; unpack8(*(const v4u*)(P + (size_t)rows[s] * REC_NP + PC_K + h * 64 + 8 * c8), x);
#pragma unroll
          for (int e = 0; e < 8; ++e) Ks[s * 64 + 8 * c8 + e] = x[e] * 0.125f; }
#pragma unroll
        for (int i = 0; i < 2; ++i) { const int s = (F.tid >> 4) + 32 * i, c8 = F.tid & 15; float x[8]; unpack8(*(const v4u*)(P + (size_t)rows[s] * REC_NP + PC_V + h * 128 + 8 * c8), x); const float w = vec[256 + s];
#pragma unroll
            for (int e = 0; e < 8; ++e) Vs[s * 128 + 8 * c8 + e] = x[e] * w; }
        __syncthreads();
        { const int dg = F.tid >> 5, vg = F.tid & 31; f32x4 acc[4];
#pragma unroll
          for (int i = 0; i < 4; ++i) acc[i] = (f32x4){0.f, 0.f, 0.f, 0.f};
#pragma unroll 4
          for (int s = 0; s < 64; ++s) { const f32x4 kd = *(const LAS f32x4*)(Ks + s * 64 + 4 * dg), vv = *(const LAS f32x4*)(Vs + s * 128 + 4 * vg);
              acc[0] += kd.x * vv; acc[1] += kd.y * vv; acc[2] += kd.z * vv; acc[3] += kd.w * vv; }
          float* dc = wsp<float>(F, WS_DC) + (size_t)u * 8192 + (size_t)(4 * dg) * 128 + 4 * vg;
#pragma unroll
          for (int i = 0; i < 4; ++i) *(f32x4*)(dc + i * 128) = acc[i];
          if (F.tid < 64) { float a = 0.f; for (int s = 0; s < 64; ++s) a += vec[256 + s] * Ks[s * 64 + F.tid]; wsp<float>(F, WS_DN)[(size_t)u * 64 + F.tid] = a; } }
        __syncthreads();
    }
}
__device__ __forceinline__ void l1_mlstm_b(const Frame& F) {
    const float* __restrict__ SC = wsp<const float>(F, WS_SC); const float* __restrict__ DC = wsp<const float>(F, WS_DC); float* __restrict__ CST = wsp<float>(F, WS_CST);
    const float* __restrict__ DN = wsp<const float>(F, WS_DN); float* __restrict__ NST = wsp<float>(F, WS_NST); float* __restrict__ MST = wsp<float>(F, WS_MST);
    for (int g = F.blk * 512 + F.tid; g < 16 * 8192; g += F.G * 512) {
        const int chain = g >> 13, el = g & 8191; float m = 0.f, C = 0.f, N = 0.f; const bool don = el < 64;
        for (int c0 = 0; c0 < 260; c0 += 10) {
            float dc[10], dn[10], bl[10], ml[10];
#pragma unroll
            for (int i = 0; i < 10; ++i) { const size_t u = (size_t)chain * 260 + c0 + i; dc[i] = DC[u * 8192 + el]; dn[i] = don ? DN[u * 64 + el] : 0.f; bl[i] = SC[2 * u]; ml[i] = SC[2 * u + 1]; }
#pragma unroll
            for (int i = 0; i < 10; ++i) { const size_t u = (size_t)chain * 260 + c0 + i;
                CST[u * 8192 + el] = C; if (don) NST[u * 64 + el] = N; if (el == 0) MST[u] = m;
                const float mn = fmaxf(bl[i] + m, ml[i]), cd = __expf(bl[i] + m - mn), inj = __expf(ml[i] - mn);
                C = cd * C + inj * dc[i]; N = cd * N + inj * dn[i]; m = mn; }
        }
    }
}
__device__ __forceinline__ void l1_mlstm_c(const Frame& F, int first_blk, int nblk) {
    LAS float* qT = (LAS float*)F.lds; LAS float* kT = qT + 4096; LAS float* Vs = kT + 4096; LAS float* Cs = Vs + 8192; LAS float* PT = Cs + 8192;
    LAS float* vec = (LAS float*)(F.lds + AUX_OFF); LAS int* rows = (LAS int*)vec;
    const bf16* P = wsp<const bf16>(F, WS_P);
    for (int u = F.blk - first_blk; u < NUNIT_M; u += nblk) {
        const int cidx = u / 260, c = u - cidx * 260, z = cidx >> 3, b = (cidx >> 2) & 1, h = cidx & 3;
        mlstm_chunk_head(F, z, b, h, c, vec);
        const float mst = wsp<const float>(F, WS_MST)[u];
        if (F.tid < 64) { const int t = F.tid; float pm = -3.0e38f; for (int s = 0; s <= t; ++s) pm = fmaxf(pm, vec[64 + s] - vec[128 + s]);
            const float gi = vec[128 + t] + mst, mo = fmaxf(gi, vec[128 + t] + pm); vec[320 + t] = __expf(gi - mo); vec[384 + t] = mo;
            vec[256 + t] = wsp<const float>(F, WS_NST)[(size_t)u * 64 + t]; }
        { const int c8 = F.tid >> 6, t = F.tid & 63; float x[8]; unpack8(*(const v4u*)(P + (size_t)rows[t] * REC_NP + PC_Q + h * 64 + 8 * c8), x);
#pragma unroll
          for (int e = 0; e < 8; ++e) qT[(8 * c8 + e) * 64 + t] = x[e];
          unpack8(*(const v4u*)(P + (size_t)rows[t] * REC_NP + PC_K + h * 64 + 8 * c8), x);
#pragma unroll
          for (int e = 0; e < 8; ++e) kT[(8 * c8 + e) * 64 + t] = x[e] * 0.125f; }
#pragma unroll
        for (int i = 0; i < 2; ++i) { const int s = (F.tid >> 4) + 32 * i, c8 = F.tid & 15; float x[8]; unpack8(*(const v4u*)(P + (size_t)rows[s] * REC_NP + PC_V + h * 128 + 8 * c8), x);
            *(LAS f32x4*)(Vs + s * 128 + 8 * c8) = (f32x4){x[0], x[1], x[2], x[3]}; *(LAS f32x4*)(Vs + s * 128 + 8 * c8 + 4) = (f32x4){x[4], x[5], x[6], x[7]}; }
        { const f32x4* src = (const f32x4*)(wsp<const float>(F, WS_CST) + (size_t)u * 8192);
#pragma unroll
          for (int i = 0; i < 4; ++i) ((LAS f32x4*)Cs)[F.tid + 512 * i] = src[F.tid + 512 * i]; }
        __syncthreads();
        { const int tg = F.tid & 15, sg = F.tid >> 4; f32x4 a0 = {0.f, 0.f, 0.f, 0.f}, a1 = a0;
#pragma unroll 4
          for (int d = 0; d < 64; ++d) { const f32x4 q4 = *(const LAS f32x4*)(qT + d * 64 + 4 * tg); const float k0 = kT[d * 64 + 2 * sg], k1 = kT[d * 64 + 2 * sg + 1]; a0 += q4 * k0; a1 += q4 * k1; }
#pragma unroll
          for (int j = 0; j < 2; ++j) { const int s = 2 * sg + j; const float cs = vec[64 + s] - vec[128 + s]; f32x4 pv;
#pragma unroll
              for (int i = 0; i < 4; ++i) { const int t = 4 * tg + i; const float qk = j == 0 ? a0[i] : a1[i]; pv[i] = (s <= t) ? qk * __expf(vec[128 + t] + cs - vec[384 + t]) : 0.f; }
              *(LAS f32x4*)(PT + s * 64 + 4 * tg) = pv; } }
        __syncthreads();
        { const int tg = F.tid >> 5, vg = F.tid & 31; f32x4 ac[4], ap[4]; f32x4 nq = {0.f, 0.f, 0.f, 0.f}, rs = nq;
#pragma unroll
          for (int i = 0; i < 4; ++i) { ac[i] = (f32x4){0.f, 0.f, 0.f, 0.f}; ap[i] = ac[i]; }
#pragma unroll 4
          for (int d = 0; d < 64; ++d) { const f32x4 q4 = *(const LAS f32x4*)(qT + d * 64 + 4 * tg), c4 = *(const LAS f32x4*)(Cs + d * 128 + 4 * vg);
              ac[0] += q4.x * c4; ac[1] += q4.y * c4; ac[2] += q4.z * c4; ac[3] += q4.w * c4; nq += q4 * vec[256 + d]; }
#pragma unroll 4
          for (int s = 0; s < 64; ++s) { const f32x4 p4 = *(const LAS f32x4*)(PT + s * 64 + 4 * tg), v4 = *(const LAS f32x4*)(Vs + s * 128 + 4 * vg);
              ap[0] += p4.x * v4; ap[1] += p4.y * v4; ap[2] += p4.z * v4; ap[3] += p4.w * v4; rs += p4; }
#pragma unroll
          for (int i = 0; i < 4; ++i) { const int t = 4 * tg + i; const float g = vec[320 + t], den = g * nq[i] + rs[i], dn = fmaxf(fabsf(den), __expf(-vec[384 + t]));
              const f32x4 hv = (g * ac[i] + ap[i]) * (1.f / dn);
              *(f32x4*)(wsp<float>(F, WS_HM) + ((size_t)z * R + rows[t]) * 512 + h * 128 + 4 * vg) = hv; } }
        __syncthreads();
    }
}
template <int CTRL> __device__ __forceinline__ float dpp_add(float v) { return v + __builtin_bit_cast(float, __builtin_amdgcn_update_dpp(0, __builtin_bit_cast(int, v), CTRL, 0xF, 0xF, true)); }
__device__ __forceinline__ float reduce16(float v) { v = dpp_add<0xB1>(v); v = dpp_add<0x4E>(v); v = dpp_add<0x141>(v); v = dpp_add<0x140>(v); return v; }
struct ScanIn { f32x4 a, b, w, k, r; float v; };
__device__ __forceinline__ float fma_s(float a, float b, float c) { float r; asm("v_fma_f32 %0, %1, %2, %3" : "=v"(r) : "v"(a), "v"(b), "v"(c)); return r; }
__device__ __forceinline__ float mul_s(float a, float b) { float r; asm("v_mul_f32_e32 %0, %1, %2" : "=v"(r) : "v"(a), "v"(b)); return r; }
__device__ __forceinline__ float add_s(float a, float b) { float r; asm("v_add_f32_e32 %0, %1, %2" : "=v"(r) : "v"(a), "v"(b)); return r; }
constexpr int SC_TS = 32, SC_MAIN = SC_TS * 320, SC_TILE = SC_MAIN + SC_TS * 16, SC_NBLK = 128;
typedef float f32x2_t __attribute__((ext_vector_type(2)));
__device__ __forceinline__ void l1_rwkv_scan(const Frame& F) {
    const int chain = F.blk >> 2, z = chain >> 4, b = (chain >> 3) & 1, h = chain & 7, qtr = F.blk & 3;
    const int g = F.lane >> 4, p = F.lane & 15, rowl = (F.wave & 3) * 4 + g; const bool cw = F.wave < 4;
    LAS float* lds = (LAS float*)F.lds; LAS float* ytile = lds + 2 * SC_TILE;
    float* Y = wsp<float>(F, WS_YR) + (size_t)z * R * 512;
    const int sst = F.tid >> 4, l16 = F.tid & 15; const size_t co = h * 64 + l16 * 4;
    const float* gR = wsp<const float>(F, WS_RR) + co; const float* gA = wsp<const float>(F, WS_AKK) + co; const float* gB = wsp<const float>(F, WS_BB) + (size_t)z * R * 512 + co;
    const float* gW = wsp<const float>(F, WS_WDEC) + (size_t)z * R * 512 + co; const float* gK = wsp<const float>(F, WS_KDIR) + (size_t)z * R * 512 + co;
    const float* gv = wsp<const float>(F, WS_VV) + h * 64 + qtr * 16 + (F.tid & 3) * 4; const int gvst = (F.tid >> 2) + 1; const bool vld = F.tid < 128;
    f32x4 tR, tA, tB, tW, tK, stv;
#define SC_ROW(sg) (((size_t)b * TB + scan_tok(z, (sg) < TB ? (sg) : TB - 1)) * 512)
#define SC_GLOAD(n) do { const size_t r0_ = SC_ROW((n) * SC_TS + sst), r1_ = SC_ROW((n) * SC_TS + sst + 1); tR = *(const f32x4*)(gR + r0_); tA = *(const f32x4*)(gA + r1_); tB = *(const f32x4*)(gB + r0_); \
    tW = *(const f32x4*)(gW + r0_); tK = *(const f32x4*)(gK + r1_); if (vld) stv = *(const f32x4*)(gv + SC_ROW((n) * SC_TS + gvst)); } while (0)
#define SC_LWRITE(buf) do { LAS float* d_ = lds + (buf) * SC_TILE + sst * 320; *(LAS f32x4*)(d_ + l16 * 8) = (f32x4){tR.x, tA.x, tR.y, tA.y}; *(LAS f32x4*)(d_ + l16 * 8 + 4) = (f32x4){tR.z, tA.z, tR.w, tA.w}; \
    *(LAS f32x4*)(d_ + 128 + l16 * 4) = tB; *(LAS f32x4*)(d_ + 192 + l16 * 4) = tW; *(LAS f32x4*)(d_ + 256 + l16 * 4) = tK; \
    if (vld) ((LAS f32x4*)(lds + (buf) * SC_TILE + SC_MAIN))[F.tid] = stv; } while (0)
    f32x2_t S01 = {0.f, 0.f}, S23 = {0.f, 0.f}; float pa = 0.f, vk0, vk1, vk2, vk3;
    { const size_t r0 = SC_ROW(0); const f32x4 k4 = *(const f32x4*)(wsp<const float>(F, WS_KDIR) + (size_t)z * R * 512 + r0 + h * 64 + 4 * p);
      const float v0 = wsp<const float>(F, WS_VV)[r0 + h * 64 + qtr * 16 + rowl]; vk0 = v0 * k4.x; vk1 = v0 * k4.y; vk2 = v0 * k4.z; vk3 = v0 * k4.w; }
    constexpr int NTILE = TB / SC_TS;
    SC_GLOAD(0); SC_LWRITE(0); __syncthreads();
    for (int n = 0; n < NTILE; ++n) {
        if (n + 1 < NTILE) SC_GLOAD(n + 1);
        const LAS float* tb = lds + (n & 1) * SC_TILE; const LAS float* tv = lds + (n & 1) * SC_TILE + SC_MAIN + rowl;
        LAS float* yw = (p == 0) ? (ytile + (n & 1) * (SC_TS * 16) + rowl) : (ytile + 2 * (SC_TS * 16) + F.tid);
        const int ystep = (p == 0) ? 16 : 0;
        struct In { f32x4 q0, q1, b, w, k; float v; };
#define SC_LD(S, s_) do { S.q0 = *(const LAS f32x4*)(tb + (s_) * 320 + 8 * p); S.q1 = *(const LAS f32x4*)(tb + (s_) * 320 + 8 * p + 4); S.b = *(const LAS f32x4*)(tb + (s_) * 320 + 128 + 4 * p); \
    S.w = *(const LAS f32x4*)(tb + (s_) * 320 + 192 + 4 * p); S.k = *(const LAS f32x4*)(tb + (s_) * 320 + 256 + 4 * p); S.v = tv[(s_) * 16]; } while (0)
#define SC_ST(S, s_) do { \
    { const f32x2_t t01_ = S.b.xy * pa + (f32x2_t){vk0, vk1}, t23_ = S.b.zw * pa + (f32x2_t){vk2, vk3}; S01 = S01 * S.w.xy + t01_; S23 = S23 * S.w.zw + t23_; } \
    f32x2_t P_ = S.q0.xy * S01.x, Q_ = S.q1.xy * S23.x; P_ = S.q0.zw * S01.y + P_; Q_ = S.q1.zw * S23.y + Q_; P_ = P_ + Q_; \
    float py_ = P_.x; pa = P_.y; \
    asm volatile("s_nop 1\n\tv_mul_f32_e32 %2, %6, %7\n\t" \
        "v_add_f32_dpp %0, %0, %0 quad_perm:[1,0,3,2] row_mask:0xf bank_mask:0xf bound_ctrl:1\n\tv_add_f32_dpp %1, %1, %1 quad_perm:[1,0,3,2] row_mask:0xf bank_mask:0xf bound_ctrl:1\n\tv_mul_f32_e32 %3, %6, %8\n\t" \
        "v_add_f32_dpp %0, %0, %0 quad_perm:[2,3,0,1] row_mask:0xf bank_mask:0xf bound_ctrl:1\n\tv_add_f32_dpp %1, %1, %1 quad_perm:[2,3,0,1] row_mask:0xf bank_mask:0xf bound_ctrl:1\n\tv_mul_f32_e32 %4, %6, %9\n\t" \
        "v_add_f32_dpp %0, %0, %0 row_half_mirror row_mask:0xf bank_mask:0xf bound_ctrl:1\n\tv_add_f32_dpp %1, %1, %1 row_half_mirror row_mask:0xf bank_mask:0xf bound_ctrl:1\n\tv_mul_f32_e32 %5, %6, %10\n\t" \
        "v_add_f32_dpp %0, %0, %0 row_mirror row_mask:0xf bank_mask:0xf bound_ctrl:1\n\tv_add_f32_dpp %1, %1, %1 row_mirror row_mask:0xf bank_mask:0xf bound_ctrl:1\n\ts_nop 0" \
        : "+v"(py_), "+v"(pa), "=&v"(vk0), "=&v"(vk1), "=&v"(vk2), "=&v"(vk3) : "v"(S.v), "v"(S.k.x), "v"(S.k.y), "v"(S.k.z), "v"(S.k.w)); \
    yw[(s_) * ystep] = py_; } while (0)
        if (cw) { In I0, I1; SC_LD(I0, 0);
#pragma unroll 4
        for (int s = 0; s < SC_TS; s += 2) {
            SC_LD(I1, s + 1); SC_ST(I0, s);
            if (s + 2 < SC_TS) SC_LD(I0, s + 2);
            SC_ST(I1, s + 1);
        } }
#undef SC_LD
#undef SC_ST
        if (n + 1 < NTILE) SC_LWRITE((n + 1) & 1);
        __syncthreads();
        { const int stp = F.tid >> 4, c1 = F.tid & 15; Y[((size_t)b * TB + scan_tok(z, n * SC_TS + stp)) * 512 + h * 64 + qtr * 16 + c1] = ytile[(n & 1) * (SC_TS * 16) + stp * 16 + c1]; }
    }
#undef SC_GLOAD
#undef SC_LWRITE
#undef SC_ROW
}
__device__ __forceinline__ void l1_rec_out(const Frame& F) {
    const int gw = F.blk * 8 + F.wave, NGW = F.G * 8, lane = F.lane, c0 = 8 * lane;
    for (int row = gw; row < R; row += NGW) {
        const size_t ro = (size_t)row * 512 + c0; bf16* a1 = wsp<bf16>(F, WS_A1) + (size_t)row * DM;
        { const float* y0 = wsp<const float>(F, WS_YR) + ro; const float* y1 = y0 + (size_t)R * 512; float y[8]; float s = 0.f;
#if RK_CHUNKED
          const float* y2 = wsp<const float>(F, WS_YB) + ro; const float* y3 = y2 + (size_t)R * 512;
#pragma unroll
          for (int e = 0; e < 8; ++e) { y[e] = (y0[e] + y1[e]) + (y2[e] + y3[e]); s += y[e]; }
#else
#pragma unroll
          for (int e = 0; e < 8; ++e) { y[e] = y0[e] + y1[e]; s += y[e]; }
#endif
          s += __shfl_xor(s, 1); s += __shfl_xor(s, 2); s += __shfl_xor(s, 4); const float mean = s * (1.f / 64.f); float q = 0.f;
#pragma unroll
          for (int e = 0; e < 8; ++e) { y[e] -= mean; q += y[e] * y[e]; }
          q += __shfl_xor(q, 1); q += __shfl_xor(q, 2); q += __shfl_xor(q, 4); const float rstd = 1.f / sqrtf(q * (1.f / 64.f) + 64e-5f);
          float rr[8], kl[8], s0[8], s1[8], vv[8], gg[8]; unpack8(*(const v4u*)(wsp<const bf16>(F, WS_RR) + ro), rr); unpack8(*(const v4u*)(wsp<const bf16>(F, WS_KL) + ro), kl);
          unpack8(*(const v4u*)(wsp<const bf16>(F, WS_ASIG) + ro), s0); unpack8(*(const v4u*)(wsp<const bf16>(F, WS_ASIG) + (size_t)R * 512 + ro), s1);
          unpack8(*(const v4u*)(wsp<const bf16>(F, WS_VV) + ro), vv); unpack8(*(const v4u*)(wsp<const bf16>(F, WS_GG) + ro), gg);
          const float* rk = F.in[I_RK] + c0; const float* ka = F.in[I_KA] + c0; float bs = 0.f;
#pragma unroll
          for (int e = 0; e < 8; ++e) bs += rr[e] * kl[e] * (2.f + (s0[e] + s1[e] - 2.f) * ka[e]) * rk[e];
          bs += __shfl_xor(bs, 1); bs += __shfl_xor(bs, 2); bs += __shfl_xor(bs, 4);
          const float* lw = F.in[I_LNW] + c0; const float* lb = F.in[I_LNB] + c0; float o[8];
#pragma unroll
          for (int e = 0; e < 8; ++e) o[e] = (y[e] * rstd * lw[e] + lb[e] + bs * vv[e]) * gg[e];
          v4u w; w.x = pk2(o[0], o[1]); w.y = pk2(o[2], o[3]); w.z = pk2(o[4], o[5]); w.w = pk2(o[6], o[7]); *(v4u*)(a1 + c0) = w; }
        { const float* h0 = wsp<const float>(F, WS_HM) + ro; const float* h1 = h0 + (size_t)R * 512; float x[8]; float q = 0.f;
#pragma unroll
          for (int e = 0; e < 8; ++e) { x[e] = h0[e] + h1[e]; q += x[e] * x[e]; }
          q += __shfl_xor(q, 1); q += __shfl_xor(q, 2); q += __shfl_xor(q, 4); q += __shfl_xor(q, 8); const float rs = 1.f / sqrtf(q * (1.f / 128.f) + NORM_EPS);
          float og[8]; unpack8(*(const v4u*)(wsp<const bf16>(F, WS_P) + (size_t)row * REC_NP + PC_O + c0), og); const float* nw = F.in[I_MNW] + c0; float o[8];
#pragma unroll
          for (int e = 0; e < 8; ++e) o[e] = x[e] * rs * nw[e] * sigmoidf_(og[e]);
          v4u w; w.x = pk2(o[0], o[1]); w.y = pk2(o[2], o[3]); w.z = pk2(o[4], o[5]); w.w = pk2(o[6], o[7]); *(v4u*)(a1 + 512 + c0) = w; }
    }
}
namespace rk {
constexpr int LS = 72;
constexpr int MB = 64 * LS * 2;
struct Acc2 { pg8::f32x4 t0, t1; };
__device__ __forceinline__ void zero(Acc2& a) { a.t0 = (pg8::f32x4){0.f, 0.f, 0.f, 0.f}; a.t1 = a.t0; }
__device__ __forceinline__ void mm_acc(Acc2& acc, const LAS bf16* A, const LAS bf16* Bt, int wave, int lane) {
    const int tm = wave >> 1, tn0 = (wave & 1) * 2, lr = lane & 15, kq = (lane >> 4) * 8;
    const LAS bf16* ap = A + (tm * 16 + lr) * LS + kq; const LAS bf16* bp0 = Bt + (tn0 * 16 + lr) * LS + kq; const LAS bf16* bp1 = bp0 + 16 * LS;
    const bf16x8 a0 = *(const LAS bf16x8*)ap, a1 = *(const LAS bf16x8*)(ap + 32);
    const bf16x8 b00 = *(const LAS bf16x8*)bp0, b01 = *(const LAS bf16x8*)(bp0 + 32), b10 = *(const LAS bf16x8*)bp1, b11 = *(const LAS bf16x8*)(bp1 + 32);
    acc.t0 = __builtin_amdgcn_mfma_f32_16x16x32_bf16(a0, b00, acc.t0, 0, 0, 0); acc.t0 = __builtin_amdgcn_mfma_f32_16x16x32_bf16(a1, b01, acc.t0, 0, 0, 0);
    acc.t1 = __builtin_amdgcn_mfma_f32_16x16x32_bf16(a0, b10, acc.t1, 0, 0, 0); acc.t1 = __builtin_amdgcn_mfma_f32_16x16x32_bf16(a1, b11, acc.t1, 0, 0, 0);
}
template <class Fn> __device__ __forceinline__ void each(const Acc2& acc, int wave, int lane, Fn fn) {
    const int m0 = (wave >> 1) * 16 + (lane >> 4) * 4, n0 = (wave & 1) * 32 + (lane & 15);
#pragma unroll
    for (int r = 0; r < 4; ++r) { fn(m0 + r, n0, acc.t0[r]); fn(m0 + r, n0 + 16, acc.t1[r]); }
}
__device__ __forceinline__ void stb(LAS bf16* M, int m, int n, float v) { M[m * LS + n] = (bf16)f2bf(v); }
__device__ __forceinline__ void st_tr(LAS bf16* M, const Acc2& acc, int wave, int lane) {
    const int m0 = (wave >> 1) * 16 + (lane >> 4) * 4, n0 = (wave & 1) * 32 + (lane & 15);
    v2u a, b; a.x = pk2(acc.t0[0], acc.t0[1]); a.y = pk2(acc.t0[2], acc.t0[3]); b.x = pk2(acc.t1[0], acc.t1[1]); b.y = pk2(acc.t1[2], acc.t1[3]);
    *(LAS v2u*)(M + n0 * LS + m0) = a; *(LAS v2u*)(M + (n0 + 16) * LS + m0) = b;
}
}
__device__ __forceinline__ void l1_rk_phase_a(const Frame& F) {
    using namespace rk;
    LAS unsigned char* L = F.lds;
    LAS bf16* Rt = (LAS bf16*)(L + 0 * MB); LAS bf16* At = (LAS bf16*)(L + 1 * MB); LAS bf16* AtT = (LAS bf16*)(L + 2 * MB); LAS bf16* Bq = (LAS bf16*)(L + 3 * MB); LAS bf16* Kq = (LAS bf16*)(L + 4 * MB);
    LAS bf16* VT = (LAS bf16*)(L + 5 * MB); LAS bf16* BhT = (LAS bf16*)(L + 6 * MB); LAS bf16* KhT = (LAS bf16*)(L + 7 * MB);
    LAS bf16* AK = (LAS bf16*)(L + 8 * MB); LAS bf16* RB = (LAS bf16*)(L + 9 * MB); LAS bf16* RK = (LAS bf16*)(L + 10 * MB);
    LAS bf16* X = (LAS bf16*)(L + 11 * MB); LAS bf16* XT = (LAS bf16*)(L + 12 * MB); LAS bf16* P = (LAS bf16*)(L + 13 * MB);
    LAS bf16* AkVT = Bq; LAS bf16* ApT = Kq; LAS bf16* W2T = X;
    LAS float* G = (LAS float*)(L + 8 * MB);
    LAS float* gl = (LAS float*)(L + 14 * MB);
    const int w = F.wave, lane = F.lane, tid = F.tid;
    const int t = tid >> 3, j0 = (tid & 7) * 8;
    float fr[8], fv[8], fa[8], fw[8], fk[8], fb[8];
#define RK_LOAD(u_) do { const int ch_ = (u_) / 260, c_ = (u_) - ch_ * 260, z_ = ch_ >> 4, b_ = (ch_ >> 3) & 1, h_ = ch_ & 7; const size_t ro = ((size_t)b_ * TB + scan_tok(z_, 64 * c_ + t)) * 512 + h_ * 64 + j0; \
    const v4u xr_ = *(const v4u*)(wsp<const bf16>(F, WS_RR) + ro), xv_ = *(const v4u*)(wsp<const bf16>(F, WS_VV) + ro), xa_ = *(const v4u*)(wsp<const bf16>(F, WS_AKK) + ro), xk_ = *(const v4u*)(wsp<const bf16>(F, WS_KL) + ro), \
              xs_ = *(const v4u*)(wsp<const bf16>(F, WS_ASIG) + (size_t)z_ * R * 512 + ro); const float* p3 = wsp<const float>(F, WS_WDEC) + (size_t)z_ * R * 512 + ro; const float* pk_ = F.in[I_KA] + h_ * 64 + j0; \
    const f32x4 w0_ = *(const f32x4*)p3, w1_ = *(const f32x4*)(p3 + 4), q0_ = *(const f32x4*)pk_, q1_ = *(const f32x4*)(pk_ + 4); float sg_[8], kl_[8]; \
    unpack8(xr_, fr); unpack8(xv_, fv); unpack8(xa_, fa); unpack8(xk_, kl_); unpack8(xs_, sg_); \
    _Pragma("unroll") for (int e = 0; e < 8; ++e) { const float kav = e < 4 ? q0_[e & 3] : q1_[e & 3]; fw[e] = e < 4 ? w0_[e & 3] : w1_[e & 3]; fk[e] = kl_[e] * (1.f + (sg_[e] - 1.f) * kav); fb[e] = -fa[e] * sg_[e]; } } while (0)
    if (F.blk < NUNIT_R) RK_LOAD(F.blk);
    for (int u = F.blk; u < NUNIT_R; u += F.G) {
        const int chain = u / 260, c = u - chain * 260, z = chain >> 4, b = (chain >> 3) & 1, h = chain & 7;
        __syncthreads();
#pragma unroll
        for (int e = 0; e < 8; ++e) G[t * 65 + j0 + e] = fw[e];
        __syncthreads();
        if (tid < 64) { float g = 1.f;
#pragma unroll 16
            for (int s = 0; s < 64; ++s) { g *= G[s * 65 + tid]; G[s * 65 + tid] = g; } gl[tid] = g; }
        __syncthreads();
#pragma unroll
        for (int e = 0; e < 8; ++e) { const int j = j0 + e; const float gt = G[t * 65 + j], gp = t > 0 ? G[(t - 1) * 65 + j] : 1.f, gL = G[63 * 65 + j], ig = 1.f / gt;
            fr[e] *= gt; fa[e] *= gp; const float bq = fb[e] * ig, kq = fk[e] * ig; fb[e] = bq; fk[e] = kq; fw[e] = gL; }
        __syncthreads();
#pragma unroll
        for (int e = 0; e < 8; ++e) { const int j = j0 + e;
            stb(Rt, t, j, fr[e]); stb(At, t, j, fa[e]); stb(AtT, j, t, fa[e]); stb(Bq, t, j, fb[e]); stb(Kq, t, j, fk[e]);
            stb(VT, j, t, fv[e]); stb(BhT, j, t, fb[e] * fw[e]); stb(KhT, j, t, fk[e] * fw[e]); }
        __syncthreads();
        if (u + F.G < NUNIT_R) RK_LOAD(u + F.G);
        Acc2 a1, a2, a3, a4;
        zero(a1); mm_acc(a1, At, Bq, w, lane); zero(a2); mm_acc(a2, At, Kq, w, lane); zero(a3); mm_acc(a3, Rt, Bq, w, lane); zero(a4); mm_acc(a4, Rt, Kq, w, lane);
        each(a1, w, lane, [&](int m, int n, float v) { const float x = n < m ? v : 0.f; stb(X, m, n, x); stb(XT, n, m, x); stb(P, m, n, m == n ? 1.f : 0.f); });
        each(a2, w, lane, [&](int m, int n, float v) { stb(AK, m, n, n < m ? v : 0.f); });
        each(a3, w, lane, [&](int m, int n, float v) { stb(RB, m, n, n <= m ? v : 0.f); });
        each(a4, w, lane, [&](int m, int n, float v) { stb(RK, m, n, n <= m ? v : 0.f); });
        __syncthreads();
#pragma unroll 1
        for (int i = 0; i < 6; ++i) {
            zero(a2); mm_acc(a2, P, XT, w, lane);
            if (i < 5) { zero(a1); mm_acc(a1, X, XT, w, lane); }
            const int m0 = (w >> 1) * 16 + (lane >> 4) * 4, n0 = (w & 1) * 32 + (lane & 15); float pv[8];
#pragma unroll
            for (int r = 0; r < 4; ++r) { pv[2 * r] = bf2f(P[(m0 + r) * LS + n0]); pv[2 * r + 1] = bf2f(P[(m0 + r) * LS + n0 + 16]); }
            __syncthreads();
#pragma unroll
            for (int r = 0; r < 4; ++r) { stb(P, m0 + r, n0, pv[2 * r] + a2.t0[r]); stb(P, m0 + r, n0 + 16, pv[2 * r + 1] + a2.t1[r]); }
            if (i < 5) { each(a1, w, lane, [&](int m, int n, float v) { stb(X, m, n, v); }); st_tr(XT, a1, w, lane); }
            __syncthreads();
        }
        zero(a1); mm_acc(a1, AK, VT, w, lane); zero(a2); mm_acc(a2, P, AtT, w, lane);
        st_tr(AkVT, a1, w, lane); st_tr(ApT, a2, w, lane);
        __syncthreads();
        zero(a3); mm_acc(a3, P, AkVT, w, lane);
        st_tr(W2T, a3, w, lane);
        __syncthreads();
        zero(a1); mm_acc(a1, RB, ApT, w, lane); zero(a2); mm_acc(a2, RB, W2T, w, lane); mm_acc(a2, RK, VT, w, lane);
        zero(a3); mm_acc(a3, BhT, ApT, w, lane); zero(a4); mm_acc(a4, BhT, W2T, w, lane); mm_acc(a4, KhT, VT, w, lane);
        __syncthreads();
        { LAS bf16* O1 = At; LAS bf16* O2 = AtT; LAS bf16* O3 = AK; LAS float* OY = (LAS float*)X;
          each(a1, w, lane, [&](int m, int n, float v) { stb(O1, m, n, v + bf2f(Rt[m * LS + n])); });
          each(a3, w, lane, [&](int m, int n, float v) { stb(O2, m, n, v + (m == n ? gl[m] : 0.f)); });
          each(a4, w, lane, [&](int m, int n, float v) { stb(O3, m, n, v); });
          each(a2, w, lane, [&](int m, int n, float v) { OY[m * 68 + n] = v; });
          __syncthreads();
          const int row = tid >> 3, c8 = (tid & 7) * 8;
          *(v4u*)(wsp<bf16>(F, WS_RKQ) + (size_t)u * 4096 + row * 64 + c8) = *(const LAS v4u*)(O1 + row * LS + c8);
          *(v4u*)(wsp<bf16>(F, WS_RKM) + (size_t)u * 4096 + row * 64 + c8) = *(const LAS v4u*)(O2 + row * LS + c8);
          *(v4u*)(wsp<bf16>(F, WS_RKZ) + (size_t)u * 4096 + row * 64 + c8) = *(const LAS v4u*)(O3 + row * LS + c8);
          float* Yg = wsp<float>(F, WS_YR) + (size_t)z * R * 512 + h * 64;
#pragma unroll
          for (int i = 0; i < 2; ++i) { const int yr = (tid >> 4) + 32 * i, c4 = (tid & 15) * 4;
              *(f32x4*)(Yg + ((size_t)b * TB + scan_tok(z, 64 * c + yr)) * 512 + c4) = *(const LAS f32x4*)(OY + yr * 68 + c4); } }
    }
#undef RK_LOAD
}
__device__ __forceinline__ void l1_rk_phase_b(const Frame& F) {
    using namespace rk;
    LAS unsigned char* L = F.lds; LAS bf16* S = (LAS bf16*)L;
    const int w = F.wave, lane = F.lane, tid = F.tid, chain = F.blk, z = chain >> 4, b = (chain >> 3) & 1, h = chain & 7;
    for (int i = tid; i < 64 * LS; i += 512) S[i] = 0;
    const int sr = tid >> 3, sc = (tid & 7) * 8;
    v4u gm, gq, gz;
#define RKB_LOAD(u_) do { gm = *(const v4u*)(wsp<const bf16>(F, WS_RKM) + (u_) * 4096 + sr * 64 + sc); gq = *(const v4u*)(wsp<const bf16>(F, WS_RKQ) + (u_) * 4096 + sr * 64 + sc); \
    gz = *(const v4u*)(wsp<const bf16>(F, WS_RKZ) + (u_) * 4096 + sr * 64 + sc); } while (0)
#define RKB_WRITE(par) do { *(LAS v4u*)((LAS bf16*)(L + (1 + 3 * (par)) * MB) + sr * LS + sc) = gm; *(LAS v4u*)((LAS bf16*)(L + (2 + 3 * (par)) * MB) + sr * LS + sc) = gq; \
    *(LAS v4u*)((LAS bf16*)(L + (3 + 3 * (par)) * MB) + sr * LS + sc) = gz; } while (0)
    RKB_LOAD((size_t)chain * 260); RKB_WRITE(0);
    __syncthreads();
    float* Yg = wsp<float>(F, WS_YB) + (size_t)z * R * 512 + h * 64;
    LAS float* OY = (LAS float*)(L + 7 * MB);
    for (int c = 0; c < 260; ++c) {
        const size_t u = (size_t)chain * 260 + c; const int par = c & 1;
        if (c + 1 < 260) RKB_LOAD(u + 1);
        const LAS bf16* Mt = (const LAS bf16*)(L + (1 + 3 * par) * MB); const LAS bf16* Qp = (const LAS bf16*)(L + (2 + 3 * par) * MB); const LAS bf16* Zt = (const LAS bf16*)(L + (3 + 3 * par) * MB);
        Acc2 a1, a2; zero(a1); mm_acc(a1, Mt, S, w, lane); zero(a2); mm_acc(a2, Qp, S, w, lane);
        const int m0 = (w >> 1) * 16 + (lane >> 4) * 4, n0 = (w & 1) * 32 + (lane & 15); float zv[8];
#pragma unroll
        for (int r = 0; r < 4; ++r) { zv[2 * r] = bf2f(Zt[(m0 + r) * LS + n0]); zv[2 * r + 1] = bf2f(Zt[(m0 + r) * LS + n0 + 16]); }
        __syncthreads();
        { Acc2 s2;
#pragma unroll
          for (int r = 0; r < 4; ++r) { s2.t0[r] = a1.t0[r] + zv[2 * r]; s2.t1[r] = a1.t1[r] + zv[2 * r + 1]; OY[(m0 + r) * 68 + n0] = a2.t0[r]; OY[(m0 + r) * 68 + n0 + 16] = a2.t1[r]; }
          st_tr(S, s2, w, lane); }
        if (c + 1 < 260) RKB_WRITE(par ^ 1);
        __syncthreads();
#pragma unroll
        for (int i = 0; i < 2; ++i) { const int yr = (tid >> 4) + 32 * i, c4 = (tid & 15) * 4;
            *(f32x4*)(Yg + ((size_t)b * TB + scan_tok(z, 64 * c + yr)) * 512 + c4) = *(const LAS f32x4*)(OY + yr * 68 + c4); }
    }
#undef RKB_LOAD
#undef RKB_WRITE
}
__device__ __forceinline__ void l1_mlstm_a2(const Frame& F) {
    using namespace rk;
    LAS bf16* KT = (LAS bf16*)F.lds; LAS bf16* VsT = KT + 64 * LS;
    LAS float* vec = (LAS float*)(F.lds + AUX_OFF); LAS int* rows = (LAS int*)vec;
    const bf16* Pg = wsp<const bf16>(F, WS_P); const int tid = F.tid, w = F.wave, lane = F.lane;
    for (int u = F.blk; u < NUNIT_M; u += F.G) {
        const int cidx = u / 260, c = u - cidx * 260, z = cidx >> 3, b = (cidx >> 2) & 1, h = cidx & 3;
        mlstm_chunk_head(F, z, b, h, c, vec);
        if (tid < 64) { const float bl = vec[128 + 63]; const float uu = bl - vec[128 + tid] + vec[64 + tid]; float m = uu;
#pragma unroll
            for (int o = 1; o < 64; o <<= 1) m = fmaxf(m, __shfl_xor(m, o));
            vec[256 + tid] = __expf(uu - m);
            if (tid == 0) { wsp<float>(F, WS_SC)[2 * u] = bl; wsp<float>(F, WS_SC)[2 * u + 1] = m; } }
        __syncthreads();
        { const int s = tid >> 3, c8 = tid & 7; float x[8]; unpack8(*(const v4u*)(Pg + (size_t)rows[s] * REC_NP + PC_K + h * 64 + 8 * c8), x);
#pragma unroll
          for (int e = 0; e < 8; ++e) stb(KT, 8 * c8 + e, s, x[e]); }
#pragma unroll
        for (int i = 0; i < 2; ++i) { const int s = (tid >> 4) + 32 * i, c8 = tid & 15; float x[8]; unpack8(*(const v4u*)(Pg + (size_t)rows[s] * REC_NP + PC_V + h * 128 + 8 * c8), x); const float sw = vec[256 + s];
#pragma unroll
            for (int e = 0; e < 8; ++e) stb(VsT, 8 * c8 + e, s, x[e] * sw); }
        __syncthreads();
        Acc2 a0, a1; zero(a0); mm_acc(a0, VsT, KT, w, lane); zero(a1); mm_acc(a1, VsT + 64 * LS, KT, w, lane);
        float* dc = wsp<float>(F, WS_DC) + (size_t)u * 8192;
        each(a0, w, lane, [&](int m, int n, float v) { dc[m * 64 + n] = 0.125f * v; });
        each(a1, w, lane, [&](int m, int n, float v) { dc[(64 + m) * 64 + n] = 0.125f * v; });
        if (tid < 64) { float a = 0.f; for (int s = 0; s < 64; ++s) a += vec[256 + s] * bf2f(KT[tid * LS + s]); wsp<float>(F, WS_DN)[(size_t)u * 64 + tid] = 0.125f * a; }
        __syncthreads();
    }
}
__device__ __forceinline__ void l1_mlstm_c2(const Frame& F, int first_blk, int nblk) {
    using namespace rk;
    LAS bf16* Q = (LAS bf16*)F.lds; LAS bf16* K = Q + 64 * LS; LAS bf16* VT = K + 64 * LS; LAS bf16* Cm = VT + 128 * LS; LAS bf16* Pm = Cm + 128 * LS;
    LAS float* OH = (LAS float*)(F.lds + 7 * MB);
    LAS float* vec = (LAS float*)(F.lds + AUX_OFF); LAS int* rows = (LAS int*)vec;
    const bf16* Pg = wsp<const bf16>(F, WS_P); const int tid = F.tid, w = F.wave, lane = F.lane;
    for (int u = F.blk - first_blk; u < NUNIT_M; u += nblk) {
        const int cidx = u / 260, c = u - cidx * 260, z = cidx >> 3, b = (cidx >> 2) & 1, h = cidx & 3;
        mlstm_chunk_head(F, z, b, h, c, vec);
        const float mst = wsp<const float>(F, WS_MST)[u];
        if (tid < 64) { const int t = tid; float pm = -3.0e38f; for (int s = 0; s <= t; ++s) pm = fmaxf(pm, vec[64 + s] - vec[128 + s]);
            const float gi = vec[128 + t] + mst, mo = fmaxf(gi, vec[128 + t] + pm); vec[320 + t] = __expf(gi - mo); vec[384 + t] = mo;
            vec[256 + t] = wsp<const float>(F, WS_NST)[(size_t)u * 64 + t]; }
        { const int t = tid >> 3, c8 = tid & 7;
          *(LAS v4u*)(Q + t * LS + 8 * c8) = *(const v4u*)(Pg + (size_t)rows[t] * REC_NP + PC_Q + h * 64 + 8 * c8);
          *(LAS v4u*)(K + t * LS + 8 * c8) = *(const v4u*)(Pg + (size_t)rows[t] * REC_NP + PC_K + h * 64 + 8 * c8); }
#pragma unroll
        for (int i = 0; i < 2; ++i) { const int s = (tid >> 4) + 32 * i, c8 = tid & 15; const v4u wv = *(const v4u*)(Pg + (size_t)rows[s] * REC_NP + PC_V + h * 128 + 8 * c8);
            const unsigned ww[4] = {wv.x, wv.y, wv.z, wv.w};
#pragma unroll
            for (int e = 0; e < 4; ++e) { VT[(8 * c8 + 2 * e) * LS + s] = (bf16)(ww[e] & 0xffffu); VT[(8 * c8 + 2 * e + 1) * LS + s] = (bf16)(ww[e] >> 16); } }
        { const int v = tid >> 2, dq = (tid & 3) * 16; const f32x4* src = (const f32x4*)(wsp<const float>(F, WS_CST) + (size_t)u * 8192 + v * 64 + dq);
          const f32x4 x0 = src[0], x1 = src[1], x2 = src[2], x3 = src[3]; v4u o0, o1;
          o0.x = pk2(x0.x, x0.y); o0.y = pk2(x0.z, x0.w); o0.z = pk2(x1.x, x1.y); o0.w = pk2(x1.z, x1.w); o1.x = pk2(x2.x, x2.y); o1.y = pk2(x2.z, x2.w); o1.z = pk2(x3.x, x3.y); o1.w = pk2(x3.z, x3.w);
          *(LAS v4u*)(Cm + v * LS + dq) = o0; *(LAS v4u*)(Cm + v * LS + dq + 8) = o1; }
        __syncthreads();
        Acc2 aq, c0, c1; zero(aq); mm_acc(aq, Q, K, w, lane); zero(c0); mm_acc(c0, Q, Cm, w, lane); zero(c1); mm_acc(c1, Q, Cm + 64 * LS, w, lane);
        each(aq, w, lane, [&](int t, int s, float v) { stb(Pm, t, s, s <= t ? 0.125f * v * __expf(vec[128 + t] + (vec[64 + s] - vec[128 + s]) - vec[384 + t]) : 0.f); });
        __syncthreads();
        Acc2 p0, p1; zero(p0); mm_acc(p0, Pm, VT, w, lane); zero(p1); mm_acc(p1, Pm, VT + 64 * LS, w, lane);
        if (tid < 64) { const int t = tid; float rs = 0.f, nq = 0.f;
            for (int s = 0; s < 64; ++s) { rs += bf2f(Pm[t * LS + s]); nq += vec[256 + s] * bf2f(Q[t * LS + s]); }
            const float den = vec[320 + t] * nq + rs; vec[448 + t] = 1.f / fmaxf(fabsf(den), __expf(-vec[384 + t])); }
        __syncthreads();
        { const int m0 = (w >> 1) * 16 + (lane >> 4) * 4, n0 = (w & 1) * 32 + (lane & 15);
#pragma unroll
          for (int r = 0; r < 4; ++r) { const int t = m0 + r; const float g = vec[320 + t], idn = vec[448 + t];
              OH[t * 132 + n0] = (g * c0.t0[r] + p0.t0[r]) * idn; OH[t * 132 + n0 + 16] = (g * c0.t1[r] + p0.t1[r]) * idn;
              OH[t * 132 + 64 + n0] = (g * c1.t0[r] + p1.t0[r]) * idn; OH[t * 132 + 64 + n0 + 16] = (g * c1.t1[r] + p1.t1[r]) * idn; } }
        __syncthreads();
#pragma unroll
        for (int i = 0; i < 4; ++i) { const int it = tid + 512 * i, t = it >> 5, c4 = (it & 31) * 4;
            *(f32x4*)(wsp<float>(F, WS_HM) + ((size_t)z * R + rows[t]) * 512 + h * 128 + c4) = *(const LAS f32x4*)(OH + t * 132 + c4); }
        __syncthreads();
    }
}
#ifndef MK_PER_PHASE
#define MK_PER_PHASE 0
#endif
constexpr int NPHASE = 26;
struct Args { const float* in[N_IN]; float* out; unsigned char* ws; int ph_lo, ph_hi, li, pad; };
#define GEMM_CALL(FnT, SchedT, g, S, fn) do { pg8::EpiGen<FnT> E_{fn}; { int k_ = g.K; asm volatile("" : "+s"(k_)); g.K = k_; } pg8::gemm_phase<pg8::EpiGen<FnT>, SchedT, true, true>((PG8_LAS unsigned char*)F.lds, g, S, E_); } while (0)
#ifndef SITE_MASK
#define SITE_MASK 0xFFFFFFFFull
#endif
#define SITE(s) (((SITE_MASK) >> (s)) & 1ull)
#ifndef DUP_MASK
#define DUP_MASK 0ull
#endif
#define NREP(s) ((((DUP_MASK) >> (s)) & 1ull) ? 2 : 1)
#define IN(k) (lo <= (k) && (k) < hi)
#define SEAM(k) do { if (IN(k) && IN((k) + 1)) xcd_barrier(bar); } while (0)
template <int LAYER> __device__ __forceinline__ void layer_phases(const Frame& F, const XcdBarrier& bar, const int lo, const int hi) {
    constexpr int layer = LAYER; constexpr int pb = 2 + 12 * LAYER;
        if (SITE(2) && IN(pb + 0)) { for (int rep_ = 0; rep_ < NREP(2); ++rep_) {
            const int N = layer == 0 ? ATT_NP : REC_NP;
            pg8::Gemm g{wsp<const bf16>(F, WS_A), layer == 0 ? wsp<const bf16>(F, WS_WIN0) : wsp<const bf16>(F, WS_WREC), R, N, 1024};
            pg8::StaticOrder S; S.init(R, N, F.G, F.blk);
            GEMM_CALL(FnStoreBf16, pg8::StaticOrder, g, S, (FnStoreBf16{wsp<bf16>(F, WS_P), N}));
             if (rep_ + 1 < NREP(2)) xcd_barrier(bar); } SEAM(pb + 0);
        }
        if constexpr (LAYER == 0) {
            if (SITE(3) && IN(pb + 1)) { for (int rep_ = 0; rep_ < NREP(3); ++rep_) { l0_post_proj(F);  if (rep_ + 1 < NREP(3)) xcd_barrier(bar); } SEAM(pb + 1); }
            if (SITE(4) && IN(pb + 2)) { for (int rep_ = 0; rep_ < NREP(4); ++rep_) {
                pg8::Gemm g{wsp<const bf16>(F, WS_CQN), wsp<const bf16>(F, WS_WUQ), R, 768, 384}; pg8::StaticOrder S; S.init(R, 768, F.G, F.blk);
                GEMM_CALL(FnStoreBf16, pg8::StaticOrder, g, S, (FnStoreBf16{wsp<bf16>(F, WS_MQ), 768}));
                 if (rep_ + 1 < NREP(4)) xcd_barrier(bar); } SEAM(pb + 2);
            }
            if (SITE(5) && IN(pb + 3)) { for (int rep_ = 0; rep_ < NREP(5); ++rep_) {
                pg8::Gemm g{wsp<const bf16>(F, WS_CKVN), wsp<const bf16>(F, WS_WUKV), R, 1024, 256}; pg8::StaticOrder S; S.init(R, 1024, F.G, F.blk);
                GEMM_CALL(FnStoreBf16, pg8::StaticOrder, g, S, (FnStoreBf16{wsp<bf16>(F, WS_MKV), 1024}));
                l0_mq_rope(F);
                 if (rep_ + 1 < NREP(5)) xcd_barrier(bar); } SEAM(pb + 3);
            }
            if (SITE(6) && IN(pb + 4)) { for (int rep_ = 0; rep_ < NREP(6); ++rep_) { l0_attention(F);  if (rep_ + 1 < NREP(6)) xcd_barrier(bar); } SEAM(pb + 4); }
            if (SITE(7) && IN(pb + 5)) { for (int rep_ = 0; rep_ < NREP(7); ++rep_) { l0_combine(F);  if (rep_ + 1 < NREP(7)) xcd_barrier(bar); } SEAM(pb + 5); }
        } else {
            if (SITE(8) && IN(pb + 1)) { for (int rep_ = 0; rep_ < NREP(8); ++rep_) { l1_rwkv_prep(F); l1_mlstm_a2(F);  if (rep_ + 1 < NREP(8)) xcd_barrier(bar); } SEAM(pb + 1); }
            if (SITE(9) && IN(pb + 2)) { for (int rep_ = 0; rep_ < NREP(9); ++rep_) {
                pg8::Gemm g{wsp<const bf16>(F, WS_ALORA), wsp<const bf16>(F, WS_WLORA), R, 2560, 384}; pg8::StaticOrder S; S.init(R, 2560, F.G, F.blk);
                { int k_ = g.K; asm volatile("" : "+s"(k_)); g.K = k_; EpiLora E_{&F}; pg8::gemm_phase<EpiLora, pg8::StaticOrder, true, true>((PG8_LAS unsigned char*)F.lds, g, S, E_); }
                l1_mlstm_b(F);
                 if (rep_ + 1 < NREP(9)) xcd_barrier(bar); } SEAM(pb + 2);
            }
            if (SITE(18) && IN(pb + 3)) { for (int rep_ = 0; rep_ < NREP(18); ++rep_) { l1_rk_phase_a(F); if (rep_ + 1 < NREP(18)) xcd_barrier(bar); } SEAM(pb + 3); }
            if (SITE(10) && IN(pb + 4)) { for (int rep_ = 0; rep_ < NREP(10); ++rep_) {
                if (F.G > 32) { if (F.blk < 32) l1_rk_phase_b(F); else { l1_mlstm_c2(F, 32, F.G - 32); moe_weights_convert(F, 1, (F.blk - 32) * 8 + F.wave, (F.G - 32) * 8); } }
                 if (rep_ + 1 < NREP(10)) xcd_barrier(bar); } SEAM(pb + 4);
            }
            if (SITE(11) && IN(pb + 5)) { for (int rep_ = 0; rep_ < NREP(11); ++rep_) { l1_rec_out(F);  if (rep_ + 1 < NREP(11)) xcd_barrier(bar); } SEAM(pb + 5); }
        }
        if (SITE(12) && IN(pb + 6)) { for (int rep_ = 0; rep_ < NREP(12); ++rep_) {
            pg8::Gemm g{wsp<const bf16>(F, WS_A1), wsp<const bf16>(F, WS_WOUT) + (size_t)layer * 1024 * 1024, R, 1024, 1024}; pg8::StaticOrder S; S.init(R, 1024, F.G, F.blk);
            GEMM_CALL(FnWout, pg8::StaticOrder, g, S, (FnWout{&F, layer}));
             if (rep_ + 1 < NREP(12)) xcd_barrier(bar); } SEAM(pb + 6);
        }
        if (SITE(13) && IN(pb + 7)) { for (int rep_ = 0; rep_ < NREP(13); ++rep_) { ph_router(F, layer);  if (rep_ + 1 < NREP(13)) xcd_barrier(bar); } SEAM(pb + 7); }
        if (SITE(14) && IN(pb + 8)) { for (int rep_ = 0; rep_ < NREP(14); ++rep_) { ph_gather(F, layer);  if (rep_ + 1 < NREP(14)) xcd_barrier(bar); } SEAM(pb + 8); }
        if (SITE(15) && IN(pb + 9)) { for (int rep_ = 0; rep_ < NREP(15); ++rep_) {
            const int* tab = wsp<const int>(F, WS_TILE);
            pg8::Gemm g{wsp<const bf16>(F, WS_XS), wsp<const bf16>(F, WS_W1T), MAXROWS, NE * 2048, 1024}; MoeOrder S{tab + 1, __builtin_amdgcn_readfirstlane(tab[0]), 8, F.G, F.blk};
            GEMM_CALL(FnSwiglu, MoeOrder, g, S, (FnSwiglu{wsp<bf16>(F, WS_HS), F.in[I_B1] + (size_t)layer * NE * 2048}));
             if (rep_ + 1 < NREP(15)) xcd_barrier(bar); } SEAM(pb + 9);
        }
        if (SITE(16) && IN(pb + 10)) { for (int rep_ = 0; rep_ < NREP(16); ++rep_) {
            const int* tab = wsp<const int>(F, WS_TILE);
            pg8::Gemm g{wsp<const bf16>(F, WS_HS), wsp<const bf16>(F, WS_W2T), MAXROWS, NE * 1024, 1024}; MoeOrder S{tab + 1, __builtin_amdgcn_readfirstlane(tab[0]), 4, F.G, F.blk};
            GEMM_CALL(FnBiasBf16, MoeOrder, g, S, (FnBiasBf16{wsp<bf16>(F, WS_XS), F.in[I_B2] + (size_t)layer * NE * 1024}));
             if (rep_ + 1 < NREP(16)) xcd_barrier(bar); } SEAM(pb + 10);
        }
        if (SITE(17) && IN(pb + 11)) { for (int rep_ = 0; rep_ < NREP(17); ++rep_) { ph_combine(F, layer);  if (rep_ + 1 < NREP(17)) xcd_barrier(bar); } SEAM(pb + 11); }
}
__global__ void __launch_bounds__(512, 2) fwd(Args args) {
    extern __shared__ __attribute__((aligned(16))) unsigned char lds_[];
    Frame F;
    F.lds = (LAS unsigned char*)lds_; F.tid = threadIdx.x; F.lane = F.tid & 63; F.wave = __builtin_amdgcn_readfirstlane(F.tid >> 6); F.blk = blockIdx.x; F.G = gridDim.x; F.probe = args.pad;
    F.ws = args.ws; F.out = args.out; F.ctl = (gu32*)(args.ws + WS_CTL);
    F.in.t = (LAS const unsigned*)(F.lds + MISC_OFF + 8192);
    if (F.tid < 64) ((LAS unsigned*)(F.lds + MISC_OFF))[F.tid] = 0u;
    if (F.tid < N_IN) { const unsigned long long pv = (unsigned long long)args.in[F.tid]; ((LAS unsigned*)(F.lds + MISC_OFF + 8192))[2 * F.tid] = (unsigned)pv; ((LAS unsigned*)(F.lds + MISC_OFF + 8192))[2 * F.tid + 1] = (unsigned)(pv >> 32); }
    __syncthreads();
    const int lo = args.ph_lo, hi = args.ph_hi;
    XcdBarrier bar; bar.bar = (unsigned*)(F.ctl + CW_BAR) + args.li * XCD_BAR_WORDS; bar.x = 0; bar.st = nullptr;
    if (hi - lo > 1) bar = xcd_barrier_post((unsigned*)(F.ctl + CW_BAR) + args.li * XCD_BAR_WORDS, (volatile LAS unsigned*)(F.lds + MISC_OFF));
    if (SITE(0) && IN(0)) { for (int rep_ = 0; rep_ < NREP(0); ++rep_) { p0a(F);  if (rep_ + 1 < NREP(0)) xcd_barrier(bar); } SEAM(0); }
    if (SITE(1) && IN(1)) { for (int rep_ = 0; rep_ < NREP(1); ++rep_) { p0b(F);  if (rep_ + 1 < NREP(1)) xcd_barrier(bar); } SEAM(1); }
    layer_phases<0>(F, bar, lo, hi);
    layer_phases<1>(F, bar, lo, hi);
}
#undef IN
#undef SEAM


extern "C" void kernel_launch(void* const* d_in, const int* in_sizes, int n_in, void* d_out, int out_size, void* d_ws, size_t ws_size, hipStream_t stream) {
    static int grid = 0;
    if (grid == 0) {
        const bool ok = n_in == N_IN && in_sizes[I_X] == NBATCH * SEQ * DM && in_sizes[I_RECW] == 1024 * REC_IN && in_sizes[I_ATTW] == 1024 * ATT_IN && in_sizes[I_MU] == RWKV_IN &&
                        in_sizes[I_GATEB] == 16 && in_sizes[I_W1] == 2 * NE * 1024 * 2048 && out_size == NBATCH * SEQ * DM && ws_size >= WS_END;
        if (!ok) { fprintf(stderr, "kernel_launch: shape mismatch (n_in %d, recw %d, attw %d, mu %d, out %d, ws %zu need %zu); nothing launched\n", n_in, n_in > I_RECW ? in_sizes[I_RECW] : -1,
                           n_in > I_ATTW ? in_sizes[I_ATTW] : -1, n_in > I_MU ? in_sizes[I_MU] : -1, out_size, ws_size, (size_t)WS_END); grid = -1; return; }
        int dev = 0, cus = 0;
        if (hipGetDevice(&dev) != hipSuccess || hipDeviceGetAttribute(&cus, hipDeviceAttributeMultiprocessorCount, dev) != hipSuccess) { grid = -1; return; }
        if (hipFuncSetAttribute((const void*)fwd, hipFuncAttributeMaxDynamicSharedMemorySize, LDS_BYTES) != hipSuccess) { fprintf(stderr, "kernel_launch: hipFuncSetAttribute failed\n"); grid = -1; return; }
        int per_cu = 0;
        if (hipOccupancyMaxActiveBlocksPerMultiprocessor(&per_cu, (const void*)fwd, 512, LDS_BYTES) != hipSuccess || per_cu < 1) { fprintf(stderr, "kernel_launch: occupancy query says %d blocks per CU\n", per_cu); }
        (void)hipGetLastError();
        grid = cus < 256 ? cus : 256;
        if (grid != 256) fprintf(stderr, "kernel_launch: %d CUs; this kernel is written for a 256-CU device\n", cus);
    }
    if (grid < 0) return;
    if (hipMemsetAsync((char*)d_ws + WS_CTL, 0, CTL_ZERO_BYTES, stream) != hipSuccess) return;
    Args a{};
    for (int i = 0; i < N_IN; ++i) a.in[i] = (const float*)d_in[i];
    a.out = (float*)d_out; a.ws = (unsigned char*)d_ws; a.pad = 0;
#if MK_PER_PHASE
    for (int ph = 0; ph < NPHASE; ++ph) { a.ph_lo = ph; a.ph_hi = ph + 1; a.li = 0; hipLaunchKernelGGL(fwd, dim3(grid), dim3(512), LDS_BYTES, stream, a); }
#elif defined(PROBE_LIST)
    { const int plist[] = {PROBE_LIST}; int cur = 0, li = 0;
      for (int p : plist) { a.ph_lo = cur; a.ph_hi = p + 1; a.li = li++; hipLaunchKernelGGL(fwd, dim3(grid), dim3(512), LDS_BYTES, stream, a);
                            a.ph_lo = p; a.ph_hi = p + 1; a.li = li++; a.pad = 1; hipLaunchKernelGGL(fwd, dim3(grid), dim3(512), LDS_BYTES, stream, a); a.pad = 0; cur = p + 1; }
      if (cur < NPHASE) { a.ph_lo = cur; a.ph_hi = NPHASE; a.li = li++; hipLaunchKernelGGL(fwd, dim3(grid), dim3(512), LDS_BYTES, stream, a); } }
#else
    a.ph_lo = 0; a.ph_hi = NPHASE; a.li = 0; hipLaunchKernelGGL(fwd, dim3(grid), dim3(512), LDS_BYTES, stream, a);
#endif
    const hipError_t le = hipPeekAtLastError();
    if (le != hipSuccess) fprintf(stderr, "kernel_launch: launch failed: %s\n", hipGetErrorName(le));
}
```

```cpp
#include <hip/hip_runtime.h>
#include <cstdio>
#include <cstdint>
#define MK_PER_PHASE 0
namespace pg8 {
#define PG8_LAS __attribute__((address_space(3)))
typedef unsigned short bf16_t;
typedef short bf16x8 __attribute__((ext_vector_type(8)));
typedef float f32x4 __attribute__((ext_vector_type(4)));
typedef unsigned u32x4 __attribute__((ext_vector_type(4)));
constexpr int BM = 256, BK = 64, HALF = 128, HTB = HALF * BK * 2  , STAGE_BYTES = 8 * HTB, NXCD = 8, WGM = 8;

__host__ __device__ __forceinline__ int lds_byte(int r, int c) { const int st = (r >> 4) * 2 + (c >> 5), rr = r & 15, cc = c & 31, ob = rr * 64 + cc * 2; return st * 1024 + (ob ^ (((ob >> 9) & 1) << 5)); }
__host__ __device__ __forceinline__ void stage_rc(int b, int& R, int& C) { const int st = b / 1024, sb = b % 1024, swz = sb ^ (((sb >> 9) & 1) << 5); R = (st >> 1) * 16 + swz / 64; C = (st & 1) * 32 + (swz % 64) / 2; }
__host__ __device__ __forceinline__ int perm32(int rho) { const int n = rho >> 4, i = rho & 15; return 8 * (i >> 2) + 4 * n + (i & 3); }

struct Unit { int pm, pn; };
struct Gemm { const bf16_t* A; const bf16_t* Bt; int M, N, K; };

struct StaticOrder {
    int nM, nN, nwg, G, c;
    __host__ __device__ void init(int M, int N, int G_, int c_) { nM = M / BM; nN = N / BM; nwg = nM * nN; G = G_; c = c_; }
    __host__ __device__ bool next(int i, Unit& u) const {
        const long L = (long)i * G + c; if (L >= nwg) return false;
        int wgid = (int)L; { const int q = nwg / NXCD, r = nwg % NXCD, xcd = wgid % NXCD, off = wgid / NXCD; wgid = (xcd < r ? xcd * (q + 1) : r * (q + 1) + (xcd - r) * q) + off; }
        const int nig = WGM * nN, gid = wgid / nig, fm = gid * WGM, gsz = (nM - fm) < WGM ? (nM - fm) : WGM;
        u.pm = fm + ((wgid % nig) % gsz); u.pn = (wgid % nig) / gsz; return true;
    }
    __device__ __forceinline__ void a_ready(const Unit&) const {}
    __device__ __forceinline__ void done(const Unit&) const {}
};

__device__ __forceinline__ unsigned cvt_pk_bf16(float lo, float hi) { unsigned r; asm volatile("v_cvt_pk_bf16_f32 %0, %1, %2" : "=v"(r) : "v"(lo), "v"(hi)); return r; }
template <class Fn> struct EpiGen {
    static constexpr bool PERM = true, AFTER_DRAIN = false;
    Fn fn;
    __device__ __forceinline__ void operator()(const f32x4 (&acc)[2][2][4][2], const Unit& u, int wr, int wc, int fr, int fq) const {
#pragma unroll
        for (int ai = 0; ai < 2; ++ai)
#pragma unroll
            for (int m = 0; m < 4; ++m) { const int row = u.pm * BM + ai * HALF + wr * 64 + m * 16 + fr;
#pragma unroll
                for (int bj = 0; bj < 2; ++bj) { const int col = u.pn * BM + bj * HALF + wc * 32 + 8 * fq; fn(row, col, acc[ai][bj][m][0], acc[ai][bj][m][1]); } }
    }
};
template <class Epi, class Sched, bool ALIGN_EPI = false, bool SP2 = false>
__device__ __forceinline__ void gemm_phase(PG8_LAS unsigned char* lds, const Gemm g, const Sched& S, const Epi& E) {
    const int tid = threadIdx.x, wid = __builtin_amdgcn_readfirstlane(tid >> 6), lane = tid & 63, wr = wid >> 2, wc = wid & 3, fr = lane & 15, fq = lane >> 4;
    const int K = g.K, nt = K / BK;
    unsigned voffA[2], voffB[2];
#pragma unroll
    for (int i = 0; i < 2; ++i) { int R, C; stage_rc(tid * 16 + i * 8192, R, C); const int Rb = Epi::PERM ? ((R & ~31) + perm32(R & 31)) : R;
        voffA[i] = (unsigned)(R * K + C) * 2u; voffB[i] = (unsigned)(Rb * K + C) * 2u; }
    const size_t kstep = (size_t)(BK * 2);
    const size_t hstep = (size_t)HALF * K * 2;
    const size_t tstep = 2 * hstep;
    const unsigned ldsw = (unsigned)wid * 1024u;
    const int aoff = lds_byte(wr * 64 + fr, fq * 8), boff = lds_byte(wc * 32 + fr, fq * 8);
#define PG8_SA(b, h) (((b) * 2 + (h)) * HTB)
#define PG8_SB(b, h) ((4 + (b) * 2 + (h)) * HTB)
#define PG8_STAGE(bufoff, gbase, voff) do { _Pragma("unroll") for (int _i = 0; _i < 2; ++_i) \
        __builtin_amdgcn_global_load_lds((const unsigned*)((const char*)(gbase) + (voff)[_i]), (PG8_LAS unsigned*)(lds + (bufoff) + ldsw + _i * 8192), 16, 0, 0); } while (0)
#define PG8_LDA(dst, b, h) do { _Pragma("unroll") for (int m = 0; m < 4; ++m) _Pragma("unroll") for (int k = 0; k < 2; ++k) dst[m][k] = *(const PG8_LAS bf16x8*)(lds + PG8_SA(b, h) + aoff + m * 2048 + k * 1024); } while (0)
#define PG8_LDB(dst, b, h) do { _Pragma("unroll") for (int n = 0; n < 2; ++n) _Pragma("unroll") for (int k = 0; k < 2; ++k) dst[n][k] = *(const PG8_LAS bf16x8*)(lds + PG8_SB(b, h) + boff + n * 2048 + k * 1024); } while (0)
#define PG8_MMA(ai, bj, At, Bt) do { __builtin_amdgcn_s_setprio(1); _Pragma("unroll") for (int m = 0; m < 4; ++m) _Pragma("unroll") for (int n = 0; n < 2; ++n) _Pragma("unroll") for (int k = 0; k < 2; ++k) \
        acc[ai][bj][m][n] = __builtin_amdgcn_mfma_f32_16x16x32_bf16(Bt[n][k], At[m][k], acc[ai][bj][m][n], 0, 0, 0); __builtin_amdgcn_s_setprio(0); } while (0)
#define PG8_WAIT_V(n) asm volatile("s_waitcnt vmcnt(" #n ")" ::: "memory")
#define PG8_WAIT_L(n) asm volatile("s_waitcnt lgkmcnt(" #n ")" ::: "memory")
#define PG8_BAR __builtin_amdgcn_s_barrier()
#define PG8_SCHED __builtin_amdgcn_sched_barrier(0)
    Unit cur, nxt; int ui = 0;
    if (!S.next(0, cur)) return;
    f32x4 acc[2][2][4][2];
#pragma unroll
    for (int a = 0; a < 2; ++a)
#pragma unroll
        for (int b = 0; b < 2; ++b)
#pragma unroll
            for (int m = 0; m < 4; ++m)
#pragma unroll
                for (int n = 0; n < 2; ++n) acc[a][b][m][n] = (f32x4){0.f, 0.f, 0.f, 0.f};
    bf16x8 At[4][2], B0[2][2], B1[2][2];
    const char* cA = (const char*)g.A + (size_t)cur.pm * tstep; const char* cB = (const char*)g.Bt + (size_t)cur.pn * tstep;
    S.a_ready(cur);
    if constexpr (SP2) {
        PG8_STAGE(PG8_SB(0, 0), cB, voffB); PG8_STAGE(PG8_SB(0, 1), cB + hstep, voffB); PG8_STAGE(PG8_SA(0, 0), cA, voffA); PG8_STAGE(PG8_SA(0, 1), cA + hstep, voffA);
        if (wr == 1) PG8_BAR;
        PG8_WAIT_V(2); PG8_BAR;
        PG8_STAGE(PG8_SB(1, 0), cB + kstep, voffB); PG8_STAGE(PG8_SA(1, 0), cA + kstep, voffA); PG8_STAGE(PG8_SB(1, 1), cB + hstep + kstep, voffB);
        PG8_WAIT_V(6); PG8_BAR;
    } else {
        PG8_STAGE(PG8_SB(0, 0), cB, voffB); PG8_STAGE(PG8_SA(0, 0), cA, voffA); PG8_STAGE(PG8_SB(0, 1), cB + hstep, voffB); PG8_STAGE(PG8_SA(0, 1), cA + hstep, voffA);
        if (wr == 1) PG8_BAR;
        PG8_WAIT_V(4); PG8_BAR;
        PG8_STAGE(PG8_SB(1, 0), cB + kstep, voffB); PG8_STAGE(PG8_SA(1, 0), cA + kstep, voffA); PG8_STAGE(PG8_SB(1, 1), cB + hstep + kstep, voffB);
        PG8_WAIT_V(6); PG8_BAR;
    }
    for (;;) {
        const bool has_next = S.next(ui + 1, nxt);
        const char* nA = has_next ? (const char*)g.A + (size_t)nxt.pm * tstep : cA; const char* nB = has_next ? (const char*)g.Bt + (size_t)nxt.pn * tstep : cB;
        for (int t = 0; t < nt; t += 2) {
            const bool last = (t == nt - 2);
            const char* a1 = cA + (size_t)(t + 1) * kstep;
            const char* a2 = last ? nA : cA + (size_t)(t + 2) * kstep; const char* b2 = last ? nB : cB + (size_t)(t + 2) * kstep;
            const char* a3 = a2 + kstep; const char* b3 = b2 + kstep;
            if (last && has_next) S.a_ready(nxt);
            if constexpr (SP2) {
            PG8_LDB(B0, 0, 0); PG8_LDB(B1, 0, 1); PG8_SCHED; PG8_LDA(At, 0, 0); PG8_STAGE(PG8_SA(1, 1), a1 + hstep, voffA);
            PG8_WAIT_V(8); PG8_WAIT_L(0); PG8_BAR; PG8_MMA(0, 0, At, B0); PG8_MMA(0, 1, At, B1); PG8_BAR; PG8_SCHED;
            PG8_LDA(At, 0, 1); PG8_STAGE(PG8_SB(0, 0), b2, voffB); PG8_STAGE(PG8_SB(0, 1), b2 + hstep, voffB); PG8_STAGE(PG8_SA(0, 0), a2, voffA);
            PG8_WAIT_V(8); PG8_WAIT_L(0); PG8_BAR; PG8_MMA(1, 0, At, B0); PG8_MMA(1, 1, At, B1); PG8_BAR; PG8_SCHED;
            PG8_LDB(B0, 1, 0); PG8_LDB(B1, 1, 1); PG8_SCHED; PG8_LDA(At, 1, 0); PG8_STAGE(PG8_SA(0, 1), a2 + hstep, voffA);
            PG8_WAIT_V(8); PG8_WAIT_L(0); PG8_BAR; PG8_MMA(0, 0, At, B0); PG8_MMA(0, 1, At, B1); PG8_BAR; PG8_SCHED;
            PG8_LDA(At, 1, 1); PG8_STAGE(PG8_SB(1, 0), b3, voffB); PG8_STAGE(PG8_SB(1, 1), b3 + hstep, voffB); PG8_STAGE(PG8_SA(1, 0), a3, voffA);
            PG8_WAIT_V(8); PG8_WAIT_L(0); PG8_BAR; PG8_MMA(1, 0, At, B0); PG8_MMA(1, 1, At, B1); PG8_BAR; PG8_SCHED;
            } else {
            PG8_LDB(B0, 0, 0); PG8_SCHED; PG8_LDA(At, 0, 0); PG8_STAGE(PG8_SA(1, 1), a1 + hstep, voffA);
            PG8_WAIT_L(8); PG8_BAR; PG8_WAIT_L(0); PG8_MMA(0, 0, At, B0); PG8_BAR; PG8_SCHED;
            PG8_LDB(B1, 0, 1); PG8_STAGE(PG8_SB(0, 0), b2, voffB);
            PG8_BAR; PG8_WAIT_L(0); PG8_MMA(0, 1, At, B1); PG8_BAR;
            PG8_LDA(At, 0, 1); PG8_STAGE(PG8_SA(0, 0), a2, voffA);
            PG8_BAR; PG8_WAIT_L(0); PG8_MMA(1, 0, At, B0); PG8_BAR; PG8_SCHED;
            PG8_STAGE(PG8_SB(0, 1), b2 + hstep, voffB);
            PG8_WAIT_V(6); PG8_BAR; PG8_MMA(1, 1, At, B1); PG8_BAR;
            PG8_LDB(B0, 1, 0); PG8_SCHED; PG8_LDA(At, 1, 0); PG8_STAGE(PG8_SA(0, 1), a2 + hstep, voffA);
            PG8_WAIT_L(8); PG8_BAR; PG8_WAIT_L(0); PG8_MMA(0, 0, At, B0); PG8_BAR; PG8_SCHED;
            PG8_LDB(B1, 1, 1); PG8_STAGE(PG8_SB(1, 0), b3, voffB);
            PG8_BAR; PG8_WAIT_L(0); PG8_MMA(0, 1, At, B1); PG8_BAR;
            PG8_LDA(At, 1, 1); PG8_STAGE(PG8_SA(1, 0), a3, voffA);
            PG8_BAR; PG8_WAIT_L(0); PG8_MMA(1, 0, At, B0); PG8_BAR; PG8_SCHED;
            PG8_STAGE(PG8_SB(1, 1), b3 + hstep, voffB);
            PG8_WAIT_V(6); PG8_BAR; PG8_MMA(1, 1, At, B1); PG8_BAR;
            }
        }
        if constexpr (ALIGN_EPI) { if (wr == 0) PG8_BAR; }
        if constexpr (!Epi::AFTER_DRAIN) { E(acc, cur, wr, wc, fr, fq); S.done(cur); }
        if (!has_next) break;
#pragma unroll
        for (int a = 0; a < 2; ++a)
#pragma unroll
            for (int b = 0; b < 2; ++b)
#pragma unroll
                for (int m = 0; m < 4; ++m)
#pragma unroll
                    for (int n = 0; n < 2; ++n) acc[a][b][m][n] = (f32x4){0.f, 0.f, 0.f, 0.f};
        cur = nxt; cA = nA; cB = nB; ++ui;
        if constexpr (ALIGN_EPI) { if (wr == 1) PG8_BAR; }
    }
    PG8_WAIT_V(0);
    if constexpr (!ALIGN_EPI) { if (wr == 0) PG8_BAR; }
    PG8_BAR;
    if constexpr (Epi::AFTER_DRAIN) { E.fused(acc, cur, wr, wc, fr, fq, lds, wid, lane); S.done(cur); }
#undef PG8_SA
#undef PG8_SB
#undef PG8_STAGE
#undef PG8_LDA
#undef PG8_LDB
#undef PG8_MMA
#undef PG8_WAIT_V
#undef PG8_WAIT_L
#undef PG8_BAR
#undef PG8_SCHED
}
}
#define GAS __attribute__((address_space(1)))
#define LAS __attribute__((address_space(3)))
typedef unsigned short bf16;
typedef unsigned v4u __attribute__((ext_vector_type(4)));
typedef unsigned v2u __attribute__((ext_vector_type(2)));
typedef float f32x4 __attribute__((ext_vector_type(4)));
typedef short bf16x8 __attribute__((ext_vector_type(8)));
typedef GAS unsigned gu32;
typedef GAS unsigned long long gu64;
#define RLX_AGENT __ATOMIC_RELAXED, __HIP_MEMORY_SCOPE_AGENT
#define LDS_WAIT() asm volatile("s_waitcnt lgkmcnt(0)" ::: "memory")
#define VM_WAIT() asm volatile("s_waitcnt vmcnt(0)" ::: "memory")
typedef float f32x2_cv __attribute__((ext_vector_type(2)));
typedef __bf16 bf16x2_cv __attribute__((ext_vector_type(2)));
__device__ __forceinline__ unsigned pk2(float lo, float hi) { const f32x2_cv v = {lo, hi}; return __builtin_bit_cast(unsigned, __builtin_convertvector(v, bf16x2_cv)); }
__device__ __forceinline__ unsigned f2bf(float f) { return (unsigned)__builtin_bit_cast(unsigned short, (__bf16)f); }
__device__ __forceinline__ float bflo(unsigned w) { return __builtin_bit_cast(float, w << 16); }
__device__ __forceinline__ float bfhi(unsigned w) { return __builtin_bit_cast(float, w & 0xffff0000u); }
__device__ __forceinline__ float bf2f(bf16 b) { return __builtin_bit_cast(float, (unsigned)b << 16); }
__device__ __forceinline__ float wave_sum(float v) {
#pragma unroll
    for (int o = 1; o < 64; o <<= 1) v += __shfl_xor(v, o);
    return v;
}
__device__ __forceinline__ float sigmoidf_(float x) { return 1.f / (1.f + __expf(-x)); }

#define XB_TMO      128
#define XB_XCNT(j)  (256  + 64 * (j))
#define XB_XSUB(j)  (1280 + 64 * (j))
#define XB_XGEN(j)  (2304 + 64 * (j))
#define XB_TOP      3328
#define XB_TOPGEN   3392
#define XCD_BAR_WORDS 3456
#define XB_SPIN_CAP (1u << 22)

__device__ __forceinline__ unsigned xb_ld(unsigned* p)              { return __hip_atomic_load(p, __ATOMIC_RELAXED, __HIP_MEMORY_SCOPE_AGENT); }
__device__ __forceinline__ unsigned xb_add(unsigned* p, unsigned v) { return __hip_atomic_fetch_add(p, v, __ATOMIC_RELAXED, __HIP_MEMORY_SCOPE_AGENT); }
__device__ __forceinline__ unsigned xb_xcc_id() { return (unsigned)__builtin_amdgcn_s_getreg((3 << 11) | 20) & 0xFu; }
#define XB_SPIN(cond, bar) do { unsigned _sp = 0; while (cond) { __builtin_amdgcn_s_sleep(1); \
    if ((++_sp & 255u) == 0u) { if (xb_ld(&(bar)[XB_TMO])) break; if (_sp > XB_SPIN_CAP) { atomicAdd(&(bar)[XB_TMO], 1u); break; } } } } while (0)

struct XcdBarrier {
    unsigned* bar; unsigned x;
    volatile LAS unsigned* st;
};

__device__ __forceinline__ XcdBarrier xcd_barrier_post(unsigned* bar, volatile LAS unsigned* st) {
    XcdBarrier b; b.bar = bar; b.x = xb_xcc_id(); b.st = st;
    if (threadIdx.x == 0) (void)xb_add(&bar[XB_XCNT(b.x)], 1u);
    return b;
}
__device__ __forceinline__ void xcd_barrier_complete(unsigned* bar, unsigned x, unsigned& nloc, unsigned& nx) {
    const unsigned G = gridDim.x * gridDim.y * gridDim.z;
    unsigned sum, cnt, mine, sp = 0u;
    for (;;) {
        sum = 0u; cnt = 0u; mine = 0u;
#pragma unroll
        for (unsigned j = 0; j < 16; ++j) { const unsigned c = xb_ld(&bar[XB_XCNT(j)]); sum += c; cnt += (c > 0u) ? 1u : 0u; mine = (j == x) ? c : mine; }
        if (sum == G) break;
        __builtin_amdgcn_s_sleep(1);
        if ((++sp & 255u) == 0u) { if (xb_ld(&bar[XB_TMO])) break; if (sp > XB_SPIN_CAP) { atomicAdd(&bar[XB_TMO], 1u); break; } }
    }
    nloc = mine > 0u ? mine : 1u; nx = cnt > 0u ? cnt : 1u;
}

__device__ __forceinline__ void xcd_barrier(const XcdBarrier& b) {
    asm volatile("s_waitcnt vmcnt(0)" ::: "memory");
    __syncthreads();
    if (threadIdx.x == 0) {
        unsigned* bar = b.bar;
        __builtin_amdgcn_s_waitcnt(0);
        unsigned nloc = b.st[0], nx = b.st[1];
        if (nloc == 0u) { xcd_barrier_complete(bar, b.x, nloc, nx); b.st[0] = nloc; b.st[1] = nx; }
        const unsigned old = xb_add(&bar[XB_XSUB(b.x)], 1u);
        const unsigned gen = old / nloc;
        if (old + 1u == (gen + 1u) * nloc) {
            __builtin_amdgcn_fence(__ATOMIC_RELEASE, "agent");
            asm volatile("s_waitcnt vmcnt(0)" ::: "memory");
            const unsigned og = xb_add(&bar[XB_TOP], 1u);
            const unsigned tg = og / nx;
            if (og + 1u == (tg + 1u) * nx) xb_add(&bar[XB_TOPGEN], 1u);
            else XB_SPIN(xb_ld(&bar[XB_TOPGEN]) == tg, bar);
            __builtin_amdgcn_fence(__ATOMIC_ACQUIRE, "agent");
            xb_add(&bar[XB_XGEN(b.x)], 1u);
            asm volatile("s_waitcnt vmcnt(0)" ::: "memory");
        } else {
            XB_SPIN(xb_ld(&bar[XB_XGEN(b.x)]) == gen, bar);
            __builtin_amdgcn_fence(__ATOMIC_ACQUIRE, "agent");
            asm volatile("s_waitcnt vmcnt(0)" ::: "memory");
        }
    }
    __syncthreads();
}
namespace att {
using s16x4  = __attribute__((ext_vector_type(4))) short;
using f32x16 = __attribute__((ext_vector_type(16))) float;
using u32x4  = __attribute__((ext_vector_type(4))) unsigned;
#define ATT_SBAR() __builtin_amdgcn_sched_barrier(0)
constexpr float THR2 = 11.5f;
__device__ __forceinline__ int crow(int r, int hi) { return (r & 3) + 8 * (r >> 2) + 4 * hi; }
__device__ __forceinline__ unsigned cvtpk(float lo, float hi) { unsigned r; asm volatile("v_cvt_pk_bf16_f32 %0, %1, %2" : "=v"(r) : "v"(lo), "v"(hi)); return r; }

__device__ __forceinline__ void partialSM(f32x16& p0, f32x16& p1, float& m_reg, float& mn, float& alpha) {
  float pmax = p0[0];
#pragma unroll
  for (int r = 1; r < 16; ++r) pmax = fmaxf(pmax, p0[r]);
#pragma unroll
  for (int r = 0; r < 16; ++r) pmax = fmaxf(pmax, p1[r]);
  { auto rr = __builtin_amdgcn_permlane32_swap(__float_as_uint(pmax), __float_as_uint(pmax), false, false);
    pmax = fmaxf(__uint_as_float(rr[0]), __uint_as_float(rr[1])); }
  if (__builtin_expect(__all(pmax - m_reg <= THR2), 1)) { mn = m_reg; alpha = 1.f; }
  else { mn = fmaxf(m_reg, pmax); alpha = __builtin_amdgcn_exp2f(m_reg - mn); m_reg = mn; }
#pragma unroll
  for (int r = 0; r < 16; ++r) p0[r] = p0[r] - mn;
#pragma unroll
  for (int r = 0; r < 16; ++r) p1[r] = p1[r] - mn;
#pragma unroll
  for (int r = 0; r < 16; ++r) p0[r] = __builtin_amdgcn_exp2f(p0[r]);
}
__device__ __forceinline__ void finishSM(f32x16& p0, f32x16& p1, bf16x8& pa0, bf16x8& pa1, bf16x8& pa2, bf16x8& pa3) {
#pragma unroll
  for (int r = 0; r < 16; ++r) p1[r] = __builtin_amdgcn_exp2f(p1[r]);
#define ATT_PK4(P, BASE, OUT) do { unsigned a0 = cvtpk(P[BASE + 0], P[BASE + 1]), a1 = cvtpk(P[BASE + 2], P[BASE + 3]);   \
    unsigned b0 = cvtpk(P[BASE + 4], P[BASE + 5]), b1 = cvtpk(P[BASE + 6], P[BASE + 7]);                              \
    auto r0 = __builtin_amdgcn_permlane32_swap(a0, b0, false, false); auto r1 = __builtin_amdgcn_permlane32_swap(a1, b1, false, false); \
    u32x4 w = {r0[0], r1[0], r0[1], r1[1]}; OUT = *reinterpret_cast<bf16x8*>(&w); } while (0)
  ATT_PK4(p0, 0, pa0); ATT_PK4(p0, 8, pa1); ATT_PK4(p1, 0, pa2); ATT_PK4(p1, 8, pa3);
#undef ATT_PK4
}
template <int NB> __device__ __forceinline__ int v_st(int k, int c) { const int kk = (k & ~0xC) | ((k & 4) << 1) | ((k & 8) >> 1); return ((kk >> 3) * NB + (c >> 5)) * 512 + ((kk & 7) * 32 + (c & 31)) * 2; }
__device__ __forceinline__ int v_rd_base(int lane) { return ((lane & 3) << 3) | (((lane >> 2) & 3) << 6) | (((lane >> 4) & 1) << 5) | (((lane >> 5) & 1) << 8); }
template <int OFF> __device__ __forceinline__ s16x4 tr_read(int vb) {
  s16x4 r; asm volatile("ds_read_b64_tr_b16 %0, %1 offset:%2" : "=&v"(r) : "v"(vb), "i"(OFF) : "memory"); return r;
}
template <int NB, int D0> __device__ __forceinline__ void pv_one(f32x16& od, int vb, bf16x8 pa0, bf16x8 pa1, bf16x8 pa2, bf16x8 pa3) {
#define ATT_VOFF(ks, half) (D0 * 512 + (ks) * (NB * 1024) + (half) * (NB * 512))
  const s16x4 l0 = tr_read<ATT_VOFF(0, 0)>(vb), h0 = tr_read<ATT_VOFF(0, 1)>(vb), l1 = tr_read<ATT_VOFF(1, 0)>(vb), h1 = tr_read<ATT_VOFF(1, 1)>(vb);
  const s16x4 l2 = tr_read<ATT_VOFF(2, 0)>(vb), h2 = tr_read<ATT_VOFF(2, 1)>(vb), l3 = tr_read<ATT_VOFF(3, 0)>(vb), h3 = tr_read<ATT_VOFF(3, 1)>(vb);
#undef ATT_VOFF
  asm volatile("s_waitcnt lgkmcnt(0)" ::: "memory"); ATT_SBAR();
#define ATT_PK(L, H) (bf16x8){L[0], L[1], L[2], L[3], H[0], H[1], H[2], H[3]}
  od = __builtin_amdgcn_mfma_f32_32x32x16_bf16(pa0, ATT_PK(l0, h0), od, 0, 0, 0);
  od = __builtin_amdgcn_mfma_f32_32x32x16_bf16(pa1, ATT_PK(l1, h1), od, 0, 0, 0);
  od = __builtin_amdgcn_mfma_f32_32x32x16_bf16(pa2, ATT_PK(l2, h2), od, 0, 0, 0);
  od = __builtin_amdgcn_mfma_f32_32x32x16_bf16(pa3, ATT_PK(l3, h3), od, 0, 0, 0);
#undef ATT_PK
}
template <int NB> __device__ __forceinline__ void pv_all(f32x16* o, f32x16& lsum, int vb, bf16x8 pa0, bf16x8 pa1, bf16x8 pa2, bf16x8 pa3) {
  const bf16x8 ones = {0x3F80, 0x3F80, 0x3F80, 0x3F80, 0x3F80, 0x3F80, 0x3F80, 0x3F80};
  lsum = __builtin_amdgcn_mfma_f32_32x32x16_bf16(pa0, ones, lsum, 0, 0, 0); lsum = __builtin_amdgcn_mfma_f32_32x32x16_bf16(pa1, ones, lsum, 0, 0, 0);
  pv_one<NB, 0>(o[0], vb, pa0, pa1, pa2, pa3); pv_one<NB, 1>(o[1], vb, pa0, pa1, pa2, pa3);
  lsum = __builtin_amdgcn_mfma_f32_32x32x16_bf16(pa2, ones, lsum, 0, 0, 0); lsum = __builtin_amdgcn_mfma_f32_32x32x16_bf16(pa3, ones, lsum, 0, 0, 0);
  if constexpr (NB == 4) { pv_one<NB, 2>(o[2], vb, pa0, pa1, pa2, pa3); pv_one<NB, 3>(o[3], vb, pa0, pa1, pa2, pa3); }
}
template <int DK> __device__ __forceinline__ void qkt(f32x16& p0, f32x16& p1, LAS const char* Ks, const bf16x8* qr, int r32, int hi) {
  constexpr int KSTR = DK * 2 + 16;
  p0 = f32x16{}; p1 = f32x16{};
#pragma unroll
  for (int d0 = 0; d0 < DK / 16; ++d0) { const int cb = (d0 * 16 + hi * 8) * 2;
    const bf16x8 b0 = *(LAS const bf16x8*)(Ks + r32 * KSTR + cb);
    const bf16x8 b1 = *(LAS const bf16x8*)(Ks + (32 + r32) * KSTR + cb);
    p0 = __builtin_amdgcn_mfma_f32_32x32x16_bf16(b0, qr[d0], p0, 0, 0, 0);
    p1 = __builtin_amdgcn_mfma_f32_32x32x16_bf16(b1, qr[d0], p1, 0, 0, 0); }
}
template <int DK, int DV> struct Cfg {
  static constexpr int KSTR = DK * 2 + 16, KT = 64 * KSTR, NB = DV / 32, VT = 64 * DV * 2, NQ = DK / 16;
  static constexpr int NKC = DK / 8, NVC = DV / 8;
  static constexpr int KN = (64 * NKC + 511) / 512, VN = (64 * NVC + 511) / 512;
  static constexpr int OFF_V = 0, OFF_K = 2 * VT, OFF_WS = 2 * VT + 2 * KT, LDS_BYTES = OFF_WS + 8 * 64 * 4;
};
template <int DK, int DV>
__device__ __forceinline__ void attn_unit(const bf16* __restrict__ Qb, int ldq, const bf16* __restrict__ K1, int ldk1, const bf16* __restrict__ K2, int ldk2,
                                          const bf16* __restrict__ Vh, int ldv, float* __restrict__ Ob, int ldo, int nkeys, LAS char* lds) {
  using C = Cfg<DK, DV>;
  const int tid = threadIdx.x, wid = tid >> 6, lane = tid & 63, r32 = lane & 31, hi = lane >> 5;
  LAS char* V_lds = lds + C::OFF_V; LAS char* K_lds = lds + C::OFF_K;
  LAS float* ws = (LAS float*)(lds + C::OFF_WS) + wid * 64; LAS float* li_l = ws; LAS float* al_l = ws + 32;
  float m_reg = -1e30f; f32x16 o[C::NB] = {}; f32x16 lsum = {}; bf16x8 qr[C::NQ];
  { const bf16* Qw = Qb + (long)(wid * 32 + r32) * ldq + hi * 8;
#pragma unroll
    for (int d0 = 0; d0 < C::NQ; ++d0) qr[d0] = *(const bf16x8*)(Qw + d0 * 16); }
  unsigned kg[C::KN], kw[C::KN], vg[C::VN], vw[C::VN]; const bool k2val = tid < 256;
  kg[0] = (unsigned)((tid >> 3) * ldk1 + (tid & 7) * 8); kw[0] = (unsigned)((tid >> 3) * C::KSTR + (tid & 7) * 16);
  if constexpr (C::KN == 2) { const int t2 = tid & 255; kg[1] = (unsigned)((t2 >> 2) * ldk2 + (t2 & 3) * 8); kw[1] = (unsigned)((t2 >> 2) * C::KSTR + (8 + (t2 & 3)) * 16); }
#pragma unroll
  for (int i = 0; i < C::VN; ++i) { const int it = tid + 512 * i, vrow = it / C::NVC, vcol = (it % C::NVC) * 8; vg[i] = (unsigned)(vrow * ldv + vcol); vw[i] = (unsigned)v_st<C::NB>(vrow, vcol); }
  const int vb0 = (int)(uintptr_t)V_lds + v_rd_base(lane);
  struct Slot { bf16x8 ks[C::KN], vs[C::VN]; } sA, sB;
#define ATT_SLOAD(S, k0) do { S.ks[0] = *(const bf16x8*)(K1 + (size_t)(k0) * ldk1 + kg[0]); if constexpr (C::KN == 2) S.ks[1] = *(const bf16x8*)(K2 + (size_t)(k0) * ldk2 + kg[1]); \
    _Pragma("unroll") for (int i = 0; i < C::VN; ++i) S.vs[i] = *(const bf16x8*)(Vh + (size_t)(k0) * ldv + vg[i]); } while (0)
#define ATT_SWRITE(b, S) do { *(LAS bf16x8*)(K_lds + (b) * C::KT + kw[0]) = S.ks[0]; if constexpr (C::KN == 2) { if (k2val) *(LAS bf16x8*)(K_lds + (b) * C::KT + kw[1]) = S.ks[1]; } \
    _Pragma("unroll") for (int i = 0; i < C::VN; ++i) *(LAS bf16x8*)(V_lds + (b) * C::VT + vw[i]) = S.vs[i]; } while (0)
#define ATT_SWAIT() asm volatile("s_waitcnt vmcnt(3)" ::: "memory")
#define ATT_RESC(a) do { if (__any((a) < 1.f)) { if (hi == 0) al_l[r32] = (a); asm volatile("s_waitcnt lgkmcnt(0)" ::: "memory"); \
    _Pragma("unroll") for (int r = 0; r < 16; ++r) { const float f_ = al_l[crow(r, hi)]; lsum[r] *= f_; _Pragma("unroll") for (int d = 0; d < C::NB; ++d) o[d][r] *= f_; } } } while (0)
  static_assert(C::KN + C::VN == 3, "three staging loads per thread per tile (ATT_SWAIT)");
  f32x16 pA0, pA1, pB0, pB1; float mnA, mnB, alA, alB; bf16x8 pa0, pa1, pa2, pa3; const int NT = nkeys / 64;
  __syncthreads();
  ATT_SLOAD(sA, 0); asm volatile("s_waitcnt vmcnt(0)" ::: "memory"); ATT_SWRITE(0, sA); __syncthreads();
  qkt<DK>(pA0, pA1, K_lds, qr, r32, hi); partialSM(pA0, pA1, m_reg, mnA, alA);
  ATT_SLOAD(sB, 64); if (2 < NT) ATT_SLOAD(sA, 128);
  ATT_SWAIT(); ATT_SWRITE(1, sB); __syncthreads();
  for (int j = 1; j + 1 < NT; j += 2) {
    ATT_SBAR(); qkt<DK>(pB0, pB1, K_lds + C::KT, qr, r32, hi);
    finishSM(pA0, pA1, pa0, pa1, pa2, pa3); ATT_SBAR();
    ATT_SLOAD(sB, (j + 2) * 64); ATT_SBAR();
    pv_all<C::NB>(o, lsum, vb0, pa0, pa1, pa2, pa3); partialSM(pB0, pB1, m_reg, mnB, alB);
    __syncthreads(); ATT_SWAIT(); ATT_SWRITE(0, sA);
    ATT_RESC(alB); __syncthreads();
    ATT_SBAR(); qkt<DK>(pA0, pA1, K_lds, qr, r32, hi);
    finishSM(pB0, pB1, pa0, pa1, pa2, pa3); ATT_SBAR();
    if (j + 3 < NT) ATT_SLOAD(sA, (j + 3) * 64); ATT_SBAR();
    pv_all<C::NB>(o, lsum, vb0 + C::VT, pa0, pa1, pa2, pa3); partialSM(pA0, pA1, m_reg, mnA, alA);
    __syncthreads(); ATT_SWAIT(); ATT_SWRITE(1, sB);
    ATT_RESC(alA); __syncthreads();
  }
  ATT_SBAR(); qkt<DK>(pB0, pB1, K_lds + C::KT, qr, r32, hi);
  finishSM(pA0, pA1, pa0, pa1, pa2, pa3); ATT_SBAR();
  pv_all<C::NB>(o, lsum, vb0, pa0, pa1, pa2, pa3); partialSM(pB0, pB1, m_reg, mnB, alB);
  __syncthreads(); ATT_RESC(alB);
  finishSM(pB0, pB1, pa0, pa1, pa2, pa3); ATT_SBAR();
  pv_all<C::NB>(o, lsum, vb0 + C::VT, pa0, pa1, pa2, pa3);
  float rli[16];
#pragma unroll
  for (int r = 0; r < 16; ++r) rli[r] = __builtin_amdgcn_rcpf(lsum[r]);
  float* Ow = Ob + (long)(wid * 32) * ldo;
#pragma unroll
  for (int r = 0; r < 16; ++r) { const int orow = crow(r, hi);
#pragma unroll
    for (int d0 = 0; d0 < C::NB; ++d0) Ow[(long)orow * ldo + d0 * 32 + r32] = o[d0][r] * rli[r]; }
#undef ATT_SLOAD
#undef ATT_SWRITE
#undef ATT_SWAIT
#undef ATT_RESC
}
}
constexpr int DM = 1024, NBATCH = 2, SEQ = 16384, CT = 256, TB = SEQ + CT  , R = NBATCH * TB  ;
constexpr int ATT_IN = 2208, ATT_NP = 2304, REC_IN = 3472, REC_NP = 3584, RWKV_IN = 1920;
constexpr int NE = 32, TOPK = 4, MAXT = R * TOPK / 256 + NE  , MAXROWS = MAXT * 256;
constexpr int NUNIT_M = 16 * 260;
constexpr float NORM_EPS = 1e-6f;
enum { I_X = 0, I_C, I_CTX, I_CCTX, I_NMIX, I_NFFN, I_ADAW, I_ADAB, I_WOUT, I_RW, I_RB, I_W1, I_B1, I_W2, I_B2, I_ATTW, I_LAM, I_SUBLN, I_QNW, I_KVNW, I_WUQ, I_WUKV,
       I_RECW, I_MU, I_W0, I_RW2, I_A0, I_A2, I_G2, I_KK, I_KA, I_RK, I_LNW, I_LNB, I_GATEB, I_MNW, I_FNW, N_IN };
constexpr size_t al256(size_t x) { return (x + 255) & ~(size_t)255; }
constexpr size_t WS_CTL = 0, CTL_ZERO_BYTES = 1u << 20;
constexpr size_t WS_MOD = CTL_ZERO_BYTES;
constexpr size_t WS_ROPE = al256(WS_MOD + 2 * 3 * 6144 * 4);
constexpr size_t ROPE_DR = 0, ROPE_DC = 256 * 16 * 2, ROPE_MR = ROPE_DC + 64 * 16 * 2, ROPE_MC = ROPE_MR + 256 * 8 * 2, ROPE_FLOATS = ROPE_MC + 64 * 8 * 2;
constexpr size_t WS_WRH = al256(WS_ROPE + ROPE_FLOATS * 4);
constexpr size_t WS_WRL = al256(WS_WRH + (size_t)2 * 32 * 1024 * 2);
constexpr size_t WS_WIN0 = al256(WS_WRL + (size_t)2 * 32 * 1024 * 2);
constexpr size_t WS_WUQ = al256(WS_WIN0 + (size_t)ATT_NP * 1024 * 2);
constexpr size_t WS_WUKV = al256(WS_WUQ + (size_t)768 * 384 * 2);
constexpr size_t WS_WOUT = al256(WS_WUKV + (size_t)1024 * 256 * 2);
constexpr size_t WS_WREC = al256(WS_WOUT + (size_t)2 * 1024 * 1024 * 2);
constexpr size_t WS_WLORA = al256(WS_WREC + (size_t)REC_NP * 1024 * 2);
constexpr size_t WS_W1T = al256(WS_WLORA + (size_t)2560 * 384 * 2);
constexpr size_t WS_W2T = al256(WS_W1T + (size_t)NE * 2048 * 1024 * 2);
constexpr size_t WS_H = al256(WS_W2T + (size_t)NE * 1024 * 1024 * 2);
constexpr size_t WS_A = al256(WS_H + (size_t)R * 1024 * 4);
constexpr size_t WS_A1 = al256(WS_A + (size_t)R * 1024 * 2);
constexpr size_t WS_F = al256(WS_A1 + (size_t)R * 1024 * 2);
constexpr size_t WS_P = al256(WS_F + (size_t)R * 1024 * 2);
constexpr size_t WS_TOPE = al256(WS_P + (size_t)R * REC_NP * 2);
constexpr size_t WS_GATE = al256(WS_TOPE + (size_t)R * 16);
constexpr size_t WS_POS = al256(WS_GATE + (size_t)R * 16);
constexpr size_t WS_DEST = al256(WS_POS + (size_t)R * 16);
constexpr size_t WS_TILE = al256(WS_DEST + (size_t)R * 16);
constexpr size_t WS_T = al256(WS_TILE + (size_t)(MAXT + 8) * 4);
constexpr size_t WS_QD = WS_T;
constexpr size_t WS_KD = al256(WS_QD + (size_t)R * 512 * 2);
constexpr size_t WS_CQN = al256(WS_KD + (size_t)R * 512 * 2);
constexpr size_t WS_CKVN = al256(WS_CQN + (size_t)R * 384 * 2);
constexpr size_t WS_MQ = al256(WS_CKVN + (size_t)R * 256 * 2);
constexpr size_t WS_MKV = al256(WS_MQ + (size_t)R * 768 * 2);
constexpr size_t WS_KRR = al256(WS_MKV + (size_t)R * 1024 * 2);
constexpr size_t WS_ODIFF = al256(WS_KRR + (size_t)R * 32 * 2);
constexpr size_t WS_OMLA = al256(WS_ODIFF + (size_t)R * 1024 * 4);
constexpr size_t WS_T0_END = al256(WS_OMLA + (size_t)R * 512 * 4);
constexpr size_t WS_XS = WS_T;
constexpr size_t WS_HS = al256(WS_XS + (size_t)MAXROWS * 1024 * 2);
constexpr size_t WS_TM_END = al256(WS_HS + (size_t)MAXROWS * 1024 * 2);
constexpr size_t SZ_RC = (size_t)R * 512 * 4;
constexpr size_t WS_RR = WS_T, WS_VV = WS_RR + SZ_RC, WS_AKK = WS_VV + SZ_RC, WS_KL = WS_AKK + SZ_RC;
constexpr size_t WS_WDEC = WS_KL + SZ_RC  , WS_KDIR = WS_WDEC + 2 * SZ_RC  , WS_BB = WS_KDIR + 2 * SZ_RC  , WS_GG = WS_BB + 2 * SZ_RC;
constexpr size_t WS_ALORA = al256(WS_GG + SZ_RC);
constexpr size_t WS_YR = al256(WS_ALORA + (size_t)R * 384 * 2);
constexpr size_t WS_DC = WS_YR;
constexpr size_t WS_HM = al256(WS_YR + 2 * SZ_RC);
constexpr size_t WS_CST = al256(WS_HM + 2 * SZ_RC);
constexpr size_t WS_DN = al256(WS_CST + (size_t)NUNIT_M * 8192 * 4);
constexpr size_t WS_NST = al256(WS_DN + (size_t)NUNIT_M * 64 * 4);
constexpr size_t WS_SC = al256(WS_NST + (size_t)NUNIT_M * 64 * 4);
constexpr size_t WS_MST = al256(WS_SC + (size_t)NUNIT_M * 2 * 4);
constexpr size_t WS_ASIG = WS_KDIR;
constexpr size_t WS_YB = WS_BB;
constexpr int NUNIT_R = 32 * 260;
constexpr size_t WS_RKM = WS_KDIR + SZ_RC;
static_assert((size_t)NUNIT_R * 4096 * 2 <= SZ_RC, "M^T fits in KL");
constexpr size_t WS_RKQ = al256(WS_MST + (size_t)NUNIT_M * 4);
constexpr size_t WS_RKZ = al256(WS_RKQ + (size_t)NUNIT_R * 4096 * 2);
constexpr size_t WS_T1_END = al256(WS_RKZ + (size_t)NUNIT_R * 4096 * 2);
constexpr size_t WS_END = WS_T1_END > WS_TM_END ? (WS_T1_END > WS_T0_END ? WS_T1_END : WS_T0_END) : (WS_TM_END > WS_T0_END ? WS_TM_END : WS_T0_END);
static_assert(WS_END <= (size_t)2147483648ull, "workspace map exceeds 2 GiB");
constexpr int CW_CNT = 1024;
constexpr int CW_BAR = 4096;
constexpr int RING_BYTES = 131072, AUX_OFF = 131072, AUX_BYTES = 16384, MISC_OFF = 147456, LDS_BYTES = 163840;

struct Frame {
    LAS unsigned char* lds; gu32* ctl; int tid, lane, wave, blk, G, probe;
    float* out; unsigned char* ws;
    struct InTab { LAS const unsigned* t;
        __device__ __forceinline__ const float* operator[](int i) const { const unsigned lo = __builtin_amdgcn_readfirstlane(t[2 * i]), hi = __builtin_amdgcn_readfirstlane(t[2 * i + 1]);
            return (const float*)(((unsigned long long)hi << 32) | lo); } } in;
};
template <class T> __device__ __forceinline__ T* wsp(const Frame& F, size_t off) { return (T*)(F.ws + off); }
__device__ __forceinline__ int row_sel(int row) { const int b = row / TB, t = row - b * TB; return t < CT ? 2 : b; }
__device__ __forceinline__ const float* h0_row(const Frame& F, int row) {
    const int b = row / TB, t = row - b * TB;
    return t < CT ? F.in[I_CTX] + ((size_t)b * CT + t) * DM : F.in[I_X] + ((size_t)b * SEQ + (t - CT)) * DM;
}
__device__ __forceinline__ const float* modp(const Frame& F, int layer, int sel, int chunk) { return wsp<const float>(F, WS_MOD) + ((size_t)(layer * 3 + sel) * 6 + chunk) * DM; }
__device__ __forceinline__ int scan_tok(int z, int sg) { return z == 0 ? sg : (sg < CT ? CT - 1 - sg : TB + CT - 1 - sg); }
__device__ __forceinline__ void tr_item(const float* W, int K, int N, bf16* WT, int row_off, LAS float* scr, int kb, int nb, int lane) {
    const int k0 = 64 * kb, n0 = 32 * nb;
    const int n = n0 + (lane & 31);
    float tv[32];
#pragma unroll
    for (int i = 0; i < 32; ++i) { const int kk = 2 * i + (lane >> 5); tv[i] = (n < N) ? W[(size_t)(k0 + kk) * N + n] : 0.f; }
#pragma unroll
    for (int i = 0; i < 32; ++i) { const int kk = 2 * i + (lane >> 5); scr[kk * 33 + (lane & 31)] = tv[i]; }
    LDS_WAIT(); asm volatile("" ::: "memory");
    const int c = lane & 7;
#pragma unroll
    for (int j = 0; j < 4; ++j) { const int nn = (lane >> 3) + 8 * j; const LAS float* s = scr + (8 * c) * 33 + nn;
        v4u o; o.x = pk2(s[0 * 33], s[1 * 33]); o.y = pk2(s[2 * 33], s[3 * 33]); o.z = pk2(s[4 * 33], s[5 * 33]); o.w = pk2(s[6 * 33], s[7 * 33]);
        *(v4u*)(WT + (size_t)(row_off + n0 + nn) * K + k0 + 8 * c) = o; }
    LDS_WAIT(); asm volatile("" ::: "memory");
}
__device__ __forceinline__ void tr_family(const Frame& F, const float* W, size_t src_stride, int nmat, int K, int N, int Npad, bf16* WT, int gw, int NGW) {
    LAS float* scr = (LAS float*)(F.lds + F.wave * 16384);
    const int nkb = K / 64, nnb = Npad / 32, per = nkb * nnb, total = per * nmat;
    for (int it = gw; it < total; it += NGW) { const int m = it / per, r = it - m * per, kb = r / nnb, nb = r - kb * nnb;
        tr_item(W + (size_t)m * src_stride, K, N, WT, m * Npad, scr, kb, nb, F.lane); }
}
__device__ __forceinline__ void moe_weights_convert(const Frame& F, int layer, int gw, int NGW) {
    tr_family(F, F.in[I_W1] + (size_t)layer * NE * 1024 * 2048, (size_t)1024 * 2048, NE, 1024, 2048, 2048, wsp<bf16>(F, WS_W1T), gw, NGW);
    tr_family(F, F.in[I_W2] + (size_t)layer * NE * 1024 * 1024, (size_t)1024 * 1024, NE, 1024, 1024, 1024, wsp<bf16>(F, WS_W2T), gw, NGW);
}
__device__ __forceinline__ void norm_mod_row(const Frame& F, const float* src, const float* nw, const float* shift, const float* scale, bf16* orow) {
    const f32x4* xr = (const f32x4*)src + F.lane;
    f32x4 v[4]; float s = 0.f;
#pragma unroll
    for (int j = 0; j < 4; ++j) { v[j] = xr[64 * j]; s += (v[j].x * v[j].x + v[j].y * v[j].y) + (v[j].z * v[j].z + v[j].w * v[j].w); }
    const float rs = 1.f / sqrtf(wave_sum(s) * (1.f / DM) + NORM_EPS);
    unsigned long long* o8 = (unsigned long long*)orow + F.lane;
#pragma unroll
    for (int j = 0; j < 4; ++j) { const f32x4 w = ((const f32x4*)nw)[F.lane + 64 * j], sh = ((const f32x4*)shift)[F.lane + 64 * j], sc = ((const f32x4*)scale)[F.lane + 64 * j];
        const f32x4 y = v[j] * rs * w * (sc + 1.f) + sh;
        o8[64 * j] = (unsigned long long)pk2(y.x, y.y) | ((unsigned long long)pk2(y.z, y.w) << 32); }
}
__device__ __forceinline__ void p0a(const Frame& F) {
    LAS float* sv = (LAS float*)F.lds; LAS float* red = (LAS float*)(F.lds + 16384);
    for (int i = F.tid; i < 3 * DM; i += 512) { const int s = i / DM, k = i - s * DM; const float cv = (s < 2) ? F.in[I_C][s * DM + k] : F.in[I_CCTX][k]; sv[i] = cv / (1.f + __expf(-cv)); }
    __syncthreads();
    for (int it = F.blk; it < 192; it += F.G) {
        const int l = it / 96, cgp = it - l * 96, kq = F.tid >> 4, cg = F.tid & 15, col = cgp * 64 + cg * 4;
        float acc[3][4];
#pragma unroll
        for (int s = 0; s < 3; ++s)
#pragma unroll
            for (int j = 0; j < 4; ++j) acc[s][j] = 0.f;
        const float* W = F.in[I_ADAW] + (size_t)l * DM * 6144 + col;
#pragma unroll 16
        for (int kk = 0; kk < 32; ++kk) { const int k = kq * 32 + kk; const f32x4 w = *(const f32x4*)(W + (size_t)k * 6144);
            const float s0 = sv[k], s1 = sv[DM + k], s2 = sv[2 * DM + k];
#pragma unroll
            for (int j = 0; j < 4; ++j) { acc[0][j] += s0 * w[j]; acc[1][j] += s1 * w[j]; acc[2][j] += s2 * w[j]; } }
#pragma unroll
        for (int s = 0; s < 3; ++s)
#pragma unroll
            for (int j = 0; j < 4; ++j) red[(kq * 16 + cg) * 12 + s * 4 + j] = acc[s][j];
        __syncthreads();
        if (F.tid < 192) { const int s = F.tid / 64, cc = F.tid - s * 64, cg2 = cc >> 2, j = cc & 3; float t = 0.f;
            for (int q = 0; q < 32; ++q) t += red[(q * 16 + cg2) * 12 + s * 4 + j];
            wsp<float>(F, WS_MOD)[(size_t)(l * 3 + s) * 6144 + cgp * 64 + cc] = t + F.in[I_ADAB][l * 6144 + cgp * 64 + cc]; }
        __syncthreads();
    }
    const int gid = F.blk * 512 + F.tid, GT = F.G * 512;
    float* rope = wsp<float>(F, WS_ROPE);
    for (int i = gid; i < 256 * 16 + 64 * 16 + 256 * 8 + 64 * 8; i += GT) {
        int j = i; float pos, inv; size_t off;
        if (j < 256 * 16) { pos = (float)(j / 16); inv = powf(10000.f, -(float)(j % 16) / 16.f); off = ROPE_DR + (size_t)j * 2; }
        else if ((j -= 256 * 16) < 64 * 16) { pos = (float)(j / 16); inv = powf(10000.f, -(float)(j % 16) / 16.f); off = ROPE_DC + (size_t)j * 2; }
        else if ((j -= 64 * 16) < 256 * 8) { pos = (float)(j / 8); inv = powf(10000.f, -(float)(j % 8) / 8.f); off = ROPE_MR + (size_t)j * 2; }
        else { j -= 256 * 8; pos = (float)(j / 8); inv = powf(10000.f, -(float)(j % 8) / 8.f); off = ROPE_MC + (size_t)j * 2; }
        const float ang = pos * inv; rope[off] = cosf(ang); rope[off + 1] = sinf(ang);
    }
    { bf16* wh = wsp<bf16>(F, WS_WRH); bf16* wl = wsp<bf16>(F, WS_WRL); for (int i = gid; i < 2 * 32 * 1024; i += GT) { const int k = i & 1023, e = (i >> 10) & 31, l = i >> 15; const float wv = F.in[I_RW][((size_t)l * DM + k) * NE + e];
        const unsigned hb = f2bf(wv); wh[i] = (bf16)hb; wl[i] = (bf16)f2bf(wv - bf2f((bf16)hb)); } }
    bf16* WL = wsp<bf16>(F, WS_WLORA);
    for (int i = gid; i < 2560 * 384; i += GT) { const int n = i / 384, k = i - n * 384, part = n >> 9, c = n & 511; float v = 0.f;
        if (part < 2) { if ((k >> 6) == part) v = F.in[I_RW2][((size_t)part * 64 + (k & 63)) * 512 + c]; }
        else if (part < 4) { if ((k >> 6) == part) v = F.in[I_A2][((size_t)(part - 2) * 64 + (k & 63)) * 512 + c]; }
        else { if (k >= 256) v = F.in[I_G2][(size_t)(k - 256) * 512 + c]; }
        WL[i] = (bf16)f2bf(v); }
    const int gw = F.blk * 8 + F.wave, NGW = F.G * 8;
    tr_family(F, F.in[I_ATTW], 0, 1, 1024, ATT_IN, ATT_NP, wsp<bf16>(F, WS_WIN0), gw, NGW);
    tr_family(F, F.in[I_WUQ], 0, 1, 384, 768, 768, wsp<bf16>(F, WS_WUQ), gw, NGW);
    tr_family(F, F.in[I_WUKV], 0, 1, 256, 1024, 1024, wsp<bf16>(F, WS_WUKV), gw, NGW);
    tr_family(F, F.in[I_WOUT], (size_t)1024 * 1024, 2, 1024, 1024, 1024, wsp<bf16>(F, WS_WOUT), gw, NGW);
    tr_family(F, F.in[I_RECW], 0, 1, 1024, REC_IN, REC_NP, wsp<bf16>(F, WS_WREC), gw, NGW);
    moe_weights_convert(F, 0, gw, NGW);
}
__device__ __forceinline__ void p0b(const Frame& F) {
    const int gw = F.blk * 8 + F.wave, NGW = F.G * 8;
    for (int row = gw; row < R; row += NGW) { const int sel = row_sel(row);
        norm_mod_row(F, h0_row(F, row), F.in[I_NMIX], modp(F, 0, sel, 0), modp(F, 0, sel, 1), wsp<bf16>(F, WS_A) + (size_t)row * DM); }
}
struct FnStoreBf16 {
    bf16* O; int ldc;
    __device__ __forceinline__ void operator()(int row, int col, f32x4 v0, f32x4 v1) const {
        v4u w; w.x = pg8::cvt_pk_bf16(v0[0], v0[1]); w.y = pg8::cvt_pk_bf16(v0[2], v0[3]); w.z = pg8::cvt_pk_bf16(v1[0], v1[1]); w.w = pg8::cvt_pk_bf16(v1[2], v1[3]);
        *(v4u*)(O + (size_t)row * ldc + col) = w; }
};
struct FnWout {
    const Frame* F; int layer;
    __device__ __forceinline__ void operator()(int row, int col, f32x4 v0, f32x4 v1) const {
        float* hrow = wsp<float>(*F, WS_H) + (size_t)row * DM + col;
        const float* base = (layer == 0) ? h0_row(*F, row) + col : hrow;
        const float* g = modp(*F, layer, row_sel(row), 2) + col;
        const f32x4 b0 = *(const f32x4*)base, b1 = *(const f32x4*)(base + 4), g0 = *(const f32x4*)g, g1 = *(const f32x4*)(g + 4);
        *(f32x4*)hrow = b0 + g0 * v0; *(f32x4*)(hrow + 4) = b1 + g1 * v1; }
};
__device__ __forceinline__ void l0_post_proj(const Frame& F) {
    const int gw = F.blk * 8 + F.wave, NGW = F.G * 8, lane = F.lane;
    const bf16* P = wsp<const bf16>(F, WS_P); const float* rope = wsp<const float>(F, WS_ROPE);
    constexpr float CD = 0.125f * 1.4426950408889634f;
    for (int row = gw; row < R; row += NGW) {
        const int b = row / TB, t = row - b * TB; const bool lat = t >= CT; const int pos = t - CT, prow = lat ? pos >> 6 : 0, pcol = lat ? pos & 63 : 0;
        const bf16* p = P + (size_t)row * ATT_NP;
        bf16* qd = wsp<bf16>(F, WS_QD) + (size_t)row * 512; bf16* kd = wsp<bf16>(F, WS_KD) + (size_t)row * 512;
#pragma unroll
        for (int j = 0; j < 8; ++j) { const int pr = lane + 64 * j, h16 = pr >> 5, i = pr & 31;
            const float x1 = bf2f(p[h16 * 64 + i]), x2 = bf2f(p[h16 * 64 + i + 32]); float c = 1.f, s = 0.f;
            if (lat) { const float* tb = (i < 16) ? rope + ROPE_DR + (size_t)(prow * 16 + i) * 2 : rope + ROPE_DC + (size_t)(pcol * 16 + i - 16) * 2; c = tb[0]; s = tb[1]; }
            float y1 = x1 * c - x2 * s, y2 = x1 * s + x2 * c;
            if (h16 < 8) { qd[h16 * 64 + i] = (bf16)f2bf(y1 * CD); qd[h16 * 64 + i + 32] = (bf16)f2bf(y2 * CD); }
            else { kd[(h16 - 8) * 64 + i] = (bf16)f2bf(y1); kd[(h16 - 8) * 64 + i + 32] = (bf16)f2bf(y2); } }
        { float x[6]; float ss = 0.f;
#pragma unroll
          for (int j = 0; j < 6; ++j) { x[j] = bf2f(p[1536 + lane + 64 * j]); ss += x[j] * x[j]; }
          const float rs = 1.f / sqrtf(wave_sum(ss) * (1.f / 384.f) + NORM_EPS); bf16* o = wsp<bf16>(F, WS_CQN) + (size_t)row * 384;
#pragma unroll
          for (int j = 0; j < 6; ++j) o[lane + 64 * j] = (bf16)f2bf(x[j] * rs * F.in[I_QNW][lane + 64 * j]); }
        { float x[4]; float ss = 0.f;
#pragma unroll
          for (int j = 0; j < 4; ++j) { x[j] = bf2f(p[1920 + lane + 64 * j]); ss += x[j] * x[j]; }
          const float rs = 1.f / sqrtf(wave_sum(ss) * (1.f / 256.f) + NORM_EPS); bf16* o = wsp<bf16>(F, WS_CKVN) + (size_t)row * 256;
#pragma unroll
          for (int j = 0; j < 4; ++j) o[lane + 64 * j] = (bf16)f2bf(x[j] * rs * F.in[I_KVNW][lane + 64 * j]); }
        if (lane < 16) { const int i = lane; const float x1 = bf2f(p[2176 + i]), x2 = bf2f(p[2176 + i + 16]); float c = 1.f, s = 0.f;
            if (lat) { const float* tb = (i < 8) ? rope + ROPE_MR + (size_t)(prow * 8 + i) * 2 : rope + ROPE_MC + (size_t)(pcol * 8 + i - 8) * 2; c = tb[0]; s = tb[1]; }
            bf16* o = wsp<bf16>(F, WS_KRR) + (size_t)row * 32; o[i] = (bf16)f2bf(x1 * c - x2 * s); o[i + 16] = (bf16)f2bf(x1 * s + x2 * c); }
    }
}
__device__ __forceinline__ void l0_mq_rope(const Frame& F) {
    const int gw = F.blk * 8 + F.wave, NGW = F.G * 8, lane = F.lane; const float* rope = wsp<const float>(F, WS_ROPE);
    const float CM = 0.10206207261596575f * 1.4426950408889634f;
    for (int row = gw; row < R; row += NGW) {
        const int b = row / TB, t = row - b * TB; const bool lat = t >= CT; const int pos = t - CT, prow = lat ? pos >> 6 : 0, pcol = lat ? pos & 63 : 0;
        bf16* q = wsp<bf16>(F, WS_MQ) + (size_t)row * 768;
#pragma unroll
        for (int j = 0; j < 8; ++j) { const int idx = lane + 64 * j, h = idx >> 6, d = idx & 63; q[h * 96 + d] = (bf16)f2bf(bf2f(q[h * 96 + d]) * CM); }
#pragma unroll
        for (int j = 0; j < 2; ++j) { const int pr = lane + 64 * j, h = pr >> 4, i = pr & 15; const float x1 = bf2f(q[h * 96 + 64 + i]), x2 = bf2f(q[h * 96 + 80 + i]); float c = 1.f, s = 0.f;
            if (lat) { const float* tb = (i < 8) ? rope + ROPE_MR + (size_t)(prow * 8 + i) * 2 : rope + ROPE_MC + (size_t)(pcol * 8 + i - 8) * 2; c = tb[0]; s = tb[1]; }
            q[h * 96 + 64 + i] = (bf16)f2bf((x1 * c - x2 * s) * CM); q[h * 96 + 80 + i] = (bf16)f2bf((x1 * s + x2 * c) * CM); }
    }
}
__device__ __forceinline__ void l0_attention(const Frame& F) {
    LAS char* lds = (LAS char*)F.lds;
    const bf16* QD = wsp<const bf16>(F, WS_QD); const bf16* KD = wsp<const bf16>(F, WS_KD); const bf16* P = wsp<const bf16>(F, WS_P);
    const bf16* MQ = wsp<const bf16>(F, WS_MQ); const bf16* MKV = wsp<const bf16>(F, WS_MKV); const bf16* KRR = wsp<const bf16>(F, WS_KRR);
    float* OD = wsp<float>(F, WS_ODIFF); float* OM = wsp<float>(F, WS_OMLA);
    for (int kind = 0; kind < 2; ++kind) {
        for (int L = F.blk; L < 1024 + 16; L += F.G) {
            int b, h8, qb, nkeys;
            if (L < 1024) { int pair;
                if (F.G == 256) { const int round = L >> 8, c = L & 255; pair = round * 4 + ((c & 7) >> 1); qb = 1 + (c & 1) * 32 + (c >> 3); }
                else { pair = L >> 6; qb = 1 + (L & 63); }
                b = pair >> 3; h8 = pair & 7; nkeys = TB; }
            else { const int s = L - 1024; b = s >> 3; h8 = s & 7; qb = 0; nkeys = CT; }
            const size_t q0 = (size_t)b * TB + (size_t)qb * 256, k0 = (size_t)b * TB;
            if (kind == 0)
                att::attn_unit<64, 128>(QD + q0 * 512 + h8 * 64, 512, KD + k0 * 512 + h8 * 64, 512, nullptr, 0, P + k0 * ATT_NP + 1024 + (h8 >> 1) * 128, ATT_NP,
                                        OD + q0 * 1024 + h8 * 128, 1024, nkeys, lds);
            else
                att::attn_unit<96, 64>(MQ + q0 * 768 + h8 * 96, 768, MKV + k0 * 1024 + h8 * 128, 1024, KRR + k0 * 32, 32, MKV + k0 * 1024 + h8 * 128 + 64, 1024,
                                       OM + q0 * 512 + h8 * 64, 512, nkeys, lds);
        }
    }
}
__device__ __forceinline__ void l0_combine(const Frame& F) {
    const int gw = F.blk * 8 + F.wave, NGW = F.G * 8, lane = F.lane;
    const float* lv = F.in[I_LAM];
    const float lam = __expf(wave_sum(lv[lane] * lv[64 + lane])) - __expf(wave_sum(lv[128 + lane] * lv[192 + lane])) + 0.2f;
    const float sw0 = F.in[I_SUBLN][2 * lane] * 0.8f, sw1 = F.in[I_SUBLN][2 * lane + 1] * 0.8f;
    for (int row = gw; row < R; row += NGW) {
        const float* od = wsp<const float>(F, WS_ODIFF) + (size_t)row * 1024; const float* om = wsp<const float>(F, WS_OMLA) + (size_t)row * 512;
        bf16* a1 = wsp<bf16>(F, WS_A1) + (size_t)row * DM;
#pragma unroll
        for (int h = 0; h < 4; ++h) {
            const float o1a = od[(2 * h) * 128 + 2 * lane], o1b = od[(2 * h) * 128 + 2 * lane + 1], o2a = od[(2 * h + 1) * 128 + 2 * lane], o2b = od[(2 * h + 1) * 128 + 2 * lane + 1];
            const float da = o1a - lam * o2a, db = o1b - lam * o2b;
            const float rs = 1.f / sqrtf(wave_sum(da * da + db * db) * (1.f / 128.f) + NORM_EPS);
            *(unsigned*)(a1 + h * 128 + 2 * lane) = pk2(da * rs * sw0, db * rs * sw1); }
#pragma unroll
        for (int j = 0; j < 2; ++j) { const f32x4 v = *(const f32x4*)(om + 4 * (lane + 64 * j)); v2u w; w.x = pk2(v.x, v.y); w.y = pk2(v.z, v.w); *(v2u*)(a1 + 512 + 4 * (lane + 64 * j)) = w; }
    }
}
constexpr int RT_LS = 264;
__device__ __forceinline__ void ph_router(const Frame& F, int layer) {
    LAS bf16* AH = (LAS bf16*)F.lds; LAS bf16* AL = AH + 64 * RT_LS; LAS bf16* WH = AL + 64 * RT_LS; LAS bf16* WL = WH + 32 * RT_LS;
    LAS float* lg = (LAS float*)(F.lds + 110592);
    LAS int* hist = (LAS int*)(F.lds + MISC_OFF + 256);
    LAS int* recs = (LAS int*)(F.lds + MISC_OFF + 512);
    const int lane = F.lane, w = F.wave, tid = F.tid, RPB = (R + F.G - 1) / F.G, row0 = F.blk * RPB;
    if (tid < 64) hist[tid] = 0;
    const float* nw = F.in[I_NFFN] + (size_t)layer * DM; const float* rbp = F.in[I_RB] + layer * NE;
    const bf16* wrh = wsp<const bf16>(F, WS_WRH) + (size_t)layer * 32 * 1024; const bf16* wrl = wsp<const bf16>(F, WS_WRL) + (size_t)layer * 32 * 1024;
    for (int pass = 0; pass * 64 < RPB; ++pass) {
        const int nrow = min(64, min(RPB - pass * 64, R - row0 - pass * 64));
        f32x4 fr[8][4];
#pragma unroll
        for (int i = 0; i < 8; ++i) { const int rl = w + 8 * i; const int row = row0 + pass * 64 + rl;
            if (rl < nrow) {
                const int sel = row_sel(row); const float* sh = modp(F, layer, sel, 3); const float* sc = modp(F, layer, sel, 4);
                const f32x4* xr = (const f32x4*)(wsp<const float>(F, WS_H) + (size_t)row * DM) + lane; float s = 0.f;
#pragma unroll
                for (int j = 0; j < 4; ++j) { fr[i][j] = xr[64 * j]; s += (fr[i][j].x * fr[i][j].x + fr[i][j].y * fr[i][j].y) + (fr[i][j].z * fr[i][j].z + fr[i][j].w * fr[i][j].w); }
                const float rs = 1.f / sqrtf(wave_sum(s) * (1.f / DM) + NORM_EPS);
                unsigned long long* o8 = (unsigned long long*)(wsp<bf16>(F, WS_F) + (size_t)row * DM) + lane;
#pragma unroll
                for (int j = 0; j < 4; ++j) { const f32x4 ww = ((const f32x4*)nw)[lane + 64 * j], a = ((const f32x4*)sh)[lane + 64 * j], c = ((const f32x4*)sc)[lane + 64 * j];
                    fr[i][j] = fr[i][j] * rs * ww * (c + 1.f) + a;
                    o8[64 * j] = (unsigned long long)pk2(fr[i][j].x, fr[i][j].y) | ((unsigned long long)pk2(fr[i][j].z, fr[i][j].w) << 32); }
            } else {
#pragma unroll
                for (int j = 0; j < 4; ++j) fr[i][j] = (f32x4){0.f, 0.f, 0.f, 0.f};
            } }
        pg8::f32x4 acc = {0.f, 0.f, 0.f, 0.f};
#pragma unroll
        for (int c = 0; c < 4; ++c) {
            __syncthreads();
#pragma unroll
            for (int i = 0; i < 8; ++i) { const f32x4 v = fr[i][c]; const unsigned h0 = pk2(v.x, v.y), h1 = pk2(v.z, v.w);
                const unsigned l0 = pk2(v.x - bflo(h0), v.y - bfhi(h0)), l1 = pk2(v.z - bflo(h1), v.w - bfhi(h1));
                v2u hh; hh.x = h0; hh.y = h1; v2u ll; ll.x = l0; ll.y = l1;
                *(LAS v2u*)(AH + (w + 8 * i) * RT_LS + 4 * lane) = hh; *(LAS v2u*)(AL + (w + 8 * i) * RT_LS + 4 * lane) = ll; }
            { const int e = tid >> 4, kp = (tid & 15) * 16;
              const v4u a0 = *(const v4u*)(wrh + (size_t)e * 1024 + 256 * c + kp), a1 = *(const v4u*)(wrh + (size_t)e * 1024 + 256 * c + kp + 8);
              const v4u b0 = *(const v4u*)(wrl + (size_t)e * 1024 + 256 * c + kp), b1 = *(const v4u*)(wrl + (size_t)e * 1024 + 256 * c + kp + 8);
              *(LAS v4u*)(WH + e * RT_LS + kp) = a0; *(LAS v4u*)(WH + e * RT_LS + kp + 8) = a1; *(LAS v4u*)(WL + e * RT_LS + kp) = b0; *(LAS v4u*)(WL + e * RT_LS + kp + 8) = b1; }
            __syncthreads();
            const int tm = w >> 1, tn = w & 1, lr = lane & 15, kq = (lane >> 4) * 8;
            const LAS bf16* ahp = AH + (tm * 16 + lr) * RT_LS + kq; const LAS bf16* alp = AL + (tm * 16 + lr) * RT_LS + kq;
            const LAS bf16* whp = WH + (tn * 16 + lr) * RT_LS + kq; const LAS bf16* wlp = WL + (tn * 16 + lr) * RT_LS + kq;
#pragma unroll
            for (int ks = 0; ks < 8; ++ks) { const bf16x8 ah = *(const LAS bf16x8*)(ahp + 32 * ks), al = *(const LAS bf16x8*)(alp + 32 * ks), bh = *(const LAS bf16x8*)(whp + 32 * ks), bl = *(const LAS bf16x8*)(wlp + 32 * ks);
                acc = __builtin_amdgcn_mfma_f32_16x16x32_bf16(ah, bh, acc, 0, 0, 0); acc = __builtin_amdgcn_mfma_f32_16x16x32_bf16(ah, bl, acc, 0, 0, 0); acc = __builtin_amdgcn_mfma_f32_16x16x32_bf16(al, bh, acc, 0, 0, 0); }
        }
        { const int m0 = (w >> 1) * 16 + (lane >> 4) * 4, n = (w & 1) * 16 + (lane & 15);
#pragma unroll
          for (int r = 0; r < 4; ++r) lg[(m0 + r) * 33 + n] = acc[r]; }
        __syncthreads();
        if (tid < nrow) { const int rl = tid, row = row0 + pass * 64 + rl; float lv[32];
#pragma unroll
            for (int e = 0; e < 32; ++e) lv[e] = lg[rl * 33 + e] + rbp[e];
            float selv[4]; int seli[4];
#pragma unroll
            for (int r = 0; r < 4; ++r) { float bv = -3.0e38f; int bi = 0;
#pragma unroll
                for (int e = 0; e < 32; ++e) { const bool taken = (r > 0 && seli[0] == e) || (r > 1 && seli[1] == e) || (r > 2 && seli[2] == e); if (!taken && lv[e] > bv) { bv = lv[e]; bi = e; } }
                selv[r] = bv; seli[r] = bi; }
            float ex[4], es = 0.f;
#pragma unroll
            for (int r = 0; r < 4; ++r) { ex[r] = __expf(selv[r] - selv[0]); es += ex[r]; }
            const float inv = 1.f / es;
#pragma unroll
            for (int r = 0; r < 4; ++r) { wsp<int>(F, WS_TOPE)[(size_t)row * 4 + r] = seli[r]; wsp<float>(F, WS_GATE)[(size_t)row * 4 + r] = ex[r] * inv;
                const int rk = __hip_atomic_fetch_add(&hist[seli[r]], 1, __ATOMIC_RELAXED, __HIP_MEMORY_SCOPE_WORKGROUP);
                recs[(pass * 64 + rl) * 4 + r] = seli[r] | (rk << 8); }
        }
    }
    __syncthreads();
    if (tid < NE) hist[32 + tid] = (int)__hip_atomic_fetch_add(F.ctl + CW_CNT + 64 * (layer + 2 * F.probe) + tid, (unsigned)hist[tid], RLX_AGENT);
    __syncthreads();
    for (int rl = tid; rl < RPB && row0 + rl < R; rl += 512) {
#pragma unroll
        for (int r = 0; r < 4; ++r) { const int rc = recs[rl * 4 + r]; wsp<int>(F, WS_POS)[(size_t)(row0 + rl) * 4 + r] = hist[32 + (rc & 255)] + (rc >> 8); } }
}
__device__ __forceinline__ void moe_tables(const Frame& F, int layer, LAS int* ps, LAS int* tile_e) {
    if (F.tid == 0) { int acc = 0, t = 0;
        for (int e = 0; e < NE; ++e) { const int c = (int)__hip_atomic_load(F.ctl + CW_CNT + 64 * layer + e, RLX_AGENT); ps[e] = acc; const int nt = (c + 255) >> 8;
            for (int i = 0; i < nt && t < MAXT; ++i) tile_e[t++] = e; acc += nt * 256; }
        ps[NE] = acc; ps[NE + 1] = t; }
    __syncthreads();
}
__device__ __forceinline__ void ph_gather(const Frame& F, int layer) {
    LAS int* ps = (LAS int*)(F.lds + MISC_OFF + 256); LAS int* tile_e = ps + 64;
    moe_tables(F, layer, ps, tile_e);
    if (F.blk == 0) { int* tab = wsp<int>(F, WS_TILE); const int nt = ps[NE + 1]; if (F.tid == 0) tab[0] = nt; for (int i = F.tid; i < nt; i += 512) tab[1 + i] = tile_e[i]; }
    const int lane = F.lane, gw = F.blk * 8 + F.wave, NGW = F.G * 8;
    for (int row = gw; row < R; row += NGW) {
        int dest = 0;
        if (lane < 4) { const int e = wsp<const int>(F, WS_TOPE)[(size_t)row * 4 + lane]; dest = ps[e] + wsp<const int>(F, WS_POS)[(size_t)row * 4 + lane]; wsp<int>(F, WS_DEST)[(size_t)row * 4 + lane] = dest; }
        const v4u* src = (const v4u*)(wsp<const bf16>(F, WS_F) + (size_t)row * DM); const v4u a = src[lane], b = src[64 + lane];
#pragma unroll
        for (int r = 0; r < 4; ++r) { const int d = __shfl(dest, r); v4u* dst = (v4u*)(wsp<bf16>(F, WS_XS) + (size_t)d * DM); dst[lane] = a; dst[64 + lane] = b; }
    }
}
struct MoeOrder {
    const int* tile_e; int ntiles, nN, G, c;
    __device__ __forceinline__ bool next(int i, pg8::Unit& u) const {
        int rt, pl;
        if (G == 256) { const int x = c & 7, y = c >> 3, rpx = 32 / nN; rt = (i * 8 + x) * rpx + y / nN; pl = y % nN; if (rt >= ntiles) return false; }
        else { const long L = (long)i * G + c; if (L >= (long)ntiles * nN) return false; rt = (int)(L / nN); pl = (int)(L - (long)rt * nN); }
        const int e = __builtin_amdgcn_readfirstlane(tile_e[rt]);
        u.pm = rt; u.pn = e * nN + pl; return true; }
    __device__ __forceinline__ void a_ready(const pg8::Unit&) const {}
    __device__ __forceinline__ void done(const pg8::Unit&) const {}
};
struct LatOrder {
    pg8::StaticOrder o;
    __device__ __forceinline__ bool next(int i, pg8::Unit& u) const { if (!o.next(i, u)) return false; u.pm += 1 + (u.pm >= 64 ? 1 : 0); return true; }
    __device__ __forceinline__ void a_ready(const pg8::Unit&) const {}
    __device__ __forceinline__ void done(const pg8::Unit&) const {}
};
struct FnSwiglu {
    bf16* HS; const float* b1;
    __device__ __forceinline__ void operator()(int row, int col, f32x4 v0, f32x4 v1) const {
        const float* bp = b1 + col;
        const f32x4 b0 = *(const f32x4*)bp, b1v = *(const f32x4*)(bp + 4); v0 = v0 + b0; v1 = v1 + b1v;
        const float hv[8] = {v0[0], v0[1], v0[2], v0[3], v1[0], v1[1], v1[2], v1[3]}; float o[4];
#pragma unroll
        for (int i = 0; i < 4; ++i) { const float g = hv[2 * i], l = hv[2 * i + 1];
            const float gl = fminf(g, 7.f), li = fminf(fmaxf(l, -7.f), 7.f); o[i] = gl * sigmoidf_(1.702f * gl) * (li + 1.f); }
        const int lc = col & 2047; v2u w; w.x = pk2(o[0], o[1]); w.y = pk2(o[2], o[3]);
        *(v2u*)(HS + (size_t)row * 1024 + (lc >> 1)) = w; }
};
struct FnBiasBf16 {
    bf16* YS; const float* b2;
    __device__ __forceinline__ void operator()(int row, int col, f32x4 v0, f32x4 v1) const {
        const f32x4 b0 = *(const f32x4*)(b2 + col), b1v = *(const f32x4*)(b2 + col + 4); v0 = v0 + b0; v1 = v1 + b1v;
        v4u w; w.x = pk2(v0[0], v0[1]); w.y = pk2(v0[2], v0[3]); w.z = pk2(v1[0], v1[1]); w.w = pk2(v1[2], v1[3]);
        *(v4u*)(YS + (size_t)row * 1024 + (col & 1023)) = w; }
};
__device__ __forceinline__ void ph_combine(const Frame& F, int layer) {
    const int lane = F.lane, gw = F.blk * 8 + F.wave, NGW = F.G * 8;
    for (int row = gw; row < R; row += NGW) {
        const int sel = row_sel(row); const float* gf = modp(F, layer, sel, 5);
        float* hrow = wsp<float>(F, WS_H) + (size_t)row * DM;
        f32x4 y[4];
#pragma unroll
        for (int j = 0; j < 4; ++j) y[j] = (f32x4){0.f, 0.f, 0.f, 0.f};
#pragma unroll
        for (int r = 0; r < 4; ++r) { const int d = wsp<const int>(F, WS_DEST)[(size_t)row * 4 + r]; const float g = wsp<const float>(F, WS_GATE)[(size_t)row * 4 + r];
            const v2u* yp = (const v2u*)(wsp<const bf16>(F, WS_XS) + (size_t)d * DM);
#pragma unroll
            for (int j = 0; j < 4; ++j) { const v2u w = yp[lane + 64 * j]; y[j] += g * (f32x4){bflo(w.x), bfhi(w.x), bflo(w.y), bfhi(w.y)}; } }
        f32x4 h[4]; float s = 0.f;
#pragma unroll
        for (int j = 0; j < 4; ++j) { h[j] = ((const f32x4*)hrow)[lane + 64 * j] + ((const f32x4*)gf)[lane + 64 * j] * y[j]; s += (h[j].x * h[j].x + h[j].y * h[j].y) + (h[j].z * h[j].z + h[j].w * h[j].w); }
        const float rs = 1.f / sqrtf(wave_sum(s) * (1.f / DM) + NORM_EPS);
        if (layer == 0) {
#pragma unroll
            for (int j = 0; j < 4; ++j) ((f32x4*)hrow)[lane + 64 * j] = h[j];
            const float* nw = F.in[I_NMIX] + DM; const float* sh = modp(F, 1, sel, 0); const float* sc = modp(F, 1, sel, 1);
            unsigned long long* o8 = (unsigned long long*)(wsp<bf16>(F, WS_A) + (size_t)row * DM) + lane;
#pragma unroll
            for (int j = 0; j < 4; ++j) { const f32x4 w = ((const f32x4*)nw)[lane + 64 * j], a = ((const f32x4*)sh)[lane + 64 * j], c = ((const f32x4*)sc)[lane + 64 * j];
                const f32x4 o = h[j] * rs * w * (c + 1.f) + a; o8[64 * j] = (unsigned long long)pk2(o.x, o.y) | ((unsigned long long)pk2(o.z, o.w) << 32); }
        } else {
            const int b = row / TB, t = row - b * TB;
            if (t >= CT) { float* orow = F.out + ((size_t)b * SEQ + (t - CT)) * DM; const float* nw = F.in[I_FNW];
#pragma unroll
                for (int j = 0; j < 4; ++j) ((f32x4*)orow)[lane + 64 * j] = h[j] * rs * ((const f32x4*)nw)[lane + 64 * j]; }
        }
    }
}
constexpr int PC_Q = 1920, PC_K = 2176, PC_V = 2432, PC_O = 2944, PC_G = 3456;
__device__ __forceinline__ float softplusf_(float y) { return fmaxf(y, 0.f) + __logf(1.f + __expf(-fabsf(y))); }
__device__ __forceinline__ float tanhf_(float x) { return 1.f - 2.f / (1.f + __expf(2.f * x)); }
__device__ __forceinline__ void unpack8(v4u w, float (&x)[8]) { x[0] = bflo(w.x); x[1] = bfhi(w.x); x[2] = bflo(w.y); x[3] = bfhi(w.y); x[4] = bflo(w.z); x[5] = bfhi(w.z); x[6] = bflo(w.w); x[7] = bfhi(w.w); }
__device__ __forceinline__ void lerp8(const bf16* p, bool hp, bool hn, int c0, const float* mu, float (&u)[8]) {
    const v4u z4 = {0u, 0u, 0u, 0u};
    const v4u wx = *(const v4u*)(p + c0), wp = hp ? *(const v4u*)(p - REC_NP + c0) : z4, wn = hn ? *(const v4u*)(p + REC_NP + c0) : z4;
    float x[8], xp[8], xn[8]; unpack8(wx, x); unpack8(wp, xp); unpack8(wn, xn);
    const f32x4 m0 = *(const f32x4*)(mu + c0), m1 = *(const f32x4*)(mu + c0 + 4);
#pragma unroll
    for (int e = 0; e < 8; ++e) { const float m = e < 4 ? m0[e & 3] : m1[e & 3]; u[e] = x[e] + m * (0.5f * (xp[e] + xn[e]) - x[e]); }
}
__device__ __forceinline__ void st8h(bf16* o, const float (&u)[8]) { v4u w; w.x = pk2(u[0], u[1]); w.y = pk2(u[2], u[3]); w.z = pk2(u[4], u[5]); w.w = pk2(u[6], u[7]); *(v4u*)o = w; }
__device__ __forceinline__ void st8f(float* o, const float (&u)[8]) { *(f32x4*)o = (f32x4){u[0], u[1], u[2], u[3]}; *(f32x4*)(o + 4) = (f32x4){u[4], u[5], u[6], u[7]}; }
__device__ __forceinline__ void l1_rwkv_prep(const Frame& F) {
    const int gw = F.blk * 8 + F.wave, NGW = F.G * 8, lane = F.lane; const float* mu = F.in[I_MU];
    for (int row = gw; row < R; row += NGW) {
        const int b = row / TB, t = row - b * TB; const bool hp = (t != 0 && t != CT), hn = (t != CT - 1 && t != TB - 1);
        const bf16* p = wsp<const bf16>(F, WS_P) + (size_t)row * REC_NP; const size_t ro = (size_t)row * 512 + 8 * lane;
        float u[8];
        lerp8(p, hp, hn, 8 * lane, mu, u); st8h(wsp<bf16>(F, WS_RR) + ro, u);
        lerp8(p, hp, hn, 1024 + 8 * lane, mu, u); st8h(wsp<bf16>(F, WS_VV) + ro, u);
        lerp8(p, hp, hn, 512 + 8 * lane, mu, u); st8h(wsp<bf16>(F, WS_KL) + ro, u);
        { const f32x4 k0 = *(const f32x4*)(F.in[I_KK] + 8 * lane), k1 = *(const f32x4*)(F.in[I_KK] + 8 * lane + 4); float ss = 0.f;
#pragma unroll
          for (int e = 0; e < 8; ++e) { u[e] *= (e < 4 ? k0[e & 3] : k1[e & 3]); ss += u[e] * u[e]; }
          ss += __shfl_xor(ss, 1); ss += __shfl_xor(ss, 2); ss += __shfl_xor(ss, 4);
          const float inv = -1.f / sqrtf(fmaxf(ss, 1e-24f));
#pragma unroll
          for (int e = 0; e < 8; ++e) u[e] *= inv;
          st8h(wsp<bf16>(F, WS_AKK) + ro, u); }
        if (lane < 48) { lerp8(p, hp, hn, 1536 + 8 * lane, mu, u);
#pragma unroll
            for (int e = 0; e < 8; ++e) u[e] = lane < 16 ? tanhf_(u[e]) : (lane < 32 ? u[e] : sigmoidf_(u[e]));
            v4u w; w.x = pk2(u[0], u[1]); w.y = pk2(u[2], u[3]); w.z = pk2(u[4], u[5]); w.w = pk2(u[6], u[7]);
            *(v4u*)(wsp<bf16>(F, WS_ALORA) + (size_t)row * 384 + 8 * lane) = w; }
    }
}
struct EpiLora {
    static constexpr bool PERM = true, AFTER_DRAIN = false;
    const Frame* F;
    template <int KIND> __device__ __forceinline__ void run(const pg8::f32x4 (&acc)[2][2][4][2], const pg8::Unit& u, int wr, int wc, int fr, int fq, int z) const {
#pragma unroll
        for (int ai = 0; ai < 2; ++ai)
#pragma unroll
            for (int m = 0; m < 4; ++m) { const int row = u.pm * 256 + ai * 128 + wr * 64 + m * 16 + fr;
#pragma unroll
                for (int bj = 0; bj < 2; ++bj) { const int c = ((u.pn & 1) * 256) + bj * 128 + wc * 32 + 8 * fq; const size_t ro = (size_t)row * 512 + c;
                    const pg8::f32x4 v0 = acc[ai][bj][m][0], v1 = acc[ai][bj][m][1]; const float x[8] = {v0[0], v0[1], v0[2], v0[3], v1[0], v1[1], v1[2], v1[3]}; float o[8];
                    if constexpr (KIND == 0) { const float* w0 = F->in[I_W0] + z * 512 + c;
#pragma unroll
                        for (int e = 0; e < 8; ++e) { const float wl = -softplusf_(-(w0[e] + x[e])) - 0.5f; o[e] = __expf(-__expf(wl)); }
                        st8f(wsp<float>(*F, WS_WDEC) + (size_t)z * R * 512 + ro, o); }
                    else if constexpr (KIND == 1) { const float* a0 = F->in[I_A0] + z * 512 + c;
#pragma unroll
                        for (int e = 0; e < 8; ++e) o[e] = sigmoidf_(a0[e] + x[e]);
                        st8h(wsp<bf16>(*F, WS_ASIG) + (size_t)z * R * 512 + ro, o); }
                    else st8h(wsp<bf16>(*F, WS_GG) + ro, x); } }
    }
    __device__ __forceinline__ void operator()(const pg8::f32x4 (&acc)[2][2][4][2], const pg8::Unit& u, int wr, int wc, int fr, int fq) const {
        const int part = u.pn >> 1;
        if (part < 2) run<0>(acc, u, wr, wc, fr, fq, part); else if (part < 4) run<1>(acc, u, wr, wc, fr, fq, part - 2); else run<2>(acc, u, wr, wc, fr, fq, 0);
    }
};
__device__ __forceinline__ void mlstm_gates(const Frame& F, int row, int z, int h, float& ig, float& lf) {
    const bf16* g = wsp<const bf16>(F, WS_P) + (size_t)row * REC_NP + PC_G + z * 8 + h; const float* gb = F.in[I_GATEB] + z * 8 + h;
    const float gi = bf2f(g[0]) + gb[0], gf = bf2f(g[4]) + gb[4];
    ig = 15.f * tanhf_(gi * (1.f / 15.f)); const float cf = 15.f * tanhf_(gf * (1.f / 15.f)); lf = fminf(cf, 0.f) - __logf(1.f + __expf(-fabsf(cf)));
}
__device__ __forceinline__ void mlstm_chunk_head(const Frame& F, int z, int b, int h, int c, LAS float* vec) {
    LAS int* rows = (LAS int*)vec;
    if (F.tid < 64) { const int s = F.tid, row = b * TB + scan_tok(z, 64 * c + s); float ig, lf; mlstm_gates(F, row, z, h, ig, lf); rows[s] = row; vec[64 + s] = ig; vec[192 + s] = lf; }
    __syncthreads();
    if (F.tid < 64) { float a = 0.f; for (int s = 0; s <= F.tid; ++s) a += vec[192 + s]; vec[128 + F.tid] = a; }
    __syncthreads();
}
__device__ __forceinline__ void l1_mlstm_b(const Frame& F) {
    const float* __restrict__ SC = wsp<const float>(F, WS_SC); const float* __restrict__ DC = wsp<const float>(F, WS_DC); float* __restrict__ CST = wsp<float>(F, WS_CST);
    const float* __restrict__ DN = wsp<const float>(F, WS_DN); float* __restrict__ NST = wsp<float>(F, WS_NST); float* __restrict__ MST = wsp<float>(F, WS_MST);
    for (int g = F.blk * 512 + F.tid; g < 16 * 8192; g += F.G * 512) {
        const int chain = g >> 13, el = g & 8191; float m = 0.f, C = 0.f, N = 0.f; const bool don = el < 64;
        for (int c0 = 0; c0 < 260; c0 += 10) {
            float dc[10], dn[10], bl[10], ml[10];
#pragma unroll
            for (int i = 0; i < 10; ++i) { const size_t u = (size_t)chain * 260 + c0 + i; dc[i] = DC[u * 8192 + el]; dn[i] = don ? DN[u * 64 + el] : 0.f; bl[i] = SC[2 * u]; ml[i] = SC[2 * u + 1]; }
#pragma unroll
            for (int i = 0; i < 10; ++i) { const size_t u = (size_t)chain * 260 + c0 + i;
                CST[u * 8192 + el] = C; if (don) NST[u * 64 + el] = N; if (el == 0) MST[u] = m;
                const float mn = fmaxf(bl[i] + m, ml[i]), cd = __expf(bl[i] + m - mn), inj = __expf(ml[i] - mn);
                C = cd * C + inj * dc[i]; N = cd * N + inj * dn[i]; m = mn; }
        }
    }
}
__device__ __forceinline__ void l1_rec_out(const Frame& F) {
    const int gw = F.blk * 8 + F.wave, NGW = F.G * 8, lane = F.lane, c0 = 8 * lane;
    for (int row = gw; row < R; row += NGW) {
        const size_t ro = (size_t)row * 512 + c0; bf16* a1 = wsp<bf16>(F, WS_A1) + (size_t)row * DM;
        { const float* y0 = wsp<const float>(F, WS_YR) + ro; const float* y1 = y0 + (size_t)R * 512; float y[8]; float s = 0.f;
          const float* y2 = wsp<const float>(F, WS_YB) + ro; const float* y3 = y2 + (size_t)R * 512;
#pragma unroll
          for (int e = 0; e < 8; ++e) { y[e] = (y0[e] + y1[e]) + (y2[e] + y3[e]); s += y[e]; }
          s += __shfl_xor(s, 1); s += __shfl_xor(s, 2); s += __shfl_xor(s, 4); const float mean = s * (1.f / 64.f); float q = 0.f;
#pragma unroll
          for (int e = 0; e < 8; ++e) { y[e] -= mean; q += y[e] * y[e]; }
          q += __shfl_xor(q, 1); q += __shfl_xor(q, 2); q += __shfl_xor(q, 4); const float rstd = 1.f / sqrtf(q * (1.f / 64.f) + 64e-5f);
          float rr[8], kl[8], s0[8], s1[8], vv[8], gg[8]; unpack8(*(const v4u*)(wsp<const bf16>(F, WS_RR) + ro), rr); unpack8(*(const v4u*)(wsp<const bf16>(F, WS_KL) + ro), kl);
          unpack8(*(const v4u*)(wsp<const bf16>(F, WS_ASIG) + ro), s0); unpack8(*(const v4u*)(wsp<const bf16>(F, WS_ASIG) + (size_t)R * 512 + ro), s1);
          unpack8(*(const v4u*)(wsp<const bf16>(F, WS_VV) + ro), vv); unpack8(*(const v4u*)(wsp<const bf16>(F, WS_GG) + ro), gg);
          const float* rk = F.in[I_RK] + c0; const float* ka = F.in[I_KA] + c0; float bs = 0.f;
#pragma unroll
          for (int e = 0; e < 8; ++e) bs += rr[e] * kl[e] * (2.f + (s0[e] + s1[e] - 2.f) * ka[e]) * rk[e];
          bs += __shfl_xor(bs, 1); bs += __shfl_xor(bs, 2); bs += __shfl_xor(bs, 4);
          const float* lw = F.in[I_LNW] + c0; const float* lb = F.in[I_LNB] + c0; float o[8];
#pragma unroll
          for (int e = 0; e < 8; ++e) o[e] = (y[e] * rstd * lw[e] + lb[e] + bs * vv[e]) * gg[e];
          v4u w; w.x = pk2(o[0], o[1]); w.y = pk2(o[2], o[3]); w.z = pk2(o[4], o[5]); w.w = pk2(o[6], o[7]); *(v4u*)(a1 + c0) = w; }
        { const float* h0 = wsp<const float>(F, WS_HM) + ro; const float* h1 = h0 + (size_t)R * 512; float x[8]; float q = 0.f;
#pragma unroll
          for (int e = 0; e < 8; ++e) { x[e] = h0[e] + h1[e]; q += x[e] * x[e]; }
          q += __shfl_xor(q, 1); q += __shfl_xor(q, 2); q += __shfl_xor(q, 4); q += __shfl_xor(q, 8); const float rs = 1.f / sqrtf(q * (1.f / 128.f) + NORM_EPS);
          float og[8]; unpack8(*(const v4u*)(wsp<const bf16>(F, WS_P) + (size_t)row * REC_NP + PC_O + c0), og); const float* nw = F.in[I_MNW] + c0; float o[8];
#pragma unroll
          for (int e = 0; e < 8; ++e) o[e] = x[e] * rs * nw[e] * sigmoidf_(og[e]);
          v4u w; w.x = pk2(o[0], o[1]); w.y = pk2(o[2], o[3]); w.z = pk2(o[4], o[5]); w.w = pk2(o[6], o[7]); *(v4u*)(a1 + 512 + c0) = w; }
    }
}
#ifndef NEU_ROUNDS
#define NEU_ROUNDS 6
#endif
namespace rk {
constexpr int LS = 72;
constexpr int MB = 64 * LS * 2;
struct Acc2 { pg8::f32x4 t0, t1; };
__device__ __forceinline__ void zero(Acc2& a) { a.t0 = (pg8::f32x4){0.f, 0.f, 0.f, 0.f}; a.t1 = a.t0; }
__device__ __forceinline__ void mm_acc(Acc2& acc, const LAS bf16* A, const LAS bf16* Bt, int wave, int lane) {
    const int tm = wave >> 1, tn0 = (wave & 1) * 2, lr = lane & 15, kq = (lane >> 4) * 8;
    const LAS bf16* ap = A + (tm * 16 + lr) * LS + kq; const LAS bf16* bp0 = Bt + (tn0 * 16 + lr) * LS + kq; const LAS bf16* bp1 = bp0 + 16 * LS;
    const bf16x8 a0 = *(const LAS bf16x8*)ap, a1 = *(const LAS bf16x8*)(ap + 32);
    const bf16x8 b00 = *(const LAS bf16x8*)bp0, b01 = *(const LAS bf16x8*)(bp0 + 32), b10 = *(const LAS bf16x8*)bp1, b11 = *(const LAS bf16x8*)(bp1 + 32);
    acc.t0 = __builtin_amdgcn_mfma_f32_16x16x32_bf16(a0, b00, acc.t0, 0, 0, 0); acc.t0 = __builtin_amdgcn_mfma_f32_16x16x32_bf16(a1, b01, acc.t0, 0, 0, 0);
    acc.t1 = __builtin_amdgcn_mfma_f32_16x16x32_bf16(a0, b10, acc.t1, 0, 0, 0); acc.t1 = __builtin_amdgcn_mfma_f32_16x16x32_bf16(a1, b11, acc.t1, 0, 0, 0);
}
template <class Fn> __device__ __forceinline__ void each(const Acc2& acc, int wave, int lane, Fn fn) {
    const int m0 = (wave >> 1) * 16 + (lane >> 4) * 4, n0 = (wave & 1) * 32 + (lane & 15);
#pragma unroll
    for (int r = 0; r < 4; ++r) { fn(m0 + r, n0, acc.t0[r]); fn(m0 + r, n0 + 16, acc.t1[r]); }
}
__device__ __forceinline__ void stb(LAS bf16* M, int m, int n, float v) { M[m * LS + n] = (bf16)f2bf(v); }
__device__ __forceinline__ void st_tr(LAS bf16* M, const Acc2& acc, int wave, int lane) {
    const int m0 = (wave >> 1) * 16 + (lane >> 4) * 4, n0 = (wave & 1) * 32 + (lane & 15);
    v2u a, b; a.x = pk2(acc.t0[0], acc.t0[1]); a.y = pk2(acc.t0[2], acc.t0[3]); b.x = pk2(acc.t1[0], acc.t1[1]); b.y = pk2(acc.t1[2], acc.t1[3]);
    *(LAS v2u*)(M + n0 * LS + m0) = a; *(LAS v2u*)(M + (n0 + 16) * LS + m0) = b;
}
}
__device__ __forceinline__ void l1_rk_phase_a(const Frame& F) {
    using namespace rk;
    LAS unsigned char* L = F.lds;
    LAS bf16* Rt = (LAS bf16*)(L + 0 * MB); LAS bf16* At = (LAS bf16*)(L + 1 * MB); LAS bf16* AtT = (LAS bf16*)(L + 2 * MB); LAS bf16* Bq = (LAS bf16*)(L + 3 * MB); LAS bf16* Kq = (LAS bf16*)(L + 4 * MB);
    LAS bf16* VT = (LAS bf16*)(L + 5 * MB); LAS bf16* BhT = (LAS bf16*)(L + 6 * MB); LAS bf16* KhT = (LAS bf16*)(L + 7 * MB);
    LAS bf16* AK = (LAS bf16*)(L + 8 * MB); LAS bf16* RB = (LAS bf16*)(L + 9 * MB); LAS bf16* RK = (LAS bf16*)(L + 10 * MB);
    LAS bf16* X = (LAS bf16*)(L + 11 * MB); LAS bf16* XT = (LAS bf16*)(L + 12 * MB); LAS bf16* P = (LAS bf16*)(L + 13 * MB);
    LAS bf16* AkVT = Bq; LAS bf16* ApT = Kq; LAS bf16* W2T = X;
    LAS float* G = (LAS float*)(L + 8 * MB);
    LAS float* gl = (LAS float*)(L + 14 * MB);
    const int w = F.wave, lane = F.lane, tid = F.tid;
    const int t = lane, j0 = 8 * w;
    float fr[8], fv[8], fa[8], fw[8], fk[8], fb[8];
#define RK_LOAD(u_) do { const int ch_ = (u_) / 260, c_ = (u_) - ch_ * 260, z_ = ch_ >> 4, b_ = (ch_ >> 3) & 1, h_ = ch_ & 7; const size_t ro = ((size_t)b_ * TB + scan_tok(z_, 64 * c_ + t)) * 512 + h_ * 64 + j0; \
    const v4u xr_ = *(const v4u*)(wsp<const bf16>(F, WS_RR) + ro), xv_ = *(const v4u*)(wsp<const bf16>(F, WS_VV) + ro), xa_ = *(const v4u*)(wsp<const bf16>(F, WS_AKK) + ro), xk_ = *(const v4u*)(wsp<const bf16>(F, WS_KL) + ro), \
              xs_ = *(const v4u*)(wsp<const bf16>(F, WS_ASIG) + (size_t)z_ * R * 512 + ro); const float* p3 = wsp<const float>(F, WS_WDEC) + (size_t)z_ * R * 512 + ro; const float* pk_ = F.in[I_KA] + h_ * 64 + j0; \
    const f32x4 w0_ = *(const f32x4*)p3, w1_ = *(const f32x4*)(p3 + 4), q0_ = *(const f32x4*)pk_, q1_ = *(const f32x4*)(pk_ + 4); float sg_[8], kl_[8]; \
    unpack8(xr_, fr); unpack8(xv_, fv); unpack8(xa_, fa); unpack8(xk_, kl_); unpack8(xs_, sg_); \
    _Pragma("unroll") for (int e = 0; e < 8; ++e) { const float kav = e < 4 ? q0_[e & 3] : q1_[e & 3]; fw[e] = e < 4 ? w0_[e & 3] : w1_[e & 3]; fk[e] = kl_[e] * (1.f + (sg_[e] - 1.f) * kav); fb[e] = -fa[e] * sg_[e]; } } while (0)
    if (F.blk < NUNIT_R) RK_LOAD(F.blk);
    for (int u = F.blk; u < NUNIT_R; u += F.G) {
        const int chain = u / 260, c = u - chain * 260, z = chain >> 4, b = (chain >> 3) & 1, h = chain & 7;
        __syncthreads();
#pragma unroll
        for (int e = 0; e < 8; ++e) G[t * 65 + j0 + e] = fw[e];
        __syncthreads();
        if (tid < 64) { float g = 1.f;
#pragma unroll 16
            for (int s = 0; s < 64; ++s) { g *= G[s * 65 + tid]; G[s * 65 + tid] = g; } gl[tid] = g; }
        __syncthreads();
#pragma unroll
        for (int e = 0; e < 8; ++e) { const int j = j0 + e; const float gt = G[t * 65 + j], gp = t > 0 ? G[(t - 1) * 65 + j] : 1.f, gL = G[63 * 65 + j], ig = 1.f / gt;
            fr[e] *= gt; fa[e] *= gp; const float bq = fb[e] * ig, kq = fk[e] * ig; fb[e] = bq; fk[e] = kq; fw[e] = gL; }
        __syncthreads();
        { v4u q; q.x = pk2(fr[0], fr[1]); q.y = pk2(fr[2], fr[3]); q.z = pk2(fr[4], fr[5]); q.w = pk2(fr[6], fr[7]); *(LAS v4u*)(Rt + t * LS + j0) = q;
          q.x = pk2(fa[0], fa[1]); q.y = pk2(fa[2], fa[3]); q.z = pk2(fa[4], fa[5]); q.w = pk2(fa[6], fa[7]); *(LAS v4u*)(At + t * LS + j0) = q;
          q.x = pk2(fb[0], fb[1]); q.y = pk2(fb[2], fb[3]); q.z = pk2(fb[4], fb[5]); q.w = pk2(fb[6], fb[7]); *(LAS v4u*)(Bq + t * LS + j0) = q;
          q.x = pk2(fk[0], fk[1]); q.y = pk2(fk[2], fk[3]); q.z = pk2(fk[4], fk[5]); q.w = pk2(fk[6], fk[7]); *(LAS v4u*)(Kq + t * LS + j0) = q; }
#pragma unroll
        for (int e = 0; e < 8; ++e) { const int j = j0 + e; stb(AtT, j, t, fa[e]); stb(VT, j, t, fv[e]); stb(BhT, j, t, fb[e] * fw[e]); stb(KhT, j, t, fk[e] * fw[e]); }
        __syncthreads();
        if (u + F.G < NUNIT_R) RK_LOAD(u + F.G);
        Acc2 a1, a2, a3, a4;
        zero(a1); mm_acc(a1, At, Bq, w, lane); zero(a2); mm_acc(a2, At, Kq, w, lane); zero(a3); mm_acc(a3, Rt, Bq, w, lane); zero(a4); mm_acc(a4, Rt, Kq, w, lane);
        each(a1, w, lane, [&](int m, int n, float v) { const float x = n < m ? v : 0.f; stb(X, m, n, x); stb(XT, n, m, x); stb(P, m, n, m == n ? 1.f : 0.f); });
        each(a2, w, lane, [&](int m, int n, float v) { stb(AK, m, n, n < m ? v : 0.f); });
        each(a3, w, lane, [&](int m, int n, float v) { stb(RB, m, n, n <= m ? v : 0.f); });
        each(a4, w, lane, [&](int m, int n, float v) { stb(RK, m, n, n <= m ? v : 0.f); });
        __syncthreads();
        { const int m0 = (w >> 1) * 16 + (lane >> 4) * 4, n0 = (w & 1) * 32 + (lane & 15);
          Acc2 pt;
#pragma unroll
          for (int r = 0; r < 4; ++r) { pt.t0[r] = (m0 + r == n0) ? 1.f : 0.f; pt.t1[r] = (m0 + r == n0 + 16) ? 1.f : 0.f; }
#pragma unroll 1
          for (int i = 0; i < NEU_ROUNDS; ++i) {
            mm_acc(pt, P, XT, w, lane);
            if (i < NEU_ROUNDS - 1) { zero(a1); mm_acc(a1, X, XT, w, lane); }
            __syncthreads();
#pragma unroll
            for (int r = 0; r < 4; ++r) { stb(P, m0 + r, n0, pt.t0[r]); stb(P, m0 + r, n0 + 16, pt.t1[r]); }
            if (i < NEU_ROUNDS - 1) { each(a1, w, lane, [&](int m, int n, float v) { stb(X, m, n, v); }); st_tr(XT, a1, w, lane); }
            __syncthreads();
          } }
        zero(a1); mm_acc(a1, AK, VT, w, lane); zero(a2); mm_acc(a2, P, AtT, w, lane);
        st_tr(AkVT, a1, w, lane); st_tr(ApT, a2, w, lane);
        __syncthreads();
        zero(a3); mm_acc(a3, P, AkVT, w, lane);
        st_tr(W2T, a3, w, lane);
        __syncthreads();
        zero(a1); mm_acc(a1, RB, ApT, w, lane); zero(a2); mm_acc(a2, RB, W2T, w, lane); mm_acc(a2, RK, VT, w, lane);
        zero(a3); mm_acc(a3, BhT, ApT, w, lane); zero(a4); mm_acc(a4, BhT, W2T, w, lane); mm_acc(a4, KhT, VT, w, lane);
        __syncthreads();
        { LAS bf16* O1 = At; LAS bf16* O2 = AtT; LAS bf16* O3 = AK; LAS float* OY = (LAS float*)X;
          each(a1, w, lane, [&](int m, int n, float v) { stb(O1, m, n, v + bf2f(Rt[m * LS + n])); });
          each(a3, w, lane, [&](int m, int n, float v) { stb(O2, m, n, v + (m == n ? gl[m] : 0.f)); });
          each(a4, w, lane, [&](int m, int n, float v) { stb(O3, m, n, v); });
          each(a2, w, lane, [&](int m, int n, float v) { OY[m * 68 + n] = v; });
          __syncthreads();
          const int row = tid >> 3, c8 = (tid & 7) * 8;
          *(v4u*)(wsp<bf16>(F, WS_RKQ) + (size_t)u * 4096 + row * 64 + c8) = *(const LAS v4u*)(O1 + row * LS + c8);
          *(v4u*)(wsp<bf16>(F, WS_RKM) + (size_t)u * 4096 + row * 64 + c8) = *(const LAS v4u*)(O2 + row * LS + c8);
          *(v4u*)(wsp<bf16>(F, WS_RKZ) + (size_t)u * 4096 + row * 64 + c8) = *(const LAS v4u*)(O3 + row * LS + c8);
          float* Yg = wsp<float>(F, WS_YR) + (size_t)z * R * 512 + h * 64;
#pragma unroll
          for (int i = 0; i < 2; ++i) { const int yr = (tid >> 4) + 32 * i, c4 = (tid & 15) * 4;
              *(f32x4*)(Yg + ((size_t)b * TB + scan_tok(z, 64 * c + yr)) * 512 + c4) = *(const LAS f32x4*)(OY + yr * 68 + c4); } }
    }
#undef RK_LOAD
}
__device__ __forceinline__ void l1_rk_phase_b(const Frame& F) {
    using namespace rk;
    LAS unsigned char* L = F.lds; LAS bf16* S = (LAS bf16*)L;
    const int w = F.wave, lane = F.lane, tid = F.tid, chain = F.blk, z = chain >> 4, b = (chain >> 3) & 1, h = chain & 7;
    for (int i = tid; i < 64 * LS; i += 512) S[i] = 0;
    const int sr = tid >> 3, sc = (tid & 7) * 8;
    v4u gm, gq, gz;
#define RKB_LOAD(u_) do { gm = *(const v4u*)(wsp<const bf16>(F, WS_RKM) + (u_) * 4096 + sr * 64 + sc); gq = *(const v4u*)(wsp<const bf16>(F, WS_RKQ) + (u_) * 4096 + sr * 64 + sc); \
    gz = *(const v4u*)(wsp<const bf16>(F, WS_RKZ) + (u_) * 4096 + sr * 64 + sc); } while (0)
#define RKB_WRITE(par) do { *(LAS v4u*)((LAS bf16*)(L + (1 + 3 * (par)) * MB) + sr * LS + sc) = gm; *(LAS v4u*)((LAS bf16*)(L + (2 + 3 * (par)) * MB) + sr * LS + sc) = gq; \
    *(LAS v4u*)((LAS bf16*)(L + (3 + 3 * (par)) * MB) + sr * LS + sc) = gz; } while (0)
    RKB_LOAD((size_t)chain * 260); RKB_WRITE(0);
    __syncthreads();
    float* Yg = wsp<float>(F, WS_YB) + (size_t)z * R * 512 + h * 64;
    LAS float* OY = (LAS float*)(L + 7 * MB);
    for (int c = 0; c < 260; ++c) {
        const size_t u = (size_t)chain * 260 + c; const int par = c & 1;
        if (c + 1 < 260) RKB_LOAD(u + 1);
        const LAS bf16* Mt = (const LAS bf16*)(L + (1 + 3 * par) * MB); const LAS bf16* Qp = (const LAS bf16*)(L + (2 + 3 * par) * MB); const LAS bf16* Zt = (const LAS bf16*)(L + (3 + 3 * par) * MB);
        Acc2 a1, a2; zero(a1); mm_acc(a1, Mt, S, w, lane); zero(a2); mm_acc(a2, Qp, S, w, lane);
        const int m0 = (w >> 1) * 16 + (lane >> 4) * 4, n0 = (w & 1) * 32 + (lane & 15); float zv[8];
#pragma unroll
        for (int r = 0; r < 4; ++r) { zv[2 * r] = bf2f(Zt[(m0 + r) * LS + n0]); zv[2 * r + 1] = bf2f(Zt[(m0 + r) * LS + n0 + 16]); }
        __syncthreads();
        { Acc2 s2;
#pragma unroll
          for (int r = 0; r < 4; ++r) { s2.t0[r] = a1.t0[r] + zv[2 * r]; s2.t1[r] = a1.t1[r] + zv[2 * r + 1]; OY[(m0 + r) * 68 + n0] = a2.t0[r]; OY[(m0 + r) * 68 + n0 + 16] = a2.t1[r]; }
          st_tr(S, s2, w, lane); }
        if (c + 1 < 260) RKB_WRITE(par ^ 1);
        __syncthreads();
#pragma unroll
        for (int i = 0; i < 2; ++i) { const int yr = (tid >> 4) + 32 * i, c4 = (tid & 15) * 4;
            *(f32x4*)(Yg + ((size_t)b * TB + scan_tok(z, 64 * c + yr)) * 512 + c4) = *(const LAS f32x4*)(OY + yr * 68 + c4); }
    }
#undef RKB_LOAD
#undef RKB_WRITE
}
__device__ __forceinline__ void l1_mlstm_a2(const Frame& F) {
    using namespace rk;
    LAS bf16* KT = (LAS bf16*)F.lds; LAS bf16* VsT = KT + 64 * LS;
    LAS float* vec = (LAS float*)(F.lds + AUX_OFF); LAS int* rows = (LAS int*)vec;
    const bf16* Pg = wsp<const bf16>(F, WS_P); const int tid = F.tid, w = F.wave, lane = F.lane;
    for (int u = F.blk; u < NUNIT_M; u += F.G) {
        const int cidx = u / 260, c = u - cidx * 260, z = cidx >> 3, b = (cidx >> 2) & 1, h = cidx & 3;
        mlstm_chunk_head(F, z, b, h, c, vec);
        if (tid < 64) { const float bl = vec[128 + 63]; const float uu = bl - vec[128 + tid] + vec[64 + tid]; float m = uu;
#pragma unroll
            for (int o = 1; o < 64; o <<= 1) m = fmaxf(m, __shfl_xor(m, o));
            vec[256 + tid] = __expf(uu - m);
            if (tid == 0) { wsp<float>(F, WS_SC)[2 * u] = bl; wsp<float>(F, WS_SC)[2 * u + 1] = m; } }
        __syncthreads();
        { const int s = tid >> 3, c8 = tid & 7; float x[8]; unpack8(*(const v4u*)(Pg + (size_t)rows[s] * REC_NP + PC_K + h * 64 + 8 * c8), x);
#pragma unroll
          for (int e = 0; e < 8; ++e) stb(KT, 8 * c8 + e, s, x[e]); }
#pragma unroll
        for (int i = 0; i < 2; ++i) { const int s = (tid >> 4) + 32 * i, c8 = tid & 15; float x[8]; unpack8(*(const v4u*)(Pg + (size_t)rows[s] * REC_NP + PC_V + h * 128 + 8 * c8), x); const float sw = vec[256 + s];
#pragma unroll
            for (int e = 0; e < 8; ++e) stb(VsT, 8 * c8 + e, s, x[e] * sw); }
        __syncthreads();
        Acc2 a0, a1; zero(a0); mm_acc(a0, VsT, KT, w, lane); zero(a1); mm_acc(a1, VsT + 64 * LS, KT, w, lane);
        float* dc = wsp<float>(F, WS_DC) + (size_t)u * 8192;
        each(a0, w, lane, [&](int m, int n, float v) { dc[m * 64 + n] = 0.125f * v; });
        each(a1, w, lane, [&](int m, int n, float v) { dc[(64 + m) * 64 + n] = 0.125f * v; });
        if (tid < 64) { float a = 0.f; for (int s = 0; s < 64; ++s) a += vec[256 + s] * bf2f(KT[tid * LS + s]); wsp<float>(F, WS_DN)[(size_t)u * 64 + tid] = 0.125f * a; }
        __syncthreads();
    }
}
__device__ __forceinline__ void l1_mlstm_c2(const Frame& F, int first_blk, int nblk) {
    using namespace rk;
    LAS bf16* Q = (LAS bf16*)F.lds; LAS bf16* K = Q + 64 * LS; LAS bf16* VT = K + 64 * LS; LAS bf16* Cm = VT + 128 * LS; LAS bf16* Pm = Cm + 128 * LS;
    LAS float* OH = (LAS float*)(F.lds + 7 * MB);
    LAS float* vec = (LAS float*)(F.lds + AUX_OFF); LAS int* rows = (LAS int*)vec;
    const bf16* Pg = wsp<const bf16>(F, WS_P); const int tid = F.tid, w = F.wave, lane = F.lane;
    for (int u = F.blk - first_blk; u < NUNIT_M; u += nblk) {
        const int cidx = u / 260, c = u - cidx * 260, z = cidx >> 3, b = (cidx >> 2) & 1, h = cidx & 3;
        mlstm_chunk_head(F, z, b, h, c, vec);
        const float mst = wsp<const float>(F, WS_MST)[u];
        if (tid < 64) { const int t = tid; float pm = -3.0e38f; for (int s = 0; s <= t; ++s) pm = fmaxf(pm, vec[64 + s] - vec[128 + s]);
            const float gi = vec[128 + t] + mst, mo = fmaxf(gi, vec[128 + t] + pm); vec[320 + t] = __expf(gi - mo); vec[384 + t] = mo;
            vec[256 + t] = wsp<const float>(F, WS_NST)[(size_t)u * 64 + t]; }
        { const int t = tid >> 3, c8 = tid & 7;
          *(LAS v4u*)(Q + t * LS + 8 * c8) = *(const v4u*)(Pg + (size_t)rows[t] * REC_NP + PC_Q + h * 64 + 8 * c8);
          *(LAS v4u*)(K + t * LS + 8 * c8) = *(const v4u*)(Pg + (size_t)rows[t] * REC_NP + PC_K + h * 64 + 8 * c8); }
#pragma unroll
        for (int i = 0; i < 2; ++i) { const int s = (tid >> 4) + 32 * i, c8 = tid & 15; const v4u wv = *(const v4u*)(Pg + (size_t)rows[s] * REC_NP + PC_V + h * 128 + 8 * c8);
            const unsigned ww[4] = {wv.x, wv.y, wv.z, wv.w};
#pragma unroll
            for (int e = 0; e < 4; ++e) { VT[(8 * c8 + 2 * e) * LS + s] = (bf16)(ww[e] & 0xffffu); VT[(8 * c8 + 2 * e + 1) * LS + s] = (bf16)(ww[e] >> 16); } }
        { const int v = tid >> 2, dq = (tid & 3) * 16; const f32x4* src = (const f32x4*)(wsp<const float>(F, WS_CST) + (size_t)u * 8192 + v * 64 + dq);
          const f32x4 x0 = src[0], x1 = src[1], x2 = src[2], x3 = src[3]; v4u o0, o1;
          o0.x = pk2(x0.x, x0.y); o0.y = pk2(x0.z, x0.w); o0.z = pk2(x1.x, x1.y); o0.w = pk2(x1.z, x1.w); o1.x = pk2(x2.x, x2.y); o1.y = pk2(x2.z, x2.w); o1.z = pk2(x3.x, x3.y); o1.w = pk2(x3.z, x3.w);
          *(LAS v4u*)(Cm + v * LS + dq) = o0; *(LAS v4u*)(Cm + v * LS + dq + 8) = o1; }
        __syncthreads();
        Acc2 aq, c0, c1; zero(aq); mm_acc(aq, Q, K, w, lane); zero(c0); mm_acc(c0, Q, Cm, w, lane); zero(c1); mm_acc(c1, Q, Cm + 64 * LS, w, lane);
        each(aq, w, lane, [&](int t, int s, float v) { stb(Pm, t, s, s <= t ? 0.125f * v * __expf(vec[128 + t] + (vec[64 + s] - vec[128 + s]) - vec[384 + t]) : 0.f); });
        __syncthreads();
        Acc2 p0, p1; zero(p0); mm_acc(p0, Pm, VT, w, lane); zero(p1); mm_acc(p1, Pm, VT + 64 * LS, w, lane);
        if (tid < 64) { const int t = tid; float rs = 0.f, nq = 0.f;
            for (int s = 0; s < 64; ++s) { rs += bf2f(Pm[t * LS + s]); nq += vec[256 + s] * bf2f(Q[t * LS + s]); }
            const float den = vec[320 + t] * nq + rs; vec[448 + t] = 1.f / fmaxf(fabsf(den), __expf(-vec[384 + t])); }
        __syncthreads();
        { const int m0 = (w >> 1) * 16 + (lane >> 4) * 4, n0 = (w & 1) * 32 + (lane & 15);
#pragma unroll
          for (int r = 0; r < 4; ++r) { const int t = m0 + r; const float g = vec[320 + t], idn = vec[448 + t];
              OH[t * 132 + n0] = (g * c0.t0[r] + p0.t0[r]) * idn; OH[t * 132 + n0 + 16] = (g * c0.t1[r] + p0.t1[r]) * idn;
              OH[t * 132 + 64 + n0] = (g * c1.t0[r] + p1.t0[r]) * idn; OH[t * 132 + 64 + n0 + 16] = (g * c1.t1[r] + p1.t1[r]) * idn; } }
        __syncthreads();
#pragma unroll
        for (int i = 0; i < 4; ++i) { const int it = tid + 512 * i, t = it >> 5, c4 = (it & 31) * 4;
            *(f32x4*)(wsp<float>(F, WS_HM) + ((size_t)z * R + rows[t]) * 512 + h * 128 + c4) = *(const LAS f32x4*)(OH + t * 132 + c4); }
        __syncthreads();
    }
}
#ifndef MK_PER_PHASE
#define MK_PER_PHASE 0
#endif
constexpr int NPHASE = 26;
struct Args { const float* in[N_IN]; float* out; unsigned char* ws; int ph_lo, ph_hi, li, pad; };
#define GEMM_CALL(FnT, SchedT, g, S, fn) do { pg8::EpiGen<FnT> E_{fn}; { int k_ = g.K; asm volatile("" : "+s"(k_)); g.K = k_; } pg8::gemm_phase<pg8::EpiGen<FnT>, SchedT, true, true>((PG8_LAS unsigned char*)F.lds, g, S, E_); } while (0)
#ifndef SITE_MASK
#define SITE_MASK 0xFFFFFFFFull
#endif
#define SITE(s) (((SITE_MASK) >> (s)) & 1ull)
#ifndef DUP_MASK
#define DUP_MASK 0ull
#endif
#define NREP(s) ((((DUP_MASK) >> (s)) & 1ull) ? 2 : 1)
#define IN(k) (lo <= (k) && (k) < hi)
#define SEAM(k) do { if (IN(k) && IN((k) + 1)) xcd_barrier(bar); } while (0)
template <int LAYER> __device__ __forceinline__ void layer_phases(const Frame& F, const XcdBarrier& bar, const int lo, const int hi) {
    constexpr int layer = LAYER; constexpr int pb = 2 + 12 * LAYER;
        if (SITE(2) && IN(pb + 0)) { for (int rep_ = 0; rep_ < NREP(2); ++rep_) {
            const int N = layer == 0 ? ATT_NP : REC_NP;
            pg8::Gemm g{wsp<const bf16>(F, WS_A), layer == 0 ? wsp<const bf16>(F, WS_WIN0) : wsp<const bf16>(F, WS_WREC), R, N, 1024};
            pg8::StaticOrder S; S.init(R, N, F.G, F.blk);
            GEMM_CALL(FnStoreBf16, pg8::StaticOrder, g, S, (FnStoreBf16{wsp<bf16>(F, WS_P), N}));
             if (rep_ + 1 < NREP(2)) xcd_barrier(bar); } SEAM(pb + 0);
        }
        if constexpr (LAYER == 0) {
            if (SITE(3) && IN(pb + 1)) { for (int rep_ = 0; rep_ < NREP(3); ++rep_) { l0_post_proj(F);  if (rep_ + 1 < NREP(3)) xcd_barrier(bar); } SEAM(pb + 1); }
            if (SITE(4) && IN(pb + 2)) { for (int rep_ = 0; rep_ < NREP(4); ++rep_) {
                pg8::Gemm g{wsp<const bf16>(F, WS_CQN), wsp<const bf16>(F, WS_WUQ), R, 768, 384}; pg8::StaticOrder S; S.init(R, 768, F.G, F.blk);
                GEMM_CALL(FnStoreBf16, pg8::StaticOrder, g, S, (FnStoreBf16{wsp<bf16>(F, WS_MQ), 768}));
                 if (rep_ + 1 < NREP(4)) xcd_barrier(bar); } SEAM(pb + 2);
            }
            if (SITE(5) && IN(pb + 3)) { for (int rep_ = 0; rep_ < NREP(5); ++rep_) {
                pg8::Gemm g{wsp<const bf16>(F, WS_CKVN), wsp<const bf16>(F, WS_WUKV), R, 1024, 256}; pg8::StaticOrder S; S.init(R, 1024, F.G, F.blk);
                GEMM_CALL(FnStoreBf16, pg8::StaticOrder, g, S, (FnStoreBf16{wsp<bf16>(F, WS_MKV), 1024}));
                l0_mq_rope(F);
                 if (rep_ + 1 < NREP(5)) xcd_barrier(bar); } SEAM(pb + 3);
            }
            if (SITE(6) && IN(pb + 4)) { for (int rep_ = 0; rep_ < NREP(6); ++rep_) { l0_attention(F);  if (rep_ + 1 < NREP(6)) xcd_barrier(bar); } SEAM(pb + 4); }
            if (SITE(7) && IN(pb + 5)) { for (int rep_ = 0; rep_ < NREP(7); ++rep_) { l0_combine(F);  if (rep_ + 1 < NREP(7)) xcd_barrier(bar); } SEAM(pb + 5); }
        } else {
            if (SITE(8) && IN(pb + 1)) { for (int rep_ = 0; rep_ < NREP(8); ++rep_) { l1_rwkv_prep(F); l1_mlstm_a2(F);  if (rep_ + 1 < NREP(8)) xcd_barrier(bar); } SEAM(pb + 1); }
            if (SITE(9) && IN(pb + 2)) { for (int rep_ = 0; rep_ < NREP(9); ++rep_) {
                pg8::Gemm g{wsp<const bf16>(F, WS_ALORA), wsp<const bf16>(F, WS_WLORA), R, 2560, 384}; pg8::StaticOrder S; S.init(R, 2560, F.G, F.blk);
                { int k_ = g.K; asm volatile("" : "+s"(k_)); g.K = k_; EpiLora E_{&F}; pg8::gemm_phase<EpiLora, pg8::StaticOrder, true, true>((PG8_LAS unsigned char*)F.lds, g, S, E_); }
                l1_mlstm_b(F);
                 if (rep_ + 1 < NREP(9)) xcd_barrier(bar); } SEAM(pb + 2);
            }
            if (SITE(18) && IN(pb + 3)) { for (int rep_ = 0; rep_ < NREP(18); ++rep_) { l1_rk_phase_a(F); if (rep_ + 1 < NREP(18)) xcd_barrier(bar); } SEAM(pb + 3); }
            if (SITE(10) && IN(pb + 4)) { for (int rep_ = 0; rep_ < NREP(10); ++rep_) {
                if (F.G > 32) { if (F.blk < 32) l1_rk_phase_b(F); else { l1_mlstm_c2(F, 32, F.G - 32); moe_weights_convert(F, 1, (F.blk - 32) * 8 + F.wave, (F.G - 32) * 8); } }
                 if (rep_ + 1 < NREP(10)) xcd_barrier(bar); } SEAM(pb + 4);
            }
            if (SITE(11) && IN(pb + 5)) { for (int rep_ = 0; rep_ < NREP(11); ++rep_) { l1_rec_out(F);  if (rep_ + 1 < NREP(11)) xcd_barrier(bar); } SEAM(pb + 5); }
        }
        if (SITE(12) && IN(pb + 6)) { for (int rep_ = 0; rep_ < NREP(12); ++rep_) {
            pg8::Gemm g{wsp<const bf16>(F, WS_A1), wsp<const bf16>(F, WS_WOUT) + (size_t)layer * 1024 * 1024, R, 1024, 1024};
            if constexpr (LAYER == 0) { pg8::StaticOrder S; S.init(R, 1024, F.G, F.blk); GEMM_CALL(FnWout, pg8::StaticOrder, g, S, (FnWout{&F, layer})); }
            else { LatOrder S; S.o.init(R - 2 * CT, 1024, F.G, F.blk); GEMM_CALL(FnWout, LatOrder, g, S, (FnWout{&F, layer})); }
             if (rep_ + 1 < NREP(12)) xcd_barrier(bar); } SEAM(pb + 6);
        }
        if (SITE(13) && IN(pb + 7)) { for (int rep_ = 0; rep_ < NREP(13); ++rep_) { ph_router(F, layer);  if (rep_ + 1 < NREP(13)) xcd_barrier(bar); } SEAM(pb + 7); }
        if (SITE(14) && IN(pb + 8)) { for (int rep_ = 0; rep_ < NREP(14); ++rep_) { ph_gather(F, layer);  if (rep_ + 1 < NREP(14)) xcd_barrier(bar); } SEAM(pb + 8); }
        if (SITE(15) && IN(pb + 9)) { for (int rep_ = 0; rep_ < NREP(15); ++rep_) {
            const int* tab = wsp<const int>(F, WS_TILE);
            pg8::Gemm g{wsp<const bf16>(F, WS_XS), wsp<const bf16>(F, WS_W1T), MAXROWS, NE * 2048, 1024}; MoeOrder S{tab + 1, __builtin_amdgcn_readfirstlane(tab[0]), 8, F.G, F.blk};
            GEMM_CALL(FnSwiglu, MoeOrder, g, S, (FnSwiglu{wsp<bf16>(F, WS_HS), F.in[I_B1] + (size_t)layer * NE * 2048}));
             if (rep_ + 1 < NREP(15)) xcd_barrier(bar); } SEAM(pb + 9);
        }
        if (SITE(16) && IN(pb + 10)) { for (int rep_ = 0; rep_ < NREP(16); ++rep_) {
            const int* tab = wsp<const int>(F, WS_TILE);
            pg8::Gemm g{wsp<const bf16>(F, WS_HS), wsp<const bf16>(F, WS_W2T), MAXROWS, NE * 1024, 1024}; MoeOrder S{tab + 1, __builtin_amdgcn_readfirstlane(tab[0]), 4, F.G, F.blk};
            GEMM_CALL(FnBiasBf16, MoeOrder, g, S, (FnBiasBf16{wsp<bf16>(F, WS_XS), F.in[I_B2] + (size_t)layer * NE * 1024}));
             if (rep_ + 1 < NREP(16)) xcd_barrier(bar); } SEAM(pb + 10);
        }
        if (SITE(17) && IN(pb + 11)) { for (int rep_ = 0; rep_ < NREP(17); ++rep_) { ph_combine(F, layer);  if (rep_ + 1 < NREP(17)) xcd_barrier(bar); } SEAM(pb + 11); }
}
__global__ void __launch_bounds__(512, 2) fwd(Args args) {
    extern __shared__ __attribute__((aligned(16))) unsigned char lds_[];
    Frame F;
    F.lds = (LAS unsigned char*)lds_; F.tid = threadIdx.x; F.lane = F.tid & 63; F.wave = __builtin_amdgcn_readfirstlane(F.tid >> 6); F.blk = blockIdx.x; F.G = gridDim.x; F.probe = args.pad;
    F.ws = args.ws; F.out = args.out; F.ctl = (gu32*)(args.ws + WS_CTL);
    F.in.t = (LAS const unsigned*)(F.lds + MISC_OFF + 8192);
    if (F.tid < 64) ((LAS unsigned*)(F.lds + MISC_OFF))[F.tid] = 0u;
    if (F.tid < N_IN) { const unsigned long long pv = (unsigned long long)args.in[F.tid]; ((LAS unsigned*)(F.lds + MISC_OFF + 8192))[2 * F.tid] = (unsigned)pv; ((LAS unsigned*)(F.lds + MISC_OFF + 8192))[2 * F.tid + 1] = (unsigned)(pv >> 32); }
    __syncthreads();
    const int lo = args.ph_lo, hi = args.ph_hi;
    XcdBarrier bar; bar.bar = (unsigned*)(F.ctl + CW_BAR) + args.li * XCD_BAR_WORDS; bar.x = 0; bar.st = nullptr;
    if (hi - lo > 1) bar = xcd_barrier_post((unsigned*)(F.ctl + CW_BAR) + args.li * XCD_BAR_WORDS, (volatile LAS unsigned*)(F.lds + MISC_OFF));
    if (SITE(0) && IN(0)) { for (int rep_ = 0; rep_ < NREP(0); ++rep_) { p0a(F);  if (rep_ + 1 < NREP(0)) xcd_barrier(bar); } SEAM(0); }
    if (SITE(1) && IN(1)) { for (int rep_ = 0; rep_ < NREP(1); ++rep_) { p0b(F);  if (rep_ + 1 < NREP(1)) xcd_barrier(bar); } SEAM(1); }
    layer_phases<0>(F, bar, lo, hi);
    layer_phases<1>(F, bar, lo, hi);
}
#undef IN
#undef SEAM


extern "C" void kernel_launch(void* const* d_in, const int* in_sizes, int n_in, void* d_out, int out_size, void* d_ws, size_t ws_size, hipStream_t stream) {
    static int grid = 0;
    if (grid == 0) {
        const bool ok = n_in == N_IN && in_sizes[I_X] == NBATCH * SEQ * DM && in_sizes[I_RECW] == 1024 * REC_IN && in_sizes[I_ATTW] == 1024 * ATT_IN && in_sizes[I_MU] == RWKV_IN &&
                        in_sizes[I_GATEB] == 16 && in_sizes[I_W1] == 2 * NE * 1024 * 2048 && out_size == NBATCH * SEQ * DM && ws_size >= WS_END;
        if (!ok) { fprintf(stderr, "kernel_launch: shape mismatch (n_in %d, recw %d, attw %d, mu %d, out %d, ws %zu need %zu); nothing launched\n", n_in, n_in > I_RECW ? in_sizes[I_RECW] : -1,
                           n_in > I_ATTW ? in_sizes[I_ATTW] : -1, n_in > I_MU ? in_sizes[I_MU] : -1, out_size, ws_size, (size_t)WS_END); grid = -1; return; }
        int dev = 0, cus = 0;
        if (hipGetDevice(&dev) != hipSuccess || hipDeviceGetAttribute(&cus, hipDeviceAttributeMultiprocessorCount, dev) != hipSuccess) { grid = -1; return; }
        if (hipFuncSetAttribute((const void*)fwd, hipFuncAttributeMaxDynamicSharedMemorySize, LDS_BYTES) != hipSuccess) { fprintf(stderr, "kernel_launch: hipFuncSetAttribute failed\n"); grid = -1; return; }
        int per_cu = 0;
        if (hipOccupancyMaxActiveBlocksPerMultiprocessor(&per_cu, (const void*)fwd, 512, LDS_BYTES) != hipSuccess || per_cu < 1) { fprintf(stderr, "kernel_launch: occupancy query says %d blocks per CU\n", per_cu); }
        (void)hipGetLastError();
        grid = cus < 256 ? cus : 256;
        if (grid != 256) fprintf(stderr, "kernel_launch: %d CUs; this kernel is written for a 256-CU device\n", cus);
    }
    if (grid < 0) return;
    if (hipMemsetAsync((char*)d_ws + WS_CTL, 0, CTL_ZERO_BYTES, stream) != hipSuccess) return;
    Args a{};
    for (int i = 0; i < N_IN; ++i) a.in[i] = (const float*)d_in[i];
    a.out = (float*)d_out; a.ws = (unsigned char*)d_ws; a.pad = 0;
#if MK_PER_PHASE
    for (int ph = 0; ph < NPHASE; ++ph) { a.ph_lo = ph; a.ph_hi = ph + 1; a.li = 0; hipLaunchKernelGGL(fwd, dim3(grid), dim3(512), LDS_BYTES, stream, a); }
#elif defined(PROBE_LIST)
    { const int plist[] = {PROBE_LIST}; int cur = 0, li = 0;
      for (int p : plist) { a.ph_lo = cur; a.ph_hi = p + 1; a.li = li++; hipLaunchKernelGGL(fwd, dim3(grid), dim3(512), LDS_BYTES, stream, a);
                            a.ph_lo = p; a.ph_hi = p + 1; a.li = li++; a.pad = 1; hipLaunchKernelGGL(fwd, dim3(grid), dim3(512), LDS_BYTES, stream, a); a.pad = 0; cur = p + 1; }
      if (cur < NPHASE) { a.ph_lo = cur; a.ph_hi = NPHASE; a.li = li++; hipLaunchKernelGGL(fwd, dim3(grid), dim3(512), LDS_BYTES, stream, a); } }
#else
    a.ph_lo = 0; a.ph_hi = NPHASE; a.li = 0; hipLaunchKernelGGL(fwd, dim3(grid), dim3(512), LDS_BYTES, stream, a);
#endif
    const hipError_t le = hipPeekAtLastError();
    if (le != hipSuccess) fprintf(stderr, "kernel_launch: launch failed: %s\n", hipGetErrorName(le));
}
```

```cpp
#include <hip/hip_runtime.h>
#include <cstdio>
#include <cstdint>
#define MK_PER_PHASE 0
namespace pg8 {
#define PG8_LAS __attribute__((address_space(3)))
typedef unsigned short bf16_t;
typedef short bf16x8 __attribute__((ext_vector_type(8)));
typedef float f32x4 __attribute__((ext_vector_type(4)));
typedef unsigned u32x4 __attribute__((ext_vector_type(4)));
constexpr int BM = 256, BK = 64, HALF = 128, HTB = HALF * BK * 2  , STAGE_BYTES = 8 * HTB, NXCD = 8, WGM = 8;

__host__ __device__ __forceinline__ int lds_byte(int r, int c) { const int st = (r >> 4) * 2 + (c >> 5), rr = r & 15, cc = c & 31, ob = rr * 64 + cc * 2; return st * 1024 + (ob ^ (((ob >> 9) & 1) << 5)); }
__host__ __device__ __forceinline__ void stage_rc(int b, int& R, int& C) { const int st = b / 1024, sb = b % 1024, swz = sb ^ (((sb >> 9) & 1) << 5); R = (st >> 1) * 16 + swz / 64; C = (st & 1) * 32 + (swz % 64) / 2; }
__host__ __device__ __forceinline__ int perm32(int rho) { const int n = rho >> 4, i = rho & 15; return 8 * (i >> 2) + 4 * n + (i & 3); }

struct Unit { int pm, pn; };
struct Gemm { const bf16_t* A; const bf16_t* Bt; int M, N, K; };

struct StaticOrder {
    int nM, nN, nwg, G, c;
    __host__ __device__ void init(int M, int N, int G_, int c_) { nM = M / BM; nN = N / BM; nwg = nM * nN; G = G_; c = c_; }
    __host__ __device__ bool next(int i, Unit& u) const {
        const long L = (long)i * G + c; if (L >= nwg) return false;
        int wgid = (int)L; { const int q = nwg / NXCD, r = nwg % NXCD, xcd = wgid % NXCD, off = wgid / NXCD; wgid = (xcd < r ? xcd * (q + 1) : r * (q + 1) + (xcd - r) * q) + off; }
        const int nig = WGM * nN, gid = wgid / nig, fm = gid * WGM, gsz = (nM - fm) < WGM ? (nM - fm) : WGM;
        u.pm = fm + ((wgid % nig) % gsz); u.pn = (wgid % nig) / gsz; return true;
    }
    __device__ __forceinline__ void a_ready(const Unit&) const {}
    __device__ __forceinline__ void done(const Unit&) const {}
};

__device__ __forceinline__ unsigned cvt_pk_bf16(float lo, float hi) { unsigned r; asm volatile("v_cvt_pk_bf16_f32 %0, %1, %2" : "=v"(r) : "v"(lo), "v"(hi)); return r; }
template <class Fn> struct EpiGen {
    static constexpr bool PERM = true, AFTER_DRAIN = false;
    Fn fn;
    __device__ __forceinline__ void operator()(const f32x4 (&acc)[2][2][4][2], const Unit& u, int wr, int wc, int fr, int fq) const {
#pragma unroll
        for (int ai = 0; ai < 2; ++ai)
#pragma unroll
            for (int m = 0; m < 4; ++m) { const int row = u.pm * BM + ai * HALF + wr * 64 + m * 16 + fr;
#pragma unroll
                for (int bj = 0; bj < 2; ++bj) { const int col = u.pn * BM + bj * HALF + wc * 32 + 8 * fq; fn(row, col, acc[ai][bj][m][0], acc[ai][bj][m][1]); } }
    }
};
template <class Epi, class Sched, bool ALIGN_EPI = false, bool SP2 = false, bool GATHER = false>
__device__ __forceinline__ void gemm_phase(PG8_LAS unsigned char* lds, const Gemm g, const Sched& S, const Epi& E) {
    static_assert(!GATHER || SP2, "the gathered A path is written for the SP2 loop");
    const int tid = threadIdx.x, wid = __builtin_amdgcn_readfirstlane(tid >> 6), lane = tid & 63, wr = wid >> 2, wc = wid & 3, fr = lane & 15, fq = lane >> 4;
    const int K = g.K, nt = K / BK;
    unsigned voffA[2], voffB[2]; int gR[2], gC[2]; unsigned gA[2][2], gN[2][2];
#pragma unroll
    for (int i = 0; i < 2; ++i) { int R, C; stage_rc(tid * 16 + i * 8192, R, C); const int Rb = Epi::PERM ? ((R & ~31) + perm32(R & 31)) : R;
        voffA[i] = (unsigned)(R * K + C) * 2u; voffB[i] = (unsigned)(Rb * K + C) * 2u; gR[i] = R; gC[i] = C; }
    const size_t kstep = (size_t)(BK * 2);
    const size_t hstep = (size_t)HALF * K * 2;
    const size_t tstep = 2 * hstep;
    const unsigned ldsw = (unsigned)wid * 1024u;
    const int aoff = lds_byte(wr * 64 + fr, fq * 8), boff = lds_byte(wc * 32 + fr, fq * 8);
#define PG8_SA(b, h) (((b) * 2 + (h)) * HTB)
#define PG8_SB(b, h) ((4 + (b) * 2 + (h)) * HTB)
#define PG8_STAGE(bufoff, gbase, voff) do { _Pragma("unroll") for (int _i = 0; _i < 2; ++_i) \
        __builtin_amdgcn_global_load_lds((const unsigned*)((const char*)(gbase) + (voff)[_i]), (PG8_LAS unsigned*)(lds + (bufoff) + ldsw + _i * 8192), 16, 0, 0); } while (0)
#define PG8_GOFF(u_, out_) do { _Pragma("unroll") for (int _h = 0; _h < 2; ++_h) _Pragma("unroll") for (int _i = 0; _i < 2; ++_i) \
        out_[_h][_i] = ((unsigned)S.src[(u_).pm * BM + _h * HALF + gR[_i]] * (unsigned)K + (unsigned)gC[_i]) * 2u; } while (0)
#define PG8_STAGE_A(bufoff, kptr, h, isnext) do { if constexpr (GATHER) { unsigned _o[2]; _o[0] = (isnext) ? gN[h][0] : gA[h][0]; _o[1] = (isnext) ? gN[h][1] : gA[h][1]; PG8_STAGE(bufoff, kptr, _o); } \
        else { PG8_STAGE(bufoff, (kptr) + (h) * hstep, voffA); } } while (0)
#define PG8_LDA(dst, b, h) do { _Pragma("unroll") for (int m = 0; m < 4; ++m) _Pragma("unroll") for (int k = 0; k < 2; ++k) dst[m][k] = *(const PG8_LAS bf16x8*)(lds + PG8_SA(b, h) + aoff + m * 2048 + k * 1024); } while (0)
#define PG8_LDB(dst, b, h) do { _Pragma("unroll") for (int n = 0; n < 2; ++n) _Pragma("unroll") for (int k = 0; k < 2; ++k) dst[n][k] = *(const PG8_LAS bf16x8*)(lds + PG8_SB(b, h) + boff + n * 2048 + k * 1024); } while (0)
#define PG8_MMA(ai, bj, At, Bt) do { __builtin_amdgcn_s_setprio(1); _Pragma("unroll") for (int m = 0; m < 4; ++m) _Pragma("unroll") for (int n = 0; n < 2; ++n) _Pragma("unroll") for (int k = 0; k < 2; ++k) \
        acc[ai][bj][m][n] = __builtin_amdgcn_mfma_f32_16x16x32_bf16(Bt[n][k], At[m][k], acc[ai][bj][m][n], 0, 0, 0); __builtin_amdgcn_s_setprio(0); } while (0)
#define PG8_WAIT_V(n) asm volatile("s_waitcnt vmcnt(" #n ")" ::: "memory")
#define PG8_WAIT_L(n) asm volatile("s_waitcnt lgkmcnt(" #n ")" ::: "memory")
#define PG8_BAR __builtin_amdgcn_s_barrier()
#define PG8_SCHED __builtin_amdgcn_sched_barrier(0)
    Unit cur, nxt; int ui = 0;
    if (!S.next(0, cur)) return;
    f32x4 acc[2][2][4][2];
#pragma unroll
    for (int a = 0; a < 2; ++a)
#pragma unroll
        for (int b = 0; b < 2; ++b)
#pragma unroll
            for (int m = 0; m < 4; ++m)
#pragma unroll
                for (int n = 0; n < 2; ++n) acc[a][b][m][n] = (f32x4){0.f, 0.f, 0.f, 0.f};
    bf16x8 At[4][2], B0[2][2], B1[2][2];
    const char* cA = (const char*)g.A + (GATHER ? (size_t)0 : (size_t)cur.pm * tstep); const char* cB = (const char*)g.Bt + (size_t)cur.pn * tstep;
    if constexpr (GATHER) PG8_GOFF(cur, gA);
    S.a_ready(cur);
    if constexpr (SP2) {
        PG8_STAGE(PG8_SB(0, 0), cB, voffB); PG8_STAGE(PG8_SB(0, 1), cB + hstep, voffB); PG8_STAGE_A(PG8_SA(0, 0), cA, 0, false); PG8_STAGE_A(PG8_SA(0, 1), cA, 1, false);
        if (wr == 1) PG8_BAR;
        PG8_WAIT_V(2); PG8_BAR;
        PG8_STAGE(PG8_SB(1, 0), cB + kstep, voffB); PG8_STAGE_A(PG8_SA(1, 0), cA + kstep, 0, false); PG8_STAGE(PG8_SB(1, 1), cB + hstep + kstep, voffB);
        PG8_WAIT_V(6); PG8_BAR;
    } else {
        PG8_STAGE(PG8_SB(0, 0), cB, voffB); PG8_STAGE(PG8_SA(0, 0), cA, voffA); PG8_STAGE(PG8_SB(0, 1), cB + hstep, voffB); PG8_STAGE(PG8_SA(0, 1), cA + hstep, voffA);
        if (wr == 1) PG8_BAR;
        PG8_WAIT_V(4); PG8_BAR;
        PG8_STAGE(PG8_SB(1, 0), cB + kstep, voffB); PG8_STAGE(PG8_SA(1, 0), cA + kstep, voffA); PG8_STAGE(PG8_SB(1, 1), cB + hstep + kstep, voffB);
        PG8_WAIT_V(6); PG8_BAR;
    }
    for (;;) {
        const bool has_next = S.next(ui + 1, nxt);
        const char* nA = (has_next && !GATHER) ? (const char*)g.A + (size_t)nxt.pm * tstep : cA; const char* nB = has_next ? (const char*)g.Bt + (size_t)nxt.pn * tstep : cB;
        if constexpr (GATHER) { if (has_next) PG8_GOFF(nxt, gN); else { _Pragma("unroll") for (int _h = 0; _h < 2; ++_h) { gN[_h][0] = gA[_h][0]; gN[_h][1] = gA[_h][1]; } } }
        for (int t = 0; t < nt; t += 2) {
            const bool last = (t == nt - 2);
            const char* a1 = cA + (size_t)(t + 1) * kstep;
            const char* a2 = last ? nA : cA + (size_t)(t + 2) * kstep; const char* b2 = last ? nB : cB + (size_t)(t + 2) * kstep;
            const char* a3 = a2 + kstep; const char* b3 = b2 + kstep;
            if (last && has_next) S.a_ready(nxt);
            if constexpr (SP2) {
            PG8_LDB(B0, 0, 0); PG8_LDB(B1, 0, 1); PG8_SCHED; PG8_LDA(At, 0, 0); PG8_STAGE_A(PG8_SA(1, 1), a1, 1, false);
            PG8_WAIT_V(8); PG8_WAIT_L(0); PG8_BAR; PG8_MMA(0, 0, At, B0); PG8_MMA(0, 1, At, B1); PG8_BAR; PG8_SCHED;
            PG8_LDA(At, 0, 1); PG8_STAGE(PG8_SB(0, 0), b2, voffB); PG8_STAGE(PG8_SB(0, 1), b2 + hstep, voffB); PG8_STAGE_A(PG8_SA(0, 0), a2, 0, last);
            PG8_WAIT_V(8); PG8_WAIT_L(0); PG8_BAR; PG8_MMA(1, 0, At, B0); PG8_MMA(1, 1, At, B1); PG8_BAR; PG8_SCHED;
            PG8_LDB(B0, 1, 0); PG8_LDB(B1, 1, 1); PG8_SCHED; PG8_LDA(At, 1, 0); PG8_STAGE_A(PG8_SA(0, 1), a2, 1, last);
            PG8_WAIT_V(8); PG8_WAIT_L(0); PG8_BAR; PG8_MMA(0, 0, At, B0); PG8_MMA(0, 1, At, B1); PG8_BAR; PG8_SCHED;
            PG8_LDA(At, 1, 1); PG8_STAGE(PG8_SB(1, 0), b3, voffB); PG8_STAGE(PG8_SB(1, 1), b3 + hstep, voffB); PG8_STAGE_A(PG8_SA(1, 0), a3, 0, last);
            PG8_WAIT_V(8); PG8_WAIT_L(0); PG8_BAR; PG8_MMA(1, 0, At, B0); PG8_MMA(1, 1, At, B1); PG8_BAR; PG8_SCHED;
            } else {
            PG8_LDB(B0, 0, 0); PG8_SCHED; PG8_LDA(At, 0, 0); PG8_STAGE(PG8_SA(1, 1), a1 + hstep, voffA);
            PG8_WAIT_L(8); PG8_BAR; PG8_WAIT_L(0); PG8_MMA(0, 0, At, B0); PG8_BAR; PG8_SCHED;
            PG8_LDB(B1, 0, 1); PG8_STAGE(PG8_SB(0, 0), b2, voffB);
            PG8_BAR; PG8_WAIT_L(0); PG8_MMA(0, 1, At, B1); PG8_BAR;
            PG8_LDA(At, 0, 1); PG8_STAGE(PG8_SA(0, 0), a2, voffA);
            PG8_BAR; PG8_WAIT_L(0); PG8_MMA(1, 0, At, B0); PG8_BAR; PG8_SCHED;
            PG8_STAGE(PG8_SB(0, 1), b2 + hstep, voffB);
            PG8_WAIT_V(6); PG8_BAR; PG8_MMA(1, 1, At, B1); PG8_BAR;
            PG8_LDB(B0, 1, 0); PG8_SCHED; PG8_LDA(At, 1, 0); PG8_STAGE(PG8_SA(0, 1), a2 + hstep, voffA);
            PG8_WAIT_L(8); PG8_BAR; PG8_WAIT_L(0); PG8_MMA(0, 0, At, B0); PG8_BAR; PG8_SCHED;
            PG8_LDB(B1, 1, 1); PG8_STAGE(PG8_SB(1, 0), b3, voffB);
            PG8_BAR; PG8_WAIT_L(0); PG8_MMA(0, 1, At, B1); PG8_BAR;
            PG8_LDA(At, 1, 1); PG8_STAGE(PG8_SA(1, 0), a3, voffA);
            PG8_BAR; PG8_WAIT_L(0); PG8_MMA(1, 0, At, B0); PG8_BAR; PG8_SCHED;
            PG8_STAGE(PG8_SB(1, 1), b3 + hstep, voffB);
            PG8_WAIT_V(6); PG8_BAR; PG8_MMA(1, 1, At, B1); PG8_BAR;
            }
        }
        if constexpr (ALIGN_EPI) { if (wr == 0) PG8_BAR; }
        if constexpr (!Epi::AFTER_DRAIN) { E(acc, cur, wr, wc, fr, fq); S.done(cur); }
        if (!has_next) break;
#pragma unroll
        for (int a = 0; a < 2; ++a)
#pragma unroll
            for (int b = 0; b < 2; ++b)
#pragma unroll
                for (int m = 0; m < 4; ++m)
#pragma unroll
                    for (int n = 0; n < 2; ++n) acc[a][b][m][n] = (f32x4){0.f, 0.f, 0.f, 0.f};
        cur = nxt; cA = nA; cB = nB; ++ui;
        if constexpr (GATHER) { _Pragma("unroll") for (int _h = 0; _h < 2; ++_h) { gA[_h][0] = gN[_h][0]; gA[_h][1] = gN[_h][1]; } }
        if constexpr (ALIGN_EPI) { if (wr == 1) PG8_BAR; }
    }
    PG8_WAIT_V(0);
    if constexpr (!ALIGN_EPI) { if (wr == 0) PG8_BAR; }
    PG8_BAR;
    if constexpr (Epi::AFTER_DRAIN) { E.fused(acc, cur, wr, wc, fr, fq, lds, wid, lane); S.done(cur); }
#undef PG8_SA
#undef PG8_SB
#undef PG8_STAGE
#undef PG8_STAGE_A
#undef PG8_GOFF
#undef PG8_LDA
#undef PG8_LDB
#undef PG8_MMA
#undef PG8_WAIT_V
#undef PG8_WAIT_L
#undef PG8_BAR
#undef PG8_SCHED
}
}
#define GAS __attribute__((address_space(1)))
#define LAS __attribute__((address_space(3)))
typedef unsigned short bf16;
typedef unsigned v4u __attribute__((ext_vector_type(4)));
typedef unsigned v2u __attribute__((ext_vector_type(2)));
typedef float f32x4 __attribute__((ext_vector_type(4)));
typedef short bf16x8 __attribute__((ext_vector_type(8)));
typedef GAS unsigned gu32;
typedef GAS unsigned long long gu64;
#define RLX_AGENT __ATOMIC_RELAXED, __HIP_MEMORY_SCOPE_AGENT
#define LDS_WAIT() asm volatile("s_waitcnt lgkmcnt(0)" ::: "memory")
#define VM_WAIT() asm volatile("s_waitcnt vmcnt(0)" ::: "memory")
typedef float f32x2_cv __attribute__((ext_vector_type(2)));
typedef __bf16 bf16x2_cv __attribute__((ext_vector_type(2)));
__device__ __forceinline__ unsigned pk2(float lo, float hi) { const f32x2_cv v = {lo, hi}; return __builtin_bit_cast(unsigned, __builtin_convertvector(v, bf16x2_cv)); }
__device__ __forceinline__ unsigned f2bf(float f) { return (unsigned)__builtin_bit_cast(unsigned short, (__bf16)f); }
__device__ __forceinline__ float bflo(unsigned w) { return __builtin_bit_cast(float, w << 16); }
__device__ __forceinline__ float bfhi(unsigned w) { return __builtin_bit_cast(float, w & 0xffff0000u); }
__device__ __forceinline__ float bf2f(bf16 b) { return __builtin_bit_cast(float, (unsigned)b << 16); }
__device__ __forceinline__ float wave_sum(float v) {
#pragma unroll
    for (int o = 1; o < 64; o <<= 1) v += __shfl_xor(v, o);
    return v;
}
__device__ __forceinline__ float sigmoidf_(float x) { return 1.f / (1.f + __expf(-x)); }

#define XB_TMO      128
#define XB_XCNT(j)  (256  + 64 * (j))
#define XB_XSUB(j)  (1280 + 64 * (j))
#define XB_XGEN(j)  (2304 + 64 * (j))
#define XB_TOP      3328
#define XB_TOPGEN   3392
#define XCD_BAR_WORDS 3456
#define XB_SPIN_CAP (1u << 22)

__device__ __forceinline__ unsigned xb_ld(unsigned* p)              { return __hip_atomic_load(p, __ATOMIC_RELAXED, __HIP_MEMORY_SCOPE_AGENT); }
__device__ __forceinline__ unsigned xb_add(unsigned* p, unsigned v) { return __hip_atomic_fetch_add(p, v, __ATOMIC_RELAXED, __HIP_MEMORY_SCOPE_AGENT); }
__device__ __forceinline__ unsigned xb_xcc_id() { return (unsigned)__builtin_amdgcn_s_getreg((3 << 11) | 20) & 0xFu; }
#define XB_SPIN(cond, bar) do { unsigned _sp = 0; while (cond) { __builtin_amdgcn_s_sleep(1); \
    if ((++_sp & 255u) == 0u) { if (xb_ld(&(bar)[XB_TMO])) break; if (_sp > XB_SPIN_CAP) { atomicAdd(&(bar)[XB_TMO], 1u); break; } } } } while (0)

struct XcdBarrier {
    unsigned* bar; unsigned x;
    volatile LAS unsigned* st;
};

__device__ __forceinline__ XcdBarrier xcd_barrier_post(unsigned* bar, volatile LAS unsigned* st) {
    XcdBarrier b; b.bar = bar; b.x = xb_xcc_id(); b.st = st;
    if (threadIdx.x == 0) (void)xb_add(&bar[XB_XCNT(b.x)], 1u);
    return b;
}
__device__ __forceinline__ void xcd_barrier_complete(unsigned* bar, unsigned x, unsigned& nloc, unsigned& nx) {
    const unsigned G = gridDim.x * gridDim.y * gridDim.z;
    unsigned sum, cnt, mine, sp = 0u;
    for (;;) {
        sum = 0u; cnt = 0u; mine = 0u;
#pragma unroll
        for (unsigned j = 0; j < 16; ++j) { const unsigned c = xb_ld(&bar[XB_XCNT(j)]); sum += c; cnt += (c > 0u) ? 1u : 0u; mine = (j == x) ? c : mine; }
        if (sum == G) break;
        __builtin_amdgcn_s_sleep(1);
        if ((++sp & 255u) == 0u) { if (xb_ld(&bar[XB_TMO])) break; if (sp > XB_SPIN_CAP) { atomicAdd(&bar[XB_TMO], 1u); break; } }
    }
    nloc = mine > 0u ? mine : 1u; nx = cnt > 0u ? cnt : 1u;
}

__device__ __forceinline__ void xcd_barrier(const XcdBarrier& b) {
    asm volatile("s_waitcnt vmcnt(0)" ::: "memory");
    __syncthreads();
    if (threadIdx.x == 0) {
        unsigned* bar = b.bar;
        __builtin_amdgcn_s_waitcnt(0);
        unsigned nloc = b.st[0], nx = b.st[1];
        if (nloc == 0u) { xcd_barrier_complete(bar, b.x, nloc, nx); b.st[0] = nloc; b.st[1] = nx; }
        const unsigned old = xb_add(&bar[XB_XSUB(b.x)], 1u);
        const unsigned gen = old / nloc;
        if (old + 1u == (gen + 1u) * nloc) {
            __builtin_amdgcn_fence(__ATOMIC_RELEASE, "agent");
            asm volatile("s_waitcnt vmcnt(0)" ::: "memory");
            const unsigned og = xb_add(&bar[XB_TOP], 1u);
            const unsigned tg = og / nx;
            if (og + 1u == (tg + 1u) * nx) xb_add(&bar[XB_TOPGEN], 1u);
            else XB_SPIN(xb_ld(&bar[XB_TOPGEN]) == tg, bar);
            __builtin_amdgcn_fence(__ATOMIC_ACQUIRE, "agent");
            xb_add(&bar[XB_XGEN(b.x)], 1u);
            asm volatile("s_waitcnt vmcnt(0)" ::: "memory");
        } else {
            XB_SPIN(xb_ld(&bar[XB_XGEN(b.x)]) == gen, bar);
            __builtin_amdgcn_fence(__ATOMIC_ACQUIRE, "agent");
            asm volatile("s_waitcnt vmcnt(0)" ::: "memory");
        }
    }
    __syncthreads();
}
namespace att {
using s16x4  = __attribute__((ext_vector_type(4))) short;
using f32x16 = __attribute__((ext_vector_type(16))) float;
using u32x4  = __attribute__((ext_vector_type(4))) unsigned;
#define ATT_SBAR() __builtin_amdgcn_sched_barrier(0)
constexpr float THR2 = 11.5f;
__device__ __forceinline__ int crow(int r, int hi) { return (r & 3) + 8 * (r >> 2) + 4 * hi; }
__device__ __forceinline__ unsigned cvtpk(float lo, float hi) { unsigned r; asm volatile("v_cvt_pk_bf16_f32 %0, %1, %2" : "=v"(r) : "v"(lo), "v"(hi)); return r; }

__device__ __forceinline__ void partialSM(f32x16& p0, f32x16& p1, float& m_reg, float& mn, float& alpha) {
  float pmax = p0[0];
#pragma unroll
  for (int r = 1; r < 16; ++r) pmax = fmaxf(pmax, p0[r]);
#pragma unroll
  for (int r = 0; r < 16; ++r) pmax = fmaxf(pmax, p1[r]);
  { auto rr = __builtin_amdgcn_permlane32_swap(__float_as_uint(pmax), __float_as_uint(pmax), false, false);
    pmax = fmaxf(__uint_as_float(rr[0]), __uint_as_float(rr[1])); }
  if (__builtin_expect(__all(pmax - m_reg <= THR2), 1)) { mn = m_reg; alpha = 1.f; }
  else { mn = fmaxf(m_reg, pmax); alpha = __builtin_amdgcn_exp2f(m_reg - mn); m_reg = mn; }
#pragma unroll
  for (int r = 0; r < 16; ++r) p0[r] = p0[r] - mn;
#pragma unroll
  for (int r = 0; r < 16; ++r) p1[r] = p1[r] - mn;
#pragma unroll
  for (int r = 0; r < 16; ++r) p0[r] = __builtin_amdgcn_exp2f(p0[r]);
}
__device__ __forceinline__ void finishSM(f32x16& p0, f32x16& p1, bf16x8& pa0, bf16x8& pa1, bf16x8& pa2, bf16x8& pa3) {
#pragma unroll
  for (int r = 0; r < 16; ++r) p1[r] = __builtin_amdgcn_exp2f(p1[r]);
#define ATT_PK4(P, BASE, OUT) do { unsigned a0 = cvtpk(P[BASE + 0], P[BASE + 1]), a1 = cvtpk(P[BASE + 2], P[BASE + 3]);   \
    unsigned b0 = cvtpk(P[BASE + 4], P[BASE + 5]), b1 = cvtpk(P[BASE + 6], P[BASE + 7]);                              \
    auto r0 = __builtin_amdgcn_permlane32_swap(a0, b0, false, false); auto r1 = __builtin_amdgcn_permlane32_swap(a1, b1, false, false); \
    u32x4 w = {r0[0], r1[0], r0[1], r1[1]}; OUT = *reinterpret_cast<bf16x8*>(&w); } while (0)
  ATT_PK4(p0, 0, pa0); ATT_PK4(p0, 8, pa1); ATT_PK4(p1, 0, pa2); ATT_PK4(p1, 8, pa3);
#undef ATT_PK4
}
template <int NB> __device__ __forceinline__ int v_st(int k, int c) { const int kk = (k & ~0xC) | ((k & 4) << 1) | ((k & 8) >> 1); return ((kk >> 3) * NB + (c >> 5)) * 512 + ((kk & 7) * 32 + (c & 31)) * 2; }
__device__ __forceinline__ int v_rd_base(int lane) { return ((lane & 3) << 3) | (((lane >> 2) & 3) << 6) | (((lane >> 4) & 1) << 5) | (((lane >> 5) & 1) << 8); }
template <int OFF> __device__ __forceinline__ s16x4 tr_read(int vb) {
  s16x4 r; asm volatile("ds_read_b64_tr_b16 %0, %1 offset:%2" : "=&v"(r) : "v"(vb), "i"(OFF) : "memory"); return r;
}
template <int NB, int D0> __device__ __forceinline__ void pv_one(f32x16& od, int vb, bf16x8 pa0, bf16x8 pa1, bf16x8 pa2, bf16x8 pa3) {
#define ATT_VOFF(ks, half) (D0 * 512 + (ks) * (NB * 1024) + (half) * (NB * 512))
  const s16x4 l0 = tr_read<ATT_VOFF(0, 0)>(vb), h0 = tr_read<ATT_VOFF(0, 1)>(vb), l1 = tr_read<ATT_VOFF(1, 0)>(vb), h1 = tr_read<ATT_VOFF(1, 1)>(vb);
  const s16x4 l2 = tr_read<ATT_VOFF(2, 0)>(vb), h2 = tr_read<ATT_VOFF(2, 1)>(vb), l3 = tr_read<ATT_VOFF(3, 0)>(vb), h3 = tr_read<ATT_VOFF(3, 1)>(vb);
#undef ATT_VOFF
  asm volatile("s_waitcnt lgkmcnt(0)" ::: "memory"); ATT_SBAR();
#define ATT_PK(L, H) (bf16x8){L[0], L[1], L[2], L[3], H[0], H[1], H[2], H[3]}
  od = __builtin_amdgcn_mfma_f32_32x32x16_bf16(pa0, ATT_PK(l0, h0), od, 0, 0, 0);
  od = __builtin_amdgcn_mfma_f32_32x32x16_bf16(pa1, ATT_PK(l1, h1), od, 0, 0, 0);
  od = __builtin_amdgcn_mfma_f32_32x32x16_bf16(pa2, ATT_PK(l2, h2), od, 0, 0, 0);
  od = __builtin_amdgcn_mfma_f32_32x32x16_bf16(pa3, ATT_PK(l3, h3), od, 0, 0, 0);
#undef ATT_PK
}
template <int NB> __device__ __forceinline__ void pv_all(f32x16* o, f32x16& lsum, int vb, bf16x8 pa0, bf16x8 pa1, bf16x8 pa2, bf16x8 pa3) {
  const bf16x8 ones = {0x3F80, 0x3F80, 0x3F80, 0x3F80, 0x3F80, 0x3F80, 0x3F80, 0x3F80};
  lsum = __builtin_amdgcn_mfma_f32_32x32x16_bf16(pa0, ones, lsum, 0, 0, 0); lsum = __builtin_amdgcn_mfma_f32_32x32x16_bf16(pa1, ones, lsum, 0, 0, 0);
  pv_one<NB, 0>(o[0], vb, pa0, pa1, pa2, pa3); pv_one<NB, 1>(o[1], vb, pa0, pa1, pa2, pa3);
  lsum = __builtin_amdgcn_mfma_f32_32x32x16_bf16(pa2, ones, lsum, 0, 0, 0); lsum = __builtin_amdgcn_mfma_f32_32x32x16_bf16(pa3, ones, lsum, 0, 0, 0);
  if constexpr (NB == 4) { pv_one<NB, 2>(o[2], vb, pa0, pa1, pa2, pa3); pv_one<NB, 3>(o[3], vb, pa0, pa1, pa2, pa3); }
}
template <int DK> __device__ __forceinline__ void qkt(f32x16& p0, f32x16& p1, LAS const char* Ks, const bf16x8* qr, int r32, int hi) {
  constexpr int KSTR = DK * 2 + 16;
  p0 = f32x16{}; p1 = f32x16{};
#pragma unroll
  for (int d0 = 0; d0 < DK / 16; ++d0) { const int cb = (d0 * 16 + hi * 8) * 2;
    const bf16x8 b0 = *(LAS const bf16x8*)(Ks + r32 * KSTR + cb);
    const bf16x8 b1 = *(LAS const bf16x8*)(Ks + (32 + r32) * KSTR + cb);
    p0 = __builtin_amdgcn_mfma_f32_32x32x16_bf16(b0, qr[d0], p0, 0, 0, 0);
    p1 = __builtin_amdgcn_mfma_f32_32x32x16_bf16(b1, qr[d0], p1, 0, 0, 0); }
}
template <int DK, int DV> struct Cfg {
  static constexpr int KSTR = DK * 2 + 16, KT = 64 * KSTR, NB = DV / 32, VT = 64 * DV * 2, NQ = DK / 16;
  static constexpr int NKC = DK / 8, NVC = DV / 8;
  static constexpr int KN = (64 * NKC + 511) / 512, VN = (64 * NVC + 511) / 512;
  static constexpr int OFF_V = 0, OFF_K = 2 * VT, OFF_WS = 2 * VT + 2 * KT, LDS_BYTES = OFF_WS + 8 * 64 * 4;
};
template <int DK, int DV>
__device__ __forceinline__ void attn_unit(const bf16* __restrict__ Qb, int ldq, const bf16* __restrict__ K1, int ldk1, const bf16* __restrict__ K2, int ldk2,
                                          const bf16* __restrict__ Vh, int ldv, float* __restrict__ Ob, int ldo, int nkeys, LAS char* lds) {
  using C = Cfg<DK, DV>;
  const int tid = threadIdx.x, wid = tid >> 6, lane = tid & 63, r32 = lane & 31, hi = lane >> 5;
  LAS char* V_lds = lds + C::OFF_V; LAS char* K_lds = lds + C::OFF_K;
  LAS float* ws = (LAS float*)(lds + C::OFF_WS) + wid * 64; LAS float* li_l = ws; LAS float* al_l = ws + 32;
  float m_reg = -1e30f; f32x16 o[C::NB] = {}; f32x16 lsum = {}; bf16x8 qr[C::NQ];
  { const bf16* Qw = Qb + (long)(wid * 32 + r32) * ldq + hi * 8;
#pragma unroll
    for (int d0 = 0; d0 < C::NQ; ++d0) qr[d0] = *(const bf16x8*)(Qw + d0 * 16); }
  unsigned kg[C::KN], kw[C::KN], vg[C::VN], vw[C::VN]; const bool k2val = tid < 256;
  kg[0] = (unsigned)((tid >> 3) * ldk1 + (tid & 7) * 8); kw[0] = (unsigned)((tid >> 3) * C::KSTR + (tid & 7) * 16);
  if constexpr (C::KN == 2) { const int t2 = tid & 255; kg[1] = (unsigned)((t2 >> 2) * ldk2 + (t2 & 3) * 8); kw[1] = (unsigned)((t2 >> 2) * C::KSTR + (8 + (t2 & 3)) * 16); }
#pragma unroll
  for (int i = 0; i < C::VN; ++i) { const int it = tid + 512 * i, vrow = it / C::NVC, vcol = (it % C::NVC) * 8; vg[i] = (unsigned)(vrow * ldv + vcol); vw[i] = (unsigned)v_st<C::NB>(vrow, vcol); }
  const int vb0 = (int)(uintptr_t)V_lds + v_rd_base(lane);
  struct Slot { bf16x8 ks[C::KN], vs[C::VN]; } sA, sB;
#define ATT_SLOAD(S, k0) do { S.ks[0] = *(const bf16x8*)(K1 + (size_t)(k0) * ldk1 + kg[0]); if constexpr (C::KN == 2) S.ks[1] = *(const bf16x8*)(K2 + (size_t)(k0) * ldk2 + kg[1]); \
    _Pragma("unroll") for (int i = 0; i < C::VN; ++i) S.vs[i] = *(const bf16x8*)(Vh + (size_t)(k0) * ldv + vg[i]); } while (0)
#define ATT_SWRITE(b, S) do { *(LAS bf16x8*)(K_lds + (b) * C::KT + kw[0]) = S.ks[0]; if constexpr (C::KN == 2) { if (k2val) *(LAS bf16x8*)(K_lds + (b) * C::KT + kw[1]) = S.ks[1]; } \
    _Pragma("unroll") for (int i = 0; i < C::VN; ++i) *(LAS bf16x8*)(V_lds + (b) * C::VT + vw[i]) = S.vs[i]; } while (0)
#define ATT_SWAIT() asm volatile("s_waitcnt vmcnt(3)" ::: "memory")
#define ATT_RESC(a) do { if (__any((a) < 1.f)) { if (hi == 0) al_l[r32] = (a); asm volatile("s_waitcnt lgkmcnt(0)" ::: "memory"); \
    _Pragma("unroll") for (int r = 0; r < 16; ++r) { const float f_ = al_l[crow(r, hi)]; lsum[r] *= f_; _Pragma("unroll") for (int d = 0; d < C::NB; ++d) o[d][r] *= f_; } } } while (0)
  static_assert(C::KN + C::VN == 3, "three staging loads per thread per tile (ATT_SWAIT)");
  f32x16 pA0, pA1, pB0, pB1; float mnA, mnB, alA, alB; bf16x8 pa0, pa1, pa2, pa3; const int NT = nkeys / 64;
  __syncthreads();
  ATT_SLOAD(sA, 0); asm volatile("s_waitcnt vmcnt(0)" ::: "memory"); ATT_SWRITE(0, sA); __syncthreads();
  qkt<DK>(pA0, pA1, K_lds, qr, r32, hi); partialSM(pA0, pA1, m_reg, mnA, alA);
  ATT_SLOAD(sB, 64); if (2 < NT) ATT_SLOAD(sA, 128);
  ATT_SWAIT(); ATT_SWRITE(1, sB); __syncthreads();
  for (int j = 1; j + 1 < NT; j += 2) {
    ATT_SBAR(); qkt<DK>(pB0, pB1, K_lds + C::KT, qr, r32, hi);
    finishSM(pA0, pA1, pa0, pa1, pa2, pa3); ATT_SBAR();
    ATT_SLOAD(sB, (j + 2) * 64); ATT_SBAR();
    pv_all<C::NB>(o, lsum, vb0, pa0, pa1, pa2, pa3); partialSM(pB0, pB1, m_reg, mnB, alB);
    __syncthreads(); ATT_SWAIT(); ATT_SWRITE(0, sA);
    ATT_RESC(alB); __syncthreads();
    ATT_SBAR(); qkt<DK>(pA0, pA1, K_lds, qr, r32, hi);
    finishSM(pB0, pB1, pa0, pa1, pa2, pa3); ATT_SBAR();
    if (j + 3 < NT) ATT_SLOAD(sA, (j + 3) * 64); ATT_SBAR();
    pv_all<C::NB>(o, lsum, vb0 + C::VT, pa0, pa1, pa2, pa3); partialSM(pA0, pA1, m_reg, mnA, alA);
    __syncthreads(); ATT_SWAIT(); ATT_SWRITE(1, sB);
    ATT_RESC(alA); __syncthreads();
  }
  ATT_SBAR(); qkt<DK>(pB0, pB1, K_lds + C::KT, qr, r32, hi);
  finishSM(pA0, pA1, pa0, pa1, pa2, pa3); ATT_SBAR();
  pv_all<C::NB>(o, lsum, vb0, pa0, pa1, pa2, pa3); partialSM(pB0, pB1, m_reg, mnB, alB);
  __syncthreads(); ATT_RESC(alB);
  finishSM(pB0, pB1, pa0, pa1, pa2, pa3); ATT_SBAR();
  pv_all<C::NB>(o, lsum, vb0 + C::VT, pa0, pa1, pa2, pa3);
  float rli[16];
#pragma unroll
  for (int r = 0; r < 16; ++r) rli[r] = __builtin_amdgcn_rcpf(lsum[r]);
  float* Ow = Ob + (long)(wid * 32) * ldo;
#pragma unroll
  for (int r = 0; r < 16; ++r) { const int orow = crow(r, hi);
#pragma unroll
    for (int d0 = 0; d0 < C::NB; ++d0) Ow[(long)orow * ldo + d0 * 32 + r32] = o[d0][r] * rli[r]; }
#undef ATT_SLOAD
#undef ATT_SWRITE
#undef ATT_SWAIT
#undef ATT_RESC
}
}
constexpr int DM = 1024, NBATCH = 2, SEQ = 16384, CT = 256, TB = SEQ + CT  , R = NBATCH * TB  ;
constexpr int ATT_IN = 2208, ATT_NP = 2304, REC_IN = 3472, REC_NP = 3584, RWKV_IN = 1920;
constexpr int NE = 32, TOPK = 4, MAXT = R * TOPK / 256 + NE  , MAXROWS = MAXT * 256;
constexpr int NUNIT_M = 16 * 260;
constexpr float NORM_EPS = 1e-6f;
enum { I_X = 0, I_C, I_CTX, I_CCTX, I_NMIX, I_NFFN, I_ADAW, I_ADAB, I_WOUT, I_RW, I_RB, I_W1, I_B1, I_W2, I_B2, I_ATTW, I_LAM, I_SUBLN, I_QNW, I_KVNW, I_WUQ, I_WUKV,
       I_RECW, I_MU, I_W0, I_RW2, I_A0, I_A2, I_G2, I_KK, I_KA, I_RK, I_LNW, I_LNB, I_GATEB, I_MNW, I_FNW, N_IN };
constexpr size_t al256(size_t x) { return (x + 255) & ~(size_t)255; }
constexpr size_t WS_CTL = 0, CTL_ZERO_BYTES = 1u << 20;
constexpr size_t WS_MOD = CTL_ZERO_BYTES;
constexpr size_t WS_ROPE = al256(WS_MOD + 2 * 3 * 6144 * 4);
constexpr size_t ROPE_DR = 0, ROPE_DC = 256 * 16 * 2, ROPE_MR = ROPE_DC + 64 * 16 * 2, ROPE_MC = ROPE_MR + 256 * 8 * 2, ROPE_FLOATS = ROPE_MC + 64 * 8 * 2;
constexpr size_t WS_WRH = al256(WS_ROPE + ROPE_FLOATS * 4);
constexpr size_t WS_WRL = al256(WS_WRH + (size_t)2 * 32 * 1024 * 2);
constexpr size_t WS_WIN0 = al256(WS_WRL + (size_t)2 * 32 * 1024 * 2);
constexpr size_t WS_WUQ = al256(WS_WIN0 + (size_t)ATT_NP * 1024 * 2);
constexpr size_t WS_WUKV = al256(WS_WUQ + (size_t)768 * 384 * 2);
constexpr size_t WS_WOUT = al256(WS_WUKV + (size_t)1024 * 256 * 2);
constexpr size_t WS_WREC = al256(WS_WOUT + (size_t)2 * 1024 * 1024 * 2);
constexpr size_t WS_WLORA = al256(WS_WREC + (size_t)REC_NP * 1024 * 2);
constexpr size_t WS_W1T = al256(WS_WLORA + (size_t)2560 * 384 * 2);
constexpr size_t WS_W2T = al256(WS_W1T + (size_t)NE * 2048 * 1024 * 2);
constexpr size_t WS_H = al256(WS_W2T + (size_t)NE * 1024 * 1024 * 2);
constexpr size_t WS_A = al256(WS_H + (size_t)R * 1024 * 4);
constexpr size_t WS_A1 = al256(WS_A + (size_t)R * 1024 * 2);
constexpr size_t WS_F = al256(WS_A1 + (size_t)R * 1024 * 2);
constexpr size_t WS_P = al256(WS_F + (size_t)R * 1024 * 2);
constexpr size_t WS_TOPE = al256(WS_P + (size_t)R * REC_NP * 2);
constexpr size_t WS_GATE = al256(WS_TOPE + (size_t)R * 16);
constexpr size_t WS_POS = al256(WS_GATE + (size_t)R * 16);
constexpr size_t WS_DEST = al256(WS_POS + (size_t)R * 16);
constexpr size_t WS_TILE = al256(WS_DEST + (size_t)R * 16);
constexpr size_t WS_SRC = al256(WS_TILE + (size_t)(MAXT + 8) * 4);
constexpr size_t WS_T = al256(WS_SRC + (size_t)MAXROWS * 4);
constexpr size_t WS_QD = WS_T;
constexpr size_t WS_KD = al256(WS_QD + (size_t)R * 512 * 2);
constexpr size_t WS_CQN = al256(WS_KD + (size_t)R * 512 * 2);
constexpr size_t WS_CKVN = al256(WS_CQN + (size_t)R * 384 * 2);
constexpr size_t WS_MQ = al256(WS_CKVN + (size_t)R * 256 * 2);
constexpr size_t WS_MKV = al256(WS_MQ + (size_t)R * 768 * 2);
constexpr size_t WS_KRR = al256(WS_MKV + (size_t)R * 1024 * 2);
constexpr size_t WS_ODIFF = al256(WS_KRR + (size_t)R * 32 * 2);
constexpr size_t WS_OMLA = al256(WS_ODIFF + (size_t)R * 1024 * 4);
constexpr size_t WS_T0_END = al256(WS_OMLA + (size_t)R * 512 * 4);
constexpr size_t WS_XS = WS_T;
constexpr size_t WS_HS = al256(WS_XS + (size_t)MAXROWS * 1024 * 2);
constexpr size_t WS_TM_END = al256(WS_HS + (size_t)MAXROWS * 1024 * 2);
constexpr size_t SZ_RC = (size_t)R * 512 * 4;
constexpr size_t WS_RR = WS_T, WS_VV = WS_RR + SZ_RC, WS_AKK = WS_VV + SZ_RC, WS_KL = WS_AKK + SZ_RC;
constexpr size_t WS_WDEC = WS_KL + SZ_RC  , WS_KDIR = WS_WDEC + 2 * SZ_RC  , WS_BB = WS_KDIR + 2 * SZ_RC  , WS_GG = WS_BB + 2 * SZ_RC;
constexpr size_t WS_ALORA = al256(WS_GG + SZ_RC);
constexpr size_t WS_YR = al256(WS_ALORA + (size_t)R * 384 * 2);
constexpr size_t WS_DC = WS_YR;
constexpr size_t WS_HM = al256(WS_YR + 2 * SZ_RC);
constexpr size_t WS_CST = al256(WS_HM + 2 * SZ_RC);
constexpr size_t WS_DN = al256(WS_CST + (size_t)NUNIT_M * 8192 * 4);
constexpr size_t WS_NST = al256(WS_DN + (size_t)NUNIT_M * 64 * 4);
constexpr size_t WS_SC = al256(WS_NST + (size_t)NUNIT_M * 64 * 4);
constexpr size_t WS_MST = al256(WS_SC + (size_t)NUNIT_M * 2 * 4);
constexpr size_t WS_ASIG = WS_KDIR;
constexpr size_t WS_YB = WS_BB;
constexpr int NUNIT_R = 32 * 260;
constexpr size_t WS_RKM = WS_KDIR + SZ_RC;
static_assert((size_t)NUNIT_R * 4096 * 2 <= SZ_RC, "M^T fits in KL");
constexpr size_t WS_RKQ = al256(WS_MST + (size_t)NUNIT_M * 4);
constexpr size_t WS_RKZ = al256(WS_RKQ + (size_t)NUNIT_R * 4096 * 2);
constexpr size_t WS_T1_END = al256(WS_RKZ + (size_t)NUNIT_R * 4096 * 2);
constexpr size_t WS_END = WS_T1_END > WS_TM_END ? (WS_T1_END > WS_T0_END ? WS_T1_END : WS_T0_END) : (WS_TM_END > WS_T0_END ? WS_TM_END : WS_T0_END);
static_assert(WS_END <= (size_t)2147483648ull, "workspace map exceeds 2 GiB");
constexpr int CW_CNT = 1024;
constexpr int CW_BAR = 4096;
constexpr int RING_BYTES = 131072, AUX_OFF = 131072, AUX_BYTES = 16384, MISC_OFF = 147456, LDS_BYTES = 163840;

struct Frame {
    LAS unsigned char* lds; gu32* ctl; int tid, lane, wave, blk, G, probe;
    float* out; unsigned char* ws;
    struct InTab { LAS const unsigned* t;
        __device__ __forceinline__ const float* operator[](int i) const { const unsigned lo = __builtin_amdgcn_readfirstlane(t[2 * i]), hi = __builtin_amdgcn_readfirstlane(t[2 * i + 1]);
            return (const float*)(((unsigned long long)hi << 32) | lo); } } in;
};
template <class T> __device__ __forceinline__ T* wsp(const Frame& F, size_t off) { return (T*)(F.ws + off); }
__device__ __forceinline__ int row_sel(int row) { const int b = row / TB, t = row - b * TB; return t < CT ? 2 : b; }
__device__ __forceinline__ const float* h0_row(const Frame& F, int row) {
    const int b = row / TB, t = row - b * TB;
    return t < CT ? F.in[I_CTX] + ((size_t)b * CT + t) * DM : F.in[I_X] + ((size_t)b * SEQ + (t - CT)) * DM;
}
__device__ __forceinline__ const float* modp(const Frame& F, int layer, int sel, int chunk) { return wsp<const float>(F, WS_MOD) + ((size_t)(layer * 3 + sel) * 6 + chunk) * DM; }
__device__ __forceinline__ int scan_tok(int z, int sg) { return z == 0 ? sg : (sg < CT ? CT - 1 - sg : TB + CT - 1 - sg); }
__device__ __forceinline__ void tr_item(const float* W, int K, int N, bf16* WT, int row_off, LAS float* scr, int kb, int nb, int lane) {
    const int k0 = 64 * kb, n0 = 32 * nb;
    const int n = n0 + (lane & 31);
    float tv[32];
#pragma unroll
    for (int i = 0; i < 32; ++i) { const int kk = 2 * i + (lane >> 5); tv[i] = (n < N) ? W[(size_t)(k0 + kk) * N + n] : 0.f; }
#pragma unroll
    for (int i = 0; i < 32; ++i) { const int kk = 2 * i + (lane >> 5); scr[kk * 33 + (lane & 31)] = tv[i]; }
    LDS_WAIT(); asm volatile("" ::: "memory");
    const int c = lane & 7;
#pragma unroll
    for (int j = 0; j < 4; ++j) { const int nn = (lane >> 3) + 8 * j; const LAS float* s = scr + (8 * c) * 33 + nn;
        v4u o; o.x = pk2(s[0 * 33], s[1 * 33]); o.y = pk2(s[2 * 33], s[3 * 33]); o.z = pk2(s[4 * 33], s[5 * 33]); o.w = pk2(s[6 * 33], s[7 * 33]);
        *(v4u*)(WT + (size_t)(row_off + n0 + nn) * K + k0 + 8 * c) = o; }
    LDS_WAIT(); asm volatile("" ::: "memory");
}
__device__ __forceinline__ void tr_family(const Frame& F, const float* W, size_t src_stride, int nmat, int K, int N, int Npad, bf16* WT, int gw, int NGW) {
    LAS float* scr = (LAS float*)(F.lds + F.wave * 16384);
    const int nkb = K / 64, nnb = Npad / 32, per = nkb * nnb, total = per * nmat;
    for (int it = gw; it < total; it += NGW) { const int m = it / per, r = it - m * per, kb = r / nnb, nb = r - kb * nnb;
        tr_item(W + (size_t)m * src_stride, K, N, WT, m * Npad, scr, kb, nb, F.lane); }
}
__device__ __forceinline__ void moe_weights_convert(const Frame& F, int layer, int gw, int NGW) {
    tr_family(F, F.in[I_W1] + (size_t)layer * NE * 1024 * 2048, (size_t)1024 * 2048, NE, 1024, 2048, 2048, wsp<bf16>(F, WS_W1T), gw, NGW);
    tr_family(F, F.in[I_W2] + (size_t)layer * NE * 1024 * 1024, (size_t)1024 * 1024, NE, 1024, 1024, 1024, wsp<bf16>(F, WS_W2T), gw, NGW);
}
__device__ __forceinline__ void norm_mod_row(const Frame& F, const float* src, const float* nw, const float* shift, const float* scale, bf16* orow) {
    const f32x4* xr = (const f32x4*)src + F.lane;
    f32x4 v[4]; float s = 0.f;
#pragma unroll
    for (int j = 0; j < 4; ++j) { v[j] = xr[64 * j]; s += (v[j].x * v[j].x + v[j].y * v[j].y) + (v[j].z * v[j].z + v[j].w * v[j].w); }
    const float rs = 1.f / sqrtf(wave_sum(s) * (1.f / DM) + NORM_EPS);
    unsigned long long* o8 = (unsigned long long*)orow + F.lane;
#pragma unroll
    for (int j = 0; j < 4; ++j) { const f32x4 w = ((const f32x4*)nw)[F.lane + 64 * j], sh = ((const f32x4*)shift)[F.lane + 64 * j], sc = ((const f32x4*)scale)[F.lane + 64 * j];
        const f32x4 y = v[j] * rs * w * (sc + 1.f) + sh;
        o8[64 * j] = (unsigned long long)pk2(y.x, y.y) | ((unsigned long long)pk2(y.z, y.w) << 32); }
}
__device__ __forceinline__ void p0a(const Frame& F) {
    LAS float* sv = (LAS float*)F.lds; LAS float* red = (LAS float*)(F.lds + 16384);
    for (int i = F.tid; i < 3 * DM; i += 512) { const int s = i / DM, k = i - s * DM; const float cv = (s < 2) ? F.in[I_C][s * DM + k] : F.in[I_CCTX][k]; sv[i] = cv / (1.f + __expf(-cv)); }
    __syncthreads();
    for (int it = F.blk; it < 192; it += F.G) {
        const int l = it / 96, cgp = it - l * 96, kq = F.tid >> 4, cg = F.tid & 15, col = cgp * 64 + cg * 4;
        float acc[3][4];
#pragma unroll
        for (int s = 0; s < 3; ++s)
#pragma unroll
            for (int j = 0; j < 4; ++j) acc[s][j] = 0.f;
        const float* W = F.in[I_ADAW] + (size_t)l * DM * 6144 + col;
#pragma unroll 16
        for (int kk = 0; kk < 32; ++kk) { const int k = kq * 32 + kk; const f32x4 w = *(const f32x4*)(W + (size_t)k * 6144);
            const float s0 = sv[k], s1 = sv[DM + k], s2 = sv[2 * DM + k];
#pragma unroll
            for (int j = 0; j < 4; ++j) { acc[0][j] += s0 * w[j]; acc[1][j] += s1 * w[j]; acc[2][j] += s2 * w[j]; } }
#pragma unroll
        for (int s = 0; s < 3; ++s)
#pragma unroll
            for (int j = 0; j < 4; ++j) red[(kq * 16 + cg) * 12 + s * 4 + j] = acc[s][j];
        __syncthreads();
        if (F.tid < 192) { const int s = F.tid / 64, cc = F.tid - s * 64, cg2 = cc >> 2, j = cc & 3; float t = 0.f;
            for (int q = 0; q < 32; ++q) t += red[(q * 16 + cg2) * 12 + s * 4 + j];
            wsp<float>(F, WS_MOD)[(size_t)(l * 3 + s) * 6144 + cgp * 64 + cc] = t + F.in[I_ADAB][l * 6144 + cgp * 64 + cc]; }
        __syncthreads();
    }
    const int gid = F.blk * 512 + F.tid, GT = F.G * 512;
    float* rope = wsp<float>(F, WS_ROPE);
    for (int i = gid; i < 256 * 16 + 64 * 16 + 256 * 8 + 64 * 8; i += GT) {
        int j = i; float pos, inv; size_t off;
        if (j < 256 * 16) { pos = (float)(j / 16); inv = powf(10000.f, -(float)(j % 16) / 16.f); off = ROPE_DR + (size_t)j * 2; }
        else if ((j -= 256 * 16) < 64 * 16) { pos = (float)(j / 16); inv = powf(10000.f, -(float)(j % 16) / 16.f); off = ROPE_DC + (size_t)j * 2; }
        else if ((j -= 64 * 16) < 256 * 8) { pos = (float)(j / 8); inv = powf(10000.f, -(float)(j % 8) / 8.f); off = ROPE_MR + (size_t)j * 2; }
        else { j -= 256 * 8; pos = (float)(j / 8); inv = powf(10000.f, -(float)(j % 8) / 8.f); off = ROPE_MC + (size_t)j * 2; }
        const float ang = pos * inv; rope[off] = cosf(ang); rope[off + 1] = sinf(ang);
    }
    { bf16* wh = wsp<bf16>(F, WS_WRH); bf16* wl = wsp<bf16>(F, WS_WRL); for (int i = gid; i < 2 * 32 * 1024; i += GT) { const int k = i & 1023, e = (i >> 10) & 31, l = i >> 15; const float wv = F.in[I_RW][((size_t)l * DM + k) * NE + e];
        const unsigned hb = f2bf(wv); wh[i] = (bf16)hb; wl[i] = (bf16)f2bf(wv - bf2f((bf16)hb)); } }
    bf16* WL = wsp<bf16>(F, WS_WLORA);
    for (int i = gid; i < 2560 * 384; i += GT) { const int n = i / 384, k = i - n * 384, part = n >> 9, c = n & 511; float v = 0.f;
        if (part < 2) { if ((k >> 6) == part) v = F.in[I_RW2][((size_t)part * 64 + (k & 63)) * 512 + c]; }
        else if (part < 4) { if ((k >> 6) == part) v = F.in[I_A2][((size_t)(part - 2) * 64 + (k & 63)) * 512 + c]; }
        else { if (k >= 256) v = F.in[I_G2][(size_t)(k - 256) * 512 + c]; }
        WL[i] = (bf16)f2bf(v); }
    const int gw = F.blk * 8 + F.wave, NGW = F.G * 8;
    tr_family(F, F.in[I_ATTW], 0, 1, 1024, ATT_IN, ATT_NP, wsp<bf16>(F, WS_WIN0), gw, NGW);
    tr_family(F, F.in[I_WUQ], 0, 1, 384, 768, 768, wsp<bf16>(F, WS_WUQ), gw, NGW);
    tr_family(F, F.in[I_WUKV], 0, 1, 256, 1024, 1024, wsp<bf16>(F, WS_WUKV), gw, NGW);
    tr_family(F, F.in[I_WOUT], (size_t)1024 * 1024, 2, 1024, 1024, 1024, wsp<bf16>(F, WS_WOUT), gw, NGW);
    tr_family(F, F.in[I_RECW], 0, 1, 1024, REC_IN, REC_NP, wsp<bf16>(F, WS_WREC), gw, NGW);
    moe_weights_convert(F, 0, gw, NGW);
}
__device__ __forceinline__ void p0b(const Frame& F) {
    const int gw = F.blk * 8 + F.wave, NGW = F.G * 8;
    for (int row = gw; row < R; row += NGW) { const int sel = row_sel(row);
        norm_mod_row(F, h0_row(F, row), F.in[I_NMIX], modp(F, 0, sel, 0), modp(F, 0, sel, 1), wsp<bf16>(F, WS_A) + (size_t)row * DM); }
}
struct FnStoreBf16 {
    bf16* O; int ldc;
    __device__ __forceinline__ void operator()(int row, int col, f32x4 v0, f32x4 v1) const {
        v4u w; w.x = pg8::cvt_pk_bf16(v0[0], v0[1]); w.y = pg8::cvt_pk_bf16(v0[2], v0[3]); w.z = pg8::cvt_pk_bf16(v1[0], v1[1]); w.w = pg8::cvt_pk_bf16(v1[2], v1[3]);
        *(v4u*)(O + (size_t)row * ldc + col) = w; }
};
struct FnWout {
    const Frame* F; int layer;
    __device__ __forceinline__ void operator()(int row, int col, f32x4 v0, f32x4 v1) const {
        float* hrow = wsp<float>(*F, WS_H) + (size_t)row * DM + col;
        const float* base = (layer == 0) ? h0_row(*F, row) + col : hrow;
        const float* g = modp(*F, layer, row_sel(row), 2) + col;
        const f32x4 b0 = *(const f32x4*)base, b1 = *(const f32x4*)(base + 4), g0 = *(const f32x4*)g, g1 = *(const f32x4*)(g + 4);
        *(f32x4*)hrow = b0 + g0 * v0; *(f32x4*)(hrow + 4) = b1 + g1 * v1; }
};
__device__ __forceinline__ void l0_post_proj(const Frame& F) {
    const int gw = F.blk * 8 + F.wave, NGW = F.G * 8, lane = F.lane;
    const bf16* P = wsp<const bf16>(F, WS_P); const float* rope = wsp<const float>(F, WS_ROPE);
    constexpr float CD = 0.125f * 1.4426950408889634f;
    for (int row = gw; row < R; row += NGW) {
        const int b = row / TB, t = row - b * TB; const bool lat = t >= CT; const int pos = t - CT, prow = lat ? pos >> 6 : 0, pcol = lat ? pos & 63 : 0;
        const bf16* p = P + (size_t)row * ATT_NP;
        bf16* qd = wsp<bf16>(F, WS_QD) + (size_t)row * 512; bf16* kd = wsp<bf16>(F, WS_KD) + (size_t)row * 512;
#pragma unroll
        for (int j = 0; j < 8; ++j) { const int pr = lane + 64 * j, h16 = pr >> 5, i = pr & 31;
            const float x1 = bf2f(p[h16 * 64 + i]), x2 = bf2f(p[h16 * 64 + i + 32]); float c = 1.f, s = 0.f;
            if (lat) { const float* tb = (i < 16) ? rope + ROPE_DR + (size_t)(prow * 16 + i) * 2 : rope + ROPE_DC + (size_t)(pcol * 16 + i - 16) * 2; c = tb[0]; s = tb[1]; }
            float y1 = x1 * c - x2 * s, y2 = x1 * s + x2 * c;
            if (h16 < 8) { qd[h16 * 64 + i] = (bf16)f2bf(y1 * CD); qd[h16 * 64 + i + 32] = (bf16)f2bf(y2 * CD); }
            else { kd[(h16 - 8) * 64 + i] = (bf16)f2bf(y1); kd[(h16 - 8) * 64 + i + 32] = (bf16)f2bf(y2); } }
        { float x[6]; float ss = 0.f;
#pragma unroll
          for (int j = 0; j < 6; ++j) { x[j] = bf2f(p[1536 + lane + 64 * j]); ss += x[j] * x[j]; }
          const float rs = 1.f / sqrtf(wave_sum(ss) * (1.f / 384.f) + NORM_EPS); bf16* o = wsp<bf16>(F, WS_CQN) + (size_t)row * 384;
#pragma unroll
          for (int j = 0; j < 6; ++j) o[lane + 64 * j] = (bf16)f2bf(x[j] * rs * F.in[I_QNW][lane + 64 * j]); }
        { float x[4]; float ss = 0.f;
#pragma unroll
          for (int j = 0; j < 4; ++j) { x[j] = bf2f(p[1920 + lane + 64 * j]); ss += x[j] * x[j]; }
          const float rs = 1.f / sqrtf(wave_sum(ss) * (1.f / 256.f) + NORM_EPS); bf16* o = wsp<bf16>(F, WS_CKVN) + (size_t)row * 256;
#pragma unroll
          for (int j = 0; j < 4; ++j) o[lane + 64 * j] = (bf16)f2bf(x[j] * rs * F.in[I_KVNW][lane + 64 * j]); }
        if (lane < 16) { const int i = lane; const float x1 = bf2f(p[2176 + i]), x2 = bf2f(p[2176 + i + 16]); float c = 1.f, s = 0.f;
            if (lat) { const float* tb = (i < 8) ? rope + ROPE_MR + (size_t)(prow * 8 + i) * 2 : rope + ROPE_MC + (size_t)(pcol * 8 + i - 8) * 2; c = tb[0]; s = tb[1]; }
            bf16* o = wsp<bf16>(F, WS_KRR) + (size_t)row * 32; o[i] = (bf16)f2bf(x1 * c - x2 * s); o[i + 16] = (bf16)f2bf(x1 * s + x2 * c); }
    }
}
__device__ __forceinline__ void l0_mq_rope(const Frame& F) {
    const int gw = F.blk * 8 + F.wave, NGW = F.G * 8, lane = F.lane; const float* rope = wsp<const float>(F, WS_ROPE);
    const float CM = 0.10206207261596575f * 1.4426950408889634f;
    for (int row = gw; row < R; row += NGW) {
        const int b = row / TB, t = row - b * TB; const bool lat = t >= CT; const int pos = t - CT, prow = lat ? pos >> 6 : 0, pcol = lat ? pos & 63 : 0;
        bf16* q = wsp<bf16>(F, WS_MQ) + (size_t)row * 768;
#pragma unroll
        for (int j = 0; j < 8; ++j) { const int idx = lane + 64 * j, h = idx >> 6, d = idx & 63; q[h * 96 + d] = (bf16)f2bf(bf2f(q[h * 96 + d]) * CM); }
#pragma unroll
        for (int j = 0; j < 2; ++j) { const int pr = lane + 64 * j, h = pr >> 4, i = pr & 15; const float x1 = bf2f(q[h * 96 + 64 + i]), x2 = bf2f(q[h * 96 + 80 + i]); float c = 1.f, s = 0.f;
            if (lat) { const float* tb = (i < 8) ? rope + ROPE_MR + (size_t)(prow * 8 + i) * 2 : rope + ROPE_MC + (size_t)(pcol * 8 + i - 8) * 2; c = tb[0]; s = tb[1]; }
            q[h * 96 + 64 + i] = (bf16)f2bf((x1 * c - x2 * s) * CM); q[h * 96 + 80 + i] = (bf16)f2bf((x1 * s + x2 * c) * CM); }
    }
}
__device__ __forceinline__ void l0_attention(const Frame& F) {
    LAS char* lds = (LAS char*)F.lds;
    const bf16* QD = wsp<const bf16>(F, WS_QD); const bf16* KD = wsp<const bf16>(F, WS_KD); const bf16* P = wsp<const bf16>(F, WS_P);
    const bf16* MQ = wsp<const bf16>(F, WS_MQ); const bf16* MKV = wsp<const bf16>(F, WS_MKV); const bf16* KRR = wsp<const bf16>(F, WS_KRR);
    float* OD = wsp<float>(F, WS_ODIFF); float* OM = wsp<float>(F, WS_OMLA);
    for (int kind = 0; kind < 2; ++kind) {
        for (int L = F.blk; L < 1024 + 16; L += F.G) {
            int b, h8, qb, nkeys;
            if (L < 1024) { int pair;
                if (F.G == 256) { const int round = L >> 8, c = L & 255; pair = round * 4 + ((c & 7) >> 1); qb = 1 + (c & 1) * 32 + (c >> 3); }
                else { pair = L >> 6; qb = 1 + (L & 63); }
                b = pair >> 3; h8 = pair & 7; nkeys = TB; }
            else { const int s = L - 1024; b = s >> 3; h8 = s & 7; qb = 0; nkeys = CT; }
            const size_t q0 = (size_t)b * TB + (size_t)qb * 256, k0 = (size_t)b * TB;
            if (kind == 0)
                att::attn_unit<64, 128>(QD + q0 * 512 + h8 * 64, 512, KD + k0 * 512 + h8 * 64, 512, nullptr, 0, P + k0 * ATT_NP + 1024 + (h8 >> 1) * 128, ATT_NP,
                                        OD + q0 * 1024 + h8 * 128, 1024, nkeys, lds);
            else
                att::attn_unit<96, 64>(MQ + q0 * 768 + h8 * 96, 768, MKV + k0 * 1024 + h8 * 128, 1024, KRR + k0 * 32, 32, MKV + k0 * 1024 + h8 * 128 + 64, 1024,
                                       OM + q0 * 512 + h8 * 64, 512, nkeys, lds);
        }
    }
}
__device__ __forceinline__ void l0_combine(const Frame& F) {
    const int gw = F.blk * 8 + F.wave, NGW = F.G * 8, lane = F.lane;
    const float* lv = F.in[I_LAM];
    const float lam = __expf(wave_sum(lv[lane] * lv[64 + lane])) - __expf(wave_sum(lv[128 + lane] * lv[192 + lane])) + 0.2f;
    const float sw0 = F.in[I_SUBLN][2 * lane] * 0.8f, sw1 = F.in[I_SUBLN][2 * lane + 1] * 0.8f;
    for (int row = gw; row < R; row += NGW) {
        const float* od = wsp<const float>(F, WS_ODIFF) + (size_t)row * 1024; const float* om = wsp<const float>(F, WS_OMLA) + (size_t)row * 512;
        bf16* a1 = wsp<bf16>(F, WS_A1) + (size_t)row * DM;
#pragma unroll
        for (int h = 0; h < 4; ++h) {
            const float o1a = od[(2 * h) * 128 + 2 * lane], o1b = od[(2 * h) * 128 + 2 * lane + 1], o2a = od[(2 * h + 1) * 128 + 2 * lane], o2b = od[(2 * h + 1) * 128 + 2 * lane + 1];
            const float da = o1a - lam * o2a, db = o1b - lam * o2b;
            const float rs = 1.f / sqrtf(wave_sum(da * da + db * db) * (1.f / 128.f) + NORM_EPS);
            *(unsigned*)(a1 + h * 128 + 2 * lane) = pk2(da * rs * sw0, db * rs * sw1); }
#pragma unroll
        for (int j = 0; j < 2; ++j) { const f32x4 v = *(const f32x4*)(om + 4 * (lane + 64 * j)); v2u w; w.x = pk2(v.x, v.y); w.y = pk2(v.z, v.w); *(v2u*)(a1 + 512 + 4 * (lane + 64 * j)) = w; }
    }
}
constexpr int RT_LS = 264;
__device__ __forceinline__ void ph_router(const Frame& F, int layer) {
    LAS bf16* AH = (LAS bf16*)F.lds; LAS bf16* AL = AH + 64 * RT_LS; LAS bf16* WH = AL + 64 * RT_LS; LAS bf16* WL = WH + 32 * RT_LS;
    LAS float* lg = (LAS float*)(F.lds + 110592);
    LAS int* hist = (LAS int*)(F.lds + MISC_OFF + 256);
    LAS int* recs = (LAS int*)(F.lds + MISC_OFF + 512);
    const int lane = F.lane, w = F.wave, tid = F.tid, RPB = (R + F.G - 1) / F.G, row0 = F.blk * RPB;
    if (tid < 64) hist[tid] = 0;
    { int* srct = wsp<int>(F, WS_SRC); for (int i = F.blk * 512 + tid; i < MAXROWS; i += F.G * 512) srct[i] = 0; }
    const float* nw = F.in[I_NFFN] + (size_t)layer * DM; const float* rbp = F.in[I_RB] + layer * NE;
    const bf16* wrh = wsp<const bf16>(F, WS_WRH) + (size_t)layer * 32 * 1024; const bf16* wrl = wsp<const bf16>(F, WS_WRL) + (size_t)layer * 32 * 1024;
    for (int pass = 0; pass * 64 < RPB; ++pass) {
        const int nrow = min(64, min(RPB - pass * 64, R - row0 - pass * 64));
        f32x4 fr[8][4];
#pragma unroll
        for (int i = 0; i < 8; ++i) { const int rl = w + 8 * i; const int row = row0 + pass * 64 + rl;
            if (rl < nrow) {
                const int sel = row_sel(row); const float* sh = modp(F, layer, sel, 3); const float* sc = modp(F, layer, sel, 4);
                const f32x4* xr = (const f32x4*)(wsp<const float>(F, WS_H) + (size_t)row * DM) + lane; float s = 0.f;
#pragma unroll
                for (int j = 0; j < 4; ++j) { fr[i][j] = xr[64 * j]; s += (fr[i][j].x * fr[i][j].x + fr[i][j].y * fr[i][j].y) + (fr[i][j].z * fr[i][j].z + fr[i][j].w * fr[i][j].w); }
                const float rs = 1.f / sqrtf(wave_sum(s) * (1.f / DM) + NORM_EPS);
                unsigned long long* o8 = (unsigned long long*)(wsp<bf16>(F, WS_F) + (size_t)row * DM) + lane;
#pragma unroll
                for (int j = 0; j < 4; ++j) { const f32x4 ww = ((const f32x4*)nw)[lane + 64 * j], a = ((const f32x4*)sh)[lane + 64 * j], c = ((const f32x4*)sc)[lane + 64 * j];
                    fr[i][j] = fr[i][j] * rs * ww * (c + 1.f) + a;
                    o8[64 * j] = (unsigned long long)pk2(fr[i][j].x, fr[i][j].y) | ((unsigned long long)pk2(fr[i][j].z, fr[i][j].w) << 32); }
            } else {
#pragma unroll
                for (int j = 0; j < 4; ++j) fr[i][j] = (f32x4){0.f, 0.f, 0.f, 0.f};
            } }
        pg8::f32x4 acc = {0.f, 0.f, 0.f, 0.f};
#pragma unroll
        for (int c = 0; c < 4; ++c) {
            __syncthreads();
#pragma unroll
            for (int i = 0; i < 8; ++i) { const f32x4 v = fr[i][c]; const unsigned h0 = pk2(v.x, v.y), h1 = pk2(v.z, v.w);
                const unsigned l0 = pk2(v.x - bflo(h0), v.y - bfhi(h0)), l1 = pk2(v.z - bflo(h1), v.w - bfhi(h1));
                v2u hh; hh.x = h0; hh.y = h1; v2u ll; ll.x = l0; ll.y = l1;
                *(LAS v2u*)(AH + (w + 8 * i) * RT_LS + 4 * lane) = hh; *(LAS v2u*)(AL + (w + 8 * i) * RT_LS + 4 * lane) = ll; }
            { const int e = tid >> 4, kp = (tid & 15) * 16;
              const v4u a0 = *(const v4u*)(wrh + (size_t)e * 1024 + 256 * c + kp), a1 = *(const v4u*)(wrh + (size_t)e * 1024 + 256 * c + kp + 8);
              const v4u b0 = *(const v4u*)(wrl + (size_t)e * 1024 + 256 * c + kp), b1 = *(const v4u*)(wrl + (size_t)e * 1024 + 256 * c + kp + 8);
              *(LAS v4u*)(WH + e * RT_LS + kp) = a0; *(LAS v4u*)(WH + e * RT_LS + kp + 8) = a1; *(LAS v4u*)(WL + e * RT_LS + kp) = b0; *(LAS v4u*)(WL + e * RT_LS + kp + 8) = b1; }
            __syncthreads();
            const int tm = w >> 1, tn = w & 1, lr = lane & 15, kq = (lane >> 4) * 8;
            const LAS bf16* ahp = AH + (tm * 16 + lr) * RT_LS + kq; const LAS bf16* alp = AL + (tm * 16 + lr) * RT_LS + kq;
            const LAS bf16* whp = WH + (tn * 16 + lr) * RT_LS + kq; const LAS bf16* wlp = WL + (tn * 16 + lr) * RT_LS + kq;
#pragma unroll
            for (int ks = 0; ks < 8; ++ks) { const bf16x8 ah = *(const LAS bf16x8*)(ahp + 32 * ks), al = *(const LAS bf16x8*)(alp + 32 * ks), bh = *(const LAS bf16x8*)(whp + 32 * ks), bl = *(const LAS bf16x8*)(wlp + 32 * ks);
                acc = __builtin_amdgcn_mfma_f32_16x16x32_bf16(ah, bh, acc, 0, 0, 0); acc = __builtin_amdgcn_mfma_f32_16x16x32_bf16(ah, bl, acc, 0, 0, 0); acc = __builtin_amdgcn_mfma_f32_16x16x32_bf16(al, bh, acc, 0, 0, 0); }
        }
        { const int m0 = (w >> 1) * 16 + (lane >> 4) * 4, n = (w & 1) * 16 + (lane & 15);
#pragma unroll
          for (int r = 0; r < 4; ++r) lg[(m0 + r) * 33 + n] = acc[r]; }
        __syncthreads();
        if (tid < nrow) { const int rl = tid, row = row0 + pass * 64 + rl; float lv[32];
#pragma unroll
            for (int e = 0; e < 32; ++e) lv[e] = lg[rl * 33 + e] + rbp[e];
            float selv[4]; int seli[4];
#pragma unroll
            for (int r = 0; r < 4; ++r) { float bv = -3.0e38f; int bi = 0;
#pragma unroll
                for (int e = 0; e < 32; ++e) { const bool taken = (r > 0 && seli[0] == e) || (r > 1 && seli[1] == e) || (r > 2 && seli[2] == e); if (!taken && lv[e] > bv) { bv = lv[e]; bi = e; } }
                selv[r] = bv; seli[r] = bi; }
            float ex[4], es = 0.f;
#pragma unroll
            for (int r = 0; r < 4; ++r) { ex[r] = __expf(selv[r] - selv[0]); es += ex[r]; }
            const float inv = 1.f / es;
#pragma unroll
            for (int r = 0; r < 4; ++r) { wsp<int>(F, WS_TOPE)[(size_t)row * 4 + r] = seli[r]; wsp<float>(F, WS_GATE)[(size_t)row * 4 + r] = ex[r] * inv;
                const int rk = __hip_atomic_fetch_add(&hist[seli[r]], 1, __ATOMIC_RELAXED, __HIP_MEMORY_SCOPE_WORKGROUP);
                recs[(pass * 64 + rl) * 4 + r] = seli[r] | (rk << 8); }
        }
    }
    __syncthreads();
    if (tid < NE) hist[32 + tid] = (int)__hip_atomic_fetch_add(F.ctl + CW_CNT + 64 * (layer + 2 * F.probe) + tid, (unsigned)hist[tid], RLX_AGENT);
    __syncthreads();
    for (int rl = tid; rl < RPB && row0 + rl < R; rl += 512) {
#pragma unroll
        for (int r = 0; r < 4; ++r) { const int rc = recs[rl * 4 + r]; wsp<int>(F, WS_POS)[(size_t)(row0 + rl) * 4 + r] = hist[32 + (rc & 255)] + (rc >> 8); } }
}
__device__ __forceinline__ void moe_tables(const Frame& F, int layer, LAS int* ps, LAS int* tile_e) {
    if (F.tid == 0) { int acc = 0, t = 0;
        for (int e = 0; e < NE; ++e) { const int c = (int)__hip_atomic_load(F.ctl + CW_CNT + 64 * layer + e, RLX_AGENT); ps[e] = acc; const int nt = (c + 255) >> 8;
            for (int i = 0; i < nt && t < MAXT; ++i) tile_e[t++] = e; acc += nt * 256; }
        ps[NE] = acc; ps[NE + 1] = t; }
    __syncthreads();
}
__device__ __forceinline__ void ph_gather(const Frame& F, int layer) {
    LAS int* ps = (LAS int*)(F.lds + MISC_OFF + 256); LAS int* tile_e = ps + 64;
    moe_tables(F, layer, ps, tile_e);
    if (F.blk == 0) { int* tab = wsp<int>(F, WS_TILE); const int nt = ps[NE + 1]; if (F.tid == 0) tab[0] = nt; for (int i = F.tid; i < nt; i += 512) tab[1 + i] = tile_e[i]; }
    for (int i = F.blk * 512 + F.tid; i < R * 4; i += F.G * 512) { const int row = i >> 2;
        const int e = wsp<const int>(F, WS_TOPE)[i]; const int dest = ps[e] + wsp<const int>(F, WS_POS)[i]; wsp<int>(F, WS_DEST)[i] = dest; wsp<int>(F, WS_SRC)[dest] = row; }
}
struct MoeOrder {
    const int* tile_e; int ntiles, nN, G, c; const int* src;
    __device__ __forceinline__ bool next(int i, pg8::Unit& u) const {
        int rt, pl;
        if (G == 256) { const int x = c & 7, y = c >> 3, rpx = 32 / nN; rt = (i * 8 + x) * rpx + y / nN; pl = y % nN; if (rt >= ntiles) return false; }
        else { const long L = (long)i * G + c; if (L >= (long)ntiles * nN) return false; rt = (int)(L / nN); pl = (int)(L - (long)rt * nN); }
        const int e = __builtin_amdgcn_readfirstlane(tile_e[rt]);
        u.pm = rt; u.pn = e * nN + pl; return true; }
    __device__ __forceinline__ void a_ready(const pg8::Unit&) const {}
    __device__ __forceinline__ void done(const pg8::Unit&) const {}
};
struct LatOrder {
    pg8::StaticOrder o;
    __device__ __forceinline__ bool next(int i, pg8::Unit& u) const { if (!o.next(i, u)) return false; u.pm += 1 + (u.pm >= 64 ? 1 : 0); return true; }
    __device__ __forceinline__ void a_ready(const pg8::Unit&) const {}
    __device__ __forceinline__ void done(const pg8::Unit&) const {}
};
struct FnSwiglu {
    bf16* HS; const float* b1;
    __device__ __forceinline__ void operator()(int row, int col, f32x4 v0, f32x4 v1) const {
        const float* bp = b1 + col;
        const f32x4 b0 = *(const f32x4*)bp, b1v = *(const f32x4*)(bp + 4); v0 = v0 + b0; v1 = v1 + b1v;
        const float hv[8] = {v0[0], v0[1], v0[2], v0[3], v1[0], v1[1], v1[2], v1[3]}; float o[4];
#pragma unroll
        for (int i = 0; i < 4; ++i) { const float g = hv[2 * i], l = hv[2 * i + 1];
            const float gl = fminf(g, 7.f), li = fminf(fmaxf(l, -7.f), 7.f); o[i] = gl * sigmoidf_(1.702f * gl) * (li + 1.f); }
        const int lc = col & 2047; v2u w; w.x = pk2(o[0], o[1]); w.y = pk2(o[2], o[3]);
        *(v2u*)(HS + (size_t)row * 1024 + (lc >> 1)) = w; }
};
struct FnBiasBf16 {
    bf16* YS; const float* b2;
    __device__ __forceinline__ void operator()(int row, int col, f32x4 v0, f32x4 v1) const {
        const f32x4 b0 = *(const f32x4*)(b2 + col), b1v = *(const f32x4*)(b2 + col + 4); v0 = v0 + b0; v1 = v1 + b1v;
        v4u w; w.x = pk2(v0[0], v0[1]); w.y = pk2(v0[2], v0[3]); w.z = pk2(v1[0], v1[1]); w.w = pk2(v1[2], v1[3]);
        *(v4u*)(YS + (size_t)row * 1024 + (col & 1023)) = w; }
};
__device__ __forceinline__ void ph_combine(const Frame& F, int layer) {
    const int lane = F.lane, gw = F.blk * 8 + F.wave, NGW = F.G * 8;
    for (int row = gw; row < R; row += NGW) {
        const int sel = row_sel(row); const float* gf = modp(F, layer, sel, 5);
        float* hrow = wsp<float>(F, WS_H) + (size_t)row * DM;
        f32x4 y[4];
#pragma unroll
        for (int j = 0; j < 4; ++j) y[j] = (f32x4){0.f, 0.f, 0.f, 0.f};
#pragma unroll
        for (int r = 0; r < 4; ++r) { const int d = wsp<const int>(F, WS_DEST)[(size_t)row * 4 + r]; const float g = wsp<const float>(F, WS_GATE)[(size_t)row * 4 + r];
            const v2u* yp = (const v2u*)(wsp<const bf16>(F, WS_XS) + (size_t)d * DM);
#pragma unroll
            for (int j = 0; j < 4; ++j) { const v2u w = yp[lane + 64 * j]; y[j] += g * (f32x4){bflo(w.x), bfhi(w.x), bflo(w.y), bfhi(w.y)}; } }
        f32x4 h[4]; float s = 0.f;
#pragma unroll
        for (int j = 0; j < 4; ++j) { h[j] = ((const f32x4*)hrow)[lane + 64 * j] + ((const f32x4*)gf)[lane + 64 * j] * y[j]; s += (h[j].x * h[j].x + h[j].y * h[j].y) + (h[j].z * h[j].z + h[j].w * h[j].w); }
        const float rs = 1.f / sqrtf(wave_sum(s) * (1.f / DM) + NORM_EPS);
        if (layer == 0) {
#pragma unroll
            for (int j = 0; j < 4; ++j) ((f32x4*)hrow)[lane + 64 * j] = h[j];
            const float* nw = F.in[I_NMIX] + DM; const float* sh = modp(F, 1, sel, 0); const float* sc = modp(F, 1, sel, 1);
            unsigned long long* o8 = (unsigned long long*)(wsp<bf16>(F, WS_A) + (size_t)row * DM) + lane;
#pragma unroll
            for (int j = 0; j < 4; ++j) { const f32x4 w = ((const f32x4*)nw)[lane + 64 * j], a = ((const f32x4*)sh)[lane + 64 * j], c = ((const f32x4*)sc)[lane + 64 * j];
                const f32x4 o = h[j] * rs * w * (c + 1.f) + a; o8[64 * j] = (unsigned long long)pk2(o.x, o.y) | ((unsigned long long)pk2(o.z, o.w) << 32); }
        } else {
            const int b = row / TB, t = row - b * TB;
            if (t >= CT) { float* orow = F.out + ((size_t)b * SEQ + (t - CT)) * DM; const float* nw = F.in[I_FNW];
#pragma unroll
                for (int j = 0; j < 4; ++j) ((f32x4*)orow)[lane + 64 * j] = h[j] * rs * ((const f32x4*)nw)[lane + 64 * j]; }
        }
    }
}
constexpr int PC_Q = 1920, PC_K = 2176, PC_V = 2432, PC_O = 2944, PC_G = 3456;
__device__ __forceinline__ float softplusf_(float y) { return fmaxf(y, 0.f) + __logf(1.f + __expf(-fabsf(y))); }
__device__ __forceinline__ float tanhf_(float x) { return 1.f - 2.f / (1.f + __expf(2.f * x)); }
__device__ __forceinline__ void unpack8(v4u w, float (&x)[8]) { x[0] = bflo(w.x); x[1] = bfhi(w.x); x[2] = bflo(w.y); x[3] = bfhi(w.y); x[4] = bflo(w.z); x[5] = bfhi(w.z); x[6] = bflo(w.w); x[7] = bfhi(w.w); }
__device__ __forceinline__ void lerp8(const bf16* p, bool hp, bool hn, int c0, const float* mu, float (&u)[8]) {
    const v4u z4 = {0u, 0u, 0u, 0u};
    const v4u wx = *(const v4u*)(p + c0), wp = hp ? *(const v4u*)(p - REC_NP + c0) : z4, wn = hn ? *(const v4u*)(p + REC_NP + c0) : z4;
    float x[8], xp[8], xn[8]; unpack8(wx, x); unpack8(wp, xp); unpack8(wn, xn);
    const f32x4 m0 = *(const f32x4*)(mu + c0), m1 = *(const f32x4*)(mu + c0 + 4);
#pragma unroll
    for (int e = 0; e < 8; ++e) { const float m = e < 4 ? m0[e & 3] : m1[e & 3]; u[e] = x[e] + m * (0.5f * (xp[e] + xn[e]) - x[e]); }
}
__device__ __forceinline__ void st8h(bf16* o, const float (&u)[8]) { v4u w; w.x = pk2(u[0], u[1]); w.y = pk2(u[2], u[3]); w.z = pk2(u[4], u[5]); w.w = pk2(u[6], u[7]); *(v4u*)o = w; }
__device__ __forceinline__ void st8f(float* o, const float (&u)[8]) { *(f32x4*)o = (f32x4){u[0], u[1], u[2], u[3]}; *(f32x4*)(o + 4) = (f32x4){u[4], u[5], u[6], u[7]}; }
__device__ __forceinline__ void l1_rwkv_prep(const Frame& F) {
    const int gw = F.blk * 8 + F.wave, NGW = F.G * 8, lane = F.lane; const float* mu = F.in[I_MU];
    for (int row = gw; row < R; row += NGW) {
        const int b = row / TB, t = row - b * TB; const bool hp = (t != 0 && t != CT), hn = (t != CT - 1 && t != TB - 1);
        const bf16* p = wsp<const bf16>(F, WS_P) + (size_t)row * REC_NP; const size_t ro = (size_t)row * 512 + 8 * lane;
        float u[8];
        lerp8(p, hp, hn, 8 * lane, mu, u); st8h(wsp<bf16>(F, WS_RR) + ro, u);
        lerp8(p, hp, hn, 1024 + 8 * lane, mu, u); st8h(wsp<bf16>(F, WS_VV) + ro, u);
        lerp8(p, hp, hn, 512 + 8 * lane, mu, u); st8h(wsp<bf16>(F, WS_KL) + ro, u);
        { const f32x4 k0 = *(const f32x4*)(F.in[I_KK] + 8 * lane), k1 = *(const f32x4*)(F.in[I_KK] + 8 * lane + 4); float ss = 0.f;
#pragma unroll
          for (int e = 0; e < 8; ++e) { u[e] *= (e < 4 ? k0[e & 3] : k1[e & 3]); ss += u[e] * u[e]; }
          ss += __shfl_xor(ss, 1); ss += __shfl_xor(ss, 2); ss += __shfl_xor(ss, 4);
          const float inv = -1.f / sqrtf(fmaxf(ss, 1e-24f));
#pragma unroll
          for (int e = 0; e < 8; ++e) u[e] *= inv;
          st8h(wsp<bf16>(F, WS_AKK) + ro, u); }
        if (lane < 48) { lerp8(p, hp, hn, 1536 + 8 * lane, mu, u);
#pragma unroll
            for (int e = 0; e < 8; ++e) u[e] = lane < 16 ? tanhf_(u[e]) : (lane < 32 ? u[e] : sigmoidf_(u[e]));
            v4u w; w.x = pk2(u[0], u[1]); w.y = pk2(u[2], u[3]); w.z = pk2(u[4], u[5]); w.w = pk2(u[6], u[7]);
            *(v4u*)(wsp<bf16>(F, WS_ALORA) + (size_t)row * 384 + 8 * lane) = w; }
    }
}
struct EpiLora {
    static constexpr bool PERM = true, AFTER_DRAIN = false;
    const Frame* F;
    template <int KIND> __device__ __forceinline__ void run(const pg8::f32x4 (&acc)[2][2][4][2], const pg8::Unit& u, int wr, int wc, int fr, int fq, int z) const {
#pragma unroll
        for (int ai = 0; ai < 2; ++ai)
#pragma unroll
            for (int m = 0; m < 4; ++m) { const int row = u.pm * 256 + ai * 128 + wr * 64 + m * 16 + fr;
#pragma unroll
                for (int bj = 0; bj < 2; ++bj) { const int c = ((u.pn & 1) * 256) + bj * 128 + wc * 32 + 8 * fq; const size_t ro = (size_t)row * 512 + c;
                    const pg8::f32x4 v0 = acc[ai][bj][m][0], v1 = acc[ai][bj][m][1]; const float x[8] = {v0[0], v0[1], v0[2], v0[3], v1[0], v1[1], v1[2], v1[3]}; float o[8];
                    if constexpr (KIND == 0) { const float* w0 = F->in[I_W0] + z * 512 + c;
#pragma unroll
                        for (int e = 0; e < 8; ++e) { const float wl = -softplusf_(-(w0[e] + x[e])) - 0.5f; o[e] = __expf(-__expf(wl)); }
                        st8f(wsp<float>(*F, WS_WDEC) + (size_t)z * R * 512 + ro, o); }
                    else if constexpr (KIND == 1) { const float* a0 = F->in[I_A0] + z * 512 + c;
#pragma unroll
                        for (int e = 0; e < 8; ++e) o[e] = sigmoidf_(a0[e] + x[e]);
                        st8h(wsp<bf16>(*F, WS_ASIG) + (size_t)z * R * 512 + ro, o); }
                    else st8h(wsp<bf16>(*F, WS_GG) + ro, x); } }
    }
    __device__ __forceinline__ void operator()(const pg8::f32x4 (&acc)[2][2][4][2], const pg8::Unit& u, int wr, int wc, int fr, int fq) const {
        const int part = u.pn >> 1;
        if (part < 2) run<0>(acc, u, wr, wc, fr, fq, part); else if (part < 4) run<1>(acc, u, wr, wc, fr, fq, part - 2); else run<2>(acc, u, wr, wc, fr, fq, 0);
    }
};
__device__ __forceinline__ void mlstm_gates(const Frame& F, int row, int z, int h, float& ig, float& lf) {
    const bf16* g = wsp<const bf16>(F, WS_P) + (size_t)row * REC_NP + PC_G + z * 8 + h; const float* gb = F.in[I_GATEB] + z * 8 + h;
    const float gi = bf2f(g[0]) + gb[0], gf = bf2f(g[4]) + gb[4];
    ig = 15.f * tanhf_(gi * (1.f / 15.f)); const float cf = 15.f * tanhf_(gf * (1.f / 15.f)); lf = fminf(cf, 0.f) - __logf(1.f + __expf(-fabsf(cf)));
}
__device__ __forceinline__ void mlstm_chunk_head(const Frame& F, int z, int b, int h, int c, LAS float* vec) {
    LAS int* rows = (LAS int*)vec;
    if (F.tid < 64) { const int s = F.tid, row = b * TB + scan_tok(z, 64 * c + s); float ig, lf; mlstm_gates(F, row, z, h, ig, lf); rows[s] = row; vec[64 + s] = ig; vec[192 + s] = lf; }
    __syncthreads();
    if (F.tid < 64) { float a = 0.f; for (int s = 0; s <= F.tid; ++s) a += vec[192 + s]; vec[128 + F.tid] = a; }
    __syncthreads();
}
__device__ __forceinline__ void l1_mlstm_b(const Frame& F) {
    const float* __restrict__ SC = wsp<const float>(F, WS_SC); const float* __restrict__ DC = wsp<const float>(F, WS_DC); float* __restrict__ CST = wsp<float>(F, WS_CST);
    const float* __restrict__ DN = wsp<const float>(F, WS_DN); float* __restrict__ NST = wsp<float>(F, WS_NST); float* __restrict__ MST = wsp<float>(F, WS_MST);
    for (int g = F.blk * 512 + F.tid; g < 16 * 8192; g += F.G * 512) {
        const int chain = g >> 13, el = g & 8191; float m = 0.f, C = 0.f, N = 0.f; const bool don = el < 64;
        for (int c0 = 0; c0 < 260; c0 += 10) {
            float dc[10], dn[10], bl[10], ml[10];
#pragma unroll
            for (int i = 0; i < 10; ++i) { const size_t u = (size_t)chain * 260 + c0 + i; dc[i] = DC[u * 8192 + el]; dn[i] = don ? DN[u * 64 + el] : 0.f; bl[i] = SC[2 * u]; ml[i] = SC[2 * u + 1]; }
#pragma unroll
            for (int i = 0; i < 10; ++i) { const size_t u = (size_t)chain * 260 + c0 + i;
                CST[u * 8192 + el] = C; if (don) NST[u * 64 + el] = N; if (el == 0) MST[u] = m;
                const float mn = fmaxf(bl[i] + m, ml[i]), cd = __expf(bl[i] + m - mn), inj = __expf(ml[i] - mn);
                C = cd * C + inj * dc[i]; N = cd * N + inj * dn[i]; m = mn; }
        }
    }
}
__device__ __forceinline__ void l1_rec_out(const Frame& F) {
    const int gw = F.blk * 8 + F.wave, NGW = F.G * 8, lane = F.lane, c0 = 8 * lane;
    for (int row = gw; row < R; row += NGW) {
        const size_t ro = (size_t)row * 512 + c0; bf16* a1 = wsp<bf16>(F, WS_A1) + (size_t)row * DM;
        { const float* y0 = wsp<const float>(F, WS_YR) + ro; const float* y1 = y0 + (size_t)R * 512; float y[8]; float s = 0.f;
          const float* y2 = wsp<const float>(F, WS_YB) + ro; const float* y3 = y2 + (size_t)R * 512;
#pragma unroll
          for (int e = 0; e < 8; ++e) { y[e] = (y0[e] + y1[e]) + (y2[e] + y3[e]); s += y[e]; }
          s += __shfl_xor(s, 1); s += __shfl_xor(s, 2); s += __shfl_xor(s, 4); const float mean = s * (1.f / 64.f); float q = 0.f;
#pragma unroll
          for (int e = 0; e < 8; ++e) { y[e] -= mean; q += y[e] * y[e]; }
          q += __shfl_xor(q, 1); q += __shfl_xor(q, 2); q += __shfl_xor(q, 4); const float rstd = 1.f / sqrtf(q * (1.f / 64.f) + 64e-5f);
          float rr[8], kl[8], s0[8], s1[8], vv[8], gg[8]; unpack8(*(const v4u*)(wsp<const bf16>(F, WS_RR) + ro), rr); unpack8(*(const v4u*)(wsp<const bf16>(F, WS_KL) + ro), kl);
          unpack8(*(const v4u*)(wsp<const bf16>(F, WS_ASIG) + ro), s0); unpack8(*(const v4u*)(wsp<const bf16>(F, WS_ASIG) + (size_t)R * 512 + ro), s1);
          unpack8(*(const v4u*)(wsp<const bf16>(F, WS_VV) + ro), vv); unpack8(*(const v4u*)(wsp<const bf16>(F, WS_GG) + ro), gg);
          const float* rk = F.in[I_RK] + c0; const float* ka = F.in[I_KA] + c0; float bs = 0.f;
#pragma unroll
          for (int e = 0; e < 8; ++e) bs += rr[e] * kl[e] * (2.f + (s0[e] + s1[e] - 2.f) * ka[e]) * rk[e];
          bs += __shfl_xor(bs, 1); bs += __shfl_xor(bs, 2); bs += __shfl_xor(bs, 4);
          const float* lw = F.in[I_LNW] + c0; const float* lb = F.in[I_LNB] + c0; float o[8];
#pragma unroll
          for (int e = 0; e < 8; ++e) o[e] = (y[e] * rstd * lw[e] + lb[e] + bs * vv[e]) * gg[e];
          v4u w; w.x = pk2(o[0], o[1]); w.y = pk2(o[2], o[3]); w.z = pk2(o[4], o[5]); w.w = pk2(o[6], o[7]); *(v4u*)(a1 + c0) = w; }
        { const float* h0 = wsp<const float>(F, WS_HM) + ro; const float* h1 = h0 + (size_t)R * 512; float x[8]; float q = 0.f;
#pragma unroll
          for (int e = 0; e < 8; ++e) { x[e] = h0[e] + h1[e]; q += x[e] * x[e]; }
          q += __shfl_xor(q, 1); q += __shfl_xor(q, 2); q += __shfl_xor(q, 4); q += __shfl_xor(q, 8); const float rs = 1.f / sqrtf(q * (1.f / 128.f) + NORM_EPS);
          float og[8]; unpack8(*(const v4u*)(wsp<const bf16>(F, WS_P) + (size_t)row * REC_NP + PC_O + c0), og); const float* nw = F.in[I_MNW] + c0; float o[8];
#pragma unroll
          for (int e = 0; e < 8; ++e) o[e] = x[e] * rs * nw[e] * sigmoidf_(og[e]);
          v4u w; w.x = pk2(o[0], o[1]); w.y = pk2(o[2], o[3]); w.z = pk2(o[4], o[5]); w.w = pk2(o[6], o[7]); *(v4u*)(a1 + 512 + c0) = w; }
    }
}
#ifndef NEU_ROUNDS
#define NEU_ROUNDS 6
#endif
namespace rk {
constexpr int LS = 72;
constexpr int MB = 64 * LS * 2;
struct Acc2 { pg8::f32x4 t0, t1; };
__device__ __forceinline__ void zero(Acc2& a) { a.t0 = (pg8::f32x4){0.f, 0.f, 0.f, 0.f}; a.t1 = a.t0; }
__device__ __forceinline__ void mm_acc(Acc2& acc, const LAS bf16* A, const LAS bf16* Bt, int wave, int lane) {
    const int tm = wave >> 1, tn0 = (wave & 1) * 2, lr = lane & 15, kq = (lane >> 4) * 8;
    const LAS bf16* ap = A + (tm * 16 + lr) * LS + kq; const LAS bf16* bp0 = Bt + (tn0 * 16 + lr) * LS + kq; const LAS bf16* bp1 = bp0 + 16 * LS;
    const bf16x8 a0 = *(const LAS bf16x8*)ap, a1 = *(const LAS bf16x8*)(ap + 32);
    const bf16x8 b00 = *(const LAS bf16x8*)bp0, b01 = *(const LAS bf16x8*)(bp0 + 32), b10 = *(const LAS bf16x8*)bp1, b11 = *(const LAS bf16x8*)(bp1 + 32);
    acc.t0 = __builtin_amdgcn_mfma_f32_16x16x32_bf16(a0, b00, acc.t0, 0, 0, 0); acc.t0 = __builtin_amdgcn_mfma_f32_16x16x32_bf16(a1, b01, acc.t0, 0, 0, 0);
    acc.t1 = __builtin_amdgcn_mfma_f32_16x16x32_bf16(a0, b10, acc.t1, 0, 0, 0); acc.t1 = __builtin_amdgcn_mfma_f32_16x16x32_bf16(a1, b11, acc.t1, 0, 0, 0);
}
template <class Fn> __device__ __forceinline__ void each(const Acc2& acc, int wave, int lane, Fn fn) {
    const int m0 = (wave >> 1) * 16 + (lane >> 4) * 4, n0 = (wave & 1) * 32 + (lane & 15);
#pragma unroll
    for (int r = 0; r < 4; ++r) { fn(m0 + r, n0, acc.t0[r]); fn(m0 + r, n0 + 16, acc.t1[r]); }
}
__device__ __forceinline__ void stb(LAS bf16* M, int m, int n, float v) { M[m * LS + n] = (bf16)f2bf(v); }
__device__ __forceinline__ void st_tr(LAS bf16* M, const Acc2& acc, int wave, int lane) {
    const int m0 = (wave >> 1) * 16 + (lane >> 4) * 4, n0 = (wave & 1) * 32 + (lane & 15);
    v2u a, b; a.x = pk2(acc.t0[0], acc.t0[1]); a.y = pk2(acc.t0[2], acc.t0[3]); b.x = pk2(acc.t1[0], acc.t1[1]); b.y = pk2(acc.t1[2], acc.t1[3]);
    *(LAS v2u*)(M + n0 * LS + m0) = a; *(LAS v2u*)(M + (n0 + 16) * LS + m0) = b;
}
}
__device__ __forceinline__ void l1_rk_phase_a(const Frame& F) {
    using namespace rk;
    LAS unsigned char* L = F.lds;
    LAS bf16* Rt = (LAS bf16*)(L + 0 * MB); LAS bf16* At = (LAS bf16*)(L + 1 * MB); LAS bf16* AtT = (LAS bf16*)(L + 2 * MB); LAS bf16* Bq = (LAS bf16*)(L + 3 * MB); LAS bf16* Kq = (LAS bf16*)(L + 4 * MB);
    LAS bf16* VT = (LAS bf16*)(L + 5 * MB); LAS bf16* BhT = (LAS bf16*)(L + 6 * MB); LAS bf16* KhT = (LAS bf16*)(L + 7 * MB);
    LAS bf16* AK = (LAS bf16*)(L + 8 * MB); LAS bf16* RB = (LAS bf16*)(L + 9 * MB); LAS bf16* RK = (LAS bf16*)(L + 10 * MB);
    LAS bf16* X = (LAS bf16*)(L + 11 * MB); LAS bf16* XT = (LAS bf16*)(L + 12 * MB); LAS bf16* P = (LAS bf16*)(L + 13 * MB);
    LAS bf16* AkVT = Bq; LAS bf16* ApT = Kq; LAS bf16* W2T = X;
    LAS float* G = (LAS float*)(L + 8 * MB);
    LAS float* gl = (LAS float*)(L + 14 * MB);
    const int w = F.wave, lane = F.lane, tid = F.tid;
    const int t = lane, j0 = 8 * w;
    float fr[8], fv[8], fa[8], fw[8], fk[8], fb[8];
#define RK_LOAD(u_) do { const int ch_ = (u_) / 260, c_ = (u_) - ch_ * 260, z_ = ch_ >> 4, b_ = (ch_ >> 3) & 1, h_ = ch_ & 7; const size_t ro = ((size_t)b_ * TB + scan_tok(z_, 64 * c_ + t)) * 512 + h_ * 64 + j0; \
    const v4u xr_ = *(const v4u*)(wsp<const bf16>(F, WS_RR) + ro), xv_ = *(const v4u*)(wsp<const bf16>(F, WS_VV) + ro), xa_ = *(const v4u*)(wsp<const bf16>(F, WS_AKK) + ro), xk_ = *(const v4u*)(wsp<const bf16>(F, WS_KL) + ro), \
              xs_ = *(const v4u*)(wsp<const bf16>(F, WS_ASIG) + (size_t)z_ * R * 512 + ro); const float* p3 = wsp<const float>(F, WS_WDEC) + (size_t)z_ * R * 512 + ro; const float* pk_ = F.in[I_KA] + h_ * 64 + j0; \
    const f32x4 w0_ = *(const f32x4*)p3, w1_ = *(const f32x4*)(p3 + 4), q0_ = *(const f32x4*)pk_, q1_ = *(const f32x4*)(pk_ + 4); float sg_[8], kl_[8]; \
    unpack8(xr_, fr); unpack8(xv_, fv); unpack8(xa_, fa); unpack8(xk_, kl_); unpack8(xs_, sg_); \
    _Pragma("unroll") for (int e = 0; e < 8; ++e) { const float kav = e < 4 ? q0_[e & 3] : q1_[e & 3]; fw[e] = e < 4 ? w0_[e & 3] : w1_[e & 3]; fk[e] = kl_[e] * (1.f + (sg_[e] - 1.f) * kav); fb[e] = -fa[e] * sg_[e]; } } while (0)
    if (F.blk < NUNIT_R) RK_LOAD(F.blk);
    for (int u = F.blk; u < NUNIT_R; u += F.G) {
        const int chain = u / 260, c = u - chain * 260, z = chain >> 4, b = (chain >> 3) & 1, h = chain & 7;
        __syncthreads();
#pragma unroll
        for (int e = 0; e < 8; ++e) G[t * 65 + j0 + e] = fw[e];
        __syncthreads();
        if (tid < 64) { float g = 1.f;
#pragma unroll 16
            for (int s = 0; s < 64; ++s) { g *= G[s * 65 + tid]; G[s * 65 + tid] = g; } gl[tid] = g; }
        __syncthreads();
#pragma unroll
        for (int e = 0; e < 8; ++e) { const int j = j0 + e; const float gt = G[t * 65 + j], gp = t > 0 ? G[(t - 1) * 65 + j] : 1.f, gL = G[63 * 65 + j], ig = 1.f / gt;
            fr[e] *= gt; fa[e] *= gp; const float bq = fb[e] * ig, kq = fk[e] * ig; fb[e] = bq; fk[e] = kq; fw[e] = gL; }
        __syncthreads();
        { v4u q; q.x = pk2(fr[0], fr[1]); q.y = pk2(fr[2], fr[3]); q.z = pk2(fr[4], fr[5]); q.w = pk2(fr[6], fr[7]); *(LAS v4u*)(Rt + t * LS + j0) = q;
          q.x = pk2(fa[0], fa[1]); q.y = pk2(fa[2], fa[3]); q.z = pk2(fa[4], fa[5]); q.w = pk2(fa[6], fa[7]); *(LAS v4u*)(At + t * LS + j0) = q;
          q.x = pk2(fb[0], fb[1]); q.y = pk2(fb[2], fb[3]); q.z = pk2(fb[4], fb[5]); q.w = pk2(fb[6], fb[7]); *(LAS v4u*)(Bq + t * LS + j0) = q;
          q.x = pk2(fk[0], fk[1]); q.y = pk2(fk[2], fk[3]); q.z = pk2(fk[4], fk[5]); q.w = pk2(fk[6], fk[7]); *(LAS v4u*)(Kq + t * LS + j0) = q; }
#pragma unroll
        for (int e = 0; e < 8; ++e) { const int j = j0 + e; stb(AtT, j, t, fa[e]); stb(VT, j, t, fv[e]); stb(BhT, j, t, fb[e] * fw[e]); stb(KhT, j, t, fk[e] * fw[e]); }
        __syncthreads();
        if (u + F.G < NUNIT_R) RK_LOAD(u + F.G);
        Acc2 a1, a2, a3, a4;
        zero(a1); mm_acc(a1, At, Bq, w, lane); zero(a2); mm_acc(a2, At, Kq, w, lane); zero(a3); mm_acc(a3, Rt, Bq, w, lane); zero(a4); mm_acc(a4, Rt, Kq, w, lane);
        each(a1, w, lane, [&](int m, int n, float v) { const float x = n < m ? v : 0.f; stb(X, m, n, x); stb(XT, n, m, x); stb(P, m, n, m == n ? 1.f : 0.f); });
        each(a2, w, lane, [&](int m, int n, float v) { stb(AK, m, n, n < m ? v : 0.f); });
        each(a3, w, lane, [&](int m, int n, float v) { stb(RB, m, n, n <= m ? v : 0.f); });
        each(a4, w, lane, [&](int m, int n, float v) { stb(RK, m, n, n <= m ? v : 0.f); });
        __syncthreads();
        { const int m0 = (w >> 1) * 16 + (lane >> 4) * 4, n0 = (w & 1) * 32 + (lane & 15);
          Acc2 pt;
#pragma unroll
          for (int r = 0; r < 4; ++r) { pt.t0[r] = (m0 + r == n0) ? 1.f : 0.f; pt.t1[r] = (m0 + r == n0 + 16) ? 1.f : 0.f; }
#pragma unroll 1
          for (int i = 0; i < NEU_ROUNDS; ++i) {
            mm_acc(pt, P, XT, w, lane);
            if (i < NEU_ROUNDS - 1) { zero(a1); mm_acc(a1, X, XT, w, lane); }
            __syncthreads();
#pragma unroll
            for (int r = 0; r < 4; ++r) { stb(P, m0 + r, n0, pt.t0[r]); stb(P, m0 + r, n0 + 16, pt.t1[r]); }
            if (i < NEU_ROUNDS - 1) { each(a1, w, lane, [&](int m, int n, float v) { stb(X, m, n, v); }); st_tr(XT, a1, w, lane); }
            __syncthreads();
          } }
        zero(a1); mm_acc(a1, AK, VT, w, lane); zero(a2); mm_acc(a2, P, AtT, w, lane);
        st_tr(AkVT, a1, w, lane); st_tr(ApT, a2, w, lane);
        __syncthreads();
        zero(a3); mm_acc(a3, P, AkVT, w, lane);
        st_tr(W2T, a3, w, lane);
        __syncthreads();
        zero(a1); mm_acc(a1, RB, ApT, w, lane); zero(a2); mm_acc(a2, RB, W2T, w, lane); mm_acc(a2, RK, VT, w, lane);
        zero(a3); mm_acc(a3, BhT, ApT, w, lane); zero(a4); mm_acc(a4, BhT, W2T, w, lane); mm_acc(a4, KhT, VT, w, lane);
        __syncthreads();
        { LAS bf16* O1 = At; LAS bf16* O2 = AtT; LAS bf16* O3 = AK; LAS float* OY = (LAS float*)X;
          each(a1, w, lane, [&](int m, int n, float v) { stb(O1, m, n, v + bf2f(Rt[m * LS + n])); });
          each(a3, w, lane, [&](int m, int n, float v) { stb(O2, m, n, v + (m == n ? gl[m] : 0.f)); });
          each(a4, w, lane, [&](int m, int n, float v) { stb(O3, m, n, v); });
          each(a2, w, lane, [&](int m, int n, float v) { OY[m * 68 + n] = v; });
          __syncthreads();
          const int row = tid >> 3, c8 = (tid & 7) * 8;
          *(v4u*)(wsp<bf16>(F, WS_RKQ) + (size_t)u * 4096 + row * 64 + c8) = *(const LAS v4u*)(O1 + row * LS + c8);
          *(v4u*)(wsp<bf16>(F, WS_RKM) + (size_t)u * 4096 + row * 64 + c8) = *(const LAS v4u*)(O2 + row * LS + c8);
          *(v4u*)(wsp<bf16>(F, WS_RKZ) + (size_t)u * 4096 + row * 64 + c8) = *(const LAS v4u*)(O3 + row * LS + c8);
          float* Yg = wsp<float>(F, WS_YR) + (size_t)z * R * 512 + h * 64;
#pragma unroll
          for (int i = 0; i < 2; ++i) { const int yr = (tid >> 4) + 32 * i, c4 = (tid & 15) * 4;
              *(f32x4*)(Yg + ((size_t)b * TB + scan_tok(z, 64 * c + yr)) * 512 + c4) = *(const LAS f32x4*)(OY + yr * 68 + c4); } }
    }
#undef RK_LOAD
}
__device__ __forceinline__ void l1_rk_phase_b(const Frame& F) {
    using namespace rk;
    LAS unsigned char* L = F.lds; LAS bf16* S = (LAS bf16*)L;
    const int w = F.wave, lane = F.lane, tid = F.tid, chain = F.blk, z = chain >> 4, b = (chain >> 3) & 1, h = chain & 7;
    for (int i = tid; i < 64 * LS; i += 512) S[i] = 0;
    const int sr = tid >> 3, sc = (tid & 7) * 8;
    v4u gm, gq, gz;
#define RKB_LOAD(u_) do { gm = *(const v4u*)(wsp<const bf16>(F, WS_RKM) + (u_) * 4096 + sr * 64 + sc); gq = *(const v4u*)(wsp<const bf16>(F, WS_RKQ) + (u_) * 4096 + sr * 64 + sc); \
    gz = *(const v4u*)(wsp<const bf16>(F, WS_RKZ) + (u_) * 4096 + sr * 64 + sc); } while (0)
#define RKB_WRITE(par) do { *(LAS v4u*)((LAS bf16*)(L + (1 + 3 * (par)) * MB) + sr * LS + sc) = gm; *(LAS v4u*)((LAS bf16*)(L + (2 + 3 * (par)) * MB) + sr * LS + sc) = gq; \
    *(LAS v4u*)((LAS bf16*)(L + (3 + 3 * (par)) * MB) + sr * LS + sc) = gz; } while (0)
    RKB_LOAD((size_t)chain * 260); RKB_WRITE(0);
    __syncthreads();
    float* Yg = wsp<float>(F, WS_YB) + (size_t)z * R * 512 + h * 64;
    LAS float* OY = (LAS float*)(L + 7 * MB);
    for (int c = 0; c < 260; ++c) {
        const size_t u = (size_t)chain * 260 + c; const int par = c & 1;
        if (c + 1 < 260) RKB_LOAD(u + 1);
        const LAS bf16* Mt = (const LAS bf16*)(L + (1 + 3 * par) * MB); const LAS bf16* Qp = (const LAS bf16*)(L + (2 + 3 * par) * MB); const LAS bf16* Zt = (const LAS bf16*)(L + (3 + 3 * par) * MB);
        Acc2 a1, a2; zero(a1); mm_acc(a1, Mt, S, w, lane); zero(a2); mm_acc(a2, Qp, S, w, lane);
        const int m0 = (w >> 1) * 16 + (lane >> 4) * 4, n0 = (w & 1) * 32 + (lane & 15); float zv[8];
#pragma unroll
        for (int r = 0; r < 4; ++r) { zv[2 * r] = bf2f(Zt[(m0 + r) * LS + n0]); zv[2 * r + 1] = bf2f(Zt[(m0 + r) * LS + n0 + 16]); }
        __syncthreads();
        { Acc2 s2;
#pragma unroll
          for (int r = 0; r < 4; ++r) { s2.t0[r] = a1.t0[r] + zv[2 * r]; s2.t1[r] = a1.t1[r] + zv[2 * r + 1]; OY[(m0 + r) * 68 + n0] = a2.t0[r]; OY[(m0 + r) * 68 + n0 + 16] = a2.t1[r]; }
          st_tr(S, s2, w, lane); }
        if (c + 1 < 260) RKB_WRITE(par ^ 1);
        __syncthreads();
#pragma unroll
        for (int i = 0; i < 2; ++i) { const int yr = (tid >> 4) + 32 * i, c4 = (tid & 15) * 4;
            *(f32x4*)(Yg + ((size_t)b * TB + scan_tok(z, 64 * c + yr)) * 512 + c4) = *(const LAS f32x4*)(OY + yr * 68 + c4); }
    }
#undef RKB_LOAD
#undef RKB_WRITE
}
__device__ __forceinline__ void l1_mlstm_a2(const Frame& F) {
    using namespace rk;
    LAS bf16* KT = (LAS bf16*)F.lds; LAS bf16* VsT = KT + 64 * LS;
    LAS float* vec = (LAS float*)(F.lds + AUX_OFF); LAS int* rows = (LAS int*)vec;
    const bf16* Pg = wsp<const bf16>(F, WS_P); const int tid = F.tid, w = F.wave, lane = F.lane;
    for (int u = F.blk; u < NUNIT_M; u += F.G) {
        const int cidx = u / 260, c = u - cidx * 260, z = cidx >> 3, b = (cidx >> 2) & 1, h = cidx & 3;
        mlstm_chunk_head(F, z, b, h, c, vec);
        if (tid < 64) { const float bl = vec[128 + 63]; const float uu = bl - vec[128 + tid] + vec[64 + tid]; float m = uu;
#pragma unroll
            for (int o = 1; o < 64; o <<= 1) m = fmaxf(m, __shfl_xor(m, o));
            vec[256 + tid] = __expf(uu - m);
            if (tid == 0) { wsp<float>(F, WS_SC)[2 * u] = bl; wsp<float>(F, WS_SC)[2 * u + 1] = m; } }
        __syncthreads();
        { const int s = tid >> 3, c8 = tid & 7; float x[8]; unpack8(*(const v4u*)(Pg + (size_t)rows[s] * REC_NP + PC_K + h * 64 + 8 * c8), x);
#pragma unroll
          for (int e = 0; e < 8; ++e) stb(KT, 8 * c8 + e, s, x[e]); }
#pragma unroll
        for (int i = 0; i < 2; ++i) { const int s = (tid >> 4) + 32 * i, c8 = tid & 15; float x[8]; unpack8(*(const v4u*)(Pg + (size_t)rows[s] * REC_NP + PC_V + h * 128 + 8 * c8), x); const float sw = vec[256 + s];
#pragma unroll
            for (int e = 0; e < 8; ++e) stb(VsT, 8 * c8 + e, s, x[e] * sw); }
        __syncthreads();
        Acc2 a0, a1; zero(a0); mm_acc(a0, VsT, KT, w, lane); zero(a1); mm_acc(a1, VsT + 64 * LS, KT, w, lane);
        float* dc = wsp<float>(F, WS_DC) + (size_t)u * 8192;
        each(a0, w, lane, [&](int m, int n, float v) { dc[m * 64 + n] = 0.125f * v; });
        each(a1, w, lane, [&](int m, int n, float v) { dc[(64 + m) * 64 + n] = 0.125f * v; });
        if (tid < 64) { float a = 0.f; for (int s = 0; s < 64; ++s) a += vec[256 + s] * bf2f(KT[tid * LS + s]); wsp<float>(F, WS_DN)[(size_t)u * 64 + tid] = 0.125f * a; }
        __syncthreads();
    }
}
__device__ __forceinline__ void l1_mlstm_c2(const Frame& F, int first_blk, int nblk) {
    using namespace rk;
    LAS bf16* Q = (LAS bf16*)F.lds; LAS bf16* K = Q + 64 * LS; LAS bf16* VT = K + 64 * LS; LAS bf16* Cm = VT + 128 * LS; LAS bf16* Pm = Cm + 128 * LS;
    LAS float* OH = (LAS float*)(F.lds + 7 * MB);
    LAS float* vec = (LAS float*)(F.lds + AUX_OFF); LAS int* rows = (LAS int*)vec;
    const bf16* Pg = wsp<const bf16>(F, WS_P); const int tid = F.tid, w = F.wave, lane = F.lane;
    for (int u = F.blk - first_blk; u < NUNIT_M; u += nblk) {
        const int cidx = u / 260, c = u - cidx * 260, z = cidx >> 3, b = (cidx >> 2) & 1, h = cidx & 3;
        mlstm_chunk_head(F, z, b, h, c, vec);
        const float mst = wsp<const float>(F, WS_MST)[u];
        if (tid < 64) { const int t = tid; float pm = -3.0e38f; for (int s = 0; s <= t; ++s) pm = fmaxf(pm, vec[64 + s] - vec[128 + s]);
            const float gi = vec[128 + t] + mst, mo = fmaxf(gi, vec[128 + t] + pm); vec[320 + t] = __expf(gi - mo); vec[384 + t] = mo;
            vec[256 + t] = wsp<const float>(F, WS_NST)[(size_t)u * 64 + t]; }
        { const int t = tid >> 3, c8 = tid & 7;
          *(LAS v4u*)(Q + t * LS + 8 * c8) = *(const v4u*)(Pg + (size_t)rows[t] * REC_NP + PC_Q + h * 64 + 8 * c8);
          *(LAS v4u*)(K + t * LS + 8 * c8) = *(const v4u*)(Pg + (size_t)rows[t] * REC_NP + PC_K + h * 64 + 8 * c8); }
#pragma unroll
        for (int i = 0; i < 2; ++i) { const int s = (tid >> 4) + 32 * i, c8 = tid & 15; const v4u wv = *(const v4u*)(Pg + (size_t)rows[s] * REC_NP + PC_V + h * 128 + 8 * c8);
            const unsigned ww[4] = {wv.x, wv.y, wv.z, wv.w};
#pragma unroll
            for (int e = 0; e < 4; ++e) { VT[(8 * c8 + 2 * e) * LS + s] = (bf16)(ww[e] & 0xffffu); VT[(8 * c8 + 2 * e + 1) * LS + s] = (bf16)(ww[e] >> 16); } }
        { const int v = tid >> 2, dq = (tid & 3) * 16; const f32x4* src = (const f32x4*)(wsp<const float>(F, WS_CST) + (size_t)u * 8192 + v * 64 + dq);
          const f32x4 x0 = src[0], x1 = src[1], x2 = src[2], x3 = src[3]; v4u o0, o1;
          o0.x = pk2(x0.x, x0.y); o0.y = pk2(x0.z, x0.w); o0.z = pk2(x1.x, x1.y); o0.w = pk2(x1.z, x1.w); o1.x = pk2(x2.x, x2.y); o1.y = pk2(x2.z, x2.w); o1.z = pk2(x3.x, x3.y); o1.w = pk2(x3.z, x3.w);
          *(LAS v4u*)(Cm + v * LS + dq) = o0; *(LAS v4u*)(Cm + v * LS + dq + 8) = o1; }
        __syncthreads();
        Acc2 aq, c0, c1; zero(aq); mm_acc(aq, Q, K, w, lane); zero(c0); mm_acc(c0, Q, Cm, w, lane); zero(c1); mm_acc(c1, Q, Cm + 64 * LS, w, lane);
        each(aq, w, lane, [&](int t, int s, float v) { stb(Pm, t, s, s <= t ? 0.125f * v * __expf(vec[128 + t] + (vec[64 + s] - vec[128 + s]) - vec[384 + t]) : 0.f); });
        __syncthreads();
        Acc2 p0, p1; zero(p0); mm_acc(p0, Pm, VT, w, lane); zero(p1); mm_acc(p1, Pm, VT + 64 * LS, w, lane);
        if (tid < 64) { const int t = tid; float rs = 0.f, nq = 0.f;
            for (int s = 0; s < 64; ++s) { rs += bf2f(Pm[t * LS + s]); nq += vec[256 + s] * bf2f(Q[t * LS + s]); }
            const float den = vec[320 + t] * nq + rs; vec[448 + t] = 1.f / fmaxf(fabsf(den), __expf(-vec[384 + t])); }
        __syncthreads();
        { const int m0 = (w >> 1) * 16 + (lane >> 4) * 4, n0 = (w & 1) * 32 + (lane & 15);
#pragma unroll
          for (int r = 0; r < 4; ++r) { const int t = m0 + r; const float g = vec[320 + t], idn = vec[448 + t];
              OH[t * 132 + n0] = (g * c0.t0[r] + p0.t0[r]) * idn; OH[t * 132 + n0 + 16] = (g * c0.t1[r] + p0.t1[r]) * idn;
              OH[t * 132 + 64 + n0] = (g * c1.t0[r] + p1.t0[r]) * idn; OH[t * 132 + 64 + n0 + 16] = (g * c1.t1[r] + p1.t1[r]) * idn; } }
        __syncthreads();
#pragma unroll
        for (int i = 0; i < 4; ++i) { const int it = tid + 512 * i, t = it >> 5, c4 = (it & 31) * 4;
            *(f32x4*)(wsp<float>(F, WS_HM) + ((size_t)z * R + rows[t]) * 512 + h * 128 + c4) = *(const LAS f32x4*)(OH + t * 132 + c4); }
        __syncthreads();
    }
}
#ifndef MK_PER_PHASE
#define MK_PER_PHASE 0
#endif
constexpr int NPHASE = 26;
struct Args { const float* in[N_IN]; float* out; unsigned char* ws; int ph_lo, ph_hi, li, pad; };
#define GEMM_CALL(FnT, SchedT, g, S, fn) do { pg8::EpiGen<FnT> E_{fn}; { int k_ = g.K; asm volatile("" : "+s"(k_)); g.K = k_; } pg8::gemm_phase<pg8::EpiGen<FnT>, SchedT, true, true>((PG8_LAS unsigned char*)F.lds, g, S, E_); } while (0)
#ifndef SITE_MASK
#define SITE_MASK 0xFFFFFFFFull
#endif
#define SITE(s) (((SITE_MASK) >> (s)) & 1ull)
#ifndef DUP_MASK
#define DUP_MASK 0ull
#endif
#define NREP(s) ((((DUP_MASK) >> (s)) & 1ull) ? 2 : 1)
#define IN(k) (lo <= (k) && (k) < hi)
#define SEAM(k) do { if (IN(k) && IN((k) + 1)) xcd_barrier(bar); } while (0)
template <int LAYER> __device__ __forceinline__ void layer_phases(const Frame& F, const XcdBarrier& bar, const int lo, const int hi) {
    constexpr int layer = LAYER; constexpr int pb = 2 + 12 * LAYER;
        if (SITE(2) && IN(pb + 0)) { for (int rep_ = 0; rep_ < NREP(2); ++rep_) {
            const int N = layer == 0 ? ATT_NP : REC_NP;
            pg8::Gemm g{wsp<const bf16>(F, WS_A), layer == 0 ? wsp<const bf16>(F, WS_WIN0) : wsp<const bf16>(F, WS_WREC), R, N, 1024};
            pg8::StaticOrder S; S.init(R, N, F.G, F.blk);
            GEMM_CALL(FnStoreBf16, pg8::StaticOrder, g, S, (FnStoreBf16{wsp<bf16>(F, WS_P), N}));
             if (rep_ + 1 < NREP(2)) xcd_barrier(bar); } SEAM(pb + 0);
        }
        if constexpr (LAYER == 0) {
            if (SITE(3) && IN(pb + 1)) { for (int rep_ = 0; rep_ < NREP(3); ++rep_) { l0_post_proj(F);  if (rep_ + 1 < NREP(3)) xcd_barrier(bar); } SEAM(pb + 1); }
            if (SITE(4) && IN(pb + 2)) { for (int rep_ = 0; rep_ < NREP(4); ++rep_) {
                pg8::Gemm g{wsp<const bf16>(F, WS_CQN), wsp<const bf16>(F, WS_WUQ), R, 768, 384}; pg8::StaticOrder S; S.init(R, 768, F.G, F.blk);
                GEMM_CALL(FnStoreBf16, pg8::StaticOrder, g, S, (FnStoreBf16{wsp<bf16>(F, WS_MQ), 768}));
                 if (rep_ + 1 < NREP(4)) xcd_barrier(bar); } SEAM(pb + 2);
            }
            if (SITE(5) && IN(pb + 3)) { for (int rep_ = 0; rep_ < NREP(5); ++rep_) {
                pg8::Gemm g{wsp<const bf16>(F, WS_CKVN), wsp<const bf16>(F, WS_WUKV), R, 1024, 256}; pg8::StaticOrder S; S.init(R, 1024, F.G, F.blk);
                GEMM_CALL(FnStoreBf16, pg8::StaticOrder, g, S, (FnStoreBf16{wsp<bf16>(F, WS_MKV), 1024}));
                l0_mq_rope(F);
                 if (rep_ + 1 < NREP(5)) xcd_barrier(bar); } SEAM(pb + 3);
            }
            if (SITE(6) && IN(pb + 4)) { for (int rep_ = 0; rep_ < NREP(6); ++rep_) { l0_attention(F);  if (rep_ + 1 < NREP(6)) xcd_barrier(bar); } SEAM(pb + 4); }
            if (SITE(7) && IN(pb + 5)) { for (int rep_ = 0; rep_ < NREP(7); ++rep_) { l0_combine(F);  if (rep_ + 1 < NREP(7)) xcd_barrier(bar); } SEAM(pb + 5); }
        } else {
            if (SITE(8) && IN(pb + 1)) { for (int rep_ = 0; rep_ < NREP(8); ++rep_) { l1_rwkv_prep(F); l1_mlstm_a2(F);  if (rep_ + 1 < NREP(8)) xcd_barrier(bar); } SEAM(pb + 1); }
            if (SITE(9) && IN(pb + 2)) { for (int rep_ = 0; rep_ < NREP(9); ++rep_) {
                pg8::Gemm g{wsp<const bf16>(F, WS_ALORA), wsp<const bf16>(F, WS_WLORA), R, 2560, 384}; pg8::StaticOrder S; S.init(R, 2560, F.G, F.blk);
                { int k_ = g.K; asm volatile("" : "+s"(k_)); g.K = k_; EpiLora E_{&F}; pg8::gemm_phase<EpiLora, pg8::StaticOrder, true, true>((PG8_LAS unsigned char*)F.lds, g, S, E_); }
                l1_mlstm_b(F);
                 if (rep_ + 1 < NREP(9)) xcd_barrier(bar); } SEAM(pb + 2);
            }
            if (SITE(18) && IN(pb + 3)) { for (int rep_ = 0; rep_ < NREP(18); ++rep_) { l1_rk_phase_a(F); if (rep_ + 1 < NREP(18)) xcd_barrier(bar); } SEAM(pb + 3); }
            if (SITE(10) && IN(pb + 4)) { for (int rep_ = 0; rep_ < NREP(10); ++rep_) {
                if (F.G > 32) { if (F.blk < 32) l1_rk_phase_b(F); else { l1_mlstm_c2(F, 32, F.G - 32); moe_weights_convert(F, 1, (F.blk - 32) * 8 + F.wave, (F.G - 32) * 8); } }
                 if (rep_ + 1 < NREP(10)) xcd_barrier(bar); } SEAM(pb + 4);
            }
            if (SITE(11) && IN(pb + 5)) { for (int rep_ = 0; rep_ < NREP(11); ++rep_) { l1_rec_out(F);  if (rep_ + 1 < NREP(11)) xcd_barrier(bar); } SEAM(pb + 5); }
        }
        if (SITE(12) && IN(pb + 6)) { for (int rep_ = 0; rep_ < NREP(12); ++rep_) {
            pg8::Gemm g{wsp<const bf16>(F, WS_A1), wsp<const bf16>(F, WS_WOUT) + (size_t)layer * 1024 * 1024, R, 1024, 1024};
            if constexpr (LAYER == 0) { pg8::StaticOrder S; S.init(R, 1024, F.G, F.blk); GEMM_CALL(FnWout, pg8::StaticOrder, g, S, (FnWout{&F, layer})); }
            else { LatOrder S; S.o.init(R - 2 * CT, 1024, F.G, F.blk); GEMM_CALL(FnWout, LatOrder, g, S, (FnWout{&F, layer})); }
             if (rep_ + 1 < NREP(12)) xcd_barrier(bar); } SEAM(pb + 6);
        }
        if (SITE(13) && IN(pb + 7)) { for (int rep_ = 0; rep_ < NREP(13); ++rep_) { ph_router(F, layer);  if (rep_ + 1 < NREP(13)) xcd_barrier(bar); } SEAM(pb + 7); }
        if (SITE(14) && IN(pb + 8)) { for (int rep_ = 0; rep_ < NREP(14); ++rep_) { ph_gather(F, layer);  if (rep_ + 1 < NREP(14)) xcd_barrier(bar); } SEAM(pb + 8); }
        if (SITE(15) && IN(pb + 9)) { for (int rep_ = 0; rep_ < NREP(15); ++rep_) {
            const int* tab = wsp<const int>(F, WS_TILE);
            pg8::Gemm g{wsp<const bf16>(F, WS_F), wsp<const bf16>(F, WS_W1T), MAXROWS, NE * 2048, 1024}; MoeOrder S{tab + 1, __builtin_amdgcn_readfirstlane(tab[0]), 8, F.G, F.blk, wsp<const int>(F, WS_SRC)};
            { int k_ = g.K; asm volatile("" : "+s"(k_)); g.K = k_; pg8::EpiGen<FnSwiglu> E_{FnSwiglu{wsp<bf16>(F, WS_HS), F.in[I_B1] + (size_t)layer * NE * 2048}};
              pg8::gemm_phase<pg8::EpiGen<FnSwiglu>, MoeOrder, true, true, true>((PG8_LAS unsigned char*)F.lds, g, S, E_); }
             if (rep_ + 1 < NREP(15)) xcd_barrier(bar); } SEAM(pb + 9);
        }
        if (SITE(16) && IN(pb + 10)) { for (int rep_ = 0; rep_ < NREP(16); ++rep_) {
            const int* tab = wsp<const int>(F, WS_TILE);
            pg8::Gemm g{wsp<const bf16>(F, WS_HS), wsp<const bf16>(F, WS_W2T), MAXROWS, NE * 1024, 1024}; MoeOrder S{tab + 1, __builtin_amdgcn_readfirstlane(tab[0]), 4, F.G, F.blk, nullptr};
            GEMM_CALL(FnBiasBf16, MoeOrder, g, S, (FnBiasBf16{wsp<bf16>(F, WS_XS), F.in[I_B2] + (size_t)layer * NE * 1024}));
             if (rep_ + 1 < NREP(16)) xcd_barrier(bar); } SEAM(pb + 10);
        }
        if (SITE(17) && IN(pb + 11)) { for (int rep_ = 0; rep_ < NREP(17); ++rep_) { ph_combine(F, layer);  if (rep_ + 1 < NREP(17)) xcd_barrier(bar); } SEAM(pb + 11); }
}
__global__ void __launch_bounds__(512, 2) fwd(Args args) {
    extern __shared__ __attribute__((aligned(16))) unsigned char lds_[];
    Frame F;
    F.lds = (LAS unsigned char*)lds_; F.tid = threadIdx.x; F.lane = F.tid & 63; F.wave = __builtin_amdgcn_readfirstlane(F.tid >> 6); F.blk = blockIdx.x; F.G = gridDim.x; F.probe = args.pad;
    F.ws = args.ws; F.out = args.out; F.ctl = (gu32*)(args.ws + WS_CTL);
    F.in.t = (LAS const unsigned*)(F.lds + MISC_OFF + 8192);
    if (F.tid < 64) ((LAS unsigned*)(F.lds + MISC_OFF))[F.tid] = 0u;
    if (F.tid < N_IN) { const unsigned long long pv = (unsigned long long)args.in[F.tid]; ((LAS unsigned*)(F.lds + MISC_OFF + 8192))[2 * F.tid] = (unsigned)pv; ((LAS unsigned*)(F.lds + MISC_OFF + 8192))[2 * F.tid + 1] = (unsigned)(pv >> 32); }
    __syncthreads();
    const int lo = args.ph_lo, hi = args.ph_hi;
    XcdBarrier bar; bar.bar = (unsigned*)(F.ctl + CW_BAR) + args.li * XCD_BAR_WORDS; bar.x = 0; bar.st = nullptr;
    if (hi - lo > 1) bar = xcd_barrier_post((unsigned*)(F.ctl + CW_BAR) + args.li * XCD_BAR_WORDS, (volatile LAS unsigned*)(F.lds + MISC_OFF));
    if (SITE(0) && IN(0)) { for (int rep_ = 0; rep_ < NREP(0); ++rep_) { p0a(F);  if (rep_ + 1 < NREP(0)) xcd_barrier(bar); } SEAM(0); }
    if (SITE(1) && IN(1)) { for (int rep_ = 0; rep_ < NREP(1); ++rep_) { p0b(F);  if (rep_ + 1 < NREP(1)) xcd_barrier(bar); } SEAM(1); }
    layer_phases<0>(F, bar, lo, hi);
    layer_phases<1>(F, bar, lo, hi);
}
#undef IN
#undef SEAM


extern "C" void kernel_launch(void* const* d_in, const int* in_sizes, int n_in, void* d_out, int out_size, void* d_ws, size_t ws_size, hipStream_t stream) {
    static int grid = 0;
    if (grid == 0) {
        const bool ok = n_in == N_IN && in_sizes[I_X] == NBATCH * SEQ * DM && in_sizes[I_RECW] == 1024 * REC_IN && in_sizes[I_ATTW] == 1024 * ATT_IN && in_sizes[I_MU] == RWKV_IN &&
                        in_sizes[I_GATEB] == 16 && in_sizes[I_W1] == 2 * NE * 1024 * 2048 && out_size == NBATCH * SEQ * DM && ws_size >= WS_END;
        if (!ok) { fprintf(stderr, "kernel_launch: shape mismatch (n_in %d, recw %d, attw %d, mu %d, out %d, ws %zu need %zu); nothing launched\n", n_in, n_in > I_RECW ? in_sizes[I_RECW] : -1,
                           n_in > I_ATTW ? in_sizes[I_ATTW] : -1, n_in > I_MU ? in_sizes[I_MU] : -1, out_size, ws_size, (size_t)WS_END); grid = -1; return; }
        int dev = 0, cus = 0;
        if (hipGetDevice(&dev) != hipSuccess || hipDeviceGetAttribute(&cus, hipDeviceAttributeMultiprocessorCount, dev) != hipSuccess) { grid = -1; return; }
        if (hipFuncSetAttribute((const void*)fwd, hipFuncAttributeMaxDynamicSharedMemorySize, LDS_BYTES) != hipSuccess) { fprintf(stderr, "kernel_launch: hipFuncSetAttribute failed\n"); grid = -1; return; }
        int per_cu = 0;
        if (hipOccupancyMaxActiveBlocksPerMultiprocessor(&per_cu, (const void*)fwd, 512, LDS_BYTES) != hipSuccess || per_cu < 1) { fprintf(stderr, "kernel_launch: occupancy query says %d blocks per CU\n", per_cu); }
        (void)hipGetLastError();
        grid = cus < 256 ? cus : 256;
        if (grid != 256) fprintf(stderr, "kernel_launch: %d CUs; this kernel is written for a 256-CU device\n", cus);
    }
    if (grid < 0) return;
    if (hipMemsetAsync((char*)d_ws + WS_CTL, 0, CTL_ZERO_BYTES, stream) != hipSuccess) return;
    Args a{};
    for (int i = 0; i < N_IN; ++i) a.in[i] = (const float*)d_in[i];
    a.out = (float*)d_out; a.ws = (unsigned char*)d_ws; a.pad = 0;
#if MK_PER_PHASE
    for (int ph = 0; ph < NPHASE; ++ph) { a.ph_lo = ph; a.ph_hi = ph + 1; a.li = 0; hipLaunchKernelGGL(fwd, dim3(grid), dim3(512), LDS_BYTES, stream, a); }
#elif defined(PROBE_LIST)
    { const int plist[] = {PROBE_LIST}; int cur = 0, li = 0;
      for (int p : plist) { a.ph_lo = cur; a.ph_hi = p + 1; a.li = li++; hipLaunchKernelGGL(fwd, dim3(grid), dim3(512), LDS_BYTES, stream, a);
                            a.ph_lo = p; a.ph_hi = p + 1; a.li = li++; a.pad = 1; hipLaunchKernelGGL(fwd, dim3(grid), dim3(512), LDS_BYTES, stream, a); a.pad = 0; cur = p + 1; }
      if (cur < NPHASE) { a.ph_lo = cur; a.ph_hi = NPHASE; a.li = li++; hipLaunchKernelGGL(fwd, dim3(grid), dim3(512), LDS_BYTES, stream, a); } }
#else
    a.ph_lo = 0; a.ph_hi = NPHASE; a.li = 0; hipLaunchKernelGGL(fwd, dim3(grid), dim3(512), LDS_BYTES, stream, a);
#endif
    const hipError_t le = hipPeekAtLastError();
    if (le != hipSuccess) fprintf(stderr, "kernel_launch: launch failed: %s\n", hipGetErrorName(le));
}
```

```cpp
#include <hip/hip_runtime.h>
#include <cstdio>
#include <cstdint>
#define MK_PER_PHASE 0
namespace pg8 {
#define PG8_LAS __attribute__((address_space(3)))
typedef unsigned short bf16_t;
typedef short bf16x8 __attribute__((ext_vector_type(8)));
typedef float f32x4 __attribute__((ext_vector_type(4)));
typedef unsigned u32x4 __attribute__((ext_vector_type(4)));
constexpr int BM = 256, BK = 64, HALF = 128, HTB = HALF * BK * 2  , STAGE_BYTES = 8 * HTB, NXCD = 8, WGM = 8;

__host__ __device__ __forceinline__ int lds_byte(int r, int c) { const int st = (r >> 4) * 2 + (c >> 5), rr = r & 15, cc = c & 31, ob = rr * 64 + cc * 2; return st * 1024 + (ob ^ (((ob >> 9) & 1) << 5)); }
__host__ __device__ __forceinline__ void stage_rc(int b, int& R, int& C) { const int st = b / 1024, sb = b % 1024, swz = sb ^ (((sb >> 9) & 1) << 5); R = (st >> 1) * 16 + swz / 64; C = (st & 1) * 32 + (swz % 64) / 2; }
__host__ __device__ __forceinline__ int perm32(int rho) { const int n = rho >> 4, i = rho & 15; return 8 * (i >> 2) + 4 * n + (i & 3); }

struct Unit { int pm, pn; };
struct Gemm { const bf16_t* A; const bf16_t* Bt; int M, N, K; };

struct StaticOrder {
    int nM, nN, nwg, G, c;
    __host__ __device__ void init(int M, int N, int G_, int c_) { nM = M / BM; nN = N / BM; nwg = nM * nN; G = G_; c = c_; }
    __host__ __device__ bool next(int i, Unit& u) const {
        const long L = (long)i * G + c; if (L >= nwg) return false;
        int wgid = (int)L; { const int q = nwg / NXCD, r = nwg % NXCD, xcd = wgid % NXCD, off = wgid / NXCD; wgid = (xcd < r ? xcd * (q + 1) : r * (q + 1) + (xcd - r) * q) + off; }
        const int nig = WGM * nN, gid = wgid / nig, fm = gid * WGM, gsz = (nM - fm) < WGM ? (nM - fm) : WGM;
        u.pm = fm + ((wgid % nig) % gsz); u.pn = (wgid % nig) / gsz; return true;
    }
    __device__ __forceinline__ void a_ready(const Unit&) const {}
    __device__ __forceinline__ void done(const Unit&) const {}
};

__device__ __forceinline__ unsigned cvt_pk_bf16(float lo, float hi) { unsigned r; asm volatile("v_cvt_pk_bf16_f32 %0, %1, %2" : "=v"(r) : "v"(lo), "v"(hi)); return r; }
template <class Fn> struct EpiGen {
    static constexpr bool PERM = true, AFTER_DRAIN = false;
    Fn fn;
    __device__ __forceinline__ void operator()(const f32x4 (&acc)[2][2][4][2], const Unit& u, int wr, int wc, int fr, int fq) const {
#pragma unroll
        for (int ai = 0; ai < 2; ++ai)
#pragma unroll
            for (int m = 0; m < 4; ++m) { const int row = u.pm * BM + ai * HALF + wr * 64 + m * 16 + fr;
#pragma unroll
                for (int bj = 0; bj < 2; ++bj) { const int col = u.pn * BM + bj * HALF + wc * 32 + 8 * fq; fn(row, col, acc[ai][bj][m][0], acc[ai][bj][m][1]); } }
    }
};
template <class Epi, class Sched, bool ALIGN_EPI = false, bool SP2 = false, bool GATHER = false>
__device__ __forceinline__ void gemm_phase(PG8_LAS unsigned char* lds, const Gemm g, const Sched& S, const Epi& E) {
    static_assert(!GATHER || SP2, "the gathered A path is written for the SP2 loop");
    const int tid = threadIdx.x, wid = __builtin_amdgcn_readfirstlane(tid >> 6), lane = tid & 63, wr = wid >> 2, wc = wid & 3, fr = lane & 15, fq = lane >> 4;
    const int K = g.K, nt = K / BK;
    unsigned voffA[2], voffB[2]; int gR[2], gC[2]; unsigned gA[2][2], gN[2][2];
#pragma unroll
    for (int i = 0; i < 2; ++i) { int R, C; stage_rc(tid * 16 + i * 8192, R, C); const int Rb = Epi::PERM ? ((R & ~31) + perm32(R & 31)) : R;
        voffA[i] = (unsigned)(R * K + C) * 2u; voffB[i] = (unsigned)(Rb * K + C) * 2u; gR[i] = R; gC[i] = C; }
    const size_t kstep = (size_t)(BK * 2);
    const size_t hstep = (size_t)HALF * K * 2;
    const size_t tstep = 2 * hstep;
    const unsigned ldsw = (unsigned)wid * 1024u;
    const int aoff = lds_byte(wr * 64 + fr, fq * 8), boff = lds_byte(wc * 32 + fr, fq * 8);
#define PG8_SA(b, h) (((b) * 2 + (h)) * HTB)
#define PG8_SB(b, h) ((4 + (b) * 2 + (h)) * HTB)
#define PG8_STAGE(bufoff, gbase, voff) do { _Pragma("unroll") for (int _i = 0; _i < 2; ++_i) \
        __builtin_amdgcn_global_load_lds((const unsigned*)((const char*)(gbase) + (voff)[_i]), (PG8_LAS unsigned*)(lds + (bufoff) + ldsw + _i * 8192), 16, 0, 0); } while (0)
#define PG8_GOFF(u_, out_) do { _Pragma("unroll") for (int _h = 0; _h < 2; ++_h) _Pragma("unroll") for (int _i = 0; _i < 2; ++_i) \
        out_[_h][_i] = ((unsigned)S.src[(u_).pm * BM + _h * HALF + gR[_i]] * (unsigned)K + (unsigned)gC[_i]) * 2u; } while (0)
#define PG8_STAGE_A(bufoff, kptr, h, isnext) do { if constexpr (GATHER) { unsigned _o[2]; _o[0] = (isnext) ? gN[h][0] : gA[h][0]; _o[1] = (isnext) ? gN[h][1] : gA[h][1]; PG8_STAGE(bufoff, kptr, _o); } \
        else { PG8_STAGE(bufoff, (kptr) + (h) * hstep, voffA); } } while (0)
#define PG8_LDA(dst, b, h) do { _Pragma("unroll") for (int m = 0; m < 4; ++m) _Pragma("unroll") for (int k = 0; k < 2; ++k) dst[m][k] = *(const PG8_LAS bf16x8*)(lds + PG8_SA(b, h) + aoff + m * 2048 + k * 1024); } while (0)
#define PG8_LDB(dst, b, h) do { _Pragma("unroll") for (int n = 0; n < 2; ++n) _Pragma("unroll") for (int k = 0; k < 2; ++k) dst[n][k] = *(const PG8_LAS bf16x8*)(lds + PG8_SB(b, h) + boff + n * 2048 + k * 1024); } while (0)
#define PG8_MMA(ai, bj, At, Bt) do { __builtin_amdgcn_s_setprio(1); _Pragma("unroll") for (int m = 0; m < 4; ++m) _Pragma("unroll") for (int n = 0; n < 2; ++n) _Pragma("unroll") for (int k = 0; k < 2; ++k) \
        acc[ai][bj][m][n] = __builtin_amdgcn_mfma_f32_16x16x32_bf16(Bt[n][k], At[m][k], acc[ai][bj][m][n], 0, 0, 0); __builtin_amdgcn_s_setprio(0); } while (0)
#define PG8_WAIT_V(n) asm volatile("s_waitcnt vmcnt(" #n ")" ::: "memory")
#define PG8_WAIT_L(n) asm volatile("s_waitcnt lgkmcnt(" #n ")" ::: "memory")
#define PG8_BAR __builtin_amdgcn_s_barrier()
#define PG8_SCHED __builtin_amdgcn_sched_barrier(0)
    Unit cur, nxt; int ui = 0;
    if (!S.next(0, cur)) return;
    f32x4 acc[2][2][4][2];
#pragma unroll
    for (int a = 0; a < 2; ++a)
#pragma unroll
        for (int b = 0; b < 2; ++b)
#pragma unroll
            for (int m = 0; m < 4; ++m)
#pragma unroll
                for (int n = 0; n < 2; ++n) acc[a][b][m][n] = (f32x4){0.f, 0.f, 0.f, 0.f};
    bf16x8 At[4][2], B0[2][2], B1[2][2];
    const char* cA = (const char*)g.A + (GATHER ? (size_t)0 : (size_t)cur.pm * tstep); const char* cB = (const char*)g.Bt + (size_t)cur.pn * tstep;
    if constexpr (GATHER) PG8_GOFF(cur, gA);
    S.a_ready(cur);
    if constexpr (SP2) {
        PG8_STAGE(PG8_SB(0, 0), cB, voffB); PG8_STAGE(PG8_SB(0, 1), cB + hstep, voffB); PG8_STAGE_A(PG8_SA(0, 0), cA, 0, false); PG8_STAGE_A(PG8_SA(0, 1), cA, 1, false);
        if (wr == 1) PG8_BAR;
        PG8_WAIT_V(2); PG8_BAR;
        PG8_STAGE(PG8_SB(1, 0), cB + kstep, voffB); PG8_STAGE_A(PG8_SA(1, 0), cA + kstep, 0, false); PG8_STAGE(PG8_SB(1, 1), cB + hstep + kstep, voffB);
        PG8_WAIT_V(6); PG8_BAR;
    } else {
        PG8_STAGE(PG8_SB(0, 0), cB, voffB); PG8_STAGE(PG8_SA(0, 0), cA, voffA); PG8_STAGE(PG8_SB(0, 1), cB + hstep, voffB); PG8_STAGE(PG8_SA(0, 1), cA + hstep, voffA);
        if (wr == 1) PG8_BAR;
        PG8_WAIT_V(4); PG8_BAR;
        PG8_STAGE(PG8_SB(1, 0), cB + kstep, voffB); PG8_STAGE(PG8_SA(1, 0), cA + kstep, voffA); PG8_STAGE(PG8_SB(1, 1), cB + hstep + kstep, voffB);
        PG8_WAIT_V(6); PG8_BAR;
    }
    for (;;) {
        const bool has_next = S.next(ui + 1, nxt);
        const char* nA = (has_next && !GATHER) ? (const char*)g.A + (size_t)nxt.pm * tstep : cA; const char* nB = has_next ? (const char*)g.Bt + (size_t)nxt.pn * tstep : cB;
        if constexpr (GATHER) { if (has_next) PG8_GOFF(nxt, gN); else { _Pragma("unroll") for (int _h = 0; _h < 2; ++_h) { gN[_h][0] = gA[_h][0]; gN[_h][1] = gA[_h][1]; } } }
        for (int t = 0; t < nt; t += 2) {
            const bool last = (t == nt - 2);
            const char* a1 = cA + (size_t)(t + 1) * kstep;
            const char* a2 = last ? nA : cA + (size_t)(t + 2) * kstep; const char* b2 = last ? nB : cB + (size_t)(t + 2) * kstep;
            const char* a3 = a2 + kstep; const char* b3 = b2 + kstep;
            if (last && has_next) S.a_ready(nxt);
            if constexpr (SP2) {
            PG8_LDB(B0, 0, 0); PG8_LDB(B1, 0, 1); PG8_SCHED; PG8_LDA(At, 0, 0); PG8_STAGE_A(PG8_SA(1, 1), a1, 1, false);
            PG8_WAIT_V(8); PG8_WAIT_L(0); PG8_BAR; PG8_MMA(0, 0, At, B0); PG8_MMA(0, 1, At, B1); PG8_BAR; PG8_SCHED;
            PG8_LDA(At, 0, 1); PG8_STAGE(PG8_SB(0, 0), b2, voffB); PG8_STAGE(PG8_SB(0, 1), b2 + hstep, voffB); PG8_STAGE_A(PG8_SA(0, 0), a2, 0, last);
            PG8_WAIT_V(8); PG8_WAIT_L(0); PG8_BAR; PG8_MMA(1, 0, At, B0); PG8_MMA(1, 1, At, B1); PG8_BAR; PG8_SCHED;
            PG8_LDB(B0, 1, 0); PG8_LDB(B1, 1, 1); PG8_SCHED; PG8_LDA(At, 1, 0); PG8_STAGE_A(PG8_SA(0, 1), a2, 1, last);
            PG8_WAIT_V(8); PG8_WAIT_L(0); PG8_BAR; PG8_MMA(0, 0, At, B0); PG8_MMA(0, 1, At, B1); PG8_BAR; PG8_SCHED;
            PG8_LDA(At, 1, 1); PG8_STAGE(PG8_SB(1, 0), b3, voffB); PG8_STAGE(PG8_SB(1, 1), b3 + hstep, voffB); PG8_STAGE_A(PG8_SA(1, 0), a3, 0, last);
            PG8_WAIT_V(8); PG8_WAIT_L(0); PG8_BAR; PG8_MMA(1, 0, At, B0); PG8_MMA(1, 1, At, B1); PG8_BAR; PG8_SCHED;
            } else {
            PG8_LDB(B0, 0, 0); PG8_SCHED; PG8_LDA(At, 0, 0); PG8_STAGE(PG8_SA(1, 1), a1 + hstep, voffA);
            PG8_WAIT_L(8); PG8_BAR; PG8_WAIT_L(0); PG8_MMA(0, 0, At, B0); PG8_BAR; PG8_SCHED;
            PG8_LDB(B1, 0, 1); PG8_STAGE(PG8_SB(0, 0), b2, voffB);
            PG8_BAR; PG8_WAIT_L(0); PG8_MMA(0, 1, At, B1); PG8_BAR;
            PG8_LDA(At, 0, 1); PG8_STAGE(PG8_SA(0, 0), a2, voffA);
            PG8_BAR; PG8_WAIT_L(0); PG8_MMA(1, 0, At, B0); PG8_BAR; PG8_SCHED;
            PG8_STAGE(PG8_SB(0, 1), b2 + hstep, voffB);
            PG8_WAIT_V(6); PG8_BAR; PG8_MMA(1, 1, At, B1); PG8_BAR;
            PG8_LDB(B0, 1, 0); PG8_SCHED; PG8_LDA(At, 1, 0); PG8_STAGE(PG8_SA(0, 1), a2 + hstep, voffA);
            PG8_WAIT_L(8); PG8_BAR; PG8_WAIT_L(0); PG8_MMA(0, 0, At, B0); PG8_BAR; PG8_SCHED;
            PG8_LDB(B1, 1, 1); PG8_STAGE(PG8_SB(1, 0), b3, voffB);
            PG8_BAR; PG8_WAIT_L(0); PG8_MMA(0, 1, At, B1); PG8_BAR;
            PG8_LDA(At, 1, 1); PG8_STAGE(PG8_SA(1, 0), a3, voffA);
            PG8_BAR; PG8_WAIT_L(0); PG8_MMA(1, 0, At, B0); PG8_BAR; PG8_SCHED;
            PG8_STAGE(PG8_SB(1, 1), b3 + hstep, voffB);
            PG8_WAIT_V(6); PG8_BAR; PG8_MMA(1, 1, At, B1); PG8_BAR;
            }
        }
        if constexpr (ALIGN_EPI) { if (wr == 0) PG8_BAR; }
        if constexpr (!Epi::AFTER_DRAIN) { E(acc, cur, wr, wc, fr, fq); S.done(cur); }
        if (!has_next) break;
#pragma unroll
        for (int a = 0; a < 2; ++a)
#pragma unroll
            for (int b = 0; b < 2; ++b)
#pragma unroll
                for (int m = 0; m < 4; ++m)
#pragma unroll
                    for (int n = 0; n < 2; ++n) acc[a][b][m][n] = (f32x4){0.f, 0.f, 0.f, 0.f};
        cur = nxt; cA = nA; cB = nB; ++ui;
        if constexpr (GATHER) { _Pragma("unroll") for (int _h = 0; _h < 2; ++_h) { gA[_h][0] = gN[_h][0]; gA[_h][1] = gN[_h][1]; } }
        if constexpr (ALIGN_EPI) { if (wr == 1) PG8_BAR; }
    }
    PG8_WAIT_V(0);
    if constexpr (!ALIGN_EPI) { if (wr == 0) PG8_BAR; }
    PG8_BAR;
    if constexpr (Epi::AFTER_DRAIN) { E.fused(acc, cur, wr, wc, fr, fq, lds, wid, lane); S.done(cur); }
#undef PG8_SA
#undef PG8_SB
#undef PG8_STAGE
#undef PG8_STAGE_A
#undef PG8_GOFF
#undef PG8_LDA
#undef PG8_LDB
#undef PG8_MMA
#undef PG8_WAIT_V
#undef PG8_WAIT_L
#undef PG8_BAR
#undef PG8_SCHED
}
}
#define GAS __attribute__((address_space(1)))
#define LAS __attribute__((address_space(3)))
typedef unsigned short bf16;
typedef unsigned v4u __attribute__((ext_vector_type(4)));
typedef unsigned v2u __attribute__((ext_vector_type(2)));
typedef float f32x4 __attribute__((ext_vector_type(4)));
typedef short bf16x8 __attribute__((ext_vector_type(8)));
typedef GAS unsigned gu32;
typedef GAS unsigned long long gu64;
#define RLX_AGENT __ATOMIC_RELAXED, __HIP_MEMORY_SCOPE_AGENT
#define LDS_WAIT() asm volatile("s_waitcnt lgkmcnt(0)" ::: "memory")
#define VM_WAIT() asm volatile("s_waitcnt vmcnt(0)" ::: "memory")
typedef float f32x2_cv __attribute__((ext_vector_type(2)));
typedef __bf16 bf16x2_cv __attribute__((ext_vector_type(2)));
__device__ __forceinline__ unsigned pk2(float lo, float hi) { const f32x2_cv v = {lo, hi}; return __builtin_bit_cast(unsigned, __builtin_convertvector(v, bf16x2_cv)); }
__device__ __forceinline__ unsigned f2bf(float f) { return (unsigned)__builtin_bit_cast(unsigned short, (__bf16)f); }
__device__ __forceinline__ float bflo(unsigned w) { return __builtin_bit_cast(float, w << 16); }
__device__ __forceinline__ float bfhi(unsigned w) { return __builtin_bit_cast(float, w & 0xffff0000u); }
__device__ __forceinline__ float bf2f(bf16 b) { return __builtin_bit_cast(float, (unsigned)b << 16); }
__device__ __forceinline__ void unpack8(v4u w, float (&x)[8]) { x[0] = bflo(w.x); x[1] = bfhi(w.x); x[2] = bflo(w.y); x[3] = bfhi(w.y); x[4] = bflo(w.z); x[5] = bfhi(w.z); x[6] = bflo(w.w); x[7] = bfhi(w.w); }
__device__ __forceinline__ float wave_sum(float v) {
#pragma unroll
    for (int o = 1; o < 64; o <<= 1) v += __shfl_xor(v, o);
    return v;
}
__device__ __forceinline__ float sigmoidf_(float x) { return 1.f / (1.f + __expf(-x)); }

#define XB_TMO      128
#define XB_XCNT(j)  (256  + 64 * (j))
#define XB_XSUB(j)  (1280 + 64 * (j))
#define XB_XGEN(j)  (2304 + 64 * (j))
#define XB_TOP      3328
#define XB_TOPGEN   3392
#define XCD_BAR_WORDS 3456
#define XB_SPIN_CAP (1u << 22)

__device__ __forceinline__ unsigned xb_ld(unsigned* p)              { return __hip_atomic_load(p, __ATOMIC_RELAXED, __HIP_MEMORY_SCOPE_AGENT); }
__device__ __forceinline__ unsigned xb_add(unsigned* p, unsigned v) { return __hip_atomic_fetch_add(p, v, __ATOMIC_RELAXED, __HIP_MEMORY_SCOPE_AGENT); }
__device__ __forceinline__ unsigned xb_xcc_id() { return (unsigned)__builtin_amdgcn_s_getreg((3 << 11) | 20) & 0xFu; }
#define XB_SPIN(cond, bar) do { unsigned _sp = 0; while (cond) { __builtin_amdgcn_s_sleep(1); \
    if ((++_sp & 255u) == 0u) { if (xb_ld(&(bar)[XB_TMO])) break; if (_sp > XB_SPIN_CAP) { atomicAdd(&(bar)[XB_TMO], 1u); break; } } } } while (0)

struct XcdBarrier {
    unsigned* bar; unsigned x;
    volatile LAS unsigned* st;
};

__device__ __forceinline__ XcdBarrier xcd_barrier_post(unsigned* bar, volatile LAS unsigned* st) {
    XcdBarrier b; b.bar = bar; b.x = xb_xcc_id(); b.st = st;
    if (threadIdx.x == 0) (void)xb_add(&bar[XB_XCNT(b.x)], 1u);
    return b;
}
__device__ __forceinline__ void xcd_barrier_complete(unsigned* bar, unsigned x, unsigned& nloc, unsigned& nx) {
    const unsigned G = gridDim.x * gridDim.y * gridDim.z;
    unsigned sum, cnt, mine, sp = 0u;
    for (;;) {
        sum = 0u; cnt = 0u; mine = 0u;
#pragma unroll
        for (unsigned j = 0; j < 16; ++j) { const unsigned c = xb_ld(&bar[XB_XCNT(j)]); sum += c; cnt += (c > 0u) ? 1u : 0u; mine = (j == x) ? c : mine; }
        if (sum == G) break;
        __builtin_amdgcn_s_sleep(1);
        if ((++sp & 255u) == 0u) { if (xb_ld(&bar[XB_TMO])) break; if (sp > XB_SPIN_CAP) { atomicAdd(&bar[XB_TMO], 1u); break; } }
    }
    nloc = mine > 0u ? mine : 1u; nx = cnt > 0u ? cnt : 1u;
}

__device__ __forceinline__ void xcd_barrier(const XcdBarrier& b) {
    asm volatile("s_waitcnt vmcnt(0)" ::: "memory");
    __syncthreads();
    if (threadIdx.x == 0) {
        unsigned* bar = b.bar;
        __builtin_amdgcn_s_waitcnt(0);
        unsigned nloc = b.st[0], nx = b.st[1];
        if (nloc == 0u) { xcd_barrier_complete(bar, b.x, nloc, nx); b.st[0] = nloc; b.st[1] = nx; }
        const unsigned old = xb_add(&bar[XB_XSUB(b.x)], 1u);
        const unsigned gen = old / nloc;
        if (old + 1u == (gen + 1u) * nloc) {
            __builtin_amdgcn_fence(__ATOMIC_RELEASE, "agent");
            asm volatile("s_waitcnt vmcnt(0)" ::: "memory");
            const unsigned og = xb_add(&bar[XB_TOP], 1u);
            const unsigned tg = og / nx;
            if (og + 1u == (tg + 1u) * nx) xb_add(&bar[XB_TOPGEN], 1u);
            else XB_SPIN(xb_ld(&bar[XB_TOPGEN]) == tg, bar);
            __builtin_amdgcn_fence(__ATOMIC_ACQUIRE, "agent");
            xb_add(&bar[XB_XGEN(b.x)], 1u);
            asm volatile("s_waitcnt vmcnt(0)" ::: "memory");
        } else {
            XB_SPIN(xb_ld(&bar[XB_XGEN(b.x)]) == gen, bar);
            __builtin_amdgcn_fence(__ATOMIC_ACQUIRE, "agent");
            asm volatile("s_waitcnt vmcnt(0)" ::: "memory");
        }
    }
    __syncthreads();
}
namespace att {
using s16x4  = __attribute__((ext_vector_type(4))) short;
using f32x16 = __attribute__((ext_vector_type(16))) float;
using u32x4  = __attribute__((ext_vector_type(4))) unsigned;
#define ATT_SBAR() __builtin_amdgcn_sched_barrier(0)
constexpr float THR2 = 11.5f;
__device__ __forceinline__ int crow(int r, int hi) { return (r & 3) + 8 * (r >> 2) + 4 * hi; }
__device__ __forceinline__ unsigned cvtpk(float lo, float hi) { unsigned r; asm volatile("v_cvt_pk_bf16_f32 %0, %1, %2" : "=v"(r) : "v"(lo), "v"(hi)); return r; }

__device__ __forceinline__ void partialSM(f32x16& p0, f32x16& p1, float& m_reg, float& mn, float& alpha) {
  float pmax = p0[0];
#pragma unroll
  for (int r = 1; r < 16; ++r) pmax = fmaxf(pmax, p0[r]);
#pragma unroll
  for (int r = 0; r < 16; ++r) pmax = fmaxf(pmax, p1[r]);
  { auto rr = __builtin_amdgcn_permlane32_swap(__float_as_uint(pmax), __float_as_uint(pmax), false, false);
    pmax = fmaxf(__uint_as_float(rr[0]), __uint_as_float(rr[1])); }
  if (__builtin_expect(__all(pmax - m_reg <= THR2), 1)) { mn = m_reg; alpha = 1.f; }
  else { mn = fmaxf(m_reg, pmax); alpha = __builtin_amdgcn_exp2f(m_reg - mn); m_reg = mn; }
#pragma unroll
  for (int r = 0; r < 16; ++r) p0[r] = p0[r] - mn;
#pragma unroll
  for (int r = 0; r < 16; ++r) p1[r] = p1[r] - mn;
#pragma unroll
  for (int r = 0; r < 16; ++r) p0[r] = __builtin_amdgcn_exp2f(p0[r]);
}
__device__ __forceinline__ void finishSM(f32x16& p0, f32x16& p1, bf16x8& pa0, bf16x8& pa1, bf16x8& pa2, bf16x8& pa3) {
#pragma unroll
  for (int r = 0; r < 16; ++r) p1[r] = __builtin_amdgcn_exp2f(p1[r]);
#define ATT_PK4(P, BASE, OUT) do { unsigned a0 = cvtpk(P[BASE + 0], P[BASE + 1]), a1 = cvtpk(P[BASE + 2], P[BASE + 3]);   \
    unsigned b0 = cvtpk(P[BASE + 4], P[BASE + 5]), b1 = cvtpk(P[BASE + 6], P[BASE + 7]);                              \
    auto r0 = __builtin_amdgcn_permlane32_swap(a0, b0, false, false); auto r1 = __builtin_amdgcn_permlane32_swap(a1, b1, false, false); \
    u32x4 w = {r0[0], r1[0], r0[1], r1[1]}; OUT = *reinterpret_cast<bf16x8*>(&w); } while (0)
  ATT_PK4(p0, 0, pa0); ATT_PK4(p0, 8, pa1); ATT_PK4(p1, 0, pa2); ATT_PK4(p1, 8, pa3);
#undef ATT_PK4
}
template <int NB> __device__ __forceinline__ int v_st(int k, int c) { const int kk = (k & ~0xC) | ((k & 4) << 1) | ((k & 8) >> 1); return ((kk >> 3) * NB + (c >> 5)) * 512 + ((kk & 7) * 32 + (c & 31)) * 2; }
__device__ __forceinline__ int v_rd_base(int lane) { return ((lane & 3) << 3) | (((lane >> 2) & 3) << 6) | (((lane >> 4) & 1) << 5) | (((lane >> 5) & 1) << 8); }
template <int OFF> __device__ __forceinline__ s16x4 tr_read(int vb) {
  s16x4 r; asm volatile("ds_read_b64_tr_b16 %0, %1 offset:%2" : "=&v"(r) : "v"(vb), "i"(OFF) : "memory"); return r;
}
template <int NB, int D0> __device__ __forceinline__ void pv_one(f32x16& od, int vb, bf16x8 pa0, bf16x8 pa1, bf16x8 pa2, bf16x8 pa3) {
#define ATT_VOFF(ks, half) (D0 * 512 + (ks) * (NB * 1024) + (half) * (NB * 512))
  const s16x4 l0 = tr_read<ATT_VOFF(0, 0)>(vb), h0 = tr_read<ATT_VOFF(0, 1)>(vb), l1 = tr_read<ATT_VOFF(1, 0)>(vb), h1 = tr_read<ATT_VOFF(1, 1)>(vb);
  const s16x4 l2 = tr_read<ATT_VOFF(2, 0)>(vb), h2 = tr_read<ATT_VOFF(2, 1)>(vb), l3 = tr_read<ATT_VOFF(3, 0)>(vb), h3 = tr_read<ATT_VOFF(3, 1)>(vb);
#undef ATT_VOFF
  asm volatile("s_waitcnt lgkmcnt(0)" ::: "memory"); ATT_SBAR();
#define ATT_PK(L, H) (bf16x8){L[0], L[1], L[2], L[3], H[0], H[1], H[2], H[3]}
  od = __builtin_amdgcn_mfma_f32_32x32x16_bf16(pa0, ATT_PK(l0, h0), od, 0, 0, 0);
  od = __builtin_amdgcn_mfma_f32_32x32x16_bf16(pa1, ATT_PK(l1, h1), od, 0, 0, 0);
  od = __builtin_amdgcn_mfma_f32_32x32x16_bf16(pa2, ATT_PK(l2, h2), od, 0, 0, 0);
  od = __builtin_amdgcn_mfma_f32_32x32x16_bf16(pa3, ATT_PK(l3, h3), od, 0, 0, 0);
#undef ATT_PK
}
template <int NB> __device__ __forceinline__ void pv_all(f32x16* o, f32x16& lsum, int vb, bf16x8 pa0, bf16x8 pa1, bf16x8 pa2, bf16x8 pa3) {
  const bf16x8 ones = {0x3F80, 0x3F80, 0x3F80, 0x3F80, 0x3F80, 0x3F80, 0x3F80, 0x3F80};
  lsum = __builtin_amdgcn_mfma_f32_32x32x16_bf16(pa0, ones, lsum, 0, 0, 0); lsum = __builtin_amdgcn_mfma_f32_32x32x16_bf16(pa1, ones, lsum, 0, 0, 0);
  pv_one<NB, 0>(o[0], vb, pa0, pa1, pa2, pa3); pv_one<NB, 1>(o[1], vb, pa0, pa1, pa2, pa3);
  lsum = __builtin_amdgcn_mfma_f32_32x32x16_bf16(pa2, ones, lsum, 0, 0, 0); lsum = __builtin_amdgcn_mfma_f32_32x32x16_bf16(pa3, ones, lsum, 0, 0, 0);
  if constexpr (NB == 4) { pv_one<NB, 2>(o[2], vb, pa0, pa1, pa2, pa3); pv_one<NB, 3>(o[3], vb, pa0, pa1, pa2, pa3); }
}
template <int DK> __device__ __forceinline__ void qkt(f32x16& p0, f32x16& p1, LAS const char* Ks, const bf16x8* qr, int r32, int hi) {
  constexpr int KSTR = DK * 2 + 16;
  p0 = f32x16{}; p1 = f32x16{};
#pragma unroll
  for (int d0 = 0; d0 < DK / 16; ++d0) { const int cb = (d0 * 16 + hi * 8) * 2;
    const bf16x8 b0 = *(LAS const bf16x8*)(Ks + r32 * KSTR + cb);
    const bf16x8 b1 = *(LAS const bf16x8*)(Ks + (32 + r32) * KSTR + cb);
    p0 = __builtin_amdgcn_mfma_f32_32x32x16_bf16(b0, qr[d0], p0, 0, 0, 0);
    p1 = __builtin_amdgcn_mfma_f32_32x32x16_bf16(b1, qr[d0], p1, 0, 0, 0); }
}
template <int DK, int DV> struct Cfg {
  static constexpr int KSTR = DK * 2 + 16, KT = 64 * KSTR, NB = DV / 32, VT = 64 * DV * 2, NQ = DK / 16;
  static constexpr int NKC = DK / 8, NVC = DV / 8;
  static constexpr int KN = (64 * NKC + 511) / 512, VN = (64 * NVC + 511) / 512;
  static constexpr int OFF_V = 0, OFF_K = 2 * VT, OFF_WS = 2 * VT + 2 * KT, LDS_BYTES = OFF_WS + 8 * 64 * 4;
};
template <int DK, int DV>
__device__ __forceinline__ void attn_unit(const bf16* __restrict__ Qb, int ldq, const bf16* __restrict__ K1, int ldk1, const bf16* __restrict__ K2, int ldk2,
                                          const bf16* __restrict__ Vh, int ldv, float* __restrict__ Ob, int ldo, int nkeys, LAS char* lds) {
  using C = Cfg<DK, DV>;
  const int tid = threadIdx.x, wid = tid >> 6, lane = tid & 63, r32 = lane & 31, hi = lane >> 5;
  LAS char* V_lds = lds + C::OFF_V; LAS char* K_lds = lds + C::OFF_K;
  LAS float* ws = (LAS float*)(lds + C::OFF_WS) + wid * 64; LAS float* li_l = ws; LAS float* al_l = ws + 32;
  float m_reg = -1e30f; f32x16 o[C::NB] = {}; f32x16 lsum = {}; bf16x8 qr[C::NQ];
  { const bf16* Qw = Qb + (long)(wid * 32 + r32) * ldq + hi * 8;
#pragma unroll
    for (int d0 = 0; d0 < C::NQ; ++d0) qr[d0] = *(const bf16x8*)(Qw + d0 * 16); }
  unsigned kg[C::KN], kw[C::KN], vg[C::VN], vw[C::VN]; const bool k2val = tid < 256;
  kg[0] = (unsigned)((tid >> 3) * ldk1 + (tid & 7) * 8); kw[0] = (unsigned)((tid >> 3) * C::KSTR + (tid & 7) * 16);
  if constexpr (C::KN == 2) { const int t2 = tid & 255; kg[1] = (unsigned)((t2 >> 2) * ldk2 + (t2 & 3) * 8); kw[1] = (unsigned)((t2 >> 2) * C::KSTR + (8 + (t2 & 3)) * 16); }
#pragma unroll
  for (int i = 0; i < C::VN; ++i) { const int it = tid + 512 * i, vrow = it / C::NVC, vcol = (it % C::NVC) * 8; vg[i] = (unsigned)(vrow * ldv + vcol); vw[i] = (unsigned)v_st<C::NB>(vrow, vcol); }
  const int vb0 = (int)(uintptr_t)V_lds + v_rd_base(lane);
  struct Slot { bf16x8 ks[C::KN], vs[C::VN]; } sA, sB;
#define ATT_SLOAD(S, k0) do { S.ks[0] = *(const bf16x8*)(K1 + (size_t)(k0) * ldk1 + kg[0]); if constexpr (C::KN == 2) S.ks[1] = *(const bf16x8*)(K2 + (size_t)(k0) * ldk2 + kg[1]); \
    _Pragma("unroll") for (int i = 0; i < C::VN; ++i) S.vs[i] = *(const bf16x8*)(Vh + (size_t)(k0) * ldv + vg[i]); } while (0)
#define ATT_SWRITE(b, S) do { *(LAS bf16x8*)(K_lds + (b) * C::KT + kw[0]) = S.ks[0]; if constexpr (C::KN == 2) { if (k2val) *(LAS bf16x8*)(K_lds + (b) * C::KT + kw[1]) = S.ks[1]; } \
    _Pragma("unroll") for (int i = 0; i < C::VN; ++i) *(LAS bf16x8*)(V_lds + (b) * C::VT + vw[i]) = S.vs[i]; } while (0)
#define ATT_SWAIT() asm volatile("s_waitcnt vmcnt(3)" ::: "memory")
#define ATT_RESC(a) do { if (__any((a) < 1.f)) { if (hi == 0) al_l[r32] = (a); asm volatile("s_waitcnt lgkmcnt(0)" ::: "memory"); \
    _Pragma("unroll") for (int r = 0; r < 16; ++r) { const float f_ = al_l[crow(r, hi)]; lsum[r] *= f_; _Pragma("unroll") for (int d = 0; d < C::NB; ++d) o[d][r] *= f_; } } } while (0)
  static_assert(C::KN + C::VN == 3, "three staging loads per thread per tile (ATT_SWAIT)");
  f32x16 pA0, pA1, pB0, pB1; float mnA, mnB, alA, alB; bf16x8 pa0, pa1, pa2, pa3; const int NT = nkeys / 64;
  __syncthreads();
  ATT_SLOAD(sA, 0); asm volatile("s_waitcnt vmcnt(0)" ::: "memory"); ATT_SWRITE(0, sA); __syncthreads();
  qkt<DK>(pA0, pA1, K_lds, qr, r32, hi); partialSM(pA0, pA1, m_reg, mnA, alA);
  ATT_SLOAD(sB, 64); if (2 < NT) ATT_SLOAD(sA, 128);
  ATT_SWAIT(); ATT_SWRITE(1, sB); __syncthreads();
  for (int j = 1; j + 1 < NT; j += 2) {
    ATT_SBAR(); qkt<DK>(pB0, pB1, K_lds + C::KT, qr, r32, hi);
    finishSM(pA0, pA1, pa0, pa1, pa2, pa3); ATT_SBAR();
    ATT_SLOAD(sB, (j + 2) * 64); ATT_SBAR();
    pv_all<C::NB>(o, lsum, vb0, pa0, pa1, pa2, pa3); partialSM(pB0, pB1, m_reg, mnB, alB);
    __syncthreads(); ATT_SWAIT(); ATT_SWRITE(0, sA);
    ATT_RESC(alB); __syncthreads();
    ATT_SBAR(); qkt<DK>(pA0, pA1, K_lds, qr, r32, hi);
    finishSM(pB0, pB1, pa0, pa1, pa2, pa3); ATT_SBAR();
    if (j + 3 < NT) ATT_SLOAD(sA, (j + 3) * 64); ATT_SBAR();
    pv_all<C::NB>(o, lsum, vb0 + C::VT, pa0, pa1, pa2, pa3); partialSM(pA0, pA1, m_reg, mnA, alA);
    __syncthreads(); ATT_SWAIT(); ATT_SWRITE(1, sB);
    ATT_RESC(alA); __syncthreads();
  }
  ATT_SBAR(); qkt<DK>(pB0, pB1, K_lds + C::KT, qr, r32, hi);
  finishSM(pA0, pA1, pa0, pa1, pa2, pa3); ATT_SBAR();
  pv_all<C::NB>(o, lsum, vb0, pa0, pa1, pa2, pa3); partialSM(pB0, pB1, m_reg, mnB, alB);
  __syncthreads(); ATT_RESC(alB);
  finishSM(pB0, pB1, pa0, pa1, pa2, pa3); ATT_SBAR();
  pv_all<C::NB>(o, lsum, vb0 + C::VT, pa0, pa1, pa2, pa3);
  float rli[16];
#pragma unroll
  for (int r = 0; r < 16; ++r) rli[r] = __builtin_amdgcn_rcpf(lsum[r]);
  float* Ow = Ob + (long)(wid * 32) * ldo;
#pragma unroll
  for (int r = 0; r < 16; ++r) { const int orow = crow(r, hi);
#pragma unroll
    for (int d0 = 0; d0 < C::NB; ++d0) Ow[(long)orow * ldo + d0 * 32 + r32] = o[d0][r] * rli[r]; }
#undef ATT_SLOAD
#undef ATT_SWRITE
#undef ATT_SWAIT
#undef ATT_RESC
}
}
constexpr int DM = 1024, NBATCH = 2, SEQ = 16384, CT = 256, TB = SEQ + CT  , R = NBATCH * TB  ;
constexpr int ATT_IN = 2208, ATT_NP = 2304, REC_IN = 3472, REC_NP = 3584, RWKV_IN = 1920;
constexpr int NE = 32, TOPK = 4, MAXT = R * TOPK / 256 + NE  , MAXROWS = MAXT * 256;
constexpr int NUNIT_M = 16 * 260;
constexpr float NORM_EPS = 1e-6f;
enum { I_X = 0, I_C, I_CTX, I_CCTX, I_NMIX, I_NFFN, I_ADAW, I_ADAB, I_WOUT, I_RW, I_RB, I_W1, I_B1, I_W2, I_B2, I_ATTW, I_LAM, I_SUBLN, I_QNW, I_KVNW, I_WUQ, I_WUKV,
       I_RECW, I_MU, I_W0, I_RW2, I_A0, I_A2, I_G2, I_KK, I_KA, I_RK, I_LNW, I_LNB, I_GATEB, I_MNW, I_FNW, N_IN };
constexpr size_t al256(size_t x) { return (x + 255) & ~(size_t)255; }
constexpr size_t WS_CTL = 0, CTL_ZERO_BYTES = 1u << 20;
constexpr size_t WS_MOD = CTL_ZERO_BYTES;
constexpr size_t WS_ROPE = al256(WS_MOD + 2 * 3 * 6144 * 4);
constexpr size_t ROPE_DR = 0, ROPE_DC = 256 * 16 * 2, ROPE_MR = ROPE_DC + 64 * 16 * 2, ROPE_MC = ROPE_MR + 256 * 8 * 2, ROPE_FLOATS = ROPE_MC + 64 * 8 * 2;
constexpr size_t WS_WRH = al256(WS_ROPE + ROPE_FLOATS * 4);
constexpr size_t WS_WRL = al256(WS_WRH + (size_t)2 * 32 * 1024 * 2);
constexpr size_t WS_WIN0 = al256(WS_WRL + (size_t)2 * 32 * 1024 * 2);
constexpr size_t WS_WUQ = al256(WS_WIN0 + (size_t)ATT_NP * 1024 * 2);
constexpr size_t WS_WUKV = al256(WS_WUQ + (size_t)768 * 384 * 2);
constexpr size_t WS_WOUT = al256(WS_WUKV + (size_t)1024 * 256 * 2);
constexpr size_t WS_WREC = al256(WS_WOUT + (size_t)2 * 1024 * 1024 * 2);
constexpr size_t WS_WLORA = al256(WS_WREC + (size_t)REC_NP * 1024 * 2);
constexpr size_t WS_W1T = al256(WS_WLORA + (size_t)2560 * 384 * 2);
constexpr size_t WS_W2T = al256(WS_W1T + (size_t)NE * 2048 * 1024 * 2);
constexpr size_t WS_H = al256(WS_W2T + (size_t)NE * 1024 * 1024 * 2);
constexpr size_t WS_A = al256(WS_H + (size_t)R * 1024 * 4);
constexpr size_t WS_A1 = al256(WS_A + (size_t)R * 1024 * 2);
constexpr size_t WS_F = al256(WS_A1 + (size_t)R * 1024 * 2);
constexpr size_t WS_P = al256(WS_F + (size_t)R * 1024 * 2);
constexpr size_t WS_TOPE = al256(WS_P + (size_t)R * REC_NP * 2);
constexpr size_t WS_GATE = al256(WS_TOPE + (size_t)R * 16);
constexpr size_t WS_POS = al256(WS_GATE + (size_t)R * 16);
constexpr size_t WS_DEST = al256(WS_POS + (size_t)R * 16);
constexpr size_t WS_TILE = al256(WS_DEST + (size_t)R * 16);
constexpr size_t WS_SRC = al256(WS_TILE + (size_t)(MAXT + 8) * 4);
constexpr size_t WS_T = al256(WS_SRC + (size_t)MAXROWS * 4);
constexpr size_t WS_QD = WS_T;
constexpr size_t WS_KD = al256(WS_QD + (size_t)R * 512 * 2);
constexpr size_t WS_CQN = al256(WS_KD + (size_t)R * 512 * 2);
constexpr size_t WS_CKVN = al256(WS_CQN + (size_t)R * 384 * 2);
constexpr size_t WS_MQ = al256(WS_CKVN + (size_t)R * 256 * 2);
constexpr size_t WS_MKV = al256(WS_MQ + (size_t)R * 768 * 2);
constexpr size_t WS_KRR = al256(WS_MKV + (size_t)R * 1024 * 2);
constexpr size_t WS_ODIFF = al256(WS_KRR + (size_t)R * 32 * 2);
constexpr size_t WS_OMLA = al256(WS_ODIFF + (size_t)R * 1024 * 4);
constexpr size_t WS_T0_END = al256(WS_OMLA + (size_t)R * 512 * 4);
constexpr size_t WS_XS = WS_T;
constexpr size_t WS_HS = al256(WS_XS + (size_t)MAXROWS * 1024 * 2);
constexpr size_t WS_TM_END = al256(WS_HS + (size_t)MAXROWS * 1024 * 2);
constexpr size_t SZ_RC = (size_t)R * 512 * 4;
constexpr size_t WS_RR = WS_T, WS_VV = WS_RR + SZ_RC, WS_AKK = WS_VV + SZ_RC, WS_KL = WS_AKK + SZ_RC;
constexpr size_t WS_WDEC = WS_KL + SZ_RC  , WS_KDIR = WS_WDEC + 2 * SZ_RC  , WS_BB = WS_KDIR + 2 * SZ_RC  , WS_GG = WS_BB + 2 * SZ_RC;
constexpr size_t WS_ALORA = al256(WS_GG + SZ_RC);
constexpr size_t WS_YR = al256(WS_ALORA + (size_t)R * 384 * 2);
constexpr size_t WS_DC = WS_YR;
constexpr size_t WS_HM = al256(WS_YR + 2 * SZ_RC);
constexpr size_t WS_CST = al256(WS_HM + 2 * SZ_RC);
constexpr size_t WS_DN = al256(WS_CST + (size_t)NUNIT_M * 8192 * 4);
constexpr size_t WS_NST = al256(WS_DN + (size_t)NUNIT_M * 64 * 4);
constexpr size_t WS_SC = al256(WS_NST + (size_t)NUNIT_M * 64 * 4);
constexpr size_t WS_MST = al256(WS_SC + (size_t)NUNIT_M * 2 * 4);
constexpr size_t WS_ASIG = WS_KDIR;
constexpr size_t WS_YB = WS_BB;
constexpr int NUNIT_R = 32 * 260;
constexpr size_t WS_RKM = WS_KDIR + SZ_RC;
static_assert((size_t)NUNIT_R * 4096 * 2 <= SZ_RC, "M^T fits in KL");
constexpr size_t WS_RKQ = al256(WS_MST + (size_t)NUNIT_M * 4);
constexpr size_t WS_RKZ = al256(WS_RKQ + (size_t)NUNIT_R * 4096 * 2);
constexpr size_t WS_T1_END = al256(WS_RKZ + (size_t)NUNIT_R * 4096 * 2);
constexpr size_t WS_END = WS_T1_END > WS_TM_END ? (WS_T1_END > WS_T0_END ? WS_T1_END : WS_T0_END) : (WS_TM_END > WS_T0_END ? WS_TM_END : WS_T0_END);
static_assert(WS_END <= (size_t)2147483648ull, "workspace map exceeds 2 GiB");
constexpr int CW_CNT = 1024;
constexpr int CW_BAR = 4096;
constexpr int RING_BYTES = 131072, AUX_OFF = 131072, AUX_BYTES = 16384, MISC_OFF = 147456, LDS_BYTES = 163840;

struct Frame {
    LAS unsigned char* lds; gu32* ctl; int tid, lane, wave, blk, G, probe;
    float* out; unsigned char* ws;
    struct InTab { LAS const unsigned* t;
        __device__ __forceinline__ const float* operator[](int i) const { const unsigned lo = __builtin_amdgcn_readfirstlane(t[2 * i]), hi = __builtin_amdgcn_readfirstlane(t[2 * i + 1]);
            return (const float*)(((unsigned long long)hi << 32) | lo); } } in;
};
template <class T> __device__ __forceinline__ T* wsp(const Frame& F, size_t off) { return (T*)(F.ws + off); }
__device__ __forceinline__ int row_sel(int row) { const int b = row / TB, t = row - b * TB; return t < CT ? 2 : b; }
__device__ __forceinline__ const float* h0_row(const Frame& F, int row) {
    const int b = row / TB, t = row - b * TB;
    return t < CT ? F.in[I_CTX] + ((size_t)b * CT + t) * DM : F.in[I_X] + ((size_t)b * SEQ + (t - CT)) * DM;
}
__device__ __forceinline__ const float* modp(const Frame& F, int layer, int sel, int chunk) { return wsp<const float>(F, WS_MOD) + ((size_t)(layer * 3 + sel) * 6 + chunk) * DM; }
__device__ __forceinline__ int scan_tok(int z, int sg) { return z == 0 ? sg : (sg < CT ? CT - 1 - sg : TB + CT - 1 - sg); }
__device__ __forceinline__ void tr_item(const float* W, int K, int N, bf16* WT, int row_off, LAS float* scr, int kb, int nb, int lane) {
    const int k0 = 64 * kb, n0 = 32 * nb;
    const int n = n0 + (lane & 31);
    float tv[32];
#pragma unroll
    for (int i = 0; i < 32; ++i) { const int kk = 2 * i + (lane >> 5); tv[i] = (n < N) ? W[(size_t)(k0 + kk) * N + n] : 0.f; }
#pragma unroll
    for (int i = 0; i < 32; ++i) { const int kk = 2 * i + (lane >> 5); scr[kk * 33 + (lane & 31)] = tv[i]; }
    LDS_WAIT(); asm volatile("" ::: "memory");
    const int c = lane & 7;
#pragma unroll
    for (int j = 0; j < 4; ++j) { const int nn = (lane >> 3) + 8 * j; const LAS float* s = scr + (8 * c) * 33 + nn;
        v4u o; o.x = pk2(s[0 * 33], s[1 * 33]); o.y = pk2(s[2 * 33], s[3 * 33]); o.z = pk2(s[4 * 33], s[5 * 33]); o.w = pk2(s[6 * 33], s[7 * 33]);
        *(v4u*)(WT + (size_t)(row_off + n0 + nn) * K + k0 + 8 * c) = o; }
    LDS_WAIT(); asm volatile("" ::: "memory");
}
__device__ __forceinline__ void tr_family(const Frame& F, const float* W, size_t src_stride, int nmat, int K, int N, int Npad, bf16* WT, int gw, int NGW) {
    LAS float* scr = (LAS float*)(F.lds + F.wave * 16384);
    const int nkb = K / 64, nnb = Npad / 32, per = nkb * nnb, total = per * nmat;
    for (int it = gw; it < total; it += NGW) { const int m = it / per, r = it - m * per, kb = r / nnb, nb = r - kb * nnb;
        tr_item(W + (size_t)m * src_stride, K, N, WT, m * Npad, scr, kb, nb, F.lane); }
}
__device__ __forceinline__ void moe_weights_convert(const Frame& F, int layer, int gw, int NGW) {
    tr_family(F, F.in[I_W1] + (size_t)layer * NE * 1024 * 2048, (size_t)1024 * 2048, NE, 1024, 2048, 2048, wsp<bf16>(F, WS_W1T), gw, NGW);
    tr_family(F, F.in[I_W2] + (size_t)layer * NE * 1024 * 1024, (size_t)1024 * 1024, NE, 1024, 1024, 1024, wsp<bf16>(F, WS_W2T), gw, NGW);
}
__device__ __forceinline__ void norm_mod_row(const Frame& F, const float* src, const float* nw, const float* shift, const float* scale, bf16* orow) {
    const f32x4* xr = (const f32x4*)src + F.lane;
    f32x4 v[4]; float s = 0.f;
#pragma unroll
    for (int j = 0; j < 4; ++j) { v[j] = xr[64 * j]; s += (v[j].x * v[j].x + v[j].y * v[j].y) + (v[j].z * v[j].z + v[j].w * v[j].w); }
    const float rs = 1.f / sqrtf(wave_sum(s) * (1.f / DM) + NORM_EPS);
    unsigned long long* o8 = (unsigned long long*)orow + F.lane;
#pragma unroll
    for (int j = 0; j < 4; ++j) { const f32x4 w = ((const f32x4*)nw)[F.lane + 64 * j], sh = ((const f32x4*)shift)[F.lane + 64 * j], sc = ((const f32x4*)scale)[F.lane + 64 * j];
        const f32x4 y = v[j] * rs * w * (sc + 1.f) + sh;
        o8[64 * j] = (unsigned long long)pk2(y.x, y.y) | ((unsigned long long)pk2(y.z, y.w) << 32); }
}
__device__ __forceinline__ void p0a(const Frame& F) {
    LAS float* sv = (LAS float*)F.lds; LAS float* red = (LAS float*)(F.lds + 16384);
    for (int i = F.tid; i < 3 * DM; i += 512) { const int s = i / DM, k = i - s * DM; const float cv = (s < 2) ? F.in[I_C][s * DM + k] : F.in[I_CCTX][k]; sv[i] = cv / (1.f + __expf(-cv)); }
    __syncthreads();
    for (int it = F.blk; it < 192; it += F.G) {
        const int l = it / 96, cgp = it - l * 96, kq = F.tid >> 4, cg = F.tid & 15, col = cgp * 64 + cg * 4;
        float acc[3][4];
#pragma unroll
        for (int s = 0; s < 3; ++s)
#pragma unroll
            for (int j = 0; j < 4; ++j) acc[s][j] = 0.f;
        const float* W = F.in[I_ADAW] + (size_t)l * DM * 6144 + col;
#pragma unroll 16
        for (int kk = 0; kk < 32; ++kk) { const int k = kq * 32 + kk; const f32x4 w = *(const f32x4*)(W + (size_t)k * 6144);
            const float s0 = sv[k], s1 = sv[DM + k], s2 = sv[2 * DM + k];
#pragma unroll
            for (int j = 0; j < 4; ++j) { acc[0][j] += s0 * w[j]; acc[1][j] += s1 * w[j]; acc[2][j] += s2 * w[j]; } }
#pragma unroll
        for (int s = 0; s < 3; ++s)
#pragma unroll
            for (int j = 0; j < 4; ++j) red[(kq * 16 + cg) * 12 + s * 4 + j] = acc[s][j];
        __syncthreads();
        if (F.tid < 192) { const int s = F.tid / 64, cc = F.tid - s * 64, cg2 = cc >> 2, j = cc & 3; float t = 0.f;
            for (int q = 0; q < 32; ++q) t += red[(q * 16 + cg2) * 12 + s * 4 + j];
            wsp<float>(F, WS_MOD)[(size_t)(l * 3 + s) * 6144 + cgp * 64 + cc] = t + F.in[I_ADAB][l * 6144 + cgp * 64 + cc]; }
        __syncthreads();
    }
    const int gid = F.blk * 512 + F.tid, GT = F.G * 512;
    float* rope = wsp<float>(F, WS_ROPE);
    for (int i = gid; i < 256 * 16 + 64 * 16 + 256 * 8 + 64 * 8; i += GT) {
        int j = i; float pos, inv; size_t off;
        if (j < 256 * 16) { pos = (float)(j / 16); inv = powf(10000.f, -(float)(j % 16) / 16.f); off = ROPE_DR + (size_t)j * 2; }
        else if ((j -= 256 * 16) < 64 * 16) { pos = (float)(j / 16); inv = powf(10000.f, -(float)(j % 16) / 16.f); off = ROPE_DC + (size_t)j * 2; }
        else if ((j -= 64 * 16) < 256 * 8) { pos = (float)(j / 8); inv = powf(10000.f, -(float)(j % 8) / 8.f); off = ROPE_MR + (size_t)j * 2; }
        else { j -= 256 * 8; pos = (float)(j / 8); inv = powf(10000.f, -(float)(j % 8) / 8.f); off = ROPE_MC + (size_t)j * 2; }
        const float ang = pos * inv; rope[off] = cosf(ang); rope[off + 1] = sinf(ang);
    }
    { bf16* wh = wsp<bf16>(F, WS_WRH); bf16* wl = wsp<bf16>(F, WS_WRL); for (int i = gid; i < 2 * 32 * 1024; i += GT) { const int k = i & 1023, e = (i >> 10) & 31, l = i >> 15; const float wv = F.in[I_RW][((size_t)l * DM + k) * NE + e];
        const unsigned hb = f2bf(wv); wh[i] = (bf16)hb; wl[i] = (bf16)f2bf(wv - bf2f((bf16)hb)); } }
    bf16* WL = wsp<bf16>(F, WS_WLORA);
    for (int i = gid; i < 2560 * 384; i += GT) { const int n = i / 384, k = i - n * 384, part = n >> 9, c = n & 511; float v = 0.f;
        if (part < 2) { if ((k >> 6) == part) v = F.in[I_RW2][((size_t)part * 64 + (k & 63)) * 512 + c]; }
        else if (part < 4) { if ((k >> 6) == part) v = F.in[I_A2][((size_t)(part - 2) * 64 + (k & 63)) * 512 + c]; }
        else { if (k >= 256) v = F.in[I_G2][(size_t)(k - 256) * 512 + c]; }
        WL[i] = (bf16)f2bf(v); }
    const int gw = F.blk * 8 + F.wave, NGW = F.G * 8;
    tr_family(F, F.in[I_ATTW], 0, 1, 1024, ATT_IN, ATT_NP, wsp<bf16>(F, WS_WIN0), gw, NGW);
    tr_family(F, F.in[I_WUQ], 0, 1, 384, 768, 768, wsp<bf16>(F, WS_WUQ), gw, NGW);
    tr_family(F, F.in[I_WUKV], 0, 1, 256, 1024, 1024, wsp<bf16>(F, WS_WUKV), gw, NGW);
    tr_family(F, F.in[I_WOUT], (size_t)1024 * 1024, 2, 1024, 1024, 1024, wsp<bf16>(F, WS_WOUT), gw, NGW);
    tr_family(F, F.in[I_RECW], 0, 1, 1024, REC_IN, REC_NP, wsp<bf16>(F, WS_WREC), gw, NGW);
    moe_weights_convert(F, 0, gw, NGW);
}
__device__ __forceinline__ void p0b(const Frame& F) {
    const int gw = F.blk * 8 + F.wave, NGW = F.G * 8;
    for (int row = gw; row < R; row += NGW) { const int sel = row_sel(row);
        norm_mod_row(F, h0_row(F, row), F.in[I_NMIX], modp(F, 0, sel, 0), modp(F, 0, sel, 1), wsp<bf16>(F, WS_A) + (size_t)row * DM); }
}
struct FnStoreBf16 {
    bf16* O; int ldc;
    __device__ __forceinline__ void operator()(int row, int col, f32x4 v0, f32x4 v1) const {
        v4u w; w.x = pg8::cvt_pk_bf16(v0[0], v0[1]); w.y = pg8::cvt_pk_bf16(v0[2], v0[3]); w.z = pg8::cvt_pk_bf16(v1[0], v1[1]); w.w = pg8::cvt_pk_bf16(v1[2], v1[3]);
        *(v4u*)(O + (size_t)row * ldc + col) = w; }
};
struct FnWout {
    const Frame* F; int layer;
    __device__ __forceinline__ void operator()(int row, int col, f32x4 v0, f32x4 v1) const {
        float* hrow = wsp<float>(*F, WS_H) + (size_t)row * DM + col;
        const float* base = (layer == 0) ? h0_row(*F, row) + col : hrow;
        const float* g = modp(*F, layer, row_sel(row), 2) + col;
        const f32x4 b0 = *(const f32x4*)base, b1 = *(const f32x4*)(base + 4), g0 = *(const f32x4*)g, g1 = *(const f32x4*)(g + 4);
        *(f32x4*)hrow = b0 + g0 * v0; *(f32x4*)(hrow + 4) = b1 + g1 * v1; }
};
__device__ __forceinline__ void l0_post_proj(const Frame& F) {
    const int gw = F.blk * 8 + F.wave, NGW = F.G * 8, lane = F.lane;
    const bf16* P = wsp<const bf16>(F, WS_P); const float* rope = wsp<const float>(F, WS_ROPE);
    constexpr float CD = 0.125f * 1.4426950408889634f;
    for (int row = gw; row < R; row += NGW) {
        const int b = row / TB, t = row - b * TB; const bool lat = t >= CT; const int pos = t - CT, prow = lat ? pos >> 6 : 0, pcol = lat ? pos & 63 : 0;
        const bf16* p = P + (size_t)row * ATT_NP;
        bf16* qd = wsp<bf16>(F, WS_QD) + (size_t)row * 512; bf16* kd = wsp<bf16>(F, WS_KD) + (size_t)row * 512;
#pragma unroll
        for (int j = 0; j < 2; ++j) { const int g = lane + 64 * j, h16 = g >> 3, i0 = (g & 7) * 4;
            const v2u w1 = *(const v2u*)(p + h16 * 64 + i0), w2 = *(const v2u*)(p + h16 * 64 + i0 + 32);
            const float x1[4] = {bflo(w1.x), bfhi(w1.x), bflo(w1.y), bfhi(w1.y)}, x2[4] = {bflo(w2.x), bfhi(w2.x), bflo(w2.y), bfhi(w2.y)};
            float cs[8] = {1.f, 0.f, 1.f, 0.f, 1.f, 0.f, 1.f, 0.f};
            if (lat) { const float* tb = (i0 < 16) ? rope + ROPE_DR + (size_t)(prow * 16 + i0) * 2 : rope + ROPE_DC + (size_t)(pcol * 16 + i0 - 16) * 2;
                const f32x4 t0 = *(const f32x4*)tb, t1 = *(const f32x4*)(tb + 4); cs[0] = t0.x; cs[1] = t0.y; cs[2] = t0.z; cs[3] = t0.w; cs[4] = t1.x; cs[5] = t1.y; cs[6] = t1.z; cs[7] = t1.w; }
            float y1[4], y2[4]; const float sc = h16 < 8 ? CD : 1.f;
#pragma unroll
            for (int e = 0; e < 4; ++e) { y1[e] = (x1[e] * cs[2 * e] - x2[e] * cs[2 * e + 1]) * sc; y2[e] = (x1[e] * cs[2 * e + 1] + x2[e] * cs[2 * e]) * sc; }
            bf16* o = (h16 < 8) ? qd + h16 * 64 + i0 : kd + (h16 - 8) * 64 + i0;
            v2u o1, o2; o1.x = pk2(y1[0], y1[1]); o1.y = pk2(y1[2], y1[3]); o2.x = pk2(y2[0], y2[1]); o2.y = pk2(y2[2], y2[3]);
            *(v2u*)o = o1; *(v2u*)(o + 32) = o2; }
        { float x[8]; float ss = 0.f; const bool act = lane < 48;
          if (act) unpack8(*(const v4u*)(p + 1536 + 8 * lane), x); else {
#pragma unroll
              for (int e = 0; e < 8; ++e) x[e] = 0.f; }
#pragma unroll
          for (int e = 0; e < 8; ++e) ss += x[e] * x[e];
          const float rs = 1.f / sqrtf(wave_sum(ss) * (1.f / 384.f) + NORM_EPS);
          if (act) { const f32x4 g0 = *(const f32x4*)(F.in[I_QNW] + 8 * lane), g1 = *(const f32x4*)(F.in[I_QNW] + 8 * lane + 4); v4u w;
              w.x = pk2(x[0] * rs * g0.x, x[1] * rs * g0.y); w.y = pk2(x[2] * rs * g0.z, x[3] * rs * g0.w); w.z = pk2(x[4] * rs * g1.x, x[5] * rs * g1.y); w.w = pk2(x[6] * rs * g1.z, x[7] * rs * g1.w);
              *(v4u*)(wsp<bf16>(F, WS_CQN) + (size_t)row * 384 + 8 * lane) = w; } }
        { const v2u wv = *(const v2u*)(p + 1920 + 4 * lane); const float x[4] = {bflo(wv.x), bfhi(wv.x), bflo(wv.y), bfhi(wv.y)};
          const float rs = 1.f / sqrtf(wave_sum((x[0] * x[0] + x[1] * x[1]) + (x[2] * x[2] + x[3] * x[3])) * (1.f / 256.f) + NORM_EPS);
          const f32x4 g0 = *(const f32x4*)(F.in[I_KVNW] + 4 * lane); v2u w; w.x = pk2(x[0] * rs * g0.x, x[1] * rs * g0.y); w.y = pk2(x[2] * rs * g0.z, x[3] * rs * g0.w);
          *(v2u*)(wsp<bf16>(F, WS_CKVN) + (size_t)row * 256 + 4 * lane) = w; }
        if (lane < 16) { const int i = lane; const float x1 = bf2f(p[2176 + i]), x2 = bf2f(p[2176 + i + 16]); float c = 1.f, s = 0.f;
            if (lat) { const float* tb = (i < 8) ? rope + ROPE_MR + (size_t)(prow * 8 + i) * 2 : rope + ROPE_MC + (size_t)(pcol * 8 + i - 8) * 2; c = tb[0]; s = tb[1]; }
            bf16* o = wsp<bf16>(F, WS_KRR) + (size_t)row * 32; o[i] = (bf16)f2bf(x1 * c - x2 * s); o[i + 16] = (bf16)f2bf(x1 * s + x2 * c); }
    }
}
__device__ __forceinline__ void l0_mq_rope(const Frame& F) {
    const int gw = F.blk * 8 + F.wave, NGW = F.G * 8, lane = F.lane; const float* rope = wsp<const float>(F, WS_ROPE);
    const float CM = 0.10206207261596575f * 1.4426950408889634f;
    for (int row = gw; row < R; row += NGW) {
        const int b = row / TB, t = row - b * TB; const bool lat = t >= CT; const int pos = t - CT, prow = lat ? pos >> 6 : 0, pcol = lat ? pos & 63 : 0;
        bf16* q = wsp<bf16>(F, WS_MQ) + (size_t)row * 768;
#pragma unroll
        for (int j = 0; j < 2; ++j) { const int g = lane + 64 * j, h = g >> 4, d0 = (g & 15) * 4;
            const v2u wv = *(const v2u*)(q + h * 96 + d0); v2u o; o.x = pk2(bflo(wv.x) * CM, bfhi(wv.x) * CM); o.y = pk2(bflo(wv.y) * CM, bfhi(wv.y) * CM); *(v2u*)(q + h * 96 + d0) = o; }
#pragma unroll
        for (int j = 0; j < 2; ++j) { const int pr = lane + 64 * j, h = pr >> 4, i = pr & 15; const float x1 = bf2f(q[h * 96 + 64 + i]), x2 = bf2f(q[h * 96 + 80 + i]); float c = 1.f, s = 0.f;
            if (lat) { const float* tb = (i < 8) ? rope + ROPE_MR + (size_t)(prow * 8 + i) * 2 : rope + ROPE_MC + (size_t)(pcol * 8 + i - 8) * 2; c = tb[0]; s = tb[1]; }
            q[h * 96 + 64 + i] = (bf16)f2bf((x1 * c - x2 * s) * CM); q[h * 96 + 80 + i] = (bf16)f2bf((x1 * s + x2 * c) * CM); }
    }
}
__device__ __forceinline__ void l0_attention(const Frame& F) {
    LAS char* lds = (LAS char*)F.lds;
    const bf16* QD = wsp<const bf16>(F, WS_QD); const bf16* KD = wsp<const bf16>(F, WS_KD); const bf16* P = wsp<const bf16>(F, WS_P);
    const bf16* MQ = wsp<const bf16>(F, WS_MQ); const bf16* MKV = wsp<const bf16>(F, WS_MKV); const bf16* KRR = wsp<const bf16>(F, WS_KRR);
    float* OD = wsp<float>(F, WS_ODIFF); float* OM = wsp<float>(F, WS_OMLA);
    for (int kind = 0; kind < 2; ++kind) {
        for (int L = F.blk; L < 1024 + 16; L += F.G) {
            int b, h8, qb, nkeys;
            if (L < 1024) { int pair;
                if (F.G == 256) { const int round = L >> 8, c = L & 255; pair = round * 4 + ((c & 7) >> 1); qb = 1 + (c & 1) * 32 + (c >> 3); }
                else { pair = L >> 6; qb = 1 + (L & 63); }
                b = pair >> 3; h8 = pair & 7; nkeys = TB; }
            else { const int s = L - 1024; b = s >> 3; h8 = s & 7; qb = 0; nkeys = CT; }
            const size_t q0 = (size_t)b * TB + (size_t)qb * 256, k0 = (size_t)b * TB;
            if (kind == 0)
                att::attn_unit<64, 128>(QD + q0 * 512 + h8 * 64, 512, KD + k0 * 512 + h8 * 64, 512, nullptr, 0, P + k0 * ATT_NP + 1024 + (h8 >> 1) * 128, ATT_NP,
                                        OD + q0 * 1024 + h8 * 128, 1024, nkeys, lds);
            else
                att::attn_unit<96, 64>(MQ + q0 * 768 + h8 * 96, 768, MKV + k0 * 1024 + h8 * 128, 1024, KRR + k0 * 32, 32, MKV + k0 * 1024 + h8 * 128 + 64, 1024,
                                       OM + q0 * 512 + h8 * 64, 512, nkeys, lds);
        }
    }
}
__device__ __forceinline__ void l0_combine(const Frame& F) {
    const int gw = F.blk * 8 + F.wave, NGW = F.G * 8, lane = F.lane;
    const float* lv = F.in[I_LAM];
    const float lam = __expf(wave_sum(lv[lane] * lv[64 + lane])) - __expf(wave_sum(lv[128 + lane] * lv[192 + lane])) + 0.2f;
    const float sw0 = F.in[I_SUBLN][2 * lane] * 0.8f, sw1 = F.in[I_SUBLN][2 * lane + 1] * 0.8f;
    for (int row = gw; row < R; row += NGW) {
        const float* od = wsp<const float>(F, WS_ODIFF) + (size_t)row * 1024; const float* om = wsp<const float>(F, WS_OMLA) + (size_t)row * 512;
        bf16* a1 = wsp<bf16>(F, WS_A1) + (size_t)row * DM;
#pragma unroll
        for (int h = 0; h < 4; ++h) {
            const float o1a = od[(2 * h) * 128 + 2 * lane], o1b = od[(2 * h) * 128 + 2 * lane + 1], o2a = od[(2 * h + 1) * 128 + 2 * lane], o2b = od[(2 * h + 1) * 128 + 2 * lane + 1];
            const float da = o1a - lam * o2a, db = o1b - lam * o2b;
            const float rs = 1.f / sqrtf(wave_sum(da * da + db * db) * (1.f / 128.f) + NORM_EPS);
            *(unsigned*)(a1 + h * 128 + 2 * lane) = pk2(da * rs * sw0, db * rs * sw1); }
#pragma unroll
        for (int j = 0; j < 2; ++j) { const f32x4 v = *(const f32x4*)(om + 4 * (lane + 64 * j)); v2u w; w.x = pk2(v.x, v.y); w.y = pk2(v.z, v.w); *(v2u*)(a1 + 512 + 4 * (lane + 64 * j)) = w; }
    }
}
constexpr int RT_LS = 264;
__device__ __forceinline__ void ph_router(const Frame& F, int layer) {
    LAS bf16* AH = (LAS bf16*)F.lds; LAS bf16* AL = AH + 64 * RT_LS; LAS bf16* WH = AL + 64 * RT_LS; LAS bf16* WL = WH + 32 * RT_LS;
    LAS float* lg = (LAS float*)(F.lds + 110592);
    LAS int* hist = (LAS int*)(F.lds + MISC_OFF + 256);
    LAS int* recs = (LAS int*)(F.lds + MISC_OFF + 512);
    const int lane = F.lane, w = F.wave, tid = F.tid, RPB = (R + F.G - 1) / F.G, row0 = F.blk * RPB;
    if (tid < 64) hist[tid] = 0;
    { int* srct = wsp<int>(F, WS_SRC); for (int i = F.blk * 512 + tid; i < MAXROWS; i += F.G * 512) srct[i] = 0; }
    const float* nw = F.in[I_NFFN] + (size_t)layer * DM; const float* rbp = F.in[I_RB] + layer * NE;
    const bf16* wrh = wsp<const bf16>(F, WS_WRH) + (size_t)layer * 32 * 1024; const bf16* wrl = wsp<const bf16>(F, WS_WRL) + (size_t)layer * 32 * 1024;
    for (int pass = 0; pass * 64 < RPB; ++pass) {
        const int nrow = min(64, min(RPB - pass * 64, R - row0 - pass * 64));
        f32x4 fr[8][4];
#pragma unroll
        for (int i = 0; i < 8; ++i) { const int rl = w + 8 * i; const int row = row0 + pass * 64 + rl;
            if (rl < nrow) {
                const int sel = row_sel(row); const float* sh = modp(F, layer, sel, 3); const float* sc = modp(F, layer, sel, 4);
                const f32x4* xr = (const f32x4*)(wsp<const float>(F, WS_H) + (size_t)row * DM) + lane; float s = 0.f;
#pragma unroll
                for (int j = 0; j < 4; ++j) { fr[i][j] = xr[64 * j]; s += (fr[i][j].x * fr[i][j].x + fr[i][j].y * fr[i][j].y) + (fr[i][j].z * fr[i][j].z + fr[i][j].w * fr[i][j].w); }
                const float rs = 1.f / sqrtf(wave_sum(s) * (1.f / DM) + NORM_EPS);
                unsigned long long* o8 = (unsigned long long*)(wsp<bf16>(F, WS_F) + (size_t)row * DM) + lane;
#pragma unroll
                for (int j = 0; j < 4; ++j) { const f32x4 ww = ((const f32x4*)nw)[lane + 64 * j], a = ((const f32x4*)sh)[lane + 64 * j], c = ((const f32x4*)sc)[lane + 64 * j];
                    fr[i][j] = fr[i][j] * rs * ww * (c + 1.f) + a;
                    o8[64 * j] = (unsigned long long)pk2(fr[i][j].x, fr[i][j].y) | ((unsigned long long)pk2(fr[i][j].z, fr[i][j].w) << 32); }
            } else {
#pragma unroll
                for (int j = 0; j < 4; ++j) fr[i][j] = (f32x4){0.f, 0.f, 0.f, 0.f};
            } }
        pg8::f32x4 acc = {0.f, 0.f, 0.f, 0.f};
#pragma unroll
        for (int c = 0; c < 4; ++c) {
            __syncthreads();
#pragma unroll
            for (int i = 0; i < 8; ++i) { const f32x4 v = fr[i][c]; const unsigned h0 = pk2(v.x, v.y), h1 = pk2(v.z, v.w);
                const unsigned l0 = pk2(v.x - bflo(h0), v.y - bfhi(h0)), l1 = pk2(v.z - bflo(h1), v.w - bfhi(h1));
                v2u hh; hh.x = h0; hh.y = h1; v2u ll; ll.x = l0; ll.y = l1;
                *(LAS v2u*)(AH + (w + 8 * i) * RT_LS + 4 * lane) = hh; *(LAS v2u*)(AL + (w + 8 * i) * RT_LS + 4 * lane) = ll; }
            { const int e = tid >> 4, kp = (tid & 15) * 16;
              const v4u a0 = *(const v4u*)(wrh + (size_t)e * 1024 + 256 * c + kp), a1 = *(const v4u*)(wrh + (size_t)e * 1024 + 256 * c + kp + 8);
              const v4u b0 = *(const v4u*)(wrl + (size_t)e * 1024 + 256 * c + kp), b1 = *(const v4u*)(wrl + (size_t)e * 1024 + 256 * c + kp + 8);
              *(LAS v4u*)(WH + e * RT_LS + kp) = a0; *(LAS v4u*)(WH + e * RT_LS + kp + 8) = a1; *(LAS v4u*)(WL + e * RT_LS + kp) = b0; *(LAS v4u*)(WL + e * RT_LS + kp + 8) = b1; }
            __syncthreads();
            const int tm = w >> 1, tn = w & 1, lr = lane & 15, kq = (lane >> 4) * 8;
            const LAS bf16* ahp = AH + (tm * 16 + lr) * RT_LS + kq; const LAS bf16* alp = AL + (tm * 16 + lr) * RT_LS + kq;
            const LAS bf16* whp = WH + (tn * 16 + lr) * RT_LS + kq; const LAS bf16* wlp = WL + (tn * 16 + lr) * RT_LS + kq;
#pragma unroll
            for (int ks = 0; ks < 8; ++ks) { const bf16x8 ah = *(const LAS bf16x8*)(ahp + 32 * ks), al = *(const LAS bf16x8*)(alp + 32 * ks), bh = *(const LAS bf16x8*)(whp + 32 * ks), bl = *(const LAS bf16x8*)(wlp + 32 * ks);
                acc = __builtin_amdgcn_mfma_f32_16x16x32_bf16(ah, bh, acc, 0, 0, 0); acc = __builtin_amdgcn_mfma_f32_16x16x32_bf16(ah, bl, acc, 0, 0, 0); acc = __builtin_amdgcn_mfma_f32_16x16x32_bf16(al, bh, acc, 0, 0, 0); }
        }
        { const int m0 = (w >> 1) * 16 + (lane >> 4) * 4, n = (w & 1) * 16 + (lane & 15);
#pragma unroll
          for (int r = 0; r < 4; ++r) lg[(m0 + r) * 33 + n] = acc[r]; }
        __syncthreads();
        if (tid < nrow) { const int rl = tid, row = row0 + pass * 64 + rl; float lv[32];
#pragma unroll
            for (int e = 0; e < 32; ++e) lv[e] = lg[rl * 33 + e] + rbp[e];
            float selv[4]; int seli[4];
#pragma unroll
            for (int r = 0; r < 4; ++r) { float bv = -3.0e38f; int bi = 0;
#pragma unroll
                for (int e = 0; e < 32; ++e) { const bool taken = (r > 0 && seli[0] == e) || (r > 1 && seli[1] == e) || (r > 2 && seli[2] == e); if (!taken && lv[e] > bv) { bv = lv[e]; bi = e; } }
                selv[r] = bv; seli[r] = bi; }
            float ex[4], es = 0.f;
#pragma unroll
            for (int r = 0; r < 4; ++r) { ex[r] = __expf(selv[r] - selv[0]); es += ex[r]; }
            const float inv = 1.f / es;
#pragma unroll
            for (int r = 0; r < 4; ++r) { wsp<int>(F, WS_TOPE)[(size_t)row * 4 + r] = seli[r]; wsp<float>(F, WS_GATE)[(size_t)row * 4 + r] = ex[r] * inv;
                const int rk = __hip_atomic_fetch_add(&hist[seli[r]], 1, __ATOMIC_RELAXED, __HIP_MEMORY_SCOPE_WORKGROUP);
                recs[(pass * 64 + rl) * 4 + r] = seli[r] | (rk << 8); }
        }
    }
    __syncthreads();
    if (tid < NE) hist[32 + tid] = (int)__hip_atomic_fetch_add(F.ctl + CW_CNT + 64 * (layer + 2 * F.probe) + tid, (unsigned)hist[tid], RLX_AGENT);
    __syncthreads();
    for (int rl = tid; rl < RPB && row0 + rl < R; rl += 512) {
#pragma unroll
        for (int r = 0; r < 4; ++r) { const int rc = recs[rl * 4 + r]; wsp<int>(F, WS_POS)[(size_t)(row0 + rl) * 4 + r] = hist[32 + (rc & 255)] + (rc >> 8); } }
}
__device__ __forceinline__ void moe_tables(const Frame& F, int layer, LAS int* ps, LAS int* tile_e) {
    if (F.tid == 0) { int acc = 0, t = 0;
        for (int e = 0; e < NE; ++e) { const int c = (int)__hip_atomic_load(F.ctl + CW_CNT + 64 * layer + e, RLX_AGENT); ps[e] = acc; const int nt = (c + 255) >> 8;
            for (int i = 0; i < nt && t < MAXT; ++i) tile_e[t++] = e; acc += nt * 256; }
        ps[NE] = acc; ps[NE + 1] = t; }
    __syncthreads();
}
__device__ __forceinline__ void ph_gather(const Frame& F, int layer) {
    LAS int* ps = (LAS int*)(F.lds + MISC_OFF + 256); LAS int* tile_e = ps + 64;
    moe_tables(F, layer, ps, tile_e);
    if (F.blk == 0) { int* tab = wsp<int>(F, WS_TILE); const int nt = ps[NE + 1]; if (F.tid == 0) tab[0] = nt; for (int i = F.tid; i < nt; i += 512) tab[1 + i] = tile_e[i]; }
    for (int i = F.blk * 512 + F.tid; i < R * 4; i += F.G * 512) { const int row = i >> 2;
        const int e = wsp<const int>(F, WS_TOPE)[i]; const int dest = ps[e] + wsp<const int>(F, WS_POS)[i]; wsp<int>(F, WS_DEST)[i] = dest; wsp<int>(F, WS_SRC)[dest] = row; }
}
struct MoeOrder {
    const int* tile_e; int ntiles, nN, G, c; const int* src;
    __device__ __forceinline__ bool next(int i, pg8::Unit& u) const {
        int rt, pl;
        if (G == 256) { const int x = c & 7, y = c >> 3, rpx = 32 / nN; rt = (i * 8 + x) * rpx + y / nN; pl = y % nN; if (rt >= ntiles) return false; }
        else { const long L = (long)i * G + c; if (L >= (long)ntiles * nN) return false; rt = (int)(L / nN); pl = (int)(L - (long)rt * nN); }
        const int e = __builtin_amdgcn_readfirstlane(tile_e[rt]);
        u.pm = rt; u.pn = e * nN + pl; return true; }
    __device__ __forceinline__ void a_ready(const pg8::Unit&) const {}
    __device__ __forceinline__ void done(const pg8::Unit&) const {}
};
struct LatOrder {
    pg8::StaticOrder o;
    __device__ __forceinline__ bool next(int i, pg8::Unit& u) const { if (!o.next(i, u)) return false; u.pm += 1 + (u.pm >= 64 ? 1 : 0); return true; }
    __device__ __forceinline__ void a_ready(const pg8::Unit&) const {}
    __device__ __forceinline__ void done(const pg8::Unit&) const {}
};
struct FnSwiglu {
    bf16* HS; const float* b1;
    __device__ __forceinline__ void operator()(int row, int col, f32x4 v0, f32x4 v1) const {
        const float* bp = b1 + col;
        const f32x4 b0 = *(const f32x4*)bp, b1v = *(const f32x4*)(bp + 4); v0 = v0 + b0; v1 = v1 + b1v;
        const float hv[8] = {v0[0], v0[1], v0[2], v0[3], v1[0], v1[1], v1[2], v1[3]}; float o[4];
#pragma unroll
        for (int i = 0; i < 4; ++i) { const float g = hv[2 * i], l = hv[2 * i + 1];
            const float gl = fminf(g, 7.f), li = fminf(fmaxf(l, -7.f), 7.f); o[i] = gl * sigmoidf_(1.702f * gl) * (li + 1.f); }
        const int lc = col & 2047; v2u w; w.x = pk2(o[0], o[1]); w.y = pk2(o[2], o[3]);
        *(v2u*)(HS + (size_t)row * 1024 + (lc >> 1)) = w; }
};
struct FnBiasBf16 {
    bf16* YS; const float* b2;
    __device__ __forceinline__ void operator()(int row, int col, f32x4 v0, f32x4 v1) const {
        const f32x4 b0 = *(const f32x4*)(b2 + col), b1v = *(const f32x4*)(b2 + col + 4); v0 = v0 + b0; v1 = v1 + b1v;
        v4u w; w.x = pk2(v0[0], v0[1]); w.y = pk2(v0[2], v0[3]); w.z = pk2(v1[0], v1[1]); w.w = pk2(v1[2], v1[3]);
        *(v4u*)(YS + (size_t)row * 1024 + (col & 1023)) = w; }
};
__device__ __forceinline__ void ph_combine(const Frame& F, int layer) {
    const int lane = F.lane, gw = F.blk * 8 + F.wave, NGW = F.G * 8;
    for (int row = gw; row < R; row += NGW) {
        const int sel = row_sel(row); const float* gf = modp(F, layer, sel, 5);
        float* hrow = wsp<float>(F, WS_H) + (size_t)row * DM;
        f32x4 y[4];
#pragma unroll
        for (int j = 0; j < 4; ++j) y[j] = (f32x4){0.f, 0.f, 0.f, 0.f};
#pragma unroll
        for (int r = 0; r < 4; ++r) { const int d = wsp<const int>(F, WS_DEST)[(size_t)row * 4 + r]; const float g = wsp<const float>(F, WS_GATE)[(size_t)row * 4 + r];
            const v2u* yp = (const v2u*)(wsp<const bf16>(F, WS_XS) + (size_t)d * DM);
#pragma unroll
            for (int j = 0; j < 4; ++j) { const v2u w = yp[lane + 64 * j]; y[j] += g * (f32x4){bflo(w.x), bfhi(w.x), bflo(w.y), bfhi(w.y)}; } }
        f32x4 h[4]; float s = 0.f;
#pragma unroll
        for (int j = 0; j < 4; ++j) { h[j] = ((const f32x4*)hrow)[lane + 64 * j] + ((const f32x4*)gf)[lane + 64 * j] * y[j]; s += (h[j].x * h[j].x + h[j].y * h[j].y) + (h[j].z * h[j].z + h[j].w * h[j].w); }
        const float rs = 1.f / sqrtf(wave_sum(s) * (1.f / DM) + NORM_EPS);
        if (layer == 0) {
#pragma unroll
            for (int j = 0; j < 4; ++j) ((f32x4*)hrow)[lane + 64 * j] = h[j];
            const float* nw = F.in[I_NMIX] + DM; const float* sh = modp(F, 1, sel, 0); const float* sc = modp(F, 1, sel, 1);
            unsigned long long* o8 = (unsigned long long*)(wsp<bf16>(F, WS_A) + (size_t)row * DM) + lane;
#pragma unroll
            for (int j = 0; j < 4; ++j) { const f32x4 w = ((const f32x4*)nw)[lane + 64 * j], a = ((const f32x4*)sh)[lane + 64 * j], c = ((const f32x4*)sc)[lane + 64 * j];
                const f32x4 o = h[j] * rs * w * (c + 1.f) + a; o8[64 * j] = (unsigned long long)pk2(o.x, o.y) | ((unsigned long long)pk2(o.z, o.w) << 32); }
        } else {
            const int b = row / TB, t = row - b * TB;
            if (t >= CT) { float* orow = F.out + ((size_t)b * SEQ + (t - CT)) * DM; const float* nw = F.in[I_FNW];
#pragma unroll
                for (int j = 0; j < 4; ++j) ((f32x4*)orow)[lane + 64 * j] = h[j] * rs * ((const f32x4*)nw)[lane + 64 * j]; }
        }
    }
}
constexpr int PC_Q = 1920, PC_K = 2176, PC_V = 2432, PC_O = 2944, PC_G = 3456;
__device__ __forceinline__ float softplusf_(float y) { return fmaxf(y, 0.f) + __logf(1.f + __expf(-fabsf(y))); }
__device__ __forceinline__ float tanhf_(float x) { return 1.f - 2.f / (1.f + __expf(2.f * x)); }
__device__ __forceinline__ void lerp8(const bf16* p, bool hp, bool hn, int c0, const float* mu, float (&u)[8]) {
    const v4u z4 = {0u, 0u, 0u, 0u};
    const v4u wx = *(const v4u*)(p + c0), wp = hp ? *(const v4u*)(p - REC_NP + c0) : z4, wn = hn ? *(const v4u*)(p + REC_NP + c0) : z4;
    float x[8], xp[8], xn[8]; unpack8(wx, x); unpack8(wp, xp); unpack8(wn, xn);
    const f32x4 m0 = *(const f32x4*)(mu + c0), m1 = *(const f32x4*)(mu + c0 + 4);
#pragma unroll
    for (int e = 0; e < 8; ++e) { const float m = e < 4 ? m0[e & 3] : m1[e & 3]; u[e] = x[e] + m * (0.5f * (xp[e] + xn[e]) - x[e]); }
}
__device__ __forceinline__ void st8h(bf16* o, const float (&u)[8]) { v4u w; w.x = pk2(u[0], u[1]); w.y = pk2(u[2], u[3]); w.z = pk2(u[4], u[5]); w.w = pk2(u[6], u[7]); *(v4u*)o = w; }
__device__ __forceinline__ void st8f(float* o, const float (&u)[8]) { *(f32x4*)o = (f32x4){u[0], u[1], u[2], u[3]}; *(f32x4*)(o + 4) = (f32x4){u[4], u[5], u[6], u[7]}; }
__device__ __forceinline__ void l1_rwkv_prep(const Frame& F) {
    const int gw = F.blk * 8 + F.wave, NGW = F.G * 8, lane = F.lane; const float* mu = F.in[I_MU];
    for (int row = gw; row < R; row += NGW) {
        const int b = row / TB, t = row - b * TB; const bool hp = (t != 0 && t != CT), hn = (t != CT - 1 && t != TB - 1);
        const bf16* p = wsp<const bf16>(F, WS_P) + (size_t)row * REC_NP; const size_t ro = (size_t)row * 512 + 8 * lane;
        float u[8];
        lerp8(p, hp, hn, 8 * lane, mu, u); st8h(wsp<bf16>(F, WS_RR) + ro, u);
        lerp8(p, hp, hn, 1024 + 8 * lane, mu, u); st8h(wsp<bf16>(F, WS_VV) + ro, u);
        lerp8(p, hp, hn, 512 + 8 * lane, mu, u); st8h(wsp<bf16>(F, WS_KL) + ro, u);
        { const f32x4 k0 = *(const f32x4*)(F.in[I_KK] + 8 * lane), k1 = *(const f32x4*)(F.in[I_KK] + 8 * lane + 4); float ss = 0.f;
#pragma unroll
          for (int e = 0; e < 8; ++e) { u[e] *= (e < 4 ? k0[e & 3] : k1[e & 3]); ss += u[e] * u[e]; }
          ss += __shfl_xor(ss, 1); ss += __shfl_xor(ss, 2); ss += __shfl_xor(ss, 4);
          const float inv = -1.f / sqrtf(fmaxf(ss, 1e-24f));
#pragma unroll
          for (int e = 0; e < 8; ++e) u[e] *= inv;
          st8h(wsp<bf16>(F, WS_AKK) + ro, u); }
        if (lane < 48) { lerp8(p, hp, hn, 1536 + 8 * lane, mu, u);
#pragma unroll
            for (int e = 0; e < 8; ++e) u[e] = lane < 16 ? tanhf_(u[e]) : (lane < 32 ? u[e] : sigmoidf_(u[e]));
            v4u w; w.x = pk2(u[0], u[1]); w.y = pk2(u[2], u[3]); w.z = pk2(u[4], u[5]); w.w = pk2(u[6], u[7]);
            *(v4u*)(wsp<bf16>(F, WS_ALORA) + (size_t)row * 384 + 8 * lane) = w; }
    }
}
struct EpiLora {
    static constexpr bool PERM = true, AFTER_DRAIN = false;
    const Frame* F;
    template <int KIND> __device__ __forceinline__ void run(const pg8::f32x4 (&acc)[2][2][4][2], const pg8::Unit& u, int wr, int wc, int fr, int fq, int z) const {
#pragma unroll
        for (int ai = 0; ai < 2; ++ai)
#pragma unroll
            for (int m = 0; m < 4; ++m) { const int row = u.pm * 256 + ai * 128 + wr * 64 + m * 16 + fr;
#pragma unroll
                for (int bj = 0; bj < 2; ++bj) { const int c = ((u.pn & 1) * 256) + bj * 128 + wc * 32 + 8 * fq; const size_t ro = (size_t)row * 512 + c;
                    const pg8::f32x4 v0 = acc[ai][bj][m][0], v1 = acc[ai][bj][m][1]; const float x[8] = {v0[0], v0[1], v0[2], v0[3], v1[0], v1[1], v1[2], v1[3]}; float o[8];
                    if constexpr (KIND == 0) { const float* w0 = F->in[I_W0] + z * 512 + c;
#pragma unroll
                        for (int e = 0; e < 8; ++e) { const float wl = -softplusf_(-(w0[e] + x[e])) - 0.5f; o[e] = __expf(-__expf(wl)); }
                        st8f(wsp<float>(*F, WS_WDEC) + (size_t)z * R * 512 + ro, o); }
                    else if constexpr (KIND == 1) { const float* a0 = F->in[I_A0] + z * 512 + c;
#pragma unroll
                        for (int e = 0; e < 8; ++e) o[e] = sigmoidf_(a0[e] + x[e]);
                        st8h(wsp<bf16>(*F, WS_ASIG) + (size_t)z * R * 512 + ro, o); }
                    else st8h(wsp<bf16>(*F, WS_GG) + ro, x); } }
    }
    __device__ __forceinline__ void operator()(const pg8::f32x4 (&acc)[2][2][4][2], const pg8::Unit& u, int wr, int wc, int fr, int fq) const {
        const int part = u.pn >> 1;
        if (part < 2) run<0>(acc, u, wr, wc, fr, fq, part); else if (part < 4) run<1>(acc, u, wr, wc, fr, fq, part - 2); else run<2>(acc, u, wr, wc, fr, fq, 0);
    }
};
__device__ __forceinline__ void mlstm_gates(const Frame& F, int row, int z, int h, float& ig, float& lf) {
    const bf16* g = wsp<const bf16>(F, WS_P) + (size_t)row * REC_NP + PC_G + z * 8 + h; const float* gb = F.in[I_GATEB] + z * 8 + h;
    const float gi = bf2f(g[0]) + gb[0], gf = bf2f(g[4]) + gb[4];
    ig = 15.f * tanhf_(gi * (1.f / 15.f)); const float cf = 15.f * tanhf_(gf * (1.f / 15.f)); lf = fminf(cf, 0.f) - __logf(1.f + __expf(-fabsf(cf)));
}
__device__ __forceinline__ void mlstm_chunk_head(const Frame& F, int z, int b, int h, int c, LAS float* vec) {
    LAS int* rows = (LAS int*)vec;
    if (F.tid < 64) { const int s = F.tid, row = b * TB + scan_tok(z, 64 * c + s); float ig, lf; mlstm_gates(F, row, z, h, ig, lf); rows[s] = row; vec[64 + s] = ig; vec[192 + s] = lf; }
    __syncthreads();
    if (F.tid < 64) { float a = 0.f; for (int s = 0; s <= F.tid; ++s) a += vec[192 + s]; vec[128 + F.tid] = a; }
    __syncthreads();
}
__device__ __forceinline__ void l1_mlstm_b(const Frame& F) {
    const float* __restrict__ SC = wsp<const float>(F, WS_SC); const float* __restrict__ DC = wsp<const float>(F, WS_DC); float* __restrict__ CST = wsp<float>(F, WS_CST);
    const float* __restrict__ DN = wsp<const float>(F, WS_DN); float* __restrict__ NST = wsp<float>(F, WS_NST); float* __restrict__ MST = wsp<float>(F, WS_MST);
    for (int g = F.blk * 512 + F.tid; g < 16 * 8192; g += F.G * 512) {
        const int chain = g >> 13, el = g & 8191; float m = 0.f, C = 0.f, N = 0.f; const bool don = el < 64;
        for (int c0 = 0; c0 < 260; c0 += 10) {
            float dc[10], dn[10], bl[10], ml[10];
#pragma unroll
            for (int i = 0; i < 10; ++i) { const size_t u = (size_t)chain * 260 + c0 + i; dc[i] = DC[u * 8192 + el]; dn[i] = don ? DN[u * 64 + el] : 0.f; bl[i] = SC[2 * u]; ml[i] = SC[2 * u + 1]; }
#pragma unroll
            for (int i = 0; i < 10; ++i) { const size_t u = (size_t)chain * 260 + c0 + i;
                CST[u * 8192 + el] = C; if (don) NST[u * 64 + el] = N; if (el == 0) MST[u] = m;
                const float mn = fmaxf(bl[i] + m, ml[i]), cd = __expf(bl[i] + m - mn), inj = __expf(ml[i] - mn);
                C = cd * C + inj * dc[i]; N = cd * N + inj * dn[i]; m = mn; }
        }
    }
}
__device__ __forceinline__ void l1_rec_out(const Frame& F) {
    const int gw = F.blk * 8 + F.wave, NGW = F.G * 8, lane = F.lane, c0 = 8 * lane;
    for (int row = gw; row < R; row += NGW) {
        const size_t ro = (size_t)row * 512 + c0; bf16* a1 = wsp<bf16>(F, WS_A1) + (size_t)row * DM;
        { const float* y0 = wsp<const float>(F, WS_YR) + ro; const float* y1 = y0 + (size_t)R * 512; float y[8]; float s = 0.f;
          const float* y2 = wsp<const float>(F, WS_YB) + ro; const float* y3 = y2 + (size_t)R * 512;
#pragma unroll
          for (int e = 0; e < 8; ++e) { y[e] = (y0[e] + y1[e]) + (y2[e] + y3[e]); s += y[e]; }
          s += __shfl_xor(s, 1); s += __shfl_xor(s, 2); s += __shfl_xor(s, 4); const float mean = s * (1.f / 64.f); float q = 0.f;
#pragma unroll
          for (int e = 0; e < 8; ++e) { y[e] -= mean; q += y[e] * y[e]; }
          q += __shfl_xor(q, 1); q += __shfl_xor(q, 2); q += __shfl_xor(q, 4); const float rstd = 1.f / sqrtf(q * (1.f / 64.f) + 64e-5f);
          float rr[8], kl[8], s0[8], s1[8], vv[8], gg[8]; unpack8(*(const v4u*)(wsp<const bf16>(F, WS_RR) + ro), rr); unpack8(*(const v4u*)(wsp<const bf16>(F, WS_KL) + ro), kl);
          unpack8(*(const v4u*)(wsp<const bf16>(F, WS_ASIG) + ro), s0); unpack8(*(const v4u*)(wsp<const bf16>(F, WS_ASIG) + (size_t)R * 512 + ro), s1);
          unpack8(*(const v4u*)(wsp<const bf16>(F, WS_VV) + ro), vv); unpack8(*(const v4u*)(wsp<const bf16>(F, WS_GG) + ro), gg);
          const float* rk = F.in[I_RK] + c0; const float* ka = F.in[I_KA] + c0; float bs = 0.f;
#pragma unroll
          for (int e = 0; e < 8; ++e) bs += rr[e] * kl[e] * (2.f + (s0[e] + s1[e] - 2.f) * ka[e]) * rk[e];
          bs += __shfl_xor(bs, 1); bs += __shfl_xor(bs, 2); bs += __shfl_xor(bs, 4);
          const float* lw = F.in[I_LNW] + c0; const float* lb = F.in[I_LNB] + c0; float o[8];
#pragma unroll
          for (int e = 0; e < 8; ++e) o[e] = (y[e] * rstd * lw[e] + lb[e] + bs * vv[e]) * gg[e];
          v4u w; w.x = pk2(o[0], o[1]); w.y = pk2(o[2], o[3]); w.z = pk2(o[4], o[5]); w.w = pk2(o[6], o[7]); *(v4u*)(a1 + c0) = w; }
        { const float* h0 = wsp<const float>(F, WS_HM) + ro; const float* h1 = h0 + (size_t)R * 512; float x[8]; float q = 0.f;
#pragma unroll
          for (int e = 0; e < 8; ++e) { x[e] = h0[e] + h1[e]; q += x[e] * x[e]; }
          q += __shfl_xor(q, 1); q += __shfl_xor(q, 2); q += __shfl_xor(q, 4); q += __shfl_xor(q, 8); const float rs = 1.f / sqrtf(q * (1.f / 128.f) + NORM_EPS);
          float og[8]; unpack8(*(const v4u*)(wsp<const bf16>(F, WS_P) + (size_t)row * REC_NP + PC_O + c0), og); const float* nw = F.in[I_MNW] + c0; float o[8];
#pragma unroll
          for (int e = 0; e < 8; ++e) o[e] = x[e] * rs * nw[e] * sigmoidf_(og[e]);
          v4u w; w.x = pk2(o[0], o[1]); w.y = pk2(o[2], o[3]); w.z = pk2(o[4], o[5]); w.w = pk2(o[6], o[7]); *(v4u*)(a1 + 512 + c0) = w; }
    }
}
#ifndef NEU_ROUNDS
#define NEU_ROUNDS 6
#endif
namespace rk {
constexpr int LS = 72;
constexpr int MB = 64 * LS * 2;
struct Acc2 { pg8::f32x4 t0, t1; };
__device__ __forceinline__ void zero(Acc2& a) { a.t0 = (pg8::f32x4){0.f, 0.f, 0.f, 0.f}; a.t1 = a.t0; }
__device__ __forceinline__ void mm_acc(Acc2& acc, const LAS bf16* A, const LAS bf16* Bt, int wave, int lane) {
    const int tm = wave >> 1, tn0 = (wave & 1) * 2, lr = lane & 15, kq = (lane >> 4) * 8;
    const LAS bf16* ap = A + (tm * 16 + lr) * LS + kq; const LAS bf16* bp0 = Bt + (tn0 * 16 + lr) * LS + kq; const LAS bf16* bp1 = bp0 + 16 * LS;
    const bf16x8 a0 = *(const LAS bf16x8*)ap, a1 = *(const LAS bf16x8*)(ap + 32);
    const bf16x8 b00 = *(const LAS bf16x8*)bp0, b01 = *(const LAS bf16x8*)(bp0 + 32), b10 = *(const LAS bf16x8*)bp1, b11 = *(const LAS bf16x8*)(bp1 + 32);
    acc.t0 = __builtin_amdgcn_mfma_f32_16x16x32_bf16(a0, b00, acc.t0, 0, 0, 0); acc.t0 = __builtin_amdgcn_mfma_f32_16x16x32_bf16(a1, b01, acc.t0, 0, 0, 0);
    acc.t1 = __builtin_amdgcn_mfma_f32_16x16x32_bf16(a0, b10, acc.t1, 0, 0, 0); acc.t1 = __builtin_amdgcn_mfma_f32_16x16x32_bf16(a1, b11, acc.t1, 0, 0, 0);
}
template <class Fn> __device__ __forceinline__ void each(const Acc2& acc, int wave, int lane, Fn fn) {
    const int m0 = (wave >> 1) * 16 + (lane >> 4) * 4, n0 = (wave & 1) * 32 + (lane & 15);
#pragma unroll
    for (int r = 0; r < 4; ++r) { fn(m0 + r, n0, acc.t0[r]); fn(m0 + r, n0 + 16, acc.t1[r]); }
}
__device__ __forceinline__ void stb(LAS bf16* M, int m, int n, float v) { M[m * LS + n] = (bf16)f2bf(v); }
__device__ __forceinline__ void st_tr(LAS bf16* M, const Acc2& acc, int wave, int lane) {
    const int m0 = (wave >> 1) * 16 + (lane >> 4) * 4, n0 = (wave & 1) * 32 + (lane & 15);
    v2u a, b; a.x = pk2(acc.t0[0], acc.t0[1]); a.y = pk2(acc.t0[2], acc.t0[3]); b.x = pk2(acc.t1[0], acc.t1[1]); b.y = pk2(acc.t1[2], acc.t1[3]);
    *(LAS v2u*)(M + n0 * LS + m0) = a; *(LAS v2u*)(M + (n0 + 16) * LS + m0) = b;
}
}
__device__ __forceinline__ void l1_rk_phase_a(const Frame& F) {
    using namespace rk;
    LAS unsigned char* L = F.lds;
    LAS bf16* Rt = (LAS bf16*)(L + 0 * MB); LAS bf16* At = (LAS bf16*)(L + 1 * MB); LAS bf16* AtT = (LAS bf16*)(L + 2 * MB); LAS bf16* Bq = (LAS bf16*)(L + 3 * MB); LAS bf16* Kq = (LAS bf16*)(L + 4 * MB);
    LAS bf16* VT = (LAS bf16*)(L + 5 * MB); LAS bf16* BhT = (LAS bf16*)(L + 6 * MB); LAS bf16* KhT = (LAS bf16*)(L + 7 * MB);
    LAS bf16* AK = (LAS bf16*)(L + 8 * MB); LAS bf16* RB = (LAS bf16*)(L + 9 * MB); LAS bf16* RK = (LAS bf16*)(L + 10 * MB);
    LAS bf16* X = (LAS bf16*)(L + 11 * MB); LAS bf16* XT = (LAS bf16*)(L + 12 * MB); LAS bf16* P = (LAS bf16*)(L + 13 * MB);
    LAS bf16* AkVT = Bq; LAS bf16* ApT = Kq; LAS bf16* W2T = X;
    LAS float* G = (LAS float*)(L + 8 * MB);
    LAS float* gl = (LAS float*)(L + 14 * MB);
    const int w = F.wave, lane = F.lane, tid = F.tid;
    const int t = lane, j0 = 8 * w;
    float fr[8], fv[8], fa[8], fw[8], fk[8], fb[8];
#define RK_LOAD(u_) do { const int ch_ = (u_) / 260, c_ = (u_) - ch_ * 260, z_ = ch_ >> 4, b_ = (ch_ >> 3) & 1, h_ = ch_ & 7; const size_t ro = ((size_t)b_ * TB + scan_tok(z_, 64 * c_ + t)) * 512 + h_ * 64 + j0; \
    const v4u xr_ = *(const v4u*)(wsp<const bf16>(F, WS_RR) + ro), xv_ = *(const v4u*)(wsp<const bf16>(F, WS_VV) + ro), xa_ = *(const v4u*)(wsp<const bf16>(F, WS_AKK) + ro), xk_ = *(const v4u*)(wsp<const bf16>(F, WS_KL) + ro), \
              xs_ = *(const v4u*)(wsp<const bf16>(F, WS_ASIG) + (size_t)z_ * R * 512 + ro); const float* p3 = wsp<const float>(F, WS_WDEC) + (size_t)z_ * R * 512 + ro; const float* pk_ = F.in[I_KA] + h_ * 64 + j0; \
    const f32x4 w0_ = *(const f32x4*)p3, w1_ = *(const f32x4*)(p3 + 4), q0_ = *(const f32x4*)pk_, q1_ = *(const f32x4*)(pk_ + 4); float sg_[8], kl_[8]; \
    unpack8(xr_, fr); unpack8(xv_, fv); unpack8(xa_, fa); unpack8(xk_, kl_); unpack8(xs_, sg_); \
    _Pragma("unroll") for (int e = 0; e < 8; ++e) { const float kav = e < 4 ? q0_[e & 3] : q1_[e & 3]; fw[e] = e < 4 ? w0_[e & 3] : w1_[e & 3]; fk[e] = kl_[e] * (1.f + (sg_[e] - 1.f) * kav); fb[e] = -fa[e] * sg_[e]; } } while (0)
    if (F.blk < NUNIT_R) RK_LOAD(F.blk);
    for (int u = F.blk; u < NUNIT_R; u += F.G) {
        const int chain = u / 260, c = u - chain * 260, z = chain >> 4, b = (chain >> 3) & 1, h = chain & 7;
        __syncthreads();
#pragma unroll
        for (int e = 0; e < 8; ++e) G[t * 65 + j0 + e] = fw[e];
        __syncthreads();
        if (tid < 64) { float g = 1.f;
#pragma unroll 16
            for (int s = 0; s < 64; ++s) { g *= G[s * 65 + tid]; G[s * 65 + tid] = g; } gl[tid] = g; }
        __syncthreads();
#pragma unroll
        for (int e = 0; e < 8; ++e) { const int j = j0 + e; const float gt = G[t * 65 + j], gp = t > 0 ? G[(t - 1) * 65 + j] : 1.f, gL = G[63 * 65 + j], ig = 1.f / gt;
            fr[e] *= gt; fa[e] *= gp; const float bq = fb[e] * ig, kq = fk[e] * ig; fb[e] = bq; fk[e] = kq; fw[e] = gL; }
        __syncthreads();
        { v4u q; q.x = pk2(fr[0], fr[1]); q.y = pk2(fr[2], fr[3]); q.z = pk2(fr[4], fr[5]); q.w = pk2(fr[6], fr[7]); *(LAS v4u*)(Rt + t * LS + j0) = q;
          q.x = pk2(fa[0], fa[1]); q.y = pk2(fa[2], fa[3]); q.z = pk2(fa[4], fa[5]); q.w = pk2(fa[6], fa[7]); *(LAS v4u*)(At + t * LS + j0) = q;
          q.x = pk2(fb[0], fb[1]); q.y = pk2(fb[2], fb[3]); q.z = pk2(fb[4], fb[5]); q.w = pk2(fb[6], fb[7]); *(LAS v4u*)(Bq + t * LS + j0) = q;
          q.x = pk2(fk[0], fk[1]); q.y = pk2(fk[2], fk[3]); q.z = pk2(fk[4], fk[5]); q.w = pk2(fk[6], fk[7]); *(LAS v4u*)(Kq + t * LS + j0) = q; }
#pragma unroll
        for (int e = 0; e < 8; ++e) { const int j = j0 + e; stb(AtT, j, t, fa[e]); stb(VT, j, t, fv[e]); stb(BhT, j, t, fb[e] * fw[e]); stb(KhT, j, t, fk[e] * fw[e]); }
        __syncthreads();
        if (u + F.G < NUNIT_R) RK_LOAD(u + F.G);
        Acc2 a1, a2, a3, a4;
        zero(a1); mm_acc(a1, At, Bq, w, lane); zero(a2); mm_acc(a2, At, Kq, w, lane); zero(a3); mm_acc(a3, Rt, Bq, w, lane); zero(a4); mm_acc(a4, Rt, Kq, w, lane);
        each(a1, w, lane, [&](int m, int n, float v) { const float x = n < m ? v : 0.f; stb(X, m, n, x); stb(XT, n, m, x); stb(P, m, n, m == n ? 1.f : 0.f); });
        each(a2, w, lane, [&](int m, int n, float v) { stb(AK, m, n, n < m ? v : 0.f); });
        each(a3, w, lane, [&](int m, int n, float v) { stb(RB, m, n, n <= m ? v : 0.f); });
        each(a4, w, lane, [&](int m, int n, float v) { stb(RK, m, n, n <= m ? v : 0.f); });
        __syncthreads();
        { const int m0 = (w >> 1) * 16 + (lane >> 4) * 4, n0 = (w & 1) * 32 + (lane & 15);
          Acc2 pt;
#pragma unroll
          for (int r = 0; r < 4; ++r) { pt.t0[r] = (m0 + r == n0) ? 1.f : 0.f; pt.t1[r] = (m0 + r == n0 + 16) ? 1.f : 0.f; }
#pragma unroll 1
          for (int i = 0; i < NEU_ROUNDS; ++i) {
            mm_acc(pt, P, XT, w, lane);
            if (i < NEU_ROUNDS - 1) { zero(a1); mm_acc(a1, X, XT, w, lane); }
            __syncthreads();
#pragma unroll
            for (int r = 0; r < 4; ++r) { stb(P, m0 + r, n0, pt.t0[r]); stb(P, m0 + r, n0 + 16, pt.t1[r]); }
            if (i < NEU_ROUNDS - 1) { each(a1, w, lane, [&](int m, int n, float v) { stb(X, m, n, v); }); st_tr(XT, a1, w, lane); }
            __syncthreads();
          } }
        zero(a1); mm_acc(a1, AK, VT, w, lane); zero(a2); mm_acc(a2, P, AtT, w, lane);
        st_tr(AkVT, a1, w, lane); st_tr(ApT, a2, w, lane);
        __syncthreads();
        zero(a3); mm_acc(a3, P, AkVT, w, lane);
        st_tr(W2T, a3, w, lane);
        __syncthreads();
        zero(a1); mm_acc(a1, RB, ApT, w, lane); zero(a2); mm_acc(a2, RB, W2T, w, lane); mm_acc(a2, RK, VT, w, lane);
        zero(a3); mm_acc(a3, BhT, ApT, w, lane); zero(a4); mm_acc(a4, BhT, W2T, w, lane); mm_acc(a4, KhT, VT, w, lane);
        __syncthreads();
        { LAS bf16* O1 = At; LAS bf16* O2 = AtT; LAS bf16* O3 = AK; LAS float* OY = (LAS float*)X;
          each(a1, w, lane, [&](int m, int n, float v) { stb(O1, m, n, v + bf2f(Rt[m * LS + n])); });
          each(a3, w, lane, [&](int m, int n, float v) { stb(O2, m, n, v + (m == n ? gl[m] : 0.f)); });
          each(a4, w, lane, [&](int m, int n, float v) { stb(O3, m, n, v); });
          each(a2, w, lane, [&](int m, int n, float v) { OY[m * 68 + n] = v; });
          __syncthreads();
          const int row = tid >> 3, c8 = (tid & 7) * 8;
          *(v4u*)(wsp<bf16>(F, WS_RKQ) + (size_t)u * 4096 + row * 64 + c8) = *(const LAS v4u*)(O1 + row * LS + c8);
          *(v4u*)(wsp<bf16>(F, WS_RKM) + (size_t)u * 4096 + row * 64 + c8) = *(const LAS v4u*)(O2 + row * LS + c8);
          *(v4u*)(wsp<bf16>(F, WS_RKZ) + (size_t)u * 4096 + row * 64 + c8) = *(const LAS v4u*)(O3 + row * LS + c8);
          float* Yg = wsp<float>(F, WS_YR) + (size_t)z * R * 512 + h * 64;
#pragma unroll
          for (int i = 0; i < 2; ++i) { const int yr = (tid >> 4) + 32 * i, c4 = (tid & 15) * 4;
              *(f32x4*)(Yg + ((size_t)b * TB + scan_tok(z, 64 * c + yr)) * 512 + c4) = *(const LAS f32x4*)(OY + yr * 68 + c4); } }
    }
#undef RK_LOAD
}
__device__ __forceinline__ void l1_rk_phase_b(const Frame& F) {
    using namespace rk;
    LAS unsigned char* L = F.lds;
    const int w = F.wave, lane = F.lane, tid = F.tid, chain = F.blk, z = chain >> 4, b = (chain >> 3) & 1, h = chain & 7;
    for (int i = tid; i < 2 * 64 * LS; i += 512) ((LAS bf16*)L)[i] = 0;
    const int sr = tid >> 3, sc = (tid & 7) * 8;
    v4u gm, gq, gz;
#define RKB_LOAD(u_) do { gm = *(const v4u*)(wsp<const bf16>(F, WS_RKM) + (u_) * 4096 + sr * 64 + sc); gq = *(const v4u*)(wsp<const bf16>(F, WS_RKQ) + (u_) * 4096 + sr * 64 + sc); \
    gz = *(const v4u*)(wsp<const bf16>(F, WS_RKZ) + (u_) * 4096 + sr * 64 + sc); } while (0)
#define RKB_WRITE(par) do { *(LAS v4u*)((LAS bf16*)(L + (2 + 3 * (par)) * MB) + sr * LS + sc) = gm; *(LAS v4u*)((LAS bf16*)(L + (3 + 3 * (par)) * MB) + sr * LS + sc) = gq; \
    *(LAS v4u*)((LAS bf16*)(L + (4 + 3 * (par)) * MB) + sr * LS + sc) = gz; } while (0)
    RKB_LOAD((size_t)chain * 260); RKB_WRITE(0);
    __syncthreads();
    float* Yg = wsp<float>(F, WS_YB) + (size_t)z * R * 512 + h * 64;
    const int m0 = (w >> 1) * 16 + (lane >> 4) * 4, n0 = (w & 1) * 32 + (lane & 15);
    for (int c = 0; c < 260; ++c) {
        const size_t u = (size_t)chain * 260 + c; const int par = c & 1;
        if (c + 1 < 260) RKB_LOAD(u + 1);
        const LAS bf16* S = (const LAS bf16*)(L + par * MB); LAS bf16* Sn = (LAS bf16*)(L + (par ^ 1) * MB);
        const LAS bf16* Mt = (const LAS bf16*)(L + (2 + 3 * par) * MB); const LAS bf16* Qp = (const LAS bf16*)(L + (3 + 3 * par) * MB); const LAS bf16* Zt = (const LAS bf16*)(L + (4 + 3 * par) * MB);
        Acc2 a1, a2;
#pragma unroll
        for (int r = 0; r < 4; ++r) { a1.t0[r] = bf2f(Zt[(m0 + r) * LS + n0]); a1.t1[r] = bf2f(Zt[(m0 + r) * LS + n0 + 16]); }
        mm_acc(a1, Mt, S, w, lane); zero(a2); mm_acc(a2, Qp, S, w, lane);
        st_tr(Sn, a1, w, lane);
        if (c + 1 < 260) RKB_WRITE(par ^ 1);
#pragma unroll
        for (int r = 0; r < 4; ++r) { const size_t yo = ((size_t)b * TB + scan_tok(z, 64 * c + m0 + r)) * 512 + n0; Yg[yo] = a2.t0[r]; Yg[yo + 16] = a2.t1[r]; }
        __syncthreads();
    }
#undef RKB_LOAD
#undef RKB_WRITE
}
__device__ __forceinline__ void l1_mlstm_a2(const Frame& F) {
    using namespace rk;
    LAS bf16* KT = (LAS bf16*)F.lds; LAS bf16* VsT = KT + 64 * LS;
    LAS float* vec = (LAS float*)(F.lds + AUX_OFF); LAS int* rows = (LAS int*)vec;
    const bf16* Pg = wsp<const bf16>(F, WS_P); const int tid = F.tid, w = F.wave, lane = F.lane;
    for (int u = F.blk; u < NUNIT_M; u += F.G) {
        const int cidx = u / 260, c = u - cidx * 260, z = cidx >> 3, b = (cidx >> 2) & 1, h = cidx & 3;
        mlstm_chunk_head(F, z, b, h, c, vec);
        if (tid < 64) { const float bl = vec[128 + 63]; const float uu = bl - vec[128 + tid] + vec[64 + tid]; float m = uu;
#pragma unroll
            for (int o = 1; o < 64; o <<= 1) m = fmaxf(m, __shfl_xor(m, o));
            vec[256 + tid] = __expf(uu - m);
            if (tid == 0) { wsp<float>(F, WS_SC)[2 * u] = bl; wsp<float>(F, WS_SC)[2 * u + 1] = m; } }
        __syncthreads();
        { const int s = tid >> 3, c8 = tid & 7; float x[8]; unpack8(*(const v4u*)(Pg + (size_t)rows[s] * REC_NP + PC_K + h * 64 + 8 * c8), x);
#pragma unroll
          for (int e = 0; e < 8; ++e) stb(KT, 8 * c8 + e, s, x[e]); }
#pragma unroll
        for (int i = 0; i < 2; ++i) { const int s = (tid >> 4) + 32 * i, c8 = tid & 15; float x[8]; unpack8(*(const v4u*)(Pg + (size_t)rows[s] * REC_NP + PC_V + h * 128 + 8 * c8), x); const float sw = vec[256 + s];
#pragma unroll
            for (int e = 0; e < 8; ++e) stb(VsT, 8 * c8 + e, s, x[e] * sw); }
        __syncthreads();
        Acc2 a0, a1; zero(a0); mm_acc(a0, VsT, KT, w, lane); zero(a1); mm_acc(a1, VsT + 64 * LS, KT, w, lane);
        float* dc = wsp<float>(F, WS_DC) + (size_t)u * 8192;
        each(a0, w, lane, [&](int m, int n, float v) { dc[m * 64 + n] = 0.125f * v; });
        each(a1, w, lane, [&](int m, int n, float v) { dc[(64 + m) * 64 + n] = 0.125f * v; });
        if (tid < 64) { float a = 0.f; for (int s = 0; s < 64; ++s) a += vec[256 + s] * bf2f(KT[tid * LS + s]); wsp<float>(F, WS_DN)[(size_t)u * 64 + tid] = 0.125f * a; }
        __syncthreads();
    }
}
__device__ __forceinline__ void l1_mlstm_c2(const Frame& F, int first_blk, int nblk) {
    using namespace rk;
    LAS bf16* Q = (LAS bf16*)F.lds; LAS bf16* K = Q + 64 * LS; LAS bf16* VT = K + 64 * LS; LAS bf16* Cm = VT + 128 * LS; LAS bf16* Pm = Cm + 128 * LS;
    LAS float* OH = (LAS float*)(F.lds + 7 * MB);
    LAS float* vec = (LAS float*)(F.lds + AUX_OFF); LAS int* rows = (LAS int*)vec;
    const bf16* Pg = wsp<const bf16>(F, WS_P); const int tid = F.tid, w = F.wave, lane = F.lane;
    for (int u = F.blk - first_blk; u < NUNIT_M; u += nblk) {
        const int cidx = u / 260, c = u - cidx * 260, z = cidx >> 3, b = (cidx >> 2) & 1, h = cidx & 3;
        mlstm_chunk_head(F, z, b, h, c, vec);
        const float mst = wsp<const float>(F, WS_MST)[u];
        if (tid < 64) { const int t = tid; float pm = -3.0e38f; for (int s = 0; s <= t; ++s) pm = fmaxf(pm, vec[64 + s] - vec[128 + s]);
            const float gi = vec[128 + t] + mst, mo = fmaxf(gi, vec[128 + t] + pm); vec[320 + t] = __expf(gi - mo); vec[384 + t] = mo;
            vec[256 + t] = wsp<const float>(F, WS_NST)[(size_t)u * 64 + t]; }
        { const int t = tid >> 3, c8 = tid & 7;
          *(LAS v4u*)(Q + t * LS + 8 * c8) = *(const v4u*)(Pg + (size_t)rows[t] * REC_NP + PC_Q + h * 64 + 8 * c8);
          *(LAS v4u*)(K + t * LS + 8 * c8) = *(const v4u*)(Pg + (size_t)rows[t] * REC_NP + PC_K + h * 64 + 8 * c8); }
#pragma unroll
        for (int i = 0; i < 2; ++i) { const int s = (tid >> 4) + 32 * i, c8 = tid & 15; const v4u wv = *(const v4u*)(Pg + (size_t)rows[s] * REC_NP + PC_V + h * 128 + 8 * c8);
            const unsigned ww[4] = {wv.x, wv.y, wv.z, wv.w};
#pragma unroll
            for (int e = 0; e < 4; ++e) { VT[(8 * c8 + 2 * e) * LS + s] = (bf16)(ww[e] & 0xffffu); VT[(8 * c8 + 2 * e + 1) * LS + s] = (bf16)(ww[e] >> 16); } }
        { const int v = tid >> 2, dq = (tid & 3) * 16; const f32x4* src = (const f32x4*)(wsp<const float>(F, WS_CST) + (size_t)u * 8192 + v * 64 + dq);
          const f32x4 x0 = src[0], x1 = src[1], x2 = src[2], x3 = src[3]; v4u o0, o1;
          o0.x = pk2(x0.x, x0.y); o0.y = pk2(x0.z, x0.w); o0.z = pk2(x1.x, x1.y); o0.w = pk2(x1.z, x1.w); o1.x = pk2(x2.x, x2.y); o1.y = pk2(x2.z, x2.w); o1.z = pk2(x3.x, x3.y); o1.w = pk2(x3.z, x3.w);
          *(LAS v4u*)(Cm + v * LS + dq) = o0; *(LAS v4u*)(Cm + v * LS + dq + 8) = o1; }
        __syncthreads();
        Acc2 aq, c0, c1; zero(aq); mm_acc(aq, Q, K, w, lane); zero(c0); mm_acc(c0, Q, Cm, w, lane); zero(c1); mm_acc(c1, Q, Cm + 64 * LS, w, lane);
        each(aq, w, lane, [&](int t, int s, float v) { stb(Pm, t, s, s <= t ? 0.125f * v * __expf(vec[128 + t] + (vec[64 + s] - vec[128 + s]) - vec[384 + t]) : 0.f); });
        __syncthreads();
        Acc2 p0, p1; zero(p0); mm_acc(p0, Pm, VT, w, lane); zero(p1); mm_acc(p1, Pm, VT + 64 * LS, w, lane);
        if (tid < 64) { const int t = tid; float rs = 0.f, nq = 0.f;
            for (int s = 0; s < 64; ++s) { rs += bf2f(Pm[t * LS + s]); nq += vec[256 + s] * bf2f(Q[t * LS + s]); }
            const float den = vec[320 + t] * nq + rs; vec[448 + t] = 1.f / fmaxf(fabsf(den), __expf(-vec[384 + t])); }
        __syncthreads();
        { const int m0 = (w >> 1) * 16 + (lane >> 4) * 4, n0 = (w & 1) * 32 + (lane & 15);
#pragma unroll
          for (int r = 0; r < 4; ++r) { const int t = m0 + r; const float g = vec[320 + t], idn = vec[448 + t];
              OH[t * 132 + n0] = (g * c0.t0[r] + p0.t0[r]) * idn; OH[t * 132 + n0 + 16] = (g * c0.t1[r] + p0.t1[r]) * idn;
              OH[t * 132 + 64 + n0] = (g * c1.t0[r] + p1.t0[r]) * idn; OH[t * 132 + 64 + n0 + 16] = (g * c1.t1[r] + p1.t1[r]) * idn; } }
        __syncthreads();
#pragma unroll
        for (int i = 0; i < 4; ++i) { const int it = tid + 512 * i, t = it >> 5, c4 = (it & 31) * 4;
            *(f32x4*)(wsp<float>(F, WS_HM) + ((size_t)z * R + rows[t]) * 512 + h * 128 + c4) = *(const LAS f32x4*)(OH + t * 132 + c4); }
        __syncthreads();
    }
}
#ifndef MK_PER_PHASE
#define MK_PER_PHASE 0
#endif
constexpr int NPHASE = 26;
struct Args { const float* in[N_IN]; float* out; unsigned char* ws; int ph_lo, ph_hi, li, pad; };
#define GEMM_CALL(FnT, SchedT, g, S, fn) do { pg8::EpiGen<FnT> E_{fn}; { int k_ = g.K; asm volatile("" : "+s"(k_)); g.K = k_; } pg8::gemm_phase<pg8::EpiGen<FnT>, SchedT, true, true>((PG8_LAS unsigned char*)F.lds, g, S, E_); } while (0)
#ifndef SITE_MASK
#define SITE_MASK 0xFFFFFFFFull
#endif
#define SITE(s) (((SITE_MASK) >> (s)) & 1ull)
#ifndef DUP_MASK
#define DUP_MASK 0ull
#endif
#define NREP(s) ((((DUP_MASK) >> (s)) & 1ull) ? 2 : 1)
#define IN(k) (lo <= (k) && (k) < hi)
#define SEAM(k) do { if (IN(k) && IN((k) + 1)) xcd_barrier(bar); } while (0)
template <int LAYER> __device__ __forceinline__ void layer_phases(const Frame& F, const XcdBarrier& bar, const int lo, const int hi) {
    constexpr int layer = LAYER; constexpr int pb = 2 + 12 * LAYER;
        if (SITE(2) && IN(pb + 0)) { for (int rep_ = 0; rep_ < NREP(2); ++rep_) {
            const int N = layer == 0 ? ATT_NP : REC_NP;
            pg8::Gemm g{wsp<const bf16>(F, WS_A), layer == 0 ? wsp<const bf16>(F, WS_WIN0) : wsp<const bf16>(F, WS_WREC), R, N, 1024};
            pg8::StaticOrder S; S.init(R, N, F.G, F.blk);
            GEMM_CALL(FnStoreBf16, pg8::StaticOrder, g, S, (FnStoreBf16{wsp<bf16>(F, WS_P), N}));
             if (rep_ + 1 < NREP(2)) xcd_barrier(bar); } SEAM(pb + 0);
        }
        if constexpr (LAYER == 0) {
            if (SITE(3) && IN(pb + 1)) { for (int rep_ = 0; rep_ < NREP(3); ++rep_) { l0_post_proj(F);  if (rep_ + 1 < NREP(3)) xcd_barrier(bar); } SEAM(pb + 1); }
            if (SITE(4) && IN(pb + 2)) { for (int rep_ = 0; rep_ < NREP(4); ++rep_) {
                pg8::Gemm g{wsp<const bf16>(F, WS_CQN), wsp<const bf16>(F, WS_WUQ), R, 768, 384}; pg8::StaticOrder S; S.init(R, 768, F.G, F.blk);
                GEMM_CALL(FnStoreBf16, pg8::StaticOrder, g, S, (FnStoreBf16{wsp<bf16>(F, WS_MQ), 768}));
                 if (rep_ + 1 < NREP(4)) xcd_barrier(bar); } SEAM(pb + 2);
            }
            if (SITE(5) && IN(pb + 3)) { for (int rep_ = 0; rep_ < NREP(5); ++rep_) {
                pg8::Gemm g{wsp<const bf16>(F, WS_CKVN), wsp<const bf16>(F, WS_WUKV), R, 1024, 256}; pg8::StaticOrder S; S.init(R, 1024, F.G, F.blk);
                GEMM_CALL(FnStoreBf16, pg8::StaticOrder, g, S, (FnStoreBf16{wsp<bf16>(F, WS_MKV), 1024}));
                l0_mq_rope(F);
                 if (rep_ + 1 < NREP(5)) xcd_barrier(bar); } SEAM(pb + 3);
            }
            if (SITE(6) && IN(pb + 4)) { for (int rep_ = 0; rep_ < NREP(6); ++rep_) { l0_attention(F);  if (rep_ + 1 < NREP(6)) xcd_barrier(bar); } SEAM(pb + 4); }
            if (SITE(7) && IN(pb + 5)) { for (int rep_ = 0; rep_ < NREP(7); ++rep_) { l0_combine(F);  if (rep_ + 1 < NREP(7)) xcd_barrier(bar); } SEAM(pb + 5); }
        } else {
            if (SITE(8) && IN(pb + 1)) { for (int rep_ = 0; rep_ < NREP(8); ++rep_) { l1_rwkv_prep(F); l1_mlstm_a2(F);  if (rep_ + 1 < NREP(8)) xcd_barrier(bar); } SEAM(pb + 1); }
            if (SITE(9) && IN(pb + 2)) { for (int rep_ = 0; rep_ < NREP(9); ++rep_) {
                pg8::Gemm g{wsp<const bf16>(F, WS_ALORA), wsp<const bf16>(F, WS_WLORA), R, 2560, 384}; pg8::StaticOrder S; S.init(R, 2560, F.G, F.blk);
                { int k_ = g.K; asm volatile("" : "+s"(k_)); g.K = k_; EpiLora E_{&F}; pg8::gemm_phase<EpiLora, pg8::StaticOrder, true, true>((PG8_LAS unsigned char*)F.lds, g, S, E_); }
                l1_mlstm_b(F);
                 if (rep_ + 1 < NREP(9)) xcd_barrier(bar); } SEAM(pb + 2);
            }
            if (SITE(18) && IN(pb + 3)) { for (int rep_ = 0; rep_ < NREP(18); ++rep_) { l1_rk_phase_a(F); if (rep_ + 1 < NREP(18)) xcd_barrier(bar); } SEAM(pb + 3); }
            if (SITE(10) && IN(pb + 4)) { for (int rep_ = 0; rep_ < NREP(10); ++rep_) {
                if (F.G > 32) { if (F.blk < 32) l1_rk_phase_b(F); else { l1_mlstm_c2(F, 32, F.G - 32); moe_weights_convert(F, 1, (F.blk - 32) * 8 + F.wave, (F.G - 32) * 8); } }
                 if (rep_ + 1 < NREP(10)) xcd_barrier(bar); } SEAM(pb + 4);
            }
            if (SITE(11) && IN(pb + 5)) { for (int rep_ = 0; rep_ < NREP(11); ++rep_) { l1_rec_out(F);  if (rep_ + 1 < NREP(11)) xcd_barrier(bar); } SEAM(pb + 5); }
        }
        if (SITE(12) && IN(pb + 6)) { for (int rep_ = 0; rep_ < NREP(12); ++rep_) {
            pg8::Gemm g{wsp<const bf16>(F, WS_A1), wsp<const bf16>(F, WS_WOUT) + (size_t)layer * 1024 * 1024, R, 1024, 1024};
            if constexpr (LAYER == 0) { pg8::StaticOrder S; S.init(R, 1024, F.G, F.blk); GEMM_CALL(FnWout, pg8::StaticOrder, g, S, (FnWout{&F, layer})); }
            else { LatOrder S; S.o.init(R - 2 * CT, 1024, F.G, F.blk); GEMM_CALL(FnWout, LatOrder, g, S, (FnWout{&F, layer})); }
             if (rep_ + 1 < NREP(12)) xcd_barrier(bar); } SEAM(pb + 6);
        }
        if (SITE(13) && IN(pb + 7)) { for (int rep_ = 0; rep_ < NREP(13); ++rep_) { ph_router(F, layer);  if (rep_ + 1 < NREP(13)) xcd_barrier(bar); } SEAM(pb + 7); }
        if (SITE(14) && IN(pb + 8)) { for (int rep_ = 0; rep_ < NREP(14); ++rep_) { ph_gather(F, layer);  if (rep_ + 1 < NREP(14)) xcd_barrier(bar); } SEAM(pb + 8); }
        if (SITE(15) && IN(pb + 9)) { for (int rep_ = 0; rep_ < NREP(15); ++rep_) {
            const int* tab = wsp<const int>(F, WS_TILE);
            pg8::Gemm g{wsp<const bf16>(F, WS_F), wsp<const bf16>(F, WS_W1T), MAXROWS, NE * 2048, 1024}; MoeOrder S{tab + 1, __builtin_amdgcn_readfirstlane(tab[0]), 8, F.G, F.blk, wsp<const int>(F, WS_SRC)};
            { int k_ = g.K; asm volatile("" : "+s"(k_)); g.K = k_; pg8::EpiGen<FnSwiglu> E_{FnSwiglu{wsp<bf16>(F, WS_HS), F.in[I_B1] + (size_t)layer * NE * 2048}};
              pg8::gemm_phase<pg8::EpiGen<FnSwiglu>, MoeOrder, true, true, true>((PG8_LAS unsigned char*)F.lds, g, S, E_); }
             if (rep_ + 1 < NREP(15)) xcd_barrier(bar); } SEAM(pb + 9);
        }
        if (SITE(16) && IN(pb + 10)) { for (int rep_ = 0; rep_ < NREP(16); ++rep_) {
            const int* tab = wsp<const int>(F, WS_TILE);
            pg8::Gemm g{wsp<const bf16>(F, WS_HS), wsp<const bf16>(F, WS_W2T), MAXROWS, NE * 1024, 1024}; MoeOrder S{tab + 1, __builtin_amdgcn_readfirstlane(tab[0]), 4, F.G, F.blk, nullptr};
            GEMM_CALL(FnBiasBf16, MoeOrder, g, S, (FnBiasBf16{wsp<bf16>(F, WS_XS), F.in[I_B2] + (size_t)layer * NE * 1024}));
             if (rep_ + 1 < NREP(16)) xcd_barrier(bar); } SEAM(pb + 10);
        }
        if (SITE(17) && IN(pb + 11)) { for (int rep_ = 0; rep_ < NREP(17); ++rep_) { ph_combine(F, layer);  if (rep_ + 1 < NREP(17)) xcd_barrier(bar); } SEAM(pb + 11); }
}
__global__ void __launch_bounds__(512, 2) fwd(Args args) {
    extern __shared__ __attribute__((aligned(16))) unsigned char lds_[];
    Frame F;
    F.lds = (LAS unsigned char*)lds_; F.tid = threadIdx.x; F.lane = F.tid & 63; F.wave = __builtin_amdgcn_readfirstlane(F.tid >> 6); F.blk = blockIdx.x; F.G = gridDim.x; F.probe = args.pad;
    F.ws = args.ws; F.out = args.out; F.ctl = (gu32*)(args.ws + WS_CTL);
    F.in.t = (LAS const unsigned*)(F.lds + MISC_OFF + 8192);
    if (F.tid < 64) ((LAS unsigned*)(F.lds + MISC_OFF))[F.tid] = 0u;
    if (F.tid < N_IN) { const unsigned long long pv = (unsigned long long)args.in[F.tid]; ((LAS unsigned*)(F.lds + MISC_OFF + 8192))[2 * F.tid] = (unsigned)pv; ((LAS unsigned*)(F.lds + MISC_OFF + 8192))[2 * F.tid + 1] = (unsigned)(pv >> 32); }
    __syncthreads();
    const int lo = args.ph_lo, hi = args.ph_hi;
    XcdBarrier bar; bar.bar = (unsigned*)(F.ctl + CW_BAR) + args.li * XCD_BAR_WORDS; bar.x = 0; bar.st = nullptr;
    if (hi - lo > 1) bar = xcd_barrier_post((unsigned*)(F.ctl + CW_BAR) + args.li * XCD_BAR_WORDS, (volatile LAS unsigned*)(F.lds + MISC_OFF));
    if (SITE(0) && IN(0)) { for (int rep_ = 0; rep_ < NREP(0); ++rep_) { p0a(F);  if (rep_ + 1 < NREP(0)) xcd_barrier(bar); } SEAM(0); }
    if (SITE(1) && IN(1)) { for (int rep_ = 0; rep_ < NREP(1); ++rep_) { p0b(F);  if (rep_ + 1 < NREP(1)) xcd_barrier(bar); } SEAM(1); }
    layer_phases<0>(F, bar, lo, hi);
    layer_phases<1>(F, bar, lo, hi);
}
#undef IN
#undef SEAM


extern "C" void kernel_launch(void* const* d_in, const int* in_sizes, int n_in, void* d_out, int out_size, void* d_ws, size_t ws_size, hipStream_t stream) {
    static int grid = 0;
    if (grid == 0) {
        const bool ok = n_in == N_IN && in_sizes[I_X] == NBATCH * SEQ * DM && in_sizes[I_RECW] == 1024 * REC_IN && in_sizes[I_ATTW] == 1024 * ATT_IN && in_sizes[I_MU] == RWKV_IN &&
                        in_sizes[I_GATEB] == 16 && in_sizes[I_W1] == 2 * NE * 1024 * 2048 && out_size == NBATCH * SEQ * DM && ws_size >= WS_END;
        if (!ok) { fprintf(stderr, "kernel_launch: shape mismatch (n_in %d, recw %d, attw %d, mu %d, out %d, ws %zu need %zu); nothing launched\n", n_in, n_in > I_RECW ? in_sizes[I_RECW] : -1,
                           n_in > I_ATTW ? in_sizes[I_ATTW] : -1, n_in > I_MU ? in_sizes[I_MU] : -1, out_size, ws_size, (size_t)WS_END); grid = -1; return; }
        int dev = 0, cus = 0;
        if (hipGetDevice(&dev) != hipSuccess || hipDeviceGetAttribute(&cus, hipDeviceAttributeMultiprocessorCount, dev) != hipSuccess) { grid = -1; return; }
        if (hipFuncSetAttribute((const void*)fwd, hipFuncAttributeMaxDynamicSharedMemorySize, LDS_BYTES) != hipSuccess) { fprintf(stderr, "kernel_launch: hipFuncSetAttribute failed\n"); grid = -1; return; }
        int per_cu = 0;
        if (hipOccupancyMaxActiveBlocksPerMultiprocessor(&per_cu, (const void*)fwd, 512, LDS_BYTES) != hipSuccess || per_cu < 1) { fprintf(stderr, "kernel_launch: occupancy query says %d blocks per CU\n", per_cu); }
        (void)hipGetLastError();
        grid = cus < 256 ? cus : 256;
        if (grid != 256) fprintf(stderr, "kernel_launch: %d CUs; this kernel is written for a 256-CU device\n", cus);
    }
    if (grid < 0) return;
    if (hipMemsetAsync((char*)d_ws + WS_CTL, 0, CTL_ZERO_BYTES, stream) != hipSuccess) return;
    Args a{};
    for (int i = 0; i < N_IN; ++i) a.in[i] = (const float*)d_in[i];
    a.out = (float*)d_out; a.ws = (unsigned char*)d_ws; a.pad = 0;
#if MK_PER_PHASE
    for (int ph = 0; ph < NPHASE; ++ph) { a.ph_lo = ph; a.ph_hi = ph + 1; a.li = 0; hipLaunchKernelGGL(fwd, dim3(grid), dim3(512), LDS_BYTES, stream, a); }
#elif defined(PROBE_LIST)
    { const int plist[] = {PROBE_LIST}; int cur = 0, li = 0;
      for (int p : plist) { a.ph_lo = cur; a.ph_hi = p + 1; a.li = li++; hipLaunchKernelGGL(fwd, dim3(grid), dim3(512), LDS_BYTES, stream, a);
                            a.ph_lo = p; a.ph_hi = p + 1; a.li = li++; a.pad = 1; hipLaunchKernelGGL(fwd, dim3(grid), dim3(512), LDS_BYTES, stream, a); a.pad = 0; cur = p + 1; }
      if (cur < NPHASE) { a.ph_lo = cur; a.ph_hi = NPHASE; a.li = li++; hipLaunchKernelGGL(fwd, dim3(grid), dim3(512), LDS_BYTES, stream, a); } }
#else
    a.ph_lo = 0; a.ph_hi = NPHASE; a.li = 0; hipLaunchKernelGGL(fwd, dim3(grid), dim3(512), LDS_BYTES, stream, a);
#endif
    const hipError_t le = hipPeekAtLastError();
    if (le != hipSuccess) fprintf(stderr, "kernel_launch: launch failed: %s\n", hipGetErrorName(le));
}
```

```cpp
#include <hip/hip_runtime.h>
#include <cstdio>
#include <cstdint>
#define MK_PER_PHASE 0
namespace pg8 {
#define PG8_LAS __attribute__((address_space(3)))
typedef unsigned short bf16_t;
typedef short bf16x8 __attribute__((ext_vector_type(8)));
typedef float f32x4 __attribute__((ext_vector_type(4)));
typedef unsigned u32x4 __attribute__((ext_vector_type(4)));
constexpr int BM = 256, BK = 64, HALF = 128, HTB = HALF * BK * 2  , STAGE_BYTES = 8 * HTB, NXCD = 8, WGM = 8;

__host__ __device__ __forceinline__ int lds_byte(int r, int c) { const int st = (r >> 4) * 2 + (c >> 5), rr = r & 15, cc = c & 31, ob = rr * 64 + cc * 2; return st * 1024 + (ob ^ (((ob >> 9) & 1) << 5)); }
__host__ __device__ __forceinline__ void stage_rc(int b, int& R, int& C) { const int st = b / 1024, sb = b % 1024, swz = sb ^ (((sb >> 9) & 1) << 5); R = (st >> 1) * 16 + swz / 64; C = (st & 1) * 32 + (swz % 64) / 2; }
__host__ __device__ __forceinline__ int perm32(int rho) { const int n = rho >> 4, i = rho & 15; return 8 * (i >> 2) + 4 * n + (i & 3); }

struct Unit { int pm, pn; };
struct Gemm { const bf16_t* A; const bf16_t* Bt; int M, N, K; };

struct StaticOrder {
    int nM, nN, nwg, G, c;
    __host__ __device__ void init(int M, int N, int G_, int c_) { nM = M / BM; nN = N / BM; nwg = nM * nN; G = G_; c = c_; }
    __host__ __device__ bool next(int i, Unit& u) const {
        const long L = (long)i * G + c; if (L >= nwg) return false;
        int wgid = (int)L; { const int q = nwg / NXCD, r = nwg % NXCD, xcd = wgid % NXCD, off = wgid / NXCD; wgid = (xcd < r ? xcd * (q + 1) : r * (q + 1) + (xcd - r) * q) + off; }
        const int nig = WGM * nN, gid = wgid / nig, fm = gid * WGM, gsz = (nM - fm) < WGM ? (nM - fm) : WGM;
        u.pm = fm + ((wgid % nig) % gsz); u.pn = (wgid % nig) / gsz; return true;
    }
    __device__ __forceinline__ void a_ready(const Unit&) const {}
    __device__ __forceinline__ void done(const Unit&) const {}
};

__device__ __forceinline__ unsigned cvt_pk_bf16(float lo, float hi) { unsigned r; asm volatile("v_cvt_pk_bf16_f32 %0, %1, %2" : "=v"(r) : "v"(lo), "v"(hi)); return r; }
template <class Fn> struct EpiGen {
    static constexpr bool PERM = true, AFTER_DRAIN = false;
    Fn fn;
    __device__ __forceinline__ void operator()(const f32x4 (&acc)[2][2][4][2], const Unit& u, int wr, int wc, int fr, int fq) const {
#pragma unroll
        for (int ai = 0; ai < 2; ++ai)
#pragma unroll
            for (int m = 0; m < 4; ++m) { const int row = u.pm * BM + ai * HALF + wr * 64 + m * 16 + fr;
#pragma unroll
                for (int bj = 0; bj < 2; ++bj) { const int col = u.pn * BM + bj * HALF + wc * 32 + 8 * fq; fn(row, col, acc[ai][bj][m][0], acc[ai][bj][m][1]); } }
    }
};
template <class Epi, class Sched, bool ALIGN_EPI = false, bool SP2 = false, bool GATHER = false>
__device__ __forceinline__ void gemm_phase(PG8_LAS unsigned char* lds, const Gemm g, const Sched& S, const Epi& E) {
    static_assert(!GATHER || SP2, "the gathered A path is written for the SP2 loop");
    const int tid = threadIdx.x, wid = __builtin_amdgcn_readfirstlane(tid >> 6), lane = tid & 63, wr = wid >> 2, wc = wid & 3, fr = lane & 15, fq = lane >> 4;
    const int K = g.K, nt = K / BK;
    unsigned voffA[2], voffB[2]; int gR[2], gC[2]; unsigned gA[2][2], gN[2][2];
#pragma unroll
    for (int i = 0; i < 2; ++i) { int R, C; stage_rc(tid * 16 + i * 8192, R, C); const int Rb = Epi::PERM ? ((R & ~31) + perm32(R & 31)) : R;
        voffA[i] = (unsigned)(R * K + C) * 2u; voffB[i] = (unsigned)(Rb * K + C) * 2u; gR[i] = R; gC[i] = C; }
    const size_t kstep = (size_t)(BK * 2);
    const size_t hstep = (size_t)HALF * K * 2;
    const size_t tstep = 2 * hstep;
    const unsigned ldsw = (unsigned)wid * 1024u;
    const int aoff = lds_byte(wr * 64 + fr, fq * 8), boff = lds_byte(wc * 32 + fr, fq * 8);
#define PG8_SA(b, h) (((b) * 2 + (h)) * HTB)
#define PG8_SB(b, h) ((4 + (b) * 2 + (h)) * HTB)
#define PG8_STAGE(bufoff, gbase, voff) do { _Pragma("unroll") for (int _i = 0; _i < 2; ++_i) \
        __builtin_amdgcn_global_load_lds((const unsigned*)((const char*)(gbase) + (voff)[_i]), (PG8_LAS unsigned*)(lds + (bufoff) + ldsw + _i * 8192), 16, 0, 0); } while (0)
#define PG8_GOFF(u_, out_) do { _Pragma("unroll") for (int _h = 0; _h < 2; ++_h) _Pragma("unroll") for (int _i = 0; _i < 2; ++_i) \
        out_[_h][_i] = ((unsigned)S.src[(u_).pm * BM + _h * HALF + gR[_i]] * (unsigned)K + (unsigned)gC[_i]) * 2u; } while (0)
#define PG8_STAGE_A(bufoff, kptr, h, isnext) do { if constexpr (GATHER) { unsigned _o[2]; _o[0] = (isnext) ? gN[h][0] : gA[h][0]; _o[1] = (isnext) ? gN[h][1] : gA[h][1]; PG8_STAGE(bufoff, kptr, _o); } \
        else { PG8_STAGE(bufoff, (kptr) + (h) * hstep, voffA); } } while (0)
#define PG8_LDA(dst, b, h) do { _Pragma("unroll") for (int m = 0; m < 4; ++m) _Pragma("unroll") for (int k = 0; k < 2; ++k) dst[m][k] = *(const PG8_LAS bf16x8*)(lds + PG8_SA(b, h) + aoff + m * 2048 + k * 1024); } while (0)
#define PG8_LDB(dst, b, h) do { _Pragma("unroll") for (int n = 0; n < 2; ++n) _Pragma("unroll") for (int k = 0; k < 2; ++k) dst[n][k] = *(const PG8_LAS bf16x8*)(lds + PG8_SB(b, h) + boff + n * 2048 + k * 1024); } while (0)
#define PG8_MMA(ai, bj, At, Bt) do { __builtin_amdgcn_s_setprio(1); _Pragma("unroll") for (int m = 0; m < 4; ++m) _Pragma("unroll") for (int n = 0; n < 2; ++n) _Pragma("unroll") for (int k = 0; k < 2; ++k) \
        acc[ai][bj][m][n] = __builtin_amdgcn_mfma_f32_16x16x32_bf16(Bt[n][k], At[m][k], acc[ai][bj][m][n], 0, 0, 0); __builtin_amdgcn_s_setprio(0); } while (0)
#define PG8_WAIT_V(n) asm volatile("s_waitcnt vmcnt(" #n ")" ::: "memory")
#define PG8_WAIT_L(n) asm volatile("s_waitcnt lgkmcnt(" #n ")" ::: "memory")
#define PG8_BAR __builtin_amdgcn_s_barrier()
#define PG8_SCHED __builtin_amdgcn_sched_barrier(0)
    Unit cur, nxt; int ui = 0;
    if (!S.next(0, cur)) return;
    f32x4 acc[2][2][4][2];
#pragma unroll
    for (int a = 0; a < 2; ++a)
#pragma unroll
        for (int b = 0; b < 2; ++b)
#pragma unroll
            for (int m = 0; m < 4; ++m)
#pragma unroll
                for (int n = 0; n < 2; ++n) acc[a][b][m][n] = (f32x4){0.f, 0.f, 0.f, 0.f};
    bf16x8 At[4][2], B0[2][2], B1[2][2];
    const char* cA = (const char*)g.A + (GATHER ? (size_t)0 : (size_t)cur.pm * tstep); const char* cB = (const char*)g.Bt + (size_t)cur.pn * tstep;
    if constexpr (GATHER) PG8_GOFF(cur, gA);
    S.a_ready(cur);
    if constexpr (SP2) {
        PG8_STAGE(PG8_SB(0, 0), cB, voffB); PG8_STAGE(PG8_SB(0, 1), cB + hstep, voffB); PG8_STAGE_A(PG8_SA(0, 0), cA, 0, false); PG8_STAGE_A(PG8_SA(0, 1), cA, 1, false);
        if (wr == 1) PG8_BAR;
        PG8_WAIT_V(2); PG8_BAR;
        PG8_STAGE(PG8_SB(1, 0), cB + kstep, voffB); PG8_STAGE_A(PG8_SA(1, 0), cA + kstep, 0, false); PG8_STAGE(PG8_SB(1, 1), cB + hstep + kstep, voffB);
        PG8_WAIT_V(6); PG8_BAR;
    } else {
        PG8_STAGE(PG8_SB(0, 0), cB, voffB); PG8_STAGE(PG8_SA(0, 0), cA, voffA); PG8_STAGE(PG8_SB(0, 1), cB + hstep, voffB); PG8_STAGE(PG8_SA(0, 1), cA + hstep, voffA);
        if (wr == 1) PG8_BAR;
        PG8_WAIT_V(4); PG8_BAR;
        PG8_STAGE(PG8_SB(1, 0), cB + kstep, voffB); PG8_STAGE(PG8_SA(1, 0), cA + kstep, voffA); PG8_STAGE(PG8_SB(1, 1), cB + hstep + kstep, voffB);
        PG8_WAIT_V(6); PG8_BAR;
    }
    for (;;) {
        const bool has_next = S.next(ui + 1, nxt);
        const char* nA = (has_next && !GATHER) ? (const char*)g.A + (size_t)nxt.pm * tstep : cA; const char* nB = has_next ? (const char*)g.Bt + (size_t)nxt.pn * tstep : cB;
        if constexpr (GATHER) { if (has_next) PG8_GOFF(nxt, gN); else { _Pragma("unroll") for (int _h = 0; _h < 2; ++_h) { gN[_h][0] = gA[_h][0]; gN[_h][1] = gA[_h][1]; } } }
        for (int t = 0; t < nt; t += 2) {
            const bool last = (t == nt - 2);
            const char* a1 = cA + (size_t)(t + 1) * kstep;
            const char* a2 = last ? nA : cA + (size_t)(t + 2) * kstep; const char* b2 = last ? nB : cB + (size_t)(t + 2) * kstep;
            const char* a3 = a2 + kstep; const char* b3 = b2 + kstep;
            if (last && has_next) S.a_ready(nxt);
            if constexpr (SP2) {
            PG8_LDB(B0, 0, 0); PG8_LDB(B1, 0, 1); PG8_SCHED; PG8_LDA(At, 0, 0); PG8_STAGE_A(PG8_SA(1, 1), a1, 1, false);
            PG8_WAIT_V(8); PG8_WAIT_L(0); PG8_BAR; PG8_MMA(0, 0, At, B0); PG8_MMA(0, 1, At, B1); PG8_BAR; PG8_SCHED;
            PG8_LDA(At, 0, 1); PG8_STAGE(PG8_SB(0, 0), b2, voffB); PG8_STAGE(PG8_SB(0, 1), b2 + hstep, voffB); PG8_STAGE_A(PG8_SA(0, 0), a2, 0, last);
            PG8_WAIT_V(8); PG8_WAIT_L(0); PG8_BAR; PG8_MMA(1, 0, At, B0); PG8_MMA(1, 1, At, B1); PG8_BAR; PG8_SCHED;
            PG8_LDB(B0, 1, 0); PG8_LDB(B1, 1, 1); PG8_SCHED; PG8_LDA(At, 1, 0); PG8_STAGE_A(PG8_SA(0, 1), a2, 1, last);
            PG8_WAIT_V(8); PG8_WAIT_L(0); PG8_BAR; PG8_MMA(0, 0, At, B0); PG8_MMA(0, 1, At, B1); PG8_BAR; PG8_SCHED;
            PG8_LDA(At, 1, 1); PG8_STAGE(PG8_SB(1, 0), b3, voffB); PG8_STAGE(PG8_SB(1, 1), b3 + hstep, voffB); PG8_STAGE_A(PG8_SA(1, 0), a3, 0, last);
            PG8_WAIT_V(8); PG8_WAIT_L(0); PG8_BAR; PG8_MMA(1, 0, At, B0); PG8_MMA(1, 1, At, B1); PG8_BAR; PG8_SCHED;
            } else {
            PG8_LDB(B0, 0, 0); PG8_SCHED; PG8_LDA(At, 0, 0); PG8_STAGE(PG8_SA(1, 1), a1 + hstep, voffA);
            PG8_WAIT_L(8); PG8_BAR; PG8_WAIT_L(0); PG8_MMA(0, 0, At, B0); PG8_BAR; PG8_SCHED;
            PG8_LDB(B1, 0, 1); PG8_STAGE(PG8_SB(0, 0), b2, voffB);
            PG8_BAR; PG8_WAIT_L(0); PG8_MMA(0, 1, At, B1); PG8_BAR;
            PG8_LDA(At, 0, 1); PG8_STAGE(PG8_SA(0, 0), a2, voffA);
            PG8_BAR; PG8_WAIT_L(0); PG8_MMA(1, 0, At, B0); PG8_BAR; PG8_SCHED;
            PG8_STAGE(PG8_SB(0, 1), b2 + hstep, voffB);
            PG8_WAIT_V(6); PG8_BAR; PG8_MMA(1, 1, At, B1); PG8_BAR;
            PG8_LDB(B0, 1, 0); PG8_SCHED; PG8_LDA(At, 1, 0); PG8_STAGE(PG8_SA(0, 1), a2 + hstep, voffA);
            PG8_WAIT_L(8); PG8_BAR; PG8_WAIT_L(0); PG8_MMA(0, 0, At, B0); PG8_BAR; PG8_SCHED;
            PG8_LDB(B1, 1, 1); PG8_STAGE(PG8_SB(1, 0), b3, voffB);
            PG8_BAR; PG8_WAIT_L(0); PG8_MMA(0, 1, At, B1); PG8_BAR;
            PG8_LDA(At, 1, 1); PG8_STAGE(PG8_SA(1, 0), a3, voffA);
            PG8_BAR; PG8_WAIT_L(0); PG8_MMA(1, 0, At, B0); PG8_BAR; PG8_SCHED;
            PG8_STAGE(PG8_SB(1, 1), b3 + hstep, voffB);
            PG8_WAIT_V(6); PG8_BAR; PG8_MMA(1, 1, At, B1); PG8_BAR;
            }
        }
        if constexpr (ALIGN_EPI) { if (wr == 0) PG8_BAR; }
        if constexpr (!Epi::AFTER_DRAIN) { E(acc, cur, wr, wc, fr, fq); S.done(cur); }
        if (!has_next) break;
#pragma unroll
        for (int a = 0; a < 2; ++a)
#pragma unroll
            for (int b = 0; b < 2; ++b)
#pragma unroll
                for (int m = 0; m < 4; ++m)
#pragma unroll
                    for (int n = 0; n < 2; ++n) acc[a][b][m][n] = (f32x4){0.f, 0.f, 0.f, 0.f};
        cur = nxt; cA = nA; cB = nB; ++ui;
        if constexpr (GATHER) { _Pragma("unroll") for (int _h = 0; _h < 2; ++_h) { gA[_h][0] = gN[_h][0]; gA[_h][1] = gN[_h][1]; } }
        if constexpr (ALIGN_EPI) { if (wr == 1) PG8_BAR; }
    }
    PG8_WAIT_V(0);
    if constexpr (!ALIGN_EPI) { if (wr == 0) PG8_BAR; }
    PG8_BAR;
    if constexpr (Epi::AFTER_DRAIN) { E.fused(acc, cur, wr, wc, fr, fq, lds, wid, lane); S.done(cur); }
#undef PG8_SA
#undef PG8_SB
#undef PG8_STAGE
#undef PG8_STAGE_A
#undef PG8_GOFF
#undef PG8_LDA
#undef PG8_LDB
#undef PG8_MMA
#undef PG8_WAIT_V
#undef PG8_WAIT_L
#undef PG8_BAR
#undef PG8_SCHED
}
}
#define GAS __attribute__((address_space(1)))
#define LAS __attribute__((address_space(3)))
typedef unsigned short bf16;
typedef unsigned v4u __attribute__((ext_vector_type(4)));
typedef unsigned v2u __attribute__((ext_vector_type(2)));
typedef float f32x4 __attribute__((ext_vector_type(4)));
typedef short bf16x8 __attribute__((ext_vector_type(8)));
typedef GAS unsigned gu32;
typedef GAS unsigned long long gu64;
#define RLX_AGENT __ATOMIC_RELAXED, __HIP_MEMORY_SCOPE_AGENT
#define LDS_WAIT() asm volatile("s_waitcnt lgkmcnt(0)" ::: "memory")
#define VM_WAIT() asm volatile("s_waitcnt vmcnt(0)" ::: "memory")
typedef float f32x2_cv __attribute__((ext_vector_type(2)));
typedef __bf16 bf16x2_cv __attribute__((ext_vector_type(2)));
__device__ __forceinline__ unsigned pk2(float lo, float hi) { const f32x2_cv v = {lo, hi}; return __builtin_bit_cast(unsigned, __builtin_convertvector(v, bf16x2_cv)); }
__device__ __forceinline__ unsigned f2bf(float f) { return (unsigned)__builtin_bit_cast(unsigned short, (__bf16)f); }
__device__ __forceinline__ float bflo(unsigned w) { return __builtin_bit_cast(float, w << 16); }
__device__ __forceinline__ float bfhi(unsigned w) { return __builtin_bit_cast(float, w & 0xffff0000u); }
__device__ __forceinline__ float bf2f(bf16 b) { return __builtin_bit_cast(float, (unsigned)b << 16); }
__device__ __forceinline__ void unpack8(v4u w, float (&x)[8]) { x[0] = bflo(w.x); x[1] = bfhi(w.x); x[2] = bflo(w.y); x[3] = bfhi(w.y); x[4] = bflo(w.z); x[5] = bfhi(w.z); x[6] = bflo(w.w); x[7] = bfhi(w.w); }
__device__ __forceinline__ float wave_sum(float v) {
#pragma unroll
    for (int o = 1; o < 64; o <<= 1) v += __shfl_xor(v, o);
    return v;
}
__device__ __forceinline__ float sigmoidf_(float x) { return 1.f / (1.f + __expf(-x)); }

#define XB_TMO      128
#define XB_XCNT(j)  (256  + 64 * (j))
#define XB_XSUB(j)  (1280 + 64 * (j))
#define XB_XGEN(j)  (2304 + 64 * (j))
#define XB_TOP      3328
#define XB_TOPGEN   3392
#define XCD_BAR_WORDS 3456
#define XB_SPIN_CAP (1u << 22)

__device__ __forceinline__ unsigned xb_ld(unsigned* p)              { return __hip_atomic_load(p, __ATOMIC_RELAXED, __HIP_MEMORY_SCOPE_AGENT); }
__device__ __forceinline__ unsigned xb_add(unsigned* p, unsigned v) { return __hip_atomic_fetch_add(p, v, __ATOMIC_RELAXED, __HIP_MEMORY_SCOPE_AGENT); }
__device__ __forceinline__ unsigned xb_xcc_id() { return (unsigned)__builtin_amdgcn_s_getreg((3 << 11) | 20) & 0xFu; }
#define XB_SPIN(cond, bar) do { unsigned _sp = 0; while (cond) { __builtin_amdgcn_s_sleep(1); \
    if ((++_sp & 255u) == 0u) { if (xb_ld(&(bar)[XB_TMO])) break; if (_sp > XB_SPIN_CAP) { atomicAdd(&(bar)[XB_TMO], 1u); break; } } } } while (0)

struct XcdBarrier {
    unsigned* bar; unsigned x;
    volatile LAS unsigned* st;
};

__device__ __forceinline__ XcdBarrier xcd_barrier_post(unsigned* bar, volatile LAS unsigned* st) {
    XcdBarrier b; b.bar = bar; b.x = xb_xcc_id(); b.st = st;
    if (threadIdx.x == 0) (void)xb_add(&bar[XB_XCNT(b.x)], 1u);
    return b;
}
__device__ __forceinline__ void xcd_barrier_complete(unsigned* bar, unsigned x, unsigned& nloc, unsigned& nx) {
    const unsigned G = gridDim.x * gridDim.y * gridDim.z;
    unsigned sum, cnt, mine, sp = 0u;
    for (;;) {
        sum = 0u; cnt = 0u; mine = 0u;
#pragma unroll
        for (unsigned j = 0; j < 16; ++j) { const unsigned c = xb_ld(&bar[XB_XCNT(j)]); sum += c; cnt += (c > 0u) ? 1u : 0u; mine = (j == x) ? c : mine; }
        if (sum == G) break;
        __builtin_amdgcn_s_sleep(1);
        if ((++sp & 255u) == 0u) { if (xb_ld(&bar[XB_TMO])) break; if (sp > XB_SPIN_CAP) { atomicAdd(&bar[XB_TMO], 1u); break; } }
    }
    nloc = mine > 0u ? mine : 1u; nx = cnt > 0u ? cnt : 1u;
}

__device__ __forceinline__ void xcd_barrier(const XcdBarrier& b) {
    asm volatile("s_waitcnt vmcnt(0)" ::: "memory");
    __syncthreads();
    if (threadIdx.x == 0) {
        unsigned* bar = b.bar;
        __builtin_amdgcn_s_waitcnt(0);
        unsigned nloc = b.st[0], nx = b.st[1];
        if (nloc == 0u) { xcd_barrier_complete(bar, b.x, nloc, nx); b.st[0] = nloc; b.st[1] = nx; }
        const unsigned old = xb_add(&bar[XB_XSUB(b.x)], 1u);
        const unsigned gen = old / nloc;
        if (old + 1u == (gen + 1u) * nloc) {
            __builtin_amdgcn_fence(__ATOMIC_RELEASE, "agent");
            asm volatile("s_waitcnt vmcnt(0)" ::: "memory");
            const unsigned og = xb_add(&bar[XB_TOP], 1u);
            const unsigned tg = og / nx;
            if (og + 1u == (tg + 1u) * nx) xb_add(&bar[XB_TOPGEN], 1u);
            else XB_SPIN(xb_ld(&bar[XB_TOPGEN]) == tg, bar);
            __builtin_amdgcn_fence(__ATOMIC_ACQUIRE, "agent");
            xb_add(&bar[XB_XGEN(b.x)], 1u);
            asm volatile("s_waitcnt vmcnt(0)" ::: "memory");
        } else {
            XB_SPIN(xb_ld(&bar[XB_XGEN(b.x)]) == gen, bar);
            __builtin_amdgcn_fence(__ATOMIC_ACQUIRE, "agent");
            asm volatile("s_waitcnt vmcnt(0)" ::: "memory");
        }
    }
    __syncthreads();
}
namespace att {
using s16x4  = __attribute__((ext_vector_type(4))) short;
using f32x16 = __attribute__((ext_vector_type(16))) float;
using u32x4  = __attribute__((ext_vector_type(4))) unsigned;
#define ATT_SBAR() __builtin_amdgcn_sched_barrier(0)
constexpr float THR2 = 11.5f;
__device__ __forceinline__ int crow(int r, int hi) { return (r & 3) + 8 * (r >> 2) + 4 * hi; }
__device__ __forceinline__ unsigned cvtpk(float lo, float hi) { unsigned r; asm volatile("v_cvt_pk_bf16_f32 %0, %1, %2" : "=v"(r) : "v"(lo), "v"(hi)); return r; }

__device__ __forceinline__ void partialSM(f32x16& p0, f32x16& p1, float& m_reg, float& mn, float& alpha) {
  float pmax = p0[0];
#pragma unroll
  for (int r = 1; r < 16; ++r) pmax = fmaxf(pmax, p0[r]);
#pragma unroll
  for (int r = 0; r < 16; ++r) pmax = fmaxf(pmax, p1[r]);
  { auto rr = __builtin_amdgcn_permlane32_swap(__float_as_uint(pmax), __float_as_uint(pmax), false, false);
    pmax = fmaxf(__uint_as_float(rr[0]), __uint_as_float(rr[1])); }
  if (__builtin_expect(__all(pmax - m_reg <= THR2), 1)) { mn = m_reg; alpha = 1.f; }
  else { mn = fmaxf(m_reg, pmax); alpha = __builtin_amdgcn_exp2f(m_reg - mn); m_reg = mn; }
#pragma unroll
  for (int r = 0; r < 16; ++r) p0[r] = p0[r] - mn;
#pragma unroll
  for (int r = 0; r < 16; ++r) p1[r] = p1[r] - mn;
#pragma unroll
  for (int r = 0; r < 16; ++r) p0[r] = __builtin_amdgcn_exp2f(p0[r]);
}
__device__ __forceinline__ void finishSM(f32x16& p0, f32x16& p1, bf16x8& pa0, bf16x8& pa1, bf16x8& pa2, bf16x8& pa3) {
#pragma unroll
  for (int r = 0; r < 16; ++r) p1[r] = __builtin_amdgcn_exp2f(p1[r]);
#define ATT_PK4(P, BASE, OUT) do { unsigned a0 = cvtpk(P[BASE + 0], P[BASE + 1]), a1 = cvtpk(P[BASE + 2], P[BASE + 3]);   \
    unsigned b0 = cvtpk(P[BASE + 4], P[BASE + 5]), b1 = cvtpk(P[BASE + 6], P[BASE + 7]);                              \
    auto r0 = __builtin_amdgcn_permlane32_swap(a0, b0, false, false); auto r1 = __builtin_amdgcn_permlane32_swap(a1, b1, false, false); \
    u32x4 w = {r0[0], r1[0], r0[1], r1[1]}; OUT = *reinterpret_cast<bf16x8*>(&w); } while (0)
  ATT_PK4(p0, 0, pa0); ATT_PK4(p0, 8, pa1); ATT_PK4(p1, 0, pa2); ATT_PK4(p1, 8, pa3);
#undef ATT_PK4
}
template <int NB> __device__ __forceinline__ int v_st(int k, int c) { const int kk = (k & ~0xC) | ((k & 4) << 1) | ((k & 8) >> 1); return ((kk >> 3) * NB + (c >> 5)) * 512 + ((kk & 7) * 32 + (c & 31)) * 2; }
__device__ __forceinline__ int v_rd_base(int lane) { return ((lane & 3) << 3) | (((lane >> 2) & 3) << 6) | (((lane >> 4) & 1) << 5) | (((lane >> 5) & 1) << 8); }
template <int OFF> __device__ __forceinline__ s16x4 tr_read(int vb) {
  s16x4 r; asm volatile("ds_read_b64_tr_b16 %0, %1 offset:%2" : "=&v"(r) : "v"(vb), "i"(OFF) : "memory"); return r;
}
template <int NB, int D0> __device__ __forceinline__ void pv_rd(s16x4 (&f)[8], int vb) {
#define ATT_VOFF(ks, half) (D0 * 512 + (ks) * (NB * 1024) + (half) * (NB * 512))
  f[0] = tr_read<ATT_VOFF(0, 0)>(vb); f[1] = tr_read<ATT_VOFF(0, 1)>(vb); f[2] = tr_read<ATT_VOFF(1, 0)>(vb); f[3] = tr_read<ATT_VOFF(1, 1)>(vb);
  f[4] = tr_read<ATT_VOFF(2, 0)>(vb); f[5] = tr_read<ATT_VOFF(2, 1)>(vb); f[6] = tr_read<ATT_VOFF(3, 0)>(vb); f[7] = tr_read<ATT_VOFF(3, 1)>(vb);
#undef ATT_VOFF
}
__device__ __forceinline__ void pv_mm(f32x16& od, const s16x4 (&f)[8], bf16x8 pa0, bf16x8 pa1, bf16x8 pa2, bf16x8 pa3) {
#define ATT_PK(L, H) (bf16x8){L[0], L[1], L[2], L[3], H[0], H[1], H[2], H[3]}
  od = __builtin_amdgcn_mfma_f32_32x32x16_bf16(pa0, ATT_PK(f[0], f[1]), od, 0, 0, 0);
  od = __builtin_amdgcn_mfma_f32_32x32x16_bf16(pa1, ATT_PK(f[2], f[3]), od, 0, 0, 0);
  od = __builtin_amdgcn_mfma_f32_32x32x16_bf16(pa2, ATT_PK(f[4], f[5]), od, 0, 0, 0);
  od = __builtin_amdgcn_mfma_f32_32x32x16_bf16(pa3, ATT_PK(f[6], f[7]), od, 0, 0, 0);
#undef ATT_PK
}
#define ATT_LWAIT(n) do { asm volatile("s_waitcnt lgkmcnt(" #n ")" ::: "memory"); ATT_SBAR(); } while (0)
template <int NB> __device__ __forceinline__ void pv_all(f32x16* o, f32x16& lsum, int vb, bf16x8 pa0, bf16x8 pa1, bf16x8 pa2, bf16x8 pa3) {
  const bf16x8 ones = {0x3F80, 0x3F80, 0x3F80, 0x3F80, 0x3F80, 0x3F80, 0x3F80, 0x3F80};
  s16x4 fa[8], fb[8];
  pv_rd<NB, 0>(fa, vb); pv_rd<NB, 1>(fb, vb);
  lsum = __builtin_amdgcn_mfma_f32_32x32x16_bf16(pa0, ones, lsum, 0, 0, 0); lsum = __builtin_amdgcn_mfma_f32_32x32x16_bf16(pa1, ones, lsum, 0, 0, 0);
  lsum = __builtin_amdgcn_mfma_f32_32x32x16_bf16(pa2, ones, lsum, 0, 0, 0); lsum = __builtin_amdgcn_mfma_f32_32x32x16_bf16(pa3, ones, lsum, 0, 0, 0);
  ATT_LWAIT(8); pv_mm(o[0], fa, pa0, pa1, pa2, pa3);
  if constexpr (NB == 4) {
    pv_rd<NB, 2>(fa, vb); ATT_LWAIT(8); pv_mm(o[1], fb, pa0, pa1, pa2, pa3);
    pv_rd<NB, 3>(fb, vb); ATT_LWAIT(8); pv_mm(o[2], fa, pa0, pa1, pa2, pa3);
    ATT_LWAIT(0); pv_mm(o[3], fb, pa0, pa1, pa2, pa3);
  } else { ATT_LWAIT(0); pv_mm(o[1], fb, pa0, pa1, pa2, pa3); }
}
template <int DK> __device__ __forceinline__ void qkt(f32x16& p0, f32x16& p1, LAS const char* Ks, const bf16x8* qr, int r32, int hi) {
  constexpr int KSTR = DK * 2 + 16;
  p0 = f32x16{}; p1 = f32x16{};
#pragma unroll
  for (int d0 = 0; d0 < DK / 16; ++d0) { const int cb = (d0 * 16 + hi * 8) * 2;
    const bf16x8 b0 = *(LAS const bf16x8*)(Ks + r32 * KSTR + cb);
    const bf16x8 b1 = *(LAS const bf16x8*)(Ks + (32 + r32) * KSTR + cb);
    p0 = __builtin_amdgcn_mfma_f32_32x32x16_bf16(b0, qr[d0], p0, 0, 0, 0);
    p1 = __builtin_amdgcn_mfma_f32_32x32x16_bf16(b1, qr[d0], p1, 0, 0, 0); }
}
template <int DK, int DV> struct Cfg {
  static constexpr int KSTR = DK * 2 + 16, KT = 64 * KSTR, NB = DV / 32, VT = 64 * DV * 2, NQ = DK / 16;
  static constexpr int NKC = DK / 8, NVC = DV / 8;
  static constexpr int KN = (64 * NKC + 511) / 512, VN = (64 * NVC + 511) / 512;
  static constexpr int OFF_V = 0, OFF_K = 2 * VT, OFF_WS = 2 * VT + 2 * KT, LDS_BYTES = OFF_WS + 8 * 64 * 4;
};
template <int DK, int DV>
__device__ __forceinline__ void attn_unit(const bf16* __restrict__ Qb, int ldq, const bf16* __restrict__ K1, int ldk1, const bf16* __restrict__ K2, int ldk2,
                                          const bf16* __restrict__ Vh, int ldv, float* __restrict__ Ob, int ldo, int nkeys, LAS char* lds) {
  using C = Cfg<DK, DV>;
  const int tid = threadIdx.x, wid = tid >> 6, lane = tid & 63, r32 = lane & 31, hi = lane >> 5;
  LAS char* V_lds = lds + C::OFF_V; LAS char* K_lds = lds + C::OFF_K;
  LAS float* ws = (LAS float*)(lds + C::OFF_WS) + wid * 64; LAS float* li_l = ws; LAS float* al_l = ws + 32;
  float m_reg = -1e30f; f32x16 o[C::NB] = {}; f32x16 lsum = {}; bf16x8 qr[C::NQ];
  { const bf16* Qw = Qb + (long)(wid * 32 + r32) * ldq + hi * 8;
#pragma unroll
    for (int d0 = 0; d0 < C::NQ; ++d0) qr[d0] = *(const bf16x8*)(Qw + d0 * 16); }
  unsigned kg[C::KN], kw[C::KN], vg[C::VN], vw[C::VN]; const bool k2val = tid < 256;
  kg[0] = (unsigned)((tid >> 3) * ldk1 + (tid & 7) * 8); kw[0] = (unsigned)((tid >> 3) * C::KSTR + (tid & 7) * 16);
  if constexpr (C::KN == 2) { const int t2 = tid & 255; kg[1] = (unsigned)((t2 >> 2) * ldk2 + (t2 & 3) * 8); kw[1] = (unsigned)((t2 >> 2) * C::KSTR + (8 + (t2 & 3)) * 16); }
#pragma unroll
  for (int i = 0; i < C::VN; ++i) { const int it = tid + 512 * i, vrow = it / C::NVC, vcol = (it % C::NVC) * 8; vg[i] = (unsigned)(vrow * ldv + vcol); vw[i] = (unsigned)v_st<C::NB>(vrow, vcol); }
  const int vb0 = (int)(uintptr_t)V_lds + v_rd_base(lane);
  struct Slot { bf16x8 ks[C::KN], vs[C::VN]; } sS;
#define ATT_SLOAD(S, k0) do { S.ks[0] = *(const bf16x8*)(K1 + (size_t)(k0) * ldk1 + kg[0]); if constexpr (C::KN == 2) S.ks[1] = *(const bf16x8*)(K2 + (size_t)(k0) * ldk2 + kg[1]); \
    _Pragma("unroll") for (int i = 0; i < C::VN; ++i) S.vs[i] = *(const bf16x8*)(Vh + (size_t)(k0) * ldv + vg[i]); } while (0)
#define ATT_SWRITE(b, S) do { *(LAS bf16x8*)(K_lds + (b) * C::KT + kw[0]) = S.ks[0]; if constexpr (C::KN == 2) { if (k2val) *(LAS bf16x8*)(K_lds + (b) * C::KT + kw[1]) = S.ks[1]; } \
    _Pragma("unroll") for (int i = 0; i < C::VN; ++i) *(LAS bf16x8*)(V_lds + (b) * C::VT + vw[i]) = S.vs[i]; } while (0)
#define ATT_SWAIT() asm volatile("s_waitcnt vmcnt(0)" ::: "memory")
#define ATT_RESC(a) do { if (__any((a) < 1.f)) { if (hi == 0) al_l[r32] = (a); asm volatile("s_waitcnt lgkmcnt(0)" ::: "memory"); \
    _Pragma("unroll") for (int r = 0; r < 16; ++r) { const float f_ = al_l[crow(r, hi)]; lsum[r] *= f_; _Pragma("unroll") for (int d = 0; d < C::NB; ++d) o[d][r] *= f_; } } } while (0)
  static_assert(C::KN + C::VN == 3, "three staging loads per thread per tile (ATT_SWAIT)");
  f32x16 pA0, pA1, pB0, pB1; float mnA, mnB, alA, alB; bf16x8 pa0, pa1, pa2, pa3; const int NT = nkeys / 64;
  __syncthreads();
  ATT_SLOAD(sS, 0); asm volatile("s_waitcnt vmcnt(0)" ::: "memory"); ATT_SWRITE(0, sS); __syncthreads();
  qkt<DK>(pA0, pA1, K_lds, qr, r32, hi); partialSM(pA0, pA1, m_reg, mnA, alA);
  ATT_SLOAD(sS, 64);
  ATT_SWAIT(); ATT_SWRITE(1, sS); __syncthreads();
  for (int j = 1; j + 1 < NT; j += 2) {
    ATT_SBAR(); qkt<DK>(pB0, pB1, K_lds + C::KT, qr, r32, hi);
    finishSM(pA0, pA1, pa0, pa1, pa2, pa3); ATT_SBAR();
    ATT_SLOAD(sS, (j + 1) * 64); ATT_SBAR();
    pv_all<C::NB>(o, lsum, vb0, pa0, pa1, pa2, pa3); partialSM(pB0, pB1, m_reg, mnB, alB);
    __syncthreads(); ATT_SWAIT(); ATT_SWRITE(0, sS);
    ATT_RESC(alB); __syncthreads();
    ATT_SBAR(); qkt<DK>(pA0, pA1, K_lds, qr, r32, hi);
    finishSM(pB0, pB1, pa0, pa1, pa2, pa3); ATT_SBAR();
    ATT_SLOAD(sS, (j + 2) * 64); ATT_SBAR();
    pv_all<C::NB>(o, lsum, vb0 + C::VT, pa0, pa1, pa2, pa3); partialSM(pA0, pA1, m_reg, mnA, alA);
    __syncthreads(); ATT_SWAIT(); ATT_SWRITE(1, sS);
    ATT_RESC(alA); __syncthreads();
  }
  ATT_SBAR(); qkt<DK>(pB0, pB1, K_lds + C::KT, qr, r32, hi);
  finishSM(pA0, pA1, pa0, pa1, pa2, pa3); ATT_SBAR();
  pv_all<C::NB>(o, lsum, vb0, pa0, pa1, pa2, pa3); partialSM(pB0, pB1, m_reg, mnB, alB);
  __syncthreads(); ATT_RESC(alB);
  finishSM(pB0, pB1, pa0, pa1, pa2, pa3); ATT_SBAR();
  pv_all<C::NB>(o, lsum, vb0 + C::VT, pa0, pa1, pa2, pa3);
  float rli[16];
#pragma unroll
  for (int r = 0; r < 16; ++r) rli[r] = __builtin_amdgcn_rcpf(lsum[r]);
  float* Ow = Ob + (long)(wid * 32) * ldo;
#pragma unroll
  for (int r = 0; r < 16; ++r) { const int orow = crow(r, hi);
#pragma unroll
    for (int d0 = 0; d0 < C::NB; ++d0) Ow[(long)orow * ldo + d0 * 32 + r32] = o[d0][r] * rli[r]; }
#undef ATT_SLOAD
#undef ATT_SWRITE
#undef ATT_SWAIT
#undef ATT_RESC
}
}
constexpr int DM = 1024, NBATCH = 2, SEQ = 16384, CT = 256, TB = SEQ + CT  , R = NBATCH * TB  ;
constexpr int ATT_IN = 2208, ATT_NP = 2304, REC_IN = 3472, REC_NP = 3584, RWKV_IN = 1920;
constexpr int NE = 32, TOPK = 4, MAXT = R * TOPK / 256 + NE  , MAXROWS = MAXT * 256;
constexpr int NUNIT_M = 16 * 260;
constexpr float NORM_EPS = 1e-6f;
enum { I_X = 0, I_C, I_CTX, I_CCTX, I_NMIX, I_NFFN, I_ADAW, I_ADAB, I_WOUT, I_RW, I_RB, I_W1, I_B1, I_W2, I_B2, I_ATTW, I_LAM, I_SUBLN, I_QNW, I_KVNW, I_WUQ, I_WUKV,
       I_RECW, I_MU, I_W0, I_RW2, I_A0, I_A2, I_G2, I_KK, I_KA, I_RK, I_LNW, I_LNB, I_GATEB, I_MNW, I_FNW, N_IN };
constexpr size_t al256(size_t x) { return (x + 255) & ~(size_t)255; }
constexpr size_t WS_CTL = 0, CTL_ZERO_BYTES = 1u << 20;
constexpr size_t WS_MOD = CTL_ZERO_BYTES;
constexpr size_t WS_ROPE = al256(WS_MOD + 2 * 3 * 6144 * 4);
constexpr size_t ROPE_DR = 0, ROPE_DC = 256 * 16 * 2, ROPE_MR = ROPE_DC + 64 * 16 * 2, ROPE_MC = ROPE_MR + 256 * 8 * 2, ROPE_FLOATS = ROPE_MC + 64 * 8 * 2;
constexpr size_t WS_WRH = al256(WS_ROPE + ROPE_FLOATS * 4);
constexpr size_t WS_WRL = al256(WS_WRH + (size_t)2 * 32 * 1024 * 2);
constexpr size_t WS_WIN0 = al256(WS_WRL + (size_t)2 * 32 * 1024 * 2);
constexpr size_t WS_WUQ = al256(WS_WIN0 + (size_t)ATT_NP * 1024 * 2);
constexpr size_t WS_WUKV = al256(WS_WUQ + (size_t)768 * 384 * 2);
constexpr size_t WS_WOUT = al256(WS_WUKV + (size_t)1024 * 256 * 2);
constexpr size_t WS_WREC = al256(WS_WOUT + (size_t)2 * 1024 * 1024 * 2);
constexpr size_t WS_WLORA = al256(WS_WREC + (size_t)REC_NP * 1024 * 2);
constexpr size_t WS_W1T = al256(WS_WLORA + (size_t)2560 * 384 * 2);
constexpr size_t WS_W2T = al256(WS_W1T + (size_t)NE * 2048 * 1024 * 2);
constexpr size_t WS_H = al256(WS_W2T + (size_t)NE * 1024 * 1024 * 2);
constexpr size_t WS_A = al256(WS_H + (size_t)R * 1024 * 4);
constexpr size_t WS_A1 = al256(WS_A + (size_t)R * 1024 * 2);
constexpr size_t WS_F = al256(WS_A1 + (size_t)R * 1024 * 2);
constexpr size_t WS_P = al256(WS_F + (size_t)R * 1024 * 2);
constexpr size_t WS_TOPE = al256(WS_P + (size_t)R * REC_NP * 2);
constexpr size_t WS_GATE = al256(WS_TOPE + (size_t)R * 16);
constexpr size_t WS_POS = al256(WS_GATE + (size_t)R * 16);
constexpr size_t WS_DEST = al256(WS_POS + (size_t)R * 16);
constexpr size_t WS_TILE = al256(WS_DEST + (size_t)R * 16);
constexpr size_t WS_SRC = al256(WS_TILE + (size_t)(MAXT + 8) * 4);
constexpr size_t WS_T = al256(WS_SRC + (size_t)MAXROWS * 4);
constexpr size_t WS_QD = WS_T;
constexpr size_t WS_KD = al256(WS_QD + (size_t)R * 512 * 2);
constexpr size_t WS_CQN = al256(WS_KD + (size_t)R * 512 * 2);
constexpr size_t WS_CKVN = al256(WS_CQN + (size_t)R * 384 * 2);
constexpr size_t WS_MQ = al256(WS_CKVN + (size_t)R * 256 * 2);
constexpr size_t WS_MKV = al256(WS_MQ + (size_t)R * 768 * 2);
constexpr size_t WS_KRR = al256(WS_MKV + (size_t)R * 1024 * 2);
constexpr size_t WS_ODIFF = al256(WS_KRR + (size_t)R * 32 * 2);
constexpr size_t WS_OMLA = al256(WS_ODIFF + (size_t)R * 1024 * 4);
constexpr size_t WS_T0_END = al256(WS_OMLA + (size_t)R * 512 * 4);
constexpr size_t WS_XS = WS_T;
constexpr size_t WS_HS = al256(WS_XS + (size_t)MAXROWS * 1024 * 2);
constexpr size_t WS_TM_END = al256(WS_HS + (size_t)MAXROWS * 1024 * 2);
constexpr size_t SZ_RC = (size_t)R * 512 * 4;
constexpr size_t WS_RR = WS_T, WS_VV = WS_RR + SZ_RC, WS_AKK = WS_VV + SZ_RC, WS_KL = WS_AKK + SZ_RC;
constexpr size_t WS_WDEC = WS_KL + SZ_RC  , WS_KDIR = WS_WDEC + 2 * SZ_RC  , WS_BB = WS_KDIR + 2 * SZ_RC  , WS_GG = WS_BB + 2 * SZ_RC;
constexpr size_t WS_ALORA = al256(WS_GG + SZ_RC);
constexpr size_t WS_YR = al256(WS_ALORA + (size_t)R * 384 * 2);
constexpr size_t WS_DC = WS_YR;
constexpr size_t WS_HM = al256(WS_YR + 2 * SZ_RC);
constexpr size_t WS_CST = al256(WS_HM + 2 * SZ_RC);
constexpr size_t WS_DN = al256(WS_CST + (size_t)NUNIT_M * 8192 * 4);
constexpr size_t WS_NST = al256(WS_DN + (size_t)NUNIT_M * 64 * 4);
constexpr size_t WS_SC = al256(WS_NST + (size_t)NUNIT_M * 64 * 4);
constexpr size_t WS_MST = al256(WS_SC + (size_t)NUNIT_M * 2 * 4);
constexpr size_t WS_ASIG = WS_KDIR;
constexpr size_t WS_YB = WS_BB;
constexpr int NUNIT_R = 32 * 260;
constexpr size_t WS_RKM = WS_KDIR + SZ_RC;
static_assert((size_t)NUNIT_R * 4096 * 2 <= SZ_RC, "M^T fits in KL");
constexpr size_t WS_RKQ = al256(WS_MST + (size_t)NUNIT_M * 4);
constexpr size_t WS_RKZ = al256(WS_RKQ + (size_t)NUNIT_R * 4096 * 2);
constexpr size_t WS_T1_END = al256(WS_RKZ + (size_t)NUNIT_R * 4096 * 2);
constexpr size_t WS_END = WS_T1_END > WS_TM_END ? (WS_T1_END > WS_T0_END ? WS_T1_END : WS_T0_END) : (WS_TM_END > WS_T0_END ? WS_TM_END : WS_T0_END);
static_assert(WS_END <= (size_t)2147483648ull, "workspace map exceeds 2 GiB");
constexpr int CW_CNT = 1024;
constexpr int CW_BAR = 4096;
constexpr int RING_BYTES = 131072, AUX_OFF = 131072, AUX_BYTES = 16384, MISC_OFF = 147456, LDS_BYTES = 163840;

struct Frame {
    LAS unsigned char* lds; gu32* ctl; int tid, lane, wave, blk, G, probe;
    float* out; unsigned char* ws;
    struct InTab { LAS const unsigned* t;
        __device__ __forceinline__ const float* operator[](int i) const { const unsigned lo = __builtin_amdgcn_readfirstlane(t[2 * i]), hi = __builtin_amdgcn_readfirstlane(t[2 * i + 1]);
            return (const float*)(((unsigned long long)hi << 32) | lo); } } in;
};
template <class T> __device__ __forceinline__ T* wsp(const Frame& F, size_t off) { return (T*)(F.ws + off); }
__device__ __forceinline__ int row_sel(int row) { const int b = row / TB, t = row - b * TB; return t < CT ? 2 : b; }
__device__ __forceinline__ const float* h0_row(const Frame& F, int row) {
    const int b = row / TB, t = row - b * TB;
    return t < CT ? F.in[I_CTX] + ((size_t)b * CT + t) * DM : F.in[I_X] + ((size_t)b * SEQ + (t - CT)) * DM;
}
__device__ __forceinline__ const float* modp(const Frame& F, int layer, int sel, int chunk) { return wsp<const float>(F, WS_MOD) + ((size_t)(layer * 3 + sel) * 6 + chunk) * DM; }
__device__ __forceinline__ int scan_tok(int z, int sg) { return z == 0 ? sg : (sg < CT ? CT - 1 - sg : TB + CT - 1 - sg); }
__device__ __forceinline__ void tr_item(const float* W, int K, int N, bf16* WT, int row_off, LAS float* scr, int kb, int nb, int lane) {
    const int k0 = 64 * kb, n0 = 32 * nb;
    const int n = n0 + (lane & 31);
    float tv[32];
#pragma unroll
    for (int i = 0; i < 32; ++i) { const int kk = 2 * i + (lane >> 5); tv[i] = (n < N) ? W[(size_t)(k0 + kk) * N + n] : 0.f; }
#pragma unroll
    for (int i = 0; i < 32; ++i) { const int kk = 2 * i + (lane >> 5); scr[kk * 33 + (lane & 31)] = tv[i]; }
    LDS_WAIT(); asm volatile("" ::: "memory");
    const int c = lane & 7;
#pragma unroll
    for (int j = 0; j < 4; ++j) { const int nn = (lane >> 3) + 8 * j; const LAS float* s = scr + (8 * c) * 33 + nn;
        v4u o; o.x = pk2(s[0 * 33], s[1 * 33]); o.y = pk2(s[2 * 33], s[3 * 33]); o.z = pk2(s[4 * 33], s[5 * 33]); o.w = pk2(s[6 * 33], s[7 * 33]);
        *(v4u*)(WT + (size_t)(row_off + n0 + nn) * K + k0 + 8 * c) = o; }
    LDS_WAIT(); asm volatile("" ::: "memory");
}
__device__ __forceinline__ void tr_family(const Frame& F, const float* W, size_t src_stride, int nmat, int K, int N, int Npad, bf16* WT, int gw, int NGW) {
    LAS float* scr = (LAS float*)(F.lds + F.wave * 16384);
    const int nkb = K / 64, nnb = Npad / 32, per = nkb * nnb, total = per * nmat;
    for (int it = gw; it < total; it += NGW) { const int m = it / per, r = it - m * per, kb = r / nnb, nb = r - kb * nnb;
        tr_item(W + (size_t)m * src_stride, K, N, WT, m * Npad, scr, kb, nb, F.lane); }
}
__device__ __forceinline__ void moe_weights_convert(const Frame& F, int layer, int gw, int NGW) {
    tr_family(F, F.in[I_W1] + (size_t)layer * NE * 1024 * 2048, (size_t)1024 * 2048, NE, 1024, 2048, 2048, wsp<bf16>(F, WS_W1T), gw, NGW);
    tr_family(F, F.in[I_W2] + (size_t)layer * NE * 1024 * 1024, (size_t)1024 * 1024, NE, 1024, 1024, 1024, wsp<bf16>(F, WS_W2T), gw, NGW);
}
__device__ __forceinline__ void norm_mod_row(const Frame& F, const float* src, const float* nw, const float* shift, const float* scale, bf16* orow) {
    const f32x4* xr = (const f32x4*)src + F.lane;
    f32x4 v[4]; float s = 0.f;
#pragma unroll
    for (int j = 0; j < 4; ++j) { v[j] = xr[64 * j]; s += (v[j].x * v[j].x + v[j].y * v[j].y) + (v[j].z * v[j].z + v[j].w * v[j].w); }
    const float rs = 1.f / sqrtf(wave_sum(s) * (1.f / DM) + NORM_EPS);
    unsigned long long* o8 = (unsigned long long*)orow + F.lane;
#pragma unroll
    for (int j = 0; j < 4; ++j) { const f32x4 w = ((const f32x4*)nw)[F.lane + 64 * j], sh = ((const f32x4*)shift)[F.lane + 64 * j], sc = ((const f32x4*)scale)[F.lane + 64 * j];
        const f32x4 y = v[j] * rs * w * (sc + 1.f) + sh;
        o8[64 * j] = (unsigned long long)pk2(y.x, y.y) | ((unsigned long long)pk2(y.z, y.w) << 32); }
}
__device__ __forceinline__ void p0a(const Frame& F) {
    LAS float* sv = (LAS float*)F.lds; LAS float* red = (LAS float*)(F.lds + 16384);
    for (int i = F.tid; i < 3 * DM; i += 512) { const int s = i / DM, k = i - s * DM; const float cv = (s < 2) ? F.in[I_C][s * DM + k] : F.in[I_CCTX][k]; sv[i] = cv / (1.f + __expf(-cv)); }
    __syncthreads();
    for (int it = F.blk; it < 192; it += F.G) {
        const int l = it / 96, cgp = it - l * 96, kq = F.tid >> 4, cg = F.tid & 15, col = cgp * 64 + cg * 4;
        float acc[3][4];
#pragma unroll
        for (int s = 0; s < 3; ++s)
#pragma unroll
            for (int j = 0; j < 4; ++j) acc[s][j] = 0.f;
        const float* W = F.in[I_ADAW] + (size_t)l * DM * 6144 + col;
#pragma unroll 16
        for (int kk = 0; kk < 32; ++kk) { const int k = kq * 32 + kk; const f32x4 w = *(const f32x4*)(W + (size_t)k * 6144);
            const float s0 = sv[k], s1 = sv[DM + k], s2 = sv[2 * DM + k];
#pragma unroll
            for (int j = 0; j < 4; ++j) { acc[0][j] += s0 * w[j]; acc[1][j] += s1 * w[j]; acc[2][j] += s2 * w[j]; } }
#pragma unroll
        for (int s = 0; s < 3; ++s)
#pragma unroll
            for (int j = 0; j < 4; ++j) red[(kq * 16 + cg) * 12 + s * 4 + j] = acc[s][j];
        __syncthreads();
        if (F.tid < 192) { const int s = F.tid / 64, cc = F.tid - s * 64, cg2 = cc >> 2, j = cc & 3; float t = 0.f;
            for (int q = 0; q < 32; ++q) t += red[(q * 16 + cg2) * 12 + s * 4 + j];
            wsp<float>(F, WS_MOD)[(size_t)(l * 3 + s) * 6144 + cgp * 64 + cc] = t + F.in[I_ADAB][l * 6144 + cgp * 64 + cc]; }
        __syncthreads();
    }
    const int gid = F.blk * 512 + F.tid, GT = F.G * 512;
    float* rope = wsp<float>(F, WS_ROPE);
    for (int i = gid; i < 256 * 16 + 64 * 16 + 256 * 8 + 64 * 8; i += GT) {
        int j = i; float pos, inv; size_t off;
        if (j < 256 * 16) { pos = (float)(j / 16); inv = powf(10000.f, -(float)(j % 16) / 16.f); off = ROPE_DR + (size_t)j * 2; }
        else if ((j -= 256 * 16) < 64 * 16) { pos = (float)(j / 16); inv = powf(10000.f, -(float)(j % 16) / 16.f); off = ROPE_DC + (size_t)j * 2; }
        else if ((j -= 64 * 16) < 256 * 8) { pos = (float)(j / 8); inv = powf(10000.f, -(float)(j % 8) / 8.f); off = ROPE_MR + (size_t)j * 2; }
        else { j -= 256 * 8; pos = (float)(j / 8); inv = powf(10000.f, -(float)(j % 8) / 8.f); off = ROPE_MC + (size_t)j * 2; }
        const float ang = pos * inv; rope[off] = cosf(ang); rope[off + 1] = sinf(ang);
    }
    { bf16* wh = wsp<bf16>(F, WS_WRH); bf16* wl = wsp<bf16>(F, WS_WRL); for (int i = gid; i < 2 * 32 * 1024; i += GT) { const int k = i & 1023, e = (i >> 10) & 31, l = i >> 15; const float wv = F.in[I_RW][((size_t)l * DM + k) * NE + e];
        const unsigned hb = f2bf(wv); wh[i] = (bf16)hb; wl[i] = (bf16)f2bf(wv - bf2f((bf16)hb)); } }
    bf16* WL = wsp<bf16>(F, WS_WLORA);
    for (int i = gid; i < 2560 * 384; i += GT) { const int n = i / 384, k = i - n * 384, part = n >> 9, c = n & 511; float v = 0.f;
        if (part < 2) { if ((k >> 6) == part) v = F.in[I_RW2][((size_t)part * 64 + (k & 63)) * 512 + c]; }
        else if (part < 4) { if ((k >> 6) == part) v = F.in[I_A2][((size_t)(part - 2) * 64 + (k & 63)) * 512 + c]; }
        else { if (k >= 256) v = F.in[I_G2][(size_t)(k - 256) * 512 + c]; }
        WL[i] = (bf16)f2bf(v); }
    const int gw = F.blk * 8 + F.wave, NGW = F.G * 8;
    tr_family(F, F.in[I_ATTW], 0, 1, 1024, ATT_IN, ATT_NP, wsp<bf16>(F, WS_WIN0), gw, NGW);
    tr_family(F, F.in[I_WUQ], 0, 1, 384, 768, 768, wsp<bf16>(F, WS_WUQ), gw, NGW);
    tr_family(F, F.in[I_WUKV], 0, 1, 256, 1024, 1024, wsp<bf16>(F, WS_WUKV), gw, NGW);
    tr_family(F, F.in[I_WOUT], (size_t)1024 * 1024, 2, 1024, 1024, 1024, wsp<bf16>(F, WS_WOUT), gw, NGW);
    tr_family(F, F.in[I_RECW], 0, 1, 1024, REC_IN, REC_NP, wsp<bf16>(F, WS_WREC), gw, NGW);
    moe_weights_convert(F, 0, gw, NGW);
}
__device__ __forceinline__ void p0b(const Frame& F) {
    const int gw = F.blk * 8 + F.wave, NGW = F.G * 8;
    for (int row = gw; row < R; row += NGW) { const int sel = row_sel(row);
        norm_mod_row(F, h0_row(F, row), F.in[I_NMIX], modp(F, 0, sel, 0), modp(F, 0, sel, 1), wsp<bf16>(F, WS_A) + (size_t)row * DM); }
}
struct FnStoreBf16 {
    bf16* O; int ldc;
    __device__ __forceinline__ void operator()(int row, int col, f32x4 v0, f32x4 v1) const {
        v4u w; w.x = pg8::cvt_pk_bf16(v0[0], v0[1]); w.y = pg8::cvt_pk_bf16(v0[2], v0[3]); w.z = pg8::cvt_pk_bf16(v1[0], v1[1]); w.w = pg8::cvt_pk_bf16(v1[2], v1[3]);
        *(v4u*)(O + (size_t)row * ldc + col) = w; }
};
struct FnWout {
    const Frame* F; int layer;
    __device__ __forceinline__ void operator()(int row, int col, f32x4 v0, f32x4 v1) const {
        float* hrow = wsp<float>(*F, WS_H) + (size_t)row * DM + col;
        const float* base = (layer == 0) ? h0_row(*F, row) + col : hrow;
        const float* g = modp(*F, layer, row_sel(row), 2) + col;
        const f32x4 b0 = *(const f32x4*)base, b1 = *(const f32x4*)(base + 4), g0 = *(const f32x4*)g, g1 = *(const f32x4*)(g + 4);
        *(f32x4*)hrow = b0 + g0 * v0; *(f32x4*)(hrow + 4) = b1 + g1 * v1; }
};
__device__ __forceinline__ void l0_post_proj(const Frame& F) {
    const int gw = F.blk * 8 + F.wave, NGW = F.G * 8, lane = F.lane;
    const bf16* P = wsp<const bf16>(F, WS_P); const float* rope = wsp<const float>(F, WS_ROPE);
    constexpr float CD = 0.125f * 1.4426950408889634f;
    for (int row = gw; row < R; row += NGW) {
        const int b = row / TB, t = row - b * TB; const bool lat = t >= CT; const int pos = t - CT, prow = lat ? pos >> 6 : 0, pcol = lat ? pos & 63 : 0;
        const bf16* p = P + (size_t)row * ATT_NP;
        bf16* qd = wsp<bf16>(F, WS_QD) + (size_t)row * 512; bf16* kd = wsp<bf16>(F, WS_KD) + (size_t)row * 512;
#pragma unroll
        for (int j = 0; j < 2; ++j) { const int g = lane + 64 * j, h16 = g >> 3, i0 = (g & 7) * 4;
            const v2u w1 = *(const v2u*)(p + h16 * 64 + i0), w2 = *(const v2u*)(p + h16 * 64 + i0 + 32);
            const float x1[4] = {bflo(w1.x), bfhi(w1.x), bflo(w1.y), bfhi(w1.y)}, x2[4] = {bflo(w2.x), bfhi(w2.x), bflo(w2.y), bfhi(w2.y)};
            float cs[8] = {1.f, 0.f, 1.f, 0.f, 1.f, 0.f, 1.f, 0.f};
            if (lat) { const float* tb = (i0 < 16) ? rope + ROPE_DR + (size_t)(prow * 16 + i0) * 2 : rope + ROPE_DC + (size_t)(pcol * 16 + i0 - 16) * 2;
                const f32x4 t0 = *(const f32x4*)tb, t1 = *(const f32x4*)(tb + 4); cs[0] = t0.x; cs[1] = t0.y; cs[2] = t0.z; cs[3] = t0.w; cs[4] = t1.x; cs[5] = t1.y; cs[6] = t1.z; cs[7] = t1.w; }
            float y1[4], y2[4]; const float sc = h16 < 8 ? CD : 1.f;
#pragma unroll
            for (int e = 0; e < 4; ++e) { y1[e] = (x1[e] * cs[2 * e] - x2[e] * cs[2 * e + 1]) * sc; y2[e] = (x1[e] * cs[2 * e + 1] + x2[e] * cs[2 * e]) * sc; }
            bf16* o = (h16 < 8) ? qd + h16 * 64 + i0 : kd + (h16 - 8) * 64 + i0;
            v2u o1, o2; o1.x = pk2(y1[0], y1[1]); o1.y = pk2(y1[2], y1[3]); o2.x = pk2(y2[0], y2[1]); o2.y = pk2(y2[2], y2[3]);
            *(v2u*)o = o1; *(v2u*)(o + 32) = o2; }
        { float x[8]; float ss = 0.f; const bool act = lane < 48;
          if (act) unpack8(*(const v4u*)(p + 1536 + 8 * lane), x); else {
#pragma unroll
              for (int e = 0; e < 8; ++e) x[e] = 0.f; }
#pragma unroll
          for (int e = 0; e < 8; ++e) ss += x[e] * x[e];
          const float rs = 1.f / sqrtf(wave_sum(ss) * (1.f / 384.f) + NORM_EPS);
          if (act) { const f32x4 g0 = *(const f32x4*)(F.in[I_QNW] + 8 * lane), g1 = *(const f32x4*)(F.in[I_QNW] + 8 * lane + 4); v4u w;
              w.x = pk2(x[0] * rs * g0.x, x[1] * rs * g0.y); w.y = pk2(x[2] * rs * g0.z, x[3] * rs * g0.w); w.z = pk2(x[4] * rs * g1.x, x[5] * rs * g1.y); w.w = pk2(x[6] * rs * g1.z, x[7] * rs * g1.w);
              *(v4u*)(wsp<bf16>(F, WS_CQN) + (size_t)row * 384 + 8 * lane) = w; } }
        { const v2u wv = *(const v2u*)(p + 1920 + 4 * lane); const float x[4] = {bflo(wv.x), bfhi(wv.x), bflo(wv.y), bfhi(wv.y)};
          const float rs = 1.f / sqrtf(wave_sum((x[0] * x[0] + x[1] * x[1]) + (x[2] * x[2] + x[3] * x[3])) * (1.f / 256.f) + NORM_EPS);
          const f32x4 g0 = *(const f32x4*)(F.in[I_KVNW] + 4 * lane); v2u w; w.x = pk2(x[0] * rs * g0.x, x[1] * rs * g0.y); w.y = pk2(x[2] * rs * g0.z, x[3] * rs * g0.w);
          *(v2u*)(wsp<bf16>(F, WS_CKVN) + (size_t)row * 256 + 4 * lane) = w; }
        if (lane < 16) { const int i = lane; const float x1 = bf2f(p[2176 + i]), x2 = bf2f(p[2176 + i + 16]); float c = 1.f, s = 0.f;
            if (lat) { const float* tb = (i < 8) ? rope + ROPE_MR + (size_t)(prow * 8 + i) * 2 : rope + ROPE_MC + (size_t)(pcol * 8 + i - 8) * 2; c = tb[0]; s = tb[1]; }
            bf16* o = wsp<bf16>(F, WS_KRR) + (size_t)row * 32; o[i] = (bf16)f2bf(x1 * c - x2 * s); o[i + 16] = (bf16)f2bf(x1 * s + x2 * c); }
    }
}
__device__ __forceinline__ void l0_mq_rope(const Frame& F) {
    const int gw = F.blk * 8 + F.wave, NGW = F.G * 8, lane = F.lane; const float* rope = wsp<const float>(F, WS_ROPE);
    const float CM = 0.10206207261596575f * 1.4426950408889634f;
    for (int row = gw; row < R; row += NGW) {
        const int b = row / TB, t = row - b * TB; const bool lat = t >= CT; const int pos = t - CT, prow = lat ? pos >> 6 : 0, pcol = lat ? pos & 63 : 0;
        bf16* q = wsp<bf16>(F, WS_MQ) + (size_t)row * 768;
#pragma unroll
        for (int j = 0; j < 2; ++j) { const int g = lane + 64 * j, h = g >> 4, d0 = (g & 15) * 4;
            const v2u wv = *(const v2u*)(q + h * 96 + d0); v2u o; o.x = pk2(bflo(wv.x) * CM, bfhi(wv.x) * CM); o.y = pk2(bflo(wv.y) * CM, bfhi(wv.y) * CM); *(v2u*)(q + h * 96 + d0) = o; }
#pragma unroll
        for (int j = 0; j < 2; ++j) { const int pr = lane + 64 * j, h = pr >> 4, i = pr & 15; const float x1 = bf2f(q[h * 96 + 64 + i]), x2 = bf2f(q[h * 96 + 80 + i]); float c = 1.f, s = 0.f;
            if (lat) { const float* tb = (i < 8) ? rope + ROPE_MR + (size_t)(prow * 8 + i) * 2 : rope + ROPE_MC + (size_t)(pcol * 8 + i - 8) * 2; c = tb[0]; s = tb[1]; }
            q[h * 96 + 64 + i] = (bf16)f2bf((x1 * c - x2 * s) * CM); q[h * 96 + 80 + i] = (bf16)f2bf((x1 * s + x2 * c) * CM); }
    }
}
__device__ __forceinline__ void l0_attention(const Frame& F) {
    LAS char* lds = (LAS char*)F.lds;
    const bf16* QD = wsp<const bf16>(F, WS_QD); const bf16* KD = wsp<const bf16>(F, WS_KD); const bf16* P = wsp<const bf16>(F, WS_P);
    const bf16* MQ = wsp<const bf16>(F, WS_MQ); const bf16* MKV = wsp<const bf16>(F, WS_MKV); const bf16* KRR = wsp<const bf16>(F, WS_KRR);
    float* OD = wsp<float>(F, WS_ODIFF); float* OM = wsp<float>(F, WS_OMLA);
    for (int kind = 0; kind < 2; ++kind) {
        for (int L = F.blk; L < 1024 + 16; L += F.G) {
            int b, h8, qb, nkeys;
            if (L < 1024) { int pair;
                if (F.G == 256) { const int round = L >> 8, c = L & 255; pair = round * 4 + ((c & 7) >> 1); qb = 1 + (c & 1) * 32 + (c >> 3); }
                else { pair = L >> 6; qb = 1 + (L & 63); }
                b = pair >> 3; h8 = pair & 7; nkeys = TB; }
            else { const int s = L - 1024; b = s >> 3; h8 = s & 7; qb = 0; nkeys = CT; }
            const size_t q0 = (size_t)b * TB + (size_t)qb * 256, k0 = (size_t)b * TB;
            if (kind == 0)
                att::attn_unit<64, 128>(QD + q0 * 512 + h8 * 64, 512, KD + k0 * 512 + h8 * 64, 512, nullptr, 0, P + k0 * ATT_NP + 1024 + (h8 >> 1) * 128, ATT_NP,
                                        OD + q0 * 1024 + h8 * 128, 1024, nkeys, lds);
            else
                att::attn_unit<96, 64>(MQ + q0 * 768 + h8 * 96, 768, MKV + k0 * 1024 + h8 * 128, 1024, KRR + k0 * 32, 32, MKV + k0 * 1024 + h8 * 128 + 64, 1024,
                                       OM + q0 * 512 + h8 * 64, 512, nkeys, lds);
        }
    }
}
__device__ __forceinline__ void l0_combine(const Frame& F) {
    const int gw = F.blk * 8 + F.wave, NGW = F.G * 8, lane = F.lane;
    const float* lv = F.in[I_LAM];
    const float lam = __expf(wave_sum(lv[lane] * lv[64 + lane])) - __expf(wave_sum(lv[128 + lane] * lv[192 + lane])) + 0.2f;
    const float sw0 = F.in[I_SUBLN][2 * lane] * 0.8f, sw1 = F.in[I_SUBLN][2 * lane + 1] * 0.8f;
    for (int row = gw; row < R; row += NGW) {
        const float* od = wsp<const float>(F, WS_ODIFF) + (size_t)row * 1024; const float* om = wsp<const float>(F, WS_OMLA) + (size_t)row * 512;
        bf16* a1 = wsp<bf16>(F, WS_A1) + (size_t)row * DM;
#pragma unroll
        for (int h = 0; h < 4; ++h) {
            const float o1a = od[(2 * h) * 128 + 2 * lane], o1b = od[(2 * h) * 128 + 2 * lane + 1], o2a = od[(2 * h + 1) * 128 + 2 * lane], o2b = od[(2 * h + 1) * 128 + 2 * lane + 1];
            const float da = o1a - lam * o2a, db = o1b - lam * o2b;
            const float rs = 1.f / sqrtf(wave_sum(da * da + db * db) * (1.f / 128.f) + NORM_EPS);
            *(unsigned*)(a1 + h * 128 + 2 * lane) = pk2(da * rs * sw0, db * rs * sw1); }
#pragma unroll
        for (int j = 0; j < 2; ++j) { const f32x4 v = *(const f32x4*)(om + 4 * (lane + 64 * j)); v2u w; w.x = pk2(v.x, v.y); w.y = pk2(v.z, v.w); *(v2u*)(a1 + 512 + 4 * (lane + 64 * j)) = w; }
    }
}
constexpr int RT_LS = 264;
__device__ __forceinline__ void ph_router(const Frame& F, int layer) {
    LAS bf16* AH = (LAS bf16*)F.lds; LAS bf16* AL = AH + 64 * RT_LS; LAS bf16* WH = AL + 64 * RT_LS; LAS bf16* WL = WH + 32 * RT_LS;
    LAS float* lg = (LAS float*)(F.lds + 110592);
    LAS int* hist = (LAS int*)(F.lds + MISC_OFF + 256);
    LAS int* recs = (LAS int*)(F.lds + MISC_OFF + 512);
    const int lane = F.lane, w = F.wave, tid = F.tid, RPB = (R + F.G - 1) / F.G, row0 = F.blk * RPB;
    if (tid < 64) hist[tid] = 0;
    { int* srct = wsp<int>(F, WS_SRC); for (int i = F.blk * 512 + tid; i < MAXROWS; i += F.G * 512) srct[i] = 0; }
    const float* nw = F.in[I_NFFN] + (size_t)layer * DM; const float* rbp = F.in[I_RB] + layer * NE;
    const bf16* wrh = wsp<const bf16>(F, WS_WRH) + (size_t)layer * 32 * 1024; const bf16* wrl = wsp<const bf16>(F, WS_WRL) + (size_t)layer * 32 * 1024;
    for (int pass = 0; pass * 64 < RPB; ++pass) {
        const int nrow = min(64, min(RPB - pass * 64, R - row0 - pass * 64));
        f32x4 fr[8][4];
#pragma unroll
        for (int i = 0; i < 8; ++i) { const int rl = w + 8 * i; const int row = row0 + pass * 64 + rl;
            if (rl < nrow) {
                const int sel = row_sel(row); const float* sh = modp(F, layer, sel, 3); const float* sc = modp(F, layer, sel, 4);
                const f32x4* xr = (const f32x4*)(wsp<const float>(F, WS_H) + (size_t)row * DM) + lane; float s = 0.f;
#pragma unroll
                for (int j = 0; j < 4; ++j) { fr[i][j] = xr[64 * j]; s += (fr[i][j].x * fr[i][j].x + fr[i][j].y * fr[i][j].y) + (fr[i][j].z * fr[i][j].z + fr[i][j].w * fr[i][j].w); }
                const float rs = 1.f / sqrtf(wave_sum(s) * (1.f / DM) + NORM_EPS);
                unsigned long long* o8 = (unsigned long long*)(wsp<bf16>(F, WS_F) + (size_t)row * DM) + lane;
#pragma unroll
                for (int j = 0; j < 4; ++j) { const f32x4 ww = ((const f32x4*)nw)[lane + 64 * j], a = ((const f32x4*)sh)[lane + 64 * j], c = ((const f32x4*)sc)[lane + 64 * j];
                    fr[i][j] = fr[i][j] * rs * ww * (c + 1.f) + a;
                    o8[64 * j] = (unsigned long long)pk2(fr[i][j].x, fr[i][j].y) | ((unsigned long long)pk2(fr[i][j].z, fr[i][j].w) << 32); }
            } else {
#pragma unroll
                for (int j = 0; j < 4; ++j) fr[i][j] = (f32x4){0.f, 0.f, 0.f, 0.f};
            } }
        pg8::f32x4 acc = {0.f, 0.f, 0.f, 0.f};
#pragma unroll
        for (int c = 0; c < 4; ++c) {
            __syncthreads();
#pragma unroll
            for (int i = 0; i < 8; ++i) { const f32x4 v = fr[i][c]; const unsigned h0 = pk2(v.x, v.y), h1 = pk2(v.z, v.w);
                const unsigned l0 = pk2(v.x - bflo(h0), v.y - bfhi(h0)), l1 = pk2(v.z - bflo(h1), v.w - bfhi(h1));
                v2u hh; hh.x = h0; hh.y = h1; v2u ll; ll.x = l0; ll.y = l1;
                *(LAS v2u*)(AH + (w + 8 * i) * RT_LS + 4 * lane) = hh; *(LAS v2u*)(AL + (w + 8 * i) * RT_LS + 4 * lane) = ll; }
            { const int e = tid >> 4, kp = (tid & 15) * 16;
              const v4u a0 = *(const v4u*)(wrh + (size_t)e * 1024 + 256 * c + kp), a1 = *(const v4u*)(wrh + (size_t)e * 1024 + 256 * c + kp + 8);
              const v4u b0 = *(const v4u*)(wrl + (size_t)e * 1024 + 256 * c + kp), b1 = *(const v4u*)(wrl + (size_t)e * 1024 + 256 * c + kp + 8);
              *(LAS v4u*)(WH + e * RT_LS + kp) = a0; *(LAS v4u*)(WH + e * RT_LS + kp + 8) = a1; *(LAS v4u*)(WL + e * RT_LS + kp) = b0; *(LAS v4u*)(WL + e * RT_LS + kp + 8) = b1; }
            __syncthreads();
            const int tm = w >> 1, tn = w & 1, lr = lane & 15, kq = (lane >> 4) * 8;
            const LAS bf16* ahp = AH + (tm * 16 + lr) * RT_LS + kq; const LAS bf16* alp = AL + (tm * 16 + lr) * RT_LS + kq;
            const LAS bf16* whp = WH + (tn * 16 + lr) * RT_LS + kq; const LAS bf16* wlp = WL + (tn * 16 + lr) * RT_LS + kq;
#pragma unroll
            for (int ks = 0; ks < 8; ++ks) { const bf16x8 ah = *(const LAS bf16x8*)(ahp + 32 * ks), al = *(const LAS bf16x8*)(alp + 32 * ks), bh = *(const LAS bf16x8*)(whp + 32 * ks), bl = *(const LAS bf16x8*)(wlp + 32 * ks);
                acc = __builtin_amdgcn_mfma_f32_16x16x32_bf16(ah, bh, acc, 0, 0, 0); acc = __builtin_amdgcn_mfma_f32_16x16x32_bf16(ah, bl, acc, 0, 0, 0); acc = __builtin_amdgcn_mfma_f32_16x16x32_bf16(al, bh, acc, 0, 0, 0); }
        }
        { const int m0 = (w >> 1) * 16 + (lane >> 4) * 4, n = (w & 1) * 16 + (lane & 15);
#pragma unroll
          for (int r = 0; r < 4; ++r) lg[(m0 + r) * 33 + n] = acc[r]; }
        __syncthreads();
        if (tid < nrow) { const int rl = tid, row = row0 + pass * 64 + rl; float lv[32];
#pragma unroll
            for (int e = 0; e < 32; ++e) lv[e] = lg[rl * 33 + e] + rbp[e];
            float selv[4]; int seli[4];
#pragma unroll
            for (int r = 0; r < 4; ++r) { float bv = -3.0e38f; int bi = 0;
#pragma unroll
                for (int e = 0; e < 32; ++e) { const bool taken = (r > 0 && seli[0] == e) || (r > 1 && seli[1] == e) || (r > 2 && seli[2] == e); if (!taken && lv[e] > bv) { bv = lv[e]; bi = e; } }
                selv[r] = bv; seli[r] = bi; }
            float ex[4], es = 0.f;
#pragma unroll
            for (int r = 0; r < 4; ++r) { ex[r] = __expf(selv[r] - selv[0]); es += ex[r]; }
            const float inv = 1.f / es;
#pragma unroll
            for (int r = 0; r < 4; ++r) { wsp<int>(F, WS_TOPE)[(size_t)row * 4 + r] = seli[r]; wsp<float>(F, WS_GATE)[(size_t)row * 4 + r] = ex[r] * inv;
                const int rk = __hip_atomic_fetch_add(&hist[seli[r]], 1, __ATOMIC_RELAXED, __HIP_MEMORY_SCOPE_WORKGROUP);
                recs[(pass * 64 + rl) * 4 + r] = seli[r] | (rk << 8); }
        }
    }
    __syncthreads();
    if (tid < NE) hist[32 + tid] = (int)__hip_atomic_fetch_add(F.ctl + CW_CNT + 64 * (layer + 2 * F.probe) + tid, (unsigned)hist[tid], RLX_AGENT);
    __syncthreads();
    for (int rl = tid; rl < RPB && row0 + rl < R; rl += 512) {
#pragma unroll
        for (int r = 0; r < 4; ++r) { const int rc = recs[rl * 4 + r]; wsp<int>(F, WS_POS)[(size_t)(row0 + rl) * 4 + r] = hist[32 + (rc & 255)] + (rc >> 8); } }
}
__device__ __forceinline__ void moe_tables(const Frame& F, int layer, LAS int* ps, LAS int* tile_e) {
    if (F.tid == 0) { int acc = 0, t = 0;
        for (int e = 0; e < NE; ++e) { const int c = (int)__hip_atomic_load(F.ctl + CW_CNT + 64 * layer + e, RLX_AGENT); ps[e] = acc; const int nt = (c + 255) >> 8;
            for (int i = 0; i < nt && t < MAXT; ++i) tile_e[t++] = e; acc += nt * 256; }
        ps[NE] = acc; ps[NE + 1] = t; }
    __syncthreads();
}
__device__ __forceinline__ void ph_gather(const Frame& F, int layer) {
    LAS int* ps = (LAS int*)(F.lds + MISC_OFF + 256); LAS int* tile_e = ps + 64;
    moe_tables(F, layer, ps, tile_e);
    if (F.blk == 0) { int* tab = wsp<int>(F, WS_TILE); const int nt = ps[NE + 1]; if (F.tid == 0) tab[0] = nt; for (int i = F.tid; i < nt; i += 512) tab[1 + i] = tile_e[i]; }
    for (int i = F.blk * 512 + F.tid; i < R * 4; i += F.G * 512) { const int row = i >> 2;
        const int e = wsp<const int>(F, WS_TOPE)[i]; const int dest = ps[e] + wsp<const int>(F, WS_POS)[i]; wsp<int>(F, WS_DEST)[i] = dest; wsp<int>(F, WS_SRC)[dest] = row; }
}
struct MoeOrder {
    const int* tile_e; int ntiles, nN, G, c; const int* src;
    __device__ __forceinline__ bool next(int i, pg8::Unit& u) const {
        int rt, pl;
        if (G == 256) { const int x = c & 7, y = c >> 3, rpx = 32 / nN; rt = (i * 8 + x) * rpx + y / nN; pl = y % nN; if (rt >= ntiles) return false; }
        else { const long L = (long)i * G + c; if (L >= (long)ntiles * nN) return false; rt = (int)(L / nN); pl = (int)(L - (long)rt * nN); }
        const int e = __builtin_amdgcn_readfirstlane(tile_e[rt]);
        u.pm = rt; u.pn = e * nN + pl; return true; }
    __device__ __forceinline__ void a_ready(const pg8::Unit&) const {}
    __device__ __forceinline__ void done(const pg8::Unit&) const {}
};
struct LatOrder {
    pg8::StaticOrder o;
    __device__ __forceinline__ bool next(int i, pg8::Unit& u) const { if (!o.next(i, u)) return false; u.pm += 1 + (u.pm >= 64 ? 1 : 0); return true; }
    __device__ __forceinline__ void a_ready(const pg8::Unit&) const {}
    __device__ __forceinline__ void done(const pg8::Unit&) const {}
};
struct FnSwiglu {
    bf16* HS; const float* b1;
    __device__ __forceinline__ void operator()(int row, int col, f32x4 v0, f32x4 v1) const {
        const float* bp = b1 + col;
        const f32x4 b0 = *(const f32x4*)bp, b1v = *(const f32x4*)(bp + 4); v0 = v0 + b0; v1 = v1 + b1v;
        const float hv[8] = {v0[0], v0[1], v0[2], v0[3], v1[0], v1[1], v1[2], v1[3]}; float o[4];
#pragma unroll
        for (int i = 0; i < 4; ++i) { const float g = hv[2 * i], l = hv[2 * i + 1];
            const float gl = fminf(g, 7.f), li = fminf(fmaxf(l, -7.f), 7.f); o[i] = gl * sigmoidf_(1.702f * gl) * (li + 1.f); }
        const int lc = col & 2047; v2u w; w.x = pk2(o[0], o[1]); w.y = pk2(o[2], o[3]);
        *(v2u*)(HS + (size_t)row * 1024 + (lc >> 1)) = w; }
};
struct FnBiasBf16 {
    bf16* YS; const float* b2;
    __device__ __forceinline__ void operator()(int row, int col, f32x4 v0, f32x4 v1) const {
        const f32x4 b0 = *(const f32x4*)(b2 + col), b1v = *(const f32x4*)(b2 + col + 4); v0 = v0 + b0; v1 = v1 + b1v;
        v4u w; w.x = pk2(v0[0], v0[1]); w.y = pk2(v0[2], v0[3]); w.z = pk2(v1[0], v1[1]); w.w = pk2(v1[2], v1[3]);
        *(v4u*)(YS + (size_t)row * 1024 + (col & 1023)) = w; }
};
__device__ __forceinline__ void ph_combine(const Frame& F, int layer) {
    const int lane = F.lane, gw = F.blk * 8 + F.wave, NGW = F.G * 8;
    for (int row = gw; row < R; row += NGW) {
        const int sel = row_sel(row); const float* gf = modp(F, layer, sel, 5);
        float* hrow = wsp<float>(F, WS_H) + (size_t)row * DM;
        f32x4 y[4];
#pragma unroll
        for (int j = 0; j < 4; ++j) y[j] = (f32x4){0.f, 0.f, 0.f, 0.f};
#pragma unroll
        for (int r = 0; r < 4; ++r) { const int d = wsp<const int>(F, WS_DEST)[(size_t)row * 4 + r]; const float g = wsp<const float>(F, WS_GATE)[(size_t)row * 4 + r];
            const v2u* yp = (const v2u*)(wsp<const bf16>(F, WS_XS) + (size_t)d * DM);
#pragma unroll
            for (int j = 0; j < 4; ++j) { const v2u w = yp[lane + 64 * j]; y[j] += g * (f32x4){bflo(w.x), bfhi(w.x), bflo(w.y), bfhi(w.y)}; } }
        f32x4 h[4]; float s = 0.f;
#pragma unroll
        for (int j = 0; j < 4; ++j) { h[j] = ((const f32x4*)hrow)[lane + 64 * j] + ((const f32x4*)gf)[lane + 64 * j] * y[j]; s += (h[j].x * h[j].x + h[j].y * h[j].y) + (h[j].z * h[j].z + h[j].w * h[j].w); }
        const float rs = 1.f / sqrtf(wave_sum(s) * (1.f / DM) + NORM_EPS);
        if (layer == 0) {
#pragma unroll
            for (int j = 0; j < 4; ++j) ((f32x4*)hrow)[lane + 64 * j] = h[j];
            const float* nw = F.in[I_NMIX] + DM; const float* sh = modp(F, 1, sel, 0); const float* sc = modp(F, 1, sel, 1);
            unsigned long long* o8 = (unsigned long long*)(wsp<bf16>(F, WS_A) + (size_t)row * DM) + lane;
#pragma unroll
            for (int j = 0; j < 4; ++j) { const f32x4 w = ((const f32x4*)nw)[lane + 64 * j], a = ((const f32x4*)sh)[lane + 64 * j], c = ((const f32x4*)sc)[lane + 64 * j];
                const f32x4 o = h[j] * rs * w * (c + 1.f) + a; o8[64 * j] = (unsigned long long)pk2(o.x, o.y) | ((unsigned long long)pk2(o.z, o.w) << 32); }
        } else {
            const int b = row / TB, t = row - b * TB;
            if (t >= CT) { float* orow = F.out + ((size_t)b * SEQ + (t - CT)) * DM; const float* nw = F.in[I_FNW];
#pragma unroll
                for (int j = 0; j < 4; ++j) ((f32x4*)orow)[lane + 64 * j] = h[j] * rs * ((const f32x4*)nw)[lane + 64 * j]; }
        }
    }
}
constexpr int PC_Q = 1920, PC_K = 2176, PC_V = 2432, PC_O = 2944, PC_G = 3456;
__device__ __forceinline__ float softplusf_(float y) { return fmaxf(y, 0.f) + __logf(1.f + __expf(-fabsf(y))); }
__device__ __forceinline__ float tanhf_(float x) { return 1.f - 2.f / (1.f + __expf(2.f * x)); }
__device__ __forceinline__ void lerp8(const bf16* p, bool hp, bool hn, int c0, const float* mu, float (&u)[8]) {
    const v4u z4 = {0u, 0u, 0u, 0u};
    const v4u wx = *(const v4u*)(p + c0), wp = hp ? *(const v4u*)(p - REC_NP + c0) : z4, wn = hn ? *(const v4u*)(p + REC_NP + c0) : z4;
    float x[8], xp[8], xn[8]; unpack8(wx, x); unpack8(wp, xp); unpack8(wn, xn);
    const f32x4 m0 = *(const f32x4*)(mu + c0), m1 = *(const f32x4*)(mu + c0 + 4);
#pragma unroll
    for (int e = 0; e < 8; ++e) { const float m = e < 4 ? m0[e & 3] : m1[e & 3]; u[e] = x[e] + m * (0.5f * (xp[e] + xn[e]) - x[e]); }
}
__device__ __forceinline__ void st8h(bf16* o, const float (&u)[8]) { v4u w; w.x = pk2(u[0], u[1]); w.y = pk2(u[2], u[3]); w.z = pk2(u[4], u[5]); w.w = pk2(u[6], u[7]); *(v4u*)o = w; }
__device__ __forceinline__ void st8f(float* o, const float (&u)[8]) { *(f32x4*)o = (f32x4){u[0], u[1], u[2], u[3]}; *(f32x4*)(o + 4) = (f32x4){u[4], u[5], u[6], u[7]}; }
__device__ __forceinline__ void l1_rwkv_prep(const Frame& F) {
    const int gw = F.blk * 8 + F.wave, NGW = F.G * 8, lane = F.lane; const float* mu = F.in[I_MU];
    for (int row = gw; row < R; row += NGW) {
        const int b = row / TB, t = row - b * TB; const bool hp = (t != 0 && t != CT), hn = (t != CT - 1 && t != TB - 1);
        const bf16* p = wsp<const bf16>(F, WS_P) + (size_t)row * REC_NP; const size_t ro = (size_t)row * 512 + 8 * lane;
        float u[8];
        lerp8(p, hp, hn, 8 * lane, mu, u); st8h(wsp<bf16>(F, WS_RR) + ro, u);
        lerp8(p, hp, hn, 1024 + 8 * lane, mu, u); st8h(wsp<bf16>(F, WS_VV) + ro, u);
        lerp8(p, hp, hn, 512 + 8 * lane, mu, u); st8h(wsp<bf16>(F, WS_KL) + ro, u);
        { const f32x4 k0 = *(const f32x4*)(F.in[I_KK] + 8 * lane), k1 = *(const f32x4*)(F.in[I_KK] + 8 * lane + 4); float ss = 0.f;
#pragma unroll
          for (int e = 0; e < 8; ++e) { u[e] *= (e < 4 ? k0[e & 3] : k1[e & 3]); ss += u[e] * u[e]; }
          ss += __shfl_xor(ss, 1); ss += __shfl_xor(ss, 2); ss += __shfl_xor(ss, 4);
          const float inv = -1.f / sqrtf(fmaxf(ss, 1e-24f));
#pragma unroll
          for (int e = 0; e < 8; ++e) u[e] *= inv;
          st8h(wsp<bf16>(F, WS_AKK) + ro, u); }
        if (lane < 48) { lerp8(p, hp, hn, 1536 + 8 * lane, mu, u);
#pragma unroll
            for (int e = 0; e < 8; ++e) u[e] = lane < 16 ? tanhf_(u[e]) : (lane < 32 ? u[e] : sigmoidf_(u[e]));
            v4u w; w.x = pk2(u[0], u[1]); w.y = pk2(u[2], u[3]); w.z = pk2(u[4], u[5]); w.w = pk2(u[6], u[7]);
            *(v4u*)(wsp<bf16>(F, WS_ALORA) + (size_t)row * 384 + 8 * lane) = w; }
    }
}
struct EpiLora {
    static constexpr bool PERM = true, AFTER_DRAIN = false;
    const Frame* F;
    template <int KIND> __device__ __forceinline__ void run(const pg8::f32x4 (&acc)[2][2][4][2], const pg8::Unit& u, int wr, int wc, int fr, int fq, int z) const {
#pragma unroll
        for (int ai = 0; ai < 2; ++ai)
#pragma unroll
            for (int m = 0; m < 4; ++m) { const int row = u.pm * 256 + ai * 128 + wr * 64 + m * 16 + fr;
#pragma unroll
                for (int bj = 0; bj < 2; ++bj) { const int c = ((u.pn & 1) * 256) + bj * 128 + wc * 32 + 8 * fq; const size_t ro = (size_t)row * 512 + c;
                    const pg8::f32x4 v0 = acc[ai][bj][m][0], v1 = acc[ai][bj][m][1]; const float x[8] = {v0[0], v0[1], v0[2], v0[3], v1[0], v1[1], v1[2], v1[3]}; float o[8];
                    if constexpr (KIND == 0) { const float* w0 = F->in[I_W0] + z * 512 + c;
#pragma unroll
                        for (int e = 0; e < 8; ++e) { const float wl = -softplusf_(-(w0[e] + x[e])) - 0.5f; o[e] = __expf(-__expf(wl)); }
                        st8f(wsp<float>(*F, WS_WDEC) + (size_t)z * R * 512 + ro, o); }
                    else if constexpr (KIND == 1) { const float* a0 = F->in[I_A0] + z * 512 + c;
#pragma unroll
                        for (int e = 0; e < 8; ++e) o[e] = sigmoidf_(a0[e] + x[e]);
                        st8h(wsp<bf16>(*F, WS_ASIG) + (size_t)z * R * 512 + ro, o); }
                    else st8h(wsp<bf16>(*F, WS_GG) + ro, x); } }
    }
    __device__ __forceinline__ void operator()(const pg8::f32x4 (&acc)[2][2][4][2], const pg8::Unit& u, int wr, int wc, int fr, int fq) const {
        const int part = u.pn >> 1;
        if (part < 2) run<0>(acc, u, wr, wc, fr, fq, part); else if (part < 4) run<1>(acc, u, wr, wc, fr, fq, part - 2); else run<2>(acc, u, wr, wc, fr, fq, 0);
    }
};
__device__ __forceinline__ void mlstm_gates(const Frame& F, int row, int z, int h, float& ig, float& lf) {
    const bf16* g = wsp<const bf16>(F, WS_P) + (size_t)row * REC_NP + PC_G + z * 8 + h; const float* gb = F.in[I_GATEB] + z * 8 + h;
    const float gi = bf2f(g[0]) + gb[0], gf = bf2f(g[4]) + gb[4];
    ig = 15.f * tanhf_(gi * (1.f / 15.f)); const float cf = 15.f * tanhf_(gf * (1.f / 15.f)); lf = fminf(cf, 0.f) - __logf(1.f + __expf(-fabsf(cf)));
}
__device__ __forceinline__ void mlstm_chunk_head(const Frame& F, int z, int b, int h, int c, LAS float* vec) {
    LAS int* rows = (LAS int*)vec;
    if (F.tid < 64) { const int s = F.tid, row = b * TB + scan_tok(z, 64 * c + s); float ig, lf; mlstm_gates(F, row, z, h, ig, lf); rows[s] = row; vec[64 + s] = ig; vec[192 + s] = lf; }
    __syncthreads();
    if (F.tid < 64) { float a = 0.f; for (int s = 0; s <= F.tid; ++s) a += vec[192 + s]; vec[128 + F.tid] = a; }
    __syncthreads();
}
__device__ __forceinline__ void l1_mlstm_b(const Frame& F) {
    const float* __restrict__ SC = wsp<const float>(F, WS_SC); const float* __restrict__ DC = wsp<const float>(F, WS_DC); float* __restrict__ CST = wsp<float>(F, WS_CST);
    const float* __restrict__ DN = wsp<const float>(F, WS_DN); float* __restrict__ NST = wsp<float>(F, WS_NST); float* __restrict__ MST = wsp<float>(F, WS_MST);
    for (int g = F.blk * 512 + F.tid; g < 16 * 8192; g += F.G * 512) {
        const int chain = g >> 13, el = g & 8191; float m = 0.f, C = 0.f, N = 0.f; const bool don = el < 64;
        for (int c0 = 0; c0 < 260; c0 += 10) {
            float dc[10], dn[10], bl[10], ml[10];
#pragma unroll
            for (int i = 0; i < 10; ++i) { const size_t u = (size_t)chain * 260 + c0 + i; dc[i] = DC[u * 8192 + el]; dn[i] = don ? DN[u * 64 + el] : 0.f; bl[i] = SC[2 * u]; ml[i] = SC[2 * u + 1]; }
#pragma unroll
            for (int i = 0; i < 10; ++i) { const size_t u = (size_t)chain * 260 + c0 + i;
                CST[u * 8192 + el] = C; if (don) NST[u * 64 + el] = N; if (el == 0) MST[u] = m;
                const float mn = fmaxf(bl[i] + m, ml[i]), cd = __expf(bl[i] + m - mn), inj = __expf(ml[i] - mn);
                C = cd * C + inj * dc[i]; N = cd * N + inj * dn[i]; m = mn; }
        }
    }
}
__device__ __forceinline__ void l1_rec_out(const Frame& F) {
    const int gw = F.blk * 8 + F.wave, NGW = F.G * 8, lane = F.lane, c0 = 8 * lane;
    for (int row = gw; row < R; row += NGW) {
        const size_t ro = (size_t)row * 512 + c0; bf16* a1 = wsp<bf16>(F, WS_A1) + (size_t)row * DM;
        { const float* y0 = wsp<const float>(F, WS_YR) + ro; const float* y1 = y0 + (size_t)R * 512; float y[8]; float s = 0.f;
          const float* y2 = wsp<const float>(F, WS_YB) + ro; const float* y3 = y2 + (size_t)R * 512;
#pragma unroll
          for (int e = 0; e < 8; ++e) { y[e] = (y0[e] + y1[e]) + (y2[e] + y3[e]); s += y[e]; }
          s += __shfl_xor(s, 1); s += __shfl_xor(s, 2); s += __shfl_xor(s, 4); const float mean = s * (1.f / 64.f); float q = 0.f;
#pragma unroll
          for (int e = 0; e < 8; ++e) { y[e] -= mean; q += y[e] * y[e]; }
          q += __shfl_xor(q, 1); q += __shfl_xor(q, 2); q += __shfl_xor(q, 4); const float rstd = 1.f / sqrtf(q * (1.f / 64.f) + 64e-5f);
          float rr[8], kl[8], s0[8], s1[8], vv[8], gg[8]; unpack8(*(const v4u*)(wsp<const bf16>(F, WS_RR) + ro), rr); unpack8(*(const v4u*)(wsp<const bf16>(F, WS_KL) + ro), kl);
          unpack8(*(const v4u*)(wsp<const bf16>(F, WS_ASIG) + ro), s0); unpack8(*(const v4u*)(wsp<const bf16>(F, WS_ASIG) + (size_t)R * 512 + ro), s1);
          unpack8(*(const v4u*)(wsp<const bf16>(F, WS_VV) + ro), vv); unpack8(*(const v4u*)(wsp<const bf16>(F, WS_GG) + ro), gg);
          const float* rk = F.in[I_RK] + c0; const float* ka = F.in[I_KA] + c0; float bs = 0.f;
#pragma unroll
          for (int e = 0; e < 8; ++e) bs += rr[e] * kl[e] * (2.f + (s0[e] + s1[e] - 2.f) * ka[e]) * rk[e];
          bs += __shfl_xor(bs, 1); bs += __shfl_xor(bs, 2); bs += __shfl_xor(bs, 4);
          const float* lw = F.in[I_LNW] + c0; const float* lb = F.in[I_LNB] + c0; float o[8];
#pragma unroll
          for (int e = 0; e < 8; ++e) o[e] = (y[e] * rstd * lw[e] + lb[e] + bs * vv[e]) * gg[e];
          v4u w; w.x = pk2(o[0], o[1]); w.y = pk2(o[2], o[3]); w.z = pk2(o[4], o[5]); w.w = pk2(o[6], o[7]); *(v4u*)(a1 + c0) = w; }
        { const float* h0 = wsp<const float>(F, WS_HM) + ro; const float* h1 = h0 + (size_t)R * 512; float x[8]; float q = 0.f;
#pragma unroll
          for (int e = 0; e < 8; ++e) { x[e] = h0[e] + h1[e]; q += x[e] * x[e]; }
          q += __shfl_xor(q, 1); q += __shfl_xor(q, 2); q += __shfl_xor(q, 4); q += __shfl_xor(q, 8); const float rs = 1.f / sqrtf(q * (1.f / 128.f) + NORM_EPS);
          float og[8]; unpack8(*(const v4u*)(wsp<const bf16>(F, WS_P) + (size_t)row * REC_NP + PC_O + c0), og); const float* nw = F.in[I_MNW] + c0; float o[8];
#pragma unroll
          for (int e = 0; e < 8; ++e) o[e] = x[e] * rs * nw[e] * sigmoidf_(og[e]);
          v4u w; w.x = pk2(o[0], o[1]); w.y = pk2(o[2], o[3]); w.z = pk2(o[4], o[5]); w.w = pk2(o[6], o[7]); *(v4u*)(a1 + 512 + c0) = w; }
    }
}
#ifndef NEU_ROUNDS
#define NEU_ROUNDS 6
#endif
namespace rk {
constexpr int LS = 72;
constexpr int MB = 64 * LS * 2;
struct Acc2 { pg8::f32x4 t0, t1; };
__device__ __forceinline__ void zero(Acc2& a) { a.t0 = (pg8::f32x4){0.f, 0.f, 0.f, 0.f}; a.t1 = a.t0; }
__device__ __forceinline__ void mm_acc(Acc2& acc, const LAS bf16* A, const LAS bf16* Bt, int wave, int lane) {
    const int tm = wave >> 1, tn0 = (wave & 1) * 2, lr = lane & 15, kq = (lane >> 4) * 8;
    const LAS bf16* ap = A + (tm * 16 + lr) * LS + kq; const LAS bf16* bp0 = Bt + (tn0 * 16 + lr) * LS + kq; const LAS bf16* bp1 = bp0 + 16 * LS;
    const bf16x8 a0 = *(const LAS bf16x8*)ap, a1 = *(const LAS bf16x8*)(ap + 32);
    const bf16x8 b00 = *(const LAS bf16x8*)bp0, b01 = *(const LAS bf16x8*)(bp0 + 32), b10 = *(const LAS bf16x8*)bp1, b11 = *(const LAS bf16x8*)(bp1 + 32);
    acc.t0 = __builtin_amdgcn_mfma_f32_16x16x32_bf16(a0, b00, acc.t0, 0, 0, 0); acc.t0 = __builtin_amdgcn_mfma_f32_16x16x32_bf16(a1, b01, acc.t0, 0, 0, 0);
    acc.t1 = __builtin_amdgcn_mfma_f32_16x16x32_bf16(a0, b10, acc.t1, 0, 0, 0); acc.t1 = __builtin_amdgcn_mfma_f32_16x16x32_bf16(a1, b11, acc.t1, 0, 0, 0);
}
template <class Fn> __device__ __forceinline__ void each(const Acc2& acc, int wave, int lane, Fn fn) {
    const int m0 = (wave >> 1) * 16 + (lane >> 4) * 4, n0 = (wave & 1) * 32 + (lane & 15);
#pragma unroll
    for (int r = 0; r < 4; ++r) { fn(m0 + r, n0, acc.t0[r]); fn(m0 + r, n0 + 16, acc.t1[r]); }
}
__device__ __forceinline__ void stb(LAS bf16* M, int m, int n, float v) { M[m * LS + n] = (bf16)f2bf(v); }
__device__ __forceinline__ void st_tr(LAS bf16* M, const Acc2& acc, int wave, int lane) {
    const int m0 = (wave >> 1) * 16 + (lane >> 4) * 4, n0 = (wave & 1) * 32 + (lane & 15);
    v2u a, b; a.x = pk2(acc.t0[0], acc.t0[1]); a.y = pk2(acc.t0[2], acc.t0[3]); b.x = pk2(acc.t1[0], acc.t1[1]); b.y = pk2(acc.t1[2], acc.t1[3]);
    *(LAS v2u*)(M + n0 * LS + m0) = a; *(LAS v2u*)(M + (n0 + 16) * LS + m0) = b;
}
}
__device__ __forceinline__ void l1_rk_phase_a(const Frame& F) {
    using namespace rk;
    LAS unsigned char* L = F.lds;
    LAS bf16* Rt = (LAS bf16*)(L + 0 * MB); LAS bf16* At = (LAS bf16*)(L + 1 * MB); LAS bf16* AtT = (LAS bf16*)(L + 2 * MB); LAS bf16* Bq = (LAS bf16*)(L + 3 * MB); LAS bf16* Kq = (LAS bf16*)(L + 4 * MB);
    LAS bf16* VT = (LAS bf16*)(L + 5 * MB); LAS bf16* BhT = (LAS bf16*)(L + 6 * MB); LAS bf16* KhT = (LAS bf16*)(L + 7 * MB);
    LAS bf16* AK = (LAS bf16*)(L + 8 * MB); LAS bf16* RB = (LAS bf16*)(L + 9 * MB); LAS bf16* RK = (LAS bf16*)(L + 10 * MB);
    LAS bf16* X = (LAS bf16*)(L + 11 * MB); LAS bf16* XT = (LAS bf16*)(L + 12 * MB); LAS bf16* P = (LAS bf16*)(L + 13 * MB);
    LAS bf16* AkVT = Bq; LAS bf16* ApT = Kq; LAS bf16* W2T = X;
    LAS float* G = (LAS float*)(L + 8 * MB);
    LAS float* gl = (LAS float*)(L + 14 * MB);
    const int w = F.wave, lane = F.lane, tid = F.tid;
    const int t = lane, j0 = 8 * w;
    float fr[8], fv[8], fa[8], fw[8], fk[8], fb[8];
#define RK_LOAD(u_) do { const int ch_ = (u_) / 260, c_ = (u_) - ch_ * 260, z_ = ch_ >> 4, b_ = (ch_ >> 3) & 1, h_ = ch_ & 7; const size_t ro = ((size_t)b_ * TB + scan_tok(z_, 64 * c_ + t)) * 512 + h_ * 64 + j0; \
    const v4u xr_ = *(const v4u*)(wsp<const bf16>(F, WS_RR) + ro), xv_ = *(const v4u*)(wsp<const bf16>(F, WS_VV) + ro), xa_ = *(const v4u*)(wsp<const bf16>(F, WS_AKK) + ro), xk_ = *(const v4u*)(wsp<const bf16>(F, WS_KL) + ro), \
              xs_ = *(const v4u*)(wsp<const bf16>(F, WS_ASIG) + (size_t)z_ * R * 512 + ro); const float* p3 = wsp<const float>(F, WS_WDEC) + (size_t)z_ * R * 512 + ro; const float* pk_ = F.in[I_KA] + h_ * 64 + j0; \
    const f32x4 w0_ = *(const f32x4*)p3, w1_ = *(const f32x4*)(p3 + 4), q0_ = *(const f32x4*)pk_, q1_ = *(const f32x4*)(pk_ + 4); float sg_[8], kl_[8]; \
    unpack8(xr_, fr); unpack8(xv_, fv); unpack8(xa_, fa); unpack8(xk_, kl_); unpack8(xs_, sg_); \
    _Pragma("unroll") for (int e = 0; e < 8; ++e) { const float kav = e < 4 ? q0_[e & 3] : q1_[e & 3]; fw[e] = e < 4 ? w0_[e & 3] : w1_[e & 3]; fk[e] = kl_[e] * (1.f + (sg_[e] - 1.f) * kav); fb[e] = -fa[e] * sg_[e]; } } while (0)
    if (F.blk < NUNIT_R) RK_LOAD(F.blk);
    for (int u = F.blk; u < NUNIT_R; u += F.G) {
        const int chain = u / 260, c = u - chain * 260, z = chain >> 4, b = (chain >> 3) & 1, h = chain & 7;
        __syncthreads();
#pragma unroll
        for (int e = 0; e < 8; ++e) G[t * 65 + j0 + e] = fw[e];
        __syncthreads();
        if (tid < 64) { float g = 1.f;
#pragma unroll 16
            for (int s = 0; s < 64; ++s) { g *= G[s * 65 + tid]; G[s * 65 + tid] = g; } gl[tid] = g; }
        __syncthreads();
#pragma unroll
        for (int e = 0; e < 8; ++e) { const int j = j0 + e; const float gt = G[t * 65 + j], gp = t > 0 ? G[(t - 1) * 65 + j] : 1.f, gL = G[63 * 65 + j], ig = 1.f / gt;
            fr[e] *= gt; fa[e] *= gp; const float bq = fb[e] * ig, kq = fk[e] * ig; fb[e] = bq; fk[e] = kq; fw[e] = gL; }
        __syncthreads();
        { v4u q; q.x = pk2(fr[0], fr[1]); q.y = pk2(fr[2], fr[3]); q.z = pk2(fr[4], fr[5]); q.w = pk2(fr[6], fr[7]); *(LAS v4u*)(Rt + t * LS + j0) = q;
          q.x = pk2(fa[0], fa[1]); q.y = pk2(fa[2], fa[3]); q.z = pk2(fa[4], fa[5]); q.w = pk2(fa[6], fa[7]); *(LAS v4u*)(At + t * LS + j0) = q;
          q.x = pk2(fb[0], fb[1]); q.y = pk2(fb[2], fb[3]); q.z = pk2(fb[4], fb[5]); q.w = pk2(fb[6], fb[7]); *(LAS v4u*)(Bq + t * LS + j0) = q;
          q.x = pk2(fk[0], fk[1]); q.y = pk2(fk[2], fk[3]); q.z = pk2(fk[4], fk[5]); q.w = pk2(fk[6], fk[7]); *(LAS v4u*)(Kq + t * LS + j0) = q; }
#pragma unroll
        for (int e = 0; e < 8; ++e) { const int j = j0 + e; stb(AtT, j, t, fa[e]); stb(VT, j, t, fv[e]); stb(BhT, j, t, fb[e] * fw[e]); stb(KhT, j, t, fk[e] * fw[e]); }
        __syncthreads();
        if (u + F.G < NUNIT_R) RK_LOAD(u + F.G);
        Acc2 a1, a2, a3, a4;
        zero(a1); mm_acc(a1, At, Bq, w, lane); zero(a2); mm_acc(a2, At, Kq, w, lane); zero(a3); mm_acc(a3, Rt, Bq, w, lane); zero(a4); mm_acc(a4, Rt, Kq, w, lane);
        each(a1, w, lane, [&](int m, int n, float v) { const float x = n < m ? v : 0.f; stb(X, m, n, x); stb(XT, n, m, x); stb(P, m, n, m == n ? 1.f : 0.f); });
        each(a2, w, lane, [&](int m, int n, float v) { stb(AK, m, n, n < m ? v : 0.f); });
        each(a3, w, lane, [&](int m, int n, float v) { stb(RB, m, n, n <= m ? v : 0.f); });
        each(a4, w, lane, [&](int m, int n, float v) { stb(RK, m, n, n <= m ? v : 0.f); });
        __syncthreads();
        { const int m0 = (w >> 1) * 16 + (lane >> 4) * 4, n0 = (w & 1) * 32 + (lane & 15);
          Acc2 pt;
#pragma unroll
          for (int r = 0; r < 4; ++r) { pt.t0[r] = (m0 + r == n0) ? 1.f : 0.f; pt.t1[r] = (m0 + r == n0 + 16) ? 1.f : 0.f; }
#pragma unroll 1
          for (int i = 0; i < NEU_ROUNDS; ++i) {
            mm_acc(pt, P, XT, w, lane);
            if (i < NEU_ROUNDS - 1) { zero(a1); mm_acc(a1, X, XT, w, lane); }
            __syncthreads();
#pragma unroll
            for (int r = 0; r < 4; ++r) { stb(P, m0 + r, n0, pt.t0[r]); stb(P, m0 + r, n0 + 16, pt.t1[r]); }
            if (i < NEU_ROUNDS - 1) { each(a1, w, lane, [&](int m, int n, float v) { stb(X, m, n, v); }); st_tr(XT, a1, w, lane); }
            __syncthreads();
          } }
        zero(a1); mm_acc(a1, AK, VT, w, lane); zero(a2); mm_acc(a2, P, AtT, w, lane);
        st_tr(AkVT, a1, w, lane); st_tr(ApT, a2, w, lane);
        __syncthreads();
        zero(a3); mm_acc(a3, P, AkVT, w, lane);
        st_tr(W2T, a3, w, lane);
        __syncthreads();
        zero(a1); mm_acc(a1, RB, ApT, w, lane); zero(a2); mm_acc(a2, RB, W2T, w, lane); mm_acc(a2, RK, VT, w, lane);
        zero(a3); mm_acc(a3, BhT, ApT, w, lane); zero(a4); mm_acc(a4, BhT, W2T, w, lane); mm_acc(a4, KhT, VT, w, lane);
        __syncthreads();
        { LAS bf16* O1 = At; LAS bf16* O2 = AtT; LAS bf16* O3 = AK; LAS float* OY = (LAS float*)X;
          each(a1, w, lane, [&](int m, int n, float v) { stb(O1, m, n, v + bf2f(Rt[m * LS + n])); });
          each(a3, w, lane, [&](int m, int n, float v) { stb(O2, m, n, v + (m == n ? gl[m] : 0.f)); });
          each(a4, w, lane, [&](int m, int n, float v) { stb(O3, m, n, v); });
          each(a2, w, lane, [&](int m, int n, float v) { OY[m * 68 + n] = v; });
          __syncthreads();
          const int row = tid >> 3, c8 = (tid & 7) * 8;
          *(v4u*)(wsp<bf16>(F, WS_RKQ) + (size_t)u * 4096 + row * 64 + c8) = *(const LAS v4u*)(O1 + row * LS + c8);
          *(v4u*)(wsp<bf16>(F, WS_RKM) + (size_t)u * 4096 + row * 64 + c8) = *(const LAS v4u*)(O2 + row * LS + c8);
          *(v4u*)(wsp<bf16>(F, WS_RKZ) + (size_t)u * 4096 + row * 64 + c8) = *(const LAS v4u*)(O3 + row * LS + c8);
          float* Yg = wsp<float>(F, WS_YR) + (size_t)z * R * 512 + h * 64;
#pragma unroll
          for (int i = 0; i < 2; ++i) { const int yr = (tid >> 4) + 32 * i, c4 = (tid & 15) * 4;
              *(f32x4*)(Yg + ((size_t)b * TB + scan_tok(z, 64 * c + yr)) * 512 + c4) = *(const LAS f32x4*)(OY + yr * 68 + c4); } }
    }
#undef RK_LOAD
}
__device__ __forceinline__ void l1_rk_phase_b(const Frame& F) {
    using namespace rk;
    LAS unsigned char* L = F.lds;
    const int w = F.wave, lane = F.lane, tid = F.tid, chain = F.blk, z = chain >> 4, b = (chain >> 3) & 1, h = chain & 7;
    for (int i = tid; i < 2 * 64 * LS; i += 512) ((LAS bf16*)L)[i] = 0;
    const int sr = tid >> 3, sc = (tid & 7) * 8;
    v4u gm, gq, gz;
#define RKB_LOAD(u_) do { gm = *(const v4u*)(wsp<const bf16>(F, WS_RKM) + (u_) * 4096 + sr * 64 + sc); gq = *(const v4u*)(wsp<const bf16>(F, WS_RKQ) + (u_) * 4096 + sr * 64 + sc); \
    gz = *(const v4u*)(wsp<const bf16>(F, WS_RKZ) + (u_) * 4096 + sr * 64 + sc); } while (0)
#define RKB_WRITE(par) do { *(LAS v4u*)((LAS bf16*)(L + (2 + 3 * (par)) * MB) + sr * LS + sc) = gm; *(LAS v4u*)((LAS bf16*)(L + (3 + 3 * (par)) * MB) + sr * LS + sc) = gq; \
    *(LAS v4u*)((LAS bf16*)(L + (4 + 3 * (par)) * MB) + sr * LS + sc) = gz; } while (0)
    RKB_LOAD((size_t)chain * 260); RKB_WRITE(0);
    __syncthreads();
    float* Yg = wsp<float>(F, WS_YB) + (size_t)z * R * 512 + h * 64;
    const int m0 = (w >> 1) * 16 + (lane >> 4) * 4, n0 = (w & 1) * 32 + (lane & 15);
    for (int c = 0; c < 260; ++c) {
        const size_t u = (size_t)chain * 260 + c; const int par = c & 1;
        if (c + 1 < 260) RKB_LOAD(u + 1);
        const LAS bf16* S = (const LAS bf16*)(L + par * MB); LAS bf16* Sn = (LAS bf16*)(L + (par ^ 1) * MB);
        const LAS bf16* Mt = (const LAS bf16*)(L + (2 + 3 * par) * MB); const LAS bf16* Qp = (const LAS bf16*)(L + (3 + 3 * par) * MB); const LAS bf16* Zt = (const LAS bf16*)(L + (4 + 3 * par) * MB);
        Acc2 a1, a2;
#pragma unroll
        for (int r = 0; r < 4; ++r) { a1.t0[r] = bf2f(Zt[(m0 + r) * LS + n0]); a1.t1[r] = bf2f(Zt[(m0 + r) * LS + n0 + 16]); }
        mm_acc(a1, Mt, S, w, lane); zero(a2); mm_acc(a2, Qp, S, w, lane);
        st_tr(Sn, a1, w, lane);
        if (c + 1 < 260) RKB_WRITE(par ^ 1);
#pragma unroll
        for (int r = 0; r < 4; ++r) { const size_t yo = ((size_t)b * TB + scan_tok(z, 64 * c + m0 + r)) * 512 + n0; Yg[yo] = a2.t0[r]; Yg[yo + 16] = a2.t1[r]; }
        __syncthreads();
    }
#undef RKB_LOAD
#undef RKB_WRITE
}
__device__ __forceinline__ void l1_mlstm_a2(const Frame& F) {
    using namespace rk;
    LAS bf16* KT = (LAS bf16*)F.lds; LAS bf16* VsT = KT + 64 * LS;
    LAS float* vec = (LAS float*)(F.lds + AUX_OFF); LAS int* rows = (LAS int*)vec;
    const bf16* Pg = wsp<const bf16>(F, WS_P); const int tid = F.tid, w = F.wave, lane = F.lane;
    for (int u = F.blk; u < NUNIT_M; u += F.G) {
        const int cidx = u / 260, c = u - cidx * 260, z = cidx >> 3, b = (cidx >> 2) & 1, h = cidx & 3;
        mlstm_chunk_head(F, z, b, h, c, vec);
        if (tid < 64) { const float bl = vec[128 + 63]; const float uu = bl - vec[128 + tid] + vec[64 + tid]; float m = uu;
#pragma unroll
            for (int o = 1; o < 64; o <<= 1) m = fmaxf(m, __shfl_xor(m, o));
            vec[256 + tid] = __expf(uu - m);
            if (tid == 0) { wsp<float>(F, WS_SC)[2 * u] = bl; wsp<float>(F, WS_SC)[2 * u + 1] = m; } }
        __syncthreads();
        { const int s = tid >> 3, c8 = tid & 7; float x[8]; unpack8(*(const v4u*)(Pg + (size_t)rows[s] * REC_NP + PC_K + h * 64 + 8 * c8), x);
#pragma unroll
          for (int e = 0; e < 8; ++e) stb(KT, 8 * c8 + e, s, x[e]); }
#pragma unroll
        for (int i = 0; i < 2; ++i) { const int s = (tid >> 4) + 32 * i, c8 = tid & 15; float x[8]; unpack8(*(const v4u*)(Pg + (size_t)rows[s] * REC_NP + PC_V + h * 128 + 8 * c8), x); const float sw = vec[256 + s];
#pragma unroll
            for (int e = 0; e < 8; ++e) stb(VsT, 8 * c8 + e, s, x[e] * sw); }
        __syncthreads();
        Acc2 a0, a1; zero(a0); mm_acc(a0, VsT, KT, w, lane); zero(a1); mm_acc(a1, VsT + 64 * LS, KT, w, lane);
        float* dc = wsp<float>(F, WS_DC) + (size_t)u * 8192;
        each(a0, w, lane, [&](int m, int n, float v) { dc[m * 64 + n] = 0.125f * v; });
        each(a1, w, lane, [&](int m, int n, float v) { dc[(64 + m) * 64 + n] = 0.125f * v; });
        if (tid < 64) { float a = 0.f; for (int s = 0; s < 64; ++s) a += vec[256 + s] * bf2f(KT[tid * LS + s]); wsp<float>(F, WS_DN)[(size_t)u * 64 + tid] = 0.125f * a; }
        __syncthreads();
    }
}
__device__ __forceinline__ void l1_mlstm_c2(const Frame& F, int first_blk, int nblk) {
    using namespace rk;
    LAS bf16* Q = (LAS bf16*)F.lds; LAS bf16* K = Q + 64 * LS; LAS bf16* VT = K + 64 * LS; LAS bf16* Cm = VT + 128 * LS; LAS bf16* Pm = Cm + 128 * LS;
    LAS float* OH = (LAS float*)(F.lds + 7 * MB);
    LAS float* vec = (LAS float*)(F.lds + AUX_OFF); LAS int* rows = (LAS int*)vec;
    const bf16* Pg = wsp<const bf16>(F, WS_P); const int tid = F.tid, w = F.wave, lane = F.lane;
    for (int u = F.blk - first_blk; u < NUNIT_M; u += nblk) {
        const int cidx = u / 260, c = u - cidx * 260, z = cidx >> 3, b = (cidx >> 2) & 1, h = cidx & 3;
        mlstm_chunk_head(F, z, b, h, c, vec);
        const float mst = wsp<const float>(F, WS_MST)[u];
        if (tid < 64) { const int t = tid; float pm = -3.0e38f; for (int s = 0; s <= t; ++s) pm = fmaxf(pm, vec[64 + s] - vec[128 + s]);
            const float gi = vec[128 + t] + mst, mo = fmaxf(gi, vec[128 + t] + pm); vec[320 + t] = __expf(gi - mo); vec[384 + t] = mo;
            vec[256 + t] = wsp<const float>(F, WS_NST)[(size_t)u * 64 + t]; }
        { const int t = tid >> 3, c8 = tid & 7;
          *(LAS v4u*)(Q + t * LS + 8 * c8) = *(const v4u*)(Pg + (size_t)rows[t] * REC_NP + PC_Q + h * 64 + 8 * c8);
          *(LAS v4u*)(K + t * LS + 8 * c8) = *(const v4u*)(Pg + (size_t)rows[t] * REC_NP + PC_K + h * 64 + 8 * c8); }
#pragma unroll
        for (int i = 0; i < 2; ++i) { const int s = (tid >> 4) + 32 * i, c8 = tid & 15; const v4u wv = *(const v4u*)(Pg + (size_t)rows[s] * REC_NP + PC_V + h * 128 + 8 * c8);
            const unsigned ww[4] = {wv.x, wv.y, wv.z, wv.w};
#pragma unroll
            for (int e = 0; e < 4; ++e) { VT[(8 * c8 + 2 * e) * LS + s] = (bf16)(ww[e] & 0xffffu); VT[(8 * c8 + 2 * e + 1) * LS + s] = (bf16)(ww[e] >> 16); } }
        { const int v = tid >> 2, dq = (tid & 3) * 16; const f32x4* src = (const f32x4*)(wsp<const float>(F, WS_CST) + (size_t)u * 8192 + v * 64 + dq);
          const f32x4 x0 = src[0], x1 = src[1], x2 = src[2], x3 = src[3]; v4u o0, o1;
          o0.x = pk2(x0.x, x0.y); o0.y = pk2(x0.z, x0.w); o0.z = pk2(x1.x, x1.y); o0.w = pk2(x1.z, x1.w); o1.x = pk2(x2.x, x2.y); o1.y = pk2(x2.z, x2.w); o1.z = pk2(x3.x, x3.y); o1.w = pk2(x3.z, x3.w);
          *(LAS v4u*)(Cm + v * LS + dq) = o0; *(LAS v4u*)(Cm + v * LS + dq + 8) = o1; }
        __syncthreads();
        Acc2 aq, c0, c1; zero(aq); mm_acc(aq, Q, K, w, lane); zero(c0); mm_acc(c0, Q, Cm, w, lane); zero(c1); mm_acc(c1, Q, Cm + 64 * LS, w, lane);
        each(aq, w, lane, [&](int t, int s, float v) { stb(Pm, t, s, s <= t ? 0.125f * v * __expf(vec[128 + t] + (vec[64 + s] - vec[128 + s]) - vec[384 + t]) : 0.f); });
        __syncthreads();
        Acc2 p0, p1; zero(p0); mm_acc(p0, Pm, VT, w, lane); zero(p1); mm_acc(p1, Pm, VT + 64 * LS, w, lane);
        if (tid < 64) { const int t = tid; float rs = 0.f, nq = 0.f;
            for (int s = 0; s < 64; ++s) { rs += bf2f(Pm[t * LS + s]); nq += vec[256 + s] * bf2f(Q[t * LS + s]); }
            const float den = vec[320 + t] * nq + rs; vec[448 + t] = 1.f / fmaxf(fabsf(den), __expf(-vec[384 + t])); }
        __syncthreads();
        { const int m0 = (w >> 1) * 16 + (lane >> 4) * 4, n0 = (w & 1) * 32 + (lane & 15);
#pragma unroll
          for (int r = 0; r < 4; ++r) { const int t = m0 + r; const float g = vec[320 + t], idn = vec[448 + t];
              OH[t * 132 + n0] = (g * c0.t0[r] + p0.t0[r]) * idn; OH[t * 132 + n0 + 16] = (g * c0.t1[r] + p0.t1[r]) * idn;
              OH[t * 132 + 64 + n0] = (g * c1.t0[r] + p1.t0[r]) * idn; OH[t * 132 + 64 + n0 + 16] = (g * c1.t1[r] + p1.t1[r]) * idn; } }
        __syncthreads();
#pragma unroll
        for (int i = 0; i < 4; ++i) { const int it = tid + 512 * i, t = it >> 5, c4 = (it & 31) * 4;
            *(f32x4*)(wsp<float>(F, WS_HM) + ((size_t)z * R + rows[t]) * 512 + h * 128 + c4) = *(const LAS f32x4*)(OH + t * 132 + c4); }
        __syncthreads();
    }
}
#ifndef MK_PER_PHASE
#define MK_PER_PHASE 0
#endif
constexpr int NPHASE = 26;
struct Args { const float* in[N_IN]; float* out; unsigned char* ws; int ph_lo, ph_hi, li, pad; };
#define GEMM_CALL(FnT, SchedT, g, S, fn) do { pg8::EpiGen<FnT> E_{fn}; { int k_ = g.K; asm volatile("" : "+s"(k_)); g.K = k_; } pg8::gemm_phase<pg8::EpiGen<FnT>, SchedT, true, true>((PG8_LAS unsigned char*)F.lds, g, S, E_); } while (0)
#ifndef SITE_MASK
#define SITE_MASK 0xFFFFFFFFull
#endif
#define SITE(s) (((SITE_MASK) >> (s)) & 1ull)
#ifndef DUP_MASK
#define DUP_MASK 0ull
#endif
#define NREP(s) ((((DUP_MASK) >> (s)) & 1ull) ? 2 : 1)
#define IN(k) (lo <= (k) && (k) < hi)
#define SEAM(k) do { if (IN(k) && IN((k) + 1)) xcd_barrier(bar); } while (0)
template <int LAYER> __device__ __forceinline__ void layer_phases(const Frame& F, const XcdBarrier& bar, const int lo, const int hi) {
    constexpr int layer = LAYER; constexpr int pb = 2 + 12 * LAYER;
        if (SITE(2) && IN(pb + 0)) { for (int rep_ = 0; rep_ < NREP(2); ++rep_) {
            const int N = layer == 0 ? ATT_NP : REC_NP;
            pg8::Gemm g{wsp<const bf16>(F, WS_A), layer == 0 ? wsp<const bf16>(F, WS_WIN0) : wsp<const bf16>(F, WS_WREC), R, N, 1024};
            pg8::StaticOrder S; S.init(R, N, F.G, F.blk);
            GEMM_CALL(FnStoreBf16, pg8::StaticOrder, g, S, (FnStoreBf16{wsp<bf16>(F, WS_P), N}));
             if (rep_ + 1 < NREP(2)) xcd_barrier(bar); } SEAM(pb + 0);
        }
        if constexpr (LAYER == 0) {
            if (SITE(3) && IN(pb + 1)) { for (int rep_ = 0; rep_ < NREP(3); ++rep_) { l0_post_proj(F);  if (rep_ + 1 < NREP(3)) xcd_barrier(bar); } SEAM(pb + 1); }
            if (SITE(4) && IN(pb + 2)) { for (int rep_ = 0; rep_ < NREP(4); ++rep_) {
                pg8::Gemm g{wsp<const bf16>(F, WS_CQN), wsp<const bf16>(F, WS_WUQ), R, 768, 384}; pg8::StaticOrder S; S.init(R, 768, F.G, F.blk);
                GEMM_CALL(FnStoreBf16, pg8::StaticOrder, g, S, (FnStoreBf16{wsp<bf16>(F, WS_MQ), 768}));
                 if (rep_ + 1 < NREP(4)) xcd_barrier(bar); } SEAM(pb + 2);
            }
            if (SITE(5) && IN(pb + 3)) { for (int rep_ = 0; rep_ < NREP(5); ++rep_) {
                pg8::Gemm g{wsp<const bf16>(F, WS_CKVN), wsp<const bf16>(F, WS_WUKV), R, 1024, 256}; pg8::StaticOrder S; S.init(R, 1024, F.G, F.blk);
                GEMM_CALL(FnStoreBf16, pg8::StaticOrder, g, S, (FnStoreBf16{wsp<bf16>(F, WS_MKV), 1024}));
                l0_mq_rope(F);
                 if (rep_ + 1 < NREP(5)) xcd_barrier(bar); } SEAM(pb + 3);
            }
            if (SITE(6) && IN(pb + 4)) { for (int rep_ = 0; rep_ < NREP(6); ++rep_) { l0_attention(F);  if (rep_ + 1 < NREP(6)) xcd_barrier(bar); } SEAM(pb + 4); }
            if (SITE(7) && IN(pb + 5)) { for (int rep_ = 0; rep_ < NREP(7); ++rep_) { l0_combine(F);  if (rep_ + 1 < NREP(7)) xcd_barrier(bar); } SEAM(pb + 5); }
        } else {
            if (SITE(8) && IN(pb + 1)) { for (int rep_ = 0; rep_ < NREP(8); ++rep_) { l1_rwkv_prep(F); l1_mlstm_a2(F);  if (rep_ + 1 < NREP(8)) xcd_barrier(bar); } SEAM(pb + 1); }
            if (SITE(9) && IN(pb + 2)) { for (int rep_ = 0; rep_ < NREP(9); ++rep_) {
                pg8::Gemm g{wsp<const bf16>(F, WS_ALORA), wsp<const bf16>(F, WS_WLORA), R, 2560, 384}; pg8::StaticOrder S; S.init(R, 2560, F.G, F.blk);
                { int k_ = g.K; asm volatile("" : "+s"(k_)); g.K = k_; EpiLora E_{&F}; pg8::gemm_phase<EpiLora, pg8::StaticOrder, true, true>((PG8_LAS unsigned char*)F.lds, g, S, E_); }
                l1_mlstm_b(F);
                 if (rep_ + 1 < NREP(9)) xcd_barrier(bar); } SEAM(pb + 2);
            }
            if (SITE(18) && IN(pb + 3)) { for (int rep_ = 0; rep_ < NREP(18); ++rep_) { l1_rk_phase_a(F); if (rep_ + 1 < NREP(18)) xcd_barrier(bar); } SEAM(pb + 3); }
            if (SITE(10) && IN(pb + 4)) { for (int rep_ = 0; rep_ < NREP(10); ++rep_) {
                if (F.G > 32) { if (F.blk < 32) l1_rk_phase_b(F); else { l1_mlstm_c2(F, 32, F.G - 32); moe_weights_convert(F, 1, (F.blk - 32) * 8 + F.wave, (F.G - 32) * 8); } }
                 if (rep_ + 1 < NREP(10)) xcd_barrier(bar); } SEAM(pb + 4);
            }
            if (SITE(11) && IN(pb + 5)) { for (int rep_ = 0; rep_ < NREP(11); ++rep_) { l1_rec_out(F);  if (rep_ + 1 < NREP(11)) xcd_barrier(bar); } SEAM(pb + 5); }
        }
        if (SITE(12) && IN(pb + 6)) { for (int rep_ = 0; rep_ < NREP(12); ++rep_) {
            pg8::Gemm g{wsp<const bf16>(F, WS_A1), wsp<const bf16>(F, WS_WOUT) + (size_t)layer * 1024 * 1024, R, 1024, 1024};
            if constexpr (LAYER == 0) { pg8::StaticOrder S; S.init(R, 1024, F.G, F.blk); GEMM_CALL(FnWout, pg8::StaticOrder, g, S, (FnWout{&F, layer})); }
            else { LatOrder S; S.o.init(R - 2 * CT, 1024, F.G, F.blk); GEMM_CALL(FnWout, LatOrder, g, S, (FnWout{&F, layer})); }
             if (rep_ + 1 < NREP(12)) xcd_barrier(bar); } SEAM(pb + 6);
        }
        if (SITE(13) && IN(pb + 7)) { for (int rep_ = 0; rep_ < NREP(13); ++rep_) { ph_router(F, layer);  if (rep_ + 1 < NREP(13)) xcd_barrier(bar); } SEAM(pb + 7); }
        if (SITE(14) && IN(pb + 8)) { for (int rep_ = 0; rep_ < NREP(14); ++rep_) { ph_gather(F, layer);  if (rep_ + 1 < NREP(14)) xcd_barrier(bar); } SEAM(pb + 8); }
        if (SITE(15) && IN(pb + 9)) { for (int rep_ = 0; rep_ < NREP(15); ++rep_) {
            const int* tab = wsp<const int>(F, WS_TILE);
            pg8::Gemm g{wsp<const bf16>(F, WS_F), wsp<const bf16>(F, WS_W1T), MAXROWS, NE * 2048, 1024}; MoeOrder S{tab + 1, __builtin_amdgcn_readfirstlane(tab[0]), 8, F.G, F.blk, wsp<const int>(F, WS_SRC)};
            { int k_ = g.K; asm volatile("" : "+s"(k_)); g.K = k_; pg8::EpiGen<FnSwiglu> E_{FnSwiglu{wsp<bf16>(F, WS_HS), F.in[I_B1] + (size_t)layer * NE * 2048}};
              pg8::gemm_phase<pg8::EpiGen<FnSwiglu>, MoeOrder, true, true, true>((PG8_LAS unsigned char*)F.lds, g, S, E_); }
             if (rep_ + 1 < NREP(15)) xcd_barrier(bar); } SEAM(pb + 9);
        }
        if (SITE(16) && IN(pb + 10)) { for (int rep_ = 0; rep_ < NREP(16); ++rep_) {
            const int* tab = wsp<const int>(F, WS_TILE);
            pg8::Gemm g{wsp<const bf16>(F, WS_HS), wsp<const bf16>(F, WS_W2T), MAXROWS, NE * 1024, 1024}; MoeOrder S{tab + 1, __builtin_amdgcn_readfirstlane(tab[0]), 4, F.G, F.blk, nullptr};
            GEMM_CALL(FnBiasBf16, MoeOrder, g, S, (FnBiasBf16{wsp<bf16>(F, WS_XS), F.in[I_B2] + (size_t)layer * NE * 1024}));
             if (rep_ + 1 < NREP(16)) xcd_barrier(bar); } SEAM(pb + 10);
        }
        if (SITE(17) && IN(pb + 11)) { for (int rep_ = 0; rep_ < NREP(17); ++rep_) { ph_combine(F, layer);  if (rep_ + 1 < NREP(17)) xcd_barrier(bar); } SEAM(pb + 11); }
}
__global__ void __launch_bounds__(512, 2) fwd(Args args) {
    extern __shared__ __attribute__((aligned(16))) unsigned char lds_[];
    Frame F;
    F.lds = (LAS unsigned char*)lds_; F.tid = threadIdx.x; F.lane = F.tid & 63; F.wave = __builtin_amdgcn_readfirstlane(F.tid >> 6); F.blk = blockIdx.x; F.G = gridDim.x; F.probe = args.pad;
    F.ws = args.ws; F.out = args.out; F.ctl = (gu32*)(args.ws + WS_CTL);
    F.in.t = (LAS const unsigned*)(F.lds + MISC_OFF + 8192);
    if (F.tid < 64) ((LAS unsigned*)(F.lds + MISC_OFF))[F.tid] = 0u;
    if (F.tid < N_IN) { const unsigned long long pv = (unsigned long long)args.in[F.tid]; ((LAS unsigned*)(F.lds + MISC_OFF + 8192))[2 * F.tid] = (unsigned)pv; ((LAS unsigned*)(F.lds + MISC_OFF + 8192))[2 * F.tid + 1] = (unsigned)(pv >> 32); }
    __syncthreads();
    const int lo = args.ph_lo, hi = args.ph_hi;
    XcdBarrier bar; bar.bar = (unsigned*)(F.ctl + CW_BAR) + args.li * XCD_BAR_WORDS; bar.x = 0; bar.st = nullptr;
    if (hi - lo > 1) bar = xcd_barrier_post((unsigned*)(F.ctl + CW_BAR) + args.li * XCD_BAR_WORDS, (volatile LAS unsigned*)(F.lds + MISC_OFF));
    if (SITE(0) && IN(0)) { for (int rep_ = 0; rep_ < NREP(0); ++rep_) { p0a(F);  if (rep_ + 1 < NREP(0)) xcd_barrier(bar); } SEAM(0); }
    if (SITE(1) && IN(1)) { for (int rep_ = 0; rep_ < NREP(1); ++rep_) { p0b(F);  if (rep_ + 1 < NREP(1)) xcd_barrier(bar); } SEAM(1); }
    layer_phases<0>(F, bar, lo, hi);
    layer_phases<1>(F, bar, lo, hi);
}
#undef IN
#undef SEAM


extern "C" void kernel_launch(void* const* d_in, const int* in_sizes, int n_in, void* d_out, int out_size, void* d_ws, size_t ws_size, hipStream_t stream) {
    static int grid = 0;
    if (grid == 0) {
        const bool ok = n_in == N_IN && in_sizes[I_X] == NBATCH * SEQ * DM && in_sizes[I_RECW] == 1024 * REC_IN && in_sizes[I_ATTW] == 1024 * ATT_IN && in_sizes[I_MU] == RWKV_IN &&
                        in_sizes[I_GATEB] == 16 && in_sizes[I_W1] == 2 * NE * 1024 * 2048 && out_size == NBATCH * SEQ * DM && ws_size >= WS_END;
        if (!ok) { fprintf(stderr, "kernel_launch: shape mismatch (n_in %d, recw %d, attw %d, mu %d, out %d, ws %zu need %zu); nothing launched\n", n_in, n_in > I_RECW ? in_sizes[I_RECW] : -1,
                           n_in > I_ATTW ? in_sizes[I_ATTW] : -1, n_in > I_MU ? in_sizes[I_MU] : -1, out_size, ws_size, (size_t)WS_END); grid = -1; return; }
        int dev = 0, cus = 0;
        if (hipGetDevice(&dev) != hipSuccess || hipDeviceGetAttribute(&cus, hipDeviceAttributeMultiprocessorCount, dev) != hipSuccess) { grid = -1; return; }
        if (hipFuncSetAttribute((const void*)fwd, hipFuncAttributeMaxDynamicSharedMemorySize, LDS_BYTES) != hipSuccess) { fprintf(stderr, "kernel_launch: hipFuncSetAttribute failed\n"); grid = -1; return; }
        int per_cu = 0;
        if (hipOccupancyMaxActiveBlocksPerMultiprocessor(&per_cu, (const void*)fwd, 512, LDS_BYTES) != hipSuccess || per_cu < 1) { fprintf(stderr, "kernel_launch: occupancy query says %d blocks per CU\n", per_cu); }
        (void)hipGetLastError();
        grid = cus < 256 ? cus : 256;
        if (grid != 256) fprintf(stderr, "kernel_launch: %d CUs; this kernel is written for a 256-CU device\n", cus);
    }
    if (grid < 0) return;
    if (hipMemsetAsync((char*)d_ws + WS_CTL, 0, CTL_ZERO_BYTES, stream) != hipSuccess) return;
    Args a{};
    for (int i = 0; i < N_IN; ++i) a.in[i] = (const float*)d_in[i];
    a.out = (float*)d_out; a.ws = (unsigned char*)d_ws; a.pad = 0;
#if MK_PER_PHASE
    for (int ph = 0; ph < NPHASE; ++ph) { a.ph_lo = ph; a.ph_hi = ph + 1; a.li = 0; hipLaunchKernelGGL(fwd, dim3(grid), dim3(512), LDS_BYTES, stream, a); }
#elif defined(PROBE_LIST)
    { const int plist[] = {PROBE_LIST}; int cur = 0, li = 0;
      for (int p : plist) { a.ph_lo = cur; a.ph_hi = p + 1; a.li = li++; hipLaunchKernelGGL(fwd, dim3(grid), dim3(512), LDS_BYTES, stream, a);
                            a.ph_lo = p; a.ph_hi = p + 1; a.li = li++; a.pad = 1; hipLaunchKernelGGL(fwd, dim3(grid), dim3(512), LDS_BYTES, stream, a); a.pad = 0; cur = p + 1; }
      if (cur < NPHASE) { a.ph_lo = cur; a.ph_hi = NPHASE; a.li = li++; hipLaunchKernelGGL(fwd, dim3(grid), dim3(512), LDS_BYTES, stream, a); } }
#else
    a.ph_lo = 0; a.ph_hi = NPHASE; a.li = 0; hipLaunchKernelGGL(fwd, dim3(grid), dim3(512), LDS_BYTES, stream, a);
#endif
    const hipError_t le = hipPeekAtLastError();
    if (le != hipSuccess) fprintf(stderr, "kernel_launch: launch failed: %s\n", hipGetErrorName(le));
}
```

```cpp
#include <hip/hip_runtime.h>
#include <cstdio>
#include <cstdint>
#define MK_PER_PHASE 0
namespace pg8 {
#define PG8_LAS __attribute__((address_space(3)))
typedef unsigned short bf16_t;
typedef short bf16x8 __attribute__((ext_vector_type(8)));
typedef float f32x4 __attribute__((ext_vector_type(4)));
typedef unsigned u32x4 __attribute__((ext_vector_type(4)));
constexpr int BM = 256, BK = 64, HALF = 128, HTB = HALF * BK * 2  , STAGE_BYTES = 8 * HTB, NXCD = 8, WGM = 8;

__host__ __device__ __forceinline__ int lds_byte(int r, int c) { const int st = (r >> 4) * 2 + (c >> 5), rr = r & 15, cc = c & 31, ob = rr * 64 + cc * 2; return st * 1024 + (ob ^ (((ob >> 9) & 1) << 5)); }
__host__ __device__ __forceinline__ void stage_rc(int b, int& R, int& C) { const int st = b / 1024, sb = b % 1024, swz = sb ^ (((sb >> 9) & 1) << 5); R = (st >> 1) * 16 + swz / 64; C = (st & 1) * 32 + (swz % 64) / 2; }
__host__ __device__ __forceinline__ int perm32(int rho) { const int n = rho >> 4, i = rho & 15; return 8 * (i >> 2) + 4 * n + (i & 3); }

struct Unit { int pm, pn; };
struct Gemm { const bf16_t* A; const bf16_t* Bt; int M, N, K; };

struct StaticOrder {
    int nM, nN, nwg, G, c;
    __host__ __device__ void init(int M, int N, int G_, int c_) { nM = M / BM; nN = N / BM; nwg = nM * nN; G = G_; c = c_; }
    __host__ __device__ bool next(int i, Unit& u) const {
        const long L = (long)i * G + c; if (L >= nwg) return false;
        int wgid = (int)L; { const int q = nwg / NXCD, r = nwg % NXCD, xcd = wgid % NXCD, off = wgid / NXCD; wgid = (xcd < r ? xcd * (q + 1) : r * (q + 1) + (xcd - r) * q) + off; }
        const int nig = WGM * nN, gid = wgid / nig, fm = gid * WGM, gsz = (nM - fm) < WGM ? (nM - fm) : WGM;
        u.pm = fm + ((wgid % nig) % gsz); u.pn = (wgid % nig) / gsz; return true;
    }
    __device__ __forceinline__ void a_ready(const Unit&) const {}
    __device__ __forceinline__ void done(const Unit&) const {}
};

__device__ __forceinline__ unsigned cvt_pk_bf16(float lo, float hi) { unsigned r; asm volatile("v_cvt_pk_bf16_f32 %0, %1, %2" : "=v"(r) : "v"(lo), "v"(hi)); return r; }
template <class Fn> struct EpiGen {
    static constexpr bool PERM = true, AFTER_DRAIN = false;
    Fn fn;
    __device__ __forceinline__ void operator()(const f32x4 (&acc)[2][2][4][2], const Unit& u, int wr, int wc, int fr, int fq) const {
#pragma unroll
        for (int ai = 0; ai < 2; ++ai)
#pragma unroll
            for (int m = 0; m < 4; ++m) { const int row = u.pm * BM + ai * HALF + wr * 64 + m * 16 + fr;
#pragma unroll
                for (int bj = 0; bj < 2; ++bj) { const int col = u.pn * BM + bj * HALF + wc * 32 + 8 * fq; fn(row, col, acc[ai][bj][m][0], acc[ai][bj][m][1]); } }
    }
};
template <class Epi, class Sched, bool ALIGN_EPI = false, bool SP2 = false, bool GATHER = false>
__device__ __forceinline__ void gemm_phase(PG8_LAS unsigned char* lds, const Gemm g, const Sched& S, const Epi& E) {
    static_assert(!GATHER || SP2, "the gathered A path is written for the SP2 loop");
    const int tid = threadIdx.x, wid = __builtin_amdgcn_readfirstlane(tid >> 6), lane = tid & 63, wr = wid >> 2, wc = wid & 3, fr = lane & 15, fq = lane >> 4;
    const int K = g.K, nt = K / BK;
    unsigned voffA[2], voffB[2]; int gR[2], gC[2]; unsigned gA[2][2], gN[2][2];
#pragma unroll
    for (int i = 0; i < 2; ++i) { int R, C; stage_rc(tid * 16 + i * 8192, R, C); const int Rb = Epi::PERM ? ((R & ~31) + perm32(R & 31)) : R;
        voffA[i] = (unsigned)(R * K + C) * 2u; voffB[i] = (unsigned)(Rb * K + C) * 2u; gR[i] = R; gC[i] = C; }
    const size_t kstep = (size_t)(BK * 2);
    const size_t hstep = (size_t)HALF * K * 2;
    const size_t tstep = 2 * hstep;
    const unsigned ldsw = (unsigned)wid * 1024u;
    const int aoff = lds_byte(wr * 64 + fr, fq * 8), boff = lds_byte(wc * 32 + fr, fq * 8);
#define PG8_SA(b, h) (((b) * 2 + (h)) * HTB)
#define PG8_SB(b, h) ((4 + (b) * 2 + (h)) * HTB)
#define PG8_STAGE(bufoff, gbase, voff) do { _Pragma("unroll") for (int _i = 0; _i < 2; ++_i) \
        __builtin_amdgcn_global_load_lds((const unsigned*)((const char*)(gbase) + (voff)[_i]), (PG8_LAS unsigned*)(lds + (bufoff) + ldsw + _i * 8192), 16, 0, 0); } while (0)
#define PG8_GOFF(u_, out_) do { _Pragma("unroll") for (int _h = 0; _h < 2; ++_h) _Pragma("unroll") for (int _i = 0; _i < 2; ++_i) \
        out_[_h][_i] = ((unsigned)S.src[(u_).pm * BM + _h * HALF + gR[_i]] * (unsigned)K + (unsigned)gC[_i]) * 2u; } while (0)
#define PG8_STAGE_A(bufoff, kptr, h, isnext) do { if constexpr (GATHER) { unsigned _o[2]; _o[0] = (isnext) ? gN[h][0] : gA[h][0]; _o[1] = (isnext) ? gN[h][1] : gA[h][1]; PG8_STAGE(bufoff, kptr, _o); } \
        else { PG8_STAGE(bufoff, (kptr) + (h) * hstep, voffA); } } while (0)
#define PG8_LDA(dst, b, h) do { _Pragma("unroll") for (int m = 0; m < 4; ++m) _Pragma("unroll") for (int k = 0; k < 2; ++k) dst[m][k] = *(const PG8_LAS bf16x8*)(lds + PG8_SA(b, h) + aoff + m * 2048 + k * 1024); } while (0)
#define PG8_LDB(dst, b, h) do { _Pragma("unroll") for (int n = 0; n < 2; ++n) _Pragma("unroll") for (int k = 0; k < 2; ++k) dst[n][k] = *(const PG8_LAS bf16x8*)(lds + PG8_SB(b, h) + boff + n * 2048 + k * 1024); } while (0)
#define PG8_MMA(ai, bj, At, Bt) do { __builtin_amdgcn_s_setprio(1); _Pragma("unroll") for (int m = 0; m < 4; ++m) _Pragma("unroll") for (int n = 0; n < 2; ++n) _Pragma("unroll") for (int k = 0; k < 2; ++k) \
        acc[ai][bj][m][n] = __builtin_amdgcn_mfma_f32_16x16x32_bf16(Bt[n][k], At[m][k], acc[ai][bj][m][n], 0, 0, 0); __builtin_amdgcn_s_setprio(0); } while (0)
#define PG8_WAIT_V(n) asm volatile("s_waitcnt vmcnt(" #n ")" ::: "memory")
#define PG8_WAIT_L(n) asm volatile("s_waitcnt lgkmcnt(" #n ")" ::: "memory")
#define PG8_BAR __builtin_amdgcn_s_barrier()
#define PG8_SCHED __builtin_amdgcn_sched_barrier(0)
    Unit cur, nxt; int ui = 0;
    if (!S.next(0, cur)) return;
    f32x4 acc[2][2][4][2];
#pragma unroll
    for (int a = 0; a < 2; ++a)
#pragma unroll
        for (int b = 0; b < 2; ++b)
#pragma unroll
            for (int m = 0; m < 4; ++m)
#pragma unroll
                for (int n = 0; n < 2; ++n) acc[a][b][m][n] = (f32x4){0.f, 0.f, 0.f, 0.f};
    bf16x8 At[4][2], B0[2][2], B1[2][2];
    const char* cA = (const char*)g.A + (GATHER ? (size_t)0 : (size_t)cur.pm * tstep); const char* cB = (const char*)g.Bt + (size_t)cur.pn * tstep;
    if constexpr (GATHER) PG8_GOFF(cur, gA);
    S.a_ready(cur);
    if constexpr (SP2) {
        PG8_STAGE(PG8_SB(0, 0), cB, voffB); PG8_STAGE(PG8_SB(0, 1), cB + hstep, voffB); PG8_STAGE_A(PG8_SA(0, 0), cA, 0, false); PG8_STAGE_A(PG8_SA(0, 1), cA, 1, false);
        if (wr == 1) PG8_BAR;
        PG8_WAIT_V(2); PG8_BAR;
        PG8_STAGE(PG8_SB(1, 0), cB + kstep, voffB); PG8_STAGE_A(PG8_SA(1, 0), cA + kstep, 0, false); PG8_STAGE(PG8_SB(1, 1), cB + hstep + kstep, voffB);
        PG8_WAIT_V(6); PG8_BAR;
    } else {
        PG8_STAGE(PG8_SB(0, 0), cB, voffB); PG8_STAGE(PG8_SA(0, 0), cA, voffA); PG8_STAGE(PG8_SB(0, 1), cB + hstep, voffB); PG8_STAGE(PG8_SA(0, 1), cA + hstep, voffA);
        if (wr == 1) PG8_BAR;
        PG8_WAIT_V(4); PG8_BAR;
        PG8_STAGE(PG8_SB(1, 0), cB + kstep, voffB); PG8_STAGE(PG8_SA(1, 0), cA + kstep, voffA); PG8_STAGE(PG8_SB(1, 1), cB + hstep + kstep, voffB);
        PG8_WAIT_V(6); PG8_BAR;
    }
    for (;;) {
        const bool has_next = S.next(ui + 1, nxt);
        const char* nA = (has_next && !GATHER) ? (const char*)g.A + (size_t)nxt.pm * tstep : cA; const char* nB = has_next ? (const char*)g.Bt + (size_t)nxt.pn * tstep : cB;
        if constexpr (GATHER) { if (has_next) PG8_GOFF(nxt, gN); else { _Pragma("unroll") for (int _h = 0; _h < 2; ++_h) { gN[_h][0] = gA[_h][0]; gN[_h][1] = gA[_h][1]; } } }
        for (int t = 0; t < nt; t += 2) {
            const bool last = (t == nt - 2);
            const char* a1 = cA + (size_t)(t + 1) * kstep;
            const char* a2 = last ? nA : cA + (size_t)(t + 2) * kstep; const char* b2 = last ? nB : cB + (size_t)(t + 2) * kstep;
            const char* a3 = a2 + kstep; const char* b3 = b2 + kstep;
            if (last && has_next) S.a_ready(nxt);
            if constexpr (SP2) {
            PG8_LDB(B0, 0, 0); PG8_LDB(B1, 0, 1); PG8_SCHED; PG8_LDA(At, 0, 0); PG8_STAGE_A(PG8_SA(1, 1), a1, 1, false);
            PG8_WAIT_V(8); PG8_WAIT_L(0); PG8_BAR; PG8_MMA(0, 0, At, B0); PG8_MMA(0, 1, At, B1); PG8_BAR; PG8_SCHED;
            PG8_LDA(At, 0, 1); PG8_STAGE(PG8_SB(0, 0), b2, voffB); PG8_STAGE(PG8_SB(0, 1), b2 + hstep, voffB); PG8_STAGE_A(PG8_SA(0, 0), a2, 0, last);
            PG8_WAIT_V(8); PG8_WAIT_L(0); PG8_BAR; PG8_MMA(1, 0, At, B0); PG8_MMA(1, 1, At, B1); PG8_BAR; PG8_SCHED;
            PG8_LDB(B0, 1, 0); PG8_LDB(B1, 1, 1); PG8_SCHED; PG8_LDA(At, 1, 0); PG8_STAGE_A(PG8_SA(0, 1), a2, 1, last);
            PG8_WAIT_V(8); PG8_WAIT_L(0); PG8_BAR; PG8_MMA(0, 0, At, B0); PG8_MMA(0, 1, At, B1); PG8_BAR; PG8_SCHED;
            PG8_LDA(At, 1, 1); PG8_STAGE(PG8_SB(1, 0), b3, voffB); PG8_STAGE(PG8_SB(1, 1), b3 + hstep, voffB); PG8_STAGE_A(PG8_SA(1, 0), a3, 0, last);
            PG8_WAIT_V(8); PG8_WAIT_L(0); PG8_BAR; PG8_MMA(1, 0, At, B0); PG8_MMA(1, 1, At, B1); PG8_BAR; PG8_SCHED;
            } else {
            PG8_LDB(B0, 0, 0); PG8_SCHED; PG8_LDA(At, 0, 0); PG8_STAGE(PG8_SA(1, 1), a1 + hstep, voffA);
            PG8_WAIT_L(8); PG8_BAR; PG8_WAIT_L(0); PG8_MMA(0, 0, At, B0); PG8_BAR; PG8_SCHED;
            PG8_LDB(B1, 0, 1); PG8_STAGE(PG8_SB(0, 0), b2, voffB);
            PG8_BAR; PG8_WAIT_L(0); PG8_MMA(0, 1, At, B1); PG8_BAR;
            PG8_LDA(At, 0, 1); PG8_STAGE(PG8_SA(0, 0), a2, voffA);
            PG8_BAR; PG8_WAIT_L(0); PG8_MMA(1, 0, At, B0); PG8_BAR; PG8_SCHED;
            PG8_STAGE(PG8_SB(0, 1), b2 + hstep, voffB);
            PG8_WAIT_V(6); PG8_BAR; PG8_MMA(1, 1, At, B1); PG8_BAR;
            PG8_LDB(B0, 1, 0); PG8_SCHED; PG8_LDA(At, 1, 0); PG8_STAGE(PG8_SA(0, 1), a2 + hstep, voffA);
            PG8_WAIT_L(8); PG8_BAR; PG8_WAIT_L(0); PG8_MMA(0, 0, At, B0); PG8_BAR; PG8_SCHED;
            PG8_LDB(B1, 1, 1); PG8_STAGE(PG8_SB(1, 0), b3, voffB);
            PG8_BAR; PG8_WAIT_L(0); PG8_MMA(0, 1, At, B1); PG8_BAR;
            PG8_LDA(At, 1, 1); PG8_STAGE(PG8_SA(1, 0), a3, voffA);
            PG8_BAR; PG8_WAIT_L(0); PG8_MMA(1, 0, At, B0); PG8_BAR; PG8_SCHED;
            PG8_STAGE(PG8_SB(1, 1), b3 + hstep, voffB);
            PG8_WAIT_V(6); PG8_BAR; PG8_MMA(1, 1, At, B1); PG8_BAR;
            }
        }
        if constexpr (ALIGN_EPI) { if (wr == 0) PG8_BAR; }
        if constexpr (!Epi::AFTER_DRAIN) { E(acc, cur, wr, wc, fr, fq); S.done(cur); }
        if (!has_next) break;
#pragma unroll
        for (int a = 0; a < 2; ++a)
#pragma unroll
            for (int b = 0; b < 2; ++b)
#pragma unroll
                for (int m = 0; m < 4; ++m)
#pragma unroll
                    for (int n = 0; n < 2; ++n) acc[a][b][m][n] = (f32x4){0.f, 0.f, 0.f, 0.f};
        cur = nxt; cA = nA; cB = nB; ++ui;
        if constexpr (GATHER) { _Pragma("unroll") for (int _h = 0; _h < 2; ++_h) { gA[_h][0] = gN[_h][0]; gA[_h][1] = gN[_h][1]; } }
        if constexpr (ALIGN_EPI) { if (wr == 1) PG8_BAR; }
    }
    PG8_WAIT_V(0);
    if constexpr (!ALIGN_EPI) { if (wr == 0) PG8_BAR; }
    PG8_BAR;
    if constexpr (Epi::AFTER_DRAIN) { E.fused(acc, cur, wr, wc, fr, fq, lds, wid, lane); S.done(cur); }
#undef PG8_SA
#undef PG8_SB
#undef PG8_STAGE
#undef PG8_STAGE_A
#undef PG8_GOFF
#undef PG8_LDA
#undef PG8_LDB
#undef PG8_MMA
#undef PG8_WAIT_V
#undef PG8_WAIT_L
#undef PG8_BAR
#undef PG8_SCHED
}
}
#define GAS __attribute__((address_space(1)))
#define LAS __attribute__((address_space(3)))
typedef unsigned short bf16;
typedef unsigned v4u __attribute__((ext_vector_type(4)));
typedef unsigned v2u __attribute__((ext_vector_type(2)));
typedef float f32x4 __attribute__((ext_vector_type(4)));
typedef short bf16x8 __attribute__((ext_vector_type(8)));
typedef GAS unsigned gu32;
typedef GAS unsigned long long gu64;
#define RLX_AGENT __ATOMIC_RELAXED, __HIP_MEMORY_SCOPE_AGENT
#define LDS_WAIT() asm volatile("s_waitcnt lgkmcnt(0)" ::: "memory")
#define VM_WAIT() asm volatile("s_waitcnt vmcnt(0)" ::: "memory")
typedef float f32x2_cv __attribute__((ext_vector_type(2)));
typedef __bf16 bf16x2_cv __attribute__((ext_vector_type(2)));
__device__ __forceinline__ unsigned pk2(float lo, float hi) { const f32x2_cv v = {lo, hi}; return __builtin_bit_cast(unsigned, __builtin_convertvector(v, bf16x2_cv)); }
__device__ __forceinline__ unsigned f2bf(float f) { return (unsigned)__builtin_bit_cast(unsigned short, (__bf16)f); }
__device__ __forceinline__ float bflo(unsigned w) { return __builtin_bit_cast(float, w << 16); }
__device__ __forceinline__ float bfhi(unsigned w) { return __builtin_bit_cast(float, w & 0xffff0000u); }
__device__ __forceinline__ float bf2f(bf16 b) { return __builtin_bit_cast(float, (unsigned)b << 16); }
__device__ __forceinline__ void unpack8(v4u w, float (&x)[8]) { x[0] = bflo(w.x); x[1] = bfhi(w.x); x[2] = bflo(w.y); x[3] = bfhi(w.y); x[4] = bflo(w.z); x[5] = bfhi(w.z); x[6] = bflo(w.w); x[7] = bfhi(w.w); }
__device__ __forceinline__ float wave_sum(float v) {
#pragma unroll
    for (int o = 1; o < 64; o <<= 1) v += __shfl_xor(v, o);
    return v;
}
__device__ __forceinline__ float sigmoidf_(float x) { return 1.f / (1.f + __expf(-x)); }

#define XB_TMO      128
#define XB_XCNT(j)  (256  + 64 * (j))
#define XB_XSUB(j)  (1280 + 64 * (j))
#define XB_XGEN(j)  (2304 + 64 * (j))
#define XB_TOP      3328
#define XB_TOPGEN   3392
#define XCD_BAR_WORDS 3456
#define XB_SPIN_CAP (1u << 22)

__device__ __forceinline__ unsigned xb_ld(unsigned* p)              { return __hip_atomic_load(p, __ATOMIC_RELAXED, __HIP_MEMORY_SCOPE_AGENT); }
__device__ __forceinline__ unsigned xb_add(unsigned* p, unsigned v) { return __hip_atomic_fetch_add(p, v, __ATOMIC_RELAXED, __HIP_MEMORY_SCOPE_AGENT); }
__device__ __forceinline__ unsigned xb_xcc_id() { return (unsigned)__builtin_amdgcn_s_getreg((3 << 11) | 20) & 0xFu; }
#define XB_SPIN(cond, bar) do { unsigned _sp = 0; while (cond) { __builtin_amdgcn_s_sleep(1); \
    if ((++_sp & 255u) == 0u) { if (xb_ld(&(bar)[XB_TMO])) break; if (_sp > XB_SPIN_CAP) { atomicAdd(&(bar)[XB_TMO], 1u); break; } } } } while (0)

struct XcdBarrier {
    unsigned* bar; unsigned x;
    volatile LAS unsigned* st;
};

__device__ __forceinline__ XcdBarrier xcd_barrier_post(unsigned* bar, volatile LAS unsigned* st) {
    XcdBarrier b; b.bar = bar; b.x = xb_xcc_id(); b.st = st;
    if (threadIdx.x == 0) (void)xb_add(&bar[XB_XCNT(b.x)], 1u);
    return b;
}
__device__ __forceinline__ void xcd_barrier_complete(unsigned* bar, unsigned x, unsigned& nloc, unsigned& nx) {
    const unsigned G = gridDim.x * gridDim.y * gridDim.z;
    unsigned sum, cnt, mine, sp = 0u;
    for (;;) {
        sum = 0u; cnt = 0u; mine = 0u;
#pragma unroll
        for (unsigned j = 0; j < 16; ++j) { const unsigned c = xb_ld(&bar[XB_XCNT(j)]); sum += c; cnt += (c > 0u) ? 1u : 0u; mine = (j == x) ? c : mine; }
        if (sum == G) break;
        __builtin_amdgcn_s_sleep(1);
        if ((++sp & 255u) == 0u) { if (xb_ld(&bar[XB_TMO])) break; if (sp > XB_SPIN_CAP) { atomicAdd(&bar[XB_TMO], 1u); break; } }
    }
    nloc = mine > 0u ? mine : 1u; nx = cnt > 0u ? cnt : 1u;
}

__device__ __forceinline__ void xcd_barrier(const XcdBarrier& b) {
    asm volatile("s_waitcnt vmcnt(0)" ::: "memory");
    __syncthreads();
    if (threadIdx.x == 0) {
        unsigned* bar = b.bar;
        __builtin_amdgcn_s_waitcnt(0);
        unsigned nloc = b.st[0], nx = b.st[1];
        if (nloc == 0u) { xcd_barrier_complete(bar, b.x, nloc, nx); b.st[0] = nloc; b.st[1] = nx; }
        const unsigned old = xb_add(&bar[XB_XSUB(b.x)], 1u);
        const unsigned gen = old / nloc;
        if (old + 1u == (gen + 1u) * nloc) {
            __builtin_amdgcn_fence(__ATOMIC_RELEASE, "agent");
            asm volatile("s_waitcnt vmcnt(0)" ::: "memory");
            const unsigned og = xb_add(&bar[XB_TOP], 1u);
            const unsigned tg = og / nx;
            if (og + 1u == (tg + 1u) * nx) xb_add(&bar[XB_TOPGEN], 1u);
            else XB_SPIN(xb_ld(&bar[XB_TOPGEN]) == tg, bar);
            __builtin_amdgcn_fence(__ATOMIC_ACQUIRE, "agent");
            xb_add(&bar[XB_XGEN(b.x)], 1u);
            asm volatile("s_waitcnt vmcnt(0)" ::: "memory");
        } else {
            XB_SPIN(xb_ld(&bar[XB_XGEN(b.x)]) == gen, bar);
            __builtin_amdgcn_fence(__ATOMIC_ACQUIRE, "agent");
            asm volatile("s_waitcnt vmcnt(0)" ::: "memory");
        }
    }
    __syncthreads();
}
namespace att {
using s16x4  = __attribute__((ext_vector_type(4))) short;
using f32x16 = __attribute__((ext_vector_type(16))) float;
using u32x4  = __attribute__((ext_vector_type(4))) unsigned;
#define ATT_SBAR() __builtin_amdgcn_sched_barrier(0)
constexpr float THR2 = 11.5f;
__device__ __forceinline__ int crow(int r, int hi) { return (r & 3) + 8 * (r >> 2) + 4 * hi; }
__device__ __forceinline__ unsigned cvtpk(float lo, float hi) { unsigned r; asm volatile("v_cvt_pk_bf16_f32 %0, %1, %2" : "=v"(r) : "v"(lo), "v"(hi)); return r; }

__device__ __forceinline__ void partialSM(f32x16& p0, f32x16& p1, float& m_reg, float& mn, float& alpha) {
  float pmax = p0[0];
#pragma unroll
  for (int r = 1; r < 16; ++r) pmax = fmaxf(pmax, p0[r]);
#pragma unroll
  for (int r = 0; r < 16; ++r) pmax = fmaxf(pmax, p1[r]);
  { auto rr = __builtin_amdgcn_permlane32_swap(__float_as_uint(pmax), __float_as_uint(pmax), false, false);
    pmax = fmaxf(__uint_as_float(rr[0]), __uint_as_float(rr[1])); }
  if (__builtin_expect(__all(pmax - m_reg <= THR2), 1)) { mn = m_reg; alpha = 1.f; }
  else { mn = fmaxf(m_reg, pmax); alpha = __builtin_amdgcn_exp2f(m_reg - mn); m_reg = mn; }
#pragma unroll
  for (int r = 0; r < 16; ++r) p0[r] = p0[r] - mn;
#pragma unroll
  for (int r = 0; r < 16; ++r) p1[r] = p1[r] - mn;
#pragma unroll
  for (int r = 0; r < 16; ++r) p0[r] = __builtin_amdgcn_exp2f(p0[r]);
}
__device__ __forceinline__ void finishSM(f32x16& p0, f32x16& p1, bf16x8& pa0, bf16x8& pa1, bf16x8& pa2, bf16x8& pa3) {
#pragma unroll
  for (int r = 0; r < 16; ++r) p1[r] = __builtin_amdgcn_exp2f(p1[r]);
#define ATT_PK4(P, BASE, OUT) do { unsigned a0 = cvtpk(P[BASE + 0], P[BASE + 1]), a1 = cvtpk(P[BASE + 2], P[BASE + 3]);   \
    unsigned b0 = cvtpk(P[BASE + 4], P[BASE + 5]), b1 = cvtpk(P[BASE + 6], P[BASE + 7]);                              \
    auto r0 = __builtin_amdgcn_permlane32_swap(a0, b0, false, false); auto r1 = __builtin_amdgcn_permlane32_swap(a1, b1, false, false); \
    u32x4 w = {r0[0], r1[0], r0[1], r1[1]}; OUT = *reinterpret_cast<bf16x8*>(&w); } while (0)
  ATT_PK4(p0, 0, pa0); ATT_PK4(p0, 8, pa1); ATT_PK4(p1, 0, pa2); ATT_PK4(p1, 8, pa3);
#undef ATT_PK4
}
template <int NB> __device__ __forceinline__ int v_st(int k, int c) { const int kk = (k & ~0xC) | ((k & 4) << 1) | ((k & 8) >> 1); return ((kk >> 3) * NB + (c >> 5)) * 512 + ((kk & 7) * 32 + (c & 31)) * 2; }
__device__ __forceinline__ int v_rd_base(int lane) { return ((lane & 3) << 3) | (((lane >> 2) & 3) << 6) | (((lane >> 4) & 1) << 5) | (((lane >> 5) & 1) << 8); }
template <int OFF> __device__ __forceinline__ s16x4 tr_read(int vb) {
  s16x4 r; asm volatile("ds_read_b64_tr_b16 %0, %1 offset:%2" : "=&v"(r) : "v"(vb), "i"(OFF) : "memory"); return r;
}
template <int NB, int D0> __device__ __forceinline__ void pv_rd(s16x4 (&f)[8], int vb) {
#define ATT_VOFF(ks, half) (D0 * 512 + (ks) * (NB * 1024) + (half) * (NB * 512))
  f[0] = tr_read<ATT_VOFF(0, 0)>(vb); f[1] = tr_read<ATT_VOFF(0, 1)>(vb); f[2] = tr_read<ATT_VOFF(1, 0)>(vb); f[3] = tr_read<ATT_VOFF(1, 1)>(vb);
  f[4] = tr_read<ATT_VOFF(2, 0)>(vb); f[5] = tr_read<ATT_VOFF(2, 1)>(vb); f[6] = tr_read<ATT_VOFF(3, 0)>(vb); f[7] = tr_read<ATT_VOFF(3, 1)>(vb);
#undef ATT_VOFF
}
__device__ __forceinline__ void pv_mm(f32x16& od, const s16x4 (&f)[8], bf16x8 pa0, bf16x8 pa1, bf16x8 pa2, bf16x8 pa3) {
#define ATT_PK(L, H) (bf16x8){L[0], L[1], L[2], L[3], H[0], H[1], H[2], H[3]}
  od = __builtin_amdgcn_mfma_f32_32x32x16_bf16(pa0, ATT_PK(f[0], f[1]), od, 0, 0, 0);
  od = __builtin_amdgcn_mfma_f32_32x32x16_bf16(pa1, ATT_PK(f[2], f[3]), od, 0, 0, 0);
  od = __builtin_amdgcn_mfma_f32_32x32x16_bf16(pa2, ATT_PK(f[4], f[5]), od, 0, 0, 0);
  od = __builtin_amdgcn_mfma_f32_32x32x16_bf16(pa3, ATT_PK(f[6], f[7]), od, 0, 0, 0);
#undef ATT_PK
}
#define ATT_LWAIT(n) do { asm volatile("s_waitcnt lgkmcnt(" #n ")" ::: "memory"); ATT_SBAR(); } while (0)
template <int NB> __device__ __forceinline__ void pv_all(f32x16* o, f32x16& lsum, int vb, bf16x8 pa0, bf16x8 pa1, bf16x8 pa2, bf16x8 pa3) {
  const bf16x8 ones = {0x3F80, 0x3F80, 0x3F80, 0x3F80, 0x3F80, 0x3F80, 0x3F80, 0x3F80};
  s16x4 fa[8], fb[8];
  pv_rd<NB, 0>(fa, vb); pv_rd<NB, 1>(fb, vb);
  lsum = __builtin_amdgcn_mfma_f32_32x32x16_bf16(pa0, ones, lsum, 0, 0, 0); lsum = __builtin_amdgcn_mfma_f32_32x32x16_bf16(pa1, ones, lsum, 0, 0, 0);
  lsum = __builtin_amdgcn_mfma_f32_32x32x16_bf16(pa2, ones, lsum, 0, 0, 0); lsum = __builtin_amdgcn_mfma_f32_32x32x16_bf16(pa3, ones, lsum, 0, 0, 0);
  ATT_LWAIT(8); pv_mm(o[0], fa, pa0, pa1, pa2, pa3);
  if constexpr (NB == 4) {
    pv_rd<NB, 2>(fa, vb); ATT_LWAIT(8); pv_mm(o[1], fb, pa0, pa1, pa2, pa3);
    pv_rd<NB, 3>(fb, vb); ATT_LWAIT(8); pv_mm(o[2], fa, pa0, pa1, pa2, pa3);
    ATT_LWAIT(0); pv_mm(o[3], fb, pa0, pa1, pa2, pa3);
  } else { ATT_LWAIT(0); pv_mm(o[1], fb, pa0, pa1, pa2, pa3); }
}
template <int DK> __device__ __forceinline__ void qkt(f32x16& p0, f32x16& p1, LAS const char* Ks, const bf16x8* qr, int r32, int hi) {
  constexpr int KSTR = DK * 2 + 16;
  p0 = f32x16{}; p1 = f32x16{};
#pragma unroll
  for (int d0 = 0; d0 < DK / 16; ++d0) { const int cb = (d0 * 16 + hi * 8) * 2;
    const bf16x8 b0 = *(LAS const bf16x8*)(Ks + r32 * KSTR + cb);
    const bf16x8 b1 = *(LAS const bf16x8*)(Ks + (32 + r32) * KSTR + cb);
    p0 = __builtin_amdgcn_mfma_f32_32x32x16_bf16(b0, qr[d0], p0, 0, 0, 0);
    p1 = __builtin_amdgcn_mfma_f32_32x32x16_bf16(b1, qr[d0], p1, 0, 0, 0); }
}
template <int DK, int DV> struct Cfg {
  static constexpr int KSTR = DK * 2 + 16, KT = 64 * KSTR, NB = DV / 32, VT = 64 * DV * 2, NQ = DK / 16;
  static constexpr int NKC = DK / 8, NVC = DV / 8;
  static constexpr int KN = (64 * NKC + 511) / 512, VN = (64 * NVC + 511) / 512;
  static constexpr int OFF_V = 0, OFF_K = 2 * VT, OFF_WS = 2 * VT + 2 * KT, LDS_BYTES = OFF_WS + 8 * 64 * 4;
};
template <int DK, int DV>
__device__ __forceinline__ void attn_unit(const bf16* __restrict__ Qb, int ldq, const bf16* __restrict__ K1, int ldk1, const bf16* __restrict__ K2, int ldk2,
                                          const bf16* __restrict__ Vh, int ldv, float* __restrict__ Ob, int ldo, int nkeys, LAS char* lds) {
  using C = Cfg<DK, DV>;
  const int tid = threadIdx.x, wid = tid >> 6, lane = tid & 63, r32 = lane & 31, hi = lane >> 5;
  LAS char* V_lds = lds + C::OFF_V; LAS char* K_lds = lds + C::OFF_K;
  LAS float* ws = (LAS float*)(lds + C::OFF_WS) + wid * 64; LAS float* li_l = ws; LAS float* al_l = ws + 32;
  float m_reg = -1e30f; f32x16 o[C::NB] = {}; f32x16 lsum = {}; bf16x8 qr[C::NQ];
  { const bf16* Qw = Qb + (long)(wid * 32 + r32) * ldq + hi * 8;
#pragma unroll
    for (int d0 = 0; d0 < C::NQ; ++d0) qr[d0] = *(const bf16x8*)(Qw + d0 * 16); }
  unsigned kg[C::KN], kw[C::KN], vg[C::VN], vw[C::VN]; const bool k2val = tid < 256;
  kg[0] = (unsigned)((tid >> 3) * ldk1 + (tid & 7) * 8); kw[0] = (unsigned)((tid >> 3) * C::KSTR + (tid & 7) * 16);
  if constexpr (C::KN == 2) { const int t2 = tid & 255; kg[1] = (unsigned)((t2 >> 2) * ldk2 + (t2 & 3) * 8); kw[1] = (unsigned)((t2 >> 2) * C::KSTR + (8 + (t2 & 3)) * 16); }
#pragma unroll
  for (int i = 0; i < C::VN; ++i) { const int it = tid + 512 * i, vrow = it / C::NVC, vcol = (it % C::NVC) * 8; vg[i] = (unsigned)(vrow * ldv + vcol); vw[i] = (unsigned)v_st<C::NB>(vrow, vcol); }
  const int vb0 = (int)(uintptr_t)V_lds + v_rd_base(lane);
  struct Slot { bf16x8 ks[C::KN], vs[C::VN]; } sS;
#define ATT_SLOAD(S, k0) do { S.ks[0] = *(const bf16x8*)(K1 + (size_t)(k0) * ldk1 + kg[0]); if constexpr (C::KN == 2) S.ks[1] = *(const bf16x8*)(K2 + (size_t)(k0) * ldk2 + kg[1]); \
    _Pragma("unroll") for (int i = 0; i < C::VN; ++i) S.vs[i] = *(const bf16x8*)(Vh + (size_t)(k0) * ldv + vg[i]); } while (0)
#define ATT_SWRITE(b, S) do { *(LAS bf16x8*)(K_lds + (b) * C::KT + kw[0]) = S.ks[0]; if constexpr (C::KN == 2) { if (k2val) *(LAS bf16x8*)(K_lds + (b) * C::KT + kw[1]) = S.ks[1]; } \
    _Pragma("unroll") for (int i = 0; i < C::VN; ++i) *(LAS bf16x8*)(V_lds + (b) * C::VT + vw[i]) = S.vs[i]; } while (0)
#define ATT_SWAIT() asm volatile("s_waitcnt vmcnt(0)" ::: "memory")
#define ATT_RESC(a) do { if (__any((a) < 1.f)) { if (hi == 0) al_l[r32] = (a); asm volatile("s_waitcnt lgkmcnt(0)" ::: "memory"); \
    _Pragma("unroll") for (int r = 0; r < 16; ++r) { const float f_ = al_l[crow(r, hi)]; lsum[r] *= f_; _Pragma("unroll") for (int d = 0; d < C::NB; ++d) o[d][r] *= f_; } } } while (0)
  static_assert(C::KN + C::VN == 3, "three staging loads per thread per tile (ATT_SWAIT)");
  f32x16 pA0, pA1, pB0, pB1; float mnA, mnB, alA, alB; bf16x8 pa0, pa1, pa2, pa3; const int NT = nkeys / 64;
  __syncthreads();
  ATT_SLOAD(sS, 0); asm volatile("s_waitcnt vmcnt(0)" ::: "memory"); ATT_SWRITE(0, sS); __syncthreads();
  qkt<DK>(pA0, pA1, K_lds, qr, r32, hi); partialSM(pA0, pA1, m_reg, mnA, alA);
  ATT_SLOAD(sS, 64);
  ATT_SWAIT(); ATT_SWRITE(1, sS); __syncthreads();
  for (int j = 1; j + 1 < NT; j += 2) {
    ATT_SBAR(); qkt<DK>(pB0, pB1, K_lds + C::KT, qr, r32, hi);
    finishSM(pA0, pA1, pa0, pa1, pa2, pa3); ATT_SBAR();
    ATT_SLOAD(sS, (j + 1) * 64); ATT_SBAR();
    pv_all<C::NB>(o, lsum, vb0, pa0, pa1, pa2, pa3); partialSM(pB0, pB1, m_reg, mnB, alB);
    __syncthreads(); ATT_SWAIT(); ATT_SWRITE(0, sS);
    ATT_RESC(alB); __syncthreads();
    ATT_SBAR(); qkt<DK>(pA0, pA1, K_lds, qr, r32, hi);
    finishSM(pB0, pB1, pa0, pa1, pa2, pa3); ATT_SBAR();
    ATT_SLOAD(sS, (j + 2) * 64); ATT_SBAR();
    pv_all<C::NB>(o, lsum, vb0 + C::VT, pa0, pa1, pa2, pa3); partialSM(pA0, pA1, m_reg, mnA, alA);
    __syncthreads(); ATT_SWAIT(); ATT_SWRITE(1, sS);
    ATT_RESC(alA); __syncthreads();
  }
  ATT_SBAR(); qkt<DK>(pB0, pB1, K_lds + C::KT, qr, r32, hi);
  finishSM(pA0, pA1, pa0, pa1, pa2, pa3); ATT_SBAR();
  pv_all<C::NB>(o, lsum, vb0, pa0, pa1, pa2, pa3); partialSM(pB0, pB1, m_reg, mnB, alB);
  __syncthreads(); ATT_RESC(alB);
  finishSM(pB0, pB1, pa0, pa1, pa2, pa3); ATT_SBAR();
  pv_all<C::NB>(o, lsum, vb0 + C::VT, pa0, pa1, pa2, pa3);
  float rli[16];
#pragma unroll
  for (int r = 0; r < 16; ++r) rli[r] = __builtin_amdgcn_rcpf(lsum[r]);
  float* Ow = Ob + (long)(wid * 32) * ldo;
#pragma unroll
  for (int r = 0; r < 16; ++r) { const int orow = crow(r, hi);
#pragma unroll
    for (int d0 = 0; d0 < C::NB; ++d0) Ow[(long)orow * ldo + d0 * 32 + r32] = o[d0][r] * rli[r]; }
#undef ATT_SLOAD
#undef ATT_SWRITE
#undef ATT_SWAIT
#undef ATT_RESC
}
}
constexpr int DM = 1024, NBATCH = 2, SEQ = 16384, CT = 256, TB = SEQ + CT  , R = NBATCH * TB  ;
constexpr int ATT_IN = 2208, ATT_NP = 2304, REC_IN = 3472, REC_NP = 3584, RWKV_IN = 1920;
constexpr int NE = 32, TOPK = 4, MAXT = R * TOPK / 256 + NE  , MAXROWS = MAXT * 256;
constexpr int NUNIT_M = 16 * 260;
constexpr float NORM_EPS = 1e-6f;
enum { I_X = 0, I_C, I_CTX, I_CCTX, I_NMIX, I_NFFN, I_ADAW, I_ADAB, I_WOUT, I_RW, I_RB, I_W1, I_B1, I_W2, I_B2, I_ATTW, I_LAM, I_SUBLN, I_QNW, I_KVNW, I_WUQ, I_WUKV,
       I_RECW, I_MU, I_W0, I_RW2, I_A0, I_A2, I_G2, I_KK, I_KA, I_RK, I_LNW, I_LNB, I_GATEB, I_MNW, I_FNW, N_IN };
constexpr size_t al256(size_t x) { return (x + 255) & ~(size_t)255; }
constexpr size_t WS_CTL = 0, CTL_ZERO_BYTES = 1u << 20;
constexpr size_t WS_MOD = CTL_ZERO_BYTES;
constexpr size_t WS_ROPE = al256(WS_MOD + 2 * 3 * 6144 * 4);
constexpr size_t ROPE_DR = 0, ROPE_DC = 256 * 16 * 2, ROPE_MR = ROPE_DC + 64 * 16 * 2, ROPE_MC = ROPE_MR + 256 * 8 * 2, ROPE_FLOATS = ROPE_MC + 64 * 8 * 2;
constexpr size_t WS_WRH = al256(WS_ROPE + ROPE_FLOATS * 4);
constexpr size_t WS_WRL = al256(WS_WRH + (size_t)2 * 32 * 1024 * 2);
constexpr size_t WS_WIN0 = al256(WS_WRL + (size_t)2 * 32 * 1024 * 2);
constexpr size_t WS_WUQ = al256(WS_WIN0 + (size_t)ATT_NP * 1024 * 2);
constexpr size_t WS_WUKV = al256(WS_WUQ + (size_t)768 * 384 * 2);
constexpr size_t WS_WOUT = al256(WS_WUKV + (size_t)1024 * 256 * 2);
constexpr size_t WS_WREC = al256(WS_WOUT + (size_t)2 * 1024 * 1024 * 2);
constexpr size_t WS_WLORA = al256(WS_WREC + (size_t)REC_NP * 1024 * 2);
constexpr size_t WS_W1T = al256(WS_WLORA + (size_t)2560 * 384 * 2);
constexpr size_t WS_W2T = al256(WS_W1T + (size_t)NE * 2048 * 1024 * 2);
constexpr size_t WS_H = al256(WS_W2T + (size_t)NE * 1024 * 1024 * 2);
constexpr size_t WS_A = al256(WS_H + (size_t)R * 1024 * 4);
constexpr size_t WS_A1 = al256(WS_A + (size_t)R * 1024 * 2);
constexpr size_t WS_F = al256(WS_A1 + (size_t)R * 1024 * 2);
constexpr size_t WS_P = al256(WS_F + (size_t)R * 1024 * 2);
constexpr size_t WS_TOPE = al256(WS_P + (size_t)R * REC_NP * 2);
constexpr size_t WS_GATE = al256(WS_TOPE + (size_t)R * 16);
constexpr size_t WS_POS = al256(WS_GATE + (size_t)R * 16);
constexpr size_t WS_DEST = al256(WS_POS + (size_t)R * 16);
constexpr size_t WS_TILE = al256(WS_DEST + (size_t)R * 16);
constexpr size_t WS_SRC = al256(WS_TILE + (size_t)(MAXT + 8) * 4);
constexpr size_t WS_T = al256(WS_SRC + (size_t)MAXROWS * 4);
constexpr size_t WS_QD = WS_T;
constexpr size_t WS_KD = al256(WS_QD + (size_t)R * 512 * 2);
constexpr size_t WS_CQN = al256(WS_KD + (size_t)R * 512 * 2);
constexpr size_t WS_CKVN = al256(WS_CQN + (size_t)R * 384 * 2);
constexpr size_t WS_MQ = al256(WS_CKVN + (size_t)R * 256 * 2);
constexpr size_t WS_MKV = al256(WS_MQ + (size_t)R * 768 * 2);
constexpr size_t WS_KRR = al256(WS_MKV + (size_t)R * 1024 * 2);
constexpr size_t WS_ODIFF = al256(WS_KRR + (size_t)R * 32 * 2);
constexpr size_t WS_OMLA = al256(WS_ODIFF + (size_t)R * 1024 * 4);
constexpr size_t WS_T0_END = al256(WS_OMLA + (size_t)R * 512 * 4);
constexpr size_t WS_XS = WS_T;
constexpr size_t WS_HS = al256(WS_XS + (size_t)MAXROWS * 1024 * 2);
constexpr size_t WS_TM_END = al256(WS_HS + (size_t)MAXROWS * 1024 * 2);
constexpr size_t SZ_RC = (size_t)R * 512 * 4;
constexpr size_t WS_RR = WS_T, WS_VV = WS_RR + SZ_RC, WS_AKK = WS_VV + SZ_RC, WS_KL = WS_AKK + SZ_RC;
constexpr size_t WS_WDEC = WS_KL + SZ_RC  , WS_KDIR = WS_WDEC + 2 * SZ_RC  , WS_BB = WS_KDIR + 2 * SZ_RC  , WS_GG = WS_BB + 2 * SZ_RC;
constexpr size_t WS_ALORA = al256(WS_GG + SZ_RC);
constexpr size_t WS_YR = al256(WS_ALORA + (size_t)R * 384 * 2);
constexpr size_t WS_DC = WS_YR;
constexpr size_t WS_HM = al256(WS_YR + 2 * SZ_RC);
constexpr size_t WS_CST = al256(WS_HM + 2 * SZ_RC);
constexpr size_t WS_DN = al256(WS_CST + (size_t)NUNIT_M * 8192 * 4);
constexpr size_t WS_NST = al256(WS_DN + (size_t)NUNIT_M * 64 * 4);
constexpr size_t WS_SC = al256(WS_NST + (size_t)NUNIT_M * 64 * 4);
constexpr size_t WS_MST = al256(WS_SC + (size_t)NUNIT_M * 2 * 4);
constexpr size_t WS_ASIG = WS_KDIR;
constexpr size_t WS_YB = WS_BB;
constexpr int NUNIT_R = 32 * 260;
constexpr size_t WS_RKM = WS_KDIR + SZ_RC;
static_assert((size_t)NUNIT_R * 4096 * 2 <= SZ_RC, "M^T fits in KL");
constexpr size_t WS_RKQ = al256(WS_MST + (size_t)NUNIT_M * 4);
constexpr size_t WS_RKZ = al256(WS_RKQ + (size_t)NUNIT_R * 4096 * 2);
constexpr size_t WS_T1_END = al256(WS_RKZ + (size_t)NUNIT_R * 4096 * 2);
constexpr size_t WS_END = WS_T1_END > WS_TM_END ? (WS_T1_END > WS_T0_END ? WS_T1_END : WS_T0_END) : (WS_TM_END > WS_T0_END ? WS_TM_END : WS_T0_END);
static_assert(WS_END <= (size_t)2147483648ull, "workspace map exceeds 2 GiB");
constexpr int CW_CNT = 1024;
constexpr int CW_BAR = 4096;
constexpr int RING_BYTES = 131072, AUX_OFF = 131072, AUX_BYTES = 16384, MISC_OFF = 147456, LDS_BYTES = 163840;

struct Frame {
    LAS unsigned char* lds; gu32* ctl; int tid, lane, wave, blk, G, probe;
    float* out; unsigned char* ws;
    struct InTab { LAS const unsigned* t;
        __device__ __forceinline__ const float* operator[](int i) const { const unsigned lo = __builtin_amdgcn_readfirstlane(t[2 * i]), hi = __builtin_amdgcn_readfirstlane(t[2 * i + 1]);
            return (const float*)(((unsigned long long)hi << 32) | lo); } } in;
};
template <class T> __device__ __forceinline__ T* wsp(const Frame& F, size_t off) { return (T*)(F.ws + off); }
__device__ __forceinline__ int row_sel(int row) { const int b = row / TB, t = row - b * TB; return t < CT ? 2 : b; }
__device__ __forceinline__ const float* h0_row(const Frame& F, int row) {
    const int b = row / TB, t = row - b * TB;
    return t < CT ? F.in[I_CTX] + ((size_t)b * CT + t) * DM : F.in[I_X] + ((size_t)b * SEQ + (t - CT)) * DM;
}
__device__ __forceinline__ const float* modp(const Frame& F, int layer, int sel, int chunk) { return wsp<const float>(F, WS_MOD) + ((size_t)(layer * 3 + sel) * 6 + chunk) * DM; }
__device__ __forceinline__ int scan_tok(int z, int sg) { return z == 0 ? sg : (sg < CT ? CT - 1 - sg : TB + CT - 1 - sg); }
__device__ __forceinline__ void tr_item(const float* W, int K, int N, bf16* WT, int row_off, LAS float* scr, int kb, int nb, int lane) {
    const int k0 = 64 * kb, n0 = 32 * nb;
    const int n = n0 + (lane & 31);
    float tv[32];
#pragma unroll
    for (int i = 0; i < 32; ++i) { const int kk = 2 * i + (lane >> 5); tv[i] = (n < N) ? W[(size_t)(k0 + kk) * N + n] : 0.f; }
#pragma unroll
    for (int i = 0; i < 32; ++i) { const int kk = 2 * i + (lane >> 5); scr[kk * 33 + (lane & 31)] = tv[i]; }
    LDS_WAIT(); asm volatile("" ::: "memory");
    const int c = lane & 7;
#pragma unroll
    for (int j = 0; j < 4; ++j) { const int nn = (lane >> 3) + 8 * j; const LAS float* s = scr + (8 * c) * 33 + nn;
        v4u o; o.x = pk2(s[0 * 33], s[1 * 33]); o.y = pk2(s[2 * 33], s[3 * 33]); o.z = pk2(s[4 * 33], s[5 * 33]); o.w = pk2(s[6 * 33], s[7 * 33]);
        *(v4u*)(WT + (size_t)(row_off + n0 + nn) * K + k0 + 8 * c) = o; }
    LDS_WAIT(); asm volatile("" ::: "memory");
}
__device__ __forceinline__ void tr_family(const Frame& F, const float* W, size_t src_stride, int nmat, int K, int N, int Npad, bf16* WT, int gw, int NGW) {
    LAS float* scr = (LAS float*)(F.lds + F.wave * 16384);
    const int nkb = K / 64, nnb = Npad / 32, per = nkb * nnb, total = per * nmat;
    for (int it = gw; it < total; it += NGW) { const int m = it / per, r = it - m * per, kb = r / nnb, nb = r - kb * nnb;
        tr_item(W + (size_t)m * src_stride, K, N, WT, m * Npad, scr, kb, nb, F.lane); }
}
__device__ __forceinline__ void moe_weights_convert(const Frame& F, int layer, int gw, int NGW) {
    tr_family(F, F.in[I_W1] + (size_t)layer * NE * 1024 * 2048, (size_t)1024 * 2048, NE, 1024, 2048, 2048, wsp<bf16>(F, WS_W1T), gw, NGW);
    tr_family(F, F.in[I_W2] + (size_t)layer * NE * 1024 * 1024, (size_t)1024 * 1024, NE, 1024, 1024, 1024, wsp<bf16>(F, WS_W2T), gw, NGW);
}
__device__ __forceinline__ void norm_mod_row(const Frame& F, const float* src, const float* nw, const float* shift, const float* scale, bf16* orow) {
    const f32x4* xr = (const f32x4*)src + F.lane;
    f32x4 v[4]; float s = 0.f;
#pragma unroll
    for (int j = 0; j < 4; ++j) { v[j] = xr[64 * j]; s += (v[j].x * v[j].x + v[j].y * v[j].y) + (v[j].z * v[j].z + v[j].w * v[j].w); }
    const float rs = 1.f / sqrtf(wave_sum(s) * (1.f / DM) + NORM_EPS);
    unsigned long long* o8 = (unsigned long long*)orow + F.lane;
#pragma unroll
    for (int j = 0; j < 4; ++j) { const f32x4 w = ((const f32x4*)nw)[F.lane + 64 * j], sh = ((const f32x4*)shift)[F.lane + 64 * j], sc = ((const f32x4*)scale)[F.lane + 64 * j];
        const f32x4 y = v[j] * rs * w * (sc + 1.f) + sh;
        o8[64 * j] = (unsigned long long)pk2(y.x, y.y) | ((unsigned long long)pk2(y.z, y.w) << 32); }
}
__device__ __forceinline__ void p0a(const Frame& F) {
    LAS float* sv = (LAS float*)F.lds; LAS float* red = (LAS float*)(F.lds + 16384);
    for (int i = F.tid; i < 3 * DM; i += 512) { const int s = i / DM, k = i - s * DM; const float cv = (s < 2) ? F.in[I_C][s * DM + k] : F.in[I_CCTX][k]; sv[i] = cv / (1.f + __expf(-cv)); }
    __syncthreads();
    for (int it = F.blk; it < 192; it += F.G) {
        const int l = it / 96, cgp = it - l * 96, kq = F.tid >> 4, cg = F.tid & 15, col = cgp * 64 + cg * 4;
        float acc[3][4];
#pragma unroll
        for (int s = 0; s < 3; ++s)
#pragma unroll
            for (int j = 0; j < 4; ++j) acc[s][j] = 0.f;
        const float* W = F.in[I_ADAW] + (size_t)l * DM * 6144 + col;
#pragma unroll 16
        for (int kk = 0; kk < 32; ++kk) { const int k = kq * 32 + kk; const f32x4 w = *(const f32x4*)(W + (size_t)k * 6144);
            const float s0 = sv[k], s1 = sv[DM + k], s2 = sv[2 * DM + k];
#pragma unroll
            for (int j = 0; j < 4; ++j) { acc[0][j] += s0 * w[j]; acc[1][j] += s1 * w[j]; acc[2][j] += s2 * w[j]; } }
#pragma unroll
        for (int s = 0; s < 3; ++s)
#pragma unroll
            for (int j = 0; j < 4; ++j) red[(kq * 16 + cg) * 12 + s * 4 + j] = acc[s][j];
        __syncthreads();
        if (F.tid < 192) { const int s = F.tid / 64, cc = F.tid - s * 64, cg2 = cc >> 2, j = cc & 3; float t = 0.f;
            for (int q = 0; q < 32; ++q) t += red[(q * 16 + cg2) * 12 + s * 4 + j];
            wsp<float>(F, WS_MOD)[(size_t)(l * 3 + s) * 6144 + cgp * 64 + cc] = t + F.in[I_ADAB][l * 6144 + cgp * 64 + cc]; }
        __syncthreads();
    }
    const int gid = F.blk * 512 + F.tid, GT = F.G * 512;
    float* rope = wsp<float>(F, WS_ROPE);
    for (int i = gid; i < 256 * 16 + 64 * 16 + 256 * 8 + 64 * 8; i += GT) {
        int j = i; float pos, inv; size_t off;
        if (j < 256 * 16) { pos = (float)(j / 16); inv = powf(10000.f, -(float)(j % 16) / 16.f); off = ROPE_DR + (size_t)j * 2; }
        else if ((j -= 256 * 16) < 64 * 16) { pos = (float)(j / 16); inv = powf(10000.f, -(float)(j % 16) / 16.f); off = ROPE_DC + (size_t)j * 2; }
        else if ((j -= 64 * 16) < 256 * 8) { pos = (float)(j / 8); inv = powf(10000.f, -(float)(j % 8) / 8.f); off = ROPE_MR + (size_t)j * 2; }
        else { j -= 256 * 8; pos = (float)(j / 8); inv = powf(10000.f, -(float)(j % 8) / 8.f); off = ROPE_MC + (size_t)j * 2; }
        const float ang = pos * inv; rope[off] = cosf(ang); rope[off + 1] = sinf(ang);
    }
    { bf16* wh = wsp<bf16>(F, WS_WRH); bf16* wl = wsp<bf16>(F, WS_WRL); for (int i = gid; i < 2 * 32 * 1024; i += GT) { const int k = i & 1023, e = (i >> 10) & 31, l = i >> 15; const float wv = F.in[I_RW][((size_t)l * DM + k) * NE + e];
        const unsigned hb = f2bf(wv); wh[i] = (bf16)hb; wl[i] = (bf16)f2bf(wv - bf2f((bf16)hb)); } }
    bf16* WL = wsp<bf16>(F, WS_WLORA);
    for (int i = gid; i < 2560 * 384; i += GT) { const int n = i / 384, k = i - n * 384, part = n >> 9, c = n & 511; float v = 0.f;
        if (part < 2) { if ((k >> 6) == part) v = F.in[I_RW2][((size_t)part * 64 + (k & 63)) * 512 + c]; }
        else if (part < 4) { if ((k >> 6) == part) v = F.in[I_A2][((size_t)(part - 2) * 64 + (k & 63)) * 512 + c]; }
        else { if (k >= 256) v = F.in[I_G2][(size_t)(k - 256) * 512 + c]; }
        WL[i] = (bf16)f2bf(v); }
    const int gw = F.blk * 8 + F.wave, NGW = F.G * 8;
    tr_family(F, F.in[I_ATTW], 0, 1, 1024, ATT_IN, ATT_NP, wsp<bf16>(F, WS_WIN0), gw, NGW);
    tr_family(F, F.in[I_WUQ], 0, 1, 384, 768, 768, wsp<bf16>(F, WS_WUQ), gw, NGW);
    tr_family(F, F.in[I_WUKV], 0, 1, 256, 1024, 1024, wsp<bf16>(F, WS_WUKV), gw, NGW);
    tr_family(F, F.in[I_WOUT], (size_t)1024 * 1024, 2, 1024, 1024, 1024, wsp<bf16>(F, WS_WOUT), gw, NGW);
    tr_family(F, F.in[I_RECW], 0, 1, 1024, REC_IN, REC_NP, wsp<bf16>(F, WS_WREC), gw, NGW);
    moe_weights_convert(F, 0, gw, NGW);
}
__device__ __forceinline__ void p0b(const Frame& F) {
    const int gw = F.blk * 8 + F.wave, NGW = F.G * 8;
    for (int row = gw; row < R; row += NGW) { const int sel = row_sel(row);
        norm_mod_row(F, h0_row(F, row), F.in[I_NMIX], modp(F, 0, sel, 0), modp(F, 0, sel, 1), wsp<bf16>(F, WS_A) + (size_t)row * DM); }
}
struct FnStoreBf16 {
    bf16* O; int ldc;
    __device__ __forceinline__ void operator()(int row, int col, f32x4 v0, f32x4 v1) const {
        v4u w; w.x = pg8::cvt_pk_bf16(v0[0], v0[1]); w.y = pg8::cvt_pk_bf16(v0[2], v0[3]); w.z = pg8::cvt_pk_bf16(v1[0], v1[1]); w.w = pg8::cvt_pk_bf16(v1[2], v1[3]);
        *(v4u*)(O + (size_t)row * ldc + col) = w; }
};
struct FnWout {
    const Frame* F; int layer;
    __device__ __forceinline__ void operator()(int row, int col, f32x4 v0, f32x4 v1) const {
        bf16* hrow = wsp<bf16>(*F, WS_H) + (size_t)row * DM + col;
        const float* g = modp(*F, layer, row_sel(row), 2) + col;
        const f32x4 g0 = *(const f32x4*)g, g1 = *(const f32x4*)(g + 4); f32x4 b0, b1;
        if (layer == 0) { const float* base = h0_row(*F, row) + col; b0 = *(const f32x4*)base; b1 = *(const f32x4*)(base + 4); }
        else { float x[8]; unpack8(*(const v4u*)hrow, x); b0 = (f32x4){x[0], x[1], x[2], x[3]}; b1 = (f32x4){x[4], x[5], x[6], x[7]}; }
        const f32x4 o0 = b0 + g0 * v0, o1 = b1 + g1 * v1; v4u w; w.x = pk2(o0.x, o0.y); w.y = pk2(o0.z, o0.w); w.z = pk2(o1.x, o1.y); w.w = pk2(o1.z, o1.w);
        *(v4u*)hrow = w; }
};
__device__ __forceinline__ void l0_post_proj(const Frame& F) {
    const int gw = F.blk * 8 + F.wave, NGW = F.G * 8, lane = F.lane;
    const bf16* P = wsp<const bf16>(F, WS_P); const float* rope = wsp<const float>(F, WS_ROPE);
    constexpr float CD = 0.125f * 1.4426950408889634f;
    for (int row = gw; row < R; row += NGW) {
        const int b = row / TB, t = row - b * TB; const bool lat = t >= CT; const int pos = t - CT, prow = lat ? pos >> 6 : 0, pcol = lat ? pos & 63 : 0;
        const bf16* p = P + (size_t)row * ATT_NP;
        bf16* qd = wsp<bf16>(F, WS_QD) + (size_t)row * 512; bf16* kd = wsp<bf16>(F, WS_KD) + (size_t)row * 512;
#pragma unroll
        for (int j = 0; j < 2; ++j) { const int g = lane + 64 * j, h16 = g >> 3, i0 = (g & 7) * 4;
            const v2u w1 = *(const v2u*)(p + h16 * 64 + i0), w2 = *(const v2u*)(p + h16 * 64 + i0 + 32);
            const float x1[4] = {bflo(w1.x), bfhi(w1.x), bflo(w1.y), bfhi(w1.y)}, x2[4] = {bflo(w2.x), bfhi(w2.x), bflo(w2.y), bfhi(w2.y)};
            float cs[8] = {1.f, 0.f, 1.f, 0.f, 1.f, 0.f, 1.f, 0.f};
            if (lat) { const float* tb = (i0 < 16) ? rope + ROPE_DR + (size_t)(prow * 16 + i0) * 2 : rope + ROPE_DC + (size_t)(pcol * 16 + i0 - 16) * 2;
                const f32x4 t0 = *(const f32x4*)tb, t1 = *(const f32x4*)(tb + 4); cs[0] = t0.x; cs[1] = t0.y; cs[2] = t0.z; cs[3] = t0.w; cs[4] = t1.x; cs[5] = t1.y; cs[6] = t1.z; cs[7] = t1.w; }
            float y1[4], y2[4]; const float sc = h16 < 8 ? CD : 1.f;
#pragma unroll
            for (int e = 0; e < 4; ++e) { y1[e] = (x1[e] * cs[2 * e] - x2[e] * cs[2 * e + 1]) * sc; y2[e] = (x1[e] * cs[2 * e + 1] + x2[e] * cs[2 * e]) * sc; }
            bf16* o = (h16 < 8) ? qd + h16 * 64 + i0 : kd + (h16 - 8) * 64 + i0;
            v2u o1, o2; o1.x = pk2(y1[0], y1[1]); o1.y = pk2(y1[2], y1[3]); o2.x = pk2(y2[0], y2[1]); o2.y = pk2(y2[2], y2[3]);
            *(v2u*)o = o1; *(v2u*)(o + 32) = o2; }
        { float x[8]; float ss = 0.f; const bool act = lane < 48;
          if (act) unpack8(*(const v4u*)(p + 1536 + 8 * lane), x); else {
#pragma unroll
              for (int e = 0; e < 8; ++e) x[e] = 0.f; }
#pragma unroll
          for (int e = 0; e < 8; ++e) ss += x[e] * x[e];
          const float rs = 1.f / sqrtf(wave_sum(ss) * (1.f / 384.f) + NORM_EPS);
          if (act) { const f32x4 g0 = *(const f32x4*)(F.in[I_QNW] + 8 * lane), g1 = *(const f32x4*)(F.in[I_QNW] + 8 * lane + 4); v4u w;
              w.x = pk2(x[0] * rs * g0.x, x[1] * rs * g0.y); w.y = pk2(x[2] * rs * g0.z, x[3] * rs * g0.w); w.z = pk2(x[4] * rs * g1.x, x[5] * rs * g1.y); w.w = pk2(x[6] * rs * g1.z, x[7] * rs * g1.w);
              *(v4u*)(wsp<bf16>(F, WS_CQN) + (size_t)row * 384 + 8 * lane) = w; } }
        { const v2u wv = *(const v2u*)(p + 1920 + 4 * lane); const float x[4] = {bflo(wv.x), bfhi(wv.x), bflo(wv.y), bfhi(wv.y)};
          const float rs = 1.f / sqrtf(wave_sum((x[0] * x[0] + x[1] * x[1]) + (x[2] * x[2] + x[3] * x[3])) * (1.f / 256.f) + NORM_EPS);
          const f32x4 g0 = *(const f32x4*)(F.in[I_KVNW] + 4 * lane); v2u w; w.x = pk2(x[0] * rs * g0.x, x[1] * rs * g0.y); w.y = pk2(x[2] * rs * g0.z, x[3] * rs * g0.w);
          *(v2u*)(wsp<bf16>(F, WS_CKVN) + (size_t)row * 256 + 4 * lane) = w; }
        if (lane < 16) { const int i = lane; const float x1 = bf2f(p[2176 + i]), x2 = bf2f(p[2176 + i + 16]); float c = 1.f, s = 0.f;
            if (lat) { const float* tb = (i < 8) ? rope + ROPE_MR + (size_t)(prow * 8 + i) * 2 : rope + ROPE_MC + (size_t)(pcol * 8 + i - 8) * 2; c = tb[0]; s = tb[1]; }
            bf16* o = wsp<bf16>(F, WS_KRR) + (size_t)row * 32; o[i] = (bf16)f2bf(x1 * c - x2 * s); o[i + 16] = (bf16)f2bf(x1 * s + x2 * c); }
    }
}
__device__ __forceinline__ void l0_mq_rope(const Frame& F) {
    const int gw = F.blk * 8 + F.wave, NGW = F.G * 8, lane = F.lane; const float* rope = wsp<const float>(F, WS_ROPE);
    const float CM = 0.10206207261596575f * 1.4426950408889634f;
    for (int row = gw; row < R; row += NGW) {
        const int b = row / TB, t = row - b * TB; const bool lat = t >= CT; const int pos = t - CT, prow = lat ? pos >> 6 : 0, pcol = lat ? pos & 63 : 0;
        bf16* q = wsp<bf16>(F, WS_MQ) + (size_t)row * 768;
#pragma unroll
        for (int j = 0; j < 2; ++j) { const int g = lane + 64 * j, h = g >> 4, d0 = (g & 15) * 4;
            const v2u wv = *(const v2u*)(q + h * 96 + d0); v2u o; o.x = pk2(bflo(wv.x) * CM, bfhi(wv.x) * CM); o.y = pk2(bflo(wv.y) * CM, bfhi(wv.y) * CM); *(v2u*)(q + h * 96 + d0) = o; }
#pragma unroll
        for (int j = 0; j < 2; ++j) { const int pr = lane + 64 * j, h = pr >> 4, i = pr & 15; const float x1 = bf2f(q[h * 96 + 64 + i]), x2 = bf2f(q[h * 96 + 80 + i]); float c = 1.f, s = 0.f;
            if (lat) { const float* tb = (i < 8) ? rope + ROPE_MR + (size_t)(prow * 8 + i) * 2 : rope + ROPE_MC + (size_t)(pcol * 8 + i - 8) * 2; c = tb[0]; s = tb[1]; }
            q[h * 96 + 64 + i] = (bf16)f2bf((x1 * c - x2 * s) * CM); q[h * 96 + 80 + i] = (bf16)f2bf((x1 * s + x2 * c) * CM); }
    }
}
__device__ __forceinline__ void l0_attention(const Frame& F) {
    LAS char* lds = (LAS char*)F.lds;
    const bf16* QD = wsp<const bf16>(F, WS_QD); const bf16* KD = wsp<const bf16>(F, WS_KD); const bf16* P = wsp<const bf16>(F, WS_P);
    const bf16* MQ = wsp<const bf16>(F, WS_MQ); const bf16* MKV = wsp<const bf16>(F, WS_MKV); const bf16* KRR = wsp<const bf16>(F, WS_KRR);
    float* OD = wsp<float>(F, WS_ODIFF); float* OM = wsp<float>(F, WS_OMLA);
    for (int kind = 0; kind < 2; ++kind) {
        for (int L = F.blk; L < 1024 + 16; L += F.G) {
            int b, h8, qb, nkeys;
            if (L < 1024) { int pair;
                if (F.G == 256) { const int round = L >> 8, c = L & 255; pair = round * 4 + ((c & 7) >> 1); qb = 1 + (c & 1) * 32 + (c >> 3); }
                else { pair = L >> 6; qb = 1 + (L & 63); }
                b = pair >> 3; h8 = pair & 7; nkeys = TB; }
            else { const int s = L - 1024; b = s >> 3; h8 = s & 7; qb = 0; nkeys = CT; }
            const size_t q0 = (size_t)b * TB + (size_t)qb * 256, k0 = (size_t)b * TB;
            if (kind == 0)
                att::attn_unit<64, 128>(QD + q0 * 512 + h8 * 64, 512, KD + k0 * 512 + h8 * 64, 512, nullptr, 0, P + k0 * ATT_NP + 1024 + (h8 >> 1) * 128, ATT_NP,
                                        OD + q0 * 1024 + h8 * 128, 1024, nkeys, lds);
            else
                att::attn_unit<96, 64>(MQ + q0 * 768 + h8 * 96, 768, MKV + k0 * 1024 + h8 * 128, 1024, KRR + k0 * 32, 32, MKV + k0 * 1024 + h8 * 128 + 64, 1024,
                                       OM + q0 * 512 + h8 * 64, 512, nkeys, lds);
        }
    }
}
__device__ __forceinline__ void l0_combine(const Frame& F) {
    const int gw = F.blk * 8 + F.wave, NGW = F.G * 8, lane = F.lane;
    const float* lv = F.in[I_LAM];
    const float lam = __expf(wave_sum(lv[lane] * lv[64 + lane])) - __expf(wave_sum(lv[128 + lane] * lv[192 + lane])) + 0.2f;
    const float sw0 = F.in[I_SUBLN][2 * lane] * 0.8f, sw1 = F.in[I_SUBLN][2 * lane + 1] * 0.8f;
    for (int row = gw; row < R; row += NGW) {
        const float* od = wsp<const float>(F, WS_ODIFF) + (size_t)row * 1024; const float* om = wsp<const float>(F, WS_OMLA) + (size_t)row * 512;
        bf16* a1 = wsp<bf16>(F, WS_A1) + (size_t)row * DM;
#pragma unroll
        for (int h = 0; h < 4; ++h) {
            const float o1a = od[(2 * h) * 128 + 2 * lane], o1b = od[(2 * h) * 128 + 2 * lane + 1], o2a = od[(2 * h + 1) * 128 + 2 * lane], o2b = od[(2 * h + 1) * 128 + 2 * lane + 1];
            const float da = o1a - lam * o2a, db = o1b - lam * o2b;
            const float rs = 1.f / sqrtf(wave_sum(da * da + db * db) * (1.f / 128.f) + NORM_EPS);
            *(unsigned*)(a1 + h * 128 + 2 * lane) = pk2(da * rs * sw0, db * rs * sw1); }
#pragma unroll
        for (int j = 0; j < 2; ++j) { const f32x4 v = *(const f32x4*)(om + 4 * (lane + 64 * j)); v2u w; w.x = pk2(v.x, v.y); w.y = pk2(v.z, v.w); *(v2u*)(a1 + 512 + 4 * (lane + 64 * j)) = w; }
    }
}
constexpr int RT_LS = 264;
__device__ __forceinline__ void ph_router(const Frame& F, int layer) {
    LAS bf16* AH = (LAS bf16*)F.lds; LAS bf16* AL = AH + 64 * RT_LS; LAS bf16* WH = AL + 64 * RT_LS; LAS bf16* WL = WH + 32 * RT_LS;
    LAS float* lg = (LAS float*)(F.lds + 110592);
    LAS int* hist = (LAS int*)(F.lds + MISC_OFF + 256);
    LAS int* recs = (LAS int*)(F.lds + MISC_OFF + 512);
    const int lane = F.lane, w = F.wave, tid = F.tid, RPB = (R + F.G - 1) / F.G, row0 = F.blk * RPB;
    if (tid < 64) hist[tid] = 0;
    { int* srct = wsp<int>(F, WS_SRC); for (int i = F.blk * 512 + tid; i < MAXROWS; i += F.G * 512) srct[i] = 0; }
    const float* nw = F.in[I_NFFN] + (size_t)layer * DM; const float* rbp = F.in[I_RB] + layer * NE;
    const bf16* wrh = wsp<const bf16>(F, WS_WRH) + (size_t)layer * 32 * 1024; const bf16* wrl = wsp<const bf16>(F, WS_WRL) + (size_t)layer * 32 * 1024;
    for (int pass = 0; pass * 64 < RPB; ++pass) {
        const int nrow = min(64, min(RPB - pass * 64, R - row0 - pass * 64));
        f32x4 fr[8][4];
#pragma unroll
        for (int i = 0; i < 8; ++i) { const int rl = w + 8 * i; const int row = row0 + pass * 64 + rl;
            if (rl < nrow) {
                const int sel = row_sel(row); const float* sh = modp(F, layer, sel, 3); const float* sc = modp(F, layer, sel, 4);
                const v2u* xr = (const v2u*)(wsp<const bf16>(F, WS_H) + (size_t)row * DM) + lane; float s = 0.f;
#pragma unroll
                for (int j = 0; j < 4; ++j) { const v2u hw = xr[64 * j]; fr[i][j] = (f32x4){bflo(hw.x), bfhi(hw.x), bflo(hw.y), bfhi(hw.y)}; s += (fr[i][j].x * fr[i][j].x + fr[i][j].y * fr[i][j].y) + (fr[i][j].z * fr[i][j].z + fr[i][j].w * fr[i][j].w); }
                const float rs = 1.f / sqrtf(wave_sum(s) * (1.f / DM) + NORM_EPS);
                unsigned long long* o8 = (unsigned long long*)(wsp<bf16>(F, WS_F) + (size_t)row * DM) + lane;
#pragma unroll
                for (int j = 0; j < 4; ++j) { const f32x4 ww = ((const f32x4*)nw)[lane + 64 * j], a = ((const f32x4*)sh)[lane + 64 * j], c = ((const f32x4*)sc)[lane + 64 * j];
                    fr[i][j] = fr[i][j] * rs * ww * (c + 1.f) + a;
                    o8[64 * j] = (unsigned long long)pk2(fr[i][j].x, fr[i][j].y) | ((unsigned long long)pk2(fr[i][j].z, fr[i][j].w) << 32); }
            } else {
#pragma unroll
                for (int j = 0; j < 4; ++j) fr[i][j] = (f32x4){0.f, 0.f, 0.f, 0.f};
            } }
        pg8::f32x4 acc = {0.f, 0.f, 0.f, 0.f};
#pragma unroll
        for (int c = 0; c < 4; ++c) {
            __syncthreads();
#pragma unroll
            for (int i = 0; i < 8; ++i) { const f32x4 v = fr[i][c]; const unsigned h0 = pk2(v.x, v.y), h1 = pk2(v.z, v.w);
                const unsigned l0 = pk2(v.x - bflo(h0), v.y - bfhi(h0)), l1 = pk2(v.z - bflo(h1), v.w - bfhi(h1));
                v2u hh; hh.x = h0; hh.y = h1; v2u ll; ll.x = l0; ll.y = l1;
                *(LAS v2u*)(AH + (w + 8 * i) * RT_LS + 4 * lane) = hh; *(LAS v2u*)(AL + (w + 8 * i) * RT_LS + 4 * lane) = ll; }
            { const int e = tid >> 4, kp = (tid & 15) * 16;
              const v4u a0 = *(const v4u*)(wrh + (size_t)e * 1024 + 256 * c + kp), a1 = *(const v4u*)(wrh + (size_t)e * 1024 + 256 * c + kp + 8);
              const v4u b0 = *(const v4u*)(wrl + (size_t)e * 1024 + 256 * c + kp), b1 = *(const v4u*)(wrl + (size_t)e * 1024 + 256 * c + kp + 8);
              *(LAS v4u*)(WH + e * RT_LS + kp) = a0; *(LAS v4u*)(WH + e * RT_LS + kp + 8) = a1; *(LAS v4u*)(WL + e * RT_LS + kp) = b0; *(LAS v4u*)(WL + e * RT_LS + kp + 8) = b1; }
            __syncthreads();
            const int tm = w >> 1, tn = w & 1, lr = lane & 15, kq = (lane >> 4) * 8;
            const LAS bf16* ahp = AH + (tm * 16 + lr) * RT_LS + kq; const LAS bf16* alp = AL + (tm * 16 + lr) * RT_LS + kq;
            const LAS bf16* whp = WH + (tn * 16 + lr) * RT_LS + kq; const LAS bf16* wlp = WL + (tn * 16 + lr) * RT_LS + kq;
#pragma unroll
            for (int ks = 0; ks < 8; ++ks) { const bf16x8 ah = *(const LAS bf16x8*)(ahp + 32 * ks), al = *(const LAS bf16x8*)(alp + 32 * ks), bh = *(const LAS bf16x8*)(whp + 32 * ks), bl = *(const LAS bf16x8*)(wlp + 32 * ks);
                acc = __builtin_amdgcn_mfma_f32_16x16x32_bf16(ah, bh, acc, 0, 0, 0); acc = __builtin_amdgcn_mfma_f32_16x16x32_bf16(ah, bl, acc, 0, 0, 0); acc = __builtin_amdgcn_mfma_f32_16x16x32_bf16(al, bh, acc, 0, 0, 0); }
        }
        { const int m0 = (w >> 1) * 16 + (lane >> 4) * 4, n = (w & 1) * 16 + (lane & 15);
#pragma unroll
          for (int r = 0; r < 4; ++r) lg[(m0 + r) * 33 + n] = acc[r]; }
        __syncthreads();
        if (tid < nrow) { const int rl = tid, row = row0 + pass * 64 + rl; float lv[32];
#pragma unroll
            for (int e = 0; e < 32; ++e) lv[e] = lg[rl * 33 + e] + rbp[e];
            float selv[4]; int seli[4];
#pragma unroll
            for (int r = 0; r < 4; ++r) { float bv = -3.0e38f; int bi = 0;
#pragma unroll
                for (int e = 0; e < 32; ++e) { const bool taken = (r > 0 && seli[0] == e) || (r > 1 && seli[1] == e) || (r > 2 && seli[2] == e); if (!taken && lv[e] > bv) { bv = lv[e]; bi = e; } }
                selv[r] = bv; seli[r] = bi; }
            float ex[4], es = 0.f;
#pragma unroll
            for (int r = 0; r < 4; ++r) { ex[r] = __expf(selv[r] - selv[0]); es += ex[r]; }
            const float inv = 1.f / es;
#pragma unroll
            for (int r = 0; r < 4; ++r) { wsp<int>(F, WS_TOPE)[(size_t)row * 4 + r] = seli[r]; wsp<float>(F, WS_GATE)[(size_t)row * 4 + r] = ex[r] * inv;
                const int rk = __hip_atomic_fetch_add(&hist[seli[r]], 1, __ATOMIC_RELAXED, __HIP_MEMORY_SCOPE_WORKGROUP);
                recs[(pass * 64 + rl) * 4 + r] = seli[r] | (rk << 8); }
        }
    }
    __syncthreads();
    if (tid < NE) hist[32 + tid] = (int)__hip_atomic_fetch_add(F.ctl + CW_CNT + 64 * (layer + 2 * F.probe) + tid, (unsigned)hist[tid], RLX_AGENT);
    __syncthreads();
    for (int rl = tid; rl < RPB && row0 + rl < R; rl += 512) {
#pragma unroll
        for (int r = 0; r < 4; ++r) { const int rc = recs[rl * 4 + r]; wsp<int>(F, WS_POS)[(size_t)(row0 + rl) * 4 + r] = hist[32 + (rc & 255)] + (rc >> 8); } }
}
__device__ __forceinline__ void moe_tables(const Frame& F, int layer, LAS int* ps, LAS int* tile_e) {
    if (F.tid == 0) { int acc = 0, t = 0;
        for (int e = 0; e < NE; ++e) { const int c = (int)__hip_atomic_load(F.ctl + CW_CNT + 64 * layer + e, RLX_AGENT); ps[e] = acc; const int nt = (c + 255) >> 8;
            for (int i = 0; i < nt && t < MAXT; ++i) tile_e[t++] = e; acc += nt * 256; }
        ps[NE] = acc; ps[NE + 1] = t; }
    __syncthreads();
}
__device__ __forceinline__ void ph_gather(const Frame& F, int layer) {
    LAS int* ps = (LAS int*)(F.lds + MISC_OFF + 256); LAS int* tile_e = ps + 64;
    moe_tables(F, layer, ps, tile_e);
    if (F.blk == 0) { int* tab = wsp<int>(F, WS_TILE); const int nt = ps[NE + 1]; if (F.tid == 0) tab[0] = nt; for (int i = F.tid; i < nt; i += 512) tab[1 + i] = tile_e[i]; }
    for (int i = F.blk * 512 + F.tid; i < R * 4; i += F.G * 512) { const int row = i >> 2;
        const int e = wsp<const int>(F, WS_TOPE)[i]; const int dest = ps[e] + wsp<const int>(F, WS_POS)[i]; wsp<int>(F, WS_DEST)[i] = dest; wsp<int>(F, WS_SRC)[dest] = row; }
}
struct MoeOrder {
    const int* tile_e; int ntiles, nN, G, c; const int* src;
    __device__ __forceinline__ bool next(int i, pg8::Unit& u) const {
        int rt, pl;
        if (G == 256) { const int x = c & 7, y = c >> 3, rpx = 32 / nN; rt = (i * 8 + x) * rpx + y / nN; pl = y % nN; if (rt >= ntiles) return false; }
        else { const long L = (long)i * G + c; if (L >= (long)ntiles * nN) return false; rt = (int)(L / nN); pl = (int)(L - (long)rt * nN); }
        const int e = __builtin_amdgcn_readfirstlane(tile_e[rt]);
        u.pm = rt; u.pn = e * nN + pl; return true; }
    __device__ __forceinline__ void a_ready(const pg8::Unit&) const {}
    __device__ __forceinline__ void done(const pg8::Unit&) const {}
};
struct LatOrder {
    pg8::StaticOrder o;
    __device__ __forceinline__ bool next(int i, pg8::Unit& u) const { if (!o.next(i, u)) return false; u.pm += 1 + (u.pm >= 64 ? 1 : 0); return true; }
    __device__ __forceinline__ void a_ready(const pg8::Unit&) const {}
    __device__ __forceinline__ void done(const pg8::Unit&) const {}
};
struct FnSwiglu {
    bf16* HS; const float* b1;
    __device__ __forceinline__ void operator()(int row, int col, f32x4 v0, f32x4 v1) const {
        const float* bp = b1 + col;
        const f32x4 b0 = *(const f32x4*)bp, b1v = *(const f32x4*)(bp + 4); v0 = v0 + b0; v1 = v1 + b1v;
        const float hv[8] = {v0[0], v0[1], v0[2], v0[3], v1[0], v1[1], v1[2], v1[3]}; float o[4];
#pragma unroll
        for (int i = 0; i < 4; ++i) { const float g = hv[2 * i], l = hv[2 * i + 1];
            const float gl = fminf(g, 7.f), li = fminf(fmaxf(l, -7.f), 7.f); o[i] = gl * sigmoidf_(1.702f * gl) * (li + 1.f); }
        const int lc = col & 2047; v2u w; w.x = pk2(o[0], o[1]); w.y = pk2(o[2], o[3]);
        *(v2u*)(HS + (size_t)row * 1024 + (lc >> 1)) = w; }
};
struct FnBiasBf16 {
    bf16* YS; const float* b2;
    __device__ __forceinline__ void operator()(int row, int col, f32x4 v0, f32x4 v1) const {
        const f32x4 b0 = *(const f32x4*)(b2 + col), b1v = *(const f32x4*)(b2 + col + 4); v0 = v0 + b0; v1 = v1 + b1v;
        v4u w; w.x = pk2(v0[0], v0[1]); w.y = pk2(v0[2], v0[3]); w.z = pk2(v1[0], v1[1]); w.w = pk2(v1[2], v1[3]);
        *(v4u*)(YS + (size_t)row * 1024 + (col & 1023)) = w; }
};
__device__ __forceinline__ void ph_combine(const Frame& F, int layer) {
    const int lane = F.lane, gw = F.blk * 8 + F.wave, NGW = F.G * 8;
    for (int row = gw; row < R; row += NGW) {
        const int sel = row_sel(row); const float* gf = modp(F, layer, sel, 5);
        bf16* hrow = wsp<bf16>(F, WS_H) + (size_t)row * DM;
        f32x4 y[4];
#pragma unroll
        for (int j = 0; j < 4; ++j) y[j] = (f32x4){0.f, 0.f, 0.f, 0.f};
#pragma unroll
        for (int r = 0; r < 4; ++r) { const int d = wsp<const int>(F, WS_DEST)[(size_t)row * 4 + r]; const float g = wsp<const float>(F, WS_GATE)[(size_t)row * 4 + r];
            const v2u* yp = (const v2u*)(wsp<const bf16>(F, WS_XS) + (size_t)d * DM);
#pragma unroll
            for (int j = 0; j < 4; ++j) { const v2u w = yp[lane + 64 * j]; y[j] += g * (f32x4){bflo(w.x), bfhi(w.x), bflo(w.y), bfhi(w.y)}; } }
        f32x4 h[4]; float s = 0.f;
#pragma unroll
        for (int j = 0; j < 4; ++j) { const v2u hw = ((const v2u*)hrow)[lane + 64 * j]; h[j] = (f32x4){bflo(hw.x), bfhi(hw.x), bflo(hw.y), bfhi(hw.y)} + ((const f32x4*)gf)[lane + 64 * j] * y[j]; s += (h[j].x * h[j].x + h[j].y * h[j].y) + (h[j].z * h[j].z + h[j].w * h[j].w); }
        const float rs = 1.f / sqrtf(wave_sum(s) * (1.f / DM) + NORM_EPS);
        if (layer == 0) {
#pragma unroll
            for (int j = 0; j < 4; ++j) { v2u hw; hw.x = pk2(h[j].x, h[j].y); hw.y = pk2(h[j].z, h[j].w); ((v2u*)hrow)[lane + 64 * j] = hw; }
            const float* nw = F.in[I_NMIX] + DM; const float* sh = modp(F, 1, sel, 0); const float* sc = modp(F, 1, sel, 1);
            unsigned long long* o8 = (unsigned long long*)(wsp<bf16>(F, WS_A) + (size_t)row * DM) + lane;
#pragma unroll
            for (int j = 0; j < 4; ++j) { const f32x4 w = ((const f32x4*)nw)[lane + 64 * j], a = ((const f32x4*)sh)[lane + 64 * j], c = ((const f32x4*)sc)[lane + 64 * j];
                const f32x4 o = h[j] * rs * w * (c + 1.f) + a; o8[64 * j] = (unsigned long long)pk2(o.x, o.y) | ((unsigned long long)pk2(o.z, o.w) << 32); }
        } else {
            const int b = row / TB, t = row - b * TB;
            if (t >= CT) { float* orow = F.out + ((size_t)b * SEQ + (t - CT)) * DM; const float* nw = F.in[I_FNW];
#pragma unroll
                for (int j = 0; j < 4; ++j) ((f32x4*)orow)[lane + 64 * j] = h[j] * rs * ((const f32x4*)nw)[lane + 64 * j]; }
        }
    }
}
constexpr int PC_Q = 1920, PC_K = 2176, PC_V = 2432, PC_O = 2944, PC_G = 3456;
__device__ __forceinline__ float softplusf_(float y) { return fmaxf(y, 0.f) + __logf(1.f + __expf(-fabsf(y))); }
__device__ __forceinline__ float tanhf_(float x) { return 1.f - 2.f / (1.f + __expf(2.f * x)); }
__device__ __forceinline__ void lerp8(const bf16* p, bool hp, bool hn, int c0, const float* mu, float (&u)[8]) {
    const v4u z4 = {0u, 0u, 0u, 0u};
    const v4u wx = *(const v4u*)(p + c0), wp = hp ? *(const v4u*)(p - REC_NP + c0) : z4, wn = hn ? *(const v4u*)(p + REC_NP + c0) : z4;
    float x[8], xp[8], xn[8]; unpack8(wx, x); unpack8(wp, xp); unpack8(wn, xn);
    const f32x4 m0 = *(const f32x4*)(mu + c0), m1 = *(const f32x4*)(mu + c0 + 4);
#pragma unroll
    for (int e = 0; e < 8; ++e) { const float m = e < 4 ? m0[e & 3] : m1[e & 3]; u[e] = x[e] + m * (0.5f * (xp[e] + xn[e]) - x[e]); }
}
__device__ __forceinline__ void st8h(bf16* o, const float (&u)[8]) { v4u w; w.x = pk2(u[0], u[1]); w.y = pk2(u[2], u[3]); w.z = pk2(u[4], u[5]); w.w = pk2(u[6], u[7]); *(v4u*)o = w; }
__device__ __forceinline__ void st8f(float* o, const float (&u)[8]) { *(f32x4*)o = (f32x4){u[0], u[1], u[2], u[3]}; *(f32x4*)(o + 4) = (f32x4){u[4], u[5], u[6], u[7]}; }
__device__ __forceinline__ void l1_rwkv_prep(const Frame& F) {
    const int gw = F.blk * 8 + F.wave, NGW = F.G * 8, lane = F.lane; const float* mu = F.in[I_MU];
    for (int row = gw; row < R; row += NGW) {
        const int b = row / TB, t = row - b * TB; const bool hp = (t != 0 && t != CT), hn = (t != CT - 1 && t != TB - 1);
        const bf16* p = wsp<const bf16>(F, WS_P) + (size_t)row * REC_NP; const size_t ro = (size_t)row * 512 + 8 * lane;
        float u[8];
        lerp8(p, hp, hn, 8 * lane, mu, u); st8h(wsp<bf16>(F, WS_RR) + ro, u);
        lerp8(p, hp, hn, 1024 + 8 * lane, mu, u); st8h(wsp<bf16>(F, WS_VV) + ro, u);
        lerp8(p, hp, hn, 512 + 8 * lane, mu, u); st8h(wsp<bf16>(F, WS_KL) + ro, u);
        { const f32x4 k0 = *(const f32x4*)(F.in[I_KK] + 8 * lane), k1 = *(const f32x4*)(F.in[I_KK] + 8 * lane + 4); float ss = 0.f;
#pragma unroll
          for (int e = 0; e < 8; ++e) { u[e] *= (e < 4 ? k0[e & 3] : k1[e & 3]); ss += u[e] * u[e]; }
          ss += __shfl_xor(ss, 1); ss += __shfl_xor(ss, 2); ss += __shfl_xor(ss, 4);
          const float inv = -1.f / sqrtf(fmaxf(ss, 1e-24f));
#pragma unroll
          for (int e = 0; e < 8; ++e) u[e] *= inv;
          st8h(wsp<bf16>(F, WS_AKK) + ro, u); }
        if (lane < 48) { lerp8(p, hp, hn, 1536 + 8 * lane, mu, u);
#pragma unroll
            for (int e = 0; e < 8; ++e) u[e] = lane < 16 ? tanhf_(u[e]) : (lane < 32 ? u[e] : sigmoidf_(u[e]));
            v4u w; w.x = pk2(u[0], u[1]); w.y = pk2(u[2], u[3]); w.z = pk2(u[4], u[5]); w.w = pk2(u[6], u[7]);
            *(v4u*)(wsp<bf16>(F, WS_ALORA) + (size_t)row * 384 + 8 * lane) = w; }
    }
}
struct EpiLora {
    static constexpr bool PERM = true, AFTER_DRAIN = false;
    const Frame* F;
    template <int KIND> __device__ __forceinline__ void run(const pg8::f32x4 (&acc)[2][2][4][2], const pg8::Unit& u, int wr, int wc, int fr, int fq, int z) const {
#pragma unroll
        for (int ai = 0; ai < 2; ++ai)
#pragma unroll
            for (int m = 0; m < 4; ++m) { const int row = u.pm * 256 + ai * 128 + wr * 64 + m * 16 + fr;
#pragma unroll
                for (int bj = 0; bj < 2; ++bj) { const int c = ((u.pn & 1) * 256) + bj * 128 + wc * 32 + 8 * fq; const size_t ro = (size_t)row * 512 + c;
                    const pg8::f32x4 v0 = acc[ai][bj][m][0], v1 = acc[ai][bj][m][1]; const float x[8] = {v0[0], v0[1], v0[2], v0[3], v1[0], v1[1], v1[2], v1[3]}; float o[8];
                    if constexpr (KIND == 0) { const float* w0 = F->in[I_W0] + z * 512 + c;
#pragma unroll
                        for (int e = 0; e < 8; ++e) { const float wl = -softplusf_(-(w0[e] + x[e])) - 0.5f; o[e] = __expf(-__expf(wl)); }
                        st8f(wsp<float>(*F, WS_WDEC) + (size_t)z * R * 512 + ro, o); }
                    else if constexpr (KIND == 1) { const float* a0 = F->in[I_A0] + z * 512 + c;
#pragma unroll
                        for (int e = 0; e < 8; ++e) o[e] = sigmoidf_(a0[e] + x[e]);
                        st8h(wsp<bf16>(*F, WS_ASIG) + (size_t)z * R * 512 + ro, o); }
                    else st8h(wsp<bf16>(*F, WS_GG) + ro, x); } }
    }
    __device__ __forceinline__ void operator()(const pg8::f32x4 (&acc)[2][2][4][2], const pg8::Unit& u, int wr, int wc, int fr, int fq) const {
        const int part = u.pn >> 1;
        if (part < 2) run<0>(acc, u, wr, wc, fr, fq, part); else if (part < 4) run<1>(acc, u, wr, wc, fr, fq, part - 2); else run<2>(acc, u, wr, wc, fr, fq, 0);
    }
};
__device__ __forceinline__ void mlstm_gates(const Frame& F, int row, int z, int h, float& ig, float& lf) {
    const bf16* g = wsp<const bf16>(F, WS_P) + (size_t)row * REC_NP + PC_G + z * 8 + h; const float* gb = F.in[I_GATEB] + z * 8 + h;
    const float gi = bf2f(g[0]) + gb[0], gf = bf2f(g[4]) + gb[4];
    ig = 15.f * tanhf_(gi * (1.f / 15.f)); const float cf = 15.f * tanhf_(gf * (1.f / 15.f)); lf = fminf(cf, 0.f) - __logf(1.f + __expf(-fabsf(cf)));
}
__device__ __forceinline__ void mlstm_chunk_head(const Frame& F, int z, int b, int h, int c, LAS float* vec) {
    LAS int* rows = (LAS int*)vec;
    if (F.tid < 64) { const int s = F.tid, row = b * TB + scan_tok(z, 64 * c + s); float ig, lf; mlstm_gates(F, row, z, h, ig, lf); rows[s] = row; vec[64 + s] = ig; vec[192 + s] = lf; }
    __syncthreads();
    if (F.tid < 64) { float a = 0.f; for (int s = 0; s <= F.tid; ++s) a += vec[192 + s]; vec[128 + F.tid] = a; }
    __syncthreads();
}
__device__ __forceinline__ void l1_mlstm_b(const Frame& F) {
    const float* __restrict__ SC = wsp<const float>(F, WS_SC); const float* __restrict__ DC = wsp<const float>(F, WS_DC); float* __restrict__ CST = wsp<float>(F, WS_CST);
    const float* __restrict__ DN = wsp<const float>(F, WS_DN); float* __restrict__ NST = wsp<float>(F, WS_NST); float* __restrict__ MST = wsp<float>(F, WS_MST);
    for (int g = F.blk * 512 + F.tid; g < 16 * 8192; g += F.G * 512) {
        const int chain = g >> 13, el = g & 8191; float m = 0.f, C = 0.f, N = 0.f; const bool don = el < 64;
        for (int c0 = 0; c0 < 260; c0 += 10) {
            float dc[10], dn[10], bl[10], ml[10];
#pragma unroll
            for (int i = 0; i < 10; ++i) { const size_t u = (size_t)chain * 260 + c0 + i; dc[i] = DC[u * 8192 + el]; dn[i] = don ? DN[u * 64 + el] : 0.f; bl[i] = SC[2 * u]; ml[i] = SC[2 * u + 1]; }
#pragma unroll
            for (int i = 0; i < 10; ++i) { const size_t u = (size_t)chain * 260 + c0 + i;
                CST[u * 8192 + el] = C; if (don) NST[u * 64 + el] = N; if (el == 0) MST[u] = m;
                const float mn = fmaxf(bl[i] + m, ml[i]), cd = __expf(bl[i] + m - mn), inj = __expf(ml[i] - mn);
                C = cd * C + inj * dc[i]; N = cd * N + inj * dn[i]; m = mn; }
        }
    }
}
__device__ __forceinline__ void l1_rec_out(const Frame& F) {
    const int gw = F.blk * 8 + F.wave, NGW = F.G * 8, lane = F.lane, c0 = 8 * lane;
    for (int row = gw; row < R; row += NGW) {
        const size_t ro = (size_t)row * 512 + c0; bf16* a1 = wsp<bf16>(F, WS_A1) + (size_t)row * DM;
        { float y0[8], y1[8], y[8]; float s = 0.f; unpack8(*(const v4u*)(wsp<const bf16>(F, WS_YR) + ro), y0); unpack8(*(const v4u*)(wsp<const bf16>(F, WS_YR) + (size_t)R * 512 + ro), y1);
          const float* y2 = wsp<const float>(F, WS_YB) + ro; const float* y3 = y2 + (size_t)R * 512;
#pragma unroll
          for (int e = 0; e < 8; ++e) { y[e] = (y0[e] + y1[e]) + (y2[e] + y3[e]); s += y[e]; }
          s += __shfl_xor(s, 1); s += __shfl_xor(s, 2); s += __shfl_xor(s, 4); const float mean = s * (1.f / 64.f); float q = 0.f;
#pragma unroll
          for (int e = 0; e < 8; ++e) { y[e] -= mean; q += y[e] * y[e]; }
          q += __shfl_xor(q, 1); q += __shfl_xor(q, 2); q += __shfl_xor(q, 4); const float rstd = 1.f / sqrtf(q * (1.f / 64.f) + 64e-5f);
          float rr[8], kl[8], s0[8], s1[8], vv[8], gg[8]; unpack8(*(const v4u*)(wsp<const bf16>(F, WS_RR) + ro), rr); unpack8(*(const v4u*)(wsp<const bf16>(F, WS_KL) + ro), kl);
          unpack8(*(const v4u*)(wsp<const bf16>(F, WS_ASIG) + ro), s0); unpack8(*(const v4u*)(wsp<const bf16>(F, WS_ASIG) + (size_t)R * 512 + ro), s1);
          unpack8(*(const v4u*)(wsp<const bf16>(F, WS_VV) + ro), vv); unpack8(*(const v4u*)(wsp<const bf16>(F, WS_GG) + ro), gg);
          const float* rk = F.in[I_RK] + c0; const float* ka = F.in[I_KA] + c0; float bs = 0.f;
#pragma unroll
          for (int e = 0; e < 8; ++e) bs += rr[e] * kl[e] * (2.f + (s0[e] + s1[e] - 2.f) * ka[e]) * rk[e];
          bs += __shfl_xor(bs, 1); bs += __shfl_xor(bs, 2); bs += __shfl_xor(bs, 4);
          const float* lw = F.in[I_LNW] + c0; const float* lb = F.in[I_LNB] + c0; float o[8];
#pragma unroll
          for (int e = 0; e < 8; ++e) o[e] = (y[e] * rstd * lw[e] + lb[e] + bs * vv[e]) * gg[e];
          v4u w; w.x = pk2(o[0], o[1]); w.y = pk2(o[2], o[3]); w.z = pk2(o[4], o[5]); w.w = pk2(o[6], o[7]); *(v4u*)(a1 + c0) = w; }
        { float h0[8], h1[8], x[8]; float q = 0.f; unpack8(*(const v4u*)(wsp<const bf16>(F, WS_HM) + ro), h0); unpack8(*(const v4u*)(wsp<const bf16>(F, WS_HM) + (size_t)R * 512 + ro), h1);
#pragma unroll
          for (int e = 0; e < 8; ++e) { x[e] = h0[e] + h1[e]; q += x[e] * x[e]; }
          q += __shfl_xor(q, 1); q += __shfl_xor(q, 2); q += __shfl_xor(q, 4); q += __shfl_xor(q, 8); const float rs = 1.f / sqrtf(q * (1.f / 128.f) + NORM_EPS);
          float og[8]; unpack8(*(const v4u*)(wsp<const bf16>(F, WS_P) + (size_t)row * REC_NP + PC_O + c0), og); const float* nw = F.in[I_MNW] + c0; float o[8];
#pragma unroll
          for (int e = 0; e < 8; ++e) o[e] = x[e] * rs * nw[e] * sigmoidf_(og[e]);
          v4u w; w.x = pk2(o[0], o[1]); w.y = pk2(o[2], o[3]); w.z = pk2(o[4], o[5]); w.w = pk2(o[6], o[7]); *(v4u*)(a1 + 512 + c0) = w; }
    }
}
#ifndef NEU_ROUNDS
#define NEU_ROUNDS 6
#endif
namespace rk {
constexpr int LS = 72;
constexpr int MB = 64 * LS * 2;
struct Acc2 { pg8::f32x4 t0, t1; };
__device__ __forceinline__ void zero(Acc2& a) { a.t0 = (pg8::f32x4){0.f, 0.f, 0.f, 0.f}; a.t1 = a.t0; }
__device__ __forceinline__ void mm_acc(Acc2& acc, const LAS bf16* A, const LAS bf16* Bt, int wave, int lane) {
    const int tm = wave >> 1, tn0 = (wave & 1) * 2, lr = lane & 15, kq = (lane >> 4) * 8;
    const LAS bf16* ap = A + (tm * 16 + lr) * LS + kq; const LAS bf16* bp0 = Bt + (tn0 * 16 + lr) * LS + kq; const LAS bf16* bp1 = bp0 + 16 * LS;
    const bf16x8 a0 = *(const LAS bf16x8*)ap, a1 = *(const LAS bf16x8*)(ap + 32);
    const bf16x8 b00 = *(const LAS bf16x8*)bp0, b01 = *(const LAS bf16x8*)(bp0 + 32), b10 = *(const LAS bf16x8*)bp1, b11 = *(const LAS bf16x8*)(bp1 + 32);
    acc.t0 = __builtin_amdgcn_mfma_f32_16x16x32_bf16(a0, b00, acc.t0, 0, 0, 0); acc.t0 = __builtin_amdgcn_mfma_f32_16x16x32_bf16(a1, b01, acc.t0, 0, 0, 0);
    acc.t1 = __builtin_amdgcn_mfma_f32_16x16x32_bf16(a0, b10, acc.t1, 0, 0, 0); acc.t1 = __builtin_amdgcn_mfma_f32_16x16x32_bf16(a1, b11, acc.t1, 0, 0, 0);
}
template <class Fn> __device__ __forceinline__ void each(const Acc2& acc, int wave, int lane, Fn fn) {
    const int m0 = (wave >> 1) * 16 + (lane >> 4) * 4, n0 = (wave & 1) * 32 + (lane & 15);
#pragma unroll
    for (int r = 0; r < 4; ++r) { fn(m0 + r, n0, acc.t0[r]); fn(m0 + r, n0 + 16, acc.t1[r]); }
}
__device__ __forceinline__ void stb(LAS bf16* M, int m, int n, float v) { M[m * LS + n] = (bf16)f2bf(v); }
__device__ __forceinline__ void st_tr(LAS bf16* M, const Acc2& acc, int wave, int lane) {
    const int m0 = (wave >> 1) * 16 + (lane >> 4) * 4, n0 = (wave & 1) * 32 + (lane & 15);
    v2u a, b; a.x = pk2(acc.t0[0], acc.t0[1]); a.y = pk2(acc.t0[2], acc.t0[3]); b.x = pk2(acc.t1[0], acc.t1[1]); b.y = pk2(acc.t1[2], acc.t1[3]);
    *(LAS v2u*)(M + n0 * LS + m0) = a; *(LAS v2u*)(M + (n0 + 16) * LS + m0) = b;
}
}
__device__ __forceinline__ void l1_rk_phase_a(const Frame& F) {
    using namespace rk;
    LAS unsigned char* L = F.lds;
    LAS bf16* Rt = (LAS bf16*)(L + 0 * MB); LAS bf16* At = (LAS bf16*)(L + 1 * MB); LAS bf16* AtT = (LAS bf16*)(L + 2 * MB); LAS bf16* Bq = (LAS bf16*)(L + 3 * MB); LAS bf16* Kq = (LAS bf16*)(L + 4 * MB);
    LAS bf16* VT = (LAS bf16*)(L + 5 * MB); LAS bf16* BhT = (LAS bf16*)(L + 6 * MB); LAS bf16* KhT = (LAS bf16*)(L + 7 * MB);
    LAS bf16* AK = (LAS bf16*)(L + 8 * MB); LAS bf16* RB = (LAS bf16*)(L + 9 * MB); LAS bf16* RK = (LAS bf16*)(L + 10 * MB);
    LAS bf16* X = (LAS bf16*)(L + 11 * MB); LAS bf16* XT = (LAS bf16*)(L + 12 * MB); LAS bf16* P = (LAS bf16*)(L + 13 * MB);
    LAS bf16* AkVT = Bq; LAS bf16* ApT = Kq; LAS bf16* W2T = X;
    LAS float* G = (LAS float*)(L + 8 * MB);
    LAS float* gl = (LAS float*)(L + 14 * MB);
    const int w = F.wave, lane = F.lane, tid = F.tid;
    const int t = lane, j0 = 8 * w;
    float fr[8], fv[8], fa[8], fw[8], fk[8], fb[8];
#define RK_LOAD(u_) do { const int ch_ = (u_) / 260, c_ = (u_) - ch_ * 260, z_ = ch_ >> 4, b_ = (ch_ >> 3) & 1, h_ = ch_ & 7; const size_t ro = ((size_t)b_ * TB + scan_tok(z_, 64 * c_ + t)) * 512 + h_ * 64 + j0; \
    const v4u xr_ = *(const v4u*)(wsp<const bf16>(F, WS_RR) + ro), xv_ = *(const v4u*)(wsp<const bf16>(F, WS_VV) + ro), xa_ = *(const v4u*)(wsp<const bf16>(F, WS_AKK) + ro), xk_ = *(const v4u*)(wsp<const bf16>(F, WS_KL) + ro), \
              xs_ = *(const v4u*)(wsp<const bf16>(F, WS_ASIG) + (size_t)z_ * R * 512 + ro); const float* p3 = wsp<const float>(F, WS_WDEC) + (size_t)z_ * R * 512 + ro; const float* pk_ = F.in[I_KA] + h_ * 64 + j0; \
    const f32x4 w0_ = *(const f32x4*)p3, w1_ = *(const f32x4*)(p3 + 4), q0_ = *(const f32x4*)pk_, q1_ = *(const f32x4*)(pk_ + 4); float sg_[8], kl_[8]; \
    unpack8(xr_, fr); unpack8(xv_, fv); unpack8(xa_, fa); unpack8(xk_, kl_); unpack8(xs_, sg_); \
    _Pragma("unroll") for (int e = 0; e < 8; ++e) { const float kav = e < 4 ? q0_[e & 3] : q1_[e & 3]; fw[e] = e < 4 ? w0_[e & 3] : w1_[e & 3]; fk[e] = kl_[e] * (1.f + (sg_[e] - 1.f) * kav); fb[e] = -fa[e] * sg_[e]; } } while (0)
    if (F.blk < NUNIT_R) RK_LOAD(F.blk);
    for (int u = F.blk; u < NUNIT_R; u += F.G) {
        const int chain = u / 260, c = u - chain * 260, z = chain >> 4, b = (chain >> 3) & 1, h = chain & 7;
        __syncthreads();
#pragma unroll
        for (int e = 0; e < 8; ++e) G[t * 65 + j0 + e] = fw[e];
        __syncthreads();
        if (tid < 64) { float g = 1.f;
#pragma unroll 16
            for (int s = 0; s < 64; ++s) { g *= G[s * 65 + tid]; G[s * 65 + tid] = g; } gl[tid] = g; }
        __syncthreads();
#pragma unroll
        for (int e = 0; e < 8; ++e) { const int j = j0 + e; const float gt = G[t * 65 + j], gp = t > 0 ? G[(t - 1) * 65 + j] : 1.f, gL = G[63 * 65 + j], ig = 1.f / gt;
            fr[e] *= gt; fa[e] *= gp; const float bq = fb[e] * ig, kq = fk[e] * ig; fb[e] = bq; fk[e] = kq; fw[e] = gL; }
        __syncthreads();
        { v4u q; q.x = pk2(fr[0], fr[1]); q.y = pk2(fr[2], fr[3]); q.z = pk2(fr[4], fr[5]); q.w = pk2(fr[6], fr[7]); *(LAS v4u*)(Rt + t * LS + j0) = q;
          q.x = pk2(fa[0], fa[1]); q.y = pk2(fa[2], fa[3]); q.z = pk2(fa[4], fa[5]); q.w = pk2(fa[6], fa[7]); *(LAS v4u*)(At + t * LS + j0) = q;
          q.x = pk2(fb[0], fb[1]); q.y = pk2(fb[2], fb[3]); q.z = pk2(fb[4], fb[5]); q.w = pk2(fb[6], fb[7]); *(LAS v4u*)(Bq + t * LS + j0) = q;
          q.x = pk2(fk[0], fk[1]); q.y = pk2(fk[2], fk[3]); q.z = pk2(fk[4], fk[5]); q.w = pk2(fk[6], fk[7]); *(LAS v4u*)(Kq + t * LS + j0) = q; }
#pragma unroll
        for (int e = 0; e < 8; ++e) { const int j = j0 + e; stb(AtT, j, t, fa[e]); stb(VT, j, t, fv[e]); stb(BhT, j, t, fb[e] * fw[e]); stb(KhT, j, t, fk[e] * fw[e]); }
        __syncthreads();
        if (u + F.G < NUNIT_R) RK_LOAD(u + F.G);
        Acc2 a1, a2, a3, a4;
        zero(a1); mm_acc(a1, At, Bq, w, lane); zero(a2); mm_acc(a2, At, Kq, w, lane); zero(a3); mm_acc(a3, Rt, Bq, w, lane); zero(a4); mm_acc(a4, Rt, Kq, w, lane);
        each(a1, w, lane, [&](int m, int n, float v) { const float x = n < m ? v : 0.f; stb(X, m, n, x); stb(XT, n, m, x); stb(P, m, n, m == n ? 1.f : 0.f); });
        each(a2, w, lane, [&](int m, int n, float v) { stb(AK, m, n, n < m ? v : 0.f); });
        each(a3, w, lane, [&](int m, int n, float v) { stb(RB, m, n, n <= m ? v : 0.f); });
        each(a4, w, lane, [&](int m, int n, float v) { stb(RK, m, n, n <= m ? v : 0.f); });
        __syncthreads();
        { const int m0 = (w >> 1) * 16 + (lane >> 4) * 4, n0 = (w & 1) * 32 + (lane & 15);
          Acc2 pt;
#pragma unroll
          for (int r = 0; r < 4; ++r) { pt.t0[r] = (m0 + r == n0) ? 1.f : 0.f; pt.t1[r] = (m0 + r == n0 + 16) ? 1.f : 0.f; }
#pragma unroll 1
          for (int i = 0; i < NEU_ROUNDS; ++i) {
            mm_acc(pt, P, XT, w, lane);
            if (i < NEU_ROUNDS - 1) { zero(a1); mm_acc(a1, X, XT, w, lane); }
            __syncthreads();
#pragma unroll
            for (int r = 0; r < 4; ++r) { stb(P, m0 + r, n0, pt.t0[r]); stb(P, m0 + r, n0 + 16, pt.t1[r]); }
            if (i < NEU_ROUNDS - 1) { each(a1, w, lane, [&](int m, int n, float v) { stb(X, m, n, v); }); st_tr(XT, a1, w, lane); }
            __syncthreads();
          } }
        zero(a1); mm_acc(a1, AK, VT, w, lane); zero(a2); mm_acc(a2, P, AtT, w, lane);
        st_tr(AkVT, a1, w, lane); st_tr(ApT, a2, w, lane);
        __syncthreads();
        zero(a3); mm_acc(a3, P, AkVT, w, lane);
        st_tr(W2T, a3, w, lane);
        __syncthreads();
        zero(a1); mm_acc(a1, RB, ApT, w, lane); zero(a2); mm_acc(a2, RB, W2T, w, lane); mm_acc(a2, RK, VT, w, lane);
        zero(a3); mm_acc(a3, BhT, ApT, w, lane); zero(a4); mm_acc(a4, BhT, W2T, w, lane); mm_acc(a4, KhT, VT, w, lane);
        __syncthreads();
        { LAS bf16* O1 = At; LAS bf16* O2 = AtT; LAS bf16* O3 = AK; LAS float* OY = (LAS float*)X;
          each(a1, w, lane, [&](int m, int n, float v) { stb(O1, m, n, v + bf2f(Rt[m * LS + n])); });
          each(a3, w, lane, [&](int m, int n, float v) { stb(O2, m, n, v + (m == n ? gl[m] : 0.f)); });
          each(a4, w, lane, [&](int m, int n, float v) { stb(O3, m, n, v); });
          each(a2, w, lane, [&](int m, int n, float v) { OY[m * 68 + n] = v; });
          __syncthreads();
          const int row = tid >> 3, c8 = (tid & 7) * 8;
          *(v4u*)(wsp<bf16>(F, WS_RKQ) + (size_t)u * 4096 + row * 64 + c8) = *(const LAS v4u*)(O1 + row * LS + c8);
          *(v4u*)(wsp<bf16>(F, WS_RKM) + (size_t)u * 4096 + row * 64 + c8) = *(const LAS v4u*)(O2 + row * LS + c8);
          *(v4u*)(wsp<bf16>(F, WS_RKZ) + (size_t)u * 4096 + row * 64 + c8) = *(const LAS v4u*)(O3 + row * LS + c8);
          bf16* Yg = wsp<bf16>(F, WS_YR) + (size_t)z * R * 512 + h * 64;
#pragma unroll
          for (int i = 0; i < 2; ++i) { const int yr = (tid >> 4) + 32 * i, c4 = (tid & 15) * 4; const f32x4 yv = *(const LAS f32x4*)(OY + yr * 68 + c4); v2u yw; yw.x = pk2(yv.x, yv.y); yw.y = pk2(yv.z, yv.w);
              *(v2u*)(Yg + ((size_t)b * TB + scan_tok(z, 64 * c + yr)) * 512 + c4) = yw; } }
    }
#undef RK_LOAD
}
__device__ __forceinline__ void l1_rk_phase_b(const Frame& F) {
    using namespace rk;
    LAS unsigned char* L = F.lds;
    const int w = F.wave, lane = F.lane, tid = F.tid, chain = F.blk, z = chain >> 4, b = (chain >> 3) & 1, h = chain & 7;
    for (int i = tid; i < 2 * 64 * LS; i += 512) ((LAS bf16*)L)[i] = 0;
    const int sr = tid >> 3, sc = (tid & 7) * 8;
    v4u gm, gq, gz;
#define RKB_LOAD(u_) do { gm = *(const v4u*)(wsp<const bf16>(F, WS_RKM) + (u_) * 4096 + sr * 64 + sc); gq = *(const v4u*)(wsp<const bf16>(F, WS_RKQ) + (u_) * 4096 + sr * 64 + sc); \
    gz = *(const v4u*)(wsp<const bf16>(F, WS_RKZ) + (u_) * 4096 + sr * 64 + sc); } while (0)
#define RKB_WRITE(par) do { *(LAS v4u*)((LAS bf16*)(L + (2 + 3 * (par)) * MB) + sr * LS + sc) = gm; *(LAS v4u*)((LAS bf16*)(L + (3 + 3 * (par)) * MB) + sr * LS + sc) = gq; \
    *(LAS v4u*)((LAS bf16*)(L + (4 + 3 * (par)) * MB) + sr * LS + sc) = gz; } while (0)
    RKB_LOAD((size_t)chain * 260); RKB_WRITE(0);
    __syncthreads();
    float* Yg = wsp<float>(F, WS_YB) + (size_t)z * R * 512 + h * 64;
    const int m0 = (w >> 1) * 16 + (lane >> 4) * 4, n0 = (w & 1) * 32 + (lane & 15);
    for (int c = 0; c < 260; ++c) {
        const size_t u = (size_t)chain * 260 + c; const int par = c & 1;
        if (c + 1 < 260) RKB_LOAD(u + 1);
        const LAS bf16* S = (const LAS bf16*)(L + par * MB); LAS bf16* Sn = (LAS bf16*)(L + (par ^ 1) * MB);
        const LAS bf16* Mt = (const LAS bf16*)(L + (2 + 3 * par) * MB); const LAS bf16* Qp = (const LAS bf16*)(L + (3 + 3 * par) * MB); const LAS bf16* Zt = (const LAS bf16*)(L + (4 + 3 * par) * MB);
        Acc2 a1, a2;
#pragma unroll
        for (int r = 0; r < 4; ++r) { a1.t0[r] = bf2f(Zt[(m0 + r) * LS + n0]); a1.t1[r] = bf2f(Zt[(m0 + r) * LS + n0 + 16]); }
        mm_acc(a1, Mt, S, w, lane); zero(a2); mm_acc(a2, Qp, S, w, lane);
        st_tr(Sn, a1, w, lane);
        if (c + 1 < 260) RKB_WRITE(par ^ 1);
#pragma unroll
        for (int r = 0; r < 4; ++r) { const size_t yo = ((size_t)b * TB + scan_tok(z, 64 * c + m0 + r)) * 512 + n0; Yg[yo] = a2.t0[r]; Yg[yo + 16] = a2.t1[r]; }
        __syncthreads();
    }
#undef RKB_LOAD
#undef RKB_WRITE
}
__device__ __forceinline__ void l1_mlstm_a2(const Frame& F) {
    using namespace rk;
    LAS bf16* KT = (LAS bf16*)F.lds; LAS bf16* VsT = KT + 64 * LS;
    LAS float* vec = (LAS float*)(F.lds + AUX_OFF); LAS int* rows = (LAS int*)vec;
    const bf16* Pg = wsp<const bf16>(F, WS_P); const int tid = F.tid, w = F.wave, lane = F.lane;
    for (int u = F.blk; u < NUNIT_M; u += F.G) {
        const int cidx = u / 260, c = u - cidx * 260, z = cidx >> 3, b = (cidx >> 2) & 1, h = cidx & 3;
        mlstm_chunk_head(F, z, b, h, c, vec);
        if (tid < 64) { const float bl = vec[128 + 63]; const float uu = bl - vec[128 + tid] + vec[64 + tid]; float m = uu;
#pragma unroll
            for (int o = 1; o < 64; o <<= 1) m = fmaxf(m, __shfl_xor(m, o));
            vec[256 + tid] = __expf(uu - m);
            if (tid == 0) { wsp<float>(F, WS_SC)[2 * u] = bl; wsp<float>(F, WS_SC)[2 * u + 1] = m; } }
        __syncthreads();
        { const int s = tid >> 3, c8 = tid & 7; float x[8]; unpack8(*(const v4u*)(Pg + (size_t)rows[s] * REC_NP + PC_K + h * 64 + 8 * c8), x);
#pragma unroll
          for (int e = 0; e < 8; ++e) stb(KT, 8 * c8 + e, s, x[e]); }
#pragma unroll
        for (int i = 0; i < 2; ++i) { const int s = (tid >> 4) + 32 * i, c8 = tid & 15; float x[8]; unpack8(*(const v4u*)(Pg + (size_t)rows[s] * REC_NP + PC_V + h * 128 + 8 * c8), x); const float sw = vec[256 + s];
#pragma unroll
            for (int e = 0; e < 8; ++e) stb(VsT, 8 * c8 + e, s, x[e] * sw); }
        __syncthreads();
        Acc2 a0, a1; zero(a0); mm_acc(a0, VsT, KT, w, lane); zero(a1); mm_acc(a1, VsT + 64 * LS, KT, w, lane);
        float* dc = wsp<float>(F, WS_DC) + (size_t)u * 8192;
        each(a0, w, lane, [&](int m, int n, float v) { dc[m * 64 + n] = 0.125f * v; });
        each(a1, w, lane, [&](int m, int n, float v) { dc[(64 + m) * 64 + n] = 0.125f * v; });
        if (tid < 64) { float a = 0.f; for (int s = 0; s < 64; ++s) a += vec[256 + s] * bf2f(KT[tid * LS + s]); wsp<float>(F, WS_DN)[(size_t)u * 64 + tid] = 0.125f * a; }
        __syncthreads();
    }
}
__device__ __forceinline__ void l1_mlstm_c2(const Frame& F, int first_blk, int nblk) {
    using namespace rk;
    LAS bf16* Q = (LAS bf16*)F.lds; LAS bf16* K = Q + 64 * LS; LAS bf16* VT = K + 64 * LS; LAS bf16* Cm = VT + 128 * LS; LAS bf16* Pm = Cm + 128 * LS;
    LAS float* OH = (LAS float*)(F.lds + 7 * MB);
    LAS float* vec = (LAS float*)(F.lds + AUX_OFF); LAS int* rows = (LAS int*)vec;
    const bf16* Pg = wsp<const bf16>(F, WS_P); const int tid = F.tid, w = F.wave, lane = F.lane;
    for (int u = F.blk - first_blk; u < NUNIT_M; u += nblk) {
        const int cidx = u / 260, c = u - cidx * 260, z = cidx >> 3, b = (cidx >> 2) & 1, h = cidx & 3;
        mlstm_chunk_head(F, z, b, h, c, vec);
        const float mst = wsp<const float>(F, WS_MST)[u];
        if (tid < 64) { const int t = tid; float pm = -3.0e38f; for (int s = 0; s <= t; ++s) pm = fmaxf(pm, vec[64 + s] - vec[128 + s]);
            const float gi = vec[128 + t] + mst, mo = fmaxf(gi, vec[128 + t] + pm); vec[320 + t] = __expf(gi - mo); vec[384 + t] = mo;
            vec[256 + t] = wsp<const float>(F, WS_NST)[(size_t)u * 64 + t]; }
        { const int t = tid >> 3, c8 = tid & 7;
          *(LAS v4u*)(Q + t * LS + 8 * c8) = *(const v4u*)(Pg + (size_t)rows[t] * REC_NP + PC_Q + h * 64 + 8 * c8);
          *(LAS v4u*)(K + t * LS + 8 * c8) = *(const v4u*)(Pg + (size_t)rows[t] * REC_NP + PC_K + h * 64 + 8 * c8); }
#pragma unroll
        for (int i = 0; i < 2; ++i) { const int s = (tid >> 4) + 32 * i, c8 = tid & 15; const v4u wv = *(const v4u*)(Pg + (size_t)rows[s] * REC_NP + PC_V + h * 128 + 8 * c8);
            const unsigned ww[4] = {wv.x, wv.y, wv.z, wv.w};
#pragma unroll
            for (int e = 0; e < 4; ++e) { VT[(8 * c8 + 2 * e) * LS + s] = (bf16)(ww[e] & 0xffffu); VT[(8 * c8 + 2 * e + 1) * LS + s] = (bf16)(ww[e] >> 16); } }
        { const int v = tid >> 2, dq = (tid & 3) * 16; const f32x4* src = (const f32x4*)(wsp<const float>(F, WS_CST) + (size_t)u * 8192 + v * 64 + dq);
          const f32x4 x0 = src[0], x1 = src[1], x2 = src[2], x3 = src[3]; v4u o0, o1;
          o0.x = pk2(x0.x, x0.y); o0.y = pk2(x0.z, x0.w); o0.z = pk2(x1.x, x1.y); o0.w = pk2(x1.z, x1.w); o1.x = pk2(x2.x, x2.y); o1.y = pk2(x2.z, x2.w); o1.z = pk2(x3.x, x3.y); o1.w = pk2(x3.z, x3.w);
          *(LAS v4u*)(Cm + v * LS + dq) = o0; *(LAS v4u*)(Cm + v * LS + dq + 8) = o1; }
        __syncthreads();
        Acc2 aq, c0, c1; zero(aq); mm_acc(aq, Q, K, w, lane); zero(c0); mm_acc(c0, Q, Cm, w, lane); zero(c1); mm_acc(c1, Q, Cm + 64 * LS, w, lane);
        each(aq, w, lane, [&](int t, int s, float v) { stb(Pm, t, s, s <= t ? 0.125f * v * __expf(vec[128 + t] + (vec[64 + s] - vec[128 + s]) - vec[384 + t]) : 0.f); });
        __syncthreads();
        Acc2 p0, p1; zero(p0); mm_acc(p0, Pm, VT, w, lane); zero(p1); mm_acc(p1, Pm, VT + 64 * LS, w, lane);
        if (tid < 64) { const int t = tid; float rs = 0.f, nq = 0.f;
            for (int s = 0; s < 64; ++s) { rs += bf2f(Pm[t * LS + s]); nq += vec[256 + s] * bf2f(Q[t * LS + s]); }
            const float den = vec[320 + t] * nq + rs; vec[448 + t] = 1.f / fmaxf(fabsf(den), __expf(-vec[384 + t])); }
        __syncthreads();
        { const int m0 = (w >> 1) * 16 + (lane >> 4) * 4, n0 = (w & 1) * 32 + (lane & 15);
#pragma unroll
          for (int r = 0; r < 4; ++r) { const int t = m0 + r; const float g = vec[320 + t], idn = vec[448 + t];
              OH[t * 132 + n0] = (g * c0.t0[r] + p0.t0[r]) * idn; OH[t * 132 + n0 + 16] = (g * c0.t1[r] + p0.t1[r]) * idn;
              OH[t * 132 + 64 + n0] = (g * c1.t0[r] + p1.t0[r]) * idn; OH[t * 132 + 64 + n0 + 16] = (g * c1.t1[r] + p1.t1[r]) * idn; } }
        __syncthreads();
#pragma unroll
        for (int i = 0; i < 4; ++i) { const int it = tid + 512 * i, t = it >> 5, c4 = (it & 31) * 4;
            const f32x4 hv = *(const LAS f32x4*)(OH + t * 132 + c4); v2u hw; hw.x = pk2(hv.x, hv.y); hw.y = pk2(hv.z, hv.w);
            *(v2u*)(wsp<bf16>(F, WS_HM) + ((size_t)z * R + rows[t]) * 512 + h * 128 + c4) = hw; }
        __syncthreads();
    }
}
#ifndef MK_PER_PHASE
#define MK_PER_PHASE 0
#endif
constexpr int NPHASE = 26;
struct Args { const float* in[N_IN]; float* out; unsigned char* ws; int ph_lo, ph_hi, li, pad; };
#define GEMM_CALL(FnT, SchedT, g, S, fn) do { pg8::EpiGen<FnT> E_{fn}; { int k_ = g.K; asm volatile("" : "+s"(k_)); g.K = k_; } pg8::gemm_phase<pg8::EpiGen<FnT>, SchedT, true, true>((PG8_LAS unsigned char*)F.lds, g, S, E_); } while (0)
#ifndef SITE_MASK
#define SITE_MASK 0xFFFFFFFFull
#endif
#define SITE(s) (((SITE_MASK) >> (s)) & 1ull)
#ifndef DUP_MASK
#define DUP_MASK 0ull
#endif
#define NREP(s) ((((DUP_MASK) >> (s)) & 1ull) ? 2 : 1)
#define IN(k) (lo <= (k) && (k) < hi)
#define SEAM(k) do { if (IN(k) && IN((k) + 1)) xcd_barrier(bar); } while (0)
template <int LAYER> __device__ __forceinline__ void layer_phases(const Frame& F, const XcdBarrier& bar, const int lo, const int hi) {
    constexpr int layer = LAYER; constexpr int pb = 2 + 12 * LAYER;
        if (SITE(2) && IN(pb + 0)) { for (int rep_ = 0; rep_ < NREP(2); ++rep_) {
            const int N = layer == 0 ? ATT_NP : REC_NP;
            pg8::Gemm g{wsp<const bf16>(F, WS_A), layer == 0 ? wsp<const bf16>(F, WS_WIN0) : wsp<const bf16>(F, WS_WREC), R, N, 1024};
            pg8::StaticOrder S; S.init(R, N, F.G, F.blk);
            GEMM_CALL(FnStoreBf16, pg8::StaticOrder, g, S, (FnStoreBf16{wsp<bf16>(F, WS_P), N}));
             if (rep_ + 1 < NREP(2)) xcd_barrier(bar); } SEAM(pb + 0);
        }
        if constexpr (LAYER == 0) {
            if (SITE(3) && IN(pb + 1)) { for (int rep_ = 0; rep_ < NREP(3); ++rep_) { l0_post_proj(F);  if (rep_ + 1 < NREP(3)) xcd_barrier(bar); } SEAM(pb + 1); }
            if (SITE(4) && IN(pb + 2)) { for (int rep_ = 0; rep_ < NREP(4); ++rep_) {
                pg8::Gemm g{wsp<const bf16>(F, WS_CQN), wsp<const bf16>(F, WS_WUQ), R, 768, 384}; pg8::StaticOrder S; S.init(R, 768, F.G, F.blk);
                GEMM_CALL(FnStoreBf16, pg8::StaticOrder, g, S, (FnStoreBf16{wsp<bf16>(F, WS_MQ), 768}));
                 if (rep_ + 1 < NREP(4)) xcd_barrier(bar); } SEAM(pb + 2);
            }
            if (SITE(5) && IN(pb + 3)) { for (int rep_ = 0; rep_ < NREP(5); ++rep_) {
                pg8::Gemm g{wsp<const bf16>(F, WS_CKVN), wsp<const bf16>(F, WS_WUKV), R, 1024, 256}; pg8::StaticOrder S; S.init(R, 1024, F.G, F.blk);
                GEMM_CALL(FnStoreBf16, pg8::StaticOrder, g, S, (FnStoreBf16{wsp<bf16>(F, WS_MKV), 1024}));
                l0_mq_rope(F);
                 if (rep_ + 1 < NREP(5)) xcd_barrier(bar); } SEAM(pb + 3);
            }
            if (SITE(6) && IN(pb + 4)) { for (int rep_ = 0; rep_ < NREP(6); ++rep_) { l0_attention(F);  if (rep_ + 1 < NREP(6)) xcd_barrier(bar); } SEAM(pb + 4); }
            if (SITE(7) && IN(pb + 5)) { for (int rep_ = 0; rep_ < NREP(7); ++rep_) { l0_combine(F);  if (rep_ + 1 < NREP(7)) xcd_barrier(bar); } SEAM(pb + 5); }
        } else {
            if (SITE(8) && IN(pb + 1)) { for (int rep_ = 0; rep_ < NREP(8); ++rep_) { l1_rwkv_prep(F); l1_mlstm_a2(F);  if (rep_ + 1 < NREP(8)) xcd_barrier(bar); } SEAM(pb + 1); }
            if (SITE(9) && IN(pb + 2)) { for (int rep_ = 0; rep_ < NREP(9); ++rep_) {
                pg8::Gemm g{wsp<const bf16>(F, WS_ALORA), wsp<const bf16>(F, WS_WLORA), R, 2560, 384}; pg8::StaticOrder S; S.init(R, 2560, F.G, F.blk);
                { int k_ = g.K; asm volatile("" : "+s"(k_)); g.K = k_; EpiLora E_{&F}; pg8::gemm_phase<EpiLora, pg8::StaticOrder, true, true>((PG8_LAS unsigned char*)F.lds, g, S, E_); }
                l1_mlstm_b(F);
                 if (rep_ + 1 < NREP(9)) xcd_barrier(bar); } SEAM(pb + 2);
            }
            if (SITE(18) && IN(pb + 3)) { for (int rep_ = 0; rep_ < NREP(18); ++rep_) { l1_rk_phase_a(F); if (rep_ + 1 < NREP(18)) xcd_barrier(bar); } SEAM(pb + 3); }
            if (SITE(10) && IN(pb + 4)) { for (int rep_ = 0; rep_ < NREP(10); ++rep_) {
                if (F.G > 32) { if (F.blk < 32) l1_rk_phase_b(F); else { l1_mlstm_c2(F, 32, F.G - 32); moe_weights_convert(F, 1, (F.blk - 32) * 8 + F.wave, (F.G - 32) * 8); } }
                 if (rep_ + 1 < NREP(10)) xcd_barrier(bar); } SEAM(pb + 4);
            }
            if (SITE(11) && IN(pb + 5)) { for (int rep_ = 0; rep_ < NREP(11); ++rep_) { l1_rec_out(F);  if (rep_ + 1 < NREP(11)) xcd_barrier(bar); } SEAM(pb + 5); }
        }
        if (SITE(12) && IN(pb + 6)) { for (int rep_ = 0; rep_ < NREP(12); ++rep_) {
            pg8::Gemm g{wsp<const bf16>(F, WS_A1), wsp<const bf16>(F, WS_WOUT) + (size_t)layer * 1024 * 1024, R, 1024, 1024};
            if constexpr (LAYER == 0) { pg8::StaticOrder S; S.init(R, 1024, F.G, F.blk); GEMM_CALL(FnWout, pg8::StaticOrder, g, S, (FnWout{&F, layer})); }
            else { LatOrder S; S.o.init(R - 2 * CT, 1024, F.G, F.blk); GEMM_CALL(FnWout, LatOrder, g, S, (FnWout{&F, layer})); }
             if (rep_ + 1 < NREP(12)) xcd_barrier(bar); } SEAM(pb + 6);
        }
        if (SITE(13) && IN(pb + 7)) { for (int rep_ = 0; rep_ < NREP(13); ++rep_) { ph_router(F, layer);  if (rep_ + 1 < NREP(13)) xcd_barrier(bar); } SEAM(pb + 7); }
        if (SITE(14) && IN(pb + 8)) { for (int rep_ = 0; rep_ < NREP(14); ++rep_) { ph_gather(F, layer);  if (rep_ + 1 < NREP(14)) xcd_barrier(bar); } SEAM(pb + 8); }
        if (SITE(15) && IN(pb + 9)) { for (int rep_ = 0; rep_ < NREP(15); ++rep_) {
            const int* tab = wsp<const int>(F, WS_TILE);
            pg8::Gemm g{wsp<const bf16>(F, WS_F), wsp<const bf16>(F, WS_W1T), MAXROWS, NE * 2048, 1024}; MoeOrder S{tab + 1, __builtin_amdgcn_readfirstlane(tab[0]), 8, F.G, F.blk, wsp<const int>(F, WS_SRC)};
            { int k_ = g.K; asm volatile("" : "+s"(k_)); g.K = k_; pg8::EpiGen<FnSwiglu> E_{FnSwiglu{wsp<bf16>(F, WS_HS), F.in[I_B1] + (size_t)layer * NE * 2048}};
              pg8::gemm_phase<pg8::EpiGen<FnSwiglu>, MoeOrder, true, true, true>((PG8_LAS unsigned char*)F.lds, g, S, E_); }
             if (rep_ + 1 < NREP(15)) xcd_barrier(bar); } SEAM(pb + 9);
        }
        if (SITE(16) && IN(pb + 10)) { for (int rep_ = 0; rep_ < NREP(16); ++rep_) {
            const int* tab = wsp<const int>(F, WS_TILE);
            pg8::Gemm g{wsp<const bf16>(F, WS_HS), wsp<const bf16>(F, WS_W2T), MAXROWS, NE * 1024, 1024}; MoeOrder S{tab + 1, __builtin_amdgcn_readfirstlane(tab[0]), 4, F.G, F.blk, nullptr};
            GEMM_CALL(FnBiasBf16, MoeOrder, g, S, (FnBiasBf16{wsp<bf16>(F, WS_XS), F.in[I_B2] + (size_t)layer * NE * 1024}));
             if (rep_ + 1 < NREP(16)) xcd_barrier(bar); } SEAM(pb + 10);
        }
        if (SITE(17) && IN(pb + 11)) { for (int rep_ = 0; rep_ < NREP(17); ++rep_) { ph_combine(F, layer);  if (rep_ + 1 < NREP(17)) xcd_barrier(bar); } SEAM(pb + 11); }
}
__global__ void __launch_bounds__(512, 2) fwd(Args args) {
    extern __shared__ __attribute__((aligned(16))) unsigned char lds_[];
    Frame F;
    F.lds = (LAS unsigned char*)lds_; F.tid = threadIdx.x; F.lane = F.tid & 63; F.wave = __builtin_amdgcn_readfirstlane(F.tid >> 6); F.blk = blockIdx.x; F.G = gridDim.x; F.probe = args.pad;
    F.ws = args.ws; F.out = args.out; F.ctl = (gu32*)(args.ws + WS_CTL);
    F.in.t = (LAS const unsigned*)(F.lds + MISC_OFF + 8192);
    if (F.tid < 64) ((LAS unsigned*)(F.lds + MISC_OFF))[F.tid] = 0u;
    if (F.tid < N_IN) { const unsigned long long pv = (unsigned long long)args.in[F.tid]; ((LAS unsigned*)(F.lds + MISC_OFF + 8192))[2 * F.tid] = (unsigned)pv; ((LAS unsigned*)(F.lds + MISC_OFF + 8192))[2 * F.tid + 1] = (unsigned)(pv >> 32); }
    __syncthreads();
    const int lo = args.ph_lo, hi = args.ph_hi;
    XcdBarrier bar; bar.bar = (unsigned*)(F.ctl + CW_BAR) + args.li * XCD_BAR_WORDS; bar.x = 0; bar.st = nullptr;
    if (hi - lo > 1) bar = xcd_barrier_post((unsigned*)(F.ctl + CW_BAR) + args.li * XCD_BAR_WORDS, (volatile LAS unsigned*)(F.lds + MISC_OFF));
    if (SITE(0) && IN(0)) { for (int rep_ = 0; rep_ < NREP(0); ++rep_) { p0a(F);  if (rep_ + 1 < NREP(0)) xcd_barrier(bar); } SEAM(0); }
    if (SITE(1) && IN(1)) { for (int rep_ = 0; rep_ < NREP(1); ++rep_) { p0b(F);  if (rep_ + 1 < NREP(1)) xcd_barrier(bar); } SEAM(1); }
    layer_phases<0>(F, bar, lo, hi);
    layer_phases<1>(F, bar, lo, hi);
}
#undef IN
#undef SEAM


extern "C" void kernel_launch(void* const* d_in, const int* in_sizes, int n_in, void* d_out, int out_size, void* d_ws, size_t ws_size, hipStream_t stream) {
    static int grid = 0;
    if (grid == 0) {
        const bool ok = n_in == N_IN && in_sizes[I_X] == NBATCH * SEQ * DM && in_sizes[I_RECW] == 1024 * REC_IN && in_sizes[I_ATTW] == 1024 * ATT_IN && in_sizes[I_MU] == RWKV_IN &&
                        in_sizes[I_GATEB] == 16 && in_sizes[I_W1] == 2 * NE * 1024 * 2048 && out_size == NBATCH * SEQ * DM && ws_size >= WS_END;
        if (!ok) { fprintf(stderr, "kernel_launch: shape mismatch (n_in %d, recw %d, attw %d, mu %d, out %d, ws %zu need %zu); nothing launched\n", n_in, n_in > I_RECW ? in_sizes[I_RECW] : -1,
                           n_in > I_ATTW ? in_sizes[I_ATTW] : -1, n_in > I_MU ? in_sizes[I_MU] : -1, out_size, ws_size, (size_t)WS_END); grid = -1; return; }
        int dev = 0, cus = 0;
        if (hipGetDevice(&dev) != hipSuccess || hipDeviceGetAttribute(&cus, hipDeviceAttributeMultiprocessorCount, dev) != hipSuccess) { grid = -1; return; }
        if (hipFuncSetAttribute((const void*)fwd, hipFuncAttributeMaxDynamicSharedMemorySize, LDS_BYTES) != hipSuccess) { fprintf(stderr, "kernel_launch: hipFuncSetAttribute failed\n"); grid = -1; return; }
        int per_cu = 0;
        if (hipOccupancyMaxActiveBlocksPerMultiprocessor(&per_cu, (const void*)fwd, 512, LDS_BYTES) != hipSuccess || per_cu < 1) { fprintf(stderr, "kernel_launch: occupancy query says %d blocks per CU\n", per_cu); }
        (void)hipGetLastError();
        grid = cus < 256 ? cus : 256;
        if (grid != 256) fprintf(stderr, "kernel_launch: %d CUs; this kernel is written for a 256-CU device\n", cus);
    }
    if (grid < 0) return;
    if (hipMemsetAsync((char*)d_ws + WS_CTL, 0, CTL_ZERO_BYTES, stream) != hipSuccess) return;
    Args a{};
    for (int i = 0; i < N_IN; ++i) a.in[i] = (const float*)d_in[i];
    a.out = (float*)d_out; a.ws = (unsigned char*)d_ws; a.pad = 0;
#if MK_PER_PHASE
    for (int ph = 0; ph < NPHASE; ++ph) { a.ph_lo = ph; a.ph_hi = ph + 1; a.li = 0; hipLaunchKernelGGL(fwd, dim3(grid), dim3(512), LDS_BYTES, stream, a); }
#elif defined(PROBE_LIST)
    { const int plist[] = {PROBE_LIST}; int cur = 0, li = 0;
      for (int p : plist) { a.ph_lo = cur; a.ph_hi = p + 1; a.li = li++; hipLaunchKernelGGL(fwd, dim3(grid), dim3(512), LDS_BYTES, stream, a);
                            a.ph_lo = p; a.ph_hi = p + 1; a.li = li++; a.pad = 1; hipLaunchKernelGGL(fwd, dim3(grid), dim3(512), LDS_BYTES, stream, a); a.pad = 0; cur = p + 1; }
      if (cur < NPHASE) { a.ph_lo = cur; a.ph_hi = NPHASE; a.li = li++; hipLaunchKernelGGL(fwd, dim3(grid), dim3(512), LDS_BYTES, stream, a); } }
#else
    a.ph_lo = 0; a.ph_hi = NPHASE; a.li = 0; hipLaunchKernelGGL(fwd, dim3(grid), dim3(512), LDS_BYTES, stream, a);
#endif
    const hipError_t le = hipPeekAtLastError();
    if (le != hipSuccess) fprintf(stderr, "kernel_launch: launch failed: %s\n", hipGetErrorName(le));
}
```

```cpp
#include <hip/hip_runtime.h>
#include <cstdio>
#include <cstdint>
#define MK_PER_PHASE 0
namespace pg8 {
#define PG8_LAS __attribute__((address_space(3)))
typedef unsigned short bf16_t;
typedef short bf16x8 __attribute__((ext_vector_type(8)));
typedef float f32x4 __attribute__((ext_vector_type(4)));
typedef unsigned u32x4 __attribute__((ext_vector_type(4)));
constexpr int BM = 256, BK = 64, HALF = 128, HTB = HALF * BK * 2  , STAGE_BYTES = 8 * HTB, NXCD = 8, WGM = 8;

__host__ __device__ __forceinline__ int lds_byte(int r, int c) { const int st = (r >> 4) * 2 + (c >> 5), rr = r & 15, cc = c & 31, ob = rr * 64 + cc * 2; return st * 1024 + (ob ^ (((ob >> 9) & 1) << 5)); }
__host__ __device__ __forceinline__ void stage_rc(int b, int& R, int& C) { const int st = b / 1024, sb = b % 1024, swz = sb ^ (((sb >> 9) & 1) << 5); R = (st >> 1) * 16 + swz / 64; C = (st & 1) * 32 + (swz % 64) / 2; }
__host__ __device__ __forceinline__ int perm32(int rho) { const int n = rho >> 4, i = rho & 15; return 8 * (i >> 2) + 4 * n + (i & 3); }

struct Unit { int pm, pn; };
struct Gemm { const bf16_t* A; const bf16_t* Bt; int M, N, K; };

struct StaticOrder {
    int nM, nN, nwg, G, c;
    __host__ __device__ void init(int M, int N, int G_, int c_) { nM = M / BM; nN = N / BM; nwg = nM * nN; G = G_; c = c_; }
    __host__ __device__ bool next(int i, Unit& u) const {
        const long L = (long)i * G + c; if (L >= nwg) return false;
        int wgid = (int)L; { const int q = nwg / NXCD, r = nwg % NXCD, xcd = wgid % NXCD, off = wgid / NXCD; wgid = (xcd < r ? xcd * (q + 1) : r * (q + 1) + (xcd - r) * q) + off; }
        const int nig = WGM * nN, gid = wgid / nig, fm = gid * WGM, gsz = (nM - fm) < WGM ? (nM - fm) : WGM;
        u.pm = fm + ((wgid % nig) % gsz); u.pn = (wgid % nig) / gsz; return true;
    }
    __device__ __forceinline__ void a_ready(const Unit&) const {}
    __device__ __forceinline__ void done(const Unit&) const {}
};

__device__ __forceinline__ unsigned cvt_pk_bf16(float lo, float hi) { unsigned r; asm volatile("v_cvt_pk_bf16_f32 %0, %1, %2" : "=v"(r) : "v"(lo), "v"(hi)); return r; }
template <class Fn> struct EpiGen {
    static constexpr bool PERM = true, AFTER_DRAIN = false;
    Fn fn;
    __device__ __forceinline__ void operator()(const f32x4 (&acc)[2][2][4][2], const Unit& u, int wr, int wc, int fr, int fq) const {
#pragma unroll
        for (int ai = 0; ai < 2; ++ai)
#pragma unroll
            for (int m = 0; m < 4; ++m) { const int row = u.pm * BM + ai * HALF + wr * 64 + m * 16 + fr;
#pragma unroll
                for (int bj = 0; bj < 2; ++bj) { const int col = u.pn * BM + bj * HALF + wc * 32 + 8 * fq; fn(row, col, acc[ai][bj][m][0], acc[ai][bj][m][1]); } }
    }
};
template <class Epi, class Sched, bool ALIGN_EPI = false, bool SP2 = false, bool GATHER = false>
__device__ __forceinline__ void gemm_phase(PG8_LAS unsigned char* lds, const Gemm g, const Sched& S, const Epi& E) {
    static_assert(!GATHER || SP2, "the gathered A path is written for the SP2 loop");
    const int tid = threadIdx.x, wid = __builtin_amdgcn_readfirstlane(tid >> 6), lane = tid & 63, wr = wid >> 2, wc = wid & 3, fr = lane & 15, fq = lane >> 4;
    const int K = g.K, nt = K / BK;
    unsigned voffA[2], voffB[2]; int gR[2], gC[2]; unsigned gA[2][2], gN[2][2];
#pragma unroll
    for (int i = 0; i < 2; ++i) { int R, C; stage_rc(tid * 16 + i * 8192, R, C); const int Rb = Epi::PERM ? ((R & ~31) + perm32(R & 31)) : R;
        voffA[i] = (unsigned)(R * K + C) * 2u; voffB[i] = (unsigned)(Rb * K + C) * 2u; gR[i] = R; gC[i] = C; }
    const size_t kstep = (size_t)(BK * 2);
    const size_t hstep = (size_t)HALF * K * 2;
    const size_t tstep = 2 * hstep;
    const unsigned ldsw = (unsigned)wid * 1024u;
    const int aoff = lds_byte(wr * 64 + fr, fq * 8), boff = lds_byte(wc * 32 + fr, fq * 8);
#define PG8_SA(b, h) (((b) * 2 + (h)) * HTB)
#define PG8_SB(b, h) ((4 + (b) * 2 + (h)) * HTB)
#define PG8_STAGE(bufoff, gbase, voff) do { _Pragma("unroll") for (int _i = 0; _i < 2; ++_i) \
        __builtin_amdgcn_global_load_lds((const unsigned*)((const char*)(gbase) + (voff)[_i]), (PG8_LAS unsigned*)(lds + (bufoff) + ldsw + _i * 8192), 16, 0, 0); } while (0)
#define PG8_GOFF(u_, out_) do { _Pragma("unroll") for (int _h = 0; _h < 2; ++_h) _Pragma("unroll") for (int _i = 0; _i < 2; ++_i) \
        out_[_h][_i] = ((unsigned)S.src[(u_).pm * BM + _h * HALF + gR[_i]] * (unsigned)K + (unsigned)gC[_i]) * 2u; } while (0)
#define PG8_STAGE_A(bufoff, kptr, h, isnext) do { if constexpr (GATHER) { unsigned _o[2]; _o[0] = (isnext) ? gN[h][0] : gA[h][0]; _o[1] = (isnext) ? gN[h][1] : gA[h][1]; PG8_STAGE(bufoff, kptr, _o); } \
        else { PG8_STAGE(bufoff, (kptr) + (h) * hstep, voffA); } } while (0)
#define PG8_LDA(dst, b, h) do { _Pragma("unroll") for (int m = 0; m < 4; ++m) _Pragma("unroll") for (int k = 0; k < 2; ++k) dst[m][k] = *(const PG8_LAS bf16x8*)(lds + PG8_SA(b, h) + aoff + m * 2048 + k * 1024); } while (0)
#define PG8_LDB(dst, b, h) do { _Pragma("unroll") for (int n = 0; n < 2; ++n) _Pragma("unroll") for (int k = 0; k < 2; ++k) dst[n][k] = *(const PG8_LAS bf16x8*)(lds + PG8_SB(b, h) + boff + n * 2048 + k * 1024); } while (0)
#define PG8_MMA(ai, bj, At, Bt) do { __builtin_amdgcn_s_setprio(1); _Pragma("unroll") for (int m = 0; m < 4; ++m) _Pragma("unroll") for (int n = 0; n < 2; ++n) _Pragma("unroll") for (int k = 0; k < 2; ++k) \
        acc[ai][bj][m][n] = __builtin_amdgcn_mfma_f32_16x16x32_bf16(Bt[n][k], At[m][k], acc[ai][bj][m][n], 0, 0, 0); __builtin_amdgcn_s_setprio(0); } while (0)
#define PG8_WAIT_V(n) asm volatile("s_waitcnt vmcnt(" #n ")" ::: "memory")
#define PG8_WAIT_L(n) asm volatile("s_waitcnt lgkmcnt(" #n ")" ::: "memory")
#define PG8_BAR __builtin_amdgcn_s_barrier()
#define PG8_SCHED __builtin_amdgcn_sched_barrier(0)
    Unit cur, nxt; int ui = 0;
    if (!S.next(0, cur)) return;
    f32x4 acc[2][2][4][2];
#pragma unroll
    for (int a = 0; a < 2; ++a)
#pragma unroll
        for (int b = 0; b < 2; ++b)
#pragma unroll
            for (int m = 0; m < 4; ++m)
#pragma unroll
                for (int n = 0; n < 2; ++n) acc[a][b][m][n] = (f32x4){0.f, 0.f, 0.f, 0.f};
    bf16x8 At[4][2], B0[2][2], B1[2][2];
    const char* cA = (const char*)g.A + (GATHER ? (size_t)0 : (size_t)cur.pm * tstep); const char* cB = (const char*)g.Bt + (size_t)cur.pn * tstep;
    if constexpr (GATHER) PG8_GOFF(cur, gA);
    S.a_ready(cur);
    if constexpr (SP2) {
        PG8_STAGE(PG8_SB(0, 0), cB, voffB); PG8_STAGE(PG8_SB(0, 1), cB + hstep, voffB); PG8_STAGE_A(PG8_SA(0, 0), cA, 0, false); PG8_STAGE_A(PG8_SA(0, 1), cA, 1, false);
        if (wr == 1) PG8_BAR;
        PG8_WAIT_V(2); PG8_BAR;
        PG8_STAGE(PG8_SB(1, 0), cB + kstep, voffB); PG8_STAGE_A(PG8_SA(1, 0), cA + kstep, 0, false); PG8_STAGE(PG8_SB(1, 1), cB + hstep + kstep, voffB);
        PG8_WAIT_V(6); PG8_BAR;
    } else {
        PG8_STAGE(PG8_SB(0, 0), cB, voffB); PG8_STAGE(PG8_SA(0, 0), cA, voffA); PG8_STAGE(PG8_SB(0, 1), cB + hstep, voffB); PG8_STAGE(PG8_SA(0, 1), cA + hstep, voffA);
        if (wr == 1) PG8_BAR;
        PG8_WAIT_V(4); PG8_BAR;
        PG8_STAGE(PG8_SB(1, 0), cB + kstep, voffB); PG8_STAGE(PG8_SA(1, 0), cA + kstep, voffA); PG8_STAGE(PG8_SB(1, 1), cB + hstep + kstep, voffB);
        PG8_WAIT_V(6); PG8_BAR;
    }
    for (;;) {
        const bool has_next = S.next(ui + 1, nxt);
        const char* nA = (has_next && !GATHER) ? (const char*)g.A + (size_t)nxt.pm * tstep : cA; const char* nB = has_next ? (const char*)g.Bt + (size_t)nxt.pn * tstep : cB;
        if constexpr (GATHER) { if (has_next) PG8_GOFF(nxt, gN); else { _Pragma("unroll") for (int _h = 0; _h < 2; ++_h) { gN[_h][0] = gA[_h][0]; gN[_h][1] = gA[_h][1]; } } }
        for (int t = 0; t < nt; t += 2) {
            const bool last = (t == nt - 2);
            const char* a1 = cA + (size_t)(t + 1) * kstep;
            const char* a2 = last ? nA : cA + (size_t)(t + 2) * kstep; const char* b2 = last ? nB : cB + (size_t)(t + 2) * kstep;
            const char* a3 = a2 + kstep; const char* b3 = b2 + kstep;
            if (last && has_next) S.a_ready(nxt);
            if constexpr (SP2) {
            PG8_LDB(B0, 0, 0); PG8_LDB(B1, 0, 1); PG8_SCHED; PG8_LDA(At, 0, 0); PG8_STAGE_A(PG8_SA(1, 1), a1, 1, false);
            PG8_WAIT_V(8); PG8_WAIT_L(0); PG8_BAR; PG8_MMA(0, 0, At, B0); PG8_MMA(0, 1, At, B1); PG8_BAR; PG8_SCHED;
            PG8_LDA(At, 0, 1); PG8_STAGE(PG8_SB(0, 0), b2, voffB); PG8_STAGE(PG8_SB(0, 1), b2 + hstep, voffB); PG8_STAGE_A(PG8_SA(0, 0), a2, 0, last);
            PG8_WAIT_V(8); PG8_WAIT_L(0); PG8_BAR; PG8_MMA(1, 0, At, B0); PG8_MMA(1, 1, At, B1); PG8_BAR; PG8_SCHED;
            PG8_LDB(B0, 1, 0); PG8_LDB(B1, 1, 1); PG8_SCHED; PG8_LDA(At, 1, 0); PG8_STAGE_A(PG8_SA(0, 1), a2, 1, last);
            PG8_WAIT_V(8); PG8_WAIT_L(0); PG8_BAR; PG8_MMA(0, 0, At, B0); PG8_MMA(0, 1, At, B1); PG8_BAR; PG8_SCHED;
            PG8_LDA(At, 1, 1); PG8_STAGE(PG8_SB(1, 0), b3, voffB); PG8_STAGE(PG8_SB(1, 1), b3 + hstep, voffB); PG8_STAGE_A(PG8_SA(1, 0), a3, 0, last);
            PG8_WAIT_V(8); PG8_WAIT_L(0); PG8_BAR; PG8_MMA(1, 0, At, B0); PG8_MMA(1, 1, At, B1); PG8_BAR; PG8_SCHED;
            } else {
            PG8_LDB(B0, 0, 0); PG8_SCHED; PG8_LDA(At, 0, 0); PG8_STAGE(PG8_SA(1, 1), a1 + hstep, voffA);
            PG8_WAIT_L(8); PG8_BAR; PG8_WAIT_L(0); PG8_MMA(0, 0, At, B0); PG8_BAR; PG8_SCHED;
            PG8_LDB(B1, 0, 1); PG8_STAGE(PG8_SB(0, 0), b2, voffB);
            PG8_BAR; PG8_WAIT_L(0); PG8_MMA(0, 1, At, B1); PG8_BAR;
            PG8_LDA(At, 0, 1); PG8_STAGE(PG8_SA(0, 0), a2, voffA);
            PG8_BAR; PG8_WAIT_L(0); PG8_MMA(1, 0, At, B0); PG8_BAR; PG8_SCHED;
            PG8_STAGE(PG8_SB(0, 1), b2 + hstep, voffB);
            PG8_WAIT_V(6); PG8_BAR; PG8_MMA(1, 1, At, B1); PG8_BAR;
            PG8_LDB(B0, 1, 0); PG8_SCHED; PG8_LDA(At, 1, 0); PG8_STAGE(PG8_SA(0, 1), a2 + hstep, voffA);
            PG8_WAIT_L(8); PG8_BAR; PG8_WAIT_L(0); PG8_MMA(0, 0, At, B0); PG8_BAR; PG8_SCHED;
            PG8_LDB(B1, 1, 1); PG8_STAGE(PG8_SB(1, 0), b3, voffB);
            PG8_BAR; PG8_WAIT_L(0); PG8_MMA(0, 1, At, B1); PG8_BAR;
            PG8_LDA(At, 1, 1); PG8_STAGE(PG8_SA(1, 0), a3, voffA);
            PG8_BAR; PG8_WAIT_L(0); PG8_MMA(1, 0, At, B0); PG8_BAR; PG8_SCHED;
            PG8_STAGE(PG8_SB(1, 1), b3 + hstep, voffB);
            PG8_WAIT_V(6); PG8_BAR; PG8_MMA(1, 1, At, B1); PG8_BAR;
            }
        }
        if constexpr (ALIGN_EPI) { if (wr == 0) PG8_BAR; }
        if constexpr (!Epi::AFTER_DRAIN) { E(acc, cur, wr, wc, fr, fq); S.done(cur); }
        if (!has_next) break;
#pragma unroll
        for (int a = 0; a < 2; ++a)
#pragma unroll
            for (int b = 0; b < 2; ++b)
#pragma unroll
                for (int m = 0; m < 4; ++m)
#pragma unroll
                    for (int n = 0; n < 2; ++n) acc[a][b][m][n] = (f32x4){0.f, 0.f, 0.f, 0.f};
        cur = nxt; cA = nA; cB = nB; ++ui;
        if constexpr (GATHER) { _Pragma("unroll") for (int _h = 0; _h < 2; ++_h) { gA[_h][0] = gN[_h][0]; gA[_h][1] = gN[_h][1]; } }
        if constexpr (ALIGN_EPI) { if (wr == 1) PG8_BAR; }
    }
    PG8_WAIT_V(0);
    if constexpr (!ALIGN_EPI) { if (wr == 0) PG8_BAR; }
    PG8_BAR;
    if constexpr (Epi::AFTER_DRAIN) { E.fused(acc, cur, wr, wc, fr, fq, lds, wid, lane); S.done(cur); }
#undef PG8_SA
#undef PG8_SB
#undef PG8_STAGE
#undef PG8_STAGE_A
#undef PG8_GOFF
#undef PG8_LDA
#undef PG8_LDB
#undef PG8_MMA
#undef PG8_WAIT_V
#undef PG8_WAIT_L
#undef PG8_BAR
#undef PG8_SCHED
}
}
#define GAS __attribute__((address_space(1)))
#define LAS __attribute__((address_space(3)))
typedef unsigned short bf16;
typedef unsigned v4u __attribute__((ext_vector_type(4)));
typedef unsigned v2u __attribute__((ext_vector_type(2)));
typedef float f32x4 __attribute__((ext_vector_type(4)));
typedef short bf16x8 __attribute__((ext_vector_type(8)));
typedef GAS unsigned gu32;
typedef GAS unsigned long long gu64;
#define RLX_AGENT __ATOMIC_RELAXED, __HIP_MEMORY_SCOPE_AGENT
#define LDS_WAIT() asm volatile("s_waitcnt lgkmcnt(0)" ::: "memory")
#define VM_WAIT() asm volatile("s_waitcnt vmcnt(0)" ::: "memory")
typedef float f32x2_cv __attribute__((ext_vector_type(2)));
typedef __bf16 bf16x2_cv __attribute__((ext_vector_type(2)));
__device__ __forceinline__ unsigned pk2(float lo, float hi) { const f32x2_cv v = {lo, hi}; return __builtin_bit_cast(unsigned, __builtin_convertvector(v, bf16x2_cv)); }
__device__ __forceinline__ unsigned f2bf(float f) { return (unsigned)__builtin_bit_cast(unsigned short, (__bf16)f); }
__device__ __forceinline__ float bflo(unsigned w) { return __builtin_bit_cast(float, w << 16); }
__device__ __forceinline__ float bfhi(unsigned w) { return __builtin_bit_cast(float, w & 0xffff0000u); }
__device__ __forceinline__ float bf2f(bf16 b) { return __builtin_bit_cast(float, (unsigned)b << 16); }
__device__ __forceinline__ void unpack8(v4u w, float (&x)[8]) { x[0] = bflo(w.x); x[1] = bfhi(w.x); x[2] = bflo(w.y); x[3] = bfhi(w.y); x[4] = bflo(w.z); x[5] = bfhi(w.z); x[6] = bflo(w.w); x[7] = bfhi(w.w); }
__device__ __forceinline__ float wave_sum(float v) {
#pragma unroll
    for (int o = 1; o < 64; o <<= 1) v += __shfl_xor(v, o);
    return v;
}
__device__ __forceinline__ float sigmoidf_(float x) { return 1.f / (1.f + __expf(-x)); }

#define XB_TMO      128
#define XB_XCNT(j)  (256  + 64 * (j))
#define XB_XSUB(j)  (1280 + 64 * (j))
#define XB_XGEN(j)  (2304 + 64 * (j))
#define XB_TOP      3328
#define XB_TOPGEN   3392
#define XCD_BAR_WORDS 3456
#define XB_SPIN_CAP (1u << 22)

__device__ __forceinline__ unsigned xb_ld(unsigned* p)              { return __hip_atomic_load(p, __ATOMIC_RELAXED, __HIP_MEMORY_SCOPE_AGENT); }
__device__ __forceinline__ unsigned xb_add(unsigned* p, unsigned v) { return __hip_atomic_fetch_add(p, v, __ATOMIC_RELAXED, __HIP_MEMORY_SCOPE_AGENT); }
__device__ __forceinline__ unsigned xb_xcc_id() { return (unsigned)__builtin_amdgcn_s_getreg((3 << 11) | 20) & 0xFu; }
#define XB_SPIN(cond, bar) do { unsigned _sp = 0; while (cond) { __builtin_amdgcn_s_sleep(1); \
    if ((++_sp & 255u) == 0u) { if (xb_ld(&(bar)[XB_TMO])) break; if (_sp > XB_SPIN_CAP) { atomicAdd(&(bar)[XB_TMO], 1u); break; } } } } while (0)

struct XcdBarrier {
    unsigned* bar; unsigned x;
    volatile LAS unsigned* st;
};

__device__ __forceinline__ XcdBarrier xcd_barrier_post(unsigned* bar, volatile LAS unsigned* st) {
    XcdBarrier b; b.bar = bar; b.x = xb_xcc_id(); b.st = st;
    if (threadIdx.x == 0) (void)xb_add(&bar[XB_XCNT(b.x)], 1u);
    return b;
}
__device__ __forceinline__ void xcd_barrier_complete(unsigned* bar, unsigned x, unsigned& nloc, unsigned& nx) {
    const unsigned G = gridDim.x * gridDim.y * gridDim.z;
    unsigned sum, cnt, mine, sp = 0u;
    for (;;) {
        sum = 0u; cnt = 0u; mine = 0u;
#pragma unroll
        for (unsigned j = 0; j < 16; ++j) { const unsigned c = xb_ld(&bar[XB_XCNT(j)]); sum += c; cnt += (c > 0u) ? 1u : 0u; mine = (j == x) ? c : mine; }
        if (sum == G) break;
        __builtin_amdgcn_s_sleep(1);
        if ((++sp & 255u) == 0u) { if (xb_ld(&bar[XB_TMO])) break; if (sp > XB_SPIN_CAP) { atomicAdd(&bar[XB_TMO], 1u); break; } }
    }
    nloc = mine > 0u ? mine : 1u; nx = cnt > 0u ? cnt : 1u;
}

__device__ __forceinline__ void xcd_barrier(const XcdBarrier& b) {
    asm volatile("s_waitcnt vmcnt(0)" ::: "memory");
    __syncthreads();
    if (threadIdx.x == 0) {
        unsigned* bar = b.bar;
        __builtin_amdgcn_s_waitcnt(0);
        unsigned nloc = b.st[0], nx = b.st[1];
        if (nloc == 0u) { xcd_barrier_complete(bar, b.x, nloc, nx); b.st[0] = nloc; b.st[1] = nx; }
        const unsigned old = xb_add(&bar[XB_XSUB(b.x)], 1u);
        const unsigned gen = old / nloc;
        if (old + 1u == (gen + 1u) * nloc) {
            __builtin_amdgcn_fence(__ATOMIC_RELEASE, "agent");
            asm volatile("s_waitcnt vmcnt(0)" ::: "memory");
            const unsigned og = xb_add(&bar[XB_TOP], 1u);
            const unsigned tg = og / nx;
            if (og + 1u == (tg + 1u) * nx) xb_add(&bar[XB_TOPGEN], 1u);
            else XB_SPIN(xb_ld(&bar[XB_TOPGEN]) == tg, bar);
            __builtin_amdgcn_fence(__ATOMIC_ACQUIRE, "agent");
            xb_add(&bar[XB_XGEN(b.x)], 1u);
            asm volatile("s_waitcnt vmcnt(0)" ::: "memory");
        } else {
            XB_SPIN(xb_ld(&bar[XB_XGEN(b.x)]) == gen, bar);
            __builtin_amdgcn_fence(__ATOMIC_ACQUIRE, "agent");
            asm volatile("s_waitcnt vmcnt(0)" ::: "memory");
        }
    }
    __syncthreads();
}
namespace att {
using s16x4  = __attribute__((ext_vector_type(4))) short;
using f32x16 = __attribute__((ext_vector_type(16))) float;
using u32x4  = __attribute__((ext_vector_type(4))) unsigned;
#define ATT_SBAR() __builtin_amdgcn_sched_barrier(0)
constexpr float THR2 = 11.5f;
__device__ __forceinline__ int crow(int r, int hi) { return (r & 3) + 8 * (r >> 2) + 4 * hi; }
__device__ __forceinline__ unsigned cvtpk(float lo, float hi) { unsigned r; asm volatile("v_cvt_pk_bf16_f32 %0, %1, %2" : "=v"(r) : "v"(lo), "v"(hi)); return r; }

__device__ __forceinline__ void partialSM(f32x16& p0, f32x16& p1, float& m_reg, float& mn, float& alpha) {
  float pmax = p0[0];
#pragma unroll
  for (int r = 1; r < 16; ++r) pmax = fmaxf(pmax, p0[r]);
#pragma unroll
  for (int r = 0; r < 16; ++r) pmax = fmaxf(pmax, p1[r]);
  { auto rr = __builtin_amdgcn_permlane32_swap(__float_as_uint(pmax), __float_as_uint(pmax), false, false);
    pmax = fmaxf(__uint_as_float(rr[0]), __uint_as_float(rr[1])); }
  if (__builtin_expect(__all(pmax - m_reg <= THR2), 1)) { mn = m_reg; alpha = 1.f; }
  else { mn = fmaxf(m_reg, pmax); alpha = __builtin_amdgcn_exp2f(m_reg - mn); m_reg = mn; }
#pragma unroll
  for (int r = 0; r < 16; ++r) p0[r] = p0[r] - mn;
#pragma unroll
  for (int r = 0; r < 16; ++r) p1[r] = p1[r] - mn;
#pragma unroll
  for (int r = 0; r < 16; ++r) p0[r] = __builtin_amdgcn_exp2f(p0[r]);
}
__device__ __forceinline__ void finishSM(f32x16& p0, f32x16& p1, bf16x8& pa0, bf16x8& pa1, bf16x8& pa2, bf16x8& pa3) {
#pragma unroll
  for (int r = 0; r < 16; ++r) p1[r] = __builtin_amdgcn_exp2f(p1[r]);
#define ATT_PK4(P, BASE, OUT) do { unsigned a0 = cvtpk(P[BASE + 0], P[BASE + 1]), a1 = cvtpk(P[BASE + 2], P[BASE + 3]);   \
    unsigned b0 = cvtpk(P[BASE + 4], P[BASE + 5]), b1 = cvtpk(P[BASE + 6], P[BASE + 7]);                              \
    auto r0 = __builtin_amdgcn_permlane32_swap(a0, b0, false, false); auto r1 = __builtin_amdgcn_permlane32_swap(a1, b1, false, false); \
    u32x4 w = {r0[0], r1[0], r0[1], r1[1]}; OUT = *reinterpret_cast<bf16x8*>(&w); } while (0)
  ATT_PK4(p0, 0, pa0); ATT_PK4(p0, 8, pa1); ATT_PK4(p1, 0, pa2); ATT_PK4(p1, 8, pa3);
#undef ATT_PK4
}
template <int NB> __device__ __forceinline__ int v_st(int k, int c) { const int kk = (k & ~0xC) | ((k & 4) << 1) | ((k & 8) >> 1); return ((kk >> 3) * NB + (c >> 5)) * 512 + ((kk & 7) * 32 + (c & 31)) * 2; }
__device__ __forceinline__ int v_rd_base(int lane) { return ((lane & 3) << 3) | (((lane >> 2) & 3) << 6) | (((lane >> 4) & 1) << 5) | (((lane >> 5) & 1) << 8); }
template <int OFF> __device__ __forceinline__ s16x4 tr_read(int vb) {
  s16x4 r; asm volatile("ds_read_b64_tr_b16 %0, %1 offset:%2" : "=&v"(r) : "v"(vb), "i"(OFF) : "memory"); return r;
}
template <int NB, int D0, int VO> __device__ __forceinline__ void pv_rd(s16x4 (&f)[8], int vb) {
#define ATT_VOFF(ks, half) (VO + D0 * 512 + (ks) * (NB * 1024) + (half) * (NB * 512))
  f[0] = tr_read<ATT_VOFF(0, 0)>(vb); f[1] = tr_read<ATT_VOFF(0, 1)>(vb); f[2] = tr_read<ATT_VOFF(1, 0)>(vb); f[3] = tr_read<ATT_VOFF(1, 1)>(vb);
  f[4] = tr_read<ATT_VOFF(2, 0)>(vb); f[5] = tr_read<ATT_VOFF(2, 1)>(vb); f[6] = tr_read<ATT_VOFF(3, 0)>(vb); f[7] = tr_read<ATT_VOFF(3, 1)>(vb);
#undef ATT_VOFF
}
__device__ __forceinline__ void pv_mm(f32x16& od, const s16x4 (&f)[8], bf16x8 pa0, bf16x8 pa1, bf16x8 pa2, bf16x8 pa3) {
#define ATT_PK(L, H) (bf16x8){L[0], L[1], L[2], L[3], H[0], H[1], H[2], H[3]}
  od = __builtin_amdgcn_mfma_f32_32x32x16_bf16(pa0, ATT_PK(f[0], f[1]), od, 0, 0, 0);
  od = __builtin_amdgcn_mfma_f32_32x32x16_bf16(pa1, ATT_PK(f[2], f[3]), od, 0, 0, 0);
  od = __builtin_amdgcn_mfma_f32_32x32x16_bf16(pa2, ATT_PK(f[4], f[5]), od, 0, 0, 0);
  od = __builtin_amdgcn_mfma_f32_32x32x16_bf16(pa3, ATT_PK(f[6], f[7]), od, 0, 0, 0);
#undef ATT_PK
}
#define ATT_LWAIT(n) do { asm volatile("s_waitcnt lgkmcnt(" #n ")" ::: "memory"); ATT_SBAR(); } while (0)
template <int NB, int VO> __device__ __forceinline__ void pv_all(f32x16* o, f32x16& lsum, int vb, bf16x8 pa0, bf16x8 pa1, bf16x8 pa2, bf16x8 pa3) {
  const bf16x8 ones = {0x3F80, 0x3F80, 0x3F80, 0x3F80, 0x3F80, 0x3F80, 0x3F80, 0x3F80};
  s16x4 fa[8], fb[8];
  pv_rd<NB, 0, VO>(fa, vb); pv_rd<NB, 1, VO>(fb, vb);
  lsum = __builtin_amdgcn_mfma_f32_32x32x16_bf16(pa0, ones, lsum, 0, 0, 0); lsum = __builtin_amdgcn_mfma_f32_32x32x16_bf16(pa1, ones, lsum, 0, 0, 0);
  lsum = __builtin_amdgcn_mfma_f32_32x32x16_bf16(pa2, ones, lsum, 0, 0, 0); lsum = __builtin_amdgcn_mfma_f32_32x32x16_bf16(pa3, ones, lsum, 0, 0, 0);
  ATT_LWAIT(8); pv_mm(o[0], fa, pa0, pa1, pa2, pa3);
  if constexpr (NB == 4) {
    pv_rd<NB, 2, VO>(fa, vb); ATT_LWAIT(8); pv_mm(o[1], fb, pa0, pa1, pa2, pa3);
    pv_rd<NB, 3, VO>(fb, vb); ATT_LWAIT(8); pv_mm(o[2], fa, pa0, pa1, pa2, pa3);
    ATT_LWAIT(0); pv_mm(o[3], fb, pa0, pa1, pa2, pa3);
  } else { ATT_LWAIT(0); pv_mm(o[1], fb, pa0, pa1, pa2, pa3); }
}
template <int DK> __device__ __forceinline__ void qkt(f32x16& p0, f32x16& p1, LAS const char* Kt, const int (&ka)[DK / 16], const bf16x8* qr) {
  p0 = f32x16{}; p1 = f32x16{};
#pragma unroll
  for (int d0 = 0; d0 < DK / 16; ++d0) {
    const bf16x8 b0 = *(LAS const bf16x8*)(Kt + ka[d0]);
    const bf16x8 b1 = *(LAS const bf16x8*)(Kt + ka[d0] + (d0 < 4 ? 4096 : 2048));
    p0 = __builtin_amdgcn_mfma_f32_32x32x16_bf16(b0, qr[d0], p0, 0, 0, 0);
    p1 = __builtin_amdgcn_mfma_f32_32x32x16_bf16(b1, qr[d0], p1, 0, 0, 0); }
}
template <int DK, int DV> struct Cfg {
  static constexpr int KT = 64 * DK * 2, NB = DV / 32, VT = 64 * DV * 2, NQ = DK / 16;
  static constexpr int KN = DK / 64 + (DK % 64 != 0), VN = (64 * DV / 8) / 512;
  static constexpr int NS = 4;
  static constexpr int OFF_K = 0, OFF_V = NS * KT, OFF_WS = NS * (KT + VT), LDS_BYTES = OFF_WS + 8 * 64 * 4;
};
template <int DK, int DV>
__device__ __forceinline__ void attn_unit(const bf16* __restrict__ Qb, int ldq, const bf16* __restrict__ K1, int ldk1, const bf16* __restrict__ K2, int ldk2,
                                          const bf16* __restrict__ Vh, int ldv, float* __restrict__ Ob, int ldo, int nkeys, LAS char* lds) {
  using C = Cfg<DK, DV>;
  const int tid = threadIdx.x, wid = __builtin_amdgcn_readfirstlane(tid >> 6), lane = tid & 63, r32 = lane & 31, hi = lane >> 5;
  LAS float* ws = (LAS float*)(lds + C::OFF_WS) + wid * 64; LAS float* al_l = ws + 32;
  float m_reg = -1e30f; f32x16 o[C::NB] = {}; f32x16 lsum = {}; bf16x8 qr[C::NQ];
  { const bf16* Qw = Qb + (long)(wid * 32 + r32) * ldq + hi * 8;
#pragma unroll
    for (int d0 = 0; d0 < C::NQ; ++d0) qr[d0] = *(const bf16x8*)(Qw + d0 * 16); }
  unsigned kg0, kg1 = 0, vg[C::VN];
  { const int row = tid >> 3, cp = tid & 7; kg0 = (unsigned)(row * ldk1 + ((cp ^ ((row >> 1) & 7)) * 8)); }
  if constexpr (C::KN == 2) { const int p = tid & 255, row = p >> 2, cp = p & 3; kg1 = (unsigned)(row * ldk2 + ((cp ^ ((row >> 2) & 3)) * 8)); }
#pragma unroll
  for (int i = 0; i < C::VN; ++i) { const int p = i * 512 + tid, st = p >> 5, wi = p & 31, kk = (st / C::NB) * 8 + (wi >> 2), col = (st % C::NB) * 32 + (wi & 3) * 8;
    const int k = (kk & ~0xC) | ((kk & 4) << 1) | ((kk & 8) >> 1); vg[i] = (unsigned)(k * ldv + col); }
  int ka[C::NQ];
#pragma unroll
  for (int d0 = 0; d0 < C::NQ; ++d0) ka[d0] = (d0 < 4) ? r32 * 128 + ((((d0 * 2) ^ hi ^ ((r32 >> 1) & 7)) & 7) << 4) : 8192 + r32 * 64 + (((((d0 - 4) * 2) ^ hi ^ ((r32 >> 2) & 3)) & 3) << 4);
  const int vb0 = (int)(uintptr_t)(lds + C::OFF_V) + v_rd_base(lane);
  const bool p3 = (C::KN == 1) || wid < 4;
#define ATT_ISSUE(S, t) do { const size_t t64_ = (size_t)(t) * 64; \
    __builtin_amdgcn_global_load_lds((const unsigned*)(K1 + t64_ * ldk1 + kg0), (LAS unsigned*)(lds + C::OFF_K + (S) * C::KT + wid * 1024), 16, 0, 0); \
    if constexpr (C::KN == 2) { if (wid < 4) __builtin_amdgcn_global_load_lds((const unsigned*)(K2 + t64_ * ldk2 + kg1), (LAS unsigned*)(lds + C::OFF_K + (S) * C::KT + 8192 + wid * 1024), 16, 0, 0); } \
    _Pragma("unroll") for (int i_ = 0; i_ < C::VN; ++i_) __builtin_amdgcn_global_load_lds((const unsigned*)(Vh + t64_ * ldv + vg[i_]), (LAS unsigned*)(lds + C::OFF_V + (S) * C::VT + (i_ * 512 + wid * 64) * 16), 16, 0, 0); } while (0)
#define ATT_LAND1() do { if (p3) asm volatile("s_waitcnt vmcnt(3)" ::: "memory"); else asm volatile("s_waitcnt vmcnt(2)" ::: "memory"); } while (0)
#define ATT_LAND2() do { if (p3) asm volatile("s_waitcnt vmcnt(6)" ::: "memory"); else asm volatile("s_waitcnt vmcnt(4)" ::: "memory"); } while (0)
#define ATT_RESC(a) do { if (__any((a) < 1.f)) { if (hi == 0) al_l[r32] = (a); asm volatile("s_waitcnt lgkmcnt(0)" ::: "memory"); \
    _Pragma("unroll") for (int r = 0; r < 16; ++r) { const float f_ = al_l[crow(r, hi)]; lsum[r] *= f_; _Pragma("unroll") for (int d = 0; d < C::NB; ++d) o[d][r] *= f_; } } } while (0)
  static_assert(C::KN + C::VN == 3 && C::NS == 4, "three (two on waves 4..7 when DK = 96) DMA pieces per thread per tile; slot = tile & 3");
#define ATT_STEP(S, t, C0, C1, N0, N1, mnN, alN, LAST) do { ATT_SBAR(); \
    { const int ti_ = ((t) + 3 < NT) ? (t) + 3 : NT - 1; ATT_ISSUE(((S) + 3) & 3, ti_); } ATT_SBAR(); \
    if constexpr (!(LAST)) qkt<DK>(N0, N1, lds + C::OFF_K + (((S) + 1) & 3) * C::KT, ka, qr); \
    finishSM(C0, C1, pa0, pa1, pa2, pa3); ATT_SBAR(); \
    pv_all<C::NB, (S) * C::VT>(o, lsum, vb0, pa0, pa1, pa2, pa3); \
    if constexpr (!(LAST)) { partialSM(N0, N1, m_reg, mnN, alN); ATT_RESC(alN); } \
    ATT_LAND1(); __builtin_amdgcn_s_barrier(); } while (0)
  f32x16 pA0, pA1, pB0, pB1; float mnA, mnB, alA, alB; bf16x8 pa0, pa1, pa2, pa3; const int NT = nkeys / 64;
  asm volatile("s_waitcnt vmcnt(0) lgkmcnt(0)" ::: "memory"); __builtin_amdgcn_s_barrier();
  ATT_ISSUE(0, 0); ATT_ISSUE(1, 1); ATT_ISSUE(2, 2);
  ATT_LAND2(); __builtin_amdgcn_s_barrier();
  qkt<DK>(pA0, pA1, lds + C::OFF_K, ka, qr); partialSM(pA0, pA1, m_reg, mnA, alA);
  ATT_LAND1(); __builtin_amdgcn_s_barrier();
  int t = 0;
  for (; t + 4 < NT; t += 4) {
    ATT_STEP(0, t,     pA0, pA1, pB0, pB1, mnB, alB, false);
    ATT_STEP(1, t + 1, pB0, pB1, pA0, pA1, mnA, alA, false);
    ATT_STEP(2, t + 2, pA0, pA1, pB0, pB1, mnB, alB, false);
    ATT_STEP(3, t + 3, pB0, pB1, pA0, pA1, mnA, alA, false);
  }
  ATT_STEP(0, t,     pA0, pA1, pB0, pB1, mnB, alB, false);
  ATT_STEP(1, t + 1, pB0, pB1, pA0, pA1, mnA, alA, false);
  ATT_STEP(2, t + 2, pA0, pA1, pB0, pB1, mnB, alB, false);
  ATT_STEP(3, t + 3, pB0, pB1, pA0, pA1, mnA, alA, true);
  asm volatile("s_waitcnt vmcnt(0)" ::: "memory");
  float rli[16];
#pragma unroll
  for (int r = 0; r < 16; ++r) rli[r] = __builtin_amdgcn_rcpf(lsum[r]);
  float* Ow = Ob + (long)(wid * 32) * ldo;
#pragma unroll
  for (int r = 0; r < 16; ++r) { const int orow = crow(r, hi);
#pragma unroll
    for (int d0 = 0; d0 < C::NB; ++d0) Ow[(long)orow * ldo + d0 * 32 + r32] = o[d0][r] * rli[r]; }
#undef ATT_ISSUE
#undef ATT_LAND1
#undef ATT_LAND2
#undef ATT_RESC
#undef ATT_STEP
}
}
constexpr int DM = 1024, NBATCH = 2, SEQ = 16384, CT = 256, TB = SEQ + CT  , R = NBATCH * TB  ;
constexpr int ATT_IN = 2208, ATT_NP = 2304, REC_IN = 3472, REC_NP = 3584, RWKV_IN = 1920;
constexpr int NE = 32, TOPK = 4, MAXT = R * TOPK / 256 + NE  , MAXROWS = MAXT * 256;
constexpr int NUNIT_M = 16 * 260;
constexpr float NORM_EPS = 1e-6f;
enum { I_X = 0, I_C, I_CTX, I_CCTX, I_NMIX, I_NFFN, I_ADAW, I_ADAB, I_WOUT, I_RW, I_RB, I_W1, I_B1, I_W2, I_B2, I_ATTW, I_LAM, I_SUBLN, I_QNW, I_KVNW, I_WUQ, I_WUKV,
       I_RECW, I_MU, I_W0, I_RW2, I_A0, I_A2, I_G2, I_KK, I_KA, I_RK, I_LNW, I_LNB, I_GATEB, I_MNW, I_FNW, N_IN };
constexpr size_t al256(size_t x) { return (x + 255) & ~(size_t)255; }
constexpr size_t WS_CTL = 0, CTL_ZERO_BYTES = 1u << 20;
constexpr size_t WS_MOD = CTL_ZERO_BYTES;
constexpr size_t WS_ROPE = al256(WS_MOD + 2 * 3 * 6144 * 4);
constexpr size_t ROPE_DR = 0, ROPE_DC = 256 * 16 * 2, ROPE_MR = ROPE_DC + 64 * 16 * 2, ROPE_MC = ROPE_MR + 256 * 8 * 2, ROPE_FLOATS = ROPE_MC + 64 * 8 * 2;
constexpr size_t WS_WRH = al256(WS_ROPE + ROPE_FLOATS * 4);
constexpr size_t WS_WRL = al256(WS_WRH + (size_t)2 * 32 * 1024 * 2);
constexpr size_t WS_WIN0 = al256(WS_WRL + (size_t)2 * 32 * 1024 * 2);
constexpr size_t WS_WUQ = al256(WS_WIN0 + (size_t)ATT_NP * 1024 * 2);
constexpr size_t WS_WUKV = al256(WS_WUQ + (size_t)768 * 384 * 2);
constexpr size_t WS_WOUT = al256(WS_WUKV + (size_t)1024 * 256 * 2);
constexpr size_t WS_WREC = al256(WS_WOUT + (size_t)2 * 1024 * 1024 * 2);
constexpr size_t WS_WLORA = al256(WS_WREC + (size_t)REC_NP * 1024 * 2);
constexpr size_t WS_W1T = al256(WS_WLORA + (size_t)2560 * 384 * 2);
constexpr size_t WS_W2T = al256(WS_W1T + (size_t)NE * 2048 * 1024 * 2);
constexpr size_t WS_H = al256(WS_W2T + (size_t)NE * 1024 * 1024 * 2);
constexpr size_t WS_A = al256(WS_H + (size_t)R * 1024 * 4);
constexpr size_t WS_A1 = al256(WS_A + (size_t)R * 1024 * 2);
constexpr size_t WS_F = al256(WS_A1 + (size_t)R * 1024 * 2);
constexpr size_t WS_P = al256(WS_F + (size_t)R * 1024 * 2);
constexpr size_t WS_TOPE = al256(WS_P + (size_t)R * REC_NP * 2);
constexpr size_t WS_GATE = al256(WS_TOPE + (size_t)R * 16);
constexpr size_t WS_POS = al256(WS_GATE + (size_t)R * 16);
constexpr size_t WS_DEST = al256(WS_POS + (size_t)R * 16);
constexpr size_t WS_TILE = al256(WS_DEST + (size_t)R * 16);
constexpr size_t WS_SRC = al256(WS_TILE + (size_t)(MAXT + 8) * 4);
constexpr size_t WS_T = al256(WS_SRC + (size_t)MAXROWS * 4);
constexpr size_t WS_QD = WS_T;
constexpr size_t WS_KD = al256(WS_QD + (size_t)R * 512 * 2);
constexpr size_t WS_CQN = al256(WS_KD + (size_t)R * 512 * 2);
constexpr size_t WS_CKVN = al256(WS_CQN + (size_t)R * 384 * 2);
constexpr size_t WS_MQ = al256(WS_CKVN + (size_t)R * 256 * 2);
constexpr size_t WS_MKV = al256(WS_MQ + (size_t)R * 768 * 2);
constexpr size_t WS_KRR = al256(WS_MKV + (size_t)R * 1024 * 2);
constexpr size_t WS_ODIFF = al256(WS_KRR + (size_t)R * 32 * 2);
constexpr size_t WS_OMLA = al256(WS_ODIFF + (size_t)R * 1024 * 4);
constexpr size_t WS_T0_END = al256(WS_OMLA + (size_t)R * 512 * 4);
constexpr size_t WS_XS = WS_T;
constexpr size_t WS_HS = al256(WS_XS + (size_t)MAXROWS * 1024 * 2);
constexpr size_t WS_TM_END = al256(WS_HS + (size_t)MAXROWS * 1024 * 2);
constexpr size_t SZ_RC = (size_t)R * 512 * 4;
constexpr size_t WS_RR = WS_T, WS_VV = WS_RR + SZ_RC, WS_AKK = WS_VV + SZ_RC, WS_KL = WS_AKK + SZ_RC;
constexpr size_t WS_WDEC = WS_KL + SZ_RC  , WS_KDIR = WS_WDEC + 2 * SZ_RC  , WS_BB = WS_KDIR + 2 * SZ_RC  , WS_GG = WS_BB + 2 * SZ_RC;
constexpr size_t WS_ALORA = al256(WS_GG + SZ_RC);
constexpr size_t WS_YR = al256(WS_ALORA + (size_t)R * 384 * 2);
constexpr size_t WS_DC = WS_YR;
constexpr size_t WS_HM = al256(WS_YR + 2 * SZ_RC);
constexpr size_t WS_CST = al256(WS_HM + 2 * SZ_RC);
constexpr size_t WS_DN = al256(WS_CST + (size_t)NUNIT_M * 8192 * 4);
constexpr size_t WS_NST = al256(WS_DN + (size_t)NUNIT_M * 64 * 4);
constexpr size_t WS_SC = al256(WS_NST + (size_t)NUNIT_M * 64 * 4);
constexpr size_t WS_MST = al256(WS_SC + (size_t)NUNIT_M * 2 * 4);
constexpr size_t WS_ASIG = WS_KDIR;
constexpr size_t WS_YB = WS_BB;
constexpr int NUNIT_R = 32 * 260;
constexpr size_t WS_RKM = WS_KDIR + SZ_RC;
static_assert((size_t)NUNIT_R * 4096 * 2 <= SZ_RC, "M^T fits in KL");
constexpr size_t WS_RKQ = al256(WS_MST + (size_t)NUNIT_M * 4);
constexpr size_t WS_RKZ = al256(WS_RKQ + (size_t)NUNIT_R * 4096 * 2);
constexpr size_t WS_T1_END = al256(WS_RKZ + (size_t)NUNIT_R * 4096 * 2);
constexpr size_t WS_END = WS_T1_END > WS_TM_END ? (WS_T1_END > WS_T0_END ? WS_T1_END : WS_T0_END) : (WS_TM_END > WS_T0_END ? WS_TM_END : WS_T0_END);
static_assert(WS_END <= (size_t)2147483648ull, "workspace map exceeds 2 GiB");
constexpr int CW_CNT = 1024;
constexpr int CW_BAR = 4096;
constexpr int RING_BYTES = 131072, AUX_OFF = 131072, AUX_BYTES = 16384, MISC_OFF = 147456, LDS_BYTES = 163840;

struct Frame {
    LAS unsigned char* lds; gu32* ctl; int tid, lane, wave, blk, G, probe;
    float* out; unsigned char* ws;
    struct InTab { LAS const unsigned* t;
        __device__ __forceinline__ const float* operator[](int i) const { const unsigned lo = __builtin_amdgcn_readfirstlane(t[2 * i]), hi = __builtin_amdgcn_readfirstlane(t[2 * i + 1]);
            return (const float*)(((unsigned long long)hi << 32) | lo); } } in;
};
template <class T> __device__ __forceinline__ T* wsp(const Frame& F, size_t off) { return (T*)(F.ws + off); }
__device__ __forceinline__ int row_sel(int row) { const int b = row / TB, t = row - b * TB; return t < CT ? 2 : b; }
__device__ __forceinline__ const float* h0_row(const Frame& F, int row) {
    const int b = row / TB, t = row - b * TB;
    return t < CT ? F.in[I_CTX] + ((size_t)b * CT + t) * DM : F.in[I_X] + ((size_t)b * SEQ + (t - CT)) * DM;
}
__device__ __forceinline__ const float* modp(const Frame& F, int layer, int sel, int chunk) { return wsp<const float>(F, WS_MOD) + ((size_t)(layer * 3 + sel) * 6 + chunk) * DM; }
__device__ __forceinline__ int scan_tok(int z, int sg) { return z == 0 ? sg : (sg < CT ? CT - 1 - sg : TB + CT - 1 - sg); }
__device__ __forceinline__ void tr_item(const float* W, int K, int N, bf16* WT, int row_off, LAS float* scr, int kb, int nb, int lane) {
    const int k0 = 64 * kb, n0 = 32 * nb;
    const int n = n0 + (lane & 31);
    float tv[32];
#pragma unroll
    for (int i = 0; i < 32; ++i) { const int kk = 2 * i + (lane >> 5); tv[i] = (n < N) ? W[(size_t)(k0 + kk) * N + n] : 0.f; }
#pragma unroll
    for (int i = 0; i < 32; ++i) { const int kk = 2 * i + (lane >> 5); scr[kk * 33 + (lane & 31)] = tv[i]; }
    LDS_WAIT(); asm volatile("" ::: "memory");
    const int c = lane & 7;
#pragma unroll
    for (int j = 0; j < 4; ++j) { const int nn = (lane >> 3) + 8 * j; const LAS float* s = scr + (8 * c) * 33 + nn;
        v4u o; o.x = pk2(s[0 * 33], s[1 * 33]); o.y = pk2(s[2 * 33], s[3 * 33]); o.z = pk2(s[4 * 33], s[5 * 33]); o.w = pk2(s[6 * 33], s[7 * 33]);
        *(v4u*)(WT + (size_t)(row_off + n0 + nn) * K + k0 + 8 * c) = o; }
    LDS_WAIT(); asm volatile("" ::: "memory");
}
__device__ __forceinline__ void tr_family(const Frame& F, const float* W, size_t src_stride, int nmat, int K, int N, int Npad, bf16* WT, int gw, int NGW) {
    LAS float* scr = (LAS float*)(F.lds + F.wave * 16384);
    const int nkb = K / 64, nnb = Npad / 32, per = nkb * nnb, total = per * nmat;
    for (int it = gw; it < total; it += NGW) { const int m = it / per, r = it - m * per, kb = r / nnb, nb = r - kb * nnb;
        tr_item(W + (size_t)m * src_stride, K, N, WT, m * Npad, scr, kb, nb, F.lane); }
}
__device__ __forceinline__ void moe_weights_convert(const Frame& F, int layer, int gw, int NGW) {
    tr_family(F, F.in[I_W1] + (size_t)layer * NE * 1024 * 2048, (size_t)1024 * 2048, NE, 1024, 2048, 2048, wsp<bf16>(F, WS_W1T), gw, NGW);
    tr_family(F, F.in[I_W2] + (size_t)layer * NE * 1024 * 1024, (size_t)1024 * 1024, NE, 1024, 1024, 1024, wsp<bf16>(F, WS_W2T), gw, NGW);
}
__device__ __forceinline__ void norm_mod_row(const Frame& F, const float* src, const float* nw, const float* shift, const float* scale, bf16* orow) {
    const f32x4* xr = (const f32x4*)src + F.lane;
    f32x4 v[4]; float s = 0.f;
#pragma unroll
    for (int j = 0; j < 4; ++j) { v[j] = xr[64 * j]; s += (v[j].x * v[j].x + v[j].y * v[j].y) + (v[j].z * v[j].z + v[j].w * v[j].w); }
    const float rs = 1.f / sqrtf(wave_sum(s) * (1.f / DM) + NORM_EPS);
    unsigned long long* o8 = (unsigned long long*)orow + F.lane;
#pragma unroll
    for (int j = 0; j < 4; ++j) { const f32x4 w = ((const f32x4*)nw)[F.lane + 64 * j], sh = ((const f32x4*)shift)[F.lane + 64 * j], sc = ((const f32x4*)scale)[F.lane + 64 * j];
        const f32x4 y = v[j] * rs * w * (sc + 1.f) + sh;
        o8[64 * j] = (unsigned long long)pk2(y.x, y.y) | ((unsigned long long)pk2(y.z, y.w) << 32); }
}
__device__ __forceinline__ void p0a(const Frame& F) {
    LAS float* sv = (LAS float*)F.lds; LAS float* red = (LAS float*)(F.lds + 16384);
    for (int i = F.tid; i < 3 * DM; i += 512) { const int s = i / DM, k = i - s * DM; const float cv = (s < 2) ? F.in[I_C][s * DM + k] : F.in[I_CCTX][k]; sv[i] = cv / (1.f + __expf(-cv)); }
    __syncthreads();
    for (int it = F.blk; it < 192; it += F.G) {
        const int l = it / 96, cgp = it - l * 96, kq = F.tid >> 4, cg = F.tid & 15, col = cgp * 64 + cg * 4;
        float acc[3][4];
#pragma unroll
        for (int s = 0; s < 3; ++s)
#pragma unroll
            for (int j = 0; j < 4; ++j) acc[s][j] = 0.f;
        const float* W = F.in[I_ADAW] + (size_t)l * DM * 6144 + col;
#pragma unroll 16
        for (int kk = 0; kk < 32; ++kk) { const int k = kq * 32 + kk; const f32x4 w = *(const f32x4*)(W + (size_t)k * 6144);
            const float s0 = sv[k], s1 = sv[DM + k], s2 = sv[2 * DM + k];
#pragma unroll
            for (int j = 0; j < 4; ++j) { acc[0][j] += s0 * w[j]; acc[1][j] += s1 * w[j]; acc[2][j] += s2 * w[j]; } }
#pragma unroll
        for (int s = 0; s < 3; ++s)
#pragma unroll
            for (int j = 0; j < 4; ++j) red[(kq * 16 + cg) * 12 + s * 4 + j] = acc[s][j];
        __syncthreads();
        if (F.tid < 192) { const int s = F.tid / 64, cc = F.tid - s * 64, cg2 = cc >> 2, j = cc & 3; float t = 0.f;
            for (int q = 0; q < 32; ++q) t += red[(q * 16 + cg2) * 12 + s * 4 + j];
            wsp<float>(F, WS_MOD)[(size_t)(l * 3 + s) * 6144 + cgp * 64 + cc] = t + F.in[I_ADAB][l * 6144 + cgp * 64 + cc]; }
        __syncthreads();
    }
    const int gid = F.blk * 512 + F.tid, GT = F.G * 512;
    float* rope = wsp<float>(F, WS_ROPE);
    for (int i = gid; i < 256 * 16 + 64 * 16 + 256 * 8 + 64 * 8; i += GT) {
        int j = i; float pos, inv; size_t off;
        if (j < 256 * 16) { pos = (float)(j / 16); inv = powf(10000.f, -(float)(j % 16) / 16.f); off = ROPE_DR + (size_t)j * 2; }
        else if ((j -= 256 * 16) < 64 * 16) { pos = (float)(j / 16); inv = powf(10000.f, -(float)(j % 16) / 16.f); off = ROPE_DC + (size_t)j * 2; }
        else if ((j -= 64 * 16) < 256 * 8) { pos = (float)(j / 8); inv = powf(10000.f, -(float)(j % 8) / 8.f); off = ROPE_MR + (size_t)j * 2; }
        else { j -= 256 * 8; pos = (float)(j / 8); inv = powf(10000.f, -(float)(j % 8) / 8.f); off = ROPE_MC + (size_t)j * 2; }
        const float ang = pos * inv; rope[off] = cosf(ang); rope[off + 1] = sinf(ang);
    }
    { bf16* wh = wsp<bf16>(F, WS_WRH); bf16* wl = wsp<bf16>(F, WS_WRL); for (int i = gid; i < 2 * 32 * 1024; i += GT) { const int k = i & 1023, e = (i >> 10) & 31, l = i >> 15; const float wv = F.in[I_RW][((size_t)l * DM + k) * NE + e];
        const unsigned hb = f2bf(wv); wh[i] = (bf16)hb; wl[i] = (bf16)f2bf(wv - bf2f((bf16)hb)); } }
    bf16* WL = wsp<bf16>(F, WS_WLORA);
    for (int i = gid; i < 2560 * 384; i += GT) { const int n = i / 384, k = i - n * 384, part = n >> 9, c = n & 511; float v = 0.f;
        if (part < 2) { if ((k >> 6) == part) v = F.in[I_RW2][((size_t)part * 64 + (k & 63)) * 512 + c]; }
        else if (part < 4) { if ((k >> 6) == part) v = F.in[I_A2][((size_t)(part - 2) * 64 + (k & 63)) * 512 + c]; }
        else { if (k >= 256) v = F.in[I_G2][(size_t)(k - 256) * 512 + c]; }
        WL[i] = (bf16)f2bf(v); }
    const int gw = F.blk * 8 + F.wave, NGW = F.G * 8;
    tr_family(F, F.in[I_ATTW], 0, 1, 1024, ATT_IN, ATT_NP, wsp<bf16>(F, WS_WIN0), gw, NGW);
    tr_family(F, F.in[I_WUQ], 0, 1, 384, 768, 768, wsp<bf16>(F, WS_WUQ), gw, NGW);
    tr_family(F, F.in[I_WUKV], 0, 1, 256, 1024, 1024, wsp<bf16>(F, WS_WUKV), gw, NGW);
    tr_family(F, F.in[I_WOUT], (size_t)1024 * 1024, 2, 1024, 1024, 1024, wsp<bf16>(F, WS_WOUT), gw, NGW);
    tr_family(F, F.in[I_RECW], 0, 1, 1024, REC_IN, REC_NP, wsp<bf16>(F, WS_WREC), gw, NGW);
    moe_weights_convert(F, 0, gw, NGW);
}
__device__ __forceinline__ void p0b(const Frame& F) {
    const int gw = F.blk * 8 + F.wave, NGW = F.G * 8;
    for (int row = gw; row < R; row += NGW) { const int sel = row_sel(row);
        norm_mod_row(F, h0_row(F, row), F.in[I_NMIX], modp(F, 0, sel, 0), modp(F, 0, sel, 1), wsp<bf16>(F, WS_A) + (size_t)row * DM); }
}
struct FnStoreBf16 {
    bf16* O; int ldc;
    __device__ __forceinline__ void operator()(int row, int col, f32x4 v0, f32x4 v1) const {
        v4u w; w.x = pg8::cvt_pk_bf16(v0[0], v0[1]); w.y = pg8::cvt_pk_bf16(v0[2], v0[3]); w.z = pg8::cvt_pk_bf16(v1[0], v1[1]); w.w = pg8::cvt_pk_bf16(v1[2], v1[3]);
        *(v4u*)(O + (size_t)row * ldc + col) = w; }
};
struct FnWout {
    const Frame* F; int layer;
    __device__ __forceinline__ void operator()(int row, int col, f32x4 v0, f32x4 v1) const {
        bf16* hrow = wsp<bf16>(*F, WS_H) + (size_t)row * DM + col;
        const float* g = modp(*F, layer, row_sel(row), 2) + col;
        const f32x4 g0 = *(const f32x4*)g, g1 = *(const f32x4*)(g + 4); f32x4 b0, b1;
        if (layer == 0) { const float* base = h0_row(*F, row) + col; b0 = *(const f32x4*)base; b1 = *(const f32x4*)(base + 4); }
        else { float x[8]; unpack8(*(const v4u*)hrow, x); b0 = (f32x4){x[0], x[1], x[2], x[3]}; b1 = (f32x4){x[4], x[5], x[6], x[7]}; }
        const f32x4 o0 = b0 + g0 * v0, o1 = b1 + g1 * v1; v4u w; w.x = pk2(o0.x, o0.y); w.y = pk2(o0.z, o0.w); w.z = pk2(o1.x, o1.y); w.w = pk2(o1.z, o1.w);
        *(v4u*)hrow = w; }
};
__device__ __forceinline__ void l0_post_proj(const Frame& F) {
    const int gw = F.blk * 8 + F.wave, NGW = F.G * 8, lane = F.lane;
    const bf16* P = wsp<const bf16>(F, WS_P); const float* rope = wsp<const float>(F, WS_ROPE);
    constexpr float CD = 0.125f * 1.4426950408889634f;
    for (int row = gw; row < R; row += NGW) {
        const int b = row / TB, t = row - b * TB; const bool lat = t >= CT; const int pos = t - CT, prow = lat ? pos >> 6 : 0, pcol = lat ? pos & 63 : 0;
        const bf16* p = P + (size_t)row * ATT_NP;
        bf16* qd = wsp<bf16>(F, WS_QD) + (size_t)row * 512; bf16* kd = wsp<bf16>(F, WS_KD) + (size_t)row * 512;
#pragma unroll
        for (int j = 0; j < 2; ++j) { const int g = lane + 64 * j, h16 = g >> 3, i0 = (g & 7) * 4;
            const v2u w1 = *(const v2u*)(p + h16 * 64 + i0), w2 = *(const v2u*)(p + h16 * 64 + i0 + 32);
            const float x1[4] = {bflo(w1.x), bfhi(w1.x), bflo(w1.y), bfhi(w1.y)}, x2[4] = {bflo(w2.x), bfhi(w2.x), bflo(w2.y), bfhi(w2.y)};
            float cs[8] = {1.f, 0.f, 1.f, 0.f, 1.f, 0.f, 1.f, 0.f};
            if (lat) { const float* tb = (i0 < 16) ? rope + ROPE_DR + (size_t)(prow * 16 + i0) * 2 : rope + ROPE_DC + (size_t)(pcol * 16 + i0 - 16) * 2;
                const f32x4 t0 = *(const f32x4*)tb, t1 = *(const f32x4*)(tb + 4); cs[0] = t0.x; cs[1] = t0.y; cs[2] = t0.z; cs[3] = t0.w; cs[4] = t1.x; cs[5] = t1.y; cs[6] = t1.z; cs[7] = t1.w; }
            float y1[4], y2[4]; const float sc = h16 < 8 ? CD : 1.f;
#pragma unroll
            for (int e = 0; e < 4; ++e) { y1[e] = (x1[e] * cs[2 * e] - x2[e] * cs[2 * e + 1]) * sc; y2[e] = (x1[e] * cs[2 * e + 1] + x2[e] * cs[2 * e]) * sc; }
            bf16* o = (h16 < 8) ? qd + h16 * 64 + i0 : kd + (h16 - 8) * 64 + i0;
            v2u o1, o2; o1.x = pk2(y1[0], y1[1]); o1.y = pk2(y1[2], y1[3]); o2.x = pk2(y2[0], y2[1]); o2.y = pk2(y2[2], y2[3]);
            *(v2u*)o = o1; *(v2u*)(o + 32) = o2; }
        { float x[8]; float ss = 0.f; const bool act = lane < 48;
          if (act) unpack8(*(const v4u*)(p + 1536 + 8 * lane), x); else {
#pragma unroll
              for (int e = 0; e < 8; ++e) x[e] = 0.f; }
#pragma unroll
          for (int e = 0; e < 8; ++e) ss += x[e] * x[e];
          const float rs = 1.f / sqrtf(wave_sum(ss) * (1.f / 384.f) + NORM_EPS);
          if (act) { const f32x4 g0 = *(const f32x4*)(F.in[I_QNW] + 8 * lane), g1 = *(const f32x4*)(F.in[I_QNW] + 8 * lane + 4); v4u w;
              w.x = pk2(x[0] * rs * g0.x, x[1] * rs * g0.y); w.y = pk2(x[2] * rs * g0.z, x[3] * rs * g0.w); w.z = pk2(x[4] * rs * g1.x, x[5] * rs * g1.y); w.w = pk2(x[6] * rs * g1.z, x[7] * rs * g1.w);
              *(v4u*)(wsp<bf16>(F, WS_CQN) + (size_t)row * 384 + 8 * lane) = w; } }
        { const v2u wv = *(const v2u*)(p + 1920 + 4 * lane); const float x[4] = {bflo(wv.x), bfhi(wv.x), bflo(wv.y), bfhi(wv.y)};
          const float rs = 1.f / sqrtf(wave_sum((x[0] * x[0] + x[1] * x[1]) + (x[2] * x[2] + x[3] * x[3])) * (1.f / 256.f) + NORM_EPS);
          const f32x4 g0 = *(const f32x4*)(F.in[I_KVNW] + 4 * lane); v2u w; w.x = pk2(x[0] * rs * g0.x, x[1] * rs * g0.y); w.y = pk2(x[2] * rs * g0.z, x[3] * rs * g0.w);
          *(v2u*)(wsp<bf16>(F, WS_CKVN) + (size_t)row * 256 + 4 * lane) = w; }
        if (lane < 16) { const int i = lane; const float x1 = bf2f(p[2176 + i]), x2 = bf2f(p[2176 + i + 16]); float c = 1.f, s = 0.f;
            if (lat) { const float* tb = (i < 8) ? rope + ROPE_MR + (size_t)(prow * 8 + i) * 2 : rope + ROPE_MC + (size_t)(pcol * 8 + i - 8) * 2; c = tb[0]; s = tb[1]; }
            bf16* o = wsp<bf16>(F, WS_KRR) + (size_t)row * 32; o[i] = (bf16)f2bf(x1 * c - x2 * s); o[i + 16] = (bf16)f2bf(x1 * s + x2 * c); }
    }
}
__device__ __forceinline__ void l0_mq_rope(const Frame& F) {
    const int gw = F.blk * 8 + F.wave, NGW = F.G * 8, lane = F.lane; const float* rope = wsp<const float>(F, WS_ROPE);
    const float CM = 0.10206207261596575f * 1.4426950408889634f;
    for (int row = gw; row < R; row += NGW) {
        const int b = row / TB, t = row - b * TB; const bool lat = t >= CT; const int pos = t - CT, prow = lat ? pos >> 6 : 0, pcol = lat ? pos & 63 : 0;
        bf16* q = wsp<bf16>(F, WS_MQ) + (size_t)row * 768;
#pragma unroll
        for (int j = 0; j < 2; ++j) { const int g = lane + 64 * j, h = g >> 4, d0 = (g & 15) * 4;
            const v2u wv = *(const v2u*)(q + h * 96 + d0); v2u o; o.x = pk2(bflo(wv.x) * CM, bfhi(wv.x) * CM); o.y = pk2(bflo(wv.y) * CM, bfhi(wv.y) * CM); *(v2u*)(q + h * 96 + d0) = o; }
#pragma unroll
        for (int j = 0; j < 2; ++j) { const int pr = lane + 64 * j, h = pr >> 4, i = pr & 15; const float x1 = bf2f(q[h * 96 + 64 + i]), x2 = bf2f(q[h * 96 + 80 + i]); float c = 1.f, s = 0.f;
            if (lat) { const float* tb = (i < 8) ? rope + ROPE_MR + (size_t)(prow * 8 + i) * 2 : rope + ROPE_MC + (size_t)(pcol * 8 + i - 8) * 2; c = tb[0]; s = tb[1]; }
            q[h * 96 + 64 + i] = (bf16)f2bf((x1 * c - x2 * s) * CM); q[h * 96 + 80 + i] = (bf16)f2bf((x1 * s + x2 * c) * CM); }
    }
}
__device__ __forceinline__ void l0_attention(const Frame& F) {
    LAS char* lds = (LAS char*)F.lds;
    const bf16* QD = wsp<const bf16>(F, WS_QD); const bf16* KD = wsp<const bf16>(F, WS_KD); const bf16* P = wsp<const bf16>(F, WS_P);
    const bf16* MQ = wsp<const bf16>(F, WS_MQ); const bf16* MKV = wsp<const bf16>(F, WS_MKV); const bf16* KRR = wsp<const bf16>(F, WS_KRR);
    float* OD = wsp<float>(F, WS_ODIFF); float* OM = wsp<float>(F, WS_OMLA);
    for (int kind = 0; kind < 2; ++kind) {
        for (int L = F.blk; L < 1024 + 16; L += F.G) {
            int b, h8, qb, nkeys;
            if (L < 1024) { int pair;
                if (F.G == 256) { const int round = L >> 8, c = L & 255; pair = round * 4 + ((c & 7) >> 1); qb = 1 + (c & 1) * 32 + (c >> 3); }
                else { pair = L >> 6; qb = 1 + (L & 63); }
                b = pair >> 3; h8 = pair & 7; nkeys = TB; }
            else { const int s = L - 1024; b = s >> 3; h8 = s & 7; qb = 0; nkeys = CT; }
            const size_t q0 = (size_t)b * TB + (size_t)qb * 256, k0 = (size_t)b * TB;
            if (kind == 0)
                att::attn_unit<64, 128>(QD + q0 * 512 + h8 * 64, 512, KD + k0 * 512 + h8 * 64, 512, nullptr, 0, P + k0 * ATT_NP + 1024 + (h8 >> 1) * 128, ATT_NP,
                                        OD + q0 * 1024 + h8 * 128, 1024, nkeys, lds);
            else
                att::attn_unit<96, 64>(MQ + q0 * 768 + h8 * 96, 768, MKV + k0 * 1024 + h8 * 128, 1024, KRR + k0 * 32, 32, MKV + k0 * 1024 + h8 * 128 + 64, 1024,
                                       OM + q0 * 512 + h8 * 64, 512, nkeys, lds);
        }
    }
}
__device__ __forceinline__ void l0_combine(const Frame& F) {
    const int gw = F.blk * 8 + F.wave, NGW = F.G * 8, lane = F.lane;
    const float* lv = F.in[I_LAM];
    const float lam = __expf(wave_sum(lv[lane] * lv[64 + lane])) - __expf(wave_sum(lv[128 + lane] * lv[192 + lane])) + 0.2f;
    const float sw0 = F.in[I_SUBLN][2 * lane] * 0.8f, sw1 = F.in[I_SUBLN][2 * lane + 1] * 0.8f;
    for (int row = gw; row < R; row += NGW) {
        const float* od = wsp<const float>(F, WS_ODIFF) + (size_t)row * 1024; const float* om = wsp<const float>(F, WS_OMLA) + (size_t)row * 512;
        bf16* a1 = wsp<bf16>(F, WS_A1) + (size_t)row * DM;
#pragma unroll
        for (int h = 0; h < 4; ++h) {
            const float o1a = od[(2 * h) * 128 + 2 * lane], o1b = od[(2 * h) * 128 + 2 * lane + 1], o2a = od[(2 * h + 1) * 128 + 2 * lane], o2b = od[(2 * h + 1) * 128 + 2 * lane + 1];
            const float da = o1a - lam * o2a, db = o1b - lam * o2b;
            const float rs = 1.f / sqrtf(wave_sum(da * da + db * db) * (1.f / 128.f) + NORM_EPS);
            *(unsigned*)(a1 + h * 128 + 2 * lane) = pk2(da * rs * sw0, db * rs * sw1); }
#pragma unroll
        for (int j = 0; j < 2; ++j) { const f32x4 v = *(const f32x4*)(om + 4 * (lane + 64 * j)); v2u w; w.x = pk2(v.x, v.y); w.y = pk2(v.z, v.w); *(v2u*)(a1 + 512 + 4 * (lane + 64 * j)) = w; }
    }
}
constexpr int RT_LS = 264;
__device__ __forceinline__ void ph_router(const Frame& F, int layer) {
    LAS bf16* AH = (LAS bf16*)F.lds; LAS bf16* AL = AH + 64 * RT_LS; LAS bf16* WH = AL + 64 * RT_LS; LAS bf16* WL = WH + 32 * RT_LS;
    LAS float* lg = (LAS float*)(F.lds + 110592);
    LAS int* hist = (LAS int*)(F.lds + MISC_OFF + 256);
    LAS int* recs = (LAS int*)(F.lds + MISC_OFF + 512);
    const int lane = F.lane, w = F.wave, tid = F.tid, RPB = (R + F.G - 1) / F.G, row0 = F.blk * RPB;
    if (tid < 64) hist[tid] = 0;
    { int* srct = wsp<int>(F, WS_SRC); for (int i = F.blk * 512 + tid; i < MAXROWS; i += F.G * 512) srct[i] = 0; }
    const float* nw = F.in[I_NFFN] + (size_t)layer * DM; const float* rbp = F.in[I_RB] + layer * NE;
    const bf16* wrh = wsp<const bf16>(F, WS_WRH) + (size_t)layer * 32 * 1024; const bf16* wrl = wsp<const bf16>(F, WS_WRL) + (size_t)layer * 32 * 1024;
    for (int pass = 0; pass * 64 < RPB; ++pass) {
        const int nrow = min(64, min(RPB - pass * 64, R - row0 - pass * 64));
        f32x4 fr[8][4];
#pragma unroll
        for (int i = 0; i < 8; ++i) { const int rl = w + 8 * i; const int row = row0 + pass * 64 + rl;
            if (rl < nrow) {
                const int sel = row_sel(row); const float* sh = modp(F, layer, sel, 3); const float* sc = modp(F, layer, sel, 4);
                const v2u* xr = (const v2u*)(wsp<const bf16>(F, WS_H) + (size_t)row * DM) + lane; float s = 0.f;
#pragma unroll
                for (int j = 0; j < 4; ++j) { const v2u hw = xr[64 * j]; fr[i][j] = (f32x4){bflo(hw.x), bfhi(hw.x), bflo(hw.y), bfhi(hw.y)}; s += (fr[i][j].x * fr[i][j].x + fr[i][j].y * fr[i][j].y) + (fr[i][j].z * fr[i][j].z + fr[i][j].w * fr[i][j].w); }
                const float rs = 1.f / sqrtf(wave_sum(s) * (1.f / DM) + NORM_EPS);
                unsigned long long* o8 = (unsigned long long*)(wsp<bf16>(F, WS_F) + (size_t)row * DM) + lane;
#pragma unroll
                for (int j = 0; j < 4; ++j) { const f32x4 ww = ((const f32x4*)nw)[lane + 64 * j], a = ((const f32x4*)sh)[lane + 64 * j], c = ((const f32x4*)sc)[lane + 64 * j];
                    fr[i][j] = fr[i][j] * rs * ww * (c + 1.f) + a;
                    o8[64 * j] = (unsigned long long)pk2(fr[i][j].x, fr[i][j].y) | ((unsigned long long)pk2(fr[i][j].z, fr[i][j].w) << 32); }
            } else {
#pragma unroll
                for (int j = 0; j < 4; ++j) fr[i][j] = (f32x4){0.f, 0.f, 0.f, 0.f};
            } }
        pg8::f32x4 acc = {0.f, 0.f, 0.f, 0.f};
#pragma unroll
        for (int c = 0; c < 4; ++c) {
            __syncthreads();
#pragma unroll
            for (int i = 0; i < 8; ++i) { const f32x4 v = fr[i][c]; const unsigned h0 = pk2(v.x, v.y), h1 = pk2(v.z, v.w);
                const unsigned l0 = pk2(v.x - bflo(h0), v.y - bfhi(h0)), l1 = pk2(v.z - bflo(h1), v.w - bfhi(h1));
                v2u hh; hh.x = h0; hh.y = h1; v2u ll; ll.x = l0; ll.y = l1;
                *(LAS v2u*)(AH + (w + 8 * i) * RT_LS + 4 * lane) = hh; *(LAS v2u*)(AL + (w + 8 * i) * RT_LS + 4 * lane) = ll; }
            { const int e = tid >> 4, kp = (tid & 15) * 16;
              const v4u a0 = *(const v4u*)(wrh + (size_t)e * 1024 + 256 * c + kp), a1 = *(const v4u*)(wrh + (size_t)e * 1024 + 256 * c + kp + 8);
              const v4u b0 = *(const v4u*)(wrl + (size_t)e * 1024 + 256 * c + kp), b1 = *(const v4u*)(wrl + (size_t)e * 1024 + 256 * c + kp + 8);
              *(LAS v4u*)(WH + e * RT_LS + kp) = a0; *(LAS v4u*)(WH + e * RT_LS + kp + 8) = a1; *(LAS v4u*)(WL + e * RT_LS + kp) = b0; *(LAS v4u*)(WL + e * RT_LS + kp + 8) = b1; }
            __syncthreads();
            const int tm = w >> 1, tn = w & 1, lr = lane & 15, kq = (lane >> 4) * 8;
            const LAS bf16* ahp = AH + (tm * 16 + lr) * RT_LS + kq; const LAS bf16* alp = AL + (tm * 16 + lr) * RT_LS + kq;
            const LAS bf16* whp = WH + (tn * 16 + lr) * RT_LS + kq; const LAS bf16* wlp = WL + (tn * 16 + lr) * RT_LS + kq;
#pragma unroll
            for (int ks = 0; ks < 8; ++ks) { const bf16x8 ah = *(const LAS bf16x8*)(ahp + 32 * ks), al = *(const LAS bf16x8*)(alp + 32 * ks), bh = *(const LAS bf16x8*)(whp + 32 * ks), bl = *(const LAS bf16x8*)(wlp + 32 * ks);
                acc = __builtin_amdgcn_mfma_f32_16x16x32_bf16(ah, bh, acc, 0, 0, 0); acc = __builtin_amdgcn_mfma_f32_16x16x32_bf16(ah, bl, acc, 0, 0, 0); acc = __builtin_amdgcn_mfma_f32_16x16x32_bf16(al, bh, acc, 0, 0, 0); }
        }
        { const int m0 = (w >> 1) * 16 + (lane >> 4) * 4, n = (w & 1) * 16 + (lane & 15);
#pragma unroll
          for (int r = 0; r < 4; ++r) lg[(m0 + r) * 33 + n] = acc[r]; }
        __syncthreads();
        if (tid < nrow) { const int rl = tid, row = row0 + pass * 64 + rl; float lv[32];
#pragma unroll
            for (int e = 0; e < 32; ++e) lv[e] = lg[rl * 33 + e] + rbp[e];
            float selv[4]; int seli[4];
#pragma unroll
            for (int r = 0; r < 4; ++r) { float bv = -3.0e38f; int bi = 0;
#pragma unroll
                for (int e = 0; e < 32; ++e) { const bool taken = (r > 0 && seli[0] == e) || (r > 1 && seli[1] == e) || (r > 2 && seli[2] == e); if (!taken && lv[e] > bv) { bv = lv[e]; bi = e; } }
                selv[r] = bv; seli[r] = bi; }
            float ex[4], es = 0.f;
#pragma unroll
            for (int r = 0; r < 4; ++r) { ex[r] = __expf(selv[r] - selv[0]); es += ex[r]; }
            const float inv = 1.f / es;
#pragma unroll
            for (int r = 0; r < 4; ++r) { wsp<int>(F, WS_TOPE)[(size_t)row * 4 + r] = seli[r]; wsp<float>(F, WS_GATE)[(size_t)row * 4 + r] = ex[r] * inv;
                const int rk = __hip_atomic_fetch_add(&hist[seli[r]], 1, __ATOMIC_RELAXED, __HIP_MEMORY_SCOPE_WORKGROUP);
                recs[(pass * 64 + rl) * 4 + r] = seli[r] | (rk << 8); }
        }
    }
    __syncthreads();
    if (tid < NE) hist[32 + tid] = (int)__hip_atomic_fetch_add(F.ctl + CW_CNT + 64 * (layer + 2 * F.probe) + tid, (unsigned)hist[tid], RLX_AGENT);
    __syncthreads();
    for (int rl = tid; rl < RPB && row0 + rl < R; rl += 512) {
#pragma unroll
        for (int r = 0; r < 4; ++r) { const int rc = recs[rl * 4 + r]; wsp<int>(F, WS_POS)[(size_t)(row0 + rl) * 4 + r] = hist[32 + (rc & 255)] + (rc >> 8); } }
}
__device__ __forceinline__ void moe_tables(const Frame& F, int layer, LAS int* ps, LAS int* tile_e) {
    if (F.tid == 0) { int acc = 0, t = 0;
        for (int e = 0; e < NE; ++e) { const int c = (int)__hip_atomic_load(F.ctl + CW_CNT + 64 * layer + e, RLX_AGENT); ps[e] = acc; const int nt = (c + 255) >> 8;
            for (int i = 0; i < nt && t < MAXT; ++i) tile_e[t++] = e; acc += nt * 256; }
        ps[NE] = acc; ps[NE + 1] = t; }
    __syncthreads();
}
__device__ __forceinline__ void ph_gather(const Frame& F, int layer) {
    LAS int* ps = (LAS int*)(F.lds + MISC_OFF + 256); LAS int* tile_e = ps + 64;
    moe_tables(F, layer, ps, tile_e);
    if (F.blk == 0) { int* tab = wsp<int>(F, WS_TILE); const int nt = ps[NE + 1]; if (F.tid == 0) tab[0] = nt; for (int i = F.tid; i < nt; i += 512) tab[1 + i] = tile_e[i]; }
    for (int i = F.blk * 512 + F.tid; i < R * 4; i += F.G * 512) { const int row = i >> 2;
        const int e = wsp<const int>(F, WS_TOPE)[i]; const int dest = ps[e] + wsp<const int>(F, WS_POS)[i]; wsp<int>(F, WS_DEST)[i] = dest; wsp<int>(F, WS_SRC)[dest] = row; }
}
struct MoeOrder {
    const int* tile_e; int ntiles, nN, G, c; const int* src;
    __device__ __forceinline__ bool next(int i, pg8::Unit& u) const {
        int rt, pl;
        if (G == 256) { const int x = c & 7, y = c >> 3, rpx = 32 / nN; rt = (i * 8 + x) * rpx + y / nN; pl = y % nN; if (rt >= ntiles) return false; }
        else { const long L = (long)i * G + c; if (L >= (long)ntiles * nN) return false; rt = (int)(L / nN); pl = (int)(L - (long)rt * nN); }
        const int e = __builtin_amdgcn_readfirstlane(tile_e[rt]);
        u.pm = rt; u.pn = e * nN + pl; return true; }
    __device__ __forceinline__ void a_ready(const pg8::Unit&) const {}
    __device__ __forceinline__ void done(const pg8::Unit&) const {}
};
struct LatOrder {
    pg8::StaticOrder o;
    __device__ __forceinline__ bool next(int i, pg8::Unit& u) const { if (!o.next(i, u)) return false; u.pm += 1 + (u.pm >= 64 ? 1 : 0); return true; }
    __device__ __forceinline__ void a_ready(const pg8::Unit&) const {}
    __device__ __forceinline__ void done(const pg8::Unit&) const {}
};
struct FnSwiglu {
    bf16* HS; const float* b1;
    __device__ __forceinline__ void operator()(int row, int col, f32x4 v0, f32x4 v1) const {
        const float* bp = b1 + col;
        const f32x4 b0 = *(const f32x4*)bp, b1v = *(const f32x4*)(bp + 4); v0 = v0 + b0; v1 = v1 + b1v;
        const float hv[8] = {v0[0], v0[1], v0[2], v0[3], v1[0], v1[1], v1[2], v1[3]}; float o[4];
#pragma unroll
        for (int i = 0; i < 4; ++i) { const float g = hv[2 * i], l = hv[2 * i + 1];
            const float gl = fminf(g, 7.f), li = fminf(fmaxf(l, -7.f), 7.f); o[i] = gl * sigmoidf_(1.702f * gl) * (li + 1.f); }
        const int lc = col & 2047; v2u w; w.x = pk2(o[0], o[1]); w.y = pk2(o[2], o[3]);
        *(v2u*)(HS + (size_t)row * 1024 + (lc >> 1)) = w; }
};
struct FnBiasBf16 {
    bf16* YS; const float* b2;
    __device__ __forceinline__ void operator()(int row, int col, f32x4 v0, f32x4 v1) const {
        const f32x4 b0 = *(const f32x4*)(b2 + col), b1v = *(const f32x4*)(b2 + col + 4); v0 = v0 + b0; v1 = v1 + b1v;
        v4u w; w.x = pk2(v0[0], v0[1]); w.y = pk2(v0[2], v0[3]); w.z = pk2(v1[0], v1[1]); w.w = pk2(v1[2], v1[3]);
        *(v4u*)(YS + (size_t)row * 1024 + (col & 1023)) = w; }
};
__device__ __forceinline__ void ph_combine(const Frame& F, int layer) {
    const int lane = F.lane, gw = F.blk * 8 + F.wave, NGW = F.G * 8;
    for (int row = gw; row < R; row += NGW) {
        const int sel = row_sel(row); const float* gf = modp(F, layer, sel, 5);
        bf16* hrow = wsp<bf16>(F, WS_H) + (size_t)row * DM;
        f32x4 y[4];
#pragma unroll
        for (int j = 0; j < 4; ++j) y[j] = (f32x4){0.f, 0.f, 0.f, 0.f};
#pragma unroll
        for (int r = 0; r < 4; ++r) { const int d = wsp<const int>(F, WS_DEST)[(size_t)row * 4 + r]; const float g = wsp<const float>(F, WS_GATE)[(size_t)row * 4 + r];
            const v2u* yp = (const v2u*)(wsp<const bf16>(F, WS_XS) + (size_t)d * DM);
#pragma unroll
            for (int j = 0; j < 4; ++j) { const v2u w = yp[lane + 64 * j]; y[j] += g * (f32x4){bflo(w.x), bfhi(w.x), bflo(w.y), bfhi(w.y)}; } }
        f32x4 h[4]; float s = 0.f;
#pragma unroll
        for (int j = 0; j < 4; ++j) { const v2u hw = ((const v2u*)hrow)[lane + 64 * j]; h[j] = (f32x4){bflo(hw.x), bfhi(hw.x), bflo(hw.y), bfhi(hw.y)} + ((const f32x4*)gf)[lane + 64 * j] * y[j]; s += (h[j].x * h[j].x + h[j].y * h[j].y) + (h[j].z * h[j].z + h[j].w * h[j].w); }
        const float rs = 1.f / sqrtf(wave_sum(s) * (1.f / DM) + NORM_EPS);
        if (layer == 0) {
#pragma unroll
            for (int j = 0; j < 4; ++j) { v2u hw; hw.x = pk2(h[j].x, h[j].y); hw.y = pk2(h[j].z, h[j].w); ((v2u*)hrow)[lane + 64 * j] = hw; }
            const float* nw = F.in[I_NMIX] + DM; const float* sh = modp(F, 1, sel, 0); const float* sc = modp(F, 1, sel, 1);
            unsigned long long* o8 = (unsigned long long*)(wsp<bf16>(F, WS_A) + (size_t)row * DM) + lane;
#pragma unroll
            for (int j = 0; j < 4; ++j) { const f32x4 w = ((const f32x4*)nw)[lane + 64 * j], a = ((const f32x4*)sh)[lane + 64 * j], c = ((const f32x4*)sc)[lane + 64 * j];
                const f32x4 o = h[j] * rs * w * (c + 1.f) + a; o8[64 * j] = (unsigned long long)pk2(o.x, o.y) | ((unsigned long long)pk2(o.z, o.w) << 32); }
        } else {
            const int b = row / TB, t = row - b * TB;
            if (t >= CT) { float* orow = F.out + ((size_t)b * SEQ + (t - CT)) * DM; const float* nw = F.in[I_FNW];
#pragma unroll
                for (int j = 0; j < 4; ++j) ((f32x4*)orow)[lane + 64 * j] = h[j] * rs * ((const f32x4*)nw)[lane + 64 * j]; }
        }
    }
}
constexpr int PC_Q = 1920, PC_K = 2176, PC_V = 2432, PC_O = 2944, PC_G = 3456;
__device__ __forceinline__ float softplusf_(float y) { return fmaxf(y, 0.f) + __logf(1.f + __expf(-fabsf(y))); }
__device__ __forceinline__ float tanhf_(float x) { return 1.f - 2.f / (1.f + __expf(2.f * x)); }
__device__ __forceinline__ void lerp8(const bf16* p, bool hp, bool hn, int c0, const float* mu, float (&u)[8]) {
    const v4u z4 = {0u, 0u, 0u, 0u};
    const v4u wx = *(const v4u*)(p + c0), wp = hp ? *(const v4u*)(p - REC_NP + c0) : z4, wn = hn ? *(const v4u*)(p + REC_NP + c0) : z4;
    float x[8], xp[8], xn[8]; unpack8(wx, x); unpack8(wp, xp); unpack8(wn, xn);
    const f32x4 m0 = *(const f32x4*)(mu + c0), m1 = *(const f32x4*)(mu + c0 + 4);
#pragma unroll
    for (int e = 0; e < 8; ++e) { const float m = e < 4 ? m0[e & 3] : m1[e & 3]; u[e] = x[e] + m * (0.5f * (xp[e] + xn[e]) - x[e]); }
}
__device__ __forceinline__ void st8h(bf16* o, const float (&u)[8]) { v4u w; w.x = pk2(u[0], u[1]); w.y = pk2(u[2], u[3]); w.z = pk2(u[4], u[5]); w.w = pk2(u[6], u[7]); *(v4u*)o = w; }
__device__ __forceinline__ void st8f(float* o, const float (&u)[8]) { *(f32x4*)o = (f32x4){u[0], u[1], u[2], u[3]}; *(f32x4*)(o + 4) = (f32x4){u[4], u[5], u[6], u[7]}; }
__device__ __forceinline__ void l1_rwkv_prep(const Frame& F) {
    const int gw = F.blk * 8 + F.wave, NGW = F.G * 8, lane = F.lane; const float* mu = F.in[I_MU];
    for (int row = gw; row < R; row += NGW) {
        const int b = row / TB, t = row - b * TB; const bool hp = (t != 0 && t != CT), hn = (t != CT - 1 && t != TB - 1);
        const bf16* p = wsp<const bf16>(F, WS_P) + (size_t)row * REC_NP; const size_t ro = (size_t)row * 512 + 8 * lane;
        float u[8];
        lerp8(p, hp, hn, 8 * lane, mu, u); st8h(wsp<bf16>(F, WS_RR) + ro, u);
        lerp8(p, hp, hn, 1024 + 8 * lane, mu, u); st8h(wsp<bf16>(F, WS_VV) + ro, u);
        lerp8(p, hp, hn, 512 + 8 * lane, mu, u); st8h(wsp<bf16>(F, WS_KL) + ro, u);
        { const f32x4 k0 = *(const f32x4*)(F.in[I_KK] + 8 * lane), k1 = *(const f32x4*)(F.in[I_KK] + 8 * lane + 4); float ss = 0.f;
#pragma unroll
          for (int e = 0; e < 8; ++e) { u[e] *= (e < 4 ? k0[e & 3] : k1[e & 3]); ss += u[e] * u[e]; }
          ss += __shfl_xor(ss, 1); ss += __shfl_xor(ss, 2); ss += __shfl_xor(ss, 4);
          const float inv = -1.f / sqrtf(fmaxf(ss, 1e-24f));
#pragma unroll
          for (int e = 0; e < 8; ++e) u[e] *= inv;
          st8h(wsp<bf16>(F, WS_AKK) + ro, u); }
        if (lane < 48) { lerp8(p, hp, hn, 1536 + 8 * lane, mu, u);
#pragma unroll
            for (int e = 0; e < 8; ++e) u[e] = lane < 16 ? tanhf_(u[e]) : (lane < 32 ? u[e] : sigmoidf_(u[e]));
            v4u w; w.x = pk2(u[0], u[1]); w.y = pk2(u[2], u[3]); w.z = pk2(u[4], u[5]); w.w = pk2(u[6], u[7]);
            *(v4u*)(wsp<bf16>(F, WS_ALORA) + (size_t)row * 384 + 8 * lane) = w; }
    }
}
struct EpiLora {
    static constexpr bool PERM = true, AFTER_DRAIN = false;
    const Frame* F;
    template <int KIND> __device__ __forceinline__ void run(const pg8::f32x4 (&acc)[2][2][4][2], const pg8::Unit& u, int wr, int wc, int fr, int fq, int z) const {
#pragma unroll
        for (int ai = 0; ai < 2; ++ai)
#pragma unroll
            for (int m = 0; m < 4; ++m) { const int row = u.pm * 256 + ai * 128 + wr * 64 + m * 16 + fr;
#pragma unroll
                for (int bj = 0; bj < 2; ++bj) { const int c = ((u.pn & 1) * 256) + bj * 128 + wc * 32 + 8 * fq; const size_t ro = (size_t)row * 512 + c;
                    const pg8::f32x4 v0 = acc[ai][bj][m][0], v1 = acc[ai][bj][m][1]; const float x[8] = {v0[0], v0[1], v0[2], v0[3], v1[0], v1[1], v1[2], v1[3]}; float o[8];
                    if constexpr (KIND == 0) { const float* w0 = F->in[I_W0] + z * 512 + c;
#pragma unroll
                        for (int e = 0; e < 8; ++e) { const float wl = -softplusf_(-(w0[e] + x[e])) - 0.5f; o[e] = __expf(-__expf(wl)); }
                        st8f(wsp<float>(*F, WS_WDEC) + (size_t)z * R * 512 + ro, o); }
                    else if constexpr (KIND == 1) { const float* a0 = F->in[I_A0] + z * 512 + c;
#pragma unroll
                        for (int e = 0; e < 8; ++e) o[e] = sigmoidf_(a0[e] + x[e]);
                        st8h(wsp<bf16>(*F, WS_ASIG) + (size_t)z * R * 512 + ro, o); }
                    else st8h(wsp<bf16>(*F, WS_GG) + ro, x); } }
    }
    __device__ __forceinline__ void operator()(const pg8::f32x4 (&acc)[2][2][4][2], const pg8::Unit& u, int wr, int wc, int fr, int fq) const {
        const int part = u.pn >> 1;
        if (part < 2) run<0>(acc, u, wr, wc, fr, fq, part); else if (part < 4) run<1>(acc, u, wr, wc, fr, fq, part - 2); else run<2>(acc, u, wr, wc, fr, fq, 0);
    }
};
__device__ __forceinline__ void mlstm_gates(const Frame& F, int row, int z, int h, float& ig, float& lf) {
    const bf16* g = wsp<const bf16>(F, WS_P) + (size_t)row * REC_NP + PC_G + z * 8 + h; const float* gb = F.in[I_GATEB] + z * 8 + h;
    const float gi = bf2f(g[0]) + gb[0], gf = bf2f(g[4]) + gb[4];
    ig = 15.f * tanhf_(gi * (1.f / 15.f)); const float cf = 15.f * tanhf_(gf * (1.f / 15.f)); lf = fminf(cf, 0.f) - __logf(1.f + __expf(-fabsf(cf)));
}
__device__ __forceinline__ void mlstm_chunk_head(const Frame& F, int z, int b, int h, int c, LAS float* vec) {
    LAS int* rows = (LAS int*)vec;
    if (F.tid < 64) { const int s = F.tid, row = b * TB + scan_tok(z, 64 * c + s); float ig, lf; mlstm_gates(F, row, z, h, ig, lf); rows[s] = row; vec[64 + s] = ig; vec[192 + s] = lf; }
    __syncthreads();
    if (F.tid < 64) { float a = 0.f; for (int s = 0; s <= F.tid; ++s) a += vec[192 + s]; vec[128 + F.tid] = a; }
    __syncthreads();
}
__device__ __forceinline__ void l1_mlstm_b(const Frame& F) {
    const float* __restrict__ SC = wsp<const float>(F, WS_SC); const float* __restrict__ DC = wsp<const float>(F, WS_DC); float* __restrict__ CST = wsp<float>(F, WS_CST);
    const float* __restrict__ DN = wsp<const float>(F, WS_DN); float* __restrict__ NST = wsp<float>(F, WS_NST); float* __restrict__ MST = wsp<float>(F, WS_MST);
    for (int g = F.blk * 512 + F.tid; g < 16 * 8192; g += F.G * 512) {
        const int chain = g >> 13, el = g & 8191; float m = 0.f, C = 0.f, N = 0.f; const bool don = el < 64;
        for (int c0 = 0; c0 < 260; c0 += 10) {
            float dc[10], dn[10], bl[10], ml[10];
#pragma unroll
            for (int i = 0; i < 10; ++i) { const size_t u = (size_t)chain * 260 + c0 + i; dc[i] = DC[u * 8192 + el]; dn[i] = don ? DN[u * 64 + el] : 0.f; bl[i] = SC[2 * u]; ml[i] = SC[2 * u + 1]; }
#pragma unroll
            for (int i = 0; i < 10; ++i) { const size_t u = (size_t)chain * 260 + c0 + i;
                CST[u * 8192 + el] = C; if (don) NST[u * 64 + el] = N; if (el == 0) MST[u] = m;
                const float mn = fmaxf(bl[i] + m, ml[i]), cd = __expf(bl[i] + m - mn), inj = __expf(ml[i] - mn);
                C = cd * C + inj * dc[i]; N = cd * N + inj * dn[i]; m = mn; }
        }
    }
}
__device__ __forceinline__ void l1_rec_out(const Frame& F) {
    const int gw = F.blk * 8 + F.wave, NGW = F.G * 8, lane = F.lane, c0 = 8 * lane;
    for (int row = gw; row < R; row += NGW) {
        const size_t ro = (size_t)row * 512 + c0; bf16* a1 = wsp<bf16>(F, WS_A1) + (size_t)row * DM;
        { float y0[8], y1[8], y[8]; float s = 0.f; unpack8(*(const v4u*)(wsp<const bf16>(F, WS_YR) + ro), y0); unpack8(*(const v4u*)(wsp<const bf16>(F, WS_YR) + (size_t)R * 512 + ro), y1);
          const float* y2 = wsp<const float>(F, WS_YB) + ro; const float* y3 = y2 + (size_t)R * 512;
#pragma unroll
          for (int e = 0; e < 8; ++e) { y[e] = (y0[e] + y1[e]) + (y2[e] + y3[e]); s += y[e]; }
          s += __shfl_xor(s, 1); s += __shfl_xor(s, 2); s += __shfl_xor(s, 4); const float mean = s * (1.f / 64.f); float q = 0.f;
#pragma unroll
          for (int e = 0; e < 8; ++e) { y[e] -= mean; q += y[e] * y[e]; }
          q += __shfl_xor(q, 1); q += __shfl_xor(q, 2); q += __shfl_xor(q, 4); const float rstd = 1.f / sqrtf(q * (1.f / 64.f) + 64e-5f);
          float rr[8], kl[8], s0[8], s1[8], vv[8], gg[8]; unpack8(*(const v4u*)(wsp<const bf16>(F, WS_RR) + ro), rr); unpack8(*(const v4u*)(wsp<const bf16>(F, WS_KL) + ro), kl);
          unpack8(*(const v4u*)(wsp<const bf16>(F, WS_ASIG) + ro), s0); unpack8(*(const v4u*)(wsp<const bf16>(F, WS_ASIG) + (size_t)R * 512 + ro), s1);
          unpack8(*(const v4u*)(wsp<const bf16>(F, WS_VV) + ro), vv); unpack8(*(const v4u*)(wsp<const bf16>(F, WS_GG) + ro), gg);
          const float* rk = F.in[I_RK] + c0; const float* ka = F.in[I_KA] + c0; float bs = 0.f;
#pragma unroll
          for (int e = 0; e < 8; ++e) bs += rr[e] * kl[e] * (2.f + (s0[e] + s1[e] - 2.f) * ka[e]) * rk[e];
          bs += __shfl_xor(bs, 1); bs += __shfl_xor(bs, 2); bs += __shfl_xor(bs, 4);
          const float* lw = F.in[I_LNW] + c0; const float* lb = F.in[I_LNB] + c0; float o[8];
#pragma unroll
          for (int e = 0; e < 8; ++e) o[e] = (y[e] * rstd * lw[e] + lb[e] + bs * vv[e]) * gg[e];
          v4u w; w.x = pk2(o[0], o[1]); w.y = pk2(o[2], o[3]); w.z = pk2(o[4], o[5]); w.w = pk2(o[6], o[7]); *(v4u*)(a1 + c0) = w; }
        { float h0[8], h1[8], x[8]; float q = 0.f; unpack8(*(const v4u*)(wsp<const bf16>(F, WS_HM) + ro), h0); unpack8(*(const v4u*)(wsp<const bf16>(F, WS_HM) + (size_t)R * 512 + ro), h1);
#pragma unroll
          for (int e = 0; e < 8; ++e) { x[e] = h0[e] + h1[e]; q += x[e] * x[e]; }
          q += __shfl_xor(q, 1); q += __shfl_xor(q, 2); q += __shfl_xor(q, 4); q += __shfl_xor(q, 8); const float rs = 1.f / sqrtf(q * (1.f / 128.f) + NORM_EPS);
          float og[8]; unpack8(*(const v4u*)(wsp<const bf16>(F, WS_P) + (size_t)row * REC_NP + PC_O + c0), og); const float* nw = F.in[I_MNW] + c0; float o[8];
#pragma unroll
          for (int e = 0; e < 8; ++e) o[e] = x[e] * rs * nw[e] * sigmoidf_(og[e]);
          v4u w; w.x = pk2(o[0], o[1]); w.y = pk2(o[2], o[3]); w.z = pk2(o[4], o[5]); w.w = pk2(o[6], o[7]); *(v4u*)(a1 + 512 + c0) = w; }
    }
}
#ifndef NEU_ROUNDS
#define NEU_ROUNDS 6
#endif
namespace rk {
constexpr int LS = 72;
constexpr int MB = 64 * LS * 2;
struct Acc2 { pg8::f32x4 t0, t1; };
__device__ __forceinline__ void zero(Acc2& a) { a.t0 = (pg8::f32x4){0.f, 0.f, 0.f, 0.f}; a.t1 = a.t0; }
__device__ __forceinline__ void mm_acc(Acc2& acc, const LAS bf16* A, const LAS bf16* Bt, int wave, int lane) {
    const int tm = wave >> 1, tn0 = (wave & 1) * 2, lr = lane & 15, kq = (lane >> 4) * 8;
    const LAS bf16* ap = A + (tm * 16 + lr) * LS + kq; const LAS bf16* bp0 = Bt + (tn0 * 16 + lr) * LS + kq; const LAS bf16* bp1 = bp0 + 16 * LS;
    const bf16x8 a0 = *(const LAS bf16x8*)ap, a1 = *(const LAS bf16x8*)(ap + 32);
    const bf16x8 b00 = *(const LAS bf16x8*)bp0, b01 = *(const LAS bf16x8*)(bp0 + 32), b10 = *(const LAS bf16x8*)bp1, b11 = *(const LAS bf16x8*)(bp1 + 32);
    acc.t0 = __builtin_amdgcn_mfma_f32_16x16x32_bf16(a0, b00, acc.t0, 0, 0, 0); acc.t0 = __builtin_amdgcn_mfma_f32_16x16x32_bf16(a1, b01, acc.t0, 0, 0, 0);
    acc.t1 = __builtin_amdgcn_mfma_f32_16x16x32_bf16(a0, b10, acc.t1, 0, 0, 0); acc.t1 = __builtin_amdgcn_mfma_f32_16x16x32_bf16(a1, b11, acc.t1, 0, 0, 0);
}
template <class Fn> __device__ __forceinline__ void each(const Acc2& acc, int wave, int lane, Fn fn) {
    const int m0 = (wave >> 1) * 16 + (lane >> 4) * 4, n0 = (wave & 1) * 32 + (lane & 15);
#pragma unroll
    for (int r = 0; r < 4; ++r) { fn(m0 + r, n0, acc.t0[r]); fn(m0 + r, n0 + 16, acc.t1[r]); }
}
__device__ __forceinline__ void stb(LAS bf16* M, int m, int n, float v) { M[m * LS + n] = (bf16)f2bf(v); }
__device__ __forceinline__ void st_tr(LAS bf16* M, const Acc2& acc, int wave, int lane) {
    const int m0 = (wave >> 1) * 16 + (lane >> 4) * 4, n0 = (wave & 1) * 32 + (lane & 15);
    v2u a, b; a.x = pk2(acc.t0[0], acc.t0[1]); a.y = pk2(acc.t0[2], acc.t0[3]); b.x = pk2(acc.t1[0], acc.t1[1]); b.y = pk2(acc.t1[2], acc.t1[3]);
    *(LAS v2u*)(M + n0 * LS + m0) = a; *(LAS v2u*)(M + (n0 + 16) * LS + m0) = b;
}
}
__device__ __forceinline__ void l1_rk_phase_a(const Frame& F) {
    using namespace rk;
    LAS unsigned char* L = F.lds;
    LAS bf16* Rt = (LAS bf16*)(L + 0 * MB); LAS bf16* At = (LAS bf16*)(L + 1 * MB); LAS bf16* AtT = (LAS bf16*)(L + 2 * MB); LAS bf16* Bq = (LAS bf16*)(L + 3 * MB); LAS bf16* Kq = (LAS bf16*)(L + 4 * MB);
    LAS bf16* VT = (LAS bf16*)(L + 5 * MB); LAS bf16* BhT = (LAS bf16*)(L + 6 * MB); LAS bf16* KhT = (LAS bf16*)(L + 7 * MB);
    LAS bf16* AK = (LAS bf16*)(L + 8 * MB); LAS bf16* RB = (LAS bf16*)(L + 9 * MB); LAS bf16* RK = (LAS bf16*)(L + 10 * MB);
    LAS bf16* X = (LAS bf16*)(L + 11 * MB); LAS bf16* XT = (LAS bf16*)(L + 12 * MB); LAS bf16* P = (LAS bf16*)(L + 13 * MB);
    LAS bf16* AkVT = Bq; LAS bf16* ApT = Kq; LAS bf16* W2T = X;
    LAS float* G = (LAS float*)(L + 8 * MB);
    LAS float* gl = (LAS float*)(L + 14 * MB);
    const int w = F.wave, lane = F.lane, tid = F.tid;
    const int t = lane, j0 = 8 * w;
    float fr[8], fv[8], fa[8], fw[8], fk[8], fb[8];
#define RK_LOAD(u_) do { const int ch_ = (u_) / 260, c_ = (u_) - ch_ * 260, z_ = ch_ >> 4, b_ = (ch_ >> 3) & 1, h_ = ch_ & 7; const size_t ro = ((size_t)b_ * TB + scan_tok(z_, 64 * c_ + t)) * 512 + h_ * 64 + j0; \
    const v4u xr_ = *(const v4u*)(wsp<const bf16>(F, WS_RR) + ro), xv_ = *(const v4u*)(wsp<const bf16>(F, WS_VV) + ro), xa_ = *(const v4u*)(wsp<const bf16>(F, WS_AKK) + ro), xk_ = *(const v4u*)(wsp<const bf16>(F, WS_KL) + ro), \
              xs_ = *(const v4u*)(wsp<const bf16>(F, WS_ASIG) + (size_t)z_ * R * 512 + ro); const float* p3 = wsp<const float>(F, WS_WDEC) + (size_t)z_ * R * 512 + ro; const float* pk_ = F.in[I_KA] + h_ * 64 + j0; \
    const f32x4 w0_ = *(const f32x4*)p3, w1_ = *(const f32x4*)(p3 + 4), q0_ = *(const f32x4*)pk_, q1_ = *(const f32x4*)(pk_ + 4); float sg_[8], kl_[8]; \
    unpack8(xr_, fr); unpack8(xv_, fv); unpack8(xa_, fa); unpack8(xk_, kl_); unpack8(xs_, sg_); \
    _Pragma("unroll") for (int e = 0; e < 8; ++e) { const float kav = e < 4 ? q0_[e & 3] : q1_[e & 3]; fw[e] = e < 4 ? w0_[e & 3] : w1_[e & 3]; fk[e] = kl_[e] * (1.f + (sg_[e] - 1.f) * kav); fb[e] = -fa[e] * sg_[e]; } } while (0)
    if (F.blk < NUNIT_R) RK_LOAD(F.blk);
    for (int u = F.blk; u < NUNIT_R; u += F.G) {
        const int chain = u / 260, c = u - chain * 260, z = chain >> 4, b = (chain >> 3) & 1, h = chain & 7;
        __syncthreads();
#pragma unroll
        for (int e = 0; e < 8; ++e) G[t * 65 + j0 + e] = fw[e];
        __syncthreads();
        if (tid < 64) { float g = 1.f;
#pragma unroll 16
            for (int s = 0; s < 64; ++s) { g *= G[s * 65 + tid]; G[s * 65 + tid] = g; } gl[tid] = g; }
        __syncthreads();
#pragma unroll
        for (int e = 0; e < 8; ++e) { const int j = j0 + e; const float gt = G[t * 65 + j], gp = t > 0 ? G[(t - 1) * 65 + j] : 1.f, gL = G[63 * 65 + j], ig = 1.f / gt;
            fr[e] *= gt; fa[e] *= gp; const float bq = fb[e] * ig, kq = fk[e] * ig; fb[e] = bq; fk[e] = kq; fw[e] = gL; }
        __syncthreads();
        { v4u q; q.x = pk2(fr[0], fr[1]); q.y = pk2(fr[2], fr[3]); q.z = pk2(fr[4], fr[5]); q.w = pk2(fr[6], fr[7]); *(LAS v4u*)(Rt + t * LS + j0) = q;
          q.x = pk2(fa[0], fa[1]); q.y = pk2(fa[2], fa[3]); q.z = pk2(fa[4], fa[5]); q.w = pk2(fa[6], fa[7]); *(LAS v4u*)(At + t * LS + j0) = q;
          q.x = pk2(fb[0], fb[1]); q.y = pk2(fb[2], fb[3]); q.z = pk2(fb[4], fb[5]); q.w = pk2(fb[6], fb[7]); *(LAS v4u*)(Bq + t * LS + j0) = q;
          q.x = pk2(fk[0], fk[1]); q.y = pk2(fk[2], fk[3]); q.z = pk2(fk[4], fk[5]); q.w = pk2(fk[6], fk[7]); *(LAS v4u*)(Kq + t * LS + j0) = q; }
#pragma unroll
        for (int e = 0; e < 8; ++e) { const int j = j0 + e; stb(AtT, j, t, fa[e]); stb(VT, j, t, fv[e]); stb(BhT, j, t, fb[e] * fw[e]); stb(KhT, j, t, fk[e] * fw[e]); }
        __syncthreads();
        if (u + F.G < NUNIT_R) RK_LOAD(u + F.G);
        Acc2 a1, a2, a3, a4;
        zero(a1); mm_acc(a1, At, Bq, w, lane); zero(a2); mm_acc(a2, At, Kq, w, lane); zero(a3); mm_acc(a3, Rt, Bq, w, lane); zero(a4); mm_acc(a4, Rt, Kq, w, lane);
        each(a1, w, lane, [&](int m, int n, float v) { const float x = n < m ? v : 0.f; stb(X, m, n, x); stb(XT, n, m, x); stb(P, m, n, m == n ? 1.f : 0.f); });
        each(a2, w, lane, [&](int m, int n, float v) { stb(AK, m, n, n < m ? v : 0.f); });
        each(a3, w, lane, [&](int m, int n, float v) { stb(RB, m, n, n <= m ? v : 0.f); });
        each(a4, w, lane, [&](int m, int n, float v) { stb(RK, m, n, n <= m ? v : 0.f); });
        __syncthreads();
        { const int m0 = (w >> 1) * 16 + (lane >> 4) * 4, n0 = (w & 1) * 32 + (lane & 15);
          Acc2 pt;
#pragma unroll
          for (int r = 0; r < 4; ++r) { pt.t0[r] = (m0 + r == n0) ? 1.f : 0.f; pt.t1[r] = (m0 + r == n0 + 16) ? 1.f : 0.f; }
#pragma unroll 1
          for (int i = 0; i < NEU_ROUNDS; ++i) {
            mm_acc(pt, P, XT, w, lane);
            if (i < NEU_ROUNDS - 1) { zero(a1); mm_acc(a1, X, XT, w, lane); }
            __syncthreads();
#pragma unroll
            for (int r = 0; r < 4; ++r) { stb(P, m0 + r, n0, pt.t0[r]); stb(P, m0 + r, n0 + 16, pt.t1[r]); }
            if (i < NEU_ROUNDS - 1) { each(a1, w, lane, [&](int m, int n, float v) { stb(X, m, n, v); }); st_tr(XT, a1, w, lane); }
            __syncthreads();
          } }
        zero(a1); mm_acc(a1, AK, VT, w, lane); zero(a2); mm_acc(a2, P, AtT, w, lane);
        st_tr(AkVT, a1, w, lane); st_tr(ApT, a2, w, lane);
        __syncthreads();
        zero(a3); mm_acc(a3, P, AkVT, w, lane);
        st_tr(W2T, a3, w, lane);
        __syncthreads();
        zero(a1); mm_acc(a1, RB, ApT, w, lane); zero(a2); mm_acc(a2, RB, W2T, w, lane); mm_acc(a2, RK, VT, w, lane);
        zero(a3); mm_acc(a3, BhT, ApT, w, lane); zero(a4); mm_acc(a4, BhT, W2T, w, lane); mm_acc(a4, KhT, VT, w, lane);
        __syncthreads();
        { LAS bf16* O1 = At; LAS bf16* O2 = AtT; LAS bf16* O3 = AK; LAS float* OY = (LAS float*)X;
          each(a1, w, lane, [&](int m, int n, float v) { stb(O1, m, n, v + bf2f(Rt[m * LS + n])); });
          each(a3, w, lane, [&](int m, int n, float v) { stb(O2, m, n, v + (m == n ? gl[m] : 0.f)); });
          each(a4, w, lane, [&](int m, int n, float v) { stb(O3, m, n, v); });
          each(a2, w, lane, [&](int m, int n, float v) { OY[m * 68 + n] = v; });
          __syncthreads();
          const int row = tid >> 3, c8 = (tid & 7) * 8;
          *(v4u*)(wsp<bf16>(F, WS_RKQ) + (size_t)u * 4096 + row * 64 + c8) = *(const LAS v4u*)(O1 + row * LS + c8);
          *(v4u*)(wsp<bf16>(F, WS_RKM) + (size_t)u * 4096 + row * 64 + c8) = *(const LAS v4u*)(O2 + row * LS + c8);
          *(v4u*)(wsp<bf16>(F, WS_RKZ) + (size_t)u * 4096 + row * 64 + c8) = *(const LAS v4u*)(O3 + row * LS + c8);
          bf16* Yg = wsp<bf16>(F, WS_YR) + (size_t)z * R * 512 + h * 64;
#pragma unroll
          for (int i = 0; i < 2; ++i) { const int yr = (tid >> 4) + 32 * i, c4 = (tid & 15) * 4; const f32x4 yv = *(const LAS f32x4*)(OY + yr * 68 + c4); v2u yw; yw.x = pk2(yv.x, yv.y); yw.y = pk2(yv.z, yv.w);
              *(v2u*)(Yg + ((size_t)b * TB + scan_tok(z, 64 * c + yr)) * 512 + c4) = yw; } }
    }
#undef RK_LOAD
}
__device__ __forceinline__ void l1_rk_phase_b(const Frame& F) {
    using namespace rk;
    LAS unsigned char* L = F.lds;
    const int w = F.wave, lane = F.lane, tid = F.tid, chain = F.blk, z = chain >> 4, b = (chain >> 3) & 1, h = chain & 7;
    for (int i = tid; i < 2 * 64 * LS; i += 512) ((LAS bf16*)L)[i] = 0;
    const int sr = tid >> 3, sc = (tid & 7) * 8;
    v4u gm, gq, gz;
#define RKB_LOAD(u_) do { gm = *(const v4u*)(wsp<const bf16>(F, WS_RKM) + (u_) * 4096 + sr * 64 + sc); gq = *(const v4u*)(wsp<const bf16>(F, WS_RKQ) + (u_) * 4096 + sr * 64 + sc); \
    gz = *(const v4u*)(wsp<const bf16>(F, WS_RKZ) + (u_) * 4096 + sr * 64 + sc); } while (0)
#define RKB_WRITE(par) do { *(LAS v4u*)((LAS bf16*)(L + (2 + 3 * (par)) * MB) + sr * LS + sc) = gm; *(LAS v4u*)((LAS bf16*)(L + (3 + 3 * (par)) * MB) + sr * LS + sc) = gq; \
    *(LAS v4u*)((LAS bf16*)(L + (4 + 3 * (par)) * MB) + sr * LS + sc) = gz; } while (0)
    RKB_LOAD((size_t)chain * 260); RKB_WRITE(0);
    __syncthreads();
    float* Yg = wsp<float>(F, WS_YB) + (size_t)z * R * 512 + h * 64;
    const int m0 = (w >> 1) * 16 + (lane >> 4) * 4, n0 = (w & 1) * 32 + (lane & 15);
    for (int c = 0; c < 260; ++c) {
        const size_t u = (size_t)chain * 260 + c; const int par = c & 1;
        if (c + 1 < 260) RKB_LOAD(u + 1);
        const LAS bf16* S = (const LAS bf16*)(L + par * MB); LAS bf16* Sn = (LAS bf16*)(L + (par ^ 1) * MB);
        const LAS bf16* Mt = (const LAS bf16*)(L + (2 + 3 * par) * MB); const LAS bf16* Qp = (const LAS bf16*)(L + (3 + 3 * par) * MB); const LAS bf16* Zt = (const LAS bf16*)(L + (4 + 3 * par) * MB);
        Acc2 a1, a2;
#pragma unroll
        for (int r = 0; r < 4; ++r) { a1.t0[r] = bf2f(Zt[(m0 + r) * LS + n0]); a1.t1[r] = bf2f(Zt[(m0 + r) * LS + n0 + 16]); }
        mm_acc(a1, Mt, S, w, lane); zero(a2); mm_acc(a2, Qp, S, w, lane);
        st_tr(Sn, a1, w, lane);
        if (c + 1 < 260) RKB_WRITE(par ^ 1);
#pragma unroll
        for (int r = 0; r < 4; ++r) { const size_t yo = ((size_t)b * TB + scan_tok(z, 64 * c + m0 + r)) * 512 + n0; Yg[yo] = a2.t0[r]; Yg[yo + 16] = a2.t1[r]; }
        __syncthreads();
    }
#undef RKB_LOAD
#undef RKB_WRITE
}
__device__ __forceinline__ void l1_mlstm_a2(const Frame& F) {
    using namespace rk;
    LAS bf16* KT = (LAS bf16*)F.lds; LAS bf16* VsT = KT + 64 * LS;
    LAS float* vec = (LAS float*)(F.lds + AUX_OFF); LAS int* rows = (LAS int*)vec;
    const bf16* Pg = wsp<const bf16>(F, WS_P); const int tid = F.tid, w = F.wave, lane = F.lane;
    for (int u = F.blk; u < NUNIT_M; u += F.G) {
        const int cidx = u / 260, c = u - cidx * 260, z = cidx >> 3, b = (cidx >> 2) & 1, h = cidx & 3;
        mlstm_chunk_head(F, z, b, h, c, vec);
        if (tid < 64) { const float bl = vec[128 + 63]; const float uu = bl - vec[128 + tid] + vec[64 + tid]; float m = uu;
#pragma unroll
            for (int o = 1; o < 64; o <<= 1) m = fmaxf(m, __shfl_xor(m, o));
            vec[256 + tid] = __expf(uu - m);
            if (tid == 0) { wsp<float>(F, WS_SC)[2 * u] = bl; wsp<float>(F, WS_SC)[2 * u + 1] = m; } }
        __syncthreads();
        { const int s = tid >> 3, c8 = tid & 7; float x[8]; unpack8(*(const v4u*)(Pg + (size_t)rows[s] * REC_NP + PC_K + h * 64 + 8 * c8), x);
#pragma unroll
          for (int e = 0; e < 8; ++e) stb(KT, 8 * c8 + e, s, x[e]); }
#pragma unroll
        for (int i = 0; i < 2; ++i) { const int s = (tid >> 4) + 32 * i, c8 = tid & 15; float x[8]; unpack8(*(const v4u*)(Pg + (size_t)rows[s] * REC_NP + PC_V + h * 128 + 8 * c8), x); const float sw = vec[256 + s];
#pragma unroll
            for (int e = 0; e < 8; ++e) stb(VsT, 8 * c8 + e, s, x[e] * sw); }
        __syncthreads();
        Acc2 a0, a1; zero(a0); mm_acc(a0, VsT, KT, w, lane); zero(a1); mm_acc(a1, VsT + 64 * LS, KT, w, lane);
        float* dc = wsp<float>(F, WS_DC) + (size_t)u * 8192;
        each(a0, w, lane, [&](int m, int n, float v) { dc[m * 64 + n] = 0.125f * v; });
        each(a1, w, lane, [&](int m, int n, float v) { dc[(64 + m) * 64 + n] = 0.125f * v; });
        if (tid < 64) { float a = 0.f; for (int s = 0; s < 64; ++s) a += vec[256 + s] * bf2f(KT[tid * LS + s]); wsp<float>(F, WS_DN)[(size_t)u * 64 + tid] = 0.125f * a; }
        __syncthreads();
    }
}
__device__ __forceinline__ void l1_mlstm_c2(const Frame& F, int first_blk, int nblk) {
    using namespace rk;
    LAS bf16* Q = (LAS bf16*)F.lds; LAS bf16* K = Q + 64 * LS; LAS bf16* VT = K + 64 * LS; LAS bf16* Cm = VT + 128 * LS; LAS bf16* Pm = Cm + 128 * LS;
    LAS float* OH = (LAS float*)(F.lds + 7 * MB);
    LAS float* vec = (LAS float*)(F.lds + AUX_OFF); LAS int* rows = (LAS int*)vec;
    const bf16* Pg = wsp<const bf16>(F, WS_P); const int tid = F.tid, w = F.wave, lane = F.lane;
    for (int u = F.blk - first_blk; u < NUNIT_M; u += nblk) {
        const int cidx = u / 260, c = u - cidx * 260, z = cidx >> 3, b = (cidx >> 2) & 1, h = cidx & 3;
        mlstm_chunk_head(F, z, b, h, c, vec);
        const float mst = wsp<const float>(F, WS_MST)[u];
        if (tid < 64) { const int t = tid; float pm = -3.0e38f; for (int s = 0; s <= t; ++s) pm = fmaxf(pm, vec[64 + s] - vec[128 + s]);
            const float gi = vec[128 + t] + mst, mo = fmaxf(gi, vec[128 + t] + pm); vec[320 + t] = __expf(gi - mo); vec[384 + t] = mo;
            vec[256 + t] = wsp<const float>(F, WS_NST)[(size_t)u * 64 + t]; }
        { const int t = tid >> 3, c8 = tid & 7;
          *(LAS v4u*)(Q + t * LS + 8 * c8) = *(const v4u*)(Pg + (size_t)rows[t] * REC_NP + PC_Q + h * 64 + 8 * c8);
          *(LAS v4u*)(K + t * LS + 8 * c8) = *(const v4u*)(Pg + (size_t)rows[t] * REC_NP + PC_K + h * 64 + 8 * c8); }
#pragma unroll
        for (int i = 0; i < 2; ++i) { const int s = (tid >> 4) + 32 * i, c8 = tid & 15; const v4u wv = *(const v4u*)(Pg + (size_t)rows[s] * REC_NP + PC_V + h * 128 + 8 * c8);
            const unsigned ww[4] = {wv.x, wv.y, wv.z, wv.w};
#pragma unroll
            for (int e = 0; e < 4; ++e) { VT[(8 * c8 + 2 * e) * LS + s] = (bf16)(ww[e] & 0xffffu); VT[(8 * c8 + 2 * e + 1) * LS + s] = (bf16)(ww[e] >> 16); } }
        { const int v = tid >> 2, dq = (tid & 3) * 16; const f32x4* src = (const f32x4*)(wsp<const float>(F, WS_CST) + (size_t)u * 8192 + v * 64 + dq);
          const f32x4 x0 = src[0], x1 = src[1], x2 = src[2], x3 = src[3]; v4u o0, o1;
          o0.x = pk2(x0.x, x0.y); o0.y = pk2(x0.z, x0.w); o0.z = pk2(x1.x, x1.y); o0.w = pk2(x1.z, x1.w); o1.x = pk2(x2.x, x2.y); o1.y = pk2(x2.z, x2.w); o1.z = pk2(x3.x, x3.y); o1.w = pk2(x3.z, x3.w);
          *(LAS v4u*)(Cm + v * LS + dq) = o0; *(LAS v4u*)(Cm + v * LS + dq + 8) = o1; }
        __syncthreads();
        Acc2 aq, c0, c1; zero(aq); mm_acc(aq, Q, K, w, lane); zero(c0); mm_acc(c0, Q, Cm, w, lane); zero(c1); mm_acc(c1, Q, Cm + 64 * LS, w, lane);
        each(aq, w, lane, [&](int t, int s, float v) { stb(Pm, t, s, s <= t ? 0.125f * v * __expf(vec[128 + t] + (vec[64 + s] - vec[128 + s]) - vec[384 + t]) : 0.f); });
        __syncthreads();
        Acc2 p0, p1; zero(p0); mm_acc(p0, Pm, VT, w, lane); zero(p1); mm_acc(p1, Pm, VT + 64 * LS, w, lane);
        if (tid < 64) { const int t = tid; float rs = 0.f, nq = 0.f;
            for (int s = 0; s < 64; ++s) { rs += bf2f(Pm[t * LS + s]); nq += vec[256 + s] * bf2f(Q[t * LS + s]); }
            const float den = vec[320 + t] * nq + rs; vec[448 + t] = 1.f / fmaxf(fabsf(den), __expf(-vec[384 + t])); }
        __syncthreads();
        { const int m0 = (w >> 1) * 16 + (lane >> 4) * 4, n0 = (w & 1) * 32 + (lane & 15);
#pragma unroll
          for (int r = 0; r < 4; ++r) { const int t = m0 + r; const float g = vec[320 + t], idn = vec[448 + t];
              OH[t * 132 + n0] = (g * c0.t0[r] + p0.t0[r]) * idn; OH[t * 132 + n0 + 16] = (g * c0.t1[r] + p0.t1[r]) * idn;
              OH[t * 132 + 64 + n0] = (g * c1.t0[r] + p1.t0[r]) * idn; OH[t * 132 + 64 + n0 + 16] = (g * c1.t1[r] + p1.t1[r]) * idn; } }
        __syncthreads();
#pragma unroll
        for (int i = 0; i < 4; ++i) { const int it = tid + 512 * i, t = it >> 5, c4 = (it & 31) * 4;
            const f32x4 hv = *(const LAS f32x4*)(OH + t * 132 + c4); v2u hw; hw.x = pk2(hv.x, hv.y); hw.y = pk2(hv.z, hv.w);
            *(v2u*)(wsp<bf16>(F, WS_HM) + ((size_t)z * R + rows[t]) * 512 + h * 128 + c4) = hw; }
        __syncthreads();
    }
}
#ifndef MK_PER_PHASE
#define MK_PER_PHASE 0
#endif
constexpr int NPHASE = 26;
struct Args { const float* in[N_IN]; float* out; unsigned char* ws; int ph_lo, ph_hi, li, pad; };
#define GEMM_CALL(FnT, SchedT, g, S, fn) do { pg8::EpiGen<FnT> E_{fn}; { int k_ = g.K; asm volatile("" : "+s"(k_)); g.K = k_; } pg8::gemm_phase<pg8::EpiGen<FnT>, SchedT, true, true>((PG8_LAS unsigned char*)F.lds, g, S, E_); } while (0)
#ifndef SITE_MASK
#define SITE_MASK 0xFFFFFFFFull
#endif
#define SITE(s) (((SITE_MASK) >> (s)) & 1ull)
#ifndef DUP_MASK
#define DUP_MASK 0ull
#endif
#define NREP(s) ((((DUP_MASK) >> (s)) & 1ull) ? 2 : 1)
#define IN(k) (lo <= (k) && (k) < hi)
#define SEAM(k) do { if (IN(k) && IN((k) + 1)) xcd_barrier(bar); } while (0)
template <int LAYER> __device__ __forceinline__ void layer_phases(const Frame& F, const XcdBarrier& bar, const int lo, const int hi) {
    constexpr int layer = LAYER; constexpr int pb = 2 + 12 * LAYER;
        if (SITE(2) && IN(pb + 0)) { for (int rep_ = 0; rep_ < NREP(2); ++rep_) {
            const int N = layer == 0 ? ATT_NP : REC_NP;
            pg8::Gemm g{wsp<const bf16>(F, WS_A), layer == 0 ? wsp<const bf16>(F, WS_WIN0) : wsp<const bf16>(F, WS_WREC), R, N, 1024};
            pg8::StaticOrder S; S.init(R, N, F.G, F.blk);
            GEMM_CALL(FnStoreBf16, pg8::StaticOrder, g, S, (FnStoreBf16{wsp<bf16>(F, WS_P), N}));
             if (rep_ + 1 < NREP(2)) xcd_barrier(bar); } SEAM(pb + 0);
        }
        if constexpr (LAYER == 0) {
            if (SITE(3) && IN(pb + 1)) { for (int rep_ = 0; rep_ < NREP(3); ++rep_) { l0_post_proj(F);  if (rep_ + 1 < NREP(3)) xcd_barrier(bar); } SEAM(pb + 1); }
            if (SITE(4) && IN(pb + 2)) { for (int rep_ = 0; rep_ < NREP(4); ++rep_) {
                pg8::Gemm g{wsp<const bf16>(F, WS_CQN), wsp<const bf16>(F, WS_WUQ), R, 768, 384}; pg8::StaticOrder S; S.init(R, 768, F.G, F.blk);
                GEMM_CALL(FnStoreBf16, pg8::StaticOrder, g, S, (FnStoreBf16{wsp<bf16>(F, WS_MQ), 768}));
                 if (rep_ + 1 < NREP(4)) xcd_barrier(bar); } SEAM(pb + 2);
            }
            if (SITE(5) && IN(pb + 3)) { for (int rep_ = 0; rep_ < NREP(5); ++rep_) {
                pg8::Gemm g{wsp<const bf16>(F, WS_CKVN), wsp<const bf16>(F, WS_WUKV), R, 1024, 256}; pg8::StaticOrder S; S.init(R, 1024, F.G, F.blk);
                GEMM_CALL(FnStoreBf16, pg8::StaticOrder, g, S, (FnStoreBf16{wsp<bf16>(F, WS_MKV), 1024}));
                l0_mq_rope(F);
                 if (rep_ + 1 < NREP(5)) xcd_barrier(bar); } SEAM(pb + 3);
            }
            if (SITE(6) && IN(pb + 4)) { for (int rep_ = 0; rep_ < NREP(6); ++rep_) { l0_attention(F);  if (rep_ + 1 < NREP(6)) xcd_barrier(bar); } SEAM(pb + 4); }
            if (SITE(7) && IN(pb + 5)) { for (int rep_ = 0; rep_ < NREP(7); ++rep_) { l0_combine(F);  if (rep_ + 1 < NREP(7)) xcd_barrier(bar); } SEAM(pb + 5); }
        } else {
            if (SITE(8) && IN(pb + 1)) { for (int rep_ = 0; rep_ < NREP(8); ++rep_) { l1_rwkv_prep(F); l1_mlstm_a2(F);  if (rep_ + 1 < NREP(8)) xcd_barrier(bar); } SEAM(pb + 1); }
            if (SITE(9) && IN(pb + 2)) { for (int rep_ = 0; rep_ < NREP(9); ++rep_) {
                pg8::Gemm g{wsp<const bf16>(F, WS_ALORA), wsp<const bf16>(F, WS_WLORA), R, 2560, 384}; pg8::StaticOrder S; S.init(R, 2560, F.G, F.blk);
                { int k_ = g.K; asm volatile("" : "+s"(k_)); g.K = k_; EpiLora E_{&F}; pg8::gemm_phase<EpiLora, pg8::StaticOrder, true, true>((PG8_LAS unsigned char*)F.lds, g, S, E_); }
                l1_mlstm_b(F);
                 if (rep_ + 1 < NREP(9)) xcd_barrier(bar); } SEAM(pb + 2);
            }
            if (SITE(18) && IN(pb + 3)) { for (int rep_ = 0; rep_ < NREP(18); ++rep_) { l1_rk_phase_a(F); if (rep_ + 1 < NREP(18)) xcd_barrier(bar); } SEAM(pb + 3); }
            if (SITE(10) && IN(pb + 4)) { for (int rep_ = 0; rep_ < NREP(10); ++rep_) {
                if (F.G > 32) { if (F.blk < 32) l1_rk_phase_b(F); else { l1_mlstm_c2(F, 32, F.G - 32); moe_weights_convert(F, 1, (F.blk - 32) * 8 + F.wave, (F.G - 32) * 8); } }
                 if (rep_ + 1 < NREP(10)) xcd_barrier(bar); } SEAM(pb + 4);
            }
            if (SITE(11) && IN(pb + 5)) { for (int rep_ = 0; rep_ < NREP(11); ++rep_) { l1_rec_out(F);  if (rep_ + 1 < NREP(11)) xcd_barrier(bar); } SEAM(pb + 5); }
        }
        if (SITE(12) && IN(pb + 6)) { for (int rep_ = 0; rep_ < NREP(12); ++rep_) {
            pg8::Gemm g{wsp<const bf16>(F, WS_A1), wsp<const bf16>(F, WS_WOUT) + (size_t)layer * 1024 * 1024, R, 1024, 1024};
            if constexpr (LAYER == 0) { pg8::StaticOrder S; S.init(R, 1024, F.G, F.blk); GEMM_CALL(FnWout, pg8::StaticOrder, g, S, (FnWout{&F, layer})); }
            else { LatOrder S; S.o.init(R - 2 * CT, 1024, F.G, F.blk); GEMM_CALL(FnWout, LatOrder, g, S, (FnWout{&F, layer})); }
             if (rep_ + 1 < NREP(12)) xcd_barrier(bar); } SEAM(pb + 6);
        }
        if (SITE(13) && IN(pb + 7)) { for (int rep_ = 0; rep_ < NREP(13); ++rep_) { ph_router(F, layer);  if (rep_ + 1 < NREP(13)) xcd_barrier(bar); } SEAM(pb + 7); }
        if (SITE(14) && IN(pb + 8)) { for (int rep_ = 0; rep_ < NREP(14); ++rep_) { ph_gather(F, layer);  if (rep_ + 1 < NREP(14)) xcd_barrier(bar); } SEAM(pb + 8); }
        if (SITE(15) && IN(pb + 9)) { for (int rep_ = 0; rep_ < NREP(15); ++rep_) {
            const int* tab = wsp<const int>(F, WS_TILE);
            pg8::Gemm g{wsp<const bf16>(F, WS_F), wsp<const bf16>(F, WS_W1T), MAXROWS, NE * 2048, 1024}; MoeOrder S{tab + 1, __builtin_amdgcn_readfirstlane(tab[0]), 8, F.G, F.blk, wsp<const int>(F, WS_SRC)};
            { int k_ = g.K; asm volatile("" : "+s"(k_)); g.K = k_; pg8::EpiGen<FnSwiglu> E_{FnSwiglu{wsp<bf16>(F, WS_HS), F.in[I_B1] + (size_t)layer * NE * 2048}};
              pg8::gemm_phase<pg8::EpiGen<FnSwiglu>, MoeOrder, true, true, true>((PG8_LAS unsigned char*)F.lds, g, S, E_); }
             if (rep_ + 1 < NREP(15)) xcd_barrier(bar); } SEAM(pb + 9);
        }
        if (SITE(16) && IN(pb + 10)) { for (int rep_ = 0; rep_ < NREP(16); ++rep_) {
            const int* tab = wsp<const int>(F, WS_TILE);
            pg8::Gemm g{wsp<const bf16>(F, WS_HS), wsp<const bf16>(F, WS_W2T), MAXROWS, NE * 1024, 1024}; MoeOrder S{tab + 1, __builtin_amdgcn_readfirstlane(tab[0]), 4, F.G, F.blk, nullptr};
            GEMM_CALL(FnBiasBf16, MoeOrder, g, S, (FnBiasBf16{wsp<bf16>(F, WS_XS), F.in[I_B2] + (size_t)layer * NE * 1024}));
             if (rep_ + 1 < NREP(16)) xcd_barrier(bar); } SEAM(pb + 10);
        }
        if (SITE(17) && IN(pb + 11)) { for (int rep_ = 0; rep_ < NREP(17); ++rep_) { ph_combine(F, layer);  if (rep_ + 1 < NREP(17)) xcd_barrier(bar); } SEAM(pb + 11); }
}
__global__ void __launch_bounds__(512, 2) fwd(Args args) {
    extern __shared__ __attribute__((aligned(16))) unsigned char lds_[];
    Frame F;
    F.lds = (LAS unsigned char*)lds_; F.tid = threadIdx.x; F.lane = F.tid & 63; F.wave = __builtin_amdgcn_readfirstlane(F.tid >> 6); F.blk = blockIdx.x; F.G = gridDim.x; F.probe = args.pad;
    F.ws = args.ws; F.out = args.out; F.ctl = (gu32*)(args.ws + WS_CTL);
    F.in.t = (LAS const unsigned*)(F.lds + MISC_OFF + 8192);
    if (F.tid < 64) ((LAS unsigned*)(F.lds + MISC_OFF))[F.tid] = 0u;
    if (F.tid < N_IN) { const unsigned long long pv = (unsigned long long)args.in[F.tid]; ((LAS unsigned*)(F.lds + MISC_OFF + 8192))[2 * F.tid] = (unsigned)pv; ((LAS unsigned*)(F.lds + MISC_OFF + 8192))[2 * F.tid + 1] = (unsigned)(pv >> 32); }
    __syncthreads();
    const int lo = args.ph_lo, hi = args.ph_hi;
    XcdBarrier bar; bar.bar = (unsigned*)(F.ctl + CW_BAR) + args.li * XCD_BAR_WORDS; bar.x = 0; bar.st = nullptr;
    if (hi - lo > 1) bar = xcd_barrier_post((unsigned*)(F.ctl + CW_BAR) + args.li * XCD_BAR_WORDS, (volatile LAS unsigned*)(F.lds + MISC_OFF));
    if (SITE(0) && IN(0)) { for (int rep_ = 0; rep_ < NREP(0); ++rep_) { p0a(F);  if (rep_ + 1 < NREP(0)) xcd_barrier(bar); } SEAM(0); }
    if (SITE(1) && IN(1)) { for (int rep_ = 0; rep_ < NREP(1); ++rep_) { p0b(F);  if (rep_ + 1 < NREP(1)) xcd_barrier(bar); } SEAM(1); }
    layer_phases<0>(F, bar, lo, hi);
    layer_phases<1>(F, bar, lo, hi);
}
#undef IN
#undef SEAM


extern "C" void kernel_launch(void* const* d_in, const int* in_sizes, int n_in, void* d_out, int out_size, void* d_ws, size_t ws_size, hipStream_t stream) {
    static int grid = 0;
    if (grid == 0) {
        const bool ok = n_in == N_IN && in_sizes[I_X] == NBATCH * SEQ * DM && in_sizes[I_RECW] == 1024 * REC_IN && in_sizes[I_ATTW] == 1024 * ATT_IN && in_sizes[I_MU] == RWKV_IN &&
                        in_sizes[I_GATEB] == 16 && in_sizes[I_W1] == 2 * NE * 1024 * 2048 && out_size == NBATCH * SEQ * DM && ws_size >= WS_END;
        if (!ok) { fprintf(stderr, "kernel_launch: shape mismatch (n_in %d, recw %d, attw %d, mu %d, out %d, ws %zu need %zu); nothing launched\n", n_in, n_in > I_RECW ? in_sizes[I_RECW] : -1,
                           n_in > I_ATTW ? in_sizes[I_ATTW] : -1, n_in > I_MU ? in_sizes[I_MU] : -1, out_size, ws_size, (size_t)WS_END); grid = -1; return; }
        int dev = 0, cus = 0;
        if (hipGetDevice(&dev) != hipSuccess || hipDeviceGetAttribute(&cus, hipDeviceAttributeMultiprocessorCount, dev) != hipSuccess) { grid = -1; return; }
        if (hipFuncSetAttribute((const void*)fwd, hipFuncAttributeMaxDynamicSharedMemorySize, LDS_BYTES) != hipSuccess) { fprintf(stderr, "kernel_launch: hipFuncSetAttribute failed\n"); grid = -1; return; }
        int per_cu = 0;
        if (hipOccupancyMaxActiveBlocksPerMultiprocessor(&per_cu, (const void*)fwd, 512, LDS_BYTES) != hipSuccess || per_cu < 1) { fprintf(stderr, "kernel_launch: occupancy query says %d blocks per CU\n", per_cu); }
        (void)hipGetLastError();
        grid = cus < 256 ? cus : 256;
        if (grid != 256) fprintf(stderr, "kernel_launch: %d CUs; this kernel is written for a 256-CU device\n", cus);
    }
    if (grid < 0) return;
    if (hipMemsetAsync((char*)d_ws + WS_CTL, 0, CTL_ZERO_BYTES, stream) != hipSuccess) return;
    Args a{};
    for (int i = 0; i < N_IN; ++i) a.in[i] = (const float*)d_in[i];
    a.out = (float*)d_out; a.ws = (unsigned char*)d_ws; a.pad = 0;
#if MK_PER_PHASE
    for (int ph = 0; ph < NPHASE; ++ph) { a.ph_lo = ph; a.ph_hi = ph + 1; a.li = 0; hipLaunchKernelGGL(fwd, dim3(grid), dim3(512), LDS_BYTES, stream, a); }
#elif defined(PROBE_PRE)
    { const int plist[] = {PROBE_PRE}; int cur = 0, li = 0;
      for (int p : plist) { if (p > cur) { a.ph_lo = cur; a.ph_hi = p; a.li = li++; hipLaunchKernelGGL(fwd, dim3(grid), dim3(512), LDS_BYTES, stream, a); }
                            a.ph_lo = p; a.ph_hi = p + 1; a.li = li++; a.pad = 1; hipLaunchKernelGGL(fwd, dim3(grid), dim3(512), LDS_BYTES, stream, a); a.pad = 0; cur = p; }
      a.ph_lo = cur; a.ph_hi = NPHASE; a.li = li++; hipLaunchKernelGGL(fwd, dim3(grid), dim3(512), LDS_BYTES, stream, a); }
#elif defined(PROBE_LIST)
    { const int plist[] = {PROBE_LIST}; int cur = 0, li = 0;
      for (int p : plist) { a.ph_lo = cur; a.ph_hi = p + 1; a.li = li++; hipLaunchKernelGGL(fwd, dim3(grid), dim3(512), LDS_BYTES, stream, a);
                            a.ph_lo = p; a.ph_hi = p + 1; a.li = li++; a.pad = 1; hipLaunchKernelGGL(fwd, dim3(grid), dim3(512), LDS_BYTES, stream, a); a.pad = 0; cur = p + 1; }
      if (cur < NPHASE) { a.ph_lo = cur; a.ph_hi = NPHASE; a.li = li++; hipLaunchKernelGGL(fwd, dim3(grid), dim3(512), LDS_BYTES, stream, a); } }
#else
    a.ph_lo = 0; a.ph_hi = NPHASE; a.li = 0; hipLaunchKernelGGL(fwd, dim3(grid), dim3(512), LDS_BYTES, stream, a);
#endif
    const hipError_t le = hipPeekAtLastError();
    if (le != hipSuccess) fprintf(stderr, "kernel_launch: launch failed: %s\n", hipGetErrorName(le));
}
```

```cpp
#include <hip/hip_runtime.h>
#include <cstdio>
#include <cstdint>
#define MK_PER_PHASE 0
namespace pg8 {
#define PG8_LAS __attribute__((address_space(3)))
typedef unsigned short bf16_t;
typedef short bf16x8 __attribute__((ext_vector_type(8)));
typedef float f32x4 __attribute__((ext_vector_type(4)));
typedef unsigned u32x4 __attribute__((ext_vector_type(4)));
constexpr int BM = 256, BK = 64, HALF = 128, HTB = HALF * BK * 2  , STAGE_BYTES = 8 * HTB, NXCD = 8, WGM = 8;

__host__ __device__ __forceinline__ int lds_byte(int r, int c) { const int st = (r >> 4) * 2 + (c >> 5), rr = r & 15, cc = c & 31, ob = rr * 64 + cc * 2; return st * 1024 + (ob ^ (((ob >> 9) & 1) << 5)); }
__host__ __device__ __forceinline__ void stage_rc(int b, int& R, int& C) { const int st = b / 1024, sb = b % 1024, swz = sb ^ (((sb >> 9) & 1) << 5); R = (st >> 1) * 16 + swz / 64; C = (st & 1) * 32 + (swz % 64) / 2; }
__host__ __device__ __forceinline__ int perm32(int rho) { const int n = rho >> 4, i = rho & 15; return 8 * (i >> 2) + 4 * n + (i & 3); }

struct Unit { int pm, pn; };
struct Gemm { const bf16_t* A; const bf16_t* Bt; int M, N, K; };

struct StaticOrder {
    int nM, nN, nwg, G, c;
    __host__ __device__ void init(int M, int N, int G_, int c_) { nM = M / BM; nN = N / BM; nwg = nM * nN; G = G_; c = c_; }
    __host__ __device__ bool next(int i, Unit& u) const {
        const long L = (long)i * G + c; if (L >= nwg) return false;
        int wgid = (int)L; { const int q = nwg / NXCD, r = nwg % NXCD, xcd = wgid % NXCD, off = wgid / NXCD; wgid = (xcd < r ? xcd * (q + 1) : r * (q + 1) + (xcd - r) * q) + off; }
        const int nig = WGM * nN, gid = wgid / nig, fm = gid * WGM, gsz = (nM - fm) < WGM ? (nM - fm) : WGM;
        u.pm = fm + ((wgid % nig) % gsz); u.pn = (wgid % nig) / gsz; return true;
    }
    __device__ __forceinline__ void a_ready(const Unit&) const {}
    __device__ __forceinline__ void done(const Unit&) const {}
};

__device__ __forceinline__ unsigned cvt_pk_bf16(float lo, float hi) { unsigned r; asm volatile("v_cvt_pk_bf16_f32 %0, %1, %2" : "=v"(r) : "v"(lo), "v"(hi)); return r; }
template <class Fn> struct EpiGen {
    static constexpr bool PERM = true, AFTER_DRAIN = false;
    Fn fn;
    __device__ __forceinline__ void operator()(const f32x4 (&acc)[2][2][4][2], const Unit& u, int wr, int wc, int fr, int fq) const {
#pragma unroll
        for (int ai = 0; ai < 2; ++ai)
#pragma unroll
            for (int m = 0; m < 4; ++m) { const int row = u.pm * BM + ai * HALF + wr * 64 + m * 16 + fr;
#pragma unroll
                for (int bj = 0; bj < 2; ++bj) { const int col = u.pn * BM + bj * HALF + wc * 32 + 8 * fq; fn(row, col, acc[ai][bj][m][0], acc[ai][bj][m][1]); } }
    }
};
template <class Epi, class Sched, bool ALIGN_EPI = false, bool SP2 = false, bool GATHER = false>
__device__ __forceinline__ void gemm_phase(PG8_LAS unsigned char* lds, const Gemm g, const Sched& S, const Epi& E) {
    static_assert(!GATHER || SP2, "the gathered A path is written for the SP2 loop");
    const int tid = threadIdx.x, wid = __builtin_amdgcn_readfirstlane(tid >> 6), lane = tid & 63, wr = wid >> 2, wc = wid & 3, fr = lane & 15, fq = lane >> 4;
    const int K = g.K, nt = K / BK;
    unsigned voffA[2], voffB[2]; int gR[2], gC[2]; unsigned gA[2][2], gN[2][2];
#pragma unroll
    for (int i = 0; i < 2; ++i) { int R, C; stage_rc(tid * 16 + i * 8192, R, C); const int Rb = Epi::PERM ? ((R & ~31) + perm32(R & 31)) : R;
        voffA[i] = (unsigned)(R * K + C) * 2u; voffB[i] = (unsigned)(Rb * K + C) * 2u; gR[i] = R; gC[i] = C; }
    const size_t kstep = (size_t)(BK * 2);
    const size_t hstep = (size_t)HALF * K * 2;
    const size_t tstep = 2 * hstep;
    const unsigned ldsw = (unsigned)wid * 1024u;
    const int aoff = lds_byte(wr * 64 + fr, fq * 8), boff = lds_byte(wc * 32 + fr, fq * 8);
#define PG8_SA(b, h) (((b) * 2 + (h)) * HTB)
#define PG8_SB(b, h) ((4 + (b) * 2 + (h)) * HTB)
#define PG8_STAGE(bufoff, gbase, voff) do { _Pragma("unroll") for (int _i = 0; _i < 2; ++_i) \
        __builtin_amdgcn_global_load_lds((const unsigned*)((const char*)(gbase) + (voff)[_i]), (PG8_LAS unsigned*)(lds + (bufoff) + ldsw + _i * 8192), 16, 0, 0); } while (0)
#define PG8_GOFF(u_, out_) do { _Pragma("unroll") for (int _h = 0; _h < 2; ++_h) _Pragma("unroll") for (int _i = 0; _i < 2; ++_i) \
        out_[_h][_i] = ((unsigned)S.src[(u_).pm * BM + _h * HALF + gR[_i]] * (unsigned)K + (unsigned)gC[_i]) * 2u; } while (0)
#define PG8_STAGE_A(bufoff, kptr, h, isnext) do { if constexpr (GATHER) { unsigned _o[2]; _o[0] = (isnext) ? gN[h][0] : gA[h][0]; _o[1] = (isnext) ? gN[h][1] : gA[h][1]; PG8_STAGE(bufoff, kptr, _o); } \
        else { PG8_STAGE(bufoff, (kptr) + (h) * hstep, voffA); } } while (0)
#define PG8_LDA(dst, b, h) do { _Pragma("unroll") for (int m = 0; m < 4; ++m) _Pragma("unroll") for (int k = 0; k < 2; ++k) dst[m][k] = *(const PG8_LAS bf16x8*)(lds + PG8_SA(b, h) + aoff + m * 2048 + k * 1024); } while (0)
#define PG8_LDB(dst, b, h) do { _Pragma("unroll") for (int n = 0; n < 2; ++n) _Pragma("unroll") for (int k = 0; k < 2; ++k) dst[n][k] = *(const PG8_LAS bf16x8*)(lds + PG8_SB(b, h) + boff + n * 2048 + k * 1024); } while (0)
#define PG8_MMA(ai, bj, At, Bt) do { __builtin_amdgcn_s_setprio(1); _Pragma("unroll") for (int m = 0; m < 4; ++m) _Pragma("unroll") for (int n = 0; n < 2; ++n) _Pragma("unroll") for (int k = 0; k < 2; ++k) \
        acc[ai][bj][m][n] = __builtin_amdgcn_mfma_f32_16x16x32_bf16(Bt[n][k], At[m][k], acc[ai][bj][m][n], 0, 0, 0); __builtin_amdgcn_s_setprio(0); } while (0)
#define PG8_WAIT_V(n) asm volatile("s_waitcnt vmcnt(" #n ")" ::: "memory")
#define PG8_WAIT_L(n) asm volatile("s_waitcnt lgkmcnt(" #n ")" ::: "memory")
#define PG8_BAR __builtin_amdgcn_s_barrier()
#define PG8_SCHED __builtin_amdgcn_sched_barrier(0)
    Unit cur, nxt; int ui = 0;
    if (!S.next(0, cur)) return;
    f32x4 acc[2][2][4][2];
#pragma unroll
    for (int a = 0; a < 2; ++a)
#pragma unroll
        for (int b = 0; b < 2; ++b)
#pragma unroll
            for (int m = 0; m < 4; ++m)
#pragma unroll
                for (int n = 0; n < 2; ++n) acc[a][b][m][n] = (f32x4){0.f, 0.f, 0.f, 0.f};
    bf16x8 At[4][2], B0[2][2], B1[2][2];
    const char* cA = (const char*)g.A + (GATHER ? (size_t)0 : (size_t)cur.pm * tstep); const char* cB = (const char*)g.Bt + (size_t)cur.pn * tstep;
    if constexpr (GATHER) PG8_GOFF(cur, gA);
    S.a_ready(cur);
    if constexpr (SP2) {
        PG8_STAGE(PG8_SB(0, 0), cB, voffB); PG8_STAGE(PG8_SB(0, 1), cB + hstep, voffB); PG8_STAGE_A(PG8_SA(0, 0), cA, 0, false); PG8_STAGE_A(PG8_SA(0, 1), cA, 1, false);
        if (wr == 1) PG8_BAR;
        PG8_WAIT_V(2); PG8_BAR;
        PG8_STAGE(PG8_SB(1, 0), cB + kstep, voffB); PG8_STAGE_A(PG8_SA(1, 0), cA + kstep, 0, false); PG8_STAGE(PG8_SB(1, 1), cB + hstep + kstep, voffB);
        PG8_WAIT_V(6); PG8_BAR;
    } else {
        PG8_STAGE(PG8_SB(0, 0), cB, voffB); PG8_STAGE(PG8_SA(0, 0), cA, voffA); PG8_STAGE(PG8_SB(0, 1), cB + hstep, voffB); PG8_STAGE(PG8_SA(0, 1), cA + hstep, voffA);
        if (wr == 1) PG8_BAR;
        PG8_WAIT_V(4); PG8_BAR;
        PG8_STAGE(PG8_SB(1, 0), cB + kstep, voffB); PG8_STAGE(PG8_SA(1, 0), cA + kstep, voffA); PG8_STAGE(PG8_SB(1, 1), cB + hstep + kstep, voffB);
        PG8_WAIT_V(6); PG8_BAR;
    }
    for (;;) {
        const bool has_next = S.next(ui + 1, nxt);
        const char* nA = (has_next && !GATHER) ? (const char*)g.A + (size_t)nxt.pm * tstep : cA; const char* nB = has_next ? (const char*)g.Bt + (size_t)nxt.pn * tstep : cB;
        if constexpr (GATHER) { if (has_next) PG8_GOFF(nxt, gN); else { _Pragma("unroll") for (int _h = 0; _h < 2; ++_h) { gN[_h][0] = gA[_h][0]; gN[_h][1] = gA[_h][1]; } } }
        for (int t = 0; t < nt; t += 2) {
            const bool last = (t == nt - 2);
            const char* a1 = cA + (size_t)(t + 1) * kstep;
            const char* a2 = last ? nA : cA + (size_t)(t + 2) * kstep; const char* b2 = last ? nB : cB + (size_t)(t + 2) * kstep;
            const char* a3 = a2 + kstep; const char* b3 = b2 + kstep;
            if (last && has_next) S.a_ready(nxt);
            if constexpr (SP2) {
            PG8_LDB(B0, 0, 0); PG8_LDB(B1, 0, 1); PG8_SCHED; PG8_LDA(At, 0, 0); PG8_STAGE_A(PG8_SA(1, 1), a1, 1, false);
            PG8_WAIT_V(8); PG8_WAIT_L(0); PG8_BAR; PG8_MMA(0, 0, At, B0); PG8_MMA(0, 1, At, B1); PG8_BAR; PG8_SCHED;
            PG8_LDA(At, 0, 1); PG8_STAGE(PG8_SB(0, 0), b2, voffB); PG8_STAGE(PG8_SB(0, 1), b2 + hstep, voffB); PG8_STAGE_A(PG8_SA(0, 0), a2, 0, last);
            PG8_WAIT_V(8); PG8_WAIT_L(0); PG8_BAR; PG8_MMA(1, 0, At, B0); PG8_MMA(1, 1, At, B1); PG8_BAR; PG8_SCHED;
            PG8_LDB(B0, 1, 0); PG8_LDB(B1, 1, 1); PG8_SCHED; PG8_LDA(At, 1, 0); PG8_STAGE_A(PG8_SA(0, 1), a2, 1, last);
            PG8_WAIT_V(8); PG8_WAIT_L(0); PG8_BAR; PG8_MMA(0, 0, At, B0); PG8_MMA(0, 1, At, B1); PG8_BAR; PG8_SCHED;
            PG8_LDA(At, 1, 1); PG8_STAGE(PG8_SB(1, 0), b3, voffB); PG8_STAGE(PG8_SB(1, 1), b3 + hstep, voffB); PG8_STAGE_A(PG8_SA(1, 0), a3, 0, last);
            PG8_WAIT_V(8); PG8_WAIT_L(0); PG8_BAR; PG8_MMA(1, 0, At, B0); PG8_MMA(1, 1, At, B1); PG8_BAR; PG8_SCHED;
            } else {
            PG8_LDB(B0, 0, 0); PG8_SCHED; PG8_LDA(At, 0, 0); PG8_STAGE(PG8_SA(1, 1), a1 + hstep, voffA);
            PG8_WAIT_L(8); PG8_BAR; PG8_WAIT_L(0); PG8_MMA(0, 0, At, B0); PG8_BAR; PG8_SCHED;
            PG8_LDB(B1, 0, 1); PG8_STAGE(PG8_SB(0, 0), b2, voffB);
            PG8_BAR; PG8_WAIT_L(0); PG8_MMA(0, 1, At, B1); PG8_BAR;
            PG8_LDA(At, 0, 1); PG8_STAGE(PG8_SA(0, 0), a2, voffA);
            PG8_BAR; PG8_WAIT_L(0); PG8_MMA(1, 0, At, B0); PG8_BAR; PG8_SCHED;
            PG8_STAGE(PG8_SB(0, 1), b2 + hstep, voffB);
            PG8_WAIT_V(6); PG8_BAR; PG8_MMA(1, 1, At, B1); PG8_BAR;
            PG8_LDB(B0, 1, 0); PG8_SCHED; PG8_LDA(At, 1, 0); PG8_STAGE(PG8_SA(0, 1), a2 + hstep, voffA);
            PG8_WAIT_L(8); PG8_BAR; PG8_WAIT_L(0); PG8_MMA(0, 0, At, B0); PG8_BAR; PG8_SCHED;
            PG8_LDB(B1, 1, 1); PG8_STAGE(PG8_SB(1, 0), b3, voffB);
            PG8_BAR; PG8_WAIT_L(0); PG8_MMA(0, 1, At, B1); PG8_BAR;
            PG8_LDA(At, 1, 1); PG8_STAGE(PG8_SA(1, 0), a3, voffA);
            PG8_BAR; PG8_WAIT_L(0); PG8_MMA(1, 0, At, B0); PG8_BAR; PG8_SCHED;
            PG8_STAGE(PG8_SB(1, 1), b3 + hstep, voffB);
            PG8_WAIT_V(6); PG8_BAR; PG8_MMA(1, 1, At, B1); PG8_BAR;
            }
        }
        if constexpr (ALIGN_EPI) { if (wr == 0) PG8_BAR; }
        if constexpr (!Epi::AFTER_DRAIN) { E(acc, cur, wr, wc, fr, fq); S.done(cur); }
        if (!has_next) break;
#pragma unroll
        for (int a = 0; a < 2; ++a)
#pragma unroll
            for (int b = 0; b < 2; ++b)
#pragma unroll
                for (int m = 0; m < 4; ++m)
#pragma unroll
                    for (int n = 0; n < 2; ++n) acc[a][b][m][n] = (f32x4){0.f, 0.f, 0.f, 0.f};
        cur = nxt; cA = nA; cB = nB; ++ui;
        if constexpr (GATHER) { _Pragma("unroll") for (int _h = 0; _h < 2; ++_h) { gA[_h][0] = gN[_h][0]; gA[_h][1] = gN[_h][1]; } }
        if constexpr (ALIGN_EPI) { if (wr == 1) PG8_BAR; }
    }
    PG8_WAIT_V(0);
    if constexpr (!ALIGN_EPI) { if (wr == 0) PG8_BAR; }
    PG8_BAR;
    if constexpr (Epi::AFTER_DRAIN) { E.fused(acc, cur, wr, wc, fr, fq, lds, wid, lane); S.done(cur); }
#undef PG8_SA
#undef PG8_SB
#undef PG8_STAGE
#undef PG8_STAGE_A
#undef PG8_GOFF
#undef PG8_LDA
#undef PG8_LDB
#undef PG8_MMA
#undef PG8_WAIT_V
#undef PG8_WAIT_L
#undef PG8_BAR
#undef PG8_SCHED
}
}
#define GAS __attribute__((address_space(1)))
#define LAS __attribute__((address_space(3)))
typedef unsigned short bf16;
typedef unsigned v4u __attribute__((ext_vector_type(4)));
typedef unsigned v2u __attribute__((ext_vector_type(2)));
typedef float f32x4 __attribute__((ext_vector_type(4)));
typedef short bf16x8 __attribute__((ext_vector_type(8)));
typedef GAS unsigned gu32;
typedef GAS unsigned long long gu64;
#define RLX_AGENT __ATOMIC_RELAXED, __HIP_MEMORY_SCOPE_AGENT
#define LDS_WAIT() asm volatile("s_waitcnt lgkmcnt(0)" ::: "memory")
#define VM_WAIT() asm volatile("s_waitcnt vmcnt(0)" ::: "memory")
typedef float f32x2_cv __attribute__((ext_vector_type(2)));
typedef __bf16 bf16x2_cv __attribute__((ext_vector_type(2)));
__device__ __forceinline__ unsigned pk2(float lo, float hi) { const f32x2_cv v = {lo, hi}; return __builtin_bit_cast(unsigned, __builtin_convertvector(v, bf16x2_cv)); }
__device__ __forceinline__ unsigned f2bf(float f) { return (unsigned)__builtin_bit_cast(unsigned short, (__bf16)f); }
__device__ __forceinline__ float bflo(unsigned w) { return __builtin_bit_cast(float, w << 16); }
__device__ __forceinline__ float bfhi(unsigned w) { return __builtin_bit_cast(float, w & 0xffff0000u); }
__device__ __forceinline__ float bf2f(bf16 b) { return __builtin_bit_cast(float, (unsigned)b << 16); }
__device__ __forceinline__ void unpack8(v4u w, float (&x)[8]) { x[0] = bflo(w.x); x[1] = bfhi(w.x); x[2] = bflo(w.y); x[3] = bfhi(w.y); x[4] = bflo(w.z); x[5] = bfhi(w.z); x[6] = bflo(w.w); x[7] = bfhi(w.w); }
__device__ __forceinline__ float wave_sum(float v) {
#pragma unroll
    for (int o = 1; o < 64; o <<= 1) v += __shfl_xor(v, o);
    return v;
}
__device__ __forceinline__ float sigmoidf_(float x) { return 1.f / (1.f + __expf(-x)); }

#define XB_TMO      128
#define XB_XCNT(j)  (256  + 64 * (j))
#define XB_XSUB(j)  (1280 + 64 * (j))
#define XB_XGEN(j)  (2304 + 64 * (j))
#define XB_TOP      3328
#define XB_TOPGEN   3392
#define XCD_BAR_WORDS 3456
#define XB_SPIN_CAP (1u << 22)

__device__ __forceinline__ unsigned xb_ld(unsigned* p)              { return __hip_atomic_load(p, __ATOMIC_RELAXED, __HIP_MEMORY_SCOPE_AGENT); }
__device__ __forceinline__ unsigned xb_add(unsigned* p, unsigned v) { return __hip_atomic_fetch_add(p, v, __ATOMIC_RELAXED, __HIP_MEMORY_SCOPE_AGENT); }
__device__ __forceinline__ unsigned xb_xcc_id() { return (unsigned)__builtin_amdgcn_s_getreg((3 << 11) | 20) & 0xFu; }
#define XB_SPIN(cond, bar) do { unsigned _sp = 0; while (cond) { __builtin_amdgcn_s_sleep(1); \
    if ((++_sp & 255u) == 0u) { if (xb_ld(&(bar)[XB_TMO])) break; if (_sp > XB_SPIN_CAP) { atomicAdd(&(bar)[XB_TMO], 1u); break; } } } } while (0)

struct XcdBarrier {
    unsigned* bar; unsigned x;
    volatile LAS unsigned* st;
};

__device__ __forceinline__ XcdBarrier xcd_barrier_post(unsigned* bar, volatile LAS unsigned* st) {
    XcdBarrier b; b.bar = bar; b.x = xb_xcc_id(); b.st = st;
    if (threadIdx.x == 0) (void)xb_add(&bar[XB_XCNT(b.x)], 1u);
    return b;
}
__device__ __forceinline__ void xcd_barrier_complete(unsigned* bar, unsigned x, unsigned& nloc, unsigned& nx) {
    const unsigned G = gridDim.x * gridDim.y * gridDim.z;
    unsigned sum, cnt, mine, sp = 0u;
    for (;;) {
        sum = 0u; cnt = 0u; mine = 0u;
#pragma unroll
        for (unsigned j = 0; j < 16; ++j) { const unsigned c = xb_ld(&bar[XB_XCNT(j)]); sum += c; cnt += (c > 0u) ? 1u : 0u; mine = (j == x) ? c : mine; }
        if (sum == G) break;
        __builtin_amdgcn_s_sleep(1);
        if ((++sp & 255u) == 0u) { if (xb_ld(&bar[XB_TMO])) break; if (sp > XB_SPIN_CAP) { atomicAdd(&bar[XB_TMO], 1u); break; } }
    }
    nloc = mine > 0u ? mine : 1u; nx = cnt > 0u ? cnt : 1u;
}

__device__ __forceinline__ void xcd_barrier(const XcdBarrier& b) {
    asm volatile("s_waitcnt vmcnt(0)" ::: "memory");
    __syncthreads();
    if (threadIdx.x == 0) {
        unsigned* bar = b.bar;
        __builtin_amdgcn_s_waitcnt(0);
        unsigned nloc = b.st[0], nx = b.st[1];
        if (nloc == 0u) { xcd_barrier_complete(bar, b.x, nloc, nx); b.st[0] = nloc; b.st[1] = nx; }
        const unsigned old = xb_add(&bar[XB_XSUB(b.x)], 1u);
        const unsigned gen = old / nloc;
        if (old + 1u == (gen + 1u) * nloc) {
            __builtin_amdgcn_fence(__ATOMIC_RELEASE, "agent");
            asm volatile("s_waitcnt vmcnt(0)" ::: "memory");
            const unsigned og = xb_add(&bar[XB_TOP], 1u);
            const unsigned tg = og / nx;
            if (og + 1u == (tg + 1u) * nx) xb_add(&bar[XB_TOPGEN], 1u);
            else XB_SPIN(xb_ld(&bar[XB_TOPGEN]) == tg, bar);
            __builtin_amdgcn_fence(__ATOMIC_ACQUIRE, "agent");
            xb_add(&bar[XB_XGEN(b.x)], 1u);
            asm volatile("s_waitcnt vmcnt(0)" ::: "memory");
        } else {
            XB_SPIN(xb_ld(&bar[XB_XGEN(b.x)]) == gen, bar);
            __builtin_amdgcn_fence(__ATOMIC_ACQUIRE, "agent");
            asm volatile("s_waitcnt vmcnt(0)" ::: "memory");
        }
    }
    __syncthreads();
}
namespace att {
using s16x4  = __attribute__((ext_vector_type(4))) short;
using f32x16 = __attribute__((ext_vector_type(16))) float;
using u32x4  = __attribute__((ext_vector_type(4))) unsigned;
using f32x4  = __attribute__((ext_vector_type(4))) float;
#define ATT_SBAR() __builtin_amdgcn_sched_barrier(0)
constexpr float THR2 = 11.5f;
__device__ __forceinline__ int crow(int r, int hi) { return (r & 3) + 8 * (r >> 2) + 4 * hi; }
__device__ __forceinline__ unsigned cvtpk(float lo, float hi) { unsigned r; asm volatile("v_cvt_pk_bf16_f32 %0, %1, %2" : "=v"(r) : "v"(lo), "v"(hi)); return r; }

__device__ __forceinline__ void partialSM(f32x16& p0, f32x16& p1, float& m_reg, float& mn, float& alpha) {
  float pmax = p0[0];
#pragma unroll
  for (int r = 1; r < 16; ++r) pmax = fmaxf(pmax, p0[r]);
#pragma unroll
  for (int r = 0; r < 16; ++r) pmax = fmaxf(pmax, p1[r]);
  { auto rr = __builtin_amdgcn_permlane32_swap(__float_as_uint(pmax), __float_as_uint(pmax), false, false);
    pmax = fmaxf(__uint_as_float(rr[0]), __uint_as_float(rr[1])); }
  if (__builtin_expect(__all(pmax - m_reg <= THR2), 1)) { mn = m_reg; alpha = 1.f; }
  else { mn = fmaxf(m_reg, pmax); alpha = __builtin_amdgcn_exp2f(m_reg - mn); m_reg = mn; }
#pragma unroll
  for (int r = 0; r < 16; ++r) p0[r] = p0[r] - mn;
#pragma unroll
  for (int r = 0; r < 16; ++r) p1[r] = p1[r] - mn;
#pragma unroll
  for (int r = 0; r < 16; ++r) p0[r] = __builtin_amdgcn_exp2f(p0[r]);
}
__device__ __forceinline__ void finishSM(f32x16& p0, f32x16& p1, bf16x8& pa0, bf16x8& pa1, bf16x8& pa2, bf16x8& pa3) {
#pragma unroll
  for (int r = 0; r < 16; ++r) p1[r] = __builtin_amdgcn_exp2f(p1[r]);
#define ATT_PK4(P, BASE, OUT) do { unsigned a0 = cvtpk(P[BASE + 0], P[BASE + 1]), a1 = cvtpk(P[BASE + 2], P[BASE + 3]);   \
    unsigned b0 = cvtpk(P[BASE + 4], P[BASE + 5]), b1 = cvtpk(P[BASE + 6], P[BASE + 7]);                              \
    auto r0 = __builtin_amdgcn_permlane32_swap(a0, b0, false, false); auto r1 = __builtin_amdgcn_permlane32_swap(a1, b1, false, false); \
    u32x4 w = {r0[0], r1[0], r0[1], r1[1]}; OUT = *reinterpret_cast<bf16x8*>(&w); } while (0)
  ATT_PK4(p0, 0, pa0); ATT_PK4(p0, 8, pa1); ATT_PK4(p1, 0, pa2); ATT_PK4(p1, 8, pa3);
#undef ATT_PK4
}
template <int NB> __device__ __forceinline__ int v_st(int k, int c) { const int kk = (k & ~0xC) | ((k & 4) << 1) | ((k & 8) >> 1); return ((kk >> 3) * NB + (c >> 5)) * 512 + ((kk & 7) * 32 + (c & 31)) * 2; }
__device__ __forceinline__ int v_rd_base(int lane) { return ((lane & 3) << 3) | (((lane >> 2) & 3) << 6) | (((lane >> 4) & 1) << 5) | (((lane >> 5) & 1) << 8); }
template <int OFF> __device__ __forceinline__ s16x4 tr_read(int vb) {
  s16x4 r; asm volatile("ds_read_b64_tr_b16 %0, %1 offset:%2" : "=&v"(r) : "v"(vb), "i"(OFF) : "memory"); return r;
}
template <int NB, int D0, int VO> __device__ __forceinline__ void pv_rd(s16x4 (&f)[8], int vb) {
#define ATT_VOFF(ks, half) (VO + D0 * 512 + (ks) * (NB * 1024) + (half) * (NB * 512))
  f[0] = tr_read<ATT_VOFF(0, 0)>(vb); f[1] = tr_read<ATT_VOFF(0, 1)>(vb); f[2] = tr_read<ATT_VOFF(1, 0)>(vb); f[3] = tr_read<ATT_VOFF(1, 1)>(vb);
  f[4] = tr_read<ATT_VOFF(2, 0)>(vb); f[5] = tr_read<ATT_VOFF(2, 1)>(vb); f[6] = tr_read<ATT_VOFF(3, 0)>(vb); f[7] = tr_read<ATT_VOFF(3, 1)>(vb);
#undef ATT_VOFF
}
__device__ __forceinline__ void pv_mm(f32x16& od, const s16x4 (&f)[8], bf16x8 pa0, bf16x8 pa1, bf16x8 pa2, bf16x8 pa3) {
#define ATT_PK(L, H) (bf16x8){L[0], L[1], L[2], L[3], H[0], H[1], H[2], H[3]}
  od = __builtin_amdgcn_mfma_f32_32x32x16_bf16(pa0, ATT_PK(f[0], f[1]), od, 0, 0, 0);
  od = __builtin_amdgcn_mfma_f32_32x32x16_bf16(pa1, ATT_PK(f[2], f[3]), od, 0, 0, 0);
  od = __builtin_amdgcn_mfma_f32_32x32x16_bf16(pa2, ATT_PK(f[4], f[5]), od, 0, 0, 0);
  od = __builtin_amdgcn_mfma_f32_32x32x16_bf16(pa3, ATT_PK(f[6], f[7]), od, 0, 0, 0);
#undef ATT_PK
}
#define ATT_LWAIT(n) do { asm volatile("s_waitcnt lgkmcnt(" #n ")" ::: "memory"); ATT_SBAR(); } while (0)
template <int NB, int VO> __device__ __forceinline__ void pv_all(f32x16* o, f32x16& lsum, int vb, bf16x8 pa0, bf16x8 pa1, bf16x8 pa2, bf16x8 pa3) {
  const bf16x8 ones = {0x3F80, 0x3F80, 0x3F80, 0x3F80, 0x3F80, 0x3F80, 0x3F80, 0x3F80};
  s16x4 fa[8], fb[8];
  pv_rd<NB, 0, VO>(fa, vb); pv_rd<NB, 1, VO>(fb, vb);
  lsum = __builtin_amdgcn_mfma_f32_32x32x16_bf16(pa0, ones, lsum, 0, 0, 0); lsum = __builtin_amdgcn_mfma_f32_32x32x16_bf16(pa1, ones, lsum, 0, 0, 0);
  lsum = __builtin_amdgcn_mfma_f32_32x32x16_bf16(pa2, ones, lsum, 0, 0, 0); lsum = __builtin_amdgcn_mfma_f32_32x32x16_bf16(pa3, ones, lsum, 0, 0, 0);
  ATT_LWAIT(8); pv_mm(o[0], fa, pa0, pa1, pa2, pa3);
  if constexpr (NB == 4) {
    pv_rd<NB, 2, VO>(fa, vb); ATT_LWAIT(8); pv_mm(o[1], fb, pa0, pa1, pa2, pa3);
    pv_rd<NB, 3, VO>(fb, vb); ATT_LWAIT(8); pv_mm(o[2], fa, pa0, pa1, pa2, pa3);
    ATT_LWAIT(0); pv_mm(o[3], fb, pa0, pa1, pa2, pa3);
  } else { ATT_LWAIT(0); pv_mm(o[1], fb, pa0, pa1, pa2, pa3); }
}
template <int NB, int VO, bool SM> __device__ __forceinline__ void pv_sm(f32x16* o, f32x4& lsum, bf16x8 sel, int vb, bf16x8 pa0, bf16x8 pa1, bf16x8 pa2, bf16x8 pa3,
                                                                         f32x16& n0, f32x16& n1, float& m_reg, float& mn, float& alpha) {
  s16x4 fa[8], fb[8]; float pmax = 0.f;
  pv_rd<NB, 0, VO>(fa, vb); pv_rd<NB, 1, VO>(fb, vb);
  lsum = __builtin_amdgcn_mfma_f32_16x16x32_bf16(sel, pa0, lsum, 0, 0, 0); lsum = __builtin_amdgcn_mfma_f32_16x16x32_bf16(sel, pa1, lsum, 0, 0, 0);
  lsum = __builtin_amdgcn_mfma_f32_16x16x32_bf16(sel, pa2, lsum, 0, 0, 0); lsum = __builtin_amdgcn_mfma_f32_16x16x32_bf16(sel, pa3, lsum, 0, 0, 0);
  if constexpr (SM) { pmax = n0[0];
#pragma unroll
    for (int r = 1; r < 16; ++r) pmax = fmaxf(pmax, n0[r]);
#pragma unroll
    for (int r = 0; r < 16; ++r) pmax = fmaxf(pmax, n1[r]);
    auto rr = __builtin_amdgcn_permlane32_swap(__float_as_uint(pmax), __float_as_uint(pmax), false, false);
    pmax = fmaxf(__uint_as_float(rr[0]), __uint_as_float(rr[1])); }
  ATT_LWAIT(8); pv_mm(o[0], fa, pa0, pa1, pa2, pa3);
  if constexpr (SM) {
    if (__builtin_expect(__all(pmax - m_reg <= THR2), 1)) { mn = m_reg; alpha = 1.f; }
    else { mn = fmaxf(m_reg, pmax); alpha = __builtin_amdgcn_exp2f(m_reg - mn); m_reg = mn; } }
  if constexpr (NB == 4) {
    pv_rd<NB, 2, VO>(fa, vb);
    if constexpr (SM) {
#pragma unroll
      for (int r = 0; r < 16; ++r) n0[r] = n0[r] - mn; }
    ATT_LWAIT(8); pv_mm(o[1], fb, pa0, pa1, pa2, pa3);
    pv_rd<NB, 3, VO>(fb, vb);
    if constexpr (SM) {
#pragma unroll
      for (int r = 0; r < 16; ++r) n1[r] = n1[r] - mn; }
    ATT_LWAIT(8); pv_mm(o[2], fa, pa0, pa1, pa2, pa3);
    if constexpr (SM) {
#pragma unroll
      for (int r = 0; r < 8; ++r) n0[r] = __builtin_amdgcn_exp2f(n0[r]); }
    ATT_LWAIT(0); pv_mm(o[3], fb, pa0, pa1, pa2, pa3);
    if constexpr (SM) {
#pragma unroll
      for (int r = 8; r < 16; ++r) n0[r] = __builtin_amdgcn_exp2f(n0[r]); }
  } else {
    if constexpr (SM) {
#pragma unroll
      for (int r = 0; r < 16; ++r) { n0[r] = n0[r] - mn; n1[r] = n1[r] - mn; } }
    ATT_LWAIT(0); pv_mm(o[1], fb, pa0, pa1, pa2, pa3);
    if constexpr (SM) {
#pragma unroll
      for (int r = 0; r < 16; ++r) n0[r] = __builtin_amdgcn_exp2f(n0[r]); }
  }
}
template <int DK> __device__ __forceinline__ void qkt(f32x16& p0, f32x16& p1, LAS const char* Kt, const int (&ka)[DK / 16], const bf16x8* qr) {
  p0 = f32x16{}; p1 = f32x16{};
#pragma unroll
  for (int d0 = 0; d0 < DK / 16; ++d0) {
    const bf16x8 b0 = *(LAS const bf16x8*)(Kt + ka[d0]);
    const bf16x8 b1 = *(LAS const bf16x8*)(Kt + ka[d0] + (d0 < 4 ? 4096 : 2048));
    p0 = __builtin_amdgcn_mfma_f32_32x32x16_bf16(b0, qr[d0], p0, 0, 0, 0);
    p1 = __builtin_amdgcn_mfma_f32_32x32x16_bf16(b1, qr[d0], p1, 0, 0, 0); }
}
template <int DK, int DV> struct Cfg {
  static constexpr int KT = 64 * DK * 2, NB = DV / 32, VT = 64 * DV * 2, NQ = DK / 16;
  static constexpr int KN = DK / 64 + (DK % 64 != 0), VN = (64 * DV / 8) / 512;
  static constexpr int NS = 4;
  static constexpr int OFF_K = 0, OFF_V = NS * KT, OFF_WS = NS * (KT + VT), LDS_BYTES = OFF_WS + 8 * 64 * 4;
};
template <int DK, int DV>
__device__ __forceinline__ void attn_unit(const bf16* __restrict__ Qb, int ldq, const bf16* __restrict__ K1, int ldk1, const bf16* __restrict__ K2, int ldk2,
                                          const bf16* __restrict__ Vh, int ldv, float* __restrict__ Ob, int ldo, int nkeys, LAS char* lds) {
  using C = Cfg<DK, DV>;
  const int tid = threadIdx.x, wid = __builtin_amdgcn_readfirstlane(tid >> 6), lane = tid & 63, r32 = lane & 31, hi = lane >> 5;
  LAS float* ws = (LAS float*)(lds + C::OFF_WS) + wid * 64; LAS float* al_l = ws + 32;
  float m_reg = -1e30f; f32x16 o[C::NB] = {}; f32x4 lsum = {}; bf16x8 qr[C::NQ];
  bf16x8 sel; { const int i_ = lane & 15, kq_ = lane >> 4; const unsigned v_ = ((i_ == 0 && !(kq_ & 1)) || (i_ == 1 && (kq_ & 1))) ? 0x3F803F80u : 0u; u32x4 w_ = {v_, v_, v_, v_}; sel = *reinterpret_cast<bf16x8*>(&w_); }
  { const bf16* Qw = Qb + (long)(wid * 32 + r32) * ldq + hi * 8;
#pragma unroll
    for (int d0 = 0; d0 < C::NQ; ++d0) qr[d0] = *(const bf16x8*)(Qw + d0 * 16); }
  unsigned kg0, kg1 = 0, vg[C::VN];
  { const int row = tid >> 3, cp = tid & 7; kg0 = (unsigned)(row * ldk1 + ((cp ^ ((row >> 1) & 7)) * 8)); }
  if constexpr (C::KN == 2) { const int p = tid & 255, row = p >> 2, cp = p & 3; kg1 = (unsigned)(row * ldk2 + ((cp ^ ((row >> 2) & 3)) * 8)); }
#pragma unroll
  for (int i = 0; i < C::VN; ++i) { const int p = i * 512 + tid, st = p >> 5, wi = p & 31, kk = (st / C::NB) * 8 + (wi >> 2), col = (st % C::NB) * 32 + (wi & 3) * 8;
    const int k = (kk & ~0xC) | ((kk & 4) << 1) | ((kk & 8) >> 1); vg[i] = (unsigned)(k * ldv + col); }
  int ka[C::NQ];
#pragma unroll
  for (int d0 = 0; d0 < C::NQ; ++d0) ka[d0] = (d0 < 4) ? r32 * 128 + ((((d0 * 2) ^ hi ^ ((r32 >> 1) & 7)) & 7) << 4) : 8192 + r32 * 64 + (((((d0 - 4) * 2) ^ hi ^ ((r32 >> 2) & 3)) & 3) << 4);
  const int vb0 = (int)(uintptr_t)(lds + C::OFF_V) + v_rd_base(lane);
  const bool p3 = (C::KN == 1) || wid < 4;
#define ATT_ISSUE(S, t) do { const size_t t64_ = (size_t)(t) * 64; \
    __builtin_amdgcn_global_load_lds((const unsigned*)(K1 + t64_ * ldk1 + kg0), (LAS unsigned*)(lds + C::OFF_K + (S) * C::KT + wid * 1024), 16, 0, 0); \
    if constexpr (C::KN == 2) { if (wid < 4) __builtin_amdgcn_global_load_lds((const unsigned*)(K2 + t64_ * ldk2 + kg1), (LAS unsigned*)(lds + C::OFF_K + (S) * C::KT + 8192 + wid * 1024), 16, 0, 0); } \
    _Pragma("unroll") for (int i_ = 0; i_ < C::VN; ++i_) __builtin_amdgcn_global_load_lds((const unsigned*)(Vh + t64_ * ldv + vg[i_]), (LAS unsigned*)(lds + C::OFF_V + (S) * C::VT + (i_ * 512 + wid * 64) * 16), 16, 0, 0); } while (0)
#define ATT_LAND1() do { if (p3) asm volatile("s_waitcnt vmcnt(3)" ::: "memory"); else asm volatile("s_waitcnt vmcnt(2)" ::: "memory"); } while (0)
#define ATT_LAND2() do { if (p3) asm volatile("s_waitcnt vmcnt(6)" ::: "memory"); else asm volatile("s_waitcnt vmcnt(4)" ::: "memory"); } while (0)
#define ATT_RESC(a) do { if (__any((a) < 1.f)) { if (hi == 0) al_l[r32] = (a); asm volatile("s_waitcnt lgkmcnt(0)" ::: "memory"); \
    lsum[0] *= al_l[lane & 15]; lsum[1] *= al_l[16 + (lane & 15)]; \
    _Pragma("unroll") for (int r = 0; r < 16; ++r) { const float f_ = al_l[crow(r, hi)]; _Pragma("unroll") for (int d = 0; d < C::NB; ++d) o[d][r] *= f_; } } } while (0)
  static_assert(C::KN + C::VN == 3 && C::NS == 4, "three (two on waves 4..7 when DK = 96) DMA pieces per thread per tile; slot = tile & 3");
#define ATT_STEP(S, t, C0, C1, N0, N1, mnN, alN, LAST) do { ATT_SBAR(); \
    { const int ti_ = ((t) + 3 < NT) ? (t) + 3 : NT - 1; ATT_ISSUE(((S) + 3) & 3, ti_); } ATT_SBAR(); \
    if constexpr (!(LAST)) qkt<DK>(N0, N1, lds + C::OFF_K + (((S) + 1) & 3) * C::KT, ka, qr); \
    finishSM(C0, C1, pa0, pa1, pa2, pa3); ATT_SBAR(); \
    pv_sm<C::NB, (S) * C::VT, !(LAST)>(o, lsum, sel, vb0, pa0, pa1, pa2, pa3, N0, N1, m_reg, mnN, alN); ATT_SBAR(); \
    if constexpr (!(LAST)) { ATT_RESC(alN); } \
    ATT_LAND1(); __builtin_amdgcn_s_barrier(); } while (0)
  f32x16 pA0, pA1, pB0, pB1; float mnA, mnB, alA, alB; bf16x8 pa0, pa1, pa2, pa3; const int NT = nkeys / 64;
  asm volatile("s_waitcnt vmcnt(0) lgkmcnt(0)" ::: "memory"); __builtin_amdgcn_s_barrier();
  ATT_ISSUE(0, 0); ATT_ISSUE(1, 1); ATT_ISSUE(2, 2);
  ATT_LAND2(); __builtin_amdgcn_s_barrier();
  qkt<DK>(pA0, pA1, lds + C::OFF_K, ka, qr); partialSM(pA0, pA1, m_reg, mnA, alA);
  ATT_LAND1(); __builtin_amdgcn_s_barrier();
  int t = 0;
  for (; t + 4 < NT; t += 4) {
    ATT_STEP(0, t,     pA0, pA1, pB0, pB1, mnB, alB, false);
    ATT_STEP(1, t + 1, pB0, pB1, pA0, pA1, mnA, alA, false);
    ATT_STEP(2, t + 2, pA0, pA1, pB0, pB1, mnB, alB, false);
    ATT_STEP(3, t + 3, pB0, pB1, pA0, pA1, mnA, alA, false);
  }
  ATT_STEP(0, t,     pA0, pA1, pB0, pB1, mnB, alB, false);
  ATT_STEP(1, t + 1, pB0, pB1, pA0, pA1, mnA, alA, false);
  ATT_STEP(2, t + 2, pA0, pA1, pB0, pB1, mnB, alB, false);
  ATT_STEP(3, t + 3, pB0, pB1, pA0, pA1, mnA, alA, true);
  asm volatile("s_waitcnt vmcnt(0)" ::: "memory");
  float rli[16];
  if (lane < 16) { al_l[lane] = lsum[0]; al_l[16 + lane] = lsum[1]; }
  asm volatile("s_waitcnt lgkmcnt(0)" ::: "memory");
#pragma unroll
  for (int r = 0; r < 16; ++r) rli[r] = __builtin_amdgcn_rcpf(al_l[crow(r, hi)]);
  float* Ow = Ob + (long)(wid * 32) * ldo;
#pragma unroll
  for (int r = 0; r < 16; ++r) { const int orow = crow(r, hi);
#pragma unroll
    for (int d0 = 0; d0 < C::NB; ++d0) Ow[(long)orow * ldo + d0 * 32 + r32] = o[d0][r] * rli[r]; }
#undef ATT_ISSUE
#undef ATT_LAND1
#undef ATT_LAND2
#undef ATT_RESC
#undef ATT_STEP
}
}
constexpr int DM = 1024, NBATCH = 2, SEQ = 16384, CT = 256, TB = SEQ + CT  , R = NBATCH * TB  ;
constexpr int ATT_IN = 2208, ATT_NP = 2304, REC_IN = 3472, REC_NP = 3584, RWKV_IN = 1920;
constexpr int NE = 32, TOPK = 4, MAXT = R * TOPK / 256 + NE  , MAXROWS = MAXT * 256;
constexpr int NUNIT_M = 16 * 260;
constexpr float NORM_EPS = 1e-6f;
enum { I_X = 0, I_C, I_CTX, I_CCTX, I_NMIX, I_NFFN, I_ADAW, I_ADAB, I_WOUT, I_RW, I_RB, I_W1, I_B1, I_W2, I_B2, I_ATTW, I_LAM, I_SUBLN, I_QNW, I_KVNW, I_WUQ, I_WUKV,
       I_RECW, I_MU, I_W0, I_RW2, I_A0, I_A2, I_G2, I_KK, I_KA, I_RK, I_LNW, I_LNB, I_GATEB, I_MNW, I_FNW, N_IN };
constexpr size_t al256(size_t x) { return (x + 255) & ~(size_t)255; }
constexpr size_t WS_CTL = 0, CTL_ZERO_BYTES = 1u << 20;
constexpr size_t WS_MOD = CTL_ZERO_BYTES;
constexpr size_t WS_ROPE = al256(WS_MOD + 2 * 3 * 6144 * 4);
constexpr size_t ROPE_DR = 0, ROPE_DC = 256 * 16 * 2, ROPE_MR = ROPE_DC + 64 * 16 * 2, ROPE_MC = ROPE_MR + 256 * 8 * 2, ROPE_FLOATS = ROPE_MC + 64 * 8 * 2;
constexpr size_t WS_WRH = al256(WS_ROPE + ROPE_FLOATS * 4);
constexpr size_t WS_WRL = al256(WS_WRH + (size_t)2 * 32 * 1024 * 2);
constexpr size_t WS_WIN0 = al256(WS_WRL + (size_t)2 * 32 * 1024 * 2);
constexpr size_t WS_WUQ = al256(WS_WIN0 + (size_t)ATT_NP * 1024 * 2);
constexpr size_t WS_WUKV = al256(WS_WUQ + (size_t)768 * 384 * 2);
constexpr size_t WS_WOUT = al256(WS_WUKV + (size_t)1024 * 256 * 2);
constexpr size_t WS_WREC = al256(WS_WOUT + (size_t)2 * 1024 * 1024 * 2);
constexpr size_t WS_WLORA = al256(WS_WREC + (size_t)REC_NP * 1024 * 2);
constexpr size_t WS_W1T = al256(WS_WLORA + (size_t)2560 * 384 * 2);
constexpr size_t WS_W2T = al256(WS_W1T + (size_t)NE * 2048 * 1024 * 2);
constexpr size_t WS_H = al256(WS_W2T + (size_t)NE * 1024 * 1024 * 2);
constexpr size_t WS_A = al256(WS_H + (size_t)R * 1024 * 4);
constexpr size_t WS_A1 = al256(WS_A + (size_t)R * 1024 * 2);
constexpr size_t WS_F = al256(WS_A1 + (size_t)R * 1024 * 2);
constexpr size_t WS_P = al256(WS_F + (size_t)R * 1024 * 2);
constexpr size_t WS_TOPE = al256(WS_P + (size_t)R * REC_NP * 2);
constexpr size_t WS_GATE = al256(WS_TOPE + (size_t)R * 16);
constexpr size_t WS_POS = al256(WS_GATE + (size_t)R * 16);
constexpr size_t WS_DEST = al256(WS_POS + (size_t)R * 16);
constexpr size_t WS_TILE = al256(WS_DEST + (size_t)R * 16);
constexpr size_t WS_SRC = al256(WS_TILE + (size_t)(MAXT + 8) * 4);
constexpr size_t WS_T = al256(WS_SRC + (size_t)MAXROWS * 4);
constexpr size_t WS_QD = WS_T;
constexpr size_t WS_KD = al256(WS_QD + (size_t)R * 512 * 2);
constexpr size_t WS_CQN = al256(WS_KD + (size_t)R * 512 * 2);
constexpr size_t WS_CKVN = al256(WS_CQN + (size_t)R * 384 * 2);
constexpr size_t WS_MQ = al256(WS_CKVN + (size_t)R * 256 * 2);
constexpr size_t WS_MKV = al256(WS_MQ + (size_t)R * 768 * 2);
constexpr size_t WS_KRR = al256(WS_MKV + (size_t)R * 1024 * 2);
constexpr size_t WS_ODIFF = al256(WS_KRR + (size_t)R * 32 * 2);
constexpr size_t WS_OMLA = al256(WS_ODIFF + (size_t)R * 1024 * 4);
constexpr size_t WS_T0_END = al256(WS_OMLA + (size_t)R * 512 * 4);
constexpr size_t WS_XS = WS_T;
constexpr size_t WS_HS = al256(WS_XS + (size_t)MAXROWS * 1024 * 2);
constexpr size_t WS_TM_END = al256(WS_HS + (size_t)MAXROWS * 1024 * 2);
constexpr size_t SZ_RC = (size_t)R * 512 * 4;
constexpr size_t WS_RR = WS_T, WS_VV = WS_RR + SZ_RC, WS_AKK = WS_VV + SZ_RC, WS_KL = WS_AKK + SZ_RC;
constexpr size_t WS_WDEC = WS_KL + SZ_RC  , WS_KDIR = WS_WDEC + 2 * SZ_RC  , WS_BB = WS_KDIR + 2 * SZ_RC  , WS_GG = WS_BB + 2 * SZ_RC;
constexpr size_t WS_ALORA = al256(WS_GG + SZ_RC);
constexpr size_t WS_YR = al256(WS_ALORA + (size_t)R * 384 * 2);
constexpr size_t WS_DC = WS_YR;
constexpr size_t WS_HM = al256(WS_YR + 2 * SZ_RC);
constexpr size_t WS_CST = al256(WS_HM + 2 * SZ_RC);
constexpr size_t WS_DN = al256(WS_CST + (size_t)NUNIT_M * 8192 * 4);
constexpr size_t WS_NST = al256(WS_DN + (size_t)NUNIT_M * 64 * 4);
constexpr size_t WS_SC = al256(WS_NST + (size_t)NUNIT_M * 64 * 4);
constexpr size_t WS_MST = al256(WS_SC + (size_t)NUNIT_M * 2 * 4);
constexpr size_t WS_ASIG = WS_KDIR;
constexpr size_t WS_YB = WS_BB;
constexpr int NUNIT_R = 32 * 260;
constexpr size_t WS_RKM = WS_KDIR + SZ_RC;
static_assert((size_t)NUNIT_R * 4096 * 2 <= SZ_RC, "M^T fits in KL");
constexpr size_t WS_RKQ = al256(WS_MST + (size_t)NUNIT_M * 4);
constexpr size_t WS_RKZ = al256(WS_RKQ + (size_t)NUNIT_R * 4096 * 2);
constexpr size_t WS_T1_END = al256(WS_RKZ + (size_t)NUNIT_R * 4096 * 2);
constexpr size_t WS_END = WS_T1_END > WS_TM_END ? (WS_T1_END > WS_T0_END ? WS_T1_END : WS_T0_END) : (WS_TM_END > WS_T0_END ? WS_TM_END : WS_T0_END);
static_assert(WS_END <= (size_t)2147483648ull, "workspace map exceeds 2 GiB");
constexpr int CW_CNT = 1024;
constexpr int CW_BAR = 4096;
constexpr int RING_BYTES = 131072, AUX_OFF = 131072, AUX_BYTES = 16384, MISC_OFF = 147456, LDS_BYTES = 163840;

struct Frame {
    LAS unsigned char* lds; gu32* ctl; int tid, lane, wave, blk, G, probe;
    float* out; unsigned char* ws;
    struct InTab { LAS const unsigned* t;
        __device__ __forceinline__ const float* operator[](int i) const { const unsigned lo = __builtin_amdgcn_readfirstlane(t[2 * i]), hi = __builtin_amdgcn_readfirstlane(t[2 * i + 1]);
            return (const float*)(((unsigned long long)hi << 32) | lo); } } in;
};
template <class T> __device__ __forceinline__ T* wsp(const Frame& F, size_t off) { return (T*)(F.ws + off); }
__device__ __forceinline__ int row_sel(int row) { const int b = row / TB, t = row - b * TB; return t < CT ? 2 : b; }
__device__ __forceinline__ const float* h0_row(const Frame& F, int row) {
    const int b = row / TB, t = row - b * TB;
    return t < CT ? F.in[I_CTX] + ((size_t)b * CT + t) * DM : F.in[I_X] + ((size_t)b * SEQ + (t - CT)) * DM;
}
__device__ __forceinline__ const float* modp(const Frame& F, int layer, int sel, int chunk) { return wsp<const float>(F, WS_MOD) + ((size_t)(layer * 3 + sel) * 6 + chunk) * DM; }
__device__ __forceinline__ int scan_tok(int z, int sg) { return z == 0 ? sg : (sg < CT ? CT - 1 - sg : TB + CT - 1 - sg); }
__device__ __forceinline__ void tr_item(const float* W, int K, int N, bf16* WT, int row_off, LAS float* scr, int kb, int nb, int lane) {
    const int k0 = 64 * kb, n0 = 32 * nb;
    const int n = n0 + (lane & 31);
    float tv[32];
#pragma unroll
    for (int i = 0; i < 32; ++i) { const int kk = 2 * i + (lane >> 5); tv[i] = (n < N) ? W[(size_t)(k0 + kk) * N + n] : 0.f; }
#pragma unroll
    for (int i = 0; i < 32; ++i) { const int kk = 2 * i + (lane >> 5); scr[kk * 33 + (lane & 31)] = tv[i]; }
    LDS_WAIT(); asm volatile("" ::: "memory");
    const int c = lane & 7;
#pragma unroll
    for (int j = 0; j < 4; ++j) { const int nn = (lane >> 3) + 8 * j; const LAS float* s = scr + (8 * c) * 33 + nn;
        v4u o; o.x = pk2(s[0 * 33], s[1 * 33]); o.y = pk2(s[2 * 33], s[3 * 33]); o.z = pk2(s[4 * 33], s[5 * 33]); o.w = pk2(s[6 * 33], s[7 * 33]);
        *(v4u*)(WT + (size_t)(row_off + n0 + nn) * K + k0 + 8 * c) = o; }
    LDS_WAIT(); asm volatile("" ::: "memory");
}
__device__ __forceinline__ void tr_family(const Frame& F, const float* W, size_t src_stride, int nmat, int K, int N, int Npad, bf16* WT, int gw, int NGW) {
    LAS float* scr = (LAS float*)(F.lds + F.wave * 16384);
    const int nkb = K / 64, nnb = Npad / 32, per = nkb * nnb, total = per * nmat;
    for (int it = gw; it < total; it += NGW) { const int m = it / per, r = it - m * per, kb = r / nnb, nb = r - kb * nnb;
        tr_item(W + (size_t)m * src_stride, K, N, WT, m * Npad, scr, kb, nb, F.lane); }
}
__device__ __forceinline__ void moe_weights_convert(const Frame& F, int layer, int gw, int NGW) {
    tr_family(F, F.in[I_W1] + (size_t)layer * NE * 1024 * 2048, (size_t)1024 * 2048, NE, 1024, 2048, 2048, wsp<bf16>(F, WS_W1T), gw, NGW);
    tr_family(F, F.in[I_W2] + (size_t)layer * NE * 1024 * 1024, (size_t)1024 * 1024, NE, 1024, 1024, 1024, wsp<bf16>(F, WS_W2T), gw, NGW);
}
__device__ __forceinline__ void norm_mod_row(const Frame& F, const float* src, const float* nw, const float* shift, const float* scale, bf16* orow) {
    const f32x4* xr = (const f32x4*)src + F.lane;
    f32x4 v[4]; float s = 0.f;
#pragma unroll
    for (int j = 0; j < 4; ++j) { v[j] = xr[64 * j]; s += (v[j].x * v[j].x + v[j].y * v[j].y) + (v[j].z * v[j].z + v[j].w * v[j].w); }
    const float rs = 1.f / sqrtf(wave_sum(s) * (1.f / DM) + NORM_EPS);
    unsigned long long* o8 = (unsigned long long*)orow + F.lane;
#pragma unroll
    for (int j = 0; j < 4; ++j) { const f32x4 w = ((const f32x4*)nw)[F.lane + 64 * j], sh = ((const f32x4*)shift)[F.lane + 64 * j], sc = ((const f32x4*)scale)[F.lane + 64 * j];
        const f32x4 y = v[j] * rs * w * (sc + 1.f) + sh;
        o8[64 * j] = (unsigned long long)pk2(y.x, y.y) | ((unsigned long long)pk2(y.z, y.w) << 32); }
}
__device__ __forceinline__ void p0a(const Frame& F) {
    LAS float* sv = (LAS float*)F.lds; LAS float* red = (LAS float*)(F.lds + 16384);
    for (int i = F.tid; i < 3 * DM; i += 512) { const int s = i / DM, k = i - s * DM; const float cv = (s < 2) ? F.in[I_C][s * DM + k] : F.in[I_CCTX][k]; sv[i] = cv / (1.f + __expf(-cv)); }
    __syncthreads();
    for (int it = F.blk; it < 192; it += F.G) {
        const int l = it / 96, cgp = it - l * 96, kq = F.tid >> 4, cg = F.tid & 15, col = cgp * 64 + cg * 4;
        float acc[3][4];
#pragma unroll
        for (int s = 0; s < 3; ++s)
#pragma unroll
            for (int j = 0; j < 4; ++j) acc[s][j] = 0.f;
        const float* W = F.in[I_ADAW] + (size_t)l * DM * 6144 + col;
#pragma unroll 16
        for (int kk = 0; kk < 32; ++kk) { const int k = kq * 32 + kk; const f32x4 w = *(const f32x4*)(W + (size_t)k * 6144);
            const float s0 = sv[k], s1 = sv[DM + k], s2 = sv[2 * DM + k];
#pragma unroll
            for (int j = 0; j < 4; ++j) { acc[0][j] += s0 * w[j]; acc[1][j] += s1 * w[j]; acc[2][j] += s2 * w[j]; } }
#pragma unroll
        for (int s = 0; s < 3; ++s)
#pragma unroll
            for (int j = 0; j < 4; ++j) red[(kq * 16 + cg) * 12 + s * 4 + j] = acc[s][j];
        __syncthreads();
        if (F.tid < 192) { const int s = F.tid / 64, cc = F.tid - s * 64, cg2 = cc >> 2, j = cc & 3; float t = 0.f;
            for (int q = 0; q < 32; ++q) t += red[(q * 16 + cg2) * 12 + s * 4 + j];
            wsp<float>(F, WS_MOD)[(size_t)(l * 3 + s) * 6144 + cgp * 64 + cc] = t + F.in[I_ADAB][l * 6144 + cgp * 64 + cc]; }
        __syncthreads();
    }
    const int gid = F.blk * 512 + F.tid, GT = F.G * 512;
    float* rope = wsp<float>(F, WS_ROPE);
    for (int i = gid; i < 256 * 16 + 64 * 16 + 256 * 8 + 64 * 8; i += GT) {
        int j = i; float pos, inv; size_t off;
        if (j < 256 * 16) { pos = (float)(j / 16); inv = powf(10000.f, -(float)(j % 16) / 16.f); off = ROPE_DR + (size_t)j * 2; }
        else if ((j -= 256 * 16) < 64 * 16) { pos = (float)(j / 16); inv = powf(10000.f, -(float)(j % 16) / 16.f); off = ROPE_DC + (size_t)j * 2; }
        else if ((j -= 64 * 16) < 256 * 8) { pos = (float)(j / 8); inv = powf(10000.f, -(float)(j % 8) / 8.f); off = ROPE_MR + (size_t)j * 2; }
        else { j -= 256 * 8; pos = (float)(j / 8); inv = powf(10000.f, -(float)(j % 8) / 8.f); off = ROPE_MC + (size_t)j * 2; }
        const float ang = pos * inv; rope[off] = cosf(ang); rope[off + 1] = sinf(ang);
    }
    { bf16* wh = wsp<bf16>(F, WS_WRH); bf16* wl = wsp<bf16>(F, WS_WRL); for (int i = gid; i < 2 * 32 * 1024; i += GT) { const int k = i & 1023, e = (i >> 10) & 31, l = i >> 15; const float wv = F.in[I_RW][((size_t)l * DM + k) * NE + e];
        const unsigned hb = f2bf(wv); wh[i] = (bf16)hb; wl[i] = (bf16)f2bf(wv - bf2f((bf16)hb)); } }
    bf16* WL = wsp<bf16>(F, WS_WLORA);
    for (int i = gid; i < 2560 * 384; i += GT) { const int n = i / 384, k = i - n * 384, part = n >> 9, c = n & 511; float v = 0.f;
        if (part < 2) { if ((k >> 6) == part) v = F.in[I_RW2][((size_t)part * 64 + (k & 63)) * 512 + c]; }
        else if (part < 4) { if ((k >> 6) == part) v = F.in[I_A2][((size_t)(part - 2) * 64 + (k & 63)) * 512 + c]; }
        else { if (k >= 256) v = F.in[I_G2][(size_t)(k - 256) * 512 + c]; }
        WL[i] = (bf16)f2bf(v); }
    const int gw = F.blk * 8 + F.wave, NGW = F.G * 8;
    tr_family(F, F.in[I_ATTW], 0, 1, 1024, ATT_IN, ATT_NP, wsp<bf16>(F, WS_WIN0), gw, NGW);
    tr_family(F, F.in[I_WUQ], 0, 1, 384, 768, 768, wsp<bf16>(F, WS_WUQ), gw, NGW);
    tr_family(F, F.in[I_WUKV], 0, 1, 256, 1024, 1024, wsp<bf16>(F, WS_WUKV), gw, NGW);
    tr_family(F, F.in[I_WOUT], (size_t)1024 * 1024, 2, 1024, 1024, 1024, wsp<bf16>(F, WS_WOUT), gw, NGW);
    tr_family(F, F.in[I_RECW], 0, 1, 1024, REC_IN, REC_NP, wsp<bf16>(F, WS_WREC), gw, NGW);
    moe_weights_convert(F, 0, gw, NGW);
}
__device__ __forceinline__ void p0b(const Frame& F) {
    const int gw = F.blk * 8 + F.wave, NGW = F.G * 8;
    for (int row = gw; row < R; row += NGW) { const int sel = row_sel(row);
        norm_mod_row(F, h0_row(F, row), F.in[I_NMIX], modp(F, 0, sel, 0), modp(F, 0, sel, 1), wsp<bf16>(F, WS_A) + (size_t)row * DM); }
}
struct FnStoreBf16 {
    bf16* O; int ldc;
    __device__ __forceinline__ void operator()(int row, int col, f32x4 v0, f32x4 v1) const {
        v4u w; w.x = pg8::cvt_pk_bf16(v0[0], v0[1]); w.y = pg8::cvt_pk_bf16(v0[2], v0[3]); w.z = pg8::cvt_pk_bf16(v1[0], v1[1]); w.w = pg8::cvt_pk_bf16(v1[2], v1[3]);
        *(v4u*)(O + (size_t)row * ldc + col) = w; }
};
struct FnWout {
    const Frame* F; int layer;
    __device__ __forceinline__ void operator()(int row, int col, f32x4 v0, f32x4 v1) const {
        bf16* hrow = wsp<bf16>(*F, WS_H) + (size_t)row * DM + col;
        const float* g = modp(*F, layer, row_sel(row), 2) + col;
        const f32x4 g0 = *(const f32x4*)g, g1 = *(const f32x4*)(g + 4); f32x4 b0, b1;
        if (layer == 0) { const float* base = h0_row(*F, row) + col; b0 = *(const f32x4*)base; b1 = *(const f32x4*)(base + 4); }
        else { float x[8]; unpack8(*(const v4u*)hrow, x); b0 = (f32x4){x[0], x[1], x[2], x[3]}; b1 = (f32x4){x[4], x[5], x[6], x[7]}; }
        const f32x4 o0 = b0 + g0 * v0, o1 = b1 + g1 * v1; v4u w; w.x = pk2(o0.x, o0.y); w.y = pk2(o0.z, o0.w); w.z = pk2(o1.x, o1.y); w.w = pk2(o1.z, o1.w);
        *(v4u*)hrow = w; }
};
__device__ __forceinline__ void l0_post_proj(const Frame& F) {
    const int gw = F.blk * 8 + F.wave, NGW = F.G * 8, lane = F.lane;
    const bf16* P = wsp<const bf16>(F, WS_P); const float* rope = wsp<const float>(F, WS_ROPE);
    constexpr float CD = 0.125f * 1.4426950408889634f;
    for (int row = gw; row < R; row += NGW) {
        const int b = row / TB, t = row - b * TB; const bool lat = t >= CT; const int pos = t - CT, prow = lat ? pos >> 6 : 0, pcol = lat ? pos & 63 : 0;
        const bf16* p = P + (size_t)row * ATT_NP;
        bf16* qd = wsp<bf16>(F, WS_QD) + (size_t)row * 512; bf16* kd = wsp<bf16>(F, WS_KD) + (size_t)row * 512;
#pragma unroll
        for (int j = 0; j < 2; ++j) { const int g = lane + 64 * j, h16 = g >> 3, i0 = (g & 7) * 4;
            const v2u w1 = *(const v2u*)(p + h16 * 64 + i0), w2 = *(const v2u*)(p + h16 * 64 + i0 + 32);
            const float x1[4] = {bflo(w1.x), bfhi(w1.x), bflo(w1.y), bfhi(w1.y)}, x2[4] = {bflo(w2.x), bfhi(w2.x), bflo(w2.y), bfhi(w2.y)};
            float cs[8] = {1.f, 0.f, 1.f, 0.f, 1.f, 0.f, 1.f, 0.f};
            if (lat) { const float* tb = (i0 < 16) ? rope + ROPE_DR + (size_t)(prow * 16 + i0) * 2 : rope + ROPE_DC + (size_t)(pcol * 16 + i0 - 16) * 2;
                const f32x4 t0 = *(const f32x4*)tb, t1 = *(const f32x4*)(tb + 4); cs[0] = t0.x; cs[1] = t0.y; cs[2] = t0.z; cs[3] = t0.w; cs[4] = t1.x; cs[5] = t1.y; cs[6] = t1.z; cs[7] = t1.w; }
            float y1[4], y2[4]; const float sc = h16 < 8 ? CD : 1.f;
#pragma unroll
            for (int e = 0; e < 4; ++e) { y1[e] = (x1[e] * cs[2 * e] - x2[e] * cs[2 * e + 1]) * sc; y2[e] = (x1[e] * cs[2 * e + 1] + x2[e] * cs[2 * e]) * sc; }
            bf16* o = (h16 < 8) ? qd + h16 * 64 + i0 : kd + (h16 - 8) * 64 + i0;
            v2u o1, o2; o1.x = pk2(y1[0], y1[1]); o1.y = pk2(y1[2], y1[3]); o2.x = pk2(y2[0], y2[1]); o2.y = pk2(y2[2], y2[3]);
            *(v2u*)o = o1; *(v2u*)(o + 32) = o2; }
        { float x[8]; float ss = 0.f; const bool act = lane < 48;
          if (act) unpack8(*(const v4u*)(p + 1536 + 8 * lane), x); else {
#pragma unroll
              for (int e = 0; e < 8; ++e) x[e] = 0.f; }
#pragma unroll
          for (int e = 0; e < 8; ++e) ss += x[e] * x[e];
          const float rs = 1.f / sqrtf(wave_sum(ss) * (1.f / 384.f) + NORM_EPS);
          if (act) { const f32x4 g0 = *(const f32x4*)(F.in[I_QNW] + 8 * lane), g1 = *(const f32x4*)(F.in[I_QNW] + 8 * lane + 4); v4u w;
              w.x = pk2(x[0] * rs * g0.x, x[1] * rs * g0.y); w.y = pk2(x[2] * rs * g0.z, x[3] * rs * g0.w); w.z = pk2(x[4] * rs * g1.x, x[5] * rs * g1.y); w.w = pk2(x[6] * rs * g1.z, x[7] * rs * g1.w);
              *(v4u*)(wsp<bf16>(F, WS_CQN) + (size_t)row * 384 + 8 * lane) = w; } }
        { const v2u wv = *(const v2u*)(p + 1920 + 4 * lane); const float x[4] = {bflo(wv.x), bfhi(wv.x), bflo(wv.y), bfhi(wv.y)};
          const float rs = 1.f / sqrtf(wave_sum((x[0] * x[0] + x[1] * x[1]) + (x[2] * x[2] + x[3] * x[3])) * (1.f / 256.f) + NORM_EPS);
          const f32x4 g0 = *(const f32x4*)(F.in[I_KVNW] + 4 * lane); v2u w; w.x = pk2(x[0] * rs * g0.x, x[1] * rs * g0.y); w.y = pk2(x[2] * rs * g0.z, x[3] * rs * g0.w);
          *(v2u*)(wsp<bf16>(F, WS_CKVN) + (size_t)row * 256 + 4 * lane) = w; }
        if (lane < 16) { const int i = lane; const float x1 = bf2f(p[2176 + i]), x2 = bf2f(p[2176 + i + 16]); float c = 1.f, s = 0.f;
            if (lat) { const float* tb = (i < 8) ? rope + ROPE_MR + (size_t)(prow * 8 + i) * 2 : rope + ROPE_MC + (size_t)(pcol * 8 + i - 8) * 2; c = tb[0]; s = tb[1]; }
            bf16* o = wsp<bf16>(F, WS_KRR) + (size_t)row * 32; o[i] = (bf16)f2bf(x1 * c - x2 * s); o[i + 16] = (bf16)f2bf(x1 * s + x2 * c); }
    }
}
__device__ __forceinline__ void l0_mq_rope(const Frame& F) {
    const int gw = F.blk * 8 + F.wave, NGW = F.G * 8, lane = F.lane; const float* rope = wsp<const float>(F, WS_ROPE);
    const float CM = 0.10206207261596575f * 1.4426950408889634f;
    for (int row = gw; row < R; row += NGW) {
        const int b = row / TB, t = row - b * TB; const bool lat = t >= CT; const int pos = t - CT, prow = lat ? pos >> 6 : 0, pcol = lat ? pos & 63 : 0;
        bf16* q = wsp<bf16>(F, WS_MQ) + (size_t)row * 768;
#pragma unroll
        for (int j = 0; j < 2; ++j) { const int g = lane + 64 * j, h = g >> 4, d0 = (g & 15) * 4;
            const v2u wv = *(const v2u*)(q + h * 96 + d0); v2u o; o.x = pk2(bflo(wv.x) * CM, bfhi(wv.x) * CM); o.y = pk2(bflo(wv.y) * CM, bfhi(wv.y) * CM); *(v2u*)(q + h * 96 + d0) = o; }
#pragma unroll
        for (int j = 0; j < 2; ++j) { const int pr = lane + 64 * j, h = pr >> 4, i = pr & 15; const float x1 = bf2f(q[h * 96 + 64 + i]), x2 = bf2f(q[h * 96 + 80 + i]); float c = 1.f, s = 0.f;
            if (lat) { const float* tb = (i < 8) ? rope + ROPE_MR + (size_t)(prow * 8 + i) * 2 : rope + ROPE_MC + (size_t)(pcol * 8 + i - 8) * 2; c = tb[0]; s = tb[1]; }
            q[h * 96 + 64 + i] = (bf16)f2bf((x1 * c - x2 * s) * CM); q[h * 96 + 80 + i] = (bf16)f2bf((x1 * s + x2 * c) * CM); }
    }
}
__device__ __forceinline__ void l0_attention(const Frame& F) {
    LAS char* lds = (LAS char*)F.lds;
    const bf16* QD = wsp<const bf16>(F, WS_QD); const bf16* KD = wsp<const bf16>(F, WS_KD); const bf16* P = wsp<const bf16>(F, WS_P);
    const bf16* MQ = wsp<const bf16>(F, WS_MQ); const bf16* MKV = wsp<const bf16>(F, WS_MKV); const bf16* KRR = wsp<const bf16>(F, WS_KRR);
    float* OD = wsp<float>(F, WS_ODIFF); float* OM = wsp<float>(F, WS_OMLA);
    for (int kind = 0; kind < 2; ++kind) {
        for (int L = F.blk; L < 1024 + 16; L += F.G) {
            int b, h8, qb, nkeys;
            if (L < 1024) { int pair;
                if (F.G == 256) { const int round = L >> 8, c = L & 255; pair = round * 4 + ((c & 7) >> 1); qb = 1 + (c & 1) * 32 + (c >> 3); }
                else { pair = L >> 6; qb = 1 + (L & 63); }
                b = pair >> 3; h8 = pair & 7; nkeys = TB; }
            else { const int s = L - 1024; b = s >> 3; h8 = s & 7; qb = 0; nkeys = CT; }
            const size_t q0 = (size_t)b * TB + (size_t)qb * 256, k0 = (size_t)b * TB;
            if (kind == 0)
                att::attn_unit<64, 128>(QD + q0 * 512 + h8 * 64, 512, KD + k0 * 512 + h8 * 64, 512, nullptr, 0, P + k0 * ATT_NP + 1024 + (h8 >> 1) * 128, ATT_NP,
                                        OD + q0 * 1024 + h8 * 128, 1024, nkeys, lds);
            else
                att::attn_unit<96, 64>(MQ + q0 * 768 + h8 * 96, 768, MKV + k0 * 1024 + h8 * 128, 1024, KRR + k0 * 32, 32, MKV + k0 * 1024 + h8 * 128 + 64, 1024,
                                       OM + q0 * 512 + h8 * 64, 512, nkeys, lds);
        }
    }
}
__device__ __forceinline__ void l0_combine(const Frame& F) {
    const int gw = F.blk * 8 + F.wave, NGW = F.G * 8, lane = F.lane;
    const float* lv = F.in[I_LAM];
    const float lam = __expf(wave_sum(lv[lane] * lv[64 + lane])) - __expf(wave_sum(lv[128 + lane] * lv[192 + lane])) + 0.2f;
    const float sw0 = F.in[I_SUBLN][2 * lane] * 0.8f, sw1 = F.in[I_SUBLN][2 * lane + 1] * 0.8f;
    for (int row = gw; row < R; row += NGW) {
        const float* od = wsp<const float>(F, WS_ODIFF) + (size_t)row * 1024; const float* om = wsp<const float>(F, WS_OMLA) + (size_t)row * 512;
        bf16* a1 = wsp<bf16>(F, WS_A1) + (size_t)row * DM;
#pragma unroll
        for (int h = 0; h < 4; ++h) {
            const float o1a = od[(2 * h) * 128 + 2 * lane], o1b = od[(2 * h) * 128 + 2 * lane + 1], o2a = od[(2 * h + 1) * 128 + 2 * lane], o2b = od[(2 * h + 1) * 128 + 2 * lane + 1];
            const float da = o1a - lam * o2a, db = o1b - lam * o2b;
            const float rs = 1.f / sqrtf(wave_sum(da * da + db * db) * (1.f / 128.f) + NORM_EPS);
            *(unsigned*)(a1 + h * 128 + 2 * lane) = pk2(da * rs * sw0, db * rs * sw1); }
#pragma unroll
        for (int j = 0; j < 2; ++j) { const f32x4 v = *(const f32x4*)(om + 4 * (lane + 64 * j)); v2u w; w.x = pk2(v.x, v.y); w.y = pk2(v.z, v.w); *(v2u*)(a1 + 512 + 4 * (lane + 64 * j)) = w; }
    }
}
constexpr int RT_LS = 264;
__device__ __forceinline__ void ph_router(const Frame& F, int layer) {
    LAS bf16* AH = (LAS bf16*)F.lds; LAS bf16* AL = AH + 64 * RT_LS; LAS bf16* WH = AL + 64 * RT_LS; LAS bf16* WL = WH + 32 * RT_LS;
    LAS float* lg = (LAS float*)(F.lds + 110592);
    LAS int* hist = (LAS int*)(F.lds + MISC_OFF + 256);
    LAS int* recs = (LAS int*)(F.lds + MISC_OFF + 512);
    const int lane = F.lane, w = F.wave, tid = F.tid, RPB = (R + F.G - 1) / F.G, row0 = F.blk * RPB;
    if (tid < 64) hist[tid] = 0;
    { int* srct = wsp<int>(F, WS_SRC); for (int i = F.blk * 512 + tid; i < MAXROWS; i += F.G * 512) srct[i] = 0; }
    const float* nw = F.in[I_NFFN] + (size_t)layer * DM; const float* rbp = F.in[I_RB] + layer * NE;
    const bf16* wrh = wsp<const bf16>(F, WS_WRH) + (size_t)layer * 32 * 1024; const bf16* wrl = wsp<const bf16>(F, WS_WRL) + (size_t)layer * 32 * 1024;
    for (int pass = 0; pass * 64 < RPB; ++pass) {
        const int nrow = min(64, min(RPB - pass * 64, R - row0 - pass * 64));
        f32x4 fr[8][4];
#pragma unroll
        for (int i = 0; i < 8; ++i) { const int rl = w + 8 * i; const int row = row0 + pass * 64 + rl;
            if (rl < nrow) {
                const int sel = row_sel(row); const float* sh = modp(F, layer, sel, 3); const float* sc = modp(F, layer, sel, 4);
                const v2u* xr = (const v2u*)(wsp<const bf16>(F, WS_H) + (size_t)row * DM) + lane; float s = 0.f;
#pragma unroll
                for (int j = 0; j < 4; ++j) { const v2u hw = xr[64 * j]; fr[i][j] = (f32x4){bflo(hw.x), bfhi(hw.x), bflo(hw.y), bfhi(hw.y)}; s += (fr[i][j].x * fr[i][j].x + fr[i][j].y * fr[i][j].y) + (fr[i][j].z * fr[i][j].z + fr[i][j].w * fr[i][j].w); }
                const float rs = 1.f / sqrtf(wave_sum(s) * (1.f / DM) + NORM_EPS);
                unsigned long long* o8 = (unsigned long long*)(wsp<bf16>(F, WS_F) + (size_t)row * DM) + lane;
#pragma unroll
                for (int j = 0; j < 4; ++j) { const f32x4 ww = ((const f32x4*)nw)[lane + 64 * j], a = ((const f32x4*)sh)[lane + 64 * j], c = ((const f32x4*)sc)[lane + 64 * j];
                    fr[i][j] = fr[i][j] * rs * ww * (c + 1.f) + a;
                    o8[64 * j] = (unsigned long long)pk2(fr[i][j].x, fr[i][j].y) | ((unsigned long long)pk2(fr[i][j].z, fr[i][j].w) << 32); }
            } else {
#pragma unroll
                for (int j = 0; j < 4; ++j) fr[i][j] = (f32x4){0.f, 0.f, 0.f, 0.f};
            } }
        pg8::f32x4 acc = {0.f, 0.f, 0.f, 0.f};
#pragma unroll
        for (int c = 0; c < 4; ++c) {
            __syncthreads();
#pragma unroll
            for (int i = 0; i < 8; ++i) { const f32x4 v = fr[i][c]; const unsigned h0 = pk2(v.x, v.y), h1 = pk2(v.z, v.w);
                const unsigned l0 = pk2(v.x - bflo(h0), v.y - bfhi(h0)), l1 = pk2(v.z - bflo(h1), v.w - bfhi(h1));
                v2u hh; hh.x = h0; hh.y = h1; v2u ll; ll.x = l0; ll.y = l1;
                *(LAS v2u*)(AH + (w + 8 * i) * RT_LS + 4 * lane) = hh; *(LAS v2u*)(AL + (w + 8 * i) * RT_LS + 4 * lane) = ll; }
            { const int e = tid >> 4, kp = (tid & 15) * 16;
              const v4u a0 = *(const v4u*)(wrh + (size_t)e * 1024 + 256 * c + kp), a1 = *(const v4u*)(wrh + (size_t)e * 1024 + 256 * c + kp + 8);
              const v4u b0 = *(const v4u*)(wrl + (size_t)e * 1024 + 256 * c + kp), b1 = *(const v4u*)(wrl + (size_t)e * 1024 + 256 * c + kp + 8);
              *(LAS v4u*)(WH + e * RT_LS + kp) = a0; *(LAS v4u*)(WH + e * RT_LS + kp + 8) = a1; *(LAS v4u*)(WL + e * RT_LS + kp) = b0; *(LAS v4u*)(WL + e * RT_LS + kp + 8) = b1; }
            __syncthreads();
            const int tm = w >> 1, tn = w & 1, lr = lane & 15, kq = (lane >> 4) * 8;
            const LAS bf16* ahp = AH + (tm * 16 + lr) * RT_LS + kq; const LAS bf16* alp = AL + (tm * 16 + lr) * RT_LS + kq;
            const LAS bf16* whp = WH + (tn * 16 + lr) * RT_LS + kq; const LAS bf16* wlp = WL + (tn * 16 + lr) * RT_LS + kq;
#pragma unroll
            for (int ks = 0; ks < 8; ++ks) { const bf16x8 ah = *(const LAS bf16x8*)(ahp + 32 * ks), al = *(const LAS bf16x8*)(alp + 32 * ks), bh = *(const LAS bf16x8*)(whp + 32 * ks), bl = *(const LAS bf16x8*)(wlp + 32 * ks);
                acc = __builtin_amdgcn_mfma_f32_16x16x32_bf16(ah, bh, acc, 0, 0, 0); acc = __builtin_amdgcn_mfma_f32_16x16x32_bf16(ah, bl, acc, 0, 0, 0); acc = __builtin_amdgcn_mfma_f32_16x16x32_bf16(al, bh, acc, 0, 0, 0); }
        }
        { const int m0 = (w >> 1) * 16 + (lane >> 4) * 4, n = (w & 1) * 16 + (lane & 15);
#pragma unroll
          for (int r = 0; r < 4; ++r) lg[(m0 + r) * 33 + n] = acc[r]; }
        __syncthreads();
        if (tid < nrow) { const int rl = tid, row = row0 + pass * 64 + rl; float lv[32];
#pragma unroll
            for (int e = 0; e < 32; ++e) lv[e] = lg[rl * 33 + e] + rbp[e];
            float selv[4]; int seli[4];
#pragma unroll
            for (int r = 0; r < 4; ++r) { float bv = -3.0e38f; int bi = 0;
#pragma unroll
                for (int e = 0; e < 32; ++e) { const bool taken = (r > 0 && seli[0] == e) || (r > 1 && seli[1] == e) || (r > 2 && seli[2] == e); if (!taken && lv[e] > bv) { bv = lv[e]; bi = e; } }
                selv[r] = bv; seli[r] = bi; }
            float ex[4], es = 0.f;
#pragma unroll
            for (int r = 0; r < 4; ++r) { ex[r] = __expf(selv[r] - selv[0]); es += ex[r]; }
            const float inv = 1.f / es;
#pragma unroll
            for (int r = 0; r < 4; ++r) { wsp<int>(F, WS_TOPE)[(size_t)row * 4 + r] = seli[r]; wsp<float>(F, WS_GATE)[(size_t)row * 4 + r] = ex[r] * inv;
                const int rk = __hip_atomic_fetch_add(&hist[seli[r]], 1, __ATOMIC_RELAXED, __HIP_MEMORY_SCOPE_WORKGROUP);
                recs[(pass * 64 + rl) * 4 + r] = seli[r] | (rk << 8); }
        }
    }
    __syncthreads();
    if (tid < NE) hist[32 + tid] = (int)__hip_atomic_fetch_add(F.ctl + CW_CNT + 64 * (layer + 2 * F.probe) + tid, (unsigned)hist[tid], RLX_AGENT);
    __syncthreads();
    for (int rl = tid; rl < RPB && row0 + rl < R; rl += 512) {
#pragma unroll
        for (int r = 0; r < 4; ++r) { const int rc = recs[rl * 4 + r]; wsp<int>(F, WS_POS)[(size_t)(row0 + rl) * 4 + r] = hist[32 + (rc & 255)] + (rc >> 8); } }
}
__device__ __forceinline__ void moe_tables(const Frame& F, int layer, LAS int* ps, LAS int* tile_e) {
    if (F.tid == 0) { int acc = 0, t = 0;
        for (int e = 0; e < NE; ++e) { const int c = (int)__hip_atomic_load(F.ctl + CW_CNT + 64 * layer + e, RLX_AGENT); ps[e] = acc; const int nt = (c + 255) >> 8;
            for (int i = 0; i < nt && t < MAXT; ++i) tile_e[t++] = e; acc += nt * 256; }
        ps[NE] = acc; ps[NE + 1] = t; }
    __syncthreads();
}
__device__ __forceinline__ void ph_gather(const Frame& F, int layer) {
    LAS int* ps = (LAS int*)(F.lds + MISC_OFF + 256); LAS int* tile_e = ps + 64;
    moe_tables(F, layer, ps, tile_e);
    if (F.blk == 0) { int* tab = wsp<int>(F, WS_TILE); const int nt = ps[NE + 1]; if (F.tid == 0) tab[0] = nt; for (int i = F.tid; i < nt; i += 512) tab[1 + i] = tile_e[i]; }
    for (int i = F.blk * 512 + F.tid; i < R * 4; i += F.G * 512) { const int row = i >> 2;
        const int e = wsp<const int>(F, WS_TOPE)[i]; const int dest = ps[e] + wsp<const int>(F, WS_POS)[i]; wsp<int>(F, WS_DEST)[i] = dest; wsp<int>(F, WS_SRC)[dest] = row; }
}
struct MoeOrder {
    const int* tile_e; int ntiles, nN, G, c; const int* src;
    __device__ __forceinline__ bool next(int i, pg8::Unit& u) const {
        int rt, pl;
        if (G == 256) { const int x = c & 7, y = c >> 3, rpx = 32 / nN; rt = (i * 8 + x) * rpx + y / nN; pl = y % nN; if (rt >= ntiles) return false; }
        else { const long L = (long)i * G + c; if (L >= (long)ntiles * nN) return false; rt = (int)(L / nN); pl = (int)(L - (long)rt * nN); }
        const int e = __builtin_amdgcn_readfirstlane(tile_e[rt]);
        u.pm = rt; u.pn = e * nN + pl; return true; }
    __device__ __forceinline__ void a_ready(const pg8::Unit&) const {}
    __device__ __forceinline__ void done(const pg8::Unit&) const {}
};
struct LatOrder {
    pg8::StaticOrder o;
    __device__ __forceinline__ bool next(int i, pg8::Unit& u) const { if (!o.next(i, u)) return false; u.pm += 1 + (u.pm >= 64 ? 1 : 0); return true; }
    __device__ __forceinline__ void a_ready(const pg8::Unit&) const {}
    __device__ __forceinline__ void done(const pg8::Unit&) const {}
};
struct FnSwiglu {
    bf16* HS; const float* b1;
    __device__ __forceinline__ void operator()(int row, int col, f32x4 v0, f32x4 v1) const {
        const float* bp = b1 + col;
        const f32x4 b0 = *(const f32x4*)bp, b1v = *(const f32x4*)(bp + 4); v0 = v0 + b0; v1 = v1 + b1v;
        const float hv[8] = {v0[0], v0[1], v0[2], v0[3], v1[0], v1[1], v1[2], v1[3]}; float o[4];
#pragma unroll
        for (int i = 0; i < 4; ++i) { const float g = hv[2 * i], l = hv[2 * i + 1];
            const float gl = fminf(g, 7.f), li = fminf(fmaxf(l, -7.f), 7.f); o[i] = gl * sigmoidf_(1.702f * gl) * (li + 1.f); }
        const int lc = col & 2047; v2u w; w.x = pk2(o[0], o[1]); w.y = pk2(o[2], o[3]);
        *(v2u*)(HS + (size_t)row * 1024 + (lc >> 1)) = w; }
};
struct FnBiasBf16 {
    bf16* YS; const float* b2;
    __device__ __forceinline__ void operator()(int row, int col, f32x4 v0, f32x4 v1) const {
        const f32x4 b0 = *(const f32x4*)(b2 + col), b1v = *(const f32x4*)(b2 + col + 4); v0 = v0 + b0; v1 = v1 + b1v;
        v4u w; w.x = pk2(v0[0], v0[1]); w.y = pk2(v0[2], v0[3]); w.z = pk2(v1[0], v1[1]); w.w = pk2(v1[2], v1[3]);
        *(v4u*)(YS + (size_t)row * 1024 + (col & 1023)) = w; }
};
__device__ __forceinline__ void ph_combine(const Frame& F, int layer) {
    const int lane = F.lane, gw = F.blk * 8 + F.wave, NGW = F.G * 8;
    for (int row = gw; row < R; row += NGW) {
        const int sel = row_sel(row); const float* gf = modp(F, layer, sel, 5);
        bf16* hrow = wsp<bf16>(F, WS_H) + (size_t)row * DM;
        f32x4 y[4];
#pragma unroll
        for (int j = 0; j < 4; ++j) y[j] = (f32x4){0.f, 0.f, 0.f, 0.f};
#pragma unroll
        for (int r = 0; r < 4; ++r) { const int d = wsp<const int>(F, WS_DEST)[(size_t)row * 4 + r]; const float g = wsp<const float>(F, WS_GATE)[(size_t)row * 4 + r];
            const v2u* yp = (const v2u*)(wsp<const bf16>(F, WS_XS) + (size_t)d * DM);
#pragma unroll
            for (int j = 0; j < 4; ++j) { const v2u w = yp[lane + 64 * j]; y[j] += g * (f32x4){bflo(w.x), bfhi(w.x), bflo(w.y), bfhi(w.y)}; } }
        f32x4 h[4]; float s = 0.f;
#pragma unroll
        for (int j = 0; j < 4; ++j) { const v2u hw = ((const v2u*)hrow)[lane + 64 * j]; h[j] = (f32x4){bflo(hw.x), bfhi(hw.x), bflo(hw.y), bfhi(hw.y)} + ((const f32x4*)gf)[lane + 64 * j] * y[j]; s += (h[j].x * h[j].x + h[j].y * h[j].y) + (h[j].z * h[j].z + h[j].w * h[j].w); }
        const float rs = 1.f / sqrtf(wave_sum(s) * (1.f / DM) + NORM_EPS);
        if (layer == 0) {
#pragma unroll
            for (int j = 0; j < 4; ++j) { v2u hw; hw.x = pk2(h[j].x, h[j].y); hw.y = pk2(h[j].z, h[j].w); ((v2u*)hrow)[lane + 64 * j] = hw; }
            const float* nw = F.in[I_NMIX] + DM; const float* sh = modp(F, 1, sel, 0); const float* sc = modp(F, 1, sel, 1);
            unsigned long long* o8 = (unsigned long long*)(wsp<bf16>(F, WS_A) + (size_t)row * DM) + lane;
#pragma unroll
            for (int j = 0; j < 4; ++j) { const f32x4 w = ((const f32x4*)nw)[lane + 64 * j], a = ((const f32x4*)sh)[lane + 64 * j], c = ((const f32x4*)sc)[lane + 64 * j];
                const f32x4 o = h[j] * rs * w * (c + 1.f) + a; o8[64 * j] = (unsigned long long)pk2(o.x, o.y) | ((unsigned long long)pk2(o.z, o.w) << 32); }
        } else {
            const int b = row / TB, t = row - b * TB;
            if (t >= CT) { float* orow = F.out + ((size_t)b * SEQ + (t - CT)) * DM; const float* nw = F.in[I_FNW];
#pragma unroll
                for (int j = 0; j < 4; ++j) ((f32x4*)orow)[lane + 64 * j] = h[j] * rs * ((const f32x4*)nw)[lane + 64 * j]; }
        }
    }
}
constexpr int PC_Q = 1920, PC_K = 2176, PC_V = 2432, PC_O = 2944, PC_G = 3456;
__device__ __forceinline__ float softplusf_(float y) { return fmaxf(y, 0.f) + __logf(1.f + __expf(-fabsf(y))); }
__device__ __forceinline__ float tanhf_(float x) { return 1.f - 2.f / (1.f + __expf(2.f * x)); }
__device__ __forceinline__ void lerp8(const bf16* p, bool hp, bool hn, int c0, const float* mu, float (&u)[8]) {
    const v4u z4 = {0u, 0u, 0u, 0u};
    const v4u wx = *(const v4u*)(p + c0), wp = hp ? *(const v4u*)(p - REC_NP + c0) : z4, wn = hn ? *(const v4u*)(p + REC_NP + c0) : z4;
    float x[8], xp[8], xn[8]; unpack8(wx, x); unpack8(wp, xp); unpack8(wn, xn);
    const f32x4 m0 = *(const f32x4*)(mu + c0), m1 = *(const f32x4*)(mu + c0 + 4);
#pragma unroll
    for (int e = 0; e < 8; ++e) { const float m = e < 4 ? m0[e & 3] : m1[e & 3]; u[e] = x[e] + m * (0.5f * (xp[e] + xn[e]) - x[e]); }
}
__device__ __forceinline__ void st8h(bf16* o, const float (&u)[8]) { v4u w; w.x = pk2(u[0], u[1]); w.y = pk2(u[2], u[3]); w.z = pk2(u[4], u[5]); w.w = pk2(u[6], u[7]); *(v4u*)o = w; }
__device__ __forceinline__ void st8f(float* o, const float (&u)[8]) { *(f32x4*)o = (f32x4){u[0], u[1], u[2], u[3]}; *(f32x4*)(o + 4) = (f32x4){u[4], u[5], u[6], u[7]}; }
__device__ __forceinline__ void l1_rwkv_prep(const Frame& F) {
    const int gw = F.blk * 8 + F.wave, NGW = F.G * 8, lane = F.lane; const float* mu = F.in[I_MU];
    for (int row = gw; row < R; row += NGW) {
        const int b = row / TB, t = row - b * TB; const bool hp = (t != 0 && t != CT), hn = (t != CT - 1 && t != TB - 1);
        const bf16* p = wsp<const bf16>(F, WS_P) + (size_t)row * REC_NP; const size_t ro = (size_t)row * 512 + 8 * lane;
        float u[8];
        lerp8(p, hp, hn, 8 * lane, mu, u); st8h(wsp<bf16>(F, WS_RR) + ro, u);
        lerp8(p, hp, hn, 1024 + 8 * lane, mu, u); st8h(wsp<bf16>(F, WS_VV) + ro, u);
        lerp8(p, hp, hn, 512 + 8 * lane, mu, u); st8h(wsp<bf16>(F, WS_KL) + ro, u);
        { const f32x4 k0 = *(const f32x4*)(F.in[I_KK] + 8 * lane), k1 = *(const f32x4*)(F.in[I_KK] + 8 * lane + 4); float ss = 0.f;
#pragma unroll
          for (int e = 0; e < 8; ++e) { u[e] *= (e < 4 ? k0[e & 3] : k1[e & 3]); ss += u[e] * u[e]; }
          ss += __shfl_xor(ss, 1); ss += __shfl_xor(ss, 2); ss += __shfl_xor(ss, 4);
          const float inv = -1.f / sqrtf(fmaxf(ss, 1e-24f));
#pragma unroll
          for (int e = 0; e < 8; ++e) u[e] *= inv;
          st8h(wsp<bf16>(F, WS_AKK) + ro, u); }
        if (lane < 48) { lerp8(p, hp, hn, 1536 + 8 * lane, mu, u);
#pragma unroll
            for (int e = 0; e < 8; ++e) u[e] = lane < 16 ? tanhf_(u[e]) : (lane < 32 ? u[e] : sigmoidf_(u[e]));
            v4u w; w.x = pk2(u[0], u[1]); w.y = pk2(u[2], u[3]); w.z = pk2(u[4], u[5]); w.w = pk2(u[6], u[7]);
            *(v4u*)(wsp<bf16>(F, WS_ALORA) + (size_t)row * 384 + 8 * lane) = w; }
    }
}
struct EpiLora {
    static constexpr bool PERM = true, AFTER_DRAIN = false;
    const Frame* F;
    template <int KIND> __device__ __forceinline__ void run(const pg8::f32x4 (&acc)[2][2][4][2], const pg8::Unit& u, int wr, int wc, int fr, int fq, int z) const {
#pragma unroll
        for (int ai = 0; ai < 2; ++ai)
#pragma unroll
            for (int m = 0; m < 4; ++m) { const int row = u.pm * 256 + ai * 128 + wr * 64 + m * 16 + fr;
#pragma unroll
                for (int bj = 0; bj < 2; ++bj) { const int c = ((u.pn & 1) * 256) + bj * 128 + wc * 32 + 8 * fq; const size_t ro = (size_t)row * 512 + c;
                    const pg8::f32x4 v0 = acc[ai][bj][m][0], v1 = acc[ai][bj][m][1]; const float x[8] = {v0[0], v0[1], v0[2], v0[3], v1[0], v1[1], v1[2], v1[3]}; float o[8];
                    if constexpr (KIND == 0) { const float* w0 = F->in[I_W0] + z * 512 + c;
#pragma unroll
                        for (int e = 0; e < 8; ++e) { const float wl = -softplusf_(-(w0[e] + x[e])) - 0.5f; o[e] = __expf(-__expf(wl)); }
                        st8f(wsp<float>(*F, WS_WDEC) + (size_t)z * R * 512 + ro, o); }
                    else if constexpr (KIND == 1) { const float* a0 = F->in[I_A0] + z * 512 + c;
#pragma unroll
                        for (int e = 0; e < 8; ++e) o[e] = sigmoidf_(a0[e] + x[e]);
                        st8h(wsp<bf16>(*F, WS_ASIG) + (size_t)z * R * 512 + ro, o); }
                    else st8h(wsp<bf16>(*F, WS_GG) + ro, x); } }
    }
    __device__ __forceinline__ void operator()(const pg8::f32x4 (&acc)[2][2][4][2], const pg8::Unit& u, int wr, int wc, int fr, int fq) const {
        const int part = u.pn >> 1;
        if (part < 2) run<0>(acc, u, wr, wc, fr, fq, part); else if (part < 4) run<1>(acc, u, wr, wc, fr, fq, part - 2); else run<2>(acc, u, wr, wc, fr, fq, 0);
    }
};
__device__ __forceinline__ void mlstm_gates(const Frame& F, int row, int z, int h, float& ig, float& lf) {
    const bf16* g = wsp<const bf16>(F, WS_P) + (size_t)row * REC_NP + PC_G + z * 8 + h; const float* gb = F.in[I_GATEB] + z * 8 + h;
    const float gi = bf2f(g[0]) + gb[0], gf = bf2f(g[4]) + gb[4];
    ig = 15.f * tanhf_(gi * (1.f / 15.f)); const float cf = 15.f * tanhf_(gf * (1.f / 15.f)); lf = fminf(cf, 0.f) - __logf(1.f + __expf(-fabsf(cf)));
}
__device__ __forceinline__ void mlstm_chunk_head(const Frame& F, int z, int b, int h, int c, LAS float* vec) {
    LAS int* rows = (LAS int*)vec;
    if (F.tid < 64) { const int s = F.tid, row = b * TB + scan_tok(z, 64 * c + s); float ig, lf; mlstm_gates(F, row, z, h, ig, lf); rows[s] = row; vec[64 + s] = ig; vec[192 + s] = lf; }
    __syncthreads();
    if (F.tid < 64) { float a = 0.f; for (int s = 0; s <= F.tid; ++s) a += vec[192 + s]; vec[128 + F.tid] = a; }
    __syncthreads();
}
__device__ __forceinline__ void l1_mlstm_b(const Frame& F) {
    const float* __restrict__ SC = wsp<const float>(F, WS_SC); const float* __restrict__ DC = wsp<const float>(F, WS_DC); float* __restrict__ CST = wsp<float>(F, WS_CST);
    const float* __restrict__ DN = wsp<const float>(F, WS_DN); float* __restrict__ NST = wsp<float>(F, WS_NST); float* __restrict__ MST = wsp<float>(F, WS_MST);
    for (int g = F.blk * 512 + F.tid; g < 16 * 8192; g += F.G * 512) {
        const int chain = g >> 13, el = g & 8191; float m = 0.f, C = 0.f, N = 0.f; const bool don = el < 64;
        for (int c0 = 0; c0 < 260; c0 += 10) {
            float dc[10], dn[10], bl[10], ml[10];
#pragma unroll
            for (int i = 0; i < 10; ++i) { const size_t u = (size_t)chain * 260 + c0 + i; dc[i] = DC[u * 8192 + el]; dn[i] = don ? DN[u * 64 + el] : 0.f; bl[i] = SC[2 * u]; ml[i] = SC[2 * u + 1]; }
#pragma unroll
            for (int i = 0; i < 10; ++i) { const size_t u = (size_t)chain * 260 + c0 + i;
                CST[u * 8192 + el] = C; if (don) NST[u * 64 + el] = N; if (el == 0) MST[u] = m;
                const float mn = fmaxf(bl[i] + m, ml[i]), cd = __expf(bl[i] + m - mn), inj = __expf(ml[i] - mn);
                C = cd * C + inj * dc[i]; N = cd * N + inj * dn[i]; m = mn; }
        }
    }
}
__device__ __forceinline__ void l1_rec_out(const Frame& F) {
    const int gw = F.blk * 8 + F.wave, NGW = F.G * 8, lane = F.lane, c0 = 8 * lane;
    for (int row = gw; row < R; row += NGW) {
        const size_t ro = (size_t)row * 512 + c0; bf16* a1 = wsp<bf16>(F, WS_A1) + (size_t)row * DM;
        { float y0[8], y1[8], y[8]; float s = 0.f; unpack8(*(const v4u*)(wsp<const bf16>(F, WS_YR) + ro), y0); unpack8(*(const v4u*)(wsp<const bf16>(F, WS_YR) + (size_t)R * 512 + ro), y1);
          const float* y2 = wsp<const float>(F, WS_YB) + ro; const float* y3 = y2 + (size_t)R * 512;
#pragma unroll
          for (int e = 0; e < 8; ++e) { y[e] = (y0[e] + y1[e]) + (y2[e] + y3[e]); s += y[e]; }
          s += __shfl_xor(s, 1); s += __shfl_xor(s, 2); s += __shfl_xor(s, 4); const float mean = s * (1.f / 64.f); float q = 0.f;
#pragma unroll
          for (int e = 0; e < 8; ++e) { y[e] -= mean; q += y[e] * y[e]; }
          q += __shfl_xor(q, 1); q += __shfl_xor(q, 2); q += __shfl_xor(q, 4); const float rstd = 1.f / sqrtf(q * (1.f / 64.f) + 64e-5f);
          float rr[8], kl[8], s0[8], s1[8], vv[8], gg[8]; unpack8(*(const v4u*)(wsp<const bf16>(F, WS_RR) + ro), rr); unpack8(*(const v4u*)(wsp<const bf16>(F, WS_KL) + ro), kl);
          unpack8(*(const v4u*)(wsp<const bf16>(F, WS_ASIG) + ro), s0); unpack8(*(const v4u*)(wsp<const bf16>(F, WS_ASIG) + (size_t)R * 512 + ro), s1);
          unpack8(*(const v4u*)(wsp<const bf16>(F, WS_VV) + ro), vv); unpack8(*(const v4u*)(wsp<const bf16>(F, WS_GG) + ro), gg);
          const float* rk = F.in[I_RK] + c0; const float* ka = F.in[I_KA] + c0; float bs = 0.f;
#pragma unroll
          for (int e = 0; e < 8; ++e) bs += rr[e] * kl[e] * (2.f + (s0[e] + s1[e] - 2.f) * ka[e]) * rk[e];
          bs += __shfl_xor(bs, 1); bs += __shfl_xor(bs, 2); bs += __shfl_xor(bs, 4);
          const float* lw = F.in[I_LNW] + c0; const float* lb = F.in[I_LNB] + c0; float o[8];
#pragma unroll
          for (int e = 0; e < 8; ++e) o[e] = (y[e] * rstd * lw[e] + lb[e] + bs * vv[e]) * gg[e];
          v4u w; w.x = pk2(o[0], o[1]); w.y = pk2(o[2], o[3]); w.z = pk2(o[4], o[5]); w.w = pk2(o[6], o[7]); *(v4u*)(a1 + c0) = w; }
        { float h0[8], h1[8], x[8]; float q = 0.f; unpack8(*(const v4u*)(wsp<const bf16>(F, WS_HM) + ro), h0); unpack8(*(const v4u*)(wsp<const bf16>(F, WS_HM) + (size_t)R * 512 + ro), h1);
#pragma unroll
          for (int e = 0; e < 8; ++e) { x[e] = h0[e] + h1[e]; q += x[e] * x[e]; }
          q += __shfl_xor(q, 1); q += __shfl_xor(q, 2); q += __shfl_xor(q, 4); q += __shfl_xor(q, 8); const float rs = 1.f / sqrtf(q * (1.f / 128.f) + NORM_EPS);
          float og[8]; unpack8(*(const v4u*)(wsp<const bf16>(F, WS_P) + (size_t)row * REC_NP + PC_O + c0), og); const float* nw = F.in[I_MNW] + c0; float o[8];
#pragma unroll
          for (int e = 0; e < 8; ++e) o[e] = x[e] * rs * nw[e] * sigmoidf_(og[e]);
          v4u w; w.x = pk2(o[0], o[1]); w.y = pk2(o[2], o[3]); w.z = pk2(o[4], o[5]); w.w = pk2(o[6], o[7]); *(v4u*)(a1 + 512 + c0) = w; }
    }
}
#ifndef NEU_ROUNDS
#define NEU_ROUNDS 6
#endif
namespace rk {
constexpr int LS = 72;
constexpr int MB = 64 * LS * 2;
struct Acc2 { pg8::f32x4 t0, t1; };
__device__ __forceinline__ void zero(Acc2& a) { a.t0 = (pg8::f32x4){0.f, 0.f, 0.f, 0.f}; a.t1 = a.t0; }
__device__ __forceinline__ void mm_acc(Acc2& acc, const LAS bf16* A, const LAS bf16* Bt, int wave, int lane) {
    const int tm = wave >> 1, tn0 = (wave & 1) * 2, lr = lane & 15, kq = (lane >> 4) * 8;
    const LAS bf16* ap = A + (tm * 16 + lr) * LS + kq; const LAS bf16* bp0 = Bt + (tn0 * 16 + lr) * LS + kq; const LAS bf16* bp1 = bp0 + 16 * LS;
    const bf16x8 a0 = *(const LAS bf16x8*)ap, a1 = *(const LAS bf16x8*)(ap + 32);
    const bf16x8 b00 = *(const LAS bf16x8*)bp0, b01 = *(const LAS bf16x8*)(bp0 + 32), b10 = *(const LAS bf16x8*)bp1, b11 = *(const LAS bf16x8*)(bp1 + 32);
    acc.t0 = __builtin_amdgcn_mfma_f32_16x16x32_bf16(a0, b00, acc.t0, 0, 0, 0); acc.t0 = __builtin_amdgcn_mfma_f32_16x16x32_bf16(a1, b01, acc.t0, 0, 0, 0);
    acc.t1 = __builtin_amdgcn_mfma_f32_16x16x32_bf16(a0, b10, acc.t1, 0, 0, 0); acc.t1 = __builtin_amdgcn_mfma_f32_16x16x32_bf16(a1, b11, acc.t1, 0, 0, 0);
}
template <class Fn> __device__ __forceinline__ void each(const Acc2& acc, int wave, int lane, Fn fn) {
    const int m0 = (wave >> 1) * 16 + (lane >> 4) * 4, n0 = (wave & 1) * 32 + (lane & 15);
#pragma unroll
    for (int r = 0; r < 4; ++r) { fn(m0 + r, n0, acc.t0[r]); fn(m0 + r, n0 + 16, acc.t1[r]); }
}
__device__ __forceinline__ void stb(LAS bf16* M, int m, int n, float v) { M[m * LS + n] = (bf16)f2bf(v); }
__device__ __forceinline__ void st_tr(LAS bf16* M, const Acc2& acc, int wave, int lane) {
    const int m0 = (wave >> 1) * 16 + (lane >> 4) * 4, n0 = (wave & 1) * 32 + (lane & 15);
    v2u a, b; a.x = pk2(acc.t0[0], acc.t0[1]); a.y = pk2(acc.t0[2], acc.t0[3]); b.x = pk2(acc.t1[0], acc.t1[1]); b.y = pk2(acc.t1[2], acc.t1[3]);
    *(LAS v2u*)(M + n0 * LS + m0) = a; *(LAS v2u*)(M + (n0 + 16) * LS + m0) = b;
}
}
__device__ __forceinline__ void l1_rk_phase_a(const Frame& F) {
    using namespace rk;
    LAS unsigned char* L = F.lds;
    LAS bf16* Rt = (LAS bf16*)(L + 0 * MB); LAS bf16* At = (LAS bf16*)(L + 1 * MB); LAS bf16* AtT = (LAS bf16*)(L + 2 * MB); LAS bf16* Bq = (LAS bf16*)(L + 3 * MB); LAS bf16* Kq = (LAS bf16*)(L + 4 * MB);
    LAS bf16* VT = (LAS bf16*)(L + 5 * MB); LAS bf16* BhT = (LAS bf16*)(L + 6 * MB); LAS bf16* KhT = (LAS bf16*)(L + 7 * MB);
    LAS bf16* AK = (LAS bf16*)(L + 8 * MB); LAS bf16* RB = (LAS bf16*)(L + 9 * MB); LAS bf16* RK = (LAS bf16*)(L + 10 * MB);
    LAS bf16* X = (LAS bf16*)(L + 11 * MB); LAS bf16* XT = (LAS bf16*)(L + 12 * MB); LAS bf16* P = (LAS bf16*)(L + 13 * MB);
    LAS bf16* AkVT = Bq; LAS bf16* ApT = Kq; LAS bf16* W2T = X;
    LAS float* G = (LAS float*)(L + 8 * MB);
    LAS float* gl = (LAS float*)(L + 14 * MB);
    const int w = F.wave, lane = F.lane, tid = F.tid;
    const int t = lane, j0 = 8 * w;
    float fr[8], fv[8], fa[8], fw[8], fk[8], fb[8];
#define RK_LOAD(u_) do { const int ch_ = (u_) / 260, c_ = (u_) - ch_ * 260, z_ = ch_ >> 4, b_ = (ch_ >> 3) & 1, h_ = ch_ & 7; const size_t ro = ((size_t)b_ * TB + scan_tok(z_, 64 * c_ + t)) * 512 + h_ * 64 + j0; \
    const v4u xr_ = *(const v4u*)(wsp<const bf16>(F, WS_RR) + ro), xv_ = *(const v4u*)(wsp<const bf16>(F, WS_VV) + ro), xa_ = *(const v4u*)(wsp<const bf16>(F, WS_AKK) + ro), xk_ = *(const v4u*)(wsp<const bf16>(F, WS_KL) + ro), \
              xs_ = *(const v4u*)(wsp<const bf16>(F, WS_ASIG) + (size_t)z_ * R * 512 + ro); const float* p3 = wsp<const float>(F, WS_WDEC) + (size_t)z_ * R * 512 + ro; const float* pk_ = F.in[I_KA] + h_ * 64 + j0; \
    const f32x4 w0_ = *(const f32x4*)p3, w1_ = *(const f32x4*)(p3 + 4), q0_ = *(const f32x4*)pk_, q1_ = *(const f32x4*)(pk_ + 4); float sg_[8], kl_[8]; \
    unpack8(xr_, fr); unpack8(xv_, fv); unpack8(xa_, fa); unpack8(xk_, kl_); unpack8(xs_, sg_); \
    _Pragma("unroll") for (int e = 0; e < 8; ++e) { const float kav = e < 4 ? q0_[e & 3] : q1_[e & 3]; fw[e] = e < 4 ? w0_[e & 3] : w1_[e & 3]; fk[e] = kl_[e] * (1.f + (sg_[e] - 1.f) * kav); fb[e] = -fa[e] * sg_[e]; } } while (0)
    if (F.blk < NUNIT_R) RK_LOAD(F.blk);
    for (int u = F.blk; u < NUNIT_R; u += F.G) {
        const int chain = u / 260, c = u - chain * 260, z = chain >> 4, b = (chain >> 3) & 1, h = chain & 7;
        __syncthreads();
#pragma unroll
        for (int e = 0; e < 8; ++e) G[t * 65 + j0 + e] = fw[e];
        __syncthreads();
        if (tid < 64) { float g = 1.f;
#pragma unroll 16
            for (int s = 0; s < 64; ++s) { g *= G[s * 65 + tid]; G[s * 65 + tid] = g; } gl[tid] = g; }
        __syncthreads();
#pragma unroll
        for (int e = 0; e < 8; ++e) { const int j = j0 + e; const float gt = G[t * 65 + j], gp = t > 0 ? G[(t - 1) * 65 + j] : 1.f, gL = G[63 * 65 + j], ig = 1.f / gt;
            fr[e] *= gt; fa[e] *= gp; const float bq = fb[e] * ig, kq = fk[e] * ig; fb[e] = bq; fk[e] = kq; fw[e] = gL; }
        __syncthreads();
        { v4u q; q.x = pk2(fr[0], fr[1]); q.y = pk2(fr[2], fr[3]); q.z = pk2(fr[4], fr[5]); q.w = pk2(fr[6], fr[7]); *(LAS v4u*)(Rt + t * LS + j0) = q;
          q.x = pk2(fa[0], fa[1]); q.y = pk2(fa[2], fa[3]); q.z = pk2(fa[4], fa[5]); q.w = pk2(fa[6], fa[7]); *(LAS v4u*)(At + t * LS + j0) = q;
          q.x = pk2(fb[0], fb[1]); q.y = pk2(fb[2], fb[3]); q.z = pk2(fb[4], fb[5]); q.w = pk2(fb[6], fb[7]); *(LAS v4u*)(Bq + t * LS + j0) = q;
          q.x = pk2(fk[0], fk[1]); q.y = pk2(fk[2], fk[3]); q.z = pk2(fk[4], fk[5]); q.w = pk2(fk[6], fk[7]); *(LAS v4u*)(Kq + t * LS + j0) = q; }
#pragma unroll
        for (int e = 0; e < 8; ++e) { const int j = j0 + e; stb(AtT, j, t, fa[e]); stb(VT, j, t, fv[e]); stb(BhT, j, t, fb[e] * fw[e]); stb(KhT, j, t, fk[e] * fw[e]); }
        __syncthreads();
        if (u + F.G < NUNIT_R) RK_LOAD(u + F.G);
        Acc2 a1, a2, a3, a4;
        zero(a1); mm_acc(a1, At, Bq, w, lane); zero(a2); mm_acc(a2, At, Kq, w, lane); zero(a3); mm_acc(a3, Rt, Bq, w, lane); zero(a4); mm_acc(a4, Rt, Kq, w, lane);
        each(a1, w, lane, [&](int m, int n, float v) { const float x = n < m ? v : 0.f; stb(X, m, n, x); stb(XT, n, m, x); stb(P, m, n, m == n ? 1.f : 0.f); });
        each(a2, w, lane, [&](int m, int n, float v) { stb(AK, m, n, n < m ? v : 0.f); });
        each(a3, w, lane, [&](int m, int n, float v) { stb(RB, m, n, n <= m ? v : 0.f); });
        each(a4, w, lane, [&](int m, int n, float v) { stb(RK, m, n, n <= m ? v : 0.f); });
        __syncthreads();
        { const int m0 = (w >> 1) * 16 + (lane >> 4) * 4, n0 = (w & 1) * 32 + (lane & 15);
          Acc2 pt;
#pragma unroll
          for (int r = 0; r < 4; ++r) { pt.t0[r] = (m0 + r == n0) ? 1.f : 0.f; pt.t1[r] = (m0 + r == n0 + 16) ? 1.f : 0.f; }
#pragma unroll 1
          for (int i = 0; i < NEU_ROUNDS; ++i) {
            mm_acc(pt, P, XT, w, lane);
            if (i < NEU_ROUNDS - 1) { zero(a1); mm_acc(a1, X, XT, w, lane); }
            __syncthreads();
#pragma unroll
            for (int r = 0; r < 4; ++r) { stb(P, m0 + r, n0, pt.t0[r]); stb(P, m0 + r, n0 + 16, pt.t1[r]); }
            if (i < NEU_ROUNDS - 1) { each(a1, w, lane, [&](int m, int n, float v) { stb(X, m, n, v); }); st_tr(XT, a1, w, lane); }
            __syncthreads();
          } }
        zero(a1); mm_acc(a1, AK, VT, w, lane); zero(a2); mm_acc(a2, P, AtT, w, lane);
        st_tr(AkVT, a1, w, lane); st_tr(ApT, a2, w, lane);
        __syncthreads();
        zero(a3); mm_acc(a3, P, AkVT, w, lane);
        st_tr(W2T, a3, w, lane);
        __syncthreads();
        zero(a1); mm_acc(a1, RB, ApT, w, lane); zero(a2); mm_acc(a2, RB, W2T, w, lane); mm_acc(a2, RK, VT, w, lane);
        zero(a3); mm_acc(a3, BhT, ApT, w, lane); zero(a4); mm_acc(a4, BhT, W2T, w, lane); mm_acc(a4, KhT, VT, w, lane);
        __syncthreads();
        { LAS bf16* O1 = At; LAS bf16* O2 = AtT; LAS bf16* O3 = AK; LAS float* OY = (LAS float*)X;
          each(a1, w, lane, [&](int m, int n, float v) { stb(O1, m, n, v + bf2f(Rt[m * LS + n])); });
          each(a3, w, lane, [&](int m, int n, float v) { stb(O2, m, n, v + (m == n ? gl[m] : 0.f)); });
          each(a4, w, lane, [&](int m, int n, float v) { stb(O3, m, n, v); });
          each(a2, w, lane, [&](int m, int n, float v) { OY[m * 68 + n] = v; });
          __syncthreads();
          const int row = tid >> 3, c8 = (tid & 7) * 8;
          *(v4u*)(wsp<bf16>(F, WS_RKQ) + (size_t)u * 4096 + row * 64 + c8) = *(const LAS v4u*)(O1 + row * LS + c8);
          *(v4u*)(wsp<bf16>(F, WS_RKM) + (size_t)u * 4096 + row * 64 + c8) = *(const LAS v4u*)(O2 + row * LS + c8);
          *(v4u*)(wsp<bf16>(F, WS_RKZ) + (size_t)u * 4096 + row * 64 + c8) = *(const LAS v4u*)(O3 + row * LS + c8);
          bf16* Yg = wsp<bf16>(F, WS_YR) + (size_t)z * R * 512 + h * 64;
#pragma unroll
          for (int i = 0; i < 2; ++i) { const int yr = (tid >> 4) + 32 * i, c4 = (tid & 15) * 4; const f32x4 yv = *(const LAS f32x4*)(OY + yr * 68 + c4); v2u yw; yw.x = pk2(yv.x, yv.y); yw.y = pk2(yv.z, yv.w);
              *(v2u*)(Yg + ((size_t)b * TB + scan_tok(z, 64 * c + yr)) * 512 + c4) = yw; } }
    }
#undef RK_LOAD
}
__device__ __forceinline__ void l1_rk_phase_b(const Frame& F) {
    using namespace rk;
    LAS unsigned char* L = F.lds;
    const int w = F.wave, lane = F.lane, tid = F.tid, chain = F.blk, z = chain >> 4, b = (chain >> 3) & 1, h = chain & 7;
    for (int i = tid; i < 2 * 64 * LS; i += 512) ((LAS bf16*)L)[i] = 0;
    const int sr = tid >> 3, sc = (tid & 7) * 8;
    v4u gm, gq, gz;
#define RKB_LOAD(u_) do { gm = *(const v4u*)(wsp<const bf16>(F, WS_RKM) + (u_) * 4096 + sr * 64 + sc); gq = *(const v4u*)(wsp<const bf16>(F, WS_RKQ) + (u_) * 4096 + sr * 64 + sc); \
    gz = *(const v4u*)(wsp<const bf16>(F, WS_RKZ) + (u_) * 4096 + sr * 64 + sc); } while (0)
#define RKB_WRITE(par) do { *(LAS v4u*)((LAS bf16*)(L + (2 + 3 * (par)) * MB) + sr * LS + sc) = gm; *(LAS v4u*)((LAS bf16*)(L + (3 + 3 * (par)) * MB) + sr * LS + sc) = gq; \
    *(LAS v4u*)((LAS bf16*)(L + (4 + 3 * (par)) * MB) + sr * LS + sc) = gz; } while (0)
    RKB_LOAD((size_t)chain * 260); RKB_WRITE(0);
    __syncthreads();
    float* Yg = wsp<float>(F, WS_YB) + (size_t)z * R * 512 + h * 64;
    const int m0 = (w >> 1) * 16 + (lane >> 4) * 4, n0 = (w & 1) * 32 + (lane & 15);
    for (int c = 0; c < 260; ++c) {
        const size_t u = (size_t)chain * 260 + c; const int par = c & 1;
        if (c + 1 < 260) RKB_LOAD(u + 1);
        const LAS bf16* S = (const LAS bf16*)(L + par * MB); LAS bf16* Sn = (LAS bf16*)(L + (par ^ 1) * MB);
        const LAS bf16* Mt = (const LAS bf16*)(L + (2 + 3 * par) * MB); const LAS bf16* Qp = (const LAS bf16*)(L + (3 + 3 * par) * MB); const LAS bf16* Zt = (const LAS bf16*)(L + (4 + 3 * par) * MB);
        Acc2 a1, a2;
#pragma unroll
        for (int r = 0; r < 4; ++r) { a1.t0[r] = bf2f(Zt[(m0 + r) * LS + n0]); a1.t1[r] = bf2f(Zt[(m0 + r) * LS + n0 + 16]); }
        mm_acc(a1, Mt, S, w, lane); zero(a2); mm_acc(a2, Qp, S, w, lane);
        st_tr(Sn, a1, w, lane);
        if (c + 1 < 260) RKB_WRITE(par ^ 1);
#pragma unroll
        for (int r = 0; r < 4; ++r) { const size_t yo = ((size_t)b * TB + scan_tok(z, 64 * c + m0 + r)) * 512 + n0; Yg[yo] = a2.t0[r]; Yg[yo + 16] = a2.t1[r]; }
        __syncthreads();
    }
#undef RKB_LOAD
#undef RKB_WRITE
}
__device__ __forceinline__ void l1_mlstm_a2(const Frame& F) {
    using namespace rk;
    LAS bf16* KT = (LAS bf16*)F.lds; LAS bf16* VsT = KT + 64 * LS;
    LAS float* vec = (LAS float*)(F.lds + AUX_OFF); LAS int* rows = (LAS int*)vec;
    const bf16* Pg = wsp<const bf16>(F, WS_P); const int tid = F.tid, w = F.wave, lane = F.lane;
    for (int u = F.blk; u < NUNIT_M; u += F.G) {
        const int cidx = u / 260, c = u - cidx * 260, z = cidx >> 3, b = (cidx >> 2) & 1, h = cidx & 3;
        mlstm_chunk_head(F, z, b, h, c, vec);
        if (tid < 64) { const float bl = vec[128 + 63]; const float uu = bl - vec[128 + tid] + vec[64 + tid]; float m = uu;
#pragma unroll
            for (int o = 1; o < 64; o <<= 1) m = fmaxf(m, __shfl_xor(m, o));
            vec[256 + tid] = __expf(uu - m);
            if (tid == 0) { wsp<float>(F, WS_SC)[2 * u] = bl; wsp<float>(F, WS_SC)[2 * u + 1] = m; } }
        __syncthreads();
        { const int s = tid >> 3, c8 = tid & 7; float x[8]; unpack8(*(const v4u*)(Pg + (size_t)rows[s] * REC_NP + PC_K + h * 64 + 8 * c8), x);
#pragma unroll
          for (int e = 0; e < 8; ++e) stb(KT, 8 * c8 + e, s, x[e]); }
#pragma unroll
        for (int i = 0; i < 2; ++i) { const int s = (tid >> 4) + 32 * i, c8 = tid & 15; float x[8]; unpack8(*(const v4u*)(Pg + (size_t)rows[s] * REC_NP + PC_V + h * 128 + 8 * c8), x); const float sw = vec[256 + s];
#pragma unroll
            for (int e = 0; e < 8; ++e) stb(VsT, 8 * c8 + e, s, x[e] * sw); }
        __syncthreads();
        Acc2 a0, a1; zero(a0); mm_acc(a0, VsT, KT, w, lane); zero(a1); mm_acc(a1, VsT + 64 * LS, KT, w, lane);
        float* dc = wsp<float>(F, WS_DC) + (size_t)u * 8192;
        each(a0, w, lane, [&](int m, int n, float v) { dc[m * 64 + n] = 0.125f * v; });
        each(a1, w, lane, [&](int m, int n, float v) { dc[(64 + m) * 64 + n] = 0.125f * v; });
        if (tid < 64) { float a = 0.f; for (int s = 0; s < 64; ++s) a += vec[256 + s] * bf2f(KT[tid * LS + s]); wsp<float>(F, WS_DN)[(size_t)u * 64 + tid] = 0.125f * a; }
        __syncthreads();
    }
}
__device__ __forceinline__ void l1_mlstm_c2(const Frame& F, int first_blk, int nblk) {
    using namespace rk;
    LAS bf16* Q = (LAS bf16*)F.lds; LAS bf16* K = Q + 64 * LS; LAS bf16* VT = K + 64 * LS; LAS bf16* Cm = VT + 128 * LS; LAS bf16* Pm = Cm + 128 * LS;
    LAS float* OH = (LAS float*)(F.lds + 7 * MB);
    LAS float* vec = (LAS float*)(F.lds + AUX_OFF); LAS int* rows = (LAS int*)vec;
    const bf16* Pg = wsp<const bf16>(F, WS_P); const int tid = F.tid, w = F.wave, lane = F.lane;
    for (int u = F.blk - first_blk; u < NUNIT_M; u += nblk) {
        const int cidx = u / 260, c = u - cidx * 260, z = cidx >> 3, b = (cidx >> 2) & 1, h = cidx & 3;
        mlstm_chunk_head(F, z, b, h, c, vec);
        const float mst = wsp<const float>(F, WS_MST)[u];
        if (tid < 64) { const int t = tid; float pm = -3.0e38f; for (int s = 0; s <= t; ++s) pm = fmaxf(pm, vec[64 + s] - vec[128 + s]);
            const float gi = vec[128 + t] + mst, mo = fmaxf(gi, vec[128 + t] + pm); vec[320 + t] = __expf(gi - mo); vec[384 + t] = mo;
            vec[256 + t] = wsp<const float>(F, WS_NST)[(size_t)u * 64 + t]; }
        { const int t = tid >> 3, c8 = tid & 7;
          *(LAS v4u*)(Q + t * LS + 8 * c8) = *(const v4u*)(Pg + (size_t)rows[t] * REC_NP + PC_Q + h * 64 + 8 * c8);
          *(LAS v4u*)(K + t * LS + 8 * c8) = *(const v4u*)(Pg + (size_t)rows[t] * REC_NP + PC_K + h * 64 + 8 * c8); }
#pragma unroll
        for (int i = 0; i < 2; ++i) { const int s = (tid >> 4) + 32 * i, c8 = tid & 15; const v4u wv = *(const v4u*)(Pg + (size_t)rows[s] * REC_NP + PC_V + h * 128 + 8 * c8);
            const unsigned ww[4] = {wv.x, wv.y, wv.z, wv.w};
#pragma unroll
            for (int e = 0; e < 4; ++e) { VT[(8 * c8 + 2 * e) * LS + s] = (bf16)(ww[e] & 0xffffu); VT[(8 * c8 + 2 * e + 1) * LS + s] = (bf16)(ww[e] >> 16); } }
        { const int v = tid >> 2, dq = (tid & 3) * 16; const f32x4* src = (const f32x4*)(wsp<const float>(F, WS_CST) + (size_t)u * 8192 + v * 64 + dq);
          const f32x4 x0 = src[0], x1 = src[1], x2 = src[2], x3 = src[3]; v4u o0, o1;
          o0.x = pk2(x0.x, x0.y); o0.y = pk2(x0.z, x0.w); o0.z = pk2(x1.x, x1.y); o0.w = pk2(x1.z, x1.w); o1.x = pk2(x2.x, x2.y); o1.y = pk2(x2.z, x2.w); o1.z = pk2(x3.x, x3.y); o1.w = pk2(x3.z, x3.w);
          *(LAS v4u*)(Cm + v * LS + dq) = o0; *(LAS v4u*)(Cm + v * LS + dq + 8) = o1; }
        __syncthreads();
        Acc2 aq, c0, c1; zero(aq); mm_acc(aq, Q, K, w, lane); zero(c0); mm_acc(c0, Q, Cm, w, lane); zero(c1); mm_acc(c1, Q, Cm + 64 * LS, w, lane);
        each(aq, w, lane, [&](int t, int s, float v) { stb(Pm, t, s, s <= t ? 0.125f * v * __expf(vec[128 + t] + (vec[64 + s] - vec[128 + s]) - vec[384 + t]) : 0.f); });
        __syncthreads();
        Acc2 p0, p1; zero(p0); mm_acc(p0, Pm, VT, w, lane); zero(p1); mm_acc(p1, Pm, VT + 64 * LS, w, lane);
        if (tid < 64) { const int t = tid; float rs = 0.f, nq = 0.f;
            for (int s = 0; s < 64; ++s) { rs += bf2f(Pm[t * LS + s]); nq += vec[256 + s] * bf2f(Q[t * LS + s]); }
            const float den = vec[320 + t] * nq + rs; vec[448 + t] = 1.f / fmaxf(fabsf(den), __expf(-vec[384 + t])); }
        __syncthreads();
        { const int m0 = (w >> 1) * 16 + (lane >> 4) * 4, n0 = (w & 1) * 32 + (lane & 15);
#pragma unroll
          for (int r = 0; r < 4; ++r) { const int t = m0 + r; const float g = vec[320 + t], idn = vec[448 + t];
              OH[t * 132 + n0] = (g * c0.t0[r] + p0.t0[r]) * idn; OH[t * 132 + n0 + 16] = (g * c0.t1[r] + p0.t1[r]) * idn;
              OH[t * 132 + 64 + n0] = (g * c1.t0[r] + p1.t0[r]) * idn; OH[t * 132 + 64 + n0 + 16] = (g * c1.t1[r] + p1.t1[r]) * idn; } }
        __syncthreads();
#pragma unroll
        for (int i = 0; i < 4; ++i) { const int it = tid + 512 * i, t = it >> 5, c4 = (it & 31) * 4;
            const f32x4 hv = *(const LAS f32x4*)(OH + t * 132 + c4); v2u hw; hw.x = pk2(hv.x, hv.y); hw.y = pk2(hv.z, hv.w);
            *(v2u*)(wsp<bf16>(F, WS_HM) + ((size_t)z * R + rows[t]) * 512 + h * 128 + c4) = hw; }
        __syncthreads();
    }
}
#ifndef MK_PER_PHASE
#define MK_PER_PHASE 0
#endif
constexpr int NPHASE = 26;
struct Args { const float* in[N_IN]; float* out; unsigned char* ws; int ph_lo, ph_hi, li, pad; };
#define GEMM_CALL(FnT, SchedT, g, S, fn) do { pg8::EpiGen<FnT> E_{fn}; { int k_ = g.K; asm volatile("" : "+s"(k_)); g.K = k_; } pg8::gemm_phase<pg8::EpiGen<FnT>, SchedT, true, true>((PG8_LAS unsigned char*)F.lds, g, S, E_); } while (0)
#ifndef SITE_MASK
#define SITE_MASK 0xFFFFFFFFull
#endif
#define SITE(s) (((SITE_MASK) >> (s)) & 1ull)
#ifndef DUP_MASK
#define DUP_MASK 0ull
#endif
#define NREP(s) ((((DUP_MASK) >> (s)) & 1ull) ? 2 : 1)
#define IN(k) (lo <= (k) && (k) < hi)
#define SEAM(k) do { if (IN(k) && IN((k) + 1)) xcd_barrier(bar); } while (0)
template <int LAYER> __device__ __forceinline__ void layer_phases(const Frame& F, const XcdBarrier& bar, const int lo, const int hi) {
    constexpr int layer = LAYER; constexpr int pb = 2 + 12 * LAYER;
        if (SITE(2) && IN(pb + 0)) { for (int rep_ = 0; rep_ < NREP(2); ++rep_) {
            const int N = layer == 0 ? ATT_NP : REC_NP;
            pg8::Gemm g{wsp<const bf16>(F, WS_A), layer == 0 ? wsp<const bf16>(F, WS_WIN0) : wsp<const bf16>(F, WS_WREC), R, N, 1024};
            pg8::StaticOrder S; S.init(R, N, F.G, F.blk);
            GEMM_CALL(FnStoreBf16, pg8::StaticOrder, g, S, (FnStoreBf16{wsp<bf16>(F, WS_P), N}));
             if (rep_ + 1 < NREP(2)) xcd_barrier(bar); } SEAM(pb + 0);
        }
        if constexpr (LAYER == 0) {
            if (SITE(3) && IN(pb + 1)) { for (int rep_ = 0; rep_ < NREP(3); ++rep_) { l0_post_proj(F);  if (rep_ + 1 < NREP(3)) xcd_barrier(bar); } SEAM(pb + 1); }
            if (SITE(4) && IN(pb + 2)) { for (int rep_ = 0; rep_ < NREP(4); ++rep_) {
                pg8::Gemm g{wsp<const bf16>(F, WS_CQN), wsp<const bf16>(F, WS_WUQ), R, 768, 384}; pg8::StaticOrder S; S.init(R, 768, F.G, F.blk);
                GEMM_CALL(FnStoreBf16, pg8::StaticOrder, g, S, (FnStoreBf16{wsp<bf16>(F, WS_MQ), 768}));
                 if (rep_ + 1 < NREP(4)) xcd_barrier(bar); } SEAM(pb + 2);
            }
            if (SITE(5) && IN(pb + 3)) { for (int rep_ = 0; rep_ < NREP(5); ++rep_) {
                pg8::Gemm g{wsp<const bf16>(F, WS_CKVN), wsp<const bf16>(F, WS_WUKV), R, 1024, 256}; pg8::StaticOrder S; S.init(R, 1024, F.G, F.blk);
                GEMM_CALL(FnStoreBf16, pg8::StaticOrder, g, S, (FnStoreBf16{wsp<bf16>(F, WS_MKV), 1024}));
                l0_mq_rope(F);
                 if (rep_ + 1 < NREP(5)) xcd_barrier(bar); } SEAM(pb + 3);
            }
            if (SITE(6) && IN(pb + 4)) { for (int rep_ = 0; rep_ < NREP(6); ++rep_) { l0_attention(F);  if (rep_ + 1 < NREP(6)) xcd_barrier(bar); } SEAM(pb + 4); }
            if (SITE(7) && IN(pb + 5)) { for (int rep_ = 0; rep_ < NREP(7); ++rep_) { l0_combine(F);  if (rep_ + 1 < NREP(7)) xcd_barrier(bar); } SEAM(pb + 5); }
        } else {
            if (SITE(8) && IN(pb + 1)) { for (int rep_ = 0; rep_ < NREP(8); ++rep_) { l1_rwkv_prep(F); l1_mlstm_a2(F);  if (rep_ + 1 < NREP(8)) xcd_barrier(bar); } SEAM(pb + 1); }
            if (SITE(9) && IN(pb + 2)) { for (int rep_ = 0; rep_ < NREP(9); ++rep_) {
                pg8::Gemm g{wsp<const bf16>(F, WS_ALORA), wsp<const bf16>(F, WS_WLORA), R, 2560, 384}; pg8::StaticOrder S; S.init(R, 2560, F.G, F.blk);
                { int k_ = g.K; asm volatile("" : "+s"(k_)); g.K = k_; EpiLora E_{&F}; pg8::gemm_phase<EpiLora, pg8::StaticOrder, true, true>((PG8_LAS unsigned char*)F.lds, g, S, E_); }
                l1_mlstm_b(F);
                 if (rep_ + 1 < NREP(9)) xcd_barrier(bar); } SEAM(pb + 2);
            }
            if (SITE(18) && IN(pb + 3)) { for (int rep_ = 0; rep_ < NREP(18); ++rep_) { l1_rk_phase_a(F); if (rep_ + 1 < NREP(18)) xcd_barrier(bar); } SEAM(pb + 3); }
            if (SITE(10) && IN(pb + 4)) { for (int rep_ = 0; rep_ < NREP(10); ++rep_) {
                if (F.G > 32) { if (F.blk < 32) l1_rk_phase_b(F); else { l1_mlstm_c2(F, 32, F.G - 32); moe_weights_convert(F, 1, (F.blk - 32) * 8 + F.wave, (F.G - 32) * 8); } }
                 if (rep_ + 1 < NREP(10)) xcd_barrier(bar); } SEAM(pb + 4);
            }
            if (SITE(11) && IN(pb + 5)) { for (int rep_ = 0; rep_ < NREP(11); ++rep_) { l1_rec_out(F);  if (rep_ + 1 < NREP(11)) xcd_barrier(bar); } SEAM(pb + 5); }
        }
        if (SITE(12) && IN(pb + 6)) { for (int rep_ = 0; rep_ < NREP(12); ++rep_) {
            pg8::Gemm g{wsp<const bf16>(F, WS_A1), wsp<const bf16>(F, WS_WOUT) + (size_t)layer * 1024 * 1024, R, 1024, 1024};
            if constexpr (LAYER == 0) { pg8::StaticOrder S; S.init(R, 1024, F.G, F.blk); GEMM_CALL(FnWout, pg8::StaticOrder, g, S, (FnWout{&F, layer})); }
            else { LatOrder S; S.o.init(R - 2 * CT, 1024, F.G, F.blk); GEMM_CALL(FnWout, LatOrder, g, S, (FnWout{&F, layer})); }
             if (rep_ + 1 < NREP(12)) xcd_barrier(bar); } SEAM(pb + 6);
        }
        if (SITE(13) && IN(pb + 7)) { for (int rep_ = 0; rep_ < NREP(13); ++rep_) { ph_router(F, layer);  if (rep_ + 1 < NREP(13)) xcd_barrier(bar); } SEAM(pb + 7); }
        if (SITE(14) && IN(pb + 8)) { for (int rep_ = 0; rep_ < NREP(14); ++rep_) { ph_gather(F, layer);  if (rep_ + 1 < NREP(14)) xcd_barrier(bar); } SEAM(pb + 8); }
        if (SITE(15) && IN(pb + 9)) { for (int rep_ = 0; rep_ < NREP(15); ++rep_) {
            const int* tab = wsp<const int>(F, WS_TILE);
            pg8::Gemm g{wsp<const bf16>(F, WS_F), wsp<const bf16>(F, WS_W1T), MAXROWS, NE * 2048, 1024}; MoeOrder S{tab + 1, __builtin_amdgcn_readfirstlane(tab[0]), 8, F.G, F.blk, wsp<const int>(F, WS_SRC)};
            { int k_ = g.K; asm volatile("" : "+s"(k_)); g.K = k_; pg8::EpiGen<FnSwiglu> E_{FnSwiglu{wsp<bf16>(F, WS_HS), F.in[I_B1] + (size_t)layer * NE * 2048}};
              pg8::gemm_phase<pg8::EpiGen<FnSwiglu>, MoeOrder, true, true, true>((PG8_LAS unsigned char*)F.lds, g, S, E_); }
             if (rep_ + 1 < NREP(15)) xcd_barrier(bar); } SEAM(pb + 9);
        }
        if (SITE(16) && IN(pb + 10)) { for (int rep_ = 0; rep_ < NREP(16); ++rep_) {
            const int* tab = wsp<const int>(F, WS_TILE);
            pg8::Gemm g{wsp<const bf16>(F, WS_HS), wsp<const bf16>(F, WS_W2T), MAXROWS, NE * 1024, 1024}; MoeOrder S{tab + 1, __builtin_amdgcn_readfirstlane(tab[0]), 4, F.G, F.blk, nullptr};
            GEMM_CALL(FnBiasBf16, MoeOrder, g, S, (FnBiasBf16{wsp<bf16>(F, WS_XS), F.in[I_B2] + (size_t)layer * NE * 1024}));
             if (rep_ + 1 < NREP(16)) xcd_barrier(bar); } SEAM(pb + 10);
        }
        if (SITE(17) && IN(pb + 11)) { for (int rep_ = 0; rep_ < NREP(17); ++rep_) { ph_combine(F, layer);  if (rep_ + 1 < NREP(17)) xcd_barrier(bar); } SEAM(pb + 11); }
}
__global__ void __launch_bounds__(512, 2) fwd(Args args) {
    extern __shared__ __attribute__((aligned(16))) unsigned char lds_[];
    Frame F;
    F.lds = (LAS unsigned char*)lds_; F.tid = threadIdx.x; F.lane = F.tid & 63; F.wave = __builtin_amdgcn_readfirstlane(F.tid >> 6); F.blk = blockIdx.x; F.G = gridDim.x; F.probe = args.pad;
    F.ws = args.ws; F.out = args.out; F.ctl = (gu32*)(args.ws + WS_CTL);
    F.in.t = (LAS const unsigned*)(F.lds + MISC_OFF + 8192);
    if (F.tid < 64) ((LAS unsigned*)(F.lds + MISC_OFF))[F.tid] = 0u;
    if (F.tid < N_IN) { const unsigned long long pv = (unsigned long long)args.in[F.tid]; ((LAS unsigned*)(F.lds + MISC_OFF + 8192))[2 * F.tid] = (unsigned)pv; ((LAS unsigned*)(F.lds + MISC_OFF + 8192))[2 * F.tid + 1] = (unsigned)(pv >> 32); }
    __syncthreads();
    const int lo = args.ph_lo, hi = args.ph_hi;
    XcdBarrier bar; bar.bar = (unsigned*)(F.ctl + CW_BAR) + args.li * XCD_BAR_WORDS; bar.x = 0; bar.st = nullptr;
    if (hi - lo > 1) bar = xcd_barrier_post((unsigned*)(F.ctl + CW_BAR) + args.li * XCD_BAR_WORDS, (volatile LAS unsigned*)(F.lds + MISC_OFF));
    if (SITE(0) && IN(0)) { for (int rep_ = 0; rep_ < NREP(0); ++rep_) { p0a(F);  if (rep_ + 1 < NREP(0)) xcd_barrier(bar); } SEAM(0); }
    if (SITE(1) && IN(1)) { for (int rep_ = 0; rep_ < NREP(1); ++rep_) { p0b(F);  if (rep_ + 1 < NREP(1)) xcd_barrier(bar); } SEAM(1); }
    layer_phases<0>(F, bar, lo, hi);
    layer_phases<1>(F, bar, lo, hi);
}
#undef IN
#undef SEAM


extern "C" void kernel_launch(void* const* d_in, const int* in_sizes, int n_in, void* d_out, int out_size, void* d_ws, size_t ws_size, hipStream_t stream) {
    static int grid = 0;
    if (grid == 0) {
        const bool ok = n_in == N_IN && in_sizes[I_X] == NBATCH * SEQ * DM && in_sizes[I_RECW] == 1024 * REC_IN && in_sizes[I_ATTW] == 1024 * ATT_IN && in_sizes[I_MU] == RWKV_IN &&
                        in_sizes[I_GATEB] == 16 && in_sizes[I_W1] == 2 * NE * 1024 * 2048 && out_size == NBATCH * SEQ * DM && ws_size >= WS_END;
        if (!ok) { fprintf(stderr, "kernel_launch: shape mismatch (n_in %d, recw %d, attw %d, mu %d, out %d, ws %zu need %zu); nothing launched\n", n_in, n_in > I_RECW ? in_sizes[I_RECW] : -1,
                           n_in > I_ATTW ? in_sizes[I_ATTW] : -1, n_in > I_MU ? in_sizes[I_MU] : -1, out_size, ws_size, (size_t)WS_END); grid = -1; return; }
        int dev = 0, cus = 0;
        if (hipGetDevice(&dev) != hipSuccess || hipDeviceGetAttribute(&cus, hipDeviceAttributeMultiprocessorCount, dev) != hipSuccess) { grid = -1; return; }
        if (hipFuncSetAttribute((const void*)fwd, hipFuncAttributeMaxDynamicSharedMemorySize, LDS_BYTES) != hipSuccess) { fprintf(stderr, "kernel_launch: hipFuncSetAttribute failed\n"); grid = -1; return; }
        int per_cu = 0;
        if (hipOccupancyMaxActiveBlocksPerMultiprocessor(&per_cu, (const void*)fwd, 512, LDS_BYTES) != hipSuccess || per_cu < 1) { fprintf(stderr, "kernel_launch: occupancy query says %d blocks per CU\n", per_cu); }
        (void)hipGetLastError();
        grid = cus < 256 ? cus : 256;
        if (grid != 256) fprintf(stderr, "kernel_launch: %d CUs; this kernel is written for a 256-CU device\n", cus);
    }
    if (grid < 0) return;
    if (hipMemsetAsync((char*)d_ws + WS_CTL, 0, CTL_ZERO_BYTES, stream) != hipSuccess) return;
    Args a{};
    for (int i = 0; i < N_IN; ++i) a.in[i] = (const float*)d_in[i];
    a.out = (float*)d_out; a.ws = (unsigned char*)d_ws; a.pad = 0;
#if MK_PER_PHASE
    for (int ph = 0; ph < NPHASE; ++ph) { a.ph_lo = ph; a.ph_hi = ph + 1; a.li = 0; hipLaunchKernelGGL(fwd, dim3(grid), dim3(512), LDS_BYTES, stream, a); }
#elif defined(PROBE_PRE)
    { const int plist[] = {PROBE_PRE}; int cur = 0, li = 0;
      for (int p : plist) { if (p > cur) { a.ph_lo = cur; a.ph_hi = p; a.li = li++; hipLaunchKernelGGL(fwd, dim3(grid), dim3(512), LDS_BYTES, stream, a); }
                            a.ph_lo = p; a.ph_hi = p + 1; a.li = li++; a.pad = 1; hipLaunchKernelGGL(fwd, dim3(grid), dim3(512), LDS_BYTES, stream, a); a.pad = 0; cur = p; }
      a.ph_lo = cur; a.ph_hi = NPHASE; a.li = li++; hipLaunchKernelGGL(fwd, dim3(grid), dim3(512), LDS_BYTES, stream, a); }
#elif defined(PROBE_LIST)
    { const int plist[] = {PROBE_LIST}; int cur = 0, li = 0;
      for (int p : plist) { a.ph_lo = cur; a.ph_hi = p + 1; a.li = li++; hipLaunchKernelGGL(fwd, dim3(grid), dim3(512), LDS_BYTES, stream, a);
                            a.ph_lo = p; a.ph_hi = p + 1; a.li = li++; a.pad = 1; hipLaunchKernelGGL(fwd, dim3(grid), dim3(512), LDS_BYTES, stream, a); a.pad = 0; cur = p + 1; }
      if (cur < NPHASE) { a.ph_lo = cur; a.ph_hi = NPHASE; a.li = li++; hipLaunchKernelGGL(fwd, dim3(grid), dim3(512), LDS_BYTES, stream, a); } }
#else
    a.ph_lo = 0; a.ph_hi = NPHASE; a.li = 0; hipLaunchKernelGGL(fwd, dim3(grid), dim3(512), LDS_BYTES, stream, a);
#endif
    const hipError_t le = hipPeekAtLastError();
    if (le != hipSuccess) fprintf(stderr, "kernel_launch: launch failed: %s\n", hipGetErrorName(le));
}
```

```cpp
#include <hip/hip_runtime.h>
#include <cstdio>
#include <cstdint>
#define MK_PER_PHASE 0
namespace pg8 {
#define PG8_LAS __attribute__((address_space(3)))
typedef unsigned short bf16_t;
typedef short bf16x8 __attribute__((ext_vector_type(8)));
typedef float f32x4 __attribute__((ext_vector_type(4)));
typedef unsigned u32x4 __attribute__((ext_vector_type(4)));
constexpr int BM = 256, BK = 64, HALF = 128, HTB = HALF * BK * 2  , STAGE_BYTES = 8 * HTB, NXCD = 8, WGM = 8;

__host__ __device__ __forceinline__ int lds_byte(int r, int c) { const int st = (r >> 4) * 2 + (c >> 5), rr = r & 15, cc = c & 31, ob = rr * 64 + cc * 2; return st * 1024 + (ob ^ (((ob >> 9) & 1) << 5)); }
__host__ __device__ __forceinline__ void stage_rc(int b, int& R, int& C) { const int st = b / 1024, sb = b % 1024, swz = sb ^ (((sb >> 9) & 1) << 5); R = (st >> 1) * 16 + swz / 64; C = (st & 1) * 32 + (swz % 64) / 2; }
__host__ __device__ __forceinline__ int perm32(int rho) { const int n = rho >> 4, i = rho & 15; return 8 * (i >> 2) + 4 * n + (i & 3); }

struct Unit { int pm, pn; };
struct Gemm { const bf16_t* A; const bf16_t* Bt; int M, N, K; };

struct StaticOrder {
    int nM, nN, nwg, G, c;
    __host__ __device__ void init(int M, int N, int G_, int c_) { nM = M / BM; nN = N / BM; nwg = nM * nN; G = G_; c = c_; }
    __host__ __device__ bool next(int i, Unit& u) const {
        const long L = (long)i * G + c; if (L >= nwg) return false;
        int wgid = (int)L; { const int q = nwg / NXCD, r = nwg % NXCD, xcd = wgid % NXCD, off = wgid / NXCD; wgid = (xcd < r ? xcd * (q + 1) : r * (q + 1) + (xcd - r) * q) + off; }
        const int nig = WGM * nN, gid = wgid / nig, fm = gid * WGM, gsz = (nM - fm) < WGM ? (nM - fm) : WGM;
        u.pm = fm + ((wgid % nig) % gsz); u.pn = (wgid % nig) / gsz; return true;
    }
    __device__ __forceinline__ void a_ready(const Unit&) const {}
    __device__ __forceinline__ void done(const Unit&) const {}
};

__device__ __forceinline__ unsigned cvt_pk_bf16(float lo, float hi) { unsigned r; asm volatile("v_cvt_pk_bf16_f32 %0, %1, %2" : "=v"(r) : "v"(lo), "v"(hi)); return r; }
template <class Fn> struct EpiGen {
    static constexpr bool PERM = true, AFTER_DRAIN = false;
    Fn fn;
    __device__ __forceinline__ void operator()(const f32x4 (&acc)[2][2][4][2], const Unit& u, int wr, int wc, int fr, int fq) const {
#pragma unroll
        for (int ai = 0; ai < 2; ++ai)
#pragma unroll
            for (int m = 0; m < 4; ++m) { const int row = u.pm * BM + ai * HALF + wr * 64 + m * 16 + fr;
#pragma unroll
                for (int bj = 0; bj < 2; ++bj) { const int col = u.pn * BM + bj * HALF + wc * 32 + 8 * fq; fn(row, col, acc[ai][bj][m][0], acc[ai][bj][m][1]); } }
    }
};
template <class Epi, class Sched, bool ALIGN_EPI = false, bool SP2 = false, bool GATHER = false>
__device__ __forceinline__ void gemm_phase(PG8_LAS unsigned char* lds, const Gemm g, const Sched& S, const Epi& E) {
    static_assert(!GATHER || SP2, "the gathered A path is written for the SP2 loop");
    const int tid = threadIdx.x, wid = __builtin_amdgcn_readfirstlane(tid >> 6), lane = tid & 63, wr = wid >> 2, wc = wid & 3, fr = lane & 15, fq = lane >> 4;
    const int K = g.K, nt = K / BK;
    unsigned voffA[2], voffB[2]; int gR[2], gC[2]; unsigned gA[2][2], gN[2][2];
#pragma unroll
    for (int i = 0; i < 2; ++i) { int R, C; stage_rc(tid * 16 + i * 8192, R, C); const int Rb = Epi::PERM ? ((R & ~31) + perm32(R & 31)) : R;
        voffA[i] = (unsigned)(R * K + C) * 2u; voffB[i] = (unsigned)(Rb * K + C) * 2u; gR[i] = R; gC[i] = C; }
    const size_t kstep = (size_t)(BK * 2);
    const size_t hstep = (size_t)HALF * K * 2;
    const size_t tstep = 2 * hstep;
    const unsigned ldsw = (unsigned)wid * 1024u;
    const int aoff = lds_byte(wr * 64 + fr, fq * 8), boff = lds_byte(wc * 32 + fr, fq * 8);
#define PG8_SA(b, h) (((b) * 2 + (h)) * HTB)
#define PG8_SB(b, h) ((4 + (b) * 2 + (h)) * HTB)
#define PG8_STAGE(bufoff, gbase, voff) do { _Pragma("unroll") for (int _i = 0; _i < 2; ++_i) \
        __builtin_amdgcn_global_load_lds((const unsigned*)((const char*)(gbase) + (voff)[_i]), (PG8_LAS unsigned*)(lds + (bufoff) + ldsw + _i * 8192), 16, 0, 0); } while (0)
#define PG8_GOFF(u_, out_) do { _Pragma("unroll") for (int _h = 0; _h < 2; ++_h) _Pragma("unroll") for (int _i = 0; _i < 2; ++_i) \
        out_[_h][_i] = ((unsigned)S.src[(u_).pm * BM + _h * HALF + gR[_i]] * (unsigned)K + (unsigned)gC[_i]) * 2u; } while (0)
#define PG8_STAGE_A(bufoff, kptr, h, isnext) do { if constexpr (GATHER) { unsigned _o[2]; _o[0] = (isnext) ? gN[h][0] : gA[h][0]; _o[1] = (isnext) ? gN[h][1] : gA[h][1]; PG8_STAGE(bufoff, kptr, _o); } \
        else { PG8_STAGE(bufoff, (kptr) + (h) * hstep, voffA); } } while (0)
#define PG8_LDA(dst, b, h) do { _Pragma("unroll") for (int m = 0; m < 4; ++m) _Pragma("unroll") for (int k = 0; k < 2; ++k) dst[m][k] = *(const PG8_LAS bf16x8*)(lds + PG8_SA(b, h) + aoff + m * 2048 + k * 1024); } while (0)
#define PG8_LDB(dst, b, h) do { _Pragma("unroll") for (int n = 0; n < 2; ++n) _Pragma("unroll") for (int k = 0; k < 2; ++k) dst[n][k] = *(const PG8_LAS bf16x8*)(lds + PG8_SB(b, h) + boff + n * 2048 + k * 1024); } while (0)
#define PG8_MMA(ai, bj, At, Bt) do { __builtin_amdgcn_s_setprio(1); _Pragma("unroll") for (int m = 0; m < 4; ++m) _Pragma("unroll") for (int n = 0; n < 2; ++n) _Pragma("unroll") for (int k = 0; k < 2; ++k) \
        acc[ai][bj][m][n] = __builtin_amdgcn_mfma_f32_16x16x32_bf16(Bt[n][k], At[m][k], acc[ai][bj][m][n], 0, 0, 0); __builtin_amdgcn_s_setprio(0); } while (0)
#define PG8_WAIT_V(n) asm volatile("s_waitcnt vmcnt(" #n ")" ::: "memory")
#define PG8_WAIT_L(n) asm volatile("s_waitcnt lgkmcnt(" #n ")" ::: "memory")
#define PG8_BAR __builtin_amdgcn_s_barrier()
#define PG8_SCHED __builtin_amdgcn_sched_barrier(0)
    Unit cur, nxt; int ui = 0;
    if (!S.next(0, cur)) return;
    f32x4 acc[2][2][4][2];
#pragma unroll
    for (int a = 0; a < 2; ++a)
#pragma unroll
        for (int b = 0; b < 2; ++b)
#pragma unroll
            for (int m = 0; m < 4; ++m)
#pragma unroll
                for (int n = 0; n < 2; ++n) acc[a][b][m][n] = (f32x4){0.f, 0.f, 0.f, 0.f};
    bf16x8 At[4][2], B0[2][2], B1[2][2];
    const char* cA = (const char*)g.A + (GATHER ? (size_t)0 : (size_t)cur.pm * tstep); const char* cB = (const char*)g.Bt + (size_t)cur.pn * tstep;
    if constexpr (GATHER) PG8_GOFF(cur, gA);
    S.a_ready(cur);
    if constexpr (SP2) {
        PG8_STAGE(PG8_SB(0, 0), cB, voffB); PG8_STAGE(PG8_SB(0, 1), cB + hstep, voffB); PG8_STAGE_A(PG8_SA(0, 0), cA, 0, false); PG8_STAGE_A(PG8_SA(0, 1), cA, 1, false);
        if (wr == 1) PG8_BAR;
        PG8_WAIT_V(2); PG8_BAR;
        PG8_STAGE(PG8_SB(1, 0), cB + kstep, voffB); PG8_STAGE_A(PG8_SA(1, 0), cA + kstep, 0, false); PG8_STAGE(PG8_SB(1, 1), cB + hstep + kstep, voffB);
        PG8_WAIT_V(6); PG8_BAR;
    } else {
        PG8_STAGE(PG8_SB(0, 0), cB, voffB); PG8_STAGE(PG8_SA(0, 0), cA, voffA); PG8_STAGE(PG8_SB(0, 1), cB + hstep, voffB); PG8_STAGE(PG8_SA(0, 1), cA + hstep, voffA);
        if (wr == 1) PG8_BAR;
        PG8_WAIT_V(4); PG8_BAR;
        PG8_STAGE(PG8_SB(1, 0), cB + kstep, voffB); PG8_STAGE(PG8_SA(1, 0), cA + kstep, voffA); PG8_STAGE(PG8_SB(1, 1), cB + hstep + kstep, voffB);
        PG8_WAIT_V(6); PG8_BAR;
    }
    for (;;) {
        const bool has_next = S.next(ui + 1, nxt);
        const char* nA = (has_next && !GATHER) ? (const char*)g.A + (size_t)nxt.pm * tstep : cA; const char* nB = has_next ? (const char*)g.Bt + (size_t)nxt.pn * tstep : cB;
        if constexpr (GATHER) { if (has_next) PG8_GOFF(nxt, gN); else { _Pragma("unroll") for (int _h = 0; _h < 2; ++_h) { gN[_h][0] = gA[_h][0]; gN[_h][1] = gA[_h][1]; } } }
        for (int t = 0; t < nt; t += 2) {
            const bool last = (t == nt - 2);
            const char* a1 = cA + (size_t)(t + 1) * kstep;
            const char* a2 = last ? nA : cA + (size_t)(t + 2) * kstep; const char* b2 = last ? nB : cB + (size_t)(t + 2) * kstep;
            const char* a3 = a2 + kstep; const char* b3 = b2 + kstep;
            if (last && has_next) S.a_ready(nxt);
            if constexpr (SP2) {
            PG8_LDB(B0, 0, 0); PG8_LDB(B1, 0, 1); PG8_SCHED; PG8_LDA(At, 0, 0); PG8_STAGE_A(PG8_SA(1, 1), a1, 1, false);
            PG8_WAIT_V(8); PG8_WAIT_L(0); PG8_BAR; PG8_MMA(0, 0, At, B0); PG8_MMA(0, 1, At, B1); PG8_BAR; PG8_SCHED;
            PG8_LDA(At, 0, 1); PG8_STAGE(PG8_SB(0, 0), b2, voffB); PG8_STAGE(PG8_SB(0, 1), b2 + hstep, voffB); PG8_STAGE_A(PG8_SA(0, 0), a2, 0, last);
            PG8_WAIT_V(8); PG8_WAIT_L(0); PG8_BAR; PG8_MMA(1, 0, At, B0); PG8_MMA(1, 1, At, B1); PG8_BAR; PG8_SCHED;
            PG8_LDB(B0, 1, 0); PG8_LDB(B1, 1, 1); PG8_SCHED; PG8_LDA(At, 1, 0); PG8_STAGE_A(PG8_SA(0, 1), a2, 1, last);
            PG8_WAIT_V(8); PG8_WAIT_L(0); PG8_BAR; PG8_MMA(0, 0, At, B0); PG8_MMA(0, 1, At, B1); PG8_BAR; PG8_SCHED;
            PG8_LDA(At, 1, 1); PG8_STAGE(PG8_SB(1, 0), b3, voffB); PG8_STAGE(PG8_SB(1, 1), b3 + hstep, voffB); PG8_STAGE_A(PG8_SA(1, 0), a3, 0, last);
            PG8_WAIT_V(8); PG8_WAIT_L(0); PG8_BAR; PG8_MMA(1, 0, At, B0); PG8_MMA(1, 1, At, B1); PG8_BAR; PG8_SCHED;
            } else {
            PG8_LDB(B0, 0, 0); PG8_SCHED; PG8_LDA(At, 0, 0); PG8_STAGE(PG8_SA(1, 1), a1 + hstep, voffA);
            PG8_WAIT_L(8); PG8_BAR; PG8_WAIT_L(0); PG8_MMA(0, 0, At, B0); PG8_BAR; PG8_SCHED;
            PG8_LDB(B1, 0, 1); PG8_STAGE(PG8_SB(0, 0), b2, voffB);
            PG8_BAR; PG8_WAIT_L(0); PG8_MMA(0, 1, At, B1); PG8_BAR;
            PG8_LDA(At, 0, 1); PG8_STAGE(PG8_SA(0, 0), a2, voffA);
            PG8_BAR; PG8_WAIT_L(0); PG8_MMA(1, 0, At, B0); PG8_BAR; PG8_SCHED;
            PG8_STAGE(PG8_SB(0, 1), b2 + hstep, voffB);
            PG8_WAIT_V(6); PG8_BAR; PG8_MMA(1, 1, At, B1); PG8_BAR;
            PG8_LDB(B0, 1, 0); PG8_SCHED; PG8_LDA(At, 1, 0); PG8_STAGE(PG8_SA(0, 1), a2 + hstep, voffA);
            PG8_WAIT_L(8); PG8_BAR; PG8_WAIT_L(0); PG8_MMA(0, 0, At, B0); PG8_BAR; PG8_SCHED;
            PG8_LDB(B1, 1, 1); PG8_STAGE(PG8_SB(1, 0), b3, voffB);
            PG8_BAR; PG8_WAIT_L(0); PG8_MMA(0, 1, At, B1); PG8_BAR;
            PG8_LDA(At, 1, 1); PG8_STAGE(PG8_SA(1, 0), a3, voffA);
            PG8_BAR; PG8_WAIT_L(0); PG8_MMA(1, 0, At, B0); PG8_BAR; PG8_SCHED;
            PG8_STAGE(PG8_SB(1, 1), b3 + hstep, voffB);
            PG8_WAIT_V(6); PG8_BAR; PG8_MMA(1, 1, At, B1); PG8_BAR;
            }
        }
        if constexpr (ALIGN_EPI) { if (wr == 0) PG8_BAR; }
        if constexpr (!Epi::AFTER_DRAIN) { E(acc, cur, wr, wc, fr, fq); S.done(cur); }
        if (!has_next) break;
#pragma unroll
        for (int a = 0; a < 2; ++a)
#pragma unroll
            for (int b = 0; b < 2; ++b)
#pragma unroll
                for (int m = 0; m < 4; ++m)
#pragma unroll
                    for (int n = 0; n < 2; ++n) acc[a][b][m][n] = (f32x4){0.f, 0.f, 0.f, 0.f};
        cur = nxt; cA = nA; cB = nB; ++ui;
        if constexpr (GATHER) { _Pragma("unroll") for (int _h = 0; _h < 2; ++_h) { gA[_h][0] = gN[_h][0]; gA[_h][1] = gN[_h][1]; } }
        if constexpr (ALIGN_EPI) { if (wr == 1) PG8_BAR; }
    }
    PG8_WAIT_V(0);
    if constexpr (!ALIGN_EPI) { if (wr == 0) PG8_BAR; }
    PG8_BAR;
    if constexpr (Epi::AFTER_DRAIN) { E.fused(acc, cur, wr, wc, fr, fq, lds, wid, lane); S.done(cur); }
#undef PG8_SA
#undef PG8_SB
#undef PG8_STAGE
#undef PG8_STAGE_A
#undef PG8_GOFF
#undef PG8_LDA
#undef PG8_LDB
#undef PG8_MMA
#undef PG8_WAIT_V
#undef PG8_WAIT_L
#undef PG8_BAR
#undef PG8_SCHED
}
}
#define GAS __attribute__((address_space(1)))
#define LAS __attribute__((address_space(3)))
typedef unsigned short bf16;
typedef unsigned v4u __attribute__((ext_vector_type(4)));
typedef unsigned v2u __attribute__((ext_vector_type(2)));
typedef float f32x4 __attribute__((ext_vector_type(4)));
typedef short bf16x8 __attribute__((ext_vector_type(8)));
typedef GAS unsigned gu32;
typedef GAS unsigned long long gu64;
#define RLX_AGENT __ATOMIC_RELAXED, __HIP_MEMORY_SCOPE_AGENT
#define LDS_WAIT() asm volatile("s_waitcnt lgkmcnt(0)" ::: "memory")
#define VM_WAIT() asm volatile("s_waitcnt vmcnt(0)" ::: "memory")
typedef float f32x2_cv __attribute__((ext_vector_type(2)));
typedef __bf16 bf16x2_cv __attribute__((ext_vector_type(2)));
__device__ __forceinline__ unsigned pk2(float lo, float hi) { const f32x2_cv v = {lo, hi}; return __builtin_bit_cast(unsigned, __builtin_convertvector(v, bf16x2_cv)); }
__device__ __forceinline__ unsigned f2bf(float f) { return (unsigned)__builtin_bit_cast(unsigned short, (__bf16)f); }
__device__ __forceinline__ float bflo(unsigned w) { return __builtin_bit_cast(float, w << 16); }
__device__ __forceinline__ float bfhi(unsigned w) { return __builtin_bit_cast(float, w & 0xffff0000u); }
__device__ __forceinline__ float bf2f(bf16 b) { return __builtin_bit_cast(float, (unsigned)b << 16); }
__device__ __forceinline__ void unpack8(v4u w, float (&x)[8]) { x[0] = bflo(w.x); x[1] = bfhi(w.x); x[2] = bflo(w.y); x[3] = bfhi(w.y); x[4] = bflo(w.z); x[5] = bfhi(w.z); x[6] = bflo(w.w); x[7] = bfhi(w.w); }
__device__ __forceinline__ float wave_sum(float v) {
#pragma unroll
    for (int o = 1; o < 64; o <<= 1) v += __shfl_xor(v, o);
    return v;
}
__device__ __forceinline__ float sigmoidf_(float x) { return 1.f / (1.f + __expf(-x)); }

#define XB_TMO      128
#define XB_XCNT(j)  (256  + 64 * (j))
#define XB_XSUB(j)  (1280 + 64 * (j))
#define XB_XGEN(j)  (2304 + 64 * (j))
#define XB_TOP      3328
#define XB_TOPGEN   3392
#define XCD_BAR_WORDS 3456
#define XB_SPIN_CAP (1u << 22)

__device__ __forceinline__ unsigned xb_ld(unsigned* p)              { return __hip_atomic_load(p, __ATOMIC_RELAXED, __HIP_MEMORY_SCOPE_AGENT); }
__device__ __forceinline__ unsigned xb_add(unsigned* p, unsigned v) { return __hip_atomic_fetch_add(p, v, __ATOMIC_RELAXED, __HIP_MEMORY_SCOPE_AGENT); }
__device__ __forceinline__ unsigned xb_xcc_id() { return (unsigned)__builtin_amdgcn_s_getreg((3 << 11) | 20) & 0xFu; }
#define XB_SPIN(cond, bar) do { unsigned _sp = 0; while (cond) { __builtin_amdgcn_s_sleep(1); \
    if ((++_sp & 255u) == 0u) { if (xb_ld(&(bar)[XB_TMO])) break; if (_sp > XB_SPIN_CAP) { atomicAdd(&(bar)[XB_TMO], 1u); break; } } } } while (0)

struct XcdBarrier {
    unsigned* bar; unsigned x;
    volatile LAS unsigned* st;
};

__device__ __forceinline__ XcdBarrier xcd_barrier_post(unsigned* bar, volatile LAS unsigned* st) {
    XcdBarrier b; b.bar = bar; b.x = xb_xcc_id(); b.st = st;
    if (threadIdx.x == 0) (void)xb_add(&bar[XB_XCNT(b.x)], 1u);
    return b;
}
__device__ __forceinline__ void xcd_barrier_complete(unsigned* bar, unsigned x, unsigned& nloc, unsigned& nx) {
    const unsigned G = gridDim.x * gridDim.y * gridDim.z;
    unsigned sum, cnt, mine, sp = 0u;
    for (;;) {
        sum = 0u; cnt = 0u; mine = 0u;
#pragma unroll
        for (unsigned j = 0; j < 16; ++j) { const unsigned c = xb_ld(&bar[XB_XCNT(j)]); sum += c; cnt += (c > 0u) ? 1u : 0u; mine = (j == x) ? c : mine; }
        if (sum == G) break;
        __builtin_amdgcn_s_sleep(1);
        if ((++sp & 255u) == 0u) { if (xb_ld(&bar[XB_TMO])) break; if (sp > XB_SPIN_CAP) { atomicAdd(&bar[XB_TMO], 1u); break; } }
    }
    nloc = mine > 0u ? mine : 1u; nx = cnt > 0u ? cnt : 1u;
}

__device__ __forceinline__ void xcd_barrier(const XcdBarrier& b) {
    asm volatile("s_waitcnt vmcnt(0)" ::: "memory");
    __syncthreads();
    if (threadIdx.x == 0) {
        unsigned* bar = b.bar;
        __builtin_amdgcn_s_waitcnt(0);
        unsigned nloc = b.st[0], nx = b.st[1];
        if (nloc == 0u) { xcd_barrier_complete(bar, b.x, nloc, nx); b.st[0] = nloc; b.st[1] = nx; }
        const unsigned old = xb_add(&bar[XB_XSUB(b.x)], 1u);
        const unsigned gen = old / nloc;
        if (old + 1u == (gen + 1u) * nloc) {
            __builtin_amdgcn_fence(__ATOMIC_RELEASE, "agent");
            asm volatile("s_waitcnt vmcnt(0)" ::: "memory");
            const unsigned og = xb_add(&bar[XB_TOP], 1u);
            const unsigned tg = og / nx;
            if (og + 1u == (tg + 1u) * nx) xb_add(&bar[XB_TOPGEN], 1u);
            else XB_SPIN(xb_ld(&bar[XB_TOPGEN]) == tg, bar);
            __builtin_amdgcn_fence(__ATOMIC_ACQUIRE, "agent");
            xb_add(&bar[XB_XGEN(b.x)], 1u);
            asm volatile("s_waitcnt vmcnt(0)" ::: "memory");
        } else {
            XB_SPIN(xb_ld(&bar[XB_XGEN(b.x)]) == gen, bar);
            __builtin_amdgcn_fence(__ATOMIC_ACQUIRE, "agent");
            asm volatile("s_waitcnt vmcnt(0)" ::: "memory");
        }
    }
    __syncthreads();
}
namespace att {
using s16x4  = __attribute__((ext_vector_type(4))) short;
using f32x16 = __attribute__((ext_vector_type(16))) float;
using u32x4  = __attribute__((ext_vector_type(4))) unsigned;
using f32x4  = __attribute__((ext_vector_type(4))) float;
#define ATT_SBAR() __builtin_amdgcn_sched_barrier(0)
constexpr float THR2 = 11.5f;
__device__ __forceinline__ int crow(int r, int hi) { return (r & 3) + 8 * (r >> 2) + 4 * hi; }
__device__ __forceinline__ unsigned cvtpk(float lo, float hi) { unsigned r; asm volatile("v_cvt_pk_bf16_f32 %0, %1, %2" : "=v"(r) : "v"(lo), "v"(hi)); return r; }

__device__ __forceinline__ void partialSM(f32x16& p0, f32x16& p1, float& m_reg, float& mn, float& alpha) {
  float pmax = p0[0];
#pragma unroll
  for (int r = 1; r < 16; ++r) pmax = fmaxf(pmax, p0[r]);
#pragma unroll
  for (int r = 0; r < 16; ++r) pmax = fmaxf(pmax, p1[r]);
  { auto rr = __builtin_amdgcn_permlane32_swap(__float_as_uint(pmax), __float_as_uint(pmax), false, false);
    pmax = fmaxf(__uint_as_float(rr[0]), __uint_as_float(rr[1])); }
  if (__builtin_expect(__all(pmax - m_reg <= THR2), 1)) { mn = m_reg; alpha = 1.f; }
  else { mn = fmaxf(m_reg, pmax); alpha = __builtin_amdgcn_exp2f(m_reg - mn); m_reg = mn; }
#pragma unroll
  for (int r = 0; r < 16; ++r) p0[r] = p0[r] - mn;
#pragma unroll
  for (int r = 0; r < 16; ++r) p1[r] = p1[r] - mn;
#pragma unroll
  for (int r = 0; r < 16; ++r) p0[r] = __builtin_amdgcn_exp2f(p0[r]);
}
__device__ __forceinline__ void finishSM(f32x16& p0, f32x16& p1, bf16x8& pa0, bf16x8& pa1, bf16x8& pa2, bf16x8& pa3) {
#pragma unroll
  for (int r = 0; r < 16; ++r) p1[r] = __builtin_amdgcn_exp2f(p1[r]);
#define ATT_PK4(P, BASE, OUT) do { unsigned a0 = cvtpk(P[BASE + 0], P[BASE + 1]), a1 = cvtpk(P[BASE + 2], P[BASE + 3]);   \
    unsigned b0 = cvtpk(P[BASE + 4], P[BASE + 5]), b1 = cvtpk(P[BASE + 6], P[BASE + 7]);                              \
    auto r0 = __builtin_amdgcn_permlane32_swap(a0, b0, false, false); auto r1 = __builtin_amdgcn_permlane32_swap(a1, b1, false, false); \
    u32x4 w = {r0[0], r1[0], r0[1], r1[1]}; OUT = *reinterpret_cast<bf16x8*>(&w); } while (0)
  ATT_PK4(p0, 0, pa0); ATT_PK4(p0, 8, pa1); ATT_PK4(p1, 0, pa2); ATT_PK4(p1, 8, pa3);
#undef ATT_PK4
}
template <int NB> __device__ __forceinline__ int v_st(int k, int c) { const int kk = (k & ~0xC) | ((k & 4) << 1) | ((k & 8) >> 1); return ((kk >> 3) * NB + (c >> 5)) * 512 + ((kk & 7) * 32 + (c & 31)) * 2; }
__device__ __forceinline__ int v_rd_base(int lane) { return ((lane & 3) << 3) | (((lane >> 2) & 3) << 6) | (((lane >> 4) & 1) << 5) | (((lane >> 5) & 1) << 8); }
template <int OFF> __device__ __forceinline__ s16x4 tr_read(int vb) {
  s16x4 r; asm volatile("ds_read_b64_tr_b16 %0, %1 offset:%2" : "=&v"(r) : "v"(vb), "i"(OFF) : "memory"); return r;
}
template <int NB, int D0, int VO> __device__ __forceinline__ void pv_rd(s16x4 (&f)[8], int vb) {
#define ATT_VOFF(ks, half) (VO + D0 * 512 + (ks) * (NB * 1024) + (half) * (NB * 512))
  f[0] = tr_read<ATT_VOFF(0, 0)>(vb); f[1] = tr_read<ATT_VOFF(0, 1)>(vb); f[2] = tr_read<ATT_VOFF(1, 0)>(vb); f[3] = tr_read<ATT_VOFF(1, 1)>(vb);
  f[4] = tr_read<ATT_VOFF(2, 0)>(vb); f[5] = tr_read<ATT_VOFF(2, 1)>(vb); f[6] = tr_read<ATT_VOFF(3, 0)>(vb); f[7] = tr_read<ATT_VOFF(3, 1)>(vb);
#undef ATT_VOFF
}
__device__ __forceinline__ void pv_mm(f32x16& od, const s16x4 (&f)[8], bf16x8 pa0, bf16x8 pa1, bf16x8 pa2, bf16x8 pa3) {
#define ATT_PK(L, H) (bf16x8){L[0], L[1], L[2], L[3], H[0], H[1], H[2], H[3]}
  od = __builtin_amdgcn_mfma_f32_32x32x16_bf16(pa0, ATT_PK(f[0], f[1]), od, 0, 0, 0);
  od = __builtin_amdgcn_mfma_f32_32x32x16_bf16(pa1, ATT_PK(f[2], f[3]), od, 0, 0, 0);
  od = __builtin_amdgcn_mfma_f32_32x32x16_bf16(pa2, ATT_PK(f[4], f[5]), od, 0, 0, 0);
  od = __builtin_amdgcn_mfma_f32_32x32x16_bf16(pa3, ATT_PK(f[6], f[7]), od, 0, 0, 0);
#undef ATT_PK
}
#define ATT_LWAIT(n) do { asm volatile("s_waitcnt lgkmcnt(" #n ")" ::: "memory"); ATT_SBAR(); } while (0)
template <int NB, int VO, bool SM, bool REL> __device__ __forceinline__ void pv_sm(f32x16* o, f32x4& lsum, bf16x8 sel, int vb, bf16x8 pa0, bf16x8 pa1, bf16x8 pa2, bf16x8 pa3,
                                                                         f32x16& n0, f32x16& n1, float& m_reg, float& mn, float& alpha, f32x16& negm) {
  s16x4 fa[8], fb[8]; float pmax = 0.f;
  pv_rd<NB, 0, VO>(fa, vb); pv_rd<NB, 1, VO>(fb, vb);
  lsum = __builtin_amdgcn_mfma_f32_16x16x32_bf16(sel, pa0, lsum, 0, 0, 0); lsum = __builtin_amdgcn_mfma_f32_16x16x32_bf16(sel, pa1, lsum, 0, 0, 0);
  lsum = __builtin_amdgcn_mfma_f32_16x16x32_bf16(sel, pa2, lsum, 0, 0, 0); lsum = __builtin_amdgcn_mfma_f32_16x16x32_bf16(sel, pa3, lsum, 0, 0, 0);
  if constexpr (SM) { pmax = n0[0];
#pragma unroll
    for (int r = 1; r < 16; ++r) pmax = fmaxf(pmax, n0[r]);
#pragma unroll
    for (int r = 0; r < 16; ++r) pmax = fmaxf(pmax, n1[r]);
    auto rr = __builtin_amdgcn_permlane32_swap(__float_as_uint(pmax), __float_as_uint(pmax), false, false);
    pmax = fmaxf(__uint_as_float(rr[0]), __uint_as_float(rr[1])); }
  ATT_LWAIT(8); pv_mm(o[0], fa, pa0, pa1, pa2, pa3);
  if constexpr (SM && !REL) {
    if (__builtin_expect(__all(pmax - m_reg <= THR2), 1)) { mn = m_reg; alpha = 1.f; }
    else { mn = fmaxf(m_reg, pmax); alpha = __builtin_amdgcn_exp2f(m_reg - mn); m_reg = mn; } }
  if constexpr (SM && REL) {
    if (__builtin_expect(__all(pmax <= THR2), 1)) { alpha = 1.f; }
    else { const float d = fmaxf(pmax, 0.f); alpha = __builtin_amdgcn_exp2f(-d);
#pragma unroll
      for (int r = 0; r < 16; ++r) { n0[r] -= d; n1[r] -= d; negm[r] -= d; } } }
  if constexpr (NB == 4) {
    pv_rd<NB, 2, VO>(fa, vb);
    if constexpr (SM && !REL) {
#pragma unroll
      for (int r = 0; r < 16; ++r) n0[r] = n0[r] - mn; }
    ATT_LWAIT(8); pv_mm(o[1], fb, pa0, pa1, pa2, pa3);
    pv_rd<NB, 3, VO>(fb, vb);
    if constexpr (SM && !REL) {
#pragma unroll
      for (int r = 0; r < 16; ++r) n1[r] = n1[r] - mn; }
    ATT_LWAIT(8); pv_mm(o[2], fa, pa0, pa1, pa2, pa3);
    if constexpr (SM) {
#pragma unroll
      for (int r = 0; r < 8; ++r) n0[r] = __builtin_amdgcn_exp2f(n0[r]); }
    ATT_LWAIT(0); pv_mm(o[3], fb, pa0, pa1, pa2, pa3);
    if constexpr (SM) {
#pragma unroll
      for (int r = 8; r < 16; ++r) n0[r] = __builtin_amdgcn_exp2f(n0[r]); }
  } else {
    if constexpr (SM && !REL) {
#pragma unroll
      for (int r = 0; r < 16; ++r) { n0[r] = n0[r] - mn; n1[r] = n1[r] - mn; } }
    ATT_LWAIT(0); pv_mm(o[1], fb, pa0, pa1, pa2, pa3);
    if constexpr (SM) {
#pragma unroll
      for (int r = 0; r < 16; ++r) n0[r] = __builtin_amdgcn_exp2f(n0[r]); }
  }
}
template <int DK, bool REL> __device__ __forceinline__ void qkt(f32x16& p0, f32x16& p1, LAS const char* Kt, const int (&ka)[DK / 16], const bf16x8* qr, const f32x16& negm) {
  if constexpr (!REL) { p0 = f32x16{}; p1 = f32x16{}; }
#pragma unroll
  for (int d0 = 0; d0 < DK / 16; ++d0) {
    const bf16x8 b0 = *(LAS const bf16x8*)(Kt + ka[d0]);
    const bf16x8 b1 = *(LAS const bf16x8*)(Kt + ka[d0] + (d0 < 4 ? 4096 : 2048));
    p0 = __builtin_amdgcn_mfma_f32_32x32x16_bf16(b0, qr[d0], (REL && d0 == 0) ? negm : p0, 0, 0, 0);
    p1 = __builtin_amdgcn_mfma_f32_32x32x16_bf16(b1, qr[d0], (REL && d0 == 0) ? negm : p1, 0, 0, 0); }
}
template <int DK, int DV> struct Cfg {
  static constexpr int KT = 64 * DK * 2, NB = DV / 32, VT = 64 * DV * 2, NQ = DK / 16;
  static constexpr int KN = DK / 64 + (DK % 64 != 0), VN = (64 * DV / 8) / 512;
  static constexpr int NS = 4;
  static constexpr int OFF_K = 0, OFF_V = NS * KT, OFF_WS = NS * (KT + VT), LDS_BYTES = OFF_WS + 8 * 64 * 4;
};
template <int DK, int DV>
__device__ __forceinline__ void attn_unit(const bf16* __restrict__ Qb, int ldq, const bf16* __restrict__ K1, int ldk1, const bf16* __restrict__ K2, int ldk2,
                                          const bf16* __restrict__ Vh, int ldv, float* __restrict__ Ob, int ldo, int nkeys, LAS char* lds) {
  using C = Cfg<DK, DV>;
  const int tid = threadIdx.x, wid = __builtin_amdgcn_readfirstlane(tid >> 6), lane = tid & 63, r32 = lane & 31, hi = lane >> 5;
  LAS float* ws = (LAS float*)(lds + C::OFF_WS) + wid * 64; LAS float* al_l = ws + 32;
  constexpr bool REL = (DV == 64);
  float m_reg = -1e30f; f32x16 negm = {}; f32x16 o[C::NB] = {}; f32x4 lsum = {}; bf16x8 qr[C::NQ];
  bf16x8 sel; { const int i_ = lane & 15, kq_ = lane >> 4; const unsigned v_ = ((i_ == 0 && !(kq_ & 1)) || (i_ == 1 && (kq_ & 1))) ? 0x3F803F80u : 0u; u32x4 w_ = {v_, v_, v_, v_}; sel = *reinterpret_cast<bf16x8*>(&w_); }
  { const bf16* Qw = Qb + (long)(wid * 32 + r32) * ldq + hi * 8;
#pragma unroll
    for (int d0 = 0; d0 < C::NQ; ++d0) qr[d0] = *(const bf16x8*)(Qw + d0 * 16); }
  unsigned kg0, kg1 = 0, vg[C::VN];
  { const int row = tid >> 3, cp = tid & 7; kg0 = (unsigned)(row * ldk1 + ((cp ^ ((row >> 1) & 7)) * 8)); }
  if constexpr (C::KN == 2) { const int p = tid & 255, row = p >> 2, cp = p & 3; kg1 = (unsigned)(row * ldk2 + ((cp ^ ((row >> 2) & 3)) * 8)); }
#pragma unroll
  for (int i = 0; i < C::VN; ++i) { const int p = i * 512 + tid, st = p >> 5, wi = p & 31, kk = (st / C::NB) * 8 + (wi >> 2), col = (st % C::NB) * 32 + (wi & 3) * 8;
    const int k = (kk & ~0xC) | ((kk & 4) << 1) | ((kk & 8) >> 1); vg[i] = (unsigned)(k * ldv + col); }
  int ka[C::NQ];
#pragma unroll
  for (int d0 = 0; d0 < C::NQ; ++d0) ka[d0] = (d0 < 4) ? r32 * 128 + ((((d0 * 2) ^ hi ^ ((r32 >> 1) & 7)) & 7) << 4) : 8192 + r32 * 64 + (((((d0 - 4) * 2) ^ hi ^ ((r32 >> 2) & 3)) & 3) << 4);
  const int vb0 = (int)(uintptr_t)(lds + C::OFF_V) + v_rd_base(lane);
  const bool p3 = (C::KN == 1) || wid < 4;
#define ATT_ISSUE(S, t) do { const size_t t64_ = (size_t)(t) * 64; \
    __builtin_amdgcn_global_load_lds((const unsigned*)(K1 + t64_ * ldk1 + kg0), (LAS unsigned*)(lds + C::OFF_K + (S) * C::KT + wid * 1024), 16, 0, 0); \
    if constexpr (C::KN == 2) { if (wid < 4) __builtin_amdgcn_global_load_lds((const unsigned*)(K2 + t64_ * ldk2 + kg1), (LAS unsigned*)(lds + C::OFF_K + (S) * C::KT + 8192 + wid * 1024), 16, 0, 0); } \
    _Pragma("unroll") for (int i_ = 0; i_ < C::VN; ++i_) __builtin_amdgcn_global_load_lds((const unsigned*)(Vh + t64_ * ldv + vg[i_]), (LAS unsigned*)(lds + C::OFF_V + (S) * C::VT + (i_ * 512 + wid * 64) * 16), 16, 0, 0); } while (0)
#define ATT_LAND1() do { if (p3) asm volatile("s_waitcnt vmcnt(3)" ::: "memory"); else asm volatile("s_waitcnt vmcnt(2)" ::: "memory"); } while (0)
#define ATT_LAND2() do { if (p3) asm volatile("s_waitcnt vmcnt(6)" ::: "memory"); else asm volatile("s_waitcnt vmcnt(4)" ::: "memory"); } while (0)
#define ATT_RESC(a) do { if (__any((a) < 1.f)) { if (hi == 0) al_l[r32] = (a); asm volatile("s_waitcnt lgkmcnt(0)" ::: "memory"); \
    lsum[0] *= al_l[lane & 15]; lsum[1] *= al_l[16 + (lane & 15)]; \
    _Pragma("unroll") for (int r = 0; r < 16; ++r) { const float f_ = al_l[crow(r, hi)]; _Pragma("unroll") for (int d = 0; d < C::NB; ++d) o[d][r] *= f_; } } } while (0)
  static_assert(C::KN + C::VN == 3 && C::NS == 4, "three (two on waves 4..7 when DK = 96) DMA pieces per thread per tile; slot = tile & 3");
#define ATT_STEP(S, t, C0, C1, N0, N1, mnN, alN, LAST) do { ATT_SBAR(); \
    { const int ti_ = ((t) + 3 < NT) ? (t) + 3 : NT - 1; ATT_ISSUE(((S) + 3) & 3, ti_); } ATT_SBAR(); \
    if constexpr (!(LAST)) qkt<DK, REL>(N0, N1, lds + C::OFF_K + (((S) + 1) & 3) * C::KT, ka, qr, negm); \
    finishSM(C0, C1, pa0, pa1, pa2, pa3); ATT_SBAR(); \
    pv_sm<C::NB, (S) * C::VT, !(LAST), REL>(o, lsum, sel, vb0, pa0, pa1, pa2, pa3, N0, N1, m_reg, mnN, alN, negm); ATT_SBAR(); \
    if constexpr (!(LAST)) { ATT_RESC(alN); } \
    ATT_LAND1(); __builtin_amdgcn_s_barrier(); } while (0)
  f32x16 pA0, pA1, pB0, pB1; float mnA, mnB, alA, alB; bf16x8 pa0, pa1, pa2, pa3; const int NT = nkeys / 64;
  asm volatile("s_waitcnt vmcnt(0) lgkmcnt(0)" ::: "memory"); __builtin_amdgcn_s_barrier();
  ATT_ISSUE(0, 0); ATT_ISSUE(1, 1); ATT_ISSUE(2, 2);
  ATT_LAND2(); __builtin_amdgcn_s_barrier();
  qkt<DK, REL>(pA0, pA1, lds + C::OFF_K, ka, qr, negm);
  partialSM(pA0, pA1, m_reg, mnA, alA);
  if constexpr (REL) {
#pragma unroll
    for (int r = 0; r < 16; ++r) negm[r] = -m_reg; }
  ATT_LAND1(); __builtin_amdgcn_s_barrier();
  int t = 0;
  for (; t + 4 < NT; t += 4) {
    ATT_STEP(0, t,     pA0, pA1, pB0, pB1, mnB, alB, false);
    ATT_STEP(1, t + 1, pB0, pB1, pA0, pA1, mnA, alA, false);
    ATT_STEP(2, t + 2, pA0, pA1, pB0, pB1, mnB, alB, false);
    ATT_STEP(3, t + 3, pB0, pB1, pA0, pA1, mnA, alA, false);
  }
  ATT_STEP(0, t,     pA0, pA1, pB0, pB1, mnB, alB, false);
  ATT_STEP(1, t + 1, pB0, pB1, pA0, pA1, mnA, alA, false);
  ATT_STEP(2, t + 2, pA0, pA1, pB0, pB1, mnB, alB, false);
  ATT_STEP(3, t + 3, pB0, pB1, pA0, pA1, mnA, alA, true);
  asm volatile("s_waitcnt vmcnt(0)" ::: "memory");
  float rli[16];
  if (lane < 16) { al_l[lane] = lsum[0]; al_l[16 + lane] = lsum[1]; }
  asm volatile("s_waitcnt lgkmcnt(0)" ::: "memory");
#pragma unroll
  for (int r = 0; r < 16; ++r) rli[r] = __builtin_amdgcn_rcpf(al_l[crow(r, hi)]);
  float* Ow = Ob + (long)(wid * 32) * ldo;
#pragma unroll
  for (int r = 0; r < 16; ++r) { const int orow = crow(r, hi);
#pragma unroll
    for (int d0 = 0; d0 < C::NB; ++d0) Ow[(long)orow * ldo + d0 * 32 + r32] = o[d0][r] * rli[r]; }
#undef ATT_ISSUE
#undef ATT_LAND1
#undef ATT_LAND2
#undef ATT_RESC
#undef ATT_STEP
}
}
constexpr int DM = 1024, NBATCH = 2, SEQ = 16384, CT = 256, TB = SEQ + CT  , R = NBATCH * TB  ;
constexpr int ATT_IN = 2208, ATT_NP = 2304, REC_IN = 3472, REC_NP = 3584, RWKV_IN = 1920;
constexpr int NE = 32, TOPK = 4, MAXT = R * TOPK / 256 + NE  , MAXROWS = MAXT * 256;
constexpr int NUNIT_M = 16 * 260;
constexpr float NORM_EPS = 1e-6f;
enum { I_X = 0, I_C, I_CTX, I_CCTX, I_NMIX, I_NFFN, I_ADAW, I_ADAB, I_WOUT, I_RW, I_RB, I_W1, I_B1, I_W2, I_B2, I_ATTW, I_LAM, I_SUBLN, I_QNW, I_KVNW, I_WUQ, I_WUKV,
       I_RECW, I_MU, I_W0, I_RW2, I_A0, I_A2, I_G2, I_KK, I_KA, I_RK, I_LNW, I_LNB, I_GATEB, I_MNW, I_FNW, N_IN };
constexpr size_t al256(size_t x) { return (x + 255) & ~(size_t)255; }
constexpr size_t WS_CTL = 0, CTL_ZERO_BYTES = 1u << 20;
constexpr size_t WS_MOD = CTL_ZERO_BYTES;
constexpr size_t WS_ROPE = al256(WS_MOD + 2 * 3 * 6144 * 4);
constexpr size_t ROPE_DR = 0, ROPE_DC = 256 * 16 * 2, ROPE_MR = ROPE_DC + 64 * 16 * 2, ROPE_MC = ROPE_MR + 256 * 8 * 2, ROPE_FLOATS = ROPE_MC + 64 * 8 * 2;
constexpr size_t WS_WRH = al256(WS_ROPE + ROPE_FLOATS * 4);
constexpr size_t WS_WRL = al256(WS_WRH + (size_t)2 * 32 * 1024 * 2);
constexpr size_t WS_WIN0 = al256(WS_WRL + (size_t)2 * 32 * 1024 * 2);
constexpr size_t WS_WUQ = al256(WS_WIN0 + (size_t)ATT_NP * 1024 * 2);
constexpr size_t WS_WUKV = al256(WS_WUQ + (size_t)768 * 384 * 2);
constexpr size_t WS_WOUT = al256(WS_WUKV + (size_t)1024 * 256 * 2);
constexpr size_t WS_WREC = al256(WS_WOUT + (size_t)2 * 1024 * 1024 * 2);
constexpr size_t WS_WLORA = al256(WS_WREC + (size_t)REC_NP * 1024 * 2);
constexpr size_t WS_W1T = al256(WS_WLORA + (size_t)2560 * 384 * 2);
constexpr size_t WS_W2T = al256(WS_W1T + (size_t)NE * 2048 * 1024 * 2);
constexpr size_t WS_H = al256(WS_W2T + (size_t)NE * 1024 * 1024 * 2);
constexpr size_t WS_A = al256(WS_H + (size_t)R * 1024 * 4);
constexpr size_t WS_A1 = al256(WS_A + (size_t)R * 1024 * 2);
constexpr size_t WS_F = al256(WS_A1 + (size_t)R * 1024 * 2);
constexpr size_t WS_P = al256(WS_F + (size_t)R * 1024 * 2);
constexpr size_t WS_TOPE = al256(WS_P + (size_t)R * REC_NP * 2);
constexpr size_t WS_GATE = al256(WS_TOPE + (size_t)R * 16);
constexpr size_t WS_POS = al256(WS_GATE + (size_t)R * 16);
constexpr size_t WS_DEST = al256(WS_POS + (size_t)R * 16);
constexpr size_t WS_TILE = al256(WS_DEST + (size_t)R * 16);
constexpr size_t WS_SRC = al256(WS_TILE + (size_t)(MAXT + 8) * 4);
constexpr size_t WS_T = al256(WS_SRC + (size_t)MAXROWS * 4);
constexpr size_t WS_QD = WS_T;
constexpr size_t WS_KD = al256(WS_QD + (size_t)R * 512 * 2);
constexpr size_t WS_CQN = al256(WS_KD + (size_t)R * 512 * 2);
constexpr size_t WS_CKVN = al256(WS_CQN + (size_t)R * 384 * 2);
constexpr size_t WS_MQ = al256(WS_CKVN + (size_t)R * 256 * 2);
constexpr size_t WS_MKV = al256(WS_MQ + (size_t)R * 768 * 2);
constexpr size_t WS_KRR = al256(WS_MKV + (size_t)R * 1024 * 2);
constexpr size_t WS_ODIFF = al256(WS_KRR + (size_t)R * 32 * 2);
constexpr size_t WS_OMLA = al256(WS_ODIFF + (size_t)R * 1024 * 4);
constexpr size_t WS_T0_END = al256(WS_OMLA + (size_t)R * 512 * 4);
constexpr size_t WS_XS = WS_T;
constexpr size_t WS_HS = al256(WS_XS + (size_t)MAXROWS * 1024 * 2);
constexpr size_t WS_TM_END = al256(WS_HS + (size_t)MAXROWS * 1024 * 2);
constexpr size_t SZ_RC = (size_t)R * 512 * 4;
constexpr size_t WS_RR = WS_T, WS_VV = WS_RR + SZ_RC, WS_AKK = WS_VV + SZ_RC, WS_KL = WS_AKK + SZ_RC;
constexpr size_t WS_WDEC = WS_KL + SZ_RC  , WS_KDIR = WS_WDEC + 2 * SZ_RC  , WS_BB = WS_KDIR + 2 * SZ_RC  , WS_GG = WS_BB + 2 * SZ_RC;
constexpr size_t WS_ALORA = al256(WS_GG + SZ_RC);
constexpr size_t WS_YR = al256(WS_ALORA + (size_t)R * 384 * 2);
constexpr size_t WS_DC = WS_YR;
constexpr size_t WS_HM = al256(WS_YR + 2 * SZ_RC);
constexpr size_t WS_CST = al256(WS_HM + 2 * SZ_RC);
constexpr size_t WS_DN = al256(WS_CST + (size_t)NUNIT_M * 8192 * 4);
constexpr size_t WS_NST = al256(WS_DN + (size_t)NUNIT_M * 64 * 4);
constexpr size_t WS_SC = al256(WS_NST + (size_t)NUNIT_M * 64 * 4);
constexpr size_t WS_MST = al256(WS_SC + (size_t)NUNIT_M * 2 * 4);
constexpr size_t WS_ASIG = WS_KDIR;
constexpr size_t WS_YB = WS_BB;
constexpr int NUNIT_R = 32 * 260;
constexpr size_t WS_RKM = WS_KDIR + SZ_RC;
static_assert((size_t)NUNIT_R * 4096 * 2 <= SZ_RC, "M^T fits in KL");
constexpr size_t WS_RKQ = al256(WS_MST + (size_t)NUNIT_M * 4);
constexpr size_t WS_RKZ = al256(WS_RKQ + (size_t)NUNIT_R * 4096 * 2);
constexpr size_t WS_T1_END = al256(WS_RKZ + (size_t)NUNIT_R * 4096 * 2);
constexpr size_t WS_END = WS_T1_END > WS_TM_END ? (WS_T1_END > WS_T0_END ? WS_T1_END : WS_T0_END) : (WS_TM_END > WS_T0_END ? WS_TM_END : WS_T0_END);
static_assert(WS_END <= (size_t)2147483648ull, "workspace map exceeds 2 GiB");
constexpr int CW_CNT = 1024;
constexpr int CW_BAR = 4096;
constexpr int RING_BYTES = 131072, AUX_OFF = 131072, AUX_BYTES = 16384, MISC_OFF = 147456, LDS_BYTES = 163840;

struct Frame {
    LAS unsigned char* lds; gu32* ctl; int tid, lane, wave, blk, G, probe;
    float* out; unsigned char* ws;
    struct InTab { LAS const unsigned* t;
        __device__ __forceinline__ const float* operator[](int i) const { const unsigned lo = __builtin_amdgcn_readfirstlane(t[2 * i]), hi = __builtin_amdgcn_readfirstlane(t[2 * i + 1]);
            return (const float*)(((unsigned long long)hi << 32) | lo); } } in;
};
template <class T> __device__ __forceinline__ T* wsp(const Frame& F, size_t off) { return (T*)(F.ws + off); }
__device__ __forceinline__ int row_sel(int row) { const int b = row / TB, t = row - b * TB; return t < CT ? 2 : b; }
__device__ __forceinline__ const float* h0_row(const Frame& F, int row) {
    const int b = row / TB, t = row - b * TB;
    return t < CT ? F.in[I_CTX] + ((size_t)b * CT + t) * DM : F.in[I_X] + ((size_t)b * SEQ + (t - CT)) * DM;
}
__device__ __forceinline__ const float* modp(const Frame& F, int layer, int sel, int chunk) { return wsp<const float>(F, WS_MOD) + ((size_t)(layer * 3 + sel) * 6 + chunk) * DM; }
__device__ __forceinline__ int scan_tok(int z, int sg) { return z == 0 ? sg : (sg < CT ? CT - 1 - sg : TB + CT - 1 - sg); }
__device__ __forceinline__ void tr_item(const float* W, int K, int N, bf16* WT, int row_off, LAS float* scr, int kb, int nb, int lane) {
    const int k0 = 64 * kb, n0 = 32 * nb;
    const int n = n0 + (lane & 31);
    float tv[32];
#pragma unroll
    for (int i = 0; i < 32; ++i) { const int kk = 2 * i + (lane >> 5); tv[i] = (n < N) ? W[(size_t)(k0 + kk) * N + n] : 0.f; }
#pragma unroll
    for (int i = 0; i < 32; ++i) { const int kk = 2 * i + (lane >> 5); scr[kk * 33 + (lane & 31)] = tv[i]; }
    LDS_WAIT(); asm volatile("" ::: "memory");
    const int c = lane & 7;
#pragma unroll
    for (int j = 0; j < 4; ++j) { const int nn = (lane >> 3) + 8 * j; const LAS float* s = scr + (8 * c) * 33 + nn;
        v4u o; o.x = pk2(s[0 * 33], s[1 * 33]); o.y = pk2(s[2 * 33], s[3 * 33]); o.z = pk2(s[4 * 33], s[5 * 33]); o.w = pk2(s[6 * 33], s[7 * 33]);
        *(v4u*)(WT + (size_t)(row_off + n0 + nn) * K + k0 + 8 * c) = o; }
    LDS_WAIT(); asm volatile("" ::: "memory");
}
__device__ __forceinline__ void tr_family(const Frame& F, const float* W, size_t src_stride, int nmat, int K, int N, int Npad, bf16* WT, int gw, int NGW) {
    LAS float* scr = (LAS float*)(F.lds + F.wave * 16384);
    const int nkb = K / 64, nnb = Npad / 32, per = nkb * nnb, total = per * nmat;
    for (int it = gw; it < total; it += NGW) { const int m = it / per, r = it - m * per, kb = r / nnb, nb = r - kb * nnb;
        tr_item(W + (size_t)m * src_stride, K, N, WT, m * Npad, scr, kb, nb, F.lane); }
}
__device__ __forceinline__ void moe_weights_convert(const Frame& F, int layer, int gw, int NGW) {
    tr_family(F, F.in[I_W1] + (size_t)layer * NE * 1024 * 2048, (size_t)1024 * 2048, NE, 1024, 2048, 2048, wsp<bf16>(F, WS_W1T), gw, NGW);
    tr_family(F, F.in[I_W2] + (size_t)layer * NE * 1024 * 1024, (size_t)1024 * 1024, NE, 1024, 1024, 1024, wsp<bf16>(F, WS_W2T), gw, NGW);
}
__device__ __forceinline__ void norm_mod_row(const Frame& F, const float* src, const float* nw, const float* shift, const float* scale, bf16* orow) {
    const f32x4* xr = (const f32x4*)src + F.lane;
    f32x4 v[4]; float s = 0.f;
#pragma unroll
    for (int j = 0; j < 4; ++j) { v[j] = xr[64 * j]; s += (v[j].x * v[j].x + v[j].y * v[j].y) + (v[j].z * v[j].z + v[j].w * v[j].w); }
    const float rs = 1.f / sqrtf(wave_sum(s) * (1.f / DM) + NORM_EPS);
    unsigned long long* o8 = (unsigned long long*)orow + F.lane;
#pragma unroll
    for (int j = 0; j < 4; ++j) { const f32x4 w = ((const f32x4*)nw)[F.lane + 64 * j], sh = ((const f32x4*)shift)[F.lane + 64 * j], sc = ((const f32x4*)scale)[F.lane + 64 * j];
        const f32x4 y = v[j] * rs * w * (sc + 1.f) + sh;
        o8[64 * j] = (unsigned long long)pk2(y.x, y.y) | ((unsigned long long)pk2(y.z, y.w) << 32); }
}
__device__ __forceinline__ void p0a(const Frame& F) {
    LAS float* sv = (LAS float*)F.lds; LAS float* red = (LAS float*)(F.lds + 16384);
    for (int i = F.tid; i < 3 * DM; i += 512) { const int s = i / DM, k = i - s * DM; const float cv = (s < 2) ? F.in[I_C][s * DM + k] : F.in[I_CCTX][k]; sv[i] = cv / (1.f + __expf(-cv)); }
    __syncthreads();
    for (int it = F.blk; it < 192; it += F.G) {
        const int l = it / 96, cgp = it - l * 96, kq = F.tid >> 4, cg = F.tid & 15, col = cgp * 64 + cg * 4;
        float acc[3][4];
#pragma unroll
        for (int s = 0; s < 3; ++s)
#pragma unroll
            for (int j = 0; j < 4; ++j) acc[s][j] = 0.f;
        const float* W = F.in[I_ADAW] + (size_t)l * DM * 6144 + col;
#pragma unroll 16
        for (int kk = 0; kk < 32; ++kk) { const int k = kq * 32 + kk; const f32x4 w = *(const f32x4*)(W + (size_t)k * 6144);
            const float s0 = sv[k], s1 = sv[DM + k], s2 = sv[2 * DM + k];
#pragma unroll
            for (int j = 0; j < 4; ++j) { acc[0][j] += s0 * w[j]; acc[1][j] += s1 * w[j]; acc[2][j] += s2 * w[j]; } }
#pragma unroll
        for (int s = 0; s < 3; ++s)
#pragma unroll
            for (int j = 0; j < 4; ++j) red[(kq * 16 + cg) * 12 + s * 4 + j] = acc[s][j];
        __syncthreads();
        if (F.tid < 192) { const int s = F.tid / 64, cc = F.tid - s * 64, cg2 = cc >> 2, j = cc & 3; float t = 0.f;
            for (int q = 0; q < 32; ++q) t += red[(q * 16 + cg2) * 12 + s * 4 + j];
            wsp<float>(F, WS_MOD)[(size_t)(l * 3 + s) * 6144 + cgp * 64 + cc] = t + F.in[I_ADAB][l * 6144 + cgp * 64 + cc]; }
        __syncthreads();
    }
    const int gid = F.blk * 512 + F.tid, GT = F.G * 512;
    float* rope = wsp<float>(F, WS_ROPE);
    for (int i = gid; i < 256 * 16 + 64 * 16 + 256 * 8 + 64 * 8; i += GT) {
        int j = i; float pos, inv; size_t off;
        if (j < 256 * 16) { pos = (float)(j / 16); inv = powf(10000.f, -(float)(j % 16) / 16.f); off = ROPE_DR + (size_t)j * 2; }
        else if ((j -= 256 * 16) < 64 * 16) { pos = (float)(j / 16); inv = powf(10000.f, -(float)(j % 16) / 16.f); off = ROPE_DC + (size_t)j * 2; }
        else if ((j -= 64 * 16) < 256 * 8) { pos = (float)(j / 8); inv = powf(10000.f, -(float)(j % 8) / 8.f); off = ROPE_MR + (size_t)j * 2; }
        else { j -= 256 * 8; pos = (float)(j / 8); inv = powf(10000.f, -(float)(j % 8) / 8.f); off = ROPE_MC + (size_t)j * 2; }
        const float ang = pos * inv; rope[off] = cosf(ang); rope[off + 1] = sinf(ang);
    }
    { bf16* wh = wsp<bf16>(F, WS_WRH); bf16* wl = wsp<bf16>(F, WS_WRL); for (int i = gid; i < 2 * 32 * 1024; i += GT) { const int k = i & 1023, e = (i >> 10) & 31, l = i >> 15; const float wv = F.in[I_RW][((size_t)l * DM + k) * NE + e];
        const unsigned hb = f2bf(wv); wh[i] = (bf16)hb; wl[i] = (bf16)f2bf(wv - bf2f((bf16)hb)); } }
    bf16* WL = wsp<bf16>(F, WS_WLORA);
    for (int i = gid; i < 2560 * 384; i += GT) { const int n = i / 384, k = i - n * 384, part = n >> 9, c = n & 511; float v = 0.f;
        if (part < 2) { if ((k >> 6) == part) v = F.in[I_RW2][((size_t)part * 64 + (k & 63)) * 512 + c]; }
        else if (part < 4) { if ((k >> 6) == part) v = F.in[I_A2][((size_t)(part - 2) * 64 + (k & 63)) * 512 + c]; }
        else { if (k >= 256) v = F.in[I_G2][(size_t)(k - 256) * 512 + c]; }
        WL[i] = (bf16)f2bf(v); }
    const int gw = F.blk * 8 + F.wave, NGW = F.G * 8;
    tr_family(F, F.in[I_ATTW], 0, 1, 1024, ATT_IN, ATT_NP, wsp<bf16>(F, WS_WIN0), gw, NGW);
    tr_family(F, F.in[I_WUQ], 0, 1, 384, 768, 768, wsp<bf16>(F, WS_WUQ), gw, NGW);
    tr_family(F, F.in[I_WUKV], 0, 1, 256, 1024, 1024, wsp<bf16>(F, WS_WUKV), gw, NGW);
    tr_family(F, F.in[I_WOUT], (size_t)1024 * 1024, 2, 1024, 1024, 1024, wsp<bf16>(F, WS_WOUT), gw, NGW);
    tr_family(F, F.in[I_RECW], 0, 1, 1024, REC_IN, REC_NP, wsp<bf16>(F, WS_WREC), gw, NGW);
    moe_weights_convert(F, 0, gw, NGW);
}
__device__ __forceinline__ void p0b(const Frame& F) {
    const int gw = F.blk * 8 + F.wave, NGW = F.G * 8;
    for (int row = gw; row < R; row += NGW) { const int sel = row_sel(row);
        norm_mod_row(F, h0_row(F, row), F.in[I_NMIX], modp(F, 0, sel, 0), modp(F, 0, sel, 1), wsp<bf16>(F, WS_A) + (size_t)row * DM); }
}
struct FnStoreBf16 {
    bf16* O; int ldc;
    __device__ __forceinline__ void operator()(int row, int col, f32x4 v0, f32x4 v1) const {
        v4u w; w.x = pg8::cvt_pk_bf16(v0[0], v0[1]); w.y = pg8::cvt_pk_bf16(v0[2], v0[3]); w.z = pg8::cvt_pk_bf16(v1[0], v1[1]); w.w = pg8::cvt_pk_bf16(v1[2], v1[3]);
        *(v4u*)(O + (size_t)row * ldc + col) = w; }
};
struct FnWout {
    const Frame* F; int layer;
    __device__ __forceinline__ void operator()(int row, int col, f32x4 v0, f32x4 v1) const {
        bf16* hrow = wsp<bf16>(*F, WS_H) + (size_t)row * DM + col;
        const float* g = modp(*F, layer, row_sel(row), 2) + col;
        const f32x4 g0 = *(const f32x4*)g, g1 = *(const f32x4*)(g + 4); f32x4 b0, b1;
        if (layer == 0) { const float* base = h0_row(*F, row) + col; b0 = *(const f32x4*)base; b1 = *(const f32x4*)(base + 4); }
        else { float x[8]; unpack8(*(const v4u*)hrow, x); b0 = (f32x4){x[0], x[1], x[2], x[3]}; b1 = (f32x4){x[4], x[5], x[6], x[7]}; }
        const f32x4 o0 = b0 + g0 * v0, o1 = b1 + g1 * v1; v4u w; w.x = pk2(o0.x, o0.y); w.y = pk2(o0.z, o0.w); w.z = pk2(o1.x, o1.y); w.w = pk2(o1.z, o1.w);
        *(v4u*)hrow = w; }
};
__device__ __forceinline__ void l0_post_proj(const Frame& F) {
    const int gw = F.blk * 8 + F.wave, NGW = F.G * 8, lane = F.lane;
    const bf16* P = wsp<const bf16>(F, WS_P); const float* rope = wsp<const float>(F, WS_ROPE);
    constexpr float CD = 0.125f * 1.4426950408889634f;
    for (int row = gw; row < R; row += NGW) {
        const int b = row / TB, t = row - b * TB; const bool lat = t >= CT; const int pos = t - CT, prow = lat ? pos >> 6 : 0, pcol = lat ? pos & 63 : 0;
        const bf16* p = P + (size_t)row * ATT_NP;
        bf16* qd = wsp<bf16>(F, WS_QD) + (size_t)row * 512; bf16* kd = wsp<bf16>(F, WS_KD) + (size_t)row * 512;
#pragma unroll
        for (int j = 0; j < 2; ++j) { const int g = lane + 64 * j, h16 = g >> 3, i0 = (g & 7) * 4;
            const v2u w1 = *(const v2u*)(p + h16 * 64 + i0), w2 = *(const v2u*)(p + h16 * 64 + i0 + 32);
            const float x1[4] = {bflo(w1.x), bfhi(w1.x), bflo(w1.y), bfhi(w1.y)}, x2[4] = {bflo(w2.x), bfhi(w2.x), bflo(w2.y), bfhi(w2.y)};
            float cs[8] = {1.f, 0.f, 1.f, 0.f, 1.f, 0.f, 1.f, 0.f};
            if (lat) { const float* tb = (i0 < 16) ? rope + ROPE_DR + (size_t)(prow * 16 + i0) * 2 : rope + ROPE_DC + (size_t)(pcol * 16 + i0 - 16) * 2;
                const f32x4 t0 = *(const f32x4*)tb, t1 = *(const f32x4*)(tb + 4); cs[0] = t0.x; cs[1] = t0.y; cs[2] = t0.z; cs[3] = t0.w; cs[4] = t1.x; cs[5] = t1.y; cs[6] = t1.z; cs[7] = t1.w; }
            float y1[4], y2[4]; const float sc = h16 < 8 ? CD : 1.f;
#pragma unroll
            for (int e = 0; e < 4; ++e) { y1[e] = (x1[e] * cs[2 * e] - x2[e] * cs[2 * e + 1]) * sc; y2[e] = (x1[e] * cs[2 * e + 1] + x2[e] * cs[2 * e]) * sc; }
            bf16* o = (h16 < 8) ? qd + h16 * 64 + i0 : kd + (h16 - 8) * 64 + i0;
            v2u o1, o2; o1.x = pk2(y1[0], y1[1]); o1.y = pk2(y1[2], y1[3]); o2.x = pk2(y2[0], y2[1]); o2.y = pk2(y2[2], y2[3]);
            *(v2u*)o = o1; *(v2u*)(o + 32) = o2; }
        { float x[8]; float ss = 0.f; const bool act = lane < 48;
          if (act) unpack8(*(const v4u*)(p + 1536 + 8 * lane), x); else {
#pragma unroll
              for (int e = 0; e < 8; ++e) x[e] = 0.f; }
#pragma unroll
          for (int e = 0; e < 8; ++e) ss += x[e] * x[e];
          const float rs = 1.f / sqrtf(wave_sum(ss) * (1.f / 384.f) + NORM_EPS);
          if (act) { const f32x4 g0 = *(const f32x4*)(F.in[I_QNW] + 8 * lane), g1 = *(const f32x4*)(F.in[I_QNW] + 8 * lane + 4); v4u w;
              w.x = pk2(x[0] * rs * g0.x, x[1] * rs * g0.y); w.y = pk2(x[2] * rs * g0.z, x[3] * rs * g0.w); w.z = pk2(x[4] * rs * g1.x, x[5] * rs * g1.y); w.w = pk2(x[6] * rs * g1.z, x[7] * rs * g1.w);
              *(v4u*)(wsp<bf16>(F, WS_CQN) + (size_t)row * 384 + 8 * lane) = w; } }
        { const v2u wv = *(const v2u*)(p + 1920 + 4 * lane); const float x[4] = {bflo(wv.x), bfhi(wv.x), bflo(wv.y), bfhi(wv.y)};
          const float rs = 1.f / sqrtf(wave_sum((x[0] * x[0] + x[1] * x[1]) + (x[2] * x[2] + x[3] * x[3])) * (1.f / 256.f) + NORM_EPS);
          const f32x4 g0 = *(const f32x4*)(F.in[I_KVNW] + 4 * lane); v2u w; w.x = pk2(x[0] * rs * g0.x, x[1] * rs * g0.y); w.y = pk2(x[2] * rs * g0.z, x[3] * rs * g0.w);
          *(v2u*)(wsp<bf16>(F, WS_CKVN) + (size_t)row * 256 + 4 * lane) = w; }
        if (lane < 16) { const int i = lane; const float x1 = bf2f(p[2176 + i]), x2 = bf2f(p[2176 + i + 16]); float c = 1.f, s = 0.f;
            if (lat) { const float* tb = (i < 8) ? rope + ROPE_MR + (size_t)(prow * 8 + i) * 2 : rope + ROPE_MC + (size_t)(pcol * 8 + i - 8) * 2; c = tb[0]; s = tb[1]; }
            bf16* o = wsp<bf16>(F, WS_KRR) + (size_t)row * 32; o[i] = (bf16)f2bf(x1 * c - x2 * s); o[i + 16] = (bf16)f2bf(x1 * s + x2 * c); }
    }
}
__device__ __forceinline__ void l0_mq_rope(const Frame& F) {
    const int gw = F.blk * 8 + F.wave, NGW = F.G * 8, lane = F.lane; const float* rope = wsp<const float>(F, WS_ROPE);
    const float CM = 0.10206207261596575f * 1.4426950408889634f;
    for (int row = gw; row < R; row += NGW) {
        const int b = row / TB, t = row - b * TB; const bool lat = t >= CT; const int pos = t - CT, prow = lat ? pos >> 6 : 0, pcol = lat ? pos & 63 : 0;
        bf16* q = wsp<bf16>(F, WS_MQ) + (size_t)row * 768;
#pragma unroll
        for (int j = 0; j < 2; ++j) { const int g = lane + 64 * j, h = g >> 4, d0 = (g & 15) * 4;
            const v2u wv = *(const v2u*)(q + h * 96 + d0); v2u o; o.x = pk2(bflo(wv.x) * CM, bfhi(wv.x) * CM); o.y = pk2(bflo(wv.y) * CM, bfhi(wv.y) * CM); *(v2u*)(q + h * 96 + d0) = o; }
#pragma unroll
        for (int j = 0; j < 2; ++j) { const int pr = lane + 64 * j, h = pr >> 4, i = pr & 15; const float x1 = bf2f(q[h * 96 + 64 + i]), x2 = bf2f(q[h * 96 + 80 + i]); float c = 1.f, s = 0.f;
            if (lat) { const float* tb = (i < 8) ? rope + ROPE_MR + (size_t)(prow * 8 + i) * 2 : rope + ROPE_MC + (size_t)(pcol * 8 + i - 8) * 2; c = tb[0]; s = tb[1]; }
            q[h * 96 + 64 + i] = (bf16)f2bf((x1 * c - x2 * s) * CM); q[h * 96 + 80 + i] = (bf16)f2bf((x1 * s + x2 * c) * CM); }
    }
}
__device__ __forceinline__ void l0_attention(const Frame& F) {
    LAS char* lds = (LAS char*)F.lds;
    const bf16* QD = wsp<const bf16>(F, WS_QD); const bf16* KD = wsp<const bf16>(F, WS_KD); const bf16* P = wsp<const bf16>(F, WS_P);
    const bf16* MQ = wsp<const bf16>(F, WS_MQ); const bf16* MKV = wsp<const bf16>(F, WS_MKV); const bf16* KRR = wsp<const bf16>(F, WS_KRR);
    float* OD = wsp<float>(F, WS_ODIFF); float* OM = wsp<float>(F, WS_OMLA);
    for (int kind = 0; kind < 2; ++kind) {
        for (int L = F.blk; L < 1024 + 16; L += F.G) {
            int b, h8, qb, nkeys;
            if (L < 1024) { int pair;
                if (F.G == 256) { const int round = L >> 8, c = L & 255; pair = round * 4 + ((c & 7) >> 1); qb = 1 + (c & 1) * 32 + (c >> 3); }
                else { pair = L >> 6; qb = 1 + (L & 63); }
                b = pair >> 3; h8 = pair & 7; nkeys = TB; }
            else { const int s = L - 1024; b = s >> 3; h8 = s & 7; qb = 0; nkeys = CT; }
            const size_t q0 = (size_t)b * TB + (size_t)qb * 256, k0 = (size_t)b * TB;
            if (kind == 0)
                att::attn_unit<64, 128>(QD + q0 * 512 + h8 * 64, 512, KD + k0 * 512 + h8 * 64, 512, nullptr, 0, P + k0 * ATT_NP + 1024 + (h8 >> 1) * 128, ATT_NP,
                                        OD + q0 * 1024 + h8 * 128, 1024, nkeys, lds);
            else
                att::attn_unit<96, 64>(MQ + q0 * 768 + h8 * 96, 768, MKV + k0 * 1024 + h8 * 128, 1024, KRR + k0 * 32, 32, MKV + k0 * 1024 + h8 * 128 + 64, 1024,
                                       OM + q0 * 512 + h8 * 64, 512, nkeys, lds);
        }
    }
}
__device__ __forceinline__ void l0_combine(const Frame& F) {
    const int gw = F.blk * 8 + F.wave, NGW = F.G * 8, lane = F.lane;
    const float* lv = F.in[I_LAM];
    const float lam = __expf(wave_sum(lv[lane] * lv[64 + lane])) - __expf(wave_sum(lv[128 + lane] * lv[192 + lane])) + 0.2f;
    const float sw0 = F.in[I_SUBLN][2 * lane] * 0.8f, sw1 = F.in[I_SUBLN][2 * lane + 1] * 0.8f;
    for (int row = gw; row < R; row += NGW) {
        const float* od = wsp<const float>(F, WS_ODIFF) + (size_t)row * 1024; const float* om = wsp<const float>(F, WS_OMLA) + (size_t)row * 512;
        bf16* a1 = wsp<bf16>(F, WS_A1) + (size_t)row * DM;
#pragma unroll
        for (int h = 0; h < 4; ++h) {
            const float o1a = od[(2 * h) * 128 + 2 * lane], o1b = od[(2 * h) * 128 + 2 * lane + 1], o2a = od[(2 * h + 1) * 128 + 2 * lane], o2b = od[(2 * h + 1) * 128 + 2 * lane + 1];
            const float da = o1a - lam * o2a, db = o1b - lam * o2b;
            const float rs = 1.f / sqrtf(wave_sum(da * da + db * db) * (1.f / 128.f) + NORM_EPS);
            *(unsigned*)(a1 + h * 128 + 2 * lane) = pk2(da * rs * sw0, db * rs * sw1); }
#pragma unroll
        for (int j = 0; j < 2; ++j) { const f32x4 v = *(const f32x4*)(om + 4 * (lane + 64 * j)); v2u w; w.x = pk2(v.x, v.y); w.y = pk2(v.z, v.w); *(v2u*)(a1 + 512 + 4 * (lane + 64 * j)) = w; }
    }
}
constexpr int RT_LS = 264;
__device__ __forceinline__ void ph_router(const Frame& F, int layer) {
    LAS bf16* AH = (LAS bf16*)F.lds; LAS bf16* AL = AH + 64 * RT_LS; LAS bf16* WH = AL + 64 * RT_LS; LAS bf16* WL = WH + 32 * RT_LS;
    LAS float* lg = (LAS float*)(F.lds + 110592);
    LAS int* hist = (LAS int*)(F.lds + MISC_OFF + 256);
    LAS int* recs = (LAS int*)(F.lds + MISC_OFF + 512);
    const int lane = F.lane, w = F.wave, tid = F.tid, RPB = (R + F.G - 1) / F.G, row0 = F.blk * RPB;
    if (tid < 64) hist[tid] = 0;
    { int* srct = wsp<int>(F, WS_SRC); for (int i = F.blk * 512 + tid; i < MAXROWS; i += F.G * 512) srct[i] = 0; }
    const float* nw = F.in[I_NFFN] + (size_t)layer * DM; const float* rbp = F.in[I_RB] + layer * NE;
    const bf16* wrh = wsp<const bf16>(F, WS_WRH) + (size_t)layer * 32 * 1024; const bf16* wrl = wsp<const bf16>(F, WS_WRL) + (size_t)layer * 32 * 1024;
    for (int pass = 0; pass * 64 < RPB; ++pass) {
        const int nrow = min(64, min(RPB - pass * 64, R - row0 - pass * 64));
        f32x4 fr[8][4];
#pragma unroll
        for (int i = 0; i < 8; ++i) { const int rl = w + 8 * i; const int row = row0 + pass * 64 + rl;
            if (rl < nrow) {
                const int sel = row_sel(row); const float* sh = modp(F, layer, sel, 3); const float* sc = modp(F, layer, sel, 4);
                const v2u* xr = (const v2u*)(wsp<const bf16>(F, WS_H) + (size_t)row * DM) + lane; float s = 0.f;
#pragma unroll
                for (int j = 0; j < 4; ++j) { const v2u hw = xr[64 * j]; fr[i][j] = (f32x4){bflo(hw.x), bfhi(hw.x), bflo(hw.y), bfhi(hw.y)}; s += (fr[i][j].x * fr[i][j].x + fr[i][j].y * fr[i][j].y) + (fr[i][j].z * fr[i][j].z + fr[i][j].w * fr[i][j].w); }
                const float rs = 1.f / sqrtf(wave_sum(s) * (1.f / DM) + NORM_EPS);
                unsigned long long* o8 = (unsigned long long*)(wsp<bf16>(F, WS_F) + (size_t)row * DM) + lane;
#pragma unroll
                for (int j = 0; j < 4; ++j) { const f32x4 ww = ((const f32x4*)nw)[lane + 64 * j], a = ((const f32x4*)sh)[lane + 64 * j], c = ((const f32x4*)sc)[lane + 64 * j];
                    fr[i][j] = fr[i][j] * rs * ww * (c + 1.f) + a;
                    o8[64 * j] = (unsigned long long)pk2(fr[i][j].x, fr[i][j].y) | ((unsigned long long)pk2(fr[i][j].z, fr[i][j].w) << 32); }
            } else {
#pragma unroll
                for (int j = 0; j < 4; ++j) fr[i][j] = (f32x4){0.f, 0.f, 0.f, 0.f};
            } }
        pg8::f32x4 acc = {0.f, 0.f, 0.f, 0.f};
#pragma unroll
        for (int c = 0; c < 4; ++c) {
            __syncthreads();
#pragma unroll
            for (int i = 0; i < 8; ++i) { const f32x4 v = fr[i][c]; const unsigned h0 = pk2(v.x, v.y), h1 = pk2(v.z, v.w);
                const unsigned l0 = pk2(v.x - bflo(h0), v.y - bfhi(h0)), l1 = pk2(v.z - bflo(h1), v.w - bfhi(h1));
                v2u hh; hh.x = h0; hh.y = h1; v2u ll; ll.x = l0; ll.y = l1;
                *(LAS v2u*)(AH + (w + 8 * i) * RT_LS + 4 * lane) = hh; *(LAS v2u*)(AL + (w + 8 * i) * RT_LS + 4 * lane) = ll; }
            { const int e = tid >> 4, kp = (tid & 15) * 16;
              const v4u a0 = *(const v4u*)(wrh + (size_t)e * 1024 + 256 * c + kp), a1 = *(const v4u*)(wrh + (size_t)e * 1024 + 256 * c + kp + 8);
              const v4u b0 = *(const v4u*)(wrl + (size_t)e * 1024 + 256 * c + kp), b1 = *(const v4u*)(wrl + (size_t)e * 1024 + 256 * c + kp + 8);
              *(LAS v4u*)(WH + e * RT_LS + kp) = a0; *(LAS v4u*)(WH + e * RT_LS + kp + 8) = a1; *(LAS v4u*)(WL + e * RT_LS + kp) = b0; *(LAS v4u*)(WL + e * RT_LS + kp + 8) = b1; }
            __syncthreads();
            const int tm = w >> 1, tn = w & 1, lr = lane & 15, kq = (lane >> 4) * 8;
            const LAS bf16* ahp = AH + (tm * 16 + lr) * RT_LS + kq; const LAS bf16* alp = AL + (tm * 16 + lr) * RT_LS + kq;
            const LAS bf16* whp = WH + (tn * 16 + lr) * RT_LS + kq; const LAS bf16* wlp = WL + (tn * 16 + lr) * RT_LS + kq;
#pragma unroll
            for (int ks = 0; ks < 8; ++ks) { const bf16x8 ah = *(const LAS bf16x8*)(ahp + 32 * ks), al = *(const LAS bf16x8*)(alp + 32 * ks), bh = *(const LAS bf16x8*)(whp + 32 * ks), bl = *(const LAS bf16x8*)(wlp + 32 * ks);
                acc = __builtin_amdgcn_mfma_f32_16x16x32_bf16(ah, bh, acc, 0, 0, 0); acc = __builtin_amdgcn_mfma_f32_16x16x32_bf16(ah, bl, acc, 0, 0, 0); acc = __builtin_amdgcn_mfma_f32_16x16x32_bf16(al, bh, acc, 0, 0, 0); }
        }
        { const int m0 = (w >> 1) * 16 + (lane >> 4) * 4, n = (w & 1) * 16 + (lane & 15);
#pragma unroll
          for (int r = 0; r < 4; ++r) lg[(m0 + r) * 33 + n] = acc[r]; }
        __syncthreads();
        if (tid < nrow) { const int rl = tid, row = row0 + pass * 64 + rl; float lv[32];
#pragma unroll
            for (int e = 0; e < 32; ++e) lv[e] = lg[rl * 33 + e] + rbp[e];
            float selv[4]; int seli[4];
#pragma unroll
            for (int r = 0; r < 4; ++r) { float bv = -3.0e38f; int bi = 0;
#pragma unroll
                for (int e = 0; e < 32; ++e) { const bool taken = (r > 0 && seli[0] == e) || (r > 1 && seli[1] == e) || (r > 2 && seli[2] == e); if (!taken && lv[e] > bv) { bv = lv[e]; bi = e; } }
                selv[r] = bv; seli[r] = bi; }
            float ex[4], es = 0.f;
#pragma unroll
            for (int r = 0; r < 4; ++r) { ex[r] = __expf(selv[r] - selv[0]); es += ex[r]; }
            const float inv = 1.f / es;
#pragma unroll
            for (int r = 0; r < 4; ++r) { wsp<int>(F, WS_TOPE)[(size_t)row * 4 + r] = seli[r]; wsp<float>(F, WS_GATE)[(size_t)row * 4 + r] = ex[r] * inv;
                const int rk = __hip_atomic_fetch_add(&hist[seli[r]], 1, __ATOMIC_RELAXED, __HIP_MEMORY_SCOPE_WORKGROUP);
                recs[(pass * 64 + rl) * 4 + r] = seli[r] | (rk << 8); }
        }
    }
    __syncthreads();
    if (tid < NE) hist[32 + tid] = (int)__hip_atomic_fetch_add(F.ctl + CW_CNT + 64 * (layer + 2 * F.probe) + tid, (unsigned)hist[tid], RLX_AGENT);
    __syncthreads();
    for (int rl = tid; rl < RPB && row0 + rl < R; rl += 512) {
#pragma unroll
        for (int r = 0; r < 4; ++r) { const int rc = recs[rl * 4 + r]; wsp<int>(F, WS_POS)[(size_t)(row0 + rl) * 4 + r] = hist[32 + (rc & 255)] + (rc >> 8); } }
}
__device__ __forceinline__ void moe_tables(const Frame& F, int layer, LAS int* ps, LAS int* tile_e) {
    if (F.tid == 0) { int acc = 0, t = 0;
        for (int e = 0; e < NE; ++e) { const int c = (int)__hip_atomic_load(F.ctl + CW_CNT + 64 * layer + e, RLX_AGENT); ps[e] = acc; const int nt = (c + 255) >> 8;
            for (int i = 0; i < nt && t < MAXT; ++i) tile_e[t++] = e; acc += nt * 256; }
        ps[NE] = acc; ps[NE + 1] = t; }
    __syncthreads();
}
__device__ __forceinline__ void ph_gather(const Frame& F, int layer) {
    LAS int* ps = (LAS int*)(F.lds + MISC_OFF + 256); LAS int* tile_e = ps + 64;
    moe_tables(F, layer, ps, tile_e);
    if (F.blk == 0) { int* tab = wsp<int>(F, WS_TILE); const int nt = ps[NE + 1]; if (F.tid == 0) tab[0] = nt; for (int i = F.tid; i < nt; i += 512) tab[1 + i] = tile_e[i]; }
    for (int i = F.blk * 512 + F.tid; i < R * 4; i += F.G * 512) { const int row = i >> 2;
        const int e = wsp<const int>(F, WS_TOPE)[i]; const int dest = ps[e] + wsp<const int>(F, WS_POS)[i]; wsp<int>(F, WS_DEST)[i] = dest; wsp<int>(F, WS_SRC)[dest] = row; }
}
struct MoeOrder {
    const int* tile_e; int ntiles, nN, G, c; const int* src;
    __device__ __forceinline__ bool next(int i, pg8::Unit& u) const {
        int rt, pl;
        if (G == 256) { const int x = c & 7, y = c >> 3, rpx = 32 / nN; rt = (i * 8 + x) * rpx + y / nN; pl = y % nN; if (rt >= ntiles) return false; }
        else { const long L = (long)i * G + c; if (L >= (long)ntiles * nN) return false; rt = (int)(L / nN); pl = (int)(L - (long)rt * nN); }
        const int e = __builtin_amdgcn_readfirstlane(tile_e[rt]);
        u.pm = rt; u.pn = e * nN + pl; return true; }
    __device__ __forceinline__ void a_ready(const pg8::Unit&) const {}
    __device__ __forceinline__ void done(const pg8::Unit&) const {}
};
struct LatOrder {
    pg8::StaticOrder o;
    __device__ __forceinline__ bool next(int i, pg8::Unit& u) const { if (!o.next(i, u)) return false; u.pm += 1 + (u.pm >= 64 ? 1 : 0); return true; }
    __device__ __forceinline__ void a_ready(const pg8::Unit&) const {}
    __device__ __forceinline__ void done(const pg8::Unit&) const {}
};
struct FnSwiglu {
    bf16* HS; const float* b1;
    __device__ __forceinline__ void operator()(int row, int col, f32x4 v0, f32x4 v1) const {
        const float* bp = b1 + col;
        const f32x4 b0 = *(const f32x4*)bp, b1v = *(const f32x4*)(bp + 4); v0 = v0 + b0; v1 = v1 + b1v;
        const float hv[8] = {v0[0], v0[1], v0[2], v0[3], v1[0], v1[1], v1[2], v1[3]}; float o[4];
#pragma unroll
        for (int i = 0; i < 4; ++i) { const float g = hv[2 * i], l = hv[2 * i + 1];
            const float gl = fminf(g, 7.f), li = fminf(fmaxf(l, -7.f), 7.f); o[i] = gl * sigmoidf_(1.702f * gl) * (li + 1.f); }
        const int lc = col & 2047; v2u w; w.x = pk2(o[0], o[1]); w.y = pk2(o[2], o[3]);
        *(v2u*)(HS + (size_t)row * 1024 + (lc >> 1)) = w; }
};
struct FnBiasBf16 {
    bf16* YS; const float* b2;
    __device__ __forceinline__ void operator()(int row, int col, f32x4 v0, f32x4 v1) const {
        const f32x4 b0 = *(const f32x4*)(b2 + col), b1v = *(const f32x4*)(b2 + col + 4); v0 = v0 + b0; v1 = v1 + b1v;
        v4u w; w.x = pk2(v0[0], v0[1]); w.y = pk2(v0[2], v0[3]); w.z = pk2(v1[0], v1[1]); w.w = pk2(v1[2], v1[3]);
        *(v4u*)(YS + (size_t)row * 1024 + (col & 1023)) = w; }
};
__device__ __forceinline__ void ph_combine(const Frame& F, int layer) {
    const int lane = F.lane, gw = F.blk * 8 + F.wave, NGW = F.G * 8;
    for (int row = gw; row < R; row += NGW) {
        const int sel = row_sel(row); const float* gf = modp(F, layer, sel, 5);
        bf16* hrow = wsp<bf16>(F, WS_H) + (size_t)row * DM;
        f32x4 y[4];
#pragma unroll
        for (int j = 0; j < 4; ++j) y[j] = (f32x4){0.f, 0.f, 0.f, 0.f};
#pragma unroll
        for (int r = 0; r < 4; ++r) { const int d = wsp<const int>(F, WS_DEST)[(size_t)row * 4 + r]; const float g = wsp<const float>(F, WS_GATE)[(size_t)row * 4 + r];
            const v2u* yp = (const v2u*)(wsp<const bf16>(F, WS_XS) + (size_t)d * DM);
#pragma unroll
            for (int j = 0; j < 4; ++j) { const v2u w = yp[lane + 64 * j]; y[j] += g * (f32x4){bflo(w.x), bfhi(w.x), bflo(w.y), bfhi(w.y)}; } }
        f32x4 h[4]; float s = 0.f;
#pragma unroll
        for (int j = 0; j < 4; ++j) { const v2u hw = ((const v2u*)hrow)[lane + 64 * j]; h[j] = (f32x4){bflo(hw.x), bfhi(hw.x), bflo(hw.y), bfhi(hw.y)} + ((const f32x4*)gf)[lane + 64 * j] * y[j]; s += (h[j].x * h[j].x + h[j].y * h[j].y) + (h[j].z * h[j].z + h[j].w * h[j].w); }
        const float rs = 1.f / sqrtf(wave_sum(s) * (1.f / DM) + NORM_EPS);
        if (layer == 0) {
#pragma unroll
            for (int j = 0; j < 4; ++j) { v2u hw; hw.x = pk2(h[j].x, h[j].y); hw.y = pk2(h[j].z, h[j].w); ((v2u*)hrow)[lane + 64 * j] = hw; }
            const float* nw = F.in[I_NMIX] + DM; const float* sh = modp(F, 1, sel, 0); const float* sc = modp(F, 1, sel, 1);
            unsigned long long* o8 = (unsigned long long*)(wsp<bf16>(F, WS_A) + (size_t)row * DM) + lane;
#pragma unroll
            for (int j = 0; j < 4; ++j) { const f32x4 w = ((const f32x4*)nw)[lane + 64 * j], a = ((const f32x4*)sh)[lane + 64 * j], c = ((const f32x4*)sc)[lane + 64 * j];
                const f32x4 o = h[j] * rs * w * (c + 1.f) + a; o8[64 * j] = (unsigned long long)pk2(o.x, o.y) | ((unsigned long long)pk2(o.z, o.w) << 32); }
        } else {
            const int b = row / TB, t = row - b * TB;
            if (t >= CT) { float* orow = F.out + ((size_t)b * SEQ + (t - CT)) * DM; const float* nw = F.in[I_FNW];
#pragma unroll
                for (int j = 0; j < 4; ++j) ((f32x4*)orow)[lane + 64 * j] = h[j] * rs * ((const f32x4*)nw)[lane + 64 * j]; }
        }
    }
}
constexpr int PC_Q = 1920, PC_K = 2176, PC_V = 2432, PC_O = 2944, PC_G = 3456;
__device__ __forceinline__ float softplusf_(float y) { return fmaxf(y, 0.f) + __logf(1.f + __expf(-fabsf(y))); }
__device__ __forceinline__ float tanhf_(float x) { return 1.f - 2.f / (1.f + __expf(2.f * x)); }
__device__ __forceinline__ void lerp8(const bf16* p, bool hp, bool hn, int c0, const float* mu, float (&u)[8]) {
    const v4u z4 = {0u, 0u, 0u, 0u};
    const v4u wx = *(const v4u*)(p + c0), wp = hp ? *(const v4u*)(p - REC_NP + c0) : z4, wn = hn ? *(const v4u*)(p + REC_NP + c0) : z4;
    float x[8], xp[8], xn[8]; unpack8(wx, x); unpack8(wp, xp); unpack8(wn, xn);
    const f32x4 m0 = *(const f32x4*)(mu + c0), m1 = *(const f32x4*)(mu + c0 + 4);
#pragma unroll
    for (int e = 0; e < 8; ++e) { const float m = e < 4 ? m0[e & 3] : m1[e & 3]; u[e] = x[e] + m * (0.5f * (xp[e] + xn[e]) - x[e]); }
}
__device__ __forceinline__ void st8h(bf16* o, const float (&u)[8]) { v4u w; w.x = pk2(u[0], u[1]); w.y = pk2(u[2], u[3]); w.z = pk2(u[4], u[5]); w.w = pk2(u[6], u[7]); *(v4u*)o = w; }
__device__ __forceinline__ void st8f(float* o, const float (&u)[8]) { *(f32x4*)o = (f32x4){u[0], u[1], u[2], u[3]}; *(f32x4*)(o + 4) = (f32x4){u[4], u[5], u[6], u[7]}; }
__device__ __forceinline__ void l1_rwkv_prep(const Frame& F) {
    const int gw = F.blk * 8 + F.wave, NGW = F.G * 8, lane = F.lane; const float* mu = F.in[I_MU];
    for (int row = gw; row < R; row += NGW) {
        const int b = row / TB, t = row - b * TB; const bool hp = (t != 0 && t != CT), hn = (t != CT - 1 && t != TB - 1);
        const bf16* p = wsp<const bf16>(F, WS_P) + (size_t)row * REC_NP; const size_t ro = (size_t)row * 512 + 8 * lane;
        float u[8];
        lerp8(p, hp, hn, 8 * lane, mu, u); st8h(wsp<bf16>(F, WS_RR) + ro, u);
        lerp8(p, hp, hn, 1024 + 8 * lane, mu, u); st8h(wsp<bf16>(F, WS_VV) + ro, u);
        lerp8(p, hp, hn, 512 + 8 * lane, mu, u); st8h(wsp<bf16>(F, WS_KL) + ro, u);
        { const f32x4 k0 = *(const f32x4*)(F.in[I_KK] + 8 * lane), k1 = *(const f32x4*)(F.in[I_KK] + 8 * lane + 4); float ss = 0.f;
#pragma unroll
          for (int e = 0; e < 8; ++e) { u[e] *= (e < 4 ? k0[e & 3] : k1[e & 3]); ss += u[e] * u[e]; }
          ss += __shfl_xor(ss, 1); ss += __shfl_xor(ss, 2); ss += __shfl_xor(ss, 4);
          const float inv = -1.f / sqrtf(fmaxf(ss, 1e-24f));
#pragma unroll
          for (int e = 0; e < 8; ++e) u[e] *= inv;
          st8h(wsp<bf16>(F, WS_AKK) + ro, u); }
        if (lane < 48) { lerp8(p, hp, hn, 1536 + 8 * lane, mu, u);
#pragma unroll
            for (int e = 0; e < 8; ++e) u[e] = lane < 16 ? tanhf_(u[e]) : (lane < 32 ? u[e] : sigmoidf_(u[e]));
            v4u w; w.x = pk2(u[0], u[1]); w.y = pk2(u[2], u[3]); w.z = pk2(u[4], u[5]); w.w = pk2(u[6], u[7]);
            *(v4u*)(wsp<bf16>(F, WS_ALORA) + (size_t)row * 384 + 8 * lane) = w; }
    }
}
struct EpiLora {
    static constexpr bool PERM = true, AFTER_DRAIN = false;
    const Frame* F;
    template <int KIND> __device__ __forceinline__ void run(const pg8::f32x4 (&acc)[2][2][4][2], const pg8::Unit& u, int wr, int wc, int fr, int fq, int z) const {
#pragma unroll
        for (int ai = 0; ai < 2; ++ai)
#pragma unroll
            for (int m = 0; m < 4; ++m) { const int row = u.pm * 256 + ai * 128 + wr * 64 + m * 16 + fr;
#pragma unroll
                for (int bj = 0; bj < 2; ++bj) { const int c = ((u.pn & 1) * 256) + bj * 128 + wc * 32 + 8 * fq; const size_t ro = (size_t)row * 512 + c;
                    const pg8::f32x4 v0 = acc[ai][bj][m][0], v1 = acc[ai][bj][m][1]; const float x[8] = {v0[0], v0[1], v0[2], v0[3], v1[0], v1[1], v1[2], v1[3]}; float o[8];
                    if constexpr (KIND == 0) { const float* w0 = F->in[I_W0] + z * 512 + c;
#pragma unroll
                        for (int e = 0; e < 8; ++e) { const float wl = -softplusf_(-(w0[e] + x[e])) - 0.5f; o[e] = __expf(-__expf(wl)); }
                        st8f(wsp<float>(*F, WS_WDEC) + (size_t)z * R * 512 + ro, o); }
                    else if constexpr (KIND == 1) { const float* a0 = F->in[I_A0] + z * 512 + c;
#pragma unroll
                        for (int e = 0; e < 8; ++e) o[e] = sigmoidf_(a0[e] + x[e]);
                        st8h(wsp<bf16>(*F, WS_ASIG) + (size_t)z * R * 512 + ro, o); }
                    else st8h(wsp<bf16>(*F, WS_GG) + ro, x); } }
    }
    __device__ __forceinline__ void operator()(const pg8::f32x4 (&acc)[2][2][4][2], const pg8::Unit& u, int wr, int wc, int fr, int fq) const {
        const int part = u.pn >> 1;
        if (part < 2) run<0>(acc, u, wr, wc, fr, fq, part); else if (part < 4) run<1>(acc, u, wr, wc, fr, fq, part - 2); else run<2>(acc, u, wr, wc, fr, fq, 0);
    }
};
__device__ __forceinline__ void mlstm_gates(const Frame& F, int row, int z, int h, float& ig, float& lf) {
    const bf16* g = wsp<const bf16>(F, WS_P) + (size_t)row * REC_NP + PC_G + z * 8 + h; const float* gb = F.in[I_GATEB] + z * 8 + h;
    const float gi = bf2f(g[0]) + gb[0], gf = bf2f(g[4]) + gb[4];
    ig = 15.f * tanhf_(gi * (1.f / 15.f)); const float cf = 15.f * tanhf_(gf * (1.f / 15.f)); lf = fminf(cf, 0.f) - __logf(1.f + __expf(-fabsf(cf)));
}
__device__ __forceinline__ void mlstm_chunk_head(const Frame& F, int z, int b, int h, int c, LAS float* vec) {
    LAS int* rows = (LAS int*)vec;
    if (F.tid < 64) { const int s = F.tid, row = b * TB + scan_tok(z, 64 * c + s); float ig, lf; mlstm_gates(F, row, z, h, ig, lf); rows[s] = row; vec[64 + s] = ig; vec[192 + s] = lf; }
    __syncthreads();
    if (F.tid < 64) { float a = 0.f; for (int s = 0; s <= F.tid; ++s) a += vec[192 + s]; vec[128 + F.tid] = a; }
    __syncthreads();
}
__device__ __forceinline__ void l1_mlstm_b(const Frame& F) {
    const float* __restrict__ SC = wsp<const float>(F, WS_SC); const float* __restrict__ DC = wsp<const float>(F, WS_DC); float* __restrict__ CST = wsp<float>(F, WS_CST);
    const float* __restrict__ DN = wsp<const float>(F, WS_DN); float* __restrict__ NST = wsp<float>(F, WS_NST); float* __restrict__ MST = wsp<float>(F, WS_MST);
    for (int g = F.blk * 512 + F.tid; g < 16 * 8192; g += F.G * 512) {
        const int chain = g >> 13, el = g & 8191; float m = 0.f, C = 0.f, N = 0.f; const bool don = el < 64;
        for (int c0 = 0; c0 < 260; c0 += 10) {
            float dc[10], dn[10], bl[10], ml[10];
#pragma unroll
            for (int i = 0; i < 10; ++i) { const size_t u = (size_t)chain * 260 + c0 + i; dc[i] = DC[u * 8192 + el]; dn[i] = don ? DN[u * 64 + el] : 0.f; bl[i] = SC[2 * u]; ml[i] = SC[2 * u + 1]; }
#pragma unroll
            for (int i = 0; i < 10; ++i) { const size_t u = (size_t)chain * 260 + c0 + i;
                CST[u * 8192 + el] = C; if (don) NST[u * 64 + el] = N; if (el == 0) MST[u] = m;
                const float mn = fmaxf(bl[i] + m, ml[i]), cd = __expf(bl[i] + m - mn), inj = __expf(ml[i] - mn);
                C = cd * C + inj * dc[i]; N = cd * N + inj * dn[i]; m = mn; }
        }
    }
}
__device__ __forceinline__ void l1_rec_out(const Frame& F) {
    const int gw = F.blk * 8 + F.wave, NGW = F.G * 8, lane = F.lane, c0 = 8 * lane;
    for (int row = gw; row < R; row += NGW) {
        const size_t ro = (size_t)row * 512 + c0; bf16* a1 = wsp<bf16>(F, WS_A1) + (size_t)row * DM;
        { float y0[8], y1[8], y[8]; float s = 0.f; unpack8(*(const v4u*)(wsp<const bf16>(F, WS_YR) + ro), y0); unpack8(*(const v4u*)(wsp<const bf16>(F, WS_YR) + (size_t)R * 512 + ro), y1);
          const float* y2 = wsp<const float>(F, WS_YB) + ro; const float* y3 = y2 + (size_t)R * 512;
#pragma unroll
          for (int e = 0; e < 8; ++e) { y[e] = (y0[e] + y1[e]) + (y2[e] + y3[e]); s += y[e]; }
          s += __shfl_xor(s, 1); s += __shfl_xor(s, 2); s += __shfl_xor(s, 4); const float mean = s * (1.f / 64.f); float q = 0.f;
#pragma unroll
          for (int e = 0; e < 8; ++e) { y[e] -= mean; q += y[e] * y[e]; }
          q += __shfl_xor(q, 1); q += __shfl_xor(q, 2); q += __shfl_xor(q, 4); const float rstd = 1.f / sqrtf(q * (1.f / 64.f) + 64e-5f);
          float rr[8], kl[8], s0[8], s1[8], vv[8], gg[8]; unpack8(*(const v4u*)(wsp<const bf16>(F, WS_RR) + ro), rr); unpack8(*(const v4u*)(wsp<const bf16>(F, WS_KL) + ro), kl);
          unpack8(*(const v4u*)(wsp<const bf16>(F, WS_ASIG) + ro), s0); unpack8(*(const v4u*)(wsp<const bf16>(F, WS_ASIG) + (size_t)R * 512 + ro), s1);
          unpack8(*(const v4u*)(wsp<const bf16>(F, WS_VV) + ro), vv); unpack8(*(const v4u*)(wsp<const bf16>(F, WS_GG) + ro), gg);
          const float* rk = F.in[I_RK] + c0; const float* ka = F.in[I_KA] + c0; float bs = 0.f;
#pragma unroll
          for (int e = 0; e < 8; ++e) bs += rr[e] * kl[e] * (2.f + (s0[e] + s1[e] - 2.f) * ka[e]) * rk[e];
          bs += __shfl_xor(bs, 1); bs += __shfl_xor(bs, 2); bs += __shfl_xor(bs, 4);
          const float* lw = F.in[I_LNW] + c0; const float* lb = F.in[I_LNB] + c0; float o[8];
#pragma unroll
          for (int e = 0; e < 8; ++e) o[e] = (y[e] * rstd * lw[e] + lb[e] + bs * vv[e]) * gg[e];
          v4u w; w.x = pk2(o[0], o[1]); w.y = pk2(o[2], o[3]); w.z = pk2(o[4], o[5]); w.w = pk2(o[6], o[7]); *(v4u*)(a1 + c0) = w; }
        { float h0[8], h1[8], x[8]; float q = 0.f; unpack8(*(const v4u*)(wsp<const bf16>(F, WS_HM) + ro), h0); unpack8(*(const v4u*)(wsp<const bf16>(F, WS_HM) + (size_t)R * 512 + ro), h1);
#pragma unroll
          for (int e = 0; e < 8; ++e) { x[e] = h0[e] + h1[e]; q += x[e] * x[e]; }
          q += __shfl_xor(q, 1); q += __shfl_xor(q, 2); q += __shfl_xor(q, 4); q += __shfl_xor(q, 8); const float rs = 1.f / sqrtf(q * (1.f / 128.f) + NORM_EPS);
          float og[8]; unpack8(*(const v4u*)(wsp<const bf16>(F, WS_P) + (size_t)row * REC_NP + PC_O + c0), og); const float* nw = F.in[I_MNW] + c0; float o[8];
#pragma unroll
          for (int e = 0; e < 8; ++e) o[e] = x[e] * rs * nw[e] * sigmoidf_(og[e]);
          v4u w; w.x = pk2(o[0], o[1]); w.y = pk2(o[2], o[3]); w.z = pk2(o[4], o[5]); w.w = pk2(o[6], o[7]); *(v4u*)(a1 + 512 + c0) = w; }
    }
}
#ifndef NEU_ROUNDS
#define NEU_ROUNDS 6
#endif
namespace rk {
constexpr int LS = 72;
constexpr int MB = 64 * LS * 2;
struct Acc2 { pg8::f32x4 t0, t1; };
__device__ __forceinline__ void zero(Acc2& a) { a.t0 = (pg8::f32x4){0.f, 0.f, 0.f, 0.f}; a.t1 = a.t0; }
__device__ __forceinline__ void mm_acc(Acc2& acc, const LAS bf16* A, const LAS bf16* Bt, int wave, int lane) {
    const int tm = wave >> 1, tn0 = (wave & 1) * 2, lr = lane & 15, kq = (lane >> 4) * 8;
    const LAS bf16* ap = A + (tm * 16 + lr) * LS + kq; const LAS bf16* bp0 = Bt + (tn0 * 16 + lr) * LS + kq; const LAS bf16* bp1 = bp0 + 16 * LS;
    const bf16x8 a0 = *(const LAS bf16x8*)ap, a1 = *(const LAS bf16x8*)(ap + 32);
    const bf16x8 b00 = *(const LAS bf16x8*)bp0, b01 = *(const LAS bf16x8*)(bp0 + 32), b10 = *(const LAS bf16x8*)bp1, b11 = *(const LAS bf16x8*)(bp1 + 32);
    acc.t0 = __builtin_amdgcn_mfma_f32_16x16x32_bf16(a0, b00, acc.t0, 0, 0, 0); acc.t0 = __builtin_amdgcn_mfma_f32_16x16x32_bf16(a1, b01, acc.t0, 0, 0, 0);
    acc.t1 = __builtin_amdgcn_mfma_f32_16x16x32_bf16(a0, b10, acc.t1, 0, 0, 0); acc.t1 = __builtin_amdgcn_mfma_f32_16x16x32_bf16(a1, b11, acc.t1, 0, 0, 0);
}
template <class Fn> __device__ __forceinline__ void each(const Acc2& acc, int wave, int lane, Fn fn) {
    const int m0 = (wave >> 1) * 16 + (lane >> 4) * 4, n0 = (wave & 1) * 32 + (lane & 15);
#pragma unroll
    for (int r = 0; r < 4; ++r) { fn(m0 + r, n0, acc.t0[r]); fn(m0 + r, n0 + 16, acc.t1[r]); }
}
__device__ __forceinline__ void stb(LAS bf16* M, int m, int n, float v) { M[m * LS + n] = (bf16)f2bf(v); }
__device__ __forceinline__ void st_tr(LAS bf16* M, const Acc2& acc, int wave, int lane) {
    const int m0 = (wave >> 1) * 16 + (lane >> 4) * 4, n0 = (wave & 1) * 32 + (lane & 15);
    v2u a, b; a.x = pk2(acc.t0[0], acc.t0[1]); a.y = pk2(acc.t0[2], acc.t0[3]); b.x = pk2(acc.t1[0], acc.t1[1]); b.y = pk2(acc.t1[2], acc.t1[3]);
    *(LAS v2u*)(M + n0 * LS + m0) = a; *(LAS v2u*)(M + (n0 + 16) * LS + m0) = b;
}
}
__device__ __forceinline__ void l1_rk_phase_a(const Frame& F) {
    using namespace rk;
    LAS unsigned char* L = F.lds;
    LAS bf16* Rt = (LAS bf16*)(L + 0 * MB); LAS bf16* At = (LAS bf16*)(L + 1 * MB); LAS bf16* AtT = (LAS bf16*)(L + 2 * MB); LAS bf16* Bq = (LAS bf16*)(L + 3 * MB); LAS bf16* Kq = (LAS bf16*)(L + 4 * MB);
    LAS bf16* VT = (LAS bf16*)(L + 5 * MB); LAS bf16* BhT = (LAS bf16*)(L + 6 * MB); LAS bf16* KhT = (LAS bf16*)(L + 7 * MB);
    LAS bf16* AK = (LAS bf16*)(L + 8 * MB); LAS bf16* RB = (LAS bf16*)(L + 9 * MB); LAS bf16* RK = (LAS bf16*)(L + 10 * MB);
    LAS bf16* X = (LAS bf16*)(L + 11 * MB); LAS bf16* XT = (LAS bf16*)(L + 12 * MB); LAS bf16* P = (LAS bf16*)(L + 13 * MB);
    LAS bf16* AkVT = Bq; LAS bf16* ApT = Kq; LAS bf16* W2T = X;
    LAS float* G = (LAS float*)(L + 8 * MB);
    LAS float* gl = (LAS float*)(L + 14 * MB);
    const int w = F.wave, lane = F.lane, tid = F.tid;
    const int t = lane, j0 = 8 * w;
    float fr[8], fv[8], fa[8], fw[8], fk[8], fb[8];
#define RK_LOAD(u_) do { const int ch_ = (u_) / 260, c_ = (u_) - ch_ * 260, z_ = ch_ >> 4, b_ = (ch_ >> 3) & 1, h_ = ch_ & 7; const size_t ro = ((size_t)b_ * TB + scan_tok(z_, 64 * c_ + t)) * 512 + h_ * 64 + j0; \
    const v4u xr_ = *(const v4u*)(wsp<const bf16>(F, WS_RR) + ro), xv_ = *(const v4u*)(wsp<const bf16>(F, WS_VV) + ro), xa_ = *(const v4u*)(wsp<const bf16>(F, WS_AKK) + ro), xk_ = *(const v4u*)(wsp<const bf16>(F, WS_KL) + ro), \
              xs_ = *(const v4u*)(wsp<const bf16>(F, WS_ASIG) + (size_t)z_ * R * 512 + ro); const float* p3 = wsp<const float>(F, WS_WDEC) + (size_t)z_ * R * 512 + ro; const float* pk_ = F.in[I_KA] + h_ * 64 + j0; \
    const f32x4 w0_ = *(const f32x4*)p3, w1_ = *(const f32x4*)(p3 + 4), q0_ = *(const f32x4*)pk_, q1_ = *(const f32x4*)(pk_ + 4); float sg_[8], kl_[8]; \
    unpack8(xr_, fr); unpack8(xv_, fv); unpack8(xa_, fa); unpack8(xk_, kl_); unpack8(xs_, sg_); \
    _Pragma("unroll") for (int e = 0; e < 8; ++e) { const float kav = e < 4 ? q0_[e & 3] : q1_[e & 3]; fw[e] = e < 4 ? w0_[e & 3] : w1_[e & 3]; fk[e] = kl_[e] * (1.f + (sg_[e] - 1.f) * kav); fb[e] = -fa[e] * sg_[e]; } } while (0)
    if (F.blk < NUNIT_R) RK_LOAD(F.blk);
    for (int u = F.blk; u < NUNIT_R; u += F.G) {
        const int chain = u / 260, c = u - chain * 260, z = chain >> 4, b = (chain >> 3) & 1, h = chain & 7;
        __syncthreads();
#pragma unroll
        for (int e = 0; e < 8; ++e) G[t * 65 + j0 + e] = fw[e];
        __syncthreads();
        if (tid < 64) { float g = 1.f;
#pragma unroll 16
            for (int s = 0; s < 64; ++s) { g *= G[s * 65 + tid]; G[s * 65 + tid] = g; } gl[tid] = g; }
        __syncthreads();
#pragma unroll
        for (int e = 0; e < 8; ++e) { const int j = j0 + e; const float gt = G[t * 65 + j], gp = t > 0 ? G[(t - 1) * 65 + j] : 1.f, gL = G[63 * 65 + j], ig = 1.f / gt;
            fr[e] *= gt; fa[e] *= gp; const float bq = fb[e] * ig, kq = fk[e] * ig; fb[e] = bq; fk[e] = kq; fw[e] = gL; }
        __syncthreads();
        { v4u q; q.x = pk2(fr[0], fr[1]); q.y = pk2(fr[2], fr[3]); q.z = pk2(fr[4], fr[5]); q.w = pk2(fr[6], fr[7]); *(LAS v4u*)(Rt + t * LS + j0) = q;
          q.x = pk2(fa[0], fa[1]); q.y = pk2(fa[2], fa[3]); q.z = pk2(fa[4], fa[5]); q.w = pk2(fa[6], fa[7]); *(LAS v4u*)(At + t * LS + j0) = q;
          q.x = pk2(fb[0], fb[1]); q.y = pk2(fb[2], fb[3]); q.z = pk2(fb[4], fb[5]); q.w = pk2(fb[6], fb[7]); *(LAS v4u*)(Bq + t * LS + j0) = q;
          q.x = pk2(fk[0], fk[1]); q.y = pk2(fk[2], fk[3]); q.z = pk2(fk[4], fk[5]); q.w = pk2(fk[6], fk[7]); *(LAS v4u*)(Kq + t * LS + j0) = q; }
#pragma unroll
        for (int e = 0; e < 8; ++e) { const int j = j0 + e; stb(AtT, j, t, fa[e]); stb(VT, j, t, fv[e]); stb(BhT, j, t, fb[e] * fw[e]); stb(KhT, j, t, fk[e] * fw[e]); }
        __syncthreads();
        if (u + F.G < NUNIT_R) RK_LOAD(u + F.G);
        Acc2 a1, a2, a3, a4;
        zero(a1); mm_acc(a1, At, Bq, w, lane); zero(a2); mm_acc(a2, At, Kq, w, lane); zero(a3); mm_acc(a3, Rt, Bq, w, lane); zero(a4); mm_acc(a4, Rt, Kq, w, lane);
        each(a1, w, lane, [&](int m, int n, float v) { const float x = n < m ? v : 0.f; stb(X, m, n, x); stb(XT, n, m, x); stb(P, m, n, m == n ? 1.f : 0.f); });
        each(a2, w, lane, [&](int m, int n, float v) { stb(AK, m, n, n < m ? v : 0.f); });
        each(a3, w, lane, [&](int m, int n, float v) { stb(RB, m, n, n <= m ? v : 0.f); });
        each(a4, w, lane, [&](int m, int n, float v) { stb(RK, m, n, n <= m ? v : 0.f); });
        __syncthreads();
        { const int m0 = (w >> 1) * 16 + (lane >> 4) * 4, n0 = (w & 1) * 32 + (lane & 15);
          Acc2 pt;
#pragma unroll
          for (int r = 0; r < 4; ++r) { pt.t0[r] = (m0 + r == n0) ? 1.f : 0.f; pt.t1[r] = (m0 + r == n0 + 16) ? 1.f : 0.f; }
#pragma unroll 1
          for (int i = 0; i < NEU_ROUNDS; ++i) {
            mm_acc(pt, P, XT, w, lane);
            if (i < NEU_ROUNDS - 1) { zero(a1); mm_acc(a1, X, XT, w, lane); }
            __syncthreads();
#pragma unroll
            for (int r = 0; r < 4; ++r) { stb(P, m0 + r, n0, pt.t0[r]); stb(P, m0 + r, n0 + 16, pt.t1[r]); }
            if (i < NEU_ROUNDS - 1) { each(a1, w, lane, [&](int m, int n, float v) { stb(X, m, n, v); }); st_tr(XT, a1, w, lane); }
            __syncthreads();
          } }
        zero(a1); mm_acc(a1, AK, VT, w, lane); zero(a2); mm_acc(a2, P, AtT, w, lane);
        st_tr(AkVT, a1, w, lane); st_tr(ApT, a2, w, lane);
        __syncthreads();
        zero(a3); mm_acc(a3, P, AkVT, w, lane);
        st_tr(W2T, a3, w, lane);
        __syncthreads();
        zero(a1); mm_acc(a1, RB, ApT, w, lane); zero(a2); mm_acc(a2, RB, W2T, w, lane); mm_acc(a2, RK, VT, w, lane);
        zero(a3); mm_acc(a3, BhT, ApT, w, lane); zero(a4); mm_acc(a4, BhT, W2T, w, lane); mm_acc(a4, KhT, VT, w, lane);
        __syncthreads();
        { LAS bf16* O1 = At; LAS bf16* O2 = AtT; LAS bf16* O3 = AK; LAS float* OY = (LAS float*)X;
          each(a1, w, lane, [&](int m, int n, float v) { stb(O1, m, n, v + bf2f(Rt[m * LS + n])); });
          each(a3, w, lane, [&](int m, int n, float v) { stb(O2, m, n, v + (m == n ? gl[m] : 0.f)); });
          each(a4, w, lane, [&](int m, int n, float v) { stb(O3, m, n, v); });
          each(a2, w, lane, [&](int m, int n, float v) { OY[m * 68 + n] = v; });
          __syncthreads();
          const int row = tid >> 3, c8 = (tid & 7) * 8;
          *(v4u*)(wsp<bf16>(F, WS_RKQ) + (size_t)u * 4096 + row * 64 + c8) = *(const LAS v4u*)(O1 + row * LS + c8);
          *(v4u*)(wsp<bf16>(F, WS_RKM) + (size_t)u * 4096 + row * 64 + c8) = *(const LAS v4u*)(O2 + row * LS + c8);
          *(v4u*)(wsp<bf16>(F, WS_RKZ) + (size_t)u * 4096 + row * 64 + c8) = *(const LAS v4u*)(O3 + row * LS + c8);
          bf16* Yg = wsp<bf16>(F, WS_YR) + (size_t)z * R * 512 + h * 64;
#pragma unroll
          for (int i = 0; i < 2; ++i) { const int yr = (tid >> 4) + 32 * i, c4 = (tid & 15) * 4; const f32x4 yv = *(const LAS f32x4*)(OY + yr * 68 + c4); v2u yw; yw.x = pk2(yv.x, yv.y); yw.y = pk2(yv.z, yv.w);
              *(v2u*)(Yg + ((size_t)b * TB + scan_tok(z, 64 * c + yr)) * 512 + c4) = yw; } }
    }
#undef RK_LOAD
}
__device__ __forceinline__ void l1_rk_phase_b(const Frame& F) {
    using namespace rk;
    LAS unsigned char* L = F.lds;
    const int w = F.wave, lane = F.lane, tid = F.tid, chain = F.blk, z = chain >> 4, b = (chain >> 3) & 1, h = chain & 7;
    for (int i = tid; i < 2 * 64 * LS; i += 512) ((LAS bf16*)L)[i] = 0;
    const int sr = tid >> 3, sc = (tid & 7) * 8;
    v4u gm, gq, gz;
#define RKB_LOAD(u_) do { gm = *(const v4u*)(wsp<const bf16>(F, WS_RKM) + (u_) * 4096 + sr * 64 + sc); gq = *(const v4u*)(wsp<const bf16>(F, WS_RKQ) + (u_) * 4096 + sr * 64 + sc); \
    gz = *(const v4u*)(wsp<const bf16>(F, WS_RKZ) + (u_) * 4096 + sr * 64 + sc); } while (0)
#define RKB_WRITE(par) do { *(LAS v4u*)((LAS bf16*)(L + (2 + 3 * (par)) * MB) + sr * LS + sc) = gm; *(LAS v4u*)((LAS bf16*)(L + (3 + 3 * (par)) * MB) + sr * LS + sc) = gq; \
    *(LAS v4u*)((LAS bf16*)(L + (4 + 3 * (par)) * MB) + sr * LS + sc) = gz; } while (0)
    RKB_LOAD((size_t)chain * 260); RKB_WRITE(0);
    __syncthreads();
    float* Yg = wsp<float>(F, WS_YB) + (size_t)z * R * 512 + h * 64;
    const int m0 = (w >> 1) * 16 + (lane >> 4) * 4, n0 = (w & 1) * 32 + (lane & 15);
    for (int c = 0; c < 260; ++c) {
        const size_t u = (size_t)chain * 260 + c; const int par = c & 1;
        if (c + 1 < 260) RKB_LOAD(u + 1);
        const LAS bf16* S = (const LAS bf16*)(L + par * MB); LAS bf16* Sn = (LAS bf16*)(L + (par ^ 1) * MB);
        const LAS bf16* Mt = (const LAS bf16*)(L + (2 + 3 * par) * MB); const LAS bf16* Qp = (const LAS bf16*)(L + (3 + 3 * par) * MB); const LAS bf16* Zt = (const LAS bf16*)(L + (4 + 3 * par) * MB);
        Acc2 a1, a2;
#pragma unroll
        for (int r = 0; r < 4; ++r) { a1.t0[r] = bf2f(Zt[(m0 + r) * LS + n0]); a1.t1[r] = bf2f(Zt[(m0 + r) * LS + n0 + 16]); }
        mm_acc(a1, Mt, S, w, lane); zero(a2); mm_acc(a2, Qp, S, w, lane);
        st_tr(Sn, a1, w, lane);
        if (c + 1 < 260) RKB_WRITE(par ^ 1);
#pragma unroll
        for (int r = 0; r < 4; ++r) { const size_t yo = ((size_t)b * TB + scan_tok(z, 64 * c + m0 + r)) * 512 + n0; Yg[yo] = a2.t0[r]; Yg[yo + 16] = a2.t1[r]; }
        __syncthreads();
    }
#undef RKB_LOAD
#undef RKB_WRITE
}
__device__ __forceinline__ void l1_mlstm_a2(const Frame& F) {
    using namespace rk;
    LAS bf16* KT = (LAS bf16*)F.lds; LAS bf16* VsT = KT + 64 * LS;
    LAS float* vec = (LAS float*)(F.lds + AUX_OFF); LAS int* rows = (LAS int*)vec;
    const bf16* Pg = wsp<const bf16>(F, WS_P); const int tid = F.tid, w = F.wave, lane = F.lane;
    for (int u = F.blk; u < NUNIT_M; u += F.G) {
        const int cidx = u / 260, c = u - cidx * 260, z = cidx >> 3, b = (cidx >> 2) & 1, h = cidx & 3;
        mlstm_chunk_head(F, z, b, h, c, vec);
        if (tid < 64) { const float bl = vec[128 + 63]; const float uu = bl - vec[128 + tid] + vec[64 + tid]; float m = uu;
#pragma unroll
            for (int o = 1; o < 64; o <<= 1) m = fmaxf(m, __shfl_xor(m, o));
            vec[256 + tid] = __expf(uu - m);
            if (tid == 0) { wsp<float>(F, WS_SC)[2 * u] = bl; wsp<float>(F, WS_SC)[2 * u + 1] = m; } }
        __syncthreads();
        { const int s = tid >> 3, c8 = tid & 7; float x[8]; unpack8(*(const v4u*)(Pg + (size_t)rows[s] * REC_NP + PC_K + h * 64 + 8 * c8), x);
#pragma unroll
          for (int e = 0; e < 8; ++e) stb(KT, 8 * c8 + e, s, x[e]); }
#pragma unroll
        for (int i = 0; i < 2; ++i) { const int s = (tid >> 4) + 32 * i, c8 = tid & 15; float x[8]; unpack8(*(const v4u*)(Pg + (size_t)rows[s] * REC_NP + PC_V + h * 128 + 8 * c8), x); const float sw = vec[256 + s];
#pragma unroll
            for (int e = 0; e < 8; ++e) stb(VsT, 8 * c8 + e, s, x[e] * sw); }
        __syncthreads();
        Acc2 a0, a1; zero(a0); mm_acc(a0, VsT, KT, w, lane); zero(a1); mm_acc(a1, VsT + 64 * LS, KT, w, lane);
        float* dc = wsp<float>(F, WS_DC) + (size_t)u * 8192;
        each(a0, w, lane, [&](int m, int n, float v) { dc[m * 64 + n] = 0.125f * v; });
        each(a1, w, lane, [&](int m, int n, float v) { dc[(64 + m) * 64 + n] = 0.125f * v; });
        if (tid < 64) { float a = 0.f; for (int s = 0; s < 64; ++s) a += vec[256 + s] * bf2f(KT[tid * LS + s]); wsp<float>(F, WS_DN)[(size_t)u * 64 + tid] = 0.125f * a; }
        __syncthreads();
    }
}
__device__ __forceinline__ void l1_mlstm_c2(const Frame& F, int first_blk, int nblk) {
    using namespace rk;
    LAS bf16* Q = (LAS bf16*)F.lds; LAS bf16* K = Q + 64 * LS; LAS bf16* VT = K + 64 * LS; LAS bf16* Cm = VT + 128 * LS; LAS bf16* Pm = Cm + 128 * LS;
    LAS float* OH = (LAS float*)(F.lds + 7 * MB);
    LAS float* vec = (LAS float*)(F.lds + AUX_OFF); LAS int* rows = (LAS int*)vec;
    const bf16* Pg = wsp<const bf16>(F, WS_P); const int tid = F.tid, w = F.wave, lane = F.lane;
    for (int u = F.blk - first_blk; u < NUNIT_M; u += nblk) {
        const int cidx = u / 260, c = u - cidx * 260, z = cidx >> 3, b = (cidx >> 2) & 1, h = cidx & 3;
        mlstm_chunk_head(F, z, b, h, c, vec);
        const float mst = wsp<const float>(F, WS_MST)[u];
        if (tid < 64) { const int t = tid; float pm = -3.0e38f; for (int s = 0; s <= t; ++s) pm = fmaxf(pm, vec[64 + s] - vec[128 + s]);
            const float gi = vec[128 + t] + mst, mo = fmaxf(gi, vec[128 + t] + pm); vec[320 + t] = __expf(gi - mo); vec[384 + t] = mo;
            vec[256 + t] = wsp<const float>(F, WS_NST)[(size_t)u * 64 + t]; }
        { const int t = tid >> 3, c8 = tid & 7;
          *(LAS v4u*)(Q + t * LS + 8 * c8) = *(const v4u*)(Pg + (size_t)rows[t] * REC_NP + PC_Q + h * 64 + 8 * c8);
          *(LAS v4u*)(K + t * LS + 8 * c8) = *(const v4u*)(Pg + (size_t)rows[t] * REC_NP + PC_K + h * 64 + 8 * c8); }
#pragma unroll
        for (int i = 0; i < 2; ++i) { const int s = (tid >> 4) + 32 * i, c8 = tid & 15; const v4u wv = *(const v4u*)(Pg + (size_t)rows[s] * REC_NP + PC_V + h * 128 + 8 * c8);
            const unsigned ww[4] = {wv.x, wv.y, wv.z, wv.w};
#pragma unroll
            for (int e = 0; e < 4; ++e) { VT[(8 * c8 + 2 * e) * LS + s] = (bf16)(ww[e] & 0xffffu); VT[(8 * c8 + 2 * e + 1) * LS + s] = (bf16)(ww[e] >> 16); } }
        { const int v = tid >> 2, dq = (tid & 3) * 16; const f32x4* src = (const f32x4*)(wsp<const float>(F, WS_CST) + (size_t)u * 8192 + v * 64 + dq);
          const f32x4 x0 = src[0], x1 = src[1], x2 = src[2], x3 = src[3]; v4u o0, o1;
          o0.x = pk2(x0.x, x0.y); o0.y = pk2(x0.z, x0.w); o0.z = pk2(x1.x, x1.y); o0.w = pk2(x1.z, x1.w); o1.x = pk2(x2.x, x2.y); o1.y = pk2(x2.z, x2.w); o1.z = pk2(x3.x, x3.y); o1.w = pk2(x3.z, x3.w);
          *(LAS v4u*)(Cm + v * LS + dq) = o0; *(LAS v4u*)(Cm + v * LS + dq + 8) = o1; }
        __syncthreads();
        Acc2 aq, c0, c1; zero(aq); mm_acc(aq, Q, K, w, lane); zero(c0); mm_acc(c0, Q, Cm, w, lane); zero(c1); mm_acc(c1, Q, Cm + 64 * LS, w, lane);
        each(aq, w, lane, [&](int t, int s, float v) { stb(Pm, t, s, s <= t ? 0.125f * v * __expf(vec[128 + t] + (vec[64 + s] - vec[128 + s]) - vec[384 + t]) : 0.f); });
        __syncthreads();
        Acc2 p0, p1; zero(p0); mm_acc(p0, Pm, VT, w, lane); zero(p1); mm_acc(p1, Pm, VT + 64 * LS, w, lane);
        if (tid < 64) { const int t = tid; float rs = 0.f, nq = 0.f;
            for (int s = 0; s < 64; ++s) { rs += bf2f(Pm[t * LS + s]); nq += vec[256 + s] * bf2f(Q[t * LS + s]); }
            const float den = vec[320 + t] * nq + rs; vec[448 + t] = 1.f / fmaxf(fabsf(den), __expf(-vec[384 + t])); }
        __syncthreads();
        { const int m0 = (w >> 1) * 16 + (lane >> 4) * 4, n0 = (w & 1) * 32 + (lane & 15);
#pragma unroll
          for (int r = 0; r < 4; ++r) { const int t = m0 + r; const float g = vec[320 + t], idn = vec[448 + t];
              OH[t * 132 + n0] = (g * c0.t0[r] + p0.t0[r]) * idn; OH[t * 132 + n0 + 16] = (g * c0.t1[r] + p0.t1[r]) * idn;
              OH[t * 132 + 64 + n0] = (g * c1.t0[r] + p1.t0[r]) * idn; OH[t * 132 + 64 + n0 + 16] = (g * c1.t1[r] + p1.t1[r]) * idn; } }
        __syncthreads();
#pragma unroll
        for (int i = 0; i < 4; ++i) { const int it = tid + 512 * i, t = it >> 5, c4 = (it & 31) * 4;
            const f32x4 hv = *(const LAS f32x4*)(OH + t * 132 + c4); v2u hw; hw.x = pk2(hv.x, hv.y); hw.y = pk2(hv.z, hv.w);
            *(v2u*)(wsp<bf16>(F, WS_HM) + ((size_t)z * R + rows[t]) * 512 + h * 128 + c4) = hw; }
        __syncthreads();
    }
}
#ifndef MK_PER_PHASE
#define MK_PER_PHASE 0
#endif
constexpr int NPHASE = 26;
struct Args { const float* in[N_IN]; float* out; unsigned char* ws; int ph_lo, ph_hi, li, pad; };
#define GEMM_CALL(FnT, SchedT, g, S, fn) do { pg8::EpiGen<FnT> E_{fn}; { int k_ = g.K; asm volatile("" : "+s"(k_)); g.K = k_; } pg8::gemm_phase<pg8::EpiGen<FnT>, SchedT, true, true>((PG8_LAS unsigned char*)F.lds, g, S, E_); } while (0)
#ifndef SITE_MASK
#define SITE_MASK 0xFFFFFFFFull
#endif
#define SITE(s) (((SITE_MASK) >> (s)) & 1ull)
#ifndef DUP_MASK
#define DUP_MASK 0ull
#endif
#define NREP(s) ((((DUP_MASK) >> (s)) & 1ull) ? 2 : 1)
#define IN(k) (lo <= (k) && (k) < hi)
#define SEAM(k) do { if (IN(k) && IN((k) + 1)) xcd_barrier(bar); } while (0)
template <int LAYER> __device__ __forceinline__ void layer_phases(const Frame& F, const XcdBarrier& bar, const int lo, const int hi) {
    constexpr int layer = LAYER; constexpr int pb = 2 + 12 * LAYER;
        if (SITE(2) && IN(pb + 0)) { for (int rep_ = 0; rep_ < NREP(2); ++rep_) {
            const int N = layer == 0 ? ATT_NP : REC_NP;
            pg8::Gemm g{wsp<const bf16>(F, WS_A), layer == 0 ? wsp<const bf16>(F, WS_WIN0) : wsp<const bf16>(F, WS_WREC), R, N, 1024};
            pg8::StaticOrder S; S.init(R, N, F.G, F.blk);
            GEMM_CALL(FnStoreBf16, pg8::StaticOrder, g, S, (FnStoreBf16{wsp<bf16>(F, WS_P), N}));
             if (rep_ + 1 < NREP(2)) xcd_barrier(bar); } SEAM(pb + 0);
        }
        if constexpr (LAYER == 0) {
            if (SITE(3) && IN(pb + 1)) { for (int rep_ = 0; rep_ < NREP(3); ++rep_) { l0_post_proj(F);  if (rep_ + 1 < NREP(3)) xcd_barrier(bar); } SEAM(pb + 1); }
            if (SITE(4) && IN(pb + 2)) { for (int rep_ = 0; rep_ < NREP(4); ++rep_) {
                pg8::Gemm g{wsp<const bf16>(F, WS_CQN), wsp<const bf16>(F, WS_WUQ), R, 768, 384}; pg8::StaticOrder S; S.init(R, 768, F.G, F.blk);
                GEMM_CALL(FnStoreBf16, pg8::StaticOrder, g, S, (FnStoreBf16{wsp<bf16>(F, WS_MQ), 768}));
                 if (rep_ + 1 < NREP(4)) xcd_barrier(bar); } SEAM(pb + 2);
            }
            if (SITE(5) && IN(pb + 3)) { for (int rep_ = 0; rep_ < NREP(5); ++rep_) {
                pg8::Gemm g{wsp<const bf16>(F, WS_CKVN), wsp<const bf16>(F, WS_WUKV), R, 1024, 256}; pg8::StaticOrder S; S.init(R, 1024, F.G, F.blk);
                GEMM_CALL(FnStoreBf16, pg8::StaticOrder, g, S, (FnStoreBf16{wsp<bf16>(F, WS_MKV), 1024}));
                l0_mq_rope(F);
                 if (rep_ + 1 < NREP(5)) xcd_barrier(bar); } SEAM(pb + 3);
            }
            if (SITE(6) && IN(pb + 4)) { for (int rep_ = 0; rep_ < NREP(6); ++rep_) { l0_attention(F);  if (rep_ + 1 < NREP(6)) xcd_barrier(bar); } SEAM(pb + 4); }
            if (SITE(7) && IN(pb + 5)) { for (int rep_ = 0; rep_ < NREP(7); ++rep_) { l0_combine(F);  if (rep_ + 1 < NREP(7)) xcd_barrier(bar); } SEAM(pb + 5); }
        } else {
            if (SITE(8) && IN(pb + 1)) { for (int rep_ = 0; rep_ < NREP(8); ++rep_) { l1_rwkv_prep(F); l1_mlstm_a2(F);  if (rep_ + 1 < NREP(8)) xcd_barrier(bar); } SEAM(pb + 1); }
            if (SITE(9) && IN(pb + 2)) { for (int rep_ = 0; rep_ < NREP(9); ++rep_) {
                pg8::Gemm g{wsp<const bf16>(F, WS_ALORA), wsp<const bf16>(F, WS_WLORA), R, 2560, 384}; pg8::StaticOrder S; S.init(R, 2560, F.G, F.blk);
                { int k_ = g.K; asm volatile("" : "+s"(k_)); g.K = k_; EpiLora E_{&F}; pg8::gemm_phase<EpiLora, pg8::StaticOrder, true, true>((PG8_LAS unsigned char*)F.lds, g, S, E_); }
                l1_mlstm_b(F);
                 if (rep_ + 1 < NREP(9)) xcd_barrier(bar); } SEAM(pb + 2);
            }
            if (SITE(18) && IN(pb + 3)) { for (int rep_ = 0; rep_ < NREP(18); ++rep_) { l1_rk_phase_a(F); if (rep_ + 1 < NREP(18)) xcd_barrier(bar); } SEAM(pb + 3); }
            if (SITE(10) && IN(pb + 4)) { for (int rep_ = 0; rep_ < NREP(10); ++rep_) {
                if (F.G > 32) { if (F.blk < 32) l1_rk_phase_b(F); else { l1_mlstm_c2(F, 32, F.G - 32); moe_weights_convert(F, 1, (F.blk - 32) * 8 + F.wave, (F.G - 32) * 8); } }
                 if (rep_ + 1 < NREP(10)) xcd_barrier(bar); } SEAM(pb + 4);
            }
            if (SITE(11) && IN(pb + 5)) { for (int rep_ = 0; rep_ < NREP(11); ++rep_) { l1_rec_out(F);  if (rep_ + 1 < NREP(11)) xcd_barrier(bar); } SEAM(pb + 5); }
        }
        if (SITE(12) && IN(pb + 6)) { for (int rep_ = 0; rep_ < NREP(12); ++rep_) {
            pg8::Gemm g{wsp<const bf16>(F, WS_A1), wsp<const bf16>(F, WS_WOUT) + (size_t)layer * 1024 * 1024, R, 1024, 1024};
            if constexpr (LAYER == 0) { pg8::StaticOrder S; S.init(R, 1024, F.G, F.blk); GEMM_CALL(FnWout, pg8::StaticOrder, g, S, (FnWout{&F, layer})); }
            else { LatOrder S; S.o.init(R - 2 * CT, 1024, F.G, F.blk); GEMM_CALL(FnWout, LatOrder, g, S, (FnWout{&F, layer})); }
             if (rep_ + 1 < NREP(12)) xcd_barrier(bar); } SEAM(pb + 6);
        }
        if (SITE(13) && IN(pb + 7)) { for (int rep_ = 0; rep_ < NREP(13); ++rep_) { ph_router(F, layer);  if (rep_ + 1 < NREP(13)) xcd_barrier(bar); } SEAM(pb + 7); }
        if (SITE(14) && IN(pb + 8)) { for (int rep_ = 0; rep_ < NREP(14); ++rep_) { ph_gather(F, layer);  if (rep_ + 1 < NREP(14)) xcd_barrier(bar); } SEAM(pb + 8); }
        if (SITE(15) && IN(pb + 9)) { for (int rep_ = 0; rep_ < NREP(15); ++rep_) {
            const int* tab = wsp<const int>(F, WS_TILE);
            pg8::Gemm g{wsp<const bf16>(F, WS_F), wsp<const bf16>(F, WS_W1T), MAXROWS, NE * 2048, 1024}; MoeOrder S{tab + 1, __builtin_amdgcn_readfirstlane(tab[0]), 8, F.G, F.blk, wsp<const int>(F, WS_SRC)};
            { int k_ = g.K; asm volatile("" : "+s"(k_)); g.K = k_; pg8::EpiGen<FnSwiglu> E_{FnSwiglu{wsp<bf16>(F, WS_HS), F.in[I_B1] + (size_t)layer * NE * 2048}};
              pg8::gemm_phase<pg8::EpiGen<FnSwiglu>, MoeOrder, true, true, true>((PG8_LAS unsigned char*)F.lds, g, S, E_); }
             if (rep_ + 1 < NREP(15)) xcd_barrier(bar); } SEAM(pb + 9);
        }
        if (SITE(16) && IN(pb + 10)) { for (int rep_ = 0; rep_ < NREP(16); ++rep_) {
            const int* tab = wsp<const int>(F, WS_TILE);
            pg8::Gemm g{wsp<const bf16>(F, WS_HS), wsp<const bf16>(F, WS_W2T), MAXROWS, NE * 1024, 1024}; MoeOrder S{tab + 1, __builtin_amdgcn_readfirstlane(tab[0]), 4, F.G, F.blk, nullptr};
            GEMM_CALL(FnBiasBf16, MoeOrder, g, S, (FnBiasBf16{wsp<bf16>(F, WS_XS), F.in[I_B2] + (size_t)layer * NE * 1024}));
             if (rep_ + 1 < NREP(16)) xcd_barrier(bar); } SEAM(pb + 10);
        }
        if (SITE(17) && IN(pb + 11)) { for (int rep_ = 0; rep_ < NREP(17); ++rep_) { ph_combine(F, layer);  if (rep_ + 1 < NREP(17)) xcd_barrier(bar); } SEAM(pb + 11); }
}
__global__ void __launch_bounds__(512, 2) fwd(Args args) {
    extern __shared__ __attribute__((aligned(16))) unsigned char lds_[];
    Frame F;
    F.lds = (LAS unsigned char*)lds_; F.tid = threadIdx.x; F.lane = F.tid & 63; F.wave = __builtin_amdgcn_readfirstlane(F.tid >> 6); F.blk = blockIdx.x; F.G = gridDim.x; F.probe = args.pad;
    F.ws = args.ws; F.out = args.out; F.ctl = (gu32*)(args.ws + WS_CTL);
    F.in.t = (LAS const unsigned*)(F.lds + MISC_OFF + 8192);
    if (F.tid < 64) ((LAS unsigned*)(F.lds + MISC_OFF))[F.tid] = 0u;
    if (F.tid < N_IN) { const unsigned long long pv = (unsigned long long)args.in[F.tid]; ((LAS unsigned*)(F.lds + MISC_OFF + 8192))[2 * F.tid] = (unsigned)pv; ((LAS unsigned*)(F.lds + MISC_OFF + 8192))[2 * F.tid + 1] = (unsigned)(pv >> 32); }
    __syncthreads();
    const int lo = args.ph_lo, hi = args.ph_hi;
    XcdBarrier bar; bar.bar = (unsigned*)(F.ctl + CW_BAR) + args.li * XCD_BAR_WORDS; bar.x = 0; bar.st = nullptr;
    if (hi - lo > 1) bar = xcd_barrier_post((unsigned*)(F.ctl + CW_BAR) + args.li * XCD_BAR_WORDS, (volatile LAS unsigned*)(F.lds + MISC_OFF));
    if (SITE(0) && IN(0)) { for (int rep_ = 0; rep_ < NREP(0); ++rep_) { p0a(F);  if (rep_ + 1 < NREP(0)) xcd_barrier(bar); } SEAM(0); }
    if (SITE(1) && IN(1)) { for (int rep_ = 0; rep_ < NREP(1); ++rep_) { p0b(F);  if (rep_ + 1 < NREP(1)) xcd_barrier(bar); } SEAM(1); }
    layer_phases<0>(F, bar, lo, hi);
    layer_phases<1>(F, bar, lo, hi);
}
#undef IN
#undef SEAM


extern "C" void kernel_launch(void* const* d_in, const int* in_sizes, int n_in, void* d_out, int out_size, void* d_ws, size_t ws_size, hipStream_t stream) {
    static int grid = 0;
    if (grid == 0) {
        const bool ok = n_in == N_IN && in_sizes[I_X] == NBATCH * SEQ * DM && in_sizes[I_RECW] == 1024 * REC_IN && in_sizes[I_ATTW] == 1024 * ATT_IN && in_sizes[I_MU] == RWKV_IN &&
                        in_sizes[I_GATEB] == 16 && in_sizes[I_W1] == 2 * NE * 1024 * 2048 && out_size == NBATCH * SEQ * DM && ws_size >= WS_END;
        if (!ok) { fprintf(stderr, "kernel_launch: shape mismatch (n_in %d, recw %d, attw %d, mu %d, out %d, ws %zu need %zu); nothing launched\n", n_in, n_in > I_RECW ? in_sizes[I_RECW] : -1,
                           n_in > I_ATTW ? in_sizes[I_ATTW] : -1, n_in > I_MU ? in_sizes[I_MU] : -1, out_size, ws_size, (size_t)WS_END); grid = -1; return; }
        int dev = 0, cus = 0;
        if (hipGetDevice(&dev) != hipSuccess || hipDeviceGetAttribute(&cus, hipDeviceAttributeMultiprocessorCount, dev) != hipSuccess) { grid = -1; return; }
        if (hipFuncSetAttribute((const void*)fwd, hipFuncAttributeMaxDynamicSharedMemorySize, LDS_BYTES) != hipSuccess) { fprintf(stderr, "kernel_launch: hipFuncSetAttribute failed\n"); grid = -1; return; }
        int per_cu = 0;
        if (hipOccupancyMaxActiveBlocksPerMultiprocessor(&per_cu, (const void*)fwd, 512, LDS_BYTES) != hipSuccess || per_cu < 1) { fprintf(stderr, "kernel_launch: occupancy query says %d blocks per CU\n", per_cu); }
        (void)hipGetLastError();
        grid = cus < 256 ? cus : 256;
        if (grid != 256) fprintf(stderr, "kernel_launch: %d CUs; this kernel is written for a 256-CU device\n", cus);
    }
    if (grid < 0) return;
    if (hipMemsetAsync((char*)d_ws + WS_CTL, 0, CTL_ZERO_BYTES, stream) != hipSuccess) return;
    Args a{};
    for (int i = 0; i < N_IN; ++i) a.in[i] = (const float*)d_in[i];
    a.out = (float*)d_out; a.ws = (unsigned char*)d_ws; a.pad = 0;
#if MK_PER_PHASE
    for (int ph = 0; ph < NPHASE; ++ph) { a.ph_lo = ph; a.ph_hi = ph + 1; a.li = 0; hipLaunchKernelGGL(fwd, dim3(grid), dim3(512), LDS_BYTES, stream, a); }
#elif defined(PROBE_PRE)
    { const int plist[] = {PROBE_PRE}; int cur = 0, li = 0;
      for (int p : plist) { if (p > cur) { a.ph_lo = cur; a.ph_hi = p; a.li = li++; hipLaunchKernelGGL(fwd, dim3(grid), dim3(512), LDS_BYTES, stream, a); }
                            a.ph_lo = p; a.ph_hi = p + 1; a.li = li++; a.pad = 1; hipLaunchKernelGGL(fwd, dim3(grid), dim3(512), LDS_BYTES, stream, a); a.pad = 0; cur = p; }
      a.ph_lo = cur; a.ph_hi = NPHASE; a.li = li++; hipLaunchKernelGGL(fwd, dim3(grid), dim3(512), LDS_BYTES, stream, a); }
#elif defined(PROBE_LIST)
    { const int plist[] = {PROBE_LIST}; int cur = 0, li = 0;
      for (int p : plist) { a.ph_lo = cur; a.ph_hi = p + 1; a.li = li++; hipLaunchKernelGGL(fwd, dim3(grid), dim3(512), LDS_BYTES, stream, a);
                            a.ph_lo = p; a.ph_hi = p + 1; a.li = li++; a.pad = 1; hipLaunchKernelGGL(fwd, dim3(grid), dim3(512), LDS_BYTES, stream, a); a.pad = 0; cur = p + 1; }
      if (cur < NPHASE) { a.ph_lo = cur; a.ph_hi = NPHASE; a.li = li++; hipLaunchKernelGGL(fwd, dim3(grid), dim3(512), LDS_BYTES, stream, a); } }
#else
    a.ph_lo = 0; a.ph_hi = NPHASE; a.li = 0; hipLaunchKernelGGL(fwd, dim3(grid), dim3(512), LDS_BYTES, stream, a);
#endif
    const hipError_t le = hipPeekAtLastError();
    if (le != hipSuccess) fprintf(stderr, "kernel_launch: launch failed: %s\n", hipGetErrorName(le));
}
```

```cpp
#include <hip/hip_runtime.h>
#include <cstdio>
#include <cstdint>
#define MK_PER_PHASE 0
namespace pg8 {
#define PG8_LAS __attribute__((address_space(3)))
typedef unsigned short bf16_t;
typedef short bf16x8 __attribute__((ext_vector_type(8)));
typedef float f32x4 __attribute__((ext_vector_type(4)));
typedef unsigned u32x4 __attribute__((ext_vector_type(4)));
constexpr int BM = 256, BK = 64, HALF = 128, HTB = HALF * BK * 2  , STAGE_BYTES = 8 * HTB, NXCD = 8, WGM = 8;

__host__ __device__ __forceinline__ int lds_byte(int r, int c) { const int st = (r >> 4) * 2 + (c >> 5), rr = r & 15, cc = c & 31, ob = rr * 64 + cc * 2; return st * 1024 + (ob ^ (((ob >> 9) & 1) << 5)); }
__host__ __device__ __forceinline__ void stage_rc(int b, int& R, int& C) { const int st = b / 1024, sb = b % 1024, swz = sb ^ (((sb >> 9) & 1) << 5); R = (st >> 1) * 16 + swz / 64; C = (st & 1) * 32 + (swz % 64) / 2; }
__host__ __device__ __forceinline__ int perm32(int rho) { const int n = rho >> 4, i = rho & 15; return 8 * (i >> 2) + 4 * n + (i & 3); }

struct Unit { int pm, pn; };
struct Gemm { const bf16_t* A; const bf16_t* Bt; int M, N, K; };

struct StaticOrder {
    int nM, nN, nwg, G, c;
    __host__ __device__ void init(int M, int N, int G_, int c_) { nM = M / BM; nN = N / BM; nwg = nM * nN; G = G_; c = c_; }
    __host__ __device__ bool next(int i, Unit& u) const {
        const long L = (long)i * G + c; if (L >= nwg) return false;
        int wgid = (int)L; { const int q = nwg / NXCD, r = nwg % NXCD, xcd = wgid % NXCD, off = wgid / NXCD; wgid = (xcd < r ? xcd * (q + 1) : r * (q + 1) + (xcd - r) * q) + off; }
        const int nig = WGM * nN, gid = wgid / nig, fm = gid * WGM, gsz = (nM - fm) < WGM ? (nM - fm) : WGM;
        u.pm = fm + ((wgid % nig) % gsz); u.pn = (wgid % nig) / gsz; return true;
    }
    __device__ __forceinline__ void a_ready(const Unit&) const {}
    __device__ __forceinline__ void done(const Unit&) const {}
};

__device__ __forceinline__ unsigned cvt_pk_bf16(float lo, float hi) { unsigned r; asm volatile("v_cvt_pk_bf16_f32 %0, %1, %2" : "=v"(r) : "v"(lo), "v"(hi)); return r; }
template <class Fn> struct EpiGen {
    static constexpr bool PERM = true, AFTER_DRAIN = false;
    Fn fn;
    __device__ __forceinline__ void operator()(const f32x4 (&acc)[2][2][4][2], const Unit& u, int wr, int wc, int fr, int fq) const {
#pragma unroll
        for (int ai = 0; ai < 2; ++ai)
#pragma unroll
            for (int m = 0; m < 4; ++m) { const int row = u.pm * BM + ai * HALF + wr * 64 + m * 16 + fr;
#pragma unroll
                for (int bj = 0; bj < 2; ++bj) { const int col = u.pn * BM + bj * HALF + wc * 32 + 8 * fq; fn(row, col, acc[ai][bj][m][0], acc[ai][bj][m][1]); } }
    }
};
template <class Epi, class Sched, bool ALIGN_EPI = false, bool SP2 = false, bool GATHER = false>
__device__ __forceinline__ void gemm_phase(PG8_LAS unsigned char* lds, const Gemm g, const Sched& S, const Epi& E) {
    static_assert(!GATHER || SP2, "the gathered A path is written for the SP2 loop");
    const int tid = threadIdx.x, wid = __builtin_amdgcn_readfirstlane(tid >> 6), lane = tid & 63, wr = wid >> 2, wc = wid & 3, fr = lane & 15, fq = lane >> 4;
    const int K = g.K, nt = K / BK;
    unsigned voffA[2], voffB[2]; int gR[2], gC[2]; unsigned gA[2][2], gN[2][2];
#pragma unroll
    for (int i = 0; i < 2; ++i) { int R, C; stage_rc(tid * 16 + i * 8192, R, C); const int Rb = Epi::PERM ? ((R & ~31) + perm32(R & 31)) : R;
        voffA[i] = (unsigned)(R * K + C) * 2u; voffB[i] = (unsigned)(Rb * K + C) * 2u; gR[i] = R; gC[i] = C; }
    const size_t kstep = (size_t)(BK * 2);
    const size_t hstep = (size_t)HALF * K * 2;
    const size_t tstep = 2 * hstep;
    const unsigned ldsw = (unsigned)wid * 1024u;
    const int aoff = lds_byte(wr * 64 + fr, fq * 8), boff = lds_byte(wc * 32 + fr, fq * 8);
#define PG8_SA(b, h) (((b) * 2 + (h)) * HTB)
#define PG8_SB(b, h) ((4 + (b) * 2 + (h)) * HTB)
#define PG8_STAGE(bufoff, gbase, voff) do { _Pragma("unroll") for (int _i = 0; _i < 2; ++_i) \
        __builtin_amdgcn_global_load_lds((const unsigned*)((const char*)(gbase) + (voff)[_i]), (PG8_LAS unsigned*)(lds + (bufoff) + ldsw + _i * 8192), 16, 0, 0); } while (0)
#define PG8_GOFF(u_, out_) do { _Pragma("unroll") for (int _h = 0; _h < 2; ++_h) _Pragma("unroll") for (int _i = 0; _i < 2; ++_i) \
        out_[_h][_i] = ((unsigned)S.src[(u_).pm * BM + _h * HALF + gR[_i]] * (unsigned)K + (unsigned)gC[_i]) * 2u; } while (0)
#define PG8_STAGE_A(bufoff, kptr, h, isnext) do { if constexpr (GATHER) { unsigned _o[2]; _o[0] = (isnext) ? gN[h][0] : gA[h][0]; _o[1] = (isnext) ? gN[h][1] : gA[h][1]; PG8_STAGE(bufoff, kptr, _o); } \
        else { PG8_STAGE(bufoff, (kptr) + (h) * hstep, voffA); } } while (0)
#define PG8_LDA(dst, b, h) do { _Pragma("unroll") for (int m = 0; m < 4; ++m) _Pragma("unroll") for (int k = 0; k < 2; ++k) dst[m][k] = *(const PG8_LAS bf16x8*)(lds + PG8_SA(b, h) + aoff + m * 2048 + k * 1024); } while (0)
#define PG8_LDB(dst, b, h) do { _Pragma("unroll") for (int n = 0; n < 2; ++n) _Pragma("unroll") for (int k = 0; k < 2; ++k) dst[n][k] = *(const PG8_LAS bf16x8*)(lds + PG8_SB(b, h) + boff + n * 2048 + k * 1024); } while (0)
#define PG8_MMA(ai, bj, At, Bt) do { __builtin_amdgcn_s_setprio(1); _Pragma("unroll") for (int m = 0; m < 4; ++m) _Pragma("unroll") for (int n = 0; n < 2; ++n) _Pragma("unroll") for (int k = 0; k < 2; ++k) \
        acc[ai][bj][m][n] = __builtin_amdgcn_mfma_f32_16x16x32_bf16(Bt[n][k], At[m][k], acc[ai][bj][m][n], 0, 0, 0); __builtin_amdgcn_s_setprio(0); } while (0)
#define PG8_WAIT_V(n) asm volatile("s_waitcnt vmcnt(" #n ")" ::: "memory")
#define PG8_WAIT_L(n) asm volatile("s_waitcnt lgkmcnt(" #n ")" ::: "memory")
#define PG8_BAR __builtin_amdgcn_s_barrier()
#define PG8_SCHED __builtin_amdgcn_sched_barrier(0)
    Unit cur, nxt; int ui = 0;
    if (!S.next(0, cur)) return;
    f32x4 acc[2][2][4][2];
#pragma unroll
    for (int a = 0; a < 2; ++a)
#pragma unroll
        for (int b = 0; b < 2; ++b)
#pragma unroll
            for (int m = 0; m < 4; ++m)
#pragma unroll
                for (int n = 0; n < 2; ++n) acc[a][b][m][n] = (f32x4){0.f, 0.f, 0.f, 0.f};
    bf16x8 At[4][2], B0[2][2], B1[2][2];
    const char* cA = (const char*)g.A + (GATHER ? (size_t)0 : (size_t)cur.pm * tstep); const char* cB = (const char*)g.Bt + (size_t)cur.pn * tstep;
    if constexpr (GATHER) PG8_GOFF(cur, gA);
    S.a_ready(cur);
    if constexpr (SP2) {
        PG8_STAGE(PG8_SB(0, 0), cB, voffB); PG8_STAGE(PG8_SB(0, 1), cB + hstep, voffB); PG8_STAGE_A(PG8_SA(0, 0), cA, 0, false); PG8_STAGE_A(PG8_SA(0, 1), cA, 1, false);
        if (wr == 1) PG8_BAR;
        PG8_WAIT_V(2); PG8_BAR;
        PG8_STAGE(PG8_SB(1, 0), cB + kstep, voffB); PG8_STAGE_A(PG8_SA(1, 0), cA + kstep, 0, false); PG8_STAGE(PG8_SB(1, 1), cB + hstep + kstep, voffB);
        PG8_WAIT_V(6); PG8_BAR;
    } else {
        PG8_STAGE(PG8_SB(0, 0), cB, voffB); PG8_STAGE(PG8_SA(0, 0), cA, voffA); PG8_STAGE(PG8_SB(0, 1), cB + hstep, voffB); PG8_STAGE(PG8_SA(0, 1), cA + hstep, voffA);
        if (wr == 1) PG8_BAR;
        PG8_WAIT_V(4); PG8_BAR;
        PG8_STAGE(PG8_SB(1, 0), cB + kstep, voffB); PG8_STAGE(PG8_SA(1, 0), cA + kstep, voffA); PG8_STAGE(PG8_SB(1, 1), cB + hstep + kstep, voffB);
        PG8_WAIT_V(6); PG8_BAR;
    }
    for (;;) {
        const bool has_next = S.next(ui + 1, nxt);
        const char* nA = (has_next && !GATHER) ? (const char*)g.A + (size_t)nxt.pm * tstep : cA; const char* nB = has_next ? (const char*)g.Bt + (size_t)nxt.pn * tstep : cB;
        if constexpr (GATHER) { if (has_next) PG8_GOFF(nxt, gN); else { _Pragma("unroll") for (int _h = 0; _h < 2; ++_h) { gN[_h][0] = gA[_h][0]; gN[_h][1] = gA[_h][1]; } } }
        for (int t = 0; t < nt; t += 2) {
            const bool last = (t == nt - 2);
            const char* a1 = cA + (size_t)(t + 1) * kstep;
            const char* a2 = last ? nA : cA + (size_t)(t + 2) * kstep; const char* b2 = last ? nB : cB + (size_t)(t + 2) * kstep;
            const char* a3 = a2 + kstep; const char* b3 = b2 + kstep;
            if (last && has_next) S.a_ready(nxt);
            if constexpr (SP2) {
            PG8_LDB(B0, 0, 0); PG8_LDB(B1, 0, 1); PG8_SCHED; PG8_LDA(At, 0, 0); PG8_STAGE_A(PG8_SA(1, 1), a1, 1, false);
            PG8_WAIT_V(8); PG8_WAIT_L(0); PG8_BAR; PG8_MMA(0, 0, At, B0); PG8_MMA(0, 1, At, B1); PG8_BAR; PG8_SCHED;
            PG8_LDA(At, 0, 1); PG8_STAGE(PG8_SB(0, 0), b2, voffB); PG8_STAGE(PG8_SB(0, 1), b2 + hstep, voffB); PG8_STAGE_A(PG8_SA(0, 0), a2, 0, last);
            PG8_WAIT_V(8); PG8_WAIT_L(0); PG8_BAR; PG8_MMA(1, 0, At, B0); PG8_MMA(1, 1, At, B1); PG8_BAR; PG8_SCHED;
            PG8_LDB(B0, 1, 0); PG8_LDB(B1, 1, 1); PG8_SCHED; PG8_LDA(At, 1, 0); PG8_STAGE_A(PG8_SA(0, 1), a2, 1, last);
            PG8_WAIT_V(8); PG8_WAIT_L(0); PG8_BAR; PG8_MMA(0, 0, At, B0); PG8_MMA(0, 1, At, B1); PG8_BAR; PG8_SCHED;
            PG8_LDA(At, 1, 1); PG8_STAGE(PG8_SB(1, 0), b3, voffB); PG8_STAGE(PG8_SB(1, 1), b3 + hstep, voffB); PG8_STAGE_A(PG8_SA(1, 0), a3, 0, last);
            PG8_WAIT_V(8); PG8_WAIT_L(0); PG8_BAR; PG8_MMA(1, 0, At, B0); PG8_MMA(1, 1, At, B1); PG8_BAR; PG8_SCHED;
            } else {
            PG8_LDB(B0, 0, 0); PG8_SCHED; PG8_LDA(At, 0, 0); PG8_STAGE(PG8_SA(1, 1), a1 + hstep, voffA);
            PG8_WAIT_L(8); PG8_BAR; PG8_WAIT_L(0); PG8_MMA(0, 0, At, B0); PG8_BAR; PG8_SCHED;
            PG8_LDB(B1, 0, 1); PG8_STAGE(PG8_SB(0, 0), b2, voffB);
            PG8_BAR; PG8_WAIT_L(0); PG8_MMA(0, 1, At, B1); PG8_BAR;
            PG8_LDA(At, 0, 1); PG8_STAGE(PG8_SA(0, 0), a2, voffA);
            PG8_BAR; PG8_WAIT_L(0); PG8_MMA(1, 0, At, B0); PG8_BAR; PG8_SCHED;
            PG8_STAGE(PG8_SB(0, 1), b2 + hstep, voffB);
            PG8_WAIT_V(6); PG8_BAR; PG8_MMA(1, 1, At, B1); PG8_BAR;
            PG8_LDB(B0, 1, 0); PG8_SCHED; PG8_LDA(At, 1, 0); PG8_STAGE(PG8_SA(0, 1), a2 + hstep, voffA);
            PG8_WAIT_L(8); PG8_BAR; PG8_WAIT_L(0); PG8_MMA(0, 0, At, B0); PG8_BAR; PG8_SCHED;
            PG8_LDB(B1, 1, 1); PG8_STAGE(PG8_SB(1, 0), b3, voffB);
            PG8_BAR; PG8_WAIT_L(0); PG8_MMA(0, 1, At, B1); PG8_BAR;
            PG8_LDA(At, 1, 1); PG8_STAGE(PG8_SA(1, 0), a3, voffA);
            PG8_BAR; PG8_WAIT_L(0); PG8_MMA(1, 0, At, B0); PG8_BAR; PG8_SCHED;
            PG8_STAGE(PG8_SB(1, 1), b3 + hstep, voffB);
            PG8_WAIT_V(6); PG8_BAR; PG8_MMA(1, 1, At, B1); PG8_BAR;
            }
        }
        if constexpr (ALIGN_EPI) { if (wr == 0) PG8_BAR; }
        if constexpr (!Epi::AFTER_DRAIN) { E(acc, cur, wr, wc, fr, fq); S.done(cur); }
        if (!has_next) break;
#pragma unroll
        for (int a = 0; a < 2; ++a)
#pragma unroll
            for (int b = 0; b < 2; ++b)
#pragma unroll
                for (int m = 0; m < 4; ++m)
#pragma unroll
                    for (int n = 0; n < 2; ++n) acc[a][b][m][n] = (f32x4){0.f, 0.f, 0.f, 0.f};
        cur = nxt; cA = nA; cB = nB; ++ui;
        if constexpr (GATHER) { _Pragma("unroll") for (int _h = 0; _h < 2; ++_h) { gA[_h][0] = gN[_h][0]; gA[_h][1] = gN[_h][1]; } }
        if constexpr (ALIGN_EPI) { if (wr == 1) PG8_BAR; }
    }
    PG8_WAIT_V(0);
    if constexpr (!ALIGN_EPI) { if (wr == 0) PG8_BAR; }
    PG8_BAR;
    if constexpr (Epi::AFTER_DRAIN) { E.fused(acc, cur, wr, wc, fr, fq, lds, wid, lane); S.done(cur); }
#undef PG8_SA
#undef PG8_SB
#undef PG8_STAGE
#undef PG8_STAGE_A
#undef PG8_GOFF
#undef PG8_LDA
#undef PG8_LDB
#undef PG8_MMA
#undef PG8_WAIT_V
#undef PG8_WAIT_L
#undef PG8_BAR
#undef PG8_SCHED
}
}
#define GAS __attribute__((address_space(1)))
#define LAS __attribute__((address_space(3)))
typedef unsigned short bf16;
typedef unsigned v4u __attribute__((ext_vector_type(4)));
typedef unsigned v2u __attribute__((ext_vector_type(2)));
typedef float f32x4 __attribute__((ext_vector_type(4)));
typedef short bf16x8 __attribute__((ext_vector_type(8)));
typedef GAS unsigned gu32;
typedef GAS unsigned long long gu64;
#define RLX_AGENT __ATOMIC_RELAXED, __HIP_MEMORY_SCOPE_AGENT
#define LDS_WAIT() asm volatile("s_waitcnt lgkmcnt(0)" ::: "memory")
#define VM_WAIT() asm volatile("s_waitcnt vmcnt(0)" ::: "memory")
typedef float f32x2_cv __attribute__((ext_vector_type(2)));
typedef __bf16 bf16x2_cv __attribute__((ext_vector_type(2)));
__device__ __forceinline__ unsigned pk2(float lo, float hi) { const f32x2_cv v = {lo, hi}; return __builtin_bit_cast(unsigned, __builtin_convertvector(v, bf16x2_cv)); }
__device__ __forceinline__ unsigned f2bf(float f) { return (unsigned)__builtin_bit_cast(unsigned short, (__bf16)f); }
__device__ __forceinline__ float bflo(unsigned w) { return __builtin_bit_cast(float, w << 16); }
__device__ __forceinline__ float bfhi(unsigned w) { return __builtin_bit_cast(float, w & 0xffff0000u); }
__device__ __forceinline__ float bf2f(bf16 b) { return __builtin_bit_cast(float, (unsigned)b << 16); }
__device__ __forceinline__ void unpack8(v4u w, float (&x)[8]) { x[0] = bflo(w.x); x[1] = bfhi(w.x); x[2] = bflo(w.y); x[3] = bfhi(w.y); x[4] = bflo(w.z); x[5] = bfhi(w.z); x[6] = bflo(w.w); x[7] = bfhi(w.w); }
__device__ __forceinline__ float wave_sum(float v) {
#pragma unroll
    for (int o = 1; o < 64; o <<= 1) v += __shfl_xor(v, o);
    return v;
}
__device__ __forceinline__ float sigmoidf_(float x) { return 1.f / (1.f + __expf(-x)); }

#define XB_TMO      128
#define XB_XCNT(j)  (256  + 64 * (j))
#define XB_XSUB(j)  (1280 + 64 * (j))
#define XB_XGEN(j)  (2304 + 64 * (j))
#define XB_TOP      3328
#define XB_TOPGEN   3392
#define XCD_BAR_WORDS 3456
#define XB_SPIN_CAP (1u << 22)

__device__ __forceinline__ unsigned xb_ld(unsigned* p)              { return __hip_atomic_load(p, __ATOMIC_RELAXED, __HIP_MEMORY_SCOPE_AGENT); }
__device__ __forceinline__ unsigned xb_add(unsigned* p, unsigned v) { return __hip_atomic_fetch_add(p, v, __ATOMIC_RELAXED, __HIP_MEMORY_SCOPE_AGENT); }
__device__ __forceinline__ unsigned xb_xcc_id() { return (unsigned)__builtin_amdgcn_s_getreg((3 << 11) | 20) & 0xFu; }
#define XB_SPIN(cond, bar) do { unsigned _sp = 0; while (cond) { __builtin_amdgcn_s_sleep(1); \
    if ((++_sp & 255u) == 0u) { if (xb_ld(&(bar)[XB_TMO])) break; if (_sp > XB_SPIN_CAP) { atomicAdd(&(bar)[XB_TMO], 1u); break; } } } } while (0)

struct XcdBarrier {
    unsigned* bar; unsigned x;
    volatile LAS unsigned* st;
};

__device__ __forceinline__ XcdBarrier xcd_barrier_post(unsigned* bar, volatile LAS unsigned* st) {
    XcdBarrier b; b.bar = bar; b.x = xb_xcc_id(); b.st = st;
    if (threadIdx.x == 0) (void)xb_add(&bar[XB_XCNT(b.x)], 1u);
    return b;
}
__device__ __forceinline__ void xcd_barrier_complete(unsigned* bar, unsigned x, unsigned& nloc, unsigned& nx) {
    const unsigned G = gridDim.x * gridDim.y * gridDim.z;
    unsigned sum, cnt, mine, sp = 0u;
    for (;;) {
        sum = 0u; cnt = 0u; mine = 0u;
#pragma unroll
        for (unsigned j = 0; j < 16; ++j) { const unsigned c = xb_ld(&bar[XB_XCNT(j)]); sum += c; cnt += (c > 0u) ? 1u : 0u; mine = (j == x) ? c : mine; }
        if (sum == G) break;
        __builtin_amdgcn_s_sleep(1);
        if ((++sp & 255u) == 0u) { if (xb_ld(&bar[XB_TMO])) break; if (sp > XB_SPIN_CAP) { atomicAdd(&bar[XB_TMO], 1u); break; } }
    }
    nloc = mine > 0u ? mine : 1u; nx = cnt > 0u ? cnt : 1u;
}

__device__ __forceinline__ void xcd_barrier(const XcdBarrier& b) {
    asm volatile("s_waitcnt vmcnt(0)" ::: "memory");
    __syncthreads();
    if (threadIdx.x == 0) {
        unsigned* bar = b.bar;
        __builtin_amdgcn_s_waitcnt(0);
        unsigned nloc = b.st[0], nx = b.st[1];
        if (nloc == 0u) { xcd_barrier_complete(bar, b.x, nloc, nx); b.st[0] = nloc; b.st[1] = nx; }
        const unsigned old = xb_add(&bar[XB_XSUB(b.x)], 1u);
        const unsigned gen = old / nloc;
        if (old + 1u == (gen + 1u) * nloc) {
            __builtin_amdgcn_fence(__ATOMIC_RELEASE, "agent");
            asm volatile("s_waitcnt vmcnt(0)" ::: "memory");
            const unsigned og = xb_add(&bar[XB_TOP], 1u);
            const unsigned tg = og / nx;
            if (og + 1u == (tg + 1u) * nx) xb_add(&bar[XB_TOPGEN], 1u);
            else XB_SPIN(xb_ld(&bar[XB_TOPGEN]) == tg, bar);
            __builtin_amdgcn_fence(__ATOMIC_ACQUIRE, "agent");
            xb_add(&bar[XB_XGEN(b.x)], 1u);
            asm volatile("s_waitcnt vmcnt(0)" ::: "memory");
        } else {
            XB_SPIN(xb_ld(&bar[XB_XGEN(b.x)]) == gen, bar);
            __builtin_amdgcn_fence(__ATOMIC_ACQUIRE, "agent");
            asm volatile("s_waitcnt vmcnt(0)" ::: "memory");
        }
    }
    __syncthreads();
}
#ifndef ATT_REL_ALL
#define ATT_REL_ALL 1
#endif
namespace att {
using s16x4  = __attribute__((ext_vector_type(4))) short;
using f32x16 = __attribute__((ext_vector_type(16))) float;
using u32x4  = __attribute__((ext_vector_type(4))) unsigned;
using f32x4  = __attribute__((ext_vector_type(4))) float;
#define ATT_SBAR() __builtin_amdgcn_sched_barrier(0)
constexpr float THR2 = 11.5f;
__device__ __forceinline__ int crow(int r, int hi) { return (r & 3) + 8 * (r >> 2) + 4 * hi; }
__device__ __forceinline__ unsigned cvtpk(float lo, float hi) { unsigned r; asm volatile("v_cvt_pk_bf16_f32 %0, %1, %2" : "=v"(r) : "v"(lo), "v"(hi)); return r; }

__device__ __forceinline__ void partialSM(f32x16& p0, f32x16& p1, float& m_reg, float& mn, float& alpha) {
  float pmax = p0[0];
#pragma unroll
  for (int r = 1; r < 16; ++r) pmax = fmaxf(pmax, p0[r]);
#pragma unroll
  for (int r = 0; r < 16; ++r) pmax = fmaxf(pmax, p1[r]);
  { auto rr = __builtin_amdgcn_permlane32_swap(__float_as_uint(pmax), __float_as_uint(pmax), false, false);
    pmax = fmaxf(__uint_as_float(rr[0]), __uint_as_float(rr[1])); }
  if (__builtin_expect(__all(pmax - m_reg <= THR2), 1)) { mn = m_reg; alpha = 1.f; }
  else { mn = fmaxf(m_reg, pmax); alpha = __builtin_amdgcn_exp2f(m_reg - mn); m_reg = mn; }
#pragma unroll
  for (int r = 0; r < 16; ++r) p0[r] = p0[r] - mn;
#pragma unroll
  for (int r = 0; r < 16; ++r) p1[r] = p1[r] - mn;
#pragma unroll
  for (int r = 0; r < 16; ++r) p0[r] = __builtin_amdgcn_exp2f(p0[r]);
}
__device__ __forceinline__ void finishSM_exp(f32x16& p1) {
#pragma unroll
  for (int r = 0; r < 16; ++r) p1[r] = __builtin_amdgcn_exp2f(p1[r]);
}
__device__ __forceinline__ void finishSM_pack(f32x16& p0, f32x16& p1, bf16x8& pa0, bf16x8& pa1, bf16x8& pa2, bf16x8& pa3) {
#define ATT_PK4(P, BASE, OUT) do { unsigned a0 = cvtpk(P[BASE + 0], P[BASE + 1]), a1 = cvtpk(P[BASE + 2], P[BASE + 3]);   \
    unsigned b0 = cvtpk(P[BASE + 4], P[BASE + 5]), b1 = cvtpk(P[BASE + 6], P[BASE + 7]);                              \
    auto r0 = __builtin_amdgcn_permlane32_swap(a0, b0, false, false); auto r1 = __builtin_amdgcn_permlane32_swap(a1, b1, false, false); \
    u32x4 w = {r0[0], r1[0], r0[1], r1[1]}; OUT = *reinterpret_cast<bf16x8*>(&w); } while (0)
  ATT_PK4(p0, 0, pa0); ATT_PK4(p0, 8, pa1); ATT_PK4(p1, 0, pa2); ATT_PK4(p1, 8, pa3);
#undef ATT_PK4
}
__device__ __forceinline__ void finishSM(f32x16& p0, f32x16& p1, bf16x8& pa0, bf16x8& pa1, bf16x8& pa2, bf16x8& pa3) { finishSM_exp(p1); finishSM_pack(p0, p1, pa0, pa1, pa2, pa3); }
template <int NB> __device__ __forceinline__ int v_st(int k, int c) { const int kk = (k & ~0xC) | ((k & 4) << 1) | ((k & 8) >> 1); return ((kk >> 3) * NB + (c >> 5)) * 512 + ((kk & 7) * 32 + (c & 31)) * 2; }
__device__ __forceinline__ int v_rd_base(int lane) { return ((lane & 3) << 3) | (((lane >> 2) & 3) << 6) | (((lane >> 4) & 1) << 5) | (((lane >> 5) & 1) << 8); }
template <int OFF> __device__ __forceinline__ s16x4 tr_read(int vb) {
  s16x4 r; asm volatile("ds_read_b64_tr_b16 %0, %1 offset:%2" : "=&v"(r) : "v"(vb), "i"(OFF) : "memory"); return r;
}
template <int NB, int D0, int VO> __device__ __forceinline__ void pv_rd(s16x4 (&f)[8], int vb) {
#define ATT_VOFF(ks, half) (VO + D0 * 512 + (ks) * (NB * 1024) + (half) * (NB * 512))
  f[0] = tr_read<ATT_VOFF(0, 0)>(vb); f[1] = tr_read<ATT_VOFF(0, 1)>(vb); f[2] = tr_read<ATT_VOFF(1, 0)>(vb); f[3] = tr_read<ATT_VOFF(1, 1)>(vb);
  f[4] = tr_read<ATT_VOFF(2, 0)>(vb); f[5] = tr_read<ATT_VOFF(2, 1)>(vb); f[6] = tr_read<ATT_VOFF(3, 0)>(vb); f[7] = tr_read<ATT_VOFF(3, 1)>(vb);
#undef ATT_VOFF
}
__device__ __forceinline__ void pv_mm(f32x16& od, const s16x4 (&f)[8], bf16x8 pa0, bf16x8 pa1, bf16x8 pa2, bf16x8 pa3) {
#define ATT_PK(L, H) (bf16x8){L[0], L[1], L[2], L[3], H[0], H[1], H[2], H[3]}
  od = __builtin_amdgcn_mfma_f32_32x32x16_bf16(pa0, ATT_PK(f[0], f[1]), od, 0, 0, 0);
  od = __builtin_amdgcn_mfma_f32_32x32x16_bf16(pa1, ATT_PK(f[2], f[3]), od, 0, 0, 0);
  od = __builtin_amdgcn_mfma_f32_32x32x16_bf16(pa2, ATT_PK(f[4], f[5]), od, 0, 0, 0);
  od = __builtin_amdgcn_mfma_f32_32x32x16_bf16(pa3, ATT_PK(f[6], f[7]), od, 0, 0, 0);
#undef ATT_PK
}
template <int NB, int D0, int HALF, int VO> __device__ __forceinline__ void pv_rdh(s16x4 (&g)[4], int vb) {
#define ATT_VOFF(ks, half) (VO + D0 * 512 + (ks) * (NB * 1024) + (half) * (NB * 512))
  g[0] = tr_read<ATT_VOFF(2 * HALF, 0)>(vb); g[1] = tr_read<ATT_VOFF(2 * HALF, 1)>(vb); g[2] = tr_read<ATT_VOFF(2 * HALF + 1, 0)>(vb); g[3] = tr_read<ATT_VOFF(2 * HALF + 1, 1)>(vb);
#undef ATT_VOFF
}
__device__ __forceinline__ void pv_mmh(f32x16& od, const s16x4 (&g)[4], bf16x8 px, bf16x8 py) {
#define ATT_PK(L, H) (bf16x8){L[0], L[1], L[2], L[3], H[0], H[1], H[2], H[3]}
  od = __builtin_amdgcn_mfma_f32_32x32x16_bf16(px, ATT_PK(g[0], g[1]), od, 0, 0, 0);
  od = __builtin_amdgcn_mfma_f32_32x32x16_bf16(py, ATT_PK(g[2], g[3]), od, 0, 0, 0);
#undef ATT_PK
}
#define ATT_LWAIT(n) do { asm volatile("s_waitcnt lgkmcnt(" #n ")" ::: "memory"); ATT_SBAR(); } while (0)
template <int NB, int VO, bool SM, bool REL> __device__ __forceinline__ void pv_sm(f32x16* o, f32x4& lsum, bf16x8 sel, int vb, bf16x8 pa0, bf16x8 pa1, bf16x8 pa2, bf16x8 pa3,
                                                                         f32x16& n0, f32x16& n1, float& m_reg, float& mn, float& alpha, f32x16& negm) {
  float pmax = 0.f;
#define ATT_LSUM() do { lsum = __builtin_amdgcn_mfma_f32_16x16x32_bf16(sel, pa0, lsum, 0, 0, 0); lsum = __builtin_amdgcn_mfma_f32_16x16x32_bf16(sel, pa1, lsum, 0, 0, 0); \
    lsum = __builtin_amdgcn_mfma_f32_16x16x32_bf16(sel, pa2, lsum, 0, 0, 0); lsum = __builtin_amdgcn_mfma_f32_16x16x32_bf16(sel, pa3, lsum, 0, 0, 0); } while (0)
#define ATT_PMAX() do { if constexpr (SM) { pmax = n0[0]; \
    _Pragma("unroll") for (int r = 1; r < 16; ++r) pmax = fmaxf(pmax, n0[r]); \
    _Pragma("unroll") for (int r = 0; r < 16; ++r) pmax = fmaxf(pmax, n1[r]); \
    auto rr = __builtin_amdgcn_permlane32_swap(__float_as_uint(pmax), __float_as_uint(pmax), false, false); \
    pmax = fmaxf(__uint_as_float(rr[0]), __uint_as_float(rr[1])); } } while (0)
#define ATT_THR() do { if constexpr (SM && !REL) { \
      if (__builtin_expect(__all(pmax - m_reg <= THR2), 1)) { mn = m_reg; alpha = 1.f; } \
      else { mn = fmaxf(m_reg, pmax); alpha = __builtin_amdgcn_exp2f(m_reg - mn); m_reg = mn; } } \
    if constexpr (SM && REL) { \
      if (__builtin_expect(__all(pmax <= THR2), 1)) { alpha = 1.f; } \
      else { const float d = fmaxf(pmax, 0.f); alpha = __builtin_amdgcn_exp2f(-d); \
        _Pragma("unroll") for (int r = 0; r < 16; ++r) { n0[r] -= d; n1[r] -= d; negm[r] -= d; } } } } while (0)
  if constexpr (NB == 4) {
    s16x4 b0[4], b1[4], b2[4];
    pv_rdh<NB, 0, 0, VO>(b0, vb); pv_rdh<NB, 0, 1, VO>(b1, vb); pv_rdh<NB, 1, 0, VO>(b2, vb);
    ATT_LSUM(); ATT_PMAX();
    ATT_LWAIT(8); pv_mmh(o[0], b0, pa0, pa1); pv_rdh<NB, 1, 1, VO>(b0, vb);
    ATT_THR();
    if constexpr (SM && !REL) {
#pragma unroll
      for (int r = 0; r < 16; ++r) n0[r] = n0[r] - mn; }
    ATT_LWAIT(8); pv_mmh(o[0], b1, pa2, pa3); pv_rdh<NB, 2, 0, VO>(b1, vb);
    if constexpr (SM && !REL) {
#pragma unroll
      for (int r = 0; r < 16; ++r) n1[r] = n1[r] - mn; }
    ATT_LWAIT(8); pv_mmh(o[1], b2, pa0, pa1); pv_rdh<NB, 2, 1, VO>(b2, vb);
    ATT_LWAIT(8); pv_mmh(o[1], b0, pa2, pa3); pv_rdh<NB, 3, 0, VO>(b0, vb);
    if constexpr (SM) {
#pragma unroll
      for (int r = 0; r < 4; ++r) n0[r] = __builtin_amdgcn_exp2f(n0[r]); }
    ATT_LWAIT(8); pv_mmh(o[2], b1, pa0, pa1); pv_rdh<NB, 3, 1, VO>(b1, vb);
    if constexpr (SM) {
#pragma unroll
      for (int r = 4; r < 8; ++r) n0[r] = __builtin_amdgcn_exp2f(n0[r]); }
    ATT_LWAIT(8); pv_mmh(o[2], b2, pa2, pa3);
    if constexpr (SM) {
#pragma unroll
      for (int r = 8; r < 12; ++r) n0[r] = __builtin_amdgcn_exp2f(n0[r]); }
    ATT_LWAIT(4); pv_mmh(o[3], b0, pa0, pa1);
    if constexpr (SM) {
#pragma unroll
      for (int r = 12; r < 16; ++r) n0[r] = __builtin_amdgcn_exp2f(n0[r]); }
    ATT_LWAIT(0); pv_mmh(o[3], b1, pa2, pa3);
  } else {
    s16x4 fa[8], fb[8];
    pv_rd<NB, 0, VO>(fa, vb); pv_rd<NB, 1, VO>(fb, vb);
    ATT_LSUM(); ATT_PMAX();
    ATT_LWAIT(8); pv_mm(o[0], fa, pa0, pa1, pa2, pa3);
    ATT_THR();
    if constexpr (SM && !REL) {
#pragma unroll
      for (int r = 0; r < 16; ++r) { n0[r] = n0[r] - mn; n1[r] = n1[r] - mn; } }
    ATT_LWAIT(0); pv_mm(o[1], fb, pa0, pa1, pa2, pa3);
    if constexpr (SM) {
#pragma unroll
      for (int r = 0; r < 16; ++r) n0[r] = __builtin_amdgcn_exp2f(n0[r]); }
  }
#undef ATT_LSUM
#undef ATT_PMAX
#undef ATT_THR
}
template <int DK, bool REL, int LO, int HI> __device__ __forceinline__ void qkt_part(f32x16& p0, f32x16& p1, LAS const char* Kt, const int (&ka)[DK / 16], const bf16x8* qr, const f32x16& negm) {
  if constexpr (!REL && LO == 0) { p0 = f32x16{}; p1 = f32x16{}; }
#pragma unroll
  for (int d0 = LO; d0 < HI; ++d0) {
    const bf16x8 b0 = *(LAS const bf16x8*)(Kt + ka[d0]);
    const bf16x8 b1 = *(LAS const bf16x8*)(Kt + ka[d0] + (d0 < 4 ? 4096 : 2048));
    p0 = __builtin_amdgcn_mfma_f32_32x32x16_bf16(b0, qr[d0], (REL && d0 == 0) ? negm : p0, 0, 0, 0);
    p1 = __builtin_amdgcn_mfma_f32_32x32x16_bf16(b1, qr[d0], (REL && d0 == 0) ? negm : p1, 0, 0, 0); }
}
template <int DK, bool REL> __device__ __forceinline__ void qkt(f32x16& p0, f32x16& p1, LAS const char* Kt, const int (&ka)[DK / 16], const bf16x8* qr, const f32x16& negm) {
  qkt_part<DK, REL, 0, DK / 16>(p0, p1, Kt, ka, qr, negm);
}
template <int DK, int DV> struct Cfg {
  static constexpr int KT = 64 * DK * 2, NB = DV / 32, VT = 64 * DV * 2, NQ = DK / 16;
  static constexpr int KN = DK / 64 + (DK % 64 != 0), VN = (64 * DV / 8) / 512;
  static constexpr int NS = 4;
  static constexpr int OFF_K = 0, OFF_V = NS * KT, OFF_WS = NS * (KT + VT), LDS_BYTES = OFF_WS + 8 * 64 * 4;
};
template <int DK, int DV>
__device__ __forceinline__ void attn_unit(const bf16* __restrict__ Qb, int ldq, const bf16* __restrict__ K1, int ldk1, const bf16* __restrict__ K2, int ldk2,
                                          const bf16* __restrict__ Vh, int ldv, float* __restrict__ Ob, int ldo, int nkeys, LAS char* lds) {
  using C = Cfg<DK, DV>;
  const int tid = threadIdx.x, wid = __builtin_amdgcn_readfirstlane(tid >> 6), lane = tid & 63, r32 = lane & 31, hi = lane >> 5;
  LAS float* ws = (LAS float*)(lds + C::OFF_WS) + wid * 64; LAS float* al_l = ws + 32;
  constexpr bool REL = ATT_REL_ALL || (DV == 64);
  float m_reg = -1e30f; f32x16 negm = {}; f32x16 o[C::NB] = {}; f32x4 lsum = {}; bf16x8 qr[C::NQ];
  bf16x8 sel; { const int i_ = lane & 15, kq_ = lane >> 4; const unsigned v_ = ((i_ == 0 && !(kq_ & 1)) || (i_ == 1 && (kq_ & 1))) ? 0x3F803F80u : 0u; u32x4 w_ = {v_, v_, v_, v_}; sel = *reinterpret_cast<bf16x8*>(&w_); }
  { const bf16* Qw = Qb + (long)(wid * 32 + r32) * ldq + hi * 8;
#pragma unroll
    for (int d0 = 0; d0 < C::NQ; ++d0) qr[d0] = *(const bf16x8*)(Qw + d0 * 16); }
  unsigned kg0, kg1 = 0, vg[C::VN];
  { const int row = tid >> 3, cp = tid & 7; kg0 = (unsigned)(row * ldk1 + ((cp ^ ((row >> 1) & 7)) * 8)); }
  if constexpr (C::KN == 2) { const int p = tid & 255, row = p >> 2, cp = p & 3; kg1 = (unsigned)(row * ldk2 + ((cp ^ ((row >> 2) & 3)) * 8)); }
#pragma unroll
  for (int i = 0; i < C::VN; ++i) { const int p = i * 512 + tid, st = p >> 5, wi = p & 31, kk = (st / C::NB) * 8 + (wi >> 2), col = (st % C::NB) * 32 + (wi & 3) * 8;
    const int k = (kk & ~0xC) | ((kk & 4) << 1) | ((kk & 8) >> 1); vg[i] = (unsigned)(k * ldv + col); }
  int ka[C::NQ];
#pragma unroll
  for (int d0 = 0; d0 < C::NQ; ++d0) ka[d0] = (d0 < 4) ? r32 * 128 + ((((d0 * 2) ^ hi ^ ((r32 >> 1) & 7)) & 7) << 4) : 8192 + r32 * 64 + (((((d0 - 4) * 2) ^ hi ^ ((r32 >> 2) & 3)) & 3) << 4);
  const int vb0 = (int)(uintptr_t)(lds + C::OFF_V) + v_rd_base(lane);
  const bool p3 = (C::KN == 1) || wid < 4;
#define ATT_ISSUE(S, t) do { const size_t t64_ = (size_t)(t) * 64; \
    __builtin_amdgcn_global_load_lds((const unsigned*)(K1 + t64_ * ldk1 + kg0), (LAS unsigned*)(lds + C::OFF_K + (S) * C::KT + wid * 1024), 16, 0, 0); \
    if constexpr (C::KN == 2) { if (wid < 4) __builtin_amdgcn_global_load_lds((const unsigned*)(K2 + t64_ * ldk2 + kg1), (LAS unsigned*)(lds + C::OFF_K + (S) * C::KT + 8192 + wid * 1024), 16, 0, 0); } \
    _Pragma("unroll") for (int i_ = 0; i_ < C::VN; ++i_) __builtin_amdgcn_global_load_lds((const unsigned*)(Vh + t64_ * ldv + vg[i_]), (LAS unsigned*)(lds + C::OFF_V + (S) * C::VT + (i_ * 512 + wid * 64) * 16), 16, 0, 0); } while (0)
#define ATT_LAND1() do { if (p3) asm volatile("s_waitcnt vmcnt(3)" ::: "memory"); else asm volatile("s_waitcnt vmcnt(2)" ::: "memory"); } while (0)
#define ATT_LAND2() do { if (p3) asm volatile("s_waitcnt vmcnt(6)" ::: "memory"); else asm volatile("s_waitcnt vmcnt(4)" ::: "memory"); } while (0)
#define ATT_RESC(a) do { if (__any((a) < 1.f)) { if (hi == 0) al_l[r32] = (a); asm volatile("s_waitcnt lgkmcnt(0)" ::: "memory"); \
    lsum[0] *= al_l[lane & 15]; lsum[1] *= al_l[16 + (lane & 15)]; \
    _Pragma("unroll") for (int r = 0; r < 16; ++r) { const float f_ = al_l[crow(r, hi)]; _Pragma("unroll") for (int d = 0; d < C::NB; ++d) o[d][r] *= f_; } } } while (0)
  static_assert(C::KN + C::VN == 3 && C::NS == 4, "three (two on waves 4..7 when DK = 96) DMA pieces per thread per tile; slot = tile & 3");
#define ATT_STEP(S, t, C0, C1, N0, N1, mnN, alN, LAST) do { ATT_SBAR(); \
    { const int ti_ = ((t) + 3 < NT) ? (t) + 3 : NT - 1; ATT_ISSUE(((S) + 3) & 3, ti_); } ATT_SBAR(); \
    if constexpr (!(LAST)) qkt_part<DK, REL, 0, C::NQ / 2>(N0, N1, lds + C::OFF_K + (((S) + 1) & 3) * C::KT, ka, qr, negm); \
    finishSM_exp(C1); ATT_SBAR(); \
    if constexpr (!(LAST)) qkt_part<DK, REL, C::NQ / 2, C::NQ>(N0, N1, lds + C::OFF_K + (((S) + 1) & 3) * C::KT, ka, qr, negm); \
    finishSM_pack(C0, C1, pa0, pa1, pa2, pa3); ATT_SBAR(); \
    pv_sm<C::NB, (S) * C::VT, !(LAST), REL>(o, lsum, sel, vb0, pa0, pa1, pa2, pa3, N0, N1, m_reg, mnN, alN, negm); ATT_SBAR(); \
    if constexpr (!(LAST)) { ATT_RESC(alN); } \
    ATT_LAND1(); __builtin_amdgcn_s_barrier(); } while (0)
  f32x16 pA0, pA1, pB0, pB1; float mnA, mnB, alA, alB; bf16x8 pa0, pa1, pa2, pa3; const int NT = nkeys / 64;
  asm volatile("s_waitcnt vmcnt(0) lgkmcnt(0)" ::: "memory"); __builtin_amdgcn_s_barrier();
  ATT_ISSUE(0, 0); ATT_ISSUE(1, 1); ATT_ISSUE(2, 2);
  ATT_LAND2(); __builtin_amdgcn_s_barrier();
  qkt<DK, REL>(pA0, pA1, lds + C::OFF_K, ka, qr, negm);
  partialSM(pA0, pA1, m_reg, mnA, alA);
  if constexpr (REL) {
#pragma unroll
    for (int r = 0; r < 16; ++r) negm[r] = -m_reg; }
  ATT_LAND1(); __builtin_amdgcn_s_barrier();
  int t = 0;
  for (; t + 4 < NT; t += 4) {
    ATT_STEP(0, t,     pA0, pA1, pB0, pB1, mnB, alB, false);
    ATT_STEP(1, t + 1, pB0, pB1, pA0, pA1, mnA, alA, false);
    ATT_STEP(2, t + 2, pA0, pA1, pB0, pB1, mnB, alB, false);
    ATT_STEP(3, t + 3, pB0, pB1, pA0, pA1, mnA, alA, false);
  }
  ATT_STEP(0, t,     pA0, pA1, pB0, pB1, mnB, alB, false);
  ATT_STEP(1, t + 1, pB0, pB1, pA0, pA1, mnA, alA, false);
  ATT_STEP(2, t + 2, pA0, pA1, pB0, pB1, mnB, alB, false);
  ATT_STEP(3, t + 3, pB0, pB1, pA0, pA1, mnA, alA, true);
  asm volatile("s_waitcnt vmcnt(0)" ::: "memory");
  float rli[16];
  if (lane < 16) { al_l[lane] = lsum[0]; al_l[16 + lane] = lsum[1]; }
  asm volatile("s_waitcnt lgkmcnt(0)" ::: "memory");
#pragma unroll
  for (int r = 0; r < 16; ++r) rli[r] = __builtin_amdgcn_rcpf(al_l[crow(r, hi)]);
  float* Ow = Ob + (long)(wid * 32) * ldo;
#pragma unroll
  for (int r = 0; r < 16; ++r) { const int orow = crow(r, hi);
#pragma unroll
    for (int d0 = 0; d0 < C::NB; ++d0) Ow[(long)orow * ldo + d0 * 32 + r32] = o[d0][r] * rli[r]; }
#undef ATT_ISSUE
#undef ATT_LAND1
#undef ATT_LAND2
#undef ATT_RESC
#undef ATT_STEP
}
}
constexpr int DM = 1024, NBATCH = 2, SEQ = 16384, CT = 256, TB = SEQ + CT  , R = NBATCH * TB  ;
constexpr int ATT_IN = 2208, ATT_NP = 2304, REC_IN = 3472, REC_NP = 3584, RWKV_IN = 1920;
constexpr int NE = 32, TOPK = 4, MAXT = R * TOPK / 256 + NE  , MAXROWS = MAXT * 256;
constexpr int NUNIT_M = 16 * 260;
constexpr float NORM_EPS = 1e-6f;
enum { I_X = 0, I_C, I_CTX, I_CCTX, I_NMIX, I_NFFN, I_ADAW, I_ADAB, I_WOUT, I_RW, I_RB, I_W1, I_B1, I_W2, I_B2, I_ATTW, I_LAM, I_SUBLN, I_QNW, I_KVNW, I_WUQ, I_WUKV,
       I_RECW, I_MU, I_W0, I_RW2, I_A0, I_A2, I_G2, I_KK, I_KA, I_RK, I_LNW, I_LNB, I_GATEB, I_MNW, I_FNW, N_IN };
constexpr size_t al256(size_t x) { return (x + 255) & ~(size_t)255; }
constexpr size_t WS_CTL = 0, CTL_ZERO_BYTES = 1u << 20;
constexpr size_t WS_MOD = CTL_ZERO_BYTES;
constexpr size_t WS_ROPE = al256(WS_MOD + 2 * 3 * 6144 * 4);
constexpr size_t ROPE_DR = 0, ROPE_DC = 256 * 16 * 2, ROPE_MR = ROPE_DC + 64 * 16 * 2, ROPE_MC = ROPE_MR + 256 * 8 * 2, ROPE_FLOATS = ROPE_MC + 64 * 8 * 2;
constexpr size_t WS_WRH = al256(WS_ROPE + ROPE_FLOATS * 4);
constexpr size_t WS_WRL = al256(WS_WRH + (size_t)2 * 32 * 1024 * 2);
constexpr size_t WS_WIN0 = al256(WS_WRL + (size_t)2 * 32 * 1024 * 2);
constexpr size_t WS_WUQ = al256(WS_WIN0 + (size_t)ATT_NP * 1024 * 2);
constexpr size_t WS_WUKV = al256(WS_WUQ + (size_t)768 * 384 * 2);
constexpr size_t WS_WOUT = al256(WS_WUKV + (size_t)1024 * 256 * 2);
constexpr size_t WS_WREC = al256(WS_WOUT + (size_t)2 * 1024 * 1024 * 2);
constexpr size_t WS_WLORA = al256(WS_WREC + (size_t)REC_NP * 1024 * 2);
constexpr size_t WS_W1T = al256(WS_WLORA + (size_t)2560 * 384 * 2);
constexpr size_t WS_W2T = al256(WS_W1T + (size_t)NE * 2048 * 1024 * 2);
constexpr size_t WS_H = al256(WS_W2T + (size_t)NE * 1024 * 1024 * 2);
constexpr size_t WS_A = al256(WS_H + (size_t)R * 1024 * 4);
constexpr size_t WS_A1 = al256(WS_A + (size_t)R * 1024 * 2);
constexpr size_t WS_F = al256(WS_A1 + (size_t)R * 1024 * 2);
constexpr size_t WS_P = al256(WS_F + (size_t)R * 1024 * 2);
constexpr size_t WS_TOPE = al256(WS_P + (size_t)R * REC_NP * 2);
constexpr size_t WS_GATE = al256(WS_TOPE + (size_t)R * 16);
constexpr size_t WS_POS = al256(WS_GATE + (size_t)R * 16);
constexpr size_t WS_DEST = al256(WS_POS + (size_t)R * 16);
constexpr size_t WS_TILE = al256(WS_DEST + (size_t)R * 16);
constexpr size_t WS_SRC = al256(WS_TILE + (size_t)(MAXT + 8) * 4);
constexpr size_t WS_T = al256(WS_SRC + (size_t)MAXROWS * 4);
constexpr size_t WS_QD = WS_T;
constexpr size_t WS_KD = al256(WS_QD + (size_t)R * 512 * 2);
constexpr size_t WS_CQN = al256(WS_KD + (size_t)R * 512 * 2);
constexpr size_t WS_CKVN = al256(WS_CQN + (size_t)R * 384 * 2);
constexpr size_t WS_MQ = al256(WS_CKVN + (size_t)R * 256 * 2);
constexpr size_t WS_MKV = al256(WS_MQ + (size_t)R * 768 * 2);
constexpr size_t WS_KRR = al256(WS_MKV + (size_t)R * 1024 * 2);
constexpr size_t WS_ODIFF = al256(WS_KRR + (size_t)R * 32 * 2);
constexpr size_t WS_OMLA = al256(WS_ODIFF + (size_t)R * 1024 * 4);
constexpr size_t WS_T0_END = al256(WS_OMLA + (size_t)R * 512 * 4);
constexpr size_t WS_XS = WS_T;
constexpr size_t WS_HS = al256(WS_XS + (size_t)MAXROWS * 1024 * 2);
constexpr size_t WS_TM_END = al256(WS_HS + (size_t)MAXROWS * 1024 * 2);
constexpr size_t SZ_RC = (size_t)R * 512 * 4;
constexpr size_t WS_RR = WS_T, WS_VV = WS_RR + SZ_RC, WS_AKK = WS_VV + SZ_RC, WS_KL = WS_AKK + SZ_RC;
constexpr size_t WS_WDEC = WS_KL + SZ_RC  , WS_KDIR = WS_WDEC + 2 * SZ_RC  , WS_BB = WS_KDIR + 2 * SZ_RC  , WS_GG = WS_BB + 2 * SZ_RC;
constexpr size_t WS_ALORA = al256(WS_GG + SZ_RC);
constexpr size_t WS_YR = al256(WS_ALORA + (size_t)R * 384 * 2);
constexpr size_t WS_DC = WS_YR;
constexpr size_t WS_HM = al256(WS_YR + 2 * SZ_RC);
constexpr size_t WS_CST = al256(WS_HM + 2 * SZ_RC);
constexpr size_t WS_DN = al256(WS_CST + (size_t)NUNIT_M * 8192 * 4);
constexpr size_t WS_NST = al256(WS_DN + (size_t)NUNIT_M * 64 * 4);
constexpr size_t WS_SC = al256(WS_NST + (size_t)NUNIT_M * 64 * 4);
constexpr size_t WS_MST = al256(WS_SC + (size_t)NUNIT_M * 2 * 4);
constexpr size_t WS_ASIG = WS_KDIR;
constexpr size_t WS_YB = WS_BB;
constexpr int NUNIT_R = 32 * 260;
constexpr size_t WS_RKM = WS_KDIR + SZ_RC;
static_assert((size_t)NUNIT_R * 4096 * 2 <= SZ_RC, "M^T fits in KL");
constexpr size_t WS_RKQ = al256(WS_MST + (size_t)NUNIT_M * 4);
constexpr size_t WS_RKZ = al256(WS_RKQ + (size_t)NUNIT_R * 4096 * 2);
constexpr size_t WS_T1_END = al256(WS_RKZ + (size_t)NUNIT_R * 4096 * 2);
constexpr size_t WS_END = WS_T1_END > WS_TM_END ? (WS_T1_END > WS_T0_END ? WS_T1_END : WS_T0_END) : (WS_TM_END > WS_T0_END ? WS_TM_END : WS_T0_END);
static_assert(WS_END <= (size_t)2147483648ull, "workspace map exceeds 2 GiB");
constexpr int CW_CNT = 1024;
constexpr int CW_BAR = 4096;
constexpr int RING_BYTES = 131072, AUX_OFF = 131072, AUX_BYTES = 16384, MISC_OFF = 147456, LDS_BYTES = 163840;

struct Frame {
    LAS unsigned char* lds; gu32* ctl; int tid, lane, wave, blk, G, probe;
    float* out; unsigned char* ws;
    struct InTab { LAS const unsigned* t;
        __device__ __forceinline__ const float* operator[](int i) const { const unsigned lo = __builtin_amdgcn_readfirstlane(t[2 * i]), hi = __builtin_amdgcn_readfirstlane(t[2 * i + 1]);
            return (const float*)(((unsigned long long)hi << 32) | lo); } } in;
};
template <class T> __device__ __forceinline__ T* wsp(const Frame& F, size_t off) { return (T*)(F.ws + off); }
__device__ __forceinline__ int row_sel(int row) { const int b = row / TB, t = row - b * TB; return t < CT ? 2 : b; }
__device__ __forceinline__ const float* h0_row(const Frame& F, int row) {
    const int b = row / TB, t = row - b * TB;
    return t < CT ? F.in[I_CTX] + ((size_t)b * CT + t) * DM : F.in[I_X] + ((size_t)b * SEQ + (t - CT)) * DM;
}
__device__ __forceinline__ const float* modp(const Frame& F, int layer, int sel, int chunk) { return wsp<const float>(F, WS_MOD) + ((size_t)(layer * 3 + sel) * 6 + chunk) * DM; }
__device__ __forceinline__ int scan_tok(int z, int sg) { return z == 0 ? sg : (sg < CT ? CT - 1 - sg : TB + CT - 1 - sg); }
__device__ __forceinline__ void tr_item(const float* W, int K, int N, bf16* WT, int row_off, LAS float* scr, int kb, int nb, int lane) {
    const int k0 = 64 * kb, n0 = 32 * nb;
    const int n = n0 + (lane & 31);
    float tv[32];
#pragma unroll
    for (int i = 0; i < 32; ++i) { const int kk = 2 * i + (lane >> 5); tv[i] = (n < N) ? W[(size_t)(k0 + kk) * N + n] : 0.f; }
#pragma unroll
    for (int i = 0; i < 32; ++i) { const int kk = 2 * i + (lane >> 5); scr[kk * 33 + (lane & 31)] = tv[i]; }
    LDS_WAIT(); asm volatile("" ::: "memory");
    const int c = lane & 7;
#pragma unroll
    for (int j = 0; j < 4; ++j) { const int nn = (lane >> 3) + 8 * j; const LAS float* s = scr + (8 * c) * 33 + nn;
        v4u o; o.x = pk2(s[0 * 33], s[1 * 33]); o.y = pk2(s[2 * 33], s[3 * 33]); o.z = pk2(s[4 * 33], s[5 * 33]); o.w = pk2(s[6 * 33], s[7 * 33]);
        *(v4u*)(WT + (size_t)(row_off + n0 + nn) * K + k0 + 8 * c) = o; }
    LDS_WAIT(); asm volatile("" ::: "memory");
}
__device__ __forceinline__ void tr_family(const Frame& F, const float* W, size_t src_stride, int nmat, int K, int N, int Npad, bf16* WT, int gw, int NGW) {
    LAS float* scr = (LAS float*)(F.lds + F.wave * 16384);
    const int nkb = K / 64, nnb = Npad / 32, per = nkb * nnb, total = per * nmat;
    for (int it = gw; it < total; it += NGW) { const int m = it / per, r = it - m * per, kb = r / nnb, nb = r - kb * nnb;
        tr_item(W + (size_t)m * src_stride, K, N, WT, m * Npad, scr, kb, nb, F.lane); }
}
__device__ __forceinline__ void moe_weights_convert(const Frame& F, int layer, int gw, int NGW) {
    tr_family(F, F.in[I_W1] + (size_t)layer * NE * 1024 * 2048, (size_t)1024 * 2048, NE, 1024, 2048, 2048, wsp<bf16>(F, WS_W1T), gw, NGW);
    tr_family(F, F.in[I_W2] + (size_t)layer * NE * 1024 * 1024, (size_t)1024 * 1024, NE, 1024, 1024, 1024, wsp<bf16>(F, WS_W2T), gw, NGW);
}
__device__ __forceinline__ void norm_mod_row(const Frame& F, const float* src, const float* nw, const float* shift, const float* scale, bf16* orow) {
    const f32x4* xr = (const f32x4*)src + F.lane;
    f32x4 v[4]; float s = 0.f;
#pragma unroll
    for (int j = 0; j < 4; ++j) { v[j] = xr[64 * j]; s += (v[j].x * v[j].x + v[j].y * v[j].y) + (v[j].z * v[j].z + v[j].w * v[j].w); }
    const float rs = 1.f / sqrtf(wave_sum(s) * (1.f / DM) + NORM_EPS);
    unsigned long long* o8 = (unsigned long long*)orow + F.lane;
#pragma unroll
    for (int j = 0; j < 4; ++j) { const f32x4 w = ((const f32x4*)nw)[F.lane + 64 * j], sh = ((const f32x4*)shift)[F.lane + 64 * j], sc = ((const f32x4*)scale)[F.lane + 64 * j];
        const f32x4 y = v[j] * rs * w * (sc + 1.f) + sh;
        o8[64 * j] = (unsigned long long)pk2(y.x, y.y) | ((unsigned long long)pk2(y.z, y.w) << 32); }
}
__device__ __forceinline__ void p0a(const Frame& F) {
    LAS float* sv = (LAS float*)F.lds; LAS float* red = (LAS float*)(F.lds + 16384);
    for (int i = F.tid; i < 3 * DM; i += 512) { const int s = i / DM, k = i - s * DM; const float cv = (s < 2) ? F.in[I_C][s * DM + k] : F.in[I_CCTX][k]; sv[i] = cv / (1.f + __expf(-cv)); }
    __syncthreads();
    for (int it = F.blk; it < 192; it += F.G) {
        const int l = it / 96, cgp = it - l * 96, kq = F.tid >> 4, cg = F.tid & 15, col = cgp * 64 + cg * 4;
        float acc[3][4];
#pragma unroll
        for (int s = 0; s < 3; ++s)
#pragma unroll
            for (int j = 0; j < 4; ++j) acc[s][j] = 0.f;
        const float* W = F.in[I_ADAW] + (size_t)l * DM * 6144 + col;
#pragma unroll 16
        for (int kk = 0; kk < 32; ++kk) { const int k = kq * 32 + kk; const f32x4 w = *(const f32x4*)(W + (size_t)k * 6144);
            const float s0 = sv[k], s1 = sv[DM + k], s2 = sv[2 * DM + k];
#pragma unroll
            for (int j = 0; j < 4; ++j) { acc[0][j] += s0 * w[j]; acc[1][j] += s1 * w[j]; acc[2][j] += s2 * w[j]; } }
#pragma unroll
        for (int s = 0; s < 3; ++s)
#pragma unroll
            for (int j = 0; j < 4; ++j) red[(kq * 16 + cg) * 12 + s * 4 + j] = acc[s][j];
        __syncthreads();
        if (F.tid < 192) { const int s = F.tid / 64, cc = F.tid - s * 64, cg2 = cc >> 2, j = cc & 3; float t = 0.f;
            for (int q = 0; q < 32; ++q) t += red[(q * 16 + cg2) * 12 + s * 4 + j];
            wsp<float>(F, WS_MOD)[(size_t)(l * 3 + s) * 6144 + cgp * 64 + cc] = t + F.in[I_ADAB][l * 6144 + cgp * 64 + cc]; }
        __syncthreads();
    }
    const int gid = F.blk * 512 + F.tid, GT = F.G * 512;
    float* rope = wsp<float>(F, WS_ROPE);
    for (int i = gid; i < 256 * 16 + 64 * 16 + 256 * 8 + 64 * 8; i += GT) {
        int j = i; float pos, inv; size_t off;
        if (j < 256 * 16) { pos = (float)(j / 16); inv = powf(10000.f, -(float)(j % 16) / 16.f); off = ROPE_DR + (size_t)j * 2; }
        else if ((j -= 256 * 16) < 64 * 16) { pos = (float)(j / 16); inv = powf(10000.f, -(float)(j % 16) / 16.f); off = ROPE_DC + (size_t)j * 2; }
        else if ((j -= 64 * 16) < 256 * 8) { pos = (float)(j / 8); inv = powf(10000.f, -(float)(j % 8) / 8.f); off = ROPE_MR + (size_t)j * 2; }
        else { j -= 256 * 8; pos = (float)(j / 8); inv = powf(10000.f, -(float)(j % 8) / 8.f); off = ROPE_MC + (size_t)j * 2; }
        const float ang = pos * inv; rope[off] = cosf(ang); rope[off + 1] = sinf(ang);
    }
    { bf16* wh = wsp<bf16>(F, WS_WRH); bf16* wl = wsp<bf16>(F, WS_WRL); for (int i = gid; i < 2 * 32 * 1024; i += GT) { const int k = i & 1023, e = (i >> 10) & 31, l = i >> 15; const float wv = F.in[I_RW][((size_t)l * DM + k) * NE + e];
        const unsigned hb = f2bf(wv); wh[i] = (bf16)hb; wl[i] = (bf16)f2bf(wv - bf2f((bf16)hb)); } }
    bf16* WL = wsp<bf16>(F, WS_WLORA);
    for (int i = gid; i < 2560 * 384; i += GT) { const int n = i / 384, k = i - n * 384, part = n >> 9, c = n & 511; float v = 0.f;
        if (part < 2) { if ((k >> 6) == part) v = F.in[I_RW2][((size_t)part * 64 + (k & 63)) * 512 + c]; }
        else if (part < 4) { if ((k >> 6) == part) v = F.in[I_A2][((size_t)(part - 2) * 64 + (k & 63)) * 512 + c]; }
        else { if (k >= 256) v = F.in[I_G2][(size_t)(k - 256) * 512 + c]; }
        WL[i] = (bf16)f2bf(v); }
    const int gw = F.blk * 8 + F.wave, NGW = F.G * 8;
    tr_family(F, F.in[I_ATTW], 0, 1, 1024, ATT_IN, ATT_NP, wsp<bf16>(F, WS_WIN0), gw, NGW);
    tr_family(F, F.in[I_WUQ], 0, 1, 384, 768, 768, wsp<bf16>(F, WS_WUQ), gw, NGW);
    tr_family(F, F.in[I_WUKV], 0, 1, 256, 1024, 1024, wsp<bf16>(F, WS_WUKV), gw, NGW);
    tr_family(F, F.in[I_WOUT], (size_t)1024 * 1024, 2, 1024, 1024, 1024, wsp<bf16>(F, WS_WOUT), gw, NGW);
    tr_family(F, F.in[I_RECW], 0, 1, 1024, REC_IN, REC_NP, wsp<bf16>(F, WS_WREC), gw, NGW);
    moe_weights_convert(F, 0, gw, NGW);
}
__device__ __forceinline__ void p0b(const Frame& F) {
    const int gw = F.blk * 8 + F.wave, NGW = F.G * 8;
    for (int row = gw; row < R; row += NGW) { const int sel = row_sel(row);
        norm_mod_row(F, h0_row(F, row), F.in[I_NMIX], modp(F, 0, sel, 0), modp(F, 0, sel, 1), wsp<bf16>(F, WS_A) + (size_t)row * DM); }
}
struct FnStoreBf16 {
    bf16* O; int ldc;
    __device__ __forceinline__ void operator()(int row, int col, f32x4 v0, f32x4 v1) const {
        v4u w; w.x = pg8::cvt_pk_bf16(v0[0], v0[1]); w.y = pg8::cvt_pk_bf16(v0[2], v0[3]); w.z = pg8::cvt_pk_bf16(v1[0], v1[1]); w.w = pg8::cvt_pk_bf16(v1[2], v1[3]);
        *(v4u*)(O + (size_t)row * ldc + col) = w; }
};
struct FnWout {
    const Frame* F; int layer;
    __device__ __forceinline__ void operator()(int row, int col, f32x4 v0, f32x4 v1) const {
        bf16* hrow = wsp<bf16>(*F, WS_H) + (size_t)row * DM + col;
        const float* g = modp(*F, layer, row_sel(row), 2) + col;
        const f32x4 g0 = *(const f32x4*)g, g1 = *(const f32x4*)(g + 4); f32x4 b0, b1;
        if (layer == 0) { const float* base = h0_row(*F, row) + col; b0 = *(const f32x4*)base; b1 = *(const f32x4*)(base + 4); }
        else { float x[8]; unpack8(*(const v4u*)hrow, x); b0 = (f32x4){x[0], x[1], x[2], x[3]}; b1 = (f32x4){x[4], x[5], x[6], x[7]}; }
        const f32x4 o0 = b0 + g0 * v0, o1 = b1 + g1 * v1; v4u w; w.x = pk2(o0.x, o0.y); w.y = pk2(o0.z, o0.w); w.z = pk2(o1.x, o1.y); w.w = pk2(o1.z, o1.w);
        *(v4u*)hrow = w; }
};
__device__ __forceinline__ void l0_post_proj(const Frame& F) {
    const int gw = F.blk * 8 + F.wave, NGW = F.G * 8, lane = F.lane;
    const bf16* P = wsp<const bf16>(F, WS_P); const float* rope = wsp<const float>(F, WS_ROPE);
    constexpr float CD = 0.125f * 1.4426950408889634f;
    for (int row = gw; row < R; row += NGW) {
        const int b = row / TB, t = row - b * TB; const bool lat = t >= CT; const int pos = t - CT, prow = lat ? pos >> 6 : 0, pcol = lat ? pos & 63 : 0;
        const bf16* p = P + (size_t)row * ATT_NP;
        bf16* qd = wsp<bf16>(F, WS_QD) + (size_t)row * 512; bf16* kd = wsp<bf16>(F, WS_KD) + (size_t)row * 512;
#pragma unroll
        for (int j = 0; j < 2; ++j) { const int g = lane + 64 * j, h16 = g >> 3, i0 = (g & 7) * 4;
            const v2u w1 = *(const v2u*)(p + h16 * 64 + i0), w2 = *(const v2u*)(p + h16 * 64 + i0 + 32);
            const float x1[4] = {bflo(w1.x), bfhi(w1.x), bflo(w1.y), bfhi(w1.y)}, x2[4] = {bflo(w2.x), bfhi(w2.x), bflo(w2.y), bfhi(w2.y)};
            float cs[8] = {1.f, 0.f, 1.f, 0.f, 1.f, 0.f, 1.f, 0.f};
            if (lat) { const float* tb = (i0 < 16) ? rope + ROPE_DR + (size_t)(prow * 16 + i0) * 2 : rope + ROPE_DC + (size_t)(pcol * 16 + i0 - 16) * 2;
                const f32x4 t0 = *(const f32x4*)tb, t1 = *(const f32x4*)(tb + 4); cs[0] = t0.x; cs[1] = t0.y; cs[2] = t0.z; cs[3] = t0.w; cs[4] = t1.x; cs[5] = t1.y; cs[6] = t1.z; cs[7] = t1.w; }
            float y1[4], y2[4]; const float sc = h16 < 8 ? CD : 1.f;
#pragma unroll
            for (int e = 0; e < 4; ++e) { y1[e] = (x1[e] * cs[2 * e] - x2[e] * cs[2 * e + 1]) * sc; y2[e] = (x1[e] * cs[2 * e + 1] + x2[e] * cs[2 * e]) * sc; }
            bf16* o = (h16 < 8) ? qd + h16 * 64 + i0 : kd + (h16 - 8) * 64 + i0;
            v2u o1, o2; o1.x = pk2(y1[0], y1[1]); o1.y = pk2(y1[2], y1[3]); o2.x = pk2(y2[0], y2[1]); o2.y = pk2(y2[2], y2[3]);
            *(v2u*)o = o1; *(v2u*)(o + 32) = o2; }
        { float x[8]; float ss = 0.f; const bool act = lane < 48;
          if (act) unpack8(*(const v4u*)(p + 1536 + 8 * lane), x); else {
#pragma unroll
              for (int e = 0; e < 8; ++e) x[e] = 0.f; }
#pragma unroll
          for (int e = 0; e < 8; ++e) ss += x[e] * x[e];
          const float rs = 1.f / sqrtf(wave_sum(ss) * (1.f / 384.f) + NORM_EPS);
          if (act) { const f32x4 g0 = *(const f32x4*)(F.in[I_QNW] + 8 * lane), g1 = *(const f32x4*)(F.in[I_QNW] + 8 * lane + 4); v4u w;
              w.x = pk2(x[0] * rs * g0.x, x[1] * rs * g0.y); w.y = pk2(x[2] * rs * g0.z, x[3] * rs * g0.w); w.z = pk2(x[4] * rs * g1.x, x[5] * rs * g1.y); w.w = pk2(x[6] * rs * g1.z, x[7] * rs * g1.w);
              *(v4u*)(wsp<bf16>(F, WS_CQN) + (size_t)row * 384 + 8 * lane) = w; } }
        { const v2u wv = *(const v2u*)(p + 1920 + 4 * lane); const float x[4] = {bflo(wv.x), bfhi(wv.x), bflo(wv.y), bfhi(wv.y)};
          const float rs = 1.f / sqrtf(wave_sum((x[0] * x[0] + x[1] * x[1]) + (x[2] * x[2] + x[3] * x[3])) * (1.f / 256.f) + NORM_EPS);
          const f32x4 g0 = *(const f32x4*)(F.in[I_KVNW] + 4 * lane); v2u w; w.x = pk2(x[0] * rs * g0.x, x[1] * rs * g0.y); w.y = pk2(x[2] * rs * g0.z, x[3] * rs * g0.w);
          *(v2u*)(wsp<bf16>(F, WS_CKVN) + (size_t)row * 256 + 4 * lane) = w; }
        if (lane < 16) { const int i = lane; const float x1 = bf2f(p[2176 + i]), x2 = bf2f(p[2176 + i + 16]); float c = 1.f, s = 0.f;
            if (lat) { const float* tb = (i < 8) ? rope + ROPE_MR + (size_t)(prow * 8 + i) * 2 : rope + ROPE_MC + (size_t)(pcol * 8 + i - 8) * 2; c = tb[0]; s = tb[1]; }
            bf16* o = wsp<bf16>(F, WS_KRR) + (size_t)row * 32; o[i] = (bf16)f2bf(x1 * c - x2 * s); o[i + 16] = (bf16)f2bf(x1 * s + x2 * c); }
    }
}
__device__ __forceinline__ void l0_mq_rope(const Frame& F) {
    const int gw = F.blk * 8 + F.wave, NGW = F.G * 8, lane = F.lane; const float* rope = wsp<const float>(F, WS_ROPE);
    const float CM = 0.10206207261596575f * 1.4426950408889634f;
    for (int row = gw; row < R; row += NGW) {
        const int b = row / TB, t = row - b * TB; const bool lat = t >= CT; const int pos = t - CT, prow = lat ? pos >> 6 : 0, pcol = lat ? pos & 63 : 0;
        bf16* q = wsp<bf16>(F, WS_MQ) + (size_t)row * 768;
#pragma unroll
        for (int j = 0; j < 2; ++j) { const int g = lane + 64 * j, h = g >> 4, d0 = (g & 15) * 4;
            const v2u wv = *(const v2u*)(q + h * 96 + d0); v2u o; o.x = pk2(bflo(wv.x) * CM, bfhi(wv.x) * CM); o.y = pk2(bflo(wv.y) * CM, bfhi(wv.y) * CM); *(v2u*)(q + h * 96 + d0) = o; }
#pragma unroll
        for (int j = 0; j < 2; ++j) { const int pr = lane + 64 * j, h = pr >> 4, i = pr & 15; const float x1 = bf2f(q[h * 96 + 64 + i]), x2 = bf2f(q[h * 96 + 80 + i]); float c = 1.f, s = 0.f;
            if (lat) { const float* tb = (i < 8) ? rope + ROPE_MR + (size_t)(prow * 8 + i) * 2 : rope + ROPE_MC + (size_t)(pcol * 8 + i - 8) * 2; c = tb[0]; s = tb[1]; }
            q[h * 96 + 64 + i] = (bf16)f2bf((x1 * c - x2 * s) * CM); q[h * 96 + 80 + i] = (bf16)f2bf((x1 * s + x2 * c) * CM); }
    }
}
__device__ __forceinline__ void l0_attention(const Frame& F) {
    LAS char* lds = (LAS char*)F.lds;
    const bf16* QD = wsp<const bf16>(F, WS_QD); const bf16* KD = wsp<const bf16>(F, WS_KD); const bf16* P = wsp<const bf16>(F, WS_P);
    const bf16* MQ = wsp<const bf16>(F, WS_MQ); const bf16* MKV = wsp<const bf16>(F, WS_MKV); const bf16* KRR = wsp<const bf16>(F, WS_KRR);
    float* OD = wsp<float>(F, WS_ODIFF); float* OM = wsp<float>(F, WS_OMLA);
    for (int kind = 0; kind < 2; ++kind) {
        for (int L = F.blk; L < 1024 + 16; L += F.G) {
            int b, h8, qb, nkeys;
            if (L < 1024) { int pair;
                if (F.G == 256) { const int round = L >> 8, c = L & 255; pair = round * 4 + ((c & 7) >> 1); qb = 1 + (c & 1) * 32 + (c >> 3); }
                else { pair = L >> 6; qb = 1 + (L & 63); }
                b = pair >> 3; h8 = pair & 7; nkeys = TB; }
            else { const int s = L - 1024; b = s >> 3; h8 = s & 7; qb = 0; nkeys = CT; }
            const size_t q0 = (size_t)b * TB + (size_t)qb * 256, k0 = (size_t)b * TB;
            if (kind == 0)
                att::attn_unit<64, 128>(QD + q0 * 512 + h8 * 64, 512, KD + k0 * 512 + h8 * 64, 512, nullptr, 0, P + k0 * ATT_NP + 1024 + (h8 >> 1) * 128, ATT_NP,
                                        OD + q0 * 1024 + h8 * 128, 1024, nkeys, lds);
            else
                att::attn_unit<96, 64>(MQ + q0 * 768 + h8 * 96, 768, MKV + k0 * 1024 + h8 * 128, 1024, KRR + k0 * 32, 32, MKV + k0 * 1024 + h8 * 128 + 64, 1024,
                                       OM + q0 * 512 + h8 * 64, 512, nkeys, lds);
        }
    }
}
__device__ __forceinline__ void l0_combine(const Frame& F) {
    const int gw = F.blk * 8 + F.wave, NGW = F.G * 8, lane = F.lane;
    const float* lv = F.in[I_LAM];
    const float lam = __expf(wave_sum(lv[lane] * lv[64 + lane])) - __expf(wave_sum(lv[128 + lane] * lv[192 + lane])) + 0.2f;
    const float sw0 = F.in[I_SUBLN][2 * lane] * 0.8f, sw1 = F.in[I_SUBLN][2 * lane + 1] * 0.8f;
    for (int row = gw; row < R; row += NGW) {
        const float* od = wsp<const float>(F, WS_ODIFF) + (size_t)row * 1024; const float* om = wsp<const float>(F, WS_OMLA) + (size_t)row * 512;
        bf16* a1 = wsp<bf16>(F, WS_A1) + (size_t)row * DM;
#pragma unroll
        for (int h = 0; h < 4; ++h) {
            const float o1a = od[(2 * h) * 128 + 2 * lane], o1b = od[(2 * h) * 128 + 2 * lane + 1], o2a = od[(2 * h + 1) * 128 + 2 * lane], o2b = od[(2 * h + 1) * 128 + 2 * lane + 1];
            const float da = o1a - lam * o2a, db = o1b - lam * o2b;
            const float rs = 1.f / sqrtf(wave_sum(da * da + db * db) * (1.f / 128.f) + NORM_EPS);
            *(unsigned*)(a1 + h * 128 + 2 * lane) = pk2(da * rs * sw0, db * rs * sw1); }
#pragma unroll
        for (int j = 0; j < 2; ++j) { const f32x4 v = *(const f32x4*)(om + 4 * (lane + 64 * j)); v2u w; w.x = pk2(v.x, v.y); w.y = pk2(v.z, v.w); *(v2u*)(a1 + 512 + 4 * (lane + 64 * j)) = w; }
    }
}
constexpr int RT_LS = 264;
__device__ __forceinline__ void ph_router(const Frame& F, int layer) {
    LAS bf16* AH = (LAS bf16*)F.lds; LAS bf16* AL = AH + 64 * RT_LS; LAS bf16* WH = AL + 64 * RT_LS; LAS bf16* WL = WH + 32 * RT_LS;
    LAS float* lg = (LAS float*)(F.lds + 110592);
    LAS int* hist = (LAS int*)(F.lds + MISC_OFF + 256);
    LAS int* recs = (LAS int*)(F.lds + MISC_OFF + 512);
    const int lane = F.lane, w = F.wave, tid = F.tid, RPB = (R + F.G - 1) / F.G, row0 = F.blk * RPB;
    if (tid < 64) hist[tid] = 0;
    { int* srct = wsp<int>(F, WS_SRC); for (int i = F.blk * 512 + tid; i < MAXROWS; i += F.G * 512) srct[i] = 0; }
    const float* nw = F.in[I_NFFN] + (size_t)layer * DM; const float* rbp = F.in[I_RB] + layer * NE;
    const bf16* wrh = wsp<const bf16>(F, WS_WRH) + (size_t)layer * 32 * 1024; const bf16* wrl = wsp<const bf16>(F, WS_WRL) + (size_t)layer * 32 * 1024;
    for (int pass = 0; pass * 64 < RPB; ++pass) {
        const int nrow = min(64, min(RPB - pass * 64, R - row0 - pass * 64));
        f32x4 fr[8][4];
#pragma unroll
        for (int i = 0; i < 8; ++i) { const int rl = w + 8 * i; const int row = row0 + pass * 64 + rl;
            if (rl < nrow) {
                const int sel = row_sel(row); const float* sh = modp(F, layer, sel, 3); const float* sc = modp(F, layer, sel, 4);
                const v2u* xr = (const v2u*)(wsp<const bf16>(F, WS_H) + (size_t)row * DM) + lane; float s = 0.f;
#pragma unroll
                for (int j = 0; j < 4; ++j) { const v2u hw = xr[64 * j]; fr[i][j] = (f32x4){bflo(hw.x), bfhi(hw.x), bflo(hw.y), bfhi(hw.y)}; s += (fr[i][j].x * fr[i][j].x + fr[i][j].y * fr[i][j].y) + (fr[i][j].z * fr[i][j].z + fr[i][j].w * fr[i][j].w); }
                const float rs = 1.f / sqrtf(wave_sum(s) * (1.f / DM) + NORM_EPS);
                unsigned long long* o8 = (unsigned long long*)(wsp<bf16>(F, WS_F) + (size_t)row * DM) + lane;
#pragma unroll
                for (int j = 0; j < 4; ++j) { const f32x4 ww = ((const f32x4*)nw)[lane + 64 * j], a = ((const f32x4*)sh)[lane + 64 * j], c = ((const f32x4*)sc)[lane + 64 * j];
                    fr[i][j] = fr[i][j] * rs * ww * (c + 1.f) + a;
                    o8[64 * j] = (unsigned long long)pk2(fr[i][j].x, fr[i][j].y) | ((unsigned long long)pk2(fr[i][j].z, fr[i][j].w) << 32); }
            } else {
#pragma unroll
                for (int j = 0; j < 4; ++j) fr[i][j] = (f32x4){0.f, 0.f, 0.f, 0.f};
            } }
        pg8::f32x4 acc = {0.f, 0.f, 0.f, 0.f};
#pragma unroll
        for (int c = 0; c < 4; ++c) {
            __syncthreads();
#pragma unroll
            for (int i = 0; i < 8; ++i) { const f32x4 v = fr[i][c]; const unsigned h0 = pk2(v.x, v.y), h1 = pk2(v.z, v.w);
                const unsigned l0 = pk2(v.x - bflo(h0), v.y - bfhi(h0)), l1 = pk2(v.z - bflo(h1), v.w - bfhi(h1));
                v2u hh; hh.x = h0; hh.y = h1; v2u ll; ll.x = l0; ll.y = l1;
                *(LAS v2u*)(AH + (w + 8 * i) * RT_LS + 4 * lane) = hh; *(LAS v2u*)(AL + (w + 8 * i) * RT_LS + 4 * lane) = ll; }
            { const int e = tid >> 4, kp = (tid & 15) * 16;
              const v4u a0 = *(const v4u*)(wrh + (size_t)e * 1024 + 256 * c + kp), a1 = *(const v4u*)(wrh + (size_t)e * 1024 + 256 * c + kp + 8);
              const v4u b0 = *(const v4u*)(wrl + (size_t)e * 1024 + 256 * c + kp), b1 = *(const v4u*)(wrl + (size_t)e * 1024 + 256 * c + kp + 8);
              *(LAS v4u*)(WH + e * RT_LS + kp) = a0; *(LAS v4u*)(WH + e * RT_LS + kp + 8) = a1; *(LAS v4u*)(WL + e * RT_LS + kp) = b0; *(LAS v4u*)(WL + e * RT_LS + kp + 8) = b1; }
            __syncthreads();
            const int tm = w >> 1, tn = w & 1, lr = lane & 15, kq = (lane >> 4) * 8;
            const LAS bf16* ahp = AH + (tm * 16 + lr) * RT_LS + kq; const LAS bf16* alp = AL + (tm * 16 + lr) * RT_LS + kq;
            const LAS bf16* whp = WH + (tn * 16 + lr) * RT_LS + kq; const LAS bf16* wlp = WL + (tn * 16 + lr) * RT_LS + kq;
#pragma unroll
            for (int ks = 0; ks < 8; ++ks) { const bf16x8 ah = *(const LAS bf16x8*)(ahp + 32 * ks), al = *(const LAS bf16x8*)(alp + 32 * ks), bh = *(const LAS bf16x8*)(whp + 32 * ks), bl = *(const LAS bf16x8*)(wlp + 32 * ks);
                acc = __builtin_amdgcn_mfma_f32_16x16x32_bf16(ah, bh, acc, 0, 0, 0); acc = __builtin_amdgcn_mfma_f32_16x16x32_bf16(ah, bl, acc, 0, 0, 0); acc = __builtin_amdgcn_mfma_f32_16x16x32_bf16(al, bh, acc, 0, 0, 0); }
        }
        { const int m0 = (w >> 1) * 16 + (lane >> 4) * 4, n = (w & 1) * 16 + (lane & 15);
#pragma unroll
          for (int r = 0; r < 4; ++r) lg[(m0 + r) * 33 + n] = acc[r]; }
        __syncthreads();
        if (tid < nrow) { const int rl = tid, row = row0 + pass * 64 + rl; float lv[32];
#pragma unroll
            for (int e = 0; e < 32; ++e) lv[e] = lg[rl * 33 + e] + rbp[e];
            float selv[4]; int seli[4];
#pragma unroll
            for (int r = 0; r < 4; ++r) { float bv = -3.0e38f; int bi = 0;
#pragma unroll
                for (int e = 0; e < 32; ++e) { const bool taken = (r > 0 && seli[0] == e) || (r > 1 && seli[1] == e) || (r > 2 && seli[2] == e); if (!taken && lv[e] > bv) { bv = lv[e]; bi = e; } }
                selv[r] = bv; seli[r] = bi; }
            float ex[4], es = 0.f;
#pragma unroll
            for (int r = 0; r < 4; ++r) { ex[r] = __expf(selv[r] - selv[0]); es += ex[r]; }
            const float inv = 1.f / es;
#pragma unroll
            for (int r = 0; r < 4; ++r) { wsp<int>(F, WS_TOPE)[(size_t)row * 4 + r] = seli[r]; wsp<float>(F, WS_GATE)[(size_t)row * 4 + r] = ex[r] * inv;
                const int rk = __hip_atomic_fetch_add(&hist[seli[r]], 1, __ATOMIC_RELAXED, __HIP_MEMORY_SCOPE_WORKGROUP);
                recs[(pass * 64 + rl) * 4 + r] = seli[r] | (rk << 8); }
        }
    }
    __syncthreads();
    if (tid < NE) hist[32 + tid] = (int)__hip_atomic_fetch_add(F.ctl + CW_CNT + 64 * (layer + 2 * F.probe) + tid, (unsigned)hist[tid], RLX_AGENT);
    __syncthreads();
    for (int rl = tid; rl < RPB && row0 + rl < R; rl += 512) {
#pragma unroll
        for (int r = 0; r < 4; ++r) { const int rc = recs[rl * 4 + r]; wsp<int>(F, WS_POS)[(size_t)(row0 + rl) * 4 + r] = hist[32 + (rc & 255)] + (rc >> 8); } }
}
__device__ __forceinline__ void moe_tables(const Frame& F, int layer, LAS int* ps, LAS int* tile_e) {
    if (F.tid == 0) { int acc = 0, t = 0;
        for (int e = 0; e < NE; ++e) { const int c = (int)__hip_atomic_load(F.ctl + CW_CNT + 64 * layer + e, RLX_AGENT); ps[e] = acc; const int nt = (c + 255) >> 8;
            for (int i = 0; i < nt && t < MAXT; ++i) tile_e[t++] = e; acc += nt * 256; }
        ps[NE] = acc; ps[NE + 1] = t; }
    __syncthreads();
}
__device__ __forceinline__ void ph_gather(const Frame& F, int layer) {
    LAS int* ps = (LAS int*)(F.lds + MISC_OFF + 256); LAS int* tile_e = ps + 64;
    moe_tables(F, layer, ps, tile_e);
    if (F.blk == 0) { int* tab = wsp<int>(F, WS_TILE); const int nt = ps[NE + 1]; if (F.tid == 0) tab[0] = nt; for (int i = F.tid; i < nt; i += 512) tab[1 + i] = tile_e[i]; }
    for (int i = F.blk * 512 + F.tid; i < R * 4; i += F.G * 512) { const int row = i >> 2;
        const int e = wsp<const int>(F, WS_TOPE)[i]; const int dest = ps[e] + wsp<const int>(F, WS_POS)[i]; wsp<int>(F, WS_DEST)[i] = dest; wsp<int>(F, WS_SRC)[dest] = row; }
}
struct MoeOrder {
    const int* tile_e; int ntiles, nN, G, c; const int* src;
    __device__ __forceinline__ bool next(int i, pg8::Unit& u) const {
        int rt, pl;
        if (G == 256) { const int x = c & 7, y = c >> 3, rpx = 32 / nN; rt = (i * 8 + x) * rpx + y / nN; pl = y % nN; if (rt >= ntiles) return false; }
        else { const long L = (long)i * G + c; if (L >= (long)ntiles * nN) return false; rt = (int)(L / nN); pl = (int)(L - (long)rt * nN); }
        const int e = __builtin_amdgcn_readfirstlane(tile_e[rt]);
        u.pm = rt; u.pn = e * nN + pl; return true; }
    __device__ __forceinline__ void a_ready(const pg8::Unit&) const {}
    __device__ __forceinline__ void done(const pg8::Unit&) const {}
};
struct LatOrder {
    pg8::StaticOrder o;
    __device__ __forceinline__ bool next(int i, pg8::Unit& u) const { if (!o.next(i, u)) return false; u.pm += 1 + (u.pm >= 64 ? 1 : 0); return true; }
    __device__ __forceinline__ void a_ready(const pg8::Unit&) const {}
    __device__ __forceinline__ void done(const pg8::Unit&) const {}
};
struct FnSwiglu {
    bf16* HS; const float* b1;
    __device__ __forceinline__ void operator()(int row, int col, f32x4 v0, f32x4 v1) const {
        const float* bp = b1 + col;
        const f32x4 b0 = *(const f32x4*)bp, b1v = *(const f32x4*)(bp + 4); v0 = v0 + b0; v1 = v1 + b1v;
        const float hv[8] = {v0[0], v0[1], v0[2], v0[3], v1[0], v1[1], v1[2], v1[3]}; float o[4];
#pragma unroll
        for (int i = 0; i < 4; ++i) { const float g = hv[2 * i], l = hv[2 * i + 1];
            const float gl = fminf(g, 7.f), li = fminf(fmaxf(l, -7.f), 7.f); o[i] = gl * sigmoidf_(1.702f * gl) * (li + 1.f); }
        const int lc = col & 2047; v2u w; w.x = pk2(o[0], o[1]); w.y = pk2(o[2], o[3]);
        *(v2u*)(HS + (size_t)row * 1024 + (lc >> 1)) = w; }
};
struct FnBiasBf16 {
    bf16* YS; const float* b2;
    __device__ __forceinline__ void operator()(int row, int col, f32x4 v0, f32x4 v1) const {
        const f32x4 b0 = *(const f32x4*)(b2 + col), b1v = *(const f32x4*)(b2 + col + 4); v0 = v0 + b0; v1 = v1 + b1v;
        v4u w; w.x = pk2(v0[0], v0[1]); w.y = pk2(v0[2], v0[3]); w.z = pk2(v1[0], v1[1]); w.w = pk2(v1[2], v1[3]);
        *(v4u*)(YS + (size_t)row * 1024 + (col & 1023)) = w; }
};
__device__ __forceinline__ void ph_combine(const Frame& F, int layer) {
    const int lane = F.lane, gw = F.blk * 8 + F.wave, NGW = F.G * 8;
    for (int row = gw; row < R; row += NGW) {
        const int sel = row_sel(row); const float* gf = modp(F, layer, sel, 5);
        bf16* hrow = wsp<bf16>(F, WS_H) + (size_t)row * DM;
        f32x4 y[4];
#pragma unroll
        for (int j = 0; j < 4; ++j) y[j] = (f32x4){0.f, 0.f, 0.f, 0.f};
#pragma unroll
        for (int r = 0; r < 4; ++r) { const int d = wsp<const int>(F, WS_DEST)[(size_t)row * 4 + r]; const float g = wsp<const float>(F, WS_GATE)[(size_t)row * 4 + r];
            const v2u* yp = (const v2u*)(wsp<const bf16>(F, WS_XS) + (size_t)d * DM);
#pragma unroll
            for (int j = 0; j < 4; ++j) { const v2u w = yp[lane + 64 * j]; y[j] += g * (f32x4){bflo(w.x), bfhi(w.x), bflo(w.y), bfhi(w.y)}; } }
        f32x4 h[4]; float s = 0.f;
#pragma unroll
        for (int j = 0; j < 4; ++j) { const v2u hw = ((const v2u*)hrow)[lane + 64 * j]; h[j] = (f32x4){bflo(hw.x), bfhi(hw.x), bflo(hw.y), bfhi(hw.y)} + ((const f32x4*)gf)[lane + 64 * j] * y[j]; s += (h[j].x * h[j].x + h[j].y * h[j].y) + (h[j].z * h[j].z + h[j].w * h[j].w); }
        const float rs = 1.f / sqrtf(wave_sum(s) * (1.f / DM) + NORM_EPS);
        if (layer == 0) {
#pragma unroll
            for (int j = 0; j < 4; ++j) { v2u hw; hw.x = pk2(h[j].x, h[j].y); hw.y = pk2(h[j].z, h[j].w); ((v2u*)hrow)[lane + 64 * j] = hw; }
            const float* nw = F.in[I_NMIX] + DM; const float* sh = modp(F, 1, sel, 0); const float* sc = modp(F, 1, sel, 1);
            unsigned long long* o8 = (unsigned long long*)(wsp<bf16>(F, WS_A) + (size_t)row * DM) + lane;
#pragma unroll
            for (int j = 0; j < 4; ++j) { const f32x4 w = ((const f32x4*)nw)[lane + 64 * j], a = ((const f32x4*)sh)[lane + 64 * j], c = ((const f32x4*)sc)[lane + 64 * j];
                const f32x4 o = h[j] * rs * w * (c + 1.f) + a; o8[64 * j] = (unsigned long long)pk2(o.x, o.y) | ((unsigned long long)pk2(o.z, o.w) << 32); }
        } else {
            const int b = row / TB, t = row - b * TB;
            if (t >= CT) { float* orow = F.out + ((size_t)b * SEQ + (t - CT)) * DM; const float* nw = F.in[I_FNW];
#pragma unroll
                for (int j = 0; j < 4; ++j) ((f32x4*)orow)[lane + 64 * j] = h[j] * rs * ((const f32x4*)nw)[lane + 64 * j]; }
        }
    }
}
constexpr int PC_Q = 1920, PC_K = 2176, PC_V = 2432, PC_O = 2944, PC_G = 3456;
__device__ __forceinline__ float softplusf_(float y) { return fmaxf(y, 0.f) + __logf(1.f + __expf(-fabsf(y))); }
__device__ __forceinline__ float tanhf_(float x) { return 1.f - 2.f / (1.f + __expf(2.f * x)); }
__device__ __forceinline__ void lerp8(const bf16* p, bool hp, bool hn, int c0, const float* mu, float (&u)[8]) {
    const v4u z4 = {0u, 0u, 0u, 0u};
    const v4u wx = *(const v4u*)(p + c0), wp = hp ? *(const v4u*)(p - REC_NP + c0) : z4, wn = hn ? *(const v4u*)(p + REC_NP + c0) : z4;
    float x[8], xp[8], xn[8]; unpack8(wx, x); unpack8(wp, xp); unpack8(wn, xn);
    const f32x4 m0 = *(const f32x4*)(mu + c0), m1 = *(const f32x4*)(mu + c0 + 4);
#pragma unroll
    for (int e = 0; e < 8; ++e) { const float m = e < 4 ? m0[e & 3] : m1[e & 3]; u[e] = x[e] + m * (0.5f * (xp[e] + xn[e]) - x[e]); }
}
__device__ __forceinline__ void st8h(bf16* o, const float (&u)[8]) { v4u w; w.x = pk2(u[0], u[1]); w.y = pk2(u[2], u[3]); w.z = pk2(u[4], u[5]); w.w = pk2(u[6], u[7]); *(v4u*)o = w; }
__device__ __forceinline__ void st8f(float* o, const float (&u)[8]) { *(f32x4*)o = (f32x4){u[0], u[1], u[2], u[3]}; *(f32x4*)(o + 4) = (f32x4){u[4], u[5], u[6], u[7]}; }
__device__ __forceinline__ void l1_rwkv_prep(const Frame& F) {
    const int gw = F.blk * 8 + F.wave, NGW = F.G * 8, lane = F.lane; const float* mu = F.in[I_MU];
    for (int row = gw; row < R; row += NGW) {
        const int b = row / TB, t = row - b * TB; const bool hp = (t != 0 && t != CT), hn = (t != CT - 1 && t != TB - 1);
        const bf16* p = wsp<const bf16>(F, WS_P) + (size_t)row * REC_NP; const size_t ro = (size_t)row * 512 + 8 * lane;
        float u[8];
        lerp8(p, hp, hn, 8 * lane, mu, u); st8h(wsp<bf16>(F, WS_RR) + ro, u);
        lerp8(p, hp, hn, 1024 + 8 * lane, mu, u); st8h(wsp<bf16>(F, WS_VV) + ro, u);
        lerp8(p, hp, hn, 512 + 8 * lane, mu, u); st8h(wsp<bf16>(F, WS_KL) + ro, u);
        { const f32x4 k0 = *(const f32x4*)(F.in[I_KK] + 8 * lane), k1 = *(const f32x4*)(F.in[I_KK] + 8 * lane + 4); float ss = 0.f;
#pragma unroll
          for (int e = 0; e < 8; ++e) { u[e] *= (e < 4 ? k0[e & 3] : k1[e & 3]); ss += u[e] * u[e]; }
          ss += __shfl_xor(ss, 1); ss += __shfl_xor(ss, 2); ss += __shfl_xor(ss, 4);
          const float inv = -1.f / sqrtf(fmaxf(ss, 1e-24f));
#pragma unroll
          for (int e = 0; e < 8; ++e) u[e] *= inv;
          st8h(wsp<bf16>(F, WS_AKK) + ro, u); }
        if (lane < 48) { lerp8(p, hp, hn, 1536 + 8 * lane, mu, u);
#pragma unroll
            for (int e = 0; e < 8; ++e) u[e] = lane < 16 ? tanhf_(u[e]) : (lane < 32 ? u[e] : sigmoidf_(u[e]));
            v4u w; w.x = pk2(u[0], u[1]); w.y = pk2(u[2], u[3]); w.z = pk2(u[4], u[5]); w.w = pk2(u[6], u[7]);
            *(v4u*)(wsp<bf16>(F, WS_ALORA) + (size_t)row * 384 + 8 * lane) = w; }
    }
}
struct EpiLora {
    static constexpr bool PERM = true, AFTER_DRAIN = false;
    const Frame* F;
    template <int KIND> __device__ __forceinline__ void run(const pg8::f32x4 (&acc)[2][2][4][2], const pg8::Unit& u, int wr, int wc, int fr, int fq, int z) const {
#pragma unroll
        for (int ai = 0; ai < 2; ++ai)
#pragma unroll
            for (int m = 0; m < 4; ++m) { const int row = u.pm * 256 + ai * 128 + wr * 64 + m * 16 + fr;
#pragma unroll
                for (int bj = 0; bj < 2; ++bj) { const int c = ((u.pn & 1) * 256) + bj * 128 + wc * 32 + 8 * fq; const size_t ro = (size_t)row * 512 + c;
                    const pg8::f32x4 v0 = acc[ai][bj][m][0], v1 = acc[ai][bj][m][1]; const float x[8] = {v0[0], v0[1], v0[2], v0[3], v1[0], v1[1], v1[2], v1[3]}; float o[8];
                    if constexpr (KIND == 0) { const float* w0 = F->in[I_W0] + z * 512 + c;
#pragma unroll
                        for (int e = 0; e < 8; ++e) { const float wl = -softplusf_(-(w0[e] + x[e])) - 0.5f; o[e] = __expf(-__expf(wl)); }
                        st8f(wsp<float>(*F, WS_WDEC) + (size_t)z * R * 512 + ro, o); }
                    else if constexpr (KIND == 1) { const float* a0 = F->in[I_A0] + z * 512 + c;
#pragma unroll
                        for (int e = 0; e < 8; ++e) o[e] = sigmoidf_(a0[e] + x[e]);
                        st8h(wsp<bf16>(*F, WS_ASIG) + (size_t)z * R * 512 + ro, o); }
                    else st8h(wsp<bf16>(*F, WS_GG) + ro, x); } }
    }
    __device__ __forceinline__ void operator()(const pg8::f32x4 (&acc)[2][2][4][2], const pg8::Unit& u, int wr, int wc, int fr, int fq) const {
        const int part = u.pn >> 1;
        if (part < 2) run<0>(acc, u, wr, wc, fr, fq, part); else if (part < 4) run<1>(acc, u, wr, wc, fr, fq, part - 2); else run<2>(acc, u, wr, wc, fr, fq, 0);
    }
};
__device__ __forceinline__ void mlstm_gates(const Frame& F, int row, int z, int h, float& ig, float& lf) {
    const bf16* g = wsp<const bf16>(F, WS_P) + (size_t)row * REC_NP + PC_G + z * 8 + h; const float* gb = F.in[I_GATEB] + z * 8 + h;
    const float gi = bf2f(g[0]) + gb[0], gf = bf2f(g[4]) + gb[4];
    ig = 15.f * tanhf_(gi * (1.f / 15.f)); const float cf = 15.f * tanhf_(gf * (1.f / 15.f)); lf = fminf(cf, 0.f) - __logf(1.f + __expf(-fabsf(cf)));
}
__device__ __forceinline__ void mlstm_chunk_head(const Frame& F, int z, int b, int h, int c, LAS float* vec) {
    LAS int* rows = (LAS int*)vec;
    if (F.tid < 64) { const int s = F.tid, row = b * TB + scan_tok(z, 64 * c + s); float ig, lf; mlstm_gates(F, row, z, h, ig, lf); rows[s] = row; vec[64 + s] = ig; vec[192 + s] = lf; }
    __syncthreads();
    if (F.tid < 64) { float a = 0.f; for (int s = 0; s <= F.tid; ++s) a += vec[192 + s]; vec[128 + F.tid] = a; }
    __syncthreads();
}
__device__ __forceinline__ void l1_mlstm_b(const Frame& F) {
    const float* __restrict__ SC = wsp<const float>(F, WS_SC); const float* __restrict__ DC = wsp<const float>(F, WS_DC); float* __restrict__ CST = wsp<float>(F, WS_CST);
    const float* __restrict__ DN = wsp<const float>(F, WS_DN); float* __restrict__ NST = wsp<float>(F, WS_NST); float* __restrict__ MST = wsp<float>(F, WS_MST);
    for (int g = F.blk * 512 + F.tid; g < 16 * 8192; g += F.G * 512) {
        const int chain = g >> 13, el = g & 8191; float m = 0.f, C = 0.f, N = 0.f; const bool don = el < 64;
        for (int c0 = 0; c0 < 260; c0 += 10) {
            float dc[10], dn[10], bl[10], ml[10];
#pragma unroll
            for (int i = 0; i < 10; ++i) { const size_t u = (size_t)chain * 260 + c0 + i; dc[i] = DC[u * 8192 + el]; dn[i] = don ? DN[u * 64 + el] : 0.f; bl[i] = SC[2 * u]; ml[i] = SC[2 * u + 1]; }
#pragma unroll
            for (int i = 0; i < 10; ++i) { const size_t u = (size_t)chain * 260 + c0 + i;
                CST[u * 8192 + el] = C; if (don) NST[u * 64 + el] = N; if (el == 0) MST[u] = m;
                const float mn = fmaxf(bl[i] + m, ml[i]), cd = __expf(bl[i] + m - mn), inj = __expf(ml[i] - mn);
                C = cd * C + inj * dc[i]; N = cd * N + inj * dn[i]; m = mn; }
        }
    }
}
__device__ __forceinline__ void l1_rec_out(const Frame& F) {
    const int gw = F.blk * 8 + F.wave, NGW = F.G * 8, lane = F.lane, c0 = 8 * lane;
    for (int row = gw; row < R; row += NGW) {
        const size_t ro = (size_t)row * 512 + c0; bf16* a1 = wsp<bf16>(F, WS_A1) + (size_t)row * DM;
        { float y0[8], y1[8], y[8]; float s = 0.f; unpack8(*(const v4u*)(wsp<const bf16>(F, WS_YR) + ro), y0); unpack8(*(const v4u*)(wsp<const bf16>(F, WS_YR) + (size_t)R * 512 + ro), y1);
          const float* y2 = wsp<const float>(F, WS_YB) + ro; const float* y3 = y2 + (size_t)R * 512;
#pragma unroll
          for (int e = 0; e < 8; ++e) { y[e] = (y0[e] + y1[e]) + (y2[e] + y3[e]); s += y[e]; }
          s += __shfl_xor(s, 1); s += __shfl_xor(s, 2); s += __shfl_xor(s, 4); const float mean = s * (1.f / 64.f); float q = 0.f;
#pragma unroll
          for (int e = 0; e < 8; ++e) { y[e] -= mean; q += y[e] * y[e]; }
          q += __shfl_xor(q, 1); q += __shfl_xor(q, 2); q += __shfl_xor(q, 4); const float rstd = 1.f / sqrtf(q * (1.f / 64.f) + 64e-5f);
          float rr[8], kl[8], s0[8], s1[8], vv[8], gg[8]; unpack8(*(const v4u*)(wsp<const bf16>(F, WS_RR) + ro), rr); unpack8(*(const v4u*)(wsp<const bf16>(F, WS_KL) + ro), kl);
          unpack8(*(const v4u*)(wsp<const bf16>(F, WS_ASIG) + ro), s0); unpack8(*(const v4u*)(wsp<const bf16>(F, WS_ASIG) + (size_t)R * 512 + ro), s1);
          unpack8(*(const v4u*)(wsp<const bf16>(F, WS_VV) + ro), vv); unpack8(*(const v4u*)(wsp<const bf16>(F, WS_GG) + ro), gg);
          const float* rk = F.in[I_RK] + c0; const float* ka = F.in[I_KA] + c0; float bs = 0.f;
#pragma unroll
          for (int e = 0; e < 8; ++e) bs += rr[e] * kl[e] * (2.f + (s0[e] + s1[e] - 2.f) * ka[e]) * rk[e];
          bs += __shfl_xor(bs, 1); bs += __shfl_xor(bs, 2); bs += __shfl_xor(bs, 4);
          const float* lw = F.in[I_LNW] + c0; const float* lb = F.in[I_LNB] + c0; float o[8];
#pragma unroll
          for (int e = 0; e < 8; ++e) o[e] = (y[e] * rstd * lw[e] + lb[e] + bs * vv[e]) * gg[e];
          v4u w; w.x = pk2(o[0], o[1]); w.y = pk2(o[2], o[3]); w.z = pk2(o[4], o[5]); w.w = pk2(o[6], o[7]); *(v4u*)(a1 + c0) = w; }
        { float h0[8], h1[8], x[8]; float q = 0.f; unpack8(*(const v4u*)(wsp<const bf16>(F, WS_HM) + ro), h0); unpack8(*(const v4u*)(wsp<const bf16>(F, WS_HM) + (size_t)R * 512 + ro), h1);
#pragma unroll
          for (int e = 0; e < 8; ++e) { x[e] = h0[e] + h1[e]; q += x[e] * x[e]; }
          q += __shfl_xor(q, 1); q += __shfl_xor(q, 2); q += __shfl_xor(q, 4); q += __shfl_xor(q, 8); const float rs = 1.f / sqrtf(q * (1.f / 128.f) + NORM_EPS);
          float og[8]; unpack8(*(const v4u*)(wsp<const bf16>(F, WS_P) + (size_t)row * REC_NP + PC_O + c0), og); const float* nw = F.in[I_MNW] + c0; float o[8];
#pragma unroll
          for (int e = 0; e < 8; ++e) o[e] = x[e] * rs * nw[e] * sigmoidf_(og[e]);
          v4u w; w.x = pk2(o[0], o[1]); w.y = pk2(o[2], o[3]); w.z = pk2(o[4], o[5]); w.w = pk2(o[6], o[7]); *(v4u*)(a1 + 512 + c0) = w; }
    }
}
#ifndef NEU_ROUNDS
#define NEU_ROUNDS 6
#endif
namespace rk {
constexpr int LS = 72;
constexpr int MB = 64 * LS * 2;
struct Acc2 { pg8::f32x4 t0, t1; };
__device__ __forceinline__ void zero(Acc2& a) { a.t0 = (pg8::f32x4){0.f, 0.f, 0.f, 0.f}; a.t1 = a.t0; }
__device__ __forceinline__ void mm_acc(Acc2& acc, const LAS bf16* A, const LAS bf16* Bt, int wave, int lane) {
    const int tm = wave >> 1, tn0 = (wave & 1) * 2, lr = lane & 15, kq = (lane >> 4) * 8;
    const LAS bf16* ap = A + (tm * 16 + lr) * LS + kq; const LAS bf16* bp0 = Bt + (tn0 * 16 + lr) * LS + kq; const LAS bf16* bp1 = bp0 + 16 * LS;
    const bf16x8 a0 = *(const LAS bf16x8*)ap, a1 = *(const LAS bf16x8*)(ap + 32);
    const bf16x8 b00 = *(const LAS bf16x8*)bp0, b01 = *(const LAS bf16x8*)(bp0 + 32), b10 = *(const LAS bf16x8*)bp1, b11 = *(const LAS bf16x8*)(bp1 + 32);
    acc.t0 = __builtin_amdgcn_mfma_f32_16x16x32_bf16(a0, b00, acc.t0, 0, 0, 0); acc.t0 = __builtin_amdgcn_mfma_f32_16x16x32_bf16(a1, b01, acc.t0, 0, 0, 0);
    acc.t1 = __builtin_amdgcn_mfma_f32_16x16x32_bf16(a0, b10, acc.t1, 0, 0, 0); acc.t1 = __builtin_amdgcn_mfma_f32_16x16x32_bf16(a1, b11, acc.t1, 0, 0, 0);
}
template <class Fn> __device__ __forceinline__ void each(const Acc2& acc, int wave, int lane, Fn fn) {
    const int m0 = (wave >> 1) * 16 + (lane >> 4) * 4, n0 = (wave & 1) * 32 + (lane & 15);
#pragma unroll
    for (int r = 0; r < 4; ++r) { fn(m0 + r, n0, acc.t0[r]); fn(m0 + r, n0 + 16, acc.t1[r]); }
}
__device__ __forceinline__ void stb(LAS bf16* M, int m, int n, float v) { M[m * LS + n] = (bf16)f2bf(v); }
__device__ __forceinline__ void st_tr(LAS bf16* M, const Acc2& acc, int wave, int lane) {
    const int m0 = (wave >> 1) * 16 + (lane >> 4) * 4, n0 = (wave & 1) * 32 + (lane & 15);
    v2u a, b; a.x = pk2(acc.t0[0], acc.t0[1]); a.y = pk2(acc.t0[2], acc.t0[3]); b.x = pk2(acc.t1[0], acc.t1[1]); b.y = pk2(acc.t1[2], acc.t1[3]);
    *(LAS v2u*)(M + n0 * LS + m0) = a; *(LAS v2u*)(M + (n0 + 16) * LS + m0) = b;
}
}
__device__ __forceinline__ void l1_rk_phase_a(const Frame& F) {
    using namespace rk;
    LAS unsigned char* L = F.lds;
    LAS bf16* Rt = (LAS bf16*)(L + 0 * MB); LAS bf16* At = (LAS bf16*)(L + 1 * MB); LAS bf16* AtT = (LAS bf16*)(L + 2 * MB); LAS bf16* Bq = (LAS bf16*)(L + 3 * MB); LAS bf16* Kq = (LAS bf16*)(L + 4 * MB);
    LAS bf16* VT = (LAS bf16*)(L + 5 * MB); LAS bf16* BhT = (LAS bf16*)(L + 6 * MB); LAS bf16* KhT = (LAS bf16*)(L + 7 * MB);
    LAS bf16* AK = (LAS bf16*)(L + 8 * MB); LAS bf16* RB = (LAS bf16*)(L + 9 * MB); LAS bf16* RK = (LAS bf16*)(L + 10 * MB);
    LAS bf16* X = (LAS bf16*)(L + 11 * MB); LAS bf16* XT = (LAS bf16*)(L + 12 * MB); LAS bf16* P = (LAS bf16*)(L + 13 * MB);
    LAS bf16* AkVT = Bq; LAS bf16* ApT = Kq; LAS bf16* W2T = X;
    LAS float* G = (LAS float*)(L + 8 * MB);
    LAS float* gl = (LAS float*)(L + 14 * MB);
    const int w = F.wave, lane = F.lane, tid = F.tid;
    const int t = lane, j0 = 8 * w;
    float fr[8], fv[8], fa[8], fw[8], fk[8], fb[8];
#define RK_LOAD(u_) do { const int ch_ = (u_) / 260, c_ = (u_) - ch_ * 260, z_ = ch_ >> 4, b_ = (ch_ >> 3) & 1, h_ = ch_ & 7; const size_t ro = ((size_t)b_ * TB + scan_tok(z_, 64 * c_ + t)) * 512 + h_ * 64 + j0; \
    const v4u xr_ = *(const v4u*)(wsp<const bf16>(F, WS_RR) + ro), xv_ = *(const v4u*)(wsp<const bf16>(F, WS_VV) + ro), xa_ = *(const v4u*)(wsp<const bf16>(F, WS_AKK) + ro), xk_ = *(const v4u*)(wsp<const bf16>(F, WS_KL) + ro), \
              xs_ = *(const v4u*)(wsp<const bf16>(F, WS_ASIG) + (size_t)z_ * R * 512 + ro); const float* p3 = wsp<const float>(F, WS_WDEC) + (size_t)z_ * R * 512 + ro; const float* pk_ = F.in[I_KA] + h_ * 64 + j0; \
    const f32x4 w0_ = *(const f32x4*)p3, w1_ = *(const f32x4*)(p3 + 4), q0_ = *(const f32x4*)pk_, q1_ = *(const f32x4*)(pk_ + 4); float sg_[8], kl_[8]; \
    unpack8(xr_, fr); unpack8(xv_, fv); unpack8(xa_, fa); unpack8(xk_, kl_); unpack8(xs_, sg_); \
    _Pragma("unroll") for (int e = 0; e < 8; ++e) { const float kav = e < 4 ? q0_[e & 3] : q1_[e & 3]; fw[e] = e < 4 ? w0_[e & 3] : w1_[e & 3]; fk[e] = kl_[e] * (1.f + (sg_[e] - 1.f) * kav); fb[e] = -fa[e] * sg_[e]; } } while (0)
    if (F.blk < NUNIT_R) RK_LOAD(F.blk);
    for (int u = F.blk; u < NUNIT_R; u += F.G) {
        const int chain = u / 260, c = u - chain * 260, z = chain >> 4, b = (chain >> 3) & 1, h = chain & 7;
        __syncthreads();
#pragma unroll
        for (int e = 0; e < 8; ++e) G[t * 65 + j0 + e] = fw[e];
        __syncthreads();
        if (tid < 64) { float g = 1.f;
#pragma unroll 16
            for (int s = 0; s < 64; ++s) { g *= G[s * 65 + tid]; G[s * 65 + tid] = g; } gl[tid] = g; }
        __syncthreads();
#pragma unroll
        for (int e = 0; e < 8; ++e) { const int j = j0 + e; const float gt = G[t * 65 + j], gp = t > 0 ? G[(t - 1) * 65 + j] : 1.f, gL = G[63 * 65 + j], ig = 1.f / gt;
            fr[e] *= gt; fa[e] *= gp; const float bq = fb[e] * ig, kq = fk[e] * ig; fb[e] = bq; fk[e] = kq; fw[e] = gL; }
        __syncthreads();
        { v4u q; q.x = pk2(fr[0], fr[1]); q.y = pk2(fr[2], fr[3]); q.z = pk2(fr[4], fr[5]); q.w = pk2(fr[6], fr[7]); *(LAS v4u*)(Rt + t * LS + j0) = q;
          q.x = pk2(fa[0], fa[1]); q.y = pk2(fa[2], fa[3]); q.z = pk2(fa[4], fa[5]); q.w = pk2(fa[6], fa[7]); *(LAS v4u*)(At + t * LS + j0) = q;
          q.x = pk2(fb[0], fb[1]); q.y = pk2(fb[2], fb[3]); q.z = pk2(fb[4], fb[5]); q.w = pk2(fb[6], fb[7]); *(LAS v4u*)(Bq + t * LS + j0) = q;
          q.x = pk2(fk[0], fk[1]); q.y = pk2(fk[2], fk[3]); q.z = pk2(fk[4], fk[5]); q.w = pk2(fk[6], fk[7]); *(LAS v4u*)(Kq + t * LS + j0) = q; }
#pragma unroll
        for (int e = 0; e < 8; ++e) { const int j = j0 + e; stb(AtT, j, t, fa[e]); stb(VT, j, t, fv[e]); stb(BhT, j, t, fb[e] * fw[e]); stb(KhT, j, t, fk[e] * fw[e]); }
        __syncthreads();
        if (u + F.G < NUNIT_R) RK_LOAD(u + F.G);
        Acc2 a1, a2, a3, a4;
        zero(a1); mm_acc(a1, At, Bq, w, lane); zero(a2); mm_acc(a2, At, Kq, w, lane); zero(a3); mm_acc(a3, Rt, Bq, w, lane); zero(a4); mm_acc(a4, Rt, Kq, w, lane);
        each(a1, w, lane, [&](int m, int n, float v) { const float x = n < m ? v : 0.f; stb(X, m, n, x); stb(XT, n, m, x); stb(P, m, n, m == n ? 1.f : 0.f); });
        each(a2, w, lane, [&](int m, int n, float v) { stb(AK, m, n, n < m ? v : 0.f); });
        each(a3, w, lane, [&](int m, int n, float v) { stb(RB, m, n, n <= m ? v : 0.f); });
        each(a4, w, lane, [&](int m, int n, float v) { stb(RK, m, n, n <= m ? v : 0.f); });
        __syncthreads();
        { const int m0 = (w >> 1) * 16 + (lane >> 4) * 4, n0 = (w & 1) * 32 + (lane & 15);
          Acc2 pt;
#pragma unroll
          for (int r = 0; r < 4; ++r) { pt.t0[r] = (m0 + r == n0) ? 1.f : 0.f; pt.t1[r] = (m0 + r == n0 + 16) ? 1.f : 0.f; }
#pragma unroll 1
          for (int i = 0; i < NEU_ROUNDS; ++i) {
            mm_acc(pt, P, XT, w, lane);
            if (i < NEU_ROUNDS - 1) { zero(a1); mm_acc(a1, X, XT, w, lane); }
            __syncthreads();
#pragma unroll
            for (int r = 0; r < 4; ++r) { stb(P, m0 + r, n0, pt.t0[r]); stb(P, m0 + r, n0 + 16, pt.t1[r]); }
            if (i < NEU_ROUNDS - 1) { each(a1, w, lane, [&](int m, int n, float v) { stb(X, m, n, v); }); st_tr(XT, a1, w, lane); }
            __syncthreads();
          } }
        zero(a1); mm_acc(a1, AK, VT, w, lane); zero(a2); mm_acc(a2, P, AtT, w, lane);
        st_tr(AkVT, a1, w, lane); st_tr(ApT, a2, w, lane);
        __syncthreads();
        zero(a3); mm_acc(a3, P, AkVT, w, lane);
        st_tr(W2T, a3, w, lane);
        __syncthreads();
        zero(a1); mm_acc(a1, RB, ApT, w, lane); zero(a2); mm_acc(a2, RB, W2T, w, lane); mm_acc(a2, RK, VT, w, lane);
        zero(a3); mm_acc(a3, BhT, ApT, w, lane); zero(a4); mm_acc(a4, BhT, W2T, w, lane); mm_acc(a4, KhT, VT, w, lane);
        __syncthreads();
        { LAS bf16* O1 = At; LAS bf16* O2 = AtT; LAS bf16* O3 = AK; LAS float* OY = (LAS float*)X;
          each(a1, w, lane, [&](int m, int n, float v) { stb(O1, m, n, v + bf2f(Rt[m * LS + n])); });
          each(a3, w, lane, [&](int m, int n, float v) { stb(O2, m, n, v + (m == n ? gl[m] : 0.f)); });
          each(a4, w, lane, [&](int m, int n, float v) { stb(O3, m, n, v); });
          each(a2, w, lane, [&](int m, int n, float v) { OY[m * 68 + n] = v; });
          __syncthreads();
          const int row = tid >> 3, c8 = (tid & 7) * 8;
          *(v4u*)(wsp<bf16>(F, WS_RKQ) + (size_t)u * 4096 + row * 64 + c8) = *(const LAS v4u*)(O1 + row * LS + c8);
          *(v4u*)(wsp<bf16>(F, WS_RKM) + (size_t)u * 4096 + row * 64 + c8) = *(const LAS v4u*)(O2 + row * LS + c8);
          *(v4u*)(wsp<bf16>(F, WS_RKZ) + (size_t)u * 4096 + row * 64 + c8) = *(const LAS v4u*)(O3 + row * LS + c8);
          bf16* Yg = wsp<bf16>(F, WS_YR) + (size_t)z * R * 512 + h * 64;
#pragma unroll
          for (int i = 0; i < 2; ++i) { const int yr = (tid >> 4) + 32 * i, c4 = (tid & 15) * 4; const f32x4 yv = *(const LAS f32x4*)(OY + yr * 68 + c4); v2u yw; yw.x = pk2(yv.x, yv.y); yw.y = pk2(yv.z, yv.w);
              *(v2u*)(Yg + ((size_t)b * TB + scan_tok(z, 64 * c + yr)) * 512 + c4) = yw; } }
    }
#undef RK_LOAD
}
__device__ __forceinline__ void l1_rk_phase_b(const Frame& F) {
    using namespace rk;
    LAS unsigned char* L = F.lds;
    const int w = F.wave, lane = F.lane, tid = F.tid, chain = F.blk, z = chain >> 4, b = (chain >> 3) & 1, h = chain & 7;
    for (int i = tid; i < 2 * 64 * LS; i += 512) ((LAS bf16*)L)[i] = 0;
    const int sr = tid >> 3, sc = (tid & 7) * 8;
    v4u gm, gq, gz;
#define RKB_LOAD(u_) do { gm = *(const v4u*)(wsp<const bf16>(F, WS_RKM) + (u_) * 4096 + sr * 64 + sc); gq = *(const v4u*)(wsp<const bf16>(F, WS_RKQ) + (u_) * 4096 + sr * 64 + sc); \
    gz = *(const v4u*)(wsp<const bf16>(F, WS_RKZ) + (u_) * 4096 + sr * 64 + sc); } while (0)
#define RKB_WRITE(par) do { *(LAS v4u*)((LAS bf16*)(L + (2 + 3 * (par)) * MB) + sr * LS + sc) = gm; *(LAS v4u*)((LAS bf16*)(L + (3 + 3 * (par)) * MB) + sr * LS + sc) = gq; \
    *(LAS v4u*)((LAS bf16*)(L + (4 + 3 * (par)) * MB) + sr * LS + sc) = gz; } while (0)
    RKB_LOAD((size_t)chain * 260); RKB_WRITE(0);
    __syncthreads();
    float* Yg = wsp<float>(F, WS_YB) + (size_t)z * R * 512 + h * 64;
    const int m0 = (w >> 1) * 16 + (lane >> 4) * 4, n0 = (w & 1) * 32 + (lane & 15);
    for (int c = 0; c < 260; ++c) {
        const size_t u = (size_t)chain * 260 + c; const int par = c & 1;
        if (c + 1 < 260) RKB_LOAD(u + 1);
        const LAS bf16* S = (const LAS bf16*)(L + par * MB); LAS bf16* Sn = (LAS bf16*)(L + (par ^ 1) * MB);
        const LAS bf16* Mt = (const LAS bf16*)(L + (2 + 3 * par) * MB); const LAS bf16* Qp = (const LAS bf16*)(L + (3 + 3 * par) * MB); const LAS bf16* Zt = (const LAS bf16*)(L + (4 + 3 * par) * MB);
        Acc2 a1, a2;
#pragma unroll
        for (int r = 0; r < 4; ++r) { a1.t0[r] = bf2f(Zt[(m0 + r) * LS + n0]); a1.t1[r] = bf2f(Zt[(m0 + r) * LS + n0 + 16]); }
        mm_acc(a1, Mt, S, w, lane); zero(a2); mm_acc(a2, Qp, S, w, lane);
        st_tr(Sn, a1, w, lane);
        if (c + 1 < 260) RKB_WRITE(par ^ 1);
#pragma unroll
        for (int r = 0; r < 4; ++r) { const size_t yo = ((size_t)b * TB + scan_tok(z, 64 * c + m0 + r)) * 512 + n0; Yg[yo] = a2.t0[r]; Yg[yo + 16] = a2.t1[r]; }
        __syncthreads();
    }
#undef RKB_LOAD
#undef RKB_WRITE
}
__device__ __forceinline__ void l1_mlstm_a2(const Frame& F) {
    using namespace rk;
    LAS bf16* KT = (LAS bf16*)F.lds; LAS bf16* VsT = KT + 64 * LS;
    LAS float* vec = (LAS float*)(F.lds + AUX_OFF); LAS int* rows = (LAS int*)vec;
    const bf16* Pg = wsp<const bf16>(F, WS_P); const int tid = F.tid, w = F.wave, lane = F.lane;
    for (int u = F.blk; u < NUNIT_M; u += F.G) {
        const int cidx = u / 260, c = u - cidx * 260, z = cidx >> 3, b = (cidx >> 2) & 1, h = cidx & 3;
        mlstm_chunk_head(F, z, b, h, c, vec);
        if (tid < 64) { const float bl = vec[128 + 63]; const float uu = bl - vec[128 + tid] + vec[64 + tid]; float m = uu;
#pragma unroll
            for (int o = 1; o < 64; o <<= 1) m = fmaxf(m, __shfl_xor(m, o));
            vec[256 + tid] = __expf(uu - m);
            if (tid == 0) { wsp<float>(F, WS_SC)[2 * u] = bl; wsp<float>(F, WS_SC)[2 * u + 1] = m; } }
        __syncthreads();
        { const int s = tid >> 3, c8 = tid & 7; float x[8]; unpack8(*(const v4u*)(Pg + (size_t)rows[s] * REC_NP + PC_K + h * 64 + 8 * c8), x);
#pragma unroll
          for (int e = 0; e < 8; ++e) stb(KT, 8 * c8 + e, s, x[e]); }
#pragma unroll
        for (int i = 0; i < 2; ++i) { const int s = (tid >> 4) + 32 * i, c8 = tid & 15; float x[8]; unpack8(*(const v4u*)(Pg + (size_t)rows[s] * REC_NP + PC_V + h * 128 + 8 * c8), x); const float sw = vec[256 + s];
#pragma unroll
            for (int e = 0; e < 8; ++e) stb(VsT, 8 * c8 + e, s, x[e] * sw); }
        __syncthreads();
        Acc2 a0, a1; zero(a0); mm_acc(a0, VsT, KT, w, lane); zero(a1); mm_acc(a1, VsT + 64 * LS, KT, w, lane);
        float* dc = wsp<float>(F, WS_DC) + (size_t)u * 8192;
        each(a0, w, lane, [&](int m, int n, float v) { dc[m * 64 + n] = 0.125f * v; });
        each(a1, w, lane, [&](int m, int n, float v) { dc[(64 + m) * 64 + n] = 0.125f * v; });
        if (tid < 64) { float a = 0.f; for (int s = 0; s < 64; ++s) a += vec[256 + s] * bf2f(KT[tid * LS + s]); wsp<float>(F, WS_DN)[(size_t)u * 64 + tid] = 0.125f * a; }
        __syncthreads();
    }
}
__device__ __forceinline__ void l1_mlstm_c2(const Frame& F, int first_blk, int nblk) {
    using namespace rk;
    LAS bf16* Q = (LAS bf16*)F.lds; LAS bf16* K = Q + 64 * LS; LAS bf16* VT = K + 64 * LS; LAS bf16* Cm = VT + 128 * LS; LAS bf16* Pm = Cm + 128 * LS;
    LAS float* OH = (LAS float*)(F.lds + 7 * MB);
    LAS float* vec = (LAS float*)(F.lds + AUX_OFF); LAS int* rows = (LAS int*)vec;
    const bf16* Pg = wsp<const bf16>(F, WS_P); const int tid = F.tid, w = F.wave, lane = F.lane;
    for (int u = F.blk - first_blk; u < NUNIT_M; u += nblk) {
        const int cidx = u / 260, c = u - cidx * 260, z = cidx >> 3, b = (cidx >> 2) & 1, h = cidx & 3;
        mlstm_chunk_head(F, z, b, h, c, vec);
        const float mst = wsp<const float>(F, WS_MST)[u];
        if (tid < 64) { const int t = tid; float pm = -3.0e38f; for (int s = 0; s <= t; ++s) pm = fmaxf(pm, vec[64 + s] - vec[128 + s]);
            const float gi = vec[128 + t] + mst, mo = fmaxf(gi, vec[128 + t] + pm); vec[320 + t] = __expf(gi - mo); vec[384 + t] = mo;
            vec[256 + t] = wsp<const float>(F, WS_NST)[(size_t)u * 64 + t]; }
        { const int t = tid >> 3, c8 = tid & 7;
          *(LAS v4u*)(Q + t * LS + 8 * c8) = *(const v4u*)(Pg + (size_t)rows[t] * REC_NP + PC_Q + h * 64 + 8 * c8);
          *(LAS v4u*)(K + t * LS + 8 * c8) = *(const v4u*)(Pg + (size_t)rows[t] * REC_NP + PC_K + h * 64 + 8 * c8); }
#pragma unroll
        for (int i = 0; i < 2; ++i) { const int s = (tid >> 4) + 32 * i, c8 = tid & 15; const v4u wv = *(const v4u*)(Pg + (size_t)rows[s] * REC_NP + PC_V + h * 128 + 8 * c8);
            const unsigned ww[4] = {wv.x, wv.y, wv.z, wv.w};
#pragma unroll
            for (int e = 0; e < 4; ++e) { VT[(8 * c8 + 2 * e) * LS + s] = (bf16)(ww[e] & 0xffffu); VT[(8 * c8 + 2 * e + 1) * LS + s] = (bf16)(ww[e] >> 16); } }
        { const int v = tid >> 2, dq = (tid & 3) * 16; const f32x4* src = (const f32x4*)(wsp<const float>(F, WS_CST) + (size_t)u * 8192 + v * 64 + dq);
          const f32x4 x0 = src[0], x1 = src[1], x2 = src[2], x3 = src[3]; v4u o0, o1;
          o0.x = pk2(x0.x, x0.y); o0.y = pk2(x0.z, x0.w); o0.z = pk2(x1.x, x1.y); o0.w = pk2(x1.z, x1.w); o1.x = pk2(x2.x, x2.y); o1.y = pk2(x2.z, x2.w); o1.z = pk2(x3.x, x3.y); o1.w = pk2(x3.z, x3.w);
          *(LAS v4u*)(Cm + v * LS + dq) = o0; *(LAS v4u*)(Cm + v * LS + dq + 8) = o1; }
        __syncthreads();
        Acc2 aq, c0, c1; zero(aq); mm_acc(aq, Q, K, w, lane); zero(c0); mm_acc(c0, Q, Cm, w, lane); zero(c1); mm_acc(c1, Q, Cm + 64 * LS, w, lane);
        each(aq, w, lane, [&](int t, int s, float v) { stb(Pm, t, s, s <= t ? 0.125f * v * __expf(vec[128 + t] + (vec[64 + s] - vec[128 + s]) - vec[384 + t]) : 0.f); });
        __syncthreads();
        Acc2 p0, p1; zero(p0); mm_acc(p0, Pm, VT, w, lane); zero(p1); mm_acc(p1, Pm, VT + 64 * LS, w, lane);
        if (tid < 64) { const int t = tid; float rs = 0.f, nq = 0.f;
            for (int s = 0; s < 64; ++s) { rs += bf2f(Pm[t * LS + s]); nq += vec[256 + s] * bf2f(Q[t * LS + s]); }
            const float den = vec[320 + t] * nq + rs; vec[448 + t] = 1.f / fmaxf(fabsf(den), __expf(-vec[384 + t])); }
        __syncthreads();
        { const int m0 = (w >> 1) * 16 + (lane >> 4) * 4, n0 = (w & 1) * 32 + (lane & 15);
#pragma unroll
          for (int r = 0; r < 4; ++r) { const int t = m0 + r; const float g = vec[320 + t], idn = vec[448 + t];
              OH[t * 132 + n0] = (g * c0.t0[r] + p0.t0[r]) * idn; OH[t * 132 + n0 + 16] = (g * c0.t1[r] + p0.t1[r]) * idn;
              OH[t * 132 + 64 + n0] = (g * c1.t0[r] + p1.t0[r]) * idn; OH[t * 132 + 64 + n0 + 16] = (g * c1.t1[r] + p1.t1[r]) * idn; } }
        __syncthreads();
#pragma unroll
        for (int i = 0; i < 4; ++i) { const int it = tid + 512 * i, t = it >> 5, c4 = (it & 31) * 4;
            const f32x4 hv = *(const LAS f32x4*)(OH + t * 132 + c4); v2u hw; hw.x = pk2(hv.x, hv.y); hw.y = pk2(hv.z, hv.w);
            *(v2u*)(wsp<bf16>(F, WS_HM) + ((size_t)z * R + rows[t]) * 512 + h * 128 + c4) = hw; }
        __syncthreads();
    }
}
#ifndef MK_PER_PHASE
#define MK_PER_PHASE 0
#endif
constexpr int NPHASE = 26;
struct Args { const float* in[N_IN]; float* out; unsigned char* ws; int ph_lo, ph_hi, li, pad; };
#define GEMM_CALL(FnT, SchedT, g, S, fn) do { pg8::EpiGen<FnT> E_{fn}; { int k_ = g.K; asm volatile("" : "+s"(k_)); g.K = k_; } pg8::gemm_phase<pg8::EpiGen<FnT>, SchedT, true, true>((PG8_LAS unsigned char*)F.lds, g, S, E_); } while (0)
#ifndef SITE_MASK
#define SITE_MASK 0xFFFFFFFFull
#endif
#define SITE(s) (((SITE_MASK) >> (s)) & 1ull)
#ifndef DUP_MASK
#define DUP_MASK 0ull
#endif
#define NREP(s) ((((DUP_MASK) >> (s)) & 1ull) ? 2 : 1)
#define IN(k) (lo <= (k) && (k) < hi)
#define SEAM(k) do { if (IN(k) && IN((k) + 1)) xcd_barrier(bar); } while (0)
template <int LAYER> __device__ __forceinline__ void layer_phases(const Frame& F, const XcdBarrier& bar, const int lo, const int hi) {
    constexpr int layer = LAYER; constexpr int pb = 2 + 12 * LAYER;
        if (SITE(2) && IN(pb + 0)) { for (int rep_ = 0; rep_ < NREP(2); ++rep_) {
            const int N = layer == 0 ? ATT_NP : REC_NP;
            pg8::Gemm g{wsp<const bf16>(F, WS_A), layer == 0 ? wsp<const bf16>(F, WS_WIN0) : wsp<const bf16>(F, WS_WREC), R, N, 1024};
            pg8::StaticOrder S; S.init(R, N, F.G, F.blk);
            GEMM_CALL(FnStoreBf16, pg8::StaticOrder, g, S, (FnStoreBf16{wsp<bf16>(F, WS_P), N}));
             if (rep_ + 1 < NREP(2)) xcd_barrier(bar); } SEAM(pb + 0);
        }
        if constexpr (LAYER == 0) {
            if (SITE(3) && IN(pb + 1)) { for (int rep_ = 0; rep_ < NREP(3); ++rep_) { l0_post_proj(F);  if (rep_ + 1 < NREP(3)) xcd_barrier(bar); } SEAM(pb + 1); }
            if (SITE(4) && IN(pb + 2)) { for (int rep_ = 0; rep_ < NREP(4); ++rep_) {
                pg8::Gemm g{wsp<const bf16>(F, WS_CQN), wsp<const bf16>(F, WS_WUQ), R, 768, 384}; pg8::StaticOrder S; S.init(R, 768, F.G, F.blk);
                GEMM_CALL(FnStoreBf16, pg8::StaticOrder, g, S, (FnStoreBf16{wsp<bf16>(F, WS_MQ), 768}));
                 if (rep_ + 1 < NREP(4)) xcd_barrier(bar); } SEAM(pb + 2);
            }
            if (SITE(5) && IN(pb + 3)) { for (int rep_ = 0; rep_ < NREP(5); ++rep_) {
                pg8::Gemm g{wsp<const bf16>(F, WS_CKVN), wsp<const bf16>(F, WS_WUKV), R, 1024, 256}; pg8::StaticOrder S; S.init(R, 1024, F.G, F.blk);
                GEMM_CALL(FnStoreBf16, pg8::StaticOrder, g, S, (FnStoreBf16{wsp<bf16>(F, WS_MKV), 1024}));
                l0_mq_rope(F);
                 if (rep_ + 1 < NREP(5)) xcd_barrier(bar); } SEAM(pb + 3);
            }
            if (SITE(6) && IN(pb + 4)) { for (int rep_ = 0; rep_ < NREP(6); ++rep_) { l0_attention(F);  if (rep_ + 1 < NREP(6)) xcd_barrier(bar); } SEAM(pb + 4); }
            if (SITE(7) && IN(pb + 5)) { for (int rep_ = 0; rep_ < NREP(7); ++rep_) { l0_combine(F);  if (rep_ + 1 < NREP(7)) xcd_barrier(bar); } SEAM(pb + 5); }
        } else {
            if (SITE(8) && IN(pb + 1)) { for (int rep_ = 0; rep_ < NREP(8); ++rep_) { l1_rwkv_prep(F); l1_mlstm_a2(F);  if (rep_ + 1 < NREP(8)) xcd_barrier(bar); } SEAM(pb + 1); }
            if (SITE(9) && IN(pb + 2)) { for (int rep_ = 0; rep_ < NREP(9); ++rep_) {
                pg8::Gemm g{wsp<const bf16>(F, WS_ALORA), wsp<const bf16>(F, WS_WLORA), R, 2560, 384}; pg8::StaticOrder S; S.init(R, 2560, F.G, F.blk);
                { int k_ = g.K; asm volatile("" : "+s"(k_)); g.K = k_; EpiLora E_{&F}; pg8::gemm_phase<EpiLora, pg8::StaticOrder, true, true>((PG8_LAS unsigned char*)F.lds, g, S, E_); }
                l1_mlstm_b(F);
                 if (rep_ + 1 < NREP(9)) xcd_barrier(bar); } SEAM(pb + 2);
            }
            if (SITE(18) && IN(pb + 3)) { for (int rep_ = 0; rep_ < NREP(18); ++rep_) { l1_rk_phase_a(F); if (rep_ + 1 < NREP(18)) xcd_barrier(bar); } SEAM(pb + 3); }
            if (SITE(10) && IN(pb + 4)) { for (int rep_ = 0; rep_ < NREP(10); ++rep_) {
                if (F.G > 32) { if (F.blk < 32) l1_rk_phase_b(F); else { l1_mlstm_c2(F, 32, F.G - 32); moe_weights_convert(F, 1, (F.blk - 32) * 8 + F.wave, (F.G - 32) * 8); } }
                 if (rep_ + 1 < NREP(10)) xcd_barrier(bar); } SEAM(pb + 4);
            }
            if (SITE(11) && IN(pb + 5)) { for (int rep_ = 0; rep_ < NREP(11); ++rep_) { l1_rec_out(F);  if (rep_ + 1 < NREP(11)) xcd_barrier(bar); } SEAM(pb + 5); }
        }
        if (SITE(12) && IN(pb + 6)) { for (int rep_ = 0; rep_ < NREP(12); ++rep_) {
            pg8::Gemm g{wsp<const bf16>(F, WS_A1), wsp<const bf16>(F, WS_WOUT) + (size_t)layer * 1024 * 1024, R, 1024, 1024};
            if constexpr (LAYER == 0) { pg8::StaticOrder S; S.init(R, 1024, F.G, F.blk); GEMM_CALL(FnWout, pg8::StaticOrder, g, S, (FnWout{&F, layer})); }
            else { LatOrder S; S.o.init(R - 2 * CT, 1024, F.G, F.blk); GEMM_CALL(FnWout, LatOrder, g, S, (FnWout{&F, layer})); }
             if (rep_ + 1 < NREP(12)) xcd_barrier(bar); } SEAM(pb + 6);
        }
        if (SITE(13) && IN(pb + 7)) { for (int rep_ = 0; rep_ < NREP(13); ++rep_) { ph_router(F, layer);  if (rep_ + 1 < NREP(13)) xcd_barrier(bar); } SEAM(pb + 7); }
        if (SITE(14) && IN(pb + 8)) { for (int rep_ = 0; rep_ < NREP(14); ++rep_) { ph_gather(F, layer);  if (rep_ + 1 < NREP(14)) xcd_barrier(bar); } SEAM(pb + 8); }
        if (SITE(15) && IN(pb + 9)) { for (int rep_ = 0; rep_ < NREP(15); ++rep_) {
            const int* tab = wsp<const int>(F, WS_TILE);
            pg8::Gemm g{wsp<const bf16>(F, WS_F), wsp<const bf16>(F, WS_W1T), MAXROWS, NE * 2048, 1024}; MoeOrder S{tab + 1, __builtin_amdgcn_readfirstlane(tab[0]), 8, F.G, F.blk, wsp<const int>(F, WS_SRC)};
            { int k_ = g.K; asm volatile("" : "+s"(k_)); g.K = k_; pg8::EpiGen<FnSwiglu> E_{FnSwiglu{wsp<bf16>(F, WS_HS), F.in[I_B1] + (size_t)layer * NE * 2048}};
              pg8::gemm_phase<pg8::EpiGen<FnSwiglu>, MoeOrder, true, true, true>((PG8_LAS unsigned char*)F.lds, g, S, E_); }
             if (rep_ + 1 < NREP(15)) xcd_barrier(bar); } SEAM(pb + 9);
        }
        if (SITE(16) && IN(pb + 10)) { for (int rep_ = 0; rep_ < NREP(16); ++rep_) {
            const int* tab = wsp<const int>(F, WS_TILE);
            pg8::Gemm g{wsp<const bf16>(F, WS_HS), wsp<const bf16>(F, WS_W2T), MAXROWS, NE * 1024, 1024}; MoeOrder S{tab + 1, __builtin_amdgcn_readfirstlane(tab[0]), 4, F.G, F.blk, nullptr};
            GEMM_CALL(FnBiasBf16, MoeOrder, g, S, (FnBiasBf16{wsp<bf16>(F, WS_XS), F.in[I_B2] + (size_t)layer * NE * 1024}));
             if (rep_ + 1 < NREP(16)) xcd_barrier(bar); } SEAM(pb + 10);
        }
        if (SITE(17) && IN(pb + 11)) { for (int rep_ = 0; rep_ < NREP(17); ++rep_) { ph_combine(F, layer);  if (rep_ + 1 < NREP(17)) xcd_barrier(bar); } SEAM(pb + 11); }
}
__global__ void __launch_bounds__(512, 2) fwd(Args args) {
    extern __shared__ __attribute__((aligned(16))) unsigned char lds_[];
    Frame F;
    F.lds = (LAS unsigned char*)lds_; F.tid = threadIdx.x; F.lane = F.tid & 63; F.wave = __builtin_amdgcn_readfirstlane(F.tid >> 6); F.blk = blockIdx.x; F.G = gridDim.x; F.probe = args.pad;
    F.ws = args.ws; F.out = args.out; F.ctl = (gu32*)(args.ws + WS_CTL);
    F.in.t = (LAS const unsigned*)(F.lds + MISC_OFF + 8192);
    if (F.tid < 64) ((LAS unsigned*)(F.lds + MISC_OFF))[F.tid] = 0u;
    if (F.tid < N_IN) { const unsigned long long pv = (unsigned long long)args.in[F.tid]; ((LAS unsigned*)(F.lds + MISC_OFF + 8192))[2 * F.tid] = (unsigned)pv; ((LAS unsigned*)(F.lds + MISC_OFF + 8192))[2 * F.tid + 1] = (unsigned)(pv >> 32); }
    __syncthreads();
    const int lo = args.ph_lo, hi = args.ph_hi;
    XcdBarrier bar; bar.bar = (unsigned*)(F.ctl + CW_BAR) + args.li * XCD_BAR_WORDS; bar.x = 0; bar.st = nullptr;
    if (hi - lo > 1) bar = xcd_barrier_post((unsigned*)(F.ctl + CW_BAR) + args.li * XCD_BAR_WORDS, (volatile LAS unsigned*)(F.lds + MISC_OFF));
    if (SITE(0) && IN(0)) { for (int rep_ = 0; rep_ < NREP(0); ++rep_) { p0a(F);  if (rep_ + 1 < NREP(0)) xcd_barrier(bar); } SEAM(0); }
    if (SITE(1) && IN(1)) { for (int rep_ = 0; rep_ < NREP(1); ++rep_) { p0b(F);  if (rep_ + 1 < NREP(1)) xcd_barrier(bar); } SEAM(1); }
    layer_phases<0>(F, bar, lo, hi);
    layer_phases<1>(F, bar, lo, hi);
}
#undef IN
#undef SEAM


extern "C" void kernel_launch(void* const* d_in, const int* in_sizes, int n_in, void* d_out, int out_size, void* d_ws, size_t ws_size, hipStream_t stream) {
    static int grid = 0;
    if (grid == 0) {
        const bool ok = n_in == N_IN && in_sizes[I_X] == NBATCH * SEQ * DM && in_sizes[I_RECW] == 1024 * REC_IN && in_sizes[I_ATTW] == 1024 * ATT_IN && in_sizes[I_MU] == RWKV_IN &&
                        in_sizes[I_GATEB] == 16 && in_sizes[I_W1] == 2 * NE * 1024 * 2048 && out_size == NBATCH * SEQ * DM && ws_size >= WS_END;
        if (!ok) { fprintf(stderr, "kernel_launch: shape mismatch (n_in %d, recw %d, attw %d, mu %d, out %d, ws %zu need %zu); nothing launched\n", n_in, n_in > I_RECW ? in_sizes[I_RECW] : -1,
                           n_in > I_ATTW ? in_sizes[I_ATTW] : -1, n_in > I_MU ? in_sizes[I_MU] : -1, out_size, ws_size, (size_t)WS_END); grid = -1; return; }
        int dev = 0, cus = 0;
        if (hipGetDevice(&dev) != hipSuccess || hipDeviceGetAttribute(&cus, hipDeviceAttributeMultiprocessorCount, dev) != hipSuccess) { grid = -1; return; }
        if (hipFuncSetAttribute((const void*)fwd, hipFuncAttributeMaxDynamicSharedMemorySize, LDS_BYTES) != hipSuccess) { fprintf(stderr, "kernel_launch: hipFuncSetAttribute failed\n"); grid = -1; return; }
        int per_cu = 0;
        if (hipOccupancyMaxActiveBlocksPerMultiprocessor(&per_cu, (const void*)fwd, 512, LDS_BYTES) != hipSuccess || per_cu < 1) { fprintf(stderr, "kernel_launch: occupancy query says %d blocks per CU\n", per_cu); }
        (void)hipGetLastError();
        grid = cus < 256 ? cus : 256;
        if (grid != 256) fprintf(stderr, "kernel_launch: %d CUs; this kernel is written for a 256-CU device\n", cus);
    }
    if (grid < 0) return;
    if (hipMemsetAsync((char*)d_ws + WS_CTL, 0, CTL_ZERO_BYTES, stream) != hipSuccess) return;
    Args a{};
    for (int i = 0; i < N_IN; ++i) a.in[i] = (const float*)d_in[i];
    a.out = (float*)d_out; a.ws = (unsigned char*)d_ws; a.pad = 0;
#if MK_PER_PHASE
    for (int ph = 0; ph < NPHASE; ++ph) { a.ph_lo = ph; a.ph_hi = ph + 1; a.li = 0; hipLaunchKernelGGL(fwd, dim3(grid), dim3(512), LDS_BYTES, stream, a); }
#elif defined(PROBE_PRE)
    { const int plist[] = {PROBE_PRE}; int cur = 0, li = 0;
      for (int p : plist) { if (p > cur) { a.ph_lo = cur; a.ph_hi = p; a.li = li++; hipLaunchKernelGGL(fwd, dim3(grid), dim3(512), LDS_BYTES, stream, a); }
                            a.ph_lo = p; a.ph_hi = p + 1; a.li = li++; a.pad = 1; hipLaunchKernelGGL(fwd, dim3(grid), dim3(512), LDS_BYTES, stream, a); a.pad = 0; cur = p; }
      a.ph_lo = cur; a.ph_hi = NPHASE; a.li = li++; hipLaunchKernelGGL(fwd, dim3(grid), dim3(512), LDS_BYTES, stream, a); }
#elif defined(PROBE_LIST)
    { const int plist[] = {PROBE_LIST}; int cur = 0, li = 0;
      for (int p : plist) { a.ph_lo = cur; a.ph_hi = p + 1; a.li = li++; hipLaunchKernelGGL(fwd, dim3(grid), dim3(512), LDS_BYTES, stream, a);
                            a.ph_lo = p; a.ph_hi = p + 1; a.li = li++; a.pad = 1; hipLaunchKernelGGL(fwd, dim3(grid), dim3(512), LDS_BYTES, stream, a); a.pad = 0; cur = p + 1; }
      if (cur < NPHASE) { a.ph_lo = cur; a.ph_hi = NPHASE; a.li = li++; hipLaunchKernelGGL(fwd, dim3(grid), dim3(512), LDS_BYTES, stream, a); } }
#else
    a.ph_lo = 0; a.ph_hi = NPHASE; a.li = 0; hipLaunchKernelGGL(fwd, dim3(grid), dim3(512), LDS_BYTES, stream, a);
#endif
    const hipError_t le = hipPeekAtLastError();
    if (le != hipSuccess) fprintf(stderr, "kernel_launch: launch failed: %s\n", hipGetErrorName(le));
}
```

```cpp
#include <hip/hip_runtime.h>
#include <cstdio>
#include <cstdint>
#define MK_PER_PHASE 0
namespace pg8 {
#define PG8_LAS __attribute__((address_space(3)))
typedef unsigned short bf16_t;
typedef short bf16x8 __attribute__((ext_vector_type(8)));
typedef float f32x4 __attribute__((ext_vector_type(4)));
typedef unsigned u32x4 __attribute__((ext_vector_type(4)));
constexpr int BM = 256, BK = 64, HALF = 128, HTB = HALF * BK * 2  , STAGE_BYTES = 8 * HTB, NXCD = 8, WGM = 8;

__host__ __device__ __forceinline__ int lds_byte(int r, int c) { const int st = (r >> 4) * 2 + (c >> 5), rr = r & 15, cc = c & 31, ob = rr * 64 + cc * 2; return st * 1024 + (ob ^ (((ob >> 9) & 1) << 5)); }
__host__ __device__ __forceinline__ void stage_rc(int b, int& R, int& C) { const int st = b / 1024, sb = b % 1024, swz = sb ^ (((sb >> 9) & 1) << 5); R = (st >> 1) * 16 + swz / 64; C = (st & 1) * 32 + (swz % 64) / 2; }
__host__ __device__ __forceinline__ int perm32(int rho) { const int n = rho >> 4, i = rho & 15; return 8 * (i >> 2) + 4 * n + (i & 3); }

struct Unit { int pm, pn; };
struct Gemm { const bf16_t* A; const bf16_t* Bt; int M, N, K; };

struct StaticOrder {
    int nM, nN, nwg, G, c;
    __host__ __device__ void init(int M, int N, int G_, int c_) { nM = M / BM; nN = N / BM; nwg = nM * nN; G = G_; c = c_; }
    __host__ __device__ bool next(int i, Unit& u) const {
        const long L = (long)i * G + c; if (L >= nwg) return false;
        int wgid = (int)L; { const int q = nwg / NXCD, r = nwg % NXCD, xcd = wgid % NXCD, off = wgid / NXCD; wgid = (xcd < r ? xcd * (q + 1) : r * (q + 1) + (xcd - r) * q) + off; }
        const int nig = WGM * nN, gid = wgid / nig, fm = gid * WGM, gsz = (nM - fm) < WGM ? (nM - fm) : WGM;
        u.pm = fm + ((wgid % nig) % gsz); u.pn = (wgid % nig) / gsz; return true;
    }
    __device__ __forceinline__ void a_ready(const Unit&) const {}
    __device__ __forceinline__ void done(const Unit&) const {}
};

__device__ __forceinline__ unsigned cvt_pk_bf16(float lo, float hi) { unsigned r; asm volatile("v_cvt_pk_bf16_f32 %0, %1, %2" : "=v"(r) : "v"(lo), "v"(hi)); return r; }
template <class Fn> struct EpiGen {
    static constexpr bool PERM = true, AFTER_DRAIN = false;
    Fn fn;
    __device__ __forceinline__ void operator()(const f32x4 (&acc)[2][2][4][2], const Unit& u, int wr, int wc, int fr, int fq) const {
#pragma unroll
        for (int ai = 0; ai < 2; ++ai)
#pragma unroll
            for (int m = 0; m < 4; ++m) { const int row = u.pm * BM + ai * HALF + wr * 64 + m * 16 + fr;
#pragma unroll
                for (int bj = 0; bj < 2; ++bj) { const int col = u.pn * BM + bj * HALF + wc * 32 + 8 * fq; fn(row, col, acc[ai][bj][m][0], acc[ai][bj][m][1]); } }
    }
};
template <class Epi, class Sched, bool ALIGN_EPI = false, bool SP2 = false, bool GATHER = false>
__device__ __forceinline__ void gemm_phase(PG8_LAS unsigned char* lds, const Gemm g, const Sched& S, const Epi& E) {
    static_assert(!GATHER || SP2, "the gathered A path is written for the SP2 loop");
    const int tid = threadIdx.x, wid = __builtin_amdgcn_readfirstlane(tid >> 6), lane = tid & 63, wr = wid >> 2, wc = wid & 3, fr = lane & 15, fq = lane >> 4;
    const int K = g.K, nt = K / BK;
    unsigned voffA[2], voffB[2]; int gR[2], gC[2]; unsigned gA[2][2], gN[2][2];
#pragma unroll
    for (int i = 0; i < 2; ++i) { int R, C; stage_rc(tid * 16 + i * 8192, R, C); const int Rb = Epi::PERM ? ((R & ~31) + perm32(R & 31)) : R;
        voffA[i] = (unsigned)(R * K + C) * 2u; voffB[i] = (unsigned)(Rb * K + C) * 2u; gR[i] = R; gC[i] = C; }
    const size_t kstep = (size_t)(BK * 2);
    const size_t hstep = (size_t)HALF * K * 2;
    const size_t tstep = 2 * hstep;
    const unsigned ldsw = (unsigned)wid * 1024u;
    const int aoff = lds_byte(wr * 64 + fr, fq * 8), boff = lds_byte(wc * 32 + fr, fq * 8);
#define PG8_SA(b, h) (((b) * 2 + (h)) * HTB)
#define PG8_SB(b, h) ((4 + (b) * 2 + (h)) * HTB)
#define PG8_STAGE(bufoff, gbase, voff) do { _Pragma("unroll") for (int _i = 0; _i < 2; ++_i) \
        __builtin_amdgcn_global_load_lds((const unsigned*)((const char*)(gbase) + (voff)[_i]), (PG8_LAS unsigned*)(lds + (bufoff) + ldsw + _i * 8192), 16, 0, 0); } while (0)
#define PG8_GOFF(u_, out_) do { _Pragma("unroll") for (int _h = 0; _h < 2; ++_h) _Pragma("unroll") for (int _i = 0; _i < 2; ++_i) \
        out_[_h][_i] = ((unsigned)S.src[(u_).pm * BM + _h * HALF + gR[_i]] * (unsigned)K + (unsigned)gC[_i]) * 2u; } while (0)
#define PG8_STAGE_A(bufoff, kptr, h, isnext) do { if constexpr (GATHER) { unsigned _o[2]; _o[0] = (isnext) ? gN[h][0] : gA[h][0]; _o[1] = (isnext) ? gN[h][1] : gA[h][1]; PG8_STAGE(bufoff, kptr, _o); } \
        else { PG8_STAGE(bufoff, (kptr) + (h) * hstep, voffA); } } while (0)
#define PG8_LDA(dst, b, h) do { _Pragma("unroll") for (int m = 0; m < 4; ++m) _Pragma("unroll") for (int k = 0; k < 2; ++k) dst[m][k] = *(const PG8_LAS bf16x8*)(lds + PG8_SA(b, h) + aoff + m * 2048 + k * 1024); } while (0)
#define PG8_LDB(dst, b, h) do { _Pragma("unroll") for (int n = 0; n < 2; ++n) _Pragma("unroll") for (int k = 0; k < 2; ++k) dst[n][k] = *(const PG8_LAS bf16x8*)(lds + PG8_SB(b, h) + boff + n * 2048 + k * 1024); } while (0)
#define PG8_MMA(ai, bj, At, Bt) do { __builtin_amdgcn_s_setprio(1); _Pragma("unroll") for (int m = 0; m < 4; ++m) _Pragma("unroll") for (int n = 0; n < 2; ++n) _Pragma("unroll") for (int k = 0; k < 2; ++k) \
        acc[ai][bj][m][n] = __builtin_amdgcn_mfma_f32_16x16x32_bf16(Bt[n][k], At[m][k], acc[ai][bj][m][n], 0, 0, 0); __builtin_amdgcn_s_setprio(0); } while (0)
#define PG8_WAIT_V(n) asm volatile("s_waitcnt vmcnt(" #n ")" ::: "memory")
#define PG8_WAIT_L(n) asm volatile("s_waitcnt lgkmcnt(" #n ")" ::: "memory")
#define PG8_BAR __builtin_amdgcn_s_barrier()
#define PG8_SCHED __builtin_amdgcn_sched_barrier(0)
    Unit cur, nxt; int ui = 0;
    if (!S.next(0, cur)) return;
    f32x4 acc[2][2][4][2];
#pragma unroll
    for (int a = 0; a < 2; ++a)
#pragma unroll
        for (int b = 0; b < 2; ++b)
#pragma unroll
            for (int m = 0; m < 4; ++m)
#pragma unroll
                for (int n = 0; n < 2; ++n) acc[a][b][m][n] = (f32x4){0.f, 0.f, 0.f, 0.f};
    bf16x8 At[4][2], B0[2][2], B1[2][2];
    const char* cA = (const char*)g.A + (GATHER ? (size_t)0 : (size_t)cur.pm * tstep); const char* cB = (const char*)g.Bt + (size_t)cur.pn * tstep;
    if constexpr (GATHER) PG8_GOFF(cur, gA);
    S.a_ready(cur);
    if constexpr (SP2) {
        PG8_STAGE(PG8_SB(0, 0), cB, voffB); PG8_STAGE(PG8_SB(0, 1), cB + hstep, voffB); PG8_STAGE_A(PG8_SA(0, 0), cA, 0, false); PG8_STAGE_A(PG8_SA(0, 1), cA, 1, false);
        if (wr == 1) PG8_BAR;
        PG8_WAIT_V(2); PG8_BAR;
        PG8_STAGE(PG8_SB(1, 0), cB + kstep, voffB); PG8_STAGE_A(PG8_SA(1, 0), cA + kstep, 0, false); PG8_STAGE(PG8_SB(1, 1), cB + hstep + kstep, voffB);
        PG8_WAIT_V(6); PG8_BAR;
    } else {
        PG8_STAGE(PG8_SB(0, 0), cB, voffB); PG8_STAGE(PG8_SA(0, 0), cA, voffA); PG8_STAGE(PG8_SB(0, 1), cB + hstep, voffB); PG8_STAGE(PG8_SA(0, 1), cA + hstep, voffA);
        if (wr == 1) PG8_BAR;
        PG8_WAIT_V(4); PG8_BAR;
        PG8_STAGE(PG8_SB(1, 0), cB + kstep, voffB); PG8_STAGE(PG8_SA(1, 0), cA + kstep, voffA); PG8_STAGE(PG8_SB(1, 1), cB + hstep + kstep, voffB);
        PG8_WAIT_V(6); PG8_BAR;
    }
    for (;;) {
        const bool has_next = S.next(ui + 1, nxt);
        const char* nA = (has_next && !GATHER) ? (const char*)g.A + (size_t)nxt.pm * tstep : cA; const char* nB = has_next ? (const char*)g.Bt + (size_t)nxt.pn * tstep : cB;
        if constexpr (GATHER) { if (has_next) PG8_GOFF(nxt, gN); else { _Pragma("unroll") for (int _h = 0; _h < 2; ++_h) { gN[_h][0] = gA[_h][0]; gN[_h][1] = gA[_h][1]; } } }
        for (int t = 0; t < nt; t += 2) {
            const bool last = (t == nt - 2);
            const char* a1 = cA + (size_t)(t + 1) * kstep;
            const char* a2 = last ? nA : cA + (size_t)(t + 2) * kstep; const char* b2 = last ? nB : cB + (size_t)(t + 2) * kstep;
            const char* a3 = a2 + kstep; const char* b3 = b2 + kstep;
            if (last && has_next) S.a_ready(nxt);
            if constexpr (SP2) {
            PG8_LDB(B0, 0, 0); PG8_LDB(B1, 0, 1); PG8_SCHED; PG8_LDA(At, 0, 0); PG8_STAGE_A(PG8_SA(1, 1), a1, 1, false);
            PG8_WAIT_V(8); PG8_WAIT_L(0); PG8_BAR; PG8_MMA(0, 0, At, B0); PG8_MMA(0, 1, At, B1); PG8_BAR; PG8_SCHED;
            PG8_LDA(At, 0, 1); PG8_STAGE(PG8_SB(0, 0), b2, voffB); PG8_STAGE(PG8_SB(0, 1), b2 + hstep, voffB); PG8_STAGE_A(PG8_SA(0, 0), a2, 0, last);
            PG8_WAIT_V(8); PG8_WAIT_L(0); PG8_BAR; PG8_MMA(1, 0, At, B0); PG8_MMA(1, 1, At, B1); PG8_BAR; PG8_SCHED;
            PG8_LDB(B0, 1, 0); PG8_LDB(B1, 1, 1); PG8_SCHED; PG8_LDA(At, 1, 0); PG8_STAGE_A(PG8_SA(0, 1), a2, 1, last);
            PG8_WAIT_V(8); PG8_WAIT_L(0); PG8_BAR; PG8_MMA(0, 0, At, B0); PG8_MMA(0, 1, At, B1); PG8_BAR; PG8_SCHED;
            PG8_LDA(At, 1, 1); PG8_STAGE(PG8_SB(1, 0), b3, voffB); PG8_STAGE(PG8_SB(1, 1), b3 + hstep, voffB); PG8_STAGE_A(PG8_SA(1, 0), a3, 0, last);
            PG8_WAIT_V(8); PG8_WAIT_L(0); PG8_BAR; PG8_MMA(1, 0, At, B0); PG8_MMA(1, 1, At, B1); PG8_BAR; PG8_SCHED;
            } else {
            PG8_LDB(B0, 0, 0); PG8_SCHED; PG8_LDA(At, 0, 0); PG8_STAGE(PG8_SA(1, 1), a1 + hstep, voffA);
            PG8_WAIT_L(8); PG8_BAR; PG8_WAIT_L(0); PG8_MMA(0, 0, At, B0); PG8_BAR; PG8_SCHED;
            PG8_LDB(B1, 0, 1); PG8_STAGE(PG8_SB(0, 0), b2, voffB);
            PG8_BAR; PG8_WAIT_L(0); PG8_MMA(0, 1, At, B1); PG8_BAR;
            PG8_LDA(At, 0, 1); PG8_STAGE(PG8_SA(0, 0), a2, voffA);
            PG8_BAR; PG8_WAIT_L(0); PG8_MMA(1, 0, At, B0); PG8_BAR; PG8_SCHED;
            PG8_STAGE(PG8_SB(0, 1), b2 + hstep, voffB);
            PG8_WAIT_V(6); PG8_BAR; PG8_MMA(1, 1, At, B1); PG8_BAR;
            PG8_LDB(B0, 1, 0); PG8_SCHED; PG8_LDA(At, 1, 0); PG8_STAGE(PG8_SA(0, 1), a2 + hstep, voffA);
            PG8_WAIT_L(8); PG8_BAR; PG8_WAIT_L(0); PG8_MMA(0, 0, At, B0); PG8_BAR; PG8_SCHED;
            PG8_LDB(B1, 1, 1); PG8_STAGE(PG8_SB(1, 0), b3, voffB);
            PG8_BAR; PG8_WAIT_L(0); PG8_MMA(0, 1, At, B1); PG8_BAR;
            PG8_LDA(At, 1, 1); PG8_STAGE(PG8_SA(1, 0), a3, voffA);
            PG8_BAR; PG8_WAIT_L(0); PG8_MMA(1, 0, At, B0); PG8_BAR; PG8_SCHED;
            PG8_STAGE(PG8_SB(1, 1), b3 + hstep, voffB);
            PG8_WAIT_V(6); PG8_BAR; PG8_MMA(1, 1, At, B1); PG8_BAR;
            }
        }
        if constexpr (ALIGN_EPI) { if (wr == 0) PG8_BAR; }
        if constexpr (!Epi::AFTER_DRAIN) { E(acc, cur, wr, wc, fr, fq); S.done(cur); }
        if (!has_next) break;
#pragma unroll
        for (int a = 0; a < 2; ++a)
#pragma unroll
            for (int b = 0; b < 2; ++b)
#pragma unroll
                for (int m = 0; m < 4; ++m)
#pragma unroll
                    for (int n = 0; n < 2; ++n) acc[a][b][m][n] = (f32x4){0.f, 0.f, 0.f, 0.f};
        cur = nxt; cA = nA; cB = nB; ++ui;
        if constexpr (GATHER) { _Pragma("unroll") for (int _h = 0; _h < 2; ++_h) { gA[_h][0] = gN[_h][0]; gA[_h][1] = gN[_h][1]; } }
        if constexpr (ALIGN_EPI) { if (wr == 1) PG8_BAR; }
    }
    PG8_WAIT_V(0);
    if constexpr (!ALIGN_EPI) { if (wr == 0) PG8_BAR; }
    PG8_BAR;
    if constexpr (Epi::AFTER_DRAIN) { E.fused(acc, cur, wr, wc, fr, fq, lds, wid, lane); S.done(cur); }
#undef PG8_SA
#undef PG8_SB
#undef PG8_STAGE
#undef PG8_STAGE_A
#undef PG8_GOFF
#undef PG8_LDA
#undef PG8_LDB
#undef PG8_MMA
#undef PG8_WAIT_V
#undef PG8_WAIT_L
#undef PG8_BAR
#undef PG8_SCHED
}
}
#define GAS __attribute__((address_space(1)))
#define LAS __attribute__((address_space(3)))
typedef unsigned short bf16;
typedef unsigned v4u __attribute__((ext_vector_type(4)));
typedef unsigned v2u __attribute__((ext_vector_type(2)));
typedef float f32x4 __attribute__((ext_vector_type(4)));
typedef short bf16x8 __attribute__((ext_vector_type(8)));
typedef GAS unsigned gu32;
typedef GAS unsigned long long gu64;
#define RLX_AGENT __ATOMIC_RELAXED, __HIP_MEMORY_SCOPE_AGENT
#define LDS_WAIT() asm volatile("s_waitcnt lgkmcnt(0)" ::: "memory")
#define VM_WAIT() asm volatile("s_waitcnt vmcnt(0)" ::: "memory")
typedef float f32x2_cv __attribute__((ext_vector_type(2)));
typedef __bf16 bf16x2_cv __attribute__((ext_vector_type(2)));
__device__ __forceinline__ unsigned pk2(float lo, float hi) { const f32x2_cv v = {lo, hi}; return __builtin_bit_cast(unsigned, __builtin_convertvector(v, bf16x2_cv)); }
__device__ __forceinline__ unsigned f2bf(float f) { return (unsigned)__builtin_bit_cast(unsigned short, (__bf16)f); }
__device__ __forceinline__ float bflo(unsigned w) { return __builtin_bit_cast(float, w << 16); }
__device__ __forceinline__ float bfhi(unsigned w) { return __builtin_bit_cast(float, w & 0xffff0000u); }
__device__ __forceinline__ float bf2f(bf16 b) { return __builtin_bit_cast(float, (unsigned)b << 16); }
__device__ __forceinline__ void unpack8(v4u w, float (&x)[8]) { x[0] = bflo(w.x); x[1] = bfhi(w.x); x[2] = bflo(w.y); x[3] = bfhi(w.y); x[4] = bflo(w.z); x[5] = bfhi(w.z); x[6] = bflo(w.w); x[7] = bfhi(w.w); }
__device__ __forceinline__ float wave_sum(float v) {
#pragma unroll
    for (int o = 1; o < 64; o <<= 1) v += __shfl_xor(v, o);
    return v;
}
__device__ __forceinline__ float sigmoidf_(float x) { return 1.f / (1.f + __expf(-x)); }

#define XB_TMO      128
#define XB_XCNT(j)  (256  + 64 * (j))
#define XB_XSUB(j)  (1280 + 64 * (j))
#define XB_XGEN(j)  (2304 + 64 * (j))
#define XB_TOP      3328
#define XB_TOPGEN   3392
#define XCD_BAR_WORDS 3456
#define XB_SPIN_CAP (1u << 22)

__device__ __forceinline__ unsigned xb_ld(unsigned* p)              { return __hip_atomic_load(p, __ATOMIC_RELAXED, __HIP_MEMORY_SCOPE_AGENT); }
__device__ __forceinline__ unsigned xb_add(unsigned* p, unsigned v) { return __hip_atomic_fetch_add(p, v, __ATOMIC_RELAXED, __HIP_MEMORY_SCOPE_AGENT); }
__device__ __forceinline__ unsigned xb_xcc_id() { return (unsigned)__builtin_amdgcn_s_getreg((3 << 11) | 20) & 0xFu; }
#define XB_SPIN(cond, bar) do { unsigned _sp = 0; while (cond) { __builtin_amdgcn_s_sleep(1); \
    if ((++_sp & 255u) == 0u) { if (xb_ld(&(bar)[XB_TMO])) break; if (_sp > XB_SPIN_CAP) { atomicAdd(&(bar)[XB_TMO], 1u); break; } } } } while (0)

struct XcdBarrier {
    unsigned* bar; unsigned x;
    volatile LAS unsigned* st;
};

__device__ __forceinline__ XcdBarrier xcd_barrier_post(unsigned* bar, volatile LAS unsigned* st) {
    XcdBarrier b; b.bar = bar; b.x = xb_xcc_id(); b.st = st;
    if (threadIdx.x == 0) (void)xb_add(&bar[XB_XCNT(b.x)], 1u);
    return b;
}
__device__ __forceinline__ void xcd_barrier_complete(unsigned* bar, unsigned x, unsigned& nloc, unsigned& nx) {
    const unsigned G = gridDim.x * gridDim.y * gridDim.z;
    unsigned sum, cnt, mine, sp = 0u;
    for (;;) {
        sum = 0u; cnt = 0u; mine = 0u;
#pragma unroll
        for (unsigned j = 0; j < 16; ++j) { const unsigned c = xb_ld(&bar[XB_XCNT(j)]); sum += c; cnt += (c > 0u) ? 1u : 0u; mine = (j == x) ? c : mine; }
        if (sum == G) break;
        __builtin_amdgcn_s_sleep(1);
        if ((++sp & 255u) == 0u) { if (xb_ld(&bar[XB_TMO])) break; if (sp > XB_SPIN_CAP) { atomicAdd(&bar[XB_TMO], 1u); break; } }
    }
    nloc = mine > 0u ? mine : 1u; nx = cnt > 0u ? cnt : 1u;
}

__device__ __forceinline__ void xcd_barrier(const XcdBarrier& b) {
    asm volatile("s_waitcnt vmcnt(0)" ::: "memory");
    __syncthreads();
    if (threadIdx.x == 0) {
        unsigned* bar = b.bar;
        __builtin_amdgcn_s_waitcnt(0);
        unsigned nloc = b.st[0], nx = b.st[1];
        if (nloc == 0u) { xcd_barrier_complete(bar, b.x, nloc, nx); b.st[0] = nloc; b.st[1] = nx; }
        const unsigned old = xb_add(&bar[XB_XSUB(b.x)], 1u);
        const unsigned gen = old / nloc;
        if (old + 1u == (gen + 1u) * nloc) {
            __builtin_amdgcn_fence(__ATOMIC_RELEASE, "agent");
            asm volatile("s_waitcnt vmcnt(0)" ::: "memory");
            const unsigned og = xb_add(&bar[XB_TOP], 1u);
            const unsigned tg = og / nx;
            if (og + 1u == (tg + 1u) * nx) xb_add(&bar[XB_TOPGEN], 1u);
            else XB_SPIN(xb_ld(&bar[XB_TOPGEN]) == tg, bar);
            __builtin_amdgcn_fence(__ATOMIC_ACQUIRE, "agent");
            xb_add(&bar[XB_XGEN(b.x)], 1u);
            asm volatile("s_waitcnt vmcnt(0)" ::: "memory");
        } else {
            XB_SPIN(xb_ld(&bar[XB_XGEN(b.x)]) == gen, bar);
            __builtin_amdgcn_fence(__ATOMIC_ACQUIRE, "agent");
            asm volatile("s_waitcnt vmcnt(0)" ::: "memory");
        }
    }
    __syncthreads();
}
#ifndef ATT_REL_ALL
#define ATT_REL_ALL 1
#endif
namespace att {
using s16x4  = __attribute__((ext_vector_type(4))) short;
using f32x16 = __attribute__((ext_vector_type(16))) float;
using u32x4  = __attribute__((ext_vector_type(4))) unsigned;
using f32x4  = __attribute__((ext_vector_type(4))) float;
#define ATT_SBAR() __builtin_amdgcn_sched_barrier(0)
constexpr float THR2 = 11.5f;
__device__ __forceinline__ int crow(int r, int hi) { return (r & 3) + 8 * (r >> 2) + 4 * hi; }
__device__ __forceinline__ unsigned cvtpk(float lo, float hi) { unsigned r; asm volatile("v_cvt_pk_bf16_f32 %0, %1, %2" : "=v"(r) : "v"(lo), "v"(hi)); return r; }

__device__ __forceinline__ void partialSM(f32x16& p0, f32x16& p1, float& m_reg, float& mn, float& alpha) {
  float pmax = p0[0];
#pragma unroll
  for (int r = 1; r < 16; ++r) pmax = fmaxf(pmax, p0[r]);
#pragma unroll
  for (int r = 0; r < 16; ++r) pmax = fmaxf(pmax, p1[r]);
  { auto rr = __builtin_amdgcn_permlane32_swap(__float_as_uint(pmax), __float_as_uint(pmax), false, false);
    pmax = fmaxf(__uint_as_float(rr[0]), __uint_as_float(rr[1])); }
  if (__builtin_expect(__all(pmax - m_reg <= THR2), 1)) { mn = m_reg; alpha = 1.f; }
  else { mn = fmaxf(m_reg, pmax); alpha = __builtin_amdgcn_exp2f(m_reg - mn); m_reg = mn; }
#pragma unroll
  for (int r = 0; r < 16; ++r) p0[r] = p0[r] - mn;
#pragma unroll
  for (int r = 0; r < 16; ++r) p1[r] = p1[r] - mn;
#pragma unroll
  for (int r = 0; r < 16; ++r) p0[r] = __builtin_amdgcn_exp2f(p0[r]);
}
__device__ __forceinline__ void finishSM_exp(f32x16& p1) {
#pragma unroll
  for (int r = 0; r < 16; ++r) p1[r] = __builtin_amdgcn_exp2f(p1[r]);
}
__device__ __forceinline__ void finishSM_pack(f32x16& p0, f32x16& p1, bf16x8& pa0, bf16x8& pa1, bf16x8& pa2, bf16x8& pa3) {
#define ATT_PK4(P, BASE, OUT) do { u32x4 w = {cvtpk(P[BASE + 0], P[BASE + 1]), cvtpk(P[BASE + 2], P[BASE + 3]), cvtpk(P[BASE + 4], P[BASE + 5]), cvtpk(P[BASE + 6], P[BASE + 7])}; \
    OUT = *reinterpret_cast<bf16x8*>(&w); } while (0)
  ATT_PK4(p0, 0, pa0); ATT_PK4(p0, 8, pa1); ATT_PK4(p1, 0, pa2); ATT_PK4(p1, 8, pa3);
#undef ATT_PK4
}
__device__ __forceinline__ void finishSM(f32x16& p0, f32x16& p1, bf16x8& pa0, bf16x8& pa1, bf16x8& pa2, bf16x8& pa3) { finishSM_exp(p1); finishSM_pack(p0, p1, pa0, pa1, pa2, pa3); }
template <int NB> __device__ __forceinline__ int v_st(int k, int c) { const int kk = (k & ~0xC) | ((k & 4) << 1) | ((k & 8) >> 1); return ((kk >> 3) * NB + (c >> 5)) * 512 + ((kk & 7) * 32 + (c & 31)) * 2; }
__device__ __forceinline__ int v_rd_base(int lane) { return ((lane & 3) << 3) | (((lane >> 2) & 3) << 6) | (((lane >> 4) & 1) << 5) | (((lane >> 5) & 1) << 8); }
template <int OFF> __device__ __forceinline__ s16x4 tr_read(int vb) {
  s16x4 r; asm volatile("ds_read_b64_tr_b16 %0, %1 offset:%2" : "=&v"(r) : "v"(vb), "i"(OFF) : "memory"); return r;
}
template <int NB, int D0, int VO> __device__ __forceinline__ void pv_rd(s16x4 (&f)[8], int vb) {
#define ATT_VOFF(ks, half) (VO + D0 * 512 + (ks) * (NB * 1024) + (half) * (NB * 512))
  f[0] = tr_read<ATT_VOFF(0, 0)>(vb); f[1] = tr_read<ATT_VOFF(0, 1)>(vb); f[2] = tr_read<ATT_VOFF(1, 0)>(vb); f[3] = tr_read<ATT_VOFF(1, 1)>(vb);
  f[4] = tr_read<ATT_VOFF(2, 0)>(vb); f[5] = tr_read<ATT_VOFF(2, 1)>(vb); f[6] = tr_read<ATT_VOFF(3, 0)>(vb); f[7] = tr_read<ATT_VOFF(3, 1)>(vb);
#undef ATT_VOFF
}
__device__ __forceinline__ void pv_mm(f32x16& od, const s16x4 (&f)[8], bf16x8 pa0, bf16x8 pa1, bf16x8 pa2, bf16x8 pa3) {
#define ATT_PK(L, H) (bf16x8){L[0], L[1], L[2], L[3], H[0], H[1], H[2], H[3]}
  od = __builtin_amdgcn_mfma_f32_32x32x16_bf16(pa0, ATT_PK(f[0], f[1]), od, 0, 0, 0);
  od = __builtin_amdgcn_mfma_f32_32x32x16_bf16(pa1, ATT_PK(f[2], f[3]), od, 0, 0, 0);
  od = __builtin_amdgcn_mfma_f32_32x32x16_bf16(pa2, ATT_PK(f[4], f[5]), od, 0, 0, 0);
  od = __builtin_amdgcn_mfma_f32_32x32x16_bf16(pa3, ATT_PK(f[6], f[7]), od, 0, 0, 0);
#undef ATT_PK
}
template <int NB, int D0, int HALF, int VO> __device__ __forceinline__ void pv_rdh(s16x4 (&g)[4], int vb) {
#define ATT_VOFF(ks, half) (VO + D0 * 512 + (ks) * (NB * 1024) + (half) * (NB * 512))
  g[0] = tr_read<ATT_VOFF(2 * HALF, 0)>(vb); g[1] = tr_read<ATT_VOFF(2 * HALF, 1)>(vb); g[2] = tr_read<ATT_VOFF(2 * HALF + 1, 0)>(vb); g[3] = tr_read<ATT_VOFF(2 * HALF + 1, 1)>(vb);
#undef ATT_VOFF
}
__device__ __forceinline__ void pv_mmh(f32x16& od, const s16x4 (&g)[4], bf16x8 px, bf16x8 py) {
#define ATT_PK(L, H) (bf16x8){L[0], L[1], L[2], L[3], H[0], H[1], H[2], H[3]}
  od = __builtin_amdgcn_mfma_f32_32x32x16_bf16(px, ATT_PK(g[0], g[1]), od, 0, 0, 0);
  od = __builtin_amdgcn_mfma_f32_32x32x16_bf16(py, ATT_PK(g[2], g[3]), od, 0, 0, 0);
#undef ATT_PK
}
#define ATT_LWAIT(n) do { asm volatile("s_waitcnt lgkmcnt(" #n ")" ::: "memory"); ATT_SBAR(); } while (0)
template <int NB, int VO, bool SM, bool REL> __device__ __forceinline__ void pv_sm(f32x16* o, f32x4& lsum, bf16x8 sel, int vb, bf16x8 pa0, bf16x8 pa1, bf16x8 pa2, bf16x8 pa3,
                                                                         f32x16& n0, f32x16& n1, float& m_reg, float& mn, float& alpha, f32x16& negm) {
  float pmax = 0.f;
#define ATT_LSUM() do { lsum = __builtin_amdgcn_mfma_f32_16x16x32_bf16(sel, pa0, lsum, 0, 0, 0); lsum = __builtin_amdgcn_mfma_f32_16x16x32_bf16(sel, pa1, lsum, 0, 0, 0); \
    lsum = __builtin_amdgcn_mfma_f32_16x16x32_bf16(sel, pa2, lsum, 0, 0, 0); lsum = __builtin_amdgcn_mfma_f32_16x16x32_bf16(sel, pa3, lsum, 0, 0, 0); } while (0)
#define ATT_PMAX() do { if constexpr (SM) { pmax = n0[0]; \
    _Pragma("unroll") for (int r = 1; r < 16; ++r) pmax = fmaxf(pmax, n0[r]); \
    _Pragma("unroll") for (int r = 0; r < 16; ++r) pmax = fmaxf(pmax, n1[r]); \
    auto rr = __builtin_amdgcn_permlane32_swap(__float_as_uint(pmax), __float_as_uint(pmax), false, false); \
    pmax = fmaxf(__uint_as_float(rr[0]), __uint_as_float(rr[1])); } } while (0)
#define ATT_THR() do { if constexpr (SM && !REL) { \
      if (__builtin_expect(__all(pmax - m_reg <= THR2), 1)) { mn = m_reg; alpha = 1.f; } \
      else { mn = fmaxf(m_reg, pmax); alpha = __builtin_amdgcn_exp2f(m_reg - mn); m_reg = mn; } } \
    if constexpr (SM && REL) { \
      if (__builtin_expect(__all(pmax <= THR2), 1)) { alpha = 1.f; } \
      else { const float d = fmaxf(pmax, 0.f); alpha = __builtin_amdgcn_exp2f(-d); \
        _Pragma("unroll") for (int r = 0; r < 16; ++r) { n0[r] -= d; n1[r] -= d; negm[r] -= d; } } } } while (0)
  if constexpr (NB == 4) {
    s16x4 b0[4], b1[4], b2[4];
    pv_rdh<NB, 0, 0, VO>(b0, vb); pv_rdh<NB, 0, 1, VO>(b1, vb); pv_rdh<NB, 1, 0, VO>(b2, vb);
    ATT_LSUM(); ATT_PMAX();
    ATT_LWAIT(8); pv_mmh(o[0], b0, pa0, pa1); pv_rdh<NB, 1, 1, VO>(b0, vb);
    ATT_THR();
    if constexpr (SM && !REL) {
#pragma unroll
      for (int r = 0; r < 16; ++r) n0[r] = n0[r] - mn; }
    ATT_LWAIT(8); pv_mmh(o[0], b1, pa2, pa3); pv_rdh<NB, 2, 0, VO>(b1, vb);
    if constexpr (SM && !REL) {
#pragma unroll
      for (int r = 0; r < 16; ++r) n1[r] = n1[r] - mn; }
    ATT_LWAIT(8); pv_mmh(o[1], b2, pa0, pa1); pv_rdh<NB, 2, 1, VO>(b2, vb);
    ATT_LWAIT(8); pv_mmh(o[1], b0, pa2, pa3); pv_rdh<NB, 3, 0, VO>(b0, vb);
    if constexpr (SM) {
#pragma unroll
      for (int r = 0; r < 4; ++r) n0[r] = __builtin_amdgcn_exp2f(n0[r]); }
    ATT_LWAIT(8); pv_mmh(o[2], b1, pa0, pa1); pv_rdh<NB, 3, 1, VO>(b1, vb);
    if constexpr (SM) {
#pragma unroll
      for (int r = 4; r < 8; ++r) n0[r] = __builtin_amdgcn_exp2f(n0[r]); }
    ATT_LWAIT(8); pv_mmh(o[2], b2, pa2, pa3);
    if constexpr (SM) {
#pragma unroll
      for (int r = 8; r < 12; ++r) n0[r] = __builtin_amdgcn_exp2f(n0[r]); }
    ATT_LWAIT(4); pv_mmh(o[3], b0, pa0, pa1);
    if constexpr (SM) {
#pragma unroll
      for (int r = 12; r < 16; ++r) n0[r] = __builtin_amdgcn_exp2f(n0[r]); }
    ATT_LWAIT(0); pv_mmh(o[3], b1, pa2, pa3);
  } else {
    s16x4 fa[8], fb[8];
    pv_rd<NB, 0, VO>(fa, vb); pv_rd<NB, 1, VO>(fb, vb);
    ATT_LSUM(); ATT_PMAX();
    ATT_LWAIT(8); pv_mm(o[0], fa, pa0, pa1, pa2, pa3);
    ATT_THR();
    if constexpr (SM && !REL) {
#pragma unroll
      for (int r = 0; r < 16; ++r) { n0[r] = n0[r] - mn; n1[r] = n1[r] - mn; } }
    ATT_LWAIT(0); pv_mm(o[1], fb, pa0, pa1, pa2, pa3);
    if constexpr (SM) {
#pragma unroll
      for (int r = 0; r < 16; ++r) n0[r] = __builtin_amdgcn_exp2f(n0[r]); }
  }
#undef ATT_LSUM
#undef ATT_PMAX
#undef ATT_THR
}
template <int DK, bool REL, int LO, int HI> __device__ __forceinline__ void qkt_part(f32x16& p0, f32x16& p1, LAS const char* Kt, const int (&ka)[DK / 16], const bf16x8* qr, const f32x16& negm) {
  if constexpr (!REL && LO == 0) { p0 = f32x16{}; p1 = f32x16{}; }
#pragma unroll
  for (int d0 = LO; d0 < HI; ++d0) {
    const bf16x8 b0 = *(LAS const bf16x8*)(Kt + ka[d0]);
    const bf16x8 b1 = *(LAS const bf16x8*)(Kt + ka[d0] + (d0 < 4 ? 4096 : 2048));
    p0 = __builtin_amdgcn_mfma_f32_32x32x16_bf16(b0, qr[d0], (REL && d0 == 0) ? negm : p0, 0, 0, 0);
    p1 = __builtin_amdgcn_mfma_f32_32x32x16_bf16(b1, qr[d0], (REL && d0 == 0) ? negm : p1, 0, 0, 0); }
}
template <int DK, bool REL> __device__ __forceinline__ void qkt(f32x16& p0, f32x16& p1, LAS const char* Kt, const int (&ka)[DK / 16], const bf16x8* qr, const f32x16& negm) {
  qkt_part<DK, REL, 0, DK / 16>(p0, p1, Kt, ka, qr, negm);
}
template <int DK, int DV> struct Cfg {
  static constexpr int KT = 64 * DK * 2, NB = DV / 32, VT = 64 * DV * 2, NQ = DK / 16;
  static constexpr int KN = DK / 64 + (DK % 64 != 0), VN = (64 * DV / 8) / 512;
  static constexpr int NS = 4;
  static constexpr int OFF_K = 0, OFF_V = NS * KT, OFF_WS = NS * (KT + VT), LDS_BYTES = OFF_WS + 8 * 64 * 4;
};
template <int DK, int DV>
__device__ __forceinline__ void attn_unit(const bf16* __restrict__ Qb, int ldq, const bf16* __restrict__ K1, int ldk1, const bf16* __restrict__ K2, int ldk2,
                                          const bf16* __restrict__ Vh, int ldv, float* __restrict__ Ob, int ldo, int nkeys, LAS char* lds) {
  using C = Cfg<DK, DV>;
  const int tid = threadIdx.x, wid = __builtin_amdgcn_readfirstlane(tid >> 6), lane = tid & 63, r32 = lane & 31, hi = lane >> 5;
  LAS float* ws = (LAS float*)(lds + C::OFF_WS) + wid * 64; LAS float* al_l = ws + 32;
  constexpr bool REL = ATT_REL_ALL || (DV == 64);
  float m_reg = -1e30f; f32x16 negm = {}; f32x16 o[C::NB] = {}; f32x4 lsum = {}; bf16x8 qr[C::NQ];
  bf16x8 sel; { const int i_ = lane & 15, kq_ = lane >> 4; const unsigned v_ = ((i_ == 0 && !(kq_ & 1)) || (i_ == 1 && (kq_ & 1))) ? 0x3F803F80u : 0u; u32x4 w_ = {v_, v_, v_, v_}; sel = *reinterpret_cast<bf16x8*>(&w_); }
  { const bf16* Qw = Qb + (long)(wid * 32 + r32) * ldq + hi * 8;
#pragma unroll
    for (int d0 = 0; d0 < C::NQ; ++d0) qr[d0] = *(const bf16x8*)(Qw + d0 * 16); }
  unsigned kg0, kg1 = 0, vg[C::VN];
  { const int row = tid >> 3, cp = tid & 7; kg0 = (unsigned)(row * ldk1 + ((cp ^ ((row >> 1) & 7)) * 8)); }
  if constexpr (C::KN == 2) { const int p = tid & 255, row = p >> 2, cp = p & 3; kg1 = (unsigned)(row * ldk2 + ((cp ^ ((row >> 2) & 3)) * 8)); }
#pragma unroll
  for (int i = 0; i < C::VN; ++i) { const int p = i * 512 + tid, st = p >> 5, wi = p & 31, kk = (st / C::NB) * 8 + (wi >> 2), col = (st % C::NB) * 32 + (wi & 3) * 8;
    vg[i] = (unsigned)(kk * ldv + col); }
  int ka[C::NQ];
#pragma unroll
  for (int d0 = 0; d0 < C::NQ; ++d0) ka[d0] = (d0 < 4) ? r32 * 128 + ((((d0 * 2) ^ hi ^ ((r32 >> 1) & 7)) & 7) << 4) : 8192 + r32 * 64 + (((((d0 - 4) * 2) ^ hi ^ ((r32 >> 2) & 3)) & 3) << 4);
  const int vb0 = (int)(uintptr_t)(lds + C::OFF_V) + v_rd_base(lane);
  const bool p3 = (C::KN == 1) || wid < 4;
#define ATT_ISSUE(S, t) do { const size_t t64_ = (size_t)(t) * 64; \
    __builtin_amdgcn_global_load_lds((const unsigned*)(K1 + t64_ * ldk1 + kg0), (LAS unsigned*)(lds + C::OFF_K + (S) * C::KT + wid * 1024), 16, 0, 0); \
    if constexpr (C::KN == 2) { if (wid < 4) __builtin_amdgcn_global_load_lds((const unsigned*)(K2 + t64_ * ldk2 + kg1), (LAS unsigned*)(lds + C::OFF_K + (S) * C::KT + 8192 + wid * 1024), 16, 0, 0); } \
    _Pragma("unroll") for (int i_ = 0; i_ < C::VN; ++i_) __builtin_amdgcn_global_load_lds((const unsigned*)(Vh + t64_ * ldv + vg[i_]), (LAS unsigned*)(lds + C::OFF_V + (S) * C::VT + (i_ * 512 + wid * 64) * 16), 16, 0, 0); } while (0)
#define ATT_LAND1() do { if (p3) asm volatile("s_waitcnt vmcnt(3)" ::: "memory"); else asm volatile("s_waitcnt vmcnt(2)" ::: "memory"); } while (0)
#define ATT_LAND2() do { if (p3) asm volatile("s_waitcnt vmcnt(6)" ::: "memory"); else asm volatile("s_waitcnt vmcnt(4)" ::: "memory"); } while (0)
#define ATT_RESC(a) do { if (__any((a) < 1.f)) { if (hi == 0) al_l[r32] = (a); asm volatile("s_waitcnt lgkmcnt(0)" ::: "memory"); \
    lsum[0] *= al_l[lane & 15]; lsum[1] *= al_l[16 + (lane & 15)]; \
    _Pragma("unroll") for (int r = 0; r < 16; ++r) { const float f_ = al_l[crow(r, hi)]; _Pragma("unroll") for (int d = 0; d < C::NB; ++d) o[d][r] *= f_; } } } while (0)
  static_assert(C::KN + C::VN == 3 && C::NS == 4, "three (two on waves 4..7 when DK = 96) DMA pieces per thread per tile; slot = tile & 3");
#define ATT_STEP(S, t, C0, C1, N0, N1, mnN, alN, LAST) do { ATT_SBAR(); \
    { const int ti_ = ((t) + 3 < NT) ? (t) + 3 : NT - 1; ATT_ISSUE(((S) + 3) & 3, ti_); } ATT_SBAR(); \
    if constexpr (!(LAST)) qkt_part<DK, REL, 0, C::NQ / 2>(N0, N1, lds + C::OFF_K + (((S) + 1) & 3) * C::KT, ka, qr, negm); \
    finishSM_exp(C1); ATT_SBAR(); \
    if constexpr (!(LAST)) qkt_part<DK, REL, C::NQ / 2, C::NQ>(N0, N1, lds + C::OFF_K + (((S) + 1) & 3) * C::KT, ka, qr, negm); \
    finishSM_pack(C0, C1, pa0, pa1, pa2, pa3); ATT_SBAR(); \
    pv_sm<C::NB, (S) * C::VT, !(LAST), REL>(o, lsum, sel, vb0, pa0, pa1, pa2, pa3, N0, N1, m_reg, mnN, alN, negm); ATT_SBAR(); \
    if constexpr (!(LAST)) { ATT_RESC(alN); } \
    ATT_LAND1(); __builtin_amdgcn_s_barrier(); } while (0)
  f32x16 pA0, pA1, pB0, pB1; float mnA, mnB, alA, alB; bf16x8 pa0, pa1, pa2, pa3; const int NT = nkeys / 64;
  asm volatile("s_waitcnt vmcnt(0) lgkmcnt(0)" ::: "memory"); __builtin_amdgcn_s_barrier();
  ATT_ISSUE(0, 0); ATT_ISSUE(1, 1); ATT_ISSUE(2, 2);
  ATT_LAND2(); __builtin_amdgcn_s_barrier();
  qkt<DK, REL>(pA0, pA1, lds + C::OFF_K, ka, qr, negm);
  partialSM(pA0, pA1, m_reg, mnA, alA);
  if constexpr (REL) {
#pragma unroll
    for (int r = 0; r < 16; ++r) negm[r] = -m_reg; }
  ATT_LAND1(); __builtin_amdgcn_s_barrier();
  int t = 0;
  for (; t + 4 < NT; t += 4) {
    ATT_STEP(0, t,     pA0, pA1, pB0, pB1, mnB, alB, false);
    ATT_STEP(1, t + 1, pB0, pB1, pA0, pA1, mnA, alA, false);
    ATT_STEP(2, t + 2, pA0, pA1, pB0, pB1, mnB, alB, false);
    ATT_STEP(3, t + 3, pB0, pB1, pA0, pA1, mnA, alA, false);
  }
  ATT_STEP(0, t,     pA0, pA1, pB0, pB1, mnB, alB, false);
  ATT_STEP(1, t + 1, pB0, pB1, pA0, pA1, mnA, alA, false);
  ATT_STEP(2, t + 2, pA0, pA1, pB0, pB1, mnB, alB, false);
  ATT_STEP(3, t + 3, pB0, pB1, pA0, pA1, mnA, alA, true);
  asm volatile("s_waitcnt vmcnt(0)" ::: "memory");
  float rli[16];
  if (lane < 16) { al_l[lane] = lsum[0]; al_l[16 + lane] = lsum[1]; }
  asm volatile("s_waitcnt lgkmcnt(0)" ::: "memory");
#pragma unroll
  for (int r = 0; r < 16; ++r) rli[r] = __builtin_amdgcn_rcpf(al_l[crow(r, hi)]);
  float* Ow = Ob + (long)(wid * 32) * ldo;
#pragma unroll
  for (int r = 0; r < 16; ++r) { const int orow = crow(r, hi);
#pragma unroll
    for (int d0 = 0; d0 < C::NB; ++d0) Ow[(long)orow * ldo + d0 * 32 + r32] = o[d0][r] * rli[r]; }
#undef ATT_ISSUE
#undef ATT_LAND1
#undef ATT_LAND2
#undef ATT_RESC
#undef ATT_STEP
}
}
constexpr int DM = 1024, NBATCH = 2, SEQ = 16384, CT = 256, TB = SEQ + CT  , R = NBATCH * TB  ;
constexpr int ATT_IN = 2208, ATT_NP = 2304, REC_IN = 3472, REC_NP = 3584, RWKV_IN = 1920;
constexpr int NE = 32, TOPK = 4, MAXT = R * TOPK / 256 + NE  , MAXROWS = MAXT * 256;
constexpr int NUNIT_M = 16 * 260;
constexpr float NORM_EPS = 1e-6f;
enum { I_X = 0, I_C, I_CTX, I_CCTX, I_NMIX, I_NFFN, I_ADAW, I_ADAB, I_WOUT, I_RW, I_RB, I_W1, I_B1, I_W2, I_B2, I_ATTW, I_LAM, I_SUBLN, I_QNW, I_KVNW, I_WUQ, I_WUKV,
       I_RECW, I_MU, I_W0, I_RW2, I_A0, I_A2, I_G2, I_KK, I_KA, I_RK, I_LNW, I_LNB, I_GATEB, I_MNW, I_FNW, N_IN };
constexpr size_t al256(size_t x) { return (x + 255) & ~(size_t)255; }
constexpr size_t WS_CTL = 0, CTL_ZERO_BYTES = 1u << 20;
constexpr size_t WS_MOD = CTL_ZERO_BYTES;
constexpr size_t WS_ROPE = al256(WS_MOD + 2 * 3 * 6144 * 4);
constexpr size_t ROPE_DR = 0, ROPE_DC = 256 * 16 * 2, ROPE_MR = ROPE_DC + 64 * 16 * 2, ROPE_MC = ROPE_MR + 256 * 8 * 2, ROPE_FLOATS = ROPE_MC + 64 * 8 * 2;
constexpr size_t WS_WRH = al256(WS_ROPE + ROPE_FLOATS * 4);
constexpr size_t WS_WRL = al256(WS_WRH + (size_t)2 * 32 * 1024 * 2);
constexpr size_t WS_WIN0 = al256(WS_WRL + (size_t)2 * 32 * 1024 * 2);
constexpr size_t WS_WUQ = al256(WS_WIN0 + (size_t)ATT_NP * 1024 * 2);
constexpr size_t WS_WUKV = al256(WS_WUQ + (size_t)768 * 384 * 2);
constexpr size_t WS_WOUT = al256(WS_WUKV + (size_t)1024 * 256 * 2);
constexpr size_t WS_WREC = al256(WS_WOUT + (size_t)2 * 1024 * 1024 * 2);
constexpr size_t WS_WLORA = al256(WS_WREC + (size_t)REC_NP * 1024 * 2);
constexpr size_t WS_W1T = al256(WS_WLORA + (size_t)2560 * 384 * 2);
constexpr size_t WS_W2T = al256(WS_W1T + (size_t)NE * 2048 * 1024 * 2);
constexpr size_t WS_H = al256(WS_W2T + (size_t)NE * 1024 * 1024 * 2);
constexpr size_t WS_A = al256(WS_H + (size_t)R * 1024 * 4);
constexpr size_t WS_A1 = al256(WS_A + (size_t)R * 1024 * 2);
constexpr size_t WS_F = al256(WS_A1 + (size_t)R * 1024 * 2);
constexpr size_t WS_P = al256(WS_F + (size_t)R * 1024 * 2);
constexpr size_t WS_TOPE = al256(WS_P + (size_t)R * REC_NP * 2);
constexpr size_t WS_GATE = al256(WS_TOPE + (size_t)R * 16);
constexpr size_t WS_POS = al256(WS_GATE + (size_t)R * 16);
constexpr size_t WS_DEST = al256(WS_POS + (size_t)R * 16);
constexpr size_t WS_TILE = al256(WS_DEST + (size_t)R * 16);
constexpr size_t WS_SRC = al256(WS_TILE + (size_t)(MAXT + 8) * 4);
constexpr size_t WS_T = al256(WS_SRC + (size_t)MAXROWS * 4);
constexpr size_t WS_QD = WS_T;
constexpr size_t WS_KD = al256(WS_QD + (size_t)R * 512 * 2);
constexpr size_t WS_CQN = al256(WS_KD + (size_t)R * 512 * 2);
constexpr size_t WS_CKVN = al256(WS_CQN + (size_t)R * 384 * 2);
constexpr size_t WS_MQ = al256(WS_CKVN + (size_t)R * 256 * 2);
constexpr size_t WS_MKV = al256(WS_MQ + (size_t)R * 768 * 2);
constexpr size_t WS_KRR = al256(WS_MKV + (size_t)R * 1024 * 2);
constexpr size_t WS_ODIFF = al256(WS_KRR + (size_t)R * 32 * 2);
constexpr size_t WS_OMLA = al256(WS_ODIFF + (size_t)R * 1024 * 4);
constexpr size_t WS_T0_END = al256(WS_OMLA + (size_t)R * 512 * 4);
constexpr size_t WS_XS = WS_T;
constexpr size_t WS_HS = al256(WS_XS + (size_t)MAXROWS * 1024 * 2);
constexpr size_t WS_TM_END = al256(WS_HS + (size_t)MAXROWS * 1024 * 2);
constexpr size_t SZ_RC = (size_t)R * 512 * 4;
constexpr size_t WS_RR = WS_T, WS_VV = WS_RR + SZ_RC, WS_AKK = WS_VV + SZ_RC, WS_KL = WS_AKK + SZ_RC;
constexpr size_t WS_WDEC = WS_KL + SZ_RC  , WS_KDIR = WS_WDEC + 2 * SZ_RC  , WS_BB = WS_KDIR + 2 * SZ_RC  , WS_GG = WS_BB + 2 * SZ_RC;
constexpr size_t WS_ALORA = al256(WS_GG + SZ_RC);
constexpr size_t WS_YR = al256(WS_ALORA + (size_t)R * 384 * 2);
constexpr size_t WS_DC = WS_YR;
constexpr size_t WS_HM = al256(WS_YR + 2 * SZ_RC);
constexpr size_t WS_CST = al256(WS_HM + 2 * SZ_RC);
constexpr size_t WS_DN = al256(WS_CST + (size_t)NUNIT_M * 8192 * 4);
constexpr size_t WS_NST = al256(WS_DN + (size_t)NUNIT_M * 64 * 4);
constexpr size_t WS_SC = al256(WS_NST + (size_t)NUNIT_M * 64 * 4);
constexpr size_t WS_MST = al256(WS_SC + (size_t)NUNIT_M * 2 * 4);
constexpr size_t WS_ASIG = WS_KDIR;
constexpr size_t WS_YB = WS_BB;
constexpr int NUNIT_R = 32 * 260;
constexpr size_t WS_RKM = WS_KDIR + SZ_RC;
static_assert((size_t)NUNIT_R * 4096 * 2 <= SZ_RC, "M^T fits in KL");
constexpr size_t WS_RKQ = al256(WS_MST + (size_t)NUNIT_M * 4);
constexpr size_t WS_RKZ = al256(WS_RKQ + (size_t)NUNIT_R * 4096 * 2);
constexpr size_t WS_T1_END = al256(WS_RKZ + (size_t)NUNIT_R * 4096 * 2);
constexpr size_t WS_END = WS_T1_END > WS_TM_END ? (WS_T1_END > WS_T0_END ? WS_T1_END : WS_T0_END) : (WS_TM_END > WS_T0_END ? WS_TM_END : WS_T0_END);
static_assert(WS_END <= (size_t)2147483648ull, "workspace map exceeds 2 GiB");
constexpr int CW_CNT = 1024;
constexpr int CW_BAR = 4096;
constexpr int RING_BYTES = 131072, AUX_OFF = 131072, AUX_BYTES = 16384, MISC_OFF = 147456, LDS_BYTES = 163840;

struct Frame {
    LAS unsigned char* lds; gu32* ctl; int tid, lane, wave, blk, G, probe;
    float* out; unsigned char* ws;
    struct InTab { LAS const unsigned* t;
        __device__ __forceinline__ const float* operator[](int i) const { const unsigned lo = __builtin_amdgcn_readfirstlane(t[2 * i]), hi = __builtin_amdgcn_readfirstlane(t[2 * i + 1]);
            return (const float*)(((unsigned long long)hi << 32) | lo); } } in;
};
template <class T> __device__ __forceinline__ T* wsp(const Frame& F, size_t off) { return (T*)(F.ws + off); }
__device__ __forceinline__ int row_sel(int row) { const int b = row / TB, t = row - b * TB; return t < CT ? 2 : b; }
__device__ __forceinline__ const float* h0_row(const Frame& F, int row) {
    const int b = row / TB, t = row - b * TB;
    return t < CT ? F.in[I_CTX] + ((size_t)b * CT + t) * DM : F.in[I_X] + ((size_t)b * SEQ + (t - CT)) * DM;
}
__device__ __forceinline__ const float* modp(const Frame& F, int layer, int sel, int chunk) { return wsp<const float>(F, WS_MOD) + ((size_t)(layer * 3 + sel) * 6 + chunk) * DM; }
__device__ __forceinline__ int scan_tok(int z, int sg) { return z == 0 ? sg : (sg < CT ? CT - 1 - sg : TB + CT - 1 - sg); }
__device__ __forceinline__ void tr_item(const float* W, int K, int N, bf16* WT, int row_off, LAS float* scr, int kb, int nb, int lane) {
    const int k0 = 64 * kb, n0 = 32 * nb;
    const int n = n0 + (lane & 31);
    float tv[32];
#pragma unroll
    for (int i = 0; i < 32; ++i) { const int kk = 2 * i + (lane >> 5); tv[i] = (n < N) ? W[(size_t)(k0 + kk) * N + n] : 0.f; }
#pragma unroll
    for (int i = 0; i < 32; ++i) { const int kk = 2 * i + (lane >> 5); scr[kk * 33 + (lane & 31)] = tv[i]; }
    LDS_WAIT(); asm volatile("" ::: "memory");
    const int c = lane & 7;
#pragma unroll
    for (int j = 0; j < 4; ++j) { const int nn = (lane >> 3) + 8 * j; const LAS float* s = scr + (8 * c) * 33 + nn;
        v4u o; o.x = pk2(s[0 * 33], s[1 * 33]); o.y = pk2(s[2 * 33], s[3 * 33]); o.z = pk2(s[4 * 33], s[5 * 33]); o.w = pk2(s[6 * 33], s[7 * 33]);
        *(v4u*)(WT + (size_t)(row_off + n0 + nn) * K + k0 + 8 * c) = o; }
    LDS_WAIT(); asm volatile("" ::: "memory");
}
__device__ __forceinline__ void tr_family(const Frame& F, const float* W, size_t src_stride, int nmat, int K, int N, int Npad, bf16* WT, int gw, int NGW) {
    LAS float* scr = (LAS float*)(F.lds + F.wave * 16384);
    const int nkb = K / 64, nnb = Npad / 32, per = nkb * nnb, total = per * nmat;
    for (int it = gw; it < total; it += NGW) { const int m = it / per, r = it - m * per, kb = r / nnb, nb = r - kb * nnb;
        tr_item(W + (size_t)m * src_stride, K, N, WT, m * Npad, scr, kb, nb, F.lane); }
}
__device__ __forceinline__ void moe_weights_convert(const Frame& F, int layer, int gw, int NGW) {
    tr_family(F, F.in[I_W1] + (size_t)layer * NE * 1024 * 2048, (size_t)1024 * 2048, NE, 1024, 2048, 2048, wsp<bf16>(F, WS_W1T), gw, NGW);
    tr_family(F, F.in[I_W2] + (size_t)layer * NE * 1024 * 1024, (size_t)1024 * 1024, NE, 1024, 1024, 1024, wsp<bf16>(F, WS_W2T), gw, NGW);
}
__device__ __forceinline__ void norm_mod_row(const Frame& F, const float* src, const float* nw, const float* shift, const float* scale, bf16* orow) {
    const f32x4* xr = (const f32x4*)src + F.lane;
    f32x4 v[4]; float s = 0.f;
#pragma unroll
    for (int j = 0; j < 4; ++j) { v[j] = xr[64 * j]; s += (v[j].x * v[j].x + v[j].y * v[j].y) + (v[j].z * v[j].z + v[j].w * v[j].w); }
    const float rs = 1.f / sqrtf(wave_sum(s) * (1.f / DM) + NORM_EPS);
    unsigned long long* o8 = (unsigned long long*)orow + F.lane;
#pragma unroll
    for (int j = 0; j < 4; ++j) { const f32x4 w = ((const f32x4*)nw)[F.lane + 64 * j], sh = ((const f32x4*)shift)[F.lane + 64 * j], sc = ((const f32x4*)scale)[F.lane + 64 * j];
        const f32x4 y = v[j] * rs * w * (sc + 1.f) + sh;
        o8[64 * j] = (unsigned long long)pk2(y.x, y.y) | ((unsigned long long)pk2(y.z, y.w) << 32); }
}
__device__ __forceinline__ void p0a(const Frame& F) {
    LAS float* sv = (LAS float*)F.lds; LAS float* red = (LAS float*)(F.lds + 16384);
    for (int i = F.tid; i < 3 * DM; i += 512) { const int s = i / DM, k = i - s * DM; const float cv = (s < 2) ? F.in[I_C][s * DM + k] : F.in[I_CCTX][k]; sv[i] = cv / (1.f + __expf(-cv)); }
    __syncthreads();
    for (int it = F.blk; it < 192; it += F.G) {
        const int l = it / 96, cgp = it - l * 96, kq = F.tid >> 4, cg = F.tid & 15, col = cgp * 64 + cg * 4;
        float acc[3][4];
#pragma unroll
        for (int s = 0; s < 3; ++s)
#pragma unroll
            for (int j = 0; j < 4; ++j) acc[s][j] = 0.f;
        const float* W = F.in[I_ADAW] + (size_t)l * DM * 6144 + col;
#pragma unroll 16
        for (int kk = 0; kk < 32; ++kk) { const int k = kq * 32 + kk; const f32x4 w = *(const f32x4*)(W + (size_t)k * 6144);
            const float s0 = sv[k], s1 = sv[DM + k], s2 = sv[2 * DM + k];
#pragma unroll
            for (int j = 0; j < 4; ++j) { acc[0][j] += s0 * w[j]; acc[1][j] += s1 * w[j]; acc[2][j] += s2 * w[j]; } }
#pragma unroll
        for (int s = 0; s < 3; ++s)
#pragma unroll
            for (int j = 0; j < 4; ++j) red[(kq * 16 + cg) * 12 + s * 4 + j] = acc[s][j];
        __syncthreads();
        if (F.tid < 192) { const int s = F.tid / 64, cc = F.tid - s * 64, cg2 = cc >> 2, j = cc & 3; float t = 0.f;
            for (int q = 0; q < 32; ++q) t += red[(q * 16 + cg2) * 12 + s * 4 + j];
            wsp<float>(F, WS_MOD)[(size_t)(l * 3 + s) * 6144 + cgp * 64 + cc] = t + F.in[I_ADAB][l * 6144 + cgp * 64 + cc]; }
        __syncthreads();
    }
    const int gid = F.blk * 512 + F.tid, GT = F.G * 512;
    float* rope = wsp<float>(F, WS_ROPE);
    for (int i = gid; i < 256 * 16 + 64 * 16 + 256 * 8 + 64 * 8; i += GT) {
        int j = i; float pos, inv; size_t off;
        if (j < 256 * 16) { pos = (float)(j / 16); inv = powf(10000.f, -(float)(j % 16) / 16.f); off = ROPE_DR + (size_t)j * 2; }
        else if ((j -= 256 * 16) < 64 * 16) { pos = (float)(j / 16); inv = powf(10000.f, -(float)(j % 16) / 16.f); off = ROPE_DC + (size_t)j * 2; }
        else if ((j -= 64 * 16) < 256 * 8) { pos = (float)(j / 8); inv = powf(10000.f, -(float)(j % 8) / 8.f); off = ROPE_MR + (size_t)j * 2; }
        else { j -= 256 * 8; pos = (float)(j / 8); inv = powf(10000.f, -(float)(j % 8) / 8.f); off = ROPE_MC + (size_t)j * 2; }
        const float ang = pos * inv; rope[off] = cosf(ang); rope[off + 1] = sinf(ang);
    }
    { bf16* wh = wsp<bf16>(F, WS_WRH); bf16* wl = wsp<bf16>(F, WS_WRL); for (int i = gid; i < 2 * 32 * 1024; i += GT) { const int k = i & 1023, e = (i >> 10) & 31, l = i >> 15; const float wv = F.in[I_RW][((size_t)l * DM + k) * NE + e];
        const unsigned hb = f2bf(wv); wh[i] = (bf16)hb; wl[i] = (bf16)f2bf(wv - bf2f((bf16)hb)); } }
    bf16* WL = wsp<bf16>(F, WS_WLORA);
    for (int i = gid; i < 2560 * 384; i += GT) { const int n = i / 384, k = i - n * 384, part = n >> 9, c = n & 511; float v = 0.f;
        if (part < 2) { if ((k >> 6) == part) v = F.in[I_RW2][((size_t)part * 64 + (k & 63)) * 512 + c]; }
        else if (part < 4) { if ((k >> 6) == part) v = F.in[I_A2][((size_t)(part - 2) * 64 + (k & 63)) * 512 + c]; }
        else { if (k >= 256) v = F.in[I_G2][(size_t)(k - 256) * 512 + c]; }
        WL[i] = (bf16)f2bf(v); }
    const int gw = F.blk * 8 + F.wave, NGW = F.G * 8;
    tr_family(F, F.in[I_ATTW], 0, 1, 1024, ATT_IN, ATT_NP, wsp<bf16>(F, WS_WIN0), gw, NGW);
    tr_family(F, F.in[I_WUQ], 0, 1, 384, 768, 768, wsp<bf16>(F, WS_WUQ), gw, NGW);
    tr_family(F, F.in[I_WUKV], 0, 1, 256, 1024, 1024, wsp<bf16>(F, WS_WUKV), gw, NGW);
    tr_family(F, F.in[I_WOUT], (size_t)1024 * 1024, 2, 1024, 1024, 1024, wsp<bf16>(F, WS_WOUT), gw, NGW);
    tr_family(F, F.in[I_RECW], 0, 1, 1024, REC_IN, REC_NP, wsp<bf16>(F, WS_WREC), gw, NGW);
    moe_weights_convert(F, 0, gw, NGW);
}
__device__ __forceinline__ void p0b(const Frame& F) {
    const int gw = F.blk * 8 + F.wave, NGW = F.G * 8;
    for (int row = gw; row < R; row += NGW) { const int sel = row_sel(row);
        norm_mod_row(F, h0_row(F, row), F.in[I_NMIX], modp(F, 0, sel, 0), modp(F, 0, sel, 1), wsp<bf16>(F, WS_A) + (size_t)row * DM); }
}
struct FnStoreBf16 {
    bf16* O; int ldc;
    __device__ __forceinline__ void operator()(int row, int col, f32x4 v0, f32x4 v1) const {
        v4u w; w.x = pg8::cvt_pk_bf16(v0[0], v0[1]); w.y = pg8::cvt_pk_bf16(v0[2], v0[3]); w.z = pg8::cvt_pk_bf16(v1[0], v1[1]); w.w = pg8::cvt_pk_bf16(v1[2], v1[3]);
        *(v4u*)(O + (size_t)row * ldc + col) = w; }
};
struct FnWout {
    const Frame* F; int layer;
    __device__ __forceinline__ void operator()(int row, int col, f32x4 v0, f32x4 v1) const {
        bf16* hrow = wsp<bf16>(*F, WS_H) + (size_t)row * DM + col;
        const float* g = modp(*F, layer, row_sel(row), 2) + col;
        const f32x4 g0 = *(const f32x4*)g, g1 = *(const f32x4*)(g + 4); f32x4 b0, b1;
        if (layer == 0) { const float* base = h0_row(*F, row) + col; b0 = *(const f32x4*)base; b1 = *(const f32x4*)(base + 4); }
        else { float x[8]; unpack8(*(const v4u*)hrow, x); b0 = (f32x4){x[0], x[1], x[2], x[3]}; b1 = (f32x4){x[4], x[5], x[6], x[7]}; }
        const f32x4 o0 = b0 + g0 * v0, o1 = b1 + g1 * v1; v4u w; w.x = pk2(o0.x, o0.y); w.y = pk2(o0.z, o0.w); w.z = pk2(o1.x, o1.y); w.w = pk2(o1.z, o1.w);
        *(v4u*)hrow = w; }
};
__device__ __forceinline__ void l0_post_proj(const Frame& F) {
    const int gw = F.blk * 8 + F.wave, NGW = F.G * 8, lane = F.lane;
    const bf16* P = wsp<const bf16>(F, WS_P); const float* rope = wsp<const float>(F, WS_ROPE);
    constexpr float CD = 0.125f * 1.4426950408889634f;
    for (int row = gw; row < R; row += NGW) {
        const int b = row / TB, t = row - b * TB; const bool lat = t >= CT; const int pos = t - CT, prow = lat ? pos >> 6 : 0, pcol = lat ? pos & 63 : 0;
        const bf16* p = P + (size_t)row * ATT_NP;
        bf16* qd = wsp<bf16>(F, WS_QD) + (size_t)row * 512; bf16* kd = wsp<bf16>(F, WS_KD) + (size_t)row * 512;
#pragma unroll
        for (int j = 0; j < 2; ++j) { const int g = lane + 64 * j, h16 = g >> 3, i0 = (g & 7) * 4;
            const v2u w1 = *(const v2u*)(p + h16 * 64 + i0), w2 = *(const v2u*)(p + h16 * 64 + i0 + 32);
            const float x1[4] = {bflo(w1.x), bfhi(w1.x), bflo(w1.y), bfhi(w1.y)}, x2[4] = {bflo(w2.x), bfhi(w2.x), bflo(w2.y), bfhi(w2.y)};
            float cs[8] = {1.f, 0.f, 1.f, 0.f, 1.f, 0.f, 1.f, 0.f};
            if (lat) { const float* tb = (i0 < 16) ? rope + ROPE_DR + (size_t)(prow * 16 + i0) * 2 : rope + ROPE_DC + (size_t)(pcol * 16 + i0 - 16) * 2;
                const f32x4 t0 = *(const f32x4*)tb, t1 = *(const f32x4*)(tb + 4); cs[0] = t0.x; cs[1] = t0.y; cs[2] = t0.z; cs[3] = t0.w; cs[4] = t1.x; cs[5] = t1.y; cs[6] = t1.z; cs[7] = t1.w; }
            float y1[4], y2[4]; const float sc = h16 < 8 ? CD : 1.f;
#pragma unroll
            for (int e = 0; e < 4; ++e) { y1[e] = (x1[e] * cs[2 * e] - x2[e] * cs[2 * e + 1]) * sc; y2[e] = (x1[e] * cs[2 * e + 1] + x2[e] * cs[2 * e]) * sc; }
            bf16* o = (h16 < 8) ? qd + h16 * 64 + i0 : kd + (h16 - 8) * 64 + i0;
            v2u o1, o2; o1.x = pk2(y1[0], y1[1]); o1.y = pk2(y1[2], y1[3]); o2.x = pk2(y2[0], y2[1]); o2.y = pk2(y2[2], y2[3]);
            *(v2u*)o = o1; *(v2u*)(o + 32) = o2; }
        { float x[8]; float ss = 0.f; const bool act = lane < 48;
          if (act) unpack8(*(const v4u*)(p + 1536 + 8 * lane), x); else {
#pragma unroll
              for (int e = 0; e < 8; ++e) x[e] = 0.f; }
#pragma unroll
          for (int e = 0; e < 8; ++e) ss += x[e] * x[e];
          const float rs = 1.f / sqrtf(wave_sum(ss) * (1.f / 384.f) + NORM_EPS);
          if (act) { const f32x4 g0 = *(const f32x4*)(F.in[I_QNW] + 8 * lane), g1 = *(const f32x4*)(F.in[I_QNW] + 8 * lane + 4); v4u w;
              w.x = pk2(x[0] * rs * g0.x, x[1] * rs * g0.y); w.y = pk2(x[2] * rs * g0.z, x[3] * rs * g0.w); w.z = pk2(x[4] * rs * g1.x, x[5] * rs * g1.y); w.w = pk2(x[6] * rs * g1.z, x[7] * rs * g1.w);
              *(v4u*)(wsp<bf16>(F, WS_CQN) + (size_t)row * 384 + 8 * lane) = w; } }
        { const v2u wv = *(const v2u*)(p + 1920 + 4 * lane); const float x[4] = {bflo(wv.x), bfhi(wv.x), bflo(wv.y), bfhi(wv.y)};
          const float rs = 1.f / sqrtf(wave_sum((x[0] * x[0] + x[1] * x[1]) + (x[2] * x[2] + x[3] * x[3])) * (1.f / 256.f) + NORM_EPS);
          const f32x4 g0 = *(const f32x4*)(F.in[I_KVNW] + 4 * lane); v2u w; w.x = pk2(x[0] * rs * g0.x, x[1] * rs * g0.y); w.y = pk2(x[2] * rs * g0.z, x[3] * rs * g0.w);
          *(v2u*)(wsp<bf16>(F, WS_CKVN) + (size_t)row * 256 + 4 * lane) = w; }
        if (lane < 16) { const int i = lane; const float x1 = bf2f(p[2176 + i]), x2 = bf2f(p[2176 + i + 16]); float c = 1.f, s = 0.f;
            if (lat) { const float* tb = (i < 8) ? rope + ROPE_MR + (size_t)(prow * 8 + i) * 2 : rope + ROPE_MC + (size_t)(pcol * 8 + i - 8) * 2; c = tb[0]; s = tb[1]; }
            bf16* o = wsp<bf16>(F, WS_KRR) + (size_t)row * 32; o[i] = (bf16)f2bf(x1 * c - x2 * s); o[i + 16] = (bf16)f2bf(x1 * s + x2 * c); }
    }
}
__device__ __forceinline__ void l0_mq_rope(const Frame& F) {
    const int gw = F.blk * 8 + F.wave, NGW = F.G * 8, lane = F.lane; const float* rope = wsp<const float>(F, WS_ROPE);
    const float CM = 0.10206207261596575f * 1.4426950408889634f;
    for (int row = gw; row < R; row += NGW) {
        const int b = row / TB, t = row - b * TB; const bool lat = t >= CT; const int pos = t - CT, prow = lat ? pos >> 6 : 0, pcol = lat ? pos & 63 : 0;
        bf16* q = wsp<bf16>(F, WS_MQ) + (size_t)row * 768;
#pragma unroll
        for (int j = 0; j < 2; ++j) { const int g = lane + 64 * j, h = g >> 4, d0 = (g & 15) * 4;
            const v2u wv = *(const v2u*)(q + h * 96 + d0); v2u o; o.x = pk2(bflo(wv.x) * CM, bfhi(wv.x) * CM); o.y = pk2(bflo(wv.y) * CM, bfhi(wv.y) * CM); *(v2u*)(q + h * 96 + d0) = o; }
#pragma unroll
        for (int j = 0; j < 2; ++j) { const int pr = lane + 64 * j, h = pr >> 4, i = pr & 15; const float x1 = bf2f(q[h * 96 + 64 + i]), x2 = bf2f(q[h * 96 + 80 + i]); float c = 1.f, s = 0.f;
            if (lat) { const float* tb = (i < 8) ? rope + ROPE_MR + (size_t)(prow * 8 + i) * 2 : rope + ROPE_MC + (size_t)(pcol * 8 + i - 8) * 2; c = tb[0]; s = tb[1]; }
            q[h * 96 + 64 + i] = (bf16)f2bf((x1 * c - x2 * s) * CM); q[h * 96 + 80 + i] = (bf16)f2bf((x1 * s + x2 * c) * CM); }
    }
}
__device__ __forceinline__ void l0_attention(const Frame& F) {
    LAS char* lds = (LAS char*)F.lds;
    const bf16* QD = wsp<const bf16>(F, WS_QD); const bf16* KD = wsp<const bf16>(F, WS_KD); const bf16* P = wsp<const bf16>(F, WS_P);
    const bf16* MQ = wsp<const bf16>(F, WS_MQ); const bf16* MKV = wsp<const bf16>(F, WS_MKV); const bf16* KRR = wsp<const bf16>(F, WS_KRR);
    float* OD = wsp<float>(F, WS_ODIFF); float* OM = wsp<float>(F, WS_OMLA);
    for (int kind = 0; kind < 2; ++kind) {
        for (int L = F.blk; L < 1024 + 16; L += F.G) {
            int b, h8, qb, nkeys;
            if (L < 1024) { int pair;
                if (F.G == 256) { const int round = L >> 8, c = L & 255; pair = round * 4 + ((c & 7) >> 1); qb = 1 + (c & 1) * 32 + (c >> 3); }
                else { pair = L >> 6; qb = 1 + (L & 63); }
                b = pair >> 3; h8 = pair & 7; nkeys = TB; }
            else { const int s = L - 1024; b = s >> 3; h8 = s & 7; qb = 0; nkeys = CT; }
            const size_t q0 = (size_t)b * TB + (size_t)qb * 256, k0 = (size_t)b * TB;
            if (kind == 0)
                att::attn_unit<64, 128>(QD + q0 * 512 + h8 * 64, 512, KD + k0 * 512 + h8 * 64, 512, nullptr, 0, P + k0 * ATT_NP + 1024 + (h8 >> 1) * 128, ATT_NP,
                                        OD + q0 * 1024 + h8 * 128, 1024, nkeys, lds);
            else
                att::attn_unit<96, 64>(MQ + q0 * 768 + h8 * 96, 768, MKV + k0 * 1024 + h8 * 128, 1024, KRR + k0 * 32, 32, MKV + k0 * 1024 + h8 * 128 + 64, 1024,
                                       OM + q0 * 512 + h8 * 64, 512, nkeys, lds);
        }
    }
}
__device__ __forceinline__ void l0_combine(const Frame& F) {
    const int gw = F.blk * 8 + F.wave, NGW = F.G * 8, lane = F.lane;
    const float* lv = F.in[I_LAM];
    const float lam = __expf(wave_sum(lv[lane] * lv[64 + lane])) - __expf(wave_sum(lv[128 + lane] * lv[192 + lane])) + 0.2f;
    const float sw0 = F.in[I_SUBLN][2 * lane] * 0.8f, sw1 = F.in[I_SUBLN][2 * lane + 1] * 0.8f;
    for (int row = gw; row < R; row += NGW) {
        const float* od = wsp<const float>(F, WS_ODIFF) + (size_t)row * 1024; const float* om = wsp<const float>(F, WS_OMLA) + (size_t)row * 512;
        bf16* a1 = wsp<bf16>(F, WS_A1) + (size_t)row * DM;
#pragma unroll
        for (int h = 0; h < 4; ++h) {
            const float o1a = od[(2 * h) * 128 + 2 * lane], o1b = od[(2 * h) * 128 + 2 * lane + 1], o2a = od[(2 * h + 1) * 128 + 2 * lane], o2b = od[(2 * h + 1) * 128 + 2 * lane + 1];
            const float da = o1a - lam * o2a, db = o1b - lam * o2b;
            const float rs = 1.f / sqrtf(wave_sum(da * da + db * db) * (1.f / 128.f) + NORM_EPS);
            *(unsigned*)(a1 + h * 128 + 2 * lane) = pk2(da * rs * sw0, db * rs * sw1); }
#pragma unroll
        for (int j = 0; j < 2; ++j) { const f32x4 v = *(const f32x4*)(om + 4 * (lane + 64 * j)); v2u w; w.x = pk2(v.x, v.y); w.y = pk2(v.z, v.w); *(v2u*)(a1 + 512 + 4 * (lane + 64 * j)) = w; }
    }
}
constexpr int RT_LS = 264;
__device__ __forceinline__ void ph_router(const Frame& F, int layer) {
    LAS bf16* AH = (LAS bf16*)F.lds; LAS bf16* AL = AH + 64 * RT_LS; LAS bf16* WH = AL + 64 * RT_LS; LAS bf16* WL = WH + 32 * RT_LS;
    LAS float* lg = (LAS float*)(F.lds + 110592);
    LAS int* hist = (LAS int*)(F.lds + MISC_OFF + 256);
    LAS int* recs = (LAS int*)(F.lds + MISC_OFF + 512);
    const int lane = F.lane, w = F.wave, tid = F.tid, RPB = (R + F.G - 1) / F.G, row0 = F.blk * RPB;
    if (tid < 64) hist[tid] = 0;
    { int* srct = wsp<int>(F, WS_SRC); for (int i = F.blk * 512 + tid; i < MAXROWS; i += F.G * 512) srct[i] = 0; }
    const float* nw = F.in[I_NFFN] + (size_t)layer * DM; const float* rbp = F.in[I_RB] + layer * NE;
    const bf16* wrh = wsp<const bf16>(F, WS_WRH) + (size_t)layer * 32 * 1024; const bf16* wrl = wsp<const bf16>(F, WS_WRL) + (size_t)layer * 32 * 1024;
    for (int pass = 0; pass * 64 < RPB; ++pass) {
        const int nrow = min(64, min(RPB - pass * 64, R - row0 - pass * 64));
        f32x4 fr[8][4];
#pragma unroll
        for (int i = 0; i < 8; ++i) { const int rl = w + 8 * i; const int row = row0 + pass * 64 + rl;
            if (rl < nrow) {
                const int sel = row_sel(row); const float* sh = modp(F, layer, sel, 3); const float* sc = modp(F, layer, sel, 4);
                const v2u* xr = (const v2u*)(wsp<const bf16>(F, WS_H) + (size_t)row * DM) + lane; float s = 0.f;
#pragma unroll
                for (int j = 0; j < 4; ++j) { const v2u hw = xr[64 * j]; fr[i][j] = (f32x4){bflo(hw.x), bfhi(hw.x), bflo(hw.y), bfhi(hw.y)}; s += (fr[i][j].x * fr[i][j].x + fr[i][j].y * fr[i][j].y) + (fr[i][j].z * fr[i][j].z + fr[i][j].w * fr[i][j].w); }
                const float rs = 1.f / sqrtf(wave_sum(s) * (1.f / DM) + NORM_EPS);
                unsigned long long* o8 = (unsigned long long*)(wsp<bf16>(F, WS_F) + (size_t)row * DM) + lane;
#pragma unroll
                for (int j = 0; j < 4; ++j) { const f32x4 ww = ((const f32x4*)nw)[lane + 64 * j], a = ((const f32x4*)sh)[lane + 64 * j], c = ((const f32x4*)sc)[lane + 64 * j];
                    fr[i][j] = fr[i][j] * rs * ww * (c + 1.f) + a;
                    o8[64 * j] = (unsigned long long)pk2(fr[i][j].x, fr[i][j].y) | ((unsigned long long)pk2(fr[i][j].z, fr[i][j].w) << 32); }
            } else {
#pragma unroll
                for (int j = 0; j < 4; ++j) fr[i][j] = (f32x4){0.f, 0.f, 0.f, 0.f};
            } }
        pg8::f32x4 acc = {0.f, 0.f, 0.f, 0.f};
#pragma unroll
        for (int c = 0; c < 4; ++c) {
            __syncthreads();
#pragma unroll
            for (int i = 0; i < 8; ++i) { const f32x4 v = fr[i][c]; const unsigned h0 = pk2(v.x, v.y), h1 = pk2(v.z, v.w);
                const unsigned l0 = pk2(v.x - bflo(h0), v.y - bfhi(h0)), l1 = pk2(v.z - bflo(h1), v.w - bfhi(h1));
                v2u hh; hh.x = h0; hh.y = h1; v2u ll; ll.x = l0; ll.y = l1;
                *(LAS v2u*)(AH + (w + 8 * i) * RT_LS + 4 * lane) = hh; *(LAS v2u*)(AL + (w + 8 * i) * RT_LS + 4 * lane) = ll; }
            { const int e = tid >> 4, kp = (tid & 15) * 16;
              const v4u a0 = *(const v4u*)(wrh + (size_t)e * 1024 + 256 * c + kp), a1 = *(const v4u*)(wrh + (size_t)e * 1024 + 256 * c + kp + 8);
              const v4u b0 = *(const v4u*)(wrl + (size_t)e * 1024 + 256 * c + kp), b1 = *(const v4u*)(wrl + (size_t)e * 1024 + 256 * c + kp + 8);
              *(LAS v4u*)(WH + e * RT_LS + kp) = a0; *(LAS v4u*)(WH + e * RT_LS + kp + 8) = a1; *(LAS v4u*)(WL + e * RT_LS + kp) = b0; *(LAS v4u*)(WL + e * RT_LS + kp + 8) = b1; }
            __syncthreads();
            const int tm = w >> 1, tn = w & 1, lr = lane & 15, kq = (lane >> 4) * 8;
            const LAS bf16* ahp = AH + (tm * 16 + lr) * RT_LS + kq; const LAS bf16* alp = AL + (tm * 16 + lr) * RT_LS + kq;
            const LAS bf16* whp = WH + (tn * 16 + lr) * RT_LS + kq; const LAS bf16* wlp = WL + (tn * 16 + lr) * RT_LS + kq;
#pragma unroll
            for (int ks = 0; ks < 8; ++ks) { const bf16x8 ah = *(const LAS bf16x8*)(ahp + 32 * ks), al = *(const LAS bf16x8*)(alp + 32 * ks), bh = *(const LAS bf16x8*)(whp + 32 * ks), bl = *(const LAS bf16x8*)(wlp + 32 * ks);
                acc = __builtin_amdgcn_mfma_f32_16x16x32_bf16(ah, bh, acc, 0, 0, 0); acc = __builtin_amdgcn_mfma_f32_16x16x32_bf16(ah, bl, acc, 0, 0, 0); acc = __builtin_amdgcn_mfma_f32_16x16x32_bf16(al, bh, acc, 0, 0, 0); }
        }
        { const int m0 = (w >> 1) * 16 + (lane >> 4) * 4, n = (w & 1) * 16 + (lane & 15);
#pragma unroll
          for (int r = 0; r < 4; ++r) lg[(m0 + r) * 33 + n] = acc[r]; }
        __syncthreads();
        if (tid < nrow) { const int rl = tid, row = row0 + pass * 64 + rl; float lv[32];
#pragma unroll
            for (int e = 0; e < 32; ++e) lv[e] = lg[rl * 33 + e] + rbp[e];
            float selv[4]; int seli[4];
#pragma unroll
            for (int r = 0; r < 4; ++r) { float bv = -3.0e38f; int bi = 0;
#pragma unroll
                for (int e = 0; e < 32; ++e) { const bool taken = (r > 0 && seli[0] == e) || (r > 1 && seli[1] == e) || (r > 2 && seli[2] == e); if (!taken && lv[e] > bv) { bv = lv[e]; bi = e; } }
                selv[r] = bv; seli[r] = bi; }
            float ex[4], es = 0.f;
#pragma unroll
            for (int r = 0; r < 4; ++r) { ex[r] = __expf(selv[r] - selv[0]); es += ex[r]; }
            const float inv = 1.f / es;
#pragma unroll
            for (int r = 0; r < 4; ++r) { wsp<int>(F, WS_TOPE)[(size_t)row * 4 + r] = seli[r]; wsp<float>(F, WS_GATE)[(size_t)row * 4 + r] = ex[r] * inv;
                const int rk = __hip_atomic_fetch_add(&hist[seli[r]], 1, __ATOMIC_RELAXED, __HIP_MEMORY_SCOPE_WORKGROUP);
                recs[(pass * 64 + rl) * 4 + r] = seli[r] | (rk << 8); }
        }
    }
    __syncthreads();
    if (tid < NE) hist[32 + tid] = (int)__hip_atomic_fetch_add(F.ctl + CW_CNT + 64 * (layer + 2 * F.probe) + tid, (unsigned)hist[tid], RLX_AGENT);
    __syncthreads();
    for (int rl = tid; rl < RPB && row0 + rl < R; rl += 512) {
#pragma unroll
        for (int r = 0; r < 4; ++r) { const int rc = recs[rl * 4 + r]; wsp<int>(F, WS_POS)[(size_t)(row0 + rl) * 4 + r] = hist[32 + (rc & 255)] + (rc >> 8); } }
}
__device__ __forceinline__ void moe_tables(const Frame& F, int layer, LAS int* ps, LAS int* tile_e) {
    if (F.tid == 0) { int acc = 0, t = 0;
        for (int e = 0; e < NE; ++e) { const int c = (int)__hip_atomic_load(F.ctl + CW_CNT + 64 * layer + e, RLX_AGENT); ps[e] = acc; const int nt = (c + 255) >> 8;
            for (int i = 0; i < nt && t < MAXT; ++i) tile_e[t++] = e; acc += nt * 256; }
        ps[NE] = acc; ps[NE + 1] = t; }
    __syncthreads();
}
__device__ __forceinline__ void ph_gather(const Frame& F, int layer) {
    LAS int* ps = (LAS int*)(F.lds + MISC_OFF + 256); LAS int* tile_e = ps + 64;
    moe_tables(F, layer, ps, tile_e);
    if (F.blk == 0) { int* tab = wsp<int>(F, WS_TILE); const int nt = ps[NE + 1]; if (F.tid == 0) tab[0] = nt; for (int i = F.tid; i < nt; i += 512) tab[1 + i] = tile_e[i]; }
    for (int i = F.blk * 512 + F.tid; i < R * 4; i += F.G * 512) { const int row = i >> 2;
        const int e = wsp<const int>(F, WS_TOPE)[i]; const int dest = ps[e] + wsp<const int>(F, WS_POS)[i]; wsp<int>(F, WS_DEST)[i] = dest; wsp<int>(F, WS_SRC)[dest] = row; }
}
struct MoeOrder {
    const int* tile_e; int ntiles, nN, G, c; const int* src;
    __device__ __forceinline__ bool next(int i, pg8::Unit& u) const {
        int rt, pl;
        if (G == 256) { const int x = c & 7, y = c >> 3, rpx = 32 / nN; rt = (i * 8 + x) * rpx + y / nN; pl = y % nN; if (rt >= ntiles) return false; }
        else { const long L = (long)i * G + c; if (L >= (long)ntiles * nN) return false; rt = (int)(L / nN); pl = (int)(L - (long)rt * nN); }
        const int e = __builtin_amdgcn_readfirstlane(tile_e[rt]);
        u.pm = rt; u.pn = e * nN + pl; return true; }
    __device__ __forceinline__ void a_ready(const pg8::Unit&) const {}
    __device__ __forceinline__ void done(const pg8::Unit&) const {}
};
struct LatOrder {
    pg8::StaticOrder o;
    __device__ __forceinline__ bool next(int i, pg8::Unit& u) const { if (!o.next(i, u)) return false; u.pm += 1 + (u.pm >= 64 ? 1 : 0); return true; }
    __device__ __forceinline__ void a_ready(const pg8::Unit&) const {}
    __device__ __forceinline__ void done(const pg8::Unit&) const {}
};
struct FnSwiglu {
    bf16* HS; const float* b1;
    __device__ __forceinline__ void operator()(int row, int col, f32x4 v0, f32x4 v1) const {
        const float* bp = b1 + col;
        const f32x4 b0 = *(const f32x4*)bp, b1v = *(const f32x4*)(bp + 4); v0 = v0 + b0; v1 = v1 + b1v;
        const float hv[8] = {v0[0], v0[1], v0[2], v0[3], v1[0], v1[1], v1[2], v1[3]}; float o[4];
#pragma unroll
        for (int i = 0; i < 4; ++i) { const float g = hv[2 * i], l = hv[2 * i + 1];
            const float gl = fminf(g, 7.f), li = fminf(fmaxf(l, -7.f), 7.f); o[i] = gl * sigmoidf_(1.702f * gl) * (li + 1.f); }
        const int lc = col & 2047; v2u w; w.x = pk2(o[0], o[1]); w.y = pk2(o[2], o[3]);
        *(v2u*)(HS + (size_t)row * 1024 + (lc >> 1)) = w; }
};
struct FnBiasBf16 {
    bf16* YS; const float* b2;
    __device__ __forceinline__ void operator()(int row, int col, f32x4 v0, f32x4 v1) const {
        const f32x4 b0 = *(const f32x4*)(b2 + col), b1v = *(const f32x4*)(b2 + col + 4); v0 = v0 + b0; v1 = v1 + b1v;
        v4u w; w.x = pk2(v0[0], v0[1]); w.y = pk2(v0[2], v0[3]); w.z = pk2(v1[0], v1[1]); w.w = pk2(v1[2], v1[3]);
        *(v4u*)(YS + (size_t)row * 1024 + (col & 1023)) = w; }
};
__device__ __forceinline__ void ph_combine(const Frame& F, int layer) {
    const int lane = F.lane, gw = F.blk * 8 + F.wave, NGW = F.G * 8;
    for (int row = gw; row < R; row += NGW) {
        const int sel = row_sel(row); const float* gf = modp(F, layer, sel, 5);
        bf16* hrow = wsp<bf16>(F, WS_H) + (size_t)row * DM;
        f32x4 y[4];
#pragma unroll
        for (int j = 0; j < 4; ++j) y[j] = (f32x4){0.f, 0.f, 0.f, 0.f};
#pragma unroll
        for (int r = 0; r < 4; ++r) { const int d = wsp<const int>(F, WS_DEST)[(size_t)row * 4 + r]; const float g = wsp<const float>(F, WS_GATE)[(size_t)row * 4 + r];
            const v2u* yp = (const v2u*)(wsp<const bf16>(F, WS_XS) + (size_t)d * DM);
#pragma unroll
            for (int j = 0; j < 4; ++j) { const v2u w = yp[lane + 64 * j]; y[j] += g * (f32x4){bflo(w.x), bfhi(w.x), bflo(w.y), bfhi(w.y)}; } }
        f32x4 h[4]; float s = 0.f;
#pragma unroll
        for (int j = 0; j < 4; ++j) { const v2u hw = ((const v2u*)hrow)[lane + 64 * j]; h[j] = (f32x4){bflo(hw.x), bfhi(hw.x), bflo(hw.y), bfhi(hw.y)} + ((const f32x4*)gf)[lane + 64 * j] * y[j]; s += (h[j].x * h[j].x + h[j].y * h[j].y) + (h[j].z * h[j].z + h[j].w * h[j].w); }
        const float rs = 1.f / sqrtf(wave_sum(s) * (1.f / DM) + NORM_EPS);
        if (layer == 0) {
#pragma unroll
            for (int j = 0; j < 4; ++j) { v2u hw; hw.x = pk2(h[j].x, h[j].y); hw.y = pk2(h[j].z, h[j].w); ((v2u*)hrow)[lane + 64 * j] = hw; }
            const float* nw = F.in[I_NMIX] + DM; const float* sh = modp(F, 1, sel, 0); const float* sc = modp(F, 1, sel, 1);
            unsigned long long* o8 = (unsigned long long*)(wsp<bf16>(F, WS_A) + (size_t)row * DM) + lane;
#pragma unroll
            for (int j = 0; j < 4; ++j) { const f32x4 w = ((const f32x4*)nw)[lane + 64 * j], a = ((const f32x4*)sh)[lane + 64 * j], c = ((const f32x4*)sc)[lane + 64 * j];
                const f32x4 o = h[j] * rs * w * (c + 1.f) + a; o8[64 * j] = (unsigned long long)pk2(o.x, o.y) | ((unsigned long long)pk2(o.z, o.w) << 32); }
        } else {
            const int b = row / TB, t = row - b * TB;
            if (t >= CT) { float* orow = F.out + ((size_t)b * SEQ + (t - CT)) * DM; const float* nw = F.in[I_FNW];
#pragma unroll
                for (int j = 0; j < 4; ++j) ((f32x4*)orow)[lane + 64 * j] = h[j] * rs * ((const f32x4*)nw)[lane + 64 * j]; }
        }
    }
}
constexpr int PC_Q = 1920, PC_K = 2176, PC_V = 2432, PC_O = 2944, PC_G = 3456;
__device__ __forceinline__ float softplusf_(float y) { return fmaxf(y, 0.f) + __logf(1.f + __expf(-fabsf(y))); }
__device__ __forceinline__ float tanhf_(float x) { return 1.f - 2.f / (1.f + __expf(2.f * x)); }
__device__ __forceinline__ void lerp8(const bf16* p, bool hp, bool hn, int c0, const float* mu, float (&u)[8]) {
    const v4u z4 = {0u, 0u, 0u, 0u};
    const v4u wx = *(const v4u*)(p + c0), wp = hp ? *(const v4u*)(p - REC_NP + c0) : z4, wn = hn ? *(const v4u*)(p + REC_NP + c0) : z4;
    float x[8], xp[8], xn[8]; unpack8(wx, x); unpack8(wp, xp); unpack8(wn, xn);
    const f32x4 m0 = *(const f32x4*)(mu + c0), m1 = *(const f32x4*)(mu + c0 + 4);
#pragma unroll
    for (int e = 0; e < 8; ++e) { const float m = e < 4 ? m0[e & 3] : m1[e & 3]; u[e] = x[e] + m * (0.5f * (xp[e] + xn[e]) - x[e]); }
}
__device__ __forceinline__ void st8h(bf16* o, const float (&u)[8]) { v4u w; w.x = pk2(u[0], u[1]); w.y = pk2(u[2], u[3]); w.z = pk2(u[4], u[5]); w.w = pk2(u[6], u[7]); *(v4u*)o = w; }
__device__ __forceinline__ void st8f(float* o, const float (&u)[8]) { *(f32x4*)o = (f32x4){u[0], u[1], u[2], u[3]}; *(f32x4*)(o + 4) = (f32x4){u[4], u[5], u[6], u[7]}; }
__device__ __forceinline__ void l1_rwkv_prep(const Frame& F) {
    const int gw = F.blk * 8 + F.wave, NGW = F.G * 8, lane = F.lane; const float* mu = F.in[I_MU];
    for (int row = gw; row < R; row += NGW) {
        const int b = row / TB, t = row - b * TB; const bool hp = (t != 0 && t != CT), hn = (t != CT - 1 && t != TB - 1);
        const bf16* p = wsp<const bf16>(F, WS_P) + (size_t)row * REC_NP; const size_t ro = (size_t)row * 512 + 8 * lane;
        float u[8];
        lerp8(p, hp, hn, 8 * lane, mu, u); st8h(wsp<bf16>(F, WS_RR) + ro, u);
        lerp8(p, hp, hn, 1024 + 8 * lane, mu, u); st8h(wsp<bf16>(F, WS_VV) + ro, u);
        lerp8(p, hp, hn, 512 + 8 * lane, mu, u); st8h(wsp<bf16>(F, WS_KL) + ro, u);
        { const f32x4 k0 = *(const f32x4*)(F.in[I_KK] + 8 * lane), k1 = *(const f32x4*)(F.in[I_KK] + 8 * lane + 4); float ss = 0.f;
#pragma unroll
          for (int e = 0; e < 8; ++e) { u[e] *= (e < 4 ? k0[e & 3] : k1[e & 3]); ss += u[e] * u[e]; }
          ss += __shfl_xor(ss, 1); ss += __shfl_xor(ss, 2); ss += __shfl_xor(ss, 4);
          const float inv = -1.f / sqrtf(fmaxf(ss, 1e-24f));
#pragma unroll
          for (int e = 0; e < 8; ++e) u[e] *= inv;
          st8h(wsp<bf16>(F, WS_AKK) + ro, u); }
        if (lane < 48) { lerp8(p, hp, hn, 1536 + 8 * lane, mu, u);
#pragma unroll
            for (int e = 0; e < 8; ++e) u[e] = lane < 16 ? tanhf_(u[e]) : (lane < 32 ? u[e] : sigmoidf_(u[e]));
            v4u w; w.x = pk2(u[0], u[1]); w.y = pk2(u[2], u[3]); w.z = pk2(u[4], u[5]); w.w = pk2(u[6], u[7]);
            *(v4u*)(wsp<bf16>(F, WS_ALORA) + (size_t)row * 384 + 8 * lane) = w; }
    }
}
struct EpiLora {
    static constexpr bool PERM = true, AFTER_DRAIN = false;
    const Frame* F;
    template <int KIND> __device__ __forceinline__ void run(const pg8::f32x4 (&acc)[2][2][4][2], const pg8::Unit& u, int wr, int wc, int fr, int fq, int z) const {
#pragma unroll
        for (int ai = 0; ai < 2; ++ai)
#pragma unroll
            for (int m = 0; m < 4; ++m) { const int row = u.pm * 256 + ai * 128 + wr * 64 + m * 16 + fr;
#pragma unroll
                for (int bj = 0; bj < 2; ++bj) { const int c = ((u.pn & 1) * 256) + bj * 128 + wc * 32 + 8 * fq; const size_t ro = (size_t)row * 512 + c;
                    const pg8::f32x4 v0 = acc[ai][bj][m][0], v1 = acc[ai][bj][m][1]; const float x[8] = {v0[0], v0[1], v0[2], v0[3], v1[0], v1[1], v1[2], v1[3]}; float o[8];
                    if constexpr (KIND == 0) { const float* w0 = F->in[I_W0] + z * 512 + c;
#pragma unroll
                        for (int e = 0; e < 8; ++e) { const float wl = -softplusf_(-(w0[e] + x[e])) - 0.5f; o[e] = __expf(-__expf(wl)); }
                        st8f(wsp<float>(*F, WS_WDEC) + (size_t)z * R * 512 + ro, o); }
                    else if constexpr (KIND == 1) { const float* a0 = F->in[I_A0] + z * 512 + c;
#pragma unroll
                        for (int e = 0; e < 8; ++e) o[e] = sigmoidf_(a0[e] + x[e]);
                        st8h(wsp<bf16>(*F, WS_ASIG) + (size_t)z * R * 512 + ro, o); }
                    else st8h(wsp<bf16>(*F, WS_GG) + ro, x); } }
    }
    __device__ __forceinline__ void operator()(const pg8::f32x4 (&acc)[2][2][4][2], const pg8::Unit& u, int wr, int wc, int fr, int fq) const {
        const int part = u.pn >> 1;
        if (part < 2) run<0>(acc, u, wr, wc, fr, fq, part); else if (part < 4) run<1>(acc, u, wr, wc, fr, fq, part - 2); else run<2>(acc, u, wr, wc, fr, fq, 0);
    }
};
__device__ __forceinline__ void mlstm_gates(const Frame& F, int row, int z, int h, float& ig, float& lf) {
    const bf16* g = wsp<const bf16>(F, WS_P) + (size_t)row * REC_NP + PC_G + z * 8 + h; const float* gb = F.in[I_GATEB] + z * 8 + h;
    const float gi = bf2f(g[0]) + gb[0], gf = bf2f(g[4]) + gb[4];
    ig = 15.f * tanhf_(gi * (1.f / 15.f)); const float cf = 15.f * tanhf_(gf * (1.f / 15.f)); lf = fminf(cf, 0.f) - __logf(1.f + __expf(-fabsf(cf)));
}
__device__ __forceinline__ void mlstm_chunk_head(const Frame& F, int z, int b, int h, int c, LAS float* vec) {
    LAS int* rows = (LAS int*)vec;
    if (F.tid < 64) { const int s = F.tid, row = b * TB + scan_tok(z, 64 * c + s); float ig, lf; mlstm_gates(F, row, z, h, ig, lf); rows[s] = row; vec[64 + s] = ig; vec[192 + s] = lf; }
    __syncthreads();
    if (F.tid < 64) { float a = 0.f; for (int s = 0; s <= F.tid; ++s) a += vec[192 + s]; vec[128 + F.tid] = a; }
    __syncthreads();
}
__device__ __forceinline__ void l1_mlstm_b(const Frame& F) {
    const float* __restrict__ SC = wsp<const float>(F, WS_SC); const float* __restrict__ DC = wsp<const float>(F, WS_DC); float* __restrict__ CST = wsp<float>(F, WS_CST);
    const float* __restrict__ DN = wsp<const float>(F, WS_DN); float* __restrict__ NST = wsp<float>(F, WS_NST); float* __restrict__ MST = wsp<float>(F, WS_MST);
    for (int g = F.blk * 512 + F.tid; g < 16 * 8192; g += F.G * 512) {
        const int chain = g >> 13, el = g & 8191; float m = 0.f, C = 0.f, N = 0.f; const bool don = el < 64;
        for (int c0 = 0; c0 < 260; c0 += 10) {
            float dc[10], dn[10], bl[10], ml[10];
#pragma unroll
            for (int i = 0; i < 10; ++i) { const size_t u = (size_t)chain * 260 + c0 + i; dc[i] = DC[u * 8192 + el]; dn[i] = don ? DN[u * 64 + el] : 0.f; bl[i] = SC[2 * u]; ml[i] = SC[2 * u + 1]; }
#pragma unroll
            for (int i = 0; i < 10; ++i) { const size_t u = (size_t)chain * 260 + c0 + i;
                CST[u * 8192 + el] = C; if (don) NST[u * 64 + el] = N; if (el == 0) MST[u] = m;
                const float mn = fmaxf(bl[i] + m, ml[i]), cd = __expf(bl[i] + m - mn), inj = __expf(ml[i] - mn);
                C = cd * C + inj * dc[i]; N = cd * N + inj * dn[i]; m = mn; }
        }
    }
}
__device__ __forceinline__ void l1_rec_out(const Frame& F) {
    const int gw = F.blk * 8 + F.wave, NGW = F.G * 8, lane = F.lane, c0 = 8 * lane;
    for (int row = gw; row < R; row += NGW) {
        const size_t ro = (size_t)row * 512 + c0; bf16* a1 = wsp<bf16>(F, WS_A1) + (size_t)row * DM;
        { float y0[8], y1[8], y[8]; float s = 0.f; unpack8(*(const v4u*)(wsp<const bf16>(F, WS_YR) + ro), y0); unpack8(*(const v4u*)(wsp<const bf16>(F, WS_YR) + (size_t)R * 512 + ro), y1);
          const float* y2 = wsp<const float>(F, WS_YB) + ro; const float* y3 = y2 + (size_t)R * 512;
#pragma unroll
          for (int e = 0; e < 8; ++e) { y[e] = (y0[e] + y1[e]) + (y2[e] + y3[e]); s += y[e]; }
          s += __shfl_xor(s, 1); s += __shfl_xor(s, 2); s += __shfl_xor(s, 4); const float mean = s * (1.f / 64.f); float q = 0.f;
#pragma unroll
          for (int e = 0; e < 8; ++e) { y[e] -= mean; q += y[e] * y[e]; }
          q += __shfl_xor(q, 1); q += __shfl_xor(q, 2); q += __shfl_xor(q, 4); const float rstd = 1.f / sqrtf(q * (1.f / 64.f) + 64e-5f);
          float rr[8], kl[8], s0[8], s1[8], vv[8], gg[8]; unpack8(*(const v4u*)(wsp<const bf16>(F, WS_RR) + ro), rr); unpack8(*(const v4u*)(wsp<const bf16>(F, WS_KL) + ro), kl);
          unpack8(*(const v4u*)(wsp<const bf16>(F, WS_ASIG) + ro), s0); unpack8(*(const v4u*)(wsp<const bf16>(F, WS_ASIG) + (size_t)R * 512 + ro), s1);
          unpack8(*(const v4u*)(wsp<const bf16>(F, WS_VV) + ro), vv); unpack8(*(const v4u*)(wsp<const bf16>(F, WS_GG) + ro), gg);
          const float* rk = F.in[I_RK] + c0; const float* ka = F.in[I_KA] + c0; float bs = 0.f;
#pragma unroll
          for (int e = 0; e < 8; ++e) bs += rr[e] * kl[e] * (2.f + (s0[e] + s1[e] - 2.f) * ka[e]) * rk[e];
          bs += __shfl_xor(bs, 1); bs += __shfl_xor(bs, 2); bs += __shfl_xor(bs, 4);
          const float* lw = F.in[I_LNW] + c0; const float* lb = F.in[I_LNB] + c0; float o[8];
#pragma unroll
          for (int e = 0; e < 8; ++e) o[e] = (y[e] * rstd * lw[e] + lb[e] + bs * vv[e]) * gg[e];
          v4u w; w.x = pk2(o[0], o[1]); w.y = pk2(o[2], o[3]); w.z = pk2(o[4], o[5]); w.w = pk2(o[6], o[7]); *(v4u*)(a1 + c0) = w; }
        { float h0[8], h1[8], x[8]; float q = 0.f; unpack8(*(const v4u*)(wsp<const bf16>(F, WS_HM) + ro), h0); unpack8(*(const v4u*)(wsp<const bf16>(F, WS_HM) + (size_t)R * 512 + ro), h1);
#pragma unroll
          for (int e = 0; e < 8; ++e) { x[e] = h0[e] + h1[e]; q += x[e] * x[e]; }
          q += __shfl_xor(q, 1); q += __shfl_xor(q, 2); q += __shfl_xor(q, 4); q += __shfl_xor(q, 8); const float rs = 1.f / sqrtf(q * (1.f / 128.f) + NORM_EPS);
          float og[8]; unpack8(*(const v4u*)(wsp<const bf16>(F, WS_P) + (size_t)row * REC_NP + PC_O + c0), og); const float* nw = F.in[I_MNW] + c0; float o[8];
#pragma unroll
          for (int e = 0; e < 8; ++e) o[e] = x[e] * rs * nw[e] * sigmoidf_(og[e]);
          v4u w; w.x = pk2(o[0], o[1]); w.y = pk2(o[2], o[3]); w.z = pk2(o[4], o[5]); w.w = pk2(o[6], o[7]); *(v4u*)(a1 + 512 + c0) = w; }
    }
}
#ifndef NEU_ROUNDS
#define NEU_ROUNDS 6
#endif
namespace rk {
constexpr int LS = 72;
constexpr int MB = 64 * LS * 2;
struct Acc2 { pg8::f32x4 t0, t1; };
__device__ __forceinline__ void zero(Acc2& a) { a.t0 = (pg8::f32x4){0.f, 0.f, 0.f, 0.f}; a.t1 = a.t0; }
__device__ __forceinline__ void mm_acc(Acc2& acc, const LAS bf16* A, const LAS bf16* Bt, int wave, int lane) {
    const int tm = wave >> 1, tn0 = (wave & 1) * 2, lr = lane & 15, kq = (lane >> 4) * 8;
    const LAS bf16* ap = A + (tm * 16 + lr) * LS + kq; const LAS bf16* bp0 = Bt + (tn0 * 16 + lr) * LS + kq; const LAS bf16* bp1 = bp0 + 16 * LS;
    const bf16x8 a0 = *(const LAS bf16x8*)ap, a1 = *(const LAS bf16x8*)(ap + 32);
    const bf16x8 b00 = *(const LAS bf16x8*)bp0, b01 = *(const LAS bf16x8*)(bp0 + 32), b10 = *(const LAS bf16x8*)bp1, b11 = *(const LAS bf16x8*)(bp1 + 32);
    acc.t0 = __builtin_amdgcn_mfma_f32_16x16x32_bf16(a0, b00, acc.t0, 0, 0, 0); acc.t0 = __builtin_amdgcn_mfma_f32_16x16x32_bf16(a1, b01, acc.t0, 0, 0, 0);
    acc.t1 = __builtin_amdgcn_mfma_f32_16x16x32_bf16(a0, b10, acc.t1, 0, 0, 0); acc.t1 = __builtin_amdgcn_mfma_f32_16x16x32_bf16(a1, b11, acc.t1, 0, 0, 0);
}
template <class Fn> __device__ __forceinline__ void each(const Acc2& acc, int wave, int lane, Fn fn) {
    const int m0 = (wave >> 1) * 16 + (lane >> 4) * 4, n0 = (wave & 1) * 32 + (lane & 15);
#pragma unroll
    for (int r = 0; r < 4; ++r) { fn(m0 + r, n0, acc.t0[r]); fn(m0 + r, n0 + 16, acc.t1[r]); }
}
__device__ __forceinline__ void stb(LAS bf16* M, int m, int n, float v) { M[m * LS + n] = (bf16)f2bf(v); }
__device__ __forceinline__ void st_tr(LAS bf16* M, const Acc2& acc, int wave, int lane) {
    const int m0 = (wave >> 1) * 16 + (lane >> 4) * 4, n0 = (wave & 1) * 32 + (lane & 15);
    v2u a, b; a.x = pk2(acc.t0[0], acc.t0[1]); a.y = pk2(acc.t0[2], acc.t0[3]); b.x = pk2(acc.t1[0], acc.t1[1]); b.y = pk2(acc.t1[2], acc.t1[3]);
    *(LAS v2u*)(M + n0 * LS + m0) = a; *(LAS v2u*)(M + (n0 + 16) * LS + m0) = b;
}
}
__device__ __forceinline__ void l1_rk_phase_a(const Frame& F) {
    using namespace rk;
    LAS unsigned char* L = F.lds;
    LAS bf16* Rt = (LAS bf16*)(L + 0 * MB); LAS bf16* At = (LAS bf16*)(L + 1 * MB); LAS bf16* AtT = (LAS bf16*)(L + 2 * MB); LAS bf16* Bq = (LAS bf16*)(L + 3 * MB); LAS bf16* Kq = (LAS bf16*)(L + 4 * MB);
    LAS bf16* VT = (LAS bf16*)(L + 5 * MB); LAS bf16* BhT = (LAS bf16*)(L + 6 * MB); LAS bf16* KhT = (LAS bf16*)(L + 7 * MB);
    LAS bf16* AK = (LAS bf16*)(L + 8 * MB); LAS bf16* RB = (LAS bf16*)(L + 9 * MB); LAS bf16* RK = (LAS bf16*)(L + 10 * MB);
    LAS bf16* X = (LAS bf16*)(L + 11 * MB); LAS bf16* XT = (LAS bf16*)(L + 12 * MB); LAS bf16* P = (LAS bf16*)(L + 13 * MB);
    LAS bf16* AkVT = Bq; LAS bf16* ApT = Kq; LAS bf16* W2T = X;
    LAS float* G = (LAS float*)(L + 8 * MB);
    LAS float* gl = (LAS float*)(L + 14 * MB);
    const int w = F.wave, lane = F.lane, tid = F.tid;
    const int t = lane, j0 = 8 * w;
    float fr[8], fv[8], fa[8], fw[8], fk[8], fb[8];
#define RK_LOAD(u_) do { const int ch_ = (u_) / 260, c_ = (u_) - ch_ * 260, z_ = ch_ >> 4, b_ = (ch_ >> 3) & 1, h_ = ch_ & 7; const size_t ro = ((size_t)b_ * TB + scan_tok(z_, 64 * c_ + t)) * 512 + h_ * 64 + j0; \
    const v4u xr_ = *(const v4u*)(wsp<const bf16>(F, WS_RR) + ro), xv_ = *(const v4u*)(wsp<const bf16>(F, WS_VV) + ro), xa_ = *(const v4u*)(wsp<const bf16>(F, WS_AKK) + ro), xk_ = *(const v4u*)(wsp<const bf16>(F, WS_KL) + ro), \
              xs_ = *(const v4u*)(wsp<const bf16>(F, WS_ASIG) + (size_t)z_ * R * 512 + ro); const float* p3 = wsp<const float>(F, WS_WDEC) + (size_t)z_ * R * 512 + ro; const float* pk_ = F.in[I_KA] + h_ * 64 + j0; \
    const f32x4 w0_ = *(const f32x4*)p3, w1_ = *(const f32x4*)(p3 + 4), q0_ = *(const f32x4*)pk_, q1_ = *(const f32x4*)(pk_ + 4); float sg_[8], kl_[8]; \
    unpack8(xr_, fr); unpack8(xv_, fv); unpack8(xa_, fa); unpack8(xk_, kl_); unpack8(xs_, sg_); \
    _Pragma("unroll") for (int e = 0; e < 8; ++e) { const float kav = e < 4 ? q0_[e & 3] : q1_[e & 3]; fw[e] = e < 4 ? w0_[e & 3] : w1_[e & 3]; fk[e] = kl_[e] * (1.f + (sg_[e] - 1.f) * kav); fb[e] = -fa[e] * sg_[e]; } } while (0)
    if (F.blk < NUNIT_R) RK_LOAD(F.blk);
    for (int u = F.blk; u < NUNIT_R; u += F.G) {
        const int chain = u / 260, c = u - chain * 260, z = chain >> 4, b = (chain >> 3) & 1, h = chain & 7;
        __syncthreads();
#pragma unroll
        for (int e = 0; e < 8; ++e) G[t * 65 + j0 + e] = fw[e];
        __syncthreads();
        if (tid < 64) { float g = 1.f;
#pragma unroll 16
            for (int s = 0; s < 64; ++s) { g *= G[s * 65 + tid]; G[s * 65 + tid] = g; } gl[tid] = g; }
        __syncthreads();
#pragma unroll
        for (int e = 0; e < 8; ++e) { const int j = j0 + e; const float gt = G[t * 65 + j], gp = t > 0 ? G[(t - 1) * 65 + j] : 1.f, gL = G[63 * 65 + j], ig = 1.f / gt;
            fr[e] *= gt; fa[e] *= gp; const float bq = fb[e] * ig, kq = fk[e] * ig; fb[e] = bq; fk[e] = kq; fw[e] = gL; }
        __syncthreads();
        { v4u q; q.x = pk2(fr[0], fr[1]); q.y = pk2(fr[2], fr[3]); q.z = pk2(fr[4], fr[5]); q.w = pk2(fr[6], fr[7]); *(LAS v4u*)(Rt + t * LS + j0) = q;
          q.x = pk2(fa[0], fa[1]); q.y = pk2(fa[2], fa[3]); q.z = pk2(fa[4], fa[5]); q.w = pk2(fa[6], fa[7]); *(LAS v4u*)(At + t * LS + j0) = q;
          q.x = pk2(fb[0], fb[1]); q.y = pk2(fb[2], fb[3]); q.z = pk2(fb[4], fb[5]); q.w = pk2(fb[6], fb[7]); *(LAS v4u*)(Bq + t * LS + j0) = q;
          q.x = pk2(fk[0], fk[1]); q.y = pk2(fk[2], fk[3]); q.z = pk2(fk[4], fk[5]); q.w = pk2(fk[6], fk[7]); *(LAS v4u*)(Kq + t * LS + j0) = q; }
#pragma unroll
        for (int e = 0; e < 8; ++e) { const int j = j0 + e; stb(AtT, j, t, fa[e]); stb(VT, j, t, fv[e]); stb(BhT, j, t, fb[e] * fw[e]); stb(KhT, j, t, fk[e] * fw[e]); }
        __syncthreads();
        if (u + F.G < NUNIT_R) RK_LOAD(u + F.G);
        Acc2 a1, a2, a3, a4;
        zero(a1); mm_acc(a1, At, Bq, w, lane); zero(a2); mm_acc(a2, At, Kq, w, lane); zero(a3); mm_acc(a3, Rt, Bq, w, lane); zero(a4); mm_acc(a4, Rt, Kq, w, lane);
        each(a1, w, lane, [&](int m, int n, float v) { const float x = n < m ? v : 0.f; stb(X, m, n, x); stb(XT, n, m, x); stb(P, m, n, m == n ? 1.f : 0.f); });
        each(a2, w, lane, [&](int m, int n, float v) { stb(AK, m, n, n < m ? v : 0.f); });
        each(a3, w, lane, [&](int m, int n, float v) { stb(RB, m, n, n <= m ? v : 0.f); });
        each(a4, w, lane, [&](int m, int n, float v) { stb(RK, m, n, n <= m ? v : 0.f); });
        __syncthreads();
        { const int m0 = (w >> 1) * 16 + (lane >> 4) * 4, n0 = (w & 1) * 32 + (lane & 15);
          Acc2 pt;
#pragma unroll
          for (int r = 0; r < 4; ++r) { pt.t0[r] = (m0 + r == n0) ? 1.f : 0.f; pt.t1[r] = (m0 + r == n0 + 16) ? 1.f : 0.f; }
#pragma unroll 1
          for (int i = 0; i < NEU_ROUNDS; ++i) {
            mm_acc(pt, P, XT, w, lane);
            if (i < NEU_ROUNDS - 1) { zero(a1); mm_acc(a1, X, XT, w, lane); }
            __syncthreads();
#pragma unroll
            for (int r = 0; r < 4; ++r) { stb(P, m0 + r, n0, pt.t0[r]); stb(P, m0 + r, n0 + 16, pt.t1[r]); }
            if (i < NEU_ROUNDS - 1) { each(a1, w, lane, [&](int m, int n, float v) { stb(X, m, n, v); }); st_tr(XT, a1, w, lane); }
            __syncthreads();
          } }
        zero(a1); mm_acc(a1, AK, VT, w, lane); zero(a2); mm_acc(a2, P, AtT, w, lane);
        st_tr(AkVT, a1, w, lane); st_tr(ApT, a2, w, lane);
        __syncthreads();
        zero(a3); mm_acc(a3, P, AkVT, w, lane);
        st_tr(W2T, a3, w, lane);
        __syncthreads();
        zero(a1); mm_acc(a1, RB, ApT, w, lane); zero(a2); mm_acc(a2, RB, W2T, w, lane); mm_acc(a2, RK, VT, w, lane);
        zero(a3); mm_acc(a3, BhT, ApT, w, lane); zero(a4); mm_acc(a4, BhT, W2T, w, lane); mm_acc(a4, KhT, VT, w, lane);
        __syncthreads();
        { LAS bf16* O1 = At; LAS bf16* O2 = AtT; LAS bf16* O3 = AK; LAS float* OY = (LAS float*)X;
          each(a1, w, lane, [&](int m, int n, float v) { stb(O1, m, n, v + bf2f(Rt[m * LS + n])); });
          each(a3, w, lane, [&](int m, int n, float v) { stb(O2, m, n, v + (m == n ? gl[m] : 0.f)); });
          each(a4, w, lane, [&](int m, int n, float v) { stb(O3, m, n, v); });
          each(a2, w, lane, [&](int m, int n, float v) { OY[m * 68 + n] = v; });
          __syncthreads();
          const int row = tid >> 3, c8 = (tid & 7) * 8;
          *(v4u*)(wsp<bf16>(F, WS_RKQ) + (size_t)u * 4096 + row * 64 + c8) = *(const LAS v4u*)(O1 + row * LS + c8);
          *(v4u*)(wsp<bf16>(F, WS_RKM) + (size_t)u * 4096 + row * 64 + c8) = *(const LAS v4u*)(O2 + row * LS + c8);
          *(v4u*)(wsp<bf16>(F, WS_RKZ) + (size_t)u * 4096 + row * 64 + c8) = *(const LAS v4u*)(O3 + row * LS + c8);
          bf16* Yg = wsp<bf16>(F, WS_YR) + (size_t)z * R * 512 + h * 64;
#pragma unroll
          for (int i = 0; i < 2; ++i) { const int yr = (tid >> 4) + 32 * i, c4 = (tid & 15) * 4; const f32x4 yv = *(const LAS f32x4*)(OY + yr * 68 + c4); v2u yw; yw.x = pk2(yv.x, yv.y); yw.y = pk2(yv.z, yv.w);
              *(v2u*)(Yg + ((size_t)b * TB + scan_tok(z, 64 * c + yr)) * 512 + c4) = yw; } }
    }
#undef RK_LOAD
}
__device__ __forceinline__ void l1_rk_phase_b(const Frame& F) {
    using namespace rk;
    LAS unsigned char* L = F.lds;
    const int w = F.wave, lane = F.lane, tid = F.tid, chain = F.blk, z = chain >> 4, b = (chain >> 3) & 1, h = chain & 7;
    for (int i = tid; i < 2 * 64 * LS; i += 512) ((LAS bf16*)L)[i] = 0;
    const int sr = tid >> 3, sc = (tid & 7) * 8;
    v4u gm, gq, gz;
#define RKB_LOAD(u_) do { gm = *(const v4u*)(wsp<const bf16>(F, WS_RKM) + (u_) * 4096 + sr * 64 + sc); gq = *(const v4u*)(wsp<const bf16>(F, WS_RKQ) + (u_) * 4096 + sr * 64 + sc); \
    gz = *(const v4u*)(wsp<const bf16>(F, WS_RKZ) + (u_) * 4096 + sr * 64 + sc); } while (0)
#define RKB_WRITE(par) do { *(LAS v4u*)((LAS bf16*)(L + (2 + 3 * (par)) * MB) + sr * LS + sc) = gm; *(LAS v4u*)((LAS bf16*)(L + (3 + 3 * (par)) * MB) + sr * LS + sc) = gq; \
    *(LAS v4u*)((LAS bf16*)(L + (4 + 3 * (par)) * MB) + sr * LS + sc) = gz; } while (0)
    RKB_LOAD((size_t)chain * 260); RKB_WRITE(0);
    __syncthreads();
    float* Yg = wsp<float>(F, WS_YB) + (size_t)z * R * 512 + h * 64;
    const int m0 = (w >> 1) * 16 + (lane >> 4) * 4, n0 = (w & 1) * 32 + (lane & 15);
    for (int c = 0; c < 260; ++c) {
        const size_t u = (size_t)chain * 260 + c; const int par = c & 1;
        if (c + 1 < 260) RKB_LOAD(u + 1);
        const LAS bf16* S = (const LAS bf16*)(L + par * MB); LAS bf16* Sn = (LAS bf16*)(L + (par ^ 1) * MB);
        const LAS bf16* Mt = (const LAS bf16*)(L + (2 + 3 * par) * MB); const LAS bf16* Qp = (const LAS bf16*)(L + (3 + 3 * par) * MB); const LAS bf16* Zt = (const LAS bf16*)(L + (4 + 3 * par) * MB);
        Acc2 a1, a2;
#pragma unroll
        for (int r = 0; r < 4; ++r) { a1.t0[r] = bf2f(Zt[(m0 + r) * LS + n0]); a1.t1[r] = bf2f(Zt[(m0 + r) * LS + n0 + 16]); }
        mm_acc(a1, Mt, S, w, lane); zero(a2); mm_acc(a2, Qp, S, w, lane);
        st_tr(Sn, a1, w, lane);
        if (c + 1 < 260) RKB_WRITE(par ^ 1);
#pragma unroll
        for (int r = 0; r < 4; ++r) { const size_t yo = ((size_t)b * TB + scan_tok(z, 64 * c + m0 + r)) * 512 + n0; Yg[yo] = a2.t0[r]; Yg[yo + 16] = a2.t1[r]; }
        __syncthreads();
    }
#undef RKB_LOAD
#undef RKB_WRITE
}
__device__ __forceinline__ void l1_mlstm_a2(const Frame& F) {
    using namespace rk;
    LAS bf16* KT = (LAS bf16*)F.lds; LAS bf16* VsT = KT + 64 * LS;
    LAS float* vec = (LAS float*)(F.lds + AUX_OFF); LAS int* rows = (LAS int*)vec;
    const bf16* Pg = wsp<const bf16>(F, WS_P); const int tid = F.tid, w = F.wave, lane = F.lane;
    for (int u = F.blk; u < NUNIT_M; u += F.G) {
        const int cidx = u / 260, c = u - cidx * 260, z = cidx >> 3, b = (cidx >> 2) & 1, h = cidx & 3;
        mlstm_chunk_head(F, z, b, h, c, vec);
        if (tid < 64) { const float bl = vec[128 + 63]; const float uu = bl - vec[128 + tid] + vec[64 + tid]; float m = uu;
#pragma unroll
            for (int o = 1; o < 64; o <<= 1) m = fmaxf(m, __shfl_xor(m, o));
            vec[256 + tid] = __expf(uu - m);
            if (tid == 0) { wsp<float>(F, WS_SC)[2 * u] = bl; wsp<float>(F, WS_SC)[2 * u + 1] = m; } }
        __syncthreads();
        { const int s = tid >> 3, c8 = tid & 7; float x[8]; unpack8(*(const v4u*)(Pg + (size_t)rows[s] * REC_NP + PC_K + h * 64 + 8 * c8), x);
#pragma unroll
          for (int e = 0; e < 8; ++e) stb(KT, 8 * c8 + e, s, x[e]); }
#pragma unroll
        for (int i = 0; i < 2; ++i) { const int s = (tid >> 4) + 32 * i, c8 = tid & 15; float x[8]; unpack8(*(const v4u*)(Pg + (size_t)rows[s] * REC_NP + PC_V + h * 128 + 8 * c8), x); const float sw = vec[256 + s];
#pragma unroll
            for (int e = 0; e < 8; ++e) stb(VsT, 8 * c8 + e, s, x[e] * sw); }
        __syncthreads();
        Acc2 a0, a1; zero(a0); mm_acc(a0, VsT, KT, w, lane); zero(a1); mm_acc(a1, VsT + 64 * LS, KT, w, lane);
        float* dc = wsp<float>(F, WS_DC) + (size_t)u * 8192;
        each(a0, w, lane, [&](int m, int n, float v) { dc[m * 64 + n] = 0.125f * v; });
        each(a1, w, lane, [&](int m, int n, float v) { dc[(64 + m) * 64 + n] = 0.125f * v; });
        if (tid < 64) { float a = 0.f; for (int s = 0; s < 64; ++s) a += vec[256 + s] * bf2f(KT[tid * LS + s]); wsp<float>(F, WS_DN)[(size_t)u * 64 + tid] = 0.125f * a; }
        __syncthreads();
    }
}
__device__ __forceinline__ void l1_mlstm_c2(const Frame& F, int first_blk, int nblk) {
    using namespace rk;
    LAS bf16* Q = (LAS bf16*)F.lds; LAS bf16* K = Q + 64 * LS; LAS bf16* VT = K + 64 * LS; LAS bf16* Cm = VT + 128 * LS; LAS bf16* Pm = Cm + 128 * LS;
    LAS float* OH = (LAS float*)(F.lds + 7 * MB);
    LAS float* vec = (LAS float*)(F.lds + AUX_OFF); LAS int* rows = (LAS int*)vec;
    const bf16* Pg = wsp<const bf16>(F, WS_P); const int tid = F.tid, w = F.wave, lane = F.lane;
    for (int u = F.blk - first_blk; u < NUNIT_M; u += nblk) {
        const int cidx = u / 260, c = u - cidx * 260, z = cidx >> 3, b = (cidx >> 2) & 1, h = cidx & 3;
        mlstm_chunk_head(F, z, b, h, c, vec);
        const float mst = wsp<const float>(F, WS_MST)[u];
        if (tid < 64) { const int t = tid; float pm = -3.0e38f; for (int s = 0; s <= t; ++s) pm = fmaxf(pm, vec[64 + s] - vec[128 + s]);
            const float gi = vec[128 + t] + mst, mo = fmaxf(gi, vec[128 + t] + pm); vec[320 + t] = __expf(gi - mo); vec[384 + t] = mo;
            vec[256 + t] = wsp<const float>(F, WS_NST)[(size_t)u * 64 + t]; }
        { const int t = tid >> 3, c8 = tid & 7;
          *(LAS v4u*)(Q + t * LS + 8 * c8) = *(const v4u*)(Pg + (size_t)rows[t] * REC_NP + PC_Q + h * 64 + 8 * c8);
          *(LAS v4u*)(K + t * LS + 8 * c8) = *(const v4u*)(Pg + (size_t)rows[t] * REC_NP + PC_K + h * 64 + 8 * c8); }
#pragma unroll
        for (int i = 0; i < 2; ++i) { const int s = (tid >> 4) + 32 * i, c8 = tid & 15; const v4u wv = *(const v4u*)(Pg + (size_t)rows[s] * REC_NP + PC_V + h * 128 + 8 * c8);
            const unsigned ww[4] = {wv.x, wv.y, wv.z, wv.w};
#pragma unroll
            for (int e = 0; e < 4; ++e) { VT[(8 * c8 + 2 * e) * LS + s] = (bf16)(ww[e] & 0xffffu); VT[(8 * c8 + 2 * e + 1) * LS + s] = (bf16)(ww[e] >> 16); } }
        { const int v = tid >> 2, dq = (tid & 3) * 16; const f32x4* src = (const f32x4*)(wsp<const float>(F, WS_CST) + (size_t)u * 8192 + v * 64 + dq);
          const f32x4 x0 = src[0], x1 = src[1], x2 = src[2], x3 = src[3]; v4u o0, o1;
          o0.x = pk2(x0.x, x0.y); o0.y = pk2(x0.z, x0.w); o0.z = pk2(x1.x, x1.y); o0.w = pk2(x1.z, x1.w); o1.x = pk2(x2.x, x2.y); o1.y = pk2(x2.z, x2.w); o1.z = pk2(x3.x, x3.y); o1.w = pk2(x3.z, x3.w);
          *(LAS v4u*)(Cm + v * LS + dq) = o0; *(LAS v4u*)(Cm + v * LS + dq + 8) = o1; }
        __syncthreads();
        Acc2 aq, c0, c1; zero(aq); mm_acc(aq, Q, K, w, lane); zero(c0); mm_acc(c0, Q, Cm, w, lane); zero(c1); mm_acc(c1, Q, Cm + 64 * LS, w, lane);
        each(aq, w, lane, [&](int t, int s, float v) { stb(Pm, t, s, s <= t ? 0.125f * v * __expf(vec[128 + t] + (vec[64 + s] - vec[128 + s]) - vec[384 + t]) : 0.f); });
        __syncthreads();
        Acc2 p0, p1; zero(p0); mm_acc(p0, Pm, VT, w, lane); zero(p1); mm_acc(p1, Pm, VT + 64 * LS, w, lane);
        if (tid < 64) { const int t = tid; float rs = 0.f, nq = 0.f;
            for (int s = 0; s < 64; ++s) { rs += bf2f(Pm[t * LS + s]); nq += vec[256 + s] * bf2f(Q[t * LS + s]); }
            const float den = vec[320 + t] * nq + rs; vec[448 + t] = 1.f / fmaxf(fabsf(den), __expf(-vec[384 + t])); }
        __syncthreads();
        { const int m0 = (w >> 1) * 16 + (lane >> 4) * 4, n0 = (w & 1) * 32 + (lane & 15);
#pragma unroll
          for (int r = 0; r < 4; ++r) { const int t = m0 + r; const float g = vec[320 + t], idn = vec[448 + t];
              OH[t * 132 + n0] = (g * c0.t0[r] + p0.t0[r]) * idn; OH[t * 132 + n0 + 16] = (g * c0.t1[r] + p0.t1[r]) * idn;
              OH[t * 132 + 64 + n0] = (g * c1.t0[r] + p1.t0[r]) * idn; OH[t * 132 + 64 + n0 + 16] = (g * c1.t1[r] + p1.t1[r]) * idn; } }
        __syncthreads();
#pragma unroll
        for (int i = 0; i < 4; ++i) { const int it = tid + 512 * i, t = it >> 5, c4 = (it & 31) * 4;
            const f32x4 hv = *(const LAS f32x4*)(OH + t * 132 + c4); v2u hw; hw.x = pk2(hv.x, hv.y); hw.y = pk2(hv.z, hv.w);
            *(v2u*)(wsp<bf16>(F, WS_HM) + ((size_t)z * R + rows[t]) * 512 + h * 128 + c4) = hw; }
        __syncthreads();
    }
}
#ifndef MK_PER_PHASE
#define MK_PER_PHASE 0
#endif
constexpr int NPHASE = 26;
struct Args { const float* in[N_IN]; float* out; unsigned char* ws; int ph_lo, ph_hi, li, pad; };
#define GEMM_CALL(FnT, SchedT, g, S, fn) do { pg8::EpiGen<FnT> E_{fn}; { int k_ = g.K; asm volatile("" : "+s"(k_)); g.K = k_; } pg8::gemm_phase<pg8::EpiGen<FnT>, SchedT, true, true>((PG8_LAS unsigned char*)F.lds, g, S, E_); } while (0)
#ifndef SITE_MASK
#define SITE_MASK 0xFFFFFFFFull
#endif
#define SITE(s) (((SITE_MASK) >> (s)) & 1ull)
#ifndef DUP_MASK
#define DUP_MASK 0ull
#endif
#define NREP(s) ((((DUP_MASK) >> (s)) & 1ull) ? 2 : 1)
#define IN(k) (lo <= (k) && (k) < hi)
#define SEAM(k) do { if (IN(k) && IN((k) + 1)) xcd_barrier(bar); } while (0)
template <int LAYER> __device__ __forceinline__ void layer_phases(const Frame& F, const XcdBarrier& bar, const int lo, const int hi) {
    constexpr int layer = LAYER; constexpr int pb = 2 + 12 * LAYER;
        if (SITE(2) && IN(pb + 0)) { for (int rep_ = 0; rep_ < NREP(2); ++rep_) {
            const int N = layer == 0 ? ATT_NP : REC_NP;
            pg8::Gemm g{wsp<const bf16>(F, WS_A), layer == 0 ? wsp<const bf16>(F, WS_WIN0) : wsp<const bf16>(F, WS_WREC), R, N, 1024};
            pg8::StaticOrder S; S.init(R, N, F.G, F.blk);
            GEMM_CALL(FnStoreBf16, pg8::StaticOrder, g, S, (FnStoreBf16{wsp<bf16>(F, WS_P), N}));
             if (rep_ + 1 < NREP(2)) xcd_barrier(bar); } SEAM(pb + 0);
        }
        if constexpr (LAYER == 0) {
            if (SITE(3) && IN(pb + 1)) { for (int rep_ = 0; rep_ < NREP(3); ++rep_) { l0_post_proj(F);  if (rep_ + 1 < NREP(3)) xcd_barrier(bar); } SEAM(pb + 1); }
            if (SITE(4) && IN(pb + 2)) { for (int rep_ = 0; rep_ < NREP(4); ++rep_) {
                pg8::Gemm g{wsp<const bf16>(F, WS_CQN), wsp<const bf16>(F, WS_WUQ), R, 768, 384}; pg8::StaticOrder S; S.init(R, 768, F.G, F.blk);
                GEMM_CALL(FnStoreBf16, pg8::StaticOrder, g, S, (FnStoreBf16{wsp<bf16>(F, WS_MQ), 768}));
                 if (rep_ + 1 < NREP(4)) xcd_barrier(bar); } SEAM(pb + 2);
            }
            if (SITE(5) && IN(pb + 3)) { for (int rep_ = 0; rep_ < NREP(5); ++rep_) {
                pg8::Gemm g{wsp<const bf16>(F, WS_CKVN), wsp<const bf16>(F, WS_WUKV), R, 1024, 256}; pg8::StaticOrder S; S.init(R, 1024, F.G, F.blk);
                GEMM_CALL(FnStoreBf16, pg8::StaticOrder, g, S, (FnStoreBf16{wsp<bf16>(F, WS_MKV), 1024}));
                l0_mq_rope(F);
                 if (rep_ + 1 < NREP(5)) xcd_barrier(bar); } SEAM(pb + 3);
            }
            if (SITE(6) && IN(pb + 4)) { for (int rep_ = 0; rep_ < NREP(6); ++rep_) { l0_attention(F);  if (rep_ + 1 < NREP(6)) xcd_barrier(bar); } SEAM(pb + 4); }
            if (SITE(7) && IN(pb + 5)) { for (int rep_ = 0; rep_ < NREP(7); ++rep_) { l0_combine(F);  if (rep_ + 1 < NREP(7)) xcd_barrier(bar); } SEAM(pb + 5); }
        } else {
            if (SITE(8) && IN(pb + 1)) { for (int rep_ = 0; rep_ < NREP(8); ++rep_) { l1_rwkv_prep(F); l1_mlstm_a2(F);  if (rep_ + 1 < NREP(8)) xcd_barrier(bar); } SEAM(pb + 1); }
            if (SITE(9) && IN(pb + 2)) { for (int rep_ = 0; rep_ < NREP(9); ++rep_) {
                pg8::Gemm g{wsp<const bf16>(F, WS_ALORA), wsp<const bf16>(F, WS_WLORA), R, 2560, 384}; pg8::StaticOrder S; S.init(R, 2560, F.G, F.blk);
                { int k_ = g.K; asm volatile("" : "+s"(k_)); g.K = k_; EpiLora E_{&F}; pg8::gemm_phase<EpiLora, pg8::StaticOrder, true, true>((PG8_LAS unsigned char*)F.lds, g, S, E_); }
                l1_mlstm_b(F);
                 if (rep_ + 1 < NREP(9)) xcd_barrier(bar); } SEAM(pb + 2);
            }
            if (SITE(18) && IN(pb + 3)) { for (int rep_ = 0; rep_ < NREP(18); ++rep_) { l1_rk_phase_a(F); if (rep_ + 1 < NREP(18)) xcd_barrier(bar); } SEAM(pb + 3); }
            if (SITE(10) && IN(pb + 4)) { for (int rep_ = 0; rep_ < NREP(10); ++rep_) {
                if (F.G > 32) { if (F.blk < 32) l1_rk_phase_b(F); else { l1_mlstm_c2(F, 32, F.G - 32); moe_weights_convert(F, 1, (F.blk - 32) * 8 + F.wave, (F.G - 32) * 8); } }
                 if (rep_ + 1 < NREP(10)) xcd_barrier(bar); } SEAM(pb + 4);
            }
            if (SITE(11) && IN(pb + 5)) { for (int rep_ = 0; rep_ < NREP(11); ++rep_) { l1_rec_out(F);  if (rep_ + 1 < NREP(11)) xcd_barrier(bar); } SEAM(pb + 5); }
        }
        if (SITE(12) && IN(pb + 6)) { for (int rep_ = 0; rep_ < NREP(12); ++rep_) {
            pg8::Gemm g{wsp<const bf16>(F, WS_A1), wsp<const bf16>(F, WS_WOUT) + (size_t)layer * 1024 * 1024, R, 1024, 1024};
            if constexpr (LAYER == 0) { pg8::StaticOrder S; S.init(R, 1024, F.G, F.blk); GEMM_CALL(FnWout, pg8::StaticOrder, g, S, (FnWout{&F, layer})); }
            else { LatOrder S; S.o.init(R - 2 * CT, 1024, F.G, F.blk); GEMM_CALL(FnWout, LatOrder, g, S, (FnWout{&F, layer})); }
             if (rep_ + 1 < NREP(12)) xcd_barrier(bar); } SEAM(pb + 6);
        }
        if (SITE(13) && IN(pb + 7)) { for (int rep_ = 0; rep_ < NREP(13); ++rep_) { ph_router(F, layer);  if (rep_ + 1 < NREP(13)) xcd_barrier(bar); } SEAM(pb + 7); }
        if (SITE(14) && IN(pb + 8)) { for (int rep_ = 0; rep_ < NREP(14); ++rep_) { ph_gather(F, layer);  if (rep_ + 1 < NREP(14)) xcd_barrier(bar); } SEAM(pb + 8); }
        if (SITE(15) && IN(pb + 9)) { for (int rep_ = 0; rep_ < NREP(15); ++rep_) {
            const int* tab = wsp<const int>(F, WS_TILE);
            pg8::Gemm g{wsp<const bf16>(F, WS_F), wsp<const bf16>(F, WS_W1T), MAXROWS, NE * 2048, 1024}; MoeOrder S{tab + 1, __builtin_amdgcn_readfirstlane(tab[0]), 8, F.G, F.blk, wsp<const int>(F, WS_SRC)};
            { int k_ = g.K; asm volatile("" : "+s"(k_)); g.K = k_; pg8::EpiGen<FnSwiglu> E_{FnSwiglu{wsp<bf16>(F, WS_HS), F.in[I_B1] + (size_t)layer * NE * 2048}};
              pg8::gemm_phase<pg8::EpiGen<FnSwiglu>, MoeOrder, true, true, true>((PG8_LAS unsigned char*)F.lds, g, S, E_); }
             if (rep_ + 1 < NREP(15)) xcd_barrier(bar); } SEAM(pb + 9);
        }
        if (SITE(16) && IN(pb + 10)) { for (int rep_ = 0; rep_ < NREP(16); ++rep_) {
            const int* tab = wsp<const int>(F, WS_TILE);
            pg8::Gemm g{wsp<const bf16>(F, WS_HS), wsp<const bf16>(F, WS_W2T), MAXROWS, NE * 1024, 1024}; MoeOrder S{tab + 1, __builtin_amdgcn_readfirstlane(tab[0]), 4, F.G, F.blk, nullptr};
            GEMM_CALL(FnBiasBf16, MoeOrder, g, S, (FnBiasBf16{wsp<bf16>(F, WS_XS), F.in[I_B2] + (size_t)layer * NE * 1024}));
             if (rep_ + 1 < NREP(16)) xcd_barrier(bar); } SEAM(pb + 10);
        }
        if (SITE(17) && IN(pb + 11)) { for (int rep_ = 0; rep_ < NREP(17); ++rep_) { ph_combine(F, layer);  if (rep_ + 1 < NREP(17)) xcd_barrier(bar); } SEAM(pb + 11); }
}
__global__ void __launch_bounds__(512, 2) fwd(Args args) {
    extern __shared__ __attribute__((aligned(16))) unsigned char lds_[];
    Frame F;
    F.lds = (LAS unsigned char*)lds_; F.tid = threadIdx.x; F.lane = F.tid & 63; F.wave = __builtin_amdgcn_readfirstlane(F.tid >> 6); F.blk = blockIdx.x; F.G = gridDim.x; F.probe = args.pad;
    F.ws = args.ws; F.out = args.out; F.ctl = (gu32*)(args.ws + WS_CTL);
    F.in.t = (LAS const unsigned*)(F.lds + MISC_OFF + 8192);
    if (F.tid < 64) ((LAS unsigned*)(F.lds + MISC_OFF))[F.tid] = 0u;
    if (F.tid < N_IN) { const unsigned long long pv = (unsigned long long)args.in[F.tid]; ((LAS unsigned*)(F.lds + MISC_OFF + 8192))[2 * F.tid] = (unsigned)pv; ((LAS unsigned*)(F.lds + MISC_OFF + 8192))[2 * F.tid + 1] = (unsigned)(pv >> 32); }
    __syncthreads();
    const int lo = args.ph_lo, hi = args.ph_hi;
    XcdBarrier bar; bar.bar = (unsigned*)(F.ctl + CW_BAR) + args.li * XCD_BAR_WORDS; bar.x = 0; bar.st = nullptr;
    if (hi - lo > 1) bar = xcd_barrier_post((unsigned*)(F.ctl + CW_BAR) + args.li * XCD_BAR_WORDS, (volatile LAS unsigned*)(F.lds + MISC_OFF));
    if (SITE(0) && IN(0)) { for (int rep_ = 0; rep_ < NREP(0); ++rep_) { p0a(F);  if (rep_ + 1 < NREP(0)) xcd_barrier(bar); } SEAM(0); }
    if (SITE(1) && IN(1)) { for (int rep_ = 0; rep_ < NREP(1); ++rep_) { p0b(F);  if (rep_ + 1 < NREP(1)) xcd_barrier(bar); } SEAM(1); }
    layer_phases<0>(F, bar, lo, hi);
    layer_phases<1>(F, bar, lo, hi);
}
#undef IN
#undef SEAM


extern "C" void kernel_launch(void* const* d_in, const int* in_sizes, int n_in, void* d_out, int out_size, void* d_ws, size_t ws_size, hipStream_t stream) {
    static int grid = 0;
    if (grid == 0) {
        const bool ok = n_in == N_IN && in_sizes[I_X] == NBATCH * SEQ * DM && in_sizes[I_RECW] == 1024 * REC_IN && in_sizes[I_ATTW] == 1024 * ATT_IN && in_sizes[I_MU] == RWKV_IN &&
                        in_sizes[I_GATEB] == 16 && in_sizes[I_W1] == 2 * NE * 1024 * 2048 && out_size == NBATCH * SEQ * DM && ws_size >= WS_END;
        if (!ok) { fprintf(stderr, "kernel_launch: shape mismatch (n_in %d, recw %d, attw %d, mu %d, out %d, ws %zu need %zu); nothing launched\n", n_in, n_in > I_RECW ? in_sizes[I_RECW] : -1,
                           n_in > I_ATTW ? in_sizes[I_ATTW] : -1, n_in > I_MU ? in_sizes[I_MU] : -1, out_size, ws_size, (size_t)WS_END); grid = -1; return; }
        int dev = 0, cus = 0;
        if (hipGetDevice(&dev) != hipSuccess || hipDeviceGetAttribute(&cus, hipDeviceAttributeMultiprocessorCount, dev) != hipSuccess) { grid = -1; return; }
        if (hipFuncSetAttribute((const void*)fwd, hipFuncAttributeMaxDynamicSharedMemorySize, LDS_BYTES) != hipSuccess) { fprintf(stderr, "kernel_launch: hipFuncSetAttribute failed\n"); grid = -1; return; }
        int per_cu = 0;
        if (hipOccupancyMaxActiveBlocksPerMultiprocessor(&per_cu, (const void*)fwd, 512, LDS_BYTES) != hipSuccess || per_cu < 1) { fprintf(stderr, "kernel_launch: occupancy query says %d blocks per CU\n", per_cu); }
        (void)hipGetLastError();
        grid = cus < 256 ? cus : 256;
        if (grid != 256) fprintf(stderr, "kernel_launch: %d CUs; this kernel is written for a 256-CU device\n", cus);
    }
    if (grid < 0) return;
    if (hipMemsetAsync((char*)d_ws + WS_CTL, 0, CTL_ZERO_BYTES, stream) != hipSuccess) return;
    Args a{};
    for (int i = 0; i < N_IN; ++i) a.in[i] = (const float*)d_in[i];
    a.out = (float*)d_out; a.ws = (unsigned char*)d_ws; a.pad = 0;
#if MK_PER_PHASE
    for (int ph = 0; ph < NPHASE; ++ph) { a.ph_lo = ph; a.ph_hi = ph + 1; a.li = 0; hipLaunchKernelGGL(fwd, dim3(grid), dim3(512), LDS_BYTES, stream, a); }
#elif defined(PROBE_PRE)
    { const int plist[] = {PROBE_PRE}; int cur = 0, li = 0;
      for (int p : plist) { if (p > cur) { a.ph_lo = cur; a.ph_hi = p; a.li = li++; hipLaunchKernelGGL(fwd, dim3(grid), dim3(512), LDS_BYTES, stream, a); }
                            a.ph_lo = p; a.ph_hi = p + 1; a.li = li++; a.pad = 1; hipLaunchKernelGGL(fwd, dim3(grid), dim3(512), LDS_BYTES, stream, a); a.pad = 0; cur = p; }
      a.ph_lo = cur; a.ph_hi = NPHASE; a.li = li++; hipLaunchKernelGGL(fwd, dim3(grid), dim3(512), LDS_BYTES, stream, a); }
#elif defined(PROBE_LIST)
    { const int plist[] = {PROBE_LIST}; int cur = 0, li = 0;
      for (int p : plist) { a.ph_lo = cur; a.ph_hi = p + 1; a.li = li++; hipLaunchKernelGGL(fwd, dim3(grid), dim3(512), LDS_BYTES, stream, a);
                            a.ph_lo = p; a.ph_hi = p + 1; a.li = li++; a.pad = 1; hipLaunchKernelGGL(fwd, dim3(grid), dim3(512), LDS_BYTES, stream, a); a.pad = 0; cur = p + 1; }
      if (cur < NPHASE) { a.ph_lo = cur; a.ph_hi = NPHASE; a.li = li++; hipLaunchKernelGGL(fwd, dim3(grid), dim3(512), LDS_BYTES, stream, a); } }
#else
    a.ph_lo = 0; a.ph_hi = NPHASE; a.li = 0; hipLaunchKernelGGL(fwd, dim3(grid), dim3(512), LDS_BYTES, stream, a);
#endif
    const hipError_t le = hipPeekAtLastError();
    if (le != hipSuccess) fprintf(stderr, "kernel_launch: launch failed: %s\n", hipGetErrorName(le));
}
```

```cpp
#include <hip/hip_runtime.h>
#include <cstdio>
#include <cstdint>
#define MK_PER_PHASE 0
namespace pg8 {
#define PG8_LAS __attribute__((address_space(3)))
typedef unsigned short bf16_t;
typedef short bf16x8 __attribute__((ext_vector_type(8)));
typedef float f32x4 __attribute__((ext_vector_type(4)));
typedef unsigned u32x4 __attribute__((ext_vector_type(4)));
constexpr int BM = 256, BK = 64, HALF = 128, HTB = HALF * BK * 2  , STAGE_BYTES = 8 * HTB, NXCD = 8, WGM = 8;

__host__ __device__ __forceinline__ int lds_byte(int r, int c) { const int st = (r >> 4) * 2 + (c >> 5), rr = r & 15, cc = c & 31, ob = rr * 64 + cc * 2; return st * 1024 + (ob ^ (((ob >> 9) & 1) << 5)); }
__host__ __device__ __forceinline__ void stage_rc(int b, int& R, int& C) { const int st = b / 1024, sb = b % 1024, swz = sb ^ (((sb >> 9) & 1) << 5); R = (st >> 1) * 16 + swz / 64; C = (st & 1) * 32 + (swz % 64) / 2; }
__host__ __device__ __forceinline__ int perm32(int rho) { const int n = rho >> 4, i = rho & 15; return 8 * (i >> 2) + 4 * n + (i & 3); }

struct Unit { int pm, pn; };
struct Gemm { const bf16_t* A; const bf16_t* Bt; int M, N, K; };

struct StaticOrder {
    int nM, nN, nwg, G, c;
    __host__ __device__ void init(int M, int N, int G_, int c_) { nM = M / BM; nN = N / BM; nwg = nM * nN; G = G_; c = c_; }
    __host__ __device__ bool next(int i, Unit& u) const {
        const long L = (long)i * G + c; if (L >= nwg) return false;
        int wgid = (int)L; { const int q = nwg / NXCD, r = nwg % NXCD, xcd = wgid % NXCD, off = wgid / NXCD; wgid = (xcd < r ? xcd * (q + 1) : r * (q + 1) + (xcd - r) * q) + off; }
        const int nig = WGM * nN, gid = wgid / nig, fm = gid * WGM, gsz = (nM - fm) < WGM ? (nM - fm) : WGM;
        u.pm = fm + ((wgid % nig) % gsz); u.pn = (wgid % nig) / gsz; return true;
    }
    __device__ __forceinline__ void a_ready(const Unit&) const {}
    __device__ __forceinline__ void done(const Unit&) const {}
};

__device__ __forceinline__ unsigned cvt_pk_bf16(float lo, float hi) { unsigned r; asm volatile("v_cvt_pk_bf16_f32 %0, %1, %2" : "=v"(r) : "v"(lo), "v"(hi)); return r; }
template <class Fn> struct EpiGen {
    static constexpr bool PERM = true, AFTER_DRAIN = false;
    Fn fn;
    __device__ __forceinline__ void operator()(const f32x4 (&acc)[2][2][4][2], const Unit& u, int wr, int wc, int fr, int fq) const {
#pragma unroll
        for (int ai = 0; ai < 2; ++ai)
#pragma unroll
            for (int m = 0; m < 4; ++m) { const int row = u.pm * BM + ai * HALF + wr * 64 + m * 16 + fr;
#pragma unroll
                for (int bj = 0; bj < 2; ++bj) { const int col = u.pn * BM + bj * HALF + wc * 32 + 8 * fq; fn(row, col, acc[ai][bj][m][0], acc[ai][bj][m][1]); } }
    }
};
template <class Epi, class Sched, bool ALIGN_EPI = false, bool SP2 = false, bool GATHER = false>
__device__ __forceinline__ void gemm_phase(PG8_LAS unsigned char* lds, const Gemm g, const Sched& S, const Epi& E) {
    static_assert(!GATHER || SP2, "the gathered A path is written for the SP2 loop");
    const int tid = threadIdx.x, wid = __builtin_amdgcn_readfirstlane(tid >> 6), lane = tid & 63, wr = wid >> 2, wc = wid & 3, fr = lane & 15, fq = lane >> 4;
    const int K = g.K, nt = K / BK;
    unsigned voffA[2], voffB[2]; int gR[2], gC[2]; unsigned gA[2][2], gN[2][2];
#pragma unroll
    for (int i = 0; i < 2; ++i) { int R, C; stage_rc(tid * 16 + i * 8192, R, C); const int Rb = Epi::PERM ? ((R & ~31) + perm32(R & 31)) : R;
        voffA[i] = (unsigned)(R * K + C) * 2u; voffB[i] = (unsigned)(Rb * K + C) * 2u; gR[i] = R; gC[i] = C; }
    const size_t kstep = (size_t)(BK * 2);
    const size_t hstep = (size_t)HALF * K * 2;
    const size_t tstep = 2 * hstep;
    const unsigned ldsw = (unsigned)wid * 1024u;
    const int aoff = lds_byte(wr * 64 + fr, fq * 8), boff = lds_byte(wc * 32 + fr, fq * 8);
#define PG8_SA(b, h) (((b) * 2 + (h)) * HTB)
#define PG8_SB(b, h) ((4 + (b) * 2 + (h)) * HTB)
#define PG8_STAGE(bufoff, gbase, voff) do { _Pragma("unroll") for (int _i = 0; _i < 2; ++_i) \
        __builtin_amdgcn_global_load_lds((const unsigned*)((const char*)(gbase) + (voff)[_i]), (PG8_LAS unsigned*)(lds + (bufoff) + ldsw + _i * 8192), 16, 0, 0); } while (0)
#define PG8_GOFF(u_, out_) do { _Pragma("unroll") for (int _h = 0; _h < 2; ++_h) _Pragma("unroll") for (int _i = 0; _i < 2; ++_i) \
        out_[_h][_i] = ((unsigned)S.src[(u_).pm * BM + _h * HALF + gR[_i]] * (unsigned)K + (unsigned)gC[_i]) * 2u; } while (0)
#define PG8_STAGE_A(bufoff, kptr, h, isnext) do { if constexpr (GATHER) { unsigned _o[2]; _o[0] = (isnext) ? gN[h][0] : gA[h][0]; _o[1] = (isnext) ? gN[h][1] : gA[h][1]; PG8_STAGE(bufoff, kptr, _o); } \
        else { PG8_STAGE(bufoff, (kptr) + (h) * hstep, voffA); } } while (0)
#define PG8_LDA(dst, b, h) do { _Pragma("unroll") for (int m = 0; m < 4; ++m) _Pragma("unroll") for (int k = 0; k < 2; ++k) dst[m][k] = *(const PG8_LAS bf16x8*)(lds + PG8_SA(b, h) + aoff + m * 2048 + k * 1024); } while (0)
#define PG8_LDB(dst, b, h) do { _Pragma("unroll") for (int n = 0; n < 2; ++n) _Pragma("unroll") for (int k = 0; k < 2; ++k) dst[n][k] = *(const PG8_LAS bf16x8*)(lds + PG8_SB(b, h) + boff + n * 2048 + k * 1024); } while (0)
#define PG8_MMA(ai, bj, At, Bt) do { __builtin_amdgcn_s_setprio(1); _Pragma("unroll") for (int m = 0; m < 4; ++m) _Pragma("unroll") for (int n = 0; n < 2; ++n) _Pragma("unroll") for (int k = 0; k < 2; ++k) \
        acc[ai][bj][m][n] = __builtin_amdgcn_mfma_f32_16x16x32_bf16(Bt[n][k], At[m][k], acc[ai][bj][m][n], 0, 0, 0); __builtin_amdgcn_s_setprio(0); } while (0)
#define PG8_WAIT_V(n) asm volatile("s_waitcnt vmcnt(" #n ")" ::: "memory")
#define PG8_WAIT_L(n) asm volatile("s_waitcnt lgkmcnt(" #n ")" ::: "memory")
#define PG8_BAR __builtin_amdgcn_s_barrier()
#define PG8_SCHED __builtin_amdgcn_sched_barrier(0)
    Unit cur, nxt; int ui = 0;
    if (!S.next(0, cur)) return;
    f32x4 acc[2][2][4][2];
#pragma unroll
    for (int a = 0; a < 2; ++a)
#pragma unroll
        for (int b = 0; b < 2; ++b)
#pragma unroll
            for (int m = 0; m < 4; ++m)
#pragma unroll
                for (int n = 0; n < 2; ++n) acc[a][b][m][n] = (f32x4){0.f, 0.f, 0.f, 0.f};
    bf16x8 At[4][2], B0[2][2], B1[2][2];
    const char* cA = (const char*)g.A + (GATHER ? (size_t)0 : (size_t)cur.pm * tstep); const char* cB = (const char*)g.Bt + (size_t)cur.pn * tstep;
    if constexpr (GATHER) PG8_GOFF(cur, gA);
    S.a_ready(cur);
    if constexpr (SP2) {
        PG8_STAGE(PG8_SB(0, 0), cB, voffB); PG8_STAGE(PG8_SB(0, 1), cB + hstep, voffB); PG8_STAGE_A(PG8_SA(0, 0), cA, 0, false); PG8_STAGE_A(PG8_SA(0, 1), cA, 1, false);
        if (wr == 1) PG8_BAR;
        PG8_WAIT_V(2); PG8_BAR;
        PG8_STAGE(PG8_SB(1, 0), cB + kstep, voffB); PG8_STAGE_A(PG8_SA(1, 0), cA + kstep, 0, false); PG8_STAGE(PG8_SB(1, 1), cB + hstep + kstep, voffB);
        PG8_WAIT_V(6); PG8_BAR;
    } else {
        PG8_STAGE(PG8_SB(0, 0), cB, voffB); PG8_STAGE(PG8_SA(0, 0), cA, voffA); PG8_STAGE(PG8_SB(0, 1), cB + hstep, voffB); PG8_STAGE(PG8_SA(0, 1), cA + hstep, voffA);
        if (wr == 1) PG8_BAR;
        PG8_WAIT_V(4); PG8_BAR;
        PG8_STAGE(PG8_SB(1, 0), cB + kstep, voffB); PG8_STAGE(PG8_SA(1, 0), cA + kstep, voffA); PG8_STAGE(PG8_SB(1, 1), cB + hstep + kstep, voffB);
        PG8_WAIT_V(6); PG8_BAR;
    }
    for (;;) {
        const bool has_next = S.next(ui + 1, nxt);
        const char* nA = (has_next && !GATHER) ? (const char*)g.A + (size_t)nxt.pm * tstep : cA; const char* nB = has_next ? (const char*)g.Bt + (size_t)nxt.pn * tstep : cB;
        if constexpr (GATHER) { if (has_next) PG8_GOFF(nxt, gN); else { _Pragma("unroll") for (int _h = 0; _h < 2; ++_h) { gN[_h][0] = gA[_h][0]; gN[_h][1] = gA[_h][1]; } } }
        for (int t = 0; t < nt; t += 2) {
            const bool last = (t == nt - 2);
            const char* a1 = cA + (size_t)(t + 1) * kstep;
            const char* a2 = last ? nA : cA + (size_t)(t + 2) * kstep; const char* b2 = last ? nB : cB + (size_t)(t + 2) * kstep;
            const char* a3 = a2 + kstep; const char* b3 = b2 + kstep;
            if (last && has_next) S.a_ready(nxt);
            if constexpr (SP2) {
            PG8_LDB(B0, 0, 0); PG8_LDB(B1, 0, 1); PG8_SCHED; PG8_LDA(At, 0, 0); PG8_STAGE_A(PG8_SA(1, 1), a1, 1, false);
            PG8_WAIT_V(8); PG8_WAIT_L(0); PG8_BAR; PG8_MMA(0, 0, At, B0); PG8_MMA(0, 1, At, B1); PG8_BAR; PG8_SCHED;
            PG8_LDA(At, 0, 1); PG8_STAGE(PG8_SB(0, 0), b2, voffB); PG8_STAGE(PG8_SB(0, 1), b2 + hstep, voffB); PG8_STAGE_A(PG8_SA(0, 0), a2, 0, last);
            PG8_WAIT_V(8); PG8_WAIT_L(0); PG8_BAR; PG8_MMA(1, 0, At, B0); PG8_MMA(1, 1, At, B1); PG8_BAR; PG8_SCHED;
            PG8_LDB(B0, 1, 0); PG8_LDB(B1, 1, 1); PG8_SCHED; PG8_LDA(At, 1, 0); PG8_STAGE_A(PG8_SA(0, 1), a2, 1, last);
            PG8_WAIT_V(8); PG8_WAIT_L(0); PG8_BAR; PG8_MMA(0, 0, At, B0); PG8_MMA(0, 1, At, B1); PG8_BAR; PG8_SCHED;
            PG8_LDA(At, 1, 1); PG8_STAGE(PG8_SB(1, 0), b3, voffB); PG8_STAGE(PG8_SB(1, 1), b3 + hstep, voffB); PG8_STAGE_A(PG8_SA(1, 0), a3, 0, last);
            PG8_WAIT_V(8); PG8_WAIT_L(0); PG8_BAR; PG8_MMA(1, 0, At, B0); PG8_MMA(1, 1, At, B1); PG8_BAR; PG8_SCHED;
            } else {
            PG8_LDB(B0, 0, 0); PG8_SCHED; PG8_LDA(At, 0, 0); PG8_STAGE(PG8_SA(1, 1), a1 + hstep, voffA);
            PG8_WAIT_L(8); PG8_BAR; PG8_WAIT_L(0); PG8_MMA(0, 0, At, B0); PG8_BAR; PG8_SCHED;
            PG8_LDB(B1, 0, 1); PG8_STAGE(PG8_SB(0, 0), b2, voffB);
            PG8_BAR; PG8_WAIT_L(0); PG8_MMA(0, 1, At, B1); PG8_BAR;
            PG8_LDA(At, 0, 1); PG8_STAGE(PG8_SA(0, 0), a2, voffA);
            PG8_BAR; PG8_WAIT_L(0); PG8_MMA(1, 0, At, B0); PG8_BAR; PG8_SCHED;
            PG8_STAGE(PG8_SB(0, 1), b2 + hstep, voffB);
            PG8_WAIT_V(6); PG8_BAR; PG8_MMA(1, 1, At, B1); PG8_BAR;
            PG8_LDB(B0, 1, 0); PG8_SCHED; PG8_LDA(At, 1, 0); PG8_STAGE(PG8_SA(0, 1), a2 + hstep, voffA);
            PG8_WAIT_L(8); PG8_BAR; PG8_WAIT_L(0); PG8_MMA(0, 0, At, B0); PG8_BAR; PG8_SCHED;
            PG8_LDB(B1, 1, 1); PG8_STAGE(PG8_SB(1, 0), b3, voffB);
            PG8_BAR; PG8_WAIT_L(0); PG8_MMA(0, 1, At, B1); PG8_BAR;
            PG8_LDA(At, 1, 1); PG8_STAGE(PG8_SA(1, 0), a3, voffA);
            PG8_BAR; PG8_WAIT_L(0); PG8_MMA(1, 0, At, B0); PG8_BAR; PG8_SCHED;
            PG8_STAGE(PG8_SB(1, 1), b3 + hstep, voffB);
            PG8_WAIT_V(6); PG8_BAR; PG8_MMA(1, 1, At, B1); PG8_BAR;
            }
        }
        if constexpr (ALIGN_EPI) { if (wr == 0) PG8_BAR; }
        if constexpr (!Epi::AFTER_DRAIN) { E(acc, cur, wr, wc, fr, fq); S.done(cur); }
        if (!has_next) break;
#pragma unroll
        for (int a = 0; a < 2; ++a)
#pragma unroll
            for (int b = 0; b < 2; ++b)
#pragma unroll
                for (int m = 0; m < 4; ++m)
#pragma unroll
                    for (int n = 0; n < 2; ++n) acc[a][b][m][n] = (f32x4){0.f, 0.f, 0.f, 0.f};
        cur = nxt; cA = nA; cB = nB; ++ui;
        if constexpr (GATHER) { _Pragma("unroll") for (int _h = 0; _h < 2; ++_h) { gA[_h][0] = gN[_h][0]; gA[_h][1] = gN[_h][1]; } }
        if constexpr (ALIGN_EPI) { if (wr == 1) PG8_BAR; }
    }
    PG8_WAIT_V(0);
    if constexpr (!ALIGN_EPI) { if (wr == 0) PG8_BAR; }
    PG8_BAR;
    if constexpr (Epi::AFTER_DRAIN) { E.fused(acc, cur, wr, wc, fr, fq, lds, wid, lane); S.done(cur); }
#undef PG8_SA
#undef PG8_SB
#undef PG8_STAGE
#undef PG8_STAGE_A
#undef PG8_GOFF
#undef PG8_LDA
#undef PG8_LDB
#undef PG8_MMA
#undef PG8_WAIT_V
#undef PG8_WAIT_L
#undef PG8_BAR
#undef PG8_SCHED
}
}
#define GAS __attribute__((address_space(1)))
#define LAS __attribute__((address_space(3)))
typedef unsigned short bf16;
typedef unsigned v4u __attribute__((ext_vector_type(4)));
typedef unsigned v2u __attribute__((ext_vector_type(2)));
typedef float f32x4 __attribute__((ext_vector_type(4)));
typedef short bf16x8 __attribute__((ext_vector_type(8)));
typedef GAS unsigned gu32;
typedef GAS unsigned long long gu64;
#define RLX_AGENT __ATOMIC_RELAXED, __HIP_MEMORY_SCOPE_AGENT
#define LDS_WAIT() asm volatile("s_waitcnt lgkmcnt(0)" ::: "memory")
#define VM_WAIT() asm volatile("s_waitcnt vmcnt(0)" ::: "memory")
typedef float f32x2_cv __attribute__((ext_vector_type(2)));
typedef __bf16 bf16x2_cv __attribute__((ext_vector_type(2)));
__device__ __forceinline__ unsigned pk2(float lo, float hi) { const f32x2_cv v = {lo, hi}; return __builtin_bit_cast(unsigned, __builtin_convertvector(v, bf16x2_cv)); }
__device__ __forceinline__ unsigned f2bf(float f) { return (unsigned)__builtin_bit_cast(unsigned short, (__bf16)f); }
__device__ __forceinline__ float bflo(unsigned w) { return __builtin_bit_cast(float, w << 16); }
__device__ __forceinline__ float bfhi(unsigned w) { return __builtin_bit_cast(float, w & 0xffff0000u); }
__device__ __forceinline__ float bf2f(bf16 b) { return __builtin_bit_cast(float, (unsigned)b << 16); }
__device__ __forceinline__ void unpack8(v4u w, float (&x)[8]) { x[0] = bflo(w.x); x[1] = bfhi(w.x); x[2] = bflo(w.y); x[3] = bfhi(w.y); x[4] = bflo(w.z); x[5] = bfhi(w.z); x[6] = bflo(w.w); x[7] = bfhi(w.w); }
__device__ __forceinline__ float wave_sum(float v) {
#pragma unroll
    for (int o = 1; o < 64; o <<= 1) v += __shfl_xor(v, o);
    return v;
}
__device__ __forceinline__ float sigmoidf_(float x) { return 1.f / (1.f + __expf(-x)); }

#define XB_TMO      128
#define XB_XCNT(j)  (256  + 64 * (j))
#define XB_XSUB(j)  (1280 + 64 * (j))
#define XB_XGEN(j)  (2304 + 64 * (j))
#define XB_TOP      3328
#define XB_TOPGEN   3392
#define XCD_BAR_WORDS 3456
#define XB_SPIN_CAP (1u << 22)

__device__ __forceinline__ unsigned xb_ld(unsigned* p)              { return __hip_atomic_load(p, __ATOMIC_RELAXED, __HIP_MEMORY_SCOPE_AGENT); }
__device__ __forceinline__ unsigned xb_add(unsigned* p, unsigned v) { return __hip_atomic_fetch_add(p, v, __ATOMIC_RELAXED, __HIP_MEMORY_SCOPE_AGENT); }
__device__ __forceinline__ unsigned xb_xcc_id() { return (unsigned)__builtin_amdgcn_s_getreg((3 << 11) | 20) & 0xFu; }
#define XB_SPIN(cond, bar) do { unsigned _sp = 0; while (cond) { __builtin_amdgcn_s_sleep(1); \
    if ((++_sp & 255u) == 0u) { if (xb_ld(&(bar)[XB_TMO])) break; if (_sp > XB_SPIN_CAP) { atomicAdd(&(bar)[XB_TMO], 1u); break; } } } } while (0)

struct XcdBarrier {
    unsigned* bar; unsigned x;
    volatile LAS unsigned* st;
};

__device__ __forceinline__ XcdBarrier xcd_barrier_post(unsigned* bar, volatile LAS unsigned* st) {
    XcdBarrier b; b.bar = bar; b.x = xb_xcc_id(); b.st = st;
    if (threadIdx.x == 0) (void)xb_add(&bar[XB_XCNT(b.x)], 1u);
    return b;
}
__device__ __forceinline__ void xcd_barrier_complete(unsigned* bar, unsigned x, unsigned& nloc, unsigned& nx) {
    const unsigned G = gridDim.x * gridDim.y * gridDim.z;
    unsigned sum, cnt, mine, sp = 0u;
    for (;;) {
        sum = 0u; cnt = 0u; mine = 0u;
#pragma unroll
        for (unsigned j = 0; j < 16; ++j) { const unsigned c = xb_ld(&bar[XB_XCNT(j)]); sum += c; cnt += (c > 0u) ? 1u : 0u; mine = (j == x) ? c : mine; }
        if (sum == G) break;
        __builtin_amdgcn_s_sleep(1);
        if ((++sp & 255u) == 0u) { if (xb_ld(&bar[XB_TMO])) break; if (sp > XB_SPIN_CAP) { atomicAdd(&bar[XB_TMO], 1u); break; } }
    }
    nloc = mine > 0u ? mine : 1u; nx = cnt > 0u ? cnt : 1u;
}

__device__ __forceinline__ void xcd_barrier(const XcdBarrier& b) {
    asm volatile("s_waitcnt vmcnt(0)" ::: "memory");
    __syncthreads();
    if (threadIdx.x == 0) {
        unsigned* bar = b.bar;
        __builtin_amdgcn_s_waitcnt(0);
        unsigned nloc = b.st[0], nx = b.st[1];
        if (nloc == 0u) { xcd_barrier_complete(bar, b.x, nloc, nx); b.st[0] = nloc; b.st[1] = nx; }
        const unsigned old = xb_add(&bar[XB_XSUB(b.x)], 1u);
        const unsigned gen = old / nloc;
        if (old + 1u == (gen + 1u) * nloc) {
            __builtin_amdgcn_fence(__ATOMIC_RELEASE, "agent");
            asm volatile("s_waitcnt vmcnt(0)" ::: "memory");
            const unsigned og = xb_add(&bar[XB_TOP], 1u);
            const unsigned tg = og / nx;
            if (og + 1u == (tg + 1u) * nx) xb_add(&bar[XB_TOPGEN], 1u);
            else XB_SPIN(xb_ld(&bar[XB_TOPGEN]) == tg, bar);
            __builtin_amdgcn_fence(__ATOMIC_ACQUIRE, "agent");
            xb_add(&bar[XB_XGEN(b.x)], 1u);
            asm volatile("s_waitcnt vmcnt(0)" ::: "memory");
        } else {
            XB_SPIN(xb_ld(&bar[XB_XGEN(b.x)]) == gen, bar);
            __builtin_amdgcn_fence(__ATOMIC_ACQUIRE, "agent");
            asm volatile("s_waitcnt vmcnt(0)" ::: "memory");
        }
    }
    __syncthreads();
}
#ifndef ATT_REL_ALL
#define ATT_REL_ALL 1
#endif
namespace att {
using s16x4  = __attribute__((ext_vector_type(4))) short;
using f32x16 = __attribute__((ext_vector_type(16))) float;
using u32x4  = __attribute__((ext_vector_type(4))) unsigned;
using f32x4  = __attribute__((ext_vector_type(4))) float;
#define ATT_SBAR() __builtin_amdgcn_sched_barrier(0)
constexpr float THR2 = 11.5f;
__device__ __forceinline__ int crow(int r, int hi) { return (r & 3) + 8 * (r >> 2) + 4 * hi; }
__device__ __forceinline__ unsigned cvtpk(float lo, float hi) { unsigned r; asm volatile("v_cvt_pk_bf16_f32 %0, %1, %2" : "=v"(r) : "v"(lo), "v"(hi)); return r; }

__device__ __forceinline__ void partialSM(f32x16& p0, f32x16& p1, float& m_reg, float& mn, float& alpha) {
  float pmax = p0[0];
#pragma unroll
  for (int r = 1; r < 16; ++r) pmax = fmaxf(pmax, p0[r]);
#pragma unroll
  for (int r = 0; r < 16; ++r) pmax = fmaxf(pmax, p1[r]);
  { auto rr = __builtin_amdgcn_permlane32_swap(__float_as_uint(pmax), __float_as_uint(pmax), false, false);
    pmax = fmaxf(__uint_as_float(rr[0]), __uint_as_float(rr[1])); }
  if (__builtin_expect(__all(pmax - m_reg <= THR2), 1)) { mn = m_reg; alpha = 1.f; }
  else { mn = fmaxf(m_reg, pmax); alpha = __builtin_amdgcn_exp2f(m_reg - mn); m_reg = mn; }
#pragma unroll
  for (int r = 0; r < 16; ++r) p0[r] = p0[r] - mn;
#pragma unroll
  for (int r = 0; r < 16; ++r) p1[r] = p1[r] - mn;
#pragma unroll
  for (int r = 0; r < 16; ++r) p0[r] = __builtin_amdgcn_exp2f(p0[r]);
}
__device__ __forceinline__ void finishSM_exp(f32x16& p1) {
#pragma unroll
  for (int r = 0; r < 16; ++r) p1[r] = __builtin_amdgcn_exp2f(p1[r]);
}
__device__ __forceinline__ void finishSM_pack(f32x16& p0, f32x16& p1, bf16x8& pa0, bf16x8& pa1, bf16x8& pa2, bf16x8& pa3) {
#define ATT_PK4(P, BASE, OUT) do { u32x4 w = {cvtpk(P[BASE + 0], P[BASE + 1]), cvtpk(P[BASE + 2], P[BASE + 3]), cvtpk(P[BASE + 4], P[BASE + 5]), cvtpk(P[BASE + 6], P[BASE + 7])}; \
    OUT = *reinterpret_cast<bf16x8*>(&w); } while (0)
  ATT_PK4(p0, 0, pa0); ATT_PK4(p0, 8, pa1); ATT_PK4(p1, 0, pa2); ATT_PK4(p1, 8, pa3);
#undef ATT_PK4
}
__device__ __forceinline__ void finishSM(f32x16& p0, f32x16& p1, bf16x8& pa0, bf16x8& pa1, bf16x8& pa2, bf16x8& pa3) { finishSM_exp(p1); finishSM_pack(p0, p1, pa0, pa1, pa2, pa3); }
template <int NB> __device__ __forceinline__ int v_st(int k, int c) { const int kk = (k & ~0xC) | ((k & 4) << 1) | ((k & 8) >> 1); return ((kk >> 3) * NB + (c >> 5)) * 512 + ((kk & 7) * 32 + (c & 31)) * 2; }
__device__ __forceinline__ int v_rd_base(int lane) { return ((lane & 3) << 3) | (((lane >> 2) & 3) << 6) | (((lane >> 4) & 1) << 5) | (((lane >> 5) & 1) << 8); }
template <int OFF> __device__ __forceinline__ s16x4 tr_read(int vb) {
  s16x4 r; asm volatile("ds_read_b64_tr_b16 %0, %1 offset:%2" : "=&v"(r) : "v"(vb), "i"(OFF) : "memory"); return r;
}
template <int NB, int D0, int VO> __device__ __forceinline__ void pv_rd(s16x4 (&f)[8], int vb) {
#define ATT_VOFF(ks, half) (VO + D0 * 512 + (ks) * (NB * 1024) + (half) * (NB * 512))
  f[0] = tr_read<ATT_VOFF(0, 0)>(vb); f[1] = tr_read<ATT_VOFF(0, 1)>(vb); f[2] = tr_read<ATT_VOFF(1, 0)>(vb); f[3] = tr_read<ATT_VOFF(1, 1)>(vb);
  f[4] = tr_read<ATT_VOFF(2, 0)>(vb); f[5] = tr_read<ATT_VOFF(2, 1)>(vb); f[6] = tr_read<ATT_VOFF(3, 0)>(vb); f[7] = tr_read<ATT_VOFF(3, 1)>(vb);
#undef ATT_VOFF
}
__device__ __forceinline__ void pv_mm(f32x16& od, const s16x4 (&f)[8], bf16x8 pa0, bf16x8 pa1, bf16x8 pa2, bf16x8 pa3) {
#define ATT_PK(L, H) (bf16x8){L[0], L[1], L[2], L[3], H[0], H[1], H[2], H[3]}
  od = __builtin_amdgcn_mfma_f32_32x32x16_bf16(pa0, ATT_PK(f[0], f[1]), od, 0, 0, 0);
  od = __builtin_amdgcn_mfma_f32_32x32x16_bf16(pa1, ATT_PK(f[2], f[3]), od, 0, 0, 0);
  od = __builtin_amdgcn_mfma_f32_32x32x16_bf16(pa2, ATT_PK(f[4], f[5]), od, 0, 0, 0);
  od = __builtin_amdgcn_mfma_f32_32x32x16_bf16(pa3, ATT_PK(f[6], f[7]), od, 0, 0, 0);
#undef ATT_PK
}
template <int NB, int D0, int HALF, int VO> __device__ __forceinline__ void pv_rdh(s16x4 (&g)[4], int vb) {
#define ATT_VOFF(ks, half) (VO + D0 * 512 + (ks) * (NB * 1024) + (half) * (NB * 512))
  g[0] = tr_read<ATT_VOFF(2 * HALF, 0)>(vb); g[1] = tr_read<ATT_VOFF(2 * HALF, 1)>(vb); g[2] = tr_read<ATT_VOFF(2 * HALF + 1, 0)>(vb); g[3] = tr_read<ATT_VOFF(2 * HALF + 1, 1)>(vb);
#undef ATT_VOFF
}
__device__ __forceinline__ void pv_mmh(f32x16& od, const s16x4 (&g)[4], bf16x8 px, bf16x8 py) {
#define ATT_PK(L, H) (bf16x8){L[0], L[1], L[2], L[3], H[0], H[1], H[2], H[3]}
  od = __builtin_amdgcn_mfma_f32_32x32x16_bf16(px, ATT_PK(g[0], g[1]), od, 0, 0, 0);
  od = __builtin_amdgcn_mfma_f32_32x32x16_bf16(py, ATT_PK(g[2], g[3]), od, 0, 0, 0);
#undef ATT_PK
}
#define ATT_LWAIT(n) do { asm volatile("s_waitcnt lgkmcnt(" #n ")" ::: "memory"); ATT_SBAR(); } while (0)
template <int NB, int VO, bool SM, bool REL> __device__ __forceinline__ void pv_sm(f32x16* o, f32x4& lsum, bf16x8 sel, int vb, bf16x8 pa0, bf16x8 pa1, bf16x8 pa2, bf16x8 pa3,
                                                                         f32x16& n0, f32x16& n1, float& m_reg, float& mn, float& alpha, f32x16& negm) {
  float pmax = 0.f;
#define ATT_LSUM() do { lsum = __builtin_amdgcn_mfma_f32_16x16x32_bf16(sel, pa0, lsum, 0, 0, 0); lsum = __builtin_amdgcn_mfma_f32_16x16x32_bf16(sel, pa1, lsum, 0, 0, 0); \
    lsum = __builtin_amdgcn_mfma_f32_16x16x32_bf16(sel, pa2, lsum, 0, 0, 0); lsum = __builtin_amdgcn_mfma_f32_16x16x32_bf16(sel, pa3, lsum, 0, 0, 0); } while (0)
#define ATT_PMAX() do { if constexpr (SM) { pmax = n0[0]; \
    _Pragma("unroll") for (int r = 1; r < 16; ++r) pmax = fmaxf(pmax, n0[r]); \
    _Pragma("unroll") for (int r = 0; r < 16; ++r) pmax = fmaxf(pmax, n1[r]); \
    auto rr = __builtin_amdgcn_permlane32_swap(__float_as_uint(pmax), __float_as_uint(pmax), false, false); \
    pmax = fmaxf(__uint_as_float(rr[0]), __uint_as_float(rr[1])); } } while (0)
#define ATT_THR() do { if constexpr (SM && !REL) { \
      if (__builtin_expect(__all(pmax - m_reg <= THR2), 1)) { mn = m_reg; alpha = 1.f; } \
      else { mn = fmaxf(m_reg, pmax); alpha = __builtin_amdgcn_exp2f(m_reg - mn); m_reg = mn; } } \
    if constexpr (SM && REL) { \
      if (__builtin_expect(__all(pmax <= THR2), 1)) { alpha = 1.f; } \
      else { const float d = fmaxf(pmax, 0.f); alpha = __builtin_amdgcn_exp2f(-d); \
        _Pragma("unroll") for (int r = 0; r < 16; ++r) { n0[r] -= d; n1[r] -= d; negm[r] -= d; } } } } while (0)
  if constexpr (NB == 4) {
    s16x4 b0[4], b1[4], b2[4];
    pv_rdh<NB, 0, 0, VO>(b0, vb); pv_rdh<NB, 0, 1, VO>(b1, vb); pv_rdh<NB, 1, 0, VO>(b2, vb);
    ATT_LSUM(); ATT_PMAX();
    ATT_LWAIT(8); pv_mmh(o[0], b0, pa0, pa1); pv_rdh<NB, 1, 1, VO>(b0, vb);
    ATT_THR();
    if constexpr (SM && !REL) {
#pragma unroll
      for (int r = 0; r < 16; ++r) n0[r] = n0[r] - mn; }
    ATT_LWAIT(8); pv_mmh(o[0], b1, pa2, pa3); pv_rdh<NB, 2, 0, VO>(b1, vb);
    if constexpr (SM && !REL) {
#pragma unroll
      for (int r = 0; r < 16; ++r) n1[r] = n1[r] - mn; }
    ATT_LWAIT(8); pv_mmh(o[1], b2, pa0, pa1); pv_rdh<NB, 2, 1, VO>(b2, vb);
    ATT_LWAIT(8); pv_mmh(o[1], b0, pa2, pa3); pv_rdh<NB, 3, 0, VO>(b0, vb);
    if constexpr (SM) {
#pragma unroll
      for (int r = 0; r < 4; ++r) n0[r] = __builtin_amdgcn_exp2f(n0[r]); }
    ATT_LWAIT(8); pv_mmh(o[2], b1, pa0, pa1); pv_rdh<NB, 3, 1, VO>(b1, vb);
    if constexpr (SM) {
#pragma unroll
      for (int r = 4; r < 8; ++r) n0[r] = __builtin_amdgcn_exp2f(n0[r]); }
    ATT_LWAIT(8); pv_mmh(o[2], b2, pa2, pa3);
    if constexpr (SM) {
#pragma unroll
      for (int r = 8; r < 12; ++r) n0[r] = __builtin_amdgcn_exp2f(n0[r]); }
    ATT_LWAIT(4); pv_mmh(o[3], b0, pa0, pa1);
    if constexpr (SM) {
#pragma unroll
      for (int r = 12; r < 16; ++r) n0[r] = __builtin_amdgcn_exp2f(n0[r]); }
    ATT_LWAIT(0); pv_mmh(o[3], b1, pa2, pa3);
  } else {
    s16x4 fa[8], fb[8];
    pv_rd<NB, 0, VO>(fa, vb); pv_rd<NB, 1, VO>(fb, vb);
    ATT_LSUM(); ATT_PMAX();
    ATT_LWAIT(8); pv_mm(o[0], fa, pa0, pa1, pa2, pa3);
    ATT_THR();
    if constexpr (SM && !REL) {
#pragma unroll
      for (int r = 0; r < 16; ++r) { n0[r] = n0[r] - mn; n1[r] = n1[r] - mn; } }
    ATT_LWAIT(0); pv_mm(o[1], fb, pa0, pa1, pa2, pa3);
    if constexpr (SM) {
#pragma unroll
      for (int r = 0; r < 16; ++r) n0[r] = __builtin_amdgcn_exp2f(n0[r]); }
  }
#undef ATT_LSUM
#undef ATT_PMAX
#undef ATT_THR
}
template <int DK, bool REL, int LO, int HI> __device__ __forceinline__ void qkt_part(f32x16& p0, f32x16& p1, LAS const char* Kt, const int (&ka)[DK / 16], const bf16x8* qr, const f32x16& negm) {
  if constexpr (!REL && LO == 0) { p0 = f32x16{}; p1 = f32x16{}; }
#pragma unroll
  for (int d0 = LO; d0 < HI; ++d0) {
    const bf16x8 b0 = *(LAS const bf16x8*)(Kt + ka[d0]);
    const bf16x8 b1 = *(LAS const bf16x8*)(Kt + ka[d0] + (d0 < 4 ? 4096 : 2048));
    p0 = __builtin_amdgcn_mfma_f32_32x32x16_bf16(b0, qr[d0], (REL && d0 == 0) ? negm : p0, 0, 0, 0);
    p1 = __builtin_amdgcn_mfma_f32_32x32x16_bf16(b1, qr[d0], (REL && d0 == 0) ? negm : p1, 0, 0, 0); }
}
template <int DK, bool REL> __device__ __forceinline__ void qkt(f32x16& p0, f32x16& p1, LAS const char* Kt, const int (&ka)[DK / 16], const bf16x8* qr, const f32x16& negm) {
  qkt_part<DK, REL, 0, DK / 16>(p0, p1, Kt, ka, qr, negm);
}
template <int DK, int DV> struct Cfg {
  static constexpr int KT = 64 * DK * 2, NB = DV / 32, VT = 64 * DV * 2, NQ = DK / 16;
  static constexpr int KN = DK / 64 + (DK % 64 != 0), VN = (64 * DV / 8) / 512;
  static constexpr int NS = 4;
  static constexpr int OFF_K = 0, OFF_V = NS * KT, OFF_WS = NS * (KT + VT), LDS_BYTES = OFF_WS + 8 * 64 * 4;
};
template <int DK, int DV>
__device__ __forceinline__ void attn_unit(const bf16* __restrict__ Qb, int ldq, const bf16* __restrict__ K1, int ldk1, const bf16* __restrict__ K2, int ldk2,
                                          const bf16* __restrict__ Vh, int ldv, float* __restrict__ Ob, int ldo, int nkeys, LAS char* lds) {
  using C = Cfg<DK, DV>;
  const int tid = threadIdx.x, wid = __builtin_amdgcn_readfirstlane(tid >> 6), lane = tid & 63, r32 = lane & 31, hi = lane >> 5;
  LAS float* ws = (LAS float*)(lds + C::OFF_WS) + wid * 64; LAS float* al_l = ws + 32;
  constexpr bool REL = ATT_REL_ALL || (DV == 64);
  float m_reg = -1e30f; f32x16 negm = {}; f32x16 o[C::NB] = {}; f32x4 lsum = {}; bf16x8 qr[C::NQ];
  bf16x8 sel; { const int i_ = lane & 15, kq_ = lane >> 4; const unsigned v_ = ((i_ == 0 && !(kq_ & 1)) || (i_ == 1 && (kq_ & 1))) ? 0x3F803F80u : 0u; u32x4 w_ = {v_, v_, v_, v_}; sel = *reinterpret_cast<bf16x8*>(&w_); }
  { const bf16* Qw = Qb + (long)(wid * 32 + r32) * ldq + hi * 8;
#pragma unroll
    for (int d0 = 0; d0 < C::NQ; ++d0) qr[d0] = *(const bf16x8*)(Qw + d0 * 16); }
  unsigned kg0, kg1 = 0, vg[C::VN];
  { const int row = tid >> 3, cp = tid & 7; kg0 = (unsigned)(row * ldk1 + ((cp ^ ((row >> 1) & 7)) * 8)); }
  if constexpr (C::KN == 2) { const int p = tid & 255, row = p >> 2, cp = p & 3; kg1 = (unsigned)(row * ldk2 + ((cp ^ ((row >> 2) & 3)) * 8)); }
#pragma unroll
  for (int i = 0; i < C::VN; ++i) { const int p = i * 512 + tid, st = p >> 5, wi = p & 31, kk = (st / C::NB) * 8 + (wi >> 2), col = (st % C::NB) * 32 + (wi & 3) * 8;
    vg[i] = (unsigned)(kk * ldv + col); }
  int ka[C::NQ];
#pragma unroll
  for (int d0 = 0; d0 < C::NQ; ++d0) ka[d0] = (d0 < 4) ? r32 * 128 + ((((d0 * 2) ^ hi ^ ((r32 >> 1) & 7)) & 7) << 4) : 8192 + r32 * 64 + (((((d0 - 4) * 2) ^ hi ^ ((r32 >> 2) & 3)) & 3) << 4);
  const int vb0 = (int)(uintptr_t)(lds + C::OFF_V) + v_rd_base(lane);
  const bool p3 = (C::KN == 1) || wid < 4;
#define ATT_ISSUE(S, t) do { const size_t t64_ = (size_t)(t) * 64; \
    __builtin_amdgcn_global_load_lds((const unsigned*)(K1 + t64_ * ldk1 + kg0), (LAS unsigned*)(lds + C::OFF_K + (S) * C::KT + wid * 1024), 16, 0, 0); \
    if constexpr (C::KN == 2) { if (wid < 4) __builtin_amdgcn_global_load_lds((const unsigned*)(K2 + t64_ * ldk2 + kg1), (LAS unsigned*)(lds + C::OFF_K + (S) * C::KT + 8192 + wid * 1024), 16, 0, 0); } \
    _Pragma("unroll") for (int i_ = 0; i_ < C::VN; ++i_) __builtin_amdgcn_global_load_lds((const unsigned*)(Vh + t64_ * ldv + vg[i_]), (LAS unsigned*)(lds + C::OFF_V + (S) * C::VT + (i_ * 512 + wid * 64) * 16), 16, 0, 0); } while (0)
#define ATT_LAND1() do { if (p3) asm volatile("s_waitcnt vmcnt(3)" ::: "memory"); else asm volatile("s_waitcnt vmcnt(2)" ::: "memory"); } while (0)
#define ATT_LAND2() do { if (p3) asm volatile("s_waitcnt vmcnt(6)" ::: "memory"); else asm volatile("s_waitcnt vmcnt(4)" ::: "memory"); } while (0)
#define ATT_RESC(a) do { if (__any((a) < 1.f)) { if (hi == 0) al_l[r32] = (a); asm volatile("s_waitcnt lgkmcnt(0)" ::: "memory"); \
    lsum[0] *= al_l[lane & 15]; lsum[1] *= al_l[16 + (lane & 15)]; \
    _Pragma("unroll") for (int r = 0; r < 16; ++r) { const float f_ = al_l[crow(r, hi)]; _Pragma("unroll") for (int d = 0; d < C::NB; ++d) o[d][r] *= f_; } } } while (0)
  static_assert(C::KN + C::VN == 3 && C::NS == 4, "three (two on waves 4..7 when DK = 96) DMA pieces per thread per tile; slot = tile & 3");
#define ATT_STEP(S, t, C0, C1, N0, N1, mnN, alN, LAST) do { ATT_SBAR(); \
    { const int ti_ = ((t) + 3 < NT) ? (t) + 3 : NT - 1; ATT_ISSUE(((S) + 3) & 3, ti_); } ATT_SBAR(); \
    if constexpr (!(LAST)) qkt_part<DK, REL, 0, C::NQ / 2>(N0, N1, lds + C::OFF_K + (((S) + 1) & 3) * C::KT, ka, qr, negm); \
    finishSM_exp(C1); ATT_SBAR(); \
    if constexpr (!(LAST)) qkt_part<DK, REL, C::NQ / 2, C::NQ>(N0, N1, lds + C::OFF_K + (((S) + 1) & 3) * C::KT, ka, qr, negm); \
    finishSM_pack(C0, C1, pa0, pa1, pa2, pa3); ATT_SBAR(); \
    pv_sm<C::NB, (S) * C::VT, !(LAST), REL>(o, lsum, sel, vb0, pa0, pa1, pa2, pa3, N0, N1, m_reg, mnN, alN, negm); ATT_SBAR(); \
    if constexpr (!(LAST)) { ATT_RESC(alN); } \
    ATT_LAND1(); __builtin_amdgcn_s_barrier(); } while (0)
  f32x16 pA0, pA1, pB0, pB1; float mnA, mnB, alA, alB; bf16x8 pa0, pa1, pa2, pa3; const int NT = nkeys / 64;
  asm volatile("s_waitcnt vmcnt(0) lgkmcnt(0)" ::: "memory"); __builtin_amdgcn_s_barrier();
  ATT_ISSUE(0, 0); ATT_ISSUE(1, 1); ATT_ISSUE(2, 2);
  ATT_LAND2(); __builtin_amdgcn_s_barrier();
  qkt<DK, REL>(pA0, pA1, lds + C::OFF_K, ka, qr, negm);
  partialSM(pA0, pA1, m_reg, mnA, alA);
  if constexpr (REL) {
#pragma unroll
    for (int r = 0; r < 16; ++r) negm[r] = -m_reg; }
  ATT_LAND1(); __builtin_amdgcn_s_barrier();
  int t = 0;
  for (; t + 4 < NT; t += 4) {
    ATT_STEP(0, t,     pA0, pA1, pB0, pB1, mnB, alB, false);
    ATT_STEP(1, t + 1, pB0, pB1, pA0, pA1, mnA, alA, false);
    ATT_STEP(2, t + 2, pA0, pA1, pB0, pB1, mnB, alB, false);
    ATT_STEP(3, t + 3, pB0, pB1, pA0, pA1, mnA, alA, false);
  }
  ATT_STEP(0, t,     pA0, pA1, pB0, pB1, mnB, alB, false);
  ATT_STEP(1, t + 1, pB0, pB1, pA0, pA1, mnA, alA, false);
  ATT_STEP(2, t + 2, pA0, pA1, pB0, pB1, mnB, alB, false);
  ATT_STEP(3, t + 3, pB0, pB1, pA0, pA1, mnA, alA, true);
  asm volatile("s_waitcnt vmcnt(0)" ::: "memory");
  float rli[16];
  if (lane < 16) { al_l[lane] = lsum[0]; al_l[16 + lane] = lsum[1]; }
  asm volatile("s_waitcnt lgkmcnt(0)" ::: "memory");
#pragma unroll
  for (int r = 0; r < 16; ++r) rli[r] = __builtin_amdgcn_rcpf(al_l[crow(r, hi)]);
  float* Ow = Ob + (long)(wid * 32) * ldo;
#pragma unroll
  for (int r = 0; r < 16; ++r) { const int orow = crow(r, hi);
#pragma unroll
    for (int d0 = 0; d0 < C::NB; ++d0) Ow[(long)orow * ldo + d0 * 32 + r32] = o[d0][r] * rli[r]; }
#undef ATT_ISSUE
#undef ATT_LAND1
#undef ATT_LAND2
#undef ATT_RESC
#undef ATT_STEP
}
}
constexpr int DM = 1024, NBATCH = 2, SEQ = 16384, CT = 256, TB = SEQ + CT  , R = NBATCH * TB  ;
constexpr int ATT_IN = 2208, ATT_NP = 2304, REC_IN = 3472, REC_NP = 3584, RWKV_IN = 1920;
constexpr int NE = 32, TOPK = 4, MAXT = R * TOPK / 256 + NE  , MAXROWS = MAXT * 256;
constexpr int NUNIT_M = 16 * 260;
constexpr float NORM_EPS = 1e-6f;
enum { I_X = 0, I_C, I_CTX, I_CCTX, I_NMIX, I_NFFN, I_ADAW, I_ADAB, I_WOUT, I_RW, I_RB, I_W1, I_B1, I_W2, I_B2, I_ATTW, I_LAM, I_SUBLN, I_QNW, I_KVNW, I_WUQ, I_WUKV,
       I_RECW, I_MU, I_W0, I_RW2, I_A0, I_A2, I_G2, I_KK, I_KA, I_RK, I_LNW, I_LNB, I_GATEB, I_MNW, I_FNW, N_IN };
constexpr size_t al256(size_t x) { return (x + 255) & ~(size_t)255; }
constexpr size_t WS_CTL = 0, CTL_ZERO_BYTES = 1u << 20;
constexpr size_t WS_MOD = CTL_ZERO_BYTES;
constexpr size_t WS_ROPE = al256(WS_MOD + 2 * 3 * 6144 * 4);
constexpr size_t ROPE_DR = 0, ROPE_DC = 256 * 16 * 2, ROPE_MR = ROPE_DC + 64 * 16 * 2, ROPE_MC = ROPE_MR + 256 * 8 * 2, ROPE_FLOATS = ROPE_MC + 64 * 8 * 2;
constexpr size_t WS_WRH = al256(WS_ROPE + ROPE_FLOATS * 4);
constexpr size_t WS_WRL = al256(WS_WRH + (size_t)2 * 32 * 1024 * 2);
constexpr size_t WS_WIN0 = al256(WS_WRL + (size_t)2 * 32 * 1024 * 2);
constexpr size_t WS_WUQ = al256(WS_WIN0 + (size_t)ATT_NP * 1024 * 2);
constexpr size_t WS_WUKV = al256(WS_WUQ + (size_t)768 * 384 * 2);
constexpr size_t WS_WOUT = al256(WS_WUKV + (size_t)1024 * 256 * 2);
constexpr size_t WS_WREC = al256(WS_WOUT + (size_t)2 * 1024 * 1024 * 2);
constexpr size_t WS_WLORA = al256(WS_WREC + (size_t)REC_NP * 1024 * 2);
constexpr size_t WS_W1T = al256(WS_WLORA + (size_t)2560 * 384 * 2);
constexpr size_t WS_W2T = al256(WS_W1T + (size_t)NE * 2048 * 1024 * 2);
constexpr size_t WS_H = al256(WS_W2T + (size_t)NE * 1024 * 1024 * 2);
constexpr size_t WS_A = al256(WS_H + (size_t)R * 1024 * 4);
constexpr size_t WS_A1 = al256(WS_A + (size_t)R * 1024 * 2);
constexpr size_t WS_F = al256(WS_A1 + (size_t)R * 1024 * 2);
constexpr size_t WS_P = al256(WS_F + (size_t)R * 1024 * 2);
constexpr size_t WS_TOPE = al256(WS_P + (size_t)R * REC_NP * 2);
constexpr size_t WS_GATE = al256(WS_TOPE + (size_t)R * 16);
constexpr size_t WS_POS = al256(WS_GATE + (size_t)R * 16);
constexpr size_t WS_DEST = al256(WS_POS + (size_t)R * 16);
constexpr size_t WS_TILE = al256(WS_DEST + (size_t)R * 16);
constexpr size_t WS_SRC = al256(WS_TILE + (size_t)(MAXT + 8) * 4);
constexpr size_t WS_T = al256(WS_SRC + (size_t)MAXROWS * 4);
constexpr size_t WS_QD = WS_T;
constexpr size_t WS_KD = al256(WS_QD + (size_t)R * 512 * 2);
constexpr size_t WS_CQN = al256(WS_KD + (size_t)R * 512 * 2);
constexpr size_t WS_CKVN = al256(WS_CQN + (size_t)R * 384 * 2);
constexpr size_t WS_MQ = al256(WS_CKVN + (size_t)R * 256 * 2);
constexpr size_t WS_MKV = al256(WS_MQ + (size_t)R * 768 * 2);
constexpr size_t WS_KRR = al256(WS_MKV + (size_t)R * 1024 * 2);
constexpr size_t WS_ODIFF = al256(WS_KRR + (size_t)R * 32 * 2);
constexpr size_t WS_OMLA = al256(WS_ODIFF + (size_t)R * 1024 * 4);
constexpr size_t WS_T0_END = al256(WS_OMLA + (size_t)R * 512 * 4);
constexpr size_t WS_XS = WS_T;
constexpr size_t WS_HS = al256(WS_XS + (size_t)MAXROWS * 1024 * 2);
constexpr size_t WS_TM_END = al256(WS_HS + (size_t)MAXROWS * 1024 * 2);
constexpr size_t SZ_RC = (size_t)R * 512 * 4;
constexpr size_t WS_RR = WS_T, WS_VV = WS_RR + SZ_RC, WS_AKK = WS_VV + SZ_RC, WS_KL = WS_AKK + SZ_RC;
constexpr size_t WS_WDEC = WS_KL + SZ_RC  , WS_KDIR = WS_WDEC + 2 * SZ_RC  , WS_BB = WS_KDIR + 2 * SZ_RC  , WS_GG = WS_BB + 2 * SZ_RC;
constexpr size_t WS_ALORA = al256(WS_GG + SZ_RC);
constexpr size_t WS_YR = al256(WS_ALORA + (size_t)R * 384 * 2);
constexpr size_t WS_DC = WS_YR;
constexpr size_t WS_HM = al256(WS_YR + 2 * SZ_RC);
constexpr size_t WS_CST = al256(WS_HM + 2 * SZ_RC);
constexpr size_t WS_DN = al256(WS_CST + (size_t)NUNIT_M * 8192 * 4);
constexpr size_t WS_NST = al256(WS_DN + (size_t)NUNIT_M * 64 * 4);
constexpr size_t WS_SC = al256(WS_NST + (size_t)NUNIT_M * 64 * 4);
constexpr size_t WS_MST = al256(WS_SC + (size_t)NUNIT_M * 2 * 4);
constexpr size_t WS_ASIG = WS_KDIR;
constexpr size_t WS_YB = WS_BB;
constexpr int NUNIT_R = 32 * 260;
constexpr size_t WS_RKM = WS_KDIR + SZ_RC;
static_assert((size_t)NUNIT_R * 4096 * 2 <= SZ_RC, "M^T fits in KL");
constexpr size_t WS_RKQ = al256(WS_MST + (size_t)NUNIT_M * 4);
constexpr size_t WS_RKZ = al256(WS_RKQ + (size_t)NUNIT_R * 4096 * 2);
constexpr size_t WS_T1_END = al256(WS_RKZ + (size_t)NUNIT_R * 4096 * 2);
constexpr size_t WS_END = WS_T1_END > WS_TM_END ? (WS_T1_END > WS_T0_END ? WS_T1_END : WS_T0_END) : (WS_TM_END > WS_T0_END ? WS_TM_END : WS_T0_END);
static_assert(WS_END <= (size_t)2147483648ull, "workspace map exceeds 2 GiB");
constexpr int CW_CNT = 1024;
constexpr int CW_BAR = 4096;
constexpr int RING_BYTES = 131072, AUX_OFF = 131072, AUX_BYTES = 16384, MISC_OFF = 147456, LDS_BYTES = 163840;

struct Frame {
    LAS unsigned char* lds; gu32* ctl; int tid, lane, wave, blk, G, probe;
    float* out; unsigned char* ws;
    struct InTab { LAS const unsigned* t;
        __device__ __forceinline__ const float* operator[](int i) const { const unsigned lo = __builtin_amdgcn_readfirstlane(t[2 * i]), hi = __builtin_amdgcn_readfirstlane(t[2 * i + 1]);
            return (const float*)(((unsigned long long)hi << 32) | lo); } } in;
};
template <class T> __device__ __forceinline__ T* wsp(const Frame& F, size_t off) { return (T*)(F.ws + off); }
__device__ __forceinline__ int row_sel(int row) { const int b = row / TB, t = row - b * TB; return t < CT ? 2 : b; }
__device__ __forceinline__ const float* h0_row(const Frame& F, int row) {
    const int b = row / TB, t = row - b * TB;
    return t < CT ? F.in[I_CTX] + ((size_t)b * CT + t) * DM : F.in[I_X] + ((size_t)b * SEQ + (t - CT)) * DM;
}
__device__ __forceinline__ const float* modp(const Frame& F, int layer, int sel, int chunk) { return wsp<const float>(F, WS_MOD) + ((size_t)(layer * 3 + sel) * 6 + chunk) * DM; }
__device__ __forceinline__ int scan_tok(int z, int sg) { return z == 0 ? sg : (sg < CT ? CT - 1 - sg : TB + CT - 1 - sg); }
__device__ __forceinline__ void tr_item(const float* W, int K, int N, bf16* WT, int row_off, LAS float* scr, int kb, int nb, int lane) {
    const int k0 = 64 * kb, n0 = 32 * nb;
    const int n = n0 + (lane & 31);
    float tv[32];
#pragma unroll
    for (int i = 0; i < 32; ++i) { const int kk = 2 * i + (lane >> 5); tv[i] = (n < N) ? W[(size_t)(k0 + kk) * N + n] : 0.f; }
#pragma unroll
    for (int i = 0; i < 32; ++i) { const int kk = 2 * i + (lane >> 5); scr[kk * 33 + (lane & 31)] = tv[i]; }
    LDS_WAIT(); asm volatile("" ::: "memory");
    const int c = lane & 7;
#pragma unroll
    for (int j = 0; j < 4; ++j) { const int nn = (lane >> 3) + 8 * j; const LAS float* s = scr + (8 * c) * 33 + nn;
        v4u o; o.x = pk2(s[0 * 33], s[1 * 33]); o.y = pk2(s[2 * 33], s[3 * 33]); o.z = pk2(s[4 * 33], s[5 * 33]); o.w = pk2(s[6 * 33], s[7 * 33]);
        *(v4u*)(WT + (size_t)(row_off + n0 + nn) * K + k0 + 8 * c) = o; }
    LDS_WAIT(); asm volatile("" ::: "memory");
}
__device__ __forceinline__ void tr_family(const Frame& F, const float* W, size_t src_stride, int nmat, int K, int N, int Npad, bf16* WT, int gw, int NGW) {
    LAS float* scr = (LAS float*)(F.lds + F.wave * 16384);
    const int nkb = K / 64, nnb = Npad / 32, per = nkb * nnb, total = per * nmat;
    for (int it = gw; it < total; it += NGW) { const int m = it / per, r = it - m * per, kb = r / nnb, nb = r - kb * nnb;
        tr_item(W + (size_t)m * src_stride, K, N, WT, m * Npad, scr, kb, nb, F.lane); }
}
__device__ __forceinline__ void moe_weights_convert(const Frame& F, int layer, int gw, int NGW) {
    tr_family(F, F.in[I_W1] + (size_t)layer * NE * 1024 * 2048, (size_t)1024 * 2048, NE, 1024, 2048, 2048, wsp<bf16>(F, WS_W1T), gw, NGW);
    tr_family(F, F.in[I_W2] + (size_t)layer * NE * 1024 * 1024, (size_t)1024 * 1024, NE, 1024, 1024, 1024, wsp<bf16>(F, WS_W2T), gw, NGW);
}
__device__ __forceinline__ void norm_mod_row(const Frame& F, const float* src, const float* nw, const float* shift, const float* scale, bf16* orow) {
    const f32x4* xr = (const f32x4*)src + F.lane;
    f32x4 v[4]; float s = 0.f;
#pragma unroll
    for (int j = 0; j < 4; ++j) { v[j] = xr[64 * j]; s += (v[j].x * v[j].x + v[j].y * v[j].y) + (v[j].z * v[j].z + v[j].w * v[j].w); }
    const float rs = 1.f / sqrtf(wave_sum(s) * (1.f / DM) + NORM_EPS);
    unsigned long long* o8 = (unsigned long long*)orow + F.lane;
#pragma unroll
    for (int j = 0; j < 4; ++j) { const f32x4 w = ((const f32x4*)nw)[F.lane + 64 * j], sh = ((const f32x4*)shift)[F.lane + 64 * j], sc = ((const f32x4*)scale)[F.lane + 64 * j];
        const f32x4 y = v[j] * rs * w * (sc + 1.f) + sh;
        o8[64 * j] = (unsigned long long)pk2(y.x, y.y) | ((unsigned long long)pk2(y.z, y.w) << 32); }
}
__device__ __forceinline__ void p0a(const Frame& F) {
    LAS float* sv = (LAS float*)F.lds; LAS float* red = (LAS float*)(F.lds + 16384);
    for (int i = F.tid; i < 3 * DM; i += 512) { const int s = i / DM, k = i - s * DM; const float cv = (s < 2) ? F.in[I_C][s * DM + k] : F.in[I_CCTX][k]; sv[i] = cv / (1.f + __expf(-cv)); }
    __syncthreads();
    for (int it = F.blk; it < 192; it += F.G) {
        const int l = it / 96, cgp = it - l * 96, kq = F.tid >> 4, cg = F.tid & 15, col = cgp * 64 + cg * 4;
        float acc[3][4];
#pragma unroll
        for (int s = 0; s < 3; ++s)
#pragma unroll
            for (int j = 0; j < 4; ++j) acc[s][j] = 0.f;
        const float* W = F.in[I_ADAW] + (size_t)l * DM * 6144 + col;
#pragma unroll 16
        for (int kk = 0; kk < 32; ++kk) { const int k = kq * 32 + kk; const f32x4 w = *(const f32x4*)(W + (size_t)k * 6144);
            const float s0 = sv[k], s1 = sv[DM + k], s2 = sv[2 * DM + k];
#pragma unroll
            for (int j = 0; j < 4; ++j) { acc[0][j] += s0 * w[j]; acc[1][j] += s1 * w[j]; acc[2][j] += s2 * w[j]; } }
#pragma unroll
        for (int s = 0; s < 3; ++s)
#pragma unroll
            for (int j = 0; j < 4; ++j) red[(kq * 16 + cg) * 12 + s * 4 + j] = acc[s][j];
        __syncthreads();
        if (F.tid < 192) { const int s = F.tid / 64, cc = F.tid - s * 64, cg2 = cc >> 2, j = cc & 3; float t = 0.f;
            for (int q = 0; q < 32; ++q) t += red[(q * 16 + cg2) * 12 + s * 4 + j];
            wsp<float>(F, WS_MOD)[(size_t)(l * 3 + s) * 6144 + cgp * 64 + cc] = t + F.in[I_ADAB][l * 6144 + cgp * 64 + cc]; }
        __syncthreads();
    }
    const int gid = F.blk * 512 + F.tid, GT = F.G * 512;
    float* rope = wsp<float>(F, WS_ROPE);
    for (int i = gid; i < 256 * 16 + 64 * 16 + 256 * 8 + 64 * 8; i += GT) {
        int j = i; float pos, inv; size_t off;
        if (j < 256 * 16) { pos = (float)(j / 16); inv = powf(10000.f, -(float)(j % 16) / 16.f); off = ROPE_DR + (size_t)j * 2; }
        else if ((j -= 256 * 16) < 64 * 16) { pos = (float)(j / 16); inv = powf(10000.f, -(float)(j % 16) / 16.f); off = ROPE_DC + (size_t)j * 2; }
        else if ((j -= 64 * 16) < 256 * 8) { pos = (float)(j / 8); inv = powf(10000.f, -(float)(j % 8) / 8.f); off = ROPE_MR + (size_t)j * 2; }
        else { j -= 256 * 8; pos = (float)(j / 8); inv = powf(10000.f, -(float)(j % 8) / 8.f); off = ROPE_MC + (size_t)j * 2; }
        const float ang = pos * inv; rope[off] = cosf(ang); rope[off + 1] = sinf(ang);
    }
    { bf16* wh = wsp<bf16>(F, WS_WRH); bf16* wl = wsp<bf16>(F, WS_WRL); for (int i = gid; i < 2 * 32 * 1024; i += GT) { const int k = i & 1023, e = (i >> 10) & 31, l = i >> 15; const float wv = F.in[I_RW][((size_t)l * DM + k) * NE + e];
        const unsigned hb = f2bf(wv); wh[i] = (bf16)hb; wl[i] = (bf16)f2bf(wv - bf2f((bf16)hb)); } }
    bf16* WL = wsp<bf16>(F, WS_WLORA);
    for (int i = gid; i < 2560 * 384; i += GT) { const int n = i / 384, k = i - n * 384, part = n >> 9, c = n & 511; float v = 0.f;
        if (part < 2) { if ((k >> 6) == part) v = F.in[I_RW2][((size_t)part * 64 + (k & 63)) * 512 + c]; }
        else if (part < 4) { if ((k >> 6) == part) v = F.in[I_A2][((size_t)(part - 2) * 64 + (k & 63)) * 512 + c]; }
        else { if (k >= 256) v = F.in[I_G2][(size_t)(k - 256) * 512 + c]; }
        WL[i] = (bf16)f2bf(v); }
    const int gw = F.blk * 8 + F.wave, NGW = F.G * 8;
    tr_family(F, F.in[I_ATTW], 0, 1, 1024, ATT_IN, ATT_NP, wsp<bf16>(F, WS_WIN0), gw, NGW);
    tr_family(F, F.in[I_WUQ], 0, 1, 384, 768, 768, wsp<bf16>(F, WS_WUQ), gw, NGW);
    tr_family(F, F.in[I_WUKV], 0, 1, 256, 1024, 1024, wsp<bf16>(F, WS_WUKV), gw, NGW);
    tr_family(F, F.in[I_WOUT], (size_t)1024 * 1024, 2, 1024, 1024, 1024, wsp<bf16>(F, WS_WOUT), gw, NGW);
    tr_family(F, F.in[I_RECW], 0, 1, 1024, REC_IN, REC_NP, wsp<bf16>(F, WS_WREC), gw, NGW);
    moe_weights_convert(F, 0, gw, NGW);
}
__device__ __forceinline__ void p0b(const Frame& F) {
    const int gw = F.blk * 8 + F.wave, NGW = F.G * 8;
    for (int row = gw; row < R; row += NGW) { const int sel = row_sel(row);
        norm_mod_row(F, h0_row(F, row), F.in[I_NMIX], modp(F, 0, sel, 0), modp(F, 0, sel, 1), wsp<bf16>(F, WS_A) + (size_t)row * DM); }
}
struct FnStoreBf16 {
    bf16* O; int ldc;
    __device__ __forceinline__ void operator()(int row, int col, f32x4 v0, f32x4 v1) const {
        v4u w; w.x = pg8::cvt_pk_bf16(v0[0], v0[1]); w.y = pg8::cvt_pk_bf16(v0[2], v0[3]); w.z = pg8::cvt_pk_bf16(v1[0], v1[1]); w.w = pg8::cvt_pk_bf16(v1[2], v1[3]);
        *(v4u*)(O + (size_t)row * ldc + col) = w; }
};
struct FnWout {
    const Frame* F; int layer;
    __device__ __forceinline__ void operator()(int row, int col, f32x4 v0, f32x4 v1) const {
        bf16* hrow = wsp<bf16>(*F, WS_H) + (size_t)row * DM + col;
        const float* g = modp(*F, layer, row_sel(row), 2) + col;
        const f32x4 g0 = *(const f32x4*)g, g1 = *(const f32x4*)(g + 4); f32x4 b0, b1;
        if (layer == 0) { const float* base = h0_row(*F, row) + col; b0 = *(const f32x4*)base; b1 = *(const f32x4*)(base + 4); }
        else { float x[8]; unpack8(*(const v4u*)hrow, x); b0 = (f32x4){x[0], x[1], x[2], x[3]}; b1 = (f32x4){x[4], x[5], x[6], x[7]}; }
        const f32x4 o0 = b0 + g0 * v0, o1 = b1 + g1 * v1; v4u w; w.x = pk2(o0.x, o0.y); w.y = pk2(o0.z, o0.w); w.z = pk2(o1.x, o1.y); w.w = pk2(o1.z, o1.w);
        *(v4u*)hrow = w; }
};
__device__ __forceinline__ void l0_post_proj(const Frame& F) {
    const int gw = F.blk * 8 + F.wave, NGW = F.G * 8, lane = F.lane;
    const bf16* P = wsp<const bf16>(F, WS_P); const float* rope = wsp<const float>(F, WS_ROPE);
    constexpr float CD = 0.125f * 1.4426950408889634f;
    for (int row = gw; row < R; row += NGW) {
        const int b = row / TB, t = row - b * TB; const bool lat = t >= CT; const int pos = t - CT, prow = lat ? pos >> 6 : 0, pcol = lat ? pos & 63 : 0;
        const bf16* p = P + (size_t)row * ATT_NP;
        bf16* qd = wsp<bf16>(F, WS_QD) + (size_t)row * 512; bf16* kd = wsp<bf16>(F, WS_KD) + (size_t)row * 512;
#pragma unroll
        for (int j = 0; j < 2; ++j) { const int g = lane + 64 * j, h16 = g >> 3, i0 = (g & 7) * 4;
            const v2u w1 = *(const v2u*)(p + h16 * 64 + i0), w2 = *(const v2u*)(p + h16 * 64 + i0 + 32);
            const float x1[4] = {bflo(w1.x), bfhi(w1.x), bflo(w1.y), bfhi(w1.y)}, x2[4] = {bflo(w2.x), bfhi(w2.x), bflo(w2.y), bfhi(w2.y)};
            float cs[8] = {1.f, 0.f, 1.f, 0.f, 1.f, 0.f, 1.f, 0.f};
            if (lat) { const float* tb = (i0 < 16) ? rope + ROPE_DR + (size_t)(prow * 16 + i0) * 2 : rope + ROPE_DC + (size_t)(pcol * 16 + i0 - 16) * 2;
                const f32x4 t0 = *(const f32x4*)tb, t1 = *(const f32x4*)(tb + 4); cs[0] = t0.x; cs[1] = t0.y; cs[2] = t0.z; cs[3] = t0.w; cs[4] = t1.x; cs[5] = t1.y; cs[6] = t1.z; cs[7] = t1.w; }
            float y1[4], y2[4]; const float sc = h16 < 8 ? CD : 1.f;
#pragma unroll
            for (int e = 0; e < 4; ++e) { y1[e] = (x1[e] * cs[2 * e] - x2[e] * cs[2 * e + 1]) * sc; y2[e] = (x1[e] * cs[2 * e + 1] + x2[e] * cs[2 * e]) * sc; }
            bf16* o = (h16 < 8) ? qd + h16 * 64 + i0 : kd + (h16 - 8) * 64 + i0;
            v2u o1, o2; o1.x = pk2(y1[0], y1[1]); o1.y = pk2(y1[2], y1[3]); o2.x = pk2(y2[0], y2[1]); o2.y = pk2(y2[2], y2[3]);
            *(v2u*)o = o1; *(v2u*)(o + 32) = o2; }
        { float x[8]; float ss = 0.f; const bool act = lane < 48;
          if (act) unpack8(*(const v4u*)(p + 1536 + 8 * lane), x); else {
#pragma unroll
              for (int e = 0; e < 8; ++e) x[e] = 0.f; }
#pragma unroll
          for (int e = 0; e < 8; ++e) ss += x[e] * x[e];
          const float rs = 1.f / sqrtf(wave_sum(ss) * (1.f / 384.f) + NORM_EPS);
          if (act) { const f32x4 g0 = *(const f32x4*)(F.in[I_QNW] + 8 * lane), g1 = *(const f32x4*)(F.in[I_QNW] + 8 * lane + 4); v4u w;
              w.x = pk2(x[0] * rs * g0.x, x[1] * rs * g0.y); w.y = pk2(x[2] * rs * g0.z, x[3] * rs * g0.w); w.z = pk2(x[4] * rs * g1.x, x[5] * rs * g1.y); w.w = pk2(x[6] * rs * g1.z, x[7] * rs * g1.w);
              *(v4u*)(wsp<bf16>(F, WS_CQN) + (size_t)row * 384 + 8 * lane) = w; } }
        { const v2u wv = *(const v2u*)(p + 1920 + 4 * lane); const float x[4] = {bflo(wv.x), bfhi(wv.x), bflo(wv.y), bfhi(wv.y)};
          const float rs = 1.f / sqrtf(wave_sum((x[0] * x[0] + x[1] * x[1]) + (x[2] * x[2] + x[3] * x[3])) * (1.f / 256.f) + NORM_EPS);
          const f32x4 g0 = *(const f32x4*)(F.in[I_KVNW] + 4 * lane); v2u w; w.x = pk2(x[0] * rs * g0.x, x[1] * rs * g0.y); w.y = pk2(x[2] * rs * g0.z, x[3] * rs * g0.w);
          *(v2u*)(wsp<bf16>(F, WS_CKVN) + (size_t)row * 256 + 4 * lane) = w; }
        if (lane < 16) { const int i = lane; const float x1 = bf2f(p[2176 + i]), x2 = bf2f(p[2176 + i + 16]); float c = 1.f, s = 0.f;
            if (lat) { const float* tb = (i < 8) ? rope + ROPE_MR + (size_t)(prow * 8 + i) * 2 : rope + ROPE_MC + (size_t)(pcol * 8 + i - 8) * 2; c = tb[0]; s = tb[1]; }
            bf16* o = wsp<bf16>(F, WS_KRR) + (size_t)row * 32; o[i] = (bf16)f2bf(x1 * c - x2 * s); o[i + 16] = (bf16)f2bf(x1 * s + x2 * c); }
    }
}
__device__ __forceinline__ void l0_mq_rope(const Frame& F) {
    const int gw = F.blk * 8 + F.wave, NGW = F.G * 8, lane = F.lane; const float* rope = wsp<const float>(F, WS_ROPE);
    const float CM = 0.10206207261596575f * 1.4426950408889634f;
    for (int row = gw; row < R; row += NGW) {
        const int b = row / TB, t = row - b * TB; const bool lat = t >= CT; const int pos = t - CT, prow = lat ? pos >> 6 : 0, pcol = lat ? pos & 63 : 0;
        bf16* q = wsp<bf16>(F, WS_MQ) + (size_t)row * 768;
#pragma unroll
        for (int j = 0; j < 2; ++j) { const int g = lane + 64 * j, h = g >> 4, d0 = (g & 15) * 4;
            const v2u wv = *(const v2u*)(q + h * 96 + d0); v2u o; o.x = pk2(bflo(wv.x) * CM, bfhi(wv.x) * CM); o.y = pk2(bflo(wv.y) * CM, bfhi(wv.y) * CM); *(v2u*)(q + h * 96 + d0) = o; }
#pragma unroll
        for (int j = 0; j < 2; ++j) { const int pr = lane + 64 * j, h = pr >> 4, i = pr & 15; const float x1 = bf2f(q[h * 96 + 64 + i]), x2 = bf2f(q[h * 96 + 80 + i]); float c = 1.f, s = 0.f;
            if (lat) { const float* tb = (i < 8) ? rope + ROPE_MR + (size_t)(prow * 8 + i) * 2 : rope + ROPE_MC + (size_t)(pcol * 8 + i - 8) * 2; c = tb[0]; s = tb[1]; }
            q[h * 96 + 64 + i] = (bf16)f2bf((x1 * c - x2 * s) * CM); q[h * 96 + 80 + i] = (bf16)f2bf((x1 * s + x2 * c) * CM); }
    }
}
__device__ __forceinline__ void l0_attention(const Frame& F) {
    LAS char* lds = (LAS char*)F.lds;
    const bf16* QD = wsp<const bf16>(F, WS_QD); const bf16* KD = wsp<const bf16>(F, WS_KD); const bf16* P = wsp<const bf16>(F, WS_P);
    const bf16* MQ = wsp<const bf16>(F, WS_MQ); const bf16* MKV = wsp<const bf16>(F, WS_MKV); const bf16* KRR = wsp<const bf16>(F, WS_KRR);
    float* OD = wsp<float>(F, WS_ODIFF); float* OM = wsp<float>(F, WS_OMLA);
    for (int kind = 0; kind < 2; ++kind) {
        for (int L = F.blk; L < 1024 + 16; L += F.G) {
            int b, h8, qb, nkeys;
            if (L < 1024) { int pair;
                if (F.G == 256) { const int round = L >> 8, c = L & 255; pair = round * 4 + ((c & 7) >> 1); qb = 1 + (c & 1) * 32 + (c >> 3); }
                else { pair = L >> 6; qb = 1 + (L & 63); }
                b = pair >> 3; h8 = pair & 7; nkeys = TB; }
            else { const int s = L - 1024; b = s >> 3; h8 = s & 7; qb = 0; nkeys = CT; }
            const size_t q0 = (size_t)b * TB + (size_t)qb * 256, k0 = (size_t)b * TB;
            if (kind == 0)
                att::attn_unit<64, 128>(QD + q0 * 512 + h8 * 64, 512, KD + k0 * 512 + h8 * 64, 512, nullptr, 0, P + k0 * ATT_NP + 1024 + (h8 >> 1) * 128, ATT_NP,
                                        OD + q0 * 1024 + h8 * 128, 1024, nkeys, lds);
            else
                att::attn_unit<96, 64>(MQ + q0 * 768 + h8 * 96, 768, MKV + k0 * 1024 + h8 * 128, 1024, KRR + k0 * 32, 32, MKV + k0 * 1024 + h8 * 128 + 64, 1024,
                                       OM + q0 * 512 + h8 * 64, 512, nkeys, lds);
        }
    }
}
__device__ __forceinline__ void l0_combine(const Frame& F) {
    const int gw = F.blk * 8 + F.wave, NGW = F.G * 8, lane = F.lane;
    const float* lv = F.in[I_LAM];
    const float lam = __expf(wave_sum(lv[lane] * lv[64 + lane])) - __expf(wave_sum(lv[128 + lane] * lv[192 + lane])) + 0.2f;
    const float sw0 = F.in[I_SUBLN][2 * lane] * 0.8f, sw1 = F.in[I_SUBLN][2 * lane + 1] * 0.8f;
    for (int row = gw; row < R; row += NGW) {
        const float* od = wsp<const float>(F, WS_ODIFF) + (size_t)row * 1024; const float* om = wsp<const float>(F, WS_OMLA) + (size_t)row * 512;
        bf16* a1 = wsp<bf16>(F, WS_A1) + (size_t)row * DM;
#pragma unroll
        for (int h = 0; h < 4; ++h) {
            const float o1a = od[(2 * h) * 128 + 2 * lane], o1b = od[(2 * h) * 128 + 2 * lane + 1], o2a = od[(2 * h + 1) * 128 + 2 * lane], o2b = od[(2 * h + 1) * 128 + 2 * lane + 1];
            const float da = o1a - lam * o2a, db = o1b - lam * o2b;
            const float rs = 1.f / sqrtf(wave_sum(da * da + db * db) * (1.f / 128.f) + NORM_EPS);
            *(unsigned*)(a1 + h * 128 + 2 * lane) = pk2(da * rs * sw0, db * rs * sw1); }
#pragma unroll
        for (int j = 0; j < 2; ++j) { const f32x4 v = *(const f32x4*)(om + 4 * (lane + 64 * j)); v2u w; w.x = pk2(v.x, v.y); w.y = pk2(v.z, v.w); *(v2u*)(a1 + 512 + 4 * (lane + 64 * j)) = w; }
    }
}
constexpr int RT_LS = 264;
__device__ __forceinline__ void ph_router(const Frame& F, int layer) {
    LAS bf16* AH = (LAS bf16*)F.lds; LAS bf16* AL = AH + 64 * RT_LS; LAS bf16* WH = AL + 64 * RT_LS; LAS bf16* WL = WH + 32 * RT_LS;
    LAS float* lg = (LAS float*)(F.lds + 110592);
    LAS int* hist = (LAS int*)(F.lds + MISC_OFF + 256);
    LAS int* recs = (LAS int*)(F.lds + MISC_OFF + 512);
    const int lane = F.lane, w = F.wave, tid = F.tid, RPB = (R + F.G - 1) / F.G, row0 = F.blk * RPB;
    if (tid < 64) hist[tid] = 0;
    { int* srct = wsp<int>(F, WS_SRC); for (int i = F.blk * 512 + tid; i < MAXROWS; i += F.G * 512) srct[i] = 0; }
    const float* nw = F.in[I_NFFN] + (size_t)layer * DM; const float* rbp = F.in[I_RB] + layer * NE;
    const bf16* wrh = wsp<const bf16>(F, WS_WRH) + (size_t)layer * 32 * 1024; const bf16* wrl = wsp<const bf16>(F, WS_WRL) + (size_t)layer * 32 * 1024;
    for (int pass = 0; pass * 64 < RPB; ++pass) {
        const int nrow = min(64, min(RPB - pass * 64, R - row0 - pass * 64));
        f32x4 fr[8][4];
#pragma unroll
        for (int i = 0; i < 8; ++i) { const int rl = w + 8 * i; const int row = row0 + pass * 64 + rl;
            if (rl < nrow) {
                const int sel = row_sel(row); const float* sh = modp(F, layer, sel, 3); const float* sc = modp(F, layer, sel, 4);
                const v2u* xr = (const v2u*)(wsp<const bf16>(F, WS_H) + (size_t)row * DM) + lane; float s = 0.f;
#pragma unroll
                for (int j = 0; j < 4; ++j) { const v2u hw = xr[64 * j]; fr[i][j] = (f32x4){bflo(hw.x), bfhi(hw.x), bflo(hw.y), bfhi(hw.y)}; s += (fr[i][j].x * fr[i][j].x + fr[i][j].y * fr[i][j].y) + (fr[i][j].z * fr[i][j].z + fr[i][j].w * fr[i][j].w); }
                const float rs = 1.f / sqrtf(wave_sum(s) * (1.f / DM) + NORM_EPS);
                unsigned long long* o8 = (unsigned long long*)(wsp<bf16>(F, WS_F) + (size_t)row * DM) + lane;
#pragma unroll
                for (int j = 0; j < 4; ++j) { const f32x4 ww = ((const f32x4*)nw)[lane + 64 * j], a = ((const f32x4*)sh)[lane + 64 * j], c = ((const f32x4*)sc)[lane + 64 * j];
                    fr[i][j] = fr[i][j] * rs * ww * (c + 1.f) + a;
                    o8[64 * j] = (unsigned long long)pk2(fr[i][j].x, fr[i][j].y) | ((unsigned long long)pk2(fr[i][j].z, fr[i][j].w) << 32); }
            } else {
#pragma unroll
                for (int j = 0; j < 4; ++j) fr[i][j] = (f32x4){0.f, 0.f, 0.f, 0.f};
            } }
        pg8::f32x4 acc = {0.f, 0.f, 0.f, 0.f};
#pragma unroll
        for (int c = 0; c < 4; ++c) {
            __syncthreads();
#pragma unroll
            for (int i = 0; i < 8; ++i) { const f32x4 v = fr[i][c]; const unsigned h0 = pk2(v.x, v.y), h1 = pk2(v.z, v.w);
                const unsigned l0 = pk2(v.x - bflo(h0), v.y - bfhi(h0)), l1 = pk2(v.z - bflo(h1), v.w - bfhi(h1));
                v2u hh; hh.x = h0; hh.y = h1; v2u ll; ll.x = l0; ll.y = l1;
                *(LAS v2u*)(AH + (w + 8 * i) * RT_LS + 4 * lane) = hh; *(LAS v2u*)(AL + (w + 8 * i) * RT_LS + 4 * lane) = ll; }
            { const int e = tid >> 4, kp = (tid & 15) * 16;
              const v4u a0 = *(const v4u*)(wrh + (size_t)e * 1024 + 256 * c + kp), a1 = *(const v4u*)(wrh + (size_t)e * 1024 + 256 * c + kp + 8);
              const v4u b0 = *(const v4u*)(wrl + (size_t)e * 1024 + 256 * c + kp), b1 = *(const v4u*)(wrl + (size_t)e * 1024 + 256 * c + kp + 8);
              *(LAS v4u*)(WH + e * RT_LS + kp) = a0; *(LAS v4u*)(WH + e * RT_LS + kp + 8) = a1; *(LAS v4u*)(WL + e * RT_LS + kp) = b0; *(LAS v4u*)(WL + e * RT_LS + kp + 8) = b1; }
            __syncthreads();
            const int tm = w >> 1, tn = w & 1, lr = lane & 15, kq = (lane >> 4) * 8;
            const LAS bf16* ahp = AH + (tm * 16 + lr) * RT_LS + kq; const LAS bf16* alp = AL + (tm * 16 + lr) * RT_LS + kq;
            const LAS bf16* whp = WH + (tn * 16 + lr) * RT_LS + kq; const LAS bf16* wlp = WL + (tn * 16 + lr) * RT_LS + kq;
#pragma unroll
            for (int ks = 0; ks < 8; ++ks) { const bf16x8 ah = *(const LAS bf16x8*)(ahp + 32 * ks), al = *(const LAS bf16x8*)(alp + 32 * ks), bh = *(const LAS bf16x8*)(whp + 32 * ks), bl = *(const LAS bf16x8*)(wlp + 32 * ks);
                acc = __builtin_amdgcn_mfma_f32_16x16x32_bf16(ah, bh, acc, 0, 0, 0); acc = __builtin_amdgcn_mfma_f32_16x16x32_bf16(ah, bl, acc, 0, 0, 0); acc = __builtin_amdgcn_mfma_f32_16x16x32_bf16(al, bh, acc, 0, 0, 0); }
        }
        { const int m0 = (w >> 1) * 16 + (lane >> 4) * 4, n = (w & 1) * 16 + (lane & 15);
#pragma unroll
          for (int r = 0; r < 4; ++r) lg[(m0 + r) * 33 + n] = acc[r]; }
        __syncthreads();
        if (tid < nrow) { const int rl = tid, row = row0 + pass * 64 + rl; float lv[32];
#pragma unroll
            for (int e = 0; e < 32; ++e) lv[e] = lg[rl * 33 + e] + rbp[e];
            float selv[4]; int seli[4];
#pragma unroll
            for (int r = 0; r < 4; ++r) { float bv = -3.0e38f; int bi = 0;
#pragma unroll
                for (int e = 0; e < 32; ++e) { const bool taken = (r > 0 && seli[0] == e) || (r > 1 && seli[1] == e) || (r > 2 && seli[2] == e); if (!taken && lv[e] > bv) { bv = lv[e]; bi = e; } }
                selv[r] = bv; seli[r] = bi; }
            float ex[4], es = 0.f;
#pragma unroll
            for (int r = 0; r < 4; ++r) { ex[r] = __expf(selv[r] - selv[0]); es += ex[r]; }
            const float inv = 1.f / es;
#pragma unroll
            for (int r = 0; r < 4; ++r) { wsp<int>(F, WS_TOPE)[(size_t)row * 4 + r] = seli[r]; wsp<float>(F, WS_GATE)[(size_t)row * 4 + r] = ex[r] * inv;
                const int rk = __hip_atomic_fetch_add(&hist[seli[r]], 1, __ATOMIC_RELAXED, __HIP_MEMORY_SCOPE_WORKGROUP);
                recs[(pass * 64 + rl) * 4 + r] = seli[r] | (rk << 8); }
        }
    }
    __syncthreads();
    if (tid < NE) hist[32 + tid] = (int)__hip_atomic_fetch_add(F.ctl + CW_CNT + 64 * (layer + 2 * F.probe) + tid, (unsigned)hist[tid], RLX_AGENT);
    __syncthreads();
    for (int rl = tid; rl < RPB && row0 + rl < R; rl += 512) {
#pragma unroll
        for (int r = 0; r < 4; ++r) { const int rc = recs[rl * 4 + r]; wsp<int>(F, WS_POS)[(size_t)(row0 + rl) * 4 + r] = hist[32 + (rc & 255)] + (rc >> 8); } }
}
__device__ __forceinline__ void moe_tables(const Frame& F, int layer, LAS int* ps, LAS int* tile_e) {
    if (F.tid == 0) { int acc = 0, t = 0;
        for (int e = 0; e < NE; ++e) { const int c = (int)__hip_atomic_load(F.ctl + CW_CNT + 64 * layer + e, RLX_AGENT); ps[e] = acc; const int nt = (c + 255) >> 8;
            for (int i = 0; i < nt && t < MAXT; ++i) tile_e[t++] = e; acc += nt * 256; }
        ps[NE] = acc; ps[NE + 1] = t; }
    __syncthreads();
}
__device__ __forceinline__ void ph_gather(const Frame& F, int layer) {
    LAS int* ps = (LAS int*)(F.lds + MISC_OFF + 256); LAS int* tile_e = ps + 64;
    moe_tables(F, layer, ps, tile_e);
    if (F.blk == 0) { int* tab = wsp<int>(F, WS_TILE); const int nt = ps[NE + 1]; if (F.tid == 0) tab[0] = nt; for (int i = F.tid; i < nt; i += 512) tab[1 + i] = tile_e[i]; }
    for (int i = F.blk * 512 + F.tid; i < R * 4; i += F.G * 512) { const int row = i >> 2;
        const int e = wsp<const int>(F, WS_TOPE)[i]; const int dest = ps[e] + wsp<const int>(F, WS_POS)[i]; wsp<int>(F, WS_DEST)[i] = dest; wsp<int>(F, WS_SRC)[dest] = row; }
}
struct MoeOrder {
    const int* tile_e; int ntiles, nN, G, c; const int* src;
    __device__ __forceinline__ bool next(int i, pg8::Unit& u) const {
        int rt, pl;
        if (G == 256) { const int x = c & 7, y = c >> 3, rpx = 32 / nN; rt = (i * 8 + x) * rpx + y / nN; pl = y % nN; if (rt >= ntiles) return false; }
        else { const long L = (long)i * G + c; if (L >= (long)ntiles * nN) return false; rt = (int)(L / nN); pl = (int)(L - (long)rt * nN); }
        const int e = __builtin_amdgcn_readfirstlane(tile_e[rt]);
        u.pm = rt; u.pn = e * nN + pl; return true; }
    __device__ __forceinline__ void a_ready(const pg8::Unit&) const {}
    __device__ __forceinline__ void done(const pg8::Unit&) const {}
};
struct LatOrder {
    pg8::StaticOrder o;
    __device__ __forceinline__ bool next(int i, pg8::Unit& u) const { if (!o.next(i, u)) return false; u.pm += 1 + (u.pm >= 64 ? 1 : 0); return true; }
    __device__ __forceinline__ void a_ready(const pg8::Unit&) const {}
    __device__ __forceinline__ void done(const pg8::Unit&) const {}
};
struct FnSwiglu {
    bf16* HS; const float* b1;
    __device__ __forceinline__ void operator()(int row, int col, f32x4 v0, f32x4 v1) const {
        const float* bp = b1 + col;
        const f32x4 b0 = *(const f32x4*)bp, b1v = *(const f32x4*)(bp + 4); v0 = v0 + b0; v1 = v1 + b1v;
        const float hv[8] = {v0[0], v0[1], v0[2], v0[3], v1[0], v1[1], v1[2], v1[3]}; float o[4];
#pragma unroll
        for (int i = 0; i < 4; ++i) { const float g = hv[2 * i], l = hv[2 * i + 1];
            const float gl = fminf(g, 7.f), li = fminf(fmaxf(l, -7.f), 7.f); o[i] = gl * sigmoidf_(1.702f * gl) * (li + 1.f); }
        const int lc = col & 2047; v2u w; w.x = pk2(o[0], o[1]); w.y = pk2(o[2], o[3]);
        *(v2u*)(HS + (size_t)row * 1024 + (lc >> 1)) = w; }
};
struct FnBiasBf16 {
    bf16* YS; const float* b2;
    __device__ __forceinline__ void operator()(int row, int col, f32x4 v0, f32x4 v1) const {
        const f32x4 b0 = *(const f32x4*)(b2 + col), b1v = *(const f32x4*)(b2 + col + 4); v0 = v0 + b0; v1 = v1 + b1v;
        v4u w; w.x = pk2(v0[0], v0[1]); w.y = pk2(v0[2], v0[3]); w.z = pk2(v1[0], v1[1]); w.w = pk2(v1[2], v1[3]);
        *(v4u*)(YS + (size_t)row * 1024 + (col & 1023)) = w; }
};
__device__ __forceinline__ void ph_combine(const Frame& F, int layer) {
    const int lane = F.lane, gw = F.blk * 8 + F.wave, NGW = F.G * 8;
    for (int row = gw; row < R; row += NGW) {
        const int sel = row_sel(row); const float* gf = modp(F, layer, sel, 5);
        bf16* hrow = wsp<bf16>(F, WS_H) + (size_t)row * DM;
        f32x4 y[4];
#pragma unroll
        for (int j = 0; j < 4; ++j) y[j] = (f32x4){0.f, 0.f, 0.f, 0.f};
#pragma unroll
        for (int r = 0; r < 4; ++r) { const int d = wsp<const int>(F, WS_DEST)[(size_t)row * 4 + r]; const float g = wsp<const float>(F, WS_GATE)[(size_t)row * 4 + r];
            const v2u* yp = (const v2u*)(wsp<const bf16>(F, WS_XS) + (size_t)d * DM);
#pragma unroll
            for (int j = 0; j < 4; ++j) { const v2u w = yp[lane + 64 * j]; y[j] += g * (f32x4){bflo(w.x), bfhi(w.x), bflo(w.y), bfhi(w.y)}; } }
        f32x4 h[4]; float s = 0.f;
#pragma unroll
        for (int j = 0; j < 4; ++j) { const v2u hw = ((const v2u*)hrow)[lane + 64 * j]; h[j] = (f32x4){bflo(hw.x), bfhi(hw.x), bflo(hw.y), bfhi(hw.y)} + ((const f32x4*)gf)[lane + 64 * j] * y[j]; s += (h[j].x * h[j].x + h[j].y * h[j].y) + (h[j].z * h[j].z + h[j].w * h[j].w); }
        const float rs = 1.f / sqrtf(wave_sum(s) * (1.f / DM) + NORM_EPS);
        if (layer == 0) {
#pragma unroll
            for (int j = 0; j < 4; ++j) { v2u hw; hw.x = pk2(h[j].x, h[j].y); hw.y = pk2(h[j].z, h[j].w); ((v2u*)hrow)[lane + 64 * j] = hw; }
            const float* nw = F.in[I_NMIX] + DM; const float* sh = modp(F, 1, sel, 0); const float* sc = modp(F, 1, sel, 1);
            unsigned long long* o8 = (unsigned long long*)(wsp<bf16>(F, WS_A) + (size_t)row * DM) + lane;
#pragma unroll
            for (int j = 0; j < 4; ++j) { const f32x4 w = ((const f32x4*)nw)[lane + 64 * j], a = ((const f32x4*)sh)[lane + 64 * j], c = ((const f32x4*)sc)[lane + 64 * j];
                const f32x4 o = h[j] * rs * w * (c + 1.f) + a; o8[64 * j] = (unsigned long long)pk2(o.x, o.y) | ((unsigned long long)pk2(o.z, o.w) << 32); }
        } else {
            const int b = row / TB, t = row - b * TB;
            if (t >= CT) { float* orow = F.out + ((size_t)b * SEQ + (t - CT)) * DM; const float* nw = F.in[I_FNW];
#pragma unroll
                for (int j = 0; j < 4; ++j) ((f32x4*)orow)[lane + 64 * j] = h[j] * rs * ((const f32x4*)nw)[lane + 64 * j]; }
        }
    }
}
constexpr int PC_Q = 1920, PC_K = 2176, PC_V = 2432, PC_O = 2944, PC_G = 3456;
__device__ __forceinline__ float softplusf_(float y) { return fmaxf(y, 0.f) + __logf(1.f + __expf(-fabsf(y))); }
__device__ __forceinline__ float tanhf_(float x) { return 1.f - 2.f / (1.f + __expf(2.f * x)); }
__device__ __forceinline__ void lerp8(const bf16* p, bool hp, bool hn, int c0, const float* mu, float (&u)[8]) {
    const v4u z4 = {0u, 0u, 0u, 0u};
    const v4u wx = *(const v4u*)(p + c0), wp = hp ? *(const v4u*)(p - REC_NP + c0) : z4, wn = hn ? *(const v4u*)(p + REC_NP + c0) : z4;
    float x[8], xp[8], xn[8]; unpack8(wx, x); unpack8(wp, xp); unpack8(wn, xn);
    const f32x4 m0 = *(const f32x4*)(mu + c0), m1 = *(const f32x4*)(mu + c0 + 4);
#pragma unroll
    for (int e = 0; e < 8; ++e) { const float m = e < 4 ? m0[e & 3] : m1[e & 3]; u[e] = x[e] + m * (0.5f * (xp[e] + xn[e]) - x[e]); }
}
__device__ __forceinline__ void st8h(bf16* o, const float (&u)[8]) { v4u w; w.x = pk2(u[0], u[1]); w.y = pk2(u[2], u[3]); w.z = pk2(u[4], u[5]); w.w = pk2(u[6], u[7]); *(v4u*)o = w; }
__device__ __forceinline__ void st8f(float* o, const float (&u)[8]) { *(f32x4*)o = (f32x4){u[0], u[1], u[2], u[3]}; *(f32x4*)(o + 4) = (f32x4){u[4], u[5], u[6], u[7]}; }
__device__ __forceinline__ void l1_rwkv_prep(const Frame& F) {
    const int gw = F.blk * 8 + F.wave, NGW = F.G * 8, lane = F.lane; const float* mu = F.in[I_MU];
    for (int row = gw; row < R; row += NGW) {
        const int b = row / TB, t = row - b * TB; const bool hp = (t != 0 && t != CT), hn = (t != CT - 1 && t != TB - 1);
        const bf16* p = wsp<const bf16>(F, WS_P) + (size_t)row * REC_NP; const size_t ro = (size_t)row * 512 + 8 * lane;
        float u[8];
        lerp8(p, hp, hn, 8 * lane, mu, u); st8h(wsp<bf16>(F, WS_RR) + ro, u);
        lerp8(p, hp, hn, 1024 + 8 * lane, mu, u); st8h(wsp<bf16>(F, WS_VV) + ro, u);
        lerp8(p, hp, hn, 512 + 8 * lane, mu, u); st8h(wsp<bf16>(F, WS_KL) + ro, u);
        { const f32x4 k0 = *(const f32x4*)(F.in[I_KK] + 8 * lane), k1 = *(const f32x4*)(F.in[I_KK] + 8 * lane + 4); float ss = 0.f;
#pragma unroll
          for (int e = 0; e < 8; ++e) { u[e] *= (e < 4 ? k0[e & 3] : k1[e & 3]); ss += u[e] * u[e]; }
          ss += __shfl_xor(ss, 1); ss += __shfl_xor(ss, 2); ss += __shfl_xor(ss, 4);
          const float inv = -1.f / sqrtf(fmaxf(ss, 1e-24f));
#pragma unroll
          for (int e = 0; e < 8; ++e) u[e] *= inv;
          st8h(wsp<bf16>(F, WS_AKK) + ro, u); }
        if (lane < 48) { lerp8(p, hp, hn, 1536 + 8 * lane, mu, u);
#pragma unroll
            for (int e = 0; e < 8; ++e) u[e] = lane < 16 ? tanhf_(u[e]) : (lane < 32 ? u[e] : sigmoidf_(u[e]));
            v4u w; w.x = pk2(u[0], u[1]); w.y = pk2(u[2], u[3]); w.z = pk2(u[4], u[5]); w.w = pk2(u[6], u[7]);
            *(v4u*)(wsp<bf16>(F, WS_ALORA) + (size_t)row * 384 + 8 * lane) = w; }
    }
}
struct EpiLora {
    static constexpr bool PERM = true, AFTER_DRAIN = false;
    const Frame* F;
    template <int KIND> __device__ __forceinline__ void run(const pg8::f32x4 (&acc)[2][2][4][2], const pg8::Unit& u, int wr, int wc, int fr, int fq, int z) const {
#pragma unroll
        for (int ai = 0; ai < 2; ++ai)
#pragma unroll
            for (int m = 0; m < 4; ++m) { const int row = u.pm * 256 + ai * 128 + wr * 64 + m * 16 + fr;
#pragma unroll
                for (int bj = 0; bj < 2; ++bj) { const int c = ((u.pn & 1) * 256) + bj * 128 + wc * 32 + 8 * fq; const size_t ro = (size_t)row * 512 + c;
                    const pg8::f32x4 v0 = acc[ai][bj][m][0], v1 = acc[ai][bj][m][1]; const float x[8] = {v0[0], v0[1], v0[2], v0[3], v1[0], v1[1], v1[2], v1[3]}; float o[8];
                    if constexpr (KIND == 0) { const float* w0 = F->in[I_W0] + z * 512 + c;
#pragma unroll
                        for (int e = 0; e < 8; ++e) { const float wl = -softplusf_(-(w0[e] + x[e])) - 0.5f; o[e] = __expf(-__expf(wl)); }
                        st8f(wsp<float>(*F, WS_WDEC) + (size_t)z * R * 512 + ro, o); }
                    else if constexpr (KIND == 1) { const float* a0 = F->in[I_A0] + z * 512 + c;
#pragma unroll
                        for (int e = 0; e < 8; ++e) o[e] = sigmoidf_(a0[e] + x[e]);
                        st8h(wsp<bf16>(*F, WS_ASIG) + (size_t)z * R * 512 + ro, o); }
                    else st8h(wsp<bf16>(*F, WS_GG) + ro, x); } }
    }
    __device__ __forceinline__ void operator()(const pg8::f32x4 (&acc)[2][2][4][2], const pg8::Unit& u, int wr, int wc, int fr, int fq) const {
        const int part = u.pn >> 1;
        if (part < 2) run<0>(acc, u, wr, wc, fr, fq, part); else if (part < 4) run<1>(acc, u, wr, wc, fr, fq, part - 2); else run<2>(acc, u, wr, wc, fr, fq, 0);
    }
};
__device__ __forceinline__ void mlstm_gates(const Frame& F, int row, int z, int h, float& ig, float& lf) {
    const bf16* g = wsp<const bf16>(F, WS_P) + (size_t)row * REC_NP + PC_G + z * 8 + h; const float* gb = F.in[I_GATEB] + z * 8 + h;
    const float gi = bf2f(g[0]) + gb[0], gf = bf2f(g[4]) + gb[4];
    ig = 15.f * tanhf_(gi * (1.f / 15.f)); const float cf = 15.f * tanhf_(gf * (1.f / 15.f)); lf = fminf(cf, 0.f) - __logf(1.f + __expf(-fabsf(cf)));
}
__device__ __forceinline__ void mlstm_chunk_head(const Frame& F, int z, int b, int h, int c, LAS float* vec) {
    LAS int* rows = (LAS int*)vec;
    if (F.tid < 64) { const int s = F.tid, row = b * TB + scan_tok(z, 64 * c + s); float ig, lf; mlstm_gates(F, row, z, h, ig, lf); rows[s] = row; vec[64 + s] = ig; vec[192 + s] = lf; }
    __syncthreads();
    if (F.tid < 64) { float a = 0.f; for (int s = 0; s <= F.tid; ++s) a += vec[192 + s]; vec[128 + F.tid] = a; }
    __syncthreads();
}
__device__ __forceinline__ void l1_mlstm_b(const Frame& F) {
    const float* __restrict__ SC = wsp<const float>(F, WS_SC); const float* __restrict__ DC = wsp<const float>(F, WS_DC); float* __restrict__ CST = wsp<float>(F, WS_CST);
    const float* __restrict__ DN = wsp<const float>(F, WS_DN); float* __restrict__ NST = wsp<float>(F, WS_NST); float* __restrict__ MST = wsp<float>(F, WS_MST);
    for (int g = F.blk * 512 + F.tid; g < 16 * 8192; g += F.G * 512) {
        const int chain = g >> 13, el = g & 8191; float m = 0.f, C = 0.f, N = 0.f; const bool don = el < 64;
        for (int c0 = 0; c0 < 260; c0 += 10) {
            float dc[10], dn[10], bl[10], ml[10];
#pragma unroll
            for (int i = 0; i < 10; ++i) { const size_t u = (size_t)chain * 260 + c0 + i; dc[i] = DC[u * 8192 + el]; dn[i] = don ? DN[u * 64 + el] : 0.f; bl[i] = SC[2 * u]; ml[i] = SC[2 * u + 1]; }
#pragma unroll
            for (int i = 0; i < 10; ++i) { const size_t u = (size_t)chain * 260 + c0 + i;
                CST[u * 8192 + el] = C; if (don) NST[u * 64 + el] = N; if (el == 0) MST[u] = m;
                const float mn = fmaxf(bl[i] + m, ml[i]), cd = __expf(bl[i] + m - mn), inj = __expf(ml[i] - mn);
                C = cd * C + inj * dc[i]; N = cd * N + inj * dn[i]; m = mn; }
        }
    }
}
__device__ __forceinline__ void l1_rec_out(const Frame& F) {
    const int gw = F.blk * 8 + F.wave, NGW = F.G * 8, lane = F.lane, c0 = 8 * lane;
    for (int row = gw; row < R; row += NGW) {
        const size_t ro = (size_t)row * 512 + c0; bf16* a1 = wsp<bf16>(F, WS_A1) + (size_t)row * DM;
        { float y0[8], y1[8], y[8]; float s = 0.f; unpack8(*(const v4u*)(wsp<const bf16>(F, WS_YR) + ro), y0); unpack8(*(const v4u*)(wsp<const bf16>(F, WS_YR) + (size_t)R * 512 + ro), y1);
          const float* y2 = wsp<const float>(F, WS_YB) + ro; const float* y3 = y2 + (size_t)R * 512;
#pragma unroll
          for (int e = 0; e < 8; ++e) { y[e] = (y0[e] + y1[e]) + (y2[e] + y3[e]); s += y[e]; }
          s += __shfl_xor(s, 1); s += __shfl_xor(s, 2); s += __shfl_xor(s, 4); const float mean = s * (1.f / 64.f); float q = 0.f;
#pragma unroll
          for (int e = 0; e < 8; ++e) { y[e] -= mean; q += y[e] * y[e]; }
          q += __shfl_xor(q, 1); q += __shfl_xor(q, 2); q += __shfl_xor(q, 4); const float rstd = 1.f / sqrtf(q * (1.f / 64.f) + 64e-5f);
          float rr[8], kl[8], s0[8], s1[8], vv[8], gg[8]; unpack8(*(const v4u*)(wsp<const bf16>(F, WS_RR) + ro), rr); unpack8(*(const v4u*)(wsp<const bf16>(F, WS_KL) + ro), kl);
          unpack8(*(const v4u*)(wsp<const bf16>(F, WS_ASIG) + ro), s0); unpack8(*(const v4u*)(wsp<const bf16>(F, WS_ASIG) + (size_t)R * 512 + ro), s1);
          unpack8(*(const v4u*)(wsp<const bf16>(F, WS_VV) + ro), vv); unpack8(*(const v4u*)(wsp<const bf16>(F, WS_GG) + ro), gg);
          const float* rk = F.in[I_RK] + c0; const float* ka = F.in[I_KA] + c0; float bs = 0.f;
#pragma unroll
          for (int e = 0; e < 8; ++e) bs += rr[e] * kl[e] * (2.f + (s0[e] + s1[e] - 2.f) * ka[e]) * rk[e];
          bs += __shfl_xor(bs, 1); bs += __shfl_xor(bs, 2); bs += __shfl_xor(bs, 4);
          const float* lw = F.in[I_LNW] + c0; const float* lb = F.in[I_LNB] + c0; float o[8];
#pragma unroll
          for (int e = 0; e < 8; ++e) o[e] = (y[e] * rstd * lw[e] + lb[e] + bs * vv[e]) * gg[e];
          v4u w; w.x = pk2(o[0], o[1]); w.y = pk2(o[2], o[3]); w.z = pk2(o[4], o[5]); w.w = pk2(o[6], o[7]); *(v4u*)(a1 + c0) = w; }
        { float h0[8], h1[8], x[8]; float q = 0.f; unpack8(*(const v4u*)(wsp<const bf16>(F, WS_HM) + ro), h0); unpack8(*(const v4u*)(wsp<const bf16>(F, WS_HM) + (size_t)R * 512 + ro), h1);
#pragma unroll
          for (int e = 0; e < 8; ++e) { x[e] = h0[e] + h1[e]; q += x[e] * x[e]; }
          q += __shfl_xor(q, 1); q += __shfl_xor(q, 2); q += __shfl_xor(q, 4); q += __shfl_xor(q, 8); const float rs = 1.f / sqrtf(q * (1.f / 128.f) + NORM_EPS);
          float og[8]; unpack8(*(const v4u*)(wsp<const bf16>(F, WS_P) + (size_t)row * REC_NP + PC_O + c0), og); const float* nw = F.in[I_MNW] + c0; float o[8];
#pragma unroll
          for (int e = 0; e < 8; ++e) o[e] = x[e] * rs * nw[e] * sigmoidf_(og[e]);
          v4u w; w.x = pk2(o[0], o[1]); w.y = pk2(o[2], o[3]); w.z = pk2(o[4], o[5]); w.w = pk2(o[6], o[7]); *(v4u*)(a1 + 512 + c0) = w; }
    }
}
#ifndef NEU_ROUNDS
#define NEU_ROUNDS 6
#endif
namespace rk {
constexpr int LS = 72;
constexpr int MB = 64 * LS * 2;
struct Acc2 { pg8::f32x4 t0, t1; };
__device__ __forceinline__ void zero(Acc2& a) { a.t0 = (pg8::f32x4){0.f, 0.f, 0.f, 0.f}; a.t1 = a.t0; }
__device__ __forceinline__ void mm_acc(Acc2& acc, const LAS bf16* A, const LAS bf16* Bt, int wave, int lane) {
    const int tm = wave >> 1, tn0 = (wave & 1) * 2, lr = lane & 15, kq = (lane >> 4) * 8;
    const LAS bf16* ap = A + (tm * 16 + lr) * LS + kq; const LAS bf16* bp0 = Bt + (tn0 * 16 + lr) * LS + kq; const LAS bf16* bp1 = bp0 + 16 * LS;
    const bf16x8 a0 = *(const LAS bf16x8*)ap, a1 = *(const LAS bf16x8*)(ap + 32);
    const bf16x8 b00 = *(const LAS bf16x8*)bp0, b01 = *(const LAS bf16x8*)(bp0 + 32), b10 = *(const LAS bf16x8*)bp1, b11 = *(const LAS bf16x8*)(bp1 + 32);
    acc.t0 = __builtin_amdgcn_mfma_f32_16x16x32_bf16(a0, b00, acc.t0, 0, 0, 0); acc.t0 = __builtin_amdgcn_mfma_f32_16x16x32_bf16(a1, b01, acc.t0, 0, 0, 0);
    acc.t1 = __builtin_amdgcn_mfma_f32_16x16x32_bf16(a0, b10, acc.t1, 0, 0, 0); acc.t1 = __builtin_amdgcn_mfma_f32_16x16x32_bf16(a1, b11, acc.t1, 0, 0, 0);
}
template <class Fn> __device__ __forceinline__ void each(const Acc2& acc, int wave, int lane, Fn fn) {
    const int m0 = (wave >> 1) * 16 + (lane >> 4) * 4, n0 = (wave & 1) * 32 + (lane & 15);
#pragma unroll
    for (int r = 0; r < 4; ++r) { fn(m0 + r, n0, acc.t0[r]); fn(m0 + r, n0 + 16, acc.t1[r]); }
}
__device__ __forceinline__ void stb(LAS bf16* M, int m, int n, float v) { M[m * LS + n] = (bf16)f2bf(v); }
__device__ __forceinline__ void st_tr(LAS bf16* M, const Acc2& acc, int wave, int lane) {
    const int m0 = (wave >> 1) * 16 + (lane >> 4) * 4, n0 = (wave & 1) * 32 + (lane & 15);
    v2u a, b; a.x = pk2(acc.t0[0], acc.t0[1]); a.y = pk2(acc.t0[2], acc.t0[3]); b.x = pk2(acc.t1[0], acc.t1[1]); b.y = pk2(acc.t1[2], acc.t1[3]);
    *(LAS v2u*)(M + n0 * LS + m0) = a; *(LAS v2u*)(M + (n0 + 16) * LS + m0) = b;
}
}
__device__ __forceinline__ void l1_rk_phase_a(const Frame& F) {
    using namespace rk;
    LAS unsigned char* L = F.lds;
    LAS bf16* Rt = (LAS bf16*)(L + 0 * MB); LAS bf16* At = (LAS bf16*)(L + 1 * MB); LAS bf16* AtT = (LAS bf16*)(L + 2 * MB); LAS bf16* Bq = (LAS bf16*)(L + 3 * MB); LAS bf16* Kq = (LAS bf16*)(L + 4 * MB);
    LAS bf16* VT = (LAS bf16*)(L + 5 * MB); LAS bf16* BhT = (LAS bf16*)(L + 6 * MB); LAS bf16* KhT = (LAS bf16*)(L + 7 * MB);
    LAS bf16* AK = (LAS bf16*)(L + 8 * MB); LAS bf16* RB = (LAS bf16*)(L + 9 * MB); LAS bf16* RK = (LAS bf16*)(L + 10 * MB);
    LAS bf16* X = (LAS bf16*)(L + 11 * MB); LAS bf16* XT = (LAS bf16*)(L + 12 * MB); LAS bf16* P = (LAS bf16*)(L + 13 * MB);
    LAS bf16* AkVT = Bq; LAS bf16* ApT = Kq; LAS bf16* W2T = X;
    LAS float* G = (LAS float*)(L + 8 * MB);
    LAS float* gl = (LAS float*)(L + 14 * MB);
    const int w = F.wave, lane = F.lane, tid = F.tid;
    const int t = lane, j0 = 8 * w;
    float fr[8], fv[8], fa[8], fw[8], fk[8], fb[8];
#define RK_LOAD(u_) do { const int ch_ = (u_) / 260, c_ = (u_) - ch_ * 260, z_ = ch_ >> 4, b_ = (ch_ >> 3) & 1, h_ = ch_ & 7; const size_t ro = ((size_t)b_ * TB + scan_tok(z_, 64 * c_ + t)) * 512 + h_ * 64 + j0; \
    const v4u xr_ = *(const v4u*)(wsp<const bf16>(F, WS_RR) + ro), xv_ = *(const v4u*)(wsp<const bf16>(F, WS_VV) + ro), xa_ = *(const v4u*)(wsp<const bf16>(F, WS_AKK) + ro), xk_ = *(const v4u*)(wsp<const bf16>(F, WS_KL) + ro), \
              xs_ = *(const v4u*)(wsp<const bf16>(F, WS_ASIG) + (size_t)z_ * R * 512 + ro); const float* p3 = wsp<const float>(F, WS_WDEC) + (size_t)z_ * R * 512 + ro; const float* pk_ = F.in[I_KA] + h_ * 64 + j0; \
    const f32x4 w0_ = *(const f32x4*)p3, w1_ = *(const f32x4*)(p3 + 4), q0_ = *(const f32x4*)pk_, q1_ = *(const f32x4*)(pk_ + 4); float sg_[8], kl_[8]; \
    unpack8(xr_, fr); unpack8(xv_, fv); unpack8(xa_, fa); unpack8(xk_, kl_); unpack8(xs_, sg_); \
    _Pragma("unroll") for (int e = 0; e < 8; ++e) { const float kav = e < 4 ? q0_[e & 3] : q1_[e & 3]; fw[e] = e < 4 ? w0_[e & 3] : w1_[e & 3]; fk[e] = kl_[e] * (1.f + (sg_[e] - 1.f) * kav); fb[e] = -fa[e] * sg_[e]; } } while (0)
    if (F.blk < NUNIT_R) RK_LOAD(F.blk);
    for (int u = F.blk; u < NUNIT_R; u += F.G) {
        const int chain = u / 260, c = u - chain * 260, z = chain >> 4, b = (chain >> 3) & 1, h = chain & 7;
#pragma unroll
        for (int e = 0; e < 8; ++e) { float g = fw[e];
            g *= __builtin_bit_cast(float, __builtin_amdgcn_update_dpp(0x3F800000, __builtin_bit_cast(int, g), 0x111, 0xF, 0xF, false));
            g *= __builtin_bit_cast(float, __builtin_amdgcn_update_dpp(0x3F800000, __builtin_bit_cast(int, g), 0x112, 0xF, 0xF, false));
            g *= __builtin_bit_cast(float, __builtin_amdgcn_update_dpp(0x3F800000, __builtin_bit_cast(int, g), 0x114, 0xF, 0xF, false));
            g *= __builtin_bit_cast(float, __builtin_amdgcn_update_dpp(0x3F800000, __builtin_bit_cast(int, g), 0x118, 0xF, 0xF, false));
            g *= __builtin_bit_cast(float, __builtin_amdgcn_update_dpp(0x3F800000, __builtin_bit_cast(int, g), 0x142, 0xA, 0xF, false));
            g *= __builtin_bit_cast(float, __builtin_amdgcn_update_dpp(0x3F800000, __builtin_bit_cast(int, g), 0x143, 0xC, 0xF, false));
            const float gp = __builtin_bit_cast(float, __builtin_amdgcn_update_dpp(0x3F800000, __builtin_bit_cast(int, g), 0x138, 0xF, 0xF, false));
            const float gL = __builtin_bit_cast(float, __builtin_amdgcn_readlane(__builtin_bit_cast(int, g), 63)), ig = 1.f / g;
            fr[e] *= g; fa[e] *= gp; const float bq = fb[e] * ig, kq = fk[e] * ig; fb[e] = bq; fk[e] = kq; fw[e] = gL; }
        __syncthreads();
        if (lane == 63) {
#pragma unroll
            for (int e = 0; e < 8; ++e) gl[j0 + e] = fw[e]; }
        { v4u q; q.x = pk2(fr[0], fr[1]); q.y = pk2(fr[2], fr[3]); q.z = pk2(fr[4], fr[5]); q.w = pk2(fr[6], fr[7]); *(LAS v4u*)(Rt + t * LS + j0) = q;
          q.x = pk2(fa[0], fa[1]); q.y = pk2(fa[2], fa[3]); q.z = pk2(fa[4], fa[5]); q.w = pk2(fa[6], fa[7]); *(LAS v4u*)(At + t * LS + j0) = q;
          q.x = pk2(fb[0], fb[1]); q.y = pk2(fb[2], fb[3]); q.z = pk2(fb[4], fb[5]); q.w = pk2(fb[6], fb[7]); *(LAS v4u*)(Bq + t * LS + j0) = q;
          q.x = pk2(fk[0], fk[1]); q.y = pk2(fk[2], fk[3]); q.z = pk2(fk[4], fk[5]); q.w = pk2(fk[6], fk[7]); *(LAS v4u*)(Kq + t * LS + j0) = q; }
#pragma unroll
        for (int e = 0; e < 8; ++e) { const int j = j0 + e; stb(AtT, j, t, fa[e]); stb(VT, j, t, fv[e]); stb(BhT, j, t, fb[e] * fw[e]); stb(KhT, j, t, fk[e] * fw[e]); }
        __syncthreads();
        if (u + F.G < NUNIT_R) RK_LOAD(u + F.G);
        Acc2 a1, a2, a3, a4;
        zero(a1); mm_acc(a1, At, Bq, w, lane); zero(a2); mm_acc(a2, At, Kq, w, lane); zero(a3); mm_acc(a3, Rt, Bq, w, lane); zero(a4); mm_acc(a4, Rt, Kq, w, lane);
        each(a1, w, lane, [&](int m, int n, float v) { const float x = n < m ? v : 0.f; stb(X, m, n, x); stb(XT, n, m, x); stb(P, m, n, m == n ? 1.f : 0.f); });
        each(a2, w, lane, [&](int m, int n, float v) { stb(AK, m, n, n < m ? v : 0.f); });
        each(a3, w, lane, [&](int m, int n, float v) { stb(RB, m, n, n <= m ? v : 0.f); });
        each(a4, w, lane, [&](int m, int n, float v) { stb(RK, m, n, n <= m ? v : 0.f); });
        __syncthreads();
        { const int m0 = (w >> 1) * 16 + (lane >> 4) * 4, n0 = (w & 1) * 32 + (lane & 15);
          Acc2 pt;
#pragma unroll
          for (int r = 0; r < 4; ++r) { pt.t0[r] = (m0 + r == n0) ? 1.f : 0.f; pt.t1[r] = (m0 + r == n0 + 16) ? 1.f : 0.f; }
#pragma unroll 1
          for (int i = 0; i < NEU_ROUNDS; ++i) {
            mm_acc(pt, P, XT, w, lane);
            if (i < NEU_ROUNDS - 1) { zero(a1); mm_acc(a1, X, XT, w, lane); }
            __syncthreads();
#pragma unroll
            for (int r = 0; r < 4; ++r) { stb(P, m0 + r, n0, pt.t0[r]); stb(P, m0 + r, n0 + 16, pt.t1[r]); }
            if (i < NEU_ROUNDS - 1) { each(a1, w, lane, [&](int m, int n, float v) { stb(X, m, n, v); }); st_tr(XT, a1, w, lane); }
            __syncthreads();
          } }
        zero(a1); mm_acc(a1, AK, VT, w, lane); zero(a2); mm_acc(a2, P, AtT, w, lane);
        st_tr(AkVT, a1, w, lane); st_tr(ApT, a2, w, lane);
        __syncthreads();
        zero(a3); mm_acc(a3, P, AkVT, w, lane);
        st_tr(W2T, a3, w, lane);
        __syncthreads();
        zero(a1); mm_acc(a1, RB, ApT, w, lane); zero(a2); mm_acc(a2, RB, W2T, w, lane); mm_acc(a2, RK, VT, w, lane);
        zero(a3); mm_acc(a3, BhT, ApT, w, lane); zero(a4); mm_acc(a4, BhT, W2T, w, lane); mm_acc(a4, KhT, VT, w, lane);
        __syncthreads();
        { LAS bf16* O1 = At; LAS bf16* O2 = AtT; LAS bf16* O3 = AK; LAS float* OY = (LAS float*)X;
          each(a1, w, lane, [&](int m, int n, float v) { stb(O1, m, n, v + bf2f(Rt[m * LS + n])); });
          each(a3, w, lane, [&](int m, int n, float v) { stb(O2, m, n, v + (m == n ? gl[m] : 0.f)); });
          each(a4, w, lane, [&](int m, int n, float v) { stb(O3, m, n, v); });
          each(a2, w, lane, [&](int m, int n, float v) { OY[m * 68 + n] = v; });
          __syncthreads();
          const int row = tid >> 3, c8 = (tid & 7) * 8;
          *(v4u*)(wsp<bf16>(F, WS_RKQ) + (size_t)u * 4096 + row * 64 + c8) = *(const LAS v4u*)(O1 + row * LS + c8);
          *(v4u*)(wsp<bf16>(F, WS_RKM) + (size_t)u * 4096 + row * 64 + c8) = *(const LAS v4u*)(O2 + row * LS + c8);
          *(v4u*)(wsp<bf16>(F, WS_RKZ) + (size_t)u * 4096 + row * 64 + c8) = *(const LAS v4u*)(O3 + row * LS + c8);
          bf16* Yg = wsp<bf16>(F, WS_YR) + (size_t)z * R * 512 + h * 64;
#pragma unroll
          for (int i = 0; i < 2; ++i) { const int yr = (tid >> 4) + 32 * i, c4 = (tid & 15) * 4; const f32x4 yv = *(const LAS f32x4*)(OY + yr * 68 + c4); v2u yw; yw.x = pk2(yv.x, yv.y); yw.y = pk2(yv.z, yv.w);
              *(v2u*)(Yg + ((size_t)b * TB + scan_tok(z, 64 * c + yr)) * 512 + c4) = yw; } }
    }
#undef RK_LOAD
}
__device__ __forceinline__ void l1_rk_phase_b(const Frame& F) {
    using namespace rk;
    LAS unsigned char* L = F.lds;
    const int w = F.wave, lane = F.lane, tid = F.tid, chain = F.blk, z = chain >> 4, b = (chain >> 3) & 1, h = chain & 7;
    for (int i = tid; i < 2 * 64 * LS; i += 512) ((LAS bf16*)L)[i] = 0;
    const int sr = tid >> 3, sc = (tid & 7) * 8;
    v4u gm, gq, gz;
#define RKB_LOAD(u_) do { gm = *(const v4u*)(wsp<const bf16>(F, WS_RKM) + (u_) * 4096 + sr * 64 + sc); gq = *(const v4u*)(wsp<const bf16>(F, WS_RKQ) + (u_) * 4096 + sr * 64 + sc); \
    gz = *(const v4u*)(wsp<const bf16>(F, WS_RKZ) + (u_) * 4096 + sr * 64 + sc); } while (0)
#define RKB_WRITE(par) do { *(LAS v4u*)((LAS bf16*)(L + (2 + 3 * (par)) * MB) + sr * LS + sc) = gm; *(LAS v4u*)((LAS bf16*)(L + (3 + 3 * (par)) * MB) + sr * LS + sc) = gq; \
    *(LAS v4u*)((LAS bf16*)(L + (4 + 3 * (par)) * MB) + sr * LS + sc) = gz; } while (0)
    RKB_LOAD((size_t)chain * 260); RKB_WRITE(0);
    __syncthreads();
    float* Yg = wsp<float>(F, WS_YB) + (size_t)z * R * 512 + h * 64;
    const int m0 = (w >> 1) * 16 + (lane >> 4) * 4, n0 = (w & 1) * 32 + (lane & 15);
    for (int c = 0; c < 260; ++c) {
        const size_t u = (size_t)chain * 260 + c; const int par = c & 1;
        if (c + 1 < 260) RKB_LOAD(u + 1);
        const LAS bf16* S = (const LAS bf16*)(L + par * MB); LAS bf16* Sn = (LAS bf16*)(L + (par ^ 1) * MB);
        const LAS bf16* Mt = (const LAS bf16*)(L + (2 + 3 * par) * MB); const LAS bf16* Qp = (const LAS bf16*)(L + (3 + 3 * par) * MB); const LAS bf16* Zt = (const LAS bf16*)(L + (4 + 3 * par) * MB);
        Acc2 a1, a2;
#pragma unroll
        for (int r = 0; r < 4; ++r) { a1.t0[r] = bf2f(Zt[(m0 + r) * LS + n0]); a1.t1[r] = bf2f(Zt[(m0 + r) * LS + n0 + 16]); }
        mm_acc(a1, Mt, S, w, lane); zero(a2); mm_acc(a2, Qp, S, w, lane);
        st_tr(Sn, a1, w, lane);
        if (c + 1 < 260) RKB_WRITE(par ^ 1);
#pragma unroll
        for (int r = 0; r < 4; ++r) { const size_t yo = ((size_t)b * TB + scan_tok(z, 64 * c + m0 + r)) * 512 + n0; Yg[yo] = a2.t0[r]; Yg[yo + 16] = a2.t1[r]; }
        __syncthreads();
    }
#undef RKB_LOAD
#undef RKB_WRITE
}
__device__ __forceinline__ void l1_mlstm_a2(const Frame& F) {
    using namespace rk;
    LAS bf16* KT = (LAS bf16*)F.lds; LAS bf16* VsT = KT + 64 * LS;
    LAS float* vec = (LAS float*)(F.lds + AUX_OFF); LAS int* rows = (LAS int*)vec;
    const bf16* Pg = wsp<const bf16>(F, WS_P); const int tid = F.tid, w = F.wave, lane = F.lane;
    for (int u = F.blk; u < NUNIT_M; u += F.G) {
        const int cidx = u / 260, c = u - cidx * 260, z = cidx >> 3, b = (cidx >> 2) & 1, h = cidx & 3;
        mlstm_chunk_head(F, z, b, h, c, vec);
        if (tid < 64) { const float bl = vec[128 + 63]; const float uu = bl - vec[128 + tid] + vec[64 + tid]; float m = uu;
#pragma unroll
            for (int o = 1; o < 64; o <<= 1) m = fmaxf(m, __shfl_xor(m, o));
            vec[256 + tid] = __expf(uu - m);
            if (tid == 0) { wsp<float>(F, WS_SC)[2 * u] = bl; wsp<float>(F, WS_SC)[2 * u + 1] = m; } }
        __syncthreads();
        { const int s = tid >> 3, c8 = tid & 7; float x[8]; unpack8(*(const v4u*)(Pg + (size_t)rows[s] * REC_NP + PC_K + h * 64 + 8 * c8), x);
#pragma unroll
          for (int e = 0; e < 8; ++e) stb(KT, 8 * c8 + e, s, x[e]); }
#pragma unroll
        for (int i = 0; i < 2; ++i) { const int s = (tid >> 4) + 32 * i, c8 = tid & 15; float x[8]; unpack8(*(const v4u*)(Pg + (size_t)rows[s] * REC_NP + PC_V + h * 128 + 8 * c8), x); const float sw = vec[256 + s];
#pragma unroll
            for (int e = 0; e < 8; ++e) stb(VsT, 8 * c8 + e, s, x[e] * sw); }
        __syncthreads();
        Acc2 a0, a1; zero(a0); mm_acc(a0, VsT, KT, w, lane); zero(a1); mm_acc(a1, VsT + 64 * LS, KT, w, lane);
        float* dc = wsp<float>(F, WS_DC) + (size_t)u * 8192;
        each(a0, w, lane, [&](int m, int n, float v) { dc[m * 64 + n] = 0.125f * v; });
        each(a1, w, lane, [&](int m, int n, float v) { dc[(64 + m) * 64 + n] = 0.125f * v; });
        if (tid < 64) { float a = 0.f; for (int s = 0; s < 64; ++s) a += vec[256 + s] * bf2f(KT[tid * LS + s]); wsp<float>(F, WS_DN)[(size_t)u * 64 + tid] = 0.125f * a; }
        __syncthreads();
    }
}
__device__ __forceinline__ void l1_mlstm_c2(const Frame& F, int first_blk, int nblk) {
    using namespace rk;
    LAS bf16* Q = (LAS bf16*)F.lds; LAS bf16* K = Q + 64 * LS; LAS bf16* VT = K + 64 * LS; LAS bf16* Cm = VT + 128 * LS; LAS bf16* Pm = Cm + 128 * LS;
    LAS float* OH = (LAS float*)(F.lds + 7 * MB);
    LAS float* vec = (LAS float*)(F.lds + AUX_OFF); LAS int* rows = (LAS int*)vec;
    const bf16* Pg = wsp<const bf16>(F, WS_P); const int tid = F.tid, w = F.wave, lane = F.lane;
    for (int u = F.blk - first_blk; u < NUNIT_M; u += nblk) {
        const int cidx = u / 260, c = u - cidx * 260, z = cidx >> 3, b = (cidx >> 2) & 1, h = cidx & 3;
        mlstm_chunk_head(F, z, b, h, c, vec);
        const float mst = wsp<const float>(F, WS_MST)[u];
        if (tid < 64) { const int t = tid; float pm = -3.0e38f; for (int s = 0; s <= t; ++s) pm = fmaxf(pm, vec[64 + s] - vec[128 + s]);
            const float gi = vec[128 + t] + mst, mo = fmaxf(gi, vec[128 + t] + pm); vec[320 + t] = __expf(gi - mo); vec[384 + t] = mo;
            vec[256 + t] = wsp<const float>(F, WS_NST)[(size_t)u * 64 + t]; }
        { const int t = tid >> 3, c8 = tid & 7;
          *(LAS v4u*)(Q + t * LS + 8 * c8) = *(const v4u*)(Pg + (size_t)rows[t] * REC_NP + PC_Q + h * 64 + 8 * c8);
          *(LAS v4u*)(K + t * LS + 8 * c8) = *(const v4u*)(Pg + (size_t)rows[t] * REC_NP + PC_K + h * 64 + 8 * c8); }
#pragma unroll
        for (int i = 0; i < 2; ++i) { const int s = (tid >> 4) + 32 * i, c8 = tid & 15; const v4u wv = *(const v4u*)(Pg + (size_t)rows[s] * REC_NP + PC_V + h * 128 + 8 * c8);
            const unsigned ww[4] = {wv.x, wv.y, wv.z, wv.w};
#pragma unroll
            for (int e = 0; e < 4; ++e) { VT[(8 * c8 + 2 * e) * LS + s] = (bf16)(ww[e] & 0xffffu); VT[(8 * c8 + 2 * e + 1) * LS + s] = (bf16)(ww[e] >> 16); } }
        { const int v = tid >> 2, dq = (tid & 3) * 16; const f32x4* src = (const f32x4*)(wsp<const float>(F, WS_CST) + (size_t)u * 8192 + v * 64 + dq);
          const f32x4 x0 = src[0], x1 = src[1], x2 = src[2], x3 = src[3]; v4u o0, o1;
          o0.x = pk2(x0.x, x0.y); o0.y = pk2(x0.z, x0.w); o0.z = pk2(x1.x, x1.y); o0.w = pk2(x1.z, x1.w); o1.x = pk2(x2.x, x2.y); o1.y = pk2(x2.z, x2.w); o1.z = pk2(x3.x, x3.y); o1.w = pk2(x3.z, x3.w);
          *(LAS v4u*)(Cm + v * LS + dq) = o0; *(LAS v4u*)(Cm + v * LS + dq + 8) = o1; }
        __syncthreads();
        Acc2 aq, c0, c1; zero(aq); mm_acc(aq, Q, K, w, lane); zero(c0); mm_acc(c0, Q, Cm, w, lane); zero(c1); mm_acc(c1, Q, Cm + 64 * LS, w, lane);
        each(aq, w, lane, [&](int t, int s, float v) { stb(Pm, t, s, s <= t ? 0.125f * v * __expf(vec[128 + t] + (vec[64 + s] - vec[128 + s]) - vec[384 + t]) : 0.f); });
        __syncthreads();
        Acc2 p0, p1; zero(p0); mm_acc(p0, Pm, VT, w, lane); zero(p1); mm_acc(p1, Pm, VT + 64 * LS, w, lane);
        if (tid < 64) { const int t = tid; float rs = 0.f, nq = 0.f;
            for (int s = 0; s < 64; ++s) { rs += bf2f(Pm[t * LS + s]); nq += vec[256 + s] * bf2f(Q[t * LS + s]); }
            const float den = vec[320 + t] * nq + rs; vec[448 + t] = 1.f / fmaxf(fabsf(den), __expf(-vec[384 + t])); }
        __syncthreads();
        { const int m0 = (w >> 1) * 16 + (lane >> 4) * 4, n0 = (w & 1) * 32 + (lane & 15);
#pragma unroll
          for (int r = 0; r < 4; ++r) { const int t = m0 + r; const float g = vec[320 + t], idn = vec[448 + t];
              OH[t * 132 + n0] = (g * c0.t0[r] + p0.t0[r]) * idn; OH[t * 132 + n0 + 16] = (g * c0.t1[r] + p0.t1[r]) * idn;
              OH[t * 132 + 64 + n0] = (g * c1.t0[r] + p1.t0[r]) * idn; OH[t * 132 + 64 + n0 + 16] = (g * c1.t1[r] + p1.t1[r]) * idn; } }
        __syncthreads();
#pragma unroll
        for (int i = 0; i < 4; ++i) { const int it = tid + 512 * i, t = it >> 5, c4 = (it & 31) * 4;
            const f32x4 hv = *(const LAS f32x4*)(OH + t * 132 + c4); v2u hw; hw.x = pk2(hv.x, hv.y); hw.y = pk2(hv.z, hv.w);
            *(v2u*)(wsp<bf16>(F, WS_HM) + ((size_t)z * R + rows[t]) * 512 + h * 128 + c4) = hw; }
        __syncthreads();
    }
}
#ifndef MK_PER_PHASE
#define MK_PER_PHASE 0
#endif
constexpr int NPHASE = 26;
struct Args { const float* in[N_IN]; float* out; unsigned char* ws; int ph_lo, ph_hi, li, pad; };
#define GEMM_CALL(FnT, SchedT, g, S, fn) do { pg8::EpiGen<FnT> E_{fn}; { int k_ = g.K; asm volatile("" : "+s"(k_)); g.K = k_; } pg8::gemm_phase<pg8::EpiGen<FnT>, SchedT, true, true>((PG8_LAS unsigned char*)F.lds, g, S, E_); } while (0)
#ifndef SITE_MASK
#define SITE_MASK 0xFFFFFFFFull
#endif
#define SITE(s) (((SITE_MASK) >> (s)) & 1ull)
#ifndef DUP_MASK
#define DUP_MASK 0ull
#endif
#define NREP(s) ((((DUP_MASK) >> (s)) & 1ull) ? 2 : 1)
#define IN(k) (lo <= (k) && (k) < hi)
#define SEAM(k) do { if (IN(k) && IN((k) + 1)) xcd_barrier(bar); } while (0)
template <int LAYER> __device__ __forceinline__ void layer_phases(const Frame& F, const XcdBarrier& bar, const int lo, const int hi) {
    constexpr int layer = LAYER; constexpr int pb = 2 + 12 * LAYER;
        if (SITE(2) && IN(pb + 0)) { for (int rep_ = 0; rep_ < NREP(2); ++rep_) {
            const int N = layer == 0 ? ATT_NP : REC_NP;
            pg8::Gemm g{wsp<const bf16>(F, WS_A), layer == 0 ? wsp<const bf16>(F, WS_WIN0) : wsp<const bf16>(F, WS_WREC), R, N, 1024};
            pg8::StaticOrder S; S.init(R, N, F.G, F.blk);
            GEMM_CALL(FnStoreBf16, pg8::StaticOrder, g, S, (FnStoreBf16{wsp<bf16>(F, WS_P), N}));
             if (rep_ + 1 < NREP(2)) xcd_barrier(bar); } SEAM(pb + 0);
        }
        if constexpr (LAYER == 0) {
            if (SITE(3) && IN(pb + 1)) { for (int rep_ = 0; rep_ < NREP(3); ++rep_) { l0_post_proj(F);  if (rep_ + 1 < NREP(3)) xcd_barrier(bar); } SEAM(pb + 1); }
            if (SITE(4) && IN(pb + 2)) { for (int rep_ = 0; rep_ < NREP(4); ++rep_) {
                pg8::Gemm g{wsp<const bf16>(F, WS_CQN), wsp<const bf16>(F, WS_WUQ), R, 768, 384}; pg8::StaticOrder S; S.init(R, 768, F.G, F.blk);
                GEMM_CALL(FnStoreBf16, pg8::StaticOrder, g, S, (FnStoreBf16{wsp<bf16>(F, WS_MQ), 768}));
                 if (rep_ + 1 < NREP(4)) xcd_barrier(bar); } SEAM(pb + 2);
            }
            if (SITE(5) && IN(pb + 3)) { for (int rep_ = 0; rep_ < NREP(5); ++rep_) {
                pg8::Gemm g{wsp<const bf16>(F, WS_CKVN), wsp<const bf16>(F, WS_WUKV), R, 1024, 256}; pg8::StaticOrder S; S.init(R, 1024, F.G, F.blk);
                GEMM_CALL(FnStoreBf16, pg8::StaticOrder, g, S, (FnStoreBf16{wsp<bf16>(F, WS_MKV), 1024}));
                l0_mq_rope(F);
                 if (rep_ + 1 < NREP(5)) xcd_barrier(bar); } SEAM(pb + 3);
            }
            if (SITE(6) && IN(pb + 4)) { for (int rep_ = 0; rep_ < NREP(6); ++rep_) { l0_attention(F);  if (rep_ + 1 < NREP(6)) xcd_barrier(bar); } SEAM(pb + 4); }
            if (SITE(7) && IN(pb + 5)) { for (int rep_ = 0; rep_ < NREP(7); ++rep_) { l0_combine(F);  if (rep_ + 1 < NREP(7)) xcd_barrier(bar); } SEAM(pb + 5); }
        } else {
            if (SITE(8) && IN(pb + 1)) { for (int rep_ = 0; rep_ < NREP(8); ++rep_) { l1_rwkv_prep(F); l1_mlstm_a2(F);  if (rep_ + 1 < NREP(8)) xcd_barrier(bar); } SEAM(pb + 1); }
            if (SITE(9) && IN(pb + 2)) { for (int rep_ = 0; rep_ < NREP(9); ++rep_) {
                pg8::Gemm g{wsp<const bf16>(F, WS_ALORA), wsp<const bf16>(F, WS_WLORA), R, 2560, 384}; pg8::StaticOrder S; S.init(R, 2560, F.G, F.blk);
                { int k_ = g.K; asm volatile("" : "+s"(k_)); g.K = k_; EpiLora E_{&F}; pg8::gemm_phase<EpiLora, pg8::StaticOrder, true, true>((PG8_LAS unsigned char*)F.lds, g, S, E_); }
                l1_mlstm_b(F);
                 if (rep_ + 1 < NREP(9)) xcd_barrier(bar); } SEAM(pb + 2);
            }
            if (SITE(18) && IN(pb + 3)) { for (int rep_ = 0; rep_ < NREP(18); ++rep_) { l1_rk_phase_a(F); if (rep_ + 1 < NREP(18)) xcd_barrier(bar); } SEAM(pb + 3); }
            if (SITE(10) && IN(pb + 4)) { for (int rep_ = 0; rep_ < NREP(10); ++rep_) {
                if (F.G > 32) { if (F.blk < 32) l1_rk_phase_b(F); else { l1_mlstm_c2(F, 32, F.G - 32); moe_weights_convert(F, 1, (F.blk - 32) * 8 + F.wave, (F.G - 32) * 8); } }
                 if (rep_ + 1 < NREP(10)) xcd_barrier(bar); } SEAM(pb + 4);
            }
            if (SITE(11) && IN(pb + 5)) { for (int rep_ = 0; rep_ < NREP(11); ++rep_) { l1_rec_out(F);  if (rep_ + 1 < NREP(11)) xcd_barrier(bar); } SEAM(pb + 5); }
        }
        if (SITE(12) && IN(pb + 6)) { for (int rep_ = 0; rep_ < NREP(12); ++rep_) {
            pg8::Gemm g{wsp<const bf16>(F, WS_A1), wsp<const bf16>(F, WS_WOUT) + (size_t)layer * 1024 * 1024, R, 1024, 1024};
            if constexpr (LAYER == 0) { pg8::StaticOrder S; S.init(R, 1024, F.G, F.blk); GEMM_CALL(FnWout, pg8::StaticOrder, g, S, (FnWout{&F, layer})); }
            else { LatOrder S; S.o.init(R - 2 * CT, 1024, F.G, F.blk); GEMM_CALL(FnWout, LatOrder, g, S, (FnWout{&F, layer})); }
             if (rep_ + 1 < NREP(12)) xcd_barrier(bar); } SEAM(pb + 6);
        }
        if (SITE(13) && IN(pb + 7)) { for (int rep_ = 0; rep_ < NREP(13); ++rep_) { ph_router(F, layer);  if (rep_ + 1 < NREP(13)) xcd_barrier(bar); } SEAM(pb + 7); }
        if (SITE(14) && IN(pb + 8)) { for (int rep_ = 0; rep_ < NREP(14); ++rep_) { ph_gather(F, layer);  if (rep_ + 1 < NREP(14)) xcd_barrier(bar); } SEAM(pb + 8); }
        if (SITE(15) && IN(pb + 9)) { for (int rep_ = 0; rep_ < NREP(15); ++rep_) {
            const int* tab = wsp<const int>(F, WS_TILE);
            pg8::Gemm g{wsp<const bf16>(F, WS_F), wsp<const bf16>(F, WS_W1T), MAXROWS, NE * 2048, 1024}; MoeOrder S{tab + 1, __builtin_amdgcn_readfirstlane(tab[0]), 8, F.G, F.blk, wsp<const int>(F, WS_SRC)};
            { int k_ = g.K; asm volatile("" : "+s"(k_)); g.K = k_; pg8::EpiGen<FnSwiglu> E_{FnSwiglu{wsp<bf16>(F, WS_HS), F.in[I_B1] + (size_t)layer * NE * 2048}};
              pg8::gemm_phase<pg8::EpiGen<FnSwiglu>, MoeOrder, true, true, true>((PG8_LAS unsigned char*)F.lds, g, S, E_); }
             if (rep_ + 1 < NREP(15)) xcd_barrier(bar); } SEAM(pb + 9);
        }
        if (SITE(16) && IN(pb + 10)) { for (int rep_ = 0; rep_ < NREP(16); ++rep_) {
            const int* tab = wsp<const int>(F, WS_TILE);
            pg8::Gemm g{wsp<const bf16>(F, WS_HS), wsp<const bf16>(F, WS_W2T), MAXROWS, NE * 1024, 1024}; MoeOrder S{tab + 1, __builtin_amdgcn_readfirstlane(tab[0]), 4, F.G, F.blk, nullptr};
            GEMM_CALL(FnBiasBf16, MoeOrder, g, S, (FnBiasBf16{wsp<bf16>(F, WS_XS), F.in[I_B2] + (size_t)layer * NE * 1024}));
             if (rep_ + 1 < NREP(16)) xcd_barrier(bar); } SEAM(pb + 10);
        }
        if (SITE(17) && IN(pb + 11)) { for (int rep_ = 0; rep_ < NREP(17); ++rep_) { ph_combine(F, layer);  if (rep_ + 1 < NREP(17)) xcd_barrier(bar); } SEAM(pb + 11); }
}
__global__ void __launch_bounds__(512, 2) fwd(Args args) {
    extern __shared__ __attribute__((aligned(16))) unsigned char lds_[];
    Frame F;
    F.lds = (LAS unsigned char*)lds_; F.tid = threadIdx.x; F.lane = F.tid & 63; F.wave = __builtin_amdgcn_readfirstlane(F.tid >> 6); F.blk = blockIdx.x; F.G = gridDim.x; F.probe = args.pad;
    F.ws = args.ws; F.out = args.out; F.ctl = (gu32*)(args.ws + WS_CTL);
    F.in.t = (LAS const unsigned*)(F.lds + MISC_OFF + 8192);
    if (F.tid < 64) ((LAS unsigned*)(F.lds + MISC_OFF))[F.tid] = 0u;
    if (F.tid < N_IN) { const unsigned long long pv = (unsigned long long)args.in[F.tid]; ((LAS unsigned*)(F.lds + MISC_OFF + 8192))[2 * F.tid] = (unsigned)pv; ((LAS unsigned*)(F.lds + MISC_OFF + 8192))[2 * F.tid + 1] = (unsigned)(pv >> 32); }
    __syncthreads();
    const int lo = args.ph_lo, hi = args.ph_hi;
    XcdBarrier bar; bar.bar = (unsigned*)(F.ctl + CW_BAR) + args.li * XCD_BAR_WORDS; bar.x = 0; bar.st = nullptr;
    if (hi - lo > 1) bar = xcd_barrier_post((unsigned*)(F.ctl + CW_BAR) + args.li * XCD_BAR_WORDS, (volatile LAS unsigned*)(F.lds + MISC_OFF));
    if (SITE(0) && IN(0)) { for (int rep_ = 0; rep_ < NREP(0); ++rep_) { p0a(F);  if (rep_ + 1 < NREP(0)) xcd_barrier(bar); } SEAM(0); }
    if (SITE(1) && IN(1)) { for (int rep_ = 0; rep_ < NREP(1); ++rep_) { p0b(F);  if (rep_ + 1 < NREP(1)) xcd_barrier(bar); } SEAM(1); }
    layer_phases<0>(F, bar, lo, hi);
    layer_phases<1>(F, bar, lo, hi);
}
#undef IN
#undef SEAM


extern "C" void kernel_launch(void* const* d_in, const int* in_sizes, int n_in, void* d_out, int out_size, void* d_ws, size_t ws_size, hipStream_t stream) {
    static int grid = 0;
    if (grid == 0) {
        const bool ok = n_in == N_IN && in_sizes[I_X] == NBATCH * SEQ * DM && in_sizes[I_RECW] == 1024 * REC_IN && in_sizes[I_ATTW] == 1024 * ATT_IN && in_sizes[I_MU] == RWKV_IN &&
                        in_sizes[I_GATEB] == 16 && in_sizes[I_W1] == 2 * NE * 1024 * 2048 && out_size == NBATCH * SEQ * DM && ws_size >= WS_END;
        if (!ok) { fprintf(stderr, "kernel_launch: shape mismatch (n_in %d, recw %d, attw %d, mu %d, out %d, ws %zu need %zu); nothing launched\n", n_in, n_in > I_RECW ? in_sizes[I_RECW] : -1,
                           n_in > I_ATTW ? in_sizes[I_ATTW] : -1, n_in > I_MU ? in_sizes[I_MU] : -1, out_size, ws_size, (size_t)WS_END); grid = -1; return; }
        int dev = 0, cus = 0;
        if (hipGetDevice(&dev) != hipSuccess || hipDeviceGetAttribute(&cus, hipDeviceAttributeMultiprocessorCount, dev) != hipSuccess) { grid = -1; return; }
        if (hipFuncSetAttribute((const void*)fwd, hipFuncAttributeMaxDynamicSharedMemorySize, LDS_BYTES) != hipSuccess) { fprintf(stderr, "kernel_launch: hipFuncSetAttribute failed\n"); grid = -1; return; }
        int per_cu = 0;
        if (hipOccupancyMaxActiveBlocksPerMultiprocessor(&per_cu, (const void*)fwd, 512, LDS_BYTES) != hipSuccess || per_cu < 1) { fprintf(stderr, "kernel_launch: occupancy query says %d blocks per CU\n", per_cu); }
        (void)hipGetLastError();
        grid = cus < 256 ? cus : 256;
        if (grid != 256) fprintf(stderr, "kernel_launch: %d CUs; this kernel is written for a 256-CU device\n", cus);
    }
    if (grid < 0) return;
    if (hipMemsetAsync((char*)d_ws + WS_CTL, 0, CTL_ZERO_BYTES, stream) != hipSuccess) return;
    Args a{};
    for (int i = 0; i < N_IN; ++i) a.in[i] = (const float*)d_in[i];
    a.out = (float*)d_out; a.ws = (unsigned char*)d_ws; a.pad = 0;
#if MK_PER_PHASE
    for (int ph = 0; ph < NPHASE; ++ph) { a.ph_lo = ph; a.ph_hi = ph + 1; a.li = 0; hipLaunchKernelGGL(fwd, dim3(grid), dim3(512), LDS_BYTES, stream, a); }
#elif defined(PROBE_PRE)
    { const int plist[] = {PROBE_PRE}; int cur = 0, li = 0;
      for (int p : plist) { if (p > cur) { a.ph_lo = cur; a.ph_hi = p; a.li = li++; hipLaunchKernelGGL(fwd, dim3(grid), dim3(512), LDS_BYTES, stream, a); }
                            a.ph_lo = p; a.ph_hi = p + 1; a.li = li++; a.pad = 1; hipLaunchKernelGGL(fwd, dim3(grid), dim3(512), LDS_BYTES, stream, a); a.pad = 0; cur = p; }
      a.ph_lo = cur; a.ph_hi = NPHASE; a.li = li++; hipLaunchKernelGGL(fwd, dim3(grid), dim3(512), LDS_BYTES, stream, a); }
#elif defined(PROBE_LIST)
    { const int plist[] = {PROBE_LIST}; int cur = 0, li = 0;
      for (int p : plist) { a.ph_lo = cur; a.ph_hi = p + 1; a.li = li++; hipLaunchKernelGGL(fwd, dim3(grid), dim3(512), LDS_BYTES, stream, a);
                            a.ph_lo = p; a.ph_hi = p + 1; a.li = li++; a.pad = 1; hipLaunchKernelGGL(fwd, dim3(grid), dim3(512), LDS_BYTES, stream, a); a.pad = 0; cur = p + 1; }
      if (cur < NPHASE) { a.ph_lo = cur; a.ph_hi = NPHASE; a.li = li++; hipLaunchKernelGGL(fwd, dim3(grid), dim3(512), LDS_BYTES, stream, a); } }
#else
    a.ph_lo = 0; a.ph_hi = NPHASE; a.li = 0; hipLaunchKernelGGL(fwd, dim3(grid), dim3(512), LDS_BYTES, stream, a);
#endif
    const hipError_t le = hipPeekAtLastError();
    if (le != hipSuccess) fprintf(stderr, "kernel_launch: launch failed: %s\n", hipGetErrorName(le));
}
```
